# Optimizing an MI355X kernel written in HIP

```python
import math
import jax
import jax.numpy as jnp
from jax import lax
import numpy as np

D_MODEL = 1024
BATCH = 2
SEQ = 16384
DEPTH = 2

GRID_W = 64
CTX_LEN = 256
NORM_EPS = 1e-6

D_MIX = D_MODEL
HEAD_DIM = 64
NA_WIDTH = D_MIX // 2
NA_HEADS = NA_WIDTH // HEAD_DIM
NA_WIN_ROWS = 8
NA_WIN_COLS = 16
NA_QBLOCK_ROWS = 2
RW_WIDTH = D_MIX // 4
RW_HEADS = RW_WIDTH // HEAD_DIM
RW_DECAY_LORA = 32
RW_ICLR_LORA = 32
RW_GATE_LORA = 64
RW_GN_EPS = 64e-5
GD_WIDTH = D_MIX - NA_WIDTH - RW_WIDTH
GD_HEADS = GD_WIDTH // HEAD_DIM
GD_CONV = 5
GD_CHUNK = 64
NA_COLS = 3 * NA_WIDTH
RW_COLS = 3 * RW_WIDTH + RW_DECAY_LORA + RW_ICLR_LORA + RW_GATE_LORA
GD_COLS = 4 * GD_WIDTH + 4 * GD_HEADS
P_IN = NA_COLS + RW_COLS + GD_COLS
N_EXPERTS = 32
TOP_K = 4
D_EXPERT = D_MODEL
SWIGLU_LIMIT = 7.0
SWIGLU_ALPHA = 1.702
MOE_BLOCK = 128

kernel_name = 'hybrid_na_rwkv7_gdn_moe_dit'


def rms_norm(x, g):
    xf = x.astype(jnp.float32)
    return xf * lax.rsqrt(jnp.mean(xf * xf, axis=-1, keepdims=True) + NORM_EPS) * g


def l2_norm(x):
    xf = x.astype(jnp.float32)
    return xf * lax.rsqrt(jnp.sum(xf * xf, axis=-1, keepdims=True) + NORM_EPS)


def split_heads(t, n_heads):
    B, T, C = t.shape
    return t.reshape(B, T, n_heads, C // n_heads).transpose(0, 2, 1, 3)


def merge_heads(t):
    B, H, T, dh = t.shape
    return t.transpose(0, 2, 1, 3).reshape(B, T, H * dh)


def centred_token_shift(p, mu):
    zero = jnp.zeros_like(p[:, :1])
    prev = jnp.concatenate([zero, p[:, :-1]], axis=1)
    nxt = jnp.concatenate([p[:, 1:], zero], axis=1)
    return p + mu * (0.5 * (prev + nxt) - p)


def depthwise_conv_centred(x, w):
    K, C = w.shape
    return lax.conv_general_dilated(x, w[:, None, :].astype(x.dtype), window_strides=(1,),
                                    padding=((K // 2, K // 2),),
                                    dimension_numbers=('NWC', 'WIO', 'NWC'),
                                    feature_group_count=C)


def neighbourhood_attention(q, k, v, qc, kc, vc, rpb):
    B, H, S, dh = q.shape
    rows = S // GRID_W
    kr = min(NA_WIN_ROWS, rows)
    kw = NA_WIN_COLS
    qblk = NA_QBLOCK_ROWS * GRID_W
    n_loc = kr * kw
    scale = dh ** -0.5
    col = jnp.arange(GRID_W)
    key_c = jnp.clip(col - kw // 2, 0, GRID_W - kw)[:, None] + jnp.arange(kw)
    dc = key_c - col[:, None] + (NA_WIN_COLS - 1)

    def block(b):
        r = b * NA_QBLOCK_ROWS + jnp.arange(NA_QBLOCK_ROWS)
        key_r = jnp.clip(r - kr // 2, 0, rows - kr)[:, None] + jnp.arange(kr)
        dr = key_r - r[:, None] + (NA_WIN_ROWS - 1)
        kidx = (key_r[:, None, :, None] * GRID_W + key_c[None, :, None, :]).reshape(qblk, n_loc)
        bias = rpb[:, dr[:, None, :, None], dc[None, :, None, :]].reshape(H, qblk, n_loc)
        qb = lax.dynamic_slice_in_dim(q, b * qblk, qblk, axis=2)
        kg = jnp.take(k, kidx, axis=2)
        vg = jnp.take(v, kidx, axis=2)
        s_loc = jnp.einsum('bhqd,bhqkd->bhqk', qb, kg) * scale + bias
        s_ctx = jnp.einsum('bhqd,bhcd->bhqc', qb, kc) * scale
        prob = jax.nn.softmax(jnp.concatenate([s_loc, s_ctx], axis=-1).astype(jnp.float32), axis=-1)
        return (jnp.einsum('bhqk,bhqkd->bhqd', prob[..., :n_loc], vg)
                + jnp.einsum('bhqc,bhcd->bhqd', prob[..., n_loc:], vc))

    out = lax.map(block, jnp.arange(rows // NA_QBLOCK_ROWS))
    return jnp.moveaxis(out, 0, 2).reshape(B, H, S, dh)


def context_attention(qc, kc, vc):
    s = jnp.einsum('bhqd,bhkd->bhqk', qc, kc) * qc.shape[-1] ** -0.5
    prob = jax.nn.softmax(s.astype(jnp.float32), axis=-1)
    return jnp.einsum('bhqk,bhkd->bhqd', prob, vc)


def na_mixer(p, pc, q_gain, k_gain, rpb):
    def qkv(t):
        q, k, v = jnp.split(t, 3, axis=-1)
        return (rms_norm(split_heads(q, NA_HEADS), q_gain),
                rms_norm(split_heads(k, NA_HEADS), k_gain),
                split_heads(v, NA_HEADS))
    q, k, v = qkv(p)
    qc, kc, vc = qkv(pc)
    return (merge_heads(neighbourhood_attention(q, k, v, qc, kc, vc, rpb)),
            merge_heads(context_attention(qc, kc, vc)))


def rwkv7_prepare(p, mu, w0, w_up, a0, a_up, g_up, k_k, k_a):
    B, T, _ = p.shape
    W = RW_WIDTH
    p = centred_token_shift(p, mu)
    r, k, v = p[..., :W], p[..., W:2 * W], p[..., 2 * W:3 * W]
    o = 3 * W
    wd = p[..., o:o + RW_DECAY_LORA]
    o += RW_DECAY_LORA
    ad = p[..., o:o + RW_ICLR_LORA]
    o += RW_ICLR_LORA
    gd = p[..., o:]
    gate = jax.nn.sigmoid(gd) @ g_up
    hd = lambda t: t.reshape(t.shape[:-1] + (RW_HEADS, HEAD_DIM))
    kk = l2_norm(hd(k * k_k))
    w_log = -jax.nn.softplus(-(w0[:, None, None, :] + jnp.einsum('btr,drc->dbtc', jnp.tanh(wd), w_up))) - 0.5
    decay = jnp.exp(-jnp.exp(w_log))
    a = jax.nn.sigmoid(a0[:, None, None, :] + jnp.einsum('btr,drc->dbtc', ad, a_up))
    k_dir = k[None] * (1 + (a - 1) * k_a)
    return hd(r), hd(v), kk, gate, hd(decay), hd(a), hd(k_dir)


def rwkv7_scan(r, decay, k, v, kk, a, s0, reverse):
    xs = tuple(jnp.moveaxis(t.astype(jnp.float32), 1, 0) for t in (r, decay, k, v, kk, a))

    def step(S, inp):
        r_t, w_t, k_t, v_t, kk_t, a_t = inp
        s_kk = jnp.einsum('bhvk,bhk->bhv', S, kk_t)
        S = (S * w_t[:, :, None, :] - s_kk[..., None] * (kk_t * a_t)[:, :, None, :]
             + v_t[..., None] * k_t[:, :, None, :])
        return S, jnp.einsum('bhvk,bhk->bhv', S, r_t)

    S, ys = lax.scan(step, s0, xs, reverse=reverse)
    return jnp.moveaxis(ys, 0, 1), S


def rwkv7_output(y, r, v, k_dir, gate, r_k, ln_w, ln_b):
    B, T, H, N = y.shape
    mean = jnp.mean(y, axis=-1, keepdims=True)
    var = jnp.mean(jnp.square(y - mean), axis=-1, keepdims=True)
    yn = ((y - mean) * lax.rsqrt(var + RW_GN_EPS)).reshape(B, T, H * N) * ln_w + ln_b
    bonus = jnp.sum(jnp.sum(r[None] * k_dir * r_k, axis=-1, keepdims=True), axis=0)
    return (yn + (bonus * v).reshape(B, T, H * N)) * gate


def rwkv7_mixer(p, pc, mu, w0, w_up, a0, a_up, g_up, k_k, k_a, r_k, ln_w, ln_b):
    lat = rwkv7_prepare(p, mu, w0, w_up, a0, a_up, g_up, k_k, k_a)
    ctx = rwkv7_prepare(pc, mu, w0, w_up, a0, a_up, g_up, k_k, k_a)
    B = p.shape[0]
    s0 = jnp.zeros((B, RW_HEADS, HEAD_DIM, HEAD_DIM), jnp.float32)
    y_lat = 0.0
    y_ctx = 0.0
    for d, rev in ((0, False), (1, True)):
        r, v, kk, _, decay, a, k_dir = ctx
        yc, s_ctx = rwkv7_scan(r, decay[d], k_dir[d], v, kk, a[d], s0, rev)
        r, v, kk, _, decay, a, k_dir = lat
        yl, _ = rwkv7_scan(r, decay[d], k_dir[d], v, kk, a[d], s_ctx, rev)
        y_ctx = y_ctx + yc
        y_lat = y_lat + yl
    out_lat = rwkv7_output(y_lat, lat[0], lat[1], lat[6], lat[3], r_k, ln_w, ln_b)
    out_ctx = rwkv7_output(y_ctx, ctx[0], ctx[1], ctx[6], ctx[3], r_k, ln_w, ln_b)
    return out_lat, out_ctx


def gated_delta_chunked(q, k, v, g, beta, s0):
    q, k, v, g, beta, s0 = (t.astype(jnp.float32) for t in (q, k, v, g, beta, s0))
    B, H, T, dk = q.shape
    dv = v.shape[-1]
    C = GD_CHUNK
    n = T // C
    q = (q * dk ** -0.5).reshape(B, H, n, C, dk)
    k = k.reshape(B, H, n, C, dk)
    v = v.reshape(B, H, n, C, dv)
    gc = jnp.cumsum(g.reshape(B, H, n, C), axis=-1)
    beta = beta.reshape(B, H, n, C)
    kb = k * beta[..., None]
    vb = v * beta[..., None]
    incl = jnp.tril(jnp.ones((C, C), bool))
    strict = jnp.tril(jnp.ones((C, C), bool), -1)
    decay_mask = jnp.exp(jnp.where(incl, gc[..., :, None] - gc[..., None, :], -jnp.inf))
    m = jnp.where(strict, jnp.einsum('bhnid,bhnjd->bhnij', kb, k) * decay_mask, 0.0)
    eye = jnp.eye(C, dtype=jnp.float32)
    t_inv = lax.linalg.triangular_solve(m + eye, jnp.broadcast_to(eye, m.shape), left_side=True,
                                        lower=True, unit_diagonal=True)
    u = t_inv @ vb
    w = t_inv @ (kb * jnp.exp(gc)[..., None])
    qk = jnp.einsum('bhnid,bhnjd->bhnij', q, k) * decay_mask
    qg = q * jnp.exp(gc)[..., None]
    kd = k * jnp.exp(gc[..., -1:] - gc)[..., None]
    decay_last = jnp.exp(gc[..., -1])
    xs = tuple(jnp.moveaxis(t, 2, 0) for t in (qg, qk, u, w, kd, decay_last))

    def step(S, inp):
        qg_i, qk_i, u_i, w_i, kd_i, dl_i = inp
        v_new = u_i - w_i @ S
        o = qg_i @ S + qk_i @ v_new
        S = S * dl_i[..., None, None] + jnp.einsum('bhck,bhcv->bhkv', kd_i, v_new)
        return S, o

    S, o = lax.scan(step, s0, xs)
    return jnp.moveaxis(o, 0, 2).reshape(B, H, T, dv), S


def gdn_prepare(p, conv_w, A_log, dt_bias):
    B, T, _ = p.shape
    W = GD_WIDTH
    qkv = jax.nn.silu(depthwise_conv_centred(p[..., :3 * W], conv_w))
    q = l2_norm(split_heads(qkv[..., :W], GD_HEADS))
    k = l2_norm(split_heads(qkv[..., W:2 * W], GD_HEADS))
    v = split_heads(qkv[..., 2 * W:], GD_HEADS)
    z = split_heads(p[..., 3 * W:4 * W], GD_HEADS)
    a = p[..., 4 * W:4 * W + 2 * GD_HEADS].reshape(B, T, 2, GD_HEADS)
    b = p[..., 4 * W + 2 * GD_HEADS:].reshape(B, T, 2, GD_HEADS)
    g = -jnp.exp(A_log) * jax.nn.softplus(a + dt_bias)
    beta = jax.nn.sigmoid(b)
    return q, k, v, z, jnp.transpose(g, (2, 0, 3, 1)), jnp.transpose(beta, (2, 0, 3, 1))


def gdn_mixer(p, pc, conv_w, A_log, dt_bias, norm_g):
    ql, kl, vl, zl, gl, bl = gdn_prepare(p, conv_w, A_log, dt_bias)
    qc, kc, vc, zc, gcx, bcx = gdn_prepare(pc, conv_w, A_log, dt_bias)
    B = p.shape[0]
    s0 = jnp.zeros((B, GD_HEADS, HEAD_DIM, HEAD_DIM), jnp.float32)
    fl = lambda t: jnp.flip(t, axis=2)
    oc_f, s_f = gated_delta_chunked(qc, kc, vc, gcx[0], bcx[0], s0)
    ol_f, _ = gated_delta_chunked(ql, kl, vl, gl[0], bl[0], s_f)
    oc_b, s_b = gated_delta_chunked(fl(qc), fl(kc), fl(vc), fl(gcx[1]), fl(bcx[1]), s0)
    ol_b, _ = gated_delta_chunked(fl(ql), fl(kl), fl(vl), fl(gl[1]), fl(bl[1]), s_b)
    out_lat = merge_heads(rms_norm(ol_f + fl(ol_b), norm_g) * jax.nn.silu(zl))
    out_ctx = merge_heads(rms_norm(oc_f + fl(oc_b), norm_g) * jax.nn.silu(zc))
    return out_lat, out_ctx


def moe_ffn(h, router_w, router_b, w_gu, b_gu, w_down, b_down):
    T, D = h.shape
    logits = (h @ router_w + router_b).astype(jnp.float32)
    top_val, top_idx = lax.top_k(logits, TOP_K)
    gates = jax.nn.softmax(top_val, axis=-1)
    tk = T * TOP_K
    flat_e = top_idx.reshape(tk)
    flat_tok = jnp.arange(tk, dtype=jnp.int32) // TOP_K
    order = jnp.argsort(flat_e)
    se, stok, sgate = flat_e[order], flat_tok[order], gates.reshape(tk)[order]
    counts = jnp.bincount(flat_e, length=N_EXPERTS)
    padded = (counts + MOE_BLOCK - 1) // MOE_BLOCK * MOE_BLOCK
    pad_end = jnp.cumsum(padded)
    pad_start = pad_end - padded
    start = jnp.cumsum(counts) - counts
    dest = pad_start[se] + jnp.arange(tk, dtype=jnp.int32) - start[se]
    n_pad = -(-tk // MOE_BLOCK) * MOE_BLOCK + N_EXPERTS * MOE_BLOCK
    n_blocks = n_pad // MOE_BLOCK
    buf_tok = jnp.full((n_pad,), T, jnp.int32).at[dest].set(stok)
    buf_gate = jnp.zeros((n_pad,), jnp.float32).at[dest].set(sgate)
    blk_e = jnp.minimum(jnp.searchsorted(pad_end, jnp.arange(n_blocks) * MOE_BLOCK, side='right'), N_EXPERTS - 1)
    h_pad = jnp.concatenate([h, jnp.zeros((1, D), h.dtype)], axis=0)
    xb = h_pad[buf_tok].reshape(n_blocks, MOE_BLOCK, D)

    def expert_block(args):
        xk, e = args
        gu = xk @ w_gu[e] + b_gu[e]
        gate = jnp.minimum(gu[:, :D_EXPERT], SWIGLU_LIMIT)
        lin = jnp.clip(gu[:, D_EXPERT:], -SWIGLU_LIMIT, SWIGLU_LIMIT)
        act = gate * jax.nn.sigmoid(SWIGLU_ALPHA * gate) * (lin + 1)
        return act @ w_down[e] + b_down[e]

    yb = lax.map(expert_block, (xb, blk_e))
    y = yb.reshape(n_pad, D) * buf_gate[:, None]
    return jnp.zeros((T + 1, D), y.dtype).at[buf_tok].add(y)[:T]


def setup_inputs(seed: int = 0) -> dict:
    key = jax.random.key(seed)
    keys = iter(jax.random.split(key, 40))

    def nrm(shape, std):
        return std * jax.random.normal(next(keys), shape, jnp.float32)

    def uni(shape, lo, hi):
        return jax.random.uniform(next(keys), shape, jnp.float32, lo, hi)

    L, D = DEPTH, D_MODEL
    x = nrm((BATCH, SEQ, D), 1.0)
    c = nrm((BATCH, D), 1.0)
    ctx = nrm((BATCH, CTX_LEN, D), 1.0)
    c_ctx = nrm((D,), 1.0)
    ada_w = nrm((L, D, 6 * D), 0.5 * D ** -0.5)
    ada_b = nrm((L, 6 * D), 0.02)
    norm_mix_g = 1.0 + nrm((L, D), 0.05)
    norm_ffn_g = 1.0 + nrm((L, D), 0.05)
    w_in = nrm((L, D, P_IN), D ** -0.5)
    w_out = nrm((L, D_MIX, D), D_MIX ** -0.5)
    na_q_gain = 1.0 + nrm((L, HEAD_DIM), 0.05)
    na_k_gain = 1.0 + nrm((L, HEAD_DIM), 0.05)
    na_rpb = nrm((L, NA_HEADS, 2 * NA_WIN_ROWS - 1, 2 * NA_WIN_COLS - 1), 0.1)
    rw_mu = uni((L, RW_COLS), 0.0, 1.0)
    rw_w0 = uni((L, 2, RW_WIDTH), -5.0, 1.0)
    rw_w_up = nrm((L, 2, RW_DECAY_LORA, RW_WIDTH), 0.1)
    rw_a0 = nrm((L, 2, RW_WIDTH), 0.1)
    rw_a_up = nrm((L, 2, RW_ICLR_LORA, RW_WIDTH), RW_ICLR_LORA ** -0.5)
    rw_g_up = nrm((L, RW_GATE_LORA, RW_WIDTH), RW_GATE_LORA ** -0.5)
    rw_k_k = 0.85 + nrm((L, RW_WIDTH), 0.05)
    rw_k_a = 1.0 + nrm((L, RW_WIDTH), 0.05)
    rw_r_k = nrm((L, RW_HEADS, HEAD_DIM), 0.1)
    rw_ln_w = 1.0 + nrm((L, RW_WIDTH), 0.05)
    rw_ln_b = nrm((L, RW_WIDTH), 0.02)
    gd_conv_w = nrm((L, GD_CONV, 3 * GD_WIDTH), GD_CONV ** -0.5)
    gd_A_log = jnp.log(uni((L, 2, GD_HEADS), 1.0, 16.0))
    dt = jnp.exp(uni((L, 2, GD_HEADS), math.log(1e-3), math.log(1e-1)))
    gd_dt_bias = dt + jnp.log(-jnp.expm1(-dt))
    gd_norm_g = 1.0 + nrm((L, HEAD_DIM), 0.05)
    moe_router_w = nrm((L, D, N_EXPERTS), D ** -0.5)
    moe_router_b = nrm((L, N_EXPERTS), 0.01)
    moe_w_gu = nrm((L, N_EXPERTS, D, 2 * D_EXPERT), D ** -0.5)
    moe_b_gu = nrm((L, N_EXPERTS, 2 * D_EXPERT), 0.01)
    moe_w_down = nrm((L, N_EXPERTS, D_EXPERT, D), D_EXPERT ** -0.5)
    moe_b_down = nrm((L, N_EXPERTS, D), 0.01)
    return {'x': x, 'c': c, 'ctx': ctx, 'c_ctx': c_ctx, 'ada_w': ada_w, 'ada_b': ada_b,
            'norm_mix_g': norm_mix_g, 'norm_ffn_g': norm_ffn_g, 'w_in': w_in, 'w_out': w_out,
            'na_q_gain': na_q_gain, 'na_k_gain': na_k_gain, 'na_rpb': na_rpb,
            'rw_mu': rw_mu, 'rw_w0': rw_w0, 'rw_w_up': rw_w_up, 'rw_a0': rw_a0, 'rw_a_up': rw_a_up,
            'rw_g_up': rw_g_up, 'rw_k_k': rw_k_k, 'rw_k_a': rw_k_a, 'rw_r_k': rw_r_k,
            'rw_ln_w': rw_ln_w, 'rw_ln_b': rw_ln_b,
            'gd_conv_w': gd_conv_w, 'gd_A_log': gd_A_log, 'gd_dt_bias': gd_dt_bias, 'gd_norm_g': gd_norm_g,
            'moe_router_w': moe_router_w, 'moe_router_b': moe_router_b, 'moe_w_gu': moe_w_gu,
            'moe_b_gu': moe_b_gu, 'moe_w_down': moe_w_down, 'moe_b_down': moe_b_down}


def reference(x, c, ctx, c_ctx, ada_w, ada_b, norm_mix_g, norm_ffn_g, w_in, w_out,
              na_q_gain, na_k_gain, na_rpb,
              rw_mu, rw_w0, rw_w_up, rw_a0, rw_a_up, rw_g_up, rw_k_k, rw_k_a, rw_r_k, rw_ln_w, rw_ln_b,
              gd_conv_w, gd_A_log, gd_dt_bias, gd_norm_g,
              moe_router_w, moe_router_b, moe_w_gu, moe_b_gu, moe_w_down, moe_b_down):
    B, S, D = x.shape
    n_ctx = ctx.shape[1]
    a_end = NA_COLS
    b_end = NA_COLS + RW_COLS
    for l in range(DEPTH):
        last = l == DEPTH - 1
        sh1, sc1, g1, sh2, sc2, g2 = jnp.split(jax.nn.silu(c) @ ada_w[l] + ada_b[l], 6, axis=-1)
        sh1c, sc1c, g1c, sh2c, sc2c, g2c = jnp.split(jax.nn.silu(c_ctx) @ ada_w[l] + ada_b[l], 6, axis=-1)
        h = rms_norm(x, norm_mix_g[l]) * (1 + sc1[:, None]) + sh1[:, None]
        hc = rms_norm(ctx, norm_mix_g[l]) * (1 + sc1c) + sh1c
        p = h @ w_in[l]
        pc = hc @ w_in[l]
        o_na, oc_na = na_mixer(p[..., :a_end], pc[..., :a_end], na_q_gain[l], na_k_gain[l], na_rpb[l])
        o_rw, oc_rw = rwkv7_mixer(p[..., a_end:b_end], pc[..., a_end:b_end], rw_mu[l], rw_w0[l], rw_w_up[l],
                                  rw_a0[l], rw_a_up[l], rw_g_up[l], rw_k_k[l], rw_k_a[l], rw_r_k[l],
                                  rw_ln_w[l], rw_ln_b[l])
        o_gd, oc_gd = gdn_mixer(p[..., b_end:], pc[..., b_end:], gd_conv_w[l], gd_A_log[l], gd_dt_bias[l],
                                gd_norm_g[l])
        x = x + g1[:, None] * (jnp.concatenate([o_na, o_rw, o_gd], axis=-1) @ w_out[l])
        h2 = rms_norm(x, norm_ffn_g[l]) * (1 + sc2[:, None]) + sh2[:, None]
        if last:
            y = moe_ffn(h2.reshape(B * S, D), moe_router_w[l], moe_router_b[l], moe_w_gu[l], moe_b_gu[l],
                        moe_w_down[l], moe_b_down[l])
            x = x + g2[:, None] * y.reshape(B, S, D)
        else:
            ctx = ctx + g1c * (jnp.concatenate([oc_na, oc_rw, oc_gd], axis=-1) @ w_out[l])
            hc2 = rms_norm(ctx, norm_ffn_g[l]) * (1 + sc2c) + sh2c
            y = moe_ffn(jnp.concatenate([h2.reshape(B * S, D), hc2.reshape(B * n_ctx, D)], axis=0),
                        moe_router_w[l], moe_router_b[l], moe_w_gu[l], moe_b_gu[l],
                        moe_w_down[l], moe_b_down[l])
            x = x + g2[:, None] * y[:B * S].reshape(B, S, D)
            ctx = ctx + g2c * y[B * S:].reshape(B, n_ctx, D)
    return x
```

```cpp
#include <hip/hip_runtime.h>
#include <hip/hip_bf16.h>
#include <hip/hip_cooperative_groups.h>
#include <stdint.h>
namespace cg = cooperative_groups;

typedef __attribute__((ext_vector_type(8))) short bf16x8;
typedef __attribute__((ext_vector_type(4))) short bf16x4;
typedef __attribute__((ext_vector_type(4))) float f32x4;
typedef unsigned short bfr;

#define D_MODEL 1024
#define NB 2
#define SEQ 16384
#define CTXL 256
#define NLAT (NB * SEQ)
#define NCTX (NB * CTXL)
#define NTOK (NLAT + NCTX)
#define TTOK (SEQ + CTXL)
#define PIN 3472
#define PINP 3584
#define A_END 1536
#define B_END 2432
#define NEXP 32
#define NSLOT_MAX (NTOK * 4 + NEXP * 256)
#define NTHR 512
#define LDS_BYTES 57344

constexpr size_t al256(size_t x) { return (x + 255) & ~(size_t)255; }
constexpr size_t WL_IN = 0;
constexpr size_t WL_OUT = WL_IN + (size_t)PINP * 1024 * 2;
constexpr size_t WL_GU = WL_OUT + (size_t)1024 * 1024 * 2;
constexpr size_t WL_DN = WL_GU + (size_t)32 * 2048 * 1024 * 2;
constexpr size_t WL_SIZE = WL_DN + (size_t)32 * 1024 * 1024 * 2;
constexpr size_t OFF_W = 0;
constexpr size_t OFF_MODS = al256(OFF_W + 2 * WL_SIZE);
constexpr size_t OFF_CTX = al256(OFF_MODS + 2 * 3 * 6144 * 4);
constexpr size_t OFF_CNT = al256(OFF_CTX + (size_t)NCTX * 1024 * 4);
constexpr size_t OFF_TOKE = al256(OFF_CNT + 256);
constexpr size_t OFF_TOKP = al256(OFF_TOKE + (size_t)NTOK * 4 * 4);
constexpr size_t OFF_TOKG = al256(OFF_TOKP + (size_t)NTOK * 4 * 4);
constexpr size_t OFF_TOKS = al256(OFF_TOKG + (size_t)NTOK * 4 * 4);
constexpr size_t OFF_SLT = al256(OFF_TOKS + (size_t)NTOK * 4 * 4);
constexpr size_t OFF_SLG = al256(OFF_SLT + (size_t)NSLOT_MAX * 4);
constexpr size_t OFF_H = al256(OFF_SLG + (size_t)NSLOT_MAX * 4);
constexpr size_t OFF_CC = al256(OFF_H + (size_t)NTOK * 1024 * 2);
constexpr size_t OFF_P = al256(OFF_CC + (size_t)NTOK * 1024 * 2);
constexpr size_t OFF_S = al256(OFF_P + (size_t)NTOK * PINP * 4);
constexpr size_t TOK256F = (size_t)NTOK * 256 * 4;
constexpr size_t S_QN = 0;
constexpr size_t S_KN = S_QN + (size_t)NTOK * 512 * 2;
constexpr size_t S_VT = S_KN + (size_t)NTOK * 512 * 2;
constexpr size_t S_RWR = S_VT + (size_t)NB * 8 * 64 * TTOK * 2;
constexpr size_t S_RWKK = S_RWR + TOK256F;
constexpr size_t S_RWV = S_RWKK + TOK256F;
constexpr size_t S_RWG = S_RWV + TOK256F;
constexpr size_t S_RWW = S_RWG + TOK256F;
constexpr size_t S_RWKD = S_RWW + 2 * TOK256F;
constexpr size_t S_RWB = S_RWKD + 2 * TOK256F;
constexpr size_t S_BON = S_RWB + 2 * TOK256F;
constexpr size_t S_GDQ = al256(S_BON + (size_t)NTOK * 4 * 4);
constexpr size_t S_GDK = S_GDQ + TOK256F;
constexpr size_t S_GDV = S_GDK + TOK256F;
constexpr size_t S_GDAB = S_GDV + TOK256F;
constexpr size_t S_YRW = al256(S_GDAB + (size_t)NTOK * 16 * 4);
constexpr size_t S_YGD = S_YRW + 2 * TOK256F;
constexpr size_t S_END = S_YGD + 2 * TOK256F;
constexpr size_t S_SIZE = (S_END > (size_t)NSLOT_MAX * 1024 * 4) ? S_END : (size_t)NSLOT_MAX * 1024 * 4;
constexpr size_t WS_TOTAL = OFF_S + S_SIZE;

struct Params {
  const float *x, *c, *ctx, *c_ctx, *ada_w, *ada_b, *norm_mix_g, *norm_ffn_g, *w_in, *w_out;
  const float *na_q_gain, *na_k_gain, *na_rpb;
  const float *rw_mu, *rw_w0, *rw_w_up, *rw_a0, *rw_a_up, *rw_g_up, *rw_k_k, *rw_k_a, *rw_r_k, *rw_ln_w, *rw_ln_b;
  const float *gd_conv_w, *gd_A_log, *gd_dt_bias, *gd_norm_g;
  const float *moe_router_w, *moe_router_b, *moe_w_gu, *moe_b_gu, *moe_w_down, *moe_b_down;
  float* out;
  char* ws;
};

__device__ __forceinline__ bfr f2bf(float f) {
  unsigned u = __float_as_uint(f);
  u += 0x7fffu + ((u >> 16) & 1u);
  return (bfr)(u >> 16);
}
__device__ __forceinline__ float sigmoidf_(float x) { return 1.f / (1.f + __expf(-x)); }
__device__ __forceinline__ float siluf_(float x) { return x / (1.f + __expf(-x)); }
__device__ __forceinline__ float softplusf_(float x) { return x > 20.f ? x : log1pf(__expf(x)); }
__device__ __forceinline__ float wave_sum(float v) {
#pragma unroll
  for (int o = 32; o >= 1; o >>= 1) v += __shfl_xor(v, o, 64);
  return v;
}
__device__ __forceinline__ float row16_sum(float v) {
  v += __builtin_bit_cast(float, __builtin_amdgcn_update_dpp(0, __builtin_bit_cast(int, v), 0xB1, 0xF, 0xF, true));
  v += __builtin_bit_cast(float, __builtin_amdgcn_update_dpp(0, __builtin_bit_cast(int, v), 0x4E, 0xF, 0xF, true));
  v += __builtin_bit_cast(float, __builtin_amdgcn_update_dpp(0, __builtin_bit_cast(int, v), 0x141, 0xF, 0xF, true));
  v += __builtin_bit_cast(float, __builtin_amdgcn_update_dpp(0, __builtin_bit_cast(int, v), 0x140, 0xF, 0xF, true));
  return v;
}
__device__ __forceinline__ int mod_row(int m) { return m < NLAT ? (m >> 14) : 2; }

__device__ void phase_ada(const Params& p, int bid, int nb, char* smem) {
  float* red = (float*)smem;
  float* mods = (float*)(p.ws + OFF_MODS);
  const int tid = threadIdx.x;
  for (int task = bid; task < 2 * 96; task += nb) {
    int l = task / 96, cgp = task % 96;
    int col = cgp * 64 + (tid & 63), ks = tid >> 6;
    const float* W = p.ada_w + (size_t)l * 1024 * 6144;
    float a0 = 0.f, a1 = 0.f, a2 = 0.f;
    for (int d = ks * 128; d < ks * 128 + 128; ++d) {
      float w = W[(size_t)d * 6144 + col];
      a0 += siluf_(p.c[d]) * w;
      a1 += siluf_(p.c[1024 + d]) * w;
      a2 += siluf_(p.c_ctx[d]) * w;
    }
    red[(ks * 3 + 0) * 64 + (tid & 63)] = a0;
    red[(ks * 3 + 1) * 64 + (tid & 63)] = a1;
    red[(ks * 3 + 2) * 64 + (tid & 63)] = a2;
    __syncthreads();
    if (tid < 192) {
      int r = tid >> 6, cc = tid & 63;
      float s = 0.f;
      for (int k = 0; k < 8; ++k) s += red[(k * 3 + r) * 64 + cc];
      mods[(size_t)(l * 3 + r) * 6144 + cgp * 64 + cc] = s + p.ada_b[(size_t)l * 6144 + cgp * 64 + cc];
    }
    __syncthreads();
  }
}

__device__ void convert_tile(const float* src, int N, bfr* dst, int kt, int nt, int mode, float* tile  ) {
  const int tid = threadIdx.x;
#pragma unroll
  for (int q = 0; q < 2; ++q) {
    int idx = tid + q * 512;
    int kk = idx >> 4, n4 = idx & 15;
    int n = nt * 64 + n4 * 4;
    float4 v = make_float4(0.f, 0.f, 0.f, 0.f);
    if (n < N) v = *(const float4*)(src + (size_t)(kt * 64 + kk) * N + n);
    tile[kk * 65 + n4 * 4 + 0] = v.x;
    tile[kk * 65 + n4 * 4 + 1] = v.y;
    tile[kk * 65 + n4 * 4 + 2] = v.z;
    tile[kk * 65 + n4 * 4 + 3] = v.w;
  }
  __syncthreads();
  {
    int nn = tid >> 3, kc = tid & 7;
    int n = nt * 64 + nn;
    int row = n;
    if (mode == 1) { int j = n & 1023; row = (j >> 4) * 32 + (j & 15) + ((n >= 1024) ? 16 : 0); }
    bf16x8 o;
#pragma unroll
    for (int j = 0; j < 8; ++j) o[j] = (short)f2bf(tile[(kc * 8 + j) * 65 + nn]);
    *(bf16x8*)(dst + (size_t)row * 1024 + kt * 64 + kc * 8) = o;
  }
  __syncthreads();
}
__device__ void phase_convert(const Params& p, int l, int bid, int nb, char* smem) {
  float* tile = (float*)smem;
  char* wl = p.ws + OFF_W + (size_t)l * WL_SIZE;
  const int T_IN = 16 * 56, T_OUT = 16 * 16, T_GU = 32 * 16 * 32, T_DN = 32 * 16 * 16;
  const int total = T_IN + T_OUT + T_GU + T_DN;
  for (int t = bid; t < total; t += nb) {
    if (t < T_IN) {
      int kt = t / 56, nt = t % 56;
      convert_tile(p.w_in + (size_t)l * 1024 * PIN, PIN, (bfr*)(wl + WL_IN), kt, nt, 0, tile);
    } else if (t < T_IN + T_OUT) {
      int u = t - T_IN; int kt = u / 16, nt = u % 16;
      convert_tile(p.w_out + (size_t)l * 1024 * 1024, 1024, (bfr*)(wl + WL_OUT), kt, nt, 0, tile);
    } else if (t < T_IN + T_OUT + T_GU) {
      int u = t - T_IN - T_OUT; int e = u / 512; int v = u % 512; int kt = v / 32, nt = v % 32;
      convert_tile(p.moe_w_gu + ((size_t)l * 32 + e) * 1024 * 2048, 2048, (bfr*)(wl + WL_GU) + (size_t)e * 2048 * 1024, kt, nt, 1, tile);
    } else {
      int u = t - T_IN - T_OUT - T_GU; int e = u / 256; int v = u % 256; int kt = v / 16, nt = v % 16;
      convert_tile(p.moe_w_down + ((size_t)l * 32 + e) * 1024 * 1024, 1024, (bfr*)(wl + WL_DN) + (size_t)e * 1024 * 1024, kt, nt, 0, tile);
    }
  }
}

__device__ void phase_prenorm(const Params& p, int l, int bid, int nb) {
  const int tid = threadIdx.x, lane = tid & 63, wv = tid >> 6;
  const float* xl = (l == 0) ? p.x : p.out;
  const float* xc = (l == 0) ? p.ctx : (const float*)(p.ws + OFF_CTX);
  const float* mods = (const float*)(p.ws + OFF_MODS) + (size_t)l * 3 * 6144;
  const float* g = p.norm_mix_g + (size_t)l * 1024;
  bfr* H = (bfr*)(p.ws + OFF_H);
  {
    int* cnt = (int*)(p.ws + OFF_CNT);
    int* slt = (int*)(p.ws + OFF_SLT);
    int gt = bid * NTHR + tid;
    if (gt < 32) cnt[gt] = 0;
    for (int i = gt; i < NSLOT_MAX; i += nb * NTHR) slt[i] = 0;
  }
  for (int m = bid * 8 + wv; m < NTOK; m += nb * 8) {
    const float* xr = (m < NLAT) ? xl + (size_t)m * 1024 : xc + (size_t)(m - NLAT) * 1024;
    const float* md = mods + (size_t)mod_row(m) * 6144;
    float4 v[4];
    float ss = 0.f;
#pragma unroll
    for (int i = 0; i < 4; ++i) {
      v[i] = *(const float4*)(xr + (lane + 64 * i) * 4);
      ss += v[i].x * v[i].x + v[i].y * v[i].y + v[i].z * v[i].z + v[i].w * v[i].w;
    }
    ss = wave_sum(ss);
    float rs = rsqrtf(ss * (1.f / 1024.f) + 1e-6f);
#pragma unroll
    for (int i = 0; i < 4; ++i) {
      int d = (lane + 64 * i) * 4;
      float4 gg = *(const float4*)(g + d);
      float4 sh = *(const float4*)(md + d);
      float4 sc = *(const float4*)(md + 1024 + d);
      bf16x4 o;
      o[0] = (short)f2bf(v[i].x * rs * gg.x * (1.f + sc.x) + sh.x);
      o[1] = (short)f2bf(v[i].y * rs * gg.y * (1.f + sc.y) + sh.y);
      o[2] = (short)f2bf(v[i].z * rs * gg.z * (1.f + sc.z) + sh.z);
      o[3] = (short)f2bf(v[i].w * rs * gg.w * (1.f + sc.w) + sh.w);
      *(bf16x4*)(H + (size_t)m * 1024 + d) = o;
    }
  }
}

#define GLDS_ROW 144
#define GEMM_LDS (384 * GLDS_ROW)
struct GemmAcc { f32x4 a[8][2]; };

template <class RowFn>
__device__ __forceinline__ void gemm_tile(GemmAcc& acc, const bfr* Abase, RowFn rowfn, const bfr* Bt  , char* smem) {
  const int tid = threadIdx.x, lane = tid & 63, wv = tid >> 6;
  const int wr = wv >> 2, wc = wv & 3;
  const int fr = lane & 15, fq = lane >> 4;
  char* sA = smem;
  char* sB = smem + 256 * GLDS_ROW;
#pragma unroll
  for (int m = 0; m < 8; ++m)
#pragma unroll
    for (int n = 0; n < 2; ++n) acc.a[m][n] = (f32x4){0.f, 0.f, 0.f, 0.f};
  const int srow = tid >> 3, c16 = tid & 7;
  unsigned ao0 = rowfn(srow) + c16 * 8, ao1 = rowfn(srow + 64) + c16 * 8, ao2 = rowfn(srow + 128) + c16 * 8, ao3 = rowfn(srow + 192) + c16 * 8;
  const bfr* bp = Bt + (size_t)srow * 1024 + c16 * 8;
  const int lo = srow * GLDS_ROW + c16 * 16;
  uint4 ra0, ra1, ra2, ra3, rb0, rb1;
  ra0 = *(const uint4*)(Abase + ao0); ra1 = *(const uint4*)(Abase + ao1);
  ra2 = *(const uint4*)(Abase + ao2); ra3 = *(const uint4*)(Abase + ao3);
  rb0 = *(const uint4*)(bp); rb1 = *(const uint4*)(bp + 64 * 1024);
  for (int kt = 0; kt < 16; ++kt) {
    __syncthreads();
    *(uint4*)(sA + lo) = ra0; *(uint4*)(sA + lo + 64 * GLDS_ROW) = ra1;
    *(uint4*)(sA + lo + 128 * GLDS_ROW) = ra2; *(uint4*)(sA + lo + 192 * GLDS_ROW) = ra3;
    *(uint4*)(sB + lo) = rb0; *(uint4*)(sB + lo + 64 * GLDS_ROW) = rb1;
    __syncthreads();
    if (kt + 1 < 16) {
      const int ko = (kt + 1) * 64;
      ra0 = *(const uint4*)(Abase + ao0 + ko); ra1 = *(const uint4*)(Abase + ao1 + ko);
      ra2 = *(const uint4*)(Abase + ao2 + ko); ra3 = *(const uint4*)(Abase + ao3 + ko);
      rb0 = *(const uint4*)(bp + ko); rb1 = *(const uint4*)(bp + 64 * 1024 + ko);
    }
#pragma unroll
    for (int s = 0; s < 2; ++s) {
      bf16x8 b0 = *(const bf16x8*)(sB + (wc * 32 + fr) * GLDS_ROW + s * 64 + fq * 16);
      bf16x8 b1 = *(const bf16x8*)(sB + (wc * 32 + 16 + fr) * GLDS_ROW + s * 64 + fq * 16);
#pragma unroll
      for (int m = 0; m < 8; ++m) {
        bf16x8 af = *(const bf16x8*)(sA + (wr * 128 + m * 16 + fr) * GLDS_ROW + s * 64 + fq * 16);
        acc.a[m][0] = __builtin_amdgcn_mfma_f32_16x16x32_bf16(af, b0, acc.a[m][0], 0, 0, 0);
        acc.a[m][1] = __builtin_amdgcn_mfma_f32_16x16x32_bf16(af, b1, acc.a[m][1], 0, 0, 0);
      }
    }
  }
}

__device__ void phase_gemm_in(const Params& p, int l, int bid, int nb, char* smem) {
  const bfr* H = (const bfr*)(p.ws + OFF_H);
  const bfr* Bt = (const bfr*)(p.ws + OFF_W + (size_t)l * WL_SIZE + WL_IN);
  float* P = (float*)(p.ws + OFF_P);
  const int lane = threadIdx.x & 63, wv = threadIdx.x >> 6, wr = wv >> 2, wc = wv & 3, fr = lane & 15, fq = lane >> 4;
  const int ntile = 130 * 28;
  for (int t = bid; t < ntile; t += nb) {
    int mt = t / 28, nt = t % 28;
    GemmAcc acc;
    gemm_tile(acc, H, [&](int r) { return (unsigned)((mt * 256 + r) * 1024); }, Bt + (size_t)nt * 128 * 1024, smem);
#pragma unroll
    for (int m = 0; m < 8; ++m)
#pragma unroll
      for (int n = 0; n < 2; ++n)
#pragma unroll
        for (int r = 0; r < 4; ++r) {
          int row = mt * 256 + wr * 128 + m * 16 + fq * 4 + r;
          int col = nt * 128 + wc * 32 + n * 16 + fr;
          P[(size_t)row * PINP + col] = acc.a[m][n][r];
        }
  }
}

__device__ void phase_gemm_out(const Params& p, int l, int bid, int nb, char* smem) {
  const bfr* CC = (const bfr*)(p.ws + OFF_CC);
  const bfr* Bt = (const bfr*)(p.ws + OFF_W + (size_t)l * WL_SIZE + WL_OUT);
  const float* mods = (const float*)(p.ws + OFF_MODS) + (size_t)l * 3 * 6144;
  const float* xl = (l == 0) ? p.x : p.out;
  const float* xc = (l == 0) ? p.ctx : (const float*)(p.ws + OFF_CTX);
  float* ol = p.out;
  float* oc = (float*)(p.ws + OFF_CTX);
  const int lane = threadIdx.x & 63, wv = threadIdx.x >> 6, wr = wv >> 2, wc = wv & 3, fr = lane & 15, fq = lane >> 4;
  const int nmt = (l == 0) ? 130 : 128;
  const int ntile = nmt * 8;
  for (int t = bid; t < ntile; t += nb) {
    int mt = t >> 3, nt = t & 7;
    GemmAcc acc;
    gemm_tile(acc, CC, [&](int r) { return (unsigned)((mt * 256 + r) * 1024); }, Bt + (size_t)nt * 128 * 1024, smem);
    const bool lat = mt < 128;
    const float* xin = lat ? xl + (size_t)mt * 256 * 1024 : xc + (size_t)(mt - 128) * 256 * 1024;
    float* xo = lat ? ol + (size_t)mt * 256 * 1024 : oc + (size_t)(mt - 128) * 256 * 1024;
    const float* g1 = mods + (size_t)(lat ? (mt >> 6) : 2) * 6144 + 2048;
#pragma unroll
    for (int m = 0; m < 8; ++m)
#pragma unroll
      for (int n = 0; n < 2; ++n)
#pragma unroll
        for (int r = 0; r < 4; ++r) {
          int row = wr * 128 + m * 16 + fq * 4 + r;
          int col = nt * 128 + wc * 32 + n * 16 + fr;
          xo[(size_t)row * 1024 + col] = xin[(size_t)row * 1024 + col] + g1[col] * acc.a[m][n][r];
        }
  }
}

__device__ void phase_prep(const Params& p, int l, int bid, int nb, char* smem) {
  const int tid = threadIdx.x, lane = tid & 63, wv = tid >> 6;
  const float* P = (const float*)(p.ws + OFF_P);
  char* S = p.ws + OFF_S;
  bfr* QN = (bfr*)(S + S_QN);
  bfr* KN = (bfr*)(S + S_KN);
  bfr* VT = (bfr*)(S + S_VT);
  float* RWR = (float*)(S + S_RWR);
  float* RWKK = (float*)(S + S_RWKK);
  float* RWV = (float*)(S + S_RWV);
  float* RWG = (float*)(S + S_RWG);
  float* RWW = (float*)(S + S_RWW);
  float* RWKD = (float*)(S + S_RWKD);
  float* RWB = (float*)(S + S_RWB);
  float* BON = (float*)(S + S_BON);
  float* GDQ = (float*)(S + S_GDQ);
  float* GDK = (float*)(S + S_GDK);
  float* GDV = (float*)(S + S_GDV);
  float* GDAB = (float*)(S + S_GDAB);
  const float* mu = p.rw_mu + (size_t)l * 896;
  const float* w0 = p.rw_w0 + (size_t)l * 512;
  const float* w_up = p.rw_w_up + (size_t)l * 2 * 32 * 256;
  const float* a0 = p.rw_a0 + (size_t)l * 512;
  const float* a_up = p.rw_a_up + (size_t)l * 2 * 32 * 256;
  const float* g_up = p.rw_g_up + (size_t)l * 64 * 256;
  const float* k_k = p.rw_k_k + (size_t)l * 256;
  const float* k_a = p.rw_k_a + (size_t)l * 256;
  const float* r_k = p.rw_r_k + (size_t)l * 256;
  const float* conv_w = p.gd_conv_w + (size_t)l * 5 * 768;
  const float* A_log = p.gd_A_log + (size_t)l * 8;
  const float* dt_bias = p.gd_dt_bias + (size_t)l * 8;
  const float* qg = p.na_q_gain + (size_t)l * 64;
  const float* kg = p.na_k_gain + (size_t)l * 64;

  float* rw = (float*)smem;
  float* lor = rw + 16 * 768;
  float* gd = rw;

  for (int tile = bid; tile < NTOK / 16; tile += nb) {
    const int m0 = tile * 16;
    int seq_lo, seq_hi;
    int bb, tau0;
    if (m0 < NLAT) { bb = m0 >> 14; seq_lo = bb << 14; seq_hi = seq_lo + SEQ; tau0 = m0 - seq_lo; }
    else { bb = (m0 - NLAT) >> 8; seq_lo = NLAT + (bb << 8); seq_hi = seq_lo + CTXL; tau0 = SEQ + (m0 - seq_lo); }

    for (int i = tid; i < 16 * 896; i += NTHR) {
      int t = i / 896, c = i % 896;
      int m = m0 + t;
      const float* pr = P + (size_t)m * PINP + A_END + c;
      float cur = *pr;
      float prev = (m - 1 >= seq_lo) ? *(pr - PINP) : 0.f;
      float nxt = (m + 1 < seq_hi) ? *(pr + PINP) : 0.f;
      float v = cur + mu[c] * (0.5f * (prev + nxt) - cur);
      if (c < 768) rw[t * 768 + c] = v;
      else if (c < 800) lor[(c - 768) * 16 + t] = tanhf(v);
      else if (c < 832) lor[(32 + c - 800) * 16 + t] = v;
      else lor[(64 + c - 832) * 16 + t] = sigmoidf_(v);
    }
    __syncthreads();
    {
      const int c = tid & 255, th = tid >> 8;
      const float kkc = k_k[c], kac = k_a[c], rkc = r_k[c];
      const float w00 = w0[c], w01 = w0[256 + c], a00 = a0[c], a01 = a0[256 + c];
      const int h = c >> 6;
#pragma unroll 1
      for (int ps = 0; ps < 2; ++ps) {
        const int tb = th * 8 + ps * 4;
        float4 gacc = make_float4(0.f, 0.f, 0.f, 0.f), wa0 = gacc, wa1 = gacc, aa0 = gacc, aa1 = gacc;
#pragma unroll 4
        for (int j = 0; j < 64; ++j) {
          float wgt = g_up[j * 256 + c];
          float4 s0 = *(const float4*)(lor + (64 + j) * 16 + tb);
          gacc.x += s0.x * wgt; gacc.y += s0.y * wgt; gacc.z += s0.z * wgt; gacc.w += s0.w * wgt;
        }
#pragma unroll 4
        for (int j = 0; j < 32; ++j) {
          float4 t0 = *(const float4*)(lor + j * 16 + tb);
          float4 d0 = *(const float4*)(lor + (32 + j) * 16 + tb);
          float ww0 = w_up[j * 256 + c], ww1 = w_up[(32 + j) * 256 + c];
          float aw0 = a_up[j * 256 + c], aw1 = a_up[(32 + j) * 256 + c];
          wa0.x += t0.x * ww0; wa0.y += t0.y * ww0; wa0.z += t0.z * ww0; wa0.w += t0.w * ww0;
          wa1.x += t0.x * ww1; wa1.y += t0.y * ww1; wa1.z += t0.z * ww1; wa1.w += t0.w * ww1;
          aa0.x += d0.x * aw0; aa0.y += d0.y * aw0; aa0.z += d0.z * aw0; aa0.w += d0.w * aw0;
          aa1.x += d0.x * aw1; aa1.y += d0.y * aw1; aa1.z += d0.z * aw1; aa1.w += d0.w * aw1;
        }
#pragma unroll
        for (int t = 0; t < 4; ++t) {
          const int tt = tb + t;
          const int m = m0 + tt;
          const float gv = t == 0 ? gacc.x : t == 1 ? gacc.y : t == 2 ? gacc.z : gacc.w;
          const float wv0 = t == 0 ? wa0.x : t == 1 ? wa0.y : t == 2 ? wa0.z : wa0.w;
          const float wv1 = t == 0 ? wa1.x : t == 1 ? wa1.y : t == 2 ? wa1.z : wa1.w;
          const float av0 = t == 0 ? aa0.x : t == 1 ? aa0.y : t == 2 ? aa0.z : aa0.w;
          const float av1 = t == 0 ? aa1.x : t == 1 ? aa1.y : t == 2 ? aa1.z : aa1.w;
          float r = rw[tt * 768 + c], k = rw[tt * 768 + 256 + c], v = rw[tt * 768 + 512 + c];
          float kkraw = k * kkc;
          float ssum = wave_sum(kkraw * kkraw);
          float kk = kkraw * rsqrtf(ssum + 1e-6f);
          float bon = 0.f;
#pragma unroll
          for (int d = 0; d < 2; ++d) {
            float wl = (d == 0 ? w00 + wv0 : w01 + wv1);
            float w_log = -softplusf_(-wl) - 0.5f;
            float decay = __expf(-__expf(w_log));
            float a = sigmoidf_(d == 0 ? a00 + av0 : a01 + av1);
            float kd = k * (1.f + (a - 1.f) * kac);
            bon += r * kd * rkc;
            size_t o = ((size_t)d * NTOK + m) * 256 + c;
            RWW[o] = decay; RWKD[o] = kd; RWB[o] = kk * a;
          }
          bon = wave_sum(bon);
          size_t o = (size_t)m * 256 + c;
          RWR[o] = r; RWKK[o] = kk; RWV[o] = v; RWG[o] = gv;
          if (lane == 0) BON[(size_t)m * 4 + h] = bon;
        }
      }
    }
    __syncthreads();
    for (int i = tid; i < 16 * 768; i += NTHR) {
      int t = i / 768, c = i % 768;
      int m = m0 + t;
      float acc = 0.f;
#pragma unroll
      for (int j = 0; j < 5; ++j) {
        int mm = m + j - 2;
        if (mm >= seq_lo && mm < seq_hi) acc += conv_w[j * 768 + c] * P[(size_t)mm * PINP + B_END + c];
      }
      gd[t * 768 + c] = siluf_(acc);
    }
    __syncthreads();
    for (int wt = wv; wt < 16 * 12; wt += 8) {
      int t = wt / 12, hs = wt % 12;
      int m = m0 + t;
      float val = gd[t * 768 + hs * 64 + lane];
      if (hs < 8) {
        float ss = wave_sum(val * val);
        val *= rsqrtf(ss + 1e-6f);
        if (hs < 4) GDQ[(size_t)m * 256 + hs * 64 + lane] = val * 0.125f;
        else GDK[(size_t)m * 256 + (hs - 4) * 64 + lane] = val;
      } else GDV[(size_t)m * 256 + (hs - 8) * 64 + lane] = val;
    }
    if (tid < 256) {
      int t = tid >> 4, j = tid & 15;
      int m = m0 + t;
      float pv = P[(size_t)m * PINP + B_END + 1024 + j];
      float o;
      if (j < 8) o = __expf(-__expf(A_log[j]) * softplusf_(pv + dt_bias[j]));
      else o = sigmoidf_(pv);
      GDAB[(size_t)m * 16 + j] = o;
    }
    for (int wt = wv; wt < 16 * 16; wt += 8) {
      int t = wt >> 4, hs = wt & 15;
      int m = m0 + t;
      float val = P[(size_t)m * PINP + hs * 64 + lane];
      float ss = wave_sum(val * val);
      val *= rsqrtf(ss * (1.f / 64.f) + 1e-6f);
      if (hs < 8) QN[(size_t)m * 512 + hs * 64 + lane] = f2bf(val * qg[lane] * (0.125f * 1.4426950408889634f));
      else KN[(size_t)m * 512 + (hs - 8) * 64 + lane] = f2bf(val * kg[lane]);
    }
    {
      int hd = tid;
      bf16x8 o0, o1;
#pragma unroll
      for (int t = 0; t < 8; ++t) {
        o0[t] = (short)f2bf(P[(size_t)(m0 + t) * PINP + 1024 + hd]);
        o1[t] = (short)f2bf(P[(size_t)(m0 + 8 + t) * PINP + 1024 + hd]);
      }
      bfr* dst = VT + ((size_t)(bb * 512 + hd)) * TTOK + tau0;
      *(bf16x8*)dst = o0;
      *(bf16x8*)(dst + 8) = o1;
    }
    __syncthreads();
  }
}

#define SC_TB 32
__device__ __forceinline__ int scan_tok(int b, int d, int s) {
  if (s < CTXL) { int t = d ? (CTXL - 1 - s) : s; return NLAT + b * CTXL + t; }
  int u = s - CTXL; int t = d ? (SEQ - 1 - u) : u; return b * SEQ + t;
}
template <bool GDN>
__device__ void scan_chain(const Params& p, int b, int h, int d, int half, char* smem) {
  const int tid = threadIdx.x, lane = tid & 63, wv = tid >> 6;
  char* S = p.ws + OFF_S;
  const float *src0, *src1, *src2, *src3, *src4, *xsrc;
  const float* ab = (const float*)(S + S_GDAB);
  float* Y;
  if (!GDN) {
    src0 = (const float*)(S + S_RWKK);
    src1 = (const float*)(S + S_RWW) + (size_t)d * NTOK * 256;
    src2 = (const float*)(S + S_RWB) + (size_t)d * NTOK * 256;
    src3 = (const float*)(S + S_RWKD) + (size_t)d * NTOK * 256;
    src4 = (const float*)(S + S_RWR);
    xsrc = (const float*)(S + S_RWV);
    Y = (float*)(S + S_YRW) + (size_t)d * NTOK * 256;
  } else {
    src0 = (const float*)(S + S_GDK);
    src1 = src0; src2 = src0; src3 = src0;
    src4 = (const float*)(S + S_GDQ);
    xsrc = (const float*)(S + S_GDV);
    Y = (float*)(S + S_YGD) + (size_t)d * NTOK * 256;
  }
  float* vec = (float*)smem;
  float* xs = vec + 5 * SC_TB * 64;
  float* sc = xs + SC_TB * 32;
  float* yb = sc + SC_TB * 2;
  const int rl = wv * 4 + (lane >> 4);
  const int j4 = (lane & 15) * 4;
  float s0 = 0.f, s1 = 0.f, s2 = 0.f, s3 = 0.f;
  float4 rg0, rg1, rg2, rg3, rg4, rx;
  rg0 = rg1 = rg2 = rg3 = rg4 = rx = make_float4(0.f, 0.f, 0.f, 0.f);
  float rsc = 0.f;
  const int st_step = tid >> 4, st_part = tid & 15;
#define SCAN_ISSUE(batch)                                                                          \
  {                                                                                                \
    int m_ = scan_tok(b, d, (batch) * SC_TB + st_step);                                            \
    size_t o_ = (size_t)m_ * 256 + h * 64 + st_part * 4;                                           \
    rg0 = *(const float4*)(src0 + o_);                                                             \
    rg4 = *(const float4*)(src4 + o_);                                                             \
    if (!GDN) { rg1 = *(const float4*)(src1 + o_); rg2 = *(const float4*)(src2 + o_); rg3 = *(const float4*)(src3 + o_); } \
    if (tid < 256) {                                                                               \
      int m2_ = scan_tok(b, d, (batch) * SC_TB + (tid >> 3));                                      \
      rx = *(const float4*)(xsrc + (size_t)m2_ * 256 + h * 64 + half * 32 + (tid & 7) * 4);        \
    }                                                                                              \
    if (GDN && tid < 64) {                                                                         \
      int m3_ = scan_tok(b, d, (batch) * SC_TB + (tid >> 1));                                      \
      rsc = ab[(size_t)m3_ * 16 + (tid & 1) * 8 + d * 4 + h];                                      \
    }                                                                                              \
  }
  const int nbatch = TTOK / SC_TB;
  SCAN_ISSUE(0)
  for (int bt = 0; bt < nbatch; ++bt) {
    __syncthreads();
    *(float4*)(vec + (0 * SC_TB + st_step) * 64 + st_part * 4) = rg0;
    *(float4*)(vec + (4 * SC_TB + st_step) * 64 + st_part * 4) = rg4;
    if (!GDN) {
      *(float4*)(vec + (1 * SC_TB + st_step) * 64 + st_part * 4) = rg1;
      *(float4*)(vec + (2 * SC_TB + st_step) * 64 + st_part * 4) = rg2;
      *(float4*)(vec + (3 * SC_TB + st_step) * 64 + st_part * 4) = rg3;
    }
    if (tid < 256) *(float4*)(xs + (tid >> 3) * 32 + (tid & 7) * 4) = rx;
    if (GDN && tid < 64) sc[tid] = rsc;
    __syncthreads();
    if (bt + 1 < nbatch) SCAN_ISSUE(bt + 1)
#pragma unroll 4
    for (int st = 0; st < SC_TB; ++st) {
      float4 kap = *(const float4*)(vec + (0 * SC_TB + st) * 64 + j4);
      float4 r4 = *(const float4*)(vec + (4 * SC_TB + st) * 64 + j4);
      float x = xs[st * 32 + rl];
      float dp = s0 * kap.x + s1 * kap.y + s2 * kap.z + s3 * kap.w;
      float dd = row16_sum(dp);
      if (!GDN) {
        float4 w4 = *(const float4*)(vec + (1 * SC_TB + st) * 64 + j4);
        float4 b4 = *(const float4*)(vec + (2 * SC_TB + st) * 64 + j4);
        float4 k4 = *(const float4*)(vec + (3 * SC_TB + st) * 64 + j4);
        s0 = s0 * w4.x + x * k4.x - dd * b4.x;
        s1 = s1 * w4.y + x * k4.y - dd * b4.y;
        s2 = s2 * w4.z + x * k4.z - dd * b4.z;
        s3 = s3 * w4.w + x * k4.w - dd * b4.w;
      } else {
        float al = sc[st * 2], be = sc[st * 2 + 1];
        float cf = be * (x - al * dd);
        s0 = al * s0 + cf * kap.x;
        s1 = al * s1 + cf * kap.y;
        s2 = al * s2 + cf * kap.z;
        s3 = al * s3 + cf * kap.w;
      }
      float yp = s0 * r4.x + s1 * r4.y + s2 * r4.z + s3 * r4.w;
      float yy = row16_sum(yp);
      if ((lane & 15) == 0) yb[st * 32 + rl] = yy;
    }
    __syncthreads();
    for (int i = tid; i < SC_TB * 32; i += NTHR) {
      int st = i >> 5, r = i & 31;
      int m = scan_tok(b, d, bt * SC_TB + st);
      Y[(size_t)m * 256 + h * 64 + half * 32 + r] = yb[i];
    }
  }
  __syncthreads();
#undef SCAN_ISSUE
}

__device__ __forceinline__ void na_pair(const bfr* KN, const bfr* VT, const bf16x8 qf0, const bf16x8 qf1,
                                        int mk0, int mk1, size_t vt_base, int tau0, int tau1, int h, int lane,
                                        bool local, int kr0, int kr1, int ct0, int ct1, int qr, int qc, const float* bias_h,
                                        f32x4 (&O)[4], float& lsum) {
  const int fr = lane & 15, fq = lane >> 4;
  const bf16x8 k00 = *(const bf16x8*)(KN + (size_t)(mk0 + fr) * 512 + h * 64 + fq * 8);
  const bf16x8 k01 = *(const bf16x8*)(KN + (size_t)(mk0 + fr) * 512 + h * 64 + 32 + fq * 8);
  const bf16x8 k10 = *(const bf16x8*)(KN + (size_t)(mk1 + fr) * 512 + h * 64 + fq * 8);
  const bf16x8 k11 = *(const bf16x8*)(KN + (size_t)(mk1 + fr) * 512 + h * 64 + 32 + fq * 8);
  f32x4 z = {0.f, 0.f, 0.f, 0.f};
  f32x4 st0 = __builtin_amdgcn_mfma_f32_16x16x32_bf16(k00, qf0, z, 0, 0, 0);
  st0 = __builtin_amdgcn_mfma_f32_16x16x32_bf16(k01, qf1, st0, 0, 0, 0);
  f32x4 st1 = __builtin_amdgcn_mfma_f32_16x16x32_bf16(k10, qf0, z, 0, 0, 0);
  st1 = __builtin_amdgcn_mfma_f32_16x16x32_bf16(k11, qf1, st1, 0, 0, 0);
  bf16x8 pf;
  if (local) {
    int cs = min(max(qc - 8, 0), 48);
#pragma unroll
    for (int r = 0; r < 4; ++r) {
      int kc0 = ct0 * 16 + fq * 4 + r;
      int kc1 = ct1 * 16 + fq * 4 + r;
      float p0 = 0.f, p1 = 0.f;
      if ((unsigned)(kc0 - cs) < 16u) p0 = exp2f(st0[r] + bias_h[(kr0 - qr + 7) * 31 + (kc0 - qc + 15)]);
      if ((unsigned)(kc1 - cs) < 16u) p1 = exp2f(st1[r] + bias_h[(kr1 - qr + 7) * 31 + (kc1 - qc + 15)]);
      lsum += p0 + p1;
      pf[r] = (short)f2bf(p0);
      pf[4 + r] = (short)f2bf(p1);
    }
  } else {
#pragma unroll
    for (int r = 0; r < 4; ++r) {
      float p0 = exp2f(st0[r]), p1 = exp2f(st1[r]);
      lsum += p0 + p1;
      pf[r] = (short)f2bf(p0);
      pf[4 + r] = (short)f2bf(p1);
    }
  }
#pragma unroll
  for (int dt = 0; dt < 4; ++dt) {
    const bfr* vrow = VT + vt_base + (size_t)(dt * 16 + fr) * TTOK;
    bf16x4 v0 = *(const bf16x4*)(vrow + tau0 + fq * 4);
    bf16x4 v1 = *(const bf16x4*)(vrow + tau1 + fq * 4);
    bf16x8 vf;
    vf[0] = v0[0]; vf[1] = v0[1]; vf[2] = v0[2]; vf[3] = v0[3];
    vf[4] = v1[0]; vf[5] = v1[1]; vf[6] = v1[2]; vf[7] = v1[3];
    O[dt] = __builtin_amdgcn_mfma_f32_16x16x32_bf16(vf, pf, O[dt], 0, 0, 0);
  }
}

__device__ void na_block_task(const Params& p, int task, const float* bias_lds) {
  const int tid = threadIdx.x, lane = tid & 63, wv = tid >> 6;
  const int fr = lane & 15, fq = lane >> 4;
  char* S = p.ws + OFF_S;
  const bfr* QN = (const bfr*)(S + S_QN);
  const bfr* KN = (const bfr*)(S + S_KN);
  const bfr* VT = (const bfr*)(S + S_VT);
  bfr* CC = (bfr*)(p.ws + OFF_CC);
  int b, h, mq0;
  bool latent = task < 2048;
  int qr = 0, cgp = 0;
  if (latent) {
    h = task & 7; int rp = (task >> 3) & 127; b = task >> 10;
    qr = rp * 2 + (wv >> 2); cgp = wv & 3;
    mq0 = b * SEQ + qr * 64 + cgp * 16;
  } else {
    int u = task - 2048;
    int half = u & 1; h = (u >> 1) & 7; b = u >> 4;
    mq0 = NLAT + b * CTXL + (half * 8 + wv) * 16;
  }
  const bf16x8 qf0 = *(const bf16x8*)(QN + (size_t)(mq0 + fr) * 512 + h * 64 + fq * 8);
  const bf16x8 qf1 = *(const bf16x8*)(QN + (size_t)(mq0 + fr) * 512 + h * 64 + 32 + fq * 8);
  f32x4 O[4];
#pragma unroll
  for (int dt = 0; dt < 4; ++dt) O[dt] = (f32x4){0.f, 0.f, 0.f, 0.f};
  float lsum = 0.f;
  const size_t vt_base = (size_t)(b * 8 + h) * 64 * TTOK;
  if (latent) {
    const int rs = min(max(qr - 4, 0), SEQ / 64 - 8);
    const int ct_first = (cgp <= 1) ? 0 : cgp - 1;
    const int nct = (cgp == 0 || cgp == 3) ? 2 : 3;
    const int npair = 4 * nct;
    const int qc = cgp * 16 + fr;
    for (int pi = 0; pi < npair; ++pi) {
      int i0 = 2 * pi, i1 = 2 * pi + 1;
      int kr0 = rs + i0 / nct, c0 = ct_first + i0 % nct;
      int kr1 = rs + i1 / nct, c1 = ct_first + i1 % nct;
      int t0 = kr0 * 64 + c0 * 16, t1 = kr1 * 64 + c1 * 16;
      na_pair(KN, VT, qf0, qf1, b * SEQ + t0, b * SEQ + t1, vt_base, t0, t1, h, lane, true, kr0, kr1, c0, c1, qr, qc,
              bias_lds + h * 465, O, lsum);
    }
  }
  for (int pi = 0; pi < 8; ++pi) {
    int t0 = pi * 32, t1 = pi * 32 + 16;
    na_pair(KN, VT, qf0, qf1, NLAT + b * CTXL + t0, NLAT + b * CTXL + t1, vt_base, SEQ + t0, SEQ + t1, h, lane, false,
            0, 0, 0, 0, 0, 0, bias_lds, O, lsum);
  }
  lsum += __shfl_xor(lsum, 16, 64);
  lsum += __shfl_xor(lsum, 32, 64);
  float inv = 1.f / lsum;
#pragma unroll
  for (int dt = 0; dt < 4; ++dt) {
    bf16x4 o;
#pragma unroll
    for (int r = 0; r < 4; ++r) o[r] = (short)f2bf(O[dt][r] * inv);
    *(bf16x4*)(CC + (size_t)(mq0 + fr) * 1024 + h * 64 + dt * 16 + fq * 4) = o;
  }
}

__device__ void phase_mix(const Params& p, int l, int bid, int nb, char* smem) {
  const int tid = threadIdx.x;
  const int nscan_blocks = (nb > 64) ? 64 : nb;
  const int first_attn_block = (nb > 64) ? 64 : 0;
  if (bid < nscan_blocks) {
    for (int c = bid; c < 64; c += nscan_blocks) {
      int half = c & 1, d = (c >> 1) & 1, h = (c >> 2) & 3, b = (c >> 4) & 1, ty = (c >> 5) & 1;
      if (ty == 0) scan_chain<false>(p, b, h, d, half, smem);
      else scan_chain<true>(p, b, h, d, half, smem);
    }
  }
  if (bid >= first_attn_block) {
    float* bias = (float*)smem;
    __syncthreads();
    for (int i = tid; i < 8 * 465; i += NTHR) bias[i] = p.na_rpb[(size_t)l * 8 * 465 + i] * 1.4426950408889634f;
    __syncthreads();
    const int ntask = (l == 0) ? 2048 + 32 : 2048;
    const int nab = nb - first_attn_block;
    for (int t = bid - first_attn_block; t < ntask; t += nab) na_block_task(p, t, bias);
  }
}

__device__ void phase_post(const Params& p, int l, int bid, int nb) {
  const int tid = threadIdx.x, lane = tid & 63, wv = tid >> 6;
  char* S = p.ws + OFF_S;
  const float* YRW = (const float*)(S + S_YRW);
  const float* YGD = (const float*)(S + S_YGD);
  const float* RWV = (const float*)(S + S_RWV);
  const float* RWG = (const float*)(S + S_RWG);
  const float* BON = (const float*)(S + S_BON);
  const float* P = (const float*)(p.ws + OFF_P);
  bfr* CC = (bfr*)(p.ws + OFF_CC);
  const float* ln_w = p.rw_ln_w + (size_t)l * 256;
  const float* ln_b = p.rw_ln_b + (size_t)l * 256;
  const float* ng = p.gd_norm_g + (size_t)l * 64;
  const int ntok = (l == 0) ? NTOK : NLAT;
  for (int wt = bid * 8 + wv; wt < ntok * 8; wt += nb * 8) {
    int m = wt >> 3, hs = wt & 7;
    if (hs < 4) {
      int c = hs * 64 + lane;
      size_t o = (size_t)m * 256 + c;
      float y = YRW[o] + YRW[(size_t)NTOK * 256 + o];
      float mean = wave_sum(y) * (1.f / 64.f);
      float dv = y - mean;
      float var = wave_sum(dv * dv) * (1.f / 64.f);
      float yn = dv * rsqrtf(var + 64e-5f) * ln_w[c] + ln_b[c];
      float out = (yn + BON[(size_t)m * 4 + hs] * RWV[o]) * RWG[o];
      CC[(size_t)m * 1024 + 512 + c] = f2bf(out);
    } else {
      int c = (hs - 4) * 64 + lane;
      size_t o = (size_t)m * 256 + c;
      float y = YGD[o] + YGD[(size_t)NTOK * 256 + o];
      float ms = wave_sum(y * y) * (1.f / 64.f);
      float z = P[(size_t)m * PINP + B_END + 768 + c];
      float out = y * rsqrtf(ms + 1e-6f) * ng[lane] * siluf_(z);
      CC[(size_t)m * 1024 + 768 + c] = f2bf(out);
    }
  }
}

__device__ void phase_router(const Params& p, int l, int bid, int nb) {
  const int tid = threadIdx.x, lane = tid & 63, wv = tid >> 6;
  const float* xl = p.out;
  const float* xc = (const float*)(p.ws + OFF_CTX);
  const float* mods = (const float*)(p.ws + OFF_MODS) + (size_t)l * 3 * 6144;
  const float* g = p.norm_ffn_g + (size_t)l * 1024;
  const float* rw = p.moe_router_w + (size_t)l * 1024 * 32;
  const float* rb = p.moe_router_b + (size_t)l * 32;
  bfr* H = (bfr*)(p.ws + OFF_H);
  int* cnt = (int*)(p.ws + OFF_CNT);
  int* TOKE = (int*)(p.ws + OFF_TOKE);
  int* TOKP = (int*)(p.ws + OFF_TOKP);
  float* TOKG = (float*)(p.ws + OFF_TOKG);
  const int ntok = (l == 0) ? NTOK : NLAT;
  for (int m = bid * 8 + wv; m < ntok; m += nb * 8) {
    const float* xr = (m < NLAT) ? xl + (size_t)m * 1024 : xc + (size_t)(m - NLAT) * 1024;
    const float* md = mods + (size_t)mod_row(m) * 6144 + 3072;
    float4 v[4];
    float ss = 0.f;
#pragma unroll
    for (int i = 0; i < 4; ++i) {
      v[i] = *(const float4*)(xr + (lane + 64 * i) * 4);
      ss += v[i].x * v[i].x + v[i].y * v[i].y + v[i].z * v[i].z + v[i].w * v[i].w;
    }
    ss = wave_sum(ss);
    float rs = rsqrtf(ss * (1.f / 1024.f) + 1e-6f);
    float acc[32];
#pragma unroll
    for (int e = 0; e < 32; ++e) acc[e] = 0.f;
#pragma unroll
    for (int i = 0; i < 4; ++i) {
      int d = (lane + 64 * i) * 4;
      float4 gg = *(const float4*)(g + d);
      float4 sh = *(const float4*)(md + d);
      float4 sc = *(const float4*)(md + 1024 + d);
      float hv[4];
      hv[0] = v[i].x * rs * gg.x * (1.f + sc.x) + sh.x;
      hv[1] = v[i].y * rs * gg.y * (1.f + sc.y) + sh.y;
      hv[2] = v[i].z * rs * gg.z * (1.f + sc.z) + sh.z;
      hv[3] = v[i].w * rs * gg.w * (1.f + sc.w) + sh.w;
      bf16x4 o;
#pragma unroll
      for (int j = 0; j < 4; ++j) o[j] = (short)f2bf(hv[j]);
      *(bf16x4*)(H + (size_t)m * 1024 + d) = o;
#pragma unroll
      for (int j = 0; j < 4; ++j) {
        const float4* wr4 = (const float4*)(rw + (size_t)(d + j) * 32);
#pragma unroll
        for (int q = 0; q < 8; ++q) {
          float4 w = wr4[q];
          acc[q * 4 + 0] += hv[j] * w.x; acc[q * 4 + 1] += hv[j] * w.y;
          acc[q * 4 + 2] += hv[j] * w.z; acc[q * 4 + 3] += hv[j] * w.w;
        }
      }
    }
#pragma unroll
    for (int e = 0; e < 32; ++e) acc[e] = wave_sum(acc[e]) + rb[e];
    unsigned taken = 0u;
    float tv[4]; int ti[4];
#pragma unroll
    for (int k = 0; k < 4; ++k) {
      float best = -3.0e38f; int bi = 0;
#pragma unroll
      for (int e = 0; e < 32; ++e) {
        bool ok = !((taken >> e) & 1u) && (acc[e] > best);
        best = ok ? acc[e] : best; bi = ok ? e : bi;
      }
      taken |= 1u << bi; tv[k] = best; ti[k] = bi;
    }
    float e0 = 1.f, e1 = __expf(tv[1] - tv[0]), e2 = __expf(tv[2] - tv[0]), e3 = __expf(tv[3] - tv[0]);
    float inv = 1.f / (e0 + e1 + e2 + e3);
    if (lane < 4) {
      int e = lane == 0 ? ti[0] : lane == 1 ? ti[1] : lane == 2 ? ti[2] : ti[3];
      float gt = (lane == 0 ? e0 : lane == 1 ? e1 : lane == 2 ? e2 : e3) * inv;
      int pos = atomicAdd(&cnt[e], 1);
      TOKE[(size_t)m * 4 + lane] = e; TOKP[(size_t)m * 4 + lane] = pos; TOKG[(size_t)m * 4 + lane] = gt;
    }
  }
}

__device__ __forceinline__ void moe_offsets(const Params& p, int* toff) {
  const int* cnt = (const int*)(p.ws + OFF_CNT);
  if (threadIdx.x == 0) {
    int a = 0;
    for (int e = 0; e < 32; ++e) { toff[e] = a; a += (cnt[e] + 255) >> 8; }
    toff[32] = a;
  }
  __syncthreads();
}

__device__ void phase_slotfill(const Params& p, int l, int bid, int nb, char* smem) {
  int* toff = (int*)smem;
  moe_offsets(p, toff);
  const int* TOKE = (const int*)(p.ws + OFF_TOKE);
  const int* TOKP = (const int*)(p.ws + OFF_TOKP);
  const float* TOKG = (const float*)(p.ws + OFF_TOKG);
  int* TOKS = (int*)(p.ws + OFF_TOKS);
  int* SLT = (int*)(p.ws + OFF_SLT);
  float* SLG = (float*)(p.ws + OFF_SLG);
  const int n = ((l == 0) ? NTOK : NLAT) * 4;
  for (int i = bid * NTHR + threadIdx.x; i < n; i += nb * NTHR) {
    int e = TOKE[i];
    int slot = toff[e] * 256 + TOKP[i];
    TOKS[i] = slot; SLT[slot] = i >> 2; SLG[slot] = TOKG[i];
  }
  __syncthreads();
}

__device__ __forceinline__ int find_expert(const int* toff, int mt) {
  int e = 0;
#pragma unroll 1
  for (int i = 1; i < 32; ++i) e = (mt >= toff[i]) ? i : e;
  return e;
}

__device__ void phase_moe1_impl(const Params& p, int l, int bid, int nb, char* smem, int* toff) {
  moe_offsets(p, toff);
  const bfr* H = (const bfr*)(p.ws + OFF_H);
  const int* SLT = (const int*)(p.ws + OFF_SLT);
  const bfr* Wgu = (const bfr*)(p.ws + OFF_W + (size_t)l * WL_SIZE + WL_GU);
  const float* bgu = p.moe_b_gu + (size_t)l * 32 * 2048;
  bfr* ACT = (bfr*)(p.ws + OFF_P);
  const int lane = threadIdx.x & 63, wv = threadIdx.x >> 6, wr = wv >> 2, wc = wv & 3, fr = lane & 15, fq = lane >> 4;
  const int ntile = toff[32] * 16;
  for (int t = bid; t < ntile; t += nb) {
    int mt = t >> 4, nt = t & 15;
    int e = find_expert(toff, mt);
    GemmAcc acc;
    gemm_tile(acc, H, [&](int r) { return (unsigned)(SLT[mt * 256 + r] * 1024); },
              Wgu + ((size_t)e * 2048 + nt * 128) * 1024, smem);
    const float* be = bgu + (size_t)e * 2048;
    const int j = nt * 64 + wc * 16 + fr;
    const float bg = be[j], bl = be[1024 + j];
#pragma unroll
    for (int m = 0; m < 8; ++m)
#pragma unroll
      for (int r = 0; r < 4; ++r) {
        int slot = mt * 256 + wr * 128 + m * 16 + fq * 4 + r;
        float gv = fminf(acc.a[m][0][r] + bg, 7.f);
        float lv = fminf(fmaxf(acc.a[m][1][r] + bl, -7.f), 7.f);
        float a = gv * sigmoidf_(1.702f * gv) * (lv + 1.f);
        ACT[(size_t)slot * 1024 + j] = f2bf(a);
      }
  }
}

__device__ void phase_moe2_impl(const Params& p, int l, int bid, int nb, char* smem, int* toff) {
  moe_offsets(p, toff);
  const bfr* ACT = (const bfr*)(p.ws + OFF_P);
  const float* SLG = (const float*)(p.ws + OFF_SLG);
  const bfr* Wdn = (const bfr*)(p.ws + OFF_W + (size_t)l * WL_SIZE + WL_DN);
  const float* bdn = p.moe_b_down + (size_t)l * 32 * 1024;
  float* YS = (float*)(p.ws + OFF_S);
  const int lane = threadIdx.x & 63, wv = threadIdx.x >> 6, wr = wv >> 2, wc = wv & 3, fr = lane & 15, fq = lane >> 4;
  const int ntile = toff[32] * 8;
  for (int t = bid; t < ntile; t += nb) {
    int mt = t >> 3, nt = t & 7;
    int e = find_expert(toff, mt);
    GemmAcc acc;
    gemm_tile(acc, ACT, [&](int r) { return (unsigned)((mt * 256 + r) * 1024); },
              Wdn + ((size_t)e * 1024 + nt * 128) * 1024, smem);
    const float* be = bdn + (size_t)e * 1024;
#pragma unroll
    for (int m = 0; m < 8; ++m)
#pragma unroll
      for (int r = 0; r < 4; ++r) {
        int slot = mt * 256 + wr * 128 + m * 16 + fq * 4 + r;
        float gt = SLG[slot];
#pragma unroll
        for (int n = 0; n < 2; ++n) {
          int col = nt * 128 + wc * 32 + n * 16 + fr;
          YS[(size_t)slot * 1024 + col] = (acc.a[m][n][r] + be[col]) * gt;
        }
      }
  }
}

__device__ void phase_combine(const Params& p, int l, int bid, int nb) {
  const int tid = threadIdx.x, lane = tid & 63, wv = tid >> 6;
  const float* YS = (const float*)(p.ws + OFF_S);
  const int* TOKS = (const int*)(p.ws + OFF_TOKS);
  const float* mods = (const float*)(p.ws + OFF_MODS) + (size_t)l * 3 * 6144;
  float* xl = p.out;
  float* xc = (float*)(p.ws + OFF_CTX);
  const int ntok = (l == 0) ? NTOK : NLAT;
  for (int m = bid * 8 + wv; m < ntok; m += nb * 8) {
    float* xr = (m < NLAT) ? xl + (size_t)m * 1024 : xc + (size_t)(m - NLAT) * 1024;
    const float* g2 = mods + (size_t)mod_row(m) * 6144 + 5120;
    int s0 = TOKS[(size_t)m * 4], s1 = TOKS[(size_t)m * 4 + 1], s2 = TOKS[(size_t)m * 4 + 2], s3 = TOKS[(size_t)m * 4 + 3];
#pragma unroll
    for (int i = 0; i < 4; ++i) {
      int d = (lane + 64 * i) * 4;
      float4 a = *(const float4*)(YS + (size_t)s0 * 1024 + d);
      float4 b = *(const float4*)(YS + (size_t)s1 * 1024 + d);
      float4 c = *(const float4*)(YS + (size_t)s2 * 1024 + d);
      float4 e = *(const float4*)(YS + (size_t)s3 * 1024 + d);
      float4 gg = *(const float4*)(g2 + d);
      float4 xv = *(const float4*)(xr + d);
      xv.x += gg.x * (a.x + b.x + c.x + e.x);
      xv.y += gg.y * (a.y + b.y + c.y + e.y);
      xv.z += gg.z * (a.z + b.z + c.z + e.z);
      xv.w += gg.w * (a.w + b.w + c.w + e.w);
      *(float4*)(xr + d) = xv;
    }
  }
}

extern __shared__ __attribute__((aligned(16))) char dyn_smem[];

#define PHASE_KERNEL(name, call)                                             \
  __global__ void __launch_bounds__(NTHR) name(Params p, int l) {            \
    __shared__ int toff_s[40];                                               \
    (void)toff_s;                                                            \
    const int bid = blockIdx.x, nb = gridDim.x;                              \
    (void)bid; (void)nb;                                                     \
    call;                                                                    \
  }

PHASE_KERNEL(k_ada, phase_ada(p, bid, nb, dyn_smem))
PHASE_KERNEL(k_convert, phase_convert(p, l, bid, nb, dyn_smem))
PHASE_KERNEL(k_prenorm, phase_prenorm(p, l, bid, nb))
PHASE_KERNEL(k_gemm_in, phase_gemm_in(p, l, bid, nb, dyn_smem))
PHASE_KERNEL(k_prep, phase_prep(p, l, bid, nb, dyn_smem))
PHASE_KERNEL(k_mix, phase_mix(p, l, bid, nb, dyn_smem))
PHASE_KERNEL(k_post, phase_post(p, l, bid, nb))
PHASE_KERNEL(k_gemm_out, phase_gemm_out(p, l, bid, nb, dyn_smem))
PHASE_KERNEL(k_router, phase_router(p, l, bid, nb))
PHASE_KERNEL(k_slotfill, phase_slotfill(p, l, bid, nb, dyn_smem))
PHASE_KERNEL(k_moe1, phase_moe1_impl(p, l, bid, nb, dyn_smem, toff_s))
PHASE_KERNEL(k_moe2, phase_moe2_impl(p, l, bid, nb, dyn_smem, toff_s))
PHASE_KERNEL(k_combine, phase_combine(p, l, bid, nb))

extern "C" void kernel_launch(void* const* d_in, const int* in_sizes, int n_in, void* d_out, int out_size, void* d_ws,
                              size_t ws_size, hipStream_t stream) {
  Params p{};
  const float** pp = (const float**)&p;
  for (int i = 0; i < 34; ++i) pp[i] = (const float*)d_in[i];
  p.out = (float*)d_out;
  p.ws = (char*)d_ws;
  static bool attr_set = false;
  if (!attr_set) {
    hipFuncSetAttribute((const void*)k_ada, hipFuncAttributeMaxDynamicSharedMemorySize, LDS_BYTES);
    hipFuncSetAttribute((const void*)k_convert, hipFuncAttributeMaxDynamicSharedMemorySize, LDS_BYTES);
    hipFuncSetAttribute((const void*)k_gemm_in, hipFuncAttributeMaxDynamicSharedMemorySize, LDS_BYTES);
    hipFuncSetAttribute((const void*)k_prep, hipFuncAttributeMaxDynamicSharedMemorySize, LDS_BYTES);
    hipFuncSetAttribute((const void*)k_mix, hipFuncAttributeMaxDynamicSharedMemorySize, LDS_BYTES);
    hipFuncSetAttribute((const void*)k_gemm_out, hipFuncAttributeMaxDynamicSharedMemorySize, LDS_BYTES);
    hipFuncSetAttribute((const void*)k_slotfill, hipFuncAttributeMaxDynamicSharedMemorySize, LDS_BYTES);
    hipFuncSetAttribute((const void*)k_moe1, hipFuncAttributeMaxDynamicSharedMemorySize, LDS_BYTES);
    hipFuncSetAttribute((const void*)k_moe2, hipFuncAttributeMaxDynamicSharedMemorySize, LDS_BYTES);
    attr_set = true;
  }
  const int G = 256;
  k_ada<<<G, NTHR, LDS_BYTES, stream>>>(p, 0);
  for (int l = 0; l < 2; ++l) {
    k_convert<<<G * 4, NTHR, LDS_BYTES, stream>>>(p, l);
    k_prenorm<<<G, NTHR, 0, stream>>>(p, l);
    k_gemm_in<<<G, NTHR, LDS_BYTES, stream>>>(p, l);
    k_prep<<<G * 2, NTHR, LDS_BYTES, stream>>>(p, l);
    k_mix<<<G, NTHR, LDS_BYTES, stream>>>(p, l);
    k_post<<<G, NTHR, 0, stream>>>(p, l);
    k_gemm_out<<<G, NTHR, LDS_BYTES, stream>>>(p, l);
    k_router<<<G, NTHR, 0, stream>>>(p, l);
    k_slotfill<<<G, NTHR, LDS_BYTES, stream>>>(p, l);
    k_moe1<<<G, NTHR, LDS_BYTES, stream>>>(p, l);
    k_moe2<<<G, NTHR, LDS_BYTES, stream>>>(p, l);
    k_combine<<<G, NTHR, 0, stream>>>(p, l);
  }
}
```

```cpp
#include <hip/hip_runtime.h>
#include <hip/hip_bf16.h>
#include <hip/hip_cooperative_groups.h>
#include <stdint.h>
namespace cg = cooperative_groups;

typedef __attribute__((ext_vector_type(8))) short bf16x8;
typedef __attribute__((ext_vector_type(4))) short bf16x4;
typedef __attribute__((ext_vector_type(4))) float f32x4;
typedef unsigned short bfr;

#define D_MODEL 1024
#define NB 2
#define SEQ 16384
#define CTXL 256
#define NLAT (NB * SEQ)
#define NCTX (NB * CTXL)
#define NTOK (NLAT + NCTX)
#define TTOK (SEQ + CTXL)
#define PIN 3472
#define PINP 3584
#define A_END 1536
#define B_END 2432
#define NEXP 32
#define NSLOT_MAX (NTOK * 4 + NEXP * 256)
#define NTHR 512
#define LDS_BYTES 57600

constexpr size_t al256(size_t x) { return (x + 255) & ~(size_t)255; }
constexpr size_t WL_IN = 0;
constexpr size_t WL_OUT = WL_IN + (size_t)PINP * 1024 * 2;
constexpr size_t WL_GU = WL_OUT + (size_t)1024 * 1024 * 2;
constexpr size_t WL_DN = WL_GU + (size_t)32 * 2048 * 1024 * 2;
constexpr size_t WL_SIZE = WL_DN + (size_t)32 * 1024 * 1024 * 2;
constexpr size_t OFF_W = 0;
constexpr size_t OFF_MODS = al256(OFF_W + 2 * WL_SIZE);
constexpr size_t OFF_CTX = al256(OFF_MODS + 2 * 3 * 6144 * 4);
constexpr size_t OFF_CNT = al256(OFF_CTX + (size_t)NCTX * 1024 * 4);
constexpr size_t OFF_TOKE = al256(OFF_CNT + 256);
constexpr size_t OFF_TOKP = al256(OFF_TOKE + (size_t)NTOK * 4 * 4);
constexpr size_t OFF_TOKG = al256(OFF_TOKP + (size_t)NTOK * 4 * 4);
constexpr size_t OFF_TOKS = al256(OFF_TOKG + (size_t)NTOK * 4 * 4);
constexpr size_t OFF_SLT = al256(OFF_TOKS + (size_t)NTOK * 4 * 4);
constexpr size_t OFF_SLG = al256(OFF_SLT + (size_t)NSLOT_MAX * 4);
constexpr size_t OFF_H = al256(OFF_SLG + (size_t)NSLOT_MAX * 4);
constexpr size_t OFF_CC = al256(OFF_H + (size_t)NTOK * 1024 * 2);
constexpr size_t OFF_P = al256(OFF_CC + (size_t)NTOK * 1024 * 2);
constexpr size_t OFF_S = al256(OFF_P + (size_t)NTOK * PINP * 4);
constexpr size_t TOK256F = (size_t)NTOK * 256 * 4;
constexpr size_t S_QN = 0;
constexpr size_t S_KN = S_QN + (size_t)NTOK * 512 * 2;
constexpr size_t S_VT = S_KN + (size_t)NTOK * 512 * 2;
constexpr size_t S_RWR = S_VT + (size_t)NB * 8 * 64 * TTOK * 2;
constexpr size_t S_RWKK = S_RWR + TOK256F;
constexpr size_t S_RWV = S_RWKK + TOK256F;
constexpr size_t S_RWG = S_RWV + TOK256F;
constexpr size_t S_RWW = S_RWG + TOK256F;
constexpr size_t S_RWKD = S_RWW + 2 * TOK256F;
constexpr size_t S_RWB = S_RWKD + 2 * TOK256F;
constexpr size_t S_BON = S_RWB + 2 * TOK256F;
constexpr size_t S_GDQ = al256(S_BON + (size_t)NTOK * 4 * 4);
constexpr size_t S_GDK = S_GDQ + TOK256F;
constexpr size_t S_GDV = S_GDK + TOK256F;
constexpr size_t S_GDAB = S_GDV + TOK256F;
constexpr size_t S_YRW = al256(S_GDAB + (size_t)NTOK * 16 * 4);
constexpr size_t S_YGD = S_YRW + 2 * TOK256F;
constexpr size_t S_END = S_YGD + 2 * TOK256F;
constexpr size_t S_SIZE = (S_END > (size_t)NSLOT_MAX * 1024 * 4) ? S_END : (size_t)NSLOT_MAX * 1024 * 4;
constexpr size_t WS_TOTAL = OFF_S + S_SIZE;

struct Params {
  const float *x, *c, *ctx, *c_ctx, *ada_w, *ada_b, *norm_mix_g, *norm_ffn_g, *w_in, *w_out;
  const float *na_q_gain, *na_k_gain, *na_rpb;
  const float *rw_mu, *rw_w0, *rw_w_up, *rw_a0, *rw_a_up, *rw_g_up, *rw_k_k, *rw_k_a, *rw_r_k, *rw_ln_w, *rw_ln_b;
  const float *gd_conv_w, *gd_A_log, *gd_dt_bias, *gd_norm_g;
  const float *moe_router_w, *moe_router_b, *moe_w_gu, *moe_b_gu, *moe_w_down, *moe_b_down;
  float* out;
  char* ws;
};

__device__ __forceinline__ int tid_opaque() { int t = (int)__builtin_amdgcn_workitem_id_x(); asm volatile("" : "+v"(t)); return t; }
__device__ __forceinline__ int wave_id(int tid) { return __builtin_amdgcn_readfirstlane(tid >> 6); }
__device__ __forceinline__ bfr f2bf(float f) {
  unsigned u = __float_as_uint(f);
  u += 0x7fffu + ((u >> 16) & 1u);
  return (bfr)(u >> 16);
}
__device__ __forceinline__ float sigmoidf_(float x) { return 1.f / (1.f + __expf(-x)); }
__device__ __forceinline__ float siluf_(float x) { return x / (1.f + __expf(-x)); }
__device__ __forceinline__ float softplusf_(float x) { return x > 20.f ? x : log1pf(__expf(x)); }
__device__ __forceinline__ float wave_sum(float v) {
#pragma unroll
  for (int o = 32; o >= 1; o >>= 1) v += __shfl_xor(v, o, 64);
  return v;
}
__device__ __forceinline__ float row16_sum(float v) {
  v += __builtin_bit_cast(float, __builtin_amdgcn_update_dpp(0, __builtin_bit_cast(int, v), 0xB1, 0xF, 0xF, true));
  v += __builtin_bit_cast(float, __builtin_amdgcn_update_dpp(0, __builtin_bit_cast(int, v), 0x4E, 0xF, 0xF, true));
  v += __builtin_bit_cast(float, __builtin_amdgcn_update_dpp(0, __builtin_bit_cast(int, v), 0x141, 0xF, 0xF, true));
  v += __builtin_bit_cast(float, __builtin_amdgcn_update_dpp(0, __builtin_bit_cast(int, v), 0x140, 0xF, 0xF, true));
  return v;
}
__device__ __forceinline__ int mod_row(int m) { return m < NLAT ? (m >> 14) : 2; }

__device__ void phase_ada(const Params& p, int bid, int nb, char* smem) {
  float* red = (float*)smem;
  float* mods = (float*)(p.ws + OFF_MODS);
  const int tid = tid_opaque();
  for (int task = bid; task < 2 * 96; task += nb) {
    int l = task / 96, cgp = task % 96;
    int col = cgp * 64 + (tid & 63), ks = tid >> 6;
    const float* W = p.ada_w + (size_t)l * 1024 * 6144;
    float a0 = 0.f, a1 = 0.f, a2 = 0.f;
    for (int d = ks * 128; d < ks * 128 + 128; ++d) {
      float w = W[(size_t)d * 6144 + col];
      a0 += siluf_(p.c[d]) * w;
      a1 += siluf_(p.c[1024 + d]) * w;
      a2 += siluf_(p.c_ctx[d]) * w;
    }
    red[(ks * 3 + 0) * 64 + (tid & 63)] = a0;
    red[(ks * 3 + 1) * 64 + (tid & 63)] = a1;
    red[(ks * 3 + 2) * 64 + (tid & 63)] = a2;
    __syncthreads();
    if (tid < 192) {
      int r = tid >> 6, cc = tid & 63;
      float s = 0.f;
      for (int k = 0; k < 8; ++k) s += red[(k * 3 + r) * 64 + cc];
      mods[(size_t)(l * 3 + r) * 6144 + cgp * 64 + cc] = s + p.ada_b[(size_t)l * 6144 + cgp * 64 + cc];
    }
    __syncthreads();
  }
}

__device__ void convert_tile(const float* src, int N, bfr* dst, int kt, int nt, int mode, float* tile  ) {
  const int tid = tid_opaque();
#pragma unroll
  for (int q = 0; q < 2; ++q) {
    int idx = tid + q * 512;
    int kk = idx >> 4, n4 = idx & 15;
    int n = nt * 64 + n4 * 4;
    float4 v = make_float4(0.f, 0.f, 0.f, 0.f);
    if (n < N) v = *(const float4*)(src + (size_t)(kt * 64 + kk) * N + n);
    tile[kk * 65 + n4 * 4 + 0] = v.x;
    tile[kk * 65 + n4 * 4 + 1] = v.y;
    tile[kk * 65 + n4 * 4 + 2] = v.z;
    tile[kk * 65 + n4 * 4 + 3] = v.w;
  }
  __syncthreads();
  {
    int nn = tid >> 3, kc = tid & 7;
    int n = nt * 64 + nn;
    int row = n;
    if (mode == 1) { int j = n & 1023; row = (j >> 4) * 32 + (j & 15) + ((n >= 1024) ? 16 : 0); }
    bf16x8 o;
#pragma unroll
    for (int j = 0; j < 8; ++j) o[j] = (short)f2bf(tile[(kc * 8 + j) * 65 + nn]);
    *(bf16x8*)(dst + (size_t)row * 1024 + kt * 64 + kc * 8) = o;
  }
  __syncthreads();
}
__device__ void phase_convert(const Params& p, int l, int bid, int nb, char* smem) {
  float* tile = (float*)smem;
  char* wl = p.ws + OFF_W + (size_t)l * WL_SIZE;
  const int T_IN = 16 * 56, T_OUT = 16 * 16, T_GU = 32 * 16 * 32, T_DN = 32 * 16 * 16;
  const int total = T_IN + T_OUT + T_GU + T_DN;
  for (int t = bid; t < total; t += nb) {
    if (t < T_IN) {
      int kt = t / 56, nt = t % 56;
      convert_tile(p.w_in + (size_t)l * 1024 * PIN, PIN, (bfr*)(wl + WL_IN), kt, nt, 0, tile);
    } else if (t < T_IN + T_OUT) {
      int u = t - T_IN; int kt = u / 16, nt = u % 16;
      convert_tile(p.w_out + (size_t)l * 1024 * 1024, 1024, (bfr*)(wl + WL_OUT), kt, nt, 0, tile);
    } else if (t < T_IN + T_OUT + T_GU) {
      int u = t - T_IN - T_OUT; int e = u / 512; int v = u % 512; int kt = v / 32, nt = v % 32;
      convert_tile(p.moe_w_gu + ((size_t)l * 32 + e) * 1024 * 2048, 2048, (bfr*)(wl + WL_GU) + (size_t)e * 2048 * 1024, kt, nt, 1, tile);
    } else {
      int u = t - T_IN - T_OUT - T_GU; int e = u / 256; int v = u % 256; int kt = v / 16, nt = v % 16;
      convert_tile(p.moe_w_down + ((size_t)l * 32 + e) * 1024 * 1024, 1024, (bfr*)(wl + WL_DN) + (size_t)e * 1024 * 1024, kt, nt, 0, tile);
    }
  }
}

__device__ void phase_prenorm(const Params& p, int l, int bid, int nb) {
  const int tid = tid_opaque(), lane = tid & 63, wv = wave_id(tid);
  const float* xl = (l == 0) ? p.x : p.out;
  const float* xc = (l == 0) ? p.ctx : (const float*)(p.ws + OFF_CTX);
  const float* mods = (const float*)(p.ws + OFF_MODS) + (size_t)l * 3 * 6144;
  const float* g = p.norm_mix_g + (size_t)l * 1024;
  bfr* H = (bfr*)(p.ws + OFF_H);
  {
    int* cnt = (int*)(p.ws + OFF_CNT);
    int* slt = (int*)(p.ws + OFF_SLT);
    int gt = bid * NTHR + tid;
    if (gt < 32) cnt[gt] = 0;
    for (int i = gt; i < NSLOT_MAX; i += nb * NTHR) slt[i] = 0;
  }
  for (int m = bid * 8 + wv; m < NTOK; m += nb * 8) {
    const float* xr = (m < NLAT) ? xl + (size_t)m * 1024 : xc + (size_t)(m - NLAT) * 1024;
    const float* md = mods + (size_t)mod_row(m) * 6144;
    float4 v[4];
    float ss = 0.f;
#pragma unroll
    for (int i = 0; i < 4; ++i) {
      v[i] = *(const float4*)(xr + (lane + 64 * i) * 4);
      ss += v[i].x * v[i].x + v[i].y * v[i].y + v[i].z * v[i].z + v[i].w * v[i].w;
    }
    ss = wave_sum(ss);
    float rs = rsqrtf(ss * (1.f / 1024.f) + 1e-6f);
#pragma unroll
    for (int i = 0; i < 4; ++i) {
      int d = (lane + 64 * i) * 4;
      float4 gg = *(const float4*)(g + d);
      float4 sh = *(const float4*)(md + d);
      float4 sc = *(const float4*)(md + 1024 + d);
      bf16x4 o;
      o[0] = (short)f2bf(v[i].x * rs * gg.x * (1.f + sc.x) + sh.x);
      o[1] = (short)f2bf(v[i].y * rs * gg.y * (1.f + sc.y) + sh.y);
      o[2] = (short)f2bf(v[i].z * rs * gg.z * (1.f + sc.z) + sh.z);
      o[3] = (short)f2bf(v[i].w * rs * gg.w * (1.f + sc.w) + sh.w);
      *(bf16x4*)(H + (size_t)m * 1024 + d) = o;
    }
  }
}

#define GLDS_ROW 144
#define GEMM_LDS (384 * GLDS_ROW)
struct GemmAcc { f32x4 a[8][2]; };

template <class RowFn>
__device__ __forceinline__ void gemm_tile(GemmAcc& acc, const bfr* Abase, RowFn rowfn, const bfr* Bt  , char* smem) {
  const int tid = tid_opaque(), lane = tid & 63, wv = wave_id(tid);
  const int wr = wv >> 2, wc = wv & 3;
  const int fr = lane & 15, fq = lane >> 4;
  char* sA = smem;
  char* sB = smem + 256 * GLDS_ROW;
#pragma unroll
  for (int m = 0; m < 8; ++m)
#pragma unroll
    for (int n = 0; n < 2; ++n) acc.a[m][n] = (f32x4){0.f, 0.f, 0.f, 0.f};
  const int srow = tid >> 3, c16 = tid & 7;
  unsigned ao0 = rowfn(srow) + c16 * 8, ao1 = rowfn(srow + 64) + c16 * 8, ao2 = rowfn(srow + 128) + c16 * 8, ao3 = rowfn(srow + 192) + c16 * 8;
  const bfr* bp = Bt + (size_t)srow * 1024 + c16 * 8;
  const int lo = srow * GLDS_ROW + c16 * 16;
  uint4 ra0, ra1, ra2, ra3, rb0, rb1;
  ra0 = *(const uint4*)(Abase + ao0); ra1 = *(const uint4*)(Abase + ao1);
  ra2 = *(const uint4*)(Abase + ao2); ra3 = *(const uint4*)(Abase + ao3);
  rb0 = *(const uint4*)(bp); rb1 = *(const uint4*)(bp + 64 * 1024);
  for (int kt = 0; kt < 16; ++kt) {
    __syncthreads();
    *(uint4*)(sA + lo) = ra0; *(uint4*)(sA + lo + 64 * GLDS_ROW) = ra1;
    *(uint4*)(sA + lo + 128 * GLDS_ROW) = ra2; *(uint4*)(sA + lo + 192 * GLDS_ROW) = ra3;
    *(uint4*)(sB + lo) = rb0; *(uint4*)(sB + lo + 64 * GLDS_ROW) = rb1;
    __syncthreads();
    if (kt + 1 < 16) {
      const int ko = (kt + 1) * 64;
      ra0 = *(const uint4*)(Abase + ao0 + ko); ra1 = *(const uint4*)(Abase + ao1 + ko);
      ra2 = *(const uint4*)(Abase + ao2 + ko); ra3 = *(const uint4*)(Abase + ao3 + ko);
      rb0 = *(const uint4*)(bp + ko); rb1 = *(const uint4*)(bp + 64 * 1024 + ko);
    }
#pragma unroll
    for (int s = 0; s < 2; ++s) {
      bf16x8 b0 = *(const bf16x8*)(sB + (wc * 32 + fr) * GLDS_ROW + s * 64 + fq * 16);
      bf16x8 b1 = *(const bf16x8*)(sB + (wc * 32 + 16 + fr) * GLDS_ROW + s * 64 + fq * 16);
#pragma unroll
      for (int m = 0; m < 8; ++m) {
        bf16x8 af = *(const bf16x8*)(sA + (wr * 128 + m * 16 + fr) * GLDS_ROW + s * 64 + fq * 16);
        acc.a[m][0] = __builtin_amdgcn_mfma_f32_16x16x32_bf16(af, b0, acc.a[m][0], 0, 0, 0);
        acc.a[m][1] = __builtin_amdgcn_mfma_f32_16x16x32_bf16(af, b1, acc.a[m][1], 0, 0, 0);
      }
    }
  }
}

__device__ void phase_gemm_in(const Params& p, int l, int bid, int nb, char* smem) {
  const bfr* H = (const bfr*)(p.ws + OFF_H);
  const bfr* Bt = (const bfr*)(p.ws + OFF_W + (size_t)l * WL_SIZE + WL_IN);
  float* P = (float*)(p.ws + OFF_P);
  const int tid = tid_opaque(), lane = tid & 63, wv = wave_id(tid), wr = wv >> 2, wc = wv & 3, fr = lane & 15, fq = lane >> 4;
  const int ntile = 130 * 28;
  for (int t = bid; t < ntile; t += nb) {
    int mt = t / 28, nt = t % 28;
    GemmAcc acc;
    gemm_tile(acc, H, [&](int r) { return (unsigned)((mt * 256 + r) * 1024); }, Bt + (size_t)nt * 128 * 1024, smem);
#pragma unroll
    for (int m = 0; m < 8; ++m)
#pragma unroll
      for (int n = 0; n < 2; ++n)
#pragma unroll
        for (int r = 0; r < 4; ++r) {
          int row = mt * 256 + wr * 128 + m * 16 + fq * 4 + r;
          int col = nt * 128 + wc * 32 + n * 16 + fr;
          P[(size_t)row * PINP + col] = acc.a[m][n][r];
        }
  }
}

__device__ void phase_gemm_out(const Params& p, int l, int bid, int nb, char* smem) {
  const bfr* CC = (const bfr*)(p.ws + OFF_CC);
  const bfr* Bt = (const bfr*)(p.ws + OFF_W + (size_t)l * WL_SIZE + WL_OUT);
  const float* mods = (const float*)(p.ws + OFF_MODS) + (size_t)l * 3 * 6144;
  const float* xl = (l == 0) ? p.x : p.out;
  const float* xc = (l == 0) ? p.ctx : (const float*)(p.ws + OFF_CTX);
  float* ol = p.out;
  float* oc = (float*)(p.ws + OFF_CTX);
  const int tid = tid_opaque(), lane = tid & 63, wv = wave_id(tid), wr = wv >> 2, wc = wv & 3, fr = lane & 15, fq = lane >> 4;
  const int nmt = (l == 0) ? 130 : 128;
  const int ntile = nmt * 8;
  for (int t = bid; t < ntile; t += nb) {
    int mt = t >> 3, nt = t & 7;
    GemmAcc acc;
    gemm_tile(acc, CC, [&](int r) { return (unsigned)((mt * 256 + r) * 1024); }, Bt + (size_t)nt * 128 * 1024, smem);
    const bool lat = mt < 128;
    const float* xin = lat ? xl + (size_t)mt * 256 * 1024 : xc + (size_t)(mt - 128) * 256 * 1024;
    float* xo = lat ? ol + (size_t)mt * 256 * 1024 : oc + (size_t)(mt - 128) * 256 * 1024;
    const float* g1 = mods + (size_t)(lat ? (mt >> 6) : 2) * 6144 + 2048;
#pragma unroll
    for (int m = 0; m < 8; ++m)
#pragma unroll
      for (int n = 0; n < 2; ++n)
#pragma unroll
        for (int r = 0; r < 4; ++r) {
          int row = wr * 128 + m * 16 + fq * 4 + r;
          int col = nt * 128 + wc * 32 + n * 16 + fr;
          xo[(size_t)row * 1024 + col] = xin[(size_t)row * 1024 + col] + g1[col] * acc.a[m][n][r];
        }
  }
}

__device__ void phase_prep(const Params& p, int l, int bid, int nb, char* smem) {
  const int tid = tid_opaque(), lane = tid & 63, wv = wave_id(tid);
  const float* P = (const float*)(p.ws + OFF_P);
  char* S = p.ws + OFF_S;
  bfr* QN = (bfr*)(S + S_QN);
  bfr* KN = (bfr*)(S + S_KN);
  bfr* VT = (bfr*)(S + S_VT);
  float* RWR = (float*)(S + S_RWR);
  float* RWKK = (float*)(S + S_RWKK);
  float* RWV = (float*)(S + S_RWV);
  float* RWG = (float*)(S + S_RWG);
  float* RWW = (float*)(S + S_RWW);
  float* RWKD = (float*)(S + S_RWKD);
  float* RWB = (float*)(S + S_RWB);
  float* BON = (float*)(S + S_BON);
  float* GDQ = (float*)(S + S_GDQ);
  float* GDK = (float*)(S + S_GDK);
  float* GDV = (float*)(S + S_GDV);
  float* GDAB = (float*)(S + S_GDAB);
  const float* mu = p.rw_mu + (size_t)l * 896;
  const float* w0 = p.rw_w0 + (size_t)l * 512;
  const float* w_up = p.rw_w_up + (size_t)l * 2 * 32 * 256;
  const float* a0 = p.rw_a0 + (size_t)l * 512;
  const float* a_up = p.rw_a_up + (size_t)l * 2 * 32 * 256;
  const float* g_up = p.rw_g_up + (size_t)l * 64 * 256;
  const float* k_k = p.rw_k_k + (size_t)l * 256;
  const float* k_a = p.rw_k_a + (size_t)l * 256;
  const float* r_k = p.rw_r_k + (size_t)l * 256;
  const float* conv_w = p.gd_conv_w + (size_t)l * 5 * 768;
  const float* A_log = p.gd_A_log + (size_t)l * 8;
  const float* dt_bias = p.gd_dt_bias + (size_t)l * 8;
  const float* qg = p.na_q_gain + (size_t)l * 64;
  const float* kg = p.na_k_gain + (size_t)l * 64;

  float* rw = (float*)smem;
  float* lor = rw + 16 * 768;
  float* gd = rw;

  for (int tile = bid; tile < NTOK / 16; tile += nb) {
    const int m0 = tile * 16;
    int seq_lo, seq_hi;
    int bb, tau0;
    if (m0 < NLAT) { bb = m0 >> 14; seq_lo = bb << 14; seq_hi = seq_lo + SEQ; tau0 = m0 - seq_lo; }
    else { bb = (m0 - NLAT) >> 8; seq_lo = NLAT + (bb << 8); seq_hi = seq_lo + CTXL; tau0 = SEQ + (m0 - seq_lo); }

    for (int i = tid; i < 16 * 896; i += NTHR) {
      int t = i / 896, c = i % 896;
      int m = m0 + t;
      const float* pr = P + (size_t)m * PINP + A_END + c;
      float cur = *pr;
      float prev = (m - 1 >= seq_lo) ? *(pr - PINP) : 0.f;
      float nxt = (m + 1 < seq_hi) ? *(pr + PINP) : 0.f;
      float v = cur + mu[c] * (0.5f * (prev + nxt) - cur);
      if (c < 768) rw[t * 768 + c] = v;
      else if (c < 800) lor[(c - 768) * 16 + t] = tanhf(v);
      else if (c < 832) lor[(32 + c - 800) * 16 + t] = v;
      else lor[(64 + c - 832) * 16 + t] = sigmoidf_(v);
    }
    __syncthreads();
    {
      const int c = tid & 255, th = tid >> 8;
      const float kkc = k_k[c], kac = k_a[c], rkc = r_k[c];
      const float w00 = w0[c], w01 = w0[256 + c], a00 = a0[c], a01 = a0[256 + c];
      const int h = c >> 6;
#pragma unroll 1
      for (int ps = 0; ps < 2; ++ps) {
        const int tb = th * 8 + ps * 4;
        float4 gacc = make_float4(0.f, 0.f, 0.f, 0.f), wa0 = gacc, wa1 = gacc, aa0 = gacc, aa1 = gacc;
#pragma unroll 4
        for (int j = 0; j < 64; ++j) {
          float wgt = g_up[j * 256 + c];
          float4 s0 = *(const float4*)(lor + (64 + j) * 16 + tb);
          gacc.x += s0.x * wgt; gacc.y += s0.y * wgt; gacc.z += s0.z * wgt; gacc.w += s0.w * wgt;
        }
#pragma unroll 4
        for (int j = 0; j < 32; ++j) {
          float4 t0 = *(const float4*)(lor + j * 16 + tb);
          float4 d0 = *(const float4*)(lor + (32 + j) * 16 + tb);
          float ww0 = w_up[j * 256 + c], ww1 = w_up[(32 + j) * 256 + c];
          float aw0 = a_up[j * 256 + c], aw1 = a_up[(32 + j) * 256 + c];
          wa0.x += t0.x * ww0; wa0.y += t0.y * ww0; wa0.z += t0.z * ww0; wa0.w += t0.w * ww0;
          wa1.x += t0.x * ww1; wa1.y += t0.y * ww1; wa1.z += t0.z * ww1; wa1.w += t0.w * ww1;
          aa0.x += d0.x * aw0; aa0.y += d0.y * aw0; aa0.z += d0.z * aw0; aa0.w += d0.w * aw0;
          aa1.x += d0.x * aw1; aa1.y += d0.y * aw1; aa1.z += d0.z * aw1; aa1.w += d0.w * aw1;
        }
#pragma unroll
        for (int t = 0; t < 4; ++t) {
          const int tt = tb + t;
          const int m = m0 + tt;
          const float gv = t == 0 ? gacc.x : t == 1 ? gacc.y : t == 2 ? gacc.z : gacc.w;
          const float wv0 = t == 0 ? wa0.x : t == 1 ? wa0.y : t == 2 ? wa0.z : wa0.w;
          const float wv1 = t == 0 ? wa1.x : t == 1 ? wa1.y : t == 2 ? wa1.z : wa1.w;
          const float av0 = t == 0 ? aa0.x : t == 1 ? aa0.y : t == 2 ? aa0.z : aa0.w;
          const float av1 = t == 0 ? aa1.x : t == 1 ? aa1.y : t == 2 ? aa1.z : aa1.w;
          float r = rw[tt * 768 + c], k = rw[tt * 768 + 256 + c], v = rw[tt * 768 + 512 + c];
          float kkraw = k * kkc;
          float ssum = wave_sum(kkraw * kkraw);
          float kk = kkraw * rsqrtf(ssum + 1e-6f);
          float bon = 0.f;
#pragma unroll
          for (int d = 0; d < 2; ++d) {
            float wl = (d == 0 ? w00 + wv0 : w01 + wv1);
            float w_log = -softplusf_(-wl) - 0.5f;
            float decay = __expf(-__expf(w_log));
            float a = sigmoidf_(d == 0 ? a00 + av0 : a01 + av1);
            float kd = k * (1.f + (a - 1.f) * kac);
            bon += r * kd * rkc;
            size_t o = ((size_t)d * NTOK + m) * 256 + c;
            RWW[o] = decay; RWKD[o] = kd; RWB[o] = kk * a;
          }
          bon = wave_sum(bon);
          size_t o = (size_t)m * 256 + c;
          RWR[o] = r; RWKK[o] = kk; RWV[o] = v; RWG[o] = gv;
          if (lane == 0) BON[(size_t)m * 4 + h] = bon;
        }
      }
    }
    __syncthreads();
    for (int i = tid; i < 16 * 768; i += NTHR) {
      int t = i / 768, c = i % 768;
      int m = m0 + t;
      float acc = 0.f;
#pragma unroll
      for (int j = 0; j < 5; ++j) {
        int mm = m + j - 2;
        if (mm >= seq_lo && mm < seq_hi) acc += conv_w[j * 768 + c] * P[(size_t)mm * PINP + B_END + c];
      }
      gd[t * 768 + c] = siluf_(acc);
    }
    __syncthreads();
    for (int wt = wv; wt < 16 * 12; wt += 8) {
      int t = wt / 12, hs = wt % 12;
      int m = m0 + t;
      float val = gd[t * 768 + hs * 64 + lane];
      if (hs < 8) {
        float ss = wave_sum(val * val);
        val *= rsqrtf(ss + 1e-6f);
        if (hs < 4) GDQ[(size_t)m * 256 + hs * 64 + lane] = val * 0.125f;
        else GDK[(size_t)m * 256 + (hs - 4) * 64 + lane] = val;
      } else GDV[(size_t)m * 256 + (hs - 8) * 64 + lane] = val;
    }
    if (tid < 256) {
      int t = tid >> 4, j = tid & 15;
      int m = m0 + t;
      float pv = P[(size_t)m * PINP + B_END + 1024 + j];
      float o;
      if (j < 8) o = __expf(-__expf(A_log[j]) * softplusf_(pv + dt_bias[j]));
      else o = sigmoidf_(pv);
      GDAB[(size_t)m * 16 + j] = o;
    }
    for (int wt = wv; wt < 16 * 16; wt += 8) {
      int t = wt >> 4, hs = wt & 15;
      int m = m0 + t;
      float val = P[(size_t)m * PINP + hs * 64 + lane];
      float ss = wave_sum(val * val);
      val *= rsqrtf(ss * (1.f / 64.f) + 1e-6f);
      if (hs < 8) QN[(size_t)m * 512 + hs * 64 + lane] = f2bf(val * qg[lane] * (0.125f * 1.4426950408889634f));
      else KN[(size_t)m * 512 + (hs - 8) * 64 + lane] = f2bf(val * kg[lane]);
    }
    {
      int hd = tid;
      bf16x8 o0, o1;
#pragma unroll
      for (int t = 0; t < 8; ++t) {
        o0[t] = (short)f2bf(P[(size_t)(m0 + t) * PINP + 1024 + hd]);
        o1[t] = (short)f2bf(P[(size_t)(m0 + 8 + t) * PINP + 1024 + hd]);
      }
      bfr* dst = VT + ((size_t)(bb * 512 + hd)) * TTOK + tau0;
      *(bf16x8*)dst = o0;
      *(bf16x8*)(dst + 8) = o1;
    }
    __syncthreads();
  }
}

#define SC_TB 32
__device__ __forceinline__ int scan_tok(int b, int d, int s) {
  if (s < CTXL) { int t = d ? (CTXL - 1 - s) : s; return NLAT + b * CTXL + t; }
  int u = s - CTXL; int t = d ? (SEQ - 1 - u) : u; return b * SEQ + t;
}
template <bool GDN>
__device__ void scan_chain(const Params& p, int b, int h, int d, int half, char* smem) {
  const int tid = tid_opaque(), lane = tid & 63, wv = wave_id(tid);
  char* S = p.ws + OFF_S;
  const float *src0, *src1, *src2, *src3, *src4, *xsrc;
  const float* ab = (const float*)(S + S_GDAB);
  float* Y;
  if (!GDN) {
    src0 = (const float*)(S + S_RWKK);
    src1 = (const float*)(S + S_RWW) + (size_t)d * NTOK * 256;
    src2 = (const float*)(S + S_RWB) + (size_t)d * NTOK * 256;
    src3 = (const float*)(S + S_RWKD) + (size_t)d * NTOK * 256;
    src4 = (const float*)(S + S_RWR);
    xsrc = (const float*)(S + S_RWV);
    Y = (float*)(S + S_YRW) + (size_t)d * NTOK * 256;
  } else {
    src0 = (const float*)(S + S_GDK);
    src1 = src0; src2 = src0; src3 = src0;
    src4 = (const float*)(S + S_GDQ);
    xsrc = (const float*)(S + S_GDV);
    Y = (float*)(S + S_YGD) + (size_t)d * NTOK * 256;
  }
  float* vec = (float*)smem;
  float* xs = vec + 5 * SC_TB * 64;
  float* sc = xs + SC_TB * 32;
  float* yb = sc + SC_TB * 2;
  const int rl = wv * 4 + (lane >> 4);
  const int j4 = (lane & 15) * 4;
  float s0 = 0.f, s1 = 0.f, s2 = 0.f, s3 = 0.f;
  float4 rg0, rg1, rg2, rg3, rg4, rx;
  rg0 = rg1 = rg2 = rg3 = rg4 = rx = make_float4(0.f, 0.f, 0.f, 0.f);
  float rsc = 0.f;
  const int st_step = tid >> 4, st_part = tid & 15;
#define SCAN_ISSUE(batch)                                                                          \
  {                                                                                                \
    int m_ = scan_tok(b, d, (batch) * SC_TB + st_step);                                            \
    size_t o_ = (size_t)m_ * 256 + h * 64 + st_part * 4;                                           \
    rg0 = *(const float4*)(src0 + o_);                                                             \
    rg4 = *(const float4*)(src4 + o_);                                                             \
    if (!GDN) { rg1 = *(const float4*)(src1 + o_); rg2 = *(const float4*)(src2 + o_); rg3 = *(const float4*)(src3 + o_); } \
    if (tid < 256) {                                                                               \
      int m2_ = scan_tok(b, d, (batch) * SC_TB + (tid >> 3));                                      \
      rx = *(const float4*)(xsrc + (size_t)m2_ * 256 + h * 64 + half * 32 + (tid & 7) * 4);        \
    }                                                                                              \
    if (GDN && tid < 64) {                                                                         \
      int m3_ = scan_tok(b, d, (batch) * SC_TB + (tid >> 1));                                      \
      rsc = ab[(size_t)m3_ * 16 + (tid & 1) * 8 + d * 4 + h];                                      \
    }                                                                                              \
  }
  const int nbatch = TTOK / SC_TB;
  SCAN_ISSUE(0)
  for (int bt = 0; bt < nbatch; ++bt) {
    __syncthreads();
    *(float4*)(vec + (0 * SC_TB + st_step) * 64 + st_part * 4) = rg0;
    *(float4*)(vec + (4 * SC_TB + st_step) * 64 + st_part * 4) = rg4;
    if (!GDN) {
      *(float4*)(vec + (1 * SC_TB + st_step) * 64 + st_part * 4) = rg1;
      *(float4*)(vec + (2 * SC_TB + st_step) * 64 + st_part * 4) = rg2;
      *(float4*)(vec + (3 * SC_TB + st_step) * 64 + st_part * 4) = rg3;
    }
    if (tid < 256) *(float4*)(xs + (tid >> 3) * 32 + (tid & 7) * 4) = rx;
    if (GDN && tid < 64) sc[tid] = rsc;
    __syncthreads();
    if (bt + 1 < nbatch) SCAN_ISSUE(bt + 1)
#pragma unroll 4
    for (int st = 0; st < SC_TB; ++st) {
      float4 kap = *(const float4*)(vec + (0 * SC_TB + st) * 64 + j4);
      float4 r4 = *(const float4*)(vec + (4 * SC_TB + st) * 64 + j4);
      float x = xs[st * 32 + rl];
      float dp = s0 * kap.x + s1 * kap.y + s2 * kap.z + s3 * kap.w;
      float dd = row16_sum(dp);
      if (!GDN) {
        float4 w4 = *(const float4*)(vec + (1 * SC_TB + st) * 64 + j4);
        float4 b4 = *(const float4*)(vec + (2 * SC_TB + st) * 64 + j4);
        float4 k4 = *(const float4*)(vec + (3 * SC_TB + st) * 64 + j4);
        s0 = s0 * w4.x + x * k4.x - dd * b4.x;
        s1 = s1 * w4.y + x * k4.y - dd * b4.y;
        s2 = s2 * w4.z + x * k4.z - dd * b4.z;
        s3 = s3 * w4.w + x * k4.w - dd * b4.w;
      } else {
        float al = sc[st * 2], be = sc[st * 2 + 1];
        float cf = be * (x - al * dd);
        s0 = al * s0 + cf * kap.x;
        s1 = al * s1 + cf * kap.y;
        s2 = al * s2 + cf * kap.z;
        s3 = al * s3 + cf * kap.w;
      }
      float yp = s0 * r4.x + s1 * r4.y + s2 * r4.z + s3 * r4.w;
      float yy = row16_sum(yp);
      if ((lane & 15) == 0) yb[st * 32 + rl] = yy;
    }
    __syncthreads();
    for (int i = tid; i < SC_TB * 32; i += NTHR) {
      int st = i >> 5, r = i & 31;
      int m = scan_tok(b, d, bt * SC_TB + st);
      Y[(size_t)m * 256 + h * 64 + half * 32 + r] = yb[i];
    }
  }
  __syncthreads();
#undef SCAN_ISSUE
}

__device__ __forceinline__ void na_pair(const bfr* KN, const bfr* VT, const bf16x8 qf0, const bf16x8 qf1,
                                        int mk0, int mk1, size_t vt_base, int tau0, int tau1, int h, int lane,
                                        bool local, int kr0, int kr1, int ct0, int ct1, int qr, int qc, const float* bias_h,
                                        f32x4 (&O)[4], float& lsum) {
  const int fr = lane & 15, fq = lane >> 4;
  const bf16x8 k00 = *(const bf16x8*)(KN + (size_t)(mk0 + fr) * 512 + h * 64 + fq * 8);
  const bf16x8 k01 = *(const bf16x8*)(KN + (size_t)(mk0 + fr) * 512 + h * 64 + 32 + fq * 8);
  const bf16x8 k10 = *(const bf16x8*)(KN + (size_t)(mk1 + fr) * 512 + h * 64 + fq * 8);
  const bf16x8 k11 = *(const bf16x8*)(KN + (size_t)(mk1 + fr) * 512 + h * 64 + 32 + fq * 8);
  f32x4 z = {0.f, 0.f, 0.f, 0.f};
  f32x4 st0 = __builtin_amdgcn_mfma_f32_16x16x32_bf16(k00, qf0, z, 0, 0, 0);
  st0 = __builtin_amdgcn_mfma_f32_16x16x32_bf16(k01, qf1, st0, 0, 0, 0);
  f32x4 st1 = __builtin_amdgcn_mfma_f32_16x16x32_bf16(k10, qf0, z, 0, 0, 0);
  st1 = __builtin_amdgcn_mfma_f32_16x16x32_bf16(k11, qf1, st1, 0, 0, 0);
  bf16x8 pf;
  if (local) {
    int cs = min(max(qc - 8, 0), 48);
#pragma unroll
    for (int r = 0; r < 4; ++r) {
      int kc0 = ct0 * 16 + fq * 4 + r;
      int kc1 = ct1 * 16 + fq * 4 + r;
      float p0 = 0.f, p1 = 0.f;
      if ((unsigned)(kc0 - cs) < 16u) p0 = exp2f(st0[r] + bias_h[(kr0 - qr + 7) * 31 + (kc0 - qc + 15)]);
      if ((unsigned)(kc1 - cs) < 16u) p1 = exp2f(st1[r] + bias_h[(kr1 - qr + 7) * 31 + (kc1 - qc + 15)]);
      lsum += p0 + p1;
      pf[r] = (short)f2bf(p0);
      pf[4 + r] = (short)f2bf(p1);
    }
  } else {
#pragma unroll
    for (int r = 0; r < 4; ++r) {
      float p0 = exp2f(st0[r]), p1 = exp2f(st1[r]);
      lsum += p0 + p1;
      pf[r] = (short)f2bf(p0);
      pf[4 + r] = (short)f2bf(p1);
    }
  }
#pragma unroll
  for (int dt = 0; dt < 4; ++dt) {
    const bfr* vrow = VT + vt_base + (size_t)(dt * 16 + fr) * TTOK;
    bf16x4 v0 = *(const bf16x4*)(vrow + tau0 + fq * 4);
    bf16x4 v1 = *(const bf16x4*)(vrow + tau1 + fq * 4);
    bf16x8 vf;
    vf[0] = v0[0]; vf[1] = v0[1]; vf[2] = v0[2]; vf[3] = v0[3];
    vf[4] = v1[0]; vf[5] = v1[1]; vf[6] = v1[2]; vf[7] = v1[3];
    O[dt] = __builtin_amdgcn_mfma_f32_16x16x32_bf16(vf, pf, O[dt], 0, 0, 0);
  }
}

__device__ void na_block_task(const Params& p, int task, const float* bias_lds) {
  const int tid = tid_opaque(), lane = tid & 63, wv = wave_id(tid);
  const int fr = lane & 15, fq = lane >> 4;
  char* S = p.ws + OFF_S;
  const bfr* QN = (const bfr*)(S + S_QN);
  const bfr* KN = (const bfr*)(S + S_KN);
  const bfr* VT = (const bfr*)(S + S_VT);
  bfr* CC = (bfr*)(p.ws + OFF_CC);
  int b, h, mq0;
  bool latent = task < 2048;
  int qr = 0, cgp = 0;
  if (latent) {
    h = task & 7; int rp = (task >> 3) & 127; b = task >> 10;
    qr = rp * 2 + (wv >> 2); cgp = wv & 3;
    mq0 = b * SEQ + qr * 64 + cgp * 16;
  } else {
    int u = task - 2048;
    int half = u & 1; h = (u >> 1) & 7; b = u >> 4;
    mq0 = NLAT + b * CTXL + (half * 8 + wv) * 16;
  }
  const bf16x8 qf0 = *(const bf16x8*)(QN + (size_t)(mq0 + fr) * 512 + h * 64 + fq * 8);
  const bf16x8 qf1 = *(const bf16x8*)(QN + (size_t)(mq0 + fr) * 512 + h * 64 + 32 + fq * 8);
  f32x4 O[4];
#pragma unroll
  for (int dt = 0; dt < 4; ++dt) O[dt] = (f32x4){0.f, 0.f, 0.f, 0.f};
  float lsum = 0.f;
  const size_t vt_base = (size_t)(b * 8 + h) * 64 * TTOK;
  if (latent) {
    const int rs = min(max(qr - 4, 0), SEQ / 64 - 8);
    const int ct_first = (cgp <= 1) ? 0 : cgp - 1;
    const int nct = (cgp == 0 || cgp == 3) ? 2 : 3;
    const int npair = 4 * nct;
    const int qc = cgp * 16 + fr;
    for (int pi = 0; pi < npair; ++pi) {
      int i0 = 2 * pi, i1 = 2 * pi + 1;
      int kr0 = rs + i0 / nct, c0 = ct_first + i0 % nct;
      int kr1 = rs + i1 / nct, c1 = ct_first + i1 % nct;
      int t0 = kr0 * 64 + c0 * 16, t1 = kr1 * 64 + c1 * 16;
      na_pair(KN, VT, qf0, qf1, b * SEQ + t0, b * SEQ + t1, vt_base, t0, t1, h, lane, true, kr0, kr1, c0, c1, qr, qc,
              bias_lds + h * 465, O, lsum);
    }
  }
  for (int pi = 0; pi < 8; ++pi) {
    int t0 = pi * 32, t1 = pi * 32 + 16;
    na_pair(KN, VT, qf0, qf1, NLAT + b * CTXL + t0, NLAT + b * CTXL + t1, vt_base, SEQ + t0, SEQ + t1, h, lane, false,
            0, 0, 0, 0, 0, 0, bias_lds, O, lsum);
  }
  lsum += __shfl_xor(lsum, 16, 64);
  lsum += __shfl_xor(lsum, 32, 64);
  float inv = 1.f / lsum;
#pragma unroll
  for (int dt = 0; dt < 4; ++dt) {
    bf16x4 o;
#pragma unroll
    for (int r = 0; r < 4; ++r) o[r] = (short)f2bf(O[dt][r] * inv);
    *(bf16x4*)(CC + (size_t)(mq0 + fr) * 1024 + h * 64 + dt * 16 + fq * 4) = o;
  }
}

__device__ void phase_mix(const Params& p, int l, int bid, int nb, char* smem) {
  const int tid = tid_opaque();
  const int nscan_blocks = (nb > 64) ? 64 : nb;
  const int first_attn_block = (nb > 64) ? 64 : 0;
  if (bid < nscan_blocks) {
    for (int c = bid; c < 64; c += nscan_blocks) {
      int half = c & 1, d = (c >> 1) & 1, h = (c >> 2) & 3, b = (c >> 4) & 1, ty = (c >> 5) & 1;
      if (ty == 0) scan_chain<false>(p, b, h, d, half, smem);
      else scan_chain<true>(p, b, h, d, half, smem);
    }
  }
  if (bid >= first_attn_block) {
    float* bias = (float*)smem;
    __syncthreads();
    for (int i = tid; i < 8 * 465; i += NTHR) bias[i] = p.na_rpb[(size_t)l * 8 * 465 + i] * 1.4426950408889634f;
    __syncthreads();
    const int ntask = (l == 0) ? 2048 + 32 : 2048;
    const int nab = nb - first_attn_block;
    for (int t = bid - first_attn_block; t < ntask; t += nab) na_block_task(p, t, bias);
  }
}

__device__ void phase_post(const Params& p, int l, int bid, int nb) {
  const int tid = tid_opaque(), lane = tid & 63, wv = wave_id(tid);
  char* S = p.ws + OFF_S;
  const float* YRW = (const float*)(S + S_YRW);
  const float* YGD = (const float*)(S + S_YGD);
  const float* RWV = (const float*)(S + S_RWV);
  const float* RWG = (const float*)(S + S_RWG);
  const float* BON = (const float*)(S + S_BON);
  const float* P = (const float*)(p.ws + OFF_P);
  bfr* CC = (bfr*)(p.ws + OFF_CC);
  const float* ln_w = p.rw_ln_w + (size_t)l * 256;
  const float* ln_b = p.rw_ln_b + (size_t)l * 256;
  const float* ng = p.gd_norm_g + (size_t)l * 64;
  const int ntok = (l == 0) ? NTOK : NLAT;
  for (int wt = bid * 8 + wv; wt < ntok * 8; wt += nb * 8) {
    int m = wt >> 3, hs = wt & 7;
    if (hs < 4) {
      int c = hs * 64 + lane;
      size_t o = (size_t)m * 256 + c;
      float y = YRW[o] + YRW[(size_t)NTOK * 256 + o];
      float mean = wave_sum(y) * (1.f / 64.f);
      float dv = y - mean;
      float var = wave_sum(dv * dv) * (1.f / 64.f);
      float yn = dv * rsqrtf(var + 64e-5f) * ln_w[c] + ln_b[c];
      float out = (yn + BON[(size_t)m * 4 + hs] * RWV[o]) * RWG[o];
      CC[(size_t)m * 1024 + 512 + c] = f2bf(out);
    } else {
      int c = (hs - 4) * 64 + lane;
      size_t o = (size_t)m * 256 + c;
      float y = YGD[o] + YGD[(size_t)NTOK * 256 + o];
      float ms = wave_sum(y * y) * (1.f / 64.f);
      float z = P[(size_t)m * PINP + B_END + 768 + c];
      float out = y * rsqrtf(ms + 1e-6f) * ng[lane] * siluf_(z);
      CC[(size_t)m * 1024 + 768 + c] = f2bf(out);
    }
  }
}

__device__ void phase_router(const Params& p, int l, int bid, int nb) {
  const int tid = tid_opaque(), lane = tid & 63, wv = wave_id(tid);
  const float* xl = p.out;
  const float* xc = (const float*)(p.ws + OFF_CTX);
  const float* mods = (const float*)(p.ws + OFF_MODS) + (size_t)l * 3 * 6144;
  const float* g = p.norm_ffn_g + (size_t)l * 1024;
  const float* rw = p.moe_router_w + (size_t)l * 1024 * 32;
  const float* rb = p.moe_router_b + (size_t)l * 32;
  bfr* H = (bfr*)(p.ws + OFF_H);
  int* cnt = (int*)(p.ws + OFF_CNT);
  int* TOKE = (int*)(p.ws + OFF_TOKE);
  int* TOKP = (int*)(p.ws + OFF_TOKP);
  float* TOKG = (float*)(p.ws + OFF_TOKG);
  const int ntok = (l == 0) ? NTOK : NLAT;
  for (int m = bid * 8 + wv; m < ntok; m += nb * 8) {
    const float* xr = (m < NLAT) ? xl + (size_t)m * 1024 : xc + (size_t)(m - NLAT) * 1024;
    const float* md = mods + (size_t)mod_row(m) * 6144 + 3072;
    float4 v[4];
    float ss = 0.f;
#pragma unroll
    for (int i = 0; i < 4; ++i) {
      v[i] = *(const float4*)(xr + (lane + 64 * i) * 4);
      ss += v[i].x * v[i].x + v[i].y * v[i].y + v[i].z * v[i].z + v[i].w * v[i].w;
    }
    ss = wave_sum(ss);
    float rs = rsqrtf(ss * (1.f / 1024.f) + 1e-6f);
    float acc[32];
#pragma unroll
    for (int e = 0; e < 32; ++e) acc[e] = 0.f;
#pragma unroll
    for (int i = 0; i < 4; ++i) {
      int d = (lane + 64 * i) * 4;
      float4 gg = *(const float4*)(g + d);
      float4 sh = *(const float4*)(md + d);
      float4 sc = *(const float4*)(md + 1024 + d);
      float hv[4];
      hv[0] = v[i].x * rs * gg.x * (1.f + sc.x) + sh.x;
      hv[1] = v[i].y * rs * gg.y * (1.f + sc.y) + sh.y;
      hv[2] = v[i].z * rs * gg.z * (1.f + sc.z) + sh.z;
      hv[3] = v[i].w * rs * gg.w * (1.f + sc.w) + sh.w;
      bf16x4 o;
#pragma unroll
      for (int j = 0; j < 4; ++j) o[j] = (short)f2bf(hv[j]);
      *(bf16x4*)(H + (size_t)m * 1024 + d) = o;
#pragma unroll
      for (int j = 0; j < 4; ++j) {
        const float4* wr4 = (const float4*)(rw + (size_t)(d + j) * 32);
#pragma unroll
        for (int q = 0; q < 8; ++q) {
          float4 w = wr4[q];
          acc[q * 4 + 0] += hv[j] * w.x; acc[q * 4 + 1] += hv[j] * w.y;
          acc[q * 4 + 2] += hv[j] * w.z; acc[q * 4 + 3] += hv[j] * w.w;
        }
      }
    }
#pragma unroll
    for (int e = 0; e < 32; ++e) acc[e] = wave_sum(acc[e]) + rb[e];
    unsigned taken = 0u;
    float tv[4]; int ti[4];
#pragma unroll
    for (int k = 0; k < 4; ++k) {
      float best = -3.0e38f; int bi = 0;
#pragma unroll
      for (int e = 0; e < 32; ++e) {
        bool ok = !((taken >> e) & 1u) && (acc[e] > best);
        best = ok ? acc[e] : best; bi = ok ? e : bi;
      }
      taken |= 1u << bi; tv[k] = best; ti[k] = bi;
    }
    float e0 = 1.f, e1 = __expf(tv[1] - tv[0]), e2 = __expf(tv[2] - tv[0]), e3 = __expf(tv[3] - tv[0]);
    float inv = 1.f / (e0 + e1 + e2 + e3);
    if (lane < 4) {
      int e = lane == 0 ? ti[0] : lane == 1 ? ti[1] : lane == 2 ? ti[2] : ti[3];
      float gt = (lane == 0 ? e0 : lane == 1 ? e1 : lane == 2 ? e2 : e3) * inv;
      int pos = atomicAdd(&cnt[e], 1);
      TOKE[(size_t)m * 4 + lane] = e; TOKP[(size_t)m * 4 + lane] = pos; TOKG[(size_t)m * 4 + lane] = gt;
    }
  }
}

__device__ __forceinline__ void moe_offsets(const Params& p, int* toff) {
  const int* cnt = (const int*)(p.ws + OFF_CNT);
  if (tid_opaque() == 0) {
    int a = 0;
    for (int e = 0; e < 32; ++e) { toff[e] = a; a += (cnt[e] + 255) >> 8; }
    toff[32] = a;
  }
  __syncthreads();
}

__device__ void phase_slotfill(const Params& p, int l, int bid, int nb, char* smem) {
  int* toff = (int*)smem;
  moe_offsets(p, toff);
  const int* TOKE = (const int*)(p.ws + OFF_TOKE);
  const int* TOKP = (const int*)(p.ws + OFF_TOKP);
  const float* TOKG = (const float*)(p.ws + OFF_TOKG);
  int* TOKS = (int*)(p.ws + OFF_TOKS);
  int* SLT = (int*)(p.ws + OFF_SLT);
  float* SLG = (float*)(p.ws + OFF_SLG);
  const int n = ((l == 0) ? NTOK : NLAT) * 4;
  for (int i = bid * NTHR + tid_opaque(); i < n; i += nb * NTHR) {
    int e = TOKE[i];
    int slot = toff[e] * 256 + TOKP[i];
    TOKS[i] = slot; SLT[slot] = i >> 2; SLG[slot] = TOKG[i];
  }
  __syncthreads();
}

__device__ __forceinline__ int find_expert(const int* toff, int mt) {
  int e = 0;
#pragma unroll 1
  for (int i = 1; i < 32; ++i) e = (mt >= toff[i]) ? i : e;
  return e;
}

__device__ void phase_moe1_impl(const Params& p, int l, int bid, int nb, char* smem, int* toff) {
  moe_offsets(p, toff);
  const bfr* H = (const bfr*)(p.ws + OFF_H);
  const int* SLT = (const int*)(p.ws + OFF_SLT);
  const bfr* Wgu = (const bfr*)(p.ws + OFF_W + (size_t)l * WL_SIZE + WL_GU);
  const float* bgu = p.moe_b_gu + (size_t)l * 32 * 2048;
  bfr* ACT = (bfr*)(p.ws + OFF_P);
  const int tid = tid_opaque(), lane = tid & 63, wv = wave_id(tid), wr = wv >> 2, wc = wv & 3, fr = lane & 15, fq = lane >> 4;
  const int ntile = toff[32] * 16;
  for (int t = bid; t < ntile; t += nb) {
    int mt = t >> 4, nt = t & 15;
    int e = find_expert(toff, mt);
    GemmAcc acc;
    gemm_tile(acc, H, [&](int r) { return (unsigned)(SLT[mt * 256 + r] * 1024); },
              Wgu + ((size_t)e * 2048 + nt * 128) * 1024, smem);
    const float* be = bgu + (size_t)e * 2048;
    const int j = nt * 64 + wc * 16 + fr;
    const float bg = be[j], bl = be[1024 + j];
#pragma unroll
    for (int m = 0; m < 8; ++m)
#pragma unroll
      for (int r = 0; r < 4; ++r) {
        int slot = mt * 256 + wr * 128 + m * 16 + fq * 4 + r;
        float gv = fminf(acc.a[m][0][r] + bg, 7.f);
        float lv = fminf(fmaxf(acc.a[m][1][r] + bl, -7.f), 7.f);
        float a = gv * sigmoidf_(1.702f * gv) * (lv + 1.f);
        ACT[(size_t)slot * 1024 + j] = f2bf(a);
      }
  }
}

__device__ void phase_moe2_impl(const Params& p, int l, int bid, int nb, char* smem, int* toff) {
  moe_offsets(p, toff);
  const bfr* ACT = (const bfr*)(p.ws + OFF_P);
  const float* SLG = (const float*)(p.ws + OFF_SLG);
  const bfr* Wdn = (const bfr*)(p.ws + OFF_W + (size_t)l * WL_SIZE + WL_DN);
  const float* bdn = p.moe_b_down + (size_t)l * 32 * 1024;
  float* YS = (float*)(p.ws + OFF_S);
  const int tid = tid_opaque(), lane = tid & 63, wv = wave_id(tid), wr = wv >> 2, wc = wv & 3, fr = lane & 15, fq = lane >> 4;
  const int ntile = toff[32] * 8;
  for (int t = bid; t < ntile; t += nb) {
    int mt = t >> 3, nt = t & 7;
    int e = find_expert(toff, mt);
    GemmAcc acc;
    gemm_tile(acc, ACT, [&](int r) { return (unsigned)((mt * 256 + r) * 1024); },
              Wdn + ((size_t)e * 1024 + nt * 128) * 1024, smem);
    const float* be = bdn + (size_t)e * 1024;
#pragma unroll
    for (int m = 0; m < 8; ++m)
#pragma unroll
      for (int r = 0; r < 4; ++r) {
        int slot = mt * 256 + wr * 128 + m * 16 + fq * 4 + r;
        float gt = SLG[slot];
#pragma unroll
        for (int n = 0; n < 2; ++n) {
          int col = nt * 128 + wc * 32 + n * 16 + fr;
          YS[(size_t)slot * 1024 + col] = (acc.a[m][n][r] + be[col]) * gt;
        }
      }
  }
}

__device__ void phase_combine(const Params& p, int l, int bid, int nb) {
  const int tid = tid_opaque(), lane = tid & 63, wv = wave_id(tid);
  const float* YS = (const float*)(p.ws + OFF_S);
  const int* TOKS = (const int*)(p.ws + OFF_TOKS);
  const float* mods = (const float*)(p.ws + OFF_MODS) + (size_t)l * 3 * 6144;
  float* xl = p.out;
  float* xc = (float*)(p.ws + OFF_CTX);
  const int ntok = (l == 0) ? NTOK : NLAT;
  for (int m = bid * 8 + wv; m < ntok; m += nb * 8) {
    float* xr = (m < NLAT) ? xl + (size_t)m * 1024 : xc + (size_t)(m - NLAT) * 1024;
    const float* g2 = mods + (size_t)mod_row(m) * 6144 + 5120;
    int s0 = TOKS[(size_t)m * 4], s1 = TOKS[(size_t)m * 4 + 1], s2 = TOKS[(size_t)m * 4 + 2], s3 = TOKS[(size_t)m * 4 + 3];
#pragma unroll
    for (int i = 0; i < 4; ++i) {
      int d = (lane + 64 * i) * 4;
      float4 a = *(const float4*)(YS + (size_t)s0 * 1024 + d);
      float4 b = *(const float4*)(YS + (size_t)s1 * 1024 + d);
      float4 c = *(const float4*)(YS + (size_t)s2 * 1024 + d);
      float4 e = *(const float4*)(YS + (size_t)s3 * 1024 + d);
      float4 gg = *(const float4*)(g2 + d);
      float4 xv = *(const float4*)(xr + d);
      xv.x += gg.x * (a.x + b.x + c.x + e.x);
      xv.y += gg.y * (a.y + b.y + c.y + e.y);
      xv.z += gg.z * (a.z + b.z + c.z + e.z);
      xv.w += gg.w * (a.w + b.w + c.w + e.w);
      *(float4*)(xr + d) = xv;
    }
  }
}

extern __shared__ __attribute__((aligned(16))) char dyn_smem[];

__global__ void __launch_bounds__(NTHR) mega(Params p) {
  cg::grid_group grid = cg::this_grid();
  const int bid = blockIdx.x, nb = gridDim.x;
  int* toff_s = (int*)(dyn_smem + LDS_BYTES - 256);
  phase_ada(p, bid, nb, dyn_smem);
  phase_convert(p, 0, bid, nb, dyn_smem);
  phase_convert(p, 1, bid, nb, dyn_smem);
  grid.sync();
  for (int l = 0; l < 2; ++l) {
    phase_prenorm(p, l, bid, nb);
    grid.sync();
    phase_gemm_in(p, l, bid, nb, dyn_smem);
    grid.sync();
    phase_prep(p, l, bid, nb, dyn_smem);
    grid.sync();
    phase_mix(p, l, bid, nb, dyn_smem);
    grid.sync();
    phase_post(p, l, bid, nb);
    grid.sync();
    phase_gemm_out(p, l, bid, nb, dyn_smem);
    grid.sync();
    phase_router(p, l, bid, nb);
    grid.sync();
    phase_slotfill(p, l, bid, nb, dyn_smem);
    grid.sync();
    phase_moe1_impl(p, l, bid, nb, dyn_smem, toff_s);
    grid.sync();
    phase_moe2_impl(p, l, bid, nb, dyn_smem, toff_s);
    grid.sync();
    phase_combine(p, l, bid, nb);
    if (l == 0) grid.sync();
  }
}

extern "C" void kernel_launch(void* const* d_in, const int* in_sizes, int n_in, void* d_out, int out_size, void* d_ws,
                              size_t ws_size, hipStream_t stream) {
  Params p{};
  const float** pp = (const float**)&p;
  for (int i = 0; i < 34; ++i) pp[i] = (const float*)d_in[i];
  p.out = (float*)d_out;
  p.ws = (char*)d_ws;
  static int grid_blocks = 0;
  if (!grid_blocks) {
    (void)hipFuncSetAttribute((const void*)mega, hipFuncAttributeMaxDynamicSharedMemorySize, LDS_BYTES);
    int dev = 0, cus = 0, per_cu = 0;
    (void)hipGetDevice(&dev);
    (void)hipDeviceGetAttribute(&cus, hipDeviceAttributeMultiprocessorCount, dev);
    (void)hipOccupancyMaxActiveBlocksPerMultiprocessor(&per_cu, mega, NTHR, LDS_BYTES);
    if (per_cu < 1) per_cu = 1;
    if (per_cu > 1) per_cu = 1;
    grid_blocks = cus * per_cu;
  }
  void* args[] = {&p};
  (void)hipLaunchCooperativeKernel((void*)mega, dim3(grid_blocks), dim3(NTHR), args, LDS_BYTES, stream);
}
```

```cpp
#include <hip/hip_runtime.h>
#include <hip/hip_bf16.h>
#include <hip/hip_cooperative_groups.h>
#include <stdint.h>
namespace cg = cooperative_groups;

typedef __attribute__((ext_vector_type(8))) short bf16x8;
typedef __attribute__((ext_vector_type(4))) short bf16x4;
typedef __attribute__((ext_vector_type(4))) float f32x4;
typedef unsigned short bfr;

#define D_MODEL 1024
#define NB 2
#define SEQ 16384
#define CTXL 256
#define NLAT (NB * SEQ)
#define NCTX (NB * CTXL)
#define NTOK (NLAT + NCTX)
#define TTOK (SEQ + CTXL)
#define PIN 3472
#define PINP 3584
#define A_END 1536
#define B_END 2432
#define NEXP 32
#define NSLOT_MAX (NTOK * 4 + NEXP * 256)
#define NTHR 512
#define LDS_BYTES (131072 + 512)

constexpr size_t al256(size_t x) { return (x + 255) & ~(size_t)255; }
constexpr size_t WL_IN = 0;
constexpr size_t WL_OUT = WL_IN + (size_t)PINP * 1024 * 2;
constexpr size_t WL_GU = WL_OUT + (size_t)1024 * 1024 * 2;
constexpr size_t WL_DN = WL_GU + (size_t)32 * 2048 * 1024 * 2;
constexpr size_t WL_SIZE = WL_DN + (size_t)32 * 1024 * 1024 * 2;
constexpr size_t OFF_W = 0;
constexpr size_t OFF_MODS = al256(OFF_W + 2 * WL_SIZE);
constexpr size_t OFF_CTX = al256(OFF_MODS + 2 * 3 * 6144 * 4);
constexpr size_t OFF_CNT = al256(OFF_CTX + (size_t)NCTX * 1024 * 4);
constexpr size_t OFF_TOKE = al256(OFF_CNT + 256);
constexpr size_t OFF_TOKP = al256(OFF_TOKE + (size_t)NTOK * 4 * 4);
constexpr size_t OFF_TOKG = al256(OFF_TOKP + (size_t)NTOK * 4 * 4);
constexpr size_t OFF_TOKS = al256(OFF_TOKG + (size_t)NTOK * 4 * 4);
constexpr size_t OFF_SLT = al256(OFF_TOKS + (size_t)NTOK * 4 * 4);
constexpr size_t OFF_SLG = al256(OFF_SLT + (size_t)NSLOT_MAX * 4);
constexpr size_t OFF_H = al256(OFF_SLG + (size_t)NSLOT_MAX * 4);
constexpr size_t OFF_CC = al256(OFF_H + (size_t)NTOK * 1024 * 2);
constexpr size_t OFF_P = al256(OFF_CC + (size_t)NTOK * 1024 * 2);
constexpr size_t OFF_S = al256(OFF_P + (size_t)NTOK * PINP * 4);
constexpr size_t TOK256F = (size_t)NTOK * 256 * 4;
constexpr size_t S_QN = 0;
constexpr size_t S_KN = S_QN + (size_t)NTOK * 512 * 2;
constexpr size_t S_VT = S_KN + (size_t)NTOK * 512 * 2;
constexpr size_t S_RWR = S_VT + (size_t)NB * 8 * 64 * TTOK * 2;
constexpr size_t S_RWKK = S_RWR + TOK256F;
constexpr size_t S_RWV = S_RWKK + TOK256F;
constexpr size_t S_RWG = S_RWV + TOK256F;
constexpr size_t S_RWW = S_RWG + TOK256F;
constexpr size_t S_RWKD = S_RWW + 2 * TOK256F;
constexpr size_t S_RWB = S_RWKD + 2 * TOK256F;
constexpr size_t S_BON = S_RWB + 2 * TOK256F;
constexpr size_t S_GDQ = al256(S_BON + (size_t)NTOK * 4 * 4);
constexpr size_t S_GDK = S_GDQ + TOK256F;
constexpr size_t S_GDV = S_GDK + TOK256F;
constexpr size_t S_GDAB = S_GDV + TOK256F;
constexpr size_t S_YRW = al256(S_GDAB + (size_t)NTOK * 16 * 4);
constexpr size_t S_YGD = S_YRW + 2 * TOK256F;
constexpr size_t S_END = S_YGD + 2 * TOK256F;
constexpr size_t S_SIZE = (S_END > (size_t)NSLOT_MAX * 1024 * 4) ? S_END : (size_t)NSLOT_MAX * 1024 * 4;
constexpr size_t WS_TOTAL = OFF_S + S_SIZE;

struct Params {
  const float *x, *c, *ctx, *c_ctx, *ada_w, *ada_b, *norm_mix_g, *norm_ffn_g, *w_in, *w_out;
  const float *na_q_gain, *na_k_gain, *na_rpb;
  const float *rw_mu, *rw_w0, *rw_w_up, *rw_a0, *rw_a_up, *rw_g_up, *rw_k_k, *rw_k_a, *rw_r_k, *rw_ln_w, *rw_ln_b;
  const float *gd_conv_w, *gd_A_log, *gd_dt_bias, *gd_norm_g;
  const float *moe_router_w, *moe_router_b, *moe_w_gu, *moe_b_gu, *moe_w_down, *moe_b_down;
  float* out;
  char* ws;
};

__device__ __forceinline__ int tid_opaque() { int t = (int)__builtin_amdgcn_workitem_id_x(); asm volatile("" : "+v"(t)); return t; }
__device__ __forceinline__ int opq(int x) { asm volatile("" : "+s"(x)); return x; }
__device__ __forceinline__ int wave_id(int tid) { return __builtin_amdgcn_readfirstlane(tid >> 6); }
__device__ __forceinline__ bfr f2bf(float f) {
  unsigned u = __float_as_uint(f);
  u += 0x7fffu + ((u >> 16) & 1u);
  return (bfr)(u >> 16);
}
__device__ __forceinline__ float sigmoidf_(float x) { return 1.f / (1.f + __expf(-x)); }
__device__ __forceinline__ float siluf_(float x) { return x / (1.f + __expf(-x)); }
__device__ __forceinline__ float softplusf_(float x) { return x > 20.f ? x : log1pf(__expf(x)); }
__device__ __forceinline__ float wave_sum(float v) {
#pragma unroll
  for (int o = 32; o >= 1; o >>= 1) v += __shfl_xor(v, o, 64);
  return v;
}
__device__ __forceinline__ float row16_sum(float v) {
  v += __builtin_bit_cast(float, __builtin_amdgcn_update_dpp(0, __builtin_bit_cast(int, v), 0xB1, 0xF, 0xF, true));
  v += __builtin_bit_cast(float, __builtin_amdgcn_update_dpp(0, __builtin_bit_cast(int, v), 0x4E, 0xF, 0xF, true));
  v += __builtin_bit_cast(float, __builtin_amdgcn_update_dpp(0, __builtin_bit_cast(int, v), 0x141, 0xF, 0xF, true));
  v += __builtin_bit_cast(float, __builtin_amdgcn_update_dpp(0, __builtin_bit_cast(int, v), 0x140, 0xF, 0xF, true));
  return v;
}
__device__ __forceinline__ int mod_row(int m) { return m < NLAT ? (m >> 14) : 2; }

__device__ void phase_ada(const Params& p, int bid, int nb, char* smem) {
  float* red = (float*)smem;
  float* mods = (float*)(p.ws + OFF_MODS);
  const int tid = tid_opaque();
  for (int task = bid; task < 2 * 96; task += nb) {
    int l = task / 96, cgp = task % 96;
    int col = cgp * 64 + (tid & 63), ks = tid >> 6;
    const float* W = p.ada_w + (size_t)l * 1024 * 6144;
    float a0 = 0.f, a1 = 0.f, a2 = 0.f;
    for (int d = ks * 128; d < ks * 128 + 128; ++d) {
      float w = W[(size_t)d * 6144 + col];
      a0 += siluf_(p.c[d]) * w;
      a1 += siluf_(p.c[1024 + d]) * w;
      a2 += siluf_(p.c_ctx[d]) * w;
    }
    red[(ks * 3 + 0) * 64 + (tid & 63)] = a0;
    red[(ks * 3 + 1) * 64 + (tid & 63)] = a1;
    red[(ks * 3 + 2) * 64 + (tid & 63)] = a2;
    __syncthreads();
    if (tid < 192) {
      int r = tid >> 6, cc = tid & 63;
      float s = 0.f;
      for (int k = 0; k < 8; ++k) s += red[(k * 3 + r) * 64 + cc];
      mods[(size_t)(l * 3 + r) * 6144 + cgp * 64 + cc] = s + p.ada_b[(size_t)l * 6144 + cgp * 64 + cc];
    }
    __syncthreads();
  }
}

__device__ void convert_tile(const float* src, int N, bfr* dst, int kt, int nt, int mode, float* tile  ) {
  const int tid = tid_opaque();
#pragma unroll
  for (int q = 0; q < 2; ++q) {
    int idx = tid + q * 512;
    int kk = idx >> 4, n4 = idx & 15;
    int n = nt * 64 + n4 * 4;
    float4 v = make_float4(0.f, 0.f, 0.f, 0.f);
    if (n < N) v = *(const float4*)(src + (size_t)(kt * 64 + kk) * N + n);
    tile[kk * 65 + n4 * 4 + 0] = v.x;
    tile[kk * 65 + n4 * 4 + 1] = v.y;
    tile[kk * 65 + n4 * 4 + 2] = v.z;
    tile[kk * 65 + n4 * 4 + 3] = v.w;
  }
  __syncthreads();
  {
    int nn = tid >> 3, kc = tid & 7;
    int n = nt * 64 + nn;
    int row = n;
    if (mode == 1) { int j = n & 1023; row = (j >> 4) * 32 + (j & 15) + ((n >= 1024) ? 16 : 0); }
    bf16x8 o;
#pragma unroll
    for (int j = 0; j < 8; ++j) o[j] = (short)f2bf(tile[(kc * 8 + j) * 65 + nn]);
    *(bf16x8*)(dst + (size_t)row * 1024 + kt * 64 + kc * 8) = o;
  }
  __syncthreads();
}
__device__ void phase_convert(const Params& p, int l, int bid, int nb, char* smem) {
  float* tile = (float*)smem;
  char* wl = p.ws + OFF_W + (size_t)l * WL_SIZE;
  const int T_IN = 16 * 56, T_OUT = 16 * 16, T_GU = 32 * 16 * 32, T_DN = 32 * 16 * 16;
  const int total = T_IN + T_OUT + T_GU + T_DN;
  for (int t = bid; t < total; t += nb) {
    if (t < T_IN) {
      int kt = t / 56, nt = t % 56;
      convert_tile(p.w_in + (size_t)l * 1024 * PIN, PIN, (bfr*)(wl + WL_IN), kt, nt, 0, tile);
    } else if (t < T_IN + T_OUT) {
      int u = t - T_IN; int kt = u / 16, nt = u % 16;
      convert_tile(p.w_out + (size_t)l * 1024 * 1024, 1024, (bfr*)(wl + WL_OUT), kt, nt, 0, tile);
    } else if (t < T_IN + T_OUT + T_GU) {
      int u = t - T_IN - T_OUT; int e = u / 512; int v = u % 512; int kt = v / 32, nt = v % 32;
      convert_tile(p.moe_w_gu + ((size_t)l * 32 + e) * 1024 * 2048, 2048, (bfr*)(wl + WL_GU) + (size_t)e * 2048 * 1024, kt, nt, 1, tile);
    } else {
      int u = t - T_IN - T_OUT - T_GU; int e = u / 256; int v = u % 256; int kt = v / 16, nt = v % 16;
      convert_tile(p.moe_w_down + ((size_t)l * 32 + e) * 1024 * 1024, 1024, (bfr*)(wl + WL_DN) + (size_t)e * 1024 * 1024, kt, nt, 0, tile);
    }
  }
}

__device__ void phase_prenorm(const Params& p, int l, int bid, int nb) {
  const int tid = tid_opaque(), lane = tid & 63, wv = wave_id(tid);
  const float* xl = (l == 0) ? p.x : p.out;
  const float* xc = (l == 0) ? p.ctx : (const float*)(p.ws + OFF_CTX);
  const float* mods = (const float*)(p.ws + OFF_MODS) + (size_t)l * 3 * 6144;
  const float* g = p.norm_mix_g + (size_t)l * 1024;
  bfr* H = (bfr*)(p.ws + OFF_H);
  {
    int* cnt = (int*)(p.ws + OFF_CNT);
    int* slt = (int*)(p.ws + OFF_SLT);
    int gt = bid * NTHR + tid;
    if (gt < 32) cnt[gt] = 0;
    for (int i = gt; i < NSLOT_MAX; i += nb * NTHR) slt[i] = 0;
  }
  for (int m = bid * 8 + wv; m < NTOK; m += nb * 8) {
    const float* xr = (m < NLAT) ? xl + (size_t)m * 1024 : xc + (size_t)(m - NLAT) * 1024;
    const float* md = mods + (size_t)mod_row(m) * 6144;
    float4 v[4];
    float ss = 0.f;
#pragma unroll
    for (int i = 0; i < 4; ++i) {
      v[i] = *(const float4*)(xr + (lane + 64 * i) * 4);
      ss += v[i].x * v[i].x + v[i].y * v[i].y + v[i].z * v[i].z + v[i].w * v[i].w;
    }
    ss = wave_sum(ss);
    float rs = rsqrtf(ss * (1.f / 1024.f) + 1e-6f);
#pragma unroll
    for (int i = 0; i < 4; ++i) {
      int d = (lane + 64 * i) * 4;
      float4 gg = *(const float4*)(g + d);
      float4 sh = *(const float4*)(md + d);
      float4 sc = *(const float4*)(md + 1024 + d);
      bf16x4 o;
      o[0] = (short)f2bf(v[i].x * rs * gg.x * (1.f + sc.x) + sh.x);
      o[1] = (short)f2bf(v[i].y * rs * gg.y * (1.f + sc.y) + sh.y);
      o[2] = (short)f2bf(v[i].z * rs * gg.z * (1.f + sc.z) + sh.z);
      o[3] = (short)f2bf(v[i].w * rs * gg.w * (1.f + sc.w) + sh.w);
      *(bf16x4*)(H + (size_t)m * 1024 + d) = o;
    }
  }
}

#define LAS __attribute__((address_space(3)))
namespace g8 {
constexpr int BM = 256, BK = 64, HALF = 128, HTB = HALF * BK * 2, STAGE_BYTES = 8 * HTB, KD = 1024;
__device__ __forceinline__ int lds_byte(int r, int c) { const int st = (r >> 4) * 2 + (c >> 5), rr = r & 15, cc = c & 31, ob = rr * 64 + cc * 2; return st * 1024 + (ob ^ (((ob >> 9) & 1) << 5)); }
__device__ __forceinline__ void stage_rc(int b, int& R, int& C) { const int st = b / 1024, sb = b % 1024, swz = sb ^ (((sb >> 9) & 1) << 5); R = (st >> 1) * 16 + swz / 64; C = (st & 1) * 32 + (swz % 64) / 2; }
struct GUnit { int pm, pn, brow0, e; };
__device__ __forceinline__ int unit_index(int i, int c, int G, int total) {
  const int x = c & 7, j = c >> 3, q = total >> 3, r = total & 7;
  const int start = x < r ? x * (q + 1) : r * (q + 1) + (x - r) * q;
  const int size = q + (x < r ? 1 : 0);
  const int li = i * (G >> 3) + j;
  return li < size ? start + li : -1;
}

template <class Sched, class Epi>
__device__ __forceinline__ void gemm_stream(LAS unsigned char* lds, const bfr* Abase, const bfr* Btbase, const Sched& S, const Epi& E) {
  const int tid = tid_opaque(), wid = __builtin_amdgcn_readfirstlane(tid >> 6), lane = tid & 63, wr = wid >> 2, wc = wid & 3, fr = lane & 15, fq = lane >> 4;
  constexpr int nt = KD / BK;
  int R[2], C[2];
  unsigned voffB[2];
#pragma unroll
  for (int i = 0; i < 2; ++i) { stage_rc(tid * 16 + i * 8192, R[i], C[i]); voffB[i] = (unsigned)(R[i] * KD + C[i]) * 2u; }
#define voffA voffB
  constexpr size_t kstep = (size_t)(BK * 2);
  constexpr size_t hstep = (size_t)HALF * KD * 2;
  const unsigned ldsw = (unsigned)wid * 1024u;
  const int aoff = lds_byte(wr * 64 + fr, fq * 8), boff = lds_byte(wc * 32 + fr, fq * 8);
#define G8_SA(b, h) (((b) * 2 + (h)) * HTB)
#define G8_SB(b, h) ((4 + (b) * 2 + (h)) * HTB)
#define G8_STAGE(bufoff, gbase, v0, v1) do { \
    __builtin_amdgcn_global_load_lds((const unsigned*)((const char*)(gbase) + (v0)), (LAS unsigned*)(lds + (bufoff) + ldsw), 16, 0, 0); \
    __builtin_amdgcn_global_load_lds((const unsigned*)((const char*)(gbase) + (v1)), (LAS unsigned*)(lds + (bufoff) + ldsw + 8192), 16, 0, 0); } while (0)
#define G8_STAGEB(bufoff, gbase) G8_STAGE(bufoff, gbase, voffB[0], voffB[1])
#define G8_STAGEA(bufoff, gbase) G8_STAGE(bufoff, gbase, voffA[0], voffA[1])
#define G8_LDA(dst, b, h) do { _Pragma("unroll") for (int m = 0; m < 4; ++m) _Pragma("unroll") for (int k = 0; k < 2; ++k) dst[m][k] = *(const LAS bf16x8*)(lds + G8_SA(b, h) + aoff + m * 2048 + k * 1024); } while (0)
#define G8_LDB(dst, b, h) do { _Pragma("unroll") for (int n = 0; n < 2; ++n) _Pragma("unroll") for (int k = 0; k < 2; ++k) dst[n][k] = *(const LAS bf16x8*)(lds + G8_SB(b, h) + boff + n * 2048 + k * 1024); } while (0)
#define G8_MMA(ai, bj, At, Bt) do { __builtin_amdgcn_s_setprio(1); _Pragma("unroll") for (int m = 0; m < 4; ++m) _Pragma("unroll") for (int n = 0; n < 2; ++n) _Pragma("unroll") for (int k = 0; k < 2; ++k) \
    acc[ai][bj][m][n] = __builtin_amdgcn_mfma_f32_16x16x32_bf16(Bt[n][k], At[m][k], acc[ai][bj][m][n], 0, 0, 0); __builtin_amdgcn_s_setprio(0); } while (0)
#define G8_WAIT_V(n) asm volatile("s_waitcnt vmcnt(" #n ")" ::: "memory")
#define G8_WAIT_L(n) asm volatile("s_waitcnt lgkmcnt(" #n ")" ::: "memory")
#define G8_BAR __builtin_amdgcn_s_barrier()
#define G8_SCHED __builtin_amdgcn_sched_barrier(0)
  GUnit cur, nxt;
  int ui = 0;
  if (!S.next(0, cur)) return;
  f32x4 acc[2][2][4][2];
#pragma unroll
  for (int a = 0; a < 2; ++a)
#pragma unroll
    for (int b = 0; b < 2; ++b)
#pragma unroll
      for (int m = 0; m < 4; ++m)
#pragma unroll
        for (int n = 0; n < 2; ++n) acc[a][b][m][n] = (f32x4){0.f, 0.f, 0.f, 0.f};
  bf16x8 At[4][2], B0[2][2], B1[2][2];
  const char* cA = (const char*)Abase + (size_t)cur.pm * (BM * KD * 2);
  const char* cB = (const char*)Btbase + (size_t)cur.brow0 * (KD * 2);
  G8_STAGEB(G8_SB(0, 0), cB); G8_STAGEA(G8_SA(0, 0), cA); G8_STAGEB(G8_SB(0, 1), cB + hstep); G8_STAGEA(G8_SA(0, 1), cA + hstep);
  if (wr == 1) G8_BAR;
  G8_WAIT_V(4); G8_BAR;
  G8_STAGEB(G8_SB(1, 0), cB + kstep); G8_STAGEA(G8_SA(1, 0), cA + kstep); G8_STAGEB(G8_SB(1, 1), cB + hstep + kstep);
  G8_WAIT_V(6); G8_BAR;
  for (;;) {
    const bool has_next = S.next(ui + 1, nxt);
    const char* nA = has_next ? (const char*)Abase + (size_t)nxt.pm * (BM * KD * 2) : cA;
    const char* nB = has_next ? (const char*)Btbase + (size_t)nxt.brow0 * (KD * 2) : cB;
    for (int t = 0; t < nt; t += 2) {
      const bool last = (t == nt - 2);
      const char* a1 = cA + (size_t)(t + 1) * kstep;
      const char* a2 = last ? nA : cA + (size_t)(t + 2) * kstep;
      const char* b2 = last ? nB : cB + (size_t)(t + 2) * kstep;
      const char* a3 = a2 + kstep;
      const char* b3 = b2 + kstep;
      G8_LDB(B0, 0, 0); G8_SCHED; G8_LDA(At, 0, 0); G8_STAGEA(G8_SA(1, 1), a1 + hstep);
      G8_WAIT_L(8); G8_BAR; G8_WAIT_L(0); G8_MMA(0, 0, At, B0); G8_BAR; G8_SCHED;
      G8_LDB(B1, 0, 1); G8_STAGEB(G8_SB(0, 0), b2);
      G8_BAR; G8_WAIT_L(0); G8_MMA(0, 1, At, B1); G8_BAR;
      G8_LDA(At, 0, 1); G8_STAGEA(G8_SA(0, 0), a2);
      G8_BAR; G8_WAIT_L(0); G8_MMA(1, 0, At, B0); G8_BAR; G8_SCHED;
      G8_STAGEB(G8_SB(0, 1), b2 + hstep);
      G8_WAIT_V(6); G8_BAR; G8_MMA(1, 1, At, B1); G8_BAR;
      G8_LDB(B0, 1, 0); G8_SCHED; G8_LDA(At, 1, 0); G8_STAGEA(G8_SA(0, 1), a2 + hstep);
      G8_WAIT_L(8); G8_BAR; G8_WAIT_L(0); G8_MMA(0, 0, At, B0); G8_BAR; G8_SCHED;
      G8_LDB(B1, 1, 1); G8_STAGEB(G8_SB(1, 0), b3);
      G8_BAR; G8_WAIT_L(0); G8_MMA(0, 1, At, B1); G8_BAR;
      G8_LDA(At, 1, 1); G8_STAGEA(G8_SA(1, 0), a3);
      G8_BAR; G8_WAIT_L(0); G8_MMA(1, 0, At, B0); G8_BAR; G8_SCHED;
      G8_STAGEB(G8_SB(1, 1), b3 + hstep);
      G8_WAIT_V(6); G8_BAR; G8_MMA(1, 1, At, B1); G8_BAR;
    }
    E(acc, cur, wr, wc, fr, fq);
    if (!has_next) break;
#pragma unroll
    for (int a = 0; a < 2; ++a)
#pragma unroll
      for (int b = 0; b < 2; ++b)
#pragma unroll
        for (int m = 0; m < 4; ++m)
#pragma unroll
          for (int n = 0; n < 2; ++n) acc[a][b][m][n] = (f32x4){0.f, 0.f, 0.f, 0.f};
    cur = nxt; cA = nA; cB = nB; ++ui;
  }
  G8_WAIT_V(0);
  if (wr == 0) G8_BAR;
  G8_BAR;
#undef G8_SA
#undef G8_SB
#undef G8_STAGE
#undef G8_STAGEB
#undef G8_STAGEA
#undef voffA
#undef G8_LDA
#undef G8_LDB
#undef G8_MMA
#undef G8_WAIT_V
#undef G8_WAIT_L
#undef G8_BAR
#undef G8_SCHED
}

struct DenseSched {
  int nM, nN, G, c;
  __device__ __forceinline__ bool next(int i, GUnit& u) const {
    const int idx = unit_index(i, c, G, nM * nN);
    if (idx < 0) return false;
    u.pm = idx / nN; u.pn = idx - u.pm * nN; u.brow0 = u.pn * BM; u.e = 0;
    return true;
  }
};
struct MoeSched {
  const int* toff; int nN, NE, G, c;
  __device__ __forceinline__ bool next(int i, GUnit& u) const {
    const int idx = unit_index(i, c, G, toff[32] * nN);
    if (idx < 0) return false;
    u.pm = idx / nN; u.pn = idx - u.pm * nN;
    int e = 0;
#pragma unroll 1
    for (int k = 1; k < 32; ++k) e = (u.pm >= toff[k]) ? k : e;
    u.e = e; u.brow0 = e * NE + u.pn * BM;
    return true;
  }
};
}

struct EpiInProj {
  float* P;
  __device__ __forceinline__ void operator()(const f32x4 (&acc)[2][2][4][2], const g8::GUnit& u, int wr, int wc, int fr, int fq) const {
    const int row0 = u.pm * 256 + wr * 64 + fr, col0 = u.pn * 256 + wc * 32 + 4 * fq;
#pragma unroll
    for (int ai = 0; ai < 2; ++ai)
#pragma unroll
      for (int m = 0; m < 4; ++m) {
        float* rowp = P + (size_t)(row0 + ai * 128 + m * 16) * PINP + col0;
#pragma unroll
        for (int bj = 0; bj < 2; ++bj)
#pragma unroll
          for (int n = 0; n < 2; ++n) *(f32x4*)(rowp + bj * 128 + n * 16) = acc[ai][bj][m][n];
      }
  }
};
__device__ void phase_gemm_in(const Params& p, int l, int bid, int nb, char* smem) {
  g8::DenseSched S{130, 14, nb, bid};
  EpiInProj E{(float*)(p.ws + OFF_P)};
  g8::gemm_stream((LAS unsigned char*)smem, (const bfr*)(p.ws + OFF_H), (const bfr*)(p.ws + OFF_W + (size_t)l * WL_SIZE + WL_IN), S, E);
}

struct EpiOutProj {
  const float *xl, *xc, *mods; float *ol, *oc;
  __device__ __forceinline__ void operator()(const f32x4 (&acc)[2][2][4][2], const g8::GUnit& u, int wr, int wc, int fr, int fq) const {
    const bool lat = u.pm < 128;
    const float* xin = lat ? xl + (size_t)u.pm * 256 * 1024 : xc + (size_t)(u.pm - 128) * 256 * 1024;
    float* xo = lat ? ol + (size_t)u.pm * 256 * 1024 : oc + (size_t)(u.pm - 128) * 256 * 1024;
    const float* g1 = mods + (size_t)(lat ? (u.pm >> 6) : 2) * 6144 + 2048;
    const int row0 = wr * 64 + fr, col0 = u.pn * 256 + wc * 32 + 4 * fq;
#pragma unroll
    for (int bj = 0; bj < 2; ++bj)
#pragma unroll
      for (int n = 0; n < 2; ++n) {
        const f32x4 gv = *(const f32x4*)(g1 + col0 + bj * 128 + n * 16);
#pragma unroll
        for (int ai = 0; ai < 2; ++ai)
#pragma unroll
          for (int m = 0; m < 4; ++m) {
            const size_t o = (size_t)(row0 + ai * 128 + m * 16) * 1024 + col0 + bj * 128 + n * 16;
            const f32x4 xv = *(const f32x4*)(xin + o);
            *(f32x4*)(xo + o) = xv + gv * acc[ai][bj][m][n];
            if (m & 1) asm volatile("" ::: "memory");
          }
      }
  }
};
__device__ void phase_gemm_out(const Params& p, int l, int bid, int nb, char* smem) {
  g8::DenseSched S{(l == 0) ? 130 : 128, 4, nb, bid};
  EpiOutProj E{(l == 0) ? p.x : p.out, (l == 0) ? p.ctx : (const float*)(p.ws + OFF_CTX),
               (const float*)(p.ws + OFF_MODS) + (size_t)l * 3 * 6144, p.out, (float*)(p.ws + OFF_CTX)};
  g8::gemm_stream((LAS unsigned char*)smem, (const bfr*)(p.ws + OFF_CC), (const bfr*)(p.ws + OFF_W + (size_t)l * WL_SIZE + WL_OUT), S, E);
}

__device__ void phase_prep(const Params& p, int l, int bid, int nb, char* smem) {
  const int tid = tid_opaque(), lane = tid & 63, wv = wave_id(tid);
  const float* P = (const float*)(p.ws + OFF_P);
  char* S = p.ws + OFF_S;
  bfr* QN = (bfr*)(S + S_QN);
  bfr* KN = (bfr*)(S + S_KN);
  bfr* VT = (bfr*)(S + S_VT);
  float* RWR = (float*)(S + S_RWR);
  float* RWKK = (float*)(S + S_RWKK);
  float* RWV = (float*)(S + S_RWV);
  float* RWG = (float*)(S + S_RWG);
  float* RWW = (float*)(S + S_RWW);
  float* RWKD = (float*)(S + S_RWKD);
  float* RWB = (float*)(S + S_RWB);
  float* BON = (float*)(S + S_BON);
  float* GDQ = (float*)(S + S_GDQ);
  float* GDK = (float*)(S + S_GDK);
  float* GDV = (float*)(S + S_GDV);
  float* GDAB = (float*)(S + S_GDAB);
  const float* mu = p.rw_mu + (size_t)l * 896;
  const float* w0 = p.rw_w0 + (size_t)l * 512;
  const float* w_up = p.rw_w_up + (size_t)l * 2 * 32 * 256;
  const float* a0 = p.rw_a0 + (size_t)l * 512;
  const float* a_up = p.rw_a_up + (size_t)l * 2 * 32 * 256;
  const float* g_up = p.rw_g_up + (size_t)l * 64 * 256;
  const float* k_k = p.rw_k_k + (size_t)l * 256;
  const float* k_a = p.rw_k_a + (size_t)l * 256;
  const float* r_k = p.rw_r_k + (size_t)l * 256;
  const float* conv_w = p.gd_conv_w + (size_t)l * 5 * 768;
  const float* A_log = p.gd_A_log + (size_t)l * 8;
  const float* dt_bias = p.gd_dt_bias + (size_t)l * 8;
  const float* qg = p.na_q_gain + (size_t)l * 64;
  const float* kg = p.na_k_gain + (size_t)l * 64;

  float* rw = (float*)smem;
  float* lor = rw + 16 * 768;
  float* gd = rw;

  for (int tile = bid; tile < NTOK / 16; tile += nb) {
    const int m0 = tile * 16;
    int seq_lo, seq_hi;
    int bb, tau0;
    if (m0 < NLAT) { bb = m0 >> 14; seq_lo = bb << 14; seq_hi = seq_lo + SEQ; tau0 = m0 - seq_lo; }
    else { bb = (m0 - NLAT) >> 8; seq_lo = NLAT + (bb << 8); seq_hi = seq_lo + CTXL; tau0 = SEQ + (m0 - seq_lo); }

    for (int i = tid; i < 16 * 896; i += NTHR) {
      int t = i / 896, c = i % 896;
      int m = m0 + t;
      const float* pr = P + (size_t)m * PINP + A_END + c;
      float cur = *pr;
      float prev = (m - 1 >= seq_lo) ? *(pr - PINP) : 0.f;
      float nxt = (m + 1 < seq_hi) ? *(pr + PINP) : 0.f;
      float v = cur + mu[c] * (0.5f * (prev + nxt) - cur);
      if (c < 768) rw[t * 768 + c] = v;
      else if (c < 800) lor[(c - 768) * 16 + t] = tanhf(v);
      else if (c < 832) lor[(32 + c - 800) * 16 + t] = v;
      else lor[(64 + c - 832) * 16 + t] = sigmoidf_(v);
    }
    __syncthreads();
    {
      const int c = tid & 255, th = tid >> 8;
      const float kkc = k_k[c], kac = k_a[c], rkc = r_k[c];
      const float w00 = w0[c], w01 = w0[256 + c], a00 = a0[c], a01 = a0[256 + c];
      const int h = c >> 6;
#pragma unroll 1
      for (int ps = 0; ps < 2; ++ps) {
        const int tb = th * 8 + ps * 4;
        float4 gacc = make_float4(0.f, 0.f, 0.f, 0.f), wa0 = gacc, wa1 = gacc, aa0 = gacc, aa1 = gacc;
#pragma unroll 4
        for (int j = 0; j < 64; ++j) {
          float wgt = g_up[j * 256 + c];
          float4 s0 = *(const float4*)(lor + (64 + j) * 16 + tb);
          gacc.x += s0.x * wgt; gacc.y += s0.y * wgt; gacc.z += s0.z * wgt; gacc.w += s0.w * wgt;
        }
#pragma unroll 4
        for (int j = 0; j < 32; ++j) {
          float4 t0 = *(const float4*)(lor + j * 16 + tb);
          float4 d0 = *(const float4*)(lor + (32 + j) * 16 + tb);
          float ww0 = w_up[j * 256 + c], ww1 = w_up[(32 + j) * 256 + c];
          float aw0 = a_up[j * 256 + c], aw1 = a_up[(32 + j) * 256 + c];
          wa0.x += t0.x * ww0; wa0.y += t0.y * ww0; wa0.z += t0.z * ww0; wa0.w += t0.w * ww0;
          wa1.x += t0.x * ww1; wa1.y += t0.y * ww1; wa1.z += t0.z * ww1; wa1.w += t0.w * ww1;
          aa0.x += d0.x * aw0; aa0.y += d0.y * aw0; aa0.z += d0.z * aw0; aa0.w += d0.w * aw0;
          aa1.x += d0.x * aw1; aa1.y += d0.y * aw1; aa1.z += d0.z * aw1; aa1.w += d0.w * aw1;
        }
#pragma unroll
        for (int t = 0; t < 4; ++t) {
          const int tt = tb + t;
          const int m = m0 + tt;
          const float gv = t == 0 ? gacc.x : t == 1 ? gacc.y : t == 2 ? gacc.z : gacc.w;
          const float wv0 = t == 0 ? wa0.x : t == 1 ? wa0.y : t == 2 ? wa0.z : wa0.w;
          const float wv1 = t == 0 ? wa1.x : t == 1 ? wa1.y : t == 2 ? wa1.z : wa1.w;
          const float av0 = t == 0 ? aa0.x : t == 1 ? aa0.y : t == 2 ? aa0.z : aa0.w;
          const float av1 = t == 0 ? aa1.x : t == 1 ? aa1.y : t == 2 ? aa1.z : aa1.w;
          float r = rw[tt * 768 + c], k = rw[tt * 768 + 256 + c], v = rw[tt * 768 + 512 + c];
          float kkraw = k * kkc;
          float ssum = wave_sum(kkraw * kkraw);
          float kk = kkraw * rsqrtf(ssum + 1e-6f);
          float bon = 0.f;
#pragma unroll
          for (int d = 0; d < 2; ++d) {
            float wl = (d == 0 ? w00 + wv0 : w01 + wv1);
            float w_log = -softplusf_(-wl) - 0.5f;
            float decay = __expf(-__expf(w_log));
            float a = sigmoidf_(d == 0 ? a00 + av0 : a01 + av1);
            float kd = k * (1.f + (a - 1.f) * kac);
            bon += r * kd * rkc;
            size_t o = ((size_t)d * NTOK + m) * 256 + c;
            RWW[o] = decay; RWKD[o] = kd; RWB[o] = kk * a;
          }
          bon = wave_sum(bon);
          size_t o = (size_t)m * 256 + c;
          RWR[o] = r; RWKK[o] = kk; RWV[o] = v; RWG[o] = gv;
          if (lane == 0) BON[(size_t)m * 4 + h] = bon;
        }
      }
    }
    __syncthreads();
    for (int i = tid; i < 16 * 768; i += NTHR) {
      int t = i / 768, c = i % 768;
      int m = m0 + t;
      float acc = 0.f;
#pragma unroll
      for (int j = 0; j < 5; ++j) {
        int mm = m + j - 2;
        if (mm >= seq_lo && mm < seq_hi) acc += conv_w[j * 768 + c] * P[(size_t)mm * PINP + B_END + c];
      }
      gd[t * 768 + c] = siluf_(acc);
    }
    __syncthreads();
    for (int wt = wv; wt < 16 * 12; wt += 8) {
      int t = wt / 12, hs = wt % 12;
      int m = m0 + t;
      float val = gd[t * 768 + hs * 64 + lane];
      if (hs < 8) {
        float ss = wave_sum(val * val);
        val *= rsqrtf(ss + 1e-6f);
        if (hs < 4) GDQ[(size_t)m * 256 + hs * 64 + lane] = val * 0.125f;
        else GDK[(size_t)m * 256 + (hs - 4) * 64 + lane] = val;
      } else GDV[(size_t)m * 256 + (hs - 8) * 64 + lane] = val;
    }
    if (tid < 256) {
      int t = tid >> 4, j = tid & 15;
      int m = m0 + t;
      float pv = P[(size_t)m * PINP + B_END + 1024 + j];
      float o;
      if (j < 8) o = __expf(-__expf(A_log[j]) * softplusf_(pv + dt_bias[j]));
      else o = sigmoidf_(pv);
      GDAB[(size_t)m * 16 + j] = o;
    }
    for (int wt = wv; wt < 16 * 16; wt += 8) {
      int t = wt >> 4, hs = wt & 15;
      int m = m0 + t;
      float val = P[(size_t)m * PINP + hs * 64 + lane];
      float ss = wave_sum(val * val);
      val *= rsqrtf(ss * (1.f / 64.f) + 1e-6f);
      if (hs < 8) QN[(size_t)m * 512 + hs * 64 + lane] = f2bf(val * qg[lane] * (0.125f * 1.4426950408889634f));
      else KN[(size_t)m * 512 + (hs - 8) * 64 + lane] = f2bf(val * kg[lane]);
    }
    {
      int hd = tid;
      bf16x8 o0, o1;
#pragma unroll
      for (int t = 0; t < 8; ++t) {
        o0[t] = (short)f2bf(P[(size_t)(m0 + t) * PINP + 1024 + hd]);
        o1[t] = (short)f2bf(P[(size_t)(m0 + 8 + t) * PINP + 1024 + hd]);
      }
      bfr* dst = VT + ((size_t)(bb * 512 + hd)) * TTOK + tau0;
      *(bf16x8*)dst = o0;
      *(bf16x8*)(dst + 8) = o1;
    }
    __syncthreads();
  }
}

#define SC_TB 32
__device__ __forceinline__ int scan_tok(int b, int d, int s) {
  if (s < CTXL) { int t = d ? (CTXL - 1 - s) : s; return NLAT + b * CTXL + t; }
  int u = s - CTXL; int t = d ? (SEQ - 1 - u) : u; return b * SEQ + t;
}
template <bool GDN>
__device__ void scan_chain(const Params& p, int b, int h, int d, int half, char* smem) {
  const int tid = tid_opaque(), lane = tid & 63, wv = wave_id(tid);
  char* S = p.ws + OFF_S;
  const float *src0, *src1, *src2, *src3, *src4, *xsrc;
  const float* ab = (const float*)(S + S_GDAB);
  float* Y;
  if (!GDN) {
    src0 = (const float*)(S + S_RWKK);
    src1 = (const float*)(S + S_RWW) + (size_t)d * NTOK * 256;
    src2 = (const float*)(S + S_RWB) + (size_t)d * NTOK * 256;
    src3 = (const float*)(S + S_RWKD) + (size_t)d * NTOK * 256;
    src4 = (const float*)(S + S_RWR);
    xsrc = (const float*)(S + S_RWV);
    Y = (float*)(S + S_YRW) + (size_t)d * NTOK * 256;
  } else {
    src0 = (const float*)(S + S_GDK);
    src1 = src0; src2 = src0; src3 = src0;
    src4 = (const float*)(S + S_GDQ);
    xsrc = (const float*)(S + S_GDV);
    Y = (float*)(S + S_YGD) + (size_t)d * NTOK * 256;
  }
  float* vec = (float*)smem;
  float* xs = vec + 5 * SC_TB * 64;
  float* sc = xs + SC_TB * 32;
  float* yb = sc + SC_TB * 2;
  const int rl = wv * 4 + (lane >> 4);
  const int j4 = (lane & 15) * 4;
  float s0 = 0.f, s1 = 0.f, s2 = 0.f, s3 = 0.f;
  float4 rg0, rg1, rg2, rg3, rg4, rx;
  rg0 = rg1 = rg2 = rg3 = rg4 = rx = make_float4(0.f, 0.f, 0.f, 0.f);
  float rsc = 0.f;
  const int st_step = tid >> 4, st_part = tid & 15;
#define SCAN_ISSUE(batch)                                                                          \
  {                                                                                                \
    int m_ = scan_tok(b, d, (batch) * SC_TB + st_step);                                            \
    size_t o_ = (size_t)m_ * 256 + h * 64 + st_part * 4;                                           \
    rg0 = *(const float4*)(src0 + o_);                                                             \
    rg4 = *(const float4*)(src4 + o_);                                                             \
    if (!GDN) { rg1 = *(const float4*)(src1 + o_); rg2 = *(const float4*)(src2 + o_); rg3 = *(const float4*)(src3 + o_); } \
    if (tid < 256) {                                                                               \
      int m2_ = scan_tok(b, d, (batch) * SC_TB + (tid >> 3));                                      \
      rx = *(const float4*)(xsrc + (size_t)m2_ * 256 + h * 64 + half * 32 + (tid & 7) * 4);        \
    }                                                                                              \
    if (GDN && tid < 64) {                                                                         \
      int m3_ = scan_tok(b, d, (batch) * SC_TB + (tid >> 1));                                      \
      rsc = ab[(size_t)m3_ * 16 + (tid & 1) * 8 + d * 4 + h];                                      \
    }                                                                                              \
  }
  const int nbatch = TTOK / SC_TB;
  SCAN_ISSUE(0)
  for (int bt = 0; bt < nbatch; ++bt) {
    __syncthreads();
    *(float4*)(vec + (0 * SC_TB + st_step) * 64 + st_part * 4) = rg0;
    *(float4*)(vec + (4 * SC_TB + st_step) * 64 + st_part * 4) = rg4;
    if (!GDN) {
      *(float4*)(vec + (1 * SC_TB + st_step) * 64 + st_part * 4) = rg1;
      *(float4*)(vec + (2 * SC_TB + st_step) * 64 + st_part * 4) = rg2;
      *(float4*)(vec + (3 * SC_TB + st_step) * 64 + st_part * 4) = rg3;
    }
    if (tid < 256) *(float4*)(xs + (tid >> 3) * 32 + (tid & 7) * 4) = rx;
    if (GDN && tid < 64) sc[tid] = rsc;
    __syncthreads();
    if (bt + 1 < nbatch) SCAN_ISSUE(bt + 1)
#pragma unroll 4
    for (int st = 0; st < SC_TB; ++st) {
      float4 kap = *(const float4*)(vec + (0 * SC_TB + st) * 64 + j4);
      float4 r4 = *(const float4*)(vec + (4 * SC_TB + st) * 64 + j4);
      float x = xs[st * 32 + rl];
      float dp = s0 * kap.x + s1 * kap.y + s2 * kap.z + s3 * kap.w;
      float dd = row16_sum(dp);
      if (!GDN) {
        float4 w4 = *(const float4*)(vec + (1 * SC_TB + st) * 64 + j4);
        float4 b4 = *(const float4*)(vec + (2 * SC_TB + st) * 64 + j4);
        float4 k4 = *(const float4*)(vec + (3 * SC_TB + st) * 64 + j4);
        s0 = s0 * w4.x + x * k4.x - dd * b4.x;
        s1 = s1 * w4.y + x * k4.y - dd * b4.y;
        s2 = s2 * w4.z + x * k4.z - dd * b4.z;
        s3 = s3 * w4.w + x * k4.w - dd * b4.w;
      } else {
        float al = sc[st * 2], be = sc[st * 2 + 1];
        float cf = be * (x - al * dd);
        s0 = al * s0 + cf * kap.x;
        s1 = al * s1 + cf * kap.y;
        s2 = al * s2 + cf * kap.z;
        s3 = al * s3 + cf * kap.w;
      }
      float yp = s0 * r4.x + s1 * r4.y + s2 * r4.z + s3 * r4.w;
      float yy = row16_sum(yp);
      if ((lane & 15) == 0) yb[st * 32 + rl] = yy;
    }
    __syncthreads();
    for (int i = tid; i < SC_TB * 32; i += NTHR) {
      int st = i >> 5, r = i & 31;
      int m = scan_tok(b, d, bt * SC_TB + st);
      Y[(size_t)m * 256 + h * 64 + half * 32 + r] = yb[i];
    }
  }
  __syncthreads();
#undef SCAN_ISSUE
}

__device__ __forceinline__ void na_pair(const bfr* KN, const bfr* VT, const bf16x8 qf0, const bf16x8 qf1,
                                        int mk0, int mk1, size_t vt_base, int tau0, int tau1, int h, int lane,
                                        bool local, int kr0, int kr1, int ct0, int ct1, int qr, int qc, const float* bias_h,
                                        f32x4 (&O)[4], float& lsum) {
  const int fr = lane & 15, fq = lane >> 4;
  const bf16x8 k00 = *(const bf16x8*)(KN + (size_t)(mk0 + fr) * 512 + h * 64 + fq * 8);
  const bf16x8 k01 = *(const bf16x8*)(KN + (size_t)(mk0 + fr) * 512 + h * 64 + 32 + fq * 8);
  const bf16x8 k10 = *(const bf16x8*)(KN + (size_t)(mk1 + fr) * 512 + h * 64 + fq * 8);
  const bf16x8 k11 = *(const bf16x8*)(KN + (size_t)(mk1 + fr) * 512 + h * 64 + 32 + fq * 8);
  f32x4 z = {0.f, 0.f, 0.f, 0.f};
  f32x4 st0 = __builtin_amdgcn_mfma_f32_16x16x32_bf16(k00, qf0, z, 0, 0, 0);
  st0 = __builtin_amdgcn_mfma_f32_16x16x32_bf16(k01, qf1, st0, 0, 0, 0);
  f32x4 st1 = __builtin_amdgcn_mfma_f32_16x16x32_bf16(k10, qf0, z, 0, 0, 0);
  st1 = __builtin_amdgcn_mfma_f32_16x16x32_bf16(k11, qf1, st1, 0, 0, 0);
  bf16x8 pf;
  if (local) {
    int cs = min(max(qc - 8, 0), 48);
#pragma unroll
    for (int r = 0; r < 4; ++r) {
      int kc0 = ct0 * 16 + fq * 4 + r;
      int kc1 = ct1 * 16 + fq * 4 + r;
      float p0 = 0.f, p1 = 0.f;
      if ((unsigned)(kc0 - cs) < 16u) p0 = exp2f(st0[r] + bias_h[(kr0 - qr + 7) * 31 + (kc0 - qc + 15)]);
      if ((unsigned)(kc1 - cs) < 16u) p1 = exp2f(st1[r] + bias_h[(kr1 - qr + 7) * 31 + (kc1 - qc + 15)]);
      lsum += p0 + p1;
      pf[r] = (short)f2bf(p0);
      pf[4 + r] = (short)f2bf(p1);
    }
  } else {
#pragma unroll
    for (int r = 0; r < 4; ++r) {
      float p0 = exp2f(st0[r]), p1 = exp2f(st1[r]);
      lsum += p0 + p1;
      pf[r] = (short)f2bf(p0);
      pf[4 + r] = (short)f2bf(p1);
    }
  }
#pragma unroll
  for (int dt = 0; dt < 4; ++dt) {
    const bfr* vrow = VT + vt_base + (size_t)(dt * 16 + fr) * TTOK;
    bf16x4 v0 = *(const bf16x4*)(vrow + tau0 + fq * 4);
    bf16x4 v1 = *(const bf16x4*)(vrow + tau1 + fq * 4);
    bf16x8 vf;
    vf[0] = v0[0]; vf[1] = v0[1]; vf[2] = v0[2]; vf[3] = v0[3];
    vf[4] = v1[0]; vf[5] = v1[1]; vf[6] = v1[2]; vf[7] = v1[3];
    O[dt] = __builtin_amdgcn_mfma_f32_16x16x32_bf16(vf, pf, O[dt], 0, 0, 0);
  }
}

__device__ void na_block_task(const Params& p, int task, const float* bias_lds) {
  const int tid = tid_opaque(), lane = tid & 63, wv = wave_id(tid);
  const int fr = lane & 15, fq = lane >> 4;
  char* S = p.ws + OFF_S;
  const bfr* QN = (const bfr*)(S + S_QN);
  const bfr* KN = (const bfr*)(S + S_KN);
  const bfr* VT = (const bfr*)(S + S_VT);
  bfr* CC = (bfr*)(p.ws + OFF_CC);
  int b, h, mq0;
  bool latent = task < 2048;
  int qr = 0, cgp = 0;
  if (latent) {
    h = task & 7; int rp = (task >> 3) & 127; b = task >> 10;
    qr = rp * 2 + (wv >> 2); cgp = wv & 3;
    mq0 = b * SEQ + qr * 64 + cgp * 16;
  } else {
    int u = task - 2048;
    int half = u & 1; h = (u >> 1) & 7; b = u >> 4;
    mq0 = NLAT + b * CTXL + (half * 8 + wv) * 16;
  }
  const bf16x8 qf0 = *(const bf16x8*)(QN + (size_t)(mq0 + fr) * 512 + h * 64 + fq * 8);
  const bf16x8 qf1 = *(const bf16x8*)(QN + (size_t)(mq0 + fr) * 512 + h * 64 + 32 + fq * 8);
  f32x4 O[4];
#pragma unroll
  for (int dt = 0; dt < 4; ++dt) O[dt] = (f32x4){0.f, 0.f, 0.f, 0.f};
  float lsum = 0.f;
  const size_t vt_base = (size_t)(b * 8 + h) * 64 * TTOK;
  if (latent) {
    const int rs = min(max(qr - 4, 0), SEQ / 64 - 8);
    const int ct_first = (cgp <= 1) ? 0 : cgp - 1;
    const int nct = (cgp == 0 || cgp == 3) ? 2 : 3;
    const int npair = 4 * nct;
    const int qc = cgp * 16 + fr;
    for (int pi = 0; pi < npair; ++pi) {
      int i0 = 2 * pi, i1 = 2 * pi + 1;
      int kr0 = rs + i0 / nct, c0 = ct_first + i0 % nct;
      int kr1 = rs + i1 / nct, c1 = ct_first + i1 % nct;
      int t0 = kr0 * 64 + c0 * 16, t1 = kr1 * 64 + c1 * 16;
      na_pair(KN, VT, qf0, qf1, b * SEQ + t0, b * SEQ + t1, vt_base, t0, t1, h, lane, true, kr0, kr1, c0, c1, qr, qc,
              bias_lds + h * 465, O, lsum);
    }
  }
  for (int pi = 0; pi < 8; ++pi) {
    int t0 = pi * 32, t1 = pi * 32 + 16;
    na_pair(KN, VT, qf0, qf1, NLAT + b * CTXL + t0, NLAT + b * CTXL + t1, vt_base, SEQ + t0, SEQ + t1, h, lane, false,
            0, 0, 0, 0, 0, 0, bias_lds, O, lsum);
  }
  lsum += __shfl_xor(lsum, 16, 64);
  lsum += __shfl_xor(lsum, 32, 64);
  float inv = 1.f / lsum;
#pragma unroll
  for (int dt = 0; dt < 4; ++dt) {
    bf16x4 o;
#pragma unroll
    for (int r = 0; r < 4; ++r) o[r] = (short)f2bf(O[dt][r] * inv);
    *(bf16x4*)(CC + (size_t)(mq0 + fr) * 1024 + h * 64 + dt * 16 + fq * 4) = o;
  }
}

__device__ void phase_mix(const Params& p, int l, int bid, int nb, char* smem) {
  const int tid = tid_opaque();
  const int nscan_blocks = (nb > 64) ? 64 : nb;
  const int first_attn_block = (nb > 64) ? 64 : 0;
  if (bid < nscan_blocks) {
    for (int c = bid; c < 64; c += nscan_blocks) {
      int half = c & 1, d = (c >> 1) & 1, h = (c >> 2) & 3, b = (c >> 4) & 1, ty = (c >> 5) & 1;
      if (ty == 0) scan_chain<false>(p, b, h, d, half, smem);
      else scan_chain<true>(p, b, h, d, half, smem);
    }
  }
  if (bid >= first_attn_block) {
    float* bias = (float*)smem;
    __syncthreads();
    for (int i = tid; i < 8 * 465; i += NTHR) bias[i] = p.na_rpb[(size_t)l * 8 * 465 + i] * 1.4426950408889634f;
    __syncthreads();
    const int ntask = (l == 0) ? 2048 + 32 : 2048;
    const int nab = nb - first_attn_block;
    for (int t = bid - first_attn_block; t < ntask; t += nab) na_block_task(p, t, bias);
  }
}

__device__ void phase_post(const Params& p, int l, int bid, int nb) {
  const int tid = tid_opaque(), lane = tid & 63, wv = wave_id(tid);
  char* S = p.ws + OFF_S;
  const float* YRW = (const float*)(S + S_YRW);
  const float* YGD = (const float*)(S + S_YGD);
  const float* RWV = (const float*)(S + S_RWV);
  const float* RWG = (const float*)(S + S_RWG);
  const float* BON = (const float*)(S + S_BON);
  const float* P = (const float*)(p.ws + OFF_P);
  bfr* CC = (bfr*)(p.ws + OFF_CC);
  const float* ln_w = p.rw_ln_w + (size_t)l * 256;
  const float* ln_b = p.rw_ln_b + (size_t)l * 256;
  const float* ng = p.gd_norm_g + (size_t)l * 64;
  const int ntok = (l == 0) ? NTOK : NLAT;
  for (int wt = bid * 8 + wv; wt < ntok * 8; wt += nb * 8) {
    int m = wt >> 3, hs = wt & 7;
    if (hs < 4) {
      int c = hs * 64 + lane;
      size_t o = (size_t)m * 256 + c;
      float y = YRW[o] + YRW[(size_t)NTOK * 256 + o];
      float mean = wave_sum(y) * (1.f / 64.f);
      float dv = y - mean;
      float var = wave_sum(dv * dv) * (1.f / 64.f);
      float yn = dv * rsqrtf(var + 64e-5f) * ln_w[c] + ln_b[c];
      float out = (yn + BON[(size_t)m * 4 + hs] * RWV[o]) * RWG[o];
      CC[(size_t)m * 1024 + 512 + c] = f2bf(out);
    } else {
      int c = (hs - 4) * 64 + lane;
      size_t o = (size_t)m * 256 + c;
      float y = YGD[o] + YGD[(size_t)NTOK * 256 + o];
      float ms = wave_sum(y * y) * (1.f / 64.f);
      float z = P[(size_t)m * PINP + B_END + 768 + c];
      float out = y * rsqrtf(ms + 1e-6f) * ng[lane] * siluf_(z);
      CC[(size_t)m * 1024 + 768 + c] = f2bf(out);
    }
  }
}

__device__ void phase_router(const Params& p, int l, int bid, int nb) {
  const int tid = tid_opaque(), lane = tid & 63, wv = wave_id(tid);
  const float* xl = p.out;
  const float* xc = (const float*)(p.ws + OFF_CTX);
  const float* mods = (const float*)(p.ws + OFF_MODS) + (size_t)l * 3 * 6144;
  const float* g = p.norm_ffn_g + (size_t)l * 1024;
  const float* rw = p.moe_router_w + (size_t)l * 1024 * 32;
  const float* rb = p.moe_router_b + (size_t)l * 32;
  bfr* H = (bfr*)(p.ws + OFF_H);
  int* cnt = (int*)(p.ws + OFF_CNT);
  int* TOKE = (int*)(p.ws + OFF_TOKE);
  int* TOKP = (int*)(p.ws + OFF_TOKP);
  float* TOKG = (float*)(p.ws + OFF_TOKG);
  const int ntok = (l == 0) ? NTOK : NLAT;
  for (int m = bid * 8 + wv; m < ntok; m += nb * 8) {
    const float* xr = (m < NLAT) ? xl + (size_t)m * 1024 : xc + (size_t)(m - NLAT) * 1024;
    const float* md = mods + (size_t)mod_row(m) * 6144 + 3072;
    float4 v[4];
    float ss = 0.f;
#pragma unroll
    for (int i = 0; i < 4; ++i) {
      v[i] = *(const float4*)(xr + (lane + 64 * i) * 4);
      ss += v[i].x * v[i].x + v[i].y * v[i].y + v[i].z * v[i].z + v[i].w * v[i].w;
    }
    ss = wave_sum(ss);
    float rs = rsqrtf(ss * (1.f / 1024.f) + 1e-6f);
    float acc[32];
#pragma unroll
    for (int e = 0; e < 32; ++e) acc[e] = 0.f;
#pragma unroll
    for (int i = 0; i < 4; ++i) {
      int d = (lane + 64 * i) * 4;
      float4 gg = *(const float4*)(g + d);
      float4 sh = *(const float4*)(md + d);
      float4 sc = *(const float4*)(md + 1024 + d);
      float hv[4];
      hv[0] = v[i].x * rs * gg.x * (1.f + sc.x) + sh.x;
      hv[1] = v[i].y * rs * gg.y * (1.f + sc.y) + sh.y;
      hv[2] = v[i].z * rs * gg.z * (1.f + sc.z) + sh.z;
      hv[3] = v[i].w * rs * gg.w * (1.f + sc.w) + sh.w;
      bf16x4 o;
#pragma unroll
      for (int j = 0; j < 4; ++j) o[j] = (short)f2bf(hv[j]);
      *(bf16x4*)(H + (size_t)m * 1024 + d) = o;
#pragma unroll
      for (int j = 0; j < 4; ++j) {
        const float4* wr4 = (const float4*)(rw + (size_t)(d + j) * 32);
#pragma unroll
        for (int q = 0; q < 8; ++q) {
          float4 w = wr4[q];
          acc[q * 4 + 0] += hv[j] * w.x; acc[q * 4 + 1] += hv[j] * w.y;
          acc[q * 4 + 2] += hv[j] * w.z; acc[q * 4 + 3] += hv[j] * w.w;
        }
      }
    }
#pragma unroll
    for (int e = 0; e < 32; ++e) acc[e] = wave_sum(acc[e]) + rb[e];
    unsigned taken = 0u;
    float tv[4]; int ti[4];
#pragma unroll
    for (int k = 0; k < 4; ++k) {
      float best = -3.0e38f; int bi = 0;
#pragma unroll
      for (int e = 0; e < 32; ++e) {
        bool ok = !((taken >> e) & 1u) && (acc[e] > best);
        best = ok ? acc[e] : best; bi = ok ? e : bi;
      }
      taken |= 1u << bi; tv[k] = best; ti[k] = bi;
    }
    float e0 = 1.f, e1 = __expf(tv[1] - tv[0]), e2 = __expf(tv[2] - tv[0]), e3 = __expf(tv[3] - tv[0]);
    float inv = 1.f / (e0 + e1 + e2 + e3);
    if (lane < 4) {
      int e = lane == 0 ? ti[0] : lane == 1 ? ti[1] : lane == 2 ? ti[2] : ti[3];
      float gt = (lane == 0 ? e0 : lane == 1 ? e1 : lane == 2 ? e2 : e3) * inv;
      int pos = atomicAdd(&cnt[e], 1);
      TOKE[(size_t)m * 4 + lane] = e; TOKP[(size_t)m * 4 + lane] = pos; TOKG[(size_t)m * 4 + lane] = gt;
    }
  }
}

__device__ __forceinline__ void moe_offsets(const Params& p, int* toff) {
  const int* cnt = (const int*)(p.ws + OFF_CNT);
  if (tid_opaque() == 0) {
    int a = 0;
    for (int e = 0; e < 32; ++e) { toff[e] = a; a += (cnt[e] + 255) >> 8; }
    toff[32] = a;
  }
  __syncthreads();
}

__device__ void phase_slotfill(const Params& p, int l, int bid, int nb, char* smem) {
  int* toff = (int*)smem;
  moe_offsets(p, toff);
  const int tid = tid_opaque(), lane = tid & 63, wv = wave_id(tid);
  const int* TOKE = (const int*)(p.ws + OFF_TOKE);
  const int* TOKP = (const int*)(p.ws + OFF_TOKP);
  const float* TOKG = (const float*)(p.ws + OFF_TOKG);
  const int* cnt = (const int*)(p.ws + OFF_CNT);
  int* TOKS = (int*)(p.ws + OFF_TOKS);
  float* SLG = (float*)(p.ws + OFF_SLG);
  const bfr* H = (const bfr*)(p.ws + OFF_H);
  bfr* XG = (bfr*)(p.ws + OFF_S);
  const int n = ((l == 0) ? NTOK : NLAT) * 4;
  for (int i = bid * 8 + wv; i < n; i += nb * 8) {
    int e = TOKE[i];
    int slot = toff[e] * 256 + TOKP[i];
    if (lane == 0) { TOKS[i] = slot; SLG[slot] = TOKG[i]; }
    const uint4* src = (const uint4*)(H + (size_t)(i >> 2) * 1024);
    uint4* dst = (uint4*)(XG + (size_t)slot * 1024);
    dst[lane] = src[lane];
    dst[lane + 64] = src[lane + 64];
  }
  for (int e = 0; e < 32; ++e) {
    const int c = cnt[e];
    const int npad = ((c + 255) & ~255) - c;
    const int base = toff[e] * 256 + c;
    for (int r = bid * 8 + wv; r < npad; r += nb * 8) {
      uint4* dst = (uint4*)(XG + (size_t)(base + r) * 1024);
      dst[lane] = make_uint4(0u, 0u, 0u, 0u);
      dst[lane + 64] = make_uint4(0u, 0u, 0u, 0u);
    }
  }
  __syncthreads();
}

struct EpiMoe1 {
  const float* bgu; bfr* ACT;
  __device__ __forceinline__ void operator()(const f32x4 (&acc)[2][2][4][2], const g8::GUnit& u, int wr, int wc, int fr, int fq) const {
    const float* be = bgu + (size_t)u.e * 2048;
    const int slot0 = u.pm * 256 + wr * 64 + fr;
#pragma unroll
    for (int bj = 0; bj < 2; ++bj) {
      const int j0 = u.pn * 128 + bj * 64 + wc * 16 + 4 * fq;
      const f32x4 bg = *(const f32x4*)(be + j0), bl = *(const f32x4*)(be + 1024 + j0);
#pragma unroll
      for (int ai = 0; ai < 2; ++ai)
#pragma unroll
        for (int m = 0; m < 4; ++m) {
          const f32x4 g = acc[ai][bj][m][0] + bg, li = acc[ai][bj][m][1] + bl;
          bf16x4 o;
#pragma unroll
          for (int q = 0; q < 4; ++q) {
            float gv = fminf(g[q], 7.f);
            float lv = fminf(fmaxf(li[q], -7.f), 7.f);
            o[q] = (short)f2bf(gv * sigmoidf_(1.702f * gv) * (lv + 1.f));
          }
          *(bf16x4*)(ACT + (size_t)(slot0 + ai * 128 + m * 16) * 1024 + j0) = o;
        }
    }
  }
};
__device__ void phase_moe1_impl(const Params& p, int l, int bid, int nb, char* smem, int* toff) {
  moe_offsets(p, toff);
  g8::MoeSched S{toff, 8, 2048, nb, bid};
  EpiMoe1 E{p.moe_b_gu + (size_t)l * 32 * 2048, (bfr*)(p.ws + OFF_P)};
  g8::gemm_stream((LAS unsigned char*)smem, (const bfr*)(p.ws + OFF_S), (const bfr*)(p.ws + OFF_W + (size_t)l * WL_SIZE + WL_GU), S, E);
}

struct EpiMoe2 {
  const float* bdn; const float* SLG; float* YS;
  __device__ __forceinline__ void operator()(const f32x4 (&acc)[2][2][4][2], const g8::GUnit& u, int wr, int wc, int fr, int fq) const {
    const float* be = bdn + (size_t)u.e * 1024;
    const int slot0 = u.pm * 256 + wr * 64 + fr, col0 = u.pn * 256 + wc * 32 + 4 * fq;
#pragma unroll
    for (int ai = 0; ai < 2; ++ai)
#pragma unroll
      for (int m = 0; m < 4; ++m) {
        const int slot = slot0 + ai * 128 + m * 16;
        const float gt = SLG[slot];
#pragma unroll
        for (int bj = 0; bj < 2; ++bj)
#pragma unroll
          for (int n = 0; n < 2; ++n) {
            const f32x4 bv = *(const f32x4*)(be + col0 + bj * 128 + n * 16);
            *(f32x4*)(YS + (size_t)slot * 1024 + col0 + bj * 128 + n * 16) = (acc[ai][bj][m][n] + bv) * gt;
          }
      }
  }
};
__device__ void phase_moe2_impl(const Params& p, int l, int bid, int nb, char* smem, int* toff) {
  moe_offsets(p, toff);
  g8::MoeSched S{toff, 4, 1024, nb, bid};
  EpiMoe2 E{p.moe_b_down + (size_t)l * 32 * 1024, (const float*)(p.ws + OFF_SLG), (float*)(p.ws + OFF_S)};
  g8::gemm_stream((LAS unsigned char*)smem, (const bfr*)(p.ws + OFF_P), (const bfr*)(p.ws + OFF_W + (size_t)l * WL_SIZE + WL_DN), S, E);
}

__device__ void phase_combine(const Params& p, int l, int bid, int nb) {
  const int tid = tid_opaque(), lane = tid & 63, wv = wave_id(tid);
  const float* YS = (const float*)(p.ws + OFF_S);
  const int* TOKS = (const int*)(p.ws + OFF_TOKS);
  const float* mods = (const float*)(p.ws + OFF_MODS) + (size_t)l * 3 * 6144;
  float* xl = p.out;
  float* xc = (float*)(p.ws + OFF_CTX);
  const int ntok = (l == 0) ? NTOK : NLAT;
  for (int m = bid * 8 + wv; m < ntok; m += nb * 8) {
    float* xr = (m < NLAT) ? xl + (size_t)m * 1024 : xc + (size_t)(m - NLAT) * 1024;
    const float* g2 = mods + (size_t)mod_row(m) * 6144 + 5120;
    int s0 = TOKS[(size_t)m * 4], s1 = TOKS[(size_t)m * 4 + 1], s2 = TOKS[(size_t)m * 4 + 2], s3 = TOKS[(size_t)m * 4 + 3];
#pragma unroll
    for (int i = 0; i < 4; ++i) {
      int d = (lane + 64 * i) * 4;
      float4 a = *(const float4*)(YS + (size_t)s0 * 1024 + d);
      float4 b = *(const float4*)(YS + (size_t)s1 * 1024 + d);
      float4 c = *(const float4*)(YS + (size_t)s2 * 1024 + d);
      float4 e = *(const float4*)(YS + (size_t)s3 * 1024 + d);
      float4 gg = *(const float4*)(g2 + d);
      float4 xv = *(const float4*)(xr + d);
      xv.x += gg.x * (a.x + b.x + c.x + e.x);
      xv.y += gg.y * (a.y + b.y + c.y + e.y);
      xv.z += gg.z * (a.z + b.z + c.z + e.z);
      xv.w += gg.w * (a.w + b.w + c.w + e.w);
      *(float4*)(xr + d) = xv;
    }
  }
}

extern __shared__ __attribute__((aligned(16))) char dyn_smem[];

__global__ void __launch_bounds__(NTHR) mega(Params p) {
  cg::grid_group grid = cg::this_grid();
  const int bid0 = blockIdx.x, nb0 = gridDim.x;
#define bid opq(bid0)
#define nb opq(nb0)
  int* toff_s = (int*)(dyn_smem + 131072);
  phase_ada(p, bid, nb, dyn_smem);
  phase_convert(p, 0, bid, nb, dyn_smem);
  phase_convert(p, 1, bid, nb, dyn_smem);
  grid.sync();
  for (int l0 = 0; l0 < 2; ++l0) {
#define l opq(l0)
    phase_prenorm(p, l, bid, nb);
    grid.sync();
    phase_gemm_in(p, l, bid, nb, dyn_smem);
    grid.sync();
    phase_prep(p, l, bid, nb, dyn_smem);
    grid.sync();
    phase_mix(p, l, bid, nb, dyn_smem);
    grid.sync();
    phase_post(p, l, bid, nb);
    grid.sync();
    phase_gemm_out(p, l, bid, nb, dyn_smem);
    grid.sync();
    phase_router(p, l, bid, nb);
    grid.sync();
    phase_slotfill(p, l, bid, nb, dyn_smem);
    grid.sync();
    phase_moe1_impl(p, l, bid, nb, dyn_smem, toff_s);
    grid.sync();
    phase_moe2_impl(p, l, bid, nb, dyn_smem, toff_s);
    grid.sync();
    phase_combine(p, l, bid, nb);
    if (l0 == 0) grid.sync();
  }
#undef l
#undef bid
#undef nb
}

extern "C" void kernel_launch(void* const* d_in, const int* in_sizes, int n_in, void* d_out, int out_size, void* d_ws,
                              size_t ws_size, hipStream_t stream) {
  Params p{};
  const float** pp = (const float**)&p;
  for (int i = 0; i < 34; ++i) pp[i] = (const float*)d_in[i];
  p.out = (float*)d_out;
  p.ws = (char*)d_ws;
  static int grid_blocks = 0;
  if (!grid_blocks) {
    (void)hipFuncSetAttribute((const void*)mega, hipFuncAttributeMaxDynamicSharedMemorySize, LDS_BYTES);
    int dev = 0, cus = 0, per_cu = 0;
    (void)hipGetDevice(&dev);
    (void)hipDeviceGetAttribute(&cus, hipDeviceAttributeMultiprocessorCount, dev);
    (void)hipOccupancyMaxActiveBlocksPerMultiprocessor(&per_cu, mega, NTHR, LDS_BYTES);
    if (per_cu < 1) per_cu = 1;
    if (per_cu > 1) per_cu = 1;
    grid_blocks = cus * per_cu;
  }
  void* args[] = {&p};
  (void)hipLaunchCooperativeKernel((void*)mega, dim3(grid_blocks), dim3(NTHR), args, LDS_BYTES, stream);
}
```

```cpp
#include <hip/hip_runtime.h>
#include <hip/hip_bf16.h>
#include <hip/hip_cooperative_groups.h>
#include <stdint.h>
namespace cg = cooperative_groups;

typedef __attribute__((ext_vector_type(8))) short bf16x8;
typedef __attribute__((ext_vector_type(4))) short bf16x4;
typedef __attribute__((ext_vector_type(4))) float f32x4;
typedef unsigned short bfr;

#define D_MODEL 1024
#define NB 2
#define SEQ 16384
#define CTXL 256
#define NLAT (NB * SEQ)
#define NCTX (NB * CTXL)
#define NTOK (NLAT + NCTX)
#define TTOK (SEQ + CTXL)
#define PIN 3472
#define PINP 3584
#define A_END 1536
#define B_END 2432
#define NEXP 32
#define NSLOT_MAX (NTOK * 4 + NEXP * 256)
#define NTHR 512
#define LDS_BYTES (147456 + 512)

constexpr size_t al256(size_t x) { return (x + 255) & ~(size_t)255; }
constexpr size_t WL_IN = 0;
constexpr size_t WL_OUT = WL_IN + (size_t)PINP * 1024 * 2;
constexpr size_t WL_GU = WL_OUT + (size_t)1024 * 1024 * 2;
constexpr size_t WL_DN = WL_GU + (size_t)32 * 2048 * 1024 * 2;
constexpr size_t WL_SIZE = WL_DN + (size_t)32 * 1024 * 1024 * 2;
constexpr size_t OFF_W = 0;
constexpr size_t OFF_MODS = al256(OFF_W + 2 * WL_SIZE);
constexpr size_t OFF_CTX = al256(OFF_MODS + 2 * 3 * 6144 * 4);
constexpr size_t OFF_CNT = al256(OFF_CTX + (size_t)NCTX * 1024 * 4);
constexpr size_t OFF_TOKE = al256(OFF_CNT + 256);
constexpr size_t OFF_TOKP = al256(OFF_TOKE + (size_t)NTOK * 4 * 4);
constexpr size_t OFF_TOKG = al256(OFF_TOKP + (size_t)NTOK * 4 * 4);
constexpr size_t OFF_TOKS = al256(OFF_TOKG + (size_t)NTOK * 4 * 4);
constexpr size_t OFF_SLT = al256(OFF_TOKS + (size_t)NTOK * 4 * 4);
constexpr size_t OFF_SLG = al256(OFF_SLT + (size_t)NSLOT_MAX * 4);
constexpr size_t OFF_H = al256(OFF_SLG + (size_t)NSLOT_MAX * 4);
constexpr size_t OFF_CC = al256(OFF_H + (size_t)NTOK * 1024 * 2);
constexpr size_t OFF_P = al256(OFF_CC + (size_t)NTOK * 1024 * 2);
constexpr size_t OFF_S = al256(OFF_P + (size_t)NTOK * PINP * 4);
constexpr size_t TOK256F = (size_t)NTOK * 256 * 4;
constexpr size_t S_QN = 0;
constexpr size_t S_KN = S_QN + (size_t)NTOK * 512 * 2;
constexpr size_t S_VT = S_KN + (size_t)NTOK * 512 * 2;
constexpr size_t S_RWR = S_VT + (size_t)NB * 8 * 64 * TTOK * 2;
constexpr size_t S_RWKK = S_RWR + TOK256F;
constexpr size_t S_RWV = S_RWKK + TOK256F;
constexpr size_t S_RWG = S_RWV + TOK256F;
constexpr size_t S_RWW = S_RWG + TOK256F;
constexpr size_t S_RWKD = S_RWW + 2 * TOK256F;
constexpr size_t S_RWB = S_RWKD + 2 * TOK256F;
constexpr size_t S_BON = S_RWB + 2 * TOK256F;
constexpr size_t S_GDQ = al256(S_BON + (size_t)NTOK * 4 * 4);
constexpr size_t S_GDK = S_GDQ + TOK256F;
constexpr size_t S_GDV = S_GDK + TOK256F;
constexpr size_t S_GDAB = S_GDV + TOK256F;
constexpr size_t S_YRW = al256(S_GDAB + (size_t)NTOK * 16 * 4);
constexpr size_t S_YGD = S_YRW + 2 * TOK256F;
constexpr size_t S_END = S_YGD + 2 * TOK256F;
constexpr size_t S_SIZE = (S_END > (size_t)NSLOT_MAX * 1024 * 4) ? S_END : (size_t)NSLOT_MAX * 1024 * 4;
constexpr size_t WS_TOTAL = OFF_S + S_SIZE;

struct Params {
  const float *x, *c, *ctx, *c_ctx, *ada_w, *ada_b, *norm_mix_g, *norm_ffn_g, *w_in, *w_out;
  const float *na_q_gain, *na_k_gain, *na_rpb;
  const float *rw_mu, *rw_w0, *rw_w_up, *rw_a0, *rw_a_up, *rw_g_up, *rw_k_k, *rw_k_a, *rw_r_k, *rw_ln_w, *rw_ln_b;
  const float *gd_conv_w, *gd_A_log, *gd_dt_bias, *gd_norm_g;
  const float *moe_router_w, *moe_router_b, *moe_w_gu, *moe_b_gu, *moe_w_down, *moe_b_down;
  float* out;
  char* ws;
};

__device__ __forceinline__ int tid_opaque() { int t = (int)__builtin_amdgcn_workitem_id_x(); asm volatile("" : "+v"(t)); return t; }
__device__ __forceinline__ int opq(int x) { asm volatile("" : "+s"(x)); return x; }
__device__ __forceinline__ int wave_id(int tid) { return __builtin_amdgcn_readfirstlane(tid >> 6); }
__device__ __forceinline__ bfr f2bf(float f) {
  unsigned u = __float_as_uint(f);
  u += 0x7fffu + ((u >> 16) & 1u);
  return (bfr)(u >> 16);
}
__device__ __forceinline__ float sigmoidf_(float x) { return 1.f / (1.f + __expf(-x)); }
__device__ __forceinline__ float siluf_(float x) { return x / (1.f + __expf(-x)); }
__device__ __forceinline__ float softplusf_(float x) { return x > 20.f ? x : log1pf(__expf(x)); }
__device__ __forceinline__ float wave_sum(float v) {
#pragma unroll
  for (int o = 32; o >= 1; o >>= 1) v += __shfl_xor(v, o, 64);
  return v;
}
__device__ __forceinline__ float row16_sum(float v) {
  v += __builtin_bit_cast(float, __builtin_amdgcn_update_dpp(0, __builtin_bit_cast(int, v), 0xB1, 0xF, 0xF, true));
  v += __builtin_bit_cast(float, __builtin_amdgcn_update_dpp(0, __builtin_bit_cast(int, v), 0x4E, 0xF, 0xF, true));
  v += __builtin_bit_cast(float, __builtin_amdgcn_update_dpp(0, __builtin_bit_cast(int, v), 0x141, 0xF, 0xF, true));
  v += __builtin_bit_cast(float, __builtin_amdgcn_update_dpp(0, __builtin_bit_cast(int, v), 0x140, 0xF, 0xF, true));
  return v;
}
__device__ __forceinline__ int mod_row(int m) { return m < NLAT ? (m >> 14) : 2; }

__device__ void phase_ada(const Params& p, int bid, int nb, char* smem) {
  float* red = (float*)smem;
  float* mods = (float*)(p.ws + OFF_MODS);
  const int tid = tid_opaque();
  for (int task = bid; task < 2 * 96; task += nb) {
    int l = task / 96, cgp = task % 96;
    int col = cgp * 64 + (tid & 63), ks = tid >> 6;
    const float* W = p.ada_w + (size_t)l * 1024 * 6144;
    float a0 = 0.f, a1 = 0.f, a2 = 0.f;
    for (int d = ks * 128; d < ks * 128 + 128; ++d) {
      float w = W[(size_t)d * 6144 + col];
      a0 += siluf_(p.c[d]) * w;
      a1 += siluf_(p.c[1024 + d]) * w;
      a2 += siluf_(p.c_ctx[d]) * w;
    }
    red[(ks * 3 + 0) * 64 + (tid & 63)] = a0;
    red[(ks * 3 + 1) * 64 + (tid & 63)] = a1;
    red[(ks * 3 + 2) * 64 + (tid & 63)] = a2;
    __syncthreads();
    if (tid < 192) {
      int r = tid >> 6, cc = tid & 63;
      float s = 0.f;
      for (int k = 0; k < 8; ++k) s += red[(k * 3 + r) * 64 + cc];
      mods[(size_t)(l * 3 + r) * 6144 + cgp * 64 + cc] = s + p.ada_b[(size_t)l * 6144 + cgp * 64 + cc];
    }
    __syncthreads();
  }
}

__device__ void convert_tile(const float* src, int N, bfr* dst, int kt, int nt, int mode, float* tile  ) {
  const int tid = tid_opaque();
#pragma unroll
  for (int q = 0; q < 2; ++q) {
    int idx = tid + q * 512;
    int kk = idx >> 4, n4 = idx & 15;
    int n = nt * 64 + n4 * 4;
    float4 v = make_float4(0.f, 0.f, 0.f, 0.f);
    if (n < N) v = *(const float4*)(src + (size_t)(kt * 64 + kk) * N + n);
    tile[kk * 65 + n4 * 4 + 0] = v.x;
    tile[kk * 65 + n4 * 4 + 1] = v.y;
    tile[kk * 65 + n4 * 4 + 2] = v.z;
    tile[kk * 65 + n4 * 4 + 3] = v.w;
  }
  __syncthreads();
  {
    int nn = tid >> 3, kc = tid & 7;
    int n = nt * 64 + nn;
    int row = n;
    if (mode == 1) { int j = n & 1023; row = (j >> 4) * 32 + (j & 15) + ((n >= 1024) ? 16 : 0); }
    bf16x8 o;
#pragma unroll
    for (int j = 0; j < 8; ++j) o[j] = (short)f2bf(tile[(kc * 8 + j) * 65 + nn]);
    *(bf16x8*)(dst + (size_t)row * 1024 + kt * 64 + kc * 8) = o;
  }
  __syncthreads();
}
__device__ void phase_convert(const Params& p, int l, int bid, int nb, char* smem) {
  float* tile = (float*)smem;
  char* wl = p.ws + OFF_W + (size_t)l * WL_SIZE;
  const int T_IN = 16 * 56, T_OUT = 16 * 16, T_GU = 32 * 16 * 32, T_DN = 32 * 16 * 16;
  const int total = T_IN + T_OUT + T_GU + T_DN;
  for (int t = bid; t < total; t += nb) {
    if (t < T_IN) {
      int kt = t / 56, nt = t % 56;
      convert_tile(p.w_in + (size_t)l * 1024 * PIN, PIN, (bfr*)(wl + WL_IN), kt, nt, 0, tile);
    } else if (t < T_IN + T_OUT) {
      int u = t - T_IN; int kt = u / 16, nt = u % 16;
      convert_tile(p.w_out + (size_t)l * 1024 * 1024, 1024, (bfr*)(wl + WL_OUT), kt, nt, 0, tile);
    } else if (t < T_IN + T_OUT + T_GU) {
      int u = t - T_IN - T_OUT; int e = u / 512; int v = u % 512; int kt = v / 32, nt = v % 32;
      convert_tile(p.moe_w_gu + ((size_t)l * 32 + e) * 1024 * 2048, 2048, (bfr*)(wl + WL_GU) + (size_t)e * 2048 * 1024, kt, nt, 1, tile);
    } else {
      int u = t - T_IN - T_OUT - T_GU; int e = u / 256; int v = u % 256; int kt = v / 16, nt = v % 16;
      convert_tile(p.moe_w_down + ((size_t)l * 32 + e) * 1024 * 1024, 1024, (bfr*)(wl + WL_DN) + (size_t)e * 1024 * 1024, kt, nt, 0, tile);
    }
  }
}

__device__ void phase_prenorm(const Params& p, int l, int bid, int nb) {
  const int tid = tid_opaque(), lane = tid & 63, wv = wave_id(tid);
  const float* xl = (l == 0) ? p.x : p.out;
  const float* xc = (l == 0) ? p.ctx : (const float*)(p.ws + OFF_CTX);
  const float* mods = (const float*)(p.ws + OFF_MODS) + (size_t)l * 3 * 6144;
  const float* g = p.norm_mix_g + (size_t)l * 1024;
  bfr* H = (bfr*)(p.ws + OFF_H);
  {
    int* cnt = (int*)(p.ws + OFF_CNT);
    int* slt = (int*)(p.ws + OFF_SLT);
    int gt = bid * NTHR + tid;
    if (gt < 32) cnt[gt] = 0;
    for (int i = gt; i < NSLOT_MAX; i += nb * NTHR) slt[i] = 0;
  }
  for (int m = bid * 8 + wv; m < NTOK; m += nb * 8) {
    const float* xr = (m < NLAT) ? xl + (size_t)m * 1024 : xc + (size_t)(m - NLAT) * 1024;
    const float* md = mods + (size_t)mod_row(m) * 6144;
    float4 v[4];
    float ss = 0.f;
#pragma unroll
    for (int i = 0; i < 4; ++i) {
      v[i] = *(const float4*)(xr + (lane + 64 * i) * 4);
      ss += v[i].x * v[i].x + v[i].y * v[i].y + v[i].z * v[i].z + v[i].w * v[i].w;
    }
    ss = wave_sum(ss);
    float rs = rsqrtf(ss * (1.f / 1024.f) + 1e-6f);
#pragma unroll
    for (int i = 0; i < 4; ++i) {
      int d = (lane + 64 * i) * 4;
      float4 gg = *(const float4*)(g + d);
      float4 sh = *(const float4*)(md + d);
      float4 sc = *(const float4*)(md + 1024 + d);
      bf16x4 o;
      o[0] = (short)f2bf(v[i].x * rs * gg.x * (1.f + sc.x) + sh.x);
      o[1] = (short)f2bf(v[i].y * rs * gg.y * (1.f + sc.y) + sh.y);
      o[2] = (short)f2bf(v[i].z * rs * gg.z * (1.f + sc.z) + sh.z);
      o[3] = (short)f2bf(v[i].w * rs * gg.w * (1.f + sc.w) + sh.w);
      *(bf16x4*)(H + (size_t)m * 1024 + d) = o;
    }
  }
}

#define LAS __attribute__((address_space(3)))
namespace g8 {
constexpr int BM = 256, BK = 64, HALF = 128, HTB = HALF * BK * 2, STAGE_BYTES = 8 * HTB, KD = 1024;
__device__ __forceinline__ int lds_byte(int r, int c) { const int st = (r >> 4) * 2 + (c >> 5), rr = r & 15, cc = c & 31, ob = rr * 64 + cc * 2; return st * 1024 + (ob ^ (((ob >> 9) & 1) << 5)); }
__device__ __forceinline__ void stage_rc(int b, int& R, int& C) { const int st = b / 1024, sb = b % 1024, swz = sb ^ (((sb >> 9) & 1) << 5); R = (st >> 1) * 16 + swz / 64; C = (st & 1) * 32 + (swz % 64) / 2; }
struct GUnit { int pm, pn, brow0, e; };
__device__ __forceinline__ int unit_index(int i, int c, int G, int total) {
  const int x = c & 7, j = c >> 3, q = total >> 3, r = total & 7;
  const int start = x < r ? x * (q + 1) : r * (q + 1) + (x - r) * q;
  const int size = q + (x < r ? 1 : 0);
  const int li = i * (G >> 3) + j;
  return li < size ? start + li : -1;
}

template <class Sched, class Epi>
__device__ __forceinline__ void gemm_stream(LAS unsigned char* lds, const bfr* Abase, const bfr* Btbase, const Sched& S, const Epi& E) {
  const int tid = tid_opaque(), wid = __builtin_amdgcn_readfirstlane(tid >> 6), lane = tid & 63, wr = wid >> 2, wc = wid & 3, fr = lane & 15, fq = lane >> 4;
  constexpr int nt = KD / BK;
  int R[2], C[2];
  unsigned voffB[2];
#pragma unroll
  for (int i = 0; i < 2; ++i) { stage_rc(tid * 16 + i * 8192, R[i], C[i]); voffB[i] = (unsigned)(R[i] * KD + C[i]) * 2u; }
#define voffA voffB
  constexpr size_t kstep = (size_t)(BK * 2);
  constexpr size_t hstep = (size_t)HALF * KD * 2;
  const unsigned ldsw = (unsigned)wid * 1024u;
  const int aoff = lds_byte(wr * 64 + fr, fq * 8), boff = lds_byte(wc * 32 + fr, fq * 8);
#define G8_SA(b, h) (((b) * 2 + (h)) * HTB)
#define G8_SB(b, h) ((4 + (b) * 2 + (h)) * HTB)
#define G8_STAGE(bufoff, gbase, v0, v1) do { \
    __builtin_amdgcn_global_load_lds((const unsigned*)((const char*)(gbase) + (v0)), (LAS unsigned*)(lds + (bufoff) + ldsw), 16, 0, 0); \
    __builtin_amdgcn_global_load_lds((const unsigned*)((const char*)(gbase) + (v1)), (LAS unsigned*)(lds + (bufoff) + ldsw + 8192), 16, 0, 0); } while (0)
#define G8_STAGEB(bufoff, gbase) G8_STAGE(bufoff, gbase, voffB[0], voffB[1])
#define G8_STAGEA(bufoff, gbase) G8_STAGE(bufoff, gbase, voffA[0], voffA[1])
#define G8_LDA(dst, b, h) do { _Pragma("unroll") for (int m = 0; m < 4; ++m) _Pragma("unroll") for (int k = 0; k < 2; ++k) dst[m][k] = *(const LAS bf16x8*)(lds + G8_SA(b, h) + aoff + m * 2048 + k * 1024); } while (0)
#define G8_LDB(dst, b, h) do { _Pragma("unroll") for (int n = 0; n < 2; ++n) _Pragma("unroll") for (int k = 0; k < 2; ++k) dst[n][k] = *(const LAS bf16x8*)(lds + G8_SB(b, h) + boff + n * 2048 + k * 1024); } while (0)
#define G8_MMA(ai, bj, At, Bt) do { __builtin_amdgcn_s_setprio(1); _Pragma("unroll") for (int m = 0; m < 4; ++m) _Pragma("unroll") for (int n = 0; n < 2; ++n) _Pragma("unroll") for (int k = 0; k < 2; ++k) \
    acc[ai][bj][m][n] = __builtin_amdgcn_mfma_f32_16x16x32_bf16(Bt[n][k], At[m][k], acc[ai][bj][m][n], 0, 0, 0); __builtin_amdgcn_s_setprio(0); } while (0)
#define G8_WAIT_V(n) asm volatile("s_waitcnt vmcnt(" #n ")" ::: "memory")
#define G8_WAIT_L(n) asm volatile("s_waitcnt lgkmcnt(" #n ")" ::: "memory")
#define G8_BAR __builtin_amdgcn_s_barrier()
#define G8_SCHED __builtin_amdgcn_sched_barrier(0)
  GUnit cur, nxt;
  int ui = 0;
  if (!S.next(0, cur)) return;
  f32x4 acc[2][2][4][2];
#pragma unroll
  for (int a = 0; a < 2; ++a)
#pragma unroll
    for (int b = 0; b < 2; ++b)
#pragma unroll
      for (int m = 0; m < 4; ++m)
#pragma unroll
        for (int n = 0; n < 2; ++n) acc[a][b][m][n] = (f32x4){0.f, 0.f, 0.f, 0.f};
  bf16x8 At[4][2], B0[2][2], B1[2][2];
  const char* cA = (const char*)Abase + (size_t)cur.pm * (BM * KD * 2);
  const char* cB = (const char*)Btbase + (size_t)cur.brow0 * (KD * 2);
  G8_STAGEB(G8_SB(0, 0), cB); G8_STAGEA(G8_SA(0, 0), cA); G8_STAGEB(G8_SB(0, 1), cB + hstep); G8_STAGEA(G8_SA(0, 1), cA + hstep);
  if (wr == 1) G8_BAR;
  G8_WAIT_V(4); G8_BAR;
  G8_STAGEB(G8_SB(1, 0), cB + kstep); G8_STAGEA(G8_SA(1, 0), cA + kstep); G8_STAGEB(G8_SB(1, 1), cB + hstep + kstep);
  G8_WAIT_V(6); G8_BAR;
  for (;;) {
    const bool has_next = S.next(ui + 1, nxt);
    const char* nA = has_next ? (const char*)Abase + (size_t)nxt.pm * (BM * KD * 2) : cA;
    const char* nB = has_next ? (const char*)Btbase + (size_t)nxt.brow0 * (KD * 2) : cB;
    for (int t = 0; t < nt; t += 2) {
      const bool last = (t == nt - 2);
      const char* a1 = cA + (size_t)(t + 1) * kstep;
      const char* a2 = last ? nA : cA + (size_t)(t + 2) * kstep;
      const char* b2 = last ? nB : cB + (size_t)(t + 2) * kstep;
      const char* a3 = a2 + kstep;
      const char* b3 = b2 + kstep;
      G8_LDB(B0, 0, 0); G8_SCHED; G8_LDA(At, 0, 0); G8_STAGEA(G8_SA(1, 1), a1 + hstep);
      G8_WAIT_L(8); G8_BAR; G8_WAIT_L(0); G8_MMA(0, 0, At, B0); G8_BAR; G8_SCHED;
      G8_LDB(B1, 0, 1); G8_STAGEB(G8_SB(0, 0), b2);
      G8_BAR; G8_WAIT_L(0); G8_MMA(0, 1, At, B1); G8_BAR;
      G8_LDA(At, 0, 1); G8_STAGEA(G8_SA(0, 0), a2);
      G8_BAR; G8_WAIT_L(0); G8_MMA(1, 0, At, B0); G8_BAR; G8_SCHED;
      G8_STAGEB(G8_SB(0, 1), b2 + hstep);
      G8_WAIT_V(6); G8_BAR; G8_MMA(1, 1, At, B1); G8_BAR;
      G8_LDB(B0, 1, 0); G8_SCHED; G8_LDA(At, 1, 0); G8_STAGEA(G8_SA(0, 1), a2 + hstep);
      G8_WAIT_L(8); G8_BAR; G8_WAIT_L(0); G8_MMA(0, 0, At, B0); G8_BAR; G8_SCHED;
      G8_LDB(B1, 1, 1); G8_STAGEB(G8_SB(1, 0), b3);
      G8_BAR; G8_WAIT_L(0); G8_MMA(0, 1, At, B1); G8_BAR;
      G8_LDA(At, 1, 1); G8_STAGEA(G8_SA(1, 0), a3);
      G8_BAR; G8_WAIT_L(0); G8_MMA(1, 0, At, B0); G8_BAR; G8_SCHED;
      G8_STAGEB(G8_SB(1, 1), b3 + hstep);
      G8_WAIT_V(6); G8_BAR; G8_MMA(1, 1, At, B1); G8_BAR;
    }
    E(acc, cur, wr, wc, fr, fq);
    if (!has_next) break;
#pragma unroll
    for (int a = 0; a < 2; ++a)
#pragma unroll
      for (int b = 0; b < 2; ++b)
#pragma unroll
        for (int m = 0; m < 4; ++m)
#pragma unroll
          for (int n = 0; n < 2; ++n) acc[a][b][m][n] = (f32x4){0.f, 0.f, 0.f, 0.f};
    cur = nxt; cA = nA; cB = nB; ++ui;
  }
  G8_WAIT_V(0);
  if (wr == 0) G8_BAR;
  G8_BAR;
#undef G8_SA
#undef G8_SB
#undef G8_STAGE
#undef G8_STAGEB
#undef G8_STAGEA
#undef voffA
#undef G8_LDA
#undef G8_LDB
#undef G8_MMA
#undef G8_WAIT_V
#undef G8_WAIT_L
#undef G8_BAR
#undef G8_SCHED
}

struct DenseSched {
  int nM, nN, G, c;
  __device__ __forceinline__ bool next(int i, GUnit& u) const {
    const int idx = unit_index(i, c, G, nM * nN);
    if (idx < 0) return false;
    u.pm = idx / nN; u.pn = idx - u.pm * nN; u.brow0 = u.pn * BM; u.e = 0;
    return true;
  }
};
struct MoeSched {
  const int* toff; int nN, NE, G, c;
  __device__ __forceinline__ bool next(int i, GUnit& u) const {
    const int idx = unit_index(i, c, G, toff[32] * nN);
    if (idx < 0) return false;
    u.pm = idx / nN; u.pn = idx - u.pm * nN;
    int e = 0;
#pragma unroll 1
    for (int k = 1; k < 32; ++k) e = (u.pm >= toff[k]) ? k : e;
    u.e = e; u.brow0 = e * NE + u.pn * BM;
    return true;
  }
};
}

struct EpiInProj {
  float* P;
  __device__ __forceinline__ void operator()(const f32x4 (&acc)[2][2][4][2], const g8::GUnit& u, int wr, int wc, int fr, int fq) const {
    const int row0 = u.pm * 256 + wr * 64 + fr, col0 = u.pn * 256 + wc * 32 + 4 * fq;
#pragma unroll
    for (int ai = 0; ai < 2; ++ai)
#pragma unroll
      for (int m = 0; m < 4; ++m) {
        float* rowp = P + (size_t)(row0 + ai * 128 + m * 16) * PINP + col0;
#pragma unroll
        for (int bj = 0; bj < 2; ++bj)
#pragma unroll
          for (int n = 0; n < 2; ++n) *(f32x4*)(rowp + bj * 128 + n * 16) = acc[ai][bj][m][n];
      }
  }
};
__device__ void phase_gemm_in(const Params& p, int l, int bid, int nb, char* smem) {
  g8::DenseSched S{130, 14, nb, bid};
  EpiInProj E{(float*)(p.ws + OFF_P)};
  g8::gemm_stream((LAS unsigned char*)smem, (const bfr*)(p.ws + OFF_H), (const bfr*)(p.ws + OFF_W + (size_t)l * WL_SIZE + WL_IN), S, E);
}

struct EpiOutProj {
  const float *xl, *xc, *mods; float *ol, *oc;
  __device__ __forceinline__ void operator()(const f32x4 (&acc)[2][2][4][2], const g8::GUnit& u, int wr, int wc, int fr, int fq) const {
    const bool lat = u.pm < 128;
    const float* xin = lat ? xl + (size_t)u.pm * 256 * 1024 : xc + (size_t)(u.pm - 128) * 256 * 1024;
    float* xo = lat ? ol + (size_t)u.pm * 256 * 1024 : oc + (size_t)(u.pm - 128) * 256 * 1024;
    const float* g1 = mods + (size_t)(lat ? (u.pm >> 6) : 2) * 6144 + 2048;
    const int row0 = wr * 64 + fr, col0 = u.pn * 256 + wc * 32 + 4 * fq;
#pragma unroll
    for (int bj = 0; bj < 2; ++bj)
#pragma unroll
      for (int n = 0; n < 2; ++n) {
        const f32x4 gv = *(const f32x4*)(g1 + col0 + bj * 128 + n * 16);
#pragma unroll
        for (int ai = 0; ai < 2; ++ai)
#pragma unroll
          for (int m = 0; m < 4; ++m) {
            const size_t o = (size_t)(row0 + ai * 128 + m * 16) * 1024 + col0 + bj * 128 + n * 16;
            const f32x4 xv = *(const f32x4*)(xin + o);
            *(f32x4*)(xo + o) = xv + gv * acc[ai][bj][m][n];
            if (m & 1) asm volatile("" ::: "memory");
          }
      }
  }
};
__device__ void phase_gemm_out(const Params& p, int l, int bid, int nb, char* smem) {
  g8::DenseSched S{(l == 0) ? 130 : 128, 4, nb, bid};
  EpiOutProj E{(l == 0) ? p.x : p.out, (l == 0) ? p.ctx : (const float*)(p.ws + OFF_CTX),
               (const float*)(p.ws + OFF_MODS) + (size_t)l * 3 * 6144, p.out, (float*)(p.ws + OFF_CTX)};
  g8::gemm_stream((LAS unsigned char*)smem, (const bfr*)(p.ws + OFF_CC), (const bfr*)(p.ws + OFF_W + (size_t)l * WL_SIZE + WL_OUT), S, E);
}

__device__ void phase_prep(const Params& p, int l, int bid, int nb, char* smem) {
  const int tid = tid_opaque(), lane = tid & 63, wv = wave_id(tid);
  const float* P = (const float*)(p.ws + OFF_P);
  char* S = p.ws + OFF_S;
  bfr* QN = (bfr*)(S + S_QN);
  bfr* KN = (bfr*)(S + S_KN);
  bfr* VT = (bfr*)(S + S_VT);
  float* RWR = (float*)(S + S_RWR);
  float* RWKK = (float*)(S + S_RWKK);
  float* RWV = (float*)(S + S_RWV);
  float* RWG = (float*)(S + S_RWG);
  float* RWW = (float*)(S + S_RWW);
  float* RWKD = (float*)(S + S_RWKD);
  float* RWB = (float*)(S + S_RWB);
  float* BON = (float*)(S + S_BON);
  float* GDQ = (float*)(S + S_GDQ);
  float* GDK = (float*)(S + S_GDK);
  float* GDV = (float*)(S + S_GDV);
  float* GDAB = (float*)(S + S_GDAB);
  const float* mu = p.rw_mu + (size_t)l * 896;
  const float* w0 = p.rw_w0 + (size_t)l * 512;
  const float* w_up = p.rw_w_up + (size_t)l * 2 * 32 * 256;
  const float* a0 = p.rw_a0 + (size_t)l * 512;
  const float* a_up = p.rw_a_up + (size_t)l * 2 * 32 * 256;
  const float* g_up = p.rw_g_up + (size_t)l * 64 * 256;
  const float* k_k = p.rw_k_k + (size_t)l * 256;
  const float* k_a = p.rw_k_a + (size_t)l * 256;
  const float* r_k = p.rw_r_k + (size_t)l * 256;
  const float* conv_w = p.gd_conv_w + (size_t)l * 5 * 768;
  const float* A_log = p.gd_A_log + (size_t)l * 8;
  const float* dt_bias = p.gd_dt_bias + (size_t)l * 8;
  const float* qg = p.na_q_gain + (size_t)l * 64;
  const float* kg = p.na_k_gain + (size_t)l * 64;

  float* rw = (float*)smem;
  float* lor = rw + 16 * 768;
  float* gd = rw;

  for (int tile = bid; tile < NTOK / 16; tile += nb) {
    const int m0 = tile * 16;
    int seq_lo, seq_hi;
    int bb, tau0;
    if (m0 < NLAT) { bb = m0 >> 14; seq_lo = bb << 14; seq_hi = seq_lo + SEQ; tau0 = m0 - seq_lo; }
    else { bb = (m0 - NLAT) >> 8; seq_lo = NLAT + (bb << 8); seq_hi = seq_lo + CTXL; tau0 = SEQ + (m0 - seq_lo); }

    for (int c = tid; c < 896; c += NTHR) {
      float pv[18];
#pragma unroll
      for (int t = 0; t < 18; ++t) {
        const int m = m0 - 1 + t;
        pv[t] = (m >= seq_lo && m < seq_hi) ? P[(size_t)m * PINP + A_END + c] : 0.f;
      }
      const float muc = mu[c];
#pragma unroll
      for (int t = 0; t < 16; ++t) {
        const float cur = pv[t + 1];
        const float v = cur + muc * (0.5f * (pv[t] + pv[t + 2]) - cur);
        if (c < 768) rw[t * 768 + c] = v;
        else if (c < 800) lor[(c - 768) * 16 + t] = tanhf(v);
        else if (c < 832) lor[(32 + c - 800) * 16 + t] = v;
        else lor[(64 + c - 832) * 16 + t] = sigmoidf_(v);
      }
    }
    __syncthreads();
    {
      const int c = tid & 255, th = tid >> 8;
      const float kkc = k_k[c], kac = k_a[c], rkc = r_k[c];
      const float w00 = w0[c], w01 = w0[256 + c], a00 = a0[c], a01 = a0[256 + c];
      const int h = c >> 6;
#pragma unroll 1
      for (int ps = 0; ps < 2; ++ps) {
        const int tb = th * 8 + ps * 4;
        float4 gacc = make_float4(0.f, 0.f, 0.f, 0.f), wa0 = gacc, wa1 = gacc, aa0 = gacc, aa1 = gacc;
#pragma unroll 8
        for (int j = 0; j < 64; ++j) {
          float wgt = g_up[j * 256 + c];
          float4 s0 = *(const float4*)(lor + (64 + j) * 16 + tb);
          gacc.x += s0.x * wgt; gacc.y += s0.y * wgt; gacc.z += s0.z * wgt; gacc.w += s0.w * wgt;
        }
#pragma unroll 8
        for (int j = 0; j < 32; ++j) {
          float4 t0 = *(const float4*)(lor + j * 16 + tb);
          float4 d0 = *(const float4*)(lor + (32 + j) * 16 + tb);
          float ww0 = w_up[j * 256 + c], ww1 = w_up[(32 + j) * 256 + c];
          float aw0 = a_up[j * 256 + c], aw1 = a_up[(32 + j) * 256 + c];
          wa0.x += t0.x * ww0; wa0.y += t0.y * ww0; wa0.z += t0.z * ww0; wa0.w += t0.w * ww0;
          wa1.x += t0.x * ww1; wa1.y += t0.y * ww1; wa1.z += t0.z * ww1; wa1.w += t0.w * ww1;
          aa0.x += d0.x * aw0; aa0.y += d0.y * aw0; aa0.z += d0.z * aw0; aa0.w += d0.w * aw0;
          aa1.x += d0.x * aw1; aa1.y += d0.y * aw1; aa1.z += d0.z * aw1; aa1.w += d0.w * aw1;
        }
#pragma unroll
        for (int t = 0; t < 4; ++t) {
          const int tt = tb + t;
          const int m = m0 + tt;
          const float gv = t == 0 ? gacc.x : t == 1 ? gacc.y : t == 2 ? gacc.z : gacc.w;
          const float wv0 = t == 0 ? wa0.x : t == 1 ? wa0.y : t == 2 ? wa0.z : wa0.w;
          const float wv1 = t == 0 ? wa1.x : t == 1 ? wa1.y : t == 2 ? wa1.z : wa1.w;
          const float av0 = t == 0 ? aa0.x : t == 1 ? aa0.y : t == 2 ? aa0.z : aa0.w;
          const float av1 = t == 0 ? aa1.x : t == 1 ? aa1.y : t == 2 ? aa1.z : aa1.w;
          float r = rw[tt * 768 + c], k = rw[tt * 768 + 256 + c], v = rw[tt * 768 + 512 + c];
          float kkraw = k * kkc;
          float ssum = wave_sum(kkraw * kkraw);
          float kk = kkraw * rsqrtf(ssum + 1e-6f);
          float bon = 0.f;
#pragma unroll
          for (int d = 0; d < 2; ++d) {
            float wl = (d == 0 ? w00 + wv0 : w01 + wv1);
            float w_log = -softplusf_(-wl) - 0.5f;
            float decay = __expf(-__expf(w_log));
            float a = sigmoidf_(d == 0 ? a00 + av0 : a01 + av1);
            float kd = k * (1.f + (a - 1.f) * kac);
            bon += r * kd * rkc;
            size_t o = ((size_t)d * NTOK + m) * 256 + c;
            RWW[o] = decay; RWKD[o] = kd; RWB[o] = kk * a;
          }
          bon = wave_sum(bon);
          size_t o = (size_t)m * 256 + c;
          RWR[o] = r; RWKK[o] = kk; RWV[o] = v; RWG[o] = gv;
          if (lane == 0) BON[(size_t)m * 4 + h] = bon;
        }
      }
    }
    __syncthreads();
    for (int c = tid; c < 768; c += NTHR) {
      float pv[20];
#pragma unroll
      for (int t = 0; t < 20; ++t) {
        const int m = m0 - 2 + t;
        pv[t] = (m >= seq_lo && m < seq_hi) ? P[(size_t)m * PINP + B_END + c] : 0.f;
      }
      float cw[5];
#pragma unroll
      for (int j = 0; j < 5; ++j) cw[j] = conv_w[j * 768 + c];
#pragma unroll
      for (int t = 0; t < 16; ++t) {
        float acc = 0.f;
#pragma unroll
        for (int j = 0; j < 5; ++j) acc += cw[j] * pv[t + j];
        gd[t * 768 + c] = siluf_(acc);
      }
    }
    __syncthreads();
    for (int wt = wv; wt < 16 * 12; wt += 8) {
      int t = wt / 12, hs = wt % 12;
      int m = m0 + t;
      float val = gd[t * 768 + hs * 64 + lane];
      if (hs < 8) {
        float ss = wave_sum(val * val);
        val *= rsqrtf(ss + 1e-6f);
        if (hs < 4) GDQ[(size_t)m * 256 + hs * 64 + lane] = val * 0.125f;
        else GDK[(size_t)m * 256 + (hs - 4) * 64 + lane] = val;
      } else GDV[(size_t)m * 256 + (hs - 8) * 64 + lane] = val;
    }
    if (tid < 256) {
      int t = tid >> 4, j = tid & 15;
      int m = m0 + t;
      float pv = P[(size_t)m * PINP + B_END + 1024 + j];
      float o;
      if (j < 8) o = __expf(-__expf(A_log[j]) * softplusf_(pv + dt_bias[j]));
      else o = sigmoidf_(pv);
      GDAB[(size_t)m * 16 + j] = o;
    }
    for (int base = 0; base < 32; base += 8) {
      float vals[8];
#pragma unroll
      for (int u = 0; u < 8; ++u) {
        const int wt = wv + (base + u) * 8;
        vals[u] = P[(size_t)(m0 + (wt >> 4)) * PINP + (wt & 15) * 64 + lane];
      }
#pragma unroll
      for (int u = 0; u < 8; ++u) {
        const int wt = wv + (base + u) * 8;
        const int t = wt >> 4, hs = wt & 15;
        const int m = m0 + t;
        float val = vals[u];
        float ss = wave_sum(val * val);
        val *= rsqrtf(ss * (1.f / 64.f) + 1e-6f);
        if (hs < 8) QN[(size_t)m * 512 + hs * 64 + lane] = f2bf(val * qg[lane] * (0.125f * 1.4426950408889634f));
        else KN[(size_t)m * 512 + (hs - 8) * 64 + lane] = f2bf(val * kg[lane]);
      }
    }
    {
      int hd = tid;
      bf16x8 o0, o1;
#pragma unroll
      for (int t = 0; t < 8; ++t) {
        o0[t] = (short)f2bf(P[(size_t)(m0 + t) * PINP + 1024 + hd]);
        o1[t] = (short)f2bf(P[(size_t)(m0 + 8 + t) * PINP + 1024 + hd]);
      }
      bfr* dst = VT + ((size_t)(bb * 512 + hd)) * TTOK + tau0;
      *(bf16x8*)dst = o0;
      *(bf16x8*)(dst + 8) = o1;
    }
    __syncthreads();
  }
}

#define SC_TB 32
__device__ __forceinline__ int scan_tok(int b, int d, int s) {
  if (s < CTXL) { int t = d ? (CTXL - 1 - s) : s; return NLAT + b * CTXL + t; }
  int u = s - CTXL; int t = d ? (SEQ - 1 - u) : u; return b * SEQ + t;
}
template <bool GDN>
__device__ void scan_chain(const Params& p, int b, int h, int d, int qtr, char* smem) {
  const int tid = tid_opaque(), lane = tid & 63, wv = wave_id(tid);
  char* S = p.ws + OFF_S;
  const float *src0, *src1, *src2, *src3, *src4, *xsrc;
  const float* ab = (const float*)(S + S_GDAB);
  float* Y;
  if (!GDN) {
    src0 = (const float*)(S + S_RWKK);
    src1 = (const float*)(S + S_RWW) + (size_t)d * NTOK * 256;
    src2 = (const float*)(S + S_RWB) + (size_t)d * NTOK * 256;
    src3 = (const float*)(S + S_RWKD) + (size_t)d * NTOK * 256;
    src4 = (const float*)(S + S_RWR);
    xsrc = (const float*)(S + S_RWV);
    Y = (float*)(S + S_YRW) + (size_t)d * NTOK * 256;
  } else {
    src0 = (const float*)(S + S_GDK);
    src1 = src0; src2 = src0; src3 = src0;
    src4 = (const float*)(S + S_GDQ);
    xsrc = (const float*)(S + S_GDV);
    Y = (float*)(S + S_YGD) + (size_t)d * NTOK * 256;
  }
  float* vec = (float*)smem;
  float* xs = vec + 5 * SC_TB * 64;
  float* sc = xs + SC_TB * 16;
  float* yb = sc + SC_TB * 2;
  const int rl = (wv & 3) * 4 + (lane >> 4);
  const int j4 = (lane & 15) * 4;
  float s0 = 0.f, s1 = 0.f, s2 = 0.f, s3 = 0.f;
  float4 rg0, rg1, rg2, rg3, rg4, rx;
  rg0 = rg1 = rg2 = rg3 = rg4 = rx = make_float4(0.f, 0.f, 0.f, 0.f);
  float rsc = 0.f;
  const int st_step = tid >> 4, st_part = tid & 15;
#define SCAN_ISSUE(batch)                                                                          \
  {                                                                                                \
    int m_ = scan_tok(b, d, (batch) * SC_TB + st_step);                                            \
    size_t o_ = (size_t)m_ * 256 + h * 64 + st_part * 4;                                           \
    rg0 = *(const float4*)(src0 + o_);                                                             \
    rg4 = *(const float4*)(src4 + o_);                                                             \
    if (!GDN) { rg1 = *(const float4*)(src1 + o_); rg2 = *(const float4*)(src2 + o_); rg3 = *(const float4*)(src3 + o_); } \
    if (tid < 128) {                                                                               \
      int m2_ = scan_tok(b, d, (batch) * SC_TB + (tid >> 2));                                      \
      rx = *(const float4*)(xsrc + (size_t)m2_ * 256 + h * 64 + qtr * 16 + (tid & 3) * 4);         \
    }                                                                                              \
    if (GDN && tid < 64) {                                                                         \
      int m3_ = scan_tok(b, d, (batch) * SC_TB + (tid >> 1));                                      \
      rsc = ab[(size_t)m3_ * 16 + (tid & 1) * 8 + d * 4 + h];                                      \
    }                                                                                              \
  }
#define SCAN_LOAD(st, KAP, R4, W4, B4, K4, X, AL, BE)                                              \
  {                                                                                                \
    KAP = *(const float4*)(vec + (0 * SC_TB + (st)) * 64 + j4);                                    \
    R4 = *(const float4*)(vec + (4 * SC_TB + (st)) * 64 + j4);                                     \
    X = xs[(st) * 16 + rl];                                                                        \
    if (!GDN) {                                                                                    \
      W4 = *(const float4*)(vec + (1 * SC_TB + (st)) * 64 + j4);                                   \
      B4 = *(const float4*)(vec + (2 * SC_TB + (st)) * 64 + j4);                                   \
      K4 = *(const float4*)(vec + (3 * SC_TB + (st)) * 64 + j4);                                   \
    } else { AL = sc[(st) * 2]; BE = sc[(st) * 2 + 1]; }                                           \
  }
  const int nbatch = TTOK / SC_TB;
  SCAN_ISSUE(0)
  for (int bt = 0; bt < nbatch; ++bt) {
    __syncthreads();
    *(float4*)(vec + (0 * SC_TB + st_step) * 64 + st_part * 4) = rg0;
    *(float4*)(vec + (4 * SC_TB + st_step) * 64 + st_part * 4) = rg4;
    if (!GDN) {
      *(float4*)(vec + (1 * SC_TB + st_step) * 64 + st_part * 4) = rg1;
      *(float4*)(vec + (2 * SC_TB + st_step) * 64 + st_part * 4) = rg2;
      *(float4*)(vec + (3 * SC_TB + st_step) * 64 + st_part * 4) = rg3;
    }
    if (tid < 128) *(float4*)(xs + (tid >> 2) * 16 + (tid & 3) * 4) = rx;
    if (GDN && tid < 64) sc[tid] = rsc;
    __syncthreads();
    if (bt + 1 < nbatch) SCAN_ISSUE(bt + 1)
    if (wv < 4) {
      float4 kapA, r4A, w4A, b4A, k4A, kapB, r4B, w4B, b4B, k4B;
      float xA, alA = 0.f, beA = 0.f, xB, alB = 0.f, beB = 0.f;
      w4A = b4A = k4A = w4B = b4B = k4B = make_float4(0.f, 0.f, 0.f, 0.f);
      SCAN_LOAD(0, kapA, r4A, w4A, b4A, k4A, xA, alA, beA)
#pragma unroll
      for (int st = 0; st < SC_TB; ++st) {
        if (st + 1 < SC_TB) SCAN_LOAD(st + 1, kapB, r4B, w4B, b4B, k4B, xB, alB, beB)
        float dp = (s0 * kapA.x + s1 * kapA.y) + (s2 * kapA.z + s3 * kapA.w);
        float dd = row16_sum(dp);
        if (!GDN) {
          s0 = (s0 * w4A.x + xA * k4A.x) - dd * b4A.x;
          s1 = (s1 * w4A.y + xA * k4A.y) - dd * b4A.y;
          s2 = (s2 * w4A.z + xA * k4A.z) - dd * b4A.z;
          s3 = (s3 * w4A.w + xA * k4A.w) - dd * b4A.w;
        } else {
          float cf = beA * (xA - alA * dd);
          s0 = alA * s0 + cf * kapA.x;
          s1 = alA * s1 + cf * kapA.y;
          s2 = alA * s2 + cf * kapA.z;
          s3 = alA * s3 + cf * kapA.w;
        }
        float yp = (s0 * r4A.x + s1 * r4A.y) + (s2 * r4A.z + s3 * r4A.w);
        float yy = row16_sum(yp);
        if ((lane & 15) == 0) yb[st * 16 + rl] = yy;
        kapA = kapB; r4A = r4B; w4A = w4B; b4A = b4B; k4A = k4B; xA = xB; alA = alB; beA = beB;
      }
    }
    __syncthreads();
    {
      int st = tid >> 4, r = tid & 15;
      int m = scan_tok(b, d, bt * SC_TB + st);
      Y[(size_t)m * 256 + h * 64 + qtr * 16 + r] = yb[tid];
    }
  }
  __syncthreads();
#undef SCAN_ISSUE
#undef SCAN_LOAD
}

__device__ __forceinline__ void na_pair(const bfr* KN, const bfr* VT, const bf16x8 qf0, const bf16x8 qf1,
                                        int mk0, int mk1, size_t vt_base, int tau0, int tau1, int h, int lane,
                                        bool local, int kr0, int kr1, int ct0, int ct1, int qr, int qc, const float* bias_h,
                                        f32x4 (&O)[4], float& lsum) {
  const int fr = lane & 15, fq = lane >> 4;
  const bf16x8 k00 = *(const bf16x8*)(KN + (size_t)(mk0 + fr) * 512 + h * 64 + fq * 8);
  const bf16x8 k01 = *(const bf16x8*)(KN + (size_t)(mk0 + fr) * 512 + h * 64 + 32 + fq * 8);
  const bf16x8 k10 = *(const bf16x8*)(KN + (size_t)(mk1 + fr) * 512 + h * 64 + fq * 8);
  const bf16x8 k11 = *(const bf16x8*)(KN + (size_t)(mk1 + fr) * 512 + h * 64 + 32 + fq * 8);
  f32x4 z = {0.f, 0.f, 0.f, 0.f};
  f32x4 st0 = __builtin_amdgcn_mfma_f32_16x16x32_bf16(k00, qf0, z, 0, 0, 0);
  st0 = __builtin_amdgcn_mfma_f32_16x16x32_bf16(k01, qf1, st0, 0, 0, 0);
  f32x4 st1 = __builtin_amdgcn_mfma_f32_16x16x32_bf16(k10, qf0, z, 0, 0, 0);
  st1 = __builtin_amdgcn_mfma_f32_16x16x32_bf16(k11, qf1, st1, 0, 0, 0);
  bf16x8 pf;
  if (local) {
    int cs = min(max(qc - 8, 0), 48);
#pragma unroll
    for (int r = 0; r < 4; ++r) {
      int kc0 = ct0 * 16 + fq * 4 + r;
      int kc1 = ct1 * 16 + fq * 4 + r;
      float p0 = 0.f, p1 = 0.f;
      if ((unsigned)(kc0 - cs) < 16u) p0 = exp2f(st0[r] + bias_h[(kr0 - qr + 7) * 31 + (kc0 - qc + 15)]);
      if ((unsigned)(kc1 - cs) < 16u) p1 = exp2f(st1[r] + bias_h[(kr1 - qr + 7) * 31 + (kc1 - qc + 15)]);
      lsum += p0 + p1;
      pf[r] = (short)f2bf(p0);
      pf[4 + r] = (short)f2bf(p1);
    }
  } else {
#pragma unroll
    for (int r = 0; r < 4; ++r) {
      float p0 = exp2f(st0[r]), p1 = exp2f(st1[r]);
      lsum += p0 + p1;
      pf[r] = (short)f2bf(p0);
      pf[4 + r] = (short)f2bf(p1);
    }
  }
#pragma unroll
  for (int dt = 0; dt < 4; ++dt) {
    const bfr* vrow = VT + vt_base + (size_t)(dt * 16 + fr) * TTOK;
    bf16x4 v0 = *(const bf16x4*)(vrow + tau0 + fq * 4);
    bf16x4 v1 = *(const bf16x4*)(vrow + tau1 + fq * 4);
    bf16x8 vf;
    vf[0] = v0[0]; vf[1] = v0[1]; vf[2] = v0[2]; vf[3] = v0[3];
    vf[4] = v1[0]; vf[5] = v1[1]; vf[6] = v1[2]; vf[7] = v1[3];
    O[dt] = __builtin_amdgcn_mfma_f32_16x16x32_bf16(vf, pf, O[dt], 0, 0, 0);
  }
}

__device__ void na_block_task(const Params& p, int task, const float* bias_lds) {
  const int tid = tid_opaque(), lane = tid & 63, wv = wave_id(tid);
  const int fr = lane & 15, fq = lane >> 4;
  char* S = p.ws + OFF_S;
  const bfr* QN = (const bfr*)(S + S_QN);
  const bfr* KN = (const bfr*)(S + S_KN);
  const bfr* VT = (const bfr*)(S + S_VT);
  bfr* CC = (bfr*)(p.ws + OFF_CC);
  int b, h, mq0;
  bool latent = task < 2048;
  int qr = 0, cgp = 0;
  if (latent) {
    h = task & 7; int rp = (task >> 3) & 127; b = task >> 10;
    qr = rp * 2 + (wv >> 2); cgp = wv & 3;
    mq0 = b * SEQ + qr * 64 + cgp * 16;
  } else {
    int u = task - 2048;
    int half = u & 1; h = (u >> 1) & 7; b = u >> 4;
    mq0 = NLAT + b * CTXL + (half * 8 + wv) * 16;
  }
  const bf16x8 qf0 = *(const bf16x8*)(QN + (size_t)(mq0 + fr) * 512 + h * 64 + fq * 8);
  const bf16x8 qf1 = *(const bf16x8*)(QN + (size_t)(mq0 + fr) * 512 + h * 64 + 32 + fq * 8);
  f32x4 O[4];
#pragma unroll
  for (int dt = 0; dt < 4; ++dt) O[dt] = (f32x4){0.f, 0.f, 0.f, 0.f};
  float lsum = 0.f;
  const size_t vt_base = (size_t)(b * 8 + h) * 64 * TTOK;
  if (latent) {
    const int rs = min(max(qr - 4, 0), SEQ / 64 - 8);
    const int ct_first = (cgp <= 1) ? 0 : cgp - 1;
    const int nct = (cgp == 0 || cgp == 3) ? 2 : 3;
    const int npair = 4 * nct;
    const int qc = cgp * 16 + fr;
    for (int pi = 0; pi < npair; ++pi) {
      int i0 = 2 * pi, i1 = 2 * pi + 1;
      int kr0 = rs + i0 / nct, c0 = ct_first + i0 % nct;
      int kr1 = rs + i1 / nct, c1 = ct_first + i1 % nct;
      int t0 = kr0 * 64 + c0 * 16, t1 = kr1 * 64 + c1 * 16;
      na_pair(KN, VT, qf0, qf1, b * SEQ + t0, b * SEQ + t1, vt_base, t0, t1, h, lane, true, kr0, kr1, c0, c1, qr, qc,
              bias_lds + h * 465, O, lsum);
    }
  }
  for (int pi = 0; pi < 8; ++pi) {
    int t0 = pi * 32, t1 = pi * 32 + 16;
    na_pair(KN, VT, qf0, qf1, NLAT + b * CTXL + t0, NLAT + b * CTXL + t1, vt_base, SEQ + t0, SEQ + t1, h, lane, false,
            0, 0, 0, 0, 0, 0, bias_lds, O, lsum);
  }
  lsum += __shfl_xor(lsum, 16, 64);
  lsum += __shfl_xor(lsum, 32, 64);
  float inv = 1.f / lsum;
#pragma unroll
  for (int dt = 0; dt < 4; ++dt) {
    bf16x4 o;
#pragma unroll
    for (int r = 0; r < 4; ++r) o[r] = (short)f2bf(O[dt][r] * inv);
    *(bf16x4*)(CC + (size_t)(mq0 + fr) * 1024 + h * 64 + dt * 16 + fq * 4) = o;
  }
}

__device__ void phase_mix(const Params& p, int l, int bid, int nb, char* smem) {
  const int tid = tid_opaque();
  const int nscan_blocks = (nb > 128) ? 128 : nb;
  const int first_attn_block = (nb > 128) ? 128 : 0;
  if (bid < nscan_blocks) {
    for (int c = bid; c < 128; c += nscan_blocks) {
      int qtr = c & 3, d = (c >> 2) & 1, h = (c >> 3) & 3, b = (c >> 5) & 1, ty = (c >> 6) & 1;
      if (ty == 0) scan_chain<false>(p, b, h, d, qtr, smem);
      else scan_chain<true>(p, b, h, d, qtr, smem);
    }
  }
  if (bid >= first_attn_block) {
    float* bias = (float*)smem;
    __syncthreads();
    for (int i = tid; i < 8 * 465; i += NTHR) bias[i] = p.na_rpb[(size_t)l * 8 * 465 + i] * 1.4426950408889634f;
    __syncthreads();
    const int ntask = (l == 0) ? 2048 + 32 : 2048;
    const int nab = nb - first_attn_block;
    for (int t = bid - first_attn_block; t < ntask; t += nab) na_block_task(p, t, bias);
  }
}

__device__ void phase_post(const Params& p, int l, int bid, int nb) {
  const int tid = tid_opaque(), lane = tid & 63, wv = wave_id(tid);
  char* S = p.ws + OFF_S;
  const float* YRW = (const float*)(S + S_YRW);
  const float* YGD = (const float*)(S + S_YGD);
  const float* RWV = (const float*)(S + S_RWV);
  const float* RWG = (const float*)(S + S_RWG);
  const float* BON = (const float*)(S + S_BON);
  const float* P = (const float*)(p.ws + OFF_P);
  bfr* CC = (bfr*)(p.ws + OFF_CC);
  const float* ln_w = p.rw_ln_w + (size_t)l * 256;
  const float* ln_b = p.rw_ln_b + (size_t)l * 256;
  const float* ng = p.gd_norm_g + (size_t)l * 64;
  const int ntok = (l == 0) ? NTOK : NLAT;
  for (int wt = bid * 8 + wv; wt < ntok * 8; wt += nb * 8) {
    int m = wt >> 3, hs = wt & 7;
    if (hs < 4) {
      int c = hs * 64 + lane;
      size_t o = (size_t)m * 256 + c;
      float y = YRW[o] + YRW[(size_t)NTOK * 256 + o];
      float mean = wave_sum(y) * (1.f / 64.f);
      float dv = y - mean;
      float var = wave_sum(dv * dv) * (1.f / 64.f);
      float yn = dv * rsqrtf(var + 64e-5f) * ln_w[c] + ln_b[c];
      float out = (yn + BON[(size_t)m * 4 + hs] * RWV[o]) * RWG[o];
      CC[(size_t)m * 1024 + 512 + c] = f2bf(out);
    } else {
      int c = (hs - 4) * 64 + lane;
      size_t o = (size_t)m * 256 + c;
      float y = YGD[o] + YGD[(size_t)NTOK * 256 + o];
      float ms = wave_sum(y * y) * (1.f / 64.f);
      float z = P[(size_t)m * PINP + B_END + 768 + c];
      float out = y * rsqrtf(ms + 1e-6f) * ng[lane] * siluf_(z);
      CC[(size_t)m * 1024 + 768 + c] = f2bf(out);
    }
  }
}

#define RW_LDS_ROW 36
__device__ void phase_router(const Params& p, int l, int bid, int nb, char* smem) {
  const int tid = tid_opaque(), lane = tid & 63, wv = wave_id(tid);
  const float* xl = p.out;
  const float* xc = (const float*)(p.ws + OFF_CTX);
  const float* mods = (const float*)(p.ws + OFF_MODS) + (size_t)l * 3 * 6144;
  const float* g = p.norm_ffn_g + (size_t)l * 1024;
  const float* rw = p.moe_router_w + (size_t)l * 1024 * 32;
  const float* rb = p.moe_router_b + (size_t)l * 32;
  bfr* H = (bfr*)(p.ws + OFF_H);
  int* cnt = (int*)(p.ws + OFF_CNT);
  int* TOKE = (int*)(p.ws + OFF_TOKE);
  int* TOKP = (int*)(p.ws + OFF_TOKP);
  float* TOKG = (float*)(p.ws + OFF_TOKG);
  float* wl = (float*)smem;
  for (int i = tid; i < 1024 * 8; i += NTHR) {
    int d = i >> 3, q = i & 7;
    *(float4*)(wl + d * RW_LDS_ROW + q * 4) = *(const float4*)(rw + (size_t)d * 32 + q * 4);
  }
  __syncthreads();
  const int ntok = (l == 0) ? NTOK : NLAT;
  const float rbl = rb[lane & 31];
  for (int m0 = (bid * 8 + wv) * 2; m0 < ntok; m0 += nb * 16) {
    float acc0[32], acc1[32];
#pragma unroll
    for (int e = 0; e < 32; ++e) { acc0[e] = 0.f; acc1[e] = 0.f; }
    float hv0[16], hv1[16];
    {
      const int ma = m0, mb = m0 + 1;
      const float* xa = (ma < NLAT) ? xl + (size_t)ma * 1024 : xc + (size_t)(ma - NLAT) * 1024;
      const float* xb = (mb < NLAT) ? xl + (size_t)mb * 1024 : xc + (size_t)(mb - NLAT) * 1024;
      const float* mda = mods + (size_t)mod_row(ma) * 6144 + 3072;
      const float* mdb = mods + (size_t)mod_row(mb) * 6144 + 3072;
      float ssa = 0.f, ssb = 0.f;
#pragma unroll
      for (int i = 0; i < 16; ++i) { hv0[i] = xa[lane + 64 * i]; hv1[i] = xb[lane + 64 * i]; }
#pragma unroll
      for (int i = 0; i < 16; ++i) { ssa += hv0[i] * hv0[i]; ssb += hv1[i] * hv1[i]; }
      ssa = wave_sum(ssa); ssb = wave_sum(ssb);
      const float rsa = rsqrtf(ssa * (1.f / 1024.f) + 1e-6f), rsb = rsqrtf(ssb * (1.f / 1024.f) + 1e-6f);
#pragma unroll
      for (int i = 0; i < 16; ++i) {
        const int d = lane + 64 * i;
        const float gg = g[d];
        hv0[i] = hv0[i] * rsa * gg * (1.f + mda[1024 + d]) + mda[d];
        hv1[i] = hv1[i] * rsb * gg * (1.f + mdb[1024 + d]) + mdb[d];
        H[(size_t)ma * 1024 + d] = f2bf(hv0[i]);
        H[(size_t)mb * 1024 + d] = f2bf(hv1[i]);
      }
    }
#pragma unroll
    for (int i = 0; i < 16; ++i) {
      const float* wr = wl + (lane + 64 * i) * RW_LDS_ROW;
#pragma unroll
      for (int q = 0; q < 8; ++q) {
        const float4 w = *(const float4*)(wr + q * 4);
        acc0[q * 4 + 0] += hv0[i] * w.x; acc0[q * 4 + 1] += hv0[i] * w.y; acc0[q * 4 + 2] += hv0[i] * w.z; acc0[q * 4 + 3] += hv0[i] * w.w;
        acc1[q * 4 + 0] += hv1[i] * w.x; acc1[q * 4 + 1] += hv1[i] * w.y; acc1[q * 4 + 2] += hv1[i] * w.z; acc1[q * 4 + 3] += hv1[i] * w.w;
      }
    }
#define BFLY(A, N, D)                                                                           \
    _Pragma("unroll") for (int i = 0; i < (N); ++i) {                                            \
      const bool up = (lane & (D)) != 0;                                                         \
      const float keep = up ? A[i + (N)] : A[i];                                                 \
      const float send = up ? A[i] : A[i + (N)];                                                 \
      A[i] = keep + __shfl_xor(send, (D), 64);                                                   \
    }
    BFLY(acc0, 16, 16) BFLY(acc1, 16, 16)
    BFLY(acc0, 8, 8) BFLY(acc1, 8, 8)
    BFLY(acc0, 4, 4) BFLY(acc1, 4, 4)
    BFLY(acc0, 2, 2) BFLY(acc1, 2, 2)
    BFLY(acc0, 1, 1) BFLY(acc1, 1, 1)
#undef BFLY
    float la = acc0[0] + __shfl_xor(acc0[0], 32, 64);
    float lb = acc1[0] + __shfl_xor(acc1[0], 32, 64);
    const int my_e = lane & 31;
    la += rbl; lb += rbl;
    (void)my_e;
#pragma unroll
    for (int tkn = 0; tkn < 2; ++tkn) {
      float v = tkn == 0 ? la : lb;
      float tv[4]; int ti[4];
#pragma unroll
      for (int k = 0; k < 4; ++k) {
        float bv = v; int bi = lane & 31;
#pragma unroll
        for (int o = 16; o >= 1; o >>= 1) {
          float ov = __shfl_xor(bv, o, 64); int oi = __shfl_xor(bi, o, 64);
          bool take = (ov > bv) || (ov == bv && oi < bi);
          bv = take ? ov : bv; bi = take ? oi : bi;
        }
        tv[k] = bv; ti[k] = bi;
        if ((lane & 31) == bi) v = -3.0e38f;
      }
      float e1 = __expf(tv[1] - tv[0]), e2 = __expf(tv[2] - tv[0]), e3 = __expf(tv[3] - tv[0]);
      float inv = 1.f / (1.f + e1 + e2 + e3);
      const int m = m0 + tkn;
      if (lane < 4) {
        int e = lane == 0 ? ti[0] : lane == 1 ? ti[1] : lane == 2 ? ti[2] : ti[3];
        float gt = (lane == 0 ? 1.f : lane == 1 ? e1 : lane == 2 ? e2 : e3) * inv;
        int pos = atomicAdd(&cnt[e], 1);
        TOKE[(size_t)m * 4 + lane] = e; TOKP[(size_t)m * 4 + lane] = pos; TOKG[(size_t)m * 4 + lane] = gt;
      }
    }
  }
  __syncthreads();
}

__device__ __forceinline__ void moe_offsets(const Params& p, int* toff) {
  const int* cnt = (const int*)(p.ws + OFF_CNT);
  if (tid_opaque() == 0) {
    int a = 0;
    for (int e = 0; e < 32; ++e) { toff[e] = a; a += (cnt[e] + 255) >> 8; }
    toff[32] = a;
  }
  __syncthreads();
}

__device__ void phase_slotfill(const Params& p, int l, int bid, int nb, char* smem) {
  int* toff = (int*)smem;
  moe_offsets(p, toff);
  const int tid = tid_opaque(), lane = tid & 63, wv = wave_id(tid);
  const int* TOKE = (const int*)(p.ws + OFF_TOKE);
  const int* TOKP = (const int*)(p.ws + OFF_TOKP);
  const float* TOKG = (const float*)(p.ws + OFF_TOKG);
  const int* cnt = (const int*)(p.ws + OFF_CNT);
  int* TOKS = (int*)(p.ws + OFF_TOKS);
  float* SLG = (float*)(p.ws + OFF_SLG);
  const bfr* H = (const bfr*)(p.ws + OFF_H);
  bfr* XG = (bfr*)(p.ws + OFF_S);
  const int n = ((l == 0) ? NTOK : NLAT) * 4;
  for (int i = bid * 8 + wv; i < n; i += nb * 8) {
    int e = TOKE[i];
    int slot = toff[e] * 256 + TOKP[i];
    if (lane == 0) { TOKS[i] = slot; SLG[slot] = TOKG[i]; }
    const uint4* src = (const uint4*)(H + (size_t)(i >> 2) * 1024);
    uint4* dst = (uint4*)(XG + (size_t)slot * 1024);
    dst[lane] = src[lane];
    dst[lane + 64] = src[lane + 64];
  }
  for (int e = 0; e < 32; ++e) {
    const int c = cnt[e];
    const int npad = ((c + 255) & ~255) - c;
    const int base = toff[e] * 256 + c;
    for (int r = bid * 8 + wv; r < npad; r += nb * 8) {
      uint4* dst = (uint4*)(XG + (size_t)(base + r) * 1024);
      dst[lane] = make_uint4(0u, 0u, 0u, 0u);
      dst[lane + 64] = make_uint4(0u, 0u, 0u, 0u);
    }
  }
  __syncthreads();
}

struct EpiMoe1 {
  const float* bgu; bfr* ACT;
  __device__ __forceinline__ void operator()(const f32x4 (&acc)[2][2][4][2], const g8::GUnit& u, int wr, int wc, int fr, int fq) const {
    const float* be = bgu + (size_t)u.e * 2048;
    const int slot0 = u.pm * 256 + wr * 64 + fr;
#pragma unroll
    for (int bj = 0; bj < 2; ++bj) {
      const int j0 = u.pn * 128 + bj * 64 + wc * 16 + 4 * fq;
      const f32x4 bg = *(const f32x4*)(be + j0), bl = *(const f32x4*)(be + 1024 + j0);
#pragma unroll
      for (int ai = 0; ai < 2; ++ai)
#pragma unroll
        for (int m = 0; m < 4; ++m) {
          const f32x4 g = acc[ai][bj][m][0] + bg, li = acc[ai][bj][m][1] + bl;
          bf16x4 o;
#pragma unroll
          for (int q = 0; q < 4; ++q) {
            float gv = fminf(g[q], 7.f);
            float lv = fminf(fmaxf(li[q], -7.f), 7.f);
            o[q] = (short)f2bf(gv * sigmoidf_(1.702f * gv) * (lv + 1.f));
          }
          *(bf16x4*)(ACT + (size_t)(slot0 + ai * 128 + m * 16) * 1024 + j0) = o;
        }
    }
  }
};
__device__ void phase_moe1_impl(const Params& p, int l, int bid, int nb, char* smem, int* toff) {
  moe_offsets(p, toff);
  g8::MoeSched S{toff, 8, 2048, nb, bid};
  EpiMoe1 E{p.moe_b_gu + (size_t)l * 32 * 2048, (bfr*)(p.ws + OFF_P)};
  g8::gemm_stream((LAS unsigned char*)smem, (const bfr*)(p.ws + OFF_S), (const bfr*)(p.ws + OFF_W + (size_t)l * WL_SIZE + WL_GU), S, E);
}

struct EpiMoe2 {
  const float* bdn; const float* SLG; float* YS;
  __device__ __forceinline__ void operator()(const f32x4 (&acc)[2][2][4][2], const g8::GUnit& u, int wr, int wc, int fr, int fq) const {
    const float* be = bdn + (size_t)u.e * 1024;
    const int slot0 = u.pm * 256 + wr * 64 + fr, col0 = u.pn * 256 + wc * 32 + 4 * fq;
#pragma unroll
    for (int ai = 0; ai < 2; ++ai)
#pragma unroll
      for (int m = 0; m < 4; ++m) {
        const int slot = slot0 + ai * 128 + m * 16;
        const float gt = SLG[slot];
#pragma unroll
        for (int bj = 0; bj < 2; ++bj)
#pragma unroll
          for (int n = 0; n < 2; ++n) {
            const f32x4 bv = *(const f32x4*)(be + col0 + bj * 128 + n * 16);
            *(f32x4*)(YS + (size_t)slot * 1024 + col0 + bj * 128 + n * 16) = (acc[ai][bj][m][n] + bv) * gt;
          }
      }
  }
};
__device__ void phase_moe2_impl(const Params& p, int l, int bid, int nb, char* smem, int* toff) {
  moe_offsets(p, toff);
  g8::MoeSched S{toff, 4, 1024, nb, bid};
  EpiMoe2 E{p.moe_b_down + (size_t)l * 32 * 1024, (const float*)(p.ws + OFF_SLG), (float*)(p.ws + OFF_S)};
  g8::gemm_stream((LAS unsigned char*)smem, (const bfr*)(p.ws + OFF_P), (const bfr*)(p.ws + OFF_W + (size_t)l * WL_SIZE + WL_DN), S, E);
}

__device__ void phase_combine(const Params& p, int l, int bid, int nb) {
  const int tid = tid_opaque(), lane = tid & 63, wv = wave_id(tid);
  const float* YS = (const float*)(p.ws + OFF_S);
  const int* TOKS = (const int*)(p.ws + OFF_TOKS);
  const float* mods = (const float*)(p.ws + OFF_MODS) + (size_t)l * 3 * 6144;
  float* xl = p.out;
  float* xc = (float*)(p.ws + OFF_CTX);
  const int ntok = (l == 0) ? NTOK : NLAT;
  for (int m = bid * 8 + wv; m < ntok; m += nb * 8) {
    float* xr = (m < NLAT) ? xl + (size_t)m * 1024 : xc + (size_t)(m - NLAT) * 1024;
    const float* g2 = mods + (size_t)mod_row(m) * 6144 + 5120;
    int s0 = TOKS[(size_t)m * 4], s1 = TOKS[(size_t)m * 4 + 1], s2 = TOKS[(size_t)m * 4 + 2], s3 = TOKS[(size_t)m * 4 + 3];
#pragma unroll
    for (int i = 0; i < 4; ++i) {
      int d = (lane + 64 * i) * 4;
      float4 a = *(const float4*)(YS + (size_t)s0 * 1024 + d);
      float4 b = *(const float4*)(YS + (size_t)s1 * 1024 + d);
      float4 c = *(const float4*)(YS + (size_t)s2 * 1024 + d);
      float4 e = *(const float4*)(YS + (size_t)s3 * 1024 + d);
      float4 gg = *(const float4*)(g2 + d);
      float4 xv = *(const float4*)(xr + d);
      xv.x += gg.x * (a.x + b.x + c.x + e.x);
      xv.y += gg.y * (a.y + b.y + c.y + e.y);
      xv.z += gg.z * (a.z + b.z + c.z + e.z);
      xv.w += gg.w * (a.w + b.w + c.w + e.w);
      *(float4*)(xr + d) = xv;
    }
  }
}

extern __shared__ __attribute__((aligned(16))) char dyn_smem[];

__global__ void __launch_bounds__(NTHR) mega(Params p) {
  cg::grid_group grid = cg::this_grid();
  const int bid0 = blockIdx.x, nb0 = gridDim.x;
#define bid opq(bid0)
#define nb opq(nb0)
  int* toff_s = (int*)(dyn_smem + 147456);
  phase_ada(p, bid, nb, dyn_smem);
  phase_convert(p, 0, bid, nb, dyn_smem);
  phase_convert(p, 1, bid, nb, dyn_smem);
  grid.sync();
  for (int l0 = 0; l0 < 2; ++l0) {
#define l opq(l0)
    phase_prenorm(p, l, bid, nb);
    grid.sync();
    phase_gemm_in(p, l, bid, nb, dyn_smem);
    grid.sync();
    phase_prep(p, l, bid, nb, dyn_smem);
    grid.sync();
    phase_mix(p, l, bid, nb, dyn_smem);
    grid.sync();
    phase_post(p, l, bid, nb);
    grid.sync();
    phase_gemm_out(p, l, bid, nb, dyn_smem);
    grid.sync();
    phase_router(p, l, bid, nb, dyn_smem);
    grid.sync();
    phase_slotfill(p, l, bid, nb, dyn_smem);
    grid.sync();
    phase_moe1_impl(p, l, bid, nb, dyn_smem, toff_s);
    grid.sync();
    phase_moe2_impl(p, l, bid, nb, dyn_smem, toff_s);
    grid.sync();
    phase_combine(p, l, bid, nb);
    if (l0 == 0) grid.sync();
  }
#undef l
#undef bid
#undef nb
}

extern "C" void kernel_launch(void* const* d_in, const int* in_sizes, int n_in, void* d_out, int out_size, void* d_ws,
                              size_t ws_size, hipStream_t stream) {
  Params p{};
  const float** pp = (const float**)&p;
  for (int i = 0; i < 34; ++i) pp[i] = (const float*)d_in[i];
  p.out = (float*)d_out;
  p.ws = (char*)d_ws;
  static int grid_blocks = 0;
  if (!grid_blocks) {
    (void)hipFuncSetAttribute((const void*)mega, hipFuncAttributeMaxDynamicSharedMemorySize, LDS_BYTES);
    int dev = 0, cus = 0, per_cu = 0;
    (void)hipGetDevice(&dev);
    (void)hipDeviceGetAttribute(&cus, hipDeviceAttributeMultiprocessorCount, dev);
    (void)hipOccupancyMaxActiveBlocksPerMultiprocessor(&per_cu, mega, NTHR, LDS_BYTES);
    if (per_cu < 1) per_cu = 1;
    if (per_cu > 1) per_cu = 1;
    grid_blocks = cus * per_cu;
  }
  void* args[] = {&p};
  (void)hipLaunchCooperativeKernel((void*)mega, dim3(grid_blocks), dim3(NTHR), args, LDS_BYTES, stream);
}
```

```cpp
#include <hip/hip_runtime.h>
#include <hip/hip_bf16.h>
#include <hip/hip_cooperative_groups.h>
#include <stdint.h>
namespace cg = cooperative_groups;

typedef __attribute__((ext_vector_type(8))) short bf16x8;
typedef __attribute__((ext_vector_type(4))) short bf16x4;
typedef __attribute__((ext_vector_type(4))) float f32x4;
typedef unsigned short bfr;

#define D_MODEL 1024
#define NB 2
#define SEQ 16384
#define CTXL 256
#define NLAT (NB * SEQ)
#define NCTX (NB * CTXL)
#define NTOK (NLAT + NCTX)
#define TTOK (SEQ + CTXL)
#define PIN 3472
#define PINP 3584
#define A_END 1536
#define B_END 2432
#define NEXP 32
#define NSLOT_MAX (NTOK * 4 + NEXP * 256)
#define NTHR 512
#define LDS_BYTES (147456 + 512)

constexpr size_t al256(size_t x) { return (x + 255) & ~(size_t)255; }
constexpr size_t WL_IN = 0;
constexpr size_t WL_OUT = WL_IN + (size_t)PINP * 1024 * 2;
constexpr size_t WL_GU = WL_OUT + (size_t)1024 * 1024 * 2;
constexpr size_t WL_DN = WL_GU + (size_t)32 * 2048 * 1024 * 2;
constexpr size_t WL_SIZE = WL_DN + (size_t)32 * 1024 * 1024 * 2;
constexpr size_t OFF_W = 0;
constexpr size_t OFF_MODS = al256(OFF_W + 2 * WL_SIZE);
constexpr size_t OFF_CTX = al256(OFF_MODS + 2 * 3 * 6144 * 4);
constexpr size_t OFF_CNT = al256(OFF_CTX + (size_t)NCTX * 1024 * 4);
constexpr size_t OFF_TOKE = al256(OFF_CNT + 256);
constexpr size_t OFF_TOKP = al256(OFF_TOKE + (size_t)NTOK * 4 * 4);
constexpr size_t OFF_TOKG = al256(OFF_TOKP + (size_t)NTOK * 4 * 4);
constexpr size_t OFF_TOKS = al256(OFF_TOKG + (size_t)NTOK * 4 * 4);
constexpr size_t OFF_SLT = al256(OFF_TOKS + (size_t)NTOK * 4 * 4);
constexpr size_t OFF_SLG = al256(OFF_SLT + (size_t)NSLOT_MAX * 4);
constexpr size_t OFF_H = al256(OFF_SLG + (size_t)NSLOT_MAX * 4);
constexpr size_t OFF_CC = al256(OFF_H + (size_t)NTOK * 1024 * 2);
constexpr size_t OFF_P = al256(OFF_CC + (size_t)NTOK * 1024 * 2);
constexpr size_t OFF_S = al256(OFF_P + (size_t)NTOK * PINP * 4);
constexpr size_t TOK256F = (size_t)NTOK * 256 * 4;
constexpr size_t S_QN = 0;
constexpr size_t S_KN = S_QN + (size_t)NTOK * 512 * 2;
constexpr size_t S_VT = S_KN + (size_t)NTOK * 512 * 2;
constexpr size_t S_RWR = S_VT + (size_t)NB * 8 * 64 * TTOK * 2;
constexpr size_t S_RWKK = S_RWR + TOK256F;
constexpr size_t S_RWV = S_RWKK + TOK256F;
constexpr size_t S_RWG = S_RWV + TOK256F;
constexpr size_t S_RWW = S_RWG + TOK256F;
constexpr size_t S_RWKD = S_RWW + 2 * TOK256F;
constexpr size_t S_RWB = S_RWKD + 2 * TOK256F;
constexpr size_t S_BON = S_RWB + 2 * TOK256F;
constexpr size_t S_GDQ = al256(S_BON + (size_t)NTOK * 4 * 4);
constexpr size_t S_GDK = S_GDQ + TOK256F;
constexpr size_t S_GDV = S_GDK + TOK256F;
constexpr size_t S_GDAB = S_GDV + TOK256F;
constexpr size_t S_YRW = al256(S_GDAB + (size_t)NTOK * 16 * 4);
constexpr size_t S_YGD = S_YRW + 2 * TOK256F;
constexpr size_t S_END = S_YGD + 2 * TOK256F;
constexpr size_t S_SIZE = (S_END > (size_t)NSLOT_MAX * 1024 * 4) ? S_END : (size_t)NSLOT_MAX * 1024 * 4;
constexpr int NCHUNK = TTOK / 64;
constexpr int NCHAIN = 32;
constexpr size_t OFF_CH = al256(OFF_S + S_SIZE);
constexpr size_t CH_N = (size_t)NCHAIN * NCHUNK;
constexpr size_t CH_REC = 49152, CH_PT = 0, CH_RYT = 8192, CH_WYT = 16384, CH_XT = 24576, CH_QT = 32768;
constexpr size_t CH_SIZE = CH_N * (4 * 8192 + 16384);
constexpr size_t WS_TOTAL = OFF_CH + CH_SIZE;
static_assert(WS_TOTAL <= (size_t)2048 * 1024 * 1024, "workspace exceeds 4x largest tensor");

struct Params {
  const float *x, *c, *ctx, *c_ctx, *ada_w, *ada_b, *norm_mix_g, *norm_ffn_g, *w_in, *w_out;
  const float *na_q_gain, *na_k_gain, *na_rpb;
  const float *rw_mu, *rw_w0, *rw_w_up, *rw_a0, *rw_a_up, *rw_g_up, *rw_k_k, *rw_k_a, *rw_r_k, *rw_ln_w, *rw_ln_b;
  const float *gd_conv_w, *gd_A_log, *gd_dt_bias, *gd_norm_g;
  const float *moe_router_w, *moe_router_b, *moe_w_gu, *moe_b_gu, *moe_w_down, *moe_b_down;
  float* out;
  char* ws;
};

typedef const __attribute__((address_space(4))) Params* PP;
#define p (*pp)
__device__ __forceinline__ int tid_opaque() { int t = (int)__builtin_amdgcn_workitem_id_x(); asm volatile("" : "+v"(t)); return t; }
__device__ __forceinline__ int opq(int x) { asm volatile("" : "+s"(x)); return x; }
__device__ __forceinline__ int wave_id(int tid) { return __builtin_amdgcn_readfirstlane(tid >> 6); }
__device__ __forceinline__ bfr f2bf(float f) {
  unsigned u = __float_as_uint(f);
  u += 0x7fffu + ((u >> 16) & 1u);
  return (bfr)(u >> 16);
}
__device__ __forceinline__ float sigmoidf_(float x) { return 1.f / (1.f + __expf(-x)); }
__device__ __forceinline__ float siluf_(float x) { return x / (1.f + __expf(-x)); }
__device__ __forceinline__ float softplusf_(float x) { return x > 20.f ? x : log1pf(__expf(x)); }
__device__ __forceinline__ float wave_sum(float v) {
  v += __builtin_bit_cast(float, __builtin_amdgcn_update_dpp(0, __builtin_bit_cast(int, v), 0xB1, 0xF, 0xF, true));
  v += __builtin_bit_cast(float, __builtin_amdgcn_update_dpp(0, __builtin_bit_cast(int, v), 0x4E, 0xF, 0xF, true));
  v += __builtin_bit_cast(float, __builtin_amdgcn_update_dpp(0, __builtin_bit_cast(int, v), 0x141, 0xF, 0xF, true));
  v += __builtin_bit_cast(float, __builtin_amdgcn_update_dpp(0, __builtin_bit_cast(int, v), 0x140, 0xF, 0xF, true));
  v += __builtin_bit_cast(float, __builtin_amdgcn_update_dpp(0, __builtin_bit_cast(int, v), 0x142, 0xA, 0xF, false));
  v += __builtin_bit_cast(float, __builtin_amdgcn_update_dpp(0, __builtin_bit_cast(int, v), 0x143, 0xC, 0xF, false));
  return __builtin_bit_cast(float, __builtin_amdgcn_readlane(__builtin_bit_cast(int, v), 63));
}
__device__ __forceinline__ float shfl_xor_l(float v, int mask, int lane) {
  return __builtin_bit_cast(float, __builtin_amdgcn_ds_bpermute((lane ^ mask) << 2, __builtin_bit_cast(int, v)));
}
__device__ __forceinline__ int shfl_xor_li(int v, int mask, int lane) {
  return __builtin_amdgcn_ds_bpermute((lane ^ mask) << 2, v);
}
__device__ __forceinline__ float row16_sum(float v) {
  v += __builtin_bit_cast(float, __builtin_amdgcn_update_dpp(0, __builtin_bit_cast(int, v), 0xB1, 0xF, 0xF, true));
  v += __builtin_bit_cast(float, __builtin_amdgcn_update_dpp(0, __builtin_bit_cast(int, v), 0x4E, 0xF, 0xF, true));
  v += __builtin_bit_cast(float, __builtin_amdgcn_update_dpp(0, __builtin_bit_cast(int, v), 0x141, 0xF, 0xF, true));
  v += __builtin_bit_cast(float, __builtin_amdgcn_update_dpp(0, __builtin_bit_cast(int, v), 0x140, 0xF, 0xF, true));
  return v;
}
__device__ __forceinline__ int mod_row(int m) { return m < NLAT ? (m >> 14) : 2; }

__device__ __forceinline__ void phase_ada(PP pp, int bid, int nb, char* smem) {
  float* red = (float*)smem;
  float* mods = (float*)(p.ws + OFF_MODS);
  const int tid = tid_opaque();
  for (int task = bid; task < 2 * 96; task += nb) {
    int l = task / 96, cgp = task % 96;
    int col = cgp * 64 + (tid & 63), ks = tid >> 6;
    const float* W = p.ada_w + (size_t)l * 1024 * 6144;
    float a0 = 0.f, a1 = 0.f, a2 = 0.f;
    for (int d = ks * 128; d < ks * 128 + 128; ++d) {
      float w = W[(size_t)d * 6144 + col];
      a0 += siluf_(p.c[d]) * w;
      a1 += siluf_(p.c[1024 + d]) * w;
      a2 += siluf_(p.c_ctx[d]) * w;
    }
    red[(ks * 3 + 0) * 64 + (tid & 63)] = a0;
    red[(ks * 3 + 1) * 64 + (tid & 63)] = a1;
    red[(ks * 3 + 2) * 64 + (tid & 63)] = a2;
    __syncthreads();
    if (tid < 192) {
      int r = tid >> 6, cc = tid & 63;
      float s = 0.f;
      for (int k = 0; k < 8; ++k) s += red[(k * 3 + r) * 64 + cc];
      mods[(size_t)(l * 3 + r) * 6144 + cgp * 64 + cc] = s + p.ada_b[(size_t)l * 6144 + cgp * 64 + cc];
    }
    __syncthreads();
  }
}

__device__ __forceinline__ void convert_tile(const float* src, int N, bfr* dst, int kt, int nt, int mode, float* tile  ) {
  const int tid = tid_opaque();
#pragma unroll
  for (int q = 0; q < 2; ++q) {
    int idx = tid + q * 512;
    int kk = idx >> 4, n4 = idx & 15;
    int n = nt * 64 + n4 * 4;
    float4 v = make_float4(0.f, 0.f, 0.f, 0.f);
    if (n < N) v = *(const float4*)(src + (size_t)(kt * 64 + kk) * N + n);
    tile[kk * 65 + n4 * 4 + 0] = v.x;
    tile[kk * 65 + n4 * 4 + 1] = v.y;
    tile[kk * 65 + n4 * 4 + 2] = v.z;
    tile[kk * 65 + n4 * 4 + 3] = v.w;
  }
  __syncthreads();
  {
    int nn = tid >> 3, kc = tid & 7;
    int n = nt * 64 + nn;
    int row = n;
    if (mode == 1) { int j = n & 1023; row = (j >> 4) * 32 + (j & 15) + ((n >= 1024) ? 16 : 0); }
    bf16x8 o;
#pragma unroll
    for (int j = 0; j < 8; ++j) o[j] = (short)f2bf(tile[(kc * 8 + j) * 65 + nn]);
    *(bf16x8*)(dst + (size_t)row * 1024 + kt * 64 + kc * 8) = o;
  }
  __syncthreads();
}
__device__ __forceinline__ void phase_convert(PP pp, int l, int bid, int nb, char* smem) {
  float* tile = (float*)smem;
  char* wl = p.ws + OFF_W + (size_t)l * WL_SIZE;
  const int T_IN = 16 * 56, T_OUT = 16 * 16, T_GU = 32 * 16 * 32, T_DN = 32 * 16 * 16;
  const int total = T_IN + T_OUT + T_GU + T_DN;
  for (int t = bid; t < total; t += nb) {
    if (t < T_IN) {
      int kt = t / 56, nt = t % 56;
      convert_tile(p.w_in + (size_t)l * 1024 * PIN, PIN, (bfr*)(wl + WL_IN), kt, nt, 0, tile);
    } else if (t < T_IN + T_OUT) {
      int u = t - T_IN; int kt = u / 16, nt = u % 16;
      convert_tile(p.w_out + (size_t)l * 1024 * 1024, 1024, (bfr*)(wl + WL_OUT), kt, nt, 0, tile);
    } else if (t < T_IN + T_OUT + T_GU) {
      int u = t - T_IN - T_OUT; int e = u / 512; int v = u % 512; int kt = v / 32, nt = v % 32;
      convert_tile(p.moe_w_gu + ((size_t)l * 32 + e) * 1024 * 2048, 2048, (bfr*)(wl + WL_GU) + (size_t)e * 2048 * 1024, kt, nt, 1, tile);
    } else {
      int u = t - T_IN - T_OUT - T_GU; int e = u / 256; int v = u % 256; int kt = v / 16, nt = v % 16;
      convert_tile(p.moe_w_down + ((size_t)l * 32 + e) * 1024 * 1024, 1024, (bfr*)(wl + WL_DN) + (size_t)e * 1024 * 1024, kt, nt, 0, tile);
    }
  }
}

__device__ __forceinline__ void phase_prenorm(PP pp, int l, int bid, int nb) {
  const int tid = tid_opaque(), lane = tid & 63, wv = wave_id(tid);
  const float* xl = (l == 0) ? p.x : p.out;
  const float* xc = (l == 0) ? p.ctx : (const float*)(p.ws + OFF_CTX);
  const float* mods = (const float*)(p.ws + OFF_MODS) + (size_t)l * 3 * 6144;
  const float* g = p.norm_mix_g + (size_t)l * 1024;
  bfr* H = (bfr*)(p.ws + OFF_H);
  {
    int* cnt = (int*)(p.ws + OFF_CNT);
    int* slt = (int*)(p.ws + OFF_SLT);
    int gt = bid * NTHR + tid;
    if (gt < 32) cnt[gt] = 0;
    for (int i = gt; i < NSLOT_MAX; i += nb * NTHR) slt[i] = 0;
  }
  for (int m = bid * 8 + wv; m < NTOK; m += nb * 8) {
    const float* xr = (m < NLAT) ? xl + (size_t)m * 1024 : xc + (size_t)(m - NLAT) * 1024;
    const float* md = mods + (size_t)mod_row(m) * 6144;
    float4 v[4];
    float ss = 0.f;
#pragma unroll
    for (int i = 0; i < 4; ++i) {
      v[i] = *(const float4*)(xr + (lane + 64 * i) * 4);
      ss += v[i].x * v[i].x + v[i].y * v[i].y + v[i].z * v[i].z + v[i].w * v[i].w;
    }
    ss = wave_sum(ss);
    float rs = rsqrtf(ss * (1.f / 1024.f) + 1e-6f);
#pragma unroll
    for (int i = 0; i < 4; ++i) {
      int d = (lane + 64 * i) * 4;
      float4 gg = *(const float4*)(g + d);
      float4 sh = *(const float4*)(md + d);
      float4 sc = *(const float4*)(md + 1024 + d);
      bf16x4 o;
      o[0] = (short)f2bf(v[i].x * rs * gg.x * (1.f + sc.x) + sh.x);
      o[1] = (short)f2bf(v[i].y * rs * gg.y * (1.f + sc.y) + sh.y);
      o[2] = (short)f2bf(v[i].z * rs * gg.z * (1.f + sc.z) + sh.z);
      o[3] = (short)f2bf(v[i].w * rs * gg.w * (1.f + sc.w) + sh.w);
      *(bf16x4*)(H + (size_t)m * 1024 + d) = o;
    }
  }
}

#define LAS __attribute__((address_space(3)))
namespace g8 {
constexpr int BM = 256, BK = 64, HALF = 128, HTB = HALF * BK * 2, STAGE_BYTES = 8 * HTB, KD = 1024;
__device__ __forceinline__ int lds_byte(int r, int c) { const int st = (r >> 4) * 2 + (c >> 5), rr = r & 15, cc = c & 31, ob = rr * 64 + cc * 2; return st * 1024 + (ob ^ (((ob >> 9) & 1) << 5)); }
__device__ __forceinline__ void stage_rc(int b, int& R, int& C) { const int st = b / 1024, sb = b % 1024, swz = sb ^ (((sb >> 9) & 1) << 5); R = (st >> 1) * 16 + swz / 64; C = (st & 1) * 32 + (swz % 64) / 2; }
struct GUnit { int pm, pn, brow0, e; };
__device__ __forceinline__ int unit_index(int i, int c, int G, int total) {
  const int x = c & 7, j = c >> 3, q = total >> 3, r = total & 7;
  const int start = x < r ? x * (q + 1) : r * (q + 1) + (x - r) * q;
  const int size = q + (x < r ? 1 : 0);
  const int li = i * (G >> 3) + j;
  return li < size ? start + li : -1;
}

template <class Sched, class Epi>
__device__ __forceinline__ void gemm_stream(LAS unsigned char* lds, const bfr* Abase, const bfr* Btbase, const Sched& S, const Epi& E) {
  const int tid = tid_opaque(), wid = __builtin_amdgcn_readfirstlane(tid >> 6), lane = tid & 63, wr = wid >> 2, wc = wid & 3, fr = lane & 15, fq = lane >> 4;
  constexpr int nt = KD / BK;
  int R[2], C[2];
  unsigned voffB[2];
#pragma unroll
  for (int i = 0; i < 2; ++i) { stage_rc(tid * 16 + i * 8192, R[i], C[i]); voffB[i] = (unsigned)(R[i] * KD + C[i]) * 2u; }
#define voffA voffB
  constexpr size_t kstep = (size_t)(BK * 2);
  constexpr size_t hstep = (size_t)HALF * KD * 2;
  const unsigned ldsw = (unsigned)wid * 1024u;
  const int aoff = lds_byte(wr * 64 + fr, fq * 8), boff = lds_byte(wc * 32 + fr, fq * 8);
#define G8_SA(b, h) (((b) * 2 + (h)) * HTB)
#define G8_SB(b, h) ((4 + (b) * 2 + (h)) * HTB)
#define G8_STAGE(bufoff, gbase, v0, v1) do { \
    __builtin_amdgcn_global_load_lds((const unsigned*)((const char*)(gbase) + (v0)), (LAS unsigned*)(lds + (bufoff) + ldsw), 16, 0, 0); \
    __builtin_amdgcn_global_load_lds((const unsigned*)((const char*)(gbase) + (v1)), (LAS unsigned*)(lds + (bufoff) + ldsw + 8192), 16, 0, 0); } while (0)
#define G8_STAGEB(bufoff, gbase) G8_STAGE(bufoff, gbase, voffB[0], voffB[1])
#define G8_STAGEA(bufoff, gbase) G8_STAGE(bufoff, gbase, voffA[0], voffA[1])
#define G8_LDA(dst, b, h) do { _Pragma("unroll") for (int m = 0; m < 4; ++m) _Pragma("unroll") for (int k = 0; k < 2; ++k) dst[m][k] = *(const LAS bf16x8*)(lds + G8_SA(b, h) + aoff + m * 2048 + k * 1024); } while (0)
#define G8_LDB(dst, b, h) do { _Pragma("unroll") for (int n = 0; n < 2; ++n) _Pragma("unroll") for (int k = 0; k < 2; ++k) dst[n][k] = *(const LAS bf16x8*)(lds + G8_SB(b, h) + boff + n * 2048 + k * 1024); } while (0)
#define G8_MMA(ai, bj, At, Bt) do { __builtin_amdgcn_s_setprio(1); _Pragma("unroll") for (int m = 0; m < 4; ++m) _Pragma("unroll") for (int n = 0; n < 2; ++n) _Pragma("unroll") for (int k = 0; k < 2; ++k) \
    acc[ai][bj][m][n] = __builtin_amdgcn_mfma_f32_16x16x32_bf16(Bt[n][k], At[m][k], acc[ai][bj][m][n], 0, 0, 0); __builtin_amdgcn_s_setprio(0); } while (0)
#define G8_WAIT_V(n) asm volatile("s_waitcnt vmcnt(" #n ")" ::: "memory")
#define G8_WAIT_L(n) asm volatile("s_waitcnt lgkmcnt(" #n ")" ::: "memory")
#define G8_BAR __builtin_amdgcn_s_barrier()
#define G8_SCHED __builtin_amdgcn_sched_barrier(0)
  GUnit cur, nxt;
  int ui = 0;
  if (!S.next(0, cur)) return;
  f32x4 acc[2][2][4][2];
#pragma unroll
  for (int a = 0; a < 2; ++a)
#pragma unroll
    for (int b = 0; b < 2; ++b)
#pragma unroll
      for (int m = 0; m < 4; ++m)
#pragma unroll
        for (int n = 0; n < 2; ++n) acc[a][b][m][n] = (f32x4){0.f, 0.f, 0.f, 0.f};
  bf16x8 At[4][2], B0[2][2], B1[2][2];
  const char* cA = (const char*)Abase + (size_t)cur.pm * (BM * KD * 2);
  const char* cB = (const char*)Btbase + (size_t)cur.brow0 * (KD * 2);
  G8_STAGEB(G8_SB(0, 0), cB); G8_STAGEA(G8_SA(0, 0), cA); G8_STAGEB(G8_SB(0, 1), cB + hstep); G8_STAGEA(G8_SA(0, 1), cA + hstep);
  if (wr == 1) G8_BAR;
  G8_WAIT_V(4); G8_BAR;
  G8_STAGEB(G8_SB(1, 0), cB + kstep); G8_STAGEA(G8_SA(1, 0), cA + kstep); G8_STAGEB(G8_SB(1, 1), cB + hstep + kstep);
  G8_WAIT_V(6); G8_BAR;
  for (;;) {
    const bool has_next = S.next(ui + 1, nxt);
    const char* nA = has_next ? (const char*)Abase + (size_t)nxt.pm * (BM * KD * 2) : cA;
    const char* nB = has_next ? (const char*)Btbase + (size_t)nxt.brow0 * (KD * 2) : cB;
    for (int t = 0; t < nt; t += 2) {
      const bool last = (t == nt - 2);
      const char* a1 = cA + (size_t)(t + 1) * kstep;
      const char* a2 = last ? nA : cA + (size_t)(t + 2) * kstep;
      const char* b2 = last ? nB : cB + (size_t)(t + 2) * kstep;
      const char* a3 = a2 + kstep;
      const char* b3 = b2 + kstep;
      G8_LDB(B0, 0, 0); G8_SCHED; G8_LDA(At, 0, 0); G8_STAGEA(G8_SA(1, 1), a1 + hstep);
      G8_WAIT_L(8); G8_BAR; G8_WAIT_L(0); G8_MMA(0, 0, At, B0); G8_BAR; G8_SCHED;
      G8_LDB(B1, 0, 1); G8_STAGEB(G8_SB(0, 0), b2);
      G8_BAR; G8_WAIT_L(0); G8_MMA(0, 1, At, B1); G8_BAR;
      G8_LDA(At, 0, 1); G8_STAGEA(G8_SA(0, 0), a2);
      G8_BAR; G8_WAIT_L(0); G8_MMA(1, 0, At, B0); G8_BAR; G8_SCHED;
      G8_STAGEB(G8_SB(0, 1), b2 + hstep);
      G8_WAIT_V(6); G8_BAR; G8_MMA(1, 1, At, B1); G8_BAR;
      G8_LDB(B0, 1, 0); G8_SCHED; G8_LDA(At, 1, 0); G8_STAGEA(G8_SA(0, 1), a2 + hstep);
      G8_WAIT_L(8); G8_BAR; G8_WAIT_L(0); G8_MMA(0, 0, At, B0); G8_BAR; G8_SCHED;
      G8_LDB(B1, 1, 1); G8_STAGEB(G8_SB(1, 0), b3);
      G8_BAR; G8_WAIT_L(0); G8_MMA(0, 1, At, B1); G8_BAR;
      G8_LDA(At, 1, 1); G8_STAGEA(G8_SA(1, 0), a3);
      G8_BAR; G8_WAIT_L(0); G8_MMA(1, 0, At, B0); G8_BAR; G8_SCHED;
      G8_STAGEB(G8_SB(1, 1), b3 + hstep);
      G8_WAIT_V(6); G8_BAR; G8_MMA(1, 1, At, B1); G8_BAR;
    }
    E(acc, cur, wr, wc, fr, fq);
    if (!has_next) break;
#pragma unroll
    for (int a = 0; a < 2; ++a)
#pragma unroll
      for (int b = 0; b < 2; ++b)
#pragma unroll
        for (int m = 0; m < 4; ++m)
#pragma unroll
          for (int n = 0; n < 2; ++n) acc[a][b][m][n] = (f32x4){0.f, 0.f, 0.f, 0.f};
    cur = nxt; cA = nA; cB = nB; ++ui;
  }
  G8_WAIT_V(0);
  if (wr == 0) G8_BAR;
  G8_BAR;
#undef G8_SA
#undef G8_SB
#undef G8_STAGE
#undef G8_STAGEB
#undef G8_STAGEA
#undef voffA
#undef G8_LDA
#undef G8_LDB
#undef G8_MMA
#undef G8_WAIT_V
#undef G8_WAIT_L
#undef G8_BAR
#undef G8_SCHED
}

struct DenseSched {
  int nM, nN, G, c;
  __device__ __forceinline__ bool next(int i, GUnit& u) const {
    const int idx = unit_index(i, c, G, nM * nN);
    if (idx < 0) return false;
    u.pm = idx / nN; u.pn = idx - u.pm * nN; u.brow0 = u.pn * BM; u.e = 0;
    return true;
  }
};
struct MoeSched {
  const int* toff; int nN, NE, G, c;
  __device__ __forceinline__ bool next(int i, GUnit& u) const {
    const int idx = unit_index(i, c, G, toff[32] * nN);
    if (idx < 0) return false;
    u.pm = idx / nN; u.pn = idx - u.pm * nN;
    int e = 0;
#pragma unroll 1
    for (int k = 1; k < 32; ++k) e = (u.pm >= toff[k]) ? k : e;
    u.e = e; u.brow0 = e * NE + u.pn * BM;
    return true;
  }
};
}

struct EpiInProj {
  float* P;
  __device__ __forceinline__ void operator()(const f32x4 (&acc)[2][2][4][2], const g8::GUnit& u, int wr, int wc, int fr, int fq) const {
    const int row0 = u.pm * 256 + wr * 64 + fr, col0 = u.pn * 256 + wc * 32 + 4 * fq;
#pragma unroll
    for (int ai = 0; ai < 2; ++ai)
#pragma unroll
      for (int m = 0; m < 4; ++m) {
        float* rowp = P + (size_t)(row0 + ai * 128 + m * 16) * PINP + col0;
#pragma unroll
        for (int bj = 0; bj < 2; ++bj)
#pragma unroll
          for (int n = 0; n < 2; ++n) *(f32x4*)(rowp + bj * 128 + n * 16) = acc[ai][bj][m][n];
      }
  }
};
__device__ __forceinline__ void phase_gemm_in(PP pp, int l, int bid, int nb, char* smem) {
  g8::DenseSched S{130, 14, nb, bid};
  EpiInProj E{(float*)(p.ws + OFF_P)};
  g8::gemm_stream((LAS unsigned char*)smem, (const bfr*)(p.ws + OFF_H), (const bfr*)(p.ws + OFF_W + (size_t)l * WL_SIZE + WL_IN), S, E);
}

struct EpiOutProj {
  const float *xl, *xc, *mods; float *ol, *oc;
  __device__ __forceinline__ void operator()(const f32x4 (&acc)[2][2][4][2], const g8::GUnit& u, int wr, int wc, int fr, int fq) const {
    const bool lat = u.pm < 128;
    const float* xin = lat ? xl + (size_t)u.pm * 256 * 1024 : xc + (size_t)(u.pm - 128) * 256 * 1024;
    float* xo = lat ? ol + (size_t)u.pm * 256 * 1024 : oc + (size_t)(u.pm - 128) * 256 * 1024;
    const float* g1 = mods + (size_t)(lat ? (u.pm >> 6) : 2) * 6144 + 2048;
    const int row0 = wr * 64 + fr, col0 = u.pn * 256 + wc * 32 + 4 * fq;
#pragma unroll
    for (int bj = 0; bj < 2; ++bj)
#pragma unroll
      for (int n = 0; n < 2; ++n) {
        const f32x4 gv = *(const f32x4*)(g1 + col0 + bj * 128 + n * 16);
#pragma unroll
        for (int ai = 0; ai < 2; ++ai)
#pragma unroll
          for (int m = 0; m < 4; ++m) {
            const size_t o = (size_t)(row0 + ai * 128 + m * 16) * 1024 + col0 + bj * 128 + n * 16;
            const f32x4 xv = *(const f32x4*)(xin + o);
            *(f32x4*)(xo + o) = xv + gv * acc[ai][bj][m][n];
            if (m & 1) asm volatile("" ::: "memory");
          }
      }
  }
};
__device__ __forceinline__ void phase_gemm_out(PP pp, int l, int bid, int nb, char* smem) {
  g8::DenseSched S{(l == 0) ? 130 : 128, 4, nb, bid};
  EpiOutProj E{(l == 0) ? p.x : p.out, (l == 0) ? p.ctx : (const float*)(p.ws + OFF_CTX),
               (const float*)(p.ws + OFF_MODS) + (size_t)l * 3 * 6144, p.out, (float*)(p.ws + OFF_CTX)};
  g8::gemm_stream((LAS unsigned char*)smem, (const bfr*)(p.ws + OFF_CC), (const bfr*)(p.ws + OFF_W + (size_t)l * WL_SIZE + WL_OUT), S, E);
}

__device__ __forceinline__ void phase_prep(PP pp, int l, int bid, int nb, char* smem) {
  const int tid = tid_opaque(), lane = tid & 63, wv = wave_id(tid);
  const float* P = (const float*)(p.ws + OFF_P);
  char* S = p.ws + OFF_S;
  bfr* QN = (bfr*)(S + S_QN);
  bfr* KN = (bfr*)(S + S_KN);
  bfr* VT = (bfr*)(S + S_VT);
  float* RWR = (float*)(S + S_RWR);
  float* RWKK = (float*)(S + S_RWKK);
  float* RWV = (float*)(S + S_RWV);
  float* RWG = (float*)(S + S_RWG);
  float* RWW = (float*)(S + S_RWW);
  float* RWKD = (float*)(S + S_RWKD);
  float* RWB = (float*)(S + S_RWB);
  float* BON = (float*)(S + S_BON);
  float* GDQ = (float*)(S + S_GDQ);
  float* GDK = (float*)(S + S_GDK);
  float* GDV = (float*)(S + S_GDV);
  float* GDAB = (float*)(S + S_GDAB);
  const float* mu = p.rw_mu + (size_t)l * 896;
  const float* w0 = p.rw_w0 + (size_t)l * 512;
  const float* w_up = p.rw_w_up + (size_t)l * 2 * 32 * 256;
  const float* a0 = p.rw_a0 + (size_t)l * 512;
  const float* a_up = p.rw_a_up + (size_t)l * 2 * 32 * 256;
  const float* g_up = p.rw_g_up + (size_t)l * 64 * 256;
  const float* k_k = p.rw_k_k + (size_t)l * 256;
  const float* k_a = p.rw_k_a + (size_t)l * 256;
  const float* r_k = p.rw_r_k + (size_t)l * 256;
  const float* conv_w = p.gd_conv_w + (size_t)l * 5 * 768;
  const float* A_log = p.gd_A_log + (size_t)l * 8;
  const float* dt_bias = p.gd_dt_bias + (size_t)l * 8;
  const float* qg = p.na_q_gain + (size_t)l * 64;
  const float* kg = p.na_k_gain + (size_t)l * 64;

  float* rw = (float*)smem;
  float* lor = rw + 16 * 768;
  float* gd = rw;

  for (int tile = bid; tile < NTOK / 16; tile += nb) {
    const int m0 = tile * 16;
    int seq_lo, seq_hi;
    int bb, tau0;
    if (m0 < NLAT) { bb = m0 >> 14; seq_lo = bb << 14; seq_hi = seq_lo + SEQ; tau0 = m0 - seq_lo; }
    else { bb = (m0 - NLAT) >> 8; seq_lo = NLAT + (bb << 8); seq_hi = seq_lo + CTXL; tau0 = SEQ + (m0 - seq_lo); }

    for (int c = tid; c < 896; c += NTHR) {
      float pv[18];
#pragma unroll
      for (int t = 0; t < 18; ++t) {
        const int m = m0 - 1 + t;
        pv[t] = (m >= seq_lo && m < seq_hi) ? P[(size_t)m * PINP + A_END + c] : 0.f;
      }
      const float muc = mu[c];
#pragma unroll
      for (int t = 0; t < 16; ++t) {
        const float cur = pv[t + 1];
        const float v = cur + muc * (0.5f * (pv[t] + pv[t + 2]) - cur);
        if (c < 768) rw[t * 768 + c] = v;
        else if (c < 800) lor[(c - 768) * 16 + t] = tanhf(v);
        else if (c < 832) lor[(32 + c - 800) * 16 + t] = v;
        else lor[(64 + c - 832) * 16 + t] = sigmoidf_(v);
      }
    }
    __syncthreads();
    {
      const int c = tid & 255, th = tid >> 8;
      const float kkc = k_k[c], kac = k_a[c], rkc = r_k[c];
      const float w00 = w0[c], w01 = w0[256 + c], a00 = a0[c], a01 = a0[256 + c];
      const int h = c >> 6;
#pragma unroll 1
      for (int ps = 0; ps < 2; ++ps) {
        const int tb = th * 8 + ps * 4;
        float4 gacc = make_float4(0.f, 0.f, 0.f, 0.f), wa0 = gacc, wa1 = gacc, aa0 = gacc, aa1 = gacc;
#pragma unroll 8
        for (int j = 0; j < 64; ++j) {
          float wgt = g_up[j * 256 + c];
          float4 s0 = *(const float4*)(lor + (64 + j) * 16 + tb);
          gacc.x += s0.x * wgt; gacc.y += s0.y * wgt; gacc.z += s0.z * wgt; gacc.w += s0.w * wgt;
        }
#pragma unroll 8
        for (int j = 0; j < 32; ++j) {
          float4 t0 = *(const float4*)(lor + j * 16 + tb);
          float4 d0 = *(const float4*)(lor + (32 + j) * 16 + tb);
          float ww0 = w_up[j * 256 + c], ww1 = w_up[(32 + j) * 256 + c];
          float aw0 = a_up[j * 256 + c], aw1 = a_up[(32 + j) * 256 + c];
          wa0.x += t0.x * ww0; wa0.y += t0.y * ww0; wa0.z += t0.z * ww0; wa0.w += t0.w * ww0;
          wa1.x += t0.x * ww1; wa1.y += t0.y * ww1; wa1.z += t0.z * ww1; wa1.w += t0.w * ww1;
          aa0.x += d0.x * aw0; aa0.y += d0.y * aw0; aa0.z += d0.z * aw0; aa0.w += d0.w * aw0;
          aa1.x += d0.x * aw1; aa1.y += d0.y * aw1; aa1.z += d0.z * aw1; aa1.w += d0.w * aw1;
        }
#pragma unroll
        for (int t = 0; t < 4; ++t) {
          const int tt = tb + t;
          const int m = m0 + tt;
          const float gv = t == 0 ? gacc.x : t == 1 ? gacc.y : t == 2 ? gacc.z : gacc.w;
          const float wv0 = t == 0 ? wa0.x : t == 1 ? wa0.y : t == 2 ? wa0.z : wa0.w;
          const float wv1 = t == 0 ? wa1.x : t == 1 ? wa1.y : t == 2 ? wa1.z : wa1.w;
          const float av0 = t == 0 ? aa0.x : t == 1 ? aa0.y : t == 2 ? aa0.z : aa0.w;
          const float av1 = t == 0 ? aa1.x : t == 1 ? aa1.y : t == 2 ? aa1.z : aa1.w;
          float r = rw[tt * 768 + c], k = rw[tt * 768 + 256 + c], v = rw[tt * 768 + 512 + c];
          float kkraw = k * kkc;
          float ssum = wave_sum(kkraw * kkraw);
          float kk = kkraw * rsqrtf(ssum + 1e-6f);
          float bon = 0.f;
#pragma unroll
          for (int d = 0; d < 2; ++d) {
            float wl = (d == 0 ? w00 + wv0 : w01 + wv1);
            float w_log = -softplusf_(-wl) - 0.5f;
            float a = sigmoidf_(d == 0 ? a00 + av0 : a01 + av1);
            float kd = k * (1.f + (a - 1.f) * kac);
            bon += r * kd * rkc;
            size_t o = ((size_t)d * NTOK + m) * 256 + c;
            RWW[o] = -__expf(w_log); RWKD[o] = kd; RWB[o] = kk * a;
          }
          bon = wave_sum(bon);
          size_t o = (size_t)m * 256 + c;
          RWR[o] = r; RWKK[o] = kk; RWV[o] = v; RWG[o] = gv;
          if (lane == 0) BON[(size_t)m * 4 + h] = bon;
        }
      }
    }
    __syncthreads();
    for (int c = tid; c < 768; c += NTHR) {
      float pv[20];
#pragma unroll
      for (int t = 0; t < 20; ++t) {
        const int m = m0 - 2 + t;
        pv[t] = (m >= seq_lo && m < seq_hi) ? P[(size_t)m * PINP + B_END + c] : 0.f;
      }
      float cw[5];
#pragma unroll
      for (int j = 0; j < 5; ++j) cw[j] = conv_w[j * 768 + c];
#pragma unroll
      for (int t = 0; t < 16; ++t) {
        float acc = 0.f;
#pragma unroll
        for (int j = 0; j < 5; ++j) acc += cw[j] * pv[t + j];
        gd[t * 768 + c] = siluf_(acc);
      }
    }
    __syncthreads();
    for (int wt = wv; wt < 16 * 12; wt += 8) {
      int t = wt / 12, hs = wt % 12;
      int m = m0 + t;
      float val = gd[t * 768 + hs * 64 + lane];
      if (hs < 8) {
        float ss = wave_sum(val * val);
        val *= rsqrtf(ss + 1e-6f);
        if (hs < 4) GDQ[(size_t)m * 256 + hs * 64 + lane] = val * 0.125f;
        else GDK[(size_t)m * 256 + (hs - 4) * 64 + lane] = val;
      } else GDV[(size_t)m * 256 + (hs - 8) * 64 + lane] = val;
    }
    if (tid < 256) {
      int t = tid >> 4, j = tid & 15;
      int m = m0 + t;
      float pv = P[(size_t)m * PINP + B_END + 1024 + j];
      float o;
      if (j < 8) o = -__expf(A_log[j]) * softplusf_(pv + dt_bias[j]);
      else o = sigmoidf_(pv);
      GDAB[(size_t)m * 16 + j] = o;
    }
    for (int base = 0; base < 32; base += 8) {
      float vals[8];
#pragma unroll
      for (int u = 0; u < 8; ++u) {
        const int wt = wv + (base + u) * 8;
        vals[u] = P[(size_t)(m0 + (wt >> 4)) * PINP + (wt & 15) * 64 + lane];
      }
#pragma unroll
      for (int u = 0; u < 8; ++u) {
        const int wt = wv + (base + u) * 8;
        const int t = wt >> 4, hs = wt & 15;
        const int m = m0 + t;
        float val = vals[u];
        float ss = wave_sum(val * val);
        val *= rsqrtf(ss * (1.f / 64.f) + 1e-6f);
        if (hs < 8) QN[(size_t)m * 512 + hs * 64 + lane] = f2bf(val * qg[lane] * (0.125f * 1.4426950408889634f));
        else KN[(size_t)m * 512 + (hs - 8) * 64 + lane] = f2bf(val * kg[lane]);
      }
    }
    {
      int hd = tid;
      bf16x8 o0, o1;
#pragma unroll
      for (int t = 0; t < 8; ++t) {
        o0[t] = (short)f2bf(P[(size_t)(m0 + t) * PINP + 1024 + hd]);
        o1[t] = (short)f2bf(P[(size_t)(m0 + 8 + t) * PINP + 1024 + hd]);
      }
      bfr* dst = VT + ((size_t)(bb * 512 + hd)) * TTOK + tau0;
      *(bf16x8*)dst = o0;
      *(bf16x8*)(dst + 8) = o1;
    }
    __syncthreads();
  }
}

__device__ __forceinline__ int scan_tok(int b, int d, int s) {
  if (s < CTXL) { int t = d ? (CTXL - 1 - s) : s; return NLAT + b * CTXL + t; }
  int u = s - CTXL; int t = d ? (SEQ - 1 - u) : u; return b * SEQ + t;
}
#define CS 72
#define SLOT_BYTES (64 * CS * 2)
#define F0_STRIDE 68
#define X1_F0 (13 * SLOT_BYTES)
#define X1_ARR (X1_F0 + 64 * F0_STRIDE * 4)

__device__ __forceinline__ bf16x4 pack4(float a, float b, float c, float d) {
  bf16x4 o; o[0] = (short)f2bf(a); o[1] = (short)f2bf(b); o[2] = (short)f2bf(c); o[3] = (short)f2bf(d); return o;
}
#define MM_FRAGS(As, Bs, a0, a1, b00, b01, b10, b11)                                                     \
  const bf16x8 a0 = *(const bf16x8*)((As) + ((mt * 16 + fr) * CS + fq * 8) * 2);                         \
  const bf16x8 a1 = *(const bf16x8*)((As) + ((mt * 16 + fr) * CS + 32 + fq * 8) * 2);                    \
  const bf16x8 b00 = *(const bf16x8*)((Bs) + ((nt0 * 16 + fr) * CS + fq * 8) * 2);                       \
  const bf16x8 b01 = *(const bf16x8*)((Bs) + ((nt0 * 16 + fr) * CS + 32 + fq * 8) * 2);                  \
  const bf16x8 b10 = *(const bf16x8*)((Bs) + ((nt0 * 16 + 16 + fr) * CS + fq * 8) * 2);                  \
  const bf16x8 b11 = *(const bf16x8*)((Bs) + ((nt0 * 16 + 16 + fr) * CS + 32 + fq * 8) * 2);
#define MM_2TILES(acc0, acc1, a0, a1, b00, b01, b10, b11)                                                \
  acc0 = __builtin_amdgcn_mfma_f32_16x16x32_bf16(a0, b00, acc0, 0, 0, 0);                                \
  acc0 = __builtin_amdgcn_mfma_f32_16x16x32_bf16(a1, b01, acc0, 0, 0, 0);                                \
  acc1 = __builtin_amdgcn_mfma_f32_16x16x32_bf16(a0, b10, acc1, 0, 0, 0);                                \
  acc1 = __builtin_amdgcn_mfma_f32_16x16x32_bf16(a1, b11, acc1, 0, 0, 0);
__device__ __forceinline__ void wr_T(char* slot, int mt, int nt, int fr, int fq, f32x4 v) {
  *(bf16x4*)(slot + ((nt * 16 + fr) * CS + mt * 16 + 4 * fq) * 2) = pack4(v[0], v[1], v[2], v[3]);
}

template <bool GDN>
__device__ __forceinline__ void chunk_prep_task(PP pp, int chain, int b, int h, int d, int n, char* smem) {
  const int tid = tid_opaque(), lane = tid & 63, wv = wave_id(tid);
  const int fr = lane & 15, fq = lane >> 4, mt = wv >> 1, nt0 = (wv & 1) * 2;
  char* S = p.ws + OFF_S;
  char* CH = p.ws + OFF_CH;
  const size_t cc = (size_t)chain * NCHUNK + n;
  char* const p0 = smem;
  char* const p1 = smem + 1 * SLOT_BYTES;
  char* const p2 = smem + 2 * SLOT_BYTES;
  char* const p3 = smem + 3 * SLOT_BYTES;
  char* const p4 = smem + 4 * SLOT_BYTES;
  char* const p5 = smem + 5 * SLOT_BYTES;
  char* const p6 = smem + 6 * SLOT_BYTES;
  char* const p7 = smem + 7 * SLOT_BYTES;
  char* const p8 = smem + 8 * SLOT_BYTES;
  char* const p9 = smem + 9 * SLOT_BYTES;
  char* const p10 = smem + 10 * SLOT_BYTES;
  char* const p11 = smem + 11 * SLOT_BYTES;
  char* const p12 = smem + 12 * SLOT_BYTES;
  float* const F0 = (float*)(smem + X1_F0);
  float* const Lv = (float*)(smem + X1_ARR);
  float* const Lm1v = Lv + 64;
  float* const betav = Lv + 128;
  float* const eLv = Lv + 192;
  float* const gC = Lv + 256;
  float* const gsum = Lv + 320;
  char* const sKt = p0;
  char* const sBh = GDN ? p0 : p1;
  char* const sKh = GDN ? p0 : p2;

  {
    const int c = lane, tg = wv;
    float lw[8], f0[8], f1[8], f2[8], f3[8], xv[8], be[8];
#pragma unroll
    for (int u = 0; u < 8; ++u) {
      const int m = scan_tok(b, d, n * 64 + tg * 8 + u);
      const size_t o = (size_t)m * 256 + h * 64 + c;
      if (!GDN) {
        lw[u] = ((const float*)(S + S_RWW))[(size_t)d * NTOK * 256 + o];
        f0[u] = ((const float*)(S + S_RWKK))[o];
        f1[u] = ((const float*)(S + S_RWB))[(size_t)d * NTOK * 256 + o];
        f2[u] = ((const float*)(S + S_RWKD))[(size_t)d * NTOK * 256 + o];
        f3[u] = ((const float*)(S + S_RWR))[o];
        xv[u] = ((const float*)(S + S_RWV))[o];
        be[u] = 1.f;
      } else {
        lw[u] = ((const float*)(S + S_GDAB))[(size_t)m * 16 + d * 4 + h];
        be[u] = ((const float*)(S + S_GDAB))[(size_t)m * 16 + 8 + d * 4 + h];
        f0[u] = ((const float*)(S + S_GDK))[o];
        f3[u] = ((const float*)(S + S_GDQ))[o];
        xv[u] = ((const float*)(S + S_GDV))[o];
        f1[u] = 0.f; f2[u] = 0.f;
      }
    }
    float cum[8];
    cum[0] = lw[0];
#pragma unroll
    for (int u = 1; u < 8; ++u) cum[u] = cum[u - 1] + lw[u];
    gsum[tg * 64 + c] = cum[7];
    __syncthreads();
    float off = 0.f, LC = 0.f;
#pragma unroll
    for (int g2 = 0; g2 < 8; ++g2) { const float gs = gsum[g2 * 64 + c]; LC += gs; off += (g2 < tg) ? gs : 0.f; }
    bf16x8 vKtT, vBbT, vKbT, vXT;
#pragma unroll
    for (int u = 0; u < 8; ++u) {
      const int t = tg * 8 + u;
      const float L = off + cum[u], Lm1 = L - lw[u];
      if (!GDN) {
        const float eLm1 = __expf(Lm1), enL = __expf(-L), eL = __expf(L), eCL = __expf(LC - L);
        const float kt = f0[u] * eLm1;
        *(bfr*)(p0 + (t * CS + c) * 2) = f2bf(kt);
        *(bfr*)(p1 + (t * CS + c) * 2) = f2bf(f1[u] * enL);
        *(bfr*)(p2 + (t * CS + c) * 2) = f2bf(f2[u] * enL);
        *(bfr*)(p3 + (t * CS + c) * 2) = f2bf(f3[u] * eL);
        vKtT[u] = (short)f2bf(kt);
        vBbT[u] = (short)f2bf(f1[u] * eCL);
        vKbT[u] = (short)f2bf(f2[u] * eCL);
        vXT[u] = (short)f2bf(xv[u]);
      } else {
        *(bfr*)(p0 + (t * CS + c) * 2) = f2bf(f0[u]);
        *(bfr*)(p3 + (t * CS + c) * 2) = f2bf(f3[u]);
        vKtT[u] = (short)f2bf(f0[u] * __expf(Lm1));
        vBbT[u] = (short)f2bf(be[u] * f0[u] * __expf(LC - Lm1));
        vKbT[u] = (short)f2bf(f0[u] * __expf(LC - L));
        vXT[u] = (short)f2bf(be[u] * xv[u]);
        if (c == 0) { Lv[t] = L; Lm1v[t] = Lm1; betav[t] = be[u]; eLv[t] = __expf(L); }
      }
    }
    *(bf16x8*)(p4 + (c * CS + tg * 8) * 2) = vKtT;
    *(bf16x8*)(p5 + (c * CS + tg * 8) * 2) = vBbT;
    *(bf16x8*)(p6 + (c * CS + tg * 8) * 2) = vKbT;
    *(bf16x8*)(p7 + (c * CS + tg * 8) * 2) = vXT;
    if (tg == 0) gC[c] = __expf(LC);
    if (!GDN && tid < 64) { Lv[tid] = 0.f; Lm1v[tid] = 0.f; betav[tid] = 1.f; eLv[tid] = 1.f; }
  }
  __syncthreads();
  {
    {
      MM_FRAGS(sKt, sBh, a0, a1, b00, b01, b10, b11)
      f32x4 c0 = {0.f, 0.f, 0.f, 0.f}, c1 = c0;
      MM_2TILES(c0, c1, a0, a1, b00, b01, b10, b11)
#pragma unroll
      for (int q = 0; q < 2; ++q) {
        const int sI = (nt0 + q) * 16 + fr;
        const f32x4 cv = q ? c1 : c0;
        f32x4 o;
#pragma unroll
        for (int r = 0; r < 4; ++r) {
          const int tI = mt * 16 + 4 * fq + r;
          float v = cv[r];
          if (GDN) v *= betav[sI] * __expf(fminf(Lm1v[tI] - Lm1v[sI], 0.f));
          o[r] = (sI < tI) ? v : 0.f;
        }
        *(f32x4*)(F0 + sI * F0_STRIDE + mt * 16 + 4 * fq) = o;
        wr_T(p11, mt, nt0 + q, fr, fq, o);
      }
    }
    {
      MM_FRAGS(sKt, sKh, a0, a1, b00, b01, b10, b11)
      f32x4 c0 = {0.f, 0.f, 0.f, 0.f}, c1 = c0;
      MM_2TILES(c0, c1, a0, a1, b00, b01, b10, b11)
#pragma unroll
      for (int q = 0; q < 2; ++q) {
        const int sI = (nt0 + q) * 16 + fr;
        const f32x4 cv = q ? c1 : c0;
        f32x4 o;
#pragma unroll
        for (int r = 0; r < 4; ++r) {
          const int tI = mt * 16 + 4 * fq + r;
          float v = cv[r];
          if (GDN) v *= __expf(fminf(Lm1v[tI] - Lv[sI], 0.f));
          o[r] = (sI < tI) ? v : 0.f;
        }
        wr_T(p9, mt, nt0 + q, fr, fq, o);
      }
    }
    {
      MM_FRAGS(sBh, p3, a0, a1, b00, b01, b10, b11)
      f32x4 c0 = {0.f, 0.f, 0.f, 0.f}, c1 = c0;
      MM_2TILES(c0, c1, a0, a1, b00, b01, b10, b11)
#pragma unroll
      for (int q = 0; q < 2; ++q) {
        const int tI = (nt0 + q) * 16 + fr;
        const f32x4 cv = q ? c1 : c0;
        f32x4 o;
#pragma unroll
        for (int r = 0; r < 4; ++r) {
          const int sI = mt * 16 + 4 * fq + r;
          float v = cv[r];
          if (GDN) v *= betav[sI] * __expf(fminf(Lv[tI] - Lm1v[sI], 0.f));
          o[r] = (sI <= tI) ? v : 0.f;
        }
        wr_T(p10, mt, nt0 + q, fr, fq, o);
      }
    }
  }
  __syncthreads();
  if (wv < 2) {
    const int base = wv * 32, other = 32 - base, c = lane & 31;
    float tr[32];
#pragma unroll
    for (int j = 0; j < 32; ++j) tr[j] = 0.f;
#pragma unroll
    for (int i = 31; i >= 0; --i) {
      float acc = (c == i) ? 1.f : 0.f;
#pragma unroll
      for (int jb = ((i + 1) & ~3); jb < 32; jb += 4) {
        const f32x4 a4 = *(const f32x4*)(F0 + (base + i) * F0_STRIDE + base + jb);
        acc -= a4[0] * tr[jb]; acc -= a4[1] * tr[jb + 1]; acc -= a4[2] * tr[jb + 2]; acc -= a4[3] * tr[jb + 3];
      }
      tr[i] = acc;
      if (lane < 32) {
        *(bfr*)(p8 + ((base + i) * CS + base + c) * 2) = f2bf(acc);
        *(bfr*)(p8 + ((base + i) * CS + other + c) * 2) = (bfr)0;
      }
    }
    if (lane < 32) {
#pragma unroll
      for (int q = 0; q < 4; ++q) {
        bf16x8 o, z;
#pragma unroll
        for (int j = 0; j < 8; ++j) { o[j] = (short)f2bf(tr[8 * q + j]); z[j] = 0; }
        *(bf16x8*)(p12 + ((base + c) * CS + base + 8 * q) * 2) = o;
        *(bf16x8*)(p12 + ((base + c) * CS + other + 8 * q) * 2) = z;
      }
    }
  }
  __syncthreads();
  {
    MM_FRAGS(p11, p12, a0, a1, b00, b01, b10, b11)
    f32x4 c0 = {0.f, 0.f, 0.f, 0.f}, c1 = c0;
    MM_2TILES(c0, c1, a0, a1, b00, b01, b10, b11)
    wr_T(p1, mt, nt0, fr, fq, c0);
    wr_T(p1, mt, nt0 + 1, fr, fq, c1);
  }
  __syncthreads();
  if (mt < 2 && nt0 == 2) {
    MM_FRAGS(p8, p1, a0, a1, b00, b01, b10, b11)
    f32x4 c0 = {0.f, 0.f, 0.f, 0.f}, c1 = c0;
    MM_2TILES(c0, c1, a0, a1, b00, b01, b10, b11)
    __builtin_amdgcn_s_waitcnt(0);
#pragma unroll
    for (int r = 0; r < 4; ++r) {
      *(bfr*)(p8 + ((mt * 16 + 4 * fq + r) * CS + (nt0) * 16 + fr) * 2) = f2bf(-c0[r]);
      *(bfr*)(p8 + ((mt * 16 + 4 * fq + r) * CS + (nt0 + 1) * 16 + fr) * 2) = f2bf(-c1[r]);
    }
  }
  __syncthreads();
  {
    {
      MM_FRAGS(p8, p5, a0, a1, b00, b01, b10, b11)
      f32x4 c0 = {0.f, 0.f, 0.f, 0.f}, c1 = c0;
      MM_2TILES(c0, c1, a0, a1, b00, b01, b10, b11)
      wr_T(p11, mt, nt0, fr, fq, -c0);
      wr_T(p11, mt, nt0 + 1, fr, fq, -c1);
    }
    {
      MM_FRAGS(p8, p10, a0, a1, b00, b01, b10, b11)
      f32x4 c0 = {0.f, 0.f, 0.f, 0.f}, c1 = c0;
      MM_2TILES(c0, c1, a0, a1, b00, b01, b10, b11)
      wr_T(p12, mt, nt0, fr, fq, -c0);
      wr_T(p12, mt, nt0 + 1, fr, fq, -c1);
    }
  }
  __syncthreads();
  {
    {
      MM_FRAGS(p4, p11, a0, a1, b00, b01, b10, b11)
      f32x4 c0 = {0.f, 0.f, 0.f, 0.f}, c1 = c0;
      MM_2TILES(c0, c1, a0, a1, b00, b01, b10, b11)
#pragma unroll
      for (int q = 0; q < 2; ++q) {
        const int cp = (nt0 + q) * 16 + fr;
        f32x4 cv = q ? c1 : c0;
#pragma unroll
        for (int r = 0; r < 4; ++r) { const int cI = mt * 16 + 4 * fq + r; if (cI == cp) cv[r] += gC[cI]; }
        wr_T(p10, mt, nt0 + q, fr, fq, cv);
      }
    }
    {
      MM_FRAGS(p9, p11, a0, a1, b00, b01, b10, b11)
      f32x4 c0 = {0.f, 0.f, 0.f, 0.f}, c1 = c0;
      MM_2TILES(c0, c1, a0, a1, b00, b01, b10, b11)
#pragma unroll
      for (int q = 0; q < 2; ++q) {
        const int cp = (nt0 + q) * 16 + fr;
        f32x4 cv = q ? c1 : c0;
        const bf16x4 kb = *(const bf16x4*)(p6 + (cp * CS + mt * 16 + 4 * fq) * 2);
#pragma unroll
        for (int r = 0; r < 4; ++r) cv[r] += __uint_as_float(((unsigned)(unsigned short)kb[r]) << 16);
        wr_T(p8, mt, nt0 + q, fr, fq, cv);
      }
    }
    {
      MM_FRAGS(p4, p12, a0, a1, b00, b01, b10, b11)
      f32x4 c0 = {0.f, 0.f, 0.f, 0.f}, c1 = c0;
      MM_2TILES(c0, c1, a0, a1, b00, b01, b10, b11)
#pragma unroll
      for (int q = 0; q < 2; ++q) {
        const int tI = (nt0 + q) * 16 + fr;
        f32x4 cv = q ? c1 : c0;
        const bf16x4 rt = *(const bf16x4*)(p3 + (tI * CS + mt * 16 + 4 * fq) * 2);
        const float el = eLv[tI];
#pragma unroll
        for (int r = 0; r < 4; ++r) cv[r] += __uint_as_float(((unsigned)(unsigned short)rt[r]) << 16) * el;
        wr_T(p1, mt, nt0 + q, fr, fq, cv);
      }
    }
    {
      f32x4 c0 = {0.f, 0.f, 0.f, 0.f}, c1 = c0;
      {
        MM_FRAGS(sKh, p3, a0, a1, b00, b01, b10, b11)
        MM_2TILES(c0, c1, a0, a1, b00, b01, b10, b11)
      }
#pragma unroll
      for (int q = 0; q < 2; ++q) {
        const int tI = (nt0 + q) * 16 + fr;
#pragma unroll
        for (int r = 0; r < 4; ++r) {
          const int sI = mt * 16 + 4 * fq + r;
          float v = q ? c1[r] : c0[r];
          if (GDN) v *= __expf(fminf(Lv[tI] - Lv[sI], 0.f));
          v = (sI <= tI) ? v : 0.f;
          if (q) c1[r] = v; else c0[r] = v;
        }
      }
      {
        MM_FRAGS(p9, p12, a0, a1, b00, b01, b10, b11)
        MM_2TILES(c0, c1, a0, a1, b00, b01, b10, b11)
      }
      wr_T(p5, mt, nt0, fr, fq, c0);
      wr_T(p5, mt, nt0 + 1, fr, fq, c1);
    }
  }
  __syncthreads();
  {
    {
      MM_FRAGS(p8, p7, a0, a1, b00, b01, b10, b11)
      f32x4 c0 = {0.f, 0.f, 0.f, 0.f}, c1 = c0;
      MM_2TILES(c0, c1, a0, a1, b00, b01, b10, b11)
      float* QT = (float*)(CH + cc * CH_REC + CH_QT);
      *(f32x4*)(QT + ((mt * 4 + nt0) * 64 + lane) * 4) = c0;
      *(f32x4*)(QT + ((mt * 4 + nt0 + 1) * 64 + lane) * 4) = c1;
    }
    {
      const int fm = wv >> 1, fa = wv & 1;
      const int row = fm * 16 + fr;
      {
        const bf16x4 lo = *(const bf16x4*)(p10 + (row * CS + 32 * fa + 4 * fq) * 2);
        const bf16x4 hi = *(const bf16x4*)(p10 + (row * CS + 32 * fa + 16 + 4 * fq) * 2);
        bf16x8 f; f[0] = lo[0]; f[1] = lo[1]; f[2] = lo[2]; f[3] = lo[3]; f[4] = hi[0]; f[5] = hi[1]; f[6] = hi[2]; f[7] = hi[3];
        *(bf16x8*)(CH + cc * CH_REC + CH_PT + (size_t)((fm * 2 + fa) * 64 + lane) * 16) = f;
      }
      {
        const bf16x4 lo = *(const bf16x4*)(p1 + (row * CS + 32 * fa + 4 * fq) * 2);
        const bf16x4 hi = *(const bf16x4*)(p1 + (row * CS + 32 * fa + 16 + 4 * fq) * 2);
        bf16x8 f; f[0] = lo[0]; f[1] = lo[1]; f[2] = lo[2]; f[3] = lo[3]; f[4] = hi[0]; f[5] = hi[1]; f[6] = hi[2]; f[7] = hi[3];
        *(bf16x8*)(CH + cc * CH_REC + CH_RYT + (size_t)((fm * 2 + fa) * 64 + lane) * 16) = f;
      }
      *(bf16x8*)(CH + cc * CH_REC + CH_WYT + (size_t)((fm * 2 + fa) * 64 + lane) * 16) = *(const bf16x8*)(p5 + (row * CS + 32 * fa + 8 * fq) * 2);
      *(bf16x8*)(CH + cc * CH_REC + CH_XT + (size_t)((fm * 2 + fa) * 64 + lane) * 16) = *(const bf16x8*)(p7 + (row * CS + 32 * fa + 8 * fq) * 2);
    }
  }
  __syncthreads();
}

__device__ __forceinline__ void phase_chunk_prep(PP pp, int bid, int nb, char* smem) {
  for (int t = bid; t < NCHAIN * NCHUNK; t += nb) {
    const int chain = t / NCHUNK, n = t - chain * NCHUNK;
    const int d = chain & 1, h = (chain >> 1) & 3, b = (chain >> 3) & 1, ty = chain >> 4;
    if (ty == 0) chunk_prep_task<false>(pp, chain, b, h, d, n, smem);
    else chunk_prep_task<true>(pp, chain, b, h, d, n, smem);
  }
}

#define X2_BUF 49152
__device__ __forceinline__ void chunk_seq_chain(PP pp, int chain, char* smem) {
  const int tid = tid_opaque(), lane = tid & 63, wv = wave_id(tid);
  const int d = chain & 1, h = (chain >> 1) & 3, b = (chain >> 3) & 1, ty = chain >> 4;
  const char* CH = p.ws + OFF_CH;
  float* Y = (float*)(p.ws + OFF_S + (ty ? S_YGD : S_YRW)) + (size_t)d * NTOK * 256;
  const size_t c0 = (size_t)chain * NCHUNK;
  if (wv >= 4) {
    const int lt = tid - 256;
    const char* src0 = CH + c0 * CH_REC + (size_t)lt * 16;
    char* dst0 = smem + (size_t)lt * 16;
#define X2_DECL(R) uint4 R##0, R##1, R##2, R##3, R##4, R##5, R##6, R##7, R##8, R##9, R##10, R##11;
#define X2_ISSUE(R, n) { const char* s_ = src0 + (size_t)(n) * CH_REC;                                                  \
      R##0 = *(const uint4*)(s_); R##1 = *(const uint4*)(s_ + 4096); R##2 = *(const uint4*)(s_ + 8192); R##3 = *(const uint4*)(s_ + 12288);            \
      R##4 = *(const uint4*)(s_ + 16384); R##5 = *(const uint4*)(s_ + 20480); R##6 = *(const uint4*)(s_ + 24576); R##7 = *(const uint4*)(s_ + 28672);  \
      R##8 = *(const uint4*)(s_ + 32768); R##9 = *(const uint4*)(s_ + 36864); R##10 = *(const uint4*)(s_ + 40960); R##11 = *(const uint4*)(s_ + 45056); }
#define X2_WRITE(R, n) { char* d_ = dst0 + ((n) & 1) * X2_BUF;                                                           \
      *(uint4*)(d_) = R##0; *(uint4*)(d_ + 4096) = R##1; *(uint4*)(d_ + 8192) = R##2; *(uint4*)(d_ + 12288) = R##3;          \
      *(uint4*)(d_ + 16384) = R##4; *(uint4*)(d_ + 20480) = R##5; *(uint4*)(d_ + 24576) = R##6; *(uint4*)(d_ + 28672) = R##7; \
      *(uint4*)(d_ + 32768) = R##8; *(uint4*)(d_ + 36864) = R##9; *(uint4*)(d_ + 40960) = R##10; *(uint4*)(d_ + 45056) = R##11; }
    X2_DECL(ra) X2_DECL(rb) X2_DECL(rc)
    X2_ISSUE(ra, 0) X2_ISSUE(rb, 1) X2_ISSUE(rc, 2)
    X2_WRITE(ra, 0) X2_ISSUE(ra, 3)
    __syncthreads();
    for (int n = 0; n < NCHUNK; n += 3) {
      if (n + 1 < NCHUNK) X2_WRITE(rb, n + 1)
      if (n + 4 < NCHUNK) X2_ISSUE(rb, n + 4)
      __syncthreads();
      if (n + 1 < NCHUNK) {
        if (n + 2 < NCHUNK) X2_WRITE(rc, n + 2)
        if (n + 5 < NCHUNK) X2_ISSUE(rc, n + 5)
        __syncthreads();
      }
      if (n + 2 < NCHUNK) {
        if (n + 3 < NCHUNK) X2_WRITE(ra, n + 3)
        if (n + 6 < NCHUNK) X2_ISSUE(ra, n + 6)
        __syncthreads();
      }
    }
#undef X2_DECL
#undef X2_ISSUE
#undef X2_WRITE
  } else {
    const int vt = wv, fr = lane & 15, fq = lane >> 4;
    f32x4 Sacc[4];
#pragma unroll
    for (int i = 0; i < 4; ++i) Sacc[i] = (f32x4){0.f, 0.f, 0.f, 0.f};
    __syncthreads();
    for (int n = 0; n < NCHUNK; ++n) {
      const char* buf = smem + (n & 1) * X2_BUF;
      bf16x8 sB0, sB1;
#pragma unroll
      for (int j = 0; j < 4; ++j) {
        sB0[j] = (short)f2bf(Sacc[0][j]); sB0[4 + j] = (short)f2bf(Sacc[1][j]);
        sB1[j] = (short)f2bf(Sacc[2][j]); sB1[4 + j] = (short)f2bf(Sacc[3][j]);
      }
      const bf16x8 xB0 = *(const bf16x8*)(buf + 24576 + ((vt * 2 + 0) * 64 + lane) * 16);
      const bf16x8 xB1 = *(const bf16x8*)(buf + 24576 + ((vt * 2 + 1) * 64 + lane) * 16);
#pragma unroll
      for (int m = 0; m < 4; ++m) {
        const bf16x8 pa0 = *(const bf16x8*)(buf + ((m * 2 + 0) * 64 + lane) * 16);
        const bf16x8 pa1 = *(const bf16x8*)(buf + ((m * 2 + 1) * 64 + lane) * 16);
        const bf16x8 ra0 = *(const bf16x8*)(buf + 8192 + ((m * 2 + 0) * 64 + lane) * 16);
        const bf16x8 ra1 = *(const bf16x8*)(buf + 8192 + ((m * 2 + 1) * 64 + lane) * 16);
        const bf16x8 wa0 = *(const bf16x8*)(buf + 16384 + ((m * 2 + 0) * 64 + lane) * 16);
        const bf16x8 wa1 = *(const bf16x8*)(buf + 16384 + ((m * 2 + 1) * 64 + lane) * 16);
        const f32x4 qt = *(const f32x4*)(buf + 32768 + ((m * 4 + vt) * 64 + lane) * 16);
        f32x4 y = {0.f, 0.f, 0.f, 0.f};
        y = __builtin_amdgcn_mfma_f32_16x16x32_bf16(ra0, sB0, y, 0, 0, 0);
        y = __builtin_amdgcn_mfma_f32_16x16x32_bf16(ra1, sB1, y, 0, 0, 0);
        y = __builtin_amdgcn_mfma_f32_16x16x32_bf16(wa0, xB0, y, 0, 0, 0);
        y = __builtin_amdgcn_mfma_f32_16x16x32_bf16(wa1, xB1, y, 0, 0, 0);
        f32x4 sn = __builtin_amdgcn_mfma_f32_16x16x32_bf16(pa0, sB0, qt, 0, 0, 0);
        sn = __builtin_amdgcn_mfma_f32_16x16x32_bf16(pa1, sB1, sn, 0, 0, 0);
        Sacc[m] = sn;
#pragma unroll
        for (int r = 0; r < 4; ++r) {
          const int mm = scan_tok(b, d, n * 64 + m * 16 + 4 * fq + r);
          Y[(size_t)mm * 256 + h * 64 + vt * 16 + fr] = y[r];
        }
      }
      __syncthreads();
    }
  }
}

__device__ __forceinline__ void na_pair(const bfr* KN, const bfr* VT, const bf16x8 qf0, const bf16x8 qf1,
                                        int mk0, int mk1, size_t vt_base, int tau0, int tau1, int h, int lane,
                                        bool local, int kr0, int kr1, int ct0, int ct1, int qr, int qc, const float* bias_h,
                                        f32x4 (&O)[4], float& lsum) {
  const int fr = lane & 15, fq = lane >> 4;
  const bf16x8 k00 = *(const bf16x8*)(KN + (size_t)(mk0 + fr) * 512 + h * 64 + fq * 8);
  const bf16x8 k01 = *(const bf16x8*)(KN + (size_t)(mk0 + fr) * 512 + h * 64 + 32 + fq * 8);
  const bf16x8 k10 = *(const bf16x8*)(KN + (size_t)(mk1 + fr) * 512 + h * 64 + fq * 8);
  const bf16x8 k11 = *(const bf16x8*)(KN + (size_t)(mk1 + fr) * 512 + h * 64 + 32 + fq * 8);
  f32x4 z = {0.f, 0.f, 0.f, 0.f};
  f32x4 st0 = __builtin_amdgcn_mfma_f32_16x16x32_bf16(k00, qf0, z, 0, 0, 0);
  st0 = __builtin_amdgcn_mfma_f32_16x16x32_bf16(k01, qf1, st0, 0, 0, 0);
  f32x4 st1 = __builtin_amdgcn_mfma_f32_16x16x32_bf16(k10, qf0, z, 0, 0, 0);
  st1 = __builtin_amdgcn_mfma_f32_16x16x32_bf16(k11, qf1, st1, 0, 0, 0);
  bf16x8 pf;
  if (local) {
    int cs = min(max(qc - 8, 0), 48);
#pragma unroll
    for (int r = 0; r < 4; ++r) {
      int kc0 = ct0 * 16 + fq * 4 + r;
      int kc1 = ct1 * 16 + fq * 4 + r;
      float p0 = 0.f, p1 = 0.f;
      if ((unsigned)(kc0 - cs) < 16u) p0 = exp2f(st0[r] + bias_h[(kr0 - qr + 7) * 31 + (kc0 - qc + 15)]);
      if ((unsigned)(kc1 - cs) < 16u) p1 = exp2f(st1[r] + bias_h[(kr1 - qr + 7) * 31 + (kc1 - qc + 15)]);
      lsum += p0 + p1;
      pf[r] = (short)f2bf(p0);
      pf[4 + r] = (short)f2bf(p1);
    }
  } else {
#pragma unroll
    for (int r = 0; r < 4; ++r) {
      float p0 = exp2f(st0[r]), p1 = exp2f(st1[r]);
      lsum += p0 + p1;
      pf[r] = (short)f2bf(p0);
      pf[4 + r] = (short)f2bf(p1);
    }
  }
#pragma unroll
  for (int dt = 0; dt < 4; ++dt) {
    const bfr* vrow = VT + vt_base + (size_t)(dt * 16 + fr) * TTOK;
    bf16x4 v0 = *(const bf16x4*)(vrow + tau0 + fq * 4);
    bf16x4 v1 = *(const bf16x4*)(vrow + tau1 + fq * 4);
    bf16x8 vf;
    vf[0] = v0[0]; vf[1] = v0[1]; vf[2] = v0[2]; vf[3] = v0[3];
    vf[4] = v1[0]; vf[5] = v1[1]; vf[6] = v1[2]; vf[7] = v1[3];
    O[dt] = __builtin_amdgcn_mfma_f32_16x16x32_bf16(vf, pf, O[dt], 0, 0, 0);
  }
}

__device__ __forceinline__ void na_block_task(PP pp, int task, const float* bias_lds) {
  const int tid = tid_opaque(), lane = tid & 63, wv = wave_id(tid);
  const int fr = lane & 15, fq = lane >> 4;
  char* S = p.ws + OFF_S;
  const bfr* QN = (const bfr*)(S + S_QN);
  const bfr* KN = (const bfr*)(S + S_KN);
  const bfr* VT = (const bfr*)(S + S_VT);
  bfr* CC = (bfr*)(p.ws + OFF_CC);
  int b, h, mq0;
  bool latent = task < 2048;
  int qr = 0, cgp = 0;
  if (latent) {
    h = task & 7; int rp = (task >> 3) & 127; b = task >> 10;
    qr = rp * 2 + (wv >> 2); cgp = wv & 3;
    mq0 = b * SEQ + qr * 64 + cgp * 16;
  } else {
    int u = task - 2048;
    int half = u & 1; h = (u >> 1) & 7; b = u >> 4;
    mq0 = NLAT + b * CTXL + (half * 8 + wv) * 16;
  }
  const bf16x8 qf0 = *(const bf16x8*)(QN + (size_t)(mq0 + fr) * 512 + h * 64 + fq * 8);
  const bf16x8 qf1 = *(const bf16x8*)(QN + (size_t)(mq0 + fr) * 512 + h * 64 + 32 + fq * 8);
  f32x4 O[4];
#pragma unroll
  for (int dt = 0; dt < 4; ++dt) O[dt] = (f32x4){0.f, 0.f, 0.f, 0.f};
  float lsum = 0.f;
  const size_t vt_base = (size_t)(b * 8 + h) * 64 * TTOK;
  if (latent) {
    const int rs = min(max(qr - 4, 0), SEQ / 64 - 8);
    const int ct_first = (cgp <= 1) ? 0 : cgp - 1;
    const int nct = (cgp == 0 || cgp == 3) ? 2 : 3;
    const int npair = 4 * nct;
    const int qc = cgp * 16 + fr;
    for (int pi = 0; pi < npair; ++pi) {
      int i0 = 2 * pi, i1 = 2 * pi + 1;
      int kr0 = rs + i0 / nct, c0 = ct_first + i0 % nct;
      int kr1 = rs + i1 / nct, c1 = ct_first + i1 % nct;
      int t0 = kr0 * 64 + c0 * 16, t1 = kr1 * 64 + c1 * 16;
      na_pair(KN, VT, qf0, qf1, b * SEQ + t0, b * SEQ + t1, vt_base, t0, t1, h, lane, true, kr0, kr1, c0, c1, qr, qc,
              bias_lds + h * 465, O, lsum);
    }
  }
  for (int pi = 0; pi < 8; ++pi) {
    int t0 = pi * 32, t1 = pi * 32 + 16;
    na_pair(KN, VT, qf0, qf1, NLAT + b * CTXL + t0, NLAT + b * CTXL + t1, vt_base, SEQ + t0, SEQ + t1, h, lane, false,
            0, 0, 0, 0, 0, 0, bias_lds, O, lsum);
  }
  lsum += shfl_xor_l(lsum, 16, lane);
  lsum += shfl_xor_l(lsum, 32, lane);
  float inv = 1.f / lsum;
#pragma unroll
  for (int dt = 0; dt < 4; ++dt) {
    bf16x4 o;
#pragma unroll
    for (int r = 0; r < 4; ++r) o[r] = (short)f2bf(O[dt][r] * inv);
    *(bf16x4*)(CC + (size_t)(mq0 + fr) * 1024 + h * 64 + dt * 16 + fq * 4) = o;
  }
}

__device__ __forceinline__ void phase_mix(PP pp, int l, int bid, int nb, char* smem) {
  const int tid = tid_opaque();
  const int nscan_blocks = (nb > 32) ? 32 : nb;
  const int first_attn_block = (nb > 32) ? 32 : 0;
  if (bid < nscan_blocks) {
    for (int c = bid; c < NCHAIN; c += nscan_blocks) chunk_seq_chain(pp, c, smem);
  }
  if (bid >= first_attn_block) {
    float* bias = (float*)smem;
    __syncthreads();
    for (int i = tid; i < 8 * 465; i += NTHR) bias[i] = p.na_rpb[(size_t)l * 8 * 465 + i] * 1.4426950408889634f;
    __syncthreads();
    const int ntask = (l == 0) ? 2048 + 32 : 2048;
    const int nab = nb - first_attn_block;
    for (int t = bid - first_attn_block; t < ntask; t += nab) na_block_task(pp, t, bias);
  }
}

__device__ __forceinline__ void phase_post(PP pp, int l, int bid, int nb) {
  const int tid = tid_opaque(), lane = tid & 63, wv = wave_id(tid);
  char* S = p.ws + OFF_S;
  const float* YRW = (const float*)(S + S_YRW);
  const float* YGD = (const float*)(S + S_YGD);
  const float* RWV = (const float*)(S + S_RWV);
  const float* RWG = (const float*)(S + S_RWG);
  const float* BON = (const float*)(S + S_BON);
  const float* P = (const float*)(p.ws + OFF_P);
  bfr* CC = (bfr*)(p.ws + OFF_CC);
  const float* ln_w = p.rw_ln_w + (size_t)l * 256;
  const float* ln_b = p.rw_ln_b + (size_t)l * 256;
  const float* ng = p.gd_norm_g + (size_t)l * 64;
  const int ntok = (l == 0) ? NTOK : NLAT;
  for (int wt = bid * 8 + wv; wt < ntok * 8; wt += nb * 8) {
    int m = wt >> 3, hs = wt & 7;
    if (hs < 4) {
      int c = hs * 64 + lane;
      size_t o = (size_t)m * 256 + c;
      float y = YRW[o] + YRW[(size_t)NTOK * 256 + o];
      float mean = wave_sum(y) * (1.f / 64.f);
      float dv = y - mean;
      float var = wave_sum(dv * dv) * (1.f / 64.f);
      float yn = dv * rsqrtf(var + 64e-5f) * ln_w[c] + ln_b[c];
      float out = (yn + BON[(size_t)m * 4 + hs] * RWV[o]) * RWG[o];
      CC[(size_t)m * 1024 + 512 + c] = f2bf(out);
    } else {
      int c = (hs - 4) * 64 + lane;
      size_t o = (size_t)m * 256 + c;
      float y = YGD[o] + YGD[(size_t)NTOK * 256 + o];
      float ms = wave_sum(y * y) * (1.f / 64.f);
      float z = P[(size_t)m * PINP + B_END + 768 + c];
      float out = y * rsqrtf(ms + 1e-6f) * ng[lane] * siluf_(z);
      CC[(size_t)m * 1024 + 768 + c] = f2bf(out);
    }
  }
}

#define RW_LDS_ROW 36
__device__ __forceinline__ void phase_router(PP pp, int l, int bid, int nb, char* smem) {
  const int tid = tid_opaque(), lane = tid & 63, wv = wave_id(tid);
  const float* xl = p.out;
  const float* xc = (const float*)(p.ws + OFF_CTX);
  const float* mods = (const float*)(p.ws + OFF_MODS) + (size_t)l * 3 * 6144;
  const float* g = p.norm_ffn_g + (size_t)l * 1024;
  const float* rw = p.moe_router_w + (size_t)l * 1024 * 32;
  const float* rb = p.moe_router_b + (size_t)l * 32;
  bfr* H = (bfr*)(p.ws + OFF_H);
  int* cnt = (int*)(p.ws + OFF_CNT);
  int* TOKE = (int*)(p.ws + OFF_TOKE);
  int* TOKP = (int*)(p.ws + OFF_TOKP);
  float* TOKG = (float*)(p.ws + OFF_TOKG);
  float* wl = (float*)smem;
  for (int i = tid; i < 1024 * 8; i += NTHR) {
    int d = i >> 3, q = i & 7;
    *(float4*)(wl + d * RW_LDS_ROW + q * 4) = *(const float4*)(rw + (size_t)d * 32 + q * 4);
  }
  __syncthreads();
  const int ntok = (l == 0) ? NTOK : NLAT;
  const float rbl = rb[lane & 31];
  for (int m0 = (bid * 8 + wv) * 2; m0 < ntok; m0 += nb * 16) {
    float acc0[32], acc1[32];
#pragma unroll
    for (int e = 0; e < 32; ++e) { acc0[e] = 0.f; acc1[e] = 0.f; }
    float hv0[16], hv1[16];
    {
      const int ma = m0, mb = m0 + 1;
      const float* xa = (ma < NLAT) ? xl + (size_t)ma * 1024 : xc + (size_t)(ma - NLAT) * 1024;
      const float* xb = (mb < NLAT) ? xl + (size_t)mb * 1024 : xc + (size_t)(mb - NLAT) * 1024;
      const float* mda = mods + (size_t)mod_row(ma) * 6144 + 3072;
      const float* mdb = mods + (size_t)mod_row(mb) * 6144 + 3072;
      float ssa = 0.f, ssb = 0.f;
#pragma unroll
      for (int i = 0; i < 16; ++i) { hv0[i] = xa[lane + 64 * i]; hv1[i] = xb[lane + 64 * i]; }
#pragma unroll
      for (int i = 0; i < 16; ++i) { ssa += hv0[i] * hv0[i]; ssb += hv1[i] * hv1[i]; }
      ssa = wave_sum(ssa); ssb = wave_sum(ssb);
      const float rsa = rsqrtf(ssa * (1.f / 1024.f) + 1e-6f), rsb = rsqrtf(ssb * (1.f / 1024.f) + 1e-6f);
#pragma unroll
      for (int i = 0; i < 16; ++i) {
        const int d = lane + 64 * i;
        const float gg = g[d];
        hv0[i] = hv0[i] * rsa * gg * (1.f + mda[1024 + d]) + mda[d];
        hv1[i] = hv1[i] * rsb * gg * (1.f + mdb[1024 + d]) + mdb[d];
        H[(size_t)ma * 1024 + d] = f2bf(hv0[i]);
        H[(size_t)mb * 1024 + d] = f2bf(hv1[i]);
      }
    }
#pragma unroll
    for (int i = 0; i < 16; ++i) {
      const float* wr = wl + (lane + 64 * i) * RW_LDS_ROW;
#pragma unroll
      for (int q = 0; q < 8; ++q) {
        const float4 w = *(const float4*)(wr + q * 4);
        acc0[q * 4 + 0] += hv0[i] * w.x; acc0[q * 4 + 1] += hv0[i] * w.y; acc0[q * 4 + 2] += hv0[i] * w.z; acc0[q * 4 + 3] += hv0[i] * w.w;
        acc1[q * 4 + 0] += hv1[i] * w.x; acc1[q * 4 + 1] += hv1[i] * w.y; acc1[q * 4 + 2] += hv1[i] * w.z; acc1[q * 4 + 3] += hv1[i] * w.w;
      }
    }
#define BFLY(A, N, D)                                                                           \
    _Pragma("unroll") for (int i = 0; i < (N); ++i) {                                            \
      const bool up = (lane & (D)) != 0;                                                         \
      const float keep = up ? A[i + (N)] : A[i];                                                 \
      const float send = up ? A[i] : A[i + (N)];                                                 \
      A[i] = keep + shfl_xor_l(send, (D), lane);                                                   \
    }
    BFLY(acc0, 16, 16) BFLY(acc1, 16, 16)
    BFLY(acc0, 8, 8) BFLY(acc1, 8, 8)
    BFLY(acc0, 4, 4) BFLY(acc1, 4, 4)
    BFLY(acc0, 2, 2) BFLY(acc1, 2, 2)
    BFLY(acc0, 1, 1) BFLY(acc1, 1, 1)
#undef BFLY
    float la = acc0[0] + shfl_xor_l(acc0[0], 32, lane);
    float lb = acc1[0] + shfl_xor_l(acc1[0], 32, lane);
    const int my_e = lane & 31;
    la += rbl; lb += rbl;
    (void)my_e;
#pragma unroll
    for (int tkn = 0; tkn < 2; ++tkn) {
      float v = tkn == 0 ? la : lb;
      float tv[4]; int ti[4];
#pragma unroll
      for (int k = 0; k < 4; ++k) {
        float bv = v; int bi = lane & 31;
#pragma unroll
        for (int o = 16; o >= 1; o >>= 1) {
          float ov = shfl_xor_l(bv, o, lane); int oi = shfl_xor_li(bi, o, lane);
          bool take = (ov > bv) || (ov == bv && oi < bi);
          bv = take ? ov : bv; bi = take ? oi : bi;
        }
        tv[k] = bv; ti[k] = bi;
        if ((lane & 31) == bi) v = -3.0e38f;
      }
      float e1 = __expf(tv[1] - tv[0]), e2 = __expf(tv[2] - tv[0]), e3 = __expf(tv[3] - tv[0]);
      float inv = 1.f / (1.f + e1 + e2 + e3);
      const int m = m0 + tkn;
      if (lane < 4) {
        int e = lane == 0 ? ti[0] : lane == 1 ? ti[1] : lane == 2 ? ti[2] : ti[3];
        float gt = (lane == 0 ? 1.f : lane == 1 ? e1 : lane == 2 ? e2 : e3) * inv;
        int pos = atomicAdd(&cnt[e], 1);
        TOKE[(size_t)m * 4 + lane] = e; TOKP[(size_t)m * 4 + lane] = pos; TOKG[(size_t)m * 4 + lane] = gt;
      }
    }
  }
  __syncthreads();
}

__device__ __forceinline__ void moe_offsets(PP pp, int* toff) {
  const int* cnt = (const int*)(p.ws + OFF_CNT);
  if (tid_opaque() == 0) {
    int a = 0;
    for (int e = 0; e < 32; ++e) { toff[e] = a; a += (cnt[e] + 255) >> 8; }
    toff[32] = a;
  }
  __syncthreads();
}

__device__ __forceinline__ void phase_slotfill(PP pp, int l, int bid, int nb, char* smem) {
  int* toff = (int*)smem;
  moe_offsets(pp, toff);
  const int tid = tid_opaque(), lane = tid & 63, wv = wave_id(tid);
  const int* TOKE = (const int*)(p.ws + OFF_TOKE);
  const int* TOKP = (const int*)(p.ws + OFF_TOKP);
  const float* TOKG = (const float*)(p.ws + OFF_TOKG);
  const int* cnt = (const int*)(p.ws + OFF_CNT);
  int* TOKS = (int*)(p.ws + OFF_TOKS);
  float* SLG = (float*)(p.ws + OFF_SLG);
  const bfr* H = (const bfr*)(p.ws + OFF_H);
  bfr* XG = (bfr*)(p.ws + OFF_S);
  const int n = ((l == 0) ? NTOK : NLAT) * 4;
  for (int i = bid * 8 + wv; i < n; i += nb * 8) {
    int e = TOKE[i];
    int slot = toff[e] * 256 + TOKP[i];
    if (lane == 0) { TOKS[i] = slot; SLG[slot] = TOKG[i]; }
    const uint4* src = (const uint4*)(H + (size_t)(i >> 2) * 1024);
    uint4* dst = (uint4*)(XG + (size_t)slot * 1024);
    dst[lane] = src[lane];
    dst[lane + 64] = src[lane + 64];
  }
  for (int e = 0; e < 32; ++e) {
    const int c = cnt[e];
    const int npad = ((c + 255) & ~255) - c;
    const int base = toff[e] * 256 + c;
    for (int r = bid * 8 + wv; r < npad; r += nb * 8) {
      uint4* dst = (uint4*)(XG + (size_t)(base + r) * 1024);
      dst[lane] = make_uint4(0u, 0u, 0u, 0u);
      dst[lane + 64] = make_uint4(0u, 0u, 0u, 0u);
    }
  }
  __syncthreads();
}

struct EpiMoe1 {
  const float* bgu; bfr* ACT;
  __device__ __forceinline__ void operator()(const f32x4 (&acc)[2][2][4][2], const g8::GUnit& u, int wr, int wc, int fr, int fq) const {
    const float* be = bgu + (size_t)u.e * 2048;
    const int slot0 = u.pm * 256 + wr * 64 + fr;
#pragma unroll
    for (int bj = 0; bj < 2; ++bj) {
      const int j0 = u.pn * 128 + bj * 64 + wc * 16 + 4 * fq;
      const f32x4 bg = *(const f32x4*)(be + j0), bl = *(const f32x4*)(be + 1024 + j0);
#pragma unroll
      for (int ai = 0; ai < 2; ++ai)
#pragma unroll
        for (int m = 0; m < 4; ++m) {
          const f32x4 g = acc[ai][bj][m][0] + bg, li = acc[ai][bj][m][1] + bl;
          bf16x4 o;
#pragma unroll
          for (int q = 0; q < 4; ++q) {
            float gv = fminf(g[q], 7.f);
            float lv = fminf(fmaxf(li[q], -7.f), 7.f);
            o[q] = (short)f2bf(gv * sigmoidf_(1.702f * gv) * (lv + 1.f));
          }
          *(bf16x4*)(ACT + (size_t)(slot0 + ai * 128 + m * 16) * 1024 + j0) = o;
        }
    }
  }
};
__device__ __forceinline__ void phase_moe1_impl(PP pp, int l, int bid, int nb, char* smem, int* toff) {
  moe_offsets(pp, toff);
  g8::MoeSched S{toff, 8, 2048, nb, bid};
  EpiMoe1 E{p.moe_b_gu + (size_t)l * 32 * 2048, (bfr*)(p.ws + OFF_P)};
  g8::gemm_stream((LAS unsigned char*)smem, (const bfr*)(p.ws + OFF_S), (const bfr*)(p.ws + OFF_W + (size_t)l * WL_SIZE + WL_GU), S, E);
}

struct EpiMoe2 {
  const float* bdn; const float* SLG; float* YS;
  __device__ __forceinline__ void operator()(const f32x4 (&acc)[2][2][4][2], const g8::GUnit& u, int wr, int wc, int fr, int fq) const {
    const float* be = bdn + (size_t)u.e * 1024;
    const int slot0 = u.pm * 256 + wr * 64 + fr, col0 = u.pn * 256 + wc * 32 + 4 * fq;
#pragma unroll
    for (int ai = 0; ai < 2; ++ai)
#pragma unroll
      for (int m = 0; m < 4; ++m) {
        const int slot = slot0 + ai * 128 + m * 16;
        const float gt = SLG[slot];
#pragma unroll
        for (int bj = 0; bj < 2; ++bj)
#pragma unroll
          for (int n = 0; n < 2; ++n) {
            const f32x4 bv = *(const f32x4*)(be + col0 + bj * 128 + n * 16);
            *(f32x4*)(YS + (size_t)slot * 1024 + col0 + bj * 128 + n * 16) = (acc[ai][bj][m][n] + bv) * gt;
          }
      }
  }
};
__device__ __forceinline__ void phase_moe2_impl(PP pp, int l, int bid, int nb, char* smem, int* toff) {
  moe_offsets(pp, toff);
  g8::MoeSched S{toff, 4, 1024, nb, bid};
  EpiMoe2 E{p.moe_b_down + (size_t)l * 32 * 1024, (const float*)(p.ws + OFF_SLG), (float*)(p.ws + OFF_S)};
  g8::gemm_stream((LAS unsigned char*)smem, (const bfr*)(p.ws + OFF_P), (const bfr*)(p.ws + OFF_W + (size_t)l * WL_SIZE + WL_DN), S, E);
}

__device__ __forceinline__ void phase_combine(PP pp, int l, int bid, int nb) {
  const int tid = tid_opaque(), lane = tid & 63, wv = wave_id(tid);
  const float* YS = (const float*)(p.ws + OFF_S);
  const int* TOKS = (const int*)(p.ws + OFF_TOKS);
  const float* mods = (const float*)(p.ws + OFF_MODS) + (size_t)l * 3 * 6144;
  float* xl = p.out;
  float* xc = (float*)(p.ws + OFF_CTX);
  const int ntok = (l == 0) ? NTOK : NLAT;
  for (int m = bid * 8 + wv; m < ntok; m += nb * 8) {
    float* xr = (m < NLAT) ? xl + (size_t)m * 1024 : xc + (size_t)(m - NLAT) * 1024;
    const float* g2 = mods + (size_t)mod_row(m) * 6144 + 5120;
    int s0 = TOKS[(size_t)m * 4], s1 = TOKS[(size_t)m * 4 + 1], s2 = TOKS[(size_t)m * 4 + 2], s3 = TOKS[(size_t)m * 4 + 3];
#pragma unroll
    for (int i = 0; i < 4; ++i) {
      int d = (lane + 64 * i) * 4;
      float4 a = *(const float4*)(YS + (size_t)s0 * 1024 + d);
      float4 b = *(const float4*)(YS + (size_t)s1 * 1024 + d);
      float4 c = *(const float4*)(YS + (size_t)s2 * 1024 + d);
      float4 e = *(const float4*)(YS + (size_t)s3 * 1024 + d);
      float4 gg = *(const float4*)(g2 + d);
      float4 xv = *(const float4*)(xr + d);
      xv.x += gg.x * (a.x + b.x + c.x + e.x);
      xv.y += gg.y * (a.y + b.y + c.y + e.y);
      xv.z += gg.z * (a.z + b.z + c.z + e.z);
      xv.w += gg.w * (a.w + b.w + c.w + e.w);
      *(float4*)(xr + d) = xv;
    }
  }
}

extern __shared__ __attribute__((aligned(16))) char dyn_smem[];

__global__ void __launch_bounds__(NTHR) mega(Params p_unused) {
  cg::grid_group grid = cg::this_grid();
  const int bid0 = blockIdx.x, nb0 = gridDim.x;
#if defined(__HIP_DEVICE_COMPILE__)
  PP pp0 = (PP)__builtin_amdgcn_kernarg_segment_ptr();
#else
  PP pp0 = nullptr;
#endif
#define pp ({ PP q_ = pp0; asm volatile("" : "+s"(q_)); q_; })
#define bid opq(bid0)
#define nb opq(nb0)
  int* toff_s = (int*)(dyn_smem + 147456);
  phase_ada(pp, bid, nb, dyn_smem);
  phase_convert(pp, 0, bid, nb, dyn_smem);
  phase_convert(pp, 1, bid, nb, dyn_smem);
  grid.sync();
#define LAYER(LV, LAST)                                      \
  {                                                          \
    phase_prenorm(pp, opq(LV), bid, nb);                     \
    grid.sync();                                             \
    phase_gemm_in(pp, opq(LV), bid, nb, dyn_smem);           \
    grid.sync();                                             \
    phase_prep(pp, opq(LV), bid, nb, dyn_smem);              \
    grid.sync();                                             \
    phase_chunk_prep(pp, bid, nb, dyn_smem);                 \
    grid.sync();                                             \
    phase_mix(pp, opq(LV), bid, nb, dyn_smem);               \
    grid.sync();                                             \
    phase_post(pp, opq(LV), bid, nb);                        \
    grid.sync();                                             \
    phase_gemm_out(pp, opq(LV), bid, nb, dyn_smem);          \
    grid.sync();                                             \
    phase_router(pp, opq(LV), bid, nb, dyn_smem);            \
    grid.sync();                                             \
    phase_slotfill(pp, opq(LV), bid, nb, dyn_smem);          \
    grid.sync();                                             \
    phase_moe1_impl(pp, opq(LV), bid, nb, dyn_smem, toff_s); \
    grid.sync();                                             \
    phase_moe2_impl(pp, opq(LV), bid, nb, dyn_smem, toff_s); \
    grid.sync();                                             \
    phase_combine(pp, opq(LV), bid, nb);                     \
    if (!(LAST)) grid.sync();                                \
  }
  LAYER(0, false)
  LAYER(1, true)
#undef LAYER
#undef bid
#undef nb
#undef pp
}

#undef p
extern "C" void kernel_launch(void* const* d_in, const int* in_sizes, int n_in, void* d_out, int out_size, void* d_ws,
                              size_t ws_size, hipStream_t stream) {
  Params hp{};
  const float** pp = (const float**)&hp;
  for (int i = 0; i < 34; ++i) pp[i] = (const float*)d_in[i];
  hp.out = (float*)d_out;
  hp.ws = (char*)d_ws;
  static int grid_blocks = 0;
  if (!grid_blocks) {
    (void)hipFuncSetAttribute((const void*)mega, hipFuncAttributeMaxDynamicSharedMemorySize, LDS_BYTES);
    int dev = 0, cus = 0, per_cu = 0;
    (void)hipGetDevice(&dev);
    (void)hipDeviceGetAttribute(&cus, hipDeviceAttributeMultiprocessorCount, dev);
    (void)hipOccupancyMaxActiveBlocksPerMultiprocessor(&per_cu, mega, NTHR, LDS_BYTES);
    if (per_cu < 1) per_cu = 1;
    if (per_cu > 1) per_cu = 1;
    grid_blocks = cus * per_cu;
  }
  void* args[] = {&hp};
  (void)hipLaunchCooperativeKernel((void*)mega, dim3(grid_blocks), dim3(NTHR), args, LDS_BYTES, stream);
}
```

```cpp
#include <hip/hip_runtime.h>
#include <hip/hip_bf16.h>
#include <hip/hip_cooperative_groups.h>
#include <stdint.h>
namespace cg = cooperative_groups;

typedef __attribute__((ext_vector_type(8))) short bf16x8;
typedef __attribute__((ext_vector_type(4))) short bf16x4;
typedef __attribute__((ext_vector_type(4))) float f32x4;
typedef unsigned short bfr;

#define D_MODEL 1024
#define NB 2
#define SEQ 16384
#define CTXL 256
#define NLAT (NB * SEQ)
#define NCTX (NB * CTXL)
#define NTOK (NLAT + NCTX)
#define TTOK (SEQ + CTXL)
#define PIN 3472
#define PINP 3584
#define A_END 1536
#define B_END 2432
#define NEXP 32
#define NSLOT_MAX (NTOK * 4 + NEXP * 256)
#define NTHR 512
#define LDS_BYTES (147456 + 512)

constexpr size_t al256(size_t x) { return (x + 255) & ~(size_t)255; }
constexpr size_t WL_IN = 0;
constexpr size_t WL_OUT = WL_IN + (size_t)PINP * 1024 * 2;
constexpr size_t WL_GU = WL_OUT + (size_t)1024 * 1024 * 2;
constexpr size_t WL_DN = WL_GU + (size_t)32 * 2048 * 1024 * 2;
constexpr size_t WL_SIZE = WL_DN + (size_t)32 * 1024 * 1024 * 2;
constexpr size_t OFF_W = 0;
constexpr size_t OFF_MODS = al256(OFF_W + 2 * WL_SIZE);
constexpr size_t OFF_BAR = al256(OFF_MODS + 2 * 3 * 6144 * 4);
constexpr size_t OFF_CTX = al256(OFF_BAR + 3456 * 4);
constexpr size_t OFF_CNT = al256(OFF_CTX + (size_t)NCTX * 1024 * 4);
constexpr size_t OFF_TOKE = al256(OFF_CNT + 256);
constexpr size_t OFF_TOKP = al256(OFF_TOKE + (size_t)NTOK * 4 * 4);
constexpr size_t OFF_TOKG = al256(OFF_TOKP + (size_t)NTOK * 4 * 4);
constexpr size_t OFF_TOKS = al256(OFF_TOKG + (size_t)NTOK * 4 * 4);
constexpr size_t OFF_SLT = al256(OFF_TOKS + (size_t)NTOK * 4 * 4);
constexpr size_t OFF_SLG = al256(OFF_SLT + (size_t)NSLOT_MAX * 4);
constexpr size_t OFF_H = al256(OFF_SLG + (size_t)NSLOT_MAX * 4);
constexpr size_t OFF_CC = al256(OFF_H + (size_t)NTOK * 1024 * 2);
constexpr size_t OFF_P = al256(OFF_CC + (size_t)NTOK * 1024 * 2);
constexpr size_t OFF_S = al256(OFF_P + (size_t)NTOK * PINP * 4);
constexpr size_t TOK256F = (size_t)NTOK * 256 * 4;
constexpr size_t S_QN = 0;
constexpr size_t S_KN = S_QN + (size_t)NTOK * 512 * 2;
constexpr size_t S_VT = S_KN + (size_t)NTOK * 512 * 2;
constexpr size_t S_RWR = S_VT + (size_t)NB * 8 * 64 * TTOK * 2;
constexpr size_t S_RWKK = S_RWR + TOK256F;
constexpr size_t S_RWV = S_RWKK + TOK256F;
constexpr size_t S_RWG = S_RWV + TOK256F;
constexpr size_t S_RWW = S_RWG + TOK256F;
constexpr size_t S_RWKD = S_RWW + 2 * TOK256F;
constexpr size_t S_RWB = S_RWKD + 2 * TOK256F;
constexpr size_t S_BON = S_RWB + 2 * TOK256F;
constexpr size_t S_GDQ = al256(S_BON + (size_t)NTOK * 4 * 4);
constexpr size_t S_GDK = S_GDQ + TOK256F;
constexpr size_t S_GDV = S_GDK + TOK256F;
constexpr size_t S_GDAB = S_GDV + TOK256F;
constexpr size_t S_YRW = al256(S_GDAB + (size_t)NTOK * 16 * 4);
constexpr size_t S_YGD = S_YRW + 2 * TOK256F;
constexpr size_t S_END = S_YGD + 2 * TOK256F;
constexpr size_t S_SIZE = (S_END > (size_t)NSLOT_MAX * 1024 * 4) ? S_END : (size_t)NSLOT_MAX * 1024 * 4;
constexpr int NCHUNK = TTOK / 64;
constexpr int NCHAIN = 32;
constexpr size_t OFF_CH = al256(OFF_S + S_SIZE);
constexpr size_t CH_N = (size_t)NCHAIN * NCHUNK;
constexpr size_t CH_REC = 49152, CH_PT = 0, CH_RYT = 8192, CH_WYT = 16384, CH_XT = 24576, CH_QT = 32768;
constexpr size_t CH_SIZE = CH_N * (4 * 8192 + 16384);
constexpr size_t WS_TOTAL = OFF_CH + CH_SIZE;
static_assert(WS_TOTAL <= (size_t)2048 * 1024 * 1024, "workspace exceeds 4x largest tensor");

struct Params {
  const float *x, *c, *ctx, *c_ctx, *ada_w, *ada_b, *norm_mix_g, *norm_ffn_g, *w_in, *w_out;
  const float *na_q_gain, *na_k_gain, *na_rpb;
  const float *rw_mu, *rw_w0, *rw_w_up, *rw_a0, *rw_a_up, *rw_g_up, *rw_k_k, *rw_k_a, *rw_r_k, *rw_ln_w, *rw_ln_b;
  const float *gd_conv_w, *gd_A_log, *gd_dt_bias, *gd_norm_g;
  const float *moe_router_w, *moe_router_b, *moe_w_gu, *moe_b_gu, *moe_w_down, *moe_b_down;
  float* out;
  char* ws;
};

typedef const __attribute__((address_space(4))) Params* PP;
#define p (*pp)
__device__ __forceinline__ char* fresh_ws(PP pp) { return p.ws; }
__device__ __forceinline__ int tid_opaque() { int t = (int)__builtin_amdgcn_workitem_id_x(); asm volatile("" : "+v"(t)); return t; }
__device__ __forceinline__ int opq(int x) { asm volatile("" : "+s"(x)); return x; }
__device__ __forceinline__ int wave_id(int tid) { return __builtin_amdgcn_readfirstlane(tid >> 6); }
__device__ __forceinline__ bfr f2bf(float f) {
  unsigned u = __float_as_uint(f);
  u += 0x7fffu + ((u >> 16) & 1u);
  return (bfr)(u >> 16);
}
__device__ __forceinline__ float sigmoidf_(float x) { return 1.f / (1.f + __expf(-x)); }
__device__ __forceinline__ float siluf_(float x) { return x / (1.f + __expf(-x)); }
__device__ __forceinline__ float softplusf_(float x) { return x > 20.f ? x : log1pf(__expf(x)); }
__device__ __forceinline__ float wave_sum(float v) {
  v += __builtin_bit_cast(float, __builtin_amdgcn_update_dpp(0, __builtin_bit_cast(int, v), 0xB1, 0xF, 0xF, true));
  v += __builtin_bit_cast(float, __builtin_amdgcn_update_dpp(0, __builtin_bit_cast(int, v), 0x4E, 0xF, 0xF, true));
  v += __builtin_bit_cast(float, __builtin_amdgcn_update_dpp(0, __builtin_bit_cast(int, v), 0x141, 0xF, 0xF, true));
  v += __builtin_bit_cast(float, __builtin_amdgcn_update_dpp(0, __builtin_bit_cast(int, v), 0x140, 0xF, 0xF, true));
  v += __builtin_bit_cast(float, __builtin_amdgcn_update_dpp(0, __builtin_bit_cast(int, v), 0x142, 0xA, 0xF, false));
  v += __builtin_bit_cast(float, __builtin_amdgcn_update_dpp(0, __builtin_bit_cast(int, v), 0x143, 0xC, 0xF, false));
  return __builtin_bit_cast(float, __builtin_amdgcn_readlane(__builtin_bit_cast(int, v), 63));
}
__device__ __forceinline__ float shfl_xor_l(float v, int mask, int lane) {
  return __builtin_bit_cast(float, __builtin_amdgcn_ds_bpermute((lane ^ mask) << 2, __builtin_bit_cast(int, v)));
}
__device__ __forceinline__ int shfl_xor_li(int v, int mask, int lane) {
  return __builtin_amdgcn_ds_bpermute((lane ^ mask) << 2, v);
}
__device__ __forceinline__ float row16_sum(float v) {
  v += __builtin_bit_cast(float, __builtin_amdgcn_update_dpp(0, __builtin_bit_cast(int, v), 0xB1, 0xF, 0xF, true));
  v += __builtin_bit_cast(float, __builtin_amdgcn_update_dpp(0, __builtin_bit_cast(int, v), 0x4E, 0xF, 0xF, true));
  v += __builtin_bit_cast(float, __builtin_amdgcn_update_dpp(0, __builtin_bit_cast(int, v), 0x141, 0xF, 0xF, true));
  v += __builtin_bit_cast(float, __builtin_amdgcn_update_dpp(0, __builtin_bit_cast(int, v), 0x140, 0xF, 0xF, true));
  return v;
}
__device__ __forceinline__ int mod_row(int m) { return m < NLAT ? (m >> 14) : 2; }

__device__ __forceinline__ void phase_ada(PP pp, int bid, int nb, char* smem) {
  float* red = (float*)smem;
  float* mods = (float*)(p.ws + OFF_MODS);
  const int tid = tid_opaque();
  for (int task = bid; task < 2 * 96; task += nb) {
    int l = task / 96, cgp = task % 96;
    int col = cgp * 64 + (tid & 63), ks = tid >> 6;
    const float* W = p.ada_w + (size_t)l * 1024 * 6144;
    float a0 = 0.f, a1 = 0.f, a2 = 0.f;
    for (int d = ks * 128; d < ks * 128 + 128; ++d) {
      float w = W[(size_t)d * 6144 + col];
      a0 += siluf_(p.c[d]) * w;
      a1 += siluf_(p.c[1024 + d]) * w;
      a2 += siluf_(p.c_ctx[d]) * w;
    }
    red[(ks * 3 + 0) * 64 + (tid & 63)] = a0;
    red[(ks * 3 + 1) * 64 + (tid & 63)] = a1;
    red[(ks * 3 + 2) * 64 + (tid & 63)] = a2;
    __syncthreads();
    if (tid < 192) {
      int r = tid >> 6, cc = tid & 63;
      float s = 0.f;
      for (int k = 0; k < 8; ++k) s += red[(k * 3 + r) * 64 + cc];
      mods[(size_t)(l * 3 + r) * 6144 + cgp * 64 + cc] = s + p.ada_b[(size_t)l * 6144 + cgp * 64 + cc];
    }
    __syncthreads();
  }
}

__device__ __forceinline__ void convert_tile(const float* src, int N, bfr* dst, int kt, int nt, int mode, float* tile  ) {
  const int tid = tid_opaque();
#pragma unroll
  for (int q = 0; q < 2; ++q) {
    int idx = tid + q * 512;
    int kk = idx >> 4, n4 = idx & 15;
    int n = nt * 64 + n4 * 4;
    float4 v = make_float4(0.f, 0.f, 0.f, 0.f);
    if (n < N) v = *(const float4*)(src + (size_t)(kt * 64 + kk) * N + n);
    tile[kk * 65 + n4 * 4 + 0] = v.x;
    tile[kk * 65 + n4 * 4 + 1] = v.y;
    tile[kk * 65 + n4 * 4 + 2] = v.z;
    tile[kk * 65 + n4 * 4 + 3] = v.w;
  }
  __syncthreads();
  {
    int nn = tid >> 3, kc = tid & 7;
    int n = nt * 64 + nn;
    int row = n;
    if (mode == 1) { int j = n & 1023; row = (j >> 4) * 32 + (j & 15) + ((n >= 1024) ? 16 : 0); }
    bf16x8 o;
#pragma unroll
    for (int j = 0; j < 8; ++j) o[j] = (short)f2bf(tile[(kc * 8 + j) * 65 + nn]);
    *(bf16x8*)(dst + (size_t)row * 1024 + kt * 64 + kc * 8) = o;
  }
  __syncthreads();
}
__device__ __forceinline__ void phase_convert(PP pp, int l, int bid, int nb, char* smem) {
  float* tile = (float*)smem;
  char* wl = p.ws + OFF_W + (size_t)l * WL_SIZE;
  const int T_IN = 16 * 56, T_OUT = 16 * 16, T_GU = 32 * 16 * 32, T_DN = 32 * 16 * 16;
  const int total = T_IN + T_OUT + T_GU + T_DN;
  for (int t = bid; t < total; t += nb) {
    if (t < T_IN) {
      int kt = t / 56, nt = t % 56;
      convert_tile(p.w_in + (size_t)l * 1024 * PIN, PIN, (bfr*)(wl + WL_IN), kt, nt, 0, tile);
    } else if (t < T_IN + T_OUT) {
      int u = t - T_IN; int kt = u / 16, nt = u % 16;
      convert_tile(p.w_out + (size_t)l * 1024 * 1024, 1024, (bfr*)(wl + WL_OUT), kt, nt, 0, tile);
    } else if (t < T_IN + T_OUT + T_GU) {
      int u = t - T_IN - T_OUT; int e = u / 512; int v = u % 512; int kt = v / 32, nt = v % 32;
      convert_tile(p.moe_w_gu + ((size_t)l * 32 + e) * 1024 * 2048, 2048, (bfr*)(wl + WL_GU) + (size_t)e * 2048 * 1024, kt, nt, 1, tile);
    } else {
      int u = t - T_IN - T_OUT - T_GU; int e = u / 256; int v = u % 256; int kt = v / 16, nt = v % 16;
      convert_tile(p.moe_w_down + ((size_t)l * 32 + e) * 1024 * 1024, 1024, (bfr*)(wl + WL_DN) + (size_t)e * 1024 * 1024, kt, nt, 0, tile);
    }
  }
}

__device__ __forceinline__ void phase_prenorm(PP pp, int l, int bid, int nb) {
  const int tid = tid_opaque(), lane = tid & 63, wv = wave_id(tid);
  const float* xl = (l == 0) ? p.x : p.out;
  const float* xc = (l == 0) ? p.ctx : (const float*)(p.ws + OFF_CTX);
  const float* mods = (const float*)(p.ws + OFF_MODS) + (size_t)l * 3 * 6144;
  const float* g = p.norm_mix_g + (size_t)l * 1024;
  bfr* H = (bfr*)(p.ws + OFF_H);
  {
    int* cnt = (int*)(p.ws + OFF_CNT);
    int* slt = (int*)(p.ws + OFF_SLT);
    int gt = bid * NTHR + tid;
    if (gt < 32) cnt[gt] = 0;
    for (int i = gt; i < NSLOT_MAX; i += nb * NTHR) slt[i] = 0;
  }
  for (int m = bid * 8 + wv; m < NTOK; m += nb * 8) {
    const float* xr = (m < NLAT) ? xl + (size_t)m * 1024 : xc + (size_t)(m - NLAT) * 1024;
    const float* md = mods + (size_t)mod_row(m) * 6144;
    float4 v[4];
    float ss = 0.f;
#pragma unroll
    for (int i = 0; i < 4; ++i) {
      v[i] = *(const float4*)(xr + (lane + 64 * i) * 4);
      ss += v[i].x * v[i].x + v[i].y * v[i].y + v[i].z * v[i].z + v[i].w * v[i].w;
    }
    ss = wave_sum(ss);
    float rs = rsqrtf(ss * (1.f / 1024.f) + 1e-6f);
#pragma unroll
    for (int i = 0; i < 4; ++i) {
      int d = (lane + 64 * i) * 4;
      float4 gg = *(const float4*)(g + d);
      float4 sh = *(const float4*)(md + d);
      float4 sc = *(const float4*)(md + 1024 + d);
      bf16x4 o;
      o[0] = (short)f2bf(v[i].x * rs * gg.x * (1.f + sc.x) + sh.x);
      o[1] = (short)f2bf(v[i].y * rs * gg.y * (1.f + sc.y) + sh.y);
      o[2] = (short)f2bf(v[i].z * rs * gg.z * (1.f + sc.z) + sh.z);
      o[3] = (short)f2bf(v[i].w * rs * gg.w * (1.f + sc.w) + sh.w);
      *(bf16x4*)(H + (size_t)m * 1024 + d) = o;
    }
  }
}

#define LAS __attribute__((address_space(3)))
namespace g8 {
constexpr int BM = 256, BK = 64, HALF = 128, HTB = HALF * BK * 2, STAGE_BYTES = 8 * HTB, KD = 1024;
__device__ __forceinline__ int lds_byte(int r, int c) { const int st = (r >> 4) * 2 + (c >> 5), rr = r & 15, cc = c & 31, ob = rr * 64 + cc * 2; return st * 1024 + (ob ^ (((ob >> 9) & 1) << 5)); }
__device__ __forceinline__ void stage_rc(int b, int& R, int& C) { const int st = b / 1024, sb = b % 1024, swz = sb ^ (((sb >> 9) & 1) << 5); R = (st >> 1) * 16 + swz / 64; C = (st & 1) * 32 + (swz % 64) / 2; }
struct GUnit { int pm, pn, brow0, e; };
__device__ __forceinline__ int unit_index(int i, int c, int G, int total) {
  const int x = c & 7, j = c >> 3, q = total >> 3, r = total & 7;
  const int start = x < r ? x * (q + 1) : r * (q + 1) + (x - r) * q;
  const int size = q + (x < r ? 1 : 0);
  const int li = i * (G >> 3) + j;
  return li < size ? start + li : -1;
}

template <class Sched, class Epi>
__device__ __forceinline__ void gemm_stream(LAS unsigned char* lds, const bfr* Abase, const bfr* Btbase, const Sched& S, const Epi& E) {
  const int tid = tid_opaque(), wid = __builtin_amdgcn_readfirstlane(tid >> 6), lane = tid & 63, wr = wid >> 2, wc = wid & 3, fr = lane & 15, fq = lane >> 4;
  constexpr int nt = KD / BK;
  int R[2], C[2];
  unsigned voffB[2];
#pragma unroll
  for (int i = 0; i < 2; ++i) { stage_rc(tid * 16 + i * 8192, R[i], C[i]); voffB[i] = (unsigned)(R[i] * KD + C[i]) * 2u; }
#define voffA voffB
  constexpr size_t kstep = (size_t)(BK * 2);
  constexpr size_t hstep = (size_t)HALF * KD * 2;
  const unsigned ldsw = (unsigned)wid * 1024u;
  const int aoff = lds_byte(wr * 64 + fr, fq * 8), boff = lds_byte(wc * 32 + fr, fq * 8);
#define G8_SA(b, h) (((b) * 2 + (h)) * HTB)
#define G8_SB(b, h) ((4 + (b) * 2 + (h)) * HTB)
#define G8_STAGE(bufoff, gbase, v0, v1) do { \
    __builtin_amdgcn_global_load_lds((const unsigned*)((const char*)(gbase) + (v0)), (LAS unsigned*)(lds + (bufoff) + ldsw), 16, 0, 0); \
    __builtin_amdgcn_global_load_lds((const unsigned*)((const char*)(gbase) + (v1)), (LAS unsigned*)(lds + (bufoff) + ldsw + 8192), 16, 0, 0); } while (0)
#define G8_STAGEB(bufoff, gbase) G8_STAGE(bufoff, gbase, voffB[0], voffB[1])
#define G8_STAGEA(bufoff, gbase) G8_STAGE(bufoff, gbase, voffA[0], voffA[1])
#define G8_LDA(dst, b, h) do { _Pragma("unroll") for (int m = 0; m < 4; ++m) _Pragma("unroll") for (int k = 0; k < 2; ++k) dst[m][k] = *(const LAS bf16x8*)(lds + G8_SA(b, h) + aoff + m * 2048 + k * 1024); } while (0)
#define G8_LDB(dst, b, h) do { _Pragma("unroll") for (int n = 0; n < 2; ++n) _Pragma("unroll") for (int k = 0; k < 2; ++k) dst[n][k] = *(const LAS bf16x8*)(lds + G8_SB(b, h) + boff + n * 2048 + k * 1024); } while (0)
#define G8_MMA(ai, bj, At, Bt) do { __builtin_amdgcn_s_setprio(1); _Pragma("unroll") for (int m = 0; m < 4; ++m) _Pragma("unroll") for (int n = 0; n < 2; ++n) _Pragma("unroll") for (int k = 0; k < 2; ++k) \
    acc[ai][bj][m][n] = __builtin_amdgcn_mfma_f32_16x16x32_bf16(Bt[n][k], At[m][k], acc[ai][bj][m][n], 0, 0, 0); __builtin_amdgcn_s_setprio(0); } while (0)
#define G8_WAIT_V(n) asm volatile("s_waitcnt vmcnt(" #n ")" ::: "memory")
#define G8_WAIT_L(n) asm volatile("s_waitcnt lgkmcnt(" #n ")" ::: "memory")
#define G8_BAR __builtin_amdgcn_s_barrier()
#define G8_SCHED __builtin_amdgcn_sched_barrier(0)
  GUnit cur, nxt;
  int ui = 0;
  if (!S.next(0, cur)) return;
  f32x4 acc[2][2][4][2];
#pragma unroll
  for (int a = 0; a < 2; ++a)
#pragma unroll
    for (int b = 0; b < 2; ++b)
#pragma unroll
      for (int m = 0; m < 4; ++m)
#pragma unroll
        for (int n = 0; n < 2; ++n) acc[a][b][m][n] = (f32x4){0.f, 0.f, 0.f, 0.f};
  bf16x8 At[4][2], B0[2][2], B1[2][2];
  const char* cA = (const char*)Abase + (size_t)cur.pm * (BM * KD * 2);
  const char* cB = (const char*)Btbase + (size_t)cur.brow0 * (KD * 2);
  G8_STAGEB(G8_SB(0, 0), cB); G8_STAGEA(G8_SA(0, 0), cA); G8_STAGEB(G8_SB(0, 1), cB + hstep); G8_STAGEA(G8_SA(0, 1), cA + hstep);
  if (wr == 1) G8_BAR;
  G8_WAIT_V(4); G8_BAR;
  G8_STAGEB(G8_SB(1, 0), cB + kstep); G8_STAGEA(G8_SA(1, 0), cA + kstep); G8_STAGEB(G8_SB(1, 1), cB + hstep + kstep);
  G8_WAIT_V(6); G8_BAR;
  for (;;) {
    const bool has_next = S.next(ui + 1, nxt);
    const char* nA = has_next ? (const char*)Abase + (size_t)nxt.pm * (BM * KD * 2) : cA;
    const char* nB = has_next ? (const char*)Btbase + (size_t)nxt.brow0 * (KD * 2) : cB;
    for (int t = 0; t < nt; t += 2) {
      const bool last = (t == nt - 2);
      const char* a1 = cA + (size_t)(t + 1) * kstep;
      const char* a2 = last ? nA : cA + (size_t)(t + 2) * kstep;
      const char* b2 = last ? nB : cB + (size_t)(t + 2) * kstep;
      const char* a3 = a2 + kstep;
      const char* b3 = b2 + kstep;
      G8_LDB(B0, 0, 0); G8_SCHED; G8_LDA(At, 0, 0); G8_STAGEA(G8_SA(1, 1), a1 + hstep);
      G8_WAIT_L(8); G8_BAR; G8_WAIT_L(0); G8_MMA(0, 0, At, B0); G8_BAR; G8_SCHED;
      G8_LDB(B1, 0, 1); G8_STAGEB(G8_SB(0, 0), b2);
      G8_BAR; G8_WAIT_L(0); G8_MMA(0, 1, At, B1); G8_BAR;
      G8_LDA(At, 0, 1); G8_STAGEA(G8_SA(0, 0), a2);
      G8_BAR; G8_WAIT_L(0); G8_MMA(1, 0, At, B0); G8_BAR; G8_SCHED;
      G8_STAGEB(G8_SB(0, 1), b2 + hstep);
      G8_WAIT_V(6); G8_BAR; G8_MMA(1, 1, At, B1); G8_BAR;
      G8_LDB(B0, 1, 0); G8_SCHED; G8_LDA(At, 1, 0); G8_STAGEA(G8_SA(0, 1), a2 + hstep);
      G8_WAIT_L(8); G8_BAR; G8_WAIT_L(0); G8_MMA(0, 0, At, B0); G8_BAR; G8_SCHED;
      G8_LDB(B1, 1, 1); G8_STAGEB(G8_SB(1, 0), b3);
      G8_BAR; G8_WAIT_L(0); G8_MMA(0, 1, At, B1); G8_BAR;
      G8_LDA(At, 1, 1); G8_STAGEA(G8_SA(1, 0), a3);
      G8_BAR; G8_WAIT_L(0); G8_MMA(1, 0, At, B0); G8_BAR; G8_SCHED;
      G8_STAGEB(G8_SB(1, 1), b3 + hstep);
      G8_WAIT_V(6); G8_BAR; G8_MMA(1, 1, At, B1); G8_BAR;
    }
    E(acc, cur, wr, wc, fr, fq);
    if (!has_next) break;
#pragma unroll
    for (int a = 0; a < 2; ++a)
#pragma unroll
      for (int b = 0; b < 2; ++b)
#pragma unroll
        for (int m = 0; m < 4; ++m)
#pragma unroll
          for (int n = 0; n < 2; ++n) acc[a][b][m][n] = (f32x4){0.f, 0.f, 0.f, 0.f};
    cur = nxt; cA = nA; cB = nB; ++ui;
  }
  G8_WAIT_V(0);
  if (wr == 0) G8_BAR;
  G8_BAR;
#undef G8_SA
#undef G8_SB
#undef G8_STAGE
#undef G8_STAGEB
#undef G8_STAGEA
#undef voffA
#undef G8_LDA
#undef G8_LDB
#undef G8_MMA
#undef G8_WAIT_V
#undef G8_WAIT_L
#undef G8_BAR
#undef G8_SCHED
}

struct DenseSched {
  int nM, nN, G, c;
  __device__ __forceinline__ bool next(int i, GUnit& u) const {
    const int idx = unit_index(i, c, G, nM * nN);
    if (idx < 0) return false;
    u.pm = idx / nN; u.pn = idx - u.pm * nN; u.brow0 = u.pn * BM; u.e = 0;
    return true;
  }
};
struct MoeSched {
  const int* toff; int nN, NE, G, c;
  __device__ __forceinline__ bool next(int i, GUnit& u) const {
    const int idx = unit_index(i, c, G, toff[32] * nN);
    if (idx < 0) return false;
    u.pm = idx / nN; u.pn = idx - u.pm * nN;
    int e = 0;
#pragma unroll 1
    for (int k = 1; k < 32; ++k) e = (u.pm >= toff[k]) ? k : e;
    u.e = e; u.brow0 = e * NE + u.pn * BM;
    return true;
  }
};
}

struct EpiInProj {
  float* P;
  __device__ __forceinline__ void operator()(const f32x4 (&acc)[2][2][4][2], const g8::GUnit& u, int wr, int wc, int fr, int fq) const {
    const int row0 = u.pm * 256 + wr * 64 + fr, col0 = u.pn * 256 + wc * 32 + 4 * fq;
#pragma unroll
    for (int ai = 0; ai < 2; ++ai)
#pragma unroll
      for (int m = 0; m < 4; ++m) {
        float* rowp = P + (size_t)(row0 + ai * 128 + m * 16) * PINP + col0;
#pragma unroll
        for (int bj = 0; bj < 2; ++bj)
#pragma unroll
          for (int n = 0; n < 2; ++n) *(f32x4*)(rowp + bj * 128 + n * 16) = acc[ai][bj][m][n];
      }
  }
};
__device__ __forceinline__ void phase_gemm_in(PP pp, int l, int bid, int nb, char* smem) {
  g8::DenseSched S{130, 14, nb, bid};
  EpiInProj E{(float*)(p.ws + OFF_P)};
  g8::gemm_stream((LAS unsigned char*)smem, (const bfr*)(p.ws + OFF_H), (const bfr*)(p.ws + OFF_W + (size_t)l * WL_SIZE + WL_IN), S, E);
}

struct EpiOutProj {
  const float *xl, *xc, *mods; float *ol, *oc;
  __device__ __forceinline__ void operator()(const f32x4 (&acc)[2][2][4][2], const g8::GUnit& u, int wr, int wc, int fr, int fq) const {
    const bool lat = u.pm < 128;
    const float* xin = lat ? xl + (size_t)u.pm * 256 * 1024 : xc + (size_t)(u.pm - 128) * 256 * 1024;
    float* xo = lat ? ol + (size_t)u.pm * 256 * 1024 : oc + (size_t)(u.pm - 128) * 256 * 1024;
    const float* g1 = mods + (size_t)(lat ? (u.pm >> 6) : 2) * 6144 + 2048;
    const int row0 = wr * 64 + fr, col0 = u.pn * 256 + wc * 32 + 4 * fq;
#pragma unroll
    for (int bj = 0; bj < 2; ++bj)
#pragma unroll
      for (int n = 0; n < 2; ++n) {
        const f32x4 gv = *(const f32x4*)(g1 + col0 + bj * 128 + n * 16);
#pragma unroll
        for (int ai = 0; ai < 2; ++ai)
#pragma unroll
          for (int m = 0; m < 4; ++m) {
            const size_t o = (size_t)(row0 + ai * 128 + m * 16) * 1024 + col0 + bj * 128 + n * 16;
            const f32x4 xv = *(const f32x4*)(xin + o);
            *(f32x4*)(xo + o) = xv + gv * acc[ai][bj][m][n];
            if (m & 1) asm volatile("" ::: "memory");
          }
      }
  }
};
__device__ __forceinline__ void phase_gemm_out(PP pp, int l, int bid, int nb, char* smem) {
  g8::DenseSched S{(l == 0) ? 130 : 128, 4, nb, bid};
  EpiOutProj E{(l == 0) ? p.x : p.out, (l == 0) ? p.ctx : (const float*)(p.ws + OFF_CTX),
               (const float*)(p.ws + OFF_MODS) + (size_t)l * 3 * 6144, p.out, (float*)(p.ws + OFF_CTX)};
  g8::gemm_stream((LAS unsigned char*)smem, (const bfr*)(p.ws + OFF_CC), (const bfr*)(p.ws + OFF_W + (size_t)l * WL_SIZE + WL_OUT), S, E);
}

__device__ __forceinline__ void phase_prep(PP pp, int l, int bid, int nb, char* smem) {
  const int tid = tid_opaque(), lane = tid & 63, wv = wave_id(tid);
  const float* P = (const float*)(p.ws + OFF_P);
  char* S = p.ws + OFF_S;
  bfr* QN = (bfr*)(S + S_QN);
  bfr* KN = (bfr*)(S + S_KN);
  bfr* VT = (bfr*)(S + S_VT);
  float* RWR = (float*)(S + S_RWR);
  float* RWKK = (float*)(S + S_RWKK);
  float* RWV = (float*)(S + S_RWV);
  float* RWG = (float*)(S + S_RWG);
  float* RWW = (float*)(S + S_RWW);
  float* RWKD = (float*)(S + S_RWKD);
  float* RWB = (float*)(S + S_RWB);
  float* BON = (float*)(S + S_BON);
  float* GDQ = (float*)(S + S_GDQ);
  float* GDK = (float*)(S + S_GDK);
  float* GDV = (float*)(S + S_GDV);
  float* GDAB = (float*)(S + S_GDAB);
  const float* mu = p.rw_mu + (size_t)l * 896;
  const float* w0 = p.rw_w0 + (size_t)l * 512;
  const float* w_up = p.rw_w_up + (size_t)l * 2 * 32 * 256;
  const float* a0 = p.rw_a0 + (size_t)l * 512;
  const float* a_up = p.rw_a_up + (size_t)l * 2 * 32 * 256;
  const float* g_up = p.rw_g_up + (size_t)l * 64 * 256;
  const float* k_k = p.rw_k_k + (size_t)l * 256;
  const float* k_a = p.rw_k_a + (size_t)l * 256;
  const float* r_k = p.rw_r_k + (size_t)l * 256;
  const float* conv_w = p.gd_conv_w + (size_t)l * 5 * 768;
  const float* A_log = p.gd_A_log + (size_t)l * 8;
  const float* dt_bias = p.gd_dt_bias + (size_t)l * 8;
  const float* qg = p.na_q_gain + (size_t)l * 64;
  const float* kg = p.na_k_gain + (size_t)l * 64;

  float* rw = (float*)smem;
  float* lor = rw + 16 * 768;
  float* gd = rw;

  for (int tile = bid; tile < NTOK / 16; tile += nb) {
    const int m0 = tile * 16;
    int seq_lo, seq_hi;
    int bb, tau0;
    if (m0 < NLAT) { bb = m0 >> 14; seq_lo = bb << 14; seq_hi = seq_lo + SEQ; tau0 = m0 - seq_lo; }
    else { bb = (m0 - NLAT) >> 8; seq_lo = NLAT + (bb << 8); seq_hi = seq_lo + CTXL; tau0 = SEQ + (m0 - seq_lo); }

    for (int c = tid; c < 896; c += NTHR) {
      float pv[18];
#pragma unroll
      for (int t = 0; t < 18; ++t) {
        const int m = m0 - 1 + t;
        pv[t] = (m >= seq_lo && m < seq_hi) ? P[(size_t)m * PINP + A_END + c] : 0.f;
      }
      const float muc = mu[c];
#pragma unroll
      for (int t = 0; t < 16; ++t) {
        const float cur = pv[t + 1];
        const float v = cur + muc * (0.5f * (pv[t] + pv[t + 2]) - cur);
        if (c < 768) rw[t * 768 + c] = v;
        else if (c < 800) lor[(c - 768) * 16 + t] = tanhf(v);
        else if (c < 832) lor[(32 + c - 800) * 16 + t] = v;
        else lor[(64 + c - 832) * 16 + t] = sigmoidf_(v);
      }
    }
    __syncthreads();
    {
      const int c = tid & 255, th = tid >> 8;
      const float kkc = k_k[c], kac = k_a[c], rkc = r_k[c];
      const float w00 = w0[c], w01 = w0[256 + c], a00 = a0[c], a01 = a0[256 + c];
      const int h = c >> 6;
#pragma unroll 1
      for (int ps = 0; ps < 2; ++ps) {
        const int tb = th * 8 + ps * 4;
        float4 gacc = make_float4(0.f, 0.f, 0.f, 0.f), wa0 = gacc, wa1 = gacc, aa0 = gacc, aa1 = gacc;
#pragma unroll 8
        for (int j = 0; j < 64; ++j) {
          float wgt = g_up[j * 256 + c];
          float4 s0 = *(const float4*)(lor + (64 + j) * 16 + tb);
          gacc.x += s0.x * wgt; gacc.y += s0.y * wgt; gacc.z += s0.z * wgt; gacc.w += s0.w * wgt;
        }
#pragma unroll 8
        for (int j = 0; j < 32; ++j) {
          float4 t0 = *(const float4*)(lor + j * 16 + tb);
          float4 d0 = *(const float4*)(lor + (32 + j) * 16 + tb);
          float ww0 = w_up[j * 256 + c], ww1 = w_up[(32 + j) * 256 + c];
          float aw0 = a_up[j * 256 + c], aw1 = a_up[(32 + j) * 256 + c];
          wa0.x += t0.x * ww0; wa0.y += t0.y * ww0; wa0.z += t0.z * ww0; wa0.w += t0.w * ww0;
          wa1.x += t0.x * ww1; wa1.y += t0.y * ww1; wa1.z += t0.z * ww1; wa1.w += t0.w * ww1;
          aa0.x += d0.x * aw0; aa0.y += d0.y * aw0; aa0.z += d0.z * aw0; aa0.w += d0.w * aw0;
          aa1.x += d0.x * aw1; aa1.y += d0.y * aw1; aa1.z += d0.z * aw1; aa1.w += d0.w * aw1;
        }
#pragma unroll
        for (int t = 0; t < 4; ++t) {
          const int tt = tb + t;
          const int m = m0 + tt;
          const float gv = t == 0 ? gacc.x : t == 1 ? gacc.y : t == 2 ? gacc.z : gacc.w;
          const float wv0 = t == 0 ? wa0.x : t == 1 ? wa0.y : t == 2 ? wa0.z : wa0.w;
          const float wv1 = t == 0 ? wa1.x : t == 1 ? wa1.y : t == 2 ? wa1.z : wa1.w;
          const float av0 = t == 0 ? aa0.x : t == 1 ? aa0.y : t == 2 ? aa0.z : aa0.w;
          const float av1 = t == 0 ? aa1.x : t == 1 ? aa1.y : t == 2 ? aa1.z : aa1.w;
          float r = rw[tt * 768 + c], k = rw[tt * 768 + 256 + c], v = rw[tt * 768 + 512 + c];
          float kkraw = k * kkc;
          float ssum = wave_sum(kkraw * kkraw);
          float kk = kkraw * rsqrtf(ssum + 1e-6f);
          float bon = 0.f;
#pragma unroll
          for (int d = 0; d < 2; ++d) {
            float wl = (d == 0 ? w00 + wv0 : w01 + wv1);
            float w_log = -softplusf_(-wl) - 0.5f;
            float a = sigmoidf_(d == 0 ? a00 + av0 : a01 + av1);
            float kd = k * (1.f + (a - 1.f) * kac);
            bon += r * kd * rkc;
            size_t o = ((size_t)d * NTOK + m) * 256 + c;
            RWW[o] = -__expf(w_log); RWKD[o] = kd; RWB[o] = kk * a;
          }
          bon = wave_sum(bon);
          size_t o = (size_t)m * 256 + c;
          RWR[o] = r; RWKK[o] = kk; RWV[o] = v; RWG[o] = gv;
          if (lane == 0) BON[(size_t)m * 4 + h] = bon;
        }
      }
    }
    __syncthreads();
    for (int c = tid; c < 768; c += NTHR) {
      float pv[20];
#pragma unroll
      for (int t = 0; t < 20; ++t) {
        const int m = m0 - 2 + t;
        pv[t] = (m >= seq_lo && m < seq_hi) ? P[(size_t)m * PINP + B_END + c] : 0.f;
      }
      float cw[5];
#pragma unroll
      for (int j = 0; j < 5; ++j) cw[j] = conv_w[j * 768 + c];
#pragma unroll
      for (int t = 0; t < 16; ++t) {
        float acc = 0.f;
#pragma unroll
        for (int j = 0; j < 5; ++j) acc += cw[j] * pv[t + j];
        gd[t * 768 + c] = siluf_(acc);
      }
    }
    __syncthreads();
    for (int wt = wv; wt < 16 * 12; wt += 8) {
      int t = wt / 12, hs = wt % 12;
      int m = m0 + t;
      float val = gd[t * 768 + hs * 64 + lane];
      if (hs < 8) {
        float ss = wave_sum(val * val);
        val *= rsqrtf(ss + 1e-6f);
        if (hs < 4) GDQ[(size_t)m * 256 + hs * 64 + lane] = val * 0.125f;
        else GDK[(size_t)m * 256 + (hs - 4) * 64 + lane] = val;
      } else GDV[(size_t)m * 256 + (hs - 8) * 64 + lane] = val;
    }
    if (tid < 256) {
      int t = tid >> 4, j = tid & 15;
      int m = m0 + t;
      float pv = P[(size_t)m * PINP + B_END + 1024 + j];
      float o;
      if (j < 8) o = -__expf(A_log[j]) * softplusf_(pv + dt_bias[j]);
      else o = sigmoidf_(pv);
      GDAB[(size_t)m * 16 + j] = o;
    }
    for (int base = 0; base < 32; base += 8) {
      float vals[8];
#pragma unroll
      for (int u = 0; u < 8; ++u) {
        const int wt = wv + (base + u) * 8;
        vals[u] = P[(size_t)(m0 + (wt >> 4)) * PINP + (wt & 15) * 64 + lane];
      }
#pragma unroll
      for (int u = 0; u < 8; ++u) {
        const int wt = wv + (base + u) * 8;
        const int t = wt >> 4, hs = wt & 15;
        const int m = m0 + t;
        float val = vals[u];
        float ss = wave_sum(val * val);
        val *= rsqrtf(ss * (1.f / 64.f) + 1e-6f);
        if (hs < 8) QN[(size_t)m * 512 + hs * 64 + lane] = f2bf(val * qg[lane] * (0.125f * 1.4426950408889634f));
        else KN[(size_t)m * 512 + (hs - 8) * 64 + lane] = f2bf(val * kg[lane]);
      }
    }
    {
      int hd = tid;
      bf16x8 o0, o1;
#pragma unroll
      for (int t = 0; t < 8; ++t) {
        o0[t] = (short)f2bf(P[(size_t)(m0 + t) * PINP + 1024 + hd]);
        o1[t] = (short)f2bf(P[(size_t)(m0 + 8 + t) * PINP + 1024 + hd]);
      }
      bfr* dst = VT + ((size_t)(bb * 512 + hd)) * TTOK + tau0;
      *(bf16x8*)dst = o0;
      *(bf16x8*)(dst + 8) = o1;
    }
    __syncthreads();
  }
}

__device__ __forceinline__ int scan_tok(int b, int d, int s) {
  if (s < CTXL) { int t = d ? (CTXL - 1 - s) : s; return NLAT + b * CTXL + t; }
  int u = s - CTXL; int t = d ? (SEQ - 1 - u) : u; return b * SEQ + t;
}
#define CS 72
#define SLOT_BYTES (64 * CS * 2)
#define F0_STRIDE 68
#define X1_F0 (13 * SLOT_BYTES)
#define X1_ARR (X1_F0 + 64 * F0_STRIDE * 4)

__device__ __forceinline__ bf16x4 pack4(float a, float b, float c, float d) {
  bf16x4 o; o[0] = (short)f2bf(a); o[1] = (short)f2bf(b); o[2] = (short)f2bf(c); o[3] = (short)f2bf(d); return o;
}
#define MM_FRAGS(As, Bs, a0, a1, b00, b01, b10, b11)                                                     \
  const bf16x8 a0 = *(const bf16x8*)((As) + ((mt * 16 + fr) * CS + fq * 8) * 2);                         \
  const bf16x8 a1 = *(const bf16x8*)((As) + ((mt * 16 + fr) * CS + 32 + fq * 8) * 2);                    \
  const bf16x8 b00 = *(const bf16x8*)((Bs) + ((nt0 * 16 + fr) * CS + fq * 8) * 2);                       \
  const bf16x8 b01 = *(const bf16x8*)((Bs) + ((nt0 * 16 + fr) * CS + 32 + fq * 8) * 2);                  \
  const bf16x8 b10 = *(const bf16x8*)((Bs) + ((nt0 * 16 + 16 + fr) * CS + fq * 8) * 2);                  \
  const bf16x8 b11 = *(const bf16x8*)((Bs) + ((nt0 * 16 + 16 + fr) * CS + 32 + fq * 8) * 2);
#define MM_2TILES(acc0, acc1, a0, a1, b00, b01, b10, b11)                                                \
  acc0 = __builtin_amdgcn_mfma_f32_16x16x32_bf16(a0, b00, acc0, 0, 0, 0);                                \
  acc0 = __builtin_amdgcn_mfma_f32_16x16x32_bf16(a1, b01, acc0, 0, 0, 0);                                \
  acc1 = __builtin_amdgcn_mfma_f32_16x16x32_bf16(a0, b10, acc1, 0, 0, 0);                                \
  acc1 = __builtin_amdgcn_mfma_f32_16x16x32_bf16(a1, b11, acc1, 0, 0, 0);
__device__ __forceinline__ void wr_T(char* slot, int mt, int nt, int fr, int fq, f32x4 v) {
  *(bf16x4*)(slot + ((nt * 16 + fr) * CS + mt * 16 + 4 * fq) * 2) = pack4(v[0], v[1], v[2], v[3]);
}

template <bool GDN>
__device__ __forceinline__ void chunk_prep_task(PP pp, int chain, int b, int h, int d, int n, char* smem) {
  const int tid = tid_opaque(), lane = tid & 63, wv = wave_id(tid);
  const int fr = lane & 15, fq = lane >> 4, mt = wv >> 1, nt0 = (wv & 1) * 2;
  char* S = p.ws + OFF_S;
  char* CH = p.ws + OFF_CH;
  const size_t cc = (size_t)chain * NCHUNK + n;
  char* const p0 = smem;
  char* const p1 = smem + 1 * SLOT_BYTES;
  char* const p2 = smem + 2 * SLOT_BYTES;
  char* const p3 = smem + 3 * SLOT_BYTES;
  char* const p4 = smem + 4 * SLOT_BYTES;
  char* const p5 = smem + 5 * SLOT_BYTES;
  char* const p6 = smem + 6 * SLOT_BYTES;
  char* const p7 = smem + 7 * SLOT_BYTES;
  char* const p8 = smem + 8 * SLOT_BYTES;
  char* const p9 = smem + 9 * SLOT_BYTES;
  char* const p10 = smem + 10 * SLOT_BYTES;
  char* const p11 = smem + 11 * SLOT_BYTES;
  char* const p12 = smem + 12 * SLOT_BYTES;
  float* const F0 = (float*)(smem + X1_F0);
  float* const Lv = (float*)(smem + X1_ARR);
  float* const Lm1v = Lv + 64;
  float* const betav = Lv + 128;
  float* const eLv = Lv + 192;
  float* const gC = Lv + 256;
  float* const gsum = Lv + 320;
  char* const sKt = p0;
  char* const sBh = GDN ? p0 : p1;
  char* const sKh = GDN ? p0 : p2;

  {
    const int c = lane, tg = wv;
    float lw[8], f0[8], f1[8], f2[8], f3[8], xv[8], be[8];
#pragma unroll
    for (int u = 0; u < 8; ++u) {
      const int m = scan_tok(b, d, n * 64 + tg * 8 + u);
      const size_t o = (size_t)m * 256 + h * 64 + c;
      if (!GDN) {
        lw[u] = ((const float*)(S + S_RWW))[(size_t)d * NTOK * 256 + o];
        f0[u] = ((const float*)(S + S_RWKK))[o];
        f1[u] = ((const float*)(S + S_RWB))[(size_t)d * NTOK * 256 + o];
        f2[u] = ((const float*)(S + S_RWKD))[(size_t)d * NTOK * 256 + o];
        f3[u] = ((const float*)(S + S_RWR))[o];
        xv[u] = ((const float*)(S + S_RWV))[o];
        be[u] = 1.f;
      } else {
        lw[u] = ((const float*)(S + S_GDAB))[(size_t)m * 16 + d * 4 + h];
        be[u] = ((const float*)(S + S_GDAB))[(size_t)m * 16 + 8 + d * 4 + h];
        f0[u] = ((const float*)(S + S_GDK))[o];
        f3[u] = ((const float*)(S + S_GDQ))[o];
        xv[u] = ((const float*)(S + S_GDV))[o];
        f1[u] = 0.f; f2[u] = 0.f;
      }
    }
    float cum[8];
    cum[0] = lw[0];
#pragma unroll
    for (int u = 1; u < 8; ++u) cum[u] = cum[u - 1] + lw[u];
    gsum[tg * 64 + c] = cum[7];
    __syncthreads();
    float off = 0.f, LC = 0.f;
#pragma unroll
    for (int g2 = 0; g2 < 8; ++g2) { const float gs = gsum[g2 * 64 + c]; LC += gs; off += (g2 < tg) ? gs : 0.f; }
    bf16x8 vKtT, vBbT, vKbT, vXT;
#pragma unroll
    for (int u = 0; u < 8; ++u) {
      const int t = tg * 8 + u;
      const float L = off + cum[u], Lm1 = L - lw[u];
      if (!GDN) {
        const float eLm1 = __expf(Lm1), enL = __expf(-L), eL = __expf(L), eCL = __expf(LC - L);
        const float kt = f0[u] * eLm1;
        *(bfr*)(p0 + (t * CS + c) * 2) = f2bf(kt);
        *(bfr*)(p1 + (t * CS + c) * 2) = f2bf(f1[u] * enL);
        *(bfr*)(p2 + (t * CS + c) * 2) = f2bf(f2[u] * enL);
        *(bfr*)(p3 + (t * CS + c) * 2) = f2bf(f3[u] * eL);
        vKtT[u] = (short)f2bf(kt);
        vBbT[u] = (short)f2bf(f1[u] * eCL);
        vKbT[u] = (short)f2bf(f2[u] * eCL);
        vXT[u] = (short)f2bf(xv[u]);
      } else {
        *(bfr*)(p0 + (t * CS + c) * 2) = f2bf(f0[u]);
        *(bfr*)(p3 + (t * CS + c) * 2) = f2bf(f3[u]);
        vKtT[u] = (short)f2bf(f0[u] * __expf(Lm1));
        vBbT[u] = (short)f2bf(be[u] * f0[u] * __expf(LC - Lm1));
        vKbT[u] = (short)f2bf(f0[u] * __expf(LC - L));
        vXT[u] = (short)f2bf(be[u] * xv[u]);
        if (c == 0) { Lv[t] = L; Lm1v[t] = Lm1; betav[t] = be[u]; eLv[t] = __expf(L); }
      }
    }
    *(bf16x8*)(p4 + (c * CS + tg * 8) * 2) = vKtT;
    *(bf16x8*)(p5 + (c * CS + tg * 8) * 2) = vBbT;
    *(bf16x8*)(p6 + (c * CS + tg * 8) * 2) = vKbT;
    *(bf16x8*)(p7 + (c * CS + tg * 8) * 2) = vXT;
    if (tg == 0) gC[c] = __expf(LC);
    if (!GDN && tid < 64) { Lv[tid] = 0.f; Lm1v[tid] = 0.f; betav[tid] = 1.f; eLv[tid] = 1.f; }
  }
  __syncthreads();
  {
    {
      MM_FRAGS(sKt, sBh, a0, a1, b00, b01, b10, b11)
      f32x4 c0 = {0.f, 0.f, 0.f, 0.f}, c1 = c0;
      MM_2TILES(c0, c1, a0, a1, b00, b01, b10, b11)
#pragma unroll
      for (int q = 0; q < 2; ++q) {
        const int sI = (nt0 + q) * 16 + fr;
        const f32x4 cv = q ? c1 : c0;
        f32x4 o;
#pragma unroll
        for (int r = 0; r < 4; ++r) {
          const int tI = mt * 16 + 4 * fq + r;
          float v = cv[r];
          if (GDN) v *= betav[sI] * __expf(fminf(Lm1v[tI] - Lm1v[sI], 0.f));
          o[r] = (sI < tI) ? v : 0.f;
        }
        *(f32x4*)(F0 + sI * F0_STRIDE + mt * 16 + 4 * fq) = o;
        wr_T(p11, mt, nt0 + q, fr, fq, o);
      }
    }
    {
      MM_FRAGS(sKt, sKh, a0, a1, b00, b01, b10, b11)
      f32x4 c0 = {0.f, 0.f, 0.f, 0.f}, c1 = c0;
      MM_2TILES(c0, c1, a0, a1, b00, b01, b10, b11)
#pragma unroll
      for (int q = 0; q < 2; ++q) {
        const int sI = (nt0 + q) * 16 + fr;
        const f32x4 cv = q ? c1 : c0;
        f32x4 o;
#pragma unroll
        for (int r = 0; r < 4; ++r) {
          const int tI = mt * 16 + 4 * fq + r;
          float v = cv[r];
          if (GDN) v *= __expf(fminf(Lm1v[tI] - Lv[sI], 0.f));
          o[r] = (sI < tI) ? v : 0.f;
        }
        wr_T(p9, mt, nt0 + q, fr, fq, o);
      }
    }
    {
      MM_FRAGS(sBh, p3, a0, a1, b00, b01, b10, b11)
      f32x4 c0 = {0.f, 0.f, 0.f, 0.f}, c1 = c0;
      MM_2TILES(c0, c1, a0, a1, b00, b01, b10, b11)
#pragma unroll
      for (int q = 0; q < 2; ++q) {
        const int tI = (nt0 + q) * 16 + fr;
        const f32x4 cv = q ? c1 : c0;
        f32x4 o;
#pragma unroll
        for (int r = 0; r < 4; ++r) {
          const int sI = mt * 16 + 4 * fq + r;
          float v = cv[r];
          if (GDN) v *= betav[sI] * __expf(fminf(Lv[tI] - Lm1v[sI], 0.f));
          o[r] = (sI <= tI) ? v : 0.f;
        }
        wr_T(p10, mt, nt0 + q, fr, fq, o);
      }
    }
  }
  __syncthreads();
  if (wv < 2) {
    const int base = wv * 32, other = 32 - base, c = lane & 31;
    float tr[32];
#pragma unroll
    for (int j = 0; j < 32; ++j) tr[j] = 0.f;
#pragma unroll
    for (int i = 31; i >= 0; --i) {
      float acc = (c == i) ? 1.f : 0.f;
#pragma unroll
      for (int jb = ((i + 1) & ~3); jb < 32; jb += 4) {
        const f32x4 a4 = *(const f32x4*)(F0 + (base + i) * F0_STRIDE + base + jb);
        acc -= a4[0] * tr[jb]; acc -= a4[1] * tr[jb + 1]; acc -= a4[2] * tr[jb + 2]; acc -= a4[3] * tr[jb + 3];
      }
      tr[i] = acc;
      if (lane < 32) {
        *(bfr*)(p8 + ((base + i) * CS + base + c) * 2) = f2bf(acc);
        *(bfr*)(p8 + ((base + i) * CS + other + c) * 2) = (bfr)0;
      }
    }
    if (lane < 32) {
#pragma unroll
      for (int q = 0; q < 4; ++q) {
        bf16x8 o, z;
#pragma unroll
        for (int j = 0; j < 8; ++j) { o[j] = (short)f2bf(tr[8 * q + j]); z[j] = 0; }
        *(bf16x8*)(p12 + ((base + c) * CS + base + 8 * q) * 2) = o;
        *(bf16x8*)(p12 + ((base + c) * CS + other + 8 * q) * 2) = z;
      }
    }
  }
  __syncthreads();
  {
    MM_FRAGS(p11, p12, a0, a1, b00, b01, b10, b11)
    f32x4 c0 = {0.f, 0.f, 0.f, 0.f}, c1 = c0;
    MM_2TILES(c0, c1, a0, a1, b00, b01, b10, b11)
    wr_T(p1, mt, nt0, fr, fq, c0);
    wr_T(p1, mt, nt0 + 1, fr, fq, c1);
  }
  __syncthreads();
  if (mt < 2 && nt0 == 2) {
    MM_FRAGS(p8, p1, a0, a1, b00, b01, b10, b11)
    f32x4 c0 = {0.f, 0.f, 0.f, 0.f}, c1 = c0;
    MM_2TILES(c0, c1, a0, a1, b00, b01, b10, b11)
    __builtin_amdgcn_s_waitcnt(0);
#pragma unroll
    for (int r = 0; r < 4; ++r) {
      *(bfr*)(p8 + ((mt * 16 + 4 * fq + r) * CS + (nt0) * 16 + fr) * 2) = f2bf(-c0[r]);
      *(bfr*)(p8 + ((mt * 16 + 4 * fq + r) * CS + (nt0 + 1) * 16 + fr) * 2) = f2bf(-c1[r]);
    }
  }
  __syncthreads();
  {
    {
      MM_FRAGS(p8, p5, a0, a1, b00, b01, b10, b11)
      f32x4 c0 = {0.f, 0.f, 0.f, 0.f}, c1 = c0;
      MM_2TILES(c0, c1, a0, a1, b00, b01, b10, b11)
      wr_T(p11, mt, nt0, fr, fq, -c0);
      wr_T(p11, mt, nt0 + 1, fr, fq, -c1);
    }
    {
      MM_FRAGS(p8, p10, a0, a1, b00, b01, b10, b11)
      f32x4 c0 = {0.f, 0.f, 0.f, 0.f}, c1 = c0;
      MM_2TILES(c0, c1, a0, a1, b00, b01, b10, b11)
      wr_T(p12, mt, nt0, fr, fq, -c0);
      wr_T(p12, mt, nt0 + 1, fr, fq, -c1);
    }
  }
  __syncthreads();
  {
    {
      MM_FRAGS(p4, p11, a0, a1, b00, b01, b10, b11)
      f32x4 c0 = {0.f, 0.f, 0.f, 0.f}, c1 = c0;
      MM_2TILES(c0, c1, a0, a1, b00, b01, b10, b11)
#pragma unroll
      for (int q = 0; q < 2; ++q) {
        const int cp = (nt0 + q) * 16 + fr;
        f32x4 cv = q ? c1 : c0;
#pragma unroll
        for (int r = 0; r < 4; ++r) { const int cI = mt * 16 + 4 * fq + r; if (cI == cp) cv[r] += gC[cI]; }
        wr_T(p10, mt, nt0 + q, fr, fq, cv);
      }
    }
    {
      MM_FRAGS(p9, p11, a0, a1, b00, b01, b10, b11)
      f32x4 c0 = {0.f, 0.f, 0.f, 0.f}, c1 = c0;
      MM_2TILES(c0, c1, a0, a1, b00, b01, b10, b11)
#pragma unroll
      for (int q = 0; q < 2; ++q) {
        const int cp = (nt0 + q) * 16 + fr;
        f32x4 cv = q ? c1 : c0;
        const bf16x4 kb = *(const bf16x4*)(p6 + (cp * CS + mt * 16 + 4 * fq) * 2);
#pragma unroll
        for (int r = 0; r < 4; ++r) cv[r] += __uint_as_float(((unsigned)(unsigned short)kb[r]) << 16);
        wr_T(p8, mt, nt0 + q, fr, fq, cv);
      }
    }
    {
      MM_FRAGS(p4, p12, a0, a1, b00, b01, b10, b11)
      f32x4 c0 = {0.f, 0.f, 0.f, 0.f}, c1 = c0;
      MM_2TILES(c0, c1, a0, a1, b00, b01, b10, b11)
#pragma unroll
      for (int q = 0; q < 2; ++q) {
        const int tI = (nt0 + q) * 16 + fr;
        f32x4 cv = q ? c1 : c0;
        const bf16x4 rt = *(const bf16x4*)(p3 + (tI * CS + mt * 16 + 4 * fq) * 2);
        const float el = eLv[tI];
#pragma unroll
        for (int r = 0; r < 4; ++r) cv[r] += __uint_as_float(((unsigned)(unsigned short)rt[r]) << 16) * el;
        wr_T(p1, mt, nt0 + q, fr, fq, cv);
      }
    }
    {
      f32x4 c0 = {0.f, 0.f, 0.f, 0.f}, c1 = c0;
      {
        MM_FRAGS(sKh, p3, a0, a1, b00, b01, b10, b11)
        MM_2TILES(c0, c1, a0, a1, b00, b01, b10, b11)
      }
#pragma unroll
      for (int q = 0; q < 2; ++q) {
        const int tI = (nt0 + q) * 16 + fr;
#pragma unroll
        for (int r = 0; r < 4; ++r) {
          const int sI = mt * 16 + 4 * fq + r;
          float v = q ? c1[r] : c0[r];
          if (GDN) v *= __expf(fminf(Lv[tI] - Lv[sI], 0.f));
          v = (sI <= tI) ? v : 0.f;
          if (q) c1[r] = v; else c0[r] = v;
        }
      }
      {
        MM_FRAGS(p9, p12, a0, a1, b00, b01, b10, b11)
        MM_2TILES(c0, c1, a0, a1, b00, b01, b10, b11)
      }
      wr_T(p5, mt, nt0, fr, fq, c0);
      wr_T(p5, mt, nt0 + 1, fr, fq, c1);
    }
  }
  __syncthreads();
  {
    {
      MM_FRAGS(p8, p7, a0, a1, b00, b01, b10, b11)
      f32x4 c0 = {0.f, 0.f, 0.f, 0.f}, c1 = c0;
      MM_2TILES(c0, c1, a0, a1, b00, b01, b10, b11)
      float* QT = (float*)(CH + cc * CH_REC + CH_QT);
      *(f32x4*)(QT + ((mt * 4 + nt0) * 64 + lane) * 4) = c0;
      *(f32x4*)(QT + ((mt * 4 + nt0 + 1) * 64 + lane) * 4) = c1;
    }
    {
      const int fm = wv >> 1, fa = wv & 1;
      const int row = fm * 16 + fr;
      {
        const bf16x4 lo = *(const bf16x4*)(p10 + (row * CS + 32 * fa + 4 * fq) * 2);
        const bf16x4 hi = *(const bf16x4*)(p10 + (row * CS + 32 * fa + 16 + 4 * fq) * 2);
        bf16x8 f; f[0] = lo[0]; f[1] = lo[1]; f[2] = lo[2]; f[3] = lo[3]; f[4] = hi[0]; f[5] = hi[1]; f[6] = hi[2]; f[7] = hi[3];
        *(bf16x8*)(CH + cc * CH_REC + CH_PT + (size_t)((fm * 2 + fa) * 64 + lane) * 16) = f;
      }
      {
        const bf16x4 lo = *(const bf16x4*)(p1 + (row * CS + 32 * fa + 4 * fq) * 2);
        const bf16x4 hi = *(const bf16x4*)(p1 + (row * CS + 32 * fa + 16 + 4 * fq) * 2);
        bf16x8 f; f[0] = lo[0]; f[1] = lo[1]; f[2] = lo[2]; f[3] = lo[3]; f[4] = hi[0]; f[5] = hi[1]; f[6] = hi[2]; f[7] = hi[3];
        *(bf16x8*)(CH + cc * CH_REC + CH_RYT + (size_t)((fm * 2 + fa) * 64 + lane) * 16) = f;
      }
      *(bf16x8*)(CH + cc * CH_REC + CH_WYT + (size_t)((fm * 2 + fa) * 64 + lane) * 16) = *(const bf16x8*)(p5 + (row * CS + 32 * fa + 8 * fq) * 2);
      *(bf16x8*)(CH + cc * CH_REC + CH_XT + (size_t)((fm * 2 + fa) * 64 + lane) * 16) = *(const bf16x8*)(p7 + (row * CS + 32 * fa + 8 * fq) * 2);
    }
  }
  __syncthreads();
}

__device__ __forceinline__ void phase_chunk_prep(PP pp, int bid, int nb, char* smem) {
  for (int t = bid; t < NCHAIN * NCHUNK; t += nb) {
    const int chain = t / NCHUNK, n = t - chain * NCHUNK;
    const int d = chain & 1, h = (chain >> 1) & 3, b = (chain >> 3) & 1, ty = chain >> 4;
    if (ty == 0) chunk_prep_task<false>(pp, chain, b, h, d, n, smem);
    else chunk_prep_task<true>(pp, chain, b, h, d, n, smem);
  }
}

#define X2_BUF 49152
__device__ __forceinline__ void chunk_seq_chain(PP pp, int chain, char* smem) {
  const int tid = tid_opaque(), lane = tid & 63, wv = wave_id(tid);
  const int d = chain & 1, h = (chain >> 1) & 3, b = (chain >> 3) & 1, ty = chain >> 4;
  const char* CH = p.ws + OFF_CH;
  float* Y = (float*)(p.ws + OFF_S + (ty ? S_YGD : S_YRW)) + (size_t)d * NTOK * 256;
  const size_t c0 = (size_t)chain * NCHUNK;
  if (wv >= 4) {
    const int lt = tid - 256;
    const char* src0 = CH + c0 * CH_REC + (size_t)lt * 16;
    char* dst0 = smem + (size_t)lt * 16;
#define X2_DECL(R) uint4 R##0, R##1, R##2, R##3, R##4, R##5, R##6, R##7, R##8, R##9, R##10, R##11;
#define X2_ISSUE(R, n) { const char* s_ = src0 + (size_t)(n) * CH_REC;                                                  \
      R##0 = *(const uint4*)(s_); R##1 = *(const uint4*)(s_ + 4096); R##2 = *(const uint4*)(s_ + 8192); R##3 = *(const uint4*)(s_ + 12288);            \
      R##4 = *(const uint4*)(s_ + 16384); R##5 = *(const uint4*)(s_ + 20480); R##6 = *(const uint4*)(s_ + 24576); R##7 = *(const uint4*)(s_ + 28672);  \
      R##8 = *(const uint4*)(s_ + 32768); R##9 = *(const uint4*)(s_ + 36864); R##10 = *(const uint4*)(s_ + 40960); R##11 = *(const uint4*)(s_ + 45056); }
#define X2_WRITE(R, n) { char* d_ = dst0 + ((n) & 1) * X2_BUF;                                                           \
      *(uint4*)(d_) = R##0; *(uint4*)(d_ + 4096) = R##1; *(uint4*)(d_ + 8192) = R##2; *(uint4*)(d_ + 12288) = R##3;          \
      *(uint4*)(d_ + 16384) = R##4; *(uint4*)(d_ + 20480) = R##5; *(uint4*)(d_ + 24576) = R##6; *(uint4*)(d_ + 28672) = R##7; \
      *(uint4*)(d_ + 32768) = R##8; *(uint4*)(d_ + 36864) = R##9; *(uint4*)(d_ + 40960) = R##10; *(uint4*)(d_ + 45056) = R##11; }
    X2_DECL(ra) X2_DECL(rb) X2_DECL(rc)
    X2_ISSUE(ra, 0) X2_ISSUE(rb, 1) X2_ISSUE(rc, 2)
    X2_WRITE(ra, 0) X2_ISSUE(ra, 3)
    __syncthreads();
    for (int n = 0; n < NCHUNK; n += 3) {
      if (n + 1 < NCHUNK) X2_WRITE(rb, n + 1)
      if (n + 4 < NCHUNK) X2_ISSUE(rb, n + 4)
      __syncthreads();
      if (n + 1 < NCHUNK) {
        if (n + 2 < NCHUNK) X2_WRITE(rc, n + 2)
        if (n + 5 < NCHUNK) X2_ISSUE(rc, n + 5)
        __syncthreads();
      }
      if (n + 2 < NCHUNK) {
        if (n + 3 < NCHUNK) X2_WRITE(ra, n + 3)
        if (n + 6 < NCHUNK) X2_ISSUE(ra, n + 6)
        __syncthreads();
      }
    }
#undef X2_DECL
#undef X2_ISSUE
#undef X2_WRITE
  } else {
    const int vt = wv, fr = lane & 15, fq = lane >> 4;
    f32x4 Sacc[4];
#pragma unroll
    for (int i = 0; i < 4; ++i) Sacc[i] = (f32x4){0.f, 0.f, 0.f, 0.f};
    __syncthreads();
    for (int n = 0; n < NCHUNK; ++n) {
      const char* buf = smem + (n & 1) * X2_BUF;
      bf16x8 sB0, sB1;
#pragma unroll
      for (int j = 0; j < 4; ++j) {
        sB0[j] = (short)f2bf(Sacc[0][j]); sB0[4 + j] = (short)f2bf(Sacc[1][j]);
        sB1[j] = (short)f2bf(Sacc[2][j]); sB1[4 + j] = (short)f2bf(Sacc[3][j]);
      }
      const bf16x8 xB0 = *(const bf16x8*)(buf + 24576 + ((vt * 2 + 0) * 64 + lane) * 16);
      const bf16x8 xB1 = *(const bf16x8*)(buf + 24576 + ((vt * 2 + 1) * 64 + lane) * 16);
#pragma unroll
      for (int m = 0; m < 4; ++m) {
        const bf16x8 pa0 = *(const bf16x8*)(buf + ((m * 2 + 0) * 64 + lane) * 16);
        const bf16x8 pa1 = *(const bf16x8*)(buf + ((m * 2 + 1) * 64 + lane) * 16);
        const bf16x8 ra0 = *(const bf16x8*)(buf + 8192 + ((m * 2 + 0) * 64 + lane) * 16);
        const bf16x8 ra1 = *(const bf16x8*)(buf + 8192 + ((m * 2 + 1) * 64 + lane) * 16);
        const bf16x8 wa0 = *(const bf16x8*)(buf + 16384 + ((m * 2 + 0) * 64 + lane) * 16);
        const bf16x8 wa1 = *(const bf16x8*)(buf + 16384 + ((m * 2 + 1) * 64 + lane) * 16);
        const f32x4 qt = *(const f32x4*)(buf + 32768 + ((m * 4 + vt) * 64 + lane) * 16);
        f32x4 y = {0.f, 0.f, 0.f, 0.f};
        y = __builtin_amdgcn_mfma_f32_16x16x32_bf16(ra0, sB0, y, 0, 0, 0);
        y = __builtin_amdgcn_mfma_f32_16x16x32_bf16(ra1, sB1, y, 0, 0, 0);
        y = __builtin_amdgcn_mfma_f32_16x16x32_bf16(wa0, xB0, y, 0, 0, 0);
        y = __builtin_amdgcn_mfma_f32_16x16x32_bf16(wa1, xB1, y, 0, 0, 0);
        f32x4 sn = __builtin_amdgcn_mfma_f32_16x16x32_bf16(pa0, sB0, qt, 0, 0, 0);
        sn = __builtin_amdgcn_mfma_f32_16x16x32_bf16(pa1, sB1, sn, 0, 0, 0);
        Sacc[m] = sn;
#pragma unroll
        for (int r = 0; r < 4; ++r) {
          const int mm = scan_tok(b, d, n * 64 + m * 16 + 4 * fq + r);
          Y[(size_t)mm * 256 + h * 64 + vt * 16 + fr] = y[r];
        }
      }
      __syncthreads();
    }
  }
}

__device__ __forceinline__ void na_pair(const bfr* KN, const bfr* VT, const bf16x8 qf0, const bf16x8 qf1,
                                        int mk0, int mk1, size_t vt_base, int tau0, int tau1, int h, int lane,
                                        bool local, int kr0, int kr1, int ct0, int ct1, int qr, int qc, const float* bias_h,
                                        f32x4 (&O)[4], float& lsum) {
  const int fr = lane & 15, fq = lane >> 4;
  const bf16x8 k00 = *(const bf16x8*)(KN + (size_t)(mk0 + fr) * 512 + h * 64 + fq * 8);
  const bf16x8 k01 = *(const bf16x8*)(KN + (size_t)(mk0 + fr) * 512 + h * 64 + 32 + fq * 8);
  const bf16x8 k10 = *(const bf16x8*)(KN + (size_t)(mk1 + fr) * 512 + h * 64 + fq * 8);
  const bf16x8 k11 = *(const bf16x8*)(KN + (size_t)(mk1 + fr) * 512 + h * 64 + 32 + fq * 8);
  f32x4 z = {0.f, 0.f, 0.f, 0.f};
  f32x4 st0 = __builtin_amdgcn_mfma_f32_16x16x32_bf16(k00, qf0, z, 0, 0, 0);
  st0 = __builtin_amdgcn_mfma_f32_16x16x32_bf16(k01, qf1, st0, 0, 0, 0);
  f32x4 st1 = __builtin_amdgcn_mfma_f32_16x16x32_bf16(k10, qf0, z, 0, 0, 0);
  st1 = __builtin_amdgcn_mfma_f32_16x16x32_bf16(k11, qf1, st1, 0, 0, 0);
  bf16x8 pf;
  if (local) {
    int cs = min(max(qc - 8, 0), 48);
#pragma unroll
    for (int r = 0; r < 4; ++r) {
      int kc0 = ct0 * 16 + fq * 4 + r;
      int kc1 = ct1 * 16 + fq * 4 + r;
      float p0 = 0.f, p1 = 0.f;
      if ((unsigned)(kc0 - cs) < 16u) p0 = exp2f(st0[r] + bias_h[(kr0 - qr + 7) * 31 + (kc0 - qc + 15)]);
      if ((unsigned)(kc1 - cs) < 16u) p1 = exp2f(st1[r] + bias_h[(kr1 - qr + 7) * 31 + (kc1 - qc + 15)]);
      lsum += p0 + p1;
      pf[r] = (short)f2bf(p0);
      pf[4 + r] = (short)f2bf(p1);
    }
  } else {
#pragma unroll
    for (int r = 0; r < 4; ++r) {
      float p0 = exp2f(st0[r]), p1 = exp2f(st1[r]);
      lsum += p0 + p1;
      pf[r] = (short)f2bf(p0);
      pf[4 + r] = (short)f2bf(p1);
    }
  }
#pragma unroll
  for (int dt = 0; dt < 4; ++dt) {
    const bfr* vrow = VT + vt_base + (size_t)(dt * 16 + fr) * TTOK;
    bf16x4 v0 = *(const bf16x4*)(vrow + tau0 + fq * 4);
    bf16x4 v1 = *(const bf16x4*)(vrow + tau1 + fq * 4);
    bf16x8 vf;
    vf[0] = v0[0]; vf[1] = v0[1]; vf[2] = v0[2]; vf[3] = v0[3];
    vf[4] = v1[0]; vf[5] = v1[1]; vf[6] = v1[2]; vf[7] = v1[3];
    O[dt] = __builtin_amdgcn_mfma_f32_16x16x32_bf16(vf, pf, O[dt], 0, 0, 0);
  }
}

__device__ __forceinline__ void na_block_task(PP pp, int task, const float* bias_lds) {
  const int tid = tid_opaque(), lane = tid & 63, wv = wave_id(tid);
  const int fr = lane & 15, fq = lane >> 4;
  char* S = p.ws + OFF_S;
  const bfr* QN = (const bfr*)(S + S_QN);
  const bfr* KN = (const bfr*)(S + S_KN);
  const bfr* VT = (const bfr*)(S + S_VT);
  bfr* CC = (bfr*)(p.ws + OFF_CC);
  int b, h, mq0;
  bool latent = task < 2048;
  int qr = 0, cgp = 0;
  if (latent) {
    h = task & 7; int rp = (task >> 3) & 127; b = task >> 10;
    qr = rp * 2 + (wv >> 2); cgp = wv & 3;
    mq0 = b * SEQ + qr * 64 + cgp * 16;
  } else {
    int u = task - 2048;
    int half = u & 1; h = (u >> 1) & 7; b = u >> 4;
    mq0 = NLAT + b * CTXL + (half * 8 + wv) * 16;
  }
  const bf16x8 qf0 = *(const bf16x8*)(QN + (size_t)(mq0 + fr) * 512 + h * 64 + fq * 8);
  const bf16x8 qf1 = *(const bf16x8*)(QN + (size_t)(mq0 + fr) * 512 + h * 64 + 32 + fq * 8);
  f32x4 O[4];
#pragma unroll
  for (int dt = 0; dt < 4; ++dt) O[dt] = (f32x4){0.f, 0.f, 0.f, 0.f};
  float lsum = 0.f;
  const size_t vt_base = (size_t)(b * 8 + h) * 64 * TTOK;
  if (latent) {
    const int rs = min(max(qr - 4, 0), SEQ / 64 - 8);
    const int ct_first = (cgp <= 1) ? 0 : cgp - 1;
    const int nct = (cgp == 0 || cgp == 3) ? 2 : 3;
    const int npair = 4 * nct;
    const int qc = cgp * 16 + fr;
    for (int pi = 0; pi < npair; ++pi) {
      int i0 = 2 * pi, i1 = 2 * pi + 1;
      int kr0 = rs + i0 / nct, c0 = ct_first + i0 % nct;
      int kr1 = rs + i1 / nct, c1 = ct_first + i1 % nct;
      int t0 = kr0 * 64 + c0 * 16, t1 = kr1 * 64 + c1 * 16;
      na_pair(KN, VT, qf0, qf1, b * SEQ + t0, b * SEQ + t1, vt_base, t0, t1, h, lane, true, kr0, kr1, c0, c1, qr, qc,
              bias_lds + h * 465, O, lsum);
    }
  }
  for (int pi = 0; pi < 8; ++pi) {
    int t0 = pi * 32, t1 = pi * 32 + 16;
    na_pair(KN, VT, qf0, qf1, NLAT + b * CTXL + t0, NLAT + b * CTXL + t1, vt_base, SEQ + t0, SEQ + t1, h, lane, false,
            0, 0, 0, 0, 0, 0, bias_lds, O, lsum);
  }
  lsum += shfl_xor_l(lsum, 16, lane);
  lsum += shfl_xor_l(lsum, 32, lane);
  float inv = 1.f / lsum;
#pragma unroll
  for (int dt = 0; dt < 4; ++dt) {
    bf16x4 o;
#pragma unroll
    for (int r = 0; r < 4; ++r) o[r] = (short)f2bf(O[dt][r] * inv);
    *(bf16x4*)(CC + (size_t)(mq0 + fr) * 1024 + h * 64 + dt * 16 + fq * 4) = o;
  }
}

__device__ __forceinline__ void phase_mix(PP pp, int l, int bid, int nb, char* smem) {
  const int tid = tid_opaque();
  const int nscan_blocks = (nb > 32) ? 32 : nb;
  const int first_attn_block = (nb > 32) ? 32 : 0;
  if (bid < nscan_blocks) {
    for (int c = bid; c < NCHAIN; c += nscan_blocks) chunk_seq_chain(pp, c, smem);
  }
  if (bid >= first_attn_block) {
    float* bias = (float*)smem;
    __syncthreads();
    for (int i = tid; i < 8 * 465; i += NTHR) bias[i] = p.na_rpb[(size_t)l * 8 * 465 + i] * 1.4426950408889634f;
    __syncthreads();
    const int ntask = (l == 0) ? 2048 + 32 : 2048;
    const int nab = nb - first_attn_block;
    for (int t = bid - first_attn_block; t < ntask; t += nab) na_block_task(pp, t, bias);
  }
}

__device__ __forceinline__ void phase_post(PP pp, int l, int bid, int nb) {
  const int tid = tid_opaque(), lane = tid & 63, wv = wave_id(tid);
  char* S = p.ws + OFF_S;
  const float* YRW = (const float*)(S + S_YRW);
  const float* YGD = (const float*)(S + S_YGD);
  const float* RWV = (const float*)(S + S_RWV);
  const float* RWG = (const float*)(S + S_RWG);
  const float* BON = (const float*)(S + S_BON);
  const float* P = (const float*)(p.ws + OFF_P);
  bfr* CC = (bfr*)(p.ws + OFF_CC);
  const float* ln_w = p.rw_ln_w + (size_t)l * 256;
  const float* ln_b = p.rw_ln_b + (size_t)l * 256;
  const float* ng = p.gd_norm_g + (size_t)l * 64;
  const int ntok = (l == 0) ? NTOK : NLAT;
  for (int wt = bid * 8 + wv; wt < ntok * 8; wt += nb * 8) {
    int m = wt >> 3, hs = wt & 7;
    if (hs < 4) {
      int c = hs * 64 + lane;
      size_t o = (size_t)m * 256 + c;
      float y = YRW[o] + YRW[(size_t)NTOK * 256 + o];
      float mean = wave_sum(y) * (1.f / 64.f);
      float dv = y - mean;
      float var = wave_sum(dv * dv) * (1.f / 64.f);
      float yn = dv * rsqrtf(var + 64e-5f) * ln_w[c] + ln_b[c];
      float out = (yn + BON[(size_t)m * 4 + hs] * RWV[o]) * RWG[o];
      CC[(size_t)m * 1024 + 512 + c] = f2bf(out);
    } else {
      int c = (hs - 4) * 64 + lane;
      size_t o = (size_t)m * 256 + c;
      float y = YGD[o] + YGD[(size_t)NTOK * 256 + o];
      float ms = wave_sum(y * y) * (1.f / 64.f);
      float z = P[(size_t)m * PINP + B_END + 768 + c];
      float out = y * rsqrtf(ms + 1e-6f) * ng[lane] * siluf_(z);
      CC[(size_t)m * 1024 + 768 + c] = f2bf(out);
    }
  }
}

#define RW_LDS_ROW 36
__device__ __forceinline__ void phase_router(PP pp, int l, int bid, int nb, char* smem) {
  const int tid = tid_opaque(), lane = tid & 63, wv = wave_id(tid);
  const float* xl = p.out;
  const float* xc = (const float*)(p.ws + OFF_CTX);
  const float* mods = (const float*)(p.ws + OFF_MODS) + (size_t)l * 3 * 6144;
  const float* g = p.norm_ffn_g + (size_t)l * 1024;
  const float* rw = p.moe_router_w + (size_t)l * 1024 * 32;
  const float* rb = p.moe_router_b + (size_t)l * 32;
  bfr* H = (bfr*)(p.ws + OFF_H);
  int* cnt = (int*)(p.ws + OFF_CNT);
  int* TOKE = (int*)(p.ws + OFF_TOKE);
  int* TOKP = (int*)(p.ws + OFF_TOKP);
  float* TOKG = (float*)(p.ws + OFF_TOKG);
  float* wl = (float*)smem;
  for (int i = tid; i < 1024 * 8; i += NTHR) {
    int d = i >> 3, q = i & 7;
    *(float4*)(wl + d * RW_LDS_ROW + q * 4) = *(const float4*)(rw + (size_t)d * 32 + q * 4);
  }
  __syncthreads();
  const int ntok = (l == 0) ? NTOK : NLAT;
  const float rbl = rb[lane & 31];
  for (int m0 = (bid * 8 + wv) * 2; m0 < ntok; m0 += nb * 16) {
    float acc0[32], acc1[32];
#pragma unroll
    for (int e = 0; e < 32; ++e) { acc0[e] = 0.f; acc1[e] = 0.f; }
    float hv0[16], hv1[16];
    {
      const int ma = m0, mb = m0 + 1;
      const float* xa = (ma < NLAT) ? xl + (size_t)ma * 1024 : xc + (size_t)(ma - NLAT) * 1024;
      const float* xb = (mb < NLAT) ? xl + (size_t)mb * 1024 : xc + (size_t)(mb - NLAT) * 1024;
      const float* mda = mods + (size_t)mod_row(ma) * 6144 + 3072;
      const float* mdb = mods + (size_t)mod_row(mb) * 6144 + 3072;
      float ssa = 0.f, ssb = 0.f;
#pragma unroll
      for (int i = 0; i < 16; ++i) { hv0[i] = xa[lane + 64 * i]; hv1[i] = xb[lane + 64 * i]; }
#pragma unroll
      for (int i = 0; i < 16; ++i) { ssa += hv0[i] * hv0[i]; ssb += hv1[i] * hv1[i]; }
      ssa = wave_sum(ssa); ssb = wave_sum(ssb);
      const float rsa = rsqrtf(ssa * (1.f / 1024.f) + 1e-6f), rsb = rsqrtf(ssb * (1.f / 1024.f) + 1e-6f);
#pragma unroll
      for (int i = 0; i < 16; ++i) {
        const int d = lane + 64 * i;
        const float gg = g[d];
        hv0[i] = hv0[i] * rsa * gg * (1.f + mda[1024 + d]) + mda[d];
        hv1[i] = hv1[i] * rsb * gg * (1.f + mdb[1024 + d]) + mdb[d];
        H[(size_t)ma * 1024 + d] = f2bf(hv0[i]);
        H[(size_t)mb * 1024 + d] = f2bf(hv1[i]);
      }
    }
#pragma unroll
    for (int i = 0; i < 16; ++i) {
      const float* wr = wl + (lane + 64 * i) * RW_LDS_ROW;
#pragma unroll
      for (int q = 0; q < 8; ++q) {
        const float4 w = *(const float4*)(wr + q * 4);
        acc0[q * 4 + 0] += hv0[i] * w.x; acc0[q * 4 + 1] += hv0[i] * w.y; acc0[q * 4 + 2] += hv0[i] * w.z; acc0[q * 4 + 3] += hv0[i] * w.w;
        acc1[q * 4 + 0] += hv1[i] * w.x; acc1[q * 4 + 1] += hv1[i] * w.y; acc1[q * 4 + 2] += hv1[i] * w.z; acc1[q * 4 + 3] += hv1[i] * w.w;
      }
    }
#define BFLY(A, N, D)                                                                           \
    _Pragma("unroll") for (int i = 0; i < (N); ++i) {                                            \
      const bool up = (lane & (D)) != 0;                                                         \
      const float keep = up ? A[i + (N)] : A[i];                                                 \
      const float send = up ? A[i] : A[i + (N)];                                                 \
      A[i] = keep + shfl_xor_l(send, (D), lane);                                                   \
    }
    BFLY(acc0, 16, 16) BFLY(acc1, 16, 16)
    BFLY(acc0, 8, 8) BFLY(acc1, 8, 8)
    BFLY(acc0, 4, 4) BFLY(acc1, 4, 4)
    BFLY(acc0, 2, 2) BFLY(acc1, 2, 2)
    BFLY(acc0, 1, 1) BFLY(acc1, 1, 1)
#undef BFLY
    float la = acc0[0] + shfl_xor_l(acc0[0], 32, lane);
    float lb = acc1[0] + shfl_xor_l(acc1[0], 32, lane);
    const int my_e = lane & 31;
    la += rbl; lb += rbl;
    (void)my_e;
#pragma unroll
    for (int tkn = 0; tkn < 2; ++tkn) {
      float v = tkn == 0 ? la : lb;
      float tv[4]; int ti[4];
#pragma unroll
      for (int k = 0; k < 4; ++k) {
        float bv = v; int bi = lane & 31;
#pragma unroll
        for (int o = 16; o >= 1; o >>= 1) {
          float ov = shfl_xor_l(bv, o, lane); int oi = shfl_xor_li(bi, o, lane);
          bool take = (ov > bv) || (ov == bv && oi < bi);
          bv = take ? ov : bv; bi = take ? oi : bi;
        }
        tv[k] = bv; ti[k] = bi;
        if ((lane & 31) == bi) v = -3.0e38f;
      }
      float e1 = __expf(tv[1] - tv[0]), e2 = __expf(tv[2] - tv[0]), e3 = __expf(tv[3] - tv[0]);
      float inv = 1.f / (1.f + e1 + e2 + e3);
      const int m = m0 + tkn;
      if (lane < 4) {
        int e = lane == 0 ? ti[0] : lane == 1 ? ti[1] : lane == 2 ? ti[2] : ti[3];
        float gt = (lane == 0 ? 1.f : lane == 1 ? e1 : lane == 2 ? e2 : e3) * inv;
        int pos = atomicAdd(&cnt[e], 1);
        TOKE[(size_t)m * 4 + lane] = e; TOKP[(size_t)m * 4 + lane] = pos; TOKG[(size_t)m * 4 + lane] = gt;
      }
    }
  }
  __syncthreads();
}

__device__ __forceinline__ void moe_offsets(PP pp, int* toff) {
  const int* cnt = (const int*)(p.ws + OFF_CNT);
  if (tid_opaque() == 0) {
    int a = 0;
    for (int e = 0; e < 32; ++e) { toff[e] = a; a += (cnt[e] + 255) >> 8; }
    toff[32] = a;
  }
  __syncthreads();
}

__device__ __forceinline__ void phase_slotfill(PP pp, int l, int bid, int nb, char* smem) {
  int* toff = (int*)smem;
  moe_offsets(pp, toff);
  const int tid = tid_opaque(), lane = tid & 63, wv = wave_id(tid);
  const int* TOKE = (const int*)(p.ws + OFF_TOKE);
  const int* TOKP = (const int*)(p.ws + OFF_TOKP);
  const float* TOKG = (const float*)(p.ws + OFF_TOKG);
  const int* cnt = (const int*)(p.ws + OFF_CNT);
  int* TOKS = (int*)(p.ws + OFF_TOKS);
  float* SLG = (float*)(p.ws + OFF_SLG);
  const bfr* H = (const bfr*)(p.ws + OFF_H);
  bfr* XG = (bfr*)(p.ws + OFF_S);
  const int n = ((l == 0) ? NTOK : NLAT) * 4;
  for (int i = bid * 8 + wv; i < n; i += nb * 8) {
    int e = TOKE[i];
    int slot = toff[e] * 256 + TOKP[i];
    if (lane == 0) { TOKS[i] = slot; SLG[slot] = TOKG[i]; }
    const uint4* src = (const uint4*)(H + (size_t)(i >> 2) * 1024);
    uint4* dst = (uint4*)(XG + (size_t)slot * 1024);
    dst[lane] = src[lane];
    dst[lane + 64] = src[lane + 64];
  }
  for (int e = 0; e < 32; ++e) {
    const int c = cnt[e];
    const int npad = ((c + 255) & ~255) - c;
    const int base = toff[e] * 256 + c;
    for (int r = bid * 8 + wv; r < npad; r += nb * 8) {
      uint4* dst = (uint4*)(XG + (size_t)(base + r) * 1024);
      dst[lane] = make_uint4(0u, 0u, 0u, 0u);
      dst[lane + 64] = make_uint4(0u, 0u, 0u, 0u);
    }
  }
  __syncthreads();
}

struct EpiMoe1 {
  const float* bgu; bfr* ACT;
  __device__ __forceinline__ void operator()(const f32x4 (&acc)[2][2][4][2], const g8::GUnit& u, int wr, int wc, int fr, int fq) const {
    const float* be = bgu + (size_t)u.e * 2048;
    const int slot0 = u.pm * 256 + wr * 64 + fr;
#pragma unroll
    for (int bj = 0; bj < 2; ++bj) {
      const int j0 = u.pn * 128 + bj * 64 + wc * 16 + 4 * fq;
      const f32x4 bg = *(const f32x4*)(be + j0), bl = *(const f32x4*)(be + 1024 + j0);
#pragma unroll
      for (int ai = 0; ai < 2; ++ai)
#pragma unroll
        for (int m = 0; m < 4; ++m) {
          const f32x4 g = acc[ai][bj][m][0] + bg, li = acc[ai][bj][m][1] + bl;
          bf16x4 o;
#pragma unroll
          for (int q = 0; q < 4; ++q) {
            float gv = fminf(g[q], 7.f);
            float lv = fminf(fmaxf(li[q], -7.f), 7.f);
            o[q] = (short)f2bf(gv * sigmoidf_(1.702f * gv) * (lv + 1.f));
          }
          *(bf16x4*)(ACT + (size_t)(slot0 + ai * 128 + m * 16) * 1024 + j0) = o;
        }
    }
  }
};
__device__ __forceinline__ void phase_moe1_impl(PP pp, int l, int bid, int nb, char* smem, int* toff) {
  moe_offsets(pp, toff);
  g8::MoeSched S{toff, 8, 2048, nb, bid};
  EpiMoe1 E{p.moe_b_gu + (size_t)l * 32 * 2048, (bfr*)(p.ws + OFF_P)};
  g8::gemm_stream((LAS unsigned char*)smem, (const bfr*)(p.ws + OFF_S), (const bfr*)(p.ws + OFF_W + (size_t)l * WL_SIZE + WL_GU), S, E);
}

struct EpiMoe2 {
  const float* bdn; const float* SLG; float* YS;
  __device__ __forceinline__ void operator()(const f32x4 (&acc)[2][2][4][2], const g8::GUnit& u, int wr, int wc, int fr, int fq) const {
    const float* be = bdn + (size_t)u.e * 1024;
    const int slot0 = u.pm * 256 + wr * 64 + fr, col0 = u.pn * 256 + wc * 32 + 4 * fq;
#pragma unroll
    for (int ai = 0; ai < 2; ++ai)
#pragma unroll
      for (int m = 0; m < 4; ++m) {
        const int slot = slot0 + ai * 128 + m * 16;
        const float gt = SLG[slot];
#pragma unroll
        for (int bj = 0; bj < 2; ++bj)
#pragma unroll
          for (int n = 0; n < 2; ++n) {
            const f32x4 bv = *(const f32x4*)(be + col0 + bj * 128 + n * 16);
            *(f32x4*)(YS + (size_t)slot * 1024 + col0 + bj * 128 + n * 16) = (acc[ai][bj][m][n] + bv) * gt;
          }
      }
  }
};
__device__ __forceinline__ void phase_moe2_impl(PP pp, int l, int bid, int nb, char* smem, int* toff) {
  moe_offsets(pp, toff);
  g8::MoeSched S{toff, 4, 1024, nb, bid};
  EpiMoe2 E{p.moe_b_down + (size_t)l * 32 * 1024, (const float*)(p.ws + OFF_SLG), (float*)(p.ws + OFF_S)};
  g8::gemm_stream((LAS unsigned char*)smem, (const bfr*)(p.ws + OFF_P), (const bfr*)(p.ws + OFF_W + (size_t)l * WL_SIZE + WL_DN), S, E);
}

__device__ __forceinline__ void phase_combine(PP pp, int l, int bid, int nb) {
  const int tid = tid_opaque(), lane = tid & 63, wv = wave_id(tid);
  const float* YS = (const float*)(p.ws + OFF_S);
  const int* TOKS = (const int*)(p.ws + OFF_TOKS);
  const float* mods = (const float*)(p.ws + OFF_MODS) + (size_t)l * 3 * 6144;
  float* xl = p.out;
  float* xc = (float*)(p.ws + OFF_CTX);
  const int ntok = (l == 0) ? NTOK : NLAT;
  for (int m = bid * 8 + wv; m < ntok; m += nb * 8) {
    float* xr = (m < NLAT) ? xl + (size_t)m * 1024 : xc + (size_t)(m - NLAT) * 1024;
    const float* g2 = mods + (size_t)mod_row(m) * 6144 + 5120;
    int s0 = TOKS[(size_t)m * 4], s1 = TOKS[(size_t)m * 4 + 1], s2 = TOKS[(size_t)m * 4 + 2], s3 = TOKS[(size_t)m * 4 + 3];
#pragma unroll
    for (int i = 0; i < 4; ++i) {
      int d = (lane + 64 * i) * 4;
      float4 a = *(const float4*)(YS + (size_t)s0 * 1024 + d);
      float4 b = *(const float4*)(YS + (size_t)s1 * 1024 + d);
      float4 c = *(const float4*)(YS + (size_t)s2 * 1024 + d);
      float4 e = *(const float4*)(YS + (size_t)s3 * 1024 + d);
      float4 gg = *(const float4*)(g2 + d);
      float4 xv = *(const float4*)(xr + d);
      xv.x += gg.x * (a.x + b.x + c.x + e.x);
      xv.y += gg.y * (a.y + b.y + c.y + e.y);
      xv.z += gg.z * (a.z + b.z + c.z + e.z);
      xv.w += gg.w * (a.w + b.w + c.w + e.w);
      *(float4*)(xr + d) = xv;
    }
  }
}

#define XB_TMO      128
#define XB_XCNT(j)  (256  + 64 * (j))
#define XB_XSUB(j)  (1280 + 64 * (j))
#define XB_XGEN(j)  (2304 + 64 * (j))
#define XB_TOP      3328
#define XB_TOPGEN   3392
#define XCD_BAR_WORDS 3456
#define XB_SPIN_CAP (1u << 22)
__device__ __forceinline__ unsigned xb_ld(unsigned* q) { return __hip_atomic_load(q, __ATOMIC_RELAXED, __HIP_MEMORY_SCOPE_AGENT); }
__device__ __forceinline__ unsigned xb_add(unsigned* q, unsigned v) { return __hip_atomic_fetch_add(q, v, __ATOMIC_RELAXED, __HIP_MEMORY_SCOPE_AGENT); }
__device__ __forceinline__ unsigned xb_xcc_id() { return (unsigned)__builtin_amdgcn_s_getreg((3 << 11) | 20) & 0xFu; }
#define XB_SPIN(cond, bar) do { unsigned _sp = 0; while (cond) { __builtin_amdgcn_s_sleep(1); \
    if ((++_sp & 255u) == 0u) { if (xb_ld(&(bar)[XB_TMO])) break; if (_sp > XB_SPIN_CAP) { atomicAdd(&(bar)[XB_TMO], 1u); break; } } } } while (0)
struct XcdBarrier { unsigned* bar; unsigned x; volatile LAS unsigned* st; };
__device__ __forceinline__ XcdBarrier xcd_barrier_post(unsigned* bar, volatile LAS unsigned* st) {
  XcdBarrier b; b.bar = bar; b.x = xb_xcc_id(); b.st = st;
  if (tid_opaque() == 0) (void)xb_add(&bar[XB_XCNT(b.x)], 1u);
  return b;
}
__device__ __forceinline__ void xcd_barrier_complete(unsigned* bar, unsigned x, unsigned& nloc, unsigned& nx) {
  const unsigned G = gridDim.x;
  unsigned sum, cnt, mine, sp = 0u;
  for (;;) {
    sum = 0u; cnt = 0u; mine = 0u;
#pragma unroll
    for (unsigned j = 0; j < 16; ++j) { const unsigned c = xb_ld(&bar[XB_XCNT(j)]); sum += c; cnt += (c > 0u) ? 1u : 0u; mine = (j == x) ? c : mine; }
    if (sum == G) break;
    __builtin_amdgcn_s_sleep(1);
    if ((++sp & 255u) == 0u) { if (xb_ld(&bar[XB_TMO])) break; if (sp > XB_SPIN_CAP) { atomicAdd(&bar[XB_TMO], 1u); break; } }
  }
  nloc = mine > 0u ? mine : 1u; nx = cnt > 0u ? cnt : 1u;
}
__device__ __forceinline__ void xcd_barrier(const XcdBarrier& b) {
  asm volatile("s_waitcnt vmcnt(0)" ::: "memory");
  __syncthreads();
  if (tid_opaque() == 0) {
    unsigned* bar = b.bar;
    __builtin_amdgcn_s_waitcnt(0);
    unsigned nloc = b.st[0], nx = b.st[1];
    if (nloc == 0u) { xcd_barrier_complete(bar, b.x, nloc, nx); b.st[0] = nloc; b.st[1] = nx; }
    const unsigned old = xb_add(&bar[XB_XSUB(b.x)], 1u);
    const unsigned gen = old / nloc;
    if (old + 1u == (gen + 1u) * nloc) {
      __builtin_amdgcn_fence(__ATOMIC_RELEASE, "agent");
      asm volatile("s_waitcnt vmcnt(0)" ::: "memory");
      const unsigned og = xb_add(&bar[XB_TOP], 1u);
      const unsigned tg = og / nx;
      if (og + 1u == (tg + 1u) * nx) xb_add(&bar[XB_TOPGEN], 1u);
      else XB_SPIN(xb_ld(&bar[XB_TOPGEN]) == tg, bar);
      __builtin_amdgcn_fence(__ATOMIC_ACQUIRE, "agent");
      xb_add(&bar[XB_XGEN(b.x)], 1u);
      asm volatile("s_waitcnt vmcnt(0)" ::: "memory");
    } else {
      XB_SPIN(xb_ld(&bar[XB_XGEN(b.x)]) == gen, bar);
      __builtin_amdgcn_fence(__ATOMIC_ACQUIRE, "agent");
      asm volatile("s_waitcnt vmcnt(0)" ::: "memory");
    }
  }
  __syncthreads();
}

extern __shared__ __attribute__((aligned(16))) char dyn_smem[];

__global__ void __launch_bounds__(NTHR) mega(Params p_unused) {
  cg::grid_group grid = cg::this_grid();
  const int bid0 = blockIdx.x, nb0 = gridDim.x;
#if defined(__HIP_DEVICE_COMPILE__)
  PP pp0 = (PP)__builtin_amdgcn_kernarg_segment_ptr();
#else
  PP pp0 = nullptr;
#endif
#define pp ({ PP q_ = pp0; asm volatile("" : "+s"(q_)); q_; })
#define bid opq(bid0)
#define nb opq(nb0)
  int* toff_s = (int*)(dyn_smem + 147456);
  volatile LAS unsigned* xb_st = (volatile LAS unsigned*)(dyn_smem + 147456 + 256);
  {
    unsigned* barw = (unsigned*)(fresh_ws(pp0) + OFF_BAR);
    if (blockIdx.x == 0) for (int i = threadIdx.x; i < XCD_BAR_WORDS; i += NTHR) barw[i] = 0u;
    if (threadIdx.x == 0) { xb_st[0] = 0u; xb_st[1] = 0u; }
  }
  grid.sync();
  const XcdBarrier xb = xcd_barrier_post((unsigned*)(fresh_ws(pp0) + OFF_BAR), xb_st);
#define GSYNC() xcd_barrier(xb)
  phase_ada(pp, bid, nb, dyn_smem);
  phase_convert(pp, 0, bid, nb, dyn_smem);
  phase_convert(pp, 1, bid, nb, dyn_smem);
  GSYNC();
#define LAYER(LV, LAST)                                      \
  {                                                          \
    phase_prenorm(pp, opq(LV), bid, nb);                     \
    GSYNC();                                                 \
    phase_gemm_in(pp, opq(LV), bid, nb, dyn_smem);           \
    GSYNC();                                                 \
    phase_prep(pp, opq(LV), bid, nb, dyn_smem);              \
    GSYNC();                                                 \
    phase_chunk_prep(pp, bid, nb, dyn_smem);                 \
    GSYNC();                                                 \
    phase_mix(pp, opq(LV), bid, nb, dyn_smem);               \
    GSYNC();                                                 \
    phase_post(pp, opq(LV), bid, nb);                        \
    GSYNC();                                                 \
    phase_gemm_out(pp, opq(LV), bid, nb, dyn_smem);          \
    GSYNC();                                                 \
    phase_router(pp, opq(LV), bid, nb, dyn_smem);            \
    GSYNC();                                                 \
    phase_slotfill(pp, opq(LV), bid, nb, dyn_smem);          \
    GSYNC();                                                 \
    phase_moe1_impl(pp, opq(LV), bid, nb, dyn_smem, toff_s); \
    GSYNC();                                                 \
    phase_moe2_impl(pp, opq(LV), bid, nb, dyn_smem, toff_s); \
    GSYNC();                                                 \
    phase_combine(pp, opq(LV), bid, nb);                     \
    if (!(LAST)) GSYNC();                                    \
  }
  LAYER(0, false)
  LAYER(1, true)
#undef LAYER
#undef GSYNC
#undef bid
#undef nb
#undef pp
}

#undef p
extern "C" void kernel_launch(void* const* d_in, const int* in_sizes, int n_in, void* d_out, int out_size, void* d_ws,
                              size_t ws_size, hipStream_t stream) {
  Params hp{};
  const float** pp = (const float**)&hp;
  for (int i = 0; i < 34; ++i) pp[i] = (const float*)d_in[i];
  hp.out = (float*)d_out;
  hp.ws = (char*)d_ws;
  static int grid_blocks = 0;
  if (!grid_blocks) {
    (void)hipFuncSetAttribute((const void*)mega, hipFuncAttributeMaxDynamicSharedMemorySize, LDS_BYTES);
    int dev = 0, cus = 0, per_cu = 0;
    (void)hipGetDevice(&dev);
    (void)hipDeviceGetAttribute(&cus, hipDeviceAttributeMultiprocessorCount, dev);
    (void)hipOccupancyMaxActiveBlocksPerMultiprocessor(&per_cu, mega, NTHR, LDS_BYTES);
    if (per_cu < 1) per_cu = 1;
    if (per_cu > 1) per_cu = 1;
    grid_blocks = cus * per_cu;
  }
  void* args[] = {&hp};
  (void)hipLaunchCooperativeKernel((void*)mega, dim3(grid_blocks), dim3(NTHR), args, LDS_BYTES, stream);
}
```

```cpp
#include <hip/hip_runtime.h>
#include <hip/hip_bf16.h>
#include <hip/hip_cooperative_groups.h>
#include <stdint.h>
namespace cg = cooperative_groups;

typedef __attribute__((ext_vector_type(8))) short bf16x8;
typedef __attribute__((ext_vector_type(4))) short bf16x4;
typedef __attribute__((ext_vector_type(4))) float f32x4;
typedef unsigned short bfr;

#define D_MODEL 1024
#define NB 2
#define SEQ 16384
#define CTXL 256
#define NLAT (NB * SEQ)
#define NCTX (NB * CTXL)
#define NTOK (NLAT + NCTX)
#define TTOK (SEQ + CTXL)
#define PIN 3472
#define PINP 3584
#define A_END 1536
#define B_END 2432
#define NEXP 32
#define NSLOT_MAX (NTOK * 4 + NEXP * 256)
#define NTHR 512
#define LDS_BYTES (147456 + 512)

constexpr size_t al256(size_t x) { return (x + 255) & ~(size_t)255; }
constexpr size_t WL_IN = 0;
constexpr size_t WL_OUT = WL_IN + (size_t)PINP * 1024 * 2;
constexpr size_t WL_GU = WL_OUT + (size_t)1024 * 1024 * 2;
constexpr size_t WL_DN = WL_GU + (size_t)32 * 2048 * 1024 * 2;
constexpr size_t WL_SIZE = WL_DN + (size_t)32 * 1024 * 1024 * 2;
constexpr size_t OFF_W = 0;
constexpr size_t OFF_MODS = al256(OFF_W + 2 * WL_SIZE);
constexpr size_t OFF_BAR = al256(OFF_MODS + 2 * 3 * 6144 * 4);
constexpr size_t OFF_CTX = al256(OFF_BAR + 3456 * 4);
constexpr size_t OFF_CNT = al256(OFF_CTX + (size_t)NCTX * 1024 * 4);
constexpr size_t OFF_TOKE = al256(OFF_CNT + 256);
constexpr size_t OFF_TOKP = al256(OFF_TOKE + (size_t)NTOK * 4 * 4);
constexpr size_t OFF_TOKG = al256(OFF_TOKP + (size_t)NTOK * 4 * 4);
constexpr size_t OFF_TOKS = al256(OFF_TOKG + (size_t)NTOK * 4 * 4);
constexpr size_t OFF_SLT = al256(OFF_TOKS + (size_t)NTOK * 4 * 4);
constexpr size_t OFF_SLG = al256(OFF_SLT + (size_t)NSLOT_MAX * 4);
constexpr size_t OFF_H = al256(OFF_SLG + (size_t)NSLOT_MAX * 4);
constexpr size_t OFF_CC = al256(OFF_H + (size_t)NTOK * 1024 * 2);
constexpr size_t OFF_P = al256(OFF_CC + (size_t)NTOK * 1024 * 2);
constexpr size_t OFF_S = al256(OFF_P + (size_t)NTOK * PINP * 4);
constexpr size_t TOK256F = (size_t)NTOK * 256 * 4;
constexpr size_t S_QN = 0;
constexpr size_t S_KN = S_QN + (size_t)NTOK * 512 * 2;
constexpr size_t S_VT = S_KN + (size_t)NTOK * 512 * 2;
constexpr size_t S_RWR = S_VT + (size_t)NB * 8 * 64 * TTOK * 2;
constexpr size_t S_RWKK = S_RWR + TOK256F;
constexpr size_t S_RWV = S_RWKK + TOK256F;
constexpr size_t S_RWG = S_RWV + TOK256F;
constexpr size_t S_RWW = S_RWG + TOK256F;
constexpr size_t S_RWKD = S_RWW + 2 * TOK256F;
constexpr size_t S_RWB = S_RWKD + 2 * TOK256F;
constexpr size_t S_BON = S_RWB + 2 * TOK256F;
constexpr size_t S_GDQ = al256(S_BON + (size_t)NTOK * 4 * 4);
constexpr size_t S_GDK = S_GDQ + TOK256F;
constexpr size_t S_GDV = S_GDK + TOK256F;
constexpr size_t S_GDAB = S_GDV + TOK256F;
constexpr size_t S_YRW = al256(S_GDAB + (size_t)NTOK * 16 * 4);
constexpr size_t S_YGD = S_YRW + 2 * TOK256F;
constexpr size_t S_END = S_YGD + 2 * TOK256F;
constexpr size_t S_SIZE = (S_END > (size_t)NSLOT_MAX * 1024 * 4) ? S_END : (size_t)NSLOT_MAX * 1024 * 4;
constexpr int NCHUNK = TTOK / 64;
constexpr int NCHAIN = 32;
constexpr size_t OFF_CH = al256(OFF_S + S_SIZE);
constexpr size_t CH_N = (size_t)NCHAIN * NCHUNK;
constexpr size_t CH_REC = 49152, CH_PT = 0, CH_RYT = 8192, CH_WYT = 16384, CH_XT = 24576, CH_QT = 32768;
constexpr size_t CH_SIZE = CH_N * (4 * 8192 + 16384);
constexpr size_t WS_TOTAL = OFF_CH + CH_SIZE;
static_assert(WS_TOTAL <= (size_t)2048 * 1024 * 1024, "workspace exceeds 4x largest tensor");

struct Params {
  const float *x, *c, *ctx, *c_ctx, *ada_w, *ada_b, *norm_mix_g, *norm_ffn_g, *w_in, *w_out;
  const float *na_q_gain, *na_k_gain, *na_rpb;
  const float *rw_mu, *rw_w0, *rw_w_up, *rw_a0, *rw_a_up, *rw_g_up, *rw_k_k, *rw_k_a, *rw_r_k, *rw_ln_w, *rw_ln_b;
  const float *gd_conv_w, *gd_A_log, *gd_dt_bias, *gd_norm_g;
  const float *moe_router_w, *moe_router_b, *moe_w_gu, *moe_b_gu, *moe_w_down, *moe_b_down;
  float* out;
  char* ws;
};

typedef const __attribute__((address_space(4))) Params* PP;
#define p (*pp)
__device__ __forceinline__ char* fresh_ws(PP pp) { return p.ws; }
__device__ __forceinline__ int tid_opaque() { int t = (int)__builtin_amdgcn_workitem_id_x(); asm volatile("" : "+v"(t)); return t; }
__device__ __forceinline__ int opq(int x) { asm volatile("" : "+s"(x)); return x; }
__device__ __forceinline__ int wave_id(int tid) { return __builtin_amdgcn_readfirstlane(tid >> 6); }
__device__ __forceinline__ bfr f2bf(float f) {
  unsigned u = __float_as_uint(f);
  u += 0x7fffu + ((u >> 16) & 1u);
  return (bfr)(u >> 16);
}
__device__ __forceinline__ float sigmoidf_(float x) { return 1.f / (1.f + __expf(-x)); }
__device__ __forceinline__ float siluf_(float x) { return x / (1.f + __expf(-x)); }
__device__ __forceinline__ float softplusf_(float x) { return x > 20.f ? x : log1pf(__expf(x)); }
__device__ __forceinline__ float wave_sum(float v) {
  v += __builtin_bit_cast(float, __builtin_amdgcn_update_dpp(0, __builtin_bit_cast(int, v), 0xB1, 0xF, 0xF, true));
  v += __builtin_bit_cast(float, __builtin_amdgcn_update_dpp(0, __builtin_bit_cast(int, v), 0x4E, 0xF, 0xF, true));
  v += __builtin_bit_cast(float, __builtin_amdgcn_update_dpp(0, __builtin_bit_cast(int, v), 0x141, 0xF, 0xF, true));
  v += __builtin_bit_cast(float, __builtin_amdgcn_update_dpp(0, __builtin_bit_cast(int, v), 0x140, 0xF, 0xF, true));
  v += __builtin_bit_cast(float, __builtin_amdgcn_update_dpp(0, __builtin_bit_cast(int, v), 0x142, 0xA, 0xF, false));
  v += __builtin_bit_cast(float, __builtin_amdgcn_update_dpp(0, __builtin_bit_cast(int, v), 0x143, 0xC, 0xF, false));
  return __builtin_bit_cast(float, __builtin_amdgcn_readlane(__builtin_bit_cast(int, v), 63));
}
__device__ __forceinline__ float shfl_xor_l(float v, int mask, int lane) {
  return __builtin_bit_cast(float, __builtin_amdgcn_ds_bpermute((lane ^ mask) << 2, __builtin_bit_cast(int, v)));
}
__device__ __forceinline__ int shfl_xor_li(int v, int mask, int lane) {
  return __builtin_amdgcn_ds_bpermute((lane ^ mask) << 2, v);
}
__device__ __forceinline__ float row16_sum(float v) {
  v += __builtin_bit_cast(float, __builtin_amdgcn_update_dpp(0, __builtin_bit_cast(int, v), 0xB1, 0xF, 0xF, true));
  v += __builtin_bit_cast(float, __builtin_amdgcn_update_dpp(0, __builtin_bit_cast(int, v), 0x4E, 0xF, 0xF, true));
  v += __builtin_bit_cast(float, __builtin_amdgcn_update_dpp(0, __builtin_bit_cast(int, v), 0x141, 0xF, 0xF, true));
  v += __builtin_bit_cast(float, __builtin_amdgcn_update_dpp(0, __builtin_bit_cast(int, v), 0x140, 0xF, 0xF, true));
  return v;
}
__device__ __forceinline__ int mod_row(int m) { return m < NLAT ? (m >> 14) : 2; }

__device__ __forceinline__ void phase_ada(PP pp, int bid, int nb, char* smem) {
  float* red = (float*)smem;
  float* mods = (float*)(p.ws + OFF_MODS);
  const int tid = tid_opaque();
  for (int task = bid; task < 2 * 96; task += nb) {
    int l = task / 96, cgp = task % 96;
    int col = cgp * 64 + (tid & 63), ks = tid >> 6;
    const float* W = p.ada_w + (size_t)l * 1024 * 6144;
    float a0 = 0.f, a1 = 0.f, a2 = 0.f;
    for (int d = ks * 128; d < ks * 128 + 128; ++d) {
      float w = W[(size_t)d * 6144 + col];
      a0 += siluf_(p.c[d]) * w;
      a1 += siluf_(p.c[1024 + d]) * w;
      a2 += siluf_(p.c_ctx[d]) * w;
    }
    red[(ks * 3 + 0) * 64 + (tid & 63)] = a0;
    red[(ks * 3 + 1) * 64 + (tid & 63)] = a1;
    red[(ks * 3 + 2) * 64 + (tid & 63)] = a2;
    __syncthreads();
    if (tid < 192) {
      int r = tid >> 6, cc = tid & 63;
      float s = 0.f;
      for (int k = 0; k < 8; ++k) s += red[(k * 3 + r) * 64 + cc];
      mods[(size_t)(l * 3 + r) * 6144 + cgp * 64 + cc] = s + p.ada_b[(size_t)l * 6144 + cgp * 64 + cc];
    }
    __syncthreads();
  }
}

__device__ __forceinline__ void convert_tile(const float* src, int N, bfr* dst, int kt, int nt, int mode, float* tile  ) {
  const int tid = tid_opaque();
#pragma unroll
  for (int q = 0; q < 2; ++q) {
    int idx = tid + q * 512;
    int kk = idx >> 4, n4 = idx & 15;
    int n = nt * 64 + n4 * 4;
    float4 v = make_float4(0.f, 0.f, 0.f, 0.f);
    if (n < N) v = *(const float4*)(src + (size_t)(kt * 64 + kk) * N + n);
    tile[kk * 65 + n4 * 4 + 0] = v.x;
    tile[kk * 65 + n4 * 4 + 1] = v.y;
    tile[kk * 65 + n4 * 4 + 2] = v.z;
    tile[kk * 65 + n4 * 4 + 3] = v.w;
  }
  __syncthreads();
  {
    int nn = tid >> 3, kc = tid & 7;
    int n = nt * 64 + nn;
    int row = n;
    if (mode == 1) { int j = n & 1023; row = (j >> 4) * 32 + (j & 15) + ((n >= 1024) ? 16 : 0); }
    bf16x8 o;
#pragma unroll
    for (int j = 0; j < 8; ++j) o[j] = (short)f2bf(tile[(kc * 8 + j) * 65 + nn]);
    *(bf16x8*)(dst + (size_t)row * 1024 + kt * 64 + kc * 8) = o;
  }
  __syncthreads();
}
__device__ __forceinline__ void phase_convert(PP pp, int l, int bid, int nb, char* smem) {
  float* tile = (float*)smem;
  char* wl = p.ws + OFF_W + (size_t)l * WL_SIZE;
  const int T_IN = 16 * 56, T_OUT = 16 * 16, T_GU = 32 * 16 * 32, T_DN = 32 * 16 * 16;
  const int total = T_IN + T_OUT + T_GU + T_DN;
  for (int t = bid; t < total; t += nb) {
    if (t < T_IN) {
      int kt = t / 56, nt = t % 56;
      convert_tile(p.w_in + (size_t)l * 1024 * PIN, PIN, (bfr*)(wl + WL_IN), kt, nt, 0, tile);
    } else if (t < T_IN + T_OUT) {
      int u = t - T_IN; int kt = u / 16, nt = u % 16;
      convert_tile(p.w_out + (size_t)l * 1024 * 1024, 1024, (bfr*)(wl + WL_OUT), kt, nt, 0, tile);
    } else if (t < T_IN + T_OUT + T_GU) {
      int u = t - T_IN - T_OUT; int e = u / 512; int v = u % 512; int kt = v / 32, nt = v % 32;
      convert_tile(p.moe_w_gu + ((size_t)l * 32 + e) * 1024 * 2048, 2048, (bfr*)(wl + WL_GU) + (size_t)e * 2048 * 1024, kt, nt, 1, tile);
    } else {
      int u = t - T_IN - T_OUT - T_GU; int e = u / 256; int v = u % 256; int kt = v / 16, nt = v % 16;
      convert_tile(p.moe_w_down + ((size_t)l * 32 + e) * 1024 * 1024, 1024, (bfr*)(wl + WL_DN) + (size_t)e * 1024 * 1024, kt, nt, 0, tile);
    }
  }
}

__device__ __forceinline__ void phase_prenorm(PP pp, int l, int bid, int nb) {
  const int tid = tid_opaque(), lane = tid & 63, wv = wave_id(tid);
  const float* xl = (l == 0) ? p.x : p.out;
  const float* xc = (l == 0) ? p.ctx : (const float*)(p.ws + OFF_CTX);
  const float* mods = (const float*)(p.ws + OFF_MODS) + (size_t)l * 3 * 6144;
  const float* g = p.norm_mix_g + (size_t)l * 1024;
  bfr* H = (bfr*)(p.ws + OFF_H);
  {
    int* cnt = (int*)(p.ws + OFF_CNT);
    int* slt = (int*)(p.ws + OFF_SLT);
    int gt = bid * NTHR + tid;
    if (gt < 32) cnt[gt] = 0;
    for (int i = gt; i < NSLOT_MAX; i += nb * NTHR) slt[i] = 0;
  }
  for (int m = bid * 8 + wv; m < NTOK; m += nb * 8) {
    const float* xr = (m < NLAT) ? xl + (size_t)m * 1024 : xc + (size_t)(m - NLAT) * 1024;
    const float* md = mods + (size_t)mod_row(m) * 6144;
    float4 v[4];
    float ss = 0.f;
#pragma unroll
    for (int i = 0; i < 4; ++i) {
      v[i] = *(const float4*)(xr + (lane + 64 * i) * 4);
      ss += v[i].x * v[i].x + v[i].y * v[i].y + v[i].z * v[i].z + v[i].w * v[i].w;
    }
    ss = wave_sum(ss);
    float rs = rsqrtf(ss * (1.f / 1024.f) + 1e-6f);
#pragma unroll
    for (int i = 0; i < 4; ++i) {
      int d = (lane + 64 * i) * 4;
      float4 gg = *(const float4*)(g + d);
      float4 sh = *(const float4*)(md + d);
      float4 sc = *(const float4*)(md + 1024 + d);
      bf16x4 o;
      o[0] = (short)f2bf(v[i].x * rs * gg.x * (1.f + sc.x) + sh.x);
      o[1] = (short)f2bf(v[i].y * rs * gg.y * (1.f + sc.y) + sh.y);
      o[2] = (short)f2bf(v[i].z * rs * gg.z * (1.f + sc.z) + sh.z);
      o[3] = (short)f2bf(v[i].w * rs * gg.w * (1.f + sc.w) + sh.w);
      *(bf16x4*)(H + (size_t)m * 1024 + d) = o;
    }
  }
}

#define LAS __attribute__((address_space(3)))
namespace g8 {
constexpr int BM = 256, BK = 64, HALF = 128, HTB = HALF * BK * 2, STAGE_BYTES = 8 * HTB, KD = 1024;
__device__ __forceinline__ int lds_byte(int r, int c) { const int st = (r >> 4) * 2 + (c >> 5), rr = r & 15, cc = c & 31, ob = rr * 64 + cc * 2; return st * 1024 + (ob ^ (((ob >> 9) & 1) << 5)); }
__device__ __forceinline__ void stage_rc(int b, int& R, int& C) { const int st = b / 1024, sb = b % 1024, swz = sb ^ (((sb >> 9) & 1) << 5); R = (st >> 1) * 16 + swz / 64; C = (st & 1) * 32 + (swz % 64) / 2; }
struct GUnit { int pm, pn, brow0, e; };
__device__ __forceinline__ int unit_index(int i, int c, int G, int total) {
  const int x = c & 7, j = c >> 3, q = total >> 3, r = total & 7;
  const int start = x < r ? x * (q + 1) : r * (q + 1) + (x - r) * q;
  const int size = q + (x < r ? 1 : 0);
  const int li = i * (G >> 3) + j;
  return li < size ? start + li : -1;
}

template <class Sched, class Epi>
__device__ __forceinline__ void gemm_stream(LAS unsigned char* lds, const bfr* Abase, const bfr* Btbase, const Sched& S, const Epi& E) {
  const int tid = tid_opaque(), wid = __builtin_amdgcn_readfirstlane(tid >> 6), lane = tid & 63, wr = wid >> 2, wc = wid & 3, fr = lane & 15, fq = lane >> 4;
  constexpr int nt = KD / BK;
  int R[2], C[2];
  unsigned voffB[2];
#pragma unroll
  for (int i = 0; i < 2; ++i) { stage_rc(tid * 16 + i * 8192, R[i], C[i]); voffB[i] = (unsigned)(R[i] * KD + C[i]) * 2u; }
#define voffA voffB
  constexpr size_t kstep = (size_t)(BK * 2);
  constexpr size_t hstep = (size_t)HALF * KD * 2;
  const unsigned ldsw = (unsigned)wid * 1024u;
  const int aoff = lds_byte(wr * 64 + fr, fq * 8), boff = lds_byte(wc * 32 + fr, fq * 8);
#define G8_SA(b, h) (((b) * 2 + (h)) * HTB)
#define G8_SB(b, h) ((4 + (b) * 2 + (h)) * HTB)
#define G8_STAGE(bufoff, gbase, v0, v1) do { \
    __builtin_amdgcn_global_load_lds((const unsigned*)((const char*)(gbase) + (v0)), (LAS unsigned*)(lds + (bufoff) + ldsw), 16, 0, 0); \
    __builtin_amdgcn_global_load_lds((const unsigned*)((const char*)(gbase) + (v1)), (LAS unsigned*)(lds + (bufoff) + ldsw + 8192), 16, 0, 0); } while (0)
#define G8_STAGEB(bufoff, gbase) G8_STAGE(bufoff, gbase, voffB[0], voffB[1])
#define G8_STAGEA(bufoff, gbase) G8_STAGE(bufoff, gbase, voffA[0], voffA[1])
#define G8_LDA(dst, b, h) do { _Pragma("unroll") for (int m = 0; m < 4; ++m) _Pragma("unroll") for (int k = 0; k < 2; ++k) dst[m][k] = *(const LAS bf16x8*)(lds + G8_SA(b, h) + aoff + m * 2048 + k * 1024); } while (0)
#define G8_LDB(dst, b, h) do { _Pragma("unroll") for (int n = 0; n < 2; ++n) _Pragma("unroll") for (int k = 0; k < 2; ++k) dst[n][k] = *(const LAS bf16x8*)(lds + G8_SB(b, h) + boff + n * 2048 + k * 1024); } while (0)
#define G8_MMA(ai, bj, At, Bt) do { __builtin_amdgcn_s_setprio(1); _Pragma("unroll") for (int m = 0; m < 4; ++m) _Pragma("unroll") for (int n = 0; n < 2; ++n) _Pragma("unroll") for (int k = 0; k < 2; ++k) \
    acc[ai][bj][m][n] = __builtin_amdgcn_mfma_f32_16x16x32_bf16(Bt[n][k], At[m][k], acc[ai][bj][m][n], 0, 0, 0); __builtin_amdgcn_s_setprio(0); } while (0)
#define G8_WAIT_V(n) asm volatile("s_waitcnt vmcnt(" #n ")" ::: "memory")
#define G8_WAIT_L(n) asm volatile("s_waitcnt lgkmcnt(" #n ")" ::: "memory")
#define G8_BAR __builtin_amdgcn_s_barrier()
#define G8_SCHED __builtin_amdgcn_sched_barrier(0)
  GUnit cur, nxt;
  int ui = 0;
  if (!S.next(0, cur)) return;
  f32x4 acc[2][2][4][2];
#pragma unroll
  for (int a = 0; a < 2; ++a)
#pragma unroll
    for (int b = 0; b < 2; ++b)
#pragma unroll
      for (int m = 0; m < 4; ++m)
#pragma unroll
        for (int n = 0; n < 2; ++n) acc[a][b][m][n] = (f32x4){0.f, 0.f, 0.f, 0.f};
  bf16x8 At[4][2], B0[2][2], B1[2][2];
  const char* cA = (const char*)Abase + (size_t)cur.pm * (BM * KD * 2);
  const char* cB = (const char*)Btbase + (size_t)cur.brow0 * (KD * 2);
  G8_STAGEB(G8_SB(0, 0), cB); G8_STAGEA(G8_SA(0, 0), cA); G8_STAGEB(G8_SB(0, 1), cB + hstep); G8_STAGEA(G8_SA(0, 1), cA + hstep);
  if (wr == 1) G8_BAR;
  G8_WAIT_V(4); G8_BAR;
  G8_STAGEB(G8_SB(1, 0), cB + kstep); G8_STAGEA(G8_SA(1, 0), cA + kstep); G8_STAGEB(G8_SB(1, 1), cB + hstep + kstep);
  G8_WAIT_V(6); G8_BAR;
  for (;;) {
    const bool has_next = S.next(ui + 1, nxt);
    const char* nA = has_next ? (const char*)Abase + (size_t)nxt.pm * (BM * KD * 2) : cA;
    const char* nB = has_next ? (const char*)Btbase + (size_t)nxt.brow0 * (KD * 2) : cB;
    for (int t = 0; t < nt; t += 2) {
      const bool last = (t == nt - 2);
      const char* a1 = cA + (size_t)(t + 1) * kstep;
      const char* a2 = last ? nA : cA + (size_t)(t + 2) * kstep;
      const char* b2 = last ? nB : cB + (size_t)(t + 2) * kstep;
      const char* a3 = a2 + kstep;
      const char* b3 = b2 + kstep;
      G8_LDB(B0, 0, 0); G8_SCHED; G8_LDA(At, 0, 0); G8_STAGEA(G8_SA(1, 1), a1 + hstep);
      G8_WAIT_L(8); G8_BAR; G8_WAIT_L(0); G8_MMA(0, 0, At, B0); G8_BAR; G8_SCHED;
      G8_LDB(B1, 0, 1); G8_STAGEB(G8_SB(0, 0), b2);
      G8_BAR; G8_WAIT_L(0); G8_MMA(0, 1, At, B1); G8_BAR;
      G8_LDA(At, 0, 1); G8_STAGEA(G8_SA(0, 0), a2);
      G8_BAR; G8_WAIT_L(0); G8_MMA(1, 0, At, B0); G8_BAR; G8_SCHED;
      G8_STAGEB(G8_SB(0, 1), b2 + hstep);
      G8_WAIT_V(6); G8_BAR; G8_MMA(1, 1, At, B1); G8_BAR;
      G8_LDB(B0, 1, 0); G8_SCHED; G8_LDA(At, 1, 0); G8_STAGEA(G8_SA(0, 1), a2 + hstep);
      G8_WAIT_L(8); G8_BAR; G8_WAIT_L(0); G8_MMA(0, 0, At, B0); G8_BAR; G8_SCHED;
      G8_LDB(B1, 1, 1); G8_STAGEB(G8_SB(1, 0), b3);
      G8_BAR; G8_WAIT_L(0); G8_MMA(0, 1, At, B1); G8_BAR;
      G8_LDA(At, 1, 1); G8_STAGEA(G8_SA(1, 0), a3);
      G8_BAR; G8_WAIT_L(0); G8_MMA(1, 0, At, B0); G8_BAR; G8_SCHED;
      G8_STAGEB(G8_SB(1, 1), b3 + hstep);
      G8_WAIT_V(6); G8_BAR; G8_MMA(1, 1, At, B1); G8_BAR;
    }
    E(acc, cur, wr, wc, fr, fq);
    if (!has_next) break;
#pragma unroll
    for (int a = 0; a < 2; ++a)
#pragma unroll
      for (int b = 0; b < 2; ++b)
#pragma unroll
        for (int m = 0; m < 4; ++m)
#pragma unroll
          for (int n = 0; n < 2; ++n) acc[a][b][m][n] = (f32x4){0.f, 0.f, 0.f, 0.f};
    cur = nxt; cA = nA; cB = nB; ++ui;
  }
  G8_WAIT_V(0);
  if (wr == 0) G8_BAR;
  G8_BAR;
#undef G8_SA
#undef G8_SB
#undef G8_STAGE
#undef G8_STAGEB
#undef G8_STAGEA
#undef voffA
#undef G8_LDA
#undef G8_LDB
#undef G8_MMA
#undef G8_WAIT_V
#undef G8_WAIT_L
#undef G8_BAR
#undef G8_SCHED
}

struct DenseSched {
  int nM, nN, G, c;
  __device__ __forceinline__ bool next(int i, GUnit& u) const {
    const int idx = unit_index(i, c, G, nM * nN);
    if (idx < 0) return false;
    u.pm = idx / nN; u.pn = idx - u.pm * nN; u.brow0 = u.pn * BM; u.e = 0;
    return true;
  }
};
struct MoeSched {
  const int* toff; int nN, NE, G, c;
  __device__ __forceinline__ bool next(int i, GUnit& u) const {
    const int idx = unit_index(i, c, G, toff[32] * nN);
    if (idx < 0) return false;
    u.pm = idx / nN; u.pn = idx - u.pm * nN;
    int e = 0;
#pragma unroll 1
    for (int k = 1; k < 32; ++k) e = (u.pm >= toff[k]) ? k : e;
    u.e = e; u.brow0 = e * NE + u.pn * BM;
    return true;
  }
};
}

struct EpiInProj {
  float* P;
  __device__ __forceinline__ void operator()(const f32x4 (&acc)[2][2][4][2], const g8::GUnit& u, int wr, int wc, int fr, int fq) const {
    const int row0 = u.pm * 256 + wr * 64 + fr, col0 = u.pn * 256 + wc * 32 + 4 * fq;
#pragma unroll
    for (int ai = 0; ai < 2; ++ai)
#pragma unroll
      for (int m = 0; m < 4; ++m) {
        float* rowp = P + (size_t)(row0 + ai * 128 + m * 16) * PINP + col0;
#pragma unroll
        for (int bj = 0; bj < 2; ++bj)
#pragma unroll
          for (int n = 0; n < 2; ++n) *(f32x4*)(rowp + bj * 128 + n * 16) = acc[ai][bj][m][n];
      }
  }
};
__device__ __forceinline__ void phase_gemm_in(PP pp, int l, int bid, int nb, char* smem) {
  g8::DenseSched S{130, 14, nb, bid};
  EpiInProj E{(float*)(p.ws + OFF_P)};
  g8::gemm_stream((LAS unsigned char*)smem, (const bfr*)(p.ws + OFF_H), (const bfr*)(p.ws + OFF_W + (size_t)l * WL_SIZE + WL_IN), S, E);
}

struct EpiOutProj {
  const float *xl, *xc, *mods; float *ol, *oc;
  __device__ __forceinline__ void operator()(const f32x4 (&acc)[2][2][4][2], const g8::GUnit& u, int wr, int wc, int fr, int fq) const {
    const bool lat = u.pm < 128;
    const float* xin = lat ? xl + (size_t)u.pm * 256 * 1024 : xc + (size_t)(u.pm - 128) * 256 * 1024;
    float* xo = lat ? ol + (size_t)u.pm * 256 * 1024 : oc + (size_t)(u.pm - 128) * 256 * 1024;
    const float* g1 = mods + (size_t)(lat ? (u.pm >> 6) : 2) * 6144 + 2048;
    const int row0 = wr * 64 + fr, col0 = u.pn * 256 + wc * 32 + 4 * fq;
#pragma unroll
    for (int bj = 0; bj < 2; ++bj)
#pragma unroll
      for (int n = 0; n < 2; ++n) {
        const f32x4 gv = *(const f32x4*)(g1 + col0 + bj * 128 + n * 16);
#pragma unroll
        for (int ai = 0; ai < 2; ++ai)
#pragma unroll
          for (int m = 0; m < 4; ++m) {
            const size_t o = (size_t)(row0 + ai * 128 + m * 16) * 1024 + col0 + bj * 128 + n * 16;
            const f32x4 xv = *(const f32x4*)(xin + o);
            *(f32x4*)(xo + o) = xv + gv * acc[ai][bj][m][n];
            if (m & 1) asm volatile("" ::: "memory");
          }
      }
  }
};
__device__ __forceinline__ void phase_gemm_out(PP pp, int l, int bid, int nb, char* smem) {
  g8::DenseSched S{(l == 0) ? 130 : 128, 4, nb, bid};
  EpiOutProj E{(l == 0) ? p.x : p.out, (l == 0) ? p.ctx : (const float*)(p.ws + OFF_CTX),
               (const float*)(p.ws + OFF_MODS) + (size_t)l * 3 * 6144, p.out, (float*)(p.ws + OFF_CTX)};
  g8::gemm_stream((LAS unsigned char*)smem, (const bfr*)(p.ws + OFF_CC), (const bfr*)(p.ws + OFF_W + (size_t)l * WL_SIZE + WL_OUT), S, E);
}

#define LBAR() do { asm volatile("s_waitcnt lgkmcnt(0)" ::: "memory"); __builtin_amdgcn_s_barrier(); asm volatile("" ::: "memory"); } while (0)
__device__ __forceinline__ void phase_prep(PP pp, int l, int bid, int nb, char* smem) {
  const int tid = tid_opaque(), lane = tid & 63, wv = wave_id(tid);
  const float* P = (const float*)(p.ws + OFF_P);
  char* S = p.ws + OFF_S;
  bfr* QN = (bfr*)(S + S_QN);
  bfr* KN = (bfr*)(S + S_KN);
  bfr* VT = (bfr*)(S + S_VT);
  float* RWR = (float*)(S + S_RWR);
  float* RWKK = (float*)(S + S_RWKK);
  float* RWV = (float*)(S + S_RWV);
  float* RWG = (float*)(S + S_RWG);
  float* RWW = (float*)(S + S_RWW);
  float* RWKD = (float*)(S + S_RWKD);
  float* RWB = (float*)(S + S_RWB);
  float* BON = (float*)(S + S_BON);
  float* GDQ = (float*)(S + S_GDQ);
  float* GDK = (float*)(S + S_GDK);
  float* GDV = (float*)(S + S_GDV);
  float* GDAB = (float*)(S + S_GDAB);
  const float* mu = p.rw_mu + (size_t)l * 896;
  const float* w0 = p.rw_w0 + (size_t)l * 512;
  const float* w_up = p.rw_w_up + (size_t)l * 2 * 32 * 256;
  const float* a0 = p.rw_a0 + (size_t)l * 512;
  const float* a_up = p.rw_a_up + (size_t)l * 2 * 32 * 256;
  const float* g_up = p.rw_g_up + (size_t)l * 64 * 256;
  const float* k_k = p.rw_k_k + (size_t)l * 256;
  const float* k_a = p.rw_k_a + (size_t)l * 256;
  const float* r_k = p.rw_r_k + (size_t)l * 256;
  const float* conv_w = p.gd_conv_w + (size_t)l * 5 * 768;
  const float* A_log = p.gd_A_log + (size_t)l * 8;
  const float* dt_bias = p.gd_dt_bias + (size_t)l * 8;
  const float* qg = p.na_q_gain + (size_t)l * 64;
  const float* kg = p.na_k_gain + (size_t)l * 64;

  bfr* wl = (bfr*)smem;
  float* lor = (float*)(smem + 192 * 256 * 2);
  __syncthreads();
  for (int i = tid; i < 192 * 256; i += NTHR) {
    const int row = i >> 8, c = i & 255;
    const float v = row < 64 ? g_up[row * 256 + c] : row < 128 ? w_up[(row - 64) * 256 + c] : a_up[(row - 128) * 256 + c];
    wl[i] = f2bf(v);
  }
  __syncthreads();
  const int c = tid & 255, th = tid >> 8;
  const int h = c >> 6;
  const float kkc = k_k[c], kac = k_a[c], rkc = r_k[c];
  const float w00 = w0[c], w01 = w0[256 + c], a00 = a0[c], a01 = a0[256 + c];
  const float mur = mu[c], muk = mu[256 + c], muv = mu[512 + c];
  const float mul = (tid < 128) ? mu[768 + tid] : 0.f;
  const int nsecA = wv, nsecB = wv + 8;

  for (int tile = bid; tile < NTOK / 16; tile += nb) {
    const int m0 = tile * 16;
    int seq_lo, seq_hi, bb, tau0;
    if (m0 < NLAT) { bb = m0 >> 14; seq_lo = bb << 14; seq_hi = seq_lo + SEQ; tau0 = m0 - seq_lo; }
    else { bb = (m0 - NLAT) >> 8; seq_lo = NLAT + (bb << 8); seq_hi = seq_lo + CTXL; tau0 = SEQ + (m0 - seq_lo); }

    float pr[3][10], pl[18];
#pragma unroll
    for (int j = 0; j < 3; ++j)
#pragma unroll
      for (int t = 0; t < 10; ++t) {
        const int m = m0 + th * 8 - 1 + t;
        pr[j][t] = (m >= seq_lo && m < seq_hi) ? P[(size_t)m * PINP + A_END + j * 256 + c] : 0.f;
      }
    if (tid < 128) {
#pragma unroll
      for (int t = 0; t < 18; ++t) {
        const int m = m0 - 1 + t;
        pl[t] = (m >= seq_lo && m < seq_hi) ? P[(size_t)m * PINP + A_END + 768 + tid] : 0.f;
      }
#pragma unroll
      for (int t = 0; t < 16; ++t) {
        const float cur = pl[t + 1];
        const float v = cur + mul * (0.5f * (pl[t] + pl[t + 2]) - cur);
        lor[tid * 16 + t] = tid < 32 ? tanhf(v) : tid < 64 ? v : sigmoidf_(v);
      }
    }
    float rr[8], rk[8], rv[8];
#pragma unroll
    for (int t = 0; t < 8; ++t) {
      rr[t] = pr[0][t + 1] + mur * (0.5f * (pr[0][t] + pr[0][t + 2]) - pr[0][t + 1]);
      rk[t] = pr[1][t + 1] + muk * (0.5f * (pr[1][t] + pr[1][t + 2]) - pr[1][t + 1]);
      rv[t] = pr[2][t + 1] + muv * (0.5f * (pr[2][t] + pr[2][t + 2]) - pr[2][t + 1]);
    }
    LBAR();
    float pgA[20], pgB[20];
    {
      const int cA = nsecA * 64 + lane, cB = nsecB * 64 + lane;
#pragma unroll
      for (int t = 0; t < 20; ++t) {
        const int m = m0 - 2 + t;
        const bool ok = (m >= seq_lo && m < seq_hi);
        pgA[t] = ok ? P[(size_t)m * PINP + B_END + cA] : 0.f;
        pgB[t] = (ok && nsecB < 12) ? P[(size_t)m * PINP + B_END + cB] : 0.f;
      }
    }
    asm volatile("" ::: "memory");
#pragma unroll 1
    for (int ps = 0; ps < 2; ++ps) {
      const int tb = th * 8 + ps * 4;
      float4 gacc = make_float4(0.f, 0.f, 0.f, 0.f), wa0 = gacc, wa1 = gacc, aa0 = gacc, aa1 = gacc;
#pragma unroll 8
      for (int j = 0; j < 64; ++j) {
        const float wgt = __uint_as_float(((unsigned)wl[j * 256 + c]) << 16);
        const float4 s0 = *(const float4*)(lor + (64 + j) * 16 + tb);
        gacc.x += s0.x * wgt; gacc.y += s0.y * wgt; gacc.z += s0.z * wgt; gacc.w += s0.w * wgt;
      }
#pragma unroll 8
      for (int j = 0; j < 32; ++j) {
        const float4 t0 = *(const float4*)(lor + j * 16 + tb);
        const float4 d0 = *(const float4*)(lor + (32 + j) * 16 + tb);
        const float ww0 = __uint_as_float(((unsigned)wl[(64 + j) * 256 + c]) << 16), ww1 = __uint_as_float(((unsigned)wl[(96 + j) * 256 + c]) << 16);
        const float aw0 = __uint_as_float(((unsigned)wl[(128 + j) * 256 + c]) << 16), aw1 = __uint_as_float(((unsigned)wl[(160 + j) * 256 + c]) << 16);
        wa0.x += t0.x * ww0; wa0.y += t0.y * ww0; wa0.z += t0.z * ww0; wa0.w += t0.w * ww0;
        wa1.x += t0.x * ww1; wa1.y += t0.y * ww1; wa1.z += t0.z * ww1; wa1.w += t0.w * ww1;
        aa0.x += d0.x * aw0; aa0.y += d0.y * aw0; aa0.z += d0.z * aw0; aa0.w += d0.w * aw0;
        aa1.x += d0.x * aw1; aa1.y += d0.y * aw1; aa1.z += d0.z * aw1; aa1.w += d0.w * aw1;
      }
#pragma unroll
      for (int t = 0; t < 4; ++t) {
        const int tt = ps * 4 + t;
        const int m = m0 + th * 8 + tt;
        const float gv = t == 0 ? gacc.x : t == 1 ? gacc.y : t == 2 ? gacc.z : gacc.w;
        const float wv0 = t == 0 ? wa0.x : t == 1 ? wa0.y : t == 2 ? wa0.z : wa0.w;
        const float wv1 = t == 0 ? wa1.x : t == 1 ? wa1.y : t == 2 ? wa1.z : wa1.w;
        const float av0 = t == 0 ? aa0.x : t == 1 ? aa0.y : t == 2 ? aa0.z : aa0.w;
        const float av1 = t == 0 ? aa1.x : t == 1 ? aa1.y : t == 2 ? aa1.z : aa1.w;
        const float r = ps == 0 ? rr[t] : rr[4 + t], k = ps == 0 ? rk[t] : rk[4 + t], v = ps == 0 ? rv[t] : rv[4 + t];
        const float kkraw = k * kkc;
        const float ssum = wave_sum(kkraw * kkraw);
        const float kk = kkraw * rsqrtf(ssum + 1e-6f);
        float bon = 0.f;
#pragma unroll
        for (int d = 0; d < 2; ++d) {
          const float wlin = (d == 0 ? w00 + wv0 : w01 + wv1);
          const float w_log = -softplusf_(-wlin) - 0.5f;
          const float a = sigmoidf_(d == 0 ? a00 + av0 : a01 + av1);
          const float kd = k * (1.f + (a - 1.f) * kac);
          bon += r * kd * rkc;
          const size_t o = ((size_t)d * NTOK + m) * 256 + c;
          RWW[o] = -__expf(w_log); RWKD[o] = kd; RWB[o] = kk * a;
        }
        bon = wave_sum(bon);
        const size_t o = (size_t)m * 256 + c;
        RWR[o] = r; RWKK[o] = kk; RWV[o] = v; RWG[o] = gv;
        if (lane == 0) BON[(size_t)m * 4 + h] = bon;
      }
    }
    float pnA[16], pnB[16], pvt[16];
#pragma unroll
    for (int t = 0; t < 16; ++t) {
      pnA[t] = P[(size_t)(m0 + t) * PINP + nsecA * 64 + lane];
      pnB[t] = P[(size_t)(m0 + t) * PINP + nsecB * 64 + lane];
      pvt[t] = P[(size_t)(m0 + t) * PINP + 1024 + tid];
    }
    asm volatile("" ::: "memory");
#pragma unroll
    for (int q = 0; q < 2; ++q) {
      const int sec = q ? nsecB : nsecA;
      if (sec < 12) {
        const int cg = sec * 64 + lane;
        float cw[5];
#pragma unroll
        for (int j = 0; j < 5; ++j) cw[j] = conv_w[j * 768 + cg];
#pragma unroll
        for (int t = 0; t < 16; ++t) {
          float acc = 0.f;
#pragma unroll
          for (int j = 0; j < 5; ++j) acc += cw[j] * (q ? pgB[t + j] : pgA[t + j]);
          float val = siluf_(acc);
          const int m = m0 + t;
          if (sec < 8) {
            const float ss = wave_sum(val * val);
            val *= rsqrtf(ss + 1e-6f);
            if (sec < 4) GDQ[(size_t)m * 256 + sec * 64 + lane] = val * 0.125f;
            else GDK[(size_t)m * 256 + (sec - 4) * 64 + lane] = val;
          } else GDV[(size_t)m * 256 + (sec - 8) * 64 + lane] = val;
        }
      }
    }
    if (tid < 256) {
      const int t = tid >> 4, j = tid & 15;
      const int m = m0 + t;
      const float pv = P[(size_t)m * PINP + B_END + 1024 + j];
      float o;
      if (j < 8) o = -__expf(A_log[j]) * softplusf_(pv + dt_bias[j]);
      else o = sigmoidf_(pv);
      GDAB[(size_t)m * 16 + j] = o;
    }
#pragma unroll
    for (int q = 0; q < 2; ++q) {
      const int hs = q ? nsecB : nsecA;
#pragma unroll
      for (int t = 0; t < 16; ++t) {
        float val = q ? pnB[t] : pnA[t];
        const float ss = wave_sum(val * val);
        val *= rsqrtf(ss * (1.f / 64.f) + 1e-6f);
        const int m = m0 + t;
        if (hs < 8) QN[(size_t)m * 512 + hs * 64 + lane] = f2bf(val * qg[lane] * (0.125f * 1.4426950408889634f));
        else KN[(size_t)m * 512 + (hs - 8) * 64 + lane] = f2bf(val * kg[lane]);
      }
    }
    {
      bf16x8 o0, o1;
#pragma unroll
      for (int t = 0; t < 8; ++t) { o0[t] = (short)f2bf(pvt[t]); o1[t] = (short)f2bf(pvt[8 + t]); }
      bfr* dst = VT + ((size_t)(bb * 512 + tid)) * TTOK + tau0;
      *(bf16x8*)dst = o0;
      *(bf16x8*)(dst + 8) = o1;
    }
    LBAR();
  }
  __syncthreads();
}

__device__ __forceinline__ int scan_tok(int b, int d, int s) {
  if (s < CTXL) { int t = d ? (CTXL - 1 - s) : s; return NLAT + b * CTXL + t; }
  int u = s - CTXL; int t = d ? (SEQ - 1 - u) : u; return b * SEQ + t;
}
#define CS 72
#define SLOT_BYTES (64 * CS * 2)
#define F0_STRIDE 68
#define X1_F0 (13 * SLOT_BYTES)
#define X1_ARR (X1_F0 + 64 * F0_STRIDE * 4)

__device__ __forceinline__ bf16x4 pack4(float a, float b, float c, float d) {
  bf16x4 o; o[0] = (short)f2bf(a); o[1] = (short)f2bf(b); o[2] = (short)f2bf(c); o[3] = (short)f2bf(d); return o;
}
#define MM_FRAGS(As, Bs, a0, a1, b00, b01, b10, b11)                                                     \
  const bf16x8 a0 = *(const bf16x8*)((As) + ((mt * 16 + fr) * CS + fq * 8) * 2);                         \
  const bf16x8 a1 = *(const bf16x8*)((As) + ((mt * 16 + fr) * CS + 32 + fq * 8) * 2);                    \
  const bf16x8 b00 = *(const bf16x8*)((Bs) + ((nt0 * 16 + fr) * CS + fq * 8) * 2);                       \
  const bf16x8 b01 = *(const bf16x8*)((Bs) + ((nt0 * 16 + fr) * CS + 32 + fq * 8) * 2);                  \
  const bf16x8 b10 = *(const bf16x8*)((Bs) + ((nt0 * 16 + 16 + fr) * CS + fq * 8) * 2);                  \
  const bf16x8 b11 = *(const bf16x8*)((Bs) + ((nt0 * 16 + 16 + fr) * CS + 32 + fq * 8) * 2);
#define MM_2TILES(acc0, acc1, a0, a1, b00, b01, b10, b11)                                                \
  acc0 = __builtin_amdgcn_mfma_f32_16x16x32_bf16(a0, b00, acc0, 0, 0, 0);                                \
  acc0 = __builtin_amdgcn_mfma_f32_16x16x32_bf16(a1, b01, acc0, 0, 0, 0);                                \
  acc1 = __builtin_amdgcn_mfma_f32_16x16x32_bf16(a0, b10, acc1, 0, 0, 0);                                \
  acc1 = __builtin_amdgcn_mfma_f32_16x16x32_bf16(a1, b11, acc1, 0, 0, 0);
__device__ __forceinline__ void wr_T(char* slot, int mt, int nt, int fr, int fq, f32x4 v) {
  *(bf16x4*)(slot + ((nt * 16 + fr) * CS + mt * 16 + 4 * fq) * 2) = pack4(v[0], v[1], v[2], v[3]);
}

struct ChunkIn { float lw[8], f0[8], f1[8], f2[8], f3[8], xv[8], be[8]; };
template <bool GDN>
__device__ __forceinline__ void chunk_load(PP pp, int t, ChunkIn& ci) {
  const int tid = tid_opaque(), c = tid & 63, tg = wave_id(tid);
  const int chain = t / NCHUNK, n = t - chain * NCHUNK;
  const int d = chain & 1, h = (chain >> 1) & 3, b = (chain >> 3) & 1;
  const char* S = p.ws + OFF_S;
#pragma unroll
  for (int u = 0; u < 8; ++u) {
    const int m = scan_tok(b, d, n * 64 + tg * 8 + u);
    const size_t o = (size_t)m * 256 + h * 64 + c;
    if (!GDN) {
      ci.lw[u] = ((const float*)(S + S_RWW))[(size_t)d * NTOK * 256 + o];
      ci.f0[u] = ((const float*)(S + S_RWKK))[o];
      ci.f1[u] = ((const float*)(S + S_RWB))[(size_t)d * NTOK * 256 + o];
      ci.f2[u] = ((const float*)(S + S_RWKD))[(size_t)d * NTOK * 256 + o];
      ci.f3[u] = ((const float*)(S + S_RWR))[o];
      ci.xv[u] = ((const float*)(S + S_RWV))[o];
      ci.be[u] = 1.f;
    } else {
      ci.lw[u] = ((const float*)(S + S_GDAB))[(size_t)m * 16 + d * 4 + h];
      ci.be[u] = ((const float*)(S + S_GDAB))[(size_t)m * 16 + 8 + d * 4 + h];
      ci.f0[u] = ((const float*)(S + S_GDK))[o];
      ci.f3[u] = ((const float*)(S + S_GDQ))[o];
      ci.xv[u] = ((const float*)(S + S_GDV))[o];
      ci.f1[u] = 0.f; ci.f2[u] = 0.f;
    }
  }
}
template <bool GDN>
__device__ __forceinline__ void chunk_prep_task(PP pp, int t, int t_next, bool has_next, const ChunkIn& ci, ChunkIn& nx, char* smem) {
  const int chain = t / NCHUNK, n = t - chain * NCHUNK;
  const int d = chain & 1, h = (chain >> 1) & 3, b = (chain >> 3) & 1;
  (void)b; (void)d; (void)h;
  const int tid = tid_opaque(), lane = tid & 63, wv = wave_id(tid);
  const int fr = lane & 15, fq = lane >> 4, mt = wv >> 1, nt0 = (wv & 1) * 2;
  char* S = p.ws + OFF_S;
  char* CH = p.ws + OFF_CH;
  const size_t cc = (size_t)chain * NCHUNK + n;
  char* const p0 = smem;
  char* const p1 = smem + 1 * SLOT_BYTES;
  char* const p2 = smem + 2 * SLOT_BYTES;
  char* const p3 = smem + 3 * SLOT_BYTES;
  char* const p4 = smem + 4 * SLOT_BYTES;
  char* const p5 = smem + 5 * SLOT_BYTES;
  char* const p6 = smem + 6 * SLOT_BYTES;
  char* const p7 = smem + 7 * SLOT_BYTES;
  char* const p8 = smem + 8 * SLOT_BYTES;
  char* const p9 = smem + 9 * SLOT_BYTES;
  char* const p10 = smem + 10 * SLOT_BYTES;
  char* const p11 = smem + 11 * SLOT_BYTES;
  char* const p12 = smem + 12 * SLOT_BYTES;
  float* const F0 = (float*)(smem + X1_F0);
  float* const Lv = (float*)(smem + X1_ARR);
  float* const Lm1v = Lv + 64;
  float* const betav = Lv + 128;
  float* const eLv = Lv + 192;
  float* const gC = Lv + 256;
  float* const gsum = Lv + 320;
  char* const sKt = p0;
  char* const sBh = GDN ? p0 : p1;
  char* const sKh = GDN ? p0 : p2;

  {
    const int c = lane, tg = wv;
    const float* lw = ci.lw; const float* f0 = ci.f0; const float* f1 = ci.f1; const float* f2 = ci.f2; const float* f3 = ci.f3; const float* xv = ci.xv; const float* be = ci.be;
    float cum[8];
    cum[0] = lw[0];
#pragma unroll
    for (int u = 1; u < 8; ++u) cum[u] = cum[u - 1] + lw[u];
    gsum[tg * 64 + c] = cum[7];
    LBAR();
    float off = 0.f, LC = 0.f;
#pragma unroll
    for (int g2 = 0; g2 < 8; ++g2) { const float gs = gsum[g2 * 64 + c]; LC += gs; off += (g2 < tg) ? gs : 0.f; }
    bf16x8 vKtT, vBbT, vKbT, vXT;
#pragma unroll
    for (int u = 0; u < 8; ++u) {
      const int t = tg * 8 + u;
      const float L = off + cum[u], Lm1 = L - lw[u];
      if (!GDN) {
        const float eLm1 = __expf(Lm1), enL = __expf(-L), eL = __expf(L), eCL = __expf(LC - L);
        const float kt = f0[u] * eLm1;
        *(bfr*)(p0 + (t * CS + c) * 2) = f2bf(kt);
        *(bfr*)(p1 + (t * CS + c) * 2) = f2bf(f1[u] * enL);
        *(bfr*)(p2 + (t * CS + c) * 2) = f2bf(f2[u] * enL);
        *(bfr*)(p3 + (t * CS + c) * 2) = f2bf(f3[u] * eL);
        vKtT[u] = (short)f2bf(kt);
        vBbT[u] = (short)f2bf(f1[u] * eCL);
        vKbT[u] = (short)f2bf(f2[u] * eCL);
        vXT[u] = (short)f2bf(xv[u]);
      } else {
        *(bfr*)(p0 + (t * CS + c) * 2) = f2bf(f0[u]);
        *(bfr*)(p3 + (t * CS + c) * 2) = f2bf(f3[u]);
        vKtT[u] = (short)f2bf(f0[u] * __expf(Lm1));
        vBbT[u] = (short)f2bf(be[u] * f0[u] * __expf(LC - Lm1));
        vKbT[u] = (short)f2bf(f0[u] * __expf(LC - L));
        vXT[u] = (short)f2bf(be[u] * xv[u]);
        if (c == 0) { Lv[t] = L; Lm1v[t] = Lm1; betav[t] = be[u]; eLv[t] = __expf(L); }
      }
    }
    *(bf16x8*)(p4 + (c * CS + tg * 8) * 2) = vKtT;
    *(bf16x8*)(p5 + (c * CS + tg * 8) * 2) = vBbT;
    *(bf16x8*)(p6 + (c * CS + tg * 8) * 2) = vKbT;
    *(bf16x8*)(p7 + (c * CS + tg * 8) * 2) = vXT;
    if (tg == 0) gC[c] = __expf(LC);
    if (!GDN && tid < 64) { Lv[tid] = 0.f; Lm1v[tid] = 0.f; betav[tid] = 1.f; eLv[tid] = 1.f; }
  }
  LBAR();
  if (has_next) chunk_load<GDN>(pp, t_next, nx);
  {
    {
      MM_FRAGS(sKt, sBh, a0, a1, b00, b01, b10, b11)
      f32x4 c0 = {0.f, 0.f, 0.f, 0.f}, c1 = c0;
      MM_2TILES(c0, c1, a0, a1, b00, b01, b10, b11)
#pragma unroll
      for (int q = 0; q < 2; ++q) {
        const int sI = (nt0 + q) * 16 + fr;
        const f32x4 cv = q ? c1 : c0;
        f32x4 o;
#pragma unroll
        for (int r = 0; r < 4; ++r) {
          const int tI = mt * 16 + 4 * fq + r;
          float v = cv[r];
          if (GDN) v *= betav[sI] * __expf(fminf(Lm1v[tI] - Lm1v[sI], 0.f));
          o[r] = (sI < tI) ? v : 0.f;
        }
        *(f32x4*)(F0 + sI * F0_STRIDE + mt * 16 + 4 * fq) = o;
        wr_T(p11, mt, nt0 + q, fr, fq, o);
      }
    }
    {
      MM_FRAGS(sKt, sKh, a0, a1, b00, b01, b10, b11)
      f32x4 c0 = {0.f, 0.f, 0.f, 0.f}, c1 = c0;
      MM_2TILES(c0, c1, a0, a1, b00, b01, b10, b11)
#pragma unroll
      for (int q = 0; q < 2; ++q) {
        const int sI = (nt0 + q) * 16 + fr;
        const f32x4 cv = q ? c1 : c0;
        f32x4 o;
#pragma unroll
        for (int r = 0; r < 4; ++r) {
          const int tI = mt * 16 + 4 * fq + r;
          float v = cv[r];
          if (GDN) v *= __expf(fminf(Lm1v[tI] - Lv[sI], 0.f));
          o[r] = (sI < tI) ? v : 0.f;
        }
        wr_T(p9, mt, nt0 + q, fr, fq, o);
      }
    }
    {
      MM_FRAGS(sBh, p3, a0, a1, b00, b01, b10, b11)
      f32x4 c0 = {0.f, 0.f, 0.f, 0.f}, c1 = c0;
      MM_2TILES(c0, c1, a0, a1, b00, b01, b10, b11)
#pragma unroll
      for (int q = 0; q < 2; ++q) {
        const int tI = (nt0 + q) * 16 + fr;
        const f32x4 cv = q ? c1 : c0;
        f32x4 o;
#pragma unroll
        for (int r = 0; r < 4; ++r) {
          const int sI = mt * 16 + 4 * fq + r;
          float v = cv[r];
          if (GDN) v *= betav[sI] * __expf(fminf(Lv[tI] - Lm1v[sI], 0.f));
          o[r] = (sI <= tI) ? v : 0.f;
        }
        wr_T(p10, mt, nt0 + q, fr, fq, o);
      }
    }
  }
  LBAR();
  if (wv < 2) {
    const int base = wv * 32, other = 32 - base, c = lane & 31;
    float tr[32];
#pragma unroll
    for (int j = 0; j < 32; ++j) tr[j] = 0.f;
#pragma unroll
    for (int i = 31; i >= 0; --i) {
      float a0 = (c == i) ? 1.f : 0.f, a1 = 0.f, a2 = 0.f, a3 = 0.f;
#pragma unroll
      for (int jb = ((i + 1) & ~3); jb < 32; jb += 4) {
        const f32x4 a4 = *(const f32x4*)(F0 + (base + i) * F0_STRIDE + base + jb);
        a0 -= a4[0] * tr[jb]; a1 -= a4[1] * tr[jb + 1]; a2 -= a4[2] * tr[jb + 2]; a3 -= a4[3] * tr[jb + 3];
      }
      const float acc = (a0 + a1) + (a2 + a3);
      tr[i] = acc;
      if (lane < 32) {
        *(bfr*)(p8 + ((base + i) * CS + base + c) * 2) = f2bf(acc);
        *(bfr*)(p8 + ((base + i) * CS + other + c) * 2) = (bfr)0;
      }
    }
    if (lane < 32) {
#pragma unroll
      for (int q = 0; q < 4; ++q) {
        bf16x8 o, z;
#pragma unroll
        for (int j = 0; j < 8; ++j) { o[j] = (short)f2bf(tr[8 * q + j]); z[j] = 0; }
        *(bf16x8*)(p12 + ((base + c) * CS + base + 8 * q) * 2) = o;
        *(bf16x8*)(p12 + ((base + c) * CS + other + 8 * q) * 2) = z;
      }
    }
  }
  LBAR();
  {
    MM_FRAGS(p11, p12, a0, a1, b00, b01, b10, b11)
    f32x4 c0 = {0.f, 0.f, 0.f, 0.f}, c1 = c0;
    MM_2TILES(c0, c1, a0, a1, b00, b01, b10, b11)
    wr_T(p1, mt, nt0, fr, fq, c0);
    wr_T(p1, mt, nt0 + 1, fr, fq, c1);
  }
  LBAR();
  if (mt < 2 && nt0 == 2) {
    MM_FRAGS(p8, p1, a0, a1, b00, b01, b10, b11)
    f32x4 c0 = {0.f, 0.f, 0.f, 0.f}, c1 = c0;
    MM_2TILES(c0, c1, a0, a1, b00, b01, b10, b11)
#pragma unroll
    for (int r = 0; r < 4; ++r) {
      *(bfr*)(p8 + ((mt * 16 + 4 * fq + r) * CS + (nt0) * 16 + fr) * 2) = f2bf(-c0[r]);
      *(bfr*)(p8 + ((mt * 16 + 4 * fq + r) * CS + (nt0 + 1) * 16 + fr) * 2) = f2bf(-c1[r]);
    }
  }
  LBAR();
  {
    {
      MM_FRAGS(p8, p5, a0, a1, b00, b01, b10, b11)
      f32x4 c0 = {0.f, 0.f, 0.f, 0.f}, c1 = c0;
      MM_2TILES(c0, c1, a0, a1, b00, b01, b10, b11)
      wr_T(p11, mt, nt0, fr, fq, -c0);
      wr_T(p11, mt, nt0 + 1, fr, fq, -c1);
    }
    {
      MM_FRAGS(p8, p10, a0, a1, b00, b01, b10, b11)
      f32x4 c0 = {0.f, 0.f, 0.f, 0.f}, c1 = c0;
      MM_2TILES(c0, c1, a0, a1, b00, b01, b10, b11)
      wr_T(p12, mt, nt0, fr, fq, -c0);
      wr_T(p12, mt, nt0 + 1, fr, fq, -c1);
    }
  }
  LBAR();
  {
    {
      MM_FRAGS(p4, p11, a0, a1, b00, b01, b10, b11)
      f32x4 c0 = {0.f, 0.f, 0.f, 0.f}, c1 = c0;
      MM_2TILES(c0, c1, a0, a1, b00, b01, b10, b11)
#pragma unroll
      for (int q = 0; q < 2; ++q) {
        const int cp = (nt0 + q) * 16 + fr;
        f32x4 cv = q ? c1 : c0;
#pragma unroll
        for (int r = 0; r < 4; ++r) { const int cI = mt * 16 + 4 * fq + r; if (cI == cp) cv[r] += gC[cI]; }
        wr_T(p10, mt, nt0 + q, fr, fq, cv);
      }
    }
    {
      MM_FRAGS(p9, p11, a0, a1, b00, b01, b10, b11)
      f32x4 c0 = {0.f, 0.f, 0.f, 0.f}, c1 = c0;
      MM_2TILES(c0, c1, a0, a1, b00, b01, b10, b11)
#pragma unroll
      for (int q = 0; q < 2; ++q) {
        const int cp = (nt0 + q) * 16 + fr;
        f32x4 cv = q ? c1 : c0;
        const bf16x4 kb = *(const bf16x4*)(p6 + (cp * CS + mt * 16 + 4 * fq) * 2);
#pragma unroll
        for (int r = 0; r < 4; ++r) cv[r] += __uint_as_float(((unsigned)(unsigned short)kb[r]) << 16);
        wr_T(p8, mt, nt0 + q, fr, fq, cv);
      }
    }
    {
      MM_FRAGS(p4, p12, a0, a1, b00, b01, b10, b11)
      f32x4 c0 = {0.f, 0.f, 0.f, 0.f}, c1 = c0;
      MM_2TILES(c0, c1, a0, a1, b00, b01, b10, b11)
#pragma unroll
      for (int q = 0; q < 2; ++q) {
        const int tI = (nt0 + q) * 16 + fr;
        f32x4 cv = q ? c1 : c0;
        const bf16x4 rt = *(const bf16x4*)(p3 + (tI * CS + mt * 16 + 4 * fq) * 2);
        const float el = eLv[tI];
#pragma unroll
        for (int r = 0; r < 4; ++r) cv[r] += __uint_as_float(((unsigned)(unsigned short)rt[r]) << 16) * el;
        wr_T(p1, mt, nt0 + q, fr, fq, cv);
      }
    }
    {
      f32x4 c0 = {0.f, 0.f, 0.f, 0.f}, c1 = c0;
      {
        MM_FRAGS(sKh, p3, a0, a1, b00, b01, b10, b11)
        MM_2TILES(c0, c1, a0, a1, b00, b01, b10, b11)
      }
#pragma unroll
      for (int q = 0; q < 2; ++q) {
        const int tI = (nt0 + q) * 16 + fr;
#pragma unroll
        for (int r = 0; r < 4; ++r) {
          const int sI = mt * 16 + 4 * fq + r;
          float v = q ? c1[r] : c0[r];
          if (GDN) v *= __expf(fminf(Lv[tI] - Lv[sI], 0.f));
          v = (sI <= tI) ? v : 0.f;
          if (q) c1[r] = v; else c0[r] = v;
        }
      }
      {
        MM_FRAGS(p9, p12, a0, a1, b00, b01, b10, b11)
        MM_2TILES(c0, c1, a0, a1, b00, b01, b10, b11)
      }
      wr_T(p5, mt, nt0, fr, fq, c0);
      wr_T(p5, mt, nt0 + 1, fr, fq, c1);
    }
  }
  LBAR();
  {
    {
      MM_FRAGS(p8, p7, a0, a1, b00, b01, b10, b11)
      f32x4 c0 = {0.f, 0.f, 0.f, 0.f}, c1 = c0;
      MM_2TILES(c0, c1, a0, a1, b00, b01, b10, b11)
      float* QT = (float*)(CH + cc * CH_REC + CH_QT);
      *(f32x4*)(QT + ((mt * 4 + nt0) * 64 + lane) * 4) = c0;
      *(f32x4*)(QT + ((mt * 4 + nt0 + 1) * 64 + lane) * 4) = c1;
    }
    {
      const int fm = wv >> 1, fa = wv & 1;
      const int row = fm * 16 + fr;
      {
        const bf16x4 lo = *(const bf16x4*)(p10 + (row * CS + 32 * fa + 4 * fq) * 2);
        const bf16x4 hi = *(const bf16x4*)(p10 + (row * CS + 32 * fa + 16 + 4 * fq) * 2);
        bf16x8 f; f[0] = lo[0]; f[1] = lo[1]; f[2] = lo[2]; f[3] = lo[3]; f[4] = hi[0]; f[5] = hi[1]; f[6] = hi[2]; f[7] = hi[3];
        *(bf16x8*)(CH + cc * CH_REC + CH_PT + (size_t)((fm * 2 + fa) * 64 + lane) * 16) = f;
      }
      {
        const bf16x4 lo = *(const bf16x4*)(p1 + (row * CS + 32 * fa + 4 * fq) * 2);
        const bf16x4 hi = *(const bf16x4*)(p1 + (row * CS + 32 * fa + 16 + 4 * fq) * 2);
        bf16x8 f; f[0] = lo[0]; f[1] = lo[1]; f[2] = lo[2]; f[3] = lo[3]; f[4] = hi[0]; f[5] = hi[1]; f[6] = hi[2]; f[7] = hi[3];
        *(bf16x8*)(CH + cc * CH_REC + CH_RYT + (size_t)((fm * 2 + fa) * 64 + lane) * 16) = f;
      }
      *(bf16x8*)(CH + cc * CH_REC + CH_WYT + (size_t)((fm * 2 + fa) * 64 + lane) * 16) = *(const bf16x8*)(p5 + (row * CS + 32 * fa + 8 * fq) * 2);
      *(bf16x8*)(CH + cc * CH_REC + CH_XT + (size_t)((fm * 2 + fa) * 64 + lane) * 16) = *(const bf16x8*)(p7 + (row * CS + 32 * fa + 8 * fq) * 2);
    }
  }
  LBAR();
}

template <bool GDN>
__device__ __forceinline__ void chunk_prep_loop(PP pp, int t0, int tend, int nb, char* smem) {
  ChunkIn cur, nxt;
  if (t0 < tend) chunk_load<GDN>(pp, t0, cur);
  for (int t = t0; t < tend; t += nb) {
    const bool has_next = (t + nb) < tend;
    chunk_prep_task<GDN>(pp, t, t + nb, has_next, cur, nxt, smem);
    cur = nxt;
  }
}
__device__ __forceinline__ void phase_chunk_prep(PP pp, int bid, int nb, char* smem) {
  __syncthreads();
  const int half = (NCHAIN / 2) * NCHUNK;
  chunk_prep_loop<false>(pp, bid, half, nb, smem);
  const int k0 = (half - bid + nb - 1) / nb;
  chunk_prep_loop<true>(pp, bid + k0 * nb, NCHAIN * NCHUNK, nb, smem);
  __syncthreads();
}

#define X2_BUF 49152
#define X2_BAR() do { asm volatile("s_waitcnt lgkmcnt(0)" ::: "memory"); __builtin_amdgcn_s_barrier(); asm volatile("" ::: "memory"); } while (0)
__device__ __forceinline__ void chunk_seq_chain(PP pp, int chain, char* smem) {
  __syncthreads();
  const int tid = tid_opaque(), lane = tid & 63, wv = wave_id(tid);
  const int d = chain & 1, h = (chain >> 1) & 3, b = (chain >> 3) & 1, ty = chain >> 4;
  const char* CH = p.ws + OFF_CH;
  float* Y = (float*)(p.ws + OFF_S + (ty ? S_YGD : S_YRW)) + (size_t)d * NTOK * 256;
  const size_t c0 = (size_t)chain * NCHUNK;
  if (wv >= 4) {
    const int lw = wv - 4;
    const char* src0 = CH + c0 * CH_REC + (size_t)lane * 16;
#define X2_DMA(n) { const char* s_ = src0 + (size_t)(n) * CH_REC; LAS unsigned char* d_ = (LAS unsigned char*)smem + ((n) % 3) * X2_BUF;       \
      _Pragma("unroll") for (int i = 0; i < 12; ++i) {                                                                                      \
        const int piece = i * 4 + lw;                                                                                                       \
        __builtin_amdgcn_global_load_lds((const unsigned*)(s_ + piece * 1024), (LAS unsigned*)(d_ + piece * 1024), 16, 0, 0); } }
    X2_DMA(0) X2_DMA(1)
    asm volatile("s_waitcnt vmcnt(12)" ::: "memory");
    X2_BAR();
    for (int n = 0; n < NCHUNK; ++n) {
      if (n + 2 < NCHUNK) { X2_DMA(n + 2) asm volatile("s_waitcnt vmcnt(12)" ::: "memory"); }
      else asm volatile("s_waitcnt vmcnt(0)" ::: "memory");
      X2_BAR();
    }
#undef X2_DMA
  } else {
    const int vt = wv, fr = lane & 15, fq = lane >> 4;
    f32x4 Sacc[4];
#pragma unroll
    for (int i = 0; i < 4; ++i) Sacc[i] = (f32x4){0.f, 0.f, 0.f, 0.f};
    X2_BAR();
    for (int n = 0; n < NCHUNK; ++n) {
      const char* buf = smem + (n % 3) * X2_BUF;
      bf16x8 sB0, sB1;
#pragma unroll
      for (int j = 0; j < 4; ++j) {
        sB0[j] = (short)f2bf(Sacc[0][j]); sB0[4 + j] = (short)f2bf(Sacc[1][j]);
        sB1[j] = (short)f2bf(Sacc[2][j]); sB1[4 + j] = (short)f2bf(Sacc[3][j]);
      }
      const bf16x8 xB0 = *(const bf16x8*)(buf + 24576 + ((vt * 2 + 0) * 64 + lane) * 16);
      const bf16x8 xB1 = *(const bf16x8*)(buf + 24576 + ((vt * 2 + 1) * 64 + lane) * 16);
#pragma unroll
      for (int m = 0; m < 4; ++m) {
        const bf16x8 pa0 = *(const bf16x8*)(buf + ((m * 2 + 0) * 64 + lane) * 16);
        const bf16x8 pa1 = *(const bf16x8*)(buf + ((m * 2 + 1) * 64 + lane) * 16);
        const bf16x8 ra0 = *(const bf16x8*)(buf + 8192 + ((m * 2 + 0) * 64 + lane) * 16);
        const bf16x8 ra1 = *(const bf16x8*)(buf + 8192 + ((m * 2 + 1) * 64 + lane) * 16);
        const bf16x8 wa0 = *(const bf16x8*)(buf + 16384 + ((m * 2 + 0) * 64 + lane) * 16);
        const bf16x8 wa1 = *(const bf16x8*)(buf + 16384 + ((m * 2 + 1) * 64 + lane) * 16);
        const f32x4 qt = *(const f32x4*)(buf + 32768 + ((m * 4 + vt) * 64 + lane) * 16);
        f32x4 y = {0.f, 0.f, 0.f, 0.f};
        y = __builtin_amdgcn_mfma_f32_16x16x32_bf16(sB0, ra0, y, 0, 0, 0);
        y = __builtin_amdgcn_mfma_f32_16x16x32_bf16(sB1, ra1, y, 0, 0, 0);
        y = __builtin_amdgcn_mfma_f32_16x16x32_bf16(xB0, wa0, y, 0, 0, 0);
        y = __builtin_amdgcn_mfma_f32_16x16x32_bf16(xB1, wa1, y, 0, 0, 0);
        f32x4 sn = __builtin_amdgcn_mfma_f32_16x16x32_bf16(pa0, sB0, qt, 0, 0, 0);
        sn = __builtin_amdgcn_mfma_f32_16x16x32_bf16(pa1, sB1, sn, 0, 0, 0);
        Sacc[m] = sn;
        {
          const int mm = scan_tok(b, d, n * 64 + m * 16 + fr);
          *(f32x4*)(Y + (size_t)mm * 256 + h * 64 + vt * 16 + 4 * fq) = y;
        }
      }
      X2_BAR();
    }
  }
}

struct NaPair { int mk0, mk1, tau0, tau1, kr0, kr1, ct0, ct1; };
struct NaFrag { bf16x8 k00, k01, k10, k11; bf16x4 v0[4], v1[4]; };

__device__ __forceinline__ void na_load(NaFrag& f, const bfr* KN, const bfr* VT, size_t vt_base, int h, int fr, int fq, const NaPair& pr) {
  const bfr* k0 = KN + (size_t)(pr.mk0 + fr) * 512 + h * 64 + fq * 8;
  const bfr* k1 = KN + (size_t)(pr.mk1 + fr) * 512 + h * 64 + fq * 8;
  f.k00 = *(const bf16x8*)(k0); f.k01 = *(const bf16x8*)(k0 + 32);
  f.k10 = *(const bf16x8*)(k1); f.k11 = *(const bf16x8*)(k1 + 32);
#pragma unroll
  for (int dt = 0; dt < 4; ++dt) {
    const bfr* vrow = VT + vt_base + (size_t)(dt * 16 + fr) * TTOK;
    f.v0[dt] = *(const bf16x4*)(vrow + pr.tau0 + fq * 4);
    f.v1[dt] = *(const bf16x4*)(vrow + pr.tau1 + fq * 4);
  }
}

__device__ __forceinline__ void na_compute(const NaFrag& f, const bf16x8 qf0, const bf16x8 qf1, bool local, bool vr0, bool vr1,
                                           int dr0, int dr1, int ct0, int ct1, int qc, int fq, const float* bias_h, f32x4 (&O)[4], float& lsum) {
  f32x4 z = {0.f, 0.f, 0.f, 0.f};
  f32x4 st0 = __builtin_amdgcn_mfma_f32_16x16x32_bf16(f.k00, qf0, z, 0, 0, 0);
  st0 = __builtin_amdgcn_mfma_f32_16x16x32_bf16(f.k01, qf1, st0, 0, 0, 0);
  f32x4 st1 = __builtin_amdgcn_mfma_f32_16x16x32_bf16(f.k10, qf0, z, 0, 0, 0);
  st1 = __builtin_amdgcn_mfma_f32_16x16x32_bf16(f.k11, qf1, st1, 0, 0, 0);
  bf16x8 pf;
  if (local) {
    const int cs = min(max(qc - 8, 0), 48);
#pragma unroll
    for (int r = 0; r < 4; ++r) {
      const int kc0 = ct0 * 16 + fq * 4 + r, kc1 = ct1 * 16 + fq * 4 + r;
      float p0 = 0.f, p1 = 0.f;
      if (vr0 && (unsigned)(kc0 - cs) < 16u) p0 = exp2f(st0[r] + bias_h[dr0 * 31 + (kc0 - qc + 15)]);
      if (vr1 && (unsigned)(kc1 - cs) < 16u) p1 = exp2f(st1[r] + bias_h[dr1 * 31 + (kc1 - qc + 15)]);
      lsum += p0 + p1;
      pf[r] = (short)f2bf(p0);
      pf[4 + r] = (short)f2bf(p1);
    }
  } else {
#pragma unroll
    for (int r = 0; r < 4; ++r) {
      const float p0 = exp2f(st0[r]), p1 = exp2f(st1[r]);
      lsum += p0 + p1;
      pf[r] = (short)f2bf(p0);
      pf[4 + r] = (short)f2bf(p1);
    }
  }
#pragma unroll
  for (int dt = 0; dt < 4; ++dt) {
    bf16x8 vf;
    vf[0] = f.v0[dt][0]; vf[1] = f.v0[dt][1]; vf[2] = f.v0[dt][2]; vf[3] = f.v0[dt][3];
    vf[4] = f.v1[dt][0]; vf[5] = f.v1[dt][1]; vf[6] = f.v1[dt][2]; vf[7] = f.v1[dt][3];
    O[dt] = __builtin_amdgcn_mfma_f32_16x16x32_bf16(vf, pf, O[dt], 0, 0, 0);
  }
}

__device__ __forceinline__ void na_block_task(PP pp, int task, const float* bias_lds) {
  const int tid = tid_opaque(), lane = tid & 63, wv = wave_id(tid);
  const int fr = lane & 15, fq = lane >> 4;
  char* S = p.ws + OFF_S;
  const bfr* QN = (const bfr*)(S + S_QN);
  const bfr* KN = (const bfr*)(S + S_KN);
  const bfr* VT = (const bfr*)(S + S_VT);
  bfr* CC = (bfr*)(p.ws + OFF_CC);
  const bool latent = task < 1024;
  int b, h, mqa, mqb, qra = 0, qrb = 0, cgp = 0;
  if (latent) {
    h = task & 7; const int quad = (task >> 3) & 63; b = task >> 9;
    qra = quad * 4 + (wv >> 2) * 2; qrb = qra + 1; cgp = wv & 3;
    mqa = b * SEQ + qra * 64 + cgp * 16; mqb = mqa + 64;
  } else {
    const int u = task - 1024;
    h = u & 7; b = u >> 3;
    mqa = NLAT + b * CTXL + (wv * 2) * 16; mqb = mqa + 16;
  }
  const bf16x8 qa0 = *(const bf16x8*)(QN + (size_t)(mqa + fr) * 512 + h * 64 + fq * 8);
  const bf16x8 qa1 = *(const bf16x8*)(QN + (size_t)(mqa + fr) * 512 + h * 64 + 32 + fq * 8);
  const bf16x8 qb0 = *(const bf16x8*)(QN + (size_t)(mqb + fr) * 512 + h * 64 + fq * 8);
  const bf16x8 qb1 = *(const bf16x8*)(QN + (size_t)(mqb + fr) * 512 + h * 64 + 32 + fq * 8);
  f32x4 Oa[4], Ob[4];
#pragma unroll
  for (int dt = 0; dt < 4; ++dt) { Oa[dt] = (f32x4){0.f, 0.f, 0.f, 0.f}; Ob[dt] = Oa[dt]; }
  float lsa = 0.f, lsb = 0.f;
  const size_t vt_base = (size_t)(b * 8 + h) * 64 * TTOK;
  const int rsa = min(max(qra - 4, 0), SEQ / 64 - 8), rsb = min(max(qrb - 4, 0), SEQ / 64 - 8);
  const int nrows = latent ? (rsb - rsa + 8) : 0;
  const int ct_first = (cgp <= 1) ? 0 : cgp - 1;
  const int nct = (cgp == 0 || cgp == 3) ? 2 : 3;
  const int ntile = nrows * nct;
  const int nlp = (ntile + 1) >> 1;
  const int npair = nlp + 8;
  const int qc = cgp * 16 + fr;
  auto mkpair = [&](int pi) {
    NaPair pr;
    if (pi < nlp) {
      const int i0 = 2 * pi, i1 = min(2 * pi + 1, ntile - 1);
      pr.kr0 = rsa + i0 / nct; pr.ct0 = ct_first + i0 % nct;
      pr.kr1 = rsa + i1 / nct; pr.ct1 = ct_first + i1 % nct;
      if (2 * pi + 1 >= ntile) pr.kr1 = -100;
      const int r1 = rsa + i1 / nct;
      pr.tau0 = pr.kr0 * 64 + pr.ct0 * 16; pr.tau1 = r1 * 64 + pr.ct1 * 16;
      pr.mk0 = b * SEQ + pr.tau0; pr.mk1 = b * SEQ + pr.tau1;
    } else {
      const int c = pi - nlp;
      pr.kr0 = pr.kr1 = pr.ct0 = pr.ct1 = 0;
      pr.tau0 = SEQ + c * 32; pr.tau1 = SEQ + c * 32 + 16;
      pr.mk0 = NLAT + b * CTXL + c * 32; pr.mk1 = pr.mk0 + 16;
    }
    return pr;
  };
  NaFrag fa, fb;
  NaPair pa = mkpair(0), pb;
  na_load(fa, KN, VT, vt_base, h, fr, fq, pa);
  const float* bias_h = bias_lds + h * 465;
#define NA_DO(F, PR, PI)                                                                                          \
  {                                                                                                               \
    const bool loc_ = (PI) < nlp;                                                                                 \
    na_compute(F, qa0, qa1, loc_, (unsigned)(PR.kr0 - rsa) < 8u, (unsigned)(PR.kr1 - rsa) < 8u,                   \
               PR.kr0 - qra + 7, PR.kr1 - qra + 7, PR.ct0, PR.ct1, qc, fq, bias_h, Oa, lsa);                      \
    na_compute(F, qb0, qb1, loc_, (unsigned)(PR.kr0 - rsb) < 8u, (unsigned)(PR.kr1 - rsb) < 8u,                   \
               PR.kr0 - qrb + 7, PR.kr1 - qrb + 7, PR.ct0, PR.ct1, qc, fq, bias_h, Ob, lsb);                      \
  }
  for (int pi = 0; pi < npair; pi += 2) {
    if (pi + 1 < npair) { pb = mkpair(pi + 1); na_load(fb, KN, VT, vt_base, h, fr, fq, pb); }
    NA_DO(fa, pa, pi)
    if (pi + 1 < npair) {
      if (pi + 2 < npair) { pa = mkpair(pi + 2); na_load(fa, KN, VT, vt_base, h, fr, fq, pa); }
      NA_DO(fb, pb, pi + 1)
    }
  }
#undef NA_DO
  lsa += shfl_xor_l(lsa, 16, lane); lsa += shfl_xor_l(lsa, 32, lane);
  lsb += shfl_xor_l(lsb, 16, lane); lsb += shfl_xor_l(lsb, 32, lane);
  const float ia = 1.f / lsa, ib = 1.f / lsb;
#pragma unroll
  for (int dt = 0; dt < 4; ++dt) {
    *(bf16x4*)(CC + (size_t)(mqa + fr) * 1024 + h * 64 + dt * 16 + fq * 4) = pack4(Oa[dt][0] * ia, Oa[dt][1] * ia, Oa[dt][2] * ia, Oa[dt][3] * ia);
    *(bf16x4*)(CC + (size_t)(mqb + fr) * 1024 + h * 64 + dt * 16 + fq * 4) = pack4(Ob[dt][0] * ib, Ob[dt][1] * ib, Ob[dt][2] * ib, Ob[dt][3] * ib);
  }
}

__device__ __forceinline__ void phase_mix(PP pp, int l, int bid, int nb, char* smem) {
  const int tid = tid_opaque();
  const int nscan_blocks = (nb > 32) ? 32 : nb;
  const int first_attn_block = (nb > 32) ? 32 : 0;
  if (bid < nscan_blocks) {
    for (int c = bid; c < NCHAIN; c += nscan_blocks) chunk_seq_chain(pp, c, smem);
  }
  if (bid >= first_attn_block) {
    float* bias = (float*)smem;
    __syncthreads();
    for (int i = tid; i < 8 * 465; i += NTHR) bias[i] = p.na_rpb[(size_t)l * 8 * 465 + i] * 1.4426950408889634f;
    __syncthreads();
    const int ntask = (l == 0) ? 1024 + 16 : 1024;
    const int nab = nb - first_attn_block;
    for (int t = bid - first_attn_block; t < ntask; t += nab) na_block_task(pp, t, bias);
  }
}

__device__ __forceinline__ void phase_post(PP pp, int l, int bid, int nb) {
  const int tid = tid_opaque(), lane = tid & 63, wv = wave_id(tid);
  char* S = p.ws + OFF_S;
  const float* YRW = (const float*)(S + S_YRW);
  const float* YGD = (const float*)(S + S_YGD);
  const float* RWV = (const float*)(S + S_RWV);
  const float* RWG = (const float*)(S + S_RWG);
  const float* BON = (const float*)(S + S_BON);
  const float* P = (const float*)(p.ws + OFF_P);
  bfr* CC = (bfr*)(p.ws + OFF_CC);
  const float* ln_w = p.rw_ln_w + (size_t)l * 256;
  const float* ln_b = p.rw_ln_b + (size_t)l * 256;
  const float* ng = p.gd_norm_g + (size_t)l * 64;
  const int ntok = (l == 0) ? NTOK : NLAT;
  for (int wt = bid * 8 + wv; wt < ntok * 8; wt += nb * 8) {
    int m = wt >> 3, hs = wt & 7;
    if (hs < 4) {
      int c = hs * 64 + lane;
      size_t o = (size_t)m * 256 + c;
      float y = YRW[o] + YRW[(size_t)NTOK * 256 + o];
      float mean = wave_sum(y) * (1.f / 64.f);
      float dv = y - mean;
      float var = wave_sum(dv * dv) * (1.f / 64.f);
      float yn = dv * rsqrtf(var + 64e-5f) * ln_w[c] + ln_b[c];
      float out = (yn + BON[(size_t)m * 4 + hs] * RWV[o]) * RWG[o];
      CC[(size_t)m * 1024 + 512 + c] = f2bf(out);
    } else {
      int c = (hs - 4) * 64 + lane;
      size_t o = (size_t)m * 256 + c;
      float y = YGD[o] + YGD[(size_t)NTOK * 256 + o];
      float ms = wave_sum(y * y) * (1.f / 64.f);
      float z = P[(size_t)m * PINP + B_END + 768 + c];
      float out = y * rsqrtf(ms + 1e-6f) * ng[lane] * siluf_(z);
      CC[(size_t)m * 1024 + 768 + c] = f2bf(out);
    }
  }
}

#define RW_LDS_ROW 36
__device__ __forceinline__ void phase_router(PP pp, int l, int bid, int nb, char* smem) {
  const int tid = tid_opaque(), lane = tid & 63, wv = wave_id(tid);
  const float* xl = p.out;
  const float* xc = (const float*)(p.ws + OFF_CTX);
  const float* mods = (const float*)(p.ws + OFF_MODS) + (size_t)l * 3 * 6144;
  const float* g = p.norm_ffn_g + (size_t)l * 1024;
  const float* rw = p.moe_router_w + (size_t)l * 1024 * 32;
  const float* rb = p.moe_router_b + (size_t)l * 32;
  bfr* H = (bfr*)(p.ws + OFF_H);
  int* cnt = (int*)(p.ws + OFF_CNT);
  int* TOKE = (int*)(p.ws + OFF_TOKE);
  int* TOKP = (int*)(p.ws + OFF_TOKP);
  float* TOKG = (float*)(p.ws + OFF_TOKG);
  float* wl = (float*)smem;
  for (int i = tid; i < 1024 * 8; i += NTHR) {
    int d = i >> 3, q = i & 7;
    *(float4*)(wl + d * RW_LDS_ROW + q * 4) = *(const float4*)(rw + (size_t)d * 32 + q * 4);
  }
  __syncthreads();
  const int ntok = (l == 0) ? NTOK : NLAT;
  const float rbl = rb[lane & 31];
  for (int m0 = (bid * 8 + wv) * 2; m0 < ntok; m0 += nb * 16) {
    float acc0[32], acc1[32];
#pragma unroll
    for (int e = 0; e < 32; ++e) { acc0[e] = 0.f; acc1[e] = 0.f; }
    float hv0[16], hv1[16];
    {
      const int ma = m0, mb = m0 + 1;
      const float* xa = (ma < NLAT) ? xl + (size_t)ma * 1024 : xc + (size_t)(ma - NLAT) * 1024;
      const float* xb = (mb < NLAT) ? xl + (size_t)mb * 1024 : xc + (size_t)(mb - NLAT) * 1024;
      const float* mda = mods + (size_t)mod_row(ma) * 6144 + 3072;
      const float* mdb = mods + (size_t)mod_row(mb) * 6144 + 3072;
      float ssa = 0.f, ssb = 0.f;
#pragma unroll
      for (int i = 0; i < 16; ++i) { hv0[i] = xa[lane + 64 * i]; hv1[i] = xb[lane + 64 * i]; }
#pragma unroll
      for (int i = 0; i < 16; ++i) { ssa += hv0[i] * hv0[i]; ssb += hv1[i] * hv1[i]; }
      ssa = wave_sum(ssa); ssb = wave_sum(ssb);
      const float rsa = rsqrtf(ssa * (1.f / 1024.f) + 1e-6f), rsb = rsqrtf(ssb * (1.f / 1024.f) + 1e-6f);
#pragma unroll
      for (int i = 0; i < 16; ++i) {
        const int d = lane + 64 * i;
        const float gg = g[d];
        hv0[i] = hv0[i] * rsa * gg * (1.f + mda[1024 + d]) + mda[d];
        hv1[i] = hv1[i] * rsb * gg * (1.f + mdb[1024 + d]) + mdb[d];
        H[(size_t)ma * 1024 + d] = f2bf(hv0[i]);
        H[(size_t)mb * 1024 + d] = f2bf(hv1[i]);
      }
    }
#pragma unroll
    for (int i = 0; i < 16; ++i) {
      const float* wr = wl + (lane + 64 * i) * RW_LDS_ROW;
#pragma unroll
      for (int q = 0; q < 8; ++q) {
        const float4 w = *(const float4*)(wr + q * 4);
        acc0[q * 4 + 0] += hv0[i] * w.x; acc0[q * 4 + 1] += hv0[i] * w.y; acc0[q * 4 + 2] += hv0[i] * w.z; acc0[q * 4 + 3] += hv0[i] * w.w;
        acc1[q * 4 + 0] += hv1[i] * w.x; acc1[q * 4 + 1] += hv1[i] * w.y; acc1[q * 4 + 2] += hv1[i] * w.z; acc1[q * 4 + 3] += hv1[i] * w.w;
      }
    }
#define BFLY(A, N, D)                                                                           \
    _Pragma("unroll") for (int i = 0; i < (N); ++i) {                                            \
      const bool up = (lane & (D)) != 0;                                                         \
      const float keep = up ? A[i + (N)] : A[i];                                                 \
      const float send = up ? A[i] : A[i + (N)];                                                 \
      A[i] = keep + shfl_xor_l(send, (D), lane);                                                   \
    }
    BFLY(acc0, 16, 16) BFLY(acc1, 16, 16)
    BFLY(acc0, 8, 8) BFLY(acc1, 8, 8)
    BFLY(acc0, 4, 4) BFLY(acc1, 4, 4)
    BFLY(acc0, 2, 2) BFLY(acc1, 2, 2)
    BFLY(acc0, 1, 1) BFLY(acc1, 1, 1)
#undef BFLY
    float la = acc0[0] + shfl_xor_l(acc0[0], 32, lane);
    float lb = acc1[0] + shfl_xor_l(acc1[0], 32, lane);
    const int my_e = lane & 31;
    la += rbl; lb += rbl;
    (void)my_e;
#pragma unroll
    for (int tkn = 0; tkn < 2; ++tkn) {
      float v = tkn == 0 ? la : lb;
      float tv[4]; int ti[4];
#pragma unroll
      for (int k = 0; k < 4; ++k) {
        float bv = v; int bi = lane & 31;
#pragma unroll
        for (int o = 16; o >= 1; o >>= 1) {
          float ov = shfl_xor_l(bv, o, lane); int oi = shfl_xor_li(bi, o, lane);
          bool take = (ov > bv) || (ov == bv && oi < bi);
          bv = take ? ov : bv; bi = take ? oi : bi;
        }
        tv[k] = bv; ti[k] = bi;
        if ((lane & 31) == bi) v = -3.0e38f;
      }
      float e1 = __expf(tv[1] - tv[0]), e2 = __expf(tv[2] - tv[0]), e3 = __expf(tv[3] - tv[0]);
      float inv = 1.f / (1.f + e1 + e2 + e3);
      const int m = m0 + tkn;
      if (lane < 4) {
        int e = lane == 0 ? ti[0] : lane == 1 ? ti[1] : lane == 2 ? ti[2] : ti[3];
        float gt = (lane == 0 ? 1.f : lane == 1 ? e1 : lane == 2 ? e2 : e3) * inv;
        int pos = atomicAdd(&cnt[e], 1);
        TOKE[(size_t)m * 4 + lane] = e; TOKP[(size_t)m * 4 + lane] = pos; TOKG[(size_t)m * 4 + lane] = gt;
      }
    }
  }
  __syncthreads();
}

__device__ __forceinline__ void moe_offsets(PP pp, int* toff) {
  const int* cnt = (const int*)(p.ws + OFF_CNT);
  if (tid_opaque() == 0) {
    int a = 0;
    for (int e = 0; e < 32; ++e) { toff[e] = a; a += (cnt[e] + 255) >> 8; }
    toff[32] = a;
  }
  __syncthreads();
}

__device__ __forceinline__ void phase_slotfill(PP pp, int l, int bid, int nb, char* smem) {
  int* toff = (int*)smem;
  moe_offsets(pp, toff);
  const int tid = tid_opaque(), lane = tid & 63, wv = wave_id(tid);
  const int* TOKE = (const int*)(p.ws + OFF_TOKE);
  const int* TOKP = (const int*)(p.ws + OFF_TOKP);
  const float* TOKG = (const float*)(p.ws + OFF_TOKG);
  const int* cnt = (const int*)(p.ws + OFF_CNT);
  int* TOKS = (int*)(p.ws + OFF_TOKS);
  float* SLG = (float*)(p.ws + OFF_SLG);
  const bfr* H = (const bfr*)(p.ws + OFF_H);
  bfr* XG = (bfr*)(p.ws + OFF_S);
  const int n = ((l == 0) ? NTOK : NLAT) * 4;
  for (int i = bid * 8 + wv; i < n; i += nb * 8) {
    int e = TOKE[i];
    int slot = toff[e] * 256 + TOKP[i];
    if (lane == 0) { TOKS[i] = slot; SLG[slot] = TOKG[i]; }
    const uint4* src = (const uint4*)(H + (size_t)(i >> 2) * 1024);
    uint4* dst = (uint4*)(XG + (size_t)slot * 1024);
    dst[lane] = src[lane];
    dst[lane + 64] = src[lane + 64];
  }
  for (int e = 0; e < 32; ++e) {
    const int c = cnt[e];
    const int npad = ((c + 255) & ~255) - c;
    const int base = toff[e] * 256 + c;
    for (int r = bid * 8 + wv; r < npad; r += nb * 8) {
      uint4* dst = (uint4*)(XG + (size_t)(base + r) * 1024);
      dst[lane] = make_uint4(0u, 0u, 0u, 0u);
      dst[lane + 64] = make_uint4(0u, 0u, 0u, 0u);
    }
  }
  __syncthreads();
}

struct EpiMoe1 {
  const float* bgu; bfr* ACT;
  __device__ __forceinline__ void operator()(const f32x4 (&acc)[2][2][4][2], const g8::GUnit& u, int wr, int wc, int fr, int fq) const {
    const float* be = bgu + (size_t)u.e * 2048;
    const int slot0 = u.pm * 256 + wr * 64 + fr;
#pragma unroll
    for (int bj = 0; bj < 2; ++bj) {
      const int j0 = u.pn * 128 + bj * 64 + wc * 16 + 4 * fq;
      const f32x4 bg = *(const f32x4*)(be + j0), bl = *(const f32x4*)(be + 1024 + j0);
#pragma unroll
      for (int ai = 0; ai < 2; ++ai)
#pragma unroll
        for (int m = 0; m < 4; ++m) {
          const f32x4 g = acc[ai][bj][m][0] + bg, li = acc[ai][bj][m][1] + bl;
          bf16x4 o;
#pragma unroll
          for (int q = 0; q < 4; ++q) {
            float gv = fminf(g[q], 7.f);
            float lv = fminf(fmaxf(li[q], -7.f), 7.f);
            o[q] = (short)f2bf(gv * sigmoidf_(1.702f * gv) * (lv + 1.f));
          }
          *(bf16x4*)(ACT + (size_t)(slot0 + ai * 128 + m * 16) * 1024 + j0) = o;
        }
    }
  }
};
__device__ __forceinline__ void phase_moe1_impl(PP pp, int l, int bid, int nb, char* smem, int* toff) {
  moe_offsets(pp, toff);
  g8::MoeSched S{toff, 8, 2048, nb, bid};
  EpiMoe1 E{p.moe_b_gu + (size_t)l * 32 * 2048, (bfr*)(p.ws + OFF_P)};
  g8::gemm_stream((LAS unsigned char*)smem, (const bfr*)(p.ws + OFF_S), (const bfr*)(p.ws + OFF_W + (size_t)l * WL_SIZE + WL_GU), S, E);
}

struct EpiMoe2 {
  const float* bdn; const float* SLG; float* YS;
  __device__ __forceinline__ void operator()(const f32x4 (&acc)[2][2][4][2], const g8::GUnit& u, int wr, int wc, int fr, int fq) const {
    const float* be = bdn + (size_t)u.e * 1024;
    const int slot0 = u.pm * 256 + wr * 64 + fr, col0 = u.pn * 256 + wc * 32 + 4 * fq;
#pragma unroll
    for (int ai = 0; ai < 2; ++ai)
#pragma unroll
      for (int m = 0; m < 4; ++m) {
        const int slot = slot0 + ai * 128 + m * 16;
        const float gt = SLG[slot];
#pragma unroll
        for (int bj = 0; bj < 2; ++bj)
#pragma unroll
          for (int n = 0; n < 2; ++n) {
            const f32x4 bv = *(const f32x4*)(be + col0 + bj * 128 + n * 16);
            *(f32x4*)(YS + (size_t)slot * 1024 + col0 + bj * 128 + n * 16) = (acc[ai][bj][m][n] + bv) * gt;
          }
      }
  }
};
__device__ __forceinline__ void phase_moe2_impl(PP pp, int l, int bid, int nb, char* smem, int* toff) {
  moe_offsets(pp, toff);
  g8::MoeSched S{toff, 4, 1024, nb, bid};
  EpiMoe2 E{p.moe_b_down + (size_t)l * 32 * 1024, (const float*)(p.ws + OFF_SLG), (float*)(p.ws + OFF_S)};
  g8::gemm_stream((LAS unsigned char*)smem, (const bfr*)(p.ws + OFF_P), (const bfr*)(p.ws + OFF_W + (size_t)l * WL_SIZE + WL_DN), S, E);
}

__device__ __forceinline__ void phase_combine(PP pp, int l, int bid, int nb) {
  const int tid = tid_opaque(), lane = tid & 63, wv = wave_id(tid);
  const float* YS = (const float*)(p.ws + OFF_S);
  const int* TOKS = (const int*)(p.ws + OFF_TOKS);
  const float* mods = (const float*)(p.ws + OFF_MODS) + (size_t)l * 3 * 6144;
  float* xl = p.out;
  float* xc = (float*)(p.ws + OFF_CTX);
  const int ntok = (l == 0) ? NTOK : NLAT;
  for (int m = bid * 8 + wv; m < ntok; m += nb * 8) {
    float* xr = (m < NLAT) ? xl + (size_t)m * 1024 : xc + (size_t)(m - NLAT) * 1024;
    const float* g2 = mods + (size_t)mod_row(m) * 6144 + 5120;
    int s0 = TOKS[(size_t)m * 4], s1 = TOKS[(size_t)m * 4 + 1], s2 = TOKS[(size_t)m * 4 + 2], s3 = TOKS[(size_t)m * 4 + 3];
#pragma unroll
    for (int i = 0; i < 4; ++i) {
      int d = (lane + 64 * i) * 4;
      float4 a = *(const float4*)(YS + (size_t)s0 * 1024 + d);
      float4 b = *(const float4*)(YS + (size_t)s1 * 1024 + d);
      float4 c = *(const float4*)(YS + (size_t)s2 * 1024 + d);
      float4 e = *(const float4*)(YS + (size_t)s3 * 1024 + d);
      float4 gg = *(const float4*)(g2 + d);
      float4 xv = *(const float4*)(xr + d);
      xv.x += gg.x * (a.x + b.x + c.x + e.x);
      xv.y += gg.y * (a.y + b.y + c.y + e.y);
      xv.z += gg.z * (a.z + b.z + c.z + e.z);
      xv.w += gg.w * (a.w + b.w + c.w + e.w);
      *(float4*)(xr + d) = xv;
    }
  }
}

#define XB_TMO      128
#define XB_XCNT(j)  (256  + 64 * (j))
#define XB_XSUB(j)  (1280 + 64 * (j))
#define XB_XGEN(j)  (2304 + 64 * (j))
#define XB_TOP      3328
#define XB_TOPGEN   3392
#define XCD_BAR_WORDS 3456
#define XB_SPIN_CAP (1u << 22)
__device__ __forceinline__ unsigned xb_ld(unsigned* q) { return __hip_atomic_load(q, __ATOMIC_RELAXED, __HIP_MEMORY_SCOPE_AGENT); }
__device__ __forceinline__ unsigned xb_add(unsigned* q, unsigned v) { return __hip_atomic_fetch_add(q, v, __ATOMIC_RELAXED, __HIP_MEMORY_SCOPE_AGENT); }
__device__ __forceinline__ unsigned xb_xcc_id() { return (unsigned)__builtin_amdgcn_s_getreg((3 << 11) | 20) & 0xFu; }
#define XB_SPIN(cond, bar) do { unsigned _sp = 0; while (cond) { __builtin_amdgcn_s_sleep(1); \
    if ((++_sp & 255u) == 0u) { if (xb_ld(&(bar)[XB_TMO])) break; if (_sp > XB_SPIN_CAP) { atomicAdd(&(bar)[XB_TMO], 1u); break; } } } } while (0)
struct XcdBarrier { unsigned* bar; unsigned x; volatile LAS unsigned* st; };
__device__ __forceinline__ XcdBarrier xcd_barrier_post(unsigned* bar, volatile LAS unsigned* st) {
  XcdBarrier b; b.bar = bar; b.x = xb_xcc_id(); b.st = st;
  if (tid_opaque() == 0) (void)xb_add(&bar[XB_XCNT(b.x)], 1u);
  return b;
}
__device__ __forceinline__ void xcd_barrier_complete(unsigned* bar, unsigned x, unsigned& nloc, unsigned& nx) {
  const unsigned G = gridDim.x;
  unsigned sum, cnt, mine, sp = 0u;
  for (;;) {
    sum = 0u; cnt = 0u; mine = 0u;
#pragma unroll
    for (unsigned j = 0; j < 16; ++j) { const unsigned c = xb_ld(&bar[XB_XCNT(j)]); sum += c; cnt += (c > 0u) ? 1u : 0u; mine = (j == x) ? c : mine; }
    if (sum == G) break;
    __builtin_amdgcn_s_sleep(1);
    if ((++sp & 255u) == 0u) { if (xb_ld(&bar[XB_TMO])) break; if (sp > XB_SPIN_CAP) { atomicAdd(&bar[XB_TMO], 1u); break; } }
  }
  nloc = mine > 0u ? mine : 1u; nx = cnt > 0u ? cnt : 1u;
}
__device__ __forceinline__ void xcd_barrier(const XcdBarrier& b) {
  asm volatile("s_waitcnt vmcnt(0)" ::: "memory");
  __syncthreads();
  if (tid_opaque() == 0) {
    unsigned* bar = b.bar;
    __builtin_amdgcn_s_waitcnt(0);
    unsigned nloc = b.st[0], nx = b.st[1];
    if (nloc == 0u) { xcd_barrier_complete(bar, b.x, nloc, nx); b.st[0] = nloc; b.st[1] = nx; }
    const unsigned old = xb_add(&bar[XB_XSUB(b.x)], 1u);
    const unsigned gen = old / nloc;
    if (old + 1u == (gen + 1u) * nloc) {
      __builtin_amdgcn_fence(__ATOMIC_RELEASE, "agent");
      asm volatile("s_waitcnt vmcnt(0)" ::: "memory");
      const unsigned og = xb_add(&bar[XB_TOP], 1u);
      const unsigned tg = og / nx;
      if (og + 1u == (tg + 1u) * nx) xb_add(&bar[XB_TOPGEN], 1u);
      else XB_SPIN(xb_ld(&bar[XB_TOPGEN]) == tg, bar);
      __builtin_amdgcn_fence(__ATOMIC_ACQUIRE, "agent");
      xb_add(&bar[XB_XGEN(b.x)], 1u);
      asm volatile("s_waitcnt vmcnt(0)" ::: "memory");
    } else {
      XB_SPIN(xb_ld(&bar[XB_XGEN(b.x)]) == gen, bar);
      __builtin_amdgcn_fence(__ATOMIC_ACQUIRE, "agent");
      asm volatile("s_waitcnt vmcnt(0)" ::: "memory");
    }
  }
  __syncthreads();
}

extern __shared__ __attribute__((aligned(16))) char dyn_smem[];

__global__ void __launch_bounds__(NTHR) mega(Params p_unused) {
  cg::grid_group grid = cg::this_grid();
  const int bid0 = blockIdx.x, nb0 = gridDim.x;
#if defined(__HIP_DEVICE_COMPILE__)
  PP pp0 = (PP)__builtin_amdgcn_kernarg_segment_ptr();
#else
  PP pp0 = nullptr;
#endif
#define pp ({ PP q_ = pp0; asm volatile("" : "+s"(q_)); q_; })
#define bid opq(bid0)
#define nb opq(nb0)
  int* toff_s = (int*)(dyn_smem + 147456);
  volatile LAS unsigned* xb_st = (volatile LAS unsigned*)(dyn_smem + 147456 + 256);
  {
    unsigned* barw = (unsigned*)(fresh_ws(pp0) + OFF_BAR);
    if (blockIdx.x == 0) for (int i = threadIdx.x; i < XCD_BAR_WORDS; i += NTHR) barw[i] = 0u;
    if (threadIdx.x == 0) { xb_st[0] = 0u; xb_st[1] = 0u; }
  }
  grid.sync();
  const XcdBarrier xb = xcd_barrier_post((unsigned*)(fresh_ws(pp0) + OFF_BAR), xb_st);
#define GSYNC() xcd_barrier(xb)
  phase_ada(pp, bid, nb, dyn_smem);
  phase_convert(pp, 0, bid, nb, dyn_smem);
  phase_convert(pp, 1, bid, nb, dyn_smem);
  GSYNC();
#define LAYER(LV, LAST)                                      \
  {                                                          \
    phase_prenorm(pp, opq(LV), bid, nb);                     \
    GSYNC();                                                 \
    phase_gemm_in(pp, opq(LV), bid, nb, dyn_smem);           \
    GSYNC();                                                 \
    phase_prep(pp, opq(LV), bid, nb, dyn_smem);              \
    GSYNC();                                                 \
    phase_chunk_prep(pp, bid, nb, dyn_smem);                 \
    GSYNC();                                                 \
    phase_mix(pp, opq(LV), bid, nb, dyn_smem);               \
    GSYNC();                                                 \
    phase_post(pp, opq(LV), bid, nb);                        \
    GSYNC();                                                 \
    phase_gemm_out(pp, opq(LV), bid, nb, dyn_smem);          \
    GSYNC();                                                 \
    phase_router(pp, opq(LV), bid, nb, dyn_smem);            \
    GSYNC();                                                 \
    phase_slotfill(pp, opq(LV), bid, nb, dyn_smem);          \
    GSYNC();                                                 \
    phase_moe1_impl(pp, opq(LV), bid, nb, dyn_smem, toff_s); \
    GSYNC();                                                 \
    phase_moe2_impl(pp, opq(LV), bid, nb, dyn_smem, toff_s); \
    GSYNC();                                                 \
    phase_combine(pp, opq(LV), bid, nb);                     \
    if (!(LAST)) GSYNC();                                    \
  }
  LAYER(0, false)
  LAYER(1, true)
#undef LAYER
#undef GSYNC
#undef bid
#undef nb
#undef pp
}

#undef p
extern "C" void kernel_launch(void* const* d_in, const int* in_sizes, int n_in, void* d_out, int out_size, void* d_ws,
                              size_t ws_size, hipStream_t stream) {
  Params hp{};
  const float** pp = (const float**)&hp;
  for (int i = 0; i < 34; ++i) pp[i] = (const float*)d_in[i];
  hp.out = (float*)d_out;
  hp.ws = (char*)d_ws;
  static int grid_blocks = 0;
  if (!grid_blocks) {
    (void)hipFuncSetAttribute((const void*)mega, hipFuncAttributeMaxDynamicSharedMemorySize, LDS_BYTES);
    int dev = 0, cus = 0, per_cu = 0;
    (void)hipGetDevice(&dev);
    (void)hipDeviceGetAttribute(&cus, hipDeviceAttributeMultiprocessorCount, dev);
    (void)hipOccupancyMaxActiveBlocksPerMultiprocessor(&per_cu, mega, NTHR, LDS_BYTES);
    if (per_cu < 1) per_cu = 1;
    if (per_cu > 1) per_cu = 1;
    grid_blocks = cus * per_cu;
  }
  void* args[] = {&hp};
  (void)hipLaunchCooperativeKernel((void*)mega, dim3(grid_blocks), dim3(NTHR), args, LDS_BYTES, stream);
}
```

```cpp
#include <hip/hip_runtime.h>
#include <hip/hip_bf16.h>
#include <hip/hip_cooperative_groups.h>
#include <stdint.h>
namespace cg = cooperative_groups;

typedef __attribute__((ext_vector_type(8))) short bf16x8;
typedef __attribute__((ext_vector_type(4))) short bf16x4;
typedef __attribute__((ext_vector_type(4))) float f32x4;
typedef unsigned short bfr;

#define D_MODEL 1024
#define NB 2
#define SEQ 16384
#define CTXL 256
#define NLAT (NB * SEQ)
#define NCTX (NB * CTXL)
#define NTOK (NLAT + NCTX)
#define TTOK (SEQ + CTXL)
#define PIN 3472
#define PINP 3584
#define A_END 1536
#define B_END 2432
#define NEXP 32
#define NSLOT_MAX (NTOK * 4 + NEXP * 256)
#define NTHR 512
#define LDS_BYTES (147456 + 512)

constexpr size_t al256(size_t x) { return (x + 255) & ~(size_t)255; }
constexpr size_t WL_IN = 0;
constexpr size_t WL_OUT = WL_IN + (size_t)PINP * 1024 * 2;
constexpr size_t WL_GU = WL_OUT + (size_t)1024 * 1024 * 2;
constexpr size_t WL_DN = WL_GU + (size_t)32 * 2048 * 1024 * 2;
constexpr size_t WL_SIZE = WL_DN + (size_t)32 * 1024 * 1024 * 2;
constexpr size_t OFF_W = 0;
constexpr size_t OFF_MODS = al256(OFF_W + 2 * WL_SIZE);
constexpr size_t OFF_BAR = al256(OFF_MODS + 2 * 3 * 6144 * 4);
constexpr size_t OFF_CTX = al256(OFF_BAR + 3456 * 4);
constexpr size_t OFF_CNT = al256(OFF_CTX + (size_t)NCTX * 1024 * 4);
constexpr size_t OFF_TOKE = al256(OFF_CNT + 256);
constexpr size_t OFF_TOKP = al256(OFF_TOKE + (size_t)NTOK * 4 * 4);
constexpr size_t OFF_TOKG = al256(OFF_TOKP + (size_t)NTOK * 4 * 4);
constexpr size_t OFF_TOKS = al256(OFF_TOKG + (size_t)NTOK * 4 * 4);
constexpr size_t OFF_SLT = al256(OFF_TOKS + (size_t)NTOK * 4 * 4);
constexpr size_t OFF_SLG = al256(OFF_SLT + (size_t)NSLOT_MAX * 4);
constexpr size_t OFF_H = al256(OFF_SLG + (size_t)NSLOT_MAX * 4);
constexpr size_t OFF_CC = al256(OFF_H + (size_t)NTOK * 1024 * 2);
constexpr size_t OFF_P = al256(OFF_CC + (size_t)NTOK * 1024 * 2);
constexpr size_t OFF_S = al256(OFF_P + (size_t)NTOK * PINP * 4);
constexpr size_t TOK256F = (size_t)NTOK * 256 * 4;
constexpr size_t S_QN = 0;
constexpr size_t S_KN = S_QN + (size_t)NTOK * 512 * 2;
constexpr size_t S_VT = S_KN + (size_t)NTOK * 512 * 2;
constexpr size_t S_RWR = S_VT + (size_t)NB * 8 * 64 * TTOK * 2;
constexpr size_t S_RWKK = S_RWR + TOK256F;
constexpr size_t S_RWV = S_RWKK + TOK256F;
constexpr size_t S_RWG = S_RWV + TOK256F;
constexpr size_t S_RWW = S_RWG + TOK256F;
constexpr size_t S_RWKD = S_RWW + 2 * TOK256F;
constexpr size_t S_RWB = S_RWKD + 2 * TOK256F;
constexpr size_t S_BON = S_RWB + 2 * TOK256F;
constexpr size_t S_GDQ = al256(S_BON + (size_t)NTOK * 4 * 4);
constexpr size_t S_GDK = S_GDQ + TOK256F;
constexpr size_t S_GDV = S_GDK + TOK256F;
constexpr size_t S_GDAB = S_GDV + TOK256F;
constexpr size_t S_YRW = al256(S_GDAB + (size_t)NTOK * 16 * 4);
constexpr size_t S_YGD = S_YRW + 2 * TOK256F;
constexpr size_t S_END = S_YGD + 2 * TOK256F;
constexpr size_t S_SIZE = (S_END > (size_t)NSLOT_MAX * 1024 * 4) ? S_END : (size_t)NSLOT_MAX * 1024 * 4;
constexpr int NCHUNK = TTOK / 64;
constexpr int NCHAIN = 32;
constexpr size_t OFF_CH = al256(OFF_S + S_SIZE);
constexpr size_t CH_N = (size_t)NCHAIN * NCHUNK;
constexpr size_t CH_REC = 32768, CH_PT = 0, CH_RYT = 8192, CH_QT = 16384, CH_YX = 24576;
constexpr size_t CH_SIZE = CH_N * CH_REC;
constexpr size_t WS_TOTAL = OFF_CH + CH_SIZE;
static_assert(WS_TOTAL <= (size_t)2048 * 1024 * 1024, "workspace exceeds 4x largest tensor");

struct Params {
  const float *x, *c, *ctx, *c_ctx, *ada_w, *ada_b, *norm_mix_g, *norm_ffn_g, *w_in, *w_out;
  const float *na_q_gain, *na_k_gain, *na_rpb;
  const float *rw_mu, *rw_w0, *rw_w_up, *rw_a0, *rw_a_up, *rw_g_up, *rw_k_k, *rw_k_a, *rw_r_k, *rw_ln_w, *rw_ln_b;
  const float *gd_conv_w, *gd_A_log, *gd_dt_bias, *gd_norm_g;
  const float *moe_router_w, *moe_router_b, *moe_w_gu, *moe_b_gu, *moe_w_down, *moe_b_down;
  float* out;
  char* ws;
};

typedef const __attribute__((address_space(4))) Params* PP;
#define p (*pp)
__device__ __forceinline__ char* fresh_ws(PP pp) { return p.ws; }
__device__ __forceinline__ int tid_opaque() { int t = (int)__builtin_amdgcn_workitem_id_x(); asm volatile("" : "+v"(t)); return t; }
__device__ __forceinline__ int opq(int x) { asm volatile("" : "+s"(x)); return x; }
__device__ __forceinline__ int wave_id(int tid) { return __builtin_amdgcn_readfirstlane(tid >> 6); }
__device__ __forceinline__ bfr f2bf(float f) {
  unsigned u = __float_as_uint(f);
  u += 0x7fffu + ((u >> 16) & 1u);
  return (bfr)(u >> 16);
}
__device__ __forceinline__ float bf2f(short v) { return __uint_as_float(((unsigned)(unsigned short)v) << 16); }
__device__ __forceinline__ bf16x4 pack4(float a, float b, float c, float d) {
  bf16x4 o; o[0] = (short)f2bf(a); o[1] = (short)f2bf(b); o[2] = (short)f2bf(c); o[3] = (short)f2bf(d); return o;
}
__device__ __forceinline__ float sigmoidf_(float x) { return 1.f / (1.f + __expf(-x)); }
__device__ __forceinline__ float siluf_(float x) { return x / (1.f + __expf(-x)); }
__device__ __forceinline__ float softplusf_(float x) { return x > 20.f ? x : log1pf(__expf(x)); }
__device__ __forceinline__ float wave_sum(float v) {
  v += __builtin_bit_cast(float, __builtin_amdgcn_update_dpp(0, __builtin_bit_cast(int, v), 0xB1, 0xF, 0xF, true));
  v += __builtin_bit_cast(float, __builtin_amdgcn_update_dpp(0, __builtin_bit_cast(int, v), 0x4E, 0xF, 0xF, true));
  v += __builtin_bit_cast(float, __builtin_amdgcn_update_dpp(0, __builtin_bit_cast(int, v), 0x141, 0xF, 0xF, true));
  v += __builtin_bit_cast(float, __builtin_amdgcn_update_dpp(0, __builtin_bit_cast(int, v), 0x140, 0xF, 0xF, true));
  v += __builtin_bit_cast(float, __builtin_amdgcn_update_dpp(0, __builtin_bit_cast(int, v), 0x142, 0xA, 0xF, false));
  v += __builtin_bit_cast(float, __builtin_amdgcn_update_dpp(0, __builtin_bit_cast(int, v), 0x143, 0xC, 0xF, false));
  return __builtin_bit_cast(float, __builtin_amdgcn_readlane(__builtin_bit_cast(int, v), 63));
}
__device__ __forceinline__ float shfl_xor_l(float v, int mask, int lane) {
  return __builtin_bit_cast(float, __builtin_amdgcn_ds_bpermute((lane ^ mask) << 2, __builtin_bit_cast(int, v)));
}
__device__ __forceinline__ int shfl_xor_li(int v, int mask, int lane) {
  return __builtin_amdgcn_ds_bpermute((lane ^ mask) << 2, v);
}
__device__ __forceinline__ float row16_sum(float v) {
  v += __builtin_bit_cast(float, __builtin_amdgcn_update_dpp(0, __builtin_bit_cast(int, v), 0xB1, 0xF, 0xF, true));
  v += __builtin_bit_cast(float, __builtin_amdgcn_update_dpp(0, __builtin_bit_cast(int, v), 0x4E, 0xF, 0xF, true));
  v += __builtin_bit_cast(float, __builtin_amdgcn_update_dpp(0, __builtin_bit_cast(int, v), 0x141, 0xF, 0xF, true));
  v += __builtin_bit_cast(float, __builtin_amdgcn_update_dpp(0, __builtin_bit_cast(int, v), 0x140, 0xF, 0xF, true));
  return v;
}
__device__ __forceinline__ int mod_row(int m) { return m < NLAT ? (m >> 14) : 2; }

__device__ __forceinline__ void phase_ada(PP pp, int bid, int nb, char* smem) {
  float* red = (float*)smem;
  float* mods = (float*)(p.ws + OFF_MODS);
  const int tid = tid_opaque();
  for (int task = bid; task < 2 * 96; task += nb) {
    int l = task / 96, cgp = task % 96;
    int col = cgp * 64 + (tid & 63), ks = tid >> 6;
    const float* W = p.ada_w + (size_t)l * 1024 * 6144;
    float a0 = 0.f, a1 = 0.f, a2 = 0.f;
    for (int d = ks * 128; d < ks * 128 + 128; ++d) {
      float w = W[(size_t)d * 6144 + col];
      a0 += siluf_(p.c[d]) * w;
      a1 += siluf_(p.c[1024 + d]) * w;
      a2 += siluf_(p.c_ctx[d]) * w;
    }
    red[(ks * 3 + 0) * 64 + (tid & 63)] = a0;
    red[(ks * 3 + 1) * 64 + (tid & 63)] = a1;
    red[(ks * 3 + 2) * 64 + (tid & 63)] = a2;
    __syncthreads();
    if (tid < 192) {
      int r = tid >> 6, cc = tid & 63;
      float s = 0.f;
      for (int k = 0; k < 8; ++k) s += red[(k * 3 + r) * 64 + cc];
      mods[(size_t)(l * 3 + r) * 6144 + cgp * 64 + cc] = s + p.ada_b[(size_t)l * 6144 + cgp * 64 + cc];
    }
    __syncthreads();
  }
}

__device__ __forceinline__ void convert_tile(const float* src, int N, bfr* dst, int kt, int nt, int mode, float* tile  ) {
  const int tid = tid_opaque();
#pragma unroll
  for (int q = 0; q < 2; ++q) {
    int idx = tid + q * 512;
    int kk = idx >> 4, n4 = idx & 15;
    int n = nt * 64 + n4 * 4;
    float4 v = make_float4(0.f, 0.f, 0.f, 0.f);
    if (n < N) v = *(const float4*)(src + (size_t)(kt * 64 + kk) * N + n);
    tile[kk * 65 + n4 * 4 + 0] = v.x;
    tile[kk * 65 + n4 * 4 + 1] = v.y;
    tile[kk * 65 + n4 * 4 + 2] = v.z;
    tile[kk * 65 + n4 * 4 + 3] = v.w;
  }
  __syncthreads();
  {
    int nn = tid >> 3, kc = tid & 7;
    int n = nt * 64 + nn;
    int row = n;
    if (mode == 1) { int j = n & 1023; row = (j >> 4) * 32 + (j & 15) + ((n >= 1024) ? 16 : 0); }
    bf16x8 o;
#pragma unroll
    for (int j = 0; j < 8; ++j) o[j] = (short)f2bf(tile[(kc * 8 + j) * 65 + nn]);
    *(bf16x8*)(dst + (size_t)row * 1024 + kt * 64 + kc * 8) = o;
  }
  __syncthreads();
}
__device__ __forceinline__ void phase_convert(PP pp, int l, int bid, int nb, char* smem) {
  float* tile = (float*)smem;
  char* wl = p.ws + OFF_W + (size_t)l * WL_SIZE;
  const int T_IN = 16 * 56, T_OUT = 16 * 16, T_GU = 32 * 16 * 32, T_DN = 32 * 16 * 16;
  const int total = T_IN + T_OUT + T_GU + T_DN;
  for (int t = bid; t < total; t += nb) {
    if (t < T_IN) {
      int kt = t / 56, nt = t % 56;
      convert_tile(p.w_in + (size_t)l * 1024 * PIN, PIN, (bfr*)(wl + WL_IN), kt, nt, 0, tile);
    } else if (t < T_IN + T_OUT) {
      int u = t - T_IN; int kt = u / 16, nt = u % 16;
      convert_tile(p.w_out + (size_t)l * 1024 * 1024, 1024, (bfr*)(wl + WL_OUT), kt, nt, 0, tile);
    } else if (t < T_IN + T_OUT + T_GU) {
      int u = t - T_IN - T_OUT; int e = u / 512; int v = u % 512; int kt = v / 32, nt = v % 32;
      convert_tile(p.moe_w_gu + ((size_t)l * 32 + e) * 1024 * 2048, 2048, (bfr*)(wl + WL_GU) + (size_t)e * 2048 * 1024, kt, nt, 1, tile);
    } else {
      int u = t - T_IN - T_OUT - T_GU; int e = u / 256; int v = u % 256; int kt = v / 16, nt = v % 16;
      convert_tile(p.moe_w_down + ((size_t)l * 32 + e) * 1024 * 1024, 1024, (bfr*)(wl + WL_DN) + (size_t)e * 1024 * 1024, kt, nt, 0, tile);
    }
  }
}

__device__ __forceinline__ void phase_prenorm(PP pp, int l, int bid, int nb) {
  const int tid = tid_opaque(), lane = tid & 63, wv = wave_id(tid);
  const float* xl = (l == 0) ? p.x : p.out;
  const float* xc = (l == 0) ? p.ctx : (const float*)(p.ws + OFF_CTX);
  const float* mods = (const float*)(p.ws + OFF_MODS) + (size_t)l * 3 * 6144;
  const float* g = p.norm_mix_g + (size_t)l * 1024;
  bfr* H = (bfr*)(p.ws + OFF_H);
  {
    int* cnt = (int*)(p.ws + OFF_CNT);
    int gt = bid * NTHR + tid;
    if (gt < 32) cnt[gt] = 0;
  }
  for (int m = bid * 8 + wv; m < NTOK; m += nb * 8) {
    const float* xr = (m < NLAT) ? xl + (size_t)m * 1024 : xc + (size_t)(m - NLAT) * 1024;
    const float* md = mods + (size_t)mod_row(m) * 6144;
    float4 v[4];
    float ss = 0.f;
#pragma unroll
    for (int i = 0; i < 4; ++i) {
      v[i] = *(const float4*)(xr + (lane + 64 * i) * 4);
      ss += v[i].x * v[i].x + v[i].y * v[i].y + v[i].z * v[i].z + v[i].w * v[i].w;
    }
    ss = wave_sum(ss);
    float rs = rsqrtf(ss * (1.f / 1024.f) + 1e-6f);
#pragma unroll
    for (int i = 0; i < 4; ++i) {
      int d = (lane + 64 * i) * 4;
      float4 gg = *(const float4*)(g + d);
      float4 sh = *(const float4*)(md + d);
      float4 sc = *(const float4*)(md + 1024 + d);
      bf16x4 o;
      o[0] = (short)f2bf(v[i].x * rs * gg.x * (1.f + sc.x) + sh.x);
      o[1] = (short)f2bf(v[i].y * rs * gg.y * (1.f + sc.y) + sh.y);
      o[2] = (short)f2bf(v[i].z * rs * gg.z * (1.f + sc.z) + sh.z);
      o[3] = (short)f2bf(v[i].w * rs * gg.w * (1.f + sc.w) + sh.w);
      *(bf16x4*)(H + (size_t)m * 1024 + d) = o;
    }
  }
}

#define LAS __attribute__((address_space(3)))
namespace g8 {
constexpr int BM = 256, BK = 64, HALF = 128, HTB = HALF * BK * 2, STAGE_BYTES = 8 * HTB, KD = 1024;
__device__ __forceinline__ int lds_byte(int r, int c) { const int st = (r >> 4) * 2 + (c >> 5), rr = r & 15, cc = c & 31, ob = rr * 64 + cc * 2; return st * 1024 + (ob ^ (((ob >> 9) & 1) << 5)); }
__device__ __forceinline__ void stage_rc(int b, int& R, int& C) { const int st = b / 1024, sb = b % 1024, swz = sb ^ (((sb >> 9) & 1) << 5); R = (st >> 1) * 16 + swz / 64; C = (st & 1) * 32 + (swz % 64) / 2; }
struct GUnit { int pm, pn, brow0, e; };
__device__ __forceinline__ int unit_index(int i, int c, int G, int total) {
  const int x = c & 7, j = c >> 3, q = total >> 3, r = total & 7;
  const int start = x < r ? x * (q + 1) : r * (q + 1) + (x - r) * q;
  const int size = q + (x < r ? 1 : 0);
  const int li = i * (G >> 3) + j;
  return li < size ? start + li : -1;
}

template <class Sched, class Epi>
__device__ __forceinline__ void gemm_stream(LAS unsigned char* lds, const bfr* Abase, const bfr* Btbase, const Sched& S, const Epi& E) {
  const int tid = tid_opaque(), wid = __builtin_amdgcn_readfirstlane(tid >> 6), lane = tid & 63, wr = wid >> 2, wc = wid & 3, fr = lane & 15, fq = lane >> 4;
  constexpr int nt = KD / BK;
  int R[2], C[2];
  unsigned voffB[2];
#pragma unroll
  for (int i = 0; i < 2; ++i) { stage_rc(tid * 16 + i * 8192, R[i], C[i]); voffB[i] = (unsigned)(R[i] * KD + C[i]) * 2u; }
#define voffA voffB
  constexpr size_t kstep = (size_t)(BK * 2);
  constexpr size_t hstep = (size_t)HALF * KD * 2;
  const unsigned ldsw = (unsigned)wid * 1024u;
  const int aoff = lds_byte(wr * 64 + fr, fq * 8), boff = lds_byte(wc * 32 + fr, fq * 8);
#define G8_SA(b, h) (((b) * 2 + (h)) * HTB)
#define G8_SB(b, h) ((4 + (b) * 2 + (h)) * HTB)
#define G8_STAGE(bufoff, gbase, v0, v1) do { \
    __builtin_amdgcn_global_load_lds((const unsigned*)((const char*)(gbase) + (v0)), (LAS unsigned*)(lds + (bufoff) + ldsw), 16, 0, 0); \
    __builtin_amdgcn_global_load_lds((const unsigned*)((const char*)(gbase) + (v1)), (LAS unsigned*)(lds + (bufoff) + ldsw + 8192), 16, 0, 0); } while (0)
#define G8_STAGEB(bufoff, gbase) G8_STAGE(bufoff, gbase, voffB[0], voffB[1])
#define G8_STAGEA(bufoff, gbase) G8_STAGE(bufoff, gbase, voffA[0], voffA[1])
#define G8_LDA(dst, b, h) do { _Pragma("unroll") for (int m = 0; m < 4; ++m) _Pragma("unroll") for (int k = 0; k < 2; ++k) dst[m][k] = *(const LAS bf16x8*)(lds + G8_SA(b, h) + aoff + m * 2048 + k * 1024); } while (0)
#define G8_LDB(dst, b, h) do { _Pragma("unroll") for (int n = 0; n < 2; ++n) _Pragma("unroll") for (int k = 0; k < 2; ++k) dst[n][k] = *(const LAS bf16x8*)(lds + G8_SB(b, h) + boff + n * 2048 + k * 1024); } while (0)
#define G8_MMA(ai, bj, At, Bt) do { __builtin_amdgcn_s_setprio(1); _Pragma("unroll") for (int m = 0; m < 4; ++m) _Pragma("unroll") for (int n = 0; n < 2; ++n) _Pragma("unroll") for (int k = 0; k < 2; ++k) \
    acc[ai][bj][m][n] = __builtin_amdgcn_mfma_f32_16x16x32_bf16(Bt[n][k], At[m][k], acc[ai][bj][m][n], 0, 0, 0); __builtin_amdgcn_s_setprio(0); } while (0)
#define G8_WAIT_V(n) asm volatile("s_waitcnt vmcnt(" #n ")" ::: "memory")
#define G8_WAIT_L(n) asm volatile("s_waitcnt lgkmcnt(" #n ")" ::: "memory")
#define G8_BAR __builtin_amdgcn_s_barrier()
#define G8_SCHED __builtin_amdgcn_sched_barrier(0)
  GUnit cur, nxt;
  int ui = 0;
  if (!S.next(0, cur)) return;
  f32x4 acc[2][2][4][2];
#pragma unroll
  for (int a = 0; a < 2; ++a)
#pragma unroll
    for (int b = 0; b < 2; ++b)
#pragma unroll
      for (int m = 0; m < 4; ++m)
#pragma unroll
        for (int n = 0; n < 2; ++n) acc[a][b][m][n] = (f32x4){0.f, 0.f, 0.f, 0.f};
  bf16x8 At[4][2], B0[2][2], B1[2][2];
  const char* cA = (const char*)Abase + (size_t)cur.pm * (BM * KD * 2);
  const char* cB = (const char*)Btbase + (size_t)cur.brow0 * (KD * 2);
  G8_STAGEB(G8_SB(0, 0), cB); G8_STAGEA(G8_SA(0, 0), cA); G8_STAGEB(G8_SB(0, 1), cB + hstep); G8_STAGEA(G8_SA(0, 1), cA + hstep);
  if (wr == 1) G8_BAR;
  G8_WAIT_V(4); G8_BAR;
  G8_STAGEB(G8_SB(1, 0), cB + kstep); G8_STAGEA(G8_SA(1, 0), cA + kstep); G8_STAGEB(G8_SB(1, 1), cB + hstep + kstep);
  G8_WAIT_V(6); G8_BAR;
  for (;;) {
    const bool has_next = S.next(ui + 1, nxt);
    const char* nA = has_next ? (const char*)Abase + (size_t)nxt.pm * (BM * KD * 2) : cA;
    const char* nB = has_next ? (const char*)Btbase + (size_t)nxt.brow0 * (KD * 2) : cB;
    for (int t = 0; t < nt; t += 2) {
      const bool last = (t == nt - 2);
      const char* a1 = cA + (size_t)(t + 1) * kstep;
      const char* a2 = last ? nA : cA + (size_t)(t + 2) * kstep;
      const char* b2 = last ? nB : cB + (size_t)(t + 2) * kstep;
      const char* a3 = a2 + kstep;
      const char* b3 = b2 + kstep;
      G8_LDB(B0, 0, 0); G8_SCHED; G8_LDA(At, 0, 0); G8_STAGEA(G8_SA(1, 1), a1 + hstep);
      G8_WAIT_L(8); G8_BAR; G8_WAIT_L(0); G8_MMA(0, 0, At, B0); G8_BAR; G8_SCHED;
      G8_LDB(B1, 0, 1); G8_STAGEB(G8_SB(0, 0), b2);
      G8_BAR; G8_WAIT_L(0); G8_MMA(0, 1, At, B1); G8_BAR;
      G8_LDA(At, 0, 1); G8_STAGEA(G8_SA(0, 0), a2);
      G8_BAR; G8_WAIT_L(0); G8_MMA(1, 0, At, B0); G8_BAR; G8_SCHED;
      G8_STAGEB(G8_SB(0, 1), b2 + hstep);
      G8_WAIT_V(6); G8_BAR; G8_MMA(1, 1, At, B1); G8_BAR;
      G8_LDB(B0, 1, 0); G8_SCHED; G8_LDA(At, 1, 0); G8_STAGEA(G8_SA(0, 1), a2 + hstep);
      G8_WAIT_L(8); G8_BAR; G8_WAIT_L(0); G8_MMA(0, 0, At, B0); G8_BAR; G8_SCHED;
      G8_LDB(B1, 1, 1); G8_STAGEB(G8_SB(1, 0), b3);
      G8_BAR; G8_WAIT_L(0); G8_MMA(0, 1, At, B1); G8_BAR;
      G8_LDA(At, 1, 1); G8_STAGEA(G8_SA(1, 0), a3);
      G8_BAR; G8_WAIT_L(0); G8_MMA(1, 0, At, B0); G8_BAR; G8_SCHED;
      G8_STAGEB(G8_SB(1, 1), b3 + hstep);
      G8_WAIT_V(6); G8_BAR; G8_MMA(1, 1, At, B1); G8_BAR;
    }
    E(acc, cur, wr, wc, fr, fq);
    if (!has_next) break;
#pragma unroll
    for (int a = 0; a < 2; ++a)
#pragma unroll
      for (int b = 0; b < 2; ++b)
#pragma unroll
        for (int m = 0; m < 4; ++m)
#pragma unroll
          for (int n = 0; n < 2; ++n) acc[a][b][m][n] = (f32x4){0.f, 0.f, 0.f, 0.f};
    cur = nxt; cA = nA; cB = nB; ++ui;
  }
  G8_WAIT_V(0);
  if (wr == 0) G8_BAR;
  G8_BAR;
#undef G8_SA
#undef G8_SB
#undef G8_STAGE
#undef G8_STAGEB
#undef G8_STAGEA
#undef voffA
#undef G8_LDA
#undef G8_LDB
#undef G8_MMA
#undef G8_WAIT_V
#undef G8_WAIT_L
#undef G8_BAR
#undef G8_SCHED
}

struct DenseSched {
  int nM, nN, G, c;
  __device__ __forceinline__ bool next(int i, GUnit& u) const {
    const int idx = unit_index(i, c, G, nM * nN);
    if (idx < 0) return false;
    u.pm = idx / nN; u.pn = idx - u.pm * nN; u.brow0 = u.pn * BM; u.e = 0;
    return true;
  }
};
struct MoeSched {
  const int* toff; int nN, NE, G, c;
  __device__ __forceinline__ bool next(int i, GUnit& u) const {
    const int idx = unit_index(i, c, G, toff[32] * nN);
    if (idx < 0) return false;
    u.pm = idx / nN; u.pn = idx - u.pm * nN;
    int e = 0;
#pragma unroll 1
    for (int k = 1; k < 32; ++k) e = (u.pm >= toff[k]) ? k : e;
    u.e = e; u.brow0 = e * NE + u.pn * BM;
    return true;
  }
};
}

struct EpiInProj {
  float* P;
  __device__ __forceinline__ void operator()(const f32x4 (&acc)[2][2][4][2], const g8::GUnit& u, int wr, int wc, int fr, int fq) const {
    const int row0 = u.pm * 256 + wr * 64 + fr, col0 = u.pn * 256 + wc * 32 + 4 * fq;
#pragma unroll
    for (int ai = 0; ai < 2; ++ai)
#pragma unroll
      for (int m = 0; m < 4; ++m) {
        float* rowp = P + (size_t)(row0 + ai * 128 + m * 16) * PINP + col0;
#pragma unroll
        for (int bj = 0; bj < 2; ++bj)
#pragma unroll
          for (int n = 0; n < 2; ++n) *(f32x4*)(rowp + bj * 128 + n * 16) = acc[ai][bj][m][n];
      }
  }
};
__device__ __forceinline__ void phase_gemm_in(PP pp, int l, int bid, int nb, char* smem) {
  g8::DenseSched S{130, 14, nb, bid};
  EpiInProj E{(float*)(p.ws + OFF_P)};
  g8::gemm_stream((LAS unsigned char*)smem, (const bfr*)(p.ws + OFF_H), (const bfr*)(p.ws + OFF_W + (size_t)l * WL_SIZE + WL_IN), S, E);
}

struct EpiOutProj {
  const float *xl, *xc, *mods; float *ol, *oc;
  __device__ __forceinline__ void operator()(const f32x4 (&acc)[2][2][4][2], const g8::GUnit& u, int wr, int wc, int fr, int fq) const {
    const bool lat = u.pm < 128;
    const float* xin = lat ? xl + (size_t)u.pm * 256 * 1024 : xc + (size_t)(u.pm - 128) * 256 * 1024;
    float* xo = lat ? ol + (size_t)u.pm * 256 * 1024 : oc + (size_t)(u.pm - 128) * 256 * 1024;
    const float* g1 = mods + (size_t)(lat ? (u.pm >> 6) : 2) * 6144 + 2048;
    const int row0 = wr * 64 + fr, col0 = u.pn * 256 + wc * 32 + 4 * fq;
#pragma unroll
    for (int bj = 0; bj < 2; ++bj)
#pragma unroll
      for (int n = 0; n < 2; ++n) {
        const f32x4 gv = *(const f32x4*)(g1 + col0 + bj * 128 + n * 16);
#pragma unroll
        for (int ai = 0; ai < 2; ++ai)
#pragma unroll
          for (int m = 0; m < 4; ++m) {
            const size_t o = (size_t)(row0 + ai * 128 + m * 16) * 1024 + col0 + bj * 128 + n * 16;
            const f32x4 xv = *(const f32x4*)(xin + o);
            *(f32x4*)(xo + o) = xv + gv * acc[ai][bj][m][n];
            if (m & 1) asm volatile("" ::: "memory");
          }
      }
  }
};
__device__ __forceinline__ void phase_gemm_out(PP pp, int l, int bid, int nb, char* smem) {
  g8::DenseSched S{(l == 0) ? 130 : 128, 4, nb, bid};
  EpiOutProj E{(l == 0) ? p.x : p.out, (l == 0) ? p.ctx : (const float*)(p.ws + OFF_CTX),
               (const float*)(p.ws + OFF_MODS) + (size_t)l * 3 * 6144, p.out, (float*)(p.ws + OFF_CTX)};
  g8::gemm_stream((LAS unsigned char*)smem, (const bfr*)(p.ws + OFF_CC), (const bfr*)(p.ws + OFF_W + (size_t)l * WL_SIZE + WL_OUT), S, E);
}

#define LBAR() do { asm volatile("s_waitcnt lgkmcnt(0)" ::: "memory"); __builtin_amdgcn_s_barrier(); asm volatile("" ::: "memory"); } while (0)
__device__ __forceinline__ void phase_prep(PP pp, int l, int bid, int nb, char* smem) {
  const int tid = tid_opaque(), lane = tid & 63, wv = wave_id(tid);
  const float* P = (const float*)(p.ws + OFF_P);
  char* S = p.ws + OFF_S;
  bfr* QN = (bfr*)(S + S_QN);
  bfr* KN = (bfr*)(S + S_KN);
  bfr* VT = (bfr*)(S + S_VT);
  float* RWR = (float*)(S + S_RWR);
  float* RWKK = (float*)(S + S_RWKK);
  float* RWV = (float*)(S + S_RWV);
  float* RWG = (float*)(S + S_RWG);
  float* RWW = (float*)(S + S_RWW);
  float* RWKD = (float*)(S + S_RWKD);
  float* RWB = (float*)(S + S_RWB);
  float* BON = (float*)(S + S_BON);
  float* GDQ = (float*)(S + S_GDQ);
  float* GDK = (float*)(S + S_GDK);
  float* GDV = (float*)(S + S_GDV);
  float* GDAB = (float*)(S + S_GDAB);
  const float* mu = p.rw_mu + (size_t)l * 896;
  const float* w0 = p.rw_w0 + (size_t)l * 512;
  const float* w_up = p.rw_w_up + (size_t)l * 2 * 32 * 256;
  const float* a0 = p.rw_a0 + (size_t)l * 512;
  const float* a_up = p.rw_a_up + (size_t)l * 2 * 32 * 256;
  const float* g_up = p.rw_g_up + (size_t)l * 64 * 256;
  const float* k_k = p.rw_k_k + (size_t)l * 256;
  const float* k_a = p.rw_k_a + (size_t)l * 256;
  const float* r_k = p.rw_r_k + (size_t)l * 256;
  const float* conv_w = p.gd_conv_w + (size_t)l * 5 * 768;
  const float* A_log = p.gd_A_log + (size_t)l * 8;
  const float* dt_bias = p.gd_dt_bias + (size_t)l * 8;
  const float* qg = p.na_q_gain + (size_t)l * 64;
  const float* kg = p.na_k_gain + (size_t)l * 64;

  bfr* wl = (bfr*)smem;
  float* lor = (float*)(smem + 192 * 256 * 2);
  __syncthreads();
  for (int i = tid; i < 192 * 256; i += NTHR) {
    const int row = i >> 8, c = i & 255;
    const float v = row < 64 ? g_up[row * 256 + c] : row < 128 ? w_up[(row - 64) * 256 + c] : a_up[(row - 128) * 256 + c];
    wl[i] = f2bf(v);
  }
  __syncthreads();
  const int c = tid & 255, th = tid >> 8;
  const int h = c >> 6;
  const float kkc = k_k[c], kac = k_a[c], rkc = r_k[c];
  const float w00 = w0[c], w01 = w0[256 + c], a00 = a0[c], a01 = a0[256 + c];
  const float mur = mu[c], muk = mu[256 + c], muv = mu[512 + c];
  const float mul = (tid < 128) ? mu[768 + tid] : 0.f;
  const int nsecA = wv, nsecB = wv + 8;

  for (int tile = bid; tile < NTOK / 16; tile += nb) {
    const int m0 = tile * 16;
    int seq_lo, seq_hi, bb, tau0;
    if (m0 < NLAT) { bb = m0 >> 14; seq_lo = bb << 14; seq_hi = seq_lo + SEQ; tau0 = m0 - seq_lo; }
    else { bb = (m0 - NLAT) >> 8; seq_lo = NLAT + (bb << 8); seq_hi = seq_lo + CTXL; tau0 = SEQ + (m0 - seq_lo); }

    float pr[3][10], pl[18];
#pragma unroll
    for (int j = 0; j < 3; ++j)
#pragma unroll
      for (int t = 0; t < 10; ++t) {
        const int m = m0 + th * 8 - 1 + t;
        pr[j][t] = (m >= seq_lo && m < seq_hi) ? P[(size_t)m * PINP + A_END + j * 256 + c] : 0.f;
      }
    if (tid < 128) {
#pragma unroll
      for (int t = 0; t < 18; ++t) {
        const int m = m0 - 1 + t;
        pl[t] = (m >= seq_lo && m < seq_hi) ? P[(size_t)m * PINP + A_END + 768 + tid] : 0.f;
      }
#pragma unroll
      for (int t = 0; t < 16; ++t) {
        const float cur = pl[t + 1];
        const float v = cur + mul * (0.5f * (pl[t] + pl[t + 2]) - cur);
        lor[tid * 16 + t] = tid < 32 ? tanhf(v) : tid < 64 ? v : sigmoidf_(v);
      }
    }
    float rr[8], rk[8], rv[8];
#pragma unroll
    for (int t = 0; t < 8; ++t) {
      rr[t] = pr[0][t + 1] + mur * (0.5f * (pr[0][t] + pr[0][t + 2]) - pr[0][t + 1]);
      rk[t] = pr[1][t + 1] + muk * (0.5f * (pr[1][t] + pr[1][t + 2]) - pr[1][t + 1]);
      rv[t] = pr[2][t + 1] + muv * (0.5f * (pr[2][t] + pr[2][t + 2]) - pr[2][t + 1]);
    }
    LBAR();
    float pgA[20], pgB[20];
    {
      const int cA = nsecA * 64 + lane, cB = nsecB * 64 + lane;
#pragma unroll
      for (int t = 0; t < 20; ++t) {
        const int m = m0 - 2 + t;
        const bool ok = (m >= seq_lo && m < seq_hi);
        pgA[t] = ok ? P[(size_t)m * PINP + B_END + cA] : 0.f;
        pgB[t] = (ok && nsecB < 12) ? P[(size_t)m * PINP + B_END + cB] : 0.f;
      }
    }
    asm volatile("" ::: "memory");
#pragma unroll 1
    for (int ps = 0; ps < 2; ++ps) {
      const int tb = th * 8 + ps * 4;
      float4 gacc = make_float4(0.f, 0.f, 0.f, 0.f), wa0 = gacc, wa1 = gacc, aa0 = gacc, aa1 = gacc;
#pragma unroll 8
      for (int j = 0; j < 64; ++j) {
        const float wgt = __uint_as_float(((unsigned)wl[j * 256 + c]) << 16);
        const float4 s0 = *(const float4*)(lor + (64 + j) * 16 + tb);
        gacc.x += s0.x * wgt; gacc.y += s0.y * wgt; gacc.z += s0.z * wgt; gacc.w += s0.w * wgt;
      }
#pragma unroll 8
      for (int j = 0; j < 32; ++j) {
        const float4 t0 = *(const float4*)(lor + j * 16 + tb);
        const float4 d0 = *(const float4*)(lor + (32 + j) * 16 + tb);
        const float ww0 = __uint_as_float(((unsigned)wl[(64 + j) * 256 + c]) << 16), ww1 = __uint_as_float(((unsigned)wl[(96 + j) * 256 + c]) << 16);
        const float aw0 = __uint_as_float(((unsigned)wl[(128 + j) * 256 + c]) << 16), aw1 = __uint_as_float(((unsigned)wl[(160 + j) * 256 + c]) << 16);
        wa0.x += t0.x * ww0; wa0.y += t0.y * ww0; wa0.z += t0.z * ww0; wa0.w += t0.w * ww0;
        wa1.x += t0.x * ww1; wa1.y += t0.y * ww1; wa1.z += t0.z * ww1; wa1.w += t0.w * ww1;
        aa0.x += d0.x * aw0; aa0.y += d0.y * aw0; aa0.z += d0.z * aw0; aa0.w += d0.w * aw0;
        aa1.x += d0.x * aw1; aa1.y += d0.y * aw1; aa1.z += d0.z * aw1; aa1.w += d0.w * aw1;
      }
#pragma unroll
      for (int t = 0; t < 4; ++t) {
        const int tt = ps * 4 + t;
        const int m = m0 + th * 8 + tt;
        const float gv = t == 0 ? gacc.x : t == 1 ? gacc.y : t == 2 ? gacc.z : gacc.w;
        const float wv0 = t == 0 ? wa0.x : t == 1 ? wa0.y : t == 2 ? wa0.z : wa0.w;
        const float wv1 = t == 0 ? wa1.x : t == 1 ? wa1.y : t == 2 ? wa1.z : wa1.w;
        const float av0 = t == 0 ? aa0.x : t == 1 ? aa0.y : t == 2 ? aa0.z : aa0.w;
        const float av1 = t == 0 ? aa1.x : t == 1 ? aa1.y : t == 2 ? aa1.z : aa1.w;
        const float r = ps == 0 ? rr[t] : rr[4 + t], k = ps == 0 ? rk[t] : rk[4 + t], v = ps == 0 ? rv[t] : rv[4 + t];
        const float kkraw = k * kkc;
        const float ssum = wave_sum(kkraw * kkraw);
        const float kk = kkraw * rsqrtf(ssum + 1e-6f);
        float bon = 0.f;
#pragma unroll
        for (int d = 0; d < 2; ++d) {
          const float wlin = (d == 0 ? w00 + wv0 : w01 + wv1);
          const float w_log = -softplusf_(-wlin) - 0.5f;
          const float a = sigmoidf_(d == 0 ? a00 + av0 : a01 + av1);
          const float kd = k * (1.f + (a - 1.f) * kac);
          bon += r * kd * rkc;
          const size_t o = ((size_t)d * NTOK + m) * 256 + c;
          RWW[o] = -__expf(w_log); RWKD[o] = kd; RWB[o] = kk * a;
        }
        bon = wave_sum(bon);
        const size_t o = (size_t)m * 256 + c;
        RWR[o] = r; RWKK[o] = kk; RWV[o] = v; RWG[o] = gv;
        if (lane == 0) BON[(size_t)m * 4 + h] = bon;
      }
    }
    float pnA[16], pnB[16], pvt[16];
#pragma unroll
    for (int t = 0; t < 16; ++t) {
      pnA[t] = P[(size_t)(m0 + t) * PINP + nsecA * 64 + lane];
      pnB[t] = P[(size_t)(m0 + t) * PINP + nsecB * 64 + lane];
      pvt[t] = P[(size_t)(m0 + t) * PINP + 1024 + tid];
    }
    asm volatile("" ::: "memory");
#pragma unroll
    for (int q = 0; q < 2; ++q) {
      const int sec = q ? nsecB : nsecA;
      if (sec < 12) {
        const int cg = sec * 64 + lane;
        float cw[5];
#pragma unroll
        for (int j = 0; j < 5; ++j) cw[j] = conv_w[j * 768 + cg];
#pragma unroll
        for (int t = 0; t < 16; ++t) {
          float acc = 0.f;
#pragma unroll
          for (int j = 0; j < 5; ++j) acc += cw[j] * (q ? pgB[t + j] : pgA[t + j]);
          float val = siluf_(acc);
          const int m = m0 + t;
          if (sec < 8) {
            const float ss = wave_sum(val * val);
            val *= rsqrtf(ss + 1e-6f);
            if (sec < 4) GDQ[(size_t)m * 256 + sec * 64 + lane] = val * 0.125f;
            else GDK[(size_t)m * 256 + (sec - 4) * 64 + lane] = val;
          } else GDV[(size_t)m * 256 + (sec - 8) * 64 + lane] = val;
        }
      }
    }
    if (tid < 256) {
      const int t = tid >> 4, j = tid & 15;
      const int m = m0 + t;
      const float pv = P[(size_t)m * PINP + B_END + 1024 + j];
      float o;
      if (j < 8) o = -__expf(A_log[j]) * softplusf_(pv + dt_bias[j]);
      else o = sigmoidf_(pv);
      GDAB[(size_t)m * 16 + j] = o;
    }
#pragma unroll
    for (int q = 0; q < 2; ++q) {
      const int hs = q ? nsecB : nsecA;
#pragma unroll
      for (int t = 0; t < 16; ++t) {
        float val = q ? pnB[t] : pnA[t];
        const float ss = wave_sum(val * val);
        val *= rsqrtf(ss * (1.f / 64.f) + 1e-6f);
        const int m = m0 + t;
        if (hs < 8) QN[(size_t)m * 512 + hs * 64 + lane] = f2bf(val * qg[lane] * (0.125f * 1.4426950408889634f));
        else KN[(size_t)m * 512 + (hs - 8) * 64 + lane] = f2bf(val * kg[lane]);
      }
    }
    {
      bf16x8 o0, o1;
#pragma unroll
      for (int t = 0; t < 8; ++t) { o0[t] = (short)f2bf(pvt[t]); o1[t] = (short)f2bf(pvt[8 + t]); }
      bfr* dst = VT + ((size_t)(bb * 512 + tid)) * TTOK + tau0;
      *(bf16x8*)dst = o0;
      *(bf16x8*)(dst + 8) = o1;
    }
    LBAR();
  }
  __syncthreads();
}

__device__ __forceinline__ int scan_tok(int b, int d, int s) {
  if (s < CTXL) { int t = d ? (CTXL - 1 - s) : s; return NLAT + b * CTXL + t; }
  int u = s - CTXL; int t = d ? (SEQ - 1 - u) : u; return b * SEQ + t;
}
#define CS 72
#define SLOT_BYTES (64 * CS * 2)
#define F0_STRIDE 68
#define X1_F0 (13 * SLOT_BYTES)
#define X1_ARR (X1_F0 + 64 * F0_STRIDE * 4)

#define MM_FRAGS(As, Bs, a0, a1, b00, b01, b10, b11)                                                     \
  const bf16x8 a0 = *(const bf16x8*)((As) + ((mt * 16 + fr) * CS + fq * 8) * 2);                         \
  const bf16x8 a1 = *(const bf16x8*)((As) + ((mt * 16 + fr) * CS + 32 + fq * 8) * 2);                    \
  const bf16x8 b00 = *(const bf16x8*)((Bs) + ((nt0 * 16 + fr) * CS + fq * 8) * 2);                       \
  const bf16x8 b01 = *(const bf16x8*)((Bs) + ((nt0 * 16 + fr) * CS + 32 + fq * 8) * 2);                  \
  const bf16x8 b10 = *(const bf16x8*)((Bs) + ((nt0 * 16 + 16 + fr) * CS + fq * 8) * 2);                  \
  const bf16x8 b11 = *(const bf16x8*)((Bs) + ((nt0 * 16 + 16 + fr) * CS + 32 + fq * 8) * 2);
#define MM_2TILES(acc0, acc1, a0, a1, b00, b01, b10, b11)                                                \
  acc0 = __builtin_amdgcn_mfma_f32_16x16x32_bf16(a0, b00, acc0, 0, 0, 0);                                \
  acc0 = __builtin_amdgcn_mfma_f32_16x16x32_bf16(a1, b01, acc0, 0, 0, 0);                                \
  acc1 = __builtin_amdgcn_mfma_f32_16x16x32_bf16(a0, b10, acc1, 0, 0, 0);                                \
  acc1 = __builtin_amdgcn_mfma_f32_16x16x32_bf16(a1, b11, acc1, 0, 0, 0);
__device__ __forceinline__ void wr_T(char* slot, int mt, int nt, int fr, int fq, f32x4 v) {
  *(bf16x4*)(slot + ((nt * 16 + fr) * CS + mt * 16 + 4 * fq) * 2) = pack4(v[0], v[1], v[2], v[3]);
}

struct ChunkIn { float lw[8], f0[8], f1[8], f2[8], f3[8], xv[8], be[8]; };
template <bool GDN>
__device__ __forceinline__ void chunk_load(PP pp, int t, ChunkIn& ci) {
  const int tid = tid_opaque(), c = tid & 63, tg = wave_id(tid);
  const int chain = t / NCHUNK, n = t - chain * NCHUNK;
  const int d = chain & 1, h = (chain >> 1) & 3, b = (chain >> 3) & 1;
  const char* S = p.ws + OFF_S;
#pragma unroll
  for (int u = 0; u < 8; ++u) {
    const int m = scan_tok(b, d, n * 64 + tg * 8 + u);
    const size_t o = (size_t)m * 256 + h * 64 + c;
    if (!GDN) {
      ci.lw[u] = ((const float*)(S + S_RWW))[(size_t)d * NTOK * 256 + o];
      ci.f0[u] = ((const float*)(S + S_RWKK))[o];
      ci.f1[u] = ((const float*)(S + S_RWB))[(size_t)d * NTOK * 256 + o];
      ci.f2[u] = ((const float*)(S + S_RWKD))[(size_t)d * NTOK * 256 + o];
      ci.f3[u] = ((const float*)(S + S_RWR))[o];
      ci.xv[u] = ((const float*)(S + S_RWV))[o];
      ci.be[u] = 1.f;
    } else {
      ci.lw[u] = ((const float*)(S + S_GDAB))[(size_t)m * 16 + d * 4 + h];
      ci.be[u] = ((const float*)(S + S_GDAB))[(size_t)m * 16 + 8 + d * 4 + h];
      ci.f0[u] = ((const float*)(S + S_GDK))[o];
      ci.f3[u] = ((const float*)(S + S_GDQ))[o];
      ci.xv[u] = ((const float*)(S + S_GDV))[o];
      ci.f1[u] = 0.f; ci.f2[u] = 0.f;
    }
  }
}
template <bool GDN>
__device__ __forceinline__ void chunk_prep_task(PP pp, int t, int t_next, bool has_next, const ChunkIn& ci, ChunkIn& nx, char* smem) {
  const int chain = t / NCHUNK, n = t - chain * NCHUNK;
  const int d = chain & 1, h = (chain >> 1) & 3, b = (chain >> 3) & 1;
  (void)b; (void)d; (void)h;
  const int tid = tid_opaque(), lane = tid & 63, wv = wave_id(tid);
  const int fr = lane & 15, fq = lane >> 4, mt = wv >> 1, nt0 = (wv & 1) * 2;
  char* S = p.ws + OFF_S;
  char* CH = p.ws + OFF_CH;
  const size_t cc = (size_t)chain * NCHUNK + n;
  char* const p0 = smem;
  char* const p1 = smem + 1 * SLOT_BYTES;
  char* const p2 = smem + 2 * SLOT_BYTES;
  char* const p3 = smem + 3 * SLOT_BYTES;
  char* const p4 = smem + 4 * SLOT_BYTES;
  char* const p5 = smem + 5 * SLOT_BYTES;
  char* const p6 = smem + 6 * SLOT_BYTES;
  char* const p7 = smem + 7 * SLOT_BYTES;
  char* const p8 = smem + 8 * SLOT_BYTES;
  char* const p9 = smem + 9 * SLOT_BYTES;
  char* const p10 = smem + 10 * SLOT_BYTES;
  char* const p11 = smem + 11 * SLOT_BYTES;
  char* const p12 = smem + 12 * SLOT_BYTES;
  float* const F0 = (float*)(smem + X1_F0);
  float* const Lv = (float*)(smem + X1_ARR);
  float* const Lm1v = Lv + 64;
  float* const betav = Lv + 128;
  float* const eLv = Lv + 192;
  float* const gC = Lv + 256;
  float* const gsum = Lv + 320;
  char* const sKt = p0;
  char* const sBh = GDN ? p0 : p1;
  char* const sKh = GDN ? p0 : p2;

  {
    const int c = lane, tg = wv;
    const float* lw = ci.lw; const float* f0 = ci.f0; const float* f1 = ci.f1; const float* f2 = ci.f2; const float* f3 = ci.f3; const float* xv = ci.xv; const float* be = ci.be;
    float cum[8];
    cum[0] = lw[0];
#pragma unroll
    for (int u = 1; u < 8; ++u) cum[u] = cum[u - 1] + lw[u];
    gsum[tg * 64 + c] = cum[7];
    LBAR();
    float off = 0.f, LC = 0.f;
#pragma unroll
    for (int g2 = 0; g2 < 8; ++g2) { const float gs = gsum[g2 * 64 + c]; LC += gs; off += (g2 < tg) ? gs : 0.f; }
    bf16x8 vKtT, vBbT, vKbT, vXT;
#pragma unroll
    for (int u = 0; u < 8; ++u) {
      const int t = tg * 8 + u;
      const float L = off + cum[u], Lm1 = L - lw[u];
      if (!GDN) {
        const float eLm1 = __expf(Lm1), enL = __expf(-L), eL = __expf(L), eCL = __expf(LC - L);
        const float kt = f0[u] * eLm1;
        *(bfr*)(p0 + (t * CS + c) * 2) = f2bf(kt);
        *(bfr*)(p1 + (t * CS + c) * 2) = f2bf(f1[u] * enL);
        *(bfr*)(p2 + (t * CS + c) * 2) = f2bf(f2[u] * enL);
        *(bfr*)(p3 + (t * CS + c) * 2) = f2bf(f3[u] * eL);
        vKtT[u] = (short)f2bf(kt);
        vBbT[u] = (short)f2bf(f1[u] * eCL);
        vKbT[u] = (short)f2bf(f2[u] * eCL);
        vXT[u] = (short)f2bf(xv[u]);
      } else {
        *(bfr*)(p0 + (t * CS + c) * 2) = f2bf(f0[u]);
        *(bfr*)(p3 + (t * CS + c) * 2) = f2bf(f3[u]);
        vKtT[u] = (short)f2bf(f0[u] * __expf(Lm1));
        vBbT[u] = (short)f2bf(be[u] * f0[u] * __expf(LC - Lm1));
        vKbT[u] = (short)f2bf(f0[u] * __expf(LC - L));
        vXT[u] = (short)f2bf(be[u] * xv[u]);
        if (c == 0) { Lv[t] = L; Lm1v[t] = Lm1; betav[t] = be[u]; eLv[t] = __expf(L); }
      }
    }
    *(bf16x8*)(p4 + (c * CS + tg * 8) * 2) = vKtT;
    *(bf16x8*)(p5 + (c * CS + tg * 8) * 2) = vBbT;
    *(bf16x8*)(p6 + (c * CS + tg * 8) * 2) = vKbT;
    *(bf16x8*)(p7 + (c * CS + tg * 8) * 2) = vXT;
    if (tg == 0) gC[c] = __expf(LC);
    if (!GDN && tid < 64) { Lv[tid] = 0.f; Lm1v[tid] = 0.f; betav[tid] = 1.f; eLv[tid] = 1.f; }
  }
  LBAR();
  if (has_next) chunk_load<GDN>(pp, t_next, nx);
  {
    {
      MM_FRAGS(sKt, sBh, a0, a1, b00, b01, b10, b11)
      f32x4 c0 = {0.f, 0.f, 0.f, 0.f}, c1 = c0;
      MM_2TILES(c0, c1, a0, a1, b00, b01, b10, b11)
#pragma unroll
      for (int q = 0; q < 2; ++q) {
        const int sI = (nt0 + q) * 16 + fr;
        const f32x4 cv = q ? c1 : c0;
        f32x4 o;
#pragma unroll
        for (int r = 0; r < 4; ++r) {
          const int tI = mt * 16 + 4 * fq + r;
          float v = cv[r];
          if (GDN) v *= betav[sI] * __expf(fminf(Lm1v[tI] - Lm1v[sI], 0.f));
          o[r] = (sI < tI) ? v : 0.f;
        }
        *(f32x4*)(F0 + sI * F0_STRIDE + mt * 16 + 4 * fq) = o;
        wr_T(p11, mt, nt0 + q, fr, fq, o);
      }
    }
    {
      MM_FRAGS(sKt, sKh, a0, a1, b00, b01, b10, b11)
      f32x4 c0 = {0.f, 0.f, 0.f, 0.f}, c1 = c0;
      MM_2TILES(c0, c1, a0, a1, b00, b01, b10, b11)
#pragma unroll
      for (int q = 0; q < 2; ++q) {
        const int sI = (nt0 + q) * 16 + fr;
        const f32x4 cv = q ? c1 : c0;
        f32x4 o;
#pragma unroll
        for (int r = 0; r < 4; ++r) {
          const int tI = mt * 16 + 4 * fq + r;
          float v = cv[r];
          if (GDN) v *= __expf(fminf(Lm1v[tI] - Lv[sI], 0.f));
          o[r] = (sI < tI) ? v : 0.f;
        }
        wr_T(p9, mt, nt0 + q, fr, fq, o);
      }
    }
    {
      MM_FRAGS(sBh, p3, a0, a1, b00, b01, b10, b11)
      f32x4 c0 = {0.f, 0.f, 0.f, 0.f}, c1 = c0;
      MM_2TILES(c0, c1, a0, a1, b00, b01, b10, b11)
#pragma unroll
      for (int q = 0; q < 2; ++q) {
        const int tI = (nt0 + q) * 16 + fr;
        const f32x4 cv = q ? c1 : c0;
        f32x4 o;
#pragma unroll
        for (int r = 0; r < 4; ++r) {
          const int sI = mt * 16 + 4 * fq + r;
          float v = cv[r];
          if (GDN) v *= betav[sI] * __expf(fminf(Lv[tI] - Lm1v[sI], 0.f));
          o[r] = (sI <= tI) ? v : 0.f;
        }
        wr_T(p10, mt, nt0 + q, fr, fq, o);
      }
    }
  }
  LBAR();
  if (wv < 2) {
    const int base = wv * 32, other = 32 - base, c = lane & 31;
    float tr[32];
#pragma unroll
    for (int j = 0; j < 32; ++j) tr[j] = 0.f;
#pragma unroll
    for (int i = 31; i >= 0; --i) {
      float a0 = (c == i) ? 1.f : 0.f, a1 = 0.f, a2 = 0.f, a3 = 0.f;
#pragma unroll
      for (int jb = ((i + 1) & ~3); jb < 32; jb += 4) {
        const f32x4 a4 = *(const f32x4*)(F0 + (base + i) * F0_STRIDE + base + jb);
        a0 -= a4[0] * tr[jb]; a1 -= a4[1] * tr[jb + 1]; a2 -= a4[2] * tr[jb + 2]; a3 -= a4[3] * tr[jb + 3];
      }
      const float acc = (a0 + a1) + (a2 + a3);
      tr[i] = acc;
      if (lane < 32) {
        *(bfr*)(p8 + ((base + i) * CS + base + c) * 2) = f2bf(acc);
        *(bfr*)(p8 + ((base + i) * CS + other + c) * 2) = (bfr)0;
      }
    }
    if (lane < 32) {
#pragma unroll
      for (int q = 0; q < 4; ++q) {
        bf16x8 o, z;
#pragma unroll
        for (int j = 0; j < 8; ++j) { o[j] = (short)f2bf(tr[8 * q + j]); z[j] = 0; }
        *(bf16x8*)(p12 + ((base + c) * CS + base + 8 * q) * 2) = o;
        *(bf16x8*)(p12 + ((base + c) * CS + other + 8 * q) * 2) = z;
      }
    }
  }
  LBAR();
  {
    MM_FRAGS(p11, p12, a0, a1, b00, b01, b10, b11)
    f32x4 c0 = {0.f, 0.f, 0.f, 0.f}, c1 = c0;
    MM_2TILES(c0, c1, a0, a1, b00, b01, b10, b11)
    wr_T(p1, mt, nt0, fr, fq, c0);
    wr_T(p1, mt, nt0 + 1, fr, fq, c1);
  }
  LBAR();
  if (mt < 2 && nt0 == 2) {
    MM_FRAGS(p8, p1, a0, a1, b00, b01, b10, b11)
    f32x4 c0 = {0.f, 0.f, 0.f, 0.f}, c1 = c0;
    MM_2TILES(c0, c1, a0, a1, b00, b01, b10, b11)
#pragma unroll
    for (int r = 0; r < 4; ++r) {
      *(bfr*)(p8 + ((mt * 16 + 4 * fq + r) * CS + (nt0) * 16 + fr) * 2) = f2bf(-c0[r]);
      *(bfr*)(p8 + ((mt * 16 + 4 * fq + r) * CS + (nt0 + 1) * 16 + fr) * 2) = f2bf(-c1[r]);
    }
  }
  LBAR();
  {
    {
      MM_FRAGS(p8, p5, a0, a1, b00, b01, b10, b11)
      f32x4 c0 = {0.f, 0.f, 0.f, 0.f}, c1 = c0;
      MM_2TILES(c0, c1, a0, a1, b00, b01, b10, b11)
      wr_T(p11, mt, nt0, fr, fq, -c0);
      wr_T(p11, mt, nt0 + 1, fr, fq, -c1);
    }
    {
      MM_FRAGS(p8, p10, a0, a1, b00, b01, b10, b11)
      f32x4 c0 = {0.f, 0.f, 0.f, 0.f}, c1 = c0;
      MM_2TILES(c0, c1, a0, a1, b00, b01, b10, b11)
      wr_T(p12, mt, nt0, fr, fq, -c0);
      wr_T(p12, mt, nt0 + 1, fr, fq, -c1);
    }
  }
  LBAR();
  {
    {
      MM_FRAGS(p4, p11, a0, a1, b00, b01, b10, b11)
      f32x4 c0 = {0.f, 0.f, 0.f, 0.f}, c1 = c0;
      MM_2TILES(c0, c1, a0, a1, b00, b01, b10, b11)
#pragma unroll
      for (int q = 0; q < 2; ++q) {
        const int cp = (nt0 + q) * 16 + fr;
        f32x4 cv = q ? c1 : c0;
#pragma unroll
        for (int r = 0; r < 4; ++r) { const int cI = mt * 16 + 4 * fq + r; if (cI == cp) cv[r] += gC[cI]; }
        wr_T(p10, mt, nt0 + q, fr, fq, cv);
      }
    }
    {
      MM_FRAGS(p9, p11, a0, a1, b00, b01, b10, b11)
      f32x4 c0 = {0.f, 0.f, 0.f, 0.f}, c1 = c0;
      MM_2TILES(c0, c1, a0, a1, b00, b01, b10, b11)
#pragma unroll
      for (int q = 0; q < 2; ++q) {
        const int cp = (nt0 + q) * 16 + fr;
        f32x4 cv = q ? c1 : c0;
        const bf16x4 kb = *(const bf16x4*)(p6 + (cp * CS + mt * 16 + 4 * fq) * 2);
#pragma unroll
        for (int r = 0; r < 4; ++r) cv[r] += __uint_as_float(((unsigned)(unsigned short)kb[r]) << 16);
        wr_T(p8, mt, nt0 + q, fr, fq, cv);
      }
    }
    {
      MM_FRAGS(p4, p12, a0, a1, b00, b01, b10, b11)
      f32x4 c0 = {0.f, 0.f, 0.f, 0.f}, c1 = c0;
      MM_2TILES(c0, c1, a0, a1, b00, b01, b10, b11)
#pragma unroll
      for (int q = 0; q < 2; ++q) {
        const int tI = (nt0 + q) * 16 + fr;
        f32x4 cv = q ? c1 : c0;
        const bf16x4 rt = *(const bf16x4*)(p3 + (tI * CS + mt * 16 + 4 * fq) * 2);
        const float el = eLv[tI];
#pragma unroll
        for (int r = 0; r < 4; ++r) cv[r] += __uint_as_float(((unsigned)(unsigned short)rt[r]) << 16) * el;
        wr_T(p1, mt, nt0 + q, fr, fq, cv);
      }
    }
    {
      f32x4 c0 = {0.f, 0.f, 0.f, 0.f}, c1 = c0;
      {
        MM_FRAGS(sKh, p3, a0, a1, b00, b01, b10, b11)
        MM_2TILES(c0, c1, a0, a1, b00, b01, b10, b11)
      }
#pragma unroll
      for (int q = 0; q < 2; ++q) {
        const int tI = (nt0 + q) * 16 + fr;
#pragma unroll
        for (int r = 0; r < 4; ++r) {
          const int sI = mt * 16 + 4 * fq + r;
          float v = q ? c1[r] : c0[r];
          if (GDN) v *= __expf(fminf(Lv[tI] - Lv[sI], 0.f));
          v = (sI <= tI) ? v : 0.f;
          if (q) c1[r] = v; else c0[r] = v;
        }
      }
      {
        MM_FRAGS(p9, p12, a0, a1, b00, b01, b10, b11)
        MM_2TILES(c0, c1, a0, a1, b00, b01, b10, b11)
      }
      wr_T(p5, mt, nt0, fr, fq, c0);
      wr_T(p5, mt, nt0 + 1, fr, fq, c1);
    }
  }
  LBAR();
  {
    {
      MM_FRAGS(p8, p7, a0, a1, b00, b01, b10, b11)
      f32x4 c0 = {0.f, 0.f, 0.f, 0.f}, c1 = c0;
      MM_2TILES(c0, c1, a0, a1, b00, b01, b10, b11)
      bfr* QT = (bfr*)(CH + cc * CH_REC + CH_QT);
      *(bf16x4*)(QT + ((mt * 4 + nt0) * 64 + lane) * 4) = pack4(c0[0], c0[1], c0[2], c0[3]);
      *(bf16x4*)(QT + ((mt * 4 + nt0 + 1) * 64 + lane) * 4) = pack4(c1[0], c1[1], c1[2], c1[3]);
    }
    {
      MM_FRAGS(p7, p5, a0, a1, b00, b01, b10, b11)
      f32x4 c0 = {0.f, 0.f, 0.f, 0.f}, c1 = c0;
      MM_2TILES(c0, c1, a0, a1, b00, b01, b10, b11)
      bfr* YX = (bfr*)(CH + cc * CH_REC + CH_YX);
      *(bf16x4*)(YX + ((mt * 4 + nt0) * 64 + lane) * 4) = pack4(c0[0], c0[1], c0[2], c0[3]);
      *(bf16x4*)(YX + ((mt * 4 + nt0 + 1) * 64 + lane) * 4) = pack4(c1[0], c1[1], c1[2], c1[3]);
    }
    {
      const int fm = wv >> 1, fa = wv & 1;
      const int row = fm * 16 + fr;
      {
        const bf16x4 lo = *(const bf16x4*)(p10 + (row * CS + 32 * fa + 4 * fq) * 2);
        const bf16x4 hi = *(const bf16x4*)(p10 + (row * CS + 32 * fa + 16 + 4 * fq) * 2);
        bf16x8 f; f[0] = lo[0]; f[1] = lo[1]; f[2] = lo[2]; f[3] = lo[3]; f[4] = hi[0]; f[5] = hi[1]; f[6] = hi[2]; f[7] = hi[3];
        *(bf16x8*)(CH + cc * CH_REC + CH_PT + (size_t)((fm * 2 + fa) * 64 + lane) * 16) = f;
      }
      {
        const bf16x4 lo = *(const bf16x4*)(p1 + (row * CS + 32 * fa + 4 * fq) * 2);
        const bf16x4 hi = *(const bf16x4*)(p1 + (row * CS + 32 * fa + 16 + 4 * fq) * 2);
        bf16x8 f; f[0] = lo[0]; f[1] = lo[1]; f[2] = lo[2]; f[3] = lo[3]; f[4] = hi[0]; f[5] = hi[1]; f[6] = hi[2]; f[7] = hi[3];
        *(bf16x8*)(CH + cc * CH_REC + CH_RYT + (size_t)((fm * 2 + fa) * 64 + lane) * 16) = f;
      }
    }
  }
  LBAR();
}

template <bool GDN>
__device__ __forceinline__ void chunk_prep_loop(PP pp, int t0, int tend, int nb, char* smem) {
  ChunkIn cur, nxt;
  if (t0 < tend) chunk_load<GDN>(pp, t0, cur);
  for (int t = t0; t < tend; t += nb) {
    const bool has_next = (t + nb) < tend;
    chunk_prep_task<GDN>(pp, t, t + nb, has_next, cur, nxt, smem);
    cur = nxt;
  }
}
__device__ __forceinline__ void phase_chunk_prep(PP pp, int bid, int nb, char* smem) {
  __syncthreads();
  const int half = (NCHAIN / 2) * NCHUNK;
  chunk_prep_loop<false>(pp, bid, half, nb, smem);
  const int k0 = (half - bid + nb - 1) / nb;
  chunk_prep_loop<true>(pp, bid + k0 * nb, NCHAIN * NCHUNK, nb, smem);
  __syncthreads();
}

#define X2_BUF 32768
#define X2_BAR() do { asm volatile("s_waitcnt lgkmcnt(0)" ::: "memory"); __builtin_amdgcn_s_barrier(); asm volatile("" ::: "memory"); } while (0)
__device__ __forceinline__ void chunk_seq_chain(PP pp, int chain, char* smem) {
  __syncthreads();
  const int tid = tid_opaque(), lane = tid & 63, wv = wave_id(tid);
  const int d = chain & 1, h = (chain >> 1) & 3, b = (chain >> 3) & 1, ty = chain >> 4;
  const char* CH = p.ws + OFF_CH;
  float* Y = (float*)(p.ws + OFF_S + (ty ? S_YGD : S_YRW)) + (size_t)d * NTOK * 256;
  const size_t c0 = (size_t)chain * NCHUNK;
  if (wv >= 4) {
    const int lw = wv - 4;
    const char* src0 = CH + c0 * CH_REC + (size_t)lane * 16;
#define X2_DMA(n) { const char* s_ = src0 + (size_t)(n) * CH_REC; LAS unsigned char* d_ = (LAS unsigned char*)smem + ((n) & 3) * X2_BUF;       \
      _Pragma("unroll") for (int i = 0; i < 8; ++i) {                                                                                       \
        const int piece = i * 4 + lw;                                                                                                       \
        __builtin_amdgcn_global_load_lds((const unsigned*)(s_ + piece * 1024), (LAS unsigned*)(d_ + piece * 1024), 16, 0, 0); } }
    X2_DMA(0) X2_DMA(1) X2_DMA(2)
    asm volatile("s_waitcnt vmcnt(16)" ::: "memory");
    X2_BAR();
    for (int n = 0; n < NCHUNK; ++n) {
      if (n + 3 < NCHUNK) { X2_DMA(n + 3) asm volatile("s_waitcnt vmcnt(16)" ::: "memory"); }
      else if (n + 2 < NCHUNK) asm volatile("s_waitcnt vmcnt(8)" ::: "memory");
      else asm volatile("s_waitcnt vmcnt(0)" ::: "memory");
      X2_BAR();
    }
#undef X2_DMA
  } else {
    const int vt = wv, fr = lane & 15, fq = lane >> 4;
    f32x4 Sacc[4];
#pragma unroll
    for (int i = 0; i < 4; ++i) Sacc[i] = (f32x4){0.f, 0.f, 0.f, 0.f};
    X2_BAR();
    for (int n = 0; n < NCHUNK; ++n) {
      const char* buf = smem + (n & 3) * X2_BUF;
      bf16x8 sB0, sB1;
#pragma unroll
      for (int j = 0; j < 4; ++j) {
        sB0[j] = (short)f2bf(Sacc[0][j]); sB0[4 + j] = (short)f2bf(Sacc[1][j]);
        sB1[j] = (short)f2bf(Sacc[2][j]); sB1[4 + j] = (short)f2bf(Sacc[3][j]);
      }
#pragma unroll
      for (int m = 0; m < 4; ++m) {
        const bf16x8 pa0 = *(const bf16x8*)(buf + ((m * 2 + 0) * 64 + lane) * 16);
        const bf16x8 pa1 = *(const bf16x8*)(buf + ((m * 2 + 1) * 64 + lane) * 16);
        const bf16x8 ra0 = *(const bf16x8*)(buf + 8192 + ((m * 2 + 0) * 64 + lane) * 16);
        const bf16x8 ra1 = *(const bf16x8*)(buf + 8192 + ((m * 2 + 1) * 64 + lane) * 16);
        const bf16x4 qb = *(const bf16x4*)(buf + 16384 + ((m * 4 + vt) * 64 + lane) * 8);
        const bf16x4 yb = *(const bf16x4*)(buf + 24576 + ((vt * 4 + m) * 64 + lane) * 8);
        f32x4 y = {bf2f(yb[0]), bf2f(yb[1]), bf2f(yb[2]), bf2f(yb[3])};
        y = __builtin_amdgcn_mfma_f32_16x16x32_bf16(sB0, ra0, y, 0, 0, 0);
        y = __builtin_amdgcn_mfma_f32_16x16x32_bf16(sB1, ra1, y, 0, 0, 0);
        f32x4 sn = {bf2f(qb[0]), bf2f(qb[1]), bf2f(qb[2]), bf2f(qb[3])};
        sn = __builtin_amdgcn_mfma_f32_16x16x32_bf16(pa0, sB0, sn, 0, 0, 0);
        sn = __builtin_amdgcn_mfma_f32_16x16x32_bf16(pa1, sB1, sn, 0, 0, 0);
        Sacc[m] = sn;
        {
          const int mm = scan_tok(b, d, n * 64 + m * 16 + fr);
          *(f32x4*)(Y + (size_t)mm * 256 + h * 64 + vt * 16 + 4 * fq) = y;
        }
      }
      X2_BAR();
    }
  }
}

struct NaPair { int mk0, mk1, tau0, tau1, kr0, kr1, ct0, ct1; };
struct NaFrag { bf16x8 k00, k01, k10, k11; bf16x4 v0[4], v1[4]; };

__device__ __forceinline__ void na_load(NaFrag& f, const bfr* KN, const bfr* VT, size_t vt_base, int h, int fr, int fq, const NaPair& pr) {
  const bfr* k0 = KN + (size_t)(pr.mk0 + fr) * 512 + h * 64 + fq * 8;
  const bfr* k1 = KN + (size_t)(pr.mk1 + fr) * 512 + h * 64 + fq * 8;
  f.k00 = *(const bf16x8*)(k0); f.k01 = *(const bf16x8*)(k0 + 32);
  f.k10 = *(const bf16x8*)(k1); f.k11 = *(const bf16x8*)(k1 + 32);
#pragma unroll
  for (int dt = 0; dt < 4; ++dt) {
    const bfr* vrow = VT + vt_base + (size_t)(dt * 16 + fr) * TTOK;
    f.v0[dt] = *(const bf16x4*)(vrow + pr.tau0 + fq * 4);
    f.v1[dt] = *(const bf16x4*)(vrow + pr.tau1 + fq * 4);
  }
}

__device__ __forceinline__ void na_compute(const NaFrag& f, const bf16x8 qf0, const bf16x8 qf1, bool local, bool vr0, bool vr1,
                                           int dr0, int dr1, int ct0, int ct1, int qc, int fq, const float* bias_h, f32x4 (&O)[4], float& lsum) {
  f32x4 z = {0.f, 0.f, 0.f, 0.f};
  f32x4 st0 = __builtin_amdgcn_mfma_f32_16x16x32_bf16(f.k00, qf0, z, 0, 0, 0);
  st0 = __builtin_amdgcn_mfma_f32_16x16x32_bf16(f.k01, qf1, st0, 0, 0, 0);
  f32x4 st1 = __builtin_amdgcn_mfma_f32_16x16x32_bf16(f.k10, qf0, z, 0, 0, 0);
  st1 = __builtin_amdgcn_mfma_f32_16x16x32_bf16(f.k11, qf1, st1, 0, 0, 0);
  bf16x8 pf;
  if (local) {
    const int cs = min(max(qc - 8, 0), 48);
#pragma unroll
    for (int r = 0; r < 4; ++r) {
      const int kc0 = ct0 * 16 + fq * 4 + r, kc1 = ct1 * 16 + fq * 4 + r;
      float p0 = 0.f, p1 = 0.f;
      if (vr0 && (unsigned)(kc0 - cs) < 16u) p0 = exp2f(st0[r] + bias_h[dr0 * 31 + (kc0 - qc + 15)]);
      if (vr1 && (unsigned)(kc1 - cs) < 16u) p1 = exp2f(st1[r] + bias_h[dr1 * 31 + (kc1 - qc + 15)]);
      lsum += p0 + p1;
      pf[r] = (short)f2bf(p0);
      pf[4 + r] = (short)f2bf(p1);
    }
  } else {
#pragma unroll
    for (int r = 0; r < 4; ++r) {
      const float p0 = exp2f(st0[r]), p1 = exp2f(st1[r]);
      lsum += p0 + p1;
      pf[r] = (short)f2bf(p0);
      pf[4 + r] = (short)f2bf(p1);
    }
  }
#pragma unroll
  for (int dt = 0; dt < 4; ++dt) {
    bf16x8 vf;
    vf[0] = f.v0[dt][0]; vf[1] = f.v0[dt][1]; vf[2] = f.v0[dt][2]; vf[3] = f.v0[dt][3];
    vf[4] = f.v1[dt][0]; vf[5] = f.v1[dt][1]; vf[6] = f.v1[dt][2]; vf[7] = f.v1[dt][3];
    O[dt] = __builtin_amdgcn_mfma_f32_16x16x32_bf16(vf, pf, O[dt], 0, 0, 0);
  }
}

__device__ __forceinline__ void na_block_task(PP pp, int task, const float* bias_lds) {
  const int tid = tid_opaque(), lane = tid & 63, wv = wave_id(tid);
  const int fr = lane & 15, fq = lane >> 4;
  char* S = p.ws + OFF_S;
  const bfr* QN = (const bfr*)(S + S_QN);
  const bfr* KN = (const bfr*)(S + S_KN);
  const bfr* VT = (const bfr*)(S + S_VT);
  bfr* CC = (bfr*)(p.ws + OFF_CC);
  const bool latent = task < 1024;
  int b, h, mqa, mqb, qra = 0, qrb = 0, cgp = 0;
  if (latent) {
    h = task & 7; const int quad = (task >> 3) & 63; b = task >> 9;
    qra = quad * 4 + (wv >> 2) * 2; qrb = qra + 1; cgp = wv & 3;
    mqa = b * SEQ + qra * 64 + cgp * 16; mqb = mqa + 64;
  } else {
    const int u = task - 1024;
    h = u & 7; b = u >> 3;
    mqa = NLAT + b * CTXL + (wv * 2) * 16; mqb = mqa + 16;
  }
  const bf16x8 qa0 = *(const bf16x8*)(QN + (size_t)(mqa + fr) * 512 + h * 64 + fq * 8);
  const bf16x8 qa1 = *(const bf16x8*)(QN + (size_t)(mqa + fr) * 512 + h * 64 + 32 + fq * 8);
  const bf16x8 qb0 = *(const bf16x8*)(QN + (size_t)(mqb + fr) * 512 + h * 64 + fq * 8);
  const bf16x8 qb1 = *(const bf16x8*)(QN + (size_t)(mqb + fr) * 512 + h * 64 + 32 + fq * 8);
  f32x4 Oa[4], Ob[4];
#pragma unroll
  for (int dt = 0; dt < 4; ++dt) { Oa[dt] = (f32x4){0.f, 0.f, 0.f, 0.f}; Ob[dt] = Oa[dt]; }
  float lsa = 0.f, lsb = 0.f;
  const size_t vt_base = (size_t)(b * 8 + h) * 64 * TTOK;
  const int rsa = min(max(qra - 4, 0), SEQ / 64 - 8), rsb = min(max(qrb - 4, 0), SEQ / 64 - 8);
  const int nrows = latent ? (rsb - rsa + 8) : 0;
  const int ct_first = (cgp <= 1) ? 0 : cgp - 1;
  const int nct = (cgp == 0 || cgp == 3) ? 2 : 3;
  const int ntile = nrows * nct;
  const int nlp = (ntile + 1) >> 1;
  const int npair = nlp + 8;
  const int qc = cgp * 16 + fr;
  auto mkpair = [&](int pi) {
    NaPair pr;
    if (pi < nlp) {
      const int i0 = 2 * pi, i1 = min(2 * pi + 1, ntile - 1);
      pr.kr0 = rsa + i0 / nct; pr.ct0 = ct_first + i0 % nct;
      pr.kr1 = rsa + i1 / nct; pr.ct1 = ct_first + i1 % nct;
      if (2 * pi + 1 >= ntile) pr.kr1 = -100;
      const int r1 = rsa + i1 / nct;
      pr.tau0 = pr.kr0 * 64 + pr.ct0 * 16; pr.tau1 = r1 * 64 + pr.ct1 * 16;
      pr.mk0 = b * SEQ + pr.tau0; pr.mk1 = b * SEQ + pr.tau1;
    } else {
      const int c = pi - nlp;
      pr.kr0 = pr.kr1 = pr.ct0 = pr.ct1 = 0;
      pr.tau0 = SEQ + c * 32; pr.tau1 = SEQ + c * 32 + 16;
      pr.mk0 = NLAT + b * CTXL + c * 32; pr.mk1 = pr.mk0 + 16;
    }
    return pr;
  };
  NaFrag fa, fb;
  NaPair pa = mkpair(0), pb;
  na_load(fa, KN, VT, vt_base, h, fr, fq, pa);
  const float* bias_h = bias_lds + h * 465;
#define NA_DO(F, PR, PI)                                                                                          \
  {                                                                                                               \
    const bool loc_ = (PI) < nlp;                                                                                 \
    na_compute(F, qa0, qa1, loc_, (unsigned)(PR.kr0 - rsa) < 8u, (unsigned)(PR.kr1 - rsa) < 8u,                   \
               PR.kr0 - qra + 7, PR.kr1 - qra + 7, PR.ct0, PR.ct1, qc, fq, bias_h, Oa, lsa);                      \
    na_compute(F, qb0, qb1, loc_, (unsigned)(PR.kr0 - rsb) < 8u, (unsigned)(PR.kr1 - rsb) < 8u,                   \
               PR.kr0 - qrb + 7, PR.kr1 - qrb + 7, PR.ct0, PR.ct1, qc, fq, bias_h, Ob, lsb);                      \
  }
  for (int pi = 0; pi < npair; pi += 2) {
    if (pi + 1 < npair) { pb = mkpair(pi + 1); na_load(fb, KN, VT, vt_base, h, fr, fq, pb); }
    NA_DO(fa, pa, pi)
    if (pi + 1 < npair) {
      if (pi + 2 < npair) { pa = mkpair(pi + 2); na_load(fa, KN, VT, vt_base, h, fr, fq, pa); }
      NA_DO(fb, pb, pi + 1)
    }
  }
#undef NA_DO
  lsa += shfl_xor_l(lsa, 16, lane); lsa += shfl_xor_l(lsa, 32, lane);
  lsb += shfl_xor_l(lsb, 16, lane); lsb += shfl_xor_l(lsb, 32, lane);
  const float ia = 1.f / lsa, ib = 1.f / lsb;
#pragma unroll
  for (int dt = 0; dt < 4; ++dt) {
    *(bf16x4*)(CC + (size_t)(mqa + fr) * 1024 + h * 64 + dt * 16 + fq * 4) = pack4(Oa[dt][0] * ia, Oa[dt][1] * ia, Oa[dt][2] * ia, Oa[dt][3] * ia);
    *(bf16x4*)(CC + (size_t)(mqb + fr) * 1024 + h * 64 + dt * 16 + fq * 4) = pack4(Ob[dt][0] * ib, Ob[dt][1] * ib, Ob[dt][2] * ib, Ob[dt][3] * ib);
  }
}

__device__ __forceinline__ void phase_mix(PP pp, int l, int bid, int nb, char* smem) {
  const int tid = tid_opaque();
  const int nscan_blocks = (nb > 32) ? 32 : nb;
  const int first_attn_block = (nb > 32) ? 32 : 0;
  if (bid < nscan_blocks) {
    for (int c = bid; c < NCHAIN; c += nscan_blocks) chunk_seq_chain(pp, c, smem);
  }
  if (bid >= first_attn_block) {
    float* bias = (float*)smem;
    __syncthreads();
    for (int i = tid; i < 8 * 465; i += NTHR) bias[i] = p.na_rpb[(size_t)l * 8 * 465 + i] * 1.4426950408889634f;
    __syncthreads();
    const int ntask = (l == 0) ? 1024 + 16 : 1024;
    const int nab = nb - first_attn_block;
    for (int t = bid - first_attn_block; t < ntask; t += nab) na_block_task(pp, t, bias);
  }
}

__device__ __forceinline__ void phase_post(PP pp, int l, int bid, int nb) {
  const int tid = tid_opaque(), lane = tid & 63, wv = wave_id(tid);
  char* S = p.ws + OFF_S;
  const float* YRW = (const float*)(S + S_YRW);
  const float* YGD = (const float*)(S + S_YGD);
  const float* RWV = (const float*)(S + S_RWV);
  const float* RWG = (const float*)(S + S_RWG);
  const float* BON = (const float*)(S + S_BON);
  const float* P = (const float*)(p.ws + OFF_P);
  bfr* CC = (bfr*)(p.ws + OFF_CC);
  const float* ln_w = p.rw_ln_w + (size_t)l * 256;
  const float* ln_b = p.rw_ln_b + (size_t)l * 256;
  const float* ng = p.gd_norm_g + (size_t)l * 64;
  const int ntok = (l == 0) ? NTOK : NLAT;
  for (int wt = bid * 8 + wv; wt < ntok * 8; wt += nb * 8) {
    int m = wt >> 3, hs = wt & 7;
    if (hs < 4) {
      int c = hs * 64 + lane;
      size_t o = (size_t)m * 256 + c;
      float y = YRW[o] + YRW[(size_t)NTOK * 256 + o];
      float mean = wave_sum(y) * (1.f / 64.f);
      float dv = y - mean;
      float var = wave_sum(dv * dv) * (1.f / 64.f);
      float yn = dv * rsqrtf(var + 64e-5f) * ln_w[c] + ln_b[c];
      float out = (yn + BON[(size_t)m * 4 + hs] * RWV[o]) * RWG[o];
      CC[(size_t)m * 1024 + 512 + c] = f2bf(out);
    } else {
      int c = (hs - 4) * 64 + lane;
      size_t o = (size_t)m * 256 + c;
      float y = YGD[o] + YGD[(size_t)NTOK * 256 + o];
      float ms = wave_sum(y * y) * (1.f / 64.f);
      float z = P[(size_t)m * PINP + B_END + 768 + c];
      float out = y * rsqrtf(ms + 1e-6f) * ng[lane] * siluf_(z);
      CC[(size_t)m * 1024 + 768 + c] = f2bf(out);
    }
  }
}

#define RW_LDS_ROW 36
__device__ __forceinline__ void phase_router(PP pp, int l, int bid, int nb, char* smem) {
  const int tid = tid_opaque(), lane = tid & 63, wv = wave_id(tid);
  const float* xl = p.out;
  const float* xc = (const float*)(p.ws + OFF_CTX);
  const float* mods = (const float*)(p.ws + OFF_MODS) + (size_t)l * 3 * 6144;
  const float* g = p.norm_ffn_g + (size_t)l * 1024;
  const float* rw = p.moe_router_w + (size_t)l * 1024 * 32;
  const float* rb = p.moe_router_b + (size_t)l * 32;
  bfr* H = (bfr*)(p.ws + OFF_H);
  int* cnt = (int*)(p.ws + OFF_CNT);
  int* TOKE = (int*)(p.ws + OFF_TOKE);
  int* TOKP = (int*)(p.ws + OFF_TOKP);
  float* TOKG = (float*)(p.ws + OFF_TOKG);
  float* wl = (float*)smem;
  for (int i = tid; i < 1024 * 8; i += NTHR) {
    int d = i >> 3, q = i & 7;
    *(float4*)(wl + d * RW_LDS_ROW + q * 4) = *(const float4*)(rw + (size_t)d * 32 + q * 4);
  }
  __syncthreads();
  const int ntok = (l == 0) ? NTOK : NLAT;
  const float rbl = rb[lane & 31];
  for (int m0 = (bid * 8 + wv) * 2; m0 < ntok; m0 += nb * 16) {
    float acc0[32], acc1[32];
#pragma unroll
    for (int e = 0; e < 32; ++e) { acc0[e] = 0.f; acc1[e] = 0.f; }
    float hv0[16], hv1[16];
    {
      const int ma = m0, mb = m0 + 1;
      const float* xa = (ma < NLAT) ? xl + (size_t)ma * 1024 : xc + (size_t)(ma - NLAT) * 1024;
      const float* xb = (mb < NLAT) ? xl + (size_t)mb * 1024 : xc + (size_t)(mb - NLAT) * 1024;
      const float* mda = mods + (size_t)mod_row(ma) * 6144 + 3072;
      const float* mdb = mods + (size_t)mod_row(mb) * 6144 + 3072;
      float ssa = 0.f, ssb = 0.f;
#pragma unroll
      for (int i = 0; i < 16; ++i) { hv0[i] = xa[lane + 64 * i]; hv1[i] = xb[lane + 64 * i]; }
#pragma unroll
      for (int i = 0; i < 16; ++i) { ssa += hv0[i] * hv0[i]; ssb += hv1[i] * hv1[i]; }
      ssa = wave_sum(ssa); ssb = wave_sum(ssb);
      const float rsa = rsqrtf(ssa * (1.f / 1024.f) + 1e-6f), rsb = rsqrtf(ssb * (1.f / 1024.f) + 1e-6f);
#pragma unroll
      for (int i = 0; i < 16; ++i) {
        const int d = lane + 64 * i;
        const float gg = g[d];
        hv0[i] = hv0[i] * rsa * gg * (1.f + mda[1024 + d]) + mda[d];
        hv1[i] = hv1[i] * rsb * gg * (1.f + mdb[1024 + d]) + mdb[d];
        H[(size_t)ma * 1024 + d] = f2bf(hv0[i]);
        H[(size_t)mb * 1024 + d] = f2bf(hv1[i]);
      }
    }
#pragma unroll
    for (int i = 0; i < 16; ++i) {
      const float* wr = wl + (lane + 64 * i) * RW_LDS_ROW;
#pragma unroll
      for (int q = 0; q < 8; ++q) {
        const float4 w = *(const float4*)(wr + q * 4);
        acc0[q * 4 + 0] += hv0[i] * w.x; acc0[q * 4 + 1] += hv0[i] * w.y; acc0[q * 4 + 2] += hv0[i] * w.z; acc0[q * 4 + 3] += hv0[i] * w.w;
        acc1[q * 4 + 0] += hv1[i] * w.x; acc1[q * 4 + 1] += hv1[i] * w.y; acc1[q * 4 + 2] += hv1[i] * w.z; acc1[q * 4 + 3] += hv1[i] * w.w;
      }
    }
#define BFLY(A, N, D)                                                                           \
    _Pragma("unroll") for (int i = 0; i < (N); ++i) {                                            \
      const bool up = (lane & (D)) != 0;                                                         \
      const float keep = up ? A[i + (N)] : A[i];                                                 \
      const float send = up ? A[i] : A[i + (N)];                                                 \
      A[i] = keep + shfl_xor_l(send, (D), lane);                                                   \
    }
    BFLY(acc0, 16, 16) BFLY(acc1, 16, 16)
    BFLY(acc0, 8, 8) BFLY(acc1, 8, 8)
    BFLY(acc0, 4, 4) BFLY(acc1, 4, 4)
    BFLY(acc0, 2, 2) BFLY(acc1, 2, 2)
    BFLY(acc0, 1, 1) BFLY(acc1, 1, 1)
#undef BFLY
    float la = acc0[0] + shfl_xor_l(acc0[0], 32, lane);
    float lb = acc1[0] + shfl_xor_l(acc1[0], 32, lane);
    const int my_e = lane & 31;
    la += rbl; lb += rbl;
    (void)my_e;
#pragma unroll
    for (int tkn = 0; tkn < 2; ++tkn) {
      float v = tkn == 0 ? la : lb;
      float tv[4]; int ti[4];
#pragma unroll
      for (int k = 0; k < 4; ++k) {
        float bv = v; int bi = lane & 31;
#pragma unroll
        for (int o = 16; o >= 1; o >>= 1) {
          float ov = shfl_xor_l(bv, o, lane); int oi = shfl_xor_li(bi, o, lane);
          bool take = (ov > bv) || (ov == bv && oi < bi);
          bv = take ? ov : bv; bi = take ? oi : bi;
        }
        tv[k] = bv; ti[k] = bi;
        if ((lane & 31) == bi) v = -3.0e38f;
      }
      float e1 = __expf(tv[1] - tv[0]), e2 = __expf(tv[2] - tv[0]), e3 = __expf(tv[3] - tv[0]);
      float inv = 1.f / (1.f + e1 + e2 + e3);
      const int m = m0 + tkn;
      if (lane < 4) {
        int e = lane == 0 ? ti[0] : lane == 1 ? ti[1] : lane == 2 ? ti[2] : ti[3];
        float gt = (lane == 0 ? 1.f : lane == 1 ? e1 : lane == 2 ? e2 : e3) * inv;
        int pos = atomicAdd(&cnt[e], 1);
        TOKE[(size_t)m * 4 + lane] = e; TOKP[(size_t)m * 4 + lane] = pos; TOKG[(size_t)m * 4 + lane] = gt;
      }
    }
  }
  __syncthreads();
}

__device__ __forceinline__ void moe_offsets(PP pp, int* toff) {
  const int* cnt = (const int*)(p.ws + OFF_CNT);
  if (tid_opaque() == 0) {
    int a = 0;
    for (int e = 0; e < 32; ++e) { toff[e] = a; a += (cnt[e] + 255) >> 8; }
    toff[32] = a;
  }
  __syncthreads();
}

__device__ __forceinline__ void phase_slotfill(PP pp, int l, int bid, int nb, char* smem) {
  int* toff = (int*)smem;
  moe_offsets(pp, toff);
  const int tid = tid_opaque(), lane = tid & 63, wv = wave_id(tid);
  const int* TOKE = (const int*)(p.ws + OFF_TOKE);
  const int* TOKP = (const int*)(p.ws + OFF_TOKP);
  const float* TOKG = (const float*)(p.ws + OFF_TOKG);
  const int* cnt = (const int*)(p.ws + OFF_CNT);
  int* TOKS = (int*)(p.ws + OFF_TOKS);
  float* SLG = (float*)(p.ws + OFF_SLG);
  const bfr* H = (const bfr*)(p.ws + OFF_H);
  bfr* XG = (bfr*)(p.ws + OFF_S);
  const int n = ((l == 0) ? NTOK : NLAT) * 4;
  for (int i = bid * 8 + wv; i < n; i += nb * 8) {
    int e = TOKE[i];
    int slot = toff[e] * 256 + TOKP[i];
    if (lane == 0) { TOKS[i] = slot; SLG[slot] = TOKG[i]; }
    const uint4* src = (const uint4*)(H + (size_t)(i >> 2) * 1024);
    uint4* dst = (uint4*)(XG + (size_t)slot * 1024);
    dst[lane] = src[lane];
    dst[lane + 64] = src[lane + 64];
  }
  for (int e = 0; e < 32; ++e) {
    const int c = cnt[e];
    const int npad = ((c + 255) & ~255) - c;
    const int base = toff[e] * 256 + c;
    for (int r = bid * 8 + wv; r < npad; r += nb * 8) {
      uint4* dst = (uint4*)(XG + (size_t)(base + r) * 1024);
      dst[lane] = make_uint4(0u, 0u, 0u, 0u);
      dst[lane + 64] = make_uint4(0u, 0u, 0u, 0u);
    }
  }
  __syncthreads();
}

struct EpiMoe1 {
  const float* bgu; bfr* ACT;
  __device__ __forceinline__ void operator()(const f32x4 (&acc)[2][2][4][2], const g8::GUnit& u, int wr, int wc, int fr, int fq) const {
    const float* be = bgu + (size_t)u.e * 2048;
    const int slot0 = u.pm * 256 + wr * 64 + fr;
#pragma unroll
    for (int bj = 0; bj < 2; ++bj) {
      const int j0 = u.pn * 128 + bj * 64 + wc * 16 + 4 * fq;
      const f32x4 bg = *(const f32x4*)(be + j0), bl = *(const f32x4*)(be + 1024 + j0);
#pragma unroll
      for (int ai = 0; ai < 2; ++ai)
#pragma unroll
        for (int m = 0; m < 4; ++m) {
          const f32x4 g = acc[ai][bj][m][0] + bg, li = acc[ai][bj][m][1] + bl;
          bf16x4 o;
#pragma unroll
          for (int q = 0; q < 4; ++q) {
            float gv = fminf(g[q], 7.f);
            float lv = fminf(fmaxf(li[q], -7.f), 7.f);
            o[q] = (short)f2bf(gv * sigmoidf_(1.702f * gv) * (lv + 1.f));
          }
          *(bf16x4*)(ACT + (size_t)(slot0 + ai * 128 + m * 16) * 1024 + j0) = o;
        }
    }
  }
};
__device__ __forceinline__ void phase_moe1_impl(PP pp, int l, int bid, int nb, char* smem, int* toff) {
  moe_offsets(pp, toff);
  g8::MoeSched S{toff, 8, 2048, nb, bid};
  EpiMoe1 E{p.moe_b_gu + (size_t)l * 32 * 2048, (bfr*)(p.ws + OFF_P)};
  g8::gemm_stream((LAS unsigned char*)smem, (const bfr*)(p.ws + OFF_S), (const bfr*)(p.ws + OFF_W + (size_t)l * WL_SIZE + WL_GU), S, E);
}

struct EpiMoe2 {
  const float* bdn; const float* SLG; bfr* YS;
  __device__ __forceinline__ void operator()(const f32x4 (&acc)[2][2][4][2], const g8::GUnit& u, int wr, int wc, int fr, int fq) const {
    const float* be = bdn + (size_t)u.e * 1024;
    const int slot0 = u.pm * 256 + wr * 64 + fr, col0 = u.pn * 256 + wc * 32 + 4 * fq;
#pragma unroll
    for (int ai = 0; ai < 2; ++ai)
#pragma unroll
      for (int m = 0; m < 4; ++m) {
        const int slot = slot0 + ai * 128 + m * 16;
        const float gt = SLG[slot];
#pragma unroll
        for (int bj = 0; bj < 2; ++bj)
#pragma unroll
          for (int n = 0; n < 2; ++n) {
            const f32x4 bv = *(const f32x4*)(be + col0 + bj * 128 + n * 16);
            const f32x4 yv = (acc[ai][bj][m][n] + bv) * gt;
            *(bf16x4*)(YS + (size_t)slot * 1024 + col0 + bj * 128 + n * 16) = pack4(yv[0], yv[1], yv[2], yv[3]);
          }
      }
  }
};
__device__ __forceinline__ void phase_moe2_impl(PP pp, int l, int bid, int nb, char* smem, int* toff) {
  moe_offsets(pp, toff);
  g8::MoeSched S{toff, 4, 1024, nb, bid};
  EpiMoe2 E{p.moe_b_down + (size_t)l * 32 * 1024, (const float*)(p.ws + OFF_SLG), (bfr*)(p.ws + OFF_S)};
  g8::gemm_stream((LAS unsigned char*)smem, (const bfr*)(p.ws + OFF_P), (const bfr*)(p.ws + OFF_W + (size_t)l * WL_SIZE + WL_DN), S, E);
}

__device__ __forceinline__ void phase_combine(PP pp, int l, int bid, int nb) {
  const int tid = tid_opaque(), lane = tid & 63, wv = wave_id(tid);
  const bfr* YS = (const bfr*)(p.ws + OFF_S);
  const int* TOKS = (const int*)(p.ws + OFF_TOKS);
  const float* mods = (const float*)(p.ws + OFF_MODS) + (size_t)l * 3 * 6144;
  const float* mods1 = (const float*)(p.ws + OFF_MODS) + (size_t)3 * 6144;
  const float* g1n = p.norm_mix_g + 1024;
  bfr* H = (bfr*)(p.ws + OFF_H);
  float* xl = p.out;
  float* xc = (float*)(p.ws + OFF_CTX);
  const int ntok = (l == 0) ? NTOK : NLAT;
  if (l == 0) {
    int* cnt = (int*)(p.ws + OFF_CNT);
    const int gt = bid * NTHR + tid;
    if (gt < 32) cnt[gt] = 0;
  }
  for (int m = bid * 8 + wv; m < ntok; m += nb * 8) {
    float* xr = (m < NLAT) ? xl + (size_t)m * 1024 : xc + (size_t)(m - NLAT) * 1024;
    const float* g2 = mods + (size_t)mod_row(m) * 6144 + 5120;
    const int s0 = TOKS[(size_t)m * 4], s1 = TOKS[(size_t)m * 4 + 1], s2 = TOKS[(size_t)m * 4 + 2], s3 = TOKS[(size_t)m * 4 + 3];
    float4 xn[4];
    float ss = 0.f;
#pragma unroll
    for (int i = 0; i < 4; ++i) {
      const int d = (lane + 64 * i) * 4;
      const bf16x4 a = *(const bf16x4*)(YS + (size_t)s0 * 1024 + d);
      const bf16x4 b = *(const bf16x4*)(YS + (size_t)s1 * 1024 + d);
      const bf16x4 c = *(const bf16x4*)(YS + (size_t)s2 * 1024 + d);
      const bf16x4 e = *(const bf16x4*)(YS + (size_t)s3 * 1024 + d);
      const float4 gg = *(const float4*)(g2 + d);
      float4 xv = *(const float4*)(xr + d);
      xv.x += gg.x * ((bf2f(a[0]) + bf2f(b[0])) + (bf2f(c[0]) + bf2f(e[0])));
      xv.y += gg.y * ((bf2f(a[1]) + bf2f(b[1])) + (bf2f(c[1]) + bf2f(e[1])));
      xv.z += gg.z * ((bf2f(a[2]) + bf2f(b[2])) + (bf2f(c[2]) + bf2f(e[2])));
      xv.w += gg.w * ((bf2f(a[3]) + bf2f(b[3])) + (bf2f(c[3]) + bf2f(e[3])));
      *(float4*)(xr + d) = xv;
      xn[i] = xv;
      ss += xv.x * xv.x + xv.y * xv.y + xv.z * xv.z + xv.w * xv.w;
    }
    if (l == 0) {
      ss = wave_sum(ss);
      const float rs = rsqrtf(ss * (1.f / 1024.f) + 1e-6f);
      const float* md = mods1 + (size_t)mod_row(m) * 6144;
#pragma unroll
      for (int i = 0; i < 4; ++i) {
        const int d = (lane + 64 * i) * 4;
        const float4 gg = *(const float4*)(g1n + d);
        const float4 sh = *(const float4*)(md + d);
        const float4 sc = *(const float4*)(md + 1024 + d);
        *(bf16x4*)(H + (size_t)m * 1024 + d) = pack4(xn[i].x * rs * gg.x * (1.f + sc.x) + sh.x, xn[i].y * rs * gg.y * (1.f + sc.y) + sh.y,
                                                      xn[i].z * rs * gg.z * (1.f + sc.z) + sh.z, xn[i].w * rs * gg.w * (1.f + sc.w) + sh.w);
      }
    }
  }
}

#define XB_TMO      128
#define XB_XCNT(j)  (256  + 64 * (j))
#define XB_XSUB(j)  (1280 + 64 * (j))
#define XB_XGEN(j)  (2304 + 64 * (j))
#define XB_TOP      3328
#define XB_TOPGEN   3392
#define XCD_BAR_WORDS 3456
#define XB_SPIN_CAP (1u << 22)
__device__ __forceinline__ unsigned xb_ld(unsigned* q) { return __hip_atomic_load(q, __ATOMIC_RELAXED, __HIP_MEMORY_SCOPE_AGENT); }
__device__ __forceinline__ unsigned xb_add(unsigned* q, unsigned v) { return __hip_atomic_fetch_add(q, v, __ATOMIC_RELAXED, __HIP_MEMORY_SCOPE_AGENT); }
__device__ __forceinline__ unsigned xb_xcc_id() { return (unsigned)__builtin_amdgcn_s_getreg((3 << 11) | 20) & 0xFu; }
#define XB_SPIN(cond, bar) do { unsigned _sp = 0; while (cond) { __builtin_amdgcn_s_sleep(1); \
    if ((++_sp & 255u) == 0u) { if (xb_ld(&(bar)[XB_TMO])) break; if (_sp > XB_SPIN_CAP) { atomicAdd(&(bar)[XB_TMO], 1u); break; } } } } while (0)
struct XcdBarrier { unsigned* bar; unsigned x; volatile LAS unsigned* st; };
__device__ __forceinline__ XcdBarrier xcd_barrier_post(unsigned* bar, volatile LAS unsigned* st) {
  XcdBarrier b; b.bar = bar; b.x = xb_xcc_id(); b.st = st;
  if (tid_opaque() == 0) (void)xb_add(&bar[XB_XCNT(b.x)], 1u);
  return b;
}
__device__ __forceinline__ void xcd_barrier_complete(unsigned* bar, unsigned x, unsigned& nloc, unsigned& nx) {
  const unsigned G = gridDim.x;
  unsigned sum, cnt, mine, sp = 0u;
  for (;;) {
    sum = 0u; cnt = 0u; mine = 0u;
#pragma unroll
    for (unsigned j = 0; j < 16; ++j) { const unsigned c = xb_ld(&bar[XB_XCNT(j)]); sum += c; cnt += (c > 0u) ? 1u : 0u; mine = (j == x) ? c : mine; }
    if (sum == G) break;
    __builtin_amdgcn_s_sleep(1);
    if ((++sp & 255u) == 0u) { if (xb_ld(&bar[XB_TMO])) break; if (sp > XB_SPIN_CAP) { atomicAdd(&bar[XB_TMO], 1u); break; } }
  }
  nloc = mine > 0u ? mine : 1u; nx = cnt > 0u ? cnt : 1u;
}
__device__ __forceinline__ void xcd_barrier(const XcdBarrier& b) {
  asm volatile("s_waitcnt vmcnt(0)" ::: "memory");
  __syncthreads();
  if (tid_opaque() == 0) {
    unsigned* bar = b.bar;
    __builtin_amdgcn_s_waitcnt(0);
    unsigned nloc = b.st[0], nx = b.st[1];
    if (nloc == 0u) { xcd_barrier_complete(bar, b.x, nloc, nx); b.st[0] = nloc; b.st[1] = nx; }
    const unsigned old = xb_add(&bar[XB_XSUB(b.x)], 1u);
    const unsigned gen = old / nloc;
    if (old + 1u == (gen + 1u) * nloc) {
      __builtin_amdgcn_fence(__ATOMIC_RELEASE, "agent");
      asm volatile("s_waitcnt vmcnt(0)" ::: "memory");
      const unsigned og = xb_add(&bar[XB_TOP], 1u);
      const unsigned tg = og / nx;
      if (og + 1u == (tg + 1u) * nx) xb_add(&bar[XB_TOPGEN], 1u);
      else XB_SPIN(xb_ld(&bar[XB_TOPGEN]) == tg, bar);
      __builtin_amdgcn_fence(__ATOMIC_ACQUIRE, "agent");
      xb_add(&bar[XB_XGEN(b.x)], 1u);
      asm volatile("s_waitcnt vmcnt(0)" ::: "memory");
    } else {
      XB_SPIN(xb_ld(&bar[XB_XGEN(b.x)]) == gen, bar);
      __builtin_amdgcn_fence(__ATOMIC_ACQUIRE, "agent");
      asm volatile("s_waitcnt vmcnt(0)" ::: "memory");
    }
  }
  __syncthreads();
}

extern __shared__ __attribute__((aligned(16))) char dyn_smem[];

__global__ void __launch_bounds__(NTHR) mega(Params p_unused) {
  cg::grid_group grid = cg::this_grid();
  const int bid0 = blockIdx.x, nb0 = gridDim.x;
#if defined(__HIP_DEVICE_COMPILE__)
  PP pp0 = (PP)__builtin_amdgcn_kernarg_segment_ptr();
#else
  PP pp0 = nullptr;
#endif
#define pp ({ PP q_ = pp0; asm volatile("" : "+s"(q_)); q_; })
#define bid opq(bid0)
#define nb opq(nb0)
  int* toff_s = (int*)(dyn_smem + 147456);
  volatile LAS unsigned* xb_st = (volatile LAS unsigned*)(dyn_smem + 147456 + 256);
  {
    unsigned* barw = (unsigned*)(fresh_ws(pp0) + OFF_BAR);
    if (blockIdx.x == 0) for (int i = threadIdx.x; i < XCD_BAR_WORDS; i += NTHR) barw[i] = 0u;
    if (threadIdx.x == 0) { xb_st[0] = 0u; xb_st[1] = 0u; }
  }
  grid.sync();
  const XcdBarrier xb = xcd_barrier_post((unsigned*)(fresh_ws(pp0) + OFF_BAR), xb_st);
#define GSYNC() xcd_barrier(xb)
  phase_ada(pp, bid, nb, dyn_smem);
  phase_convert(pp, 0, bid, nb, dyn_smem);
  phase_convert(pp, 1, bid, nb, dyn_smem);
  GSYNC();
#define LAYER(LV, LAST)                                      \
  {                                                          \
    if ((LV) == 0) { phase_prenorm(pp, opq(LV), bid, nb); GSYNC(); } \
    phase_gemm_in(pp, opq(LV), bid, nb, dyn_smem);           \
    GSYNC();                                                 \
    phase_prep(pp, opq(LV), bid, nb, dyn_smem);              \
    GSYNC();                                                 \
    phase_chunk_prep(pp, bid, nb, dyn_smem);                 \
    GSYNC();                                                 \
    phase_mix(pp, opq(LV), bid, nb, dyn_smem);               \
    GSYNC();                                                 \
    phase_post(pp, opq(LV), bid, nb);                        \
    GSYNC();                                                 \
    phase_gemm_out(pp, opq(LV), bid, nb, dyn_smem);          \
    GSYNC();                                                 \
    phase_router(pp, opq(LV), bid, nb, dyn_smem);            \
    GSYNC();                                                 \
    phase_slotfill(pp, opq(LV), bid, nb, dyn_smem);          \
    GSYNC();                                                 \
    phase_moe1_impl(pp, opq(LV), bid, nb, dyn_smem, toff_s); \
    GSYNC();                                                 \
    phase_moe2_impl(pp, opq(LV), bid, nb, dyn_smem, toff_s); \
    GSYNC();                                                 \
    phase_combine(pp, opq(LV), bid, nb);                     \
    if (!(LAST)) GSYNC();                                    \
  }
  LAYER(0, false)
  LAYER(1, true)
#undef LAYER
#undef GSYNC
#undef bid
#undef nb
#undef pp
}

#undef p
extern "C" void kernel_launch(void* const* d_in, const int* in_sizes, int n_in, void* d_out, int out_size, void* d_ws,
                              size_t ws_size, hipStream_t stream) {
  Params hp{};
  const float** pp = (const float**)&hp;
  for (int i = 0; i < 34; ++i) pp[i] = (const float*)d_in[i];
  hp.out = (float*)d_out;
  hp.ws = (char*)d_ws;
  static int grid_blocks = 0;
  if (!grid_blocks) {
    (void)hipFuncSetAttribute((const void*)mega, hipFuncAttributeMaxDynamicSharedMemorySize, LDS_BYTES);
    int dev = 0, cus = 0, per_cu = 0;
    (void)hipGetDevice(&dev);
    (void)hipDeviceGetAttribute(&cus, hipDeviceAttributeMultiprocessorCount, dev);
    (void)hipOccupancyMaxActiveBlocksPerMultiprocessor(&per_cu, mega, NTHR, LDS_BYTES);
    if (per_cu < 1) per_cu = 1;
    if (per_cu > 1) per_cu = 1;
    grid_blocks = cus * per_cu;
  }
  void* args[] = {&hp};
  (void)hipLaunchCooperativeKernel((void*)mega, dim3(grid_blocks), dim3(NTHR), args, LDS_BYTES, stream);
}
```

```cpp
#include <hip/hip_runtime.h>
#include <hip/hip_bf16.h>
#include <hip/hip_cooperative_groups.h>
#include <stdint.h>
#include <type_traits>
namespace cg = cooperative_groups;

typedef __attribute__((ext_vector_type(8))) short bf16x8;
typedef __attribute__((ext_vector_type(4))) short bf16x4;
typedef __attribute__((ext_vector_type(4))) float f32x4;
typedef __attribute__((ext_vector_type(4))) int i32x4;
typedef unsigned short bfr;

#define D_MODEL 1024
#define NB 2
#define SEQ 16384
#define CTXL 256
#define NLAT (NB * SEQ)
#define NCTX (NB * CTXL)
#define NTOK (NLAT + NCTX)
#define TTOK (SEQ + CTXL)
#define PIN 3472
#define PINP 3584
#define A_END 1536
#define B_END 2432
#define NEXP 32
#define NSLOT_MAX (NTOK * 4 + NEXP * 256)
#define NTHR 512
#define LDS_BYTES (147456 + 512)

constexpr size_t al256(size_t x) { return (x + 255) & ~(size_t)255; }
constexpr size_t WL_IN = 0;
constexpr size_t WL_OUT = WL_IN + (size_t)PINP * 1024 * 2;
constexpr size_t WL_GU = WL_OUT + (size_t)1024 * 1024 * 2;
constexpr size_t WL_DN = WL_GU + (size_t)32 * 2048 * 1024 * 2;
constexpr size_t WL_SIZE = WL_DN + (size_t)32 * 1024 * 1024 * 2;
constexpr size_t OFF_W = 0;
constexpr size_t OFF_MODS = al256(OFF_W + 2 * WL_SIZE);
constexpr size_t OFF_BAR = al256(OFF_MODS + 2 * 3 * 6144 * 4);
constexpr size_t OFF_SW = al256(OFF_BAR + 3456 * 4);
constexpr size_t OFF_SLS = al256(OFF_SW + (size_t)2 * 32 * 2048 * 4);
constexpr size_t OFF_SCL = al256(OFF_SLS + (size_t)(NTOK * 4 + 32 * 256) * 4);
constexpr size_t OFF_CTX = al256(OFF_SCL + (size_t)NTOK * 4);
constexpr size_t OFF_CNT = al256(OFF_CTX + (size_t)NCTX * 1024 * 4);
constexpr size_t OFF_TOKE = al256(OFF_CNT + 256);
constexpr size_t OFF_TOKP = al256(OFF_TOKE + (size_t)NTOK * 4 * 4);
constexpr size_t OFF_TOKG = al256(OFF_TOKP + (size_t)NTOK * 4 * 4);
constexpr size_t OFF_TOKS = al256(OFF_TOKG + (size_t)NTOK * 4 * 4);
constexpr size_t OFF_SLT = al256(OFF_TOKS + (size_t)NTOK * 4 * 4);
constexpr size_t OFF_SLG = al256(OFF_SLT + (size_t)NSLOT_MAX * 4);
constexpr size_t OFF_H = al256(OFF_SLG + (size_t)NSLOT_MAX * 4);
constexpr size_t OFF_CC = al256(OFF_H + (size_t)NTOK * 1024 * 2);
constexpr size_t OFF_P = al256(OFF_CC + (size_t)NTOK * 1024 * 2);
constexpr size_t OFF_S = al256(OFF_P + (size_t)NTOK * PINP * 4);
constexpr size_t TOK256F = (size_t)NTOK * 256 * 4;
constexpr size_t S_QN = 0;
constexpr size_t S_KN = S_QN + (size_t)NTOK * 512 * 2;
constexpr size_t S_VT = S_KN + (size_t)NTOK * 512 * 2;
constexpr size_t S_RWR = S_VT + (size_t)NB * 8 * 64 * TTOK * 2;
constexpr size_t S_RWKK = S_RWR + TOK256F;
constexpr size_t S_RWV = S_RWKK + TOK256F;
constexpr size_t S_RWG = S_RWV + TOK256F;
constexpr size_t S_RWW = S_RWG + TOK256F;
constexpr size_t S_RWKD = S_RWW + 2 * TOK256F;
constexpr size_t S_RWB = S_RWKD + 2 * TOK256F;
constexpr size_t S_BON = S_RWB + 2 * TOK256F;
constexpr size_t S_GDQ = al256(S_BON + (size_t)NTOK * 4 * 4);
constexpr size_t S_GDK = S_GDQ + TOK256F;
constexpr size_t S_GDV = S_GDK + TOK256F;
constexpr size_t S_GDAB = S_GDV + TOK256F;
constexpr size_t S_YRW = al256(S_GDAB + (size_t)NTOK * 16 * 4);
constexpr size_t S_YGD = S_YRW + 2 * TOK256F;
constexpr size_t S_END = S_YGD + 2 * TOK256F;
constexpr size_t S_SIZE = (S_END > (size_t)NSLOT_MAX * 1024 * 4) ? S_END : (size_t)NSLOT_MAX * 1024 * 4;
constexpr int NCHUNK = TTOK / 64;
constexpr int NCHAIN = 32;
constexpr size_t OFF_CH = al256(OFF_S + S_SIZE);
constexpr size_t CH_N = (size_t)NCHAIN * NCHUNK;
constexpr size_t CH_REC = 32768, CH_PT = 0, CH_RYT = 8192, CH_QT = 16384, CH_YX = 24576;
constexpr size_t CH_SIZE = CH_N * CH_REC;
constexpr size_t WS_TOTAL = OFF_CH + CH_SIZE;
static_assert(WS_TOTAL <= (size_t)2048 * 1024 * 1024, "workspace exceeds 4x largest tensor");

struct Params {
  const float *x, *c, *ctx, *c_ctx, *ada_w, *ada_b, *norm_mix_g, *norm_ffn_g, *w_in, *w_out;
  const float *na_q_gain, *na_k_gain, *na_rpb;
  const float *rw_mu, *rw_w0, *rw_w_up, *rw_a0, *rw_a_up, *rw_g_up, *rw_k_k, *rw_k_a, *rw_r_k, *rw_ln_w, *rw_ln_b;
  const float *gd_conv_w, *gd_A_log, *gd_dt_bias, *gd_norm_g;
  const float *moe_router_w, *moe_router_b, *moe_w_gu, *moe_b_gu, *moe_w_down, *moe_b_down;
  float* out;
  char* ws;
};

typedef const __attribute__((address_space(4))) Params* PP;
#define p (*pp)
__device__ __forceinline__ char* fresh_ws(PP pp) { return p.ws; }
__device__ __forceinline__ int tid_opaque() { int t = (int)__builtin_amdgcn_workitem_id_x(); asm volatile("" : "+v"(t)); return t; }
__device__ __forceinline__ int opq(int x) { asm volatile("" : "+s"(x)); return x; }
__device__ __forceinline__ int wave_id(int tid) { return __builtin_amdgcn_readfirstlane(tid >> 6); }
__device__ __forceinline__ bfr f2bf(float f) {
  unsigned u = __float_as_uint(f);
  u += 0x7fffu + ((u >> 16) & 1u);
  return (bfr)(u >> 16);
}
__device__ __forceinline__ float bf2f(short v) { return __uint_as_float(((unsigned)(unsigned short)v) << 16); }
__device__ __forceinline__ bf16x4 pack4(float a, float b, float c, float d) {
  bf16x4 o; o[0] = (short)f2bf(a); o[1] = (short)f2bf(b); o[2] = (short)f2bf(c); o[3] = (short)f2bf(d); return o;
}
__device__ __forceinline__ float sigmoidf_(float x) { return 1.f / (1.f + __expf(-x)); }
__device__ __forceinline__ float siluf_(float x) { return x / (1.f + __expf(-x)); }
__device__ __forceinline__ float softplusf_(float x) { return x > 20.f ? x : log1pf(__expf(x)); }
__device__ __forceinline__ float wave_sum(float v) {
  v += __builtin_bit_cast(float, __builtin_amdgcn_update_dpp(0, __builtin_bit_cast(int, v), 0xB1, 0xF, 0xF, true));
  v += __builtin_bit_cast(float, __builtin_amdgcn_update_dpp(0, __builtin_bit_cast(int, v), 0x4E, 0xF, 0xF, true));
  v += __builtin_bit_cast(float, __builtin_amdgcn_update_dpp(0, __builtin_bit_cast(int, v), 0x141, 0xF, 0xF, true));
  v += __builtin_bit_cast(float, __builtin_amdgcn_update_dpp(0, __builtin_bit_cast(int, v), 0x140, 0xF, 0xF, true));
  v += __builtin_bit_cast(float, __builtin_amdgcn_update_dpp(0, __builtin_bit_cast(int, v), 0x142, 0xA, 0xF, false));
  v += __builtin_bit_cast(float, __builtin_amdgcn_update_dpp(0, __builtin_bit_cast(int, v), 0x143, 0xC, 0xF, false));
  return __builtin_bit_cast(float, __builtin_amdgcn_readlane(__builtin_bit_cast(int, v), 63));
}
__device__ __forceinline__ float wave_max(float v) {
  v = fmaxf(v, __builtin_bit_cast(float, __builtin_amdgcn_update_dpp(0, __builtin_bit_cast(int, v), 0xB1, 0xF, 0xF, true)));
  v = fmaxf(v, __builtin_bit_cast(float, __builtin_amdgcn_update_dpp(0, __builtin_bit_cast(int, v), 0x4E, 0xF, 0xF, true)));
  v = fmaxf(v, __builtin_bit_cast(float, __builtin_amdgcn_update_dpp(0, __builtin_bit_cast(int, v), 0x141, 0xF, 0xF, true)));
  v = fmaxf(v, __builtin_bit_cast(float, __builtin_amdgcn_update_dpp(0, __builtin_bit_cast(int, v), 0x140, 0xF, 0xF, true)));
  const float r1 = __builtin_bit_cast(float, __builtin_amdgcn_readlane(__builtin_bit_cast(int, v), 0));
  const float r2 = __builtin_bit_cast(float, __builtin_amdgcn_readlane(__builtin_bit_cast(int, v), 16));
  const float r3 = __builtin_bit_cast(float, __builtin_amdgcn_readlane(__builtin_bit_cast(int, v), 32));
  const float r4 = __builtin_bit_cast(float, __builtin_amdgcn_readlane(__builtin_bit_cast(int, v), 48));
  return fmaxf(fmaxf(r1, r2), fmaxf(r3, r4));
}
__device__ __forceinline__ float shfl_xor_l(float v, int mask, int lane) {
  return __builtin_bit_cast(float, __builtin_amdgcn_ds_bpermute((lane ^ mask) << 2, __builtin_bit_cast(int, v)));
}
__device__ __forceinline__ int shfl_xor_li(int v, int mask, int lane) {
  return __builtin_amdgcn_ds_bpermute((lane ^ mask) << 2, v);
}
__device__ __forceinline__ float row16_sum(float v) {
  v += __builtin_bit_cast(float, __builtin_amdgcn_update_dpp(0, __builtin_bit_cast(int, v), 0xB1, 0xF, 0xF, true));
  v += __builtin_bit_cast(float, __builtin_amdgcn_update_dpp(0, __builtin_bit_cast(int, v), 0x4E, 0xF, 0xF, true));
  v += __builtin_bit_cast(float, __builtin_amdgcn_update_dpp(0, __builtin_bit_cast(int, v), 0x141, 0xF, 0xF, true));
  v += __builtin_bit_cast(float, __builtin_amdgcn_update_dpp(0, __builtin_bit_cast(int, v), 0x140, 0xF, 0xF, true));
  return v;
}
__device__ __forceinline__ int mod_row(int m) { return m < NLAT ? (m >> 14) : 2; }

__device__ __forceinline__ void phase_ada(PP pp, int bid, int nb, char* smem) {
  float* red = (float*)smem;
  float* mods = (float*)(p.ws + OFF_MODS);
  const int tid = tid_opaque();
  for (int task = bid; task < 2 * 96; task += nb) {
    int l = task / 96, cgp = task % 96;
    int col = cgp * 64 + (tid & 63), ks = tid >> 6;
    const float* W = p.ada_w + (size_t)l * 1024 * 6144;
    float a0 = 0.f, a1 = 0.f, a2 = 0.f;
    for (int d = ks * 128; d < ks * 128 + 128; ++d) {
      float w = W[(size_t)d * 6144 + col];
      a0 += siluf_(p.c[d]) * w;
      a1 += siluf_(p.c[1024 + d]) * w;
      a2 += siluf_(p.c_ctx[d]) * w;
    }
    red[(ks * 3 + 0) * 64 + (tid & 63)] = a0;
    red[(ks * 3 + 1) * 64 + (tid & 63)] = a1;
    red[(ks * 3 + 2) * 64 + (tid & 63)] = a2;
    __syncthreads();
    if (tid < 192) {
      int r = tid >> 6, cc = tid & 63;
      float s = 0.f;
      for (int k = 0; k < 8; ++k) s += red[(k * 3 + r) * 64 + cc];
      mods[(size_t)(l * 3 + r) * 6144 + cgp * 64 + cc] = s + p.ada_b[(size_t)l * 6144 + cgp * 64 + cc];
    }
    __syncthreads();
  }
}

__device__ __forceinline__ void convert_tile(const float* src, int N, bfr* dst, int kt, int nt, int mode, float* tile  ) {
  const int tid = tid_opaque();
#pragma unroll
  for (int q = 0; q < 2; ++q) {
    int idx = tid + q * 512;
    int kk = idx >> 4, n4 = idx & 15;
    int n = nt * 64 + n4 * 4;
    float4 v = make_float4(0.f, 0.f, 0.f, 0.f);
    if (n < N) v = *(const float4*)(src + (size_t)(kt * 64 + kk) * N + n);
    tile[kk * 65 + n4 * 4 + 0] = v.x;
    tile[kk * 65 + n4 * 4 + 1] = v.y;
    tile[kk * 65 + n4 * 4 + 2] = v.z;
    tile[kk * 65 + n4 * 4 + 3] = v.w;
  }
  __syncthreads();
  {
    int nn = tid >> 3, kc = tid & 7;
    int n = nt * 64 + nn;
    int row = n;
    if (mode == 1) { int j = n & 1023; row = (j >> 4) * 32 + (j & 15) + ((n >= 1024) ? 16 : 0); }
    bf16x8 o;
#pragma unroll
    for (int j = 0; j < 8; ++j) o[j] = (short)f2bf(tile[(kc * 8 + j) * 65 + nn]);
    *(bf16x8*)(dst + (size_t)row * 1024 + kt * 64 + kc * 8) = o;
  }
  __syncthreads();
}
__device__ __forceinline__ void convert_gu_i8(const float* src  , signed char* dst  , float* sw  , int ng, char* smem) {
  const int tid = tid_opaque();
  bfr* blk = (bfr*)smem;
  int* cmax = (int*)(smem + 131072);
  if (tid < 64) cmax[tid] = 0;
  __syncthreads();
  {
    const int n4 = tid & 15, kk0 = tid >> 4;
    float m0 = 0.f, m1 = 0.f, m2 = 0.f, m3 = 0.f;
#pragma unroll 4
    for (int ps = 0; ps < 32; ++ps) {
      const int k = ps * 32 + kk0;
      const float4 v = *(const float4*)(src + (size_t)k * 2048 + ng * 64 + n4 * 4);
      m0 = fmaxf(m0, fabsf(v.x)); m1 = fmaxf(m1, fabsf(v.y)); m2 = fmaxf(m2, fabsf(v.z)); m3 = fmaxf(m3, fabsf(v.w));
      *(bf16x4*)(blk + k * 64 + n4 * 4) = pack4(v.x, v.y, v.z, v.w);
    }
    atomicMax(&cmax[n4 * 4 + 0], __float_as_int(m0)); atomicMax(&cmax[n4 * 4 + 1], __float_as_int(m1));
    atomicMax(&cmax[n4 * 4 + 2], __float_as_int(m2)); atomicMax(&cmax[n4 * 4 + 3], __float_as_int(m3));
  }
  __syncthreads();
  {
    const int nn = tid >> 3, kc = tid & 7;
    const int n = ng * 64 + nn;
    const float am = __int_as_float(cmax[nn]);
    const float sc = am > 0.f ? am * (1.f / 127.f) : 1.f, iv = 1.f / sc;
    const int j = n & 1023;
    const int row = (j >> 4) * 32 + (j & 15) + ((n >= 1024) ? 16 : 0);
    if (kc == 0) sw[n] = sc;
#pragma unroll 2
    for (int q = 0; q < 8; ++q) {
      const int k0 = (kc + 8 * q) * 16;
      unsigned w[4];
#pragma unroll
      for (int g4 = 0; g4 < 4; ++g4) {
        unsigned acc = 0u;
#pragma unroll
        for (int b = 0; b < 4; ++b) {
          const float v = bf2f((short)blk[(k0 + g4 * 4 + b) * 64 + nn]);
          const int qi = (int)fminf(fmaxf(rintf(v * iv), -127.f), 127.f);
          acc |= ((unsigned)(qi & 0xff)) << (8 * b);
        }
        w[g4] = acc;
      }
      *(uint4*)(dst + (size_t)row * 1024 + k0) = make_uint4(w[0], w[1], w[2], w[3]);
    }
  }
  __syncthreads();
}
__device__ __forceinline__ void phase_convert(PP pp, int l, int bid, int nb, char* smem) {
  float* tile = (float*)smem;
  char* wl = p.ws + OFF_W + (size_t)l * WL_SIZE;
  const int T_IN = 16 * 56, T_OUT = 16 * 16, T_GU = 32 * 32, T_DN = 32 * 16 * 16;
  const int total = T_IN + T_OUT + T_GU + T_DN;
  for (int t = bid; t < total; t += nb) {
    if (t < T_IN) {
      int kt = t / 56, nt = t % 56;
      convert_tile(p.w_in + (size_t)l * 1024 * PIN, PIN, (bfr*)(wl + WL_IN), kt, nt, 0, tile);
    } else if (t < T_IN + T_OUT) {
      int u = t - T_IN; int kt = u / 16, nt = u % 16;
      convert_tile(p.w_out + (size_t)l * 1024 * 1024, 1024, (bfr*)(wl + WL_OUT), kt, nt, 0, tile);
    } else if (t < T_IN + T_OUT + T_GU) {
      int u = t - T_IN - T_OUT; int e = u / 32, ng = u % 32;
      convert_gu_i8(p.moe_w_gu + ((size_t)l * 32 + e) * 1024 * 2048, (signed char*)(wl + WL_GU) + (size_t)e * 2048 * 1024,
                    (float*)(p.ws + OFF_SW) + ((size_t)l * 32 + e) * 2048, ng, smem);
    } else {
      int u = t - T_IN - T_OUT - T_GU; int e = u / 256; int v = u % 256; int kt = v / 16, nt = v % 16;
      convert_tile(p.moe_w_down + ((size_t)l * 32 + e) * 1024 * 1024, 1024, (bfr*)(wl + WL_DN) + (size_t)e * 1024 * 1024, kt, nt, 0, tile);
    }
  }
}

__device__ __forceinline__ void phase_prenorm(PP pp, int l, int bid, int nb) {
  const int tid = tid_opaque(), lane = tid & 63, wv = wave_id(tid);
  const float* xl = (l == 0) ? p.x : p.out;
  const float* xc = (l == 0) ? p.ctx : (const float*)(p.ws + OFF_CTX);
  const float* mods = (const float*)(p.ws + OFF_MODS) + (size_t)l * 3 * 6144;
  const float* g = p.norm_mix_g + (size_t)l * 1024;
  bfr* H = (bfr*)(p.ws + OFF_H);
  {
    int* cnt = (int*)(p.ws + OFF_CNT);
    int gt = bid * NTHR + tid;
    if (gt < 32) cnt[gt] = 0;
  }
  for (int m = bid * 8 + wv; m < NTOK; m += nb * 8) {
    const float* xr = (m < NLAT) ? xl + (size_t)m * 1024 : xc + (size_t)(m - NLAT) * 1024;
    const float* md = mods + (size_t)mod_row(m) * 6144;
    float4 v[4];
    float ss = 0.f;
#pragma unroll
    for (int i = 0; i < 4; ++i) {
      v[i] = *(const float4*)(xr + (lane + 64 * i) * 4);
      ss += v[i].x * v[i].x + v[i].y * v[i].y + v[i].z * v[i].z + v[i].w * v[i].w;
    }
    ss = wave_sum(ss);
    float rs = rsqrtf(ss * (1.f / 1024.f) + 1e-6f);
#pragma unroll
    for (int i = 0; i < 4; ++i) {
      int d = (lane + 64 * i) * 4;
      float4 gg = *(const float4*)(g + d);
      float4 sh = *(const float4*)(md + d);
      float4 sc = *(const float4*)(md + 1024 + d);
      bf16x4 o;
      o[0] = (short)f2bf(v[i].x * rs * gg.x * (1.f + sc.x) + sh.x);
      o[1] = (short)f2bf(v[i].y * rs * gg.y * (1.f + sc.y) + sh.y);
      o[2] = (short)f2bf(v[i].z * rs * gg.z * (1.f + sc.z) + sh.z);
      o[3] = (short)f2bf(v[i].w * rs * gg.w * (1.f + sc.w) + sh.w);
      *(bf16x4*)(H + (size_t)m * 1024 + d) = o;
    }
  }
}

#define LAS __attribute__((address_space(3)))
namespace g8 {
constexpr int BM = 256, BK = 64, HALF = 128, HTB = HALF * BK * 2, STAGE_BYTES = 8 * HTB, KD = 1024;
__device__ __forceinline__ int lds_byte(int r, int c) { const int st = (r >> 4) * 2 + (c >> 5), rr = r & 15, cc = c & 31, ob = rr * 64 + cc * 2; return st * 1024 + (ob ^ (((ob >> 9) & 1) << 5)); }
__device__ __forceinline__ void stage_rc(int b, int& R, int& C) { const int st = b / 1024, sb = b % 1024, swz = sb ^ (((sb >> 9) & 1) << 5); R = (st >> 1) * 16 + swz / 64; C = (st & 1) * 32 + (swz % 64) / 2; }
struct GUnit { int pm, pn, brow0, e; };
__device__ __forceinline__ int unit_index(int i, int c, int G, int total) {
  const int x = c & 7, j = c >> 3, q = total >> 3, r = total & 7;
  const int start = x < r ? x * (q + 1) : r * (q + 1) + (x - r) * q;
  const int size = q + (x < r ? 1 : 0);
  const int li = i * (G >> 3) + j;
  return li < size ? start + li : -1;
}

__device__ __forceinline__ f32x4 mma16(bf16x8 a, bf16x8 b, f32x4 c) { return __builtin_amdgcn_mfma_f32_16x16x32_bf16(a, b, c, 0, 0, 0); }
__device__ __forceinline__ i32x4 mma16(i32x4 a, i32x4 b, i32x4 c) { return __builtin_amdgcn_mfma_i32_16x16x64_i8(a, b, c, 0, 0, 0); }
template <bool I8, class Sched, class Epi>
__device__ __forceinline__ void gemm_stream(LAS unsigned char* lds, const void* Abase, const void* Btbase, const Sched& S, const Epi& E) {
  typedef typename std::conditional<I8, i32x4, f32x4>::type AccT;
  typedef typename std::conditional<I8, i32x4, bf16x8>::type FragT;
  constexpr int KB = I8 ? KD : KD * 2;
  const int tid = tid_opaque(), wid = __builtin_amdgcn_readfirstlane(tid >> 6), lane = tid & 63, wr = wid >> 2, wc = wid & 3, fr = lane & 15, fq = lane >> 4;
  constexpr int nt = KB / 128;
  int R[2], C[2];
  unsigned voffB[2];
#pragma unroll
  for (int i = 0; i < 2; ++i) { stage_rc(tid * 16 + i * 8192, R[i], C[i]); voffB[i] = (unsigned)(R[i] * KB + C[i] * 2); }
#define voffA voffB
  constexpr size_t kstep = (size_t)(BK * 2);
  constexpr size_t hstep = (size_t)HALF * KB;
  const unsigned ldsw = (unsigned)wid * 1024u;
  const int aoff = lds_byte(wr * 64 + fr, fq * 8), boff = lds_byte(wc * 32 + fr, fq * 8);
#define G8_SA(b, h) (((b) * 2 + (h)) * HTB)
#define G8_SB(b, h) ((4 + (b) * 2 + (h)) * HTB)
#define G8_STAGE(bufoff, gbase, v0, v1) do { \
    __builtin_amdgcn_global_load_lds((const unsigned*)((const char*)(gbase) + (v0)), (LAS unsigned*)(lds + (bufoff) + ldsw), 16, 0, 0); \
    __builtin_amdgcn_global_load_lds((const unsigned*)((const char*)(gbase) + (v1)), (LAS unsigned*)(lds + (bufoff) + ldsw + 8192), 16, 0, 0); } while (0)
#define G8_STAGEB(bufoff, gbase) G8_STAGE(bufoff, gbase, voffB[0], voffB[1])
#define G8_STAGEA(bufoff, gbase) G8_STAGE(bufoff, gbase, voffA[0], voffA[1])
#define G8_LDA(dst, b, h) do { _Pragma("unroll") for (int m = 0; m < 4; ++m) _Pragma("unroll") for (int k = 0; k < 2; ++k) dst[m][k] = *(const LAS FragT*)(lds + G8_SA(b, h) + aoff + m * 2048 + k * 1024); } while (0)
#define G8_LDB(dst, b, h) do { _Pragma("unroll") for (int n = 0; n < 2; ++n) _Pragma("unroll") for (int k = 0; k < 2; ++k) dst[n][k] = *(const LAS FragT*)(lds + G8_SB(b, h) + boff + n * 2048 + k * 1024); } while (0)
#define G8_MMA(ai, bj, At, Bt) do { __builtin_amdgcn_s_setprio(1); _Pragma("unroll") for (int m = 0; m < 4; ++m) _Pragma("unroll") for (int n = 0; n < 2; ++n) _Pragma("unroll") for (int k = 0; k < 2; ++k) \
    acc[ai][bj][m][n] = mma16(Bt[n][k], At[m][k], acc[ai][bj][m][n]); __builtin_amdgcn_s_setprio(0); } while (0)
#define G8_WAIT_V(n) asm volatile("s_waitcnt vmcnt(" #n ")" ::: "memory")
#define G8_WAIT_L(n) asm volatile("s_waitcnt lgkmcnt(" #n ")" ::: "memory")
#define G8_BAR __builtin_amdgcn_s_barrier()
#define G8_SCHED __builtin_amdgcn_sched_barrier(0)
  GUnit cur, nxt;
  int ui = 0;
  if (!S.next(0, cur)) return;
  AccT acc[2][2][4][2];
#pragma unroll
  for (int a = 0; a < 2; ++a)
#pragma unroll
    for (int b = 0; b < 2; ++b)
#pragma unroll
      for (int m = 0; m < 4; ++m)
#pragma unroll
        for (int n = 0; n < 2; ++n) acc[a][b][m][n] = AccT{};
  FragT At[4][2], B0[2][2], B1[2][2];
  const char* cA = (const char*)Abase + (size_t)cur.pm * (BM * KB);
  const char* cB = (const char*)Btbase + (size_t)cur.brow0 * KB;
  G8_STAGEB(G8_SB(0, 0), cB); G8_STAGEA(G8_SA(0, 0), cA); G8_STAGEB(G8_SB(0, 1), cB + hstep); G8_STAGEA(G8_SA(0, 1), cA + hstep);
  if (wr == 1) G8_BAR;
  G8_WAIT_V(4); G8_BAR;
  G8_STAGEB(G8_SB(1, 0), cB + kstep); G8_STAGEA(G8_SA(1, 0), cA + kstep); G8_STAGEB(G8_SB(1, 1), cB + hstep + kstep);
  G8_WAIT_V(6); G8_BAR;
  for (;;) {
    const bool has_next = S.next(ui + 1, nxt);
    const char* nA = has_next ? (const char*)Abase + (size_t)nxt.pm * (BM * KB) : cA;
    const char* nB = has_next ? (const char*)Btbase + (size_t)nxt.brow0 * KB : cB;
#pragma unroll 1
    for (int t = 0; t < nt; t += 2) {
      const bool last = (t == nt - 2);
      const char* a1 = cA + (size_t)(t + 1) * kstep;
      const char* a2 = last ? nA : cA + (size_t)(t + 2) * kstep;
      const char* b2 = last ? nB : cB + (size_t)(t + 2) * kstep;
      const char* a3 = a2 + kstep;
      const char* b3 = b2 + kstep;
      G8_LDB(B0, 0, 0); G8_SCHED; G8_LDA(At, 0, 0); G8_STAGEA(G8_SA(1, 1), a1 + hstep);
      G8_WAIT_L(8); G8_BAR; G8_WAIT_L(0); G8_MMA(0, 0, At, B0); G8_BAR; G8_SCHED;
      G8_LDB(B1, 0, 1); G8_STAGEB(G8_SB(0, 0), b2);
      G8_BAR; G8_WAIT_L(0); G8_MMA(0, 1, At, B1); G8_BAR;
      G8_LDA(At, 0, 1); G8_STAGEA(G8_SA(0, 0), a2);
      G8_BAR; G8_WAIT_L(0); G8_MMA(1, 0, At, B0); G8_BAR; G8_SCHED;
      G8_STAGEB(G8_SB(0, 1), b2 + hstep);
      G8_WAIT_V(6); G8_BAR; G8_MMA(1, 1, At, B1); G8_BAR;
      G8_LDB(B0, 1, 0); G8_SCHED; G8_LDA(At, 1, 0); G8_STAGEA(G8_SA(0, 1), a2 + hstep);
      G8_WAIT_L(8); G8_BAR; G8_WAIT_L(0); G8_MMA(0, 0, At, B0); G8_BAR; G8_SCHED;
      G8_LDB(B1, 1, 1); G8_STAGEB(G8_SB(1, 0), b3);
      G8_BAR; G8_WAIT_L(0); G8_MMA(0, 1, At, B1); G8_BAR;
      G8_LDA(At, 1, 1); G8_STAGEA(G8_SA(1, 0), a3);
      G8_BAR; G8_WAIT_L(0); G8_MMA(1, 0, At, B0); G8_BAR; G8_SCHED;
      G8_STAGEB(G8_SB(1, 1), b3 + hstep);
      G8_WAIT_V(6); G8_BAR; G8_MMA(1, 1, At, B1); G8_BAR;
    }
    E(acc, cur, wr, wc, fr, fq);
    if (!has_next) break;
#pragma unroll
    for (int a = 0; a < 2; ++a)
#pragma unroll
      for (int b = 0; b < 2; ++b)
#pragma unroll
        for (int m = 0; m < 4; ++m)
#pragma unroll
          for (int n = 0; n < 2; ++n) acc[a][b][m][n] = AccT{};
    cur = nxt; cA = nA; cB = nB; ++ui;
  }
  G8_WAIT_V(0);
  if (wr == 0) G8_BAR;
  G8_BAR;
#undef G8_SA
#undef G8_SB
#undef G8_STAGE
#undef G8_STAGEB
#undef G8_STAGEA
#undef voffA
#undef G8_LDA
#undef G8_LDB
#undef G8_MMA
#undef G8_WAIT_V
#undef G8_WAIT_L
#undef G8_BAR
#undef G8_SCHED
}

struct DenseSched {
  int nM, nN, G, c;
  __device__ __forceinline__ bool next(int i, GUnit& u) const {
    const int idx = unit_index(i, c, G, nM * nN);
    if (idx < 0) return false;
    u.pm = idx / nN; u.pn = idx - u.pm * nN; u.brow0 = u.pn * BM; u.e = 0;
    return true;
  }
};
struct MoeSched {
  const int* toff; int nN, NE, G, c;
  __device__ __forceinline__ bool next(int i, GUnit& u) const {
    const int idx = unit_index(i, c, G, toff[32] * nN);
    if (idx < 0) return false;
    u.pm = idx / nN; u.pn = idx - u.pm * nN;
    int e = 0;
#pragma unroll 1
    for (int k = 1; k < 32; ++k) e = (u.pm >= toff[k]) ? k : e;
    u.e = e; u.brow0 = e * NE + u.pn * BM;
    return true;
  }
};
}

struct EpiInProj {
  float* P;
  __device__ __forceinline__ void operator()(const f32x4 (&acc)[2][2][4][2], const g8::GUnit& u, int wr, int wc, int fr, int fq) const {
    const int row0 = u.pm * 256 + wr * 64 + fr, col0 = u.pn * 256 + wc * 32 + 4 * fq;
#pragma unroll
    for (int ai = 0; ai < 2; ++ai)
#pragma unroll
      for (int m = 0; m < 4; ++m) {
        float* rowp = P + (size_t)(row0 + ai * 128 + m * 16) * PINP + col0;
#pragma unroll
        for (int bj = 0; bj < 2; ++bj)
#pragma unroll
          for (int n = 0; n < 2; ++n) *(f32x4*)(rowp + bj * 128 + n * 16) = acc[ai][bj][m][n];
      }
  }
};
__device__ __forceinline__ void phase_gemm_in(PP pp, int l, int bid, int nb, char* smem) {
  g8::DenseSched S{130, 14, nb, bid};
  EpiInProj E{(float*)(p.ws + OFF_P)};
  g8::gemm_stream<false>((LAS unsigned char*)smem, p.ws + OFF_H, p.ws + OFF_W + (size_t)l * WL_SIZE + WL_IN, S, E);
}

struct EpiOutProj {
  const float *xl, *xc, *mods; float *ol, *oc;
  __device__ __forceinline__ void operator()(const f32x4 (&acc)[2][2][4][2], const g8::GUnit& u, int wr, int wc, int fr, int fq) const {
    const bool lat = u.pm < 128;
    const float* xin = lat ? xl + (size_t)u.pm * 256 * 1024 : xc + (size_t)(u.pm - 128) * 256 * 1024;
    float* xo = lat ? ol + (size_t)u.pm * 256 * 1024 : oc + (size_t)(u.pm - 128) * 256 * 1024;
    const float* g1 = mods + (size_t)(lat ? (u.pm >> 6) : 2) * 6144 + 2048;
    const int row0 = wr * 64 + fr, col0 = u.pn * 256 + wc * 32 + 4 * fq;
#pragma unroll
    for (int bj = 0; bj < 2; ++bj)
#pragma unroll
      for (int n = 0; n < 2; ++n) {
        const f32x4 gv = *(const f32x4*)(g1 + col0 + bj * 128 + n * 16);
#pragma unroll
        for (int ai = 0; ai < 2; ++ai)
#pragma unroll
          for (int m = 0; m < 4; ++m) {
            const size_t o = (size_t)(row0 + ai * 128 + m * 16) * 1024 + col0 + bj * 128 + n * 16;
            const f32x4 xv = *(const f32x4*)(xin + o);
            *(f32x4*)(xo + o) = xv + gv * acc[ai][bj][m][n];
            if (m & 1) asm volatile("" ::: "memory");
          }
      }
  }
};
__device__ __forceinline__ void phase_gemm_out(PP pp, int l, int bid, int nb, char* smem) {
  g8::DenseSched S{(l == 0) ? 130 : 128, 4, nb, bid};
  EpiOutProj E{(l == 0) ? p.x : p.out, (l == 0) ? p.ctx : (const float*)(p.ws + OFF_CTX),
               (const float*)(p.ws + OFF_MODS) + (size_t)l * 3 * 6144, p.out, (float*)(p.ws + OFF_CTX)};
  g8::gemm_stream<false>((LAS unsigned char*)smem, p.ws + OFF_CC, p.ws + OFF_W + (size_t)l * WL_SIZE + WL_OUT, S, E);
}

#define LBAR() do { asm volatile("s_waitcnt lgkmcnt(0)" ::: "memory"); __builtin_amdgcn_s_barrier(); asm volatile("" ::: "memory"); } while (0)
__device__ __forceinline__ void phase_prep(PP pp, int l, int bid, int nb, char* smem) {
  const int tid = tid_opaque(), lane = tid & 63, wv = wave_id(tid);
  const float* P = (const float*)(p.ws + OFF_P);
  char* S = p.ws + OFF_S;
  bfr* QN = (bfr*)(S + S_QN);
  bfr* KN = (bfr*)(S + S_KN);
  bfr* VT = (bfr*)(S + S_VT);
  float* RWR = (float*)(S + S_RWR);
  float* RWKK = (float*)(S + S_RWKK);
  float* RWV = (float*)(S + S_RWV);
  float* RWG = (float*)(S + S_RWG);
  float* RWW = (float*)(S + S_RWW);
  float* RWKD = (float*)(S + S_RWKD);
  float* RWB = (float*)(S + S_RWB);
  float* BON = (float*)(S + S_BON);
  float* GDQ = (float*)(S + S_GDQ);
  float* GDK = (float*)(S + S_GDK);
  float* GDV = (float*)(S + S_GDV);
  float* GDAB = (float*)(S + S_GDAB);
  const float* mu = p.rw_mu + (size_t)l * 896;
  const float* w0 = p.rw_w0 + (size_t)l * 512;
  const float* w_up = p.rw_w_up + (size_t)l * 2 * 32 * 256;
  const float* a0 = p.rw_a0 + (size_t)l * 512;
  const float* a_up = p.rw_a_up + (size_t)l * 2 * 32 * 256;
  const float* g_up = p.rw_g_up + (size_t)l * 64 * 256;
  const float* k_k = p.rw_k_k + (size_t)l * 256;
  const float* k_a = p.rw_k_a + (size_t)l * 256;
  const float* r_k = p.rw_r_k + (size_t)l * 256;
  const float* conv_w = p.gd_conv_w + (size_t)l * 5 * 768;
  const float* A_log = p.gd_A_log + (size_t)l * 8;
  const float* dt_bias = p.gd_dt_bias + (size_t)l * 8;
  const float* qg = p.na_q_gain + (size_t)l * 64;
  const float* kg = p.na_k_gain + (size_t)l * 64;

  bfr* wl = (bfr*)smem;
  float* lor = (float*)(smem + 192 * 256 * 2);
  __syncthreads();
  for (int i = tid; i < 192 * 256; i += NTHR) {
    const int row = i >> 8, c = i & 255;
    const float v = row < 64 ? g_up[row * 256 + c] : row < 128 ? w_up[(row - 64) * 256 + c] : a_up[(row - 128) * 256 + c];
    wl[i] = f2bf(v);
  }
  __syncthreads();
  const int c = tid & 255, th = tid >> 8;
  const int h = c >> 6;
  const float kkc = k_k[c], kac = k_a[c], rkc = r_k[c];
  const float w00 = w0[c], w01 = w0[256 + c], a00 = a0[c], a01 = a0[256 + c];
  const float mur = mu[c], muk = mu[256 + c], muv = mu[512 + c];
  const float mul = (tid < 128) ? mu[768 + tid] : 0.f;
  const int nsecA = wv, nsecB = wv + 8;

  for (int tile = bid; tile < NTOK / 16; tile += nb) {
    const int m0 = tile * 16;
    int seq_lo, seq_hi, bb, tau0;
    if (m0 < NLAT) { bb = m0 >> 14; seq_lo = bb << 14; seq_hi = seq_lo + SEQ; tau0 = m0 - seq_lo; }
    else { bb = (m0 - NLAT) >> 8; seq_lo = NLAT + (bb << 8); seq_hi = seq_lo + CTXL; tau0 = SEQ + (m0 - seq_lo); }

    float pr[3][10], pl[18];
#pragma unroll
    for (int j = 0; j < 3; ++j)
#pragma unroll
      for (int t = 0; t < 10; ++t) {
        const int m = m0 + th * 8 - 1 + t;
        pr[j][t] = (m >= seq_lo && m < seq_hi) ? P[(size_t)m * PINP + A_END + j * 256 + c] : 0.f;
      }
    if (tid < 128) {
#pragma unroll
      for (int t = 0; t < 18; ++t) {
        const int m = m0 - 1 + t;
        pl[t] = (m >= seq_lo && m < seq_hi) ? P[(size_t)m * PINP + A_END + 768 + tid] : 0.f;
      }
#pragma unroll
      for (int t = 0; t < 16; ++t) {
        const float cur = pl[t + 1];
        const float v = cur + mul * (0.5f * (pl[t] + pl[t + 2]) - cur);
        lor[tid * 16 + t] = tid < 32 ? tanhf(v) : tid < 64 ? v : sigmoidf_(v);
      }
    }
    float rr[8], rk[8], rv[8];
#pragma unroll
    for (int t = 0; t < 8; ++t) {
      rr[t] = pr[0][t + 1] + mur * (0.5f * (pr[0][t] + pr[0][t + 2]) - pr[0][t + 1]);
      rk[t] = pr[1][t + 1] + muk * (0.5f * (pr[1][t] + pr[1][t + 2]) - pr[1][t + 1]);
      rv[t] = pr[2][t + 1] + muv * (0.5f * (pr[2][t] + pr[2][t + 2]) - pr[2][t + 1]);
    }
    LBAR();
    float pgA[20], pgB[20];
    {
      const int cA = nsecA * 64 + lane, cB = nsecB * 64 + lane;
#pragma unroll
      for (int t = 0; t < 20; ++t) {
        const int m = m0 - 2 + t;
        const bool ok = (m >= seq_lo && m < seq_hi);
        pgA[t] = ok ? P[(size_t)m * PINP + B_END + cA] : 0.f;
        pgB[t] = (ok && nsecB < 12) ? P[(size_t)m * PINP + B_END + cB] : 0.f;
      }
    }
    asm volatile("" ::: "memory");
#pragma unroll 1
    for (int ps = 0; ps < 2; ++ps) {
      const int tb = th * 8 + ps * 4;
      float4 gacc = make_float4(0.f, 0.f, 0.f, 0.f), wa0 = gacc, wa1 = gacc, aa0 = gacc, aa1 = gacc;
#pragma unroll 8
      for (int j = 0; j < 64; ++j) {
        const float wgt = __uint_as_float(((unsigned)wl[j * 256 + c]) << 16);
        const float4 s0 = *(const float4*)(lor + (64 + j) * 16 + tb);
        gacc.x += s0.x * wgt; gacc.y += s0.y * wgt; gacc.z += s0.z * wgt; gacc.w += s0.w * wgt;
      }
#pragma unroll 8
      for (int j = 0; j < 32; ++j) {
        const float4 t0 = *(const float4*)(lor + j * 16 + tb);
        const float4 d0 = *(const float4*)(lor + (32 + j) * 16 + tb);
        const float ww0 = __uint_as_float(((unsigned)wl[(64 + j) * 256 + c]) << 16), ww1 = __uint_as_float(((unsigned)wl[(96 + j) * 256 + c]) << 16);
        const float aw0 = __uint_as_float(((unsigned)wl[(128 + j) * 256 + c]) << 16), aw1 = __uint_as_float(((unsigned)wl[(160 + j) * 256 + c]) << 16);
        wa0.x += t0.x * ww0; wa0.y += t0.y * ww0; wa0.z += t0.z * ww0; wa0.w += t0.w * ww0;
        wa1.x += t0.x * ww1; wa1.y += t0.y * ww1; wa1.z += t0.z * ww1; wa1.w += t0.w * ww1;
        aa0.x += d0.x * aw0; aa0.y += d0.y * aw0; aa0.z += d0.z * aw0; aa0.w += d0.w * aw0;
        aa1.x += d0.x * aw1; aa1.y += d0.y * aw1; aa1.z += d0.z * aw1; aa1.w += d0.w * aw1;
      }
#pragma unroll
      for (int t = 0; t < 4; ++t) {
        const int tt = ps * 4 + t;
        const int m = m0 + th * 8 + tt;
        const float gv = t == 0 ? gacc.x : t == 1 ? gacc.y : t == 2 ? gacc.z : gacc.w;
        const float wv0 = t == 0 ? wa0.x : t == 1 ? wa0.y : t == 2 ? wa0.z : wa0.w;
        const float wv1 = t == 0 ? wa1.x : t == 1 ? wa1.y : t == 2 ? wa1.z : wa1.w;
        const float av0 = t == 0 ? aa0.x : t == 1 ? aa0.y : t == 2 ? aa0.z : aa0.w;
        const float av1 = t == 0 ? aa1.x : t == 1 ? aa1.y : t == 2 ? aa1.z : aa1.w;
        const float r = ps == 0 ? rr[t] : rr[4 + t], k = ps == 0 ? rk[t] : rk[4 + t], v = ps == 0 ? rv[t] : rv[4 + t];
        const float kkraw = k * kkc;
        const float ssum = wave_sum(kkraw * kkraw);
        const float kk = kkraw * rsqrtf(ssum + 1e-6f);
        float bon = 0.f;
#pragma unroll
        for (int d = 0; d < 2; ++d) {
          const float wlin = (d == 0 ? w00 + wv0 : w01 + wv1);
          const float w_log = -softplusf_(-wlin) - 0.5f;
          const float a = sigmoidf_(d == 0 ? a00 + av0 : a01 + av1);
          const float kd = k * (1.f + (a - 1.f) * kac);
          bon += r * kd * rkc;
          const size_t o = ((size_t)d * NTOK + m) * 256 + c;
          RWW[o] = -__expf(w_log); RWKD[o] = kd; RWB[o] = kk * a;
        }
        bon = wave_sum(bon);
        const size_t o = (size_t)m * 256 + c;
        RWR[o] = r; RWKK[o] = kk; RWV[o] = v; RWG[o] = gv;
        if (lane == 0) BON[(size_t)m * 4 + h] = bon;
      }
    }
    float pnA[16], pnB[16], pvt[16];
#pragma unroll
    for (int t = 0; t < 16; ++t) {
      pnA[t] = P[(size_t)(m0 + t) * PINP + nsecA * 64 + lane];
      pnB[t] = P[(size_t)(m0 + t) * PINP + nsecB * 64 + lane];
      pvt[t] = P[(size_t)(m0 + t) * PINP + 1024 + tid];
    }
    asm volatile("" ::: "memory");
#pragma unroll
    for (int q = 0; q < 2; ++q) {
      const int sec = q ? nsecB : nsecA;
      if (sec < 12) {
        const int cg = sec * 64 + lane;
        float cw[5];
#pragma unroll
        for (int j = 0; j < 5; ++j) cw[j] = conv_w[j * 768 + cg];
#pragma unroll
        for (int t = 0; t < 16; ++t) {
          float acc = 0.f;
#pragma unroll
          for (int j = 0; j < 5; ++j) acc += cw[j] * (q ? pgB[t + j] : pgA[t + j]);
          float val = siluf_(acc);
          const int m = m0 + t;
          if (sec < 8) {
            const float ss = wave_sum(val * val);
            val *= rsqrtf(ss + 1e-6f);
            if (sec < 4) GDQ[(size_t)m * 256 + sec * 64 + lane] = val * 0.125f;
            else GDK[(size_t)m * 256 + (sec - 4) * 64 + lane] = val;
          } else GDV[(size_t)m * 256 + (sec - 8) * 64 + lane] = val;
        }
      }
    }
    if (tid < 256) {
      const int t = tid >> 4, j = tid & 15;
      const int m = m0 + t;
      const float pv = P[(size_t)m * PINP + B_END + 1024 + j];
      float o;
      if (j < 8) o = -__expf(A_log[j]) * softplusf_(pv + dt_bias[j]);
      else o = sigmoidf_(pv);
      GDAB[(size_t)m * 16 + j] = o;
    }
#pragma unroll
    for (int q = 0; q < 2; ++q) {
      const int hs = q ? nsecB : nsecA;
#pragma unroll
      for (int t = 0; t < 16; ++t) {
        float val = q ? pnB[t] : pnA[t];
        const float ss = wave_sum(val * val);
        val *= rsqrtf(ss * (1.f / 64.f) + 1e-6f);
        const int m = m0 + t;
        if (hs < 8) QN[(size_t)m * 512 + hs * 64 + lane] = f2bf(val * qg[lane] * (0.125f * 1.4426950408889634f));
        else KN[(size_t)m * 512 + (hs - 8) * 64 + lane] = f2bf(val * kg[lane]);
      }
    }
    {
      bf16x8 o0, o1;
#pragma unroll
      for (int t = 0; t < 8; ++t) { o0[t] = (short)f2bf(pvt[t]); o1[t] = (short)f2bf(pvt[8 + t]); }
      bfr* dst = VT + ((size_t)(bb * 8 + (tid >> 6)) * (TTOK / 16) + (tau0 >> 4)) * 1024 + (tid & 63) * 16;
      *(bf16x8*)dst = o0;
      *(bf16x8*)(dst + 8) = o1;
    }
    LBAR();
  }
  __syncthreads();
}

__device__ __forceinline__ int scan_tok(int b, int d, int s) {
  if (s < CTXL) { int t = d ? (CTXL - 1 - s) : s; return NLAT + b * CTXL + t; }
  int u = s - CTXL; int t = d ? (SEQ - 1 - u) : u; return b * SEQ + t;
}
#define CS 72
#define SLOT_BYTES (64 * CS * 2)
#define F0_STRIDE 68
#define X1_F0 (13 * SLOT_BYTES)
#define X1_ARR (X1_F0 + 64 * F0_STRIDE * 4)

#define MM_FRAGS(As, Bs, a0, a1, b00, b01, b10, b11)                                                     \
  const bf16x8 a0 = *(const bf16x8*)((As) + ((mt * 16 + fr) * CS + fq * 8) * 2);                         \
  const bf16x8 a1 = *(const bf16x8*)((As) + ((mt * 16 + fr) * CS + 32 + fq * 8) * 2);                    \
  const bf16x8 b00 = *(const bf16x8*)((Bs) + ((nt0 * 16 + fr) * CS + fq * 8) * 2);                       \
  const bf16x8 b01 = *(const bf16x8*)((Bs) + ((nt0 * 16 + fr) * CS + 32 + fq * 8) * 2);                  \
  const bf16x8 b10 = *(const bf16x8*)((Bs) + ((nt0 * 16 + 16 + fr) * CS + fq * 8) * 2);                  \
  const bf16x8 b11 = *(const bf16x8*)((Bs) + ((nt0 * 16 + 16 + fr) * CS + 32 + fq * 8) * 2);
#define MM_2TILES(acc0, acc1, a0, a1, b00, b01, b10, b11)                                                \
  acc0 = __builtin_amdgcn_mfma_f32_16x16x32_bf16(a0, b00, acc0, 0, 0, 0);                                \
  acc0 = __builtin_amdgcn_mfma_f32_16x16x32_bf16(a1, b01, acc0, 0, 0, 0);                                \
  acc1 = __builtin_amdgcn_mfma_f32_16x16x32_bf16(a0, b10, acc1, 0, 0, 0);                                \
  acc1 = __builtin_amdgcn_mfma_f32_16x16x32_bf16(a1, b11, acc1, 0, 0, 0);
__device__ __forceinline__ void wr_T(char* slot, int mt, int nt, int fr, int fq, f32x4 v) {
  *(bf16x4*)(slot + ((nt * 16 + fr) * CS + mt * 16 + 4 * fq) * 2) = pack4(v[0], v[1], v[2], v[3]);
}

struct ChunkIn { float lw[8], f0[8], f1[8], f2[8], f3[8], xv[8], be[8]; };
template <bool GDN>
__device__ __forceinline__ void chunk_load(PP pp, int t, ChunkIn& ci) {
  const int tid = tid_opaque(), c = tid & 63, tg = wave_id(tid);
  const int chain = t / NCHUNK, n = t - chain * NCHUNK;
  const int d = chain & 1, h = (chain >> 1) & 3, b = (chain >> 3) & 1;
  const char* S = p.ws + OFF_S;
#pragma unroll
  for (int u = 0; u < 8; ++u) {
    const int m = scan_tok(b, d, n * 64 + tg * 8 + u);
    const size_t o = (size_t)m * 256 + h * 64 + c;
    if (!GDN) {
      ci.lw[u] = ((const float*)(S + S_RWW))[(size_t)d * NTOK * 256 + o];
      ci.f0[u] = ((const float*)(S + S_RWKK))[o];
      ci.f1[u] = ((const float*)(S + S_RWB))[(size_t)d * NTOK * 256 + o];
      ci.f2[u] = ((const float*)(S + S_RWKD))[(size_t)d * NTOK * 256 + o];
      ci.f3[u] = ((const float*)(S + S_RWR))[o];
      ci.xv[u] = ((const float*)(S + S_RWV))[o];
      ci.be[u] = 1.f;
    } else {
      ci.lw[u] = ((const float*)(S + S_GDAB))[(size_t)m * 16 + d * 4 + h];
      ci.be[u] = ((const float*)(S + S_GDAB))[(size_t)m * 16 + 8 + d * 4 + h];
      ci.f0[u] = ((const float*)(S + S_GDK))[o];
      ci.f3[u] = ((const float*)(S + S_GDQ))[o];
      ci.xv[u] = ((const float*)(S + S_GDV))[o];
      ci.f1[u] = 0.f; ci.f2[u] = 0.f;
    }
  }
}
template <bool GDN>
__device__ __forceinline__ void chunk_prep_task(PP pp, int t, int t_next, bool has_next, const ChunkIn& ci, ChunkIn& nx, char* smem) {
  const int chain = t / NCHUNK, n = t - chain * NCHUNK;
  const int d = chain & 1, h = (chain >> 1) & 3, b = (chain >> 3) & 1;
  (void)b; (void)d; (void)h;
  const int tid = tid_opaque(), lane = tid & 63, wv = wave_id(tid);
  const int fr = lane & 15, fq = lane >> 4, mt = wv >> 1, nt0 = (wv & 1) * 2;
  char* S = p.ws + OFF_S;
  char* CH = p.ws + OFF_CH;
  const size_t cc = (size_t)chain * NCHUNK + n;
  char* const p0 = smem;
  char* const p1 = smem + 1 * SLOT_BYTES;
  char* const p2 = smem + 2 * SLOT_BYTES;
  char* const p3 = smem + 3 * SLOT_BYTES;
  char* const p4 = smem + 4 * SLOT_BYTES;
  char* const p5 = smem + 5 * SLOT_BYTES;
  char* const p6 = smem + 6 * SLOT_BYTES;
  char* const p7 = smem + 7 * SLOT_BYTES;
  char* const p8 = smem + 8 * SLOT_BYTES;
  char* const p9 = smem + 9 * SLOT_BYTES;
  char* const p10 = smem + 10 * SLOT_BYTES;
  char* const p11 = smem + 11 * SLOT_BYTES;
  char* const p12 = smem + 12 * SLOT_BYTES;
  float* const F0 = (float*)(smem + X1_F0);
  float* const Lv = (float*)(smem + X1_ARR);
  float* const Lm1v = Lv + 64;
  float* const betav = Lv + 128;
  float* const eLv = Lv + 192;
  float* const gC = Lv + 256;
  float* const gsum = Lv + 320;
  char* const sKt = p0;
  char* const sBh = GDN ? p0 : p1;
  char* const sKh = GDN ? p0 : p2;

  {
    const int c = lane, tg = wv;
    const float* lw = ci.lw; const float* f0 = ci.f0; const float* f1 = ci.f1; const float* f2 = ci.f2; const float* f3 = ci.f3; const float* xv = ci.xv; const float* be = ci.be;
    float cum[8];
    cum[0] = lw[0];
#pragma unroll
    for (int u = 1; u < 8; ++u) cum[u] = cum[u - 1] + lw[u];
    gsum[tg * 64 + c] = cum[7];
    LBAR();
    float off = 0.f, LC = 0.f;
#pragma unroll
    for (int g2 = 0; g2 < 8; ++g2) { const float gs = gsum[g2 * 64 + c]; LC += gs; off += (g2 < tg) ? gs : 0.f; }
    bf16x8 vKtT, vBbT, vKbT, vXT;
#pragma unroll
    for (int u = 0; u < 8; ++u) {
      const int t = tg * 8 + u;
      const float L = off + cum[u], Lm1 = L - lw[u];
      if (!GDN) {
        const float eLm1 = __expf(Lm1), enL = __expf(-L), eL = __expf(L), eCL = __expf(LC - L);
        const float kt = f0[u] * eLm1;
        *(bfr*)(p0 + (t * CS + c) * 2) = f2bf(kt);
        *(bfr*)(p1 + (t * CS + c) * 2) = f2bf(f1[u] * enL);
        *(bfr*)(p2 + (t * CS + c) * 2) = f2bf(f2[u] * enL);
        *(bfr*)(p3 + (t * CS + c) * 2) = f2bf(f3[u] * eL);
        vKtT[u] = (short)f2bf(kt);
        vBbT[u] = (short)f2bf(f1[u] * eCL);
        vKbT[u] = (short)f2bf(f2[u] * eCL);
        vXT[u] = (short)f2bf(xv[u]);
      } else {
        *(bfr*)(p0 + (t * CS + c) * 2) = f2bf(f0[u]);
        *(bfr*)(p3 + (t * CS + c) * 2) = f2bf(f3[u]);
        vKtT[u] = (short)f2bf(f0[u] * __expf(Lm1));
        vBbT[u] = (short)f2bf(be[u] * f0[u] * __expf(LC - Lm1));
        vKbT[u] = (short)f2bf(f0[u] * __expf(LC - L));
        vXT[u] = (short)f2bf(be[u] * xv[u]);
        if (c == 0) { Lv[t] = L; Lm1v[t] = Lm1; betav[t] = be[u]; eLv[t] = __expf(L); }
      }
    }
    *(bf16x8*)(p4 + (c * CS + tg * 8) * 2) = vKtT;
    *(bf16x8*)(p5 + (c * CS + tg * 8) * 2) = vBbT;
    *(bf16x8*)(p6 + (c * CS + tg * 8) * 2) = vKbT;
    *(bf16x8*)(p7 + (c * CS + tg * 8) * 2) = vXT;
    if (tg == 0) gC[c] = __expf(LC);
    if (!GDN && tid < 64) { Lv[tid] = 0.f; Lm1v[tid] = 0.f; betav[tid] = 1.f; eLv[tid] = 1.f; }
  }
  LBAR();
  if (has_next) chunk_load<GDN>(pp, t_next, nx);
  {
    {
      MM_FRAGS(sKt, sBh, a0, a1, b00, b01, b10, b11)
      f32x4 c0 = {0.f, 0.f, 0.f, 0.f}, c1 = c0;
      MM_2TILES(c0, c1, a0, a1, b00, b01, b10, b11)
#pragma unroll
      for (int q = 0; q < 2; ++q) {
        const int sI = (nt0 + q) * 16 + fr;
        const f32x4 cv = q ? c1 : c0;
        f32x4 o;
#pragma unroll
        for (int r = 0; r < 4; ++r) {
          const int tI = mt * 16 + 4 * fq + r;
          float v = cv[r];
          if (GDN) v *= betav[sI] * __expf(fminf(Lm1v[tI] - Lm1v[sI], 0.f));
          o[r] = (sI < tI) ? v : 0.f;
        }
        *(f32x4*)(F0 + sI * F0_STRIDE + mt * 16 + 4 * fq) = o;
        wr_T(p11, mt, nt0 + q, fr, fq, o);
      }
    }
    {
      MM_FRAGS(sKt, sKh, a0, a1, b00, b01, b10, b11)
      f32x4 c0 = {0.f, 0.f, 0.f, 0.f}, c1 = c0;
      MM_2TILES(c0, c1, a0, a1, b00, b01, b10, b11)
#pragma unroll
      for (int q = 0; q < 2; ++q) {
        const int sI = (nt0 + q) * 16 + fr;
        const f32x4 cv = q ? c1 : c0;
        f32x4 o;
#pragma unroll
        for (int r = 0; r < 4; ++r) {
          const int tI = mt * 16 + 4 * fq + r;
          float v = cv[r];
          if (GDN) v *= __expf(fminf(Lm1v[tI] - Lv[sI], 0.f));
          o[r] = (sI < tI) ? v : 0.f;
        }
        wr_T(p9, mt, nt0 + q, fr, fq, o);
      }
    }
    {
      MM_FRAGS(sBh, p3, a0, a1, b00, b01, b10, b11)
      f32x4 c0 = {0.f, 0.f, 0.f, 0.f}, c1 = c0;
      MM_2TILES(c0, c1, a0, a1, b00, b01, b10, b11)
#pragma unroll
      for (int q = 0; q < 2; ++q) {
        const int tI = (nt0 + q) * 16 + fr;
        const f32x4 cv = q ? c1 : c0;
        f32x4 o;
#pragma unroll
        for (int r = 0; r < 4; ++r) {
          const int sI = mt * 16 + 4 * fq + r;
          float v = cv[r];
          if (GDN) v *= betav[sI] * __expf(fminf(Lv[tI] - Lm1v[sI], 0.f));
          o[r] = (sI <= tI) ? v : 0.f;
        }
        wr_T(p10, mt, nt0 + q, fr, fq, o);
      }
    }
  }
  LBAR();
  if (wv < 2) {
    const int base = wv * 32, other = 32 - base, c = lane & 31;
    float tr[32];
#pragma unroll
    for (int j = 0; j < 32; ++j) tr[j] = 0.f;
#pragma unroll
    for (int i = 31; i >= 0; --i) {
      float a0 = (c == i) ? 1.f : 0.f, a1 = 0.f, a2 = 0.f, a3 = 0.f;
#pragma unroll
      for (int jb = ((i + 1) & ~3); jb < 32; jb += 4) {
        const f32x4 a4 = *(const f32x4*)(F0 + (base + i) * F0_STRIDE + base + jb);
        a0 -= a4[0] * tr[jb]; a1 -= a4[1] * tr[jb + 1]; a2 -= a4[2] * tr[jb + 2]; a3 -= a4[3] * tr[jb + 3];
      }
      const float acc = (a0 + a1) + (a2 + a3);
      tr[i] = acc;
      if (lane < 32) {
        *(bfr*)(p8 + ((base + i) * CS + base + c) * 2) = f2bf(acc);
        *(bfr*)(p8 + ((base + i) * CS + other + c) * 2) = (bfr)0;
      }
    }
    if (lane < 32) {
#pragma unroll
      for (int q = 0; q < 4; ++q) {
        bf16x8 o, z;
#pragma unroll
        for (int j = 0; j < 8; ++j) { o[j] = (short)f2bf(tr[8 * q + j]); z[j] = 0; }
        *(bf16x8*)(p12 + ((base + c) * CS + base + 8 * q) * 2) = o;
        *(bf16x8*)(p12 + ((base + c) * CS + other + 8 * q) * 2) = z;
      }
    }
  }
  LBAR();
  {
    MM_FRAGS(p11, p12, a0, a1, b00, b01, b10, b11)
    f32x4 c0 = {0.f, 0.f, 0.f, 0.f}, c1 = c0;
    MM_2TILES(c0, c1, a0, a1, b00, b01, b10, b11)
    wr_T(p1, mt, nt0, fr, fq, c0);
    wr_T(p1, mt, nt0 + 1, fr, fq, c1);
  }
  LBAR();
  if (mt < 2 && nt0 == 2) {
    MM_FRAGS(p8, p1, a0, a1, b00, b01, b10, b11)
    f32x4 c0 = {0.f, 0.f, 0.f, 0.f}, c1 = c0;
    MM_2TILES(c0, c1, a0, a1, b00, b01, b10, b11)
#pragma unroll
    for (int r = 0; r < 4; ++r) {
      *(bfr*)(p8 + ((mt * 16 + 4 * fq + r) * CS + (nt0) * 16 + fr) * 2) = f2bf(-c0[r]);
      *(bfr*)(p8 + ((mt * 16 + 4 * fq + r) * CS + (nt0 + 1) * 16 + fr) * 2) = f2bf(-c1[r]);
    }
  }
  LBAR();
  {
    {
      MM_FRAGS(p8, p5, a0, a1, b00, b01, b10, b11)
      f32x4 c0 = {0.f, 0.f, 0.f, 0.f}, c1 = c0;
      MM_2TILES(c0, c1, a0, a1, b00, b01, b10, b11)
      wr_T(p11, mt, nt0, fr, fq, -c0);
      wr_T(p11, mt, nt0 + 1, fr, fq, -c1);
    }
    {
      MM_FRAGS(p8, p10, a0, a1, b00, b01, b10, b11)
      f32x4 c0 = {0.f, 0.f, 0.f, 0.f}, c1 = c0;
      MM_2TILES(c0, c1, a0, a1, b00, b01, b10, b11)
      wr_T(p12, mt, nt0, fr, fq, -c0);
      wr_T(p12, mt, nt0 + 1, fr, fq, -c1);
    }
  }
  LBAR();
  {
    {
      MM_FRAGS(p4, p11, a0, a1, b00, b01, b10, b11)
      f32x4 c0 = {0.f, 0.f, 0.f, 0.f}, c1 = c0;
      MM_2TILES(c0, c1, a0, a1, b00, b01, b10, b11)
#pragma unroll
      for (int q = 0; q < 2; ++q) {
        const int cp = (nt0 + q) * 16 + fr;
        f32x4 cv = q ? c1 : c0;
#pragma unroll
        for (int r = 0; r < 4; ++r) { const int cI = mt * 16 + 4 * fq + r; if (cI == cp) cv[r] += gC[cI]; }
        wr_T(p10, mt, nt0 + q, fr, fq, cv);
      }
    }
    {
      MM_FRAGS(p9, p11, a0, a1, b00, b01, b10, b11)
      f32x4 c0 = {0.f, 0.f, 0.f, 0.f}, c1 = c0;
      MM_2TILES(c0, c1, a0, a1, b00, b01, b10, b11)
#pragma unroll
      for (int q = 0; q < 2; ++q) {
        const int cp = (nt0 + q) * 16 + fr;
        f32x4 cv = q ? c1 : c0;
        const bf16x4 kb = *(const bf16x4*)(p6 + (cp * CS + mt * 16 + 4 * fq) * 2);
#pragma unroll
        for (int r = 0; r < 4; ++r) cv[r] += __uint_as_float(((unsigned)(unsigned short)kb[r]) << 16);
        wr_T(p8, mt, nt0 + q, fr, fq, cv);
      }
    }
    {
      MM_FRAGS(p4, p12, a0, a1, b00, b01, b10, b11)
      f32x4 c0 = {0.f, 0.f, 0.f, 0.f}, c1 = c0;
      MM_2TILES(c0, c1, a0, a1, b00, b01, b10, b11)
#pragma unroll
      for (int q = 0; q < 2; ++q) {
        const int tI = (nt0 + q) * 16 + fr;
        f32x4 cv = q ? c1 : c0;
        const bf16x4 rt = *(const bf16x4*)(p3 + (tI * CS + mt * 16 + 4 * fq) * 2);
        const float el = eLv[tI];
#pragma unroll
        for (int r = 0; r < 4; ++r) cv[r] += __uint_as_float(((unsigned)(unsigned short)rt[r]) << 16) * el;
        wr_T(p1, mt, nt0 + q, fr, fq, cv);
      }
    }
    {
      f32x4 c0 = {0.f, 0.f, 0.f, 0.f}, c1 = c0;
      {
        MM_FRAGS(sKh, p3, a0, a1, b00, b01, b10, b11)
        MM_2TILES(c0, c1, a0, a1, b00, b01, b10, b11)
      }
#pragma unroll
      for (int q = 0; q < 2; ++q) {
        const int tI = (nt0 + q) * 16 + fr;
#pragma unroll
        for (int r = 0; r < 4; ++r) {
          const int sI = mt * 16 + 4 * fq + r;
          float v = q ? c1[r] : c0[r];
          if (GDN) v *= __expf(fminf(Lv[tI] - Lv[sI], 0.f));
          v = (sI <= tI) ? v : 0.f;
          if (q) c1[r] = v; else c0[r] = v;
        }
      }
      {
        MM_FRAGS(p9, p12, a0, a1, b00, b01, b10, b11)
        MM_2TILES(c0, c1, a0, a1, b00, b01, b10, b11)
      }
      wr_T(p5, mt, nt0, fr, fq, c0);
      wr_T(p5, mt, nt0 + 1, fr, fq, c1);
    }
  }
  LBAR();
  {
    {
      MM_FRAGS(p8, p7, a0, a1, b00, b01, b10, b11)
      f32x4 c0 = {0.f, 0.f, 0.f, 0.f}, c1 = c0;
      MM_2TILES(c0, c1, a0, a1, b00, b01, b10, b11)
      bfr* QT = (bfr*)(CH + cc * CH_REC + CH_QT);
      *(bf16x4*)(QT + ((mt * 4 + nt0) * 64 + lane) * 4) = pack4(c0[0], c0[1], c0[2], c0[3]);
      *(bf16x4*)(QT + ((mt * 4 + nt0 + 1) * 64 + lane) * 4) = pack4(c1[0], c1[1], c1[2], c1[3]);
    }
    {
      MM_FRAGS(p7, p5, a0, a1, b00, b01, b10, b11)
      f32x4 c0 = {0.f, 0.f, 0.f, 0.f}, c1 = c0;
      MM_2TILES(c0, c1, a0, a1, b00, b01, b10, b11)
      bfr* YX = (bfr*)(CH + cc * CH_REC + CH_YX);
      *(bf16x4*)(YX + ((mt * 4 + nt0) * 64 + lane) * 4) = pack4(c0[0], c0[1], c0[2], c0[3]);
      *(bf16x4*)(YX + ((mt * 4 + nt0 + 1) * 64 + lane) * 4) = pack4(c1[0], c1[1], c1[2], c1[3]);
    }
    {
      const int fm = wv >> 1, fa = wv & 1;
      const int row = fm * 16 + fr;
      {
        const bf16x4 lo = *(const bf16x4*)(p10 + (row * CS + 32 * fa + 4 * fq) * 2);
        const bf16x4 hi = *(const bf16x4*)(p10 + (row * CS + 32 * fa + 16 + 4 * fq) * 2);
        bf16x8 f; f[0] = lo[0]; f[1] = lo[1]; f[2] = lo[2]; f[3] = lo[3]; f[4] = hi[0]; f[5] = hi[1]; f[6] = hi[2]; f[7] = hi[3];
        *(bf16x8*)(CH + cc * CH_REC + CH_PT + (size_t)((fm * 2 + fa) * 64 + lane) * 16) = f;
      }
      {
        const bf16x4 lo = *(const bf16x4*)(p1 + (row * CS + 32 * fa + 4 * fq) * 2);
        const bf16x4 hi = *(const bf16x4*)(p1 + (row * CS + 32 * fa + 16 + 4 * fq) * 2);
        bf16x8 f; f[0] = lo[0]; f[1] = lo[1]; f[2] = lo[2]; f[3] = lo[3]; f[4] = hi[0]; f[5] = hi[1]; f[6] = hi[2]; f[7] = hi[3];
        *(bf16x8*)(CH + cc * CH_REC + CH_RYT + (size_t)((fm * 2 + fa) * 64 + lane) * 16) = f;
      }
    }
  }
  LBAR();
}

template <bool GDN>
__device__ __forceinline__ void chunk_prep_loop(PP pp, int t0, int tend, int nb, char* smem) {
  ChunkIn cur, nxt;
  if (t0 < tend) chunk_load<GDN>(pp, t0, cur);
  for (int t = t0; t < tend; t += nb) {
    const bool has_next = (t + nb) < tend;
    chunk_prep_task<GDN>(pp, t, t + nb, has_next, cur, nxt, smem);
    cur = nxt;
  }
}
__device__ __forceinline__ void phase_chunk_prep(PP pp, int bid, int nb, char* smem) {
  __syncthreads();
  const int half = (NCHAIN / 2) * NCHUNK;
  chunk_prep_loop<false>(pp, bid, half, nb, smem);
  const int k0 = (half - bid + nb - 1) / nb;
  chunk_prep_loop<true>(pp, bid + k0 * nb, NCHAIN * NCHUNK, nb, smem);
  __syncthreads();
}

#define X2_BUF 32768
#define X2_BAR() do { asm volatile("s_waitcnt lgkmcnt(0)" ::: "memory"); __builtin_amdgcn_s_barrier(); asm volatile("" ::: "memory"); } while (0)
__device__ __forceinline__ void chunk_seq_chain(PP pp, int chain, char* smem) {
  __syncthreads();
  const int tid = tid_opaque(), lane = tid & 63, wv = wave_id(tid);
  const int d = chain & 1, h = (chain >> 1) & 3, b = (chain >> 3) & 1, ty = chain >> 4;
  const char* CH = p.ws + OFF_CH;
  float* Y = (float*)(p.ws + OFF_S + (ty ? S_YGD : S_YRW)) + (size_t)d * NTOK * 256;
  const size_t c0 = (size_t)chain * NCHUNK;
  if (wv >= 4) {
    const int lw = wv - 4;
    const char* src0 = CH + c0 * CH_REC + (size_t)lane * 16;
#define X2_DMA(n) { const char* s_ = src0 + (size_t)(n) * CH_REC; LAS unsigned char* d_ = (LAS unsigned char*)smem + ((n) & 3) * X2_BUF;       \
      _Pragma("unroll") for (int i = 0; i < 8; ++i) {                                                                                       \
        const int piece = i * 4 + lw;                                                                                                       \
        __builtin_amdgcn_global_load_lds((const unsigned*)(s_ + piece * 1024), (LAS unsigned*)(d_ + piece * 1024), 16, 0, 0); } }
    X2_DMA(0) X2_DMA(1) X2_DMA(2)
    asm volatile("s_waitcnt vmcnt(16)" ::: "memory");
    X2_BAR();
    for (int n = 0; n < NCHUNK; ++n) {
      if (n + 3 < NCHUNK) { X2_DMA(n + 3) asm volatile("s_waitcnt vmcnt(16)" ::: "memory"); }
      else if (n + 2 < NCHUNK) asm volatile("s_waitcnt vmcnt(8)" ::: "memory");
      else asm volatile("s_waitcnt vmcnt(0)" ::: "memory");
      X2_BAR();
    }
#undef X2_DMA
  } else {
    const int vt = wv, fr = lane & 15, fq = lane >> 4;
    f32x4 Sacc[4];
#pragma unroll
    for (int i = 0; i < 4; ++i) Sacc[i] = (f32x4){0.f, 0.f, 0.f, 0.f};
    X2_BAR();
    for (int n = 0; n < NCHUNK; ++n) {
      const char* buf = smem + (n & 3) * X2_BUF;
      bf16x8 sB0, sB1;
#pragma unroll
      for (int j = 0; j < 4; ++j) {
        sB0[j] = (short)f2bf(Sacc[0][j]); sB0[4 + j] = (short)f2bf(Sacc[1][j]);
        sB1[j] = (short)f2bf(Sacc[2][j]); sB1[4 + j] = (short)f2bf(Sacc[3][j]);
      }
#pragma unroll
      for (int m = 0; m < 4; ++m) {
        const bf16x8 pa0 = *(const bf16x8*)(buf + ((m * 2 + 0) * 64 + lane) * 16);
        const bf16x8 pa1 = *(const bf16x8*)(buf + ((m * 2 + 1) * 64 + lane) * 16);
        const bf16x8 ra0 = *(const bf16x8*)(buf + 8192 + ((m * 2 + 0) * 64 + lane) * 16);
        const bf16x8 ra1 = *(const bf16x8*)(buf + 8192 + ((m * 2 + 1) * 64 + lane) * 16);
        const bf16x4 qb = *(const bf16x4*)(buf + 16384 + ((m * 4 + vt) * 64 + lane) * 8);
        const bf16x4 yb = *(const bf16x4*)(buf + 24576 + ((vt * 4 + m) * 64 + lane) * 8);
        f32x4 y = {bf2f(yb[0]), bf2f(yb[1]), bf2f(yb[2]), bf2f(yb[3])};
        y = __builtin_amdgcn_mfma_f32_16x16x32_bf16(sB0, ra0, y, 0, 0, 0);
        y = __builtin_amdgcn_mfma_f32_16x16x32_bf16(sB1, ra1, y, 0, 0, 0);
        f32x4 sn = {bf2f(qb[0]), bf2f(qb[1]), bf2f(qb[2]), bf2f(qb[3])};
        sn = __builtin_amdgcn_mfma_f32_16x16x32_bf16(pa0, sB0, sn, 0, 0, 0);
        sn = __builtin_amdgcn_mfma_f32_16x16x32_bf16(pa1, sB1, sn, 0, 0, 0);
        Sacc[m] = sn;
        {
          const int mm = scan_tok(b, d, n * 64 + m * 16 + fr);
          *(f32x4*)(Y + (size_t)mm * 256 + h * 64 + vt * 16 + 4 * fq) = y;
        }
      }
      X2_BAR();
    }
  }
}

struct NaPair { int mk0, mk1, tau0, tau1, kr0, kr1, ct0, ct1; };
struct NaFrag { bf16x8 k00, k01, k10, k11; bf16x4 v0[4], v1[4]; };

__device__ __forceinline__ void na_load(NaFrag& f, const bfr* KN, const bfr* VT, size_t vt_base, int h, int fr, int fq, const NaPair& pr) {
  const bfr* k0 = KN + (size_t)(pr.mk0 + fr) * 512 + h * 64 + fq * 8;
  const bfr* k1 = KN + (size_t)(pr.mk1 + fr) * 512 + h * 64 + fq * 8;
  f.k00 = *(const bf16x8*)(k0); f.k01 = *(const bf16x8*)(k0 + 32);
  f.k10 = *(const bf16x8*)(k1); f.k11 = *(const bf16x8*)(k1 + 32);
#pragma unroll
  for (int dt = 0; dt < 4; ++dt) {
    const int vo = (dt * 16 + fr) * 16 + fq * 4;
    f.v0[dt] = *(const bf16x4*)(VT + vt_base + (size_t)(pr.tau0 >> 4) * 1024 + vo);
    f.v1[dt] = *(const bf16x4*)(VT + vt_base + (size_t)(pr.tau1 >> 4) * 1024 + vo);
  }
}

__device__ __forceinline__ void na_compute(const NaFrag& f, const bf16x8 qf0, const bf16x8 qf1, bool local, bool vr0, bool vr1,
                                           int dr0, int dr1, int ct0, int ct1, int qc, int fq, const float* bias_h, f32x4 (&O)[4], float& lsum) {
  f32x4 z = {0.f, 0.f, 0.f, 0.f};
  f32x4 st0 = __builtin_amdgcn_mfma_f32_16x16x32_bf16(f.k00, qf0, z, 0, 0, 0);
  st0 = __builtin_amdgcn_mfma_f32_16x16x32_bf16(f.k01, qf1, st0, 0, 0, 0);
  f32x4 st1 = __builtin_amdgcn_mfma_f32_16x16x32_bf16(f.k10, qf0, z, 0, 0, 0);
  st1 = __builtin_amdgcn_mfma_f32_16x16x32_bf16(f.k11, qf1, st1, 0, 0, 0);
  bf16x8 pf;
  if (local) {
    const int cs = min(max(qc - 8, 0), 48);
#pragma unroll
    for (int r = 0; r < 4; ++r) {
      const int kc0 = ct0 * 16 + fq * 4 + r, kc1 = ct1 * 16 + fq * 4 + r;
      float p0 = 0.f, p1 = 0.f;
      if (vr0 && (unsigned)(kc0 - cs) < 16u) p0 = exp2f(st0[r] + bias_h[dr0 * 31 + (kc0 - qc + 15)]);
      if (vr1 && (unsigned)(kc1 - cs) < 16u) p1 = exp2f(st1[r] + bias_h[dr1 * 31 + (kc1 - qc + 15)]);
      lsum += p0 + p1;
      pf[r] = (short)f2bf(p0);
      pf[4 + r] = (short)f2bf(p1);
    }
  } else {
#pragma unroll
    for (int r = 0; r < 4; ++r) {
      const float p0 = exp2f(st0[r]), p1 = exp2f(st1[r]);
      lsum += p0 + p1;
      pf[r] = (short)f2bf(p0);
      pf[4 + r] = (short)f2bf(p1);
    }
  }
#pragma unroll
  for (int dt = 0; dt < 4; ++dt) {
    bf16x8 vf;
    vf[0] = f.v0[dt][0]; vf[1] = f.v0[dt][1]; vf[2] = f.v0[dt][2]; vf[3] = f.v0[dt][3];
    vf[4] = f.v1[dt][0]; vf[5] = f.v1[dt][1]; vf[6] = f.v1[dt][2]; vf[7] = f.v1[dt][3];
    O[dt] = __builtin_amdgcn_mfma_f32_16x16x32_bf16(vf, pf, O[dt], 0, 0, 0);
  }
}

__device__ __forceinline__ void na_block_task(PP pp, int task, const float* bias_lds) {
  const int tid = tid_opaque(), lane = tid & 63, wv = wave_id(tid);
  const int fr = lane & 15, fq = lane >> 4;
  char* S = p.ws + OFF_S;
  const bfr* QN = (const bfr*)(S + S_QN);
  const bfr* KN = (const bfr*)(S + S_KN);
  const bfr* VT = (const bfr*)(S + S_VT);
  bfr* CC = (bfr*)(p.ws + OFF_CC);
  const bool latent = task < 1024;
  int b, h, mqa, mqb, qra = 0, qrb = 0, cgp = 0;
  if (latent) {
    h = task & 7; const int quad = (task >> 3) & 63; b = task >> 9;
    qra = quad * 4 + (wv >> 2) * 2; qrb = qra + 1; cgp = wv & 3;
    mqa = b * SEQ + qra * 64 + cgp * 16; mqb = mqa + 64;
  } else {
    const int u = task - 1024;
    h = u & 7; b = u >> 3;
    mqa = NLAT + b * CTXL + (wv * 2) * 16; mqb = mqa + 16;
  }
  const bf16x8 qa0 = *(const bf16x8*)(QN + (size_t)(mqa + fr) * 512 + h * 64 + fq * 8);
  const bf16x8 qa1 = *(const bf16x8*)(QN + (size_t)(mqa + fr) * 512 + h * 64 + 32 + fq * 8);
  const bf16x8 qb0 = *(const bf16x8*)(QN + (size_t)(mqb + fr) * 512 + h * 64 + fq * 8);
  const bf16x8 qb1 = *(const bf16x8*)(QN + (size_t)(mqb + fr) * 512 + h * 64 + 32 + fq * 8);
  f32x4 Oa[4], Ob[4];
#pragma unroll
  for (int dt = 0; dt < 4; ++dt) { Oa[dt] = (f32x4){0.f, 0.f, 0.f, 0.f}; Ob[dt] = Oa[dt]; }
  float lsa = 0.f, lsb = 0.f;
  const size_t vt_base = (size_t)(b * 8 + h) * 64 * TTOK;
  const int rsa = min(max(qra - 4, 0), SEQ / 64 - 8), rsb = min(max(qrb - 4, 0), SEQ / 64 - 8);
  const int nrows = latent ? (rsb - rsa + 8) : 0;
  const int ct_first = (cgp <= 1) ? 0 : cgp - 1;
  const int nct = (cgp == 0 || cgp == 3) ? 2 : 3;
  const int ntile = nrows * nct;
  const int nlp = (ntile + 1) >> 1;
  const int npair = nlp + 8;
  const int qc = cgp * 16 + fr;
  auto mkpair = [&](int pi) {
    NaPair pr;
    if (pi < nlp) {
      const int i0 = 2 * pi, i1 = min(2 * pi + 1, ntile - 1);
      pr.kr0 = rsa + i0 / nct; pr.ct0 = ct_first + i0 % nct;
      pr.kr1 = rsa + i1 / nct; pr.ct1 = ct_first + i1 % nct;
      if (2 * pi + 1 >= ntile) pr.kr1 = -100;
      const int r1 = rsa + i1 / nct;
      pr.tau0 = pr.kr0 * 64 + pr.ct0 * 16; pr.tau1 = r1 * 64 + pr.ct1 * 16;
      pr.mk0 = b * SEQ + pr.tau0; pr.mk1 = b * SEQ + pr.tau1;
    } else {
      const int c = pi - nlp;
      pr.kr0 = pr.kr1 = pr.ct0 = pr.ct1 = 0;
      pr.tau0 = SEQ + c * 32; pr.tau1 = SEQ + c * 32 + 16;
      pr.mk0 = NLAT + b * CTXL + c * 32; pr.mk1 = pr.mk0 + 16;
    }
    return pr;
  };
  NaFrag fa, fb;
  NaPair pa = mkpair(0), pb;
  na_load(fa, KN, VT, vt_base, h, fr, fq, pa);
  const float* bias_h = bias_lds + h * 465;
#define NA_DO(F, PR, PI)                                                                                          \
  {                                                                                                               \
    const bool loc_ = (PI) < nlp;                                                                                 \
    na_compute(F, qa0, qa1, loc_, (unsigned)(PR.kr0 - rsa) < 8u, (unsigned)(PR.kr1 - rsa) < 8u,                   \
               PR.kr0 - qra + 7, PR.kr1 - qra + 7, PR.ct0, PR.ct1, qc, fq, bias_h, Oa, lsa);                      \
    na_compute(F, qb0, qb1, loc_, (unsigned)(PR.kr0 - rsb) < 8u, (unsigned)(PR.kr1 - rsb) < 8u,                   \
               PR.kr0 - qrb + 7, PR.kr1 - qrb + 7, PR.ct0, PR.ct1, qc, fq, bias_h, Ob, lsb);                      \
  }
  for (int pi = 0; pi < npair; pi += 2) {
    if (pi + 1 < npair) { pb = mkpair(pi + 1); na_load(fb, KN, VT, vt_base, h, fr, fq, pb); }
    NA_DO(fa, pa, pi)
    if (pi + 1 < npair) {
      if (pi + 2 < npair) { pa = mkpair(pi + 2); na_load(fa, KN, VT, vt_base, h, fr, fq, pa); }
      NA_DO(fb, pb, pi + 1)
    }
  }
#undef NA_DO
  lsa += shfl_xor_l(lsa, 16, lane); lsa += shfl_xor_l(lsa, 32, lane);
  lsb += shfl_xor_l(lsb, 16, lane); lsb += shfl_xor_l(lsb, 32, lane);
  const float ia = 1.f / lsa, ib = 1.f / lsb;
#pragma unroll
  for (int dt = 0; dt < 4; ++dt) {
    *(bf16x4*)(CC + (size_t)(mqa + fr) * 1024 + h * 64 + dt * 16 + fq * 4) = pack4(Oa[dt][0] * ia, Oa[dt][1] * ia, Oa[dt][2] * ia, Oa[dt][3] * ia);
    *(bf16x4*)(CC + (size_t)(mqb + fr) * 1024 + h * 64 + dt * 16 + fq * 4) = pack4(Ob[dt][0] * ib, Ob[dt][1] * ib, Ob[dt][2] * ib, Ob[dt][3] * ib);
  }
}

__device__ __forceinline__ void phase_mix(PP pp, int l, int bid, int nb, char* smem) {
  const int tid = tid_opaque();
  const int nscan_blocks = (nb > 32) ? 32 : nb;
  const int first_attn_block = (nb > 32) ? 32 : 0;
  if (bid < nscan_blocks) {
    for (int c = bid; c < NCHAIN; c += nscan_blocks) chunk_seq_chain(pp, c, smem);
  }
  if (bid >= first_attn_block) {
    float* bias = (float*)smem;
    __syncthreads();
    for (int i = tid; i < 8 * 465; i += NTHR) bias[i] = p.na_rpb[(size_t)l * 8 * 465 + i] * 1.4426950408889634f;
    __syncthreads();
    const int ntask = (l == 0) ? 1024 + 16 : 1024;
    const int nab = nb - first_attn_block;
    for (int t = bid - first_attn_block; t < ntask; t += nab) na_block_task(pp, t, bias);
  }
}

__device__ __forceinline__ void phase_post(PP pp, int l, int bid, int nb) {
  const int tid = tid_opaque(), lane = tid & 63, wv = wave_id(tid);
  char* S = p.ws + OFF_S;
  const float* YRW = (const float*)(S + S_YRW);
  const float* YGD = (const float*)(S + S_YGD);
  const float* RWV = (const float*)(S + S_RWV);
  const float* RWG = (const float*)(S + S_RWG);
  const float* BON = (const float*)(S + S_BON);
  const float* P = (const float*)(p.ws + OFF_P);
  bfr* CC = (bfr*)(p.ws + OFF_CC);
  const float* ln_w = p.rw_ln_w + (size_t)l * 256;
  const float* ln_b = p.rw_ln_b + (size_t)l * 256;
  const float* ng = p.gd_norm_g + (size_t)l * 64;
  const int ntok = (l == 0) ? NTOK : NLAT;
  for (int wt = bid * 8 + wv; wt < ntok * 8; wt += nb * 8) {
    int m = wt >> 3, hs = wt & 7;
    if (hs < 4) {
      int c = hs * 64 + lane;
      size_t o = (size_t)m * 256 + c;
      float y = YRW[o] + YRW[(size_t)NTOK * 256 + o];
      float mean = wave_sum(y) * (1.f / 64.f);
      float dv = y - mean;
      float var = wave_sum(dv * dv) * (1.f / 64.f);
      float yn = dv * rsqrtf(var + 64e-5f) * ln_w[c] + ln_b[c];
      float out = (yn + BON[(size_t)m * 4 + hs] * RWV[o]) * RWG[o];
      CC[(size_t)m * 1024 + 512 + c] = f2bf(out);
    } else {
      int c = (hs - 4) * 64 + lane;
      size_t o = (size_t)m * 256 + c;
      float y = YGD[o] + YGD[(size_t)NTOK * 256 + o];
      float ms = wave_sum(y * y) * (1.f / 64.f);
      float z = P[(size_t)m * PINP + B_END + 768 + c];
      float out = y * rsqrtf(ms + 1e-6f) * ng[lane] * siluf_(z);
      CC[(size_t)m * 1024 + 768 + c] = f2bf(out);
    }
  }
}

#define RW_LDS_ROW 36
__device__ __forceinline__ void phase_router(PP pp, int l, int bid, int nb, char* smem) {
  const int tid = tid_opaque(), lane = tid & 63, wv = wave_id(tid);
  const float* xl = p.out;
  const float* xc = (const float*)(p.ws + OFF_CTX);
  const float* mods = (const float*)(p.ws + OFF_MODS) + (size_t)l * 3 * 6144;
  const float* g = p.norm_ffn_g + (size_t)l * 1024;
  const float* rw = p.moe_router_w + (size_t)l * 1024 * 32;
  const float* rb = p.moe_router_b + (size_t)l * 32;
  bfr* H = (bfr*)(p.ws + OFF_H);
  int* cnt = (int*)(p.ws + OFF_CNT);
  int* TOKE = (int*)(p.ws + OFF_TOKE);
  int* TOKP = (int*)(p.ws + OFF_TOKP);
  float* TOKG = (float*)(p.ws + OFF_TOKG);
  float* wl = (float*)smem;
  for (int i = tid; i < 1024 * 8; i += NTHR) {
    int d = i >> 3, q = i & 7;
    *(float4*)(wl + d * RW_LDS_ROW + q * 4) = *(const float4*)(rw + (size_t)d * 32 + q * 4);
  }
  __syncthreads();
  const int ntok = (l == 0) ? NTOK : NLAT;
  const float rbl = rb[lane & 31];
  for (int m0 = (bid * 8 + wv) * 2; m0 < ntok; m0 += nb * 16) {
    float acc0[32], acc1[32];
#pragma unroll
    for (int e = 0; e < 32; ++e) { acc0[e] = 0.f; acc1[e] = 0.f; }
    float hv0[16], hv1[16];
    {
      const int ma = m0, mb = m0 + 1;
      const float* xa = (ma < NLAT) ? xl + (size_t)ma * 1024 : xc + (size_t)(ma - NLAT) * 1024;
      const float* xb = (mb < NLAT) ? xl + (size_t)mb * 1024 : xc + (size_t)(mb - NLAT) * 1024;
      const float* mda = mods + (size_t)mod_row(ma) * 6144 + 3072;
      const float* mdb = mods + (size_t)mod_row(mb) * 6144 + 3072;
      float ssa = 0.f, ssb = 0.f;
#pragma unroll
      for (int i = 0; i < 16; ++i) { hv0[i] = xa[lane + 64 * i]; hv1[i] = xb[lane + 64 * i]; }
#pragma unroll
      for (int i = 0; i < 16; ++i) { ssa += hv0[i] * hv0[i]; ssb += hv1[i] * hv1[i]; }
      ssa = wave_sum(ssa); ssb = wave_sum(ssb);
      const float rsa = rsqrtf(ssa * (1.f / 1024.f) + 1e-6f), rsb = rsqrtf(ssb * (1.f / 1024.f) + 1e-6f);
#pragma unroll
      for (int i = 0; i < 16; ++i) {
        const int d = lane + 64 * i;
        const float gg = g[d];
        hv0[i] = hv0[i] * rsa * gg * (1.f + mda[1024 + d]) + mda[d];
        hv1[i] = hv1[i] * rsb * gg * (1.f + mdb[1024 + d]) + mdb[d];
      }
      float am0 = 0.f, am1 = 0.f;
#pragma unroll
      for (int i = 0; i < 16; ++i) { am0 = fmaxf(am0, fabsf(hv0[i])); am1 = fmaxf(am1, fabsf(hv1[i])); }
      am0 = wave_max(am0); am1 = wave_max(am1);
      const float sc0 = am0 > 0.f ? am0 * (1.f / 127.f) : 1.f, sc1 = am1 > 0.f ? am1 * (1.f / 127.f) : 1.f;
      const float iv0 = 1.f / sc0, iv1 = 1.f / sc1;
      signed char* H8 = (signed char*)(p.ws + OFF_H);
#pragma unroll
      for (int i = 0; i < 16; ++i) {
        const int d = lane + 64 * i;
        H8[(size_t)ma * 1024 + d] = (signed char)(int)fminf(fmaxf(rintf(hv0[i] * iv0), -127.f), 127.f);
        H8[(size_t)mb * 1024 + d] = (signed char)(int)fminf(fmaxf(rintf(hv1[i] * iv1), -127.f), 127.f);
      }
      if (lane == 0) { float* SCL = (float*)(p.ws + OFF_SCL); SCL[ma] = sc0; SCL[mb] = sc1; }
      asm volatile("" ::: "memory");
    }
#pragma unroll
    for (int i = 0; i < 16; ++i) {
      if ((i & 3) == 0) asm volatile("" ::: "memory");
      const float* wr = wl + (lane + 64 * i) * RW_LDS_ROW;
#pragma unroll
      for (int q = 0; q < 8; ++q) {
        const float4 w = *(const float4*)(wr + q * 4);
        acc0[q * 4 + 0] += hv0[i] * w.x; acc0[q * 4 + 1] += hv0[i] * w.y; acc0[q * 4 + 2] += hv0[i] * w.z; acc0[q * 4 + 3] += hv0[i] * w.w;
        acc1[q * 4 + 0] += hv1[i] * w.x; acc1[q * 4 + 1] += hv1[i] * w.y; acc1[q * 4 + 2] += hv1[i] * w.z; acc1[q * 4 + 3] += hv1[i] * w.w;
      }
    }
#define BFLY(A, N, D)                                                                           \
    _Pragma("unroll") for (int i = 0; i < (N); ++i) {                                            \
      const bool up = (lane & (D)) != 0;                                                         \
      const float keep = up ? A[i + (N)] : A[i];                                                 \
      const float send = up ? A[i] : A[i + (N)];                                                 \
      A[i] = keep + shfl_xor_l(send, (D), lane);                                                   \
    }
    BFLY(acc0, 16, 16) BFLY(acc1, 16, 16)
    BFLY(acc0, 8, 8) BFLY(acc1, 8, 8)
    BFLY(acc0, 4, 4) BFLY(acc1, 4, 4)
    BFLY(acc0, 2, 2) BFLY(acc1, 2, 2)
    BFLY(acc0, 1, 1) BFLY(acc1, 1, 1)
#undef BFLY
    float la = acc0[0] + shfl_xor_l(acc0[0], 32, lane);
    float lb = acc1[0] + shfl_xor_l(acc1[0], 32, lane);
    const int my_e = lane & 31;
    la += rbl; lb += rbl;
    (void)my_e;
#pragma unroll
    for (int tkn = 0; tkn < 2; ++tkn) {
      float v = tkn == 0 ? la : lb;
      float tv[4]; int ti[4];
#pragma unroll
      for (int k = 0; k < 4; ++k) {
        float bv = v; int bi = lane & 31;
#pragma unroll
        for (int o = 16; o >= 1; o >>= 1) {
          float ov = shfl_xor_l(bv, o, lane); int oi = shfl_xor_li(bi, o, lane);
          bool take = (ov > bv) || (ov == bv && oi < bi);
          bv = take ? ov : bv; bi = take ? oi : bi;
        }
        tv[k] = bv; ti[k] = bi;
        if ((lane & 31) == bi) v = -3.0e38f;
      }
      float e1 = __expf(tv[1] - tv[0]), e2 = __expf(tv[2] - tv[0]), e3 = __expf(tv[3] - tv[0]);
      float inv = 1.f / (1.f + e1 + e2 + e3);
      const int m = m0 + tkn;
      if (lane < 4) {
        int e = lane == 0 ? ti[0] : lane == 1 ? ti[1] : lane == 2 ? ti[2] : ti[3];
        float gt = (lane == 0 ? 1.f : lane == 1 ? e1 : lane == 2 ? e2 : e3) * inv;
        int pos = atomicAdd(&cnt[e], 1);
        TOKE[(size_t)m * 4 + lane] = e; TOKP[(size_t)m * 4 + lane] = pos; TOKG[(size_t)m * 4 + lane] = gt;
      }
    }
  }
  __syncthreads();
}

__device__ __forceinline__ void moe_offsets(PP pp, int* toff) {
  const int* cnt = (const int*)(p.ws + OFF_CNT);
  if (tid_opaque() == 0) {
    int a = 0;
    for (int e = 0; e < 32; ++e) { toff[e] = a; a += (cnt[e] + 255) >> 8; }
    toff[32] = a;
  }
  __syncthreads();
}

__device__ __forceinline__ void phase_slotfill(PP pp, int l, int bid, int nb, char* smem) {
  int* toff = (int*)smem;
  moe_offsets(pp, toff);
  const int tid = tid_opaque(), lane = tid & 63, wv = wave_id(tid);
  const int* TOKE = (const int*)(p.ws + OFF_TOKE);
  const int* TOKP = (const int*)(p.ws + OFF_TOKP);
  const float* TOKG = (const float*)(p.ws + OFF_TOKG);
  const int* cnt = (const int*)(p.ws + OFF_CNT);
  int* TOKS = (int*)(p.ws + OFF_TOKS);
  float* SLG = (float*)(p.ws + OFF_SLG);
  float* SLS = (float*)(p.ws + OFF_SLS);
  const float* SCL = (const float*)(p.ws + OFF_SCL);
  const signed char* H8 = (const signed char*)(p.ws + OFF_H);
  signed char* XG = (signed char*)(p.ws + OFF_S);
  const int n = ((l == 0) ? NTOK : NLAT) * 4;
  for (int i = bid * 8 + wv; i < n; i += nb * 8) {
    int e = TOKE[i];
    int slot = toff[e] * 256 + TOKP[i];
    if (lane == 0) { TOKS[i] = slot; SLG[slot] = TOKG[i]; SLS[slot] = SCL[i >> 2]; }
    const uint4* src = (const uint4*)(H8 + (size_t)(i >> 2) * 1024);
    uint4* dst = (uint4*)(XG + (size_t)slot * 1024);
    dst[lane] = src[lane];
  }
  for (int e = 0; e < 32; ++e) {
    const int c = cnt[e];
    const int npad = ((c + 255) & ~255) - c;
    const int base = toff[e] * 256 + c;
    for (int r = bid * 8 + wv; r < npad; r += nb * 8) {
      uint4* dst = (uint4*)(XG + (size_t)(base + r) * 1024);
      dst[lane] = make_uint4(0u, 0u, 0u, 0u);
      if (lane == 0) SLS[base + r] = 0.f;
    }
  }
  __syncthreads();
}

struct EpiMoe1 {
  const float* bgu; const float* sw; const float* SLS; bfr* ACT;
  __device__ __forceinline__ void operator()(const i32x4 (&acc)[2][2][4][2], const g8::GUnit& u, int wr, int wc, int fr, int fq) const {
    const float* be = bgu + (size_t)u.e * 2048;
    const float* se = sw + (size_t)u.e * 2048;
    const int slot0 = u.pm * 256 + wr * 64 + fr;
#pragma unroll
    for (int bj = 0; bj < 2; ++bj) {
      const int j0 = u.pn * 128 + bj * 64 + wc * 16 + 4 * fq;
      const f32x4 bg = *(const f32x4*)(be + j0), bl = *(const f32x4*)(be + 1024 + j0);
      const f32x4 sg = *(const f32x4*)(se + j0), sl = *(const f32x4*)(se + 1024 + j0);
#pragma unroll
      for (int ai = 0; ai < 2; ++ai)
#pragma unroll
        for (int m = 0; m < 4; ++m) {
          const int slot = slot0 + ai * 128 + m * 16;
          const float sa = SLS[slot];
          bf16x4 o;
#pragma unroll
          for (int q = 0; q < 4; ++q) {
            const float g = (float)acc[ai][bj][m][0][q] * (sa * sg[q]) + bg[q];
            const float li = (float)acc[ai][bj][m][1][q] * (sa * sl[q]) + bl[q];
            const float gv = fminf(g, 7.f);
            const float lv = fminf(fmaxf(li, -7.f), 7.f);
            o[q] = (short)f2bf(gv * sigmoidf_(1.702f * gv) * (lv + 1.f));
          }
          *(bf16x4*)(ACT + (size_t)slot * 1024 + j0) = o;
        }
    }
  }
};
__device__ __forceinline__ void phase_moe1_impl(PP pp, int l, int bid, int nb, char* smem, int* toff) {
  moe_offsets(pp, toff);
  g8::MoeSched S{toff, 8, 2048, nb, bid};
  EpiMoe1 E{p.moe_b_gu + (size_t)l * 32 * 2048, (const float*)(p.ws + OFF_SW) + (size_t)l * 32 * 2048, (const float*)(p.ws + OFF_SLS), (bfr*)(p.ws + OFF_P)};
  g8::gemm_stream<true>((LAS unsigned char*)smem, p.ws + OFF_S, p.ws + OFF_W + (size_t)l * WL_SIZE + WL_GU, S, E);
}

struct EpiMoe2 {
  const float* bdn; const float* SLG; bfr* YS;
  __device__ __forceinline__ void operator()(const f32x4 (&acc)[2][2][4][2], const g8::GUnit& u, int wr, int wc, int fr, int fq) const {
    const float* be = bdn + (size_t)u.e * 1024;
    const int slot0 = u.pm * 256 + wr * 64 + fr, col0 = u.pn * 256 + wc * 32 + 4 * fq;
#pragma unroll
    for (int ai = 0; ai < 2; ++ai)
#pragma unroll
      for (int m = 0; m < 4; ++m) {
        const int slot = slot0 + ai * 128 + m * 16;
        const float gt = SLG[slot];
#pragma unroll
        for (int bj = 0; bj < 2; ++bj)
#pragma unroll
          for (int n = 0; n < 2; ++n) {
            const f32x4 bv = *(const f32x4*)(be + col0 + bj * 128 + n * 16);
            const f32x4 yv = (acc[ai][bj][m][n] + bv) * gt;
            *(bf16x4*)(YS + (size_t)slot * 1024 + col0 + bj * 128 + n * 16) = pack4(yv[0], yv[1], yv[2], yv[3]);
          }
      }
  }
};
__device__ __forceinline__ void phase_moe2_impl(PP pp, int l, int bid, int nb, char* smem, int* toff) {
  moe_offsets(pp, toff);
  g8::MoeSched S{toff, 4, 1024, nb, bid};
  EpiMoe2 E{p.moe_b_down + (size_t)l * 32 * 1024, (const float*)(p.ws + OFF_SLG), (bfr*)(p.ws + OFF_S)};
  g8::gemm_stream<false>((LAS unsigned char*)smem, p.ws + OFF_P, p.ws + OFF_W + (size_t)l * WL_SIZE + WL_DN, S, E);
}

__device__ __forceinline__ void phase_combine(PP pp, int l, int bid, int nb) {
  const int tid = tid_opaque(), lane = tid & 63, wv = wave_id(tid);
  const bfr* YS = (const bfr*)(p.ws + OFF_S);
  const int* TOKS = (const int*)(p.ws + OFF_TOKS);
  const float* mods = (const float*)(p.ws + OFF_MODS) + (size_t)l * 3 * 6144;
  const float* mods1 = (const float*)(p.ws + OFF_MODS) + (size_t)3 * 6144;
  const float* g1n = p.norm_mix_g + 1024;
  bfr* H = (bfr*)(p.ws + OFF_H);
  float* xl = p.out;
  float* xc = (float*)(p.ws + OFF_CTX);
  const int ntok = (l == 0) ? NTOK : NLAT;
  if (l == 0) {
    int* cnt = (int*)(p.ws + OFF_CNT);
    const int gt = bid * NTHR + tid;
    if (gt < 32) cnt[gt] = 0;
  }
  for (int m = bid * 8 + wv; m < ntok; m += nb * 8) {
    float* xr = (m < NLAT) ? xl + (size_t)m * 1024 : xc + (size_t)(m - NLAT) * 1024;
    const float* g2 = mods + (size_t)mod_row(m) * 6144 + 5120;
    const int s0 = TOKS[(size_t)m * 4], s1 = TOKS[(size_t)m * 4 + 1], s2 = TOKS[(size_t)m * 4 + 2], s3 = TOKS[(size_t)m * 4 + 3];
    float4 xn[4];
    float ss = 0.f;
#pragma unroll
    for (int i = 0; i < 4; ++i) {
      const int d = (lane + 64 * i) * 4;
      const bf16x4 a = *(const bf16x4*)(YS + (size_t)s0 * 1024 + d);
      const bf16x4 b = *(const bf16x4*)(YS + (size_t)s1 * 1024 + d);
      const bf16x4 c = *(const bf16x4*)(YS + (size_t)s2 * 1024 + d);
      const bf16x4 e = *(const bf16x4*)(YS + (size_t)s3 * 1024 + d);
      const float4 gg = *(const float4*)(g2 + d);
      float4 xv = *(const float4*)(xr + d);
      xv.x += gg.x * ((bf2f(a[0]) + bf2f(b[0])) + (bf2f(c[0]) + bf2f(e[0])));
      xv.y += gg.y * ((bf2f(a[1]) + bf2f(b[1])) + (bf2f(c[1]) + bf2f(e[1])));
      xv.z += gg.z * ((bf2f(a[2]) + bf2f(b[2])) + (bf2f(c[2]) + bf2f(e[2])));
      xv.w += gg.w * ((bf2f(a[3]) + bf2f(b[3])) + (bf2f(c[3]) + bf2f(e[3])));
      *(float4*)(xr + d) = xv;
      xn[i] = xv;
      ss += xv.x * xv.x + xv.y * xv.y + xv.z * xv.z + xv.w * xv.w;
    }
    if (l == 0) {
      ss = wave_sum(ss);
      const float rs = rsqrtf(ss * (1.f / 1024.f) + 1e-6f);
      const float* md = mods1 + (size_t)mod_row(m) * 6144;
#pragma unroll
      for (int i = 0; i < 4; ++i) {
        const int d = (lane + 64 * i) * 4;
        const float4 gg = *(const float4*)(g1n + d);
        const float4 sh = *(const float4*)(md + d);
        const float4 sc = *(const float4*)(md + 1024 + d);
        *(bf16x4*)(H + (size_t)m * 1024 + d) = pack4(xn[i].x * rs * gg.x * (1.f + sc.x) + sh.x, xn[i].y * rs * gg.y * (1.f + sc.y) + sh.y,
                                                      xn[i].z * rs * gg.z * (1.f + sc.z) + sh.z, xn[i].w * rs * gg.w * (1.f + sc.w) + sh.w);
      }
    }
  }
}

#define XB_TMO      128
#define XB_XCNT(j)  (256  + 64 * (j))
#define XB_XSUB(j)  (1280 + 64 * (j))
#define XB_XGEN(j)  (2304 + 64 * (j))
#define XB_TOP      3328
#define XB_TOPGEN   3392
#define XCD_BAR_WORDS 3456
#define XB_SPIN_CAP (1u << 22)
__device__ __forceinline__ unsigned xb_ld(unsigned* q) { return __hip_atomic_load(q, __ATOMIC_RELAXED, __HIP_MEMORY_SCOPE_AGENT); }
__device__ __forceinline__ unsigned xb_add(unsigned* q, unsigned v) { return __hip_atomic_fetch_add(q, v, __ATOMIC_RELAXED, __HIP_MEMORY_SCOPE_AGENT); }
__device__ __forceinline__ unsigned xb_xcc_id() { return (unsigned)__builtin_amdgcn_s_getreg((3 << 11) | 20) & 0xFu; }
#define XB_SPIN(cond, bar) do { unsigned _sp = 0; while (cond) { __builtin_amdgcn_s_sleep(1); \
    if ((++_sp & 255u) == 0u) { if (xb_ld(&(bar)[XB_TMO])) break; if (_sp > XB_SPIN_CAP) { atomicAdd(&(bar)[XB_TMO], 1u); break; } } } } while (0)
struct XcdBarrier { unsigned* bar; unsigned x; volatile LAS unsigned* st; };
__device__ __forceinline__ XcdBarrier xcd_barrier_post(unsigned* bar, volatile LAS unsigned* st) {
  XcdBarrier b; b.bar = bar; b.x = xb_xcc_id(); b.st = st;
  if (tid_opaque() == 0) (void)xb_add(&bar[XB_XCNT(b.x)], 1u);
  return b;
}
__device__ __forceinline__ void xcd_barrier_complete(unsigned* bar, unsigned x, unsigned& nloc, unsigned& nx) {
  const unsigned G = gridDim.x;
  unsigned sum, cnt, mine, sp = 0u;
  for (;;) {
    sum = 0u; cnt = 0u; mine = 0u;
#pragma unroll
    for (unsigned j = 0; j < 16; ++j) { const unsigned c = xb_ld(&bar[XB_XCNT(j)]); sum += c; cnt += (c > 0u) ? 1u : 0u; mine = (j == x) ? c : mine; }
    if (sum == G) break;
    __builtin_amdgcn_s_sleep(1);
    if ((++sp & 255u) == 0u) { if (xb_ld(&bar[XB_TMO])) break; if (sp > XB_SPIN_CAP) { atomicAdd(&bar[XB_TMO], 1u); break; } }
  }
  nloc = mine > 0u ? mine : 1u; nx = cnt > 0u ? cnt : 1u;
}
__device__ __forceinline__ void xcd_barrier(const XcdBarrier& b) {
  asm volatile("s_waitcnt vmcnt(0)" ::: "memory");
  __syncthreads();
  if (tid_opaque() == 0) {
    unsigned* bar = b.bar;
    __builtin_amdgcn_s_waitcnt(0);
    unsigned nloc = b.st[0], nx = b.st[1];
    if (nloc == 0u) { xcd_barrier_complete(bar, b.x, nloc, nx); b.st[0] = nloc; b.st[1] = nx; }
    const unsigned old = xb_add(&bar[XB_XSUB(b.x)], 1u);
    const unsigned gen = old / nloc;
    if (old + 1u == (gen + 1u) * nloc) {
      __builtin_amdgcn_fence(__ATOMIC_RELEASE, "agent");
      asm volatile("s_waitcnt vmcnt(0)" ::: "memory");
      const unsigned og = xb_add(&bar[XB_TOP], 1u);
      const unsigned tg = og / nx;
      if (og + 1u == (tg + 1u) * nx) xb_add(&bar[XB_TOPGEN], 1u);
      else XB_SPIN(xb_ld(&bar[XB_TOPGEN]) == tg, bar);
      __builtin_amdgcn_fence(__ATOMIC_ACQUIRE, "agent");
      xb_add(&bar[XB_XGEN(b.x)], 1u);
      asm volatile("s_waitcnt vmcnt(0)" ::: "memory");
    } else {
      XB_SPIN(xb_ld(&bar[XB_XGEN(b.x)]) == gen, bar);
      __builtin_amdgcn_fence(__ATOMIC_ACQUIRE, "agent");
      asm volatile("s_waitcnt vmcnt(0)" ::: "memory");
    }
  }
  __syncthreads();
}

extern __shared__ __attribute__((aligned(16))) char dyn_smem[];

__global__ void __launch_bounds__(NTHR) mega(Params p_unused) {
  cg::grid_group grid = cg::this_grid();
  const int bid0 = blockIdx.x, nb0 = gridDim.x;
#if defined(__HIP_DEVICE_COMPILE__)
  PP pp0 = (PP)__builtin_amdgcn_kernarg_segment_ptr();
#else
  PP pp0 = nullptr;
#endif
#define pp ({ PP q_ = pp0; asm volatile("" : "+s"(q_)); q_; })
#define bid opq(bid0)
#define nb opq(nb0)
  int* toff_s = (int*)(dyn_smem + 147456);
  volatile LAS unsigned* xb_st = (volatile LAS unsigned*)(dyn_smem + 147456 + 256);
  {
    unsigned* barw = (unsigned*)(fresh_ws(pp0) + OFF_BAR);
    if (blockIdx.x == 0) for (int i = threadIdx.x; i < XCD_BAR_WORDS; i += NTHR) barw[i] = 0u;
    if (threadIdx.x == 0) { xb_st[0] = 0u; xb_st[1] = 0u; }
  }
  grid.sync();
  const XcdBarrier xb = xcd_barrier_post((unsigned*)(fresh_ws(pp0) + OFF_BAR), xb_st);
#define GSYNC() xcd_barrier(xb)
  phase_ada(pp, bid, nb, dyn_smem);
  phase_convert(pp, 0, bid, nb, dyn_smem);
  phase_convert(pp, 1, bid, nb, dyn_smem);
  GSYNC();
#define LAYER(LV, LAST)                                      \
  {                                                          \
    if ((LV) == 0) { phase_prenorm(pp, opq(LV), bid, nb); GSYNC(); } \
    phase_gemm_in(pp, opq(LV), bid, nb, dyn_smem);           \
    GSYNC();                                                 \
    phase_prep(pp, opq(LV), bid, nb, dyn_smem);              \
    GSYNC();                                                 \
    phase_chunk_prep(pp, bid, nb, dyn_smem);                 \
    GSYNC();                                                 \
    phase_mix(pp, opq(LV), bid, nb, dyn_smem);               \
    GSYNC();                                                 \
    phase_post(pp, opq(LV), bid, nb);                        \
    GSYNC();                                                 \
    phase_gemm_out(pp, opq(LV), bid, nb, dyn_smem);          \
    GSYNC();                                                 \
    phase_router(pp, opq(LV), bid, nb, dyn_smem);            \
    GSYNC();                                                 \
    phase_slotfill(pp, opq(LV), bid, nb, dyn_smem);          \
    GSYNC();                                                 \
    phase_moe1_impl(pp, opq(LV), bid, nb, dyn_smem, toff_s); \
    GSYNC();                                                 \
    phase_moe2_impl(pp, opq(LV), bid, nb, dyn_smem, toff_s); \
    GSYNC();                                                 \
    phase_combine(pp, opq(LV), bid, nb);                     \
    if (!(LAST)) GSYNC();                                    \
  }
  LAYER(0, false)
  LAYER(1, true)
#undef LAYER
#undef GSYNC
#undef bid
#undef nb
#undef pp
}

#undef p
extern "C" void kernel_launch(void* const* d_in, const int* in_sizes, int n_in, void* d_out, int out_size, void* d_ws,
                              size_t ws_size, hipStream_t stream) {
  Params hp{};
  const float** pp = (const float**)&hp;
  for (int i = 0; i < 34; ++i) pp[i] = (const float*)d_in[i];
  hp.out = (float*)d_out;
  hp.ws = (char*)d_ws;
  static int grid_blocks = 0;
  if (!grid_blocks) {
    (void)hipFuncSetAttribute((const void*)mega, hipFuncAttributeMaxDynamicSharedMemorySize, LDS_BYTES);
    int dev = 0, cus = 0, per_cu = 0;
    (void)hipGetDevice(&dev);
    (void)hipDeviceGetAttribute(&cus, hipDeviceAttributeMultiprocessorCount, dev);
    (void)hipOccupancyMaxActiveBlocksPerMultiprocessor(&per_cu, mega, NTHR, LDS_BYTES);
    if (per_cu < 1) per_cu = 1;
    if (per_cu > 1) per_cu = 1;
    grid_blocks = cus * per_cu;
  }
  void* args[] = {&hp};
  (void)hipLaunchCooperativeKernel((void*)mega, dim3(grid_blocks), dim3(NTHR), args, LDS_BYTES, stream);
}
```

```cpp
#include <hip/hip_runtime.h>
#include <hip/hip_bf16.h>
#include <hip/hip_cooperative_groups.h>
#include <stdint.h>
#include <type_traits>
namespace cg = cooperative_groups;

typedef __attribute__((ext_vector_type(8))) short bf16x8;
typedef __attribute__((ext_vector_type(4))) short bf16x4;
typedef __attribute__((ext_vector_type(4))) float f32x4;
typedef __attribute__((ext_vector_type(4))) int i32x4;
typedef unsigned short bfr;

#define D_MODEL 1024
#define NB 2
#define SEQ 16384
#define CTXL 256
#define NLAT (NB * SEQ)
#define NCTX (NB * CTXL)
#define NTOK (NLAT + NCTX)
#define TTOK (SEQ + CTXL)
#define PIN 3472
#define PINP 3584
#define A_END 1536
#define B_END 2432
#define NEXP 32
#define NSLOT_MAX (NTOK * 4 + NEXP * 256)
#define NTHR 512
#define LDS_BYTES (147456 + 512)

constexpr size_t al256(size_t x) { return (x + 255) & ~(size_t)255; }
constexpr size_t WL_IN = 0;
constexpr size_t WL_OUT = WL_IN + (size_t)PINP * 1024 * 2;
constexpr size_t WL_GU = WL_OUT + (size_t)1024 * 1024 * 2;
constexpr size_t WL_DN = WL_GU + (size_t)32 * 2048 * 1024 * 2;
constexpr size_t WL_SIZE = WL_DN + (size_t)32 * 1024 * 1024 * 2;
constexpr size_t OFF_W = 0;
constexpr size_t OFF_MODS = al256(OFF_W + 2 * WL_SIZE);
constexpr size_t OFF_BAR = al256(OFF_MODS + 2 * 3 * 6144 * 4);
constexpr size_t OFF_SW = al256(OFF_BAR + 3456 * 4);
constexpr size_t OFF_SWIN = al256(OFF_SW + (size_t)2 * 32 * 2048 * 4);
constexpr size_t OFF_SLS = al256(OFF_SWIN + (size_t)2 * PINP * 4);
constexpr size_t OFF_SCL = al256(OFF_SLS + (size_t)(NTOK * 4 + 32 * 256) * 4);
constexpr size_t OFF_CTX = al256(OFF_SCL + (size_t)NTOK * 4);
constexpr size_t OFF_CNT = al256(OFF_CTX + (size_t)NCTX * 1024 * 4);
constexpr size_t OFF_TOKE = al256(OFF_CNT + 256);
constexpr size_t OFF_TOKP = al256(OFF_TOKE + (size_t)NTOK * 4 * 4);
constexpr size_t OFF_TOKG = al256(OFF_TOKP + (size_t)NTOK * 4 * 4);
constexpr size_t OFF_TOKS = al256(OFF_TOKG + (size_t)NTOK * 4 * 4);
constexpr size_t OFF_SLT = al256(OFF_TOKS + (size_t)NTOK * 4 * 4);
constexpr size_t OFF_SLG = al256(OFF_SLT + (size_t)NSLOT_MAX * 4);
constexpr size_t OFF_H = al256(OFF_SLG + (size_t)NSLOT_MAX * 4);
constexpr size_t OFF_CC = al256(OFF_H + (size_t)NTOK * 1024 * 2);
constexpr size_t OFF_P = al256(OFF_CC + (size_t)NTOK * 1024 * 2);
constexpr size_t OFF_S = al256(OFF_P + (size_t)NTOK * PINP * 4);
constexpr size_t TOK256F = (size_t)NTOK * 256 * 4;
constexpr size_t S_QN = 0;
constexpr size_t S_KN = S_QN + (size_t)NTOK * 512 * 2;
constexpr size_t S_VT = S_KN + (size_t)NTOK * 512 * 2;
constexpr size_t S_RWR = S_VT + (size_t)NB * 8 * 64 * TTOK * 2;
constexpr size_t S_RWKK = S_RWR + TOK256F;
constexpr size_t S_RWV = S_RWKK + TOK256F;
constexpr size_t S_RWG = S_RWV + TOK256F;
constexpr size_t S_RWW = S_RWG + TOK256F;
constexpr size_t S_RWKD = S_RWW + 2 * TOK256F;
constexpr size_t S_RWB = S_RWKD + 2 * TOK256F;
constexpr size_t S_BON = S_RWB + 2 * TOK256F;
constexpr size_t S_GDQ = al256(S_BON + (size_t)NTOK * 4 * 4);
constexpr size_t S_GDK = S_GDQ + TOK256F;
constexpr size_t S_GDV = S_GDK + TOK256F;
constexpr size_t S_GDAB = S_GDV + TOK256F;
constexpr size_t S_YRW = al256(S_GDAB + (size_t)NTOK * 16 * 4);
constexpr size_t S_YGD = S_YRW + 2 * TOK256F;
constexpr size_t S_END = S_YGD + 2 * TOK256F;
constexpr size_t S_SIZE = (S_END > (size_t)NSLOT_MAX * 1024 * 4) ? S_END : (size_t)NSLOT_MAX * 1024 * 4;
constexpr int NCHUNK = TTOK / 64;
constexpr int NCHAIN = 32;
constexpr size_t OFF_CH = al256(OFF_S + S_SIZE);
constexpr size_t CH_N = (size_t)NCHAIN * NCHUNK;
constexpr size_t CH_REC = 32768, CH_PT = 0, CH_RYT = 8192, CH_QT = 16384, CH_YX = 24576;
constexpr size_t CH_SIZE = CH_N * CH_REC;
constexpr size_t WS_TOTAL = OFF_CH + CH_SIZE;
static_assert(WS_TOTAL <= (size_t)2048 * 1024 * 1024, "workspace exceeds 4x largest tensor");

struct Params {
  const float *x, *c, *ctx, *c_ctx, *ada_w, *ada_b, *norm_mix_g, *norm_ffn_g, *w_in, *w_out;
  const float *na_q_gain, *na_k_gain, *na_rpb;
  const float *rw_mu, *rw_w0, *rw_w_up, *rw_a0, *rw_a_up, *rw_g_up, *rw_k_k, *rw_k_a, *rw_r_k, *rw_ln_w, *rw_ln_b;
  const float *gd_conv_w, *gd_A_log, *gd_dt_bias, *gd_norm_g;
  const float *moe_router_w, *moe_router_b, *moe_w_gu, *moe_b_gu, *moe_w_down, *moe_b_down;
  float* out;
  char* ws;
};

typedef const __attribute__((address_space(4))) Params* PP;
#define p (*pp)
__device__ __forceinline__ char* fresh_ws(PP pp) { return p.ws; }
__device__ __forceinline__ int tid_opaque() { int t = (int)__builtin_amdgcn_workitem_id_x(); asm volatile("" : "+v"(t)); return t; }
__device__ __forceinline__ int opq(int x) { asm volatile("" : "+s"(x)); return x; }
__device__ __forceinline__ int wave_id(int tid) { return __builtin_amdgcn_readfirstlane(tid >> 6); }
__device__ __forceinline__ bfr f2bf(float f) {
  unsigned u = __float_as_uint(f);
  u += 0x7fffu + ((u >> 16) & 1u);
  return (bfr)(u >> 16);
}
__device__ __forceinline__ float bf2f(short v) { return __uint_as_float(((unsigned)(unsigned short)v) << 16); }
__device__ __forceinline__ bf16x4 pack4(float a, float b, float c, float d) {
  bf16x4 o; o[0] = (short)f2bf(a); o[1] = (short)f2bf(b); o[2] = (short)f2bf(c); o[3] = (short)f2bf(d); return o;
}
__device__ __forceinline__ float sigmoidf_(float x) { return 1.f / (1.f + __expf(-x)); }
__device__ __forceinline__ float siluf_(float x) { return x / (1.f + __expf(-x)); }
__device__ __forceinline__ float softplusf_(float x) { return x > 20.f ? x : log1pf(__expf(x)); }
__device__ __forceinline__ float wave_sum(float v) {
  v += __builtin_bit_cast(float, __builtin_amdgcn_update_dpp(0, __builtin_bit_cast(int, v), 0xB1, 0xF, 0xF, true));
  v += __builtin_bit_cast(float, __builtin_amdgcn_update_dpp(0, __builtin_bit_cast(int, v), 0x4E, 0xF, 0xF, true));
  v += __builtin_bit_cast(float, __builtin_amdgcn_update_dpp(0, __builtin_bit_cast(int, v), 0x141, 0xF, 0xF, true));
  v += __builtin_bit_cast(float, __builtin_amdgcn_update_dpp(0, __builtin_bit_cast(int, v), 0x140, 0xF, 0xF, true));
  v += __builtin_bit_cast(float, __builtin_amdgcn_update_dpp(0, __builtin_bit_cast(int, v), 0x142, 0xA, 0xF, false));
  v += __builtin_bit_cast(float, __builtin_amdgcn_update_dpp(0, __builtin_bit_cast(int, v), 0x143, 0xC, 0xF, false));
  return __builtin_bit_cast(float, __builtin_amdgcn_readlane(__builtin_bit_cast(int, v), 63));
}
__device__ __forceinline__ float wave_max(float v) {
  v = fmaxf(v, __builtin_bit_cast(float, __builtin_amdgcn_update_dpp(0, __builtin_bit_cast(int, v), 0xB1, 0xF, 0xF, true)));
  v = fmaxf(v, __builtin_bit_cast(float, __builtin_amdgcn_update_dpp(0, __builtin_bit_cast(int, v), 0x4E, 0xF, 0xF, true)));
  v = fmaxf(v, __builtin_bit_cast(float, __builtin_amdgcn_update_dpp(0, __builtin_bit_cast(int, v), 0x141, 0xF, 0xF, true)));
  v = fmaxf(v, __builtin_bit_cast(float, __builtin_amdgcn_update_dpp(0, __builtin_bit_cast(int, v), 0x140, 0xF, 0xF, true)));
  const float r1 = __builtin_bit_cast(float, __builtin_amdgcn_readlane(__builtin_bit_cast(int, v), 0));
  const float r2 = __builtin_bit_cast(float, __builtin_amdgcn_readlane(__builtin_bit_cast(int, v), 16));
  const float r3 = __builtin_bit_cast(float, __builtin_amdgcn_readlane(__builtin_bit_cast(int, v), 32));
  const float r4 = __builtin_bit_cast(float, __builtin_amdgcn_readlane(__builtin_bit_cast(int, v), 48));
  return fmaxf(fmaxf(r1, r2), fmaxf(r3, r4));
}
__device__ __forceinline__ float shfl_xor_l(float v, int mask, int lane) {
  return __builtin_bit_cast(float, __builtin_amdgcn_ds_bpermute((lane ^ mask) << 2, __builtin_bit_cast(int, v)));
}
__device__ __forceinline__ int shfl_xor_li(int v, int mask, int lane) {
  return __builtin_amdgcn_ds_bpermute((lane ^ mask) << 2, v);
}
__device__ __forceinline__ float row16_sum(float v) {
  v += __builtin_bit_cast(float, __builtin_amdgcn_update_dpp(0, __builtin_bit_cast(int, v), 0xB1, 0xF, 0xF, true));
  v += __builtin_bit_cast(float, __builtin_amdgcn_update_dpp(0, __builtin_bit_cast(int, v), 0x4E, 0xF, 0xF, true));
  v += __builtin_bit_cast(float, __builtin_amdgcn_update_dpp(0, __builtin_bit_cast(int, v), 0x141, 0xF, 0xF, true));
  v += __builtin_bit_cast(float, __builtin_amdgcn_update_dpp(0, __builtin_bit_cast(int, v), 0x140, 0xF, 0xF, true));
  return v;
}
__device__ __forceinline__ float quant_row_store(const float4 (&v)[4], signed char* dst_row, int lane) {
  float am = 0.f;
#pragma unroll
  for (int i = 0; i < 4; ++i) am = fmaxf(fmaxf(am, fmaxf(fabsf(v[i].x), fabsf(v[i].y))), fmaxf(fabsf(v[i].z), fabsf(v[i].w)));
  am = wave_max(am);
  const float sc = am > 0.f ? am * (1.f / 127.f) : 1.f, iv = 1.f / sc;
#pragma unroll
  for (int i = 0; i < 4; ++i) {
    const int q0 = (int)fminf(fmaxf(rintf(v[i].x * iv), -127.f), 127.f), q1 = (int)fminf(fmaxf(rintf(v[i].y * iv), -127.f), 127.f);
    const int q2 = (int)fminf(fmaxf(rintf(v[i].z * iv), -127.f), 127.f), q3 = (int)fminf(fmaxf(rintf(v[i].w * iv), -127.f), 127.f);
    *(unsigned*)(dst_row + (lane + 64 * i) * 4) = (unsigned)(q0 & 0xff) | ((unsigned)(q1 & 0xff) << 8) | ((unsigned)(q2 & 0xff) << 16) | ((unsigned)(q3 & 0xff) << 24);
  }
  return sc;
}
__device__ __forceinline__ int mod_row(int m) { return m < NLAT ? (m >> 14) : 2; }

__device__ __forceinline__ void phase_ada(PP pp, int bid, int nb, char* smem) {
  float* red = (float*)smem;
  float* mods = (float*)(p.ws + OFF_MODS);
  const int tid = tid_opaque();
  for (int task = bid; task < 2 * 96; task += nb) {
    int l = task / 96, cgp = task % 96;
    int col = cgp * 64 + (tid & 63), ks = tid >> 6;
    const float* W = p.ada_w + (size_t)l * 1024 * 6144;
    float a0 = 0.f, a1 = 0.f, a2 = 0.f;
    for (int d = ks * 128; d < ks * 128 + 128; ++d) {
      float w = W[(size_t)d * 6144 + col];
      a0 += siluf_(p.c[d]) * w;
      a1 += siluf_(p.c[1024 + d]) * w;
      a2 += siluf_(p.c_ctx[d]) * w;
    }
    red[(ks * 3 + 0) * 64 + (tid & 63)] = a0;
    red[(ks * 3 + 1) * 64 + (tid & 63)] = a1;
    red[(ks * 3 + 2) * 64 + (tid & 63)] = a2;
    __syncthreads();
    if (tid < 192) {
      int r = tid >> 6, cc = tid & 63;
      float s = 0.f;
      for (int k = 0; k < 8; ++k) s += red[(k * 3 + r) * 64 + cc];
      mods[(size_t)(l * 3 + r) * 6144 + cgp * 64 + cc] = s + p.ada_b[(size_t)l * 6144 + cgp * 64 + cc];
    }
    __syncthreads();
  }
}

__device__ __forceinline__ void convert_tile(const float* src, int N, bfr* dst, int kt, int nt, int mode, float* tile  ) {
  const int tid = tid_opaque();
#pragma unroll
  for (int q = 0; q < 2; ++q) {
    int idx = tid + q * 512;
    int kk = idx >> 4, n4 = idx & 15;
    int n = nt * 64 + n4 * 4;
    float4 v = make_float4(0.f, 0.f, 0.f, 0.f);
    if (n < N) v = *(const float4*)(src + (size_t)(kt * 64 + kk) * N + n);
    tile[kk * 65 + n4 * 4 + 0] = v.x;
    tile[kk * 65 + n4 * 4 + 1] = v.y;
    tile[kk * 65 + n4 * 4 + 2] = v.z;
    tile[kk * 65 + n4 * 4 + 3] = v.w;
  }
  __syncthreads();
  {
    int nn = tid >> 3, kc = tid & 7;
    int n = nt * 64 + nn;
    int row = n;
    if (mode == 1) { int j = n & 1023; row = (j >> 4) * 32 + (j & 15) + ((n >= 1024) ? 16 : 0); }
    bf16x8 o;
#pragma unroll
    for (int j = 0; j < 8; ++j) o[j] = (short)f2bf(tile[(kc * 8 + j) * 65 + nn]);
    *(bf16x8*)(dst + (size_t)row * 1024 + kt * 64 + kc * 8) = o;
  }
  __syncthreads();
}
template <int N, bool INTERLEAVE>
__device__ __forceinline__ void convert_i8(const float* src  , signed char* dst  , float* sw, int ng, char* smem) {
  const int tid = tid_opaque();
  bfr* blk = (bfr*)smem;
  int* cmax = (int*)(smem + 131072);
  if (tid < 64) cmax[tid] = 0;
  __syncthreads();
  {
    const int n4 = tid & 15, kk0 = tid >> 4;
    float m0 = 0.f, m1 = 0.f, m2 = 0.f, m3 = 0.f;
#pragma unroll 4
    for (int ps = 0; ps < 32; ++ps) {
      const int k = ps * 32 + kk0;
      float4 v = make_float4(0.f, 0.f, 0.f, 0.f);
      if (ng * 64 + n4 * 4 < N) v = *(const float4*)(src + (size_t)k * N + ng * 64 + n4 * 4);
      m0 = fmaxf(m0, fabsf(v.x)); m1 = fmaxf(m1, fabsf(v.y)); m2 = fmaxf(m2, fabsf(v.z)); m3 = fmaxf(m3, fabsf(v.w));
      *(bf16x4*)(blk + k * 64 + n4 * 4) = pack4(v.x, v.y, v.z, v.w);
    }
    atomicMax(&cmax[n4 * 4 + 0], __float_as_int(m0)); atomicMax(&cmax[n4 * 4 + 1], __float_as_int(m1));
    atomicMax(&cmax[n4 * 4 + 2], __float_as_int(m2)); atomicMax(&cmax[n4 * 4 + 3], __float_as_int(m3));
  }
  __syncthreads();
  {
    const int nn = tid >> 3, kc = tid & 7;
    const int n = ng * 64 + nn;
    const float am = __int_as_float(cmax[nn]);
    const float sc = am > 0.f ? am * (1.f / 127.f) : 1.f, iv = 1.f / sc;
    const int j = n & 1023;
    const int row = INTERLEAVE ? (j >> 4) * 32 + (j & 15) + ((n >= 1024) ? 16 : 0) : n;
    if (kc == 0) sw[n] = sc;
#pragma unroll 2
    for (int q = 0; q < 8; ++q) {
      const int k0 = (kc + 8 * q) * 16;
      unsigned w[4];
#pragma unroll
      for (int g4 = 0; g4 < 4; ++g4) {
        unsigned acc = 0u;
#pragma unroll
        for (int b = 0; b < 4; ++b) {
          const float v = bf2f((short)blk[(k0 + g4 * 4 + b) * 64 + nn]);
          const int qi = (int)fminf(fmaxf(rintf(v * iv), -127.f), 127.f);
          acc |= ((unsigned)(qi & 0xff)) << (8 * b);
        }
        w[g4] = acc;
      }
      *(uint4*)(dst + (size_t)row * 1024 + k0) = make_uint4(w[0], w[1], w[2], w[3]);
    }
  }
  __syncthreads();
}
__device__ __forceinline__ void phase_convert(PP pp, int l, int bid, int nb, char* smem) {
  float* tile = (float*)smem;
  char* wl = p.ws + OFF_W + (size_t)l * WL_SIZE;
  const int T_IN = 56, T_OUT = 16 * 16, T_GU = 32 * 32, T_DN = 32 * 16 * 16;
  const int total = T_IN + T_OUT + T_GU + T_DN;
  for (int t = bid; t < total; t += nb) {
    if (t < T_IN) {
      convert_i8<PIN, false>(p.w_in + (size_t)l * 1024 * PIN, (signed char*)(wl + WL_IN), (float*)(p.ws + OFF_SWIN) + (size_t)l * PINP, t, smem);
    } else if (t < T_IN + T_OUT) {
      int u = t - T_IN; int kt = u / 16, nt = u % 16;
      convert_tile(p.w_out + (size_t)l * 1024 * 1024, 1024, (bfr*)(wl + WL_OUT), kt, nt, 0, tile);
    } else if (t < T_IN + T_OUT + T_GU) {
      int u = t - T_IN - T_OUT; int e = u / 32, ng = u % 32;
      convert_i8<2048, true>(p.moe_w_gu + ((size_t)l * 32 + e) * 1024 * 2048, (signed char*)(wl + WL_GU) + (size_t)e * 2048 * 1024,
                    (float*)(p.ws + OFF_SW) + ((size_t)l * 32 + e) * 2048, ng, smem);
    } else {
      int u = t - T_IN - T_OUT - T_GU; int e = u / 256; int v = u % 256; int kt = v / 16, nt = v % 16;
      convert_tile(p.moe_w_down + ((size_t)l * 32 + e) * 1024 * 1024, 1024, (bfr*)(wl + WL_DN) + (size_t)e * 1024 * 1024, kt, nt, 0, tile);
    }
  }
}

__device__ __forceinline__ void phase_prenorm(PP pp, int l, int bid, int nb) {
  const int tid = tid_opaque(), lane = tid & 63, wv = wave_id(tid);
  const float* xl = (l == 0) ? p.x : p.out;
  const float* xc = (l == 0) ? p.ctx : (const float*)(p.ws + OFF_CTX);
  const float* mods = (const float*)(p.ws + OFF_MODS) + (size_t)l * 3 * 6144;
  const float* g = p.norm_mix_g + (size_t)l * 1024;
  signed char* H8 = (signed char*)(p.ws + OFF_H);
  float* SCL = (float*)(p.ws + OFF_SCL);
  {
    int* cnt = (int*)(p.ws + OFF_CNT);
    int gt = bid * NTHR + tid;
    if (gt < 32) cnt[gt] = 0;
  }
  for (int m = bid * 8 + wv; m < NTOK; m += nb * 8) {
    const float* xr = (m < NLAT) ? xl + (size_t)m * 1024 : xc + (size_t)(m - NLAT) * 1024;
    const float* md = mods + (size_t)mod_row(m) * 6144;
    float4 v[4];
    float ss = 0.f;
#pragma unroll
    for (int i = 0; i < 4; ++i) {
      v[i] = *(const float4*)(xr + (lane + 64 * i) * 4);
      ss += v[i].x * v[i].x + v[i].y * v[i].y + v[i].z * v[i].z + v[i].w * v[i].w;
    }
    ss = wave_sum(ss);
    float rs = rsqrtf(ss * (1.f / 1024.f) + 1e-6f);
    float4 hq[4];
#pragma unroll
    for (int i = 0; i < 4; ++i) {
      int d = (lane + 64 * i) * 4;
      float4 gg = *(const float4*)(g + d);
      float4 sh = *(const float4*)(md + d);
      float4 sc = *(const float4*)(md + 1024 + d);
      hq[i] = make_float4(v[i].x * rs * gg.x * (1.f + sc.x) + sh.x, v[i].y * rs * gg.y * (1.f + sc.y) + sh.y,
                          v[i].z * rs * gg.z * (1.f + sc.z) + sh.z, v[i].w * rs * gg.w * (1.f + sc.w) + sh.w);
    }
    const float qs = quant_row_store(hq, H8 + (size_t)m * 1024, lane);
    if (lane == 0) SCL[m] = qs;
  }
}

#define LAS __attribute__((address_space(3)))
namespace g8 {
constexpr int BM = 256, BK = 64, HALF = 128, HTB = HALF * BK * 2, STAGE_BYTES = 8 * HTB, KD = 1024;
__device__ __forceinline__ int lds_byte(int r, int c) { const int st = (r >> 4) * 2 + (c >> 5), rr = r & 15, cc = c & 31, ob = rr * 64 + cc * 2; return st * 1024 + (ob ^ (((ob >> 9) & 1) << 5)); }
__device__ __forceinline__ void stage_rc(int b, int& R, int& C) { const int st = b / 1024, sb = b % 1024, swz = sb ^ (((sb >> 9) & 1) << 5); R = (st >> 1) * 16 + swz / 64; C = (st & 1) * 32 + (swz % 64) / 2; }
struct GUnit { int pm, pn, brow0, e; };
__device__ __forceinline__ int unit_index(int i, int c, int G, int total) {
  const int x = c & 7, j = c >> 3, q = total >> 3, r = total & 7;
  const int start = x < r ? x * (q + 1) : r * (q + 1) + (x - r) * q;
  const int size = q + (x < r ? 1 : 0);
  const int li = i * (G >> 3) + j;
  return li < size ? start + li : -1;
}

__device__ __forceinline__ f32x4 mma16(bf16x8 a, bf16x8 b, f32x4 c) { return __builtin_amdgcn_mfma_f32_16x16x32_bf16(a, b, c, 0, 0, 0); }
__device__ __forceinline__ i32x4 mma16(i32x4 a, i32x4 b, i32x4 c) { return __builtin_amdgcn_mfma_i32_16x16x64_i8(a, b, c, 0, 0, 0); }
template <bool I8, class Sched, class Epi>
__device__ __forceinline__ void gemm_stream(LAS unsigned char* lds, const void* Abase, const void* Btbase, const Sched& S, const Epi& E) {
  typedef typename std::conditional<I8, i32x4, f32x4>::type AccT;
  typedef typename std::conditional<I8, i32x4, bf16x8>::type FragT;
  constexpr int KB = I8 ? KD : KD * 2;
  const int tid = tid_opaque(), wid = __builtin_amdgcn_readfirstlane(tid >> 6), lane = tid & 63, wr = wid >> 2, wc = wid & 3, fr = lane & 15, fq = lane >> 4;
  constexpr int nt = KB / 128;
  int R[2], C[2];
  unsigned voffB[2];
#pragma unroll
  for (int i = 0; i < 2; ++i) { stage_rc(tid * 16 + i * 8192, R[i], C[i]); voffB[i] = (unsigned)(R[i] * KB + C[i] * 2); }
#define voffA voffB
  constexpr size_t kstep = (size_t)(BK * 2);
  constexpr size_t hstep = (size_t)HALF * KB;
  const unsigned ldsw = (unsigned)wid * 1024u;
  const int aoff = lds_byte(wr * 64 + fr, fq * 8), boff = lds_byte(wc * 32 + fr, fq * 8);
#define G8_SA(b, h) (((b) * 2 + (h)) * HTB)
#define G8_SB(b, h) ((4 + (b) * 2 + (h)) * HTB)
#define G8_STAGE(bufoff, gbase, v0, v1) do { \
    __builtin_amdgcn_global_load_lds((const unsigned*)((const char*)(gbase) + (v0)), (LAS unsigned*)(lds + (bufoff) + ldsw), 16, 0, 0); \
    __builtin_amdgcn_global_load_lds((const unsigned*)((const char*)(gbase) + (v1)), (LAS unsigned*)(lds + (bufoff) + ldsw + 8192), 16, 0, 0); } while (0)
#define G8_STAGEB(bufoff, gbase) G8_STAGE(bufoff, gbase, voffB[0], voffB[1])
#define G8_STAGEA(bufoff, gbase) G8_STAGE(bufoff, gbase, voffA[0], voffA[1])
#define G8_LDA(dst, b, h) do { _Pragma("unroll") for (int m = 0; m < 4; ++m) _Pragma("unroll") for (int k = 0; k < 2; ++k) dst[m][k] = *(const LAS FragT*)(lds + G8_SA(b, h) + aoff + m * 2048 + k * 1024); } while (0)
#define G8_LDB(dst, b, h) do { _Pragma("unroll") for (int n = 0; n < 2; ++n) _Pragma("unroll") for (int k = 0; k < 2; ++k) dst[n][k] = *(const LAS FragT*)(lds + G8_SB(b, h) + boff + n * 2048 + k * 1024); } while (0)
#define G8_MMA(ai, bj, At, Bt) do { __builtin_amdgcn_s_setprio(1); _Pragma("unroll") for (int m = 0; m < 4; ++m) _Pragma("unroll") for (int n = 0; n < 2; ++n) _Pragma("unroll") for (int k = 0; k < 2; ++k) \
    acc[ai][bj][m][n] = mma16(Bt[n][k], At[m][k], acc[ai][bj][m][n]); __builtin_amdgcn_s_setprio(0); } while (0)
#define G8_WAIT_V(n) asm volatile("s_waitcnt vmcnt(" #n ")" ::: "memory")
#define G8_WAIT_L(n) asm volatile("s_waitcnt lgkmcnt(" #n ")" ::: "memory")
#define G8_BAR __builtin_amdgcn_s_barrier()
#define G8_SCHED __builtin_amdgcn_sched_barrier(0)
  GUnit cur, nxt;
  int ui = 0;
  if (!S.next(0, cur)) return;
  AccT acc[2][2][4][2];
#pragma unroll
  for (int a = 0; a < 2; ++a)
#pragma unroll
    for (int b = 0; b < 2; ++b)
#pragma unroll
      for (int m = 0; m < 4; ++m)
#pragma unroll
        for (int n = 0; n < 2; ++n) acc[a][b][m][n] = AccT{};
  FragT At[4][2], B0[2][2], B1[2][2];
  const char* cA = (const char*)Abase + (size_t)cur.pm * (BM * KB);
  const char* cB = (const char*)Btbase + (size_t)cur.brow0 * KB;
  G8_STAGEB(G8_SB(0, 0), cB); G8_STAGEA(G8_SA(0, 0), cA); G8_STAGEB(G8_SB(0, 1), cB + hstep); G8_STAGEA(G8_SA(0, 1), cA + hstep);
  if (wr == 1) G8_BAR;
  G8_WAIT_V(4); G8_BAR;
  G8_STAGEB(G8_SB(1, 0), cB + kstep); G8_STAGEA(G8_SA(1, 0), cA + kstep); G8_STAGEB(G8_SB(1, 1), cB + hstep + kstep);
  G8_WAIT_V(6); G8_BAR;
  for (;;) {
    const bool has_next = S.next(ui + 1, nxt);
    const char* nA = has_next ? (const char*)Abase + (size_t)nxt.pm * (BM * KB) : cA;
    const char* nB = has_next ? (const char*)Btbase + (size_t)nxt.brow0 * KB : cB;
#pragma unroll 1
    for (int t = 0; t < nt; t += 2) {
      const bool last = (t == nt - 2);
      const char* a1 = cA + (size_t)(t + 1) * kstep;
      const char* a2 = last ? nA : cA + (size_t)(t + 2) * kstep;
      const char* b2 = last ? nB : cB + (size_t)(t + 2) * kstep;
      const char* a3 = a2 + kstep;
      const char* b3 = b2 + kstep;
      G8_LDB(B0, 0, 0); G8_SCHED; G8_LDA(At, 0, 0); G8_STAGEA(G8_SA(1, 1), a1 + hstep);
      G8_WAIT_L(8); G8_BAR; G8_WAIT_L(0); G8_MMA(0, 0, At, B0); G8_BAR; G8_SCHED;
      G8_LDB(B1, 0, 1); G8_STAGEB(G8_SB(0, 0), b2);
      G8_BAR; G8_WAIT_L(0); G8_MMA(0, 1, At, B1); G8_BAR;
      G8_LDA(At, 0, 1); G8_STAGEA(G8_SA(0, 0), a2);
      G8_BAR; G8_WAIT_L(0); G8_MMA(1, 0, At, B0); G8_BAR; G8_SCHED;
      G8_STAGEB(G8_SB(0, 1), b2 + hstep);
      G8_WAIT_V(6); G8_BAR; G8_MMA(1, 1, At, B1); G8_BAR;
      G8_LDB(B0, 1, 0); G8_SCHED; G8_LDA(At, 1, 0); G8_STAGEA(G8_SA(0, 1), a2 + hstep);
      G8_WAIT_L(8); G8_BAR; G8_WAIT_L(0); G8_MMA(0, 0, At, B0); G8_BAR; G8_SCHED;
      G8_LDB(B1, 1, 1); G8_STAGEB(G8_SB(1, 0), b3);
      G8_BAR; G8_WAIT_L(0); G8_MMA(0, 1, At, B1); G8_BAR;
      G8_LDA(At, 1, 1); G8_STAGEA(G8_SA(1, 0), a3);
      G8_BAR; G8_WAIT_L(0); G8_MMA(1, 0, At, B0); G8_BAR; G8_SCHED;
      G8_STAGEB(G8_SB(1, 1), b3 + hstep);
      G8_WAIT_V(6); G8_BAR; G8_MMA(1, 1, At, B1); G8_BAR;
    }
    E(acc, cur, wr, wc, fr, fq);
    if (!has_next) break;
#pragma unroll
    for (int a = 0; a < 2; ++a)
#pragma unroll
      for (int b = 0; b < 2; ++b)
#pragma unroll
        for (int m = 0; m < 4; ++m)
#pragma unroll
          for (int n = 0; n < 2; ++n) acc[a][b][m][n] = AccT{};
    cur = nxt; cA = nA; cB = nB; ++ui;
  }
  G8_WAIT_V(0);
  if (wr == 0) G8_BAR;
  G8_BAR;
#undef G8_SA
#undef G8_SB
#undef G8_STAGE
#undef G8_STAGEB
#undef G8_STAGEA
#undef voffA
#undef G8_LDA
#undef G8_LDB
#undef G8_MMA
#undef G8_WAIT_V
#undef G8_WAIT_L
#undef G8_BAR
#undef G8_SCHED
}

struct DenseSched {
  int nM, nN, G, c;
  __device__ __forceinline__ bool next(int i, GUnit& u) const {
    const int idx = unit_index(i, c, G, nM * nN);
    if (idx < 0) return false;
    u.pm = idx / nN; u.pn = idx - u.pm * nN; u.brow0 = u.pn * BM; u.e = 0;
    return true;
  }
};
struct MoeSched {
  const int* toff; int nN, NE, G, c;
  __device__ __forceinline__ bool next(int i, GUnit& u) const {
    const int idx = unit_index(i, c, G, toff[32] * nN);
    if (idx < 0) return false;
    u.pm = idx / nN; u.pn = idx - u.pm * nN;
    int e = 0;
#pragma unroll 1
    for (int k = 1; k < 32; ++k) e = (u.pm >= toff[k]) ? k : e;
    u.e = e; u.brow0 = e * NE + u.pn * BM;
    return true;
  }
};
}

struct EpiInProj {
  float* P; const float* SCL; const float* sw;
  __device__ __forceinline__ void operator()(const i32x4 (&acc)[2][2][4][2], const g8::GUnit& u, int wr, int wc, int fr, int fq) const {
    const int row0 = u.pm * 256 + wr * 64 + fr, col0 = u.pn * 256 + wc * 32 + 4 * fq;
    f32x4 cs[2][2];
#pragma unroll
    for (int bj = 0; bj < 2; ++bj)
#pragma unroll
      for (int n = 0; n < 2; ++n) cs[bj][n] = *(const f32x4*)(sw + col0 + bj * 128 + n * 16);
#pragma unroll
    for (int ai = 0; ai < 2; ++ai)
#pragma unroll
      for (int m = 0; m < 4; ++m) {
        const int row = row0 + ai * 128 + m * 16;
        const float sa = SCL[row];
        float* rowp = P + (size_t)row * PINP + col0;
#pragma unroll
        for (int bj = 0; bj < 2; ++bj)
#pragma unroll
          for (int n = 0; n < 2; ++n) {
            const i32x4 a = acc[ai][bj][m][n];
            f32x4 o = {(float)a[0], (float)a[1], (float)a[2], (float)a[3]};
            *(f32x4*)(rowp + bj * 128 + n * 16) = o * (cs[bj][n] * sa);
          }
      }
  }
};
__device__ __forceinline__ void phase_gemm_in(PP pp, int l, int bid, int nb, char* smem) {
  g8::DenseSched S{130, 14, nb, bid};
  EpiInProj E{(float*)(p.ws + OFF_P), (const float*)(p.ws + OFF_SCL), (const float*)(p.ws + OFF_SWIN) + (size_t)l * PINP};
  g8::gemm_stream<true>((LAS unsigned char*)smem, p.ws + OFF_H, p.ws + OFF_W + (size_t)l * WL_SIZE + WL_IN, S, E);
}

struct EpiOutProj {
  const float *xl, *xc, *mods; float *ol, *oc;
  __device__ __forceinline__ void operator()(const f32x4 (&acc)[2][2][4][2], const g8::GUnit& u, int wr, int wc, int fr, int fq) const {
    const bool lat = u.pm < 128;
    const float* xin = lat ? xl + (size_t)u.pm * 256 * 1024 : xc + (size_t)(u.pm - 128) * 256 * 1024;
    float* xo = lat ? ol + (size_t)u.pm * 256 * 1024 : oc + (size_t)(u.pm - 128) * 256 * 1024;
    const float* g1 = mods + (size_t)(lat ? (u.pm >> 6) : 2) * 6144 + 2048;
    const int row0 = wr * 64 + fr, col0 = u.pn * 256 + wc * 32 + 4 * fq;
#pragma unroll
    for (int bj = 0; bj < 2; ++bj)
#pragma unroll
      for (int n = 0; n < 2; ++n) {
        const f32x4 gv = *(const f32x4*)(g1 + col0 + bj * 128 + n * 16);
#pragma unroll
        for (int ai = 0; ai < 2; ++ai)
#pragma unroll
          for (int m = 0; m < 4; ++m) {
            const size_t o = (size_t)(row0 + ai * 128 + m * 16) * 1024 + col0 + bj * 128 + n * 16;
            const f32x4 xv = *(const f32x4*)(xin + o);
            *(f32x4*)(xo + o) = xv + gv * acc[ai][bj][m][n];
            if (m & 1) asm volatile("" ::: "memory");
          }
      }
  }
};
__device__ __forceinline__ void phase_gemm_out(PP pp, int l, int bid, int nb, char* smem) {
  g8::DenseSched S{(l == 0) ? 130 : 128, 4, nb, bid};
  EpiOutProj E{(l == 0) ? p.x : p.out, (l == 0) ? p.ctx : (const float*)(p.ws + OFF_CTX),
               (const float*)(p.ws + OFF_MODS) + (size_t)l * 3 * 6144, p.out, (float*)(p.ws + OFF_CTX)};
  g8::gemm_stream<false>((LAS unsigned char*)smem, p.ws + OFF_CC, p.ws + OFF_W + (size_t)l * WL_SIZE + WL_OUT, S, E);
}

#define LBAR() do { asm volatile("s_waitcnt lgkmcnt(0)" ::: "memory"); __builtin_amdgcn_s_barrier(); asm volatile("" ::: "memory"); } while (0)
__device__ __forceinline__ void phase_prep(PP pp, int l, int bid, int nb, char* smem) {
  const int tid = tid_opaque(), lane = tid & 63, wv = wave_id(tid);
  const float* P = (const float*)(p.ws + OFF_P);
  char* S = p.ws + OFF_S;
  bfr* QN = (bfr*)(S + S_QN);
  bfr* KN = (bfr*)(S + S_KN);
  bfr* VT = (bfr*)(S + S_VT);
  float* RWR = (float*)(S + S_RWR);
  float* RWKK = (float*)(S + S_RWKK);
  float* RWV = (float*)(S + S_RWV);
  float* RWG = (float*)(S + S_RWG);
  float* RWW = (float*)(S + S_RWW);
  float* RWKD = (float*)(S + S_RWKD);
  float* RWB = (float*)(S + S_RWB);
  float* BON = (float*)(S + S_BON);
  float* GDQ = (float*)(S + S_GDQ);
  float* GDK = (float*)(S + S_GDK);
  float* GDV = (float*)(S + S_GDV);
  float* GDAB = (float*)(S + S_GDAB);
  const float* mu = p.rw_mu + (size_t)l * 896;
  const float* w0 = p.rw_w0 + (size_t)l * 512;
  const float* w_up = p.rw_w_up + (size_t)l * 2 * 32 * 256;
  const float* a0 = p.rw_a0 + (size_t)l * 512;
  const float* a_up = p.rw_a_up + (size_t)l * 2 * 32 * 256;
  const float* g_up = p.rw_g_up + (size_t)l * 64 * 256;
  const float* k_k = p.rw_k_k + (size_t)l * 256;
  const float* k_a = p.rw_k_a + (size_t)l * 256;
  const float* r_k = p.rw_r_k + (size_t)l * 256;
  const float* conv_w = p.gd_conv_w + (size_t)l * 5 * 768;
  const float* A_log = p.gd_A_log + (size_t)l * 8;
  const float* dt_bias = p.gd_dt_bias + (size_t)l * 8;
  const float* qg = p.na_q_gain + (size_t)l * 64;
  const float* kg = p.na_k_gain + (size_t)l * 64;

  bfr* wl = (bfr*)smem;
  float* lor = (float*)(smem + 192 * 256 * 2);
  __syncthreads();
  for (int i = tid; i < 192 * 256; i += NTHR) {
    const int row = i >> 8, c = i & 255;
    const float v = row < 64 ? g_up[row * 256 + c] : row < 128 ? w_up[(row - 64) * 256 + c] : a_up[(row - 128) * 256 + c];
    wl[i] = f2bf(v);
  }
  __syncthreads();
  const int c = tid & 255, th = tid >> 8;
  const int h = c >> 6;
  const float kkc = k_k[c], kac = k_a[c], rkc = r_k[c];
  const float w00 = w0[c], w01 = w0[256 + c], a00 = a0[c], a01 = a0[256 + c];
  const float mur = mu[c], muk = mu[256 + c], muv = mu[512 + c];
  const float mul = (tid < 128) ? mu[768 + tid] : 0.f;
  const int nsecA = wv, nsecB = wv + 8;

  for (int tile = bid; tile < NTOK / 16; tile += nb) {
    const int m0 = tile * 16;
    int seq_lo, seq_hi, bb, tau0;
    if (m0 < NLAT) { bb = m0 >> 14; seq_lo = bb << 14; seq_hi = seq_lo + SEQ; tau0 = m0 - seq_lo; }
    else { bb = (m0 - NLAT) >> 8; seq_lo = NLAT + (bb << 8); seq_hi = seq_lo + CTXL; tau0 = SEQ + (m0 - seq_lo); }

    float pr[3][10], pl[18];
#pragma unroll
    for (int j = 0; j < 3; ++j)
#pragma unroll
      for (int t = 0; t < 10; ++t) {
        const int m = m0 + th * 8 - 1 + t;
        pr[j][t] = (m >= seq_lo && m < seq_hi) ? P[(size_t)m * PINP + A_END + j * 256 + c] : 0.f;
      }
    if (tid < 128) {
#pragma unroll
      for (int t = 0; t < 18; ++t) {
        const int m = m0 - 1 + t;
        pl[t] = (m >= seq_lo && m < seq_hi) ? P[(size_t)m * PINP + A_END + 768 + tid] : 0.f;
      }
#pragma unroll
      for (int t = 0; t < 16; ++t) {
        const float cur = pl[t + 1];
        const float v = cur + mul * (0.5f * (pl[t] + pl[t + 2]) - cur);
        lor[tid * 16 + t] = tid < 32 ? tanhf(v) : tid < 64 ? v : sigmoidf_(v);
      }
    }
    float rr[8], rk[8], rv[8];
#pragma unroll
    for (int t = 0; t < 8; ++t) {
      rr[t] = pr[0][t + 1] + mur * (0.5f * (pr[0][t] + pr[0][t + 2]) - pr[0][t + 1]);
      rk[t] = pr[1][t + 1] + muk * (0.5f * (pr[1][t] + pr[1][t + 2]) - pr[1][t + 1]);
      rv[t] = pr[2][t + 1] + muv * (0.5f * (pr[2][t] + pr[2][t + 2]) - pr[2][t + 1]);
    }
    LBAR();
    float pgA[20], pgB[20];
    {
      const int cA = nsecA * 64 + lane, cB = nsecB * 64 + lane;
#pragma unroll
      for (int t = 0; t < 20; ++t) {
        const int m = m0 - 2 + t;
        const bool ok = (m >= seq_lo && m < seq_hi);
        pgA[t] = ok ? P[(size_t)m * PINP + B_END + cA] : 0.f;
        pgB[t] = (ok && nsecB < 12) ? P[(size_t)m * PINP + B_END + cB] : 0.f;
      }
    }
    asm volatile("" ::: "memory");
#pragma unroll 1
    for (int ps = 0; ps < 2; ++ps) {
      const int tb = th * 8 + ps * 4;
      float4 gacc = make_float4(0.f, 0.f, 0.f, 0.f), wa0 = gacc, wa1 = gacc, aa0 = gacc, aa1 = gacc;
#pragma unroll 8
      for (int j = 0; j < 64; ++j) {
        const float wgt = __uint_as_float(((unsigned)wl[j * 256 + c]) << 16);
        const float4 s0 = *(const float4*)(lor + (64 + j) * 16 + tb);
        gacc.x += s0.x * wgt; gacc.y += s0.y * wgt; gacc.z += s0.z * wgt; gacc.w += s0.w * wgt;
      }
#pragma unroll 8
      for (int j = 0; j < 32; ++j) {
        const float4 t0 = *(const float4*)(lor + j * 16 + tb);
        const float4 d0 = *(const float4*)(lor + (32 + j) * 16 + tb);
        const float ww0 = __uint_as_float(((unsigned)wl[(64 + j) * 256 + c]) << 16), ww1 = __uint_as_float(((unsigned)wl[(96 + j) * 256 + c]) << 16);
        const float aw0 = __uint_as_float(((unsigned)wl[(128 + j) * 256 + c]) << 16), aw1 = __uint_as_float(((unsigned)wl[(160 + j) * 256 + c]) << 16);
        wa0.x += t0.x * ww0; wa0.y += t0.y * ww0; wa0.z += t0.z * ww0; wa0.w += t0.w * ww0;
        wa1.x += t0.x * ww1; wa1.y += t0.y * ww1; wa1.z += t0.z * ww1; wa1.w += t0.w * ww1;
        aa0.x += d0.x * aw0; aa0.y += d0.y * aw0; aa0.z += d0.z * aw0; aa0.w += d0.w * aw0;
        aa1.x += d0.x * aw1; aa1.y += d0.y * aw1; aa1.z += d0.z * aw1; aa1.w += d0.w * aw1;
      }
#pragma unroll
      for (int t = 0; t < 4; ++t) {
        const int tt = ps * 4 + t;
        const int m = m0 + th * 8 + tt;
        const float gv = t == 0 ? gacc.x : t == 1 ? gacc.y : t == 2 ? gacc.z : gacc.w;
        const float wv0 = t == 0 ? wa0.x : t == 1 ? wa0.y : t == 2 ? wa0.z : wa0.w;
        const float wv1 = t == 0 ? wa1.x : t == 1 ? wa1.y : t == 2 ? wa1.z : wa1.w;
        const float av0 = t == 0 ? aa0.x : t == 1 ? aa0.y : t == 2 ? aa0.z : aa0.w;
        const float av1 = t == 0 ? aa1.x : t == 1 ? aa1.y : t == 2 ? aa1.z : aa1.w;
        const float r = ps == 0 ? rr[t] : rr[4 + t], k = ps == 0 ? rk[t] : rk[4 + t], v = ps == 0 ? rv[t] : rv[4 + t];
        const float kkraw = k * kkc;
        const float ssum = wave_sum(kkraw * kkraw);
        const float kk = kkraw * rsqrtf(ssum + 1e-6f);
        float bon = 0.f;
#pragma unroll
        for (int d = 0; d < 2; ++d) {
          const float wlin = (d == 0 ? w00 + wv0 : w01 + wv1);
          const float w_log = -softplusf_(-wlin) - 0.5f;
          const float a = sigmoidf_(d == 0 ? a00 + av0 : a01 + av1);
          const float kd = k * (1.f + (a - 1.f) * kac);
          bon += r * kd * rkc;
          const size_t o = ((size_t)d * NTOK + m) * 256 + c;
          RWW[o] = -__expf(w_log); RWKD[o] = kd; RWB[o] = kk * a;
        }
        bon = wave_sum(bon);
        const size_t o = (size_t)m * 256 + c;
        RWR[o] = r; RWKK[o] = kk; RWV[o] = v; RWG[o] = gv;
        if (lane == 0) BON[(size_t)m * 4 + h] = bon;
      }
    }
    float pnA[16], pnB[16], pvt[16];
#pragma unroll
    for (int t = 0; t < 16; ++t) {
      pnA[t] = P[(size_t)(m0 + t) * PINP + nsecA * 64 + lane];
      pnB[t] = P[(size_t)(m0 + t) * PINP + nsecB * 64 + lane];
      pvt[t] = P[(size_t)(m0 + t) * PINP + 1024 + tid];
    }
    asm volatile("" ::: "memory");
#pragma unroll
    for (int q = 0; q < 2; ++q) {
      const int sec = q ? nsecB : nsecA;
      if (sec < 12) {
        const int cg = sec * 64 + lane;
        float cw[5];
#pragma unroll
        for (int j = 0; j < 5; ++j) cw[j] = conv_w[j * 768 + cg];
#pragma unroll
        for (int t = 0; t < 16; ++t) {
          float acc = 0.f;
#pragma unroll
          for (int j = 0; j < 5; ++j) acc += cw[j] * (q ? pgB[t + j] : pgA[t + j]);
          float val = siluf_(acc);
          const int m = m0 + t;
          if (sec < 8) {
            const float ss = wave_sum(val * val);
            val *= rsqrtf(ss + 1e-6f);
            if (sec < 4) GDQ[(size_t)m * 256 + sec * 64 + lane] = val * 0.125f;
            else GDK[(size_t)m * 256 + (sec - 4) * 64 + lane] = val;
          } else GDV[(size_t)m * 256 + (sec - 8) * 64 + lane] = val;
        }
      }
    }
    if (tid < 256) {
      const int t = tid >> 4, j = tid & 15;
      const int m = m0 + t;
      const float pv = P[(size_t)m * PINP + B_END + 1024 + j];
      float o;
      if (j < 8) o = -__expf(A_log[j]) * softplusf_(pv + dt_bias[j]);
      else o = sigmoidf_(pv);
      GDAB[(size_t)m * 16 + j] = o;
    }
#pragma unroll
    for (int q = 0; q < 2; ++q) {
      const int hs = q ? nsecB : nsecA;
#pragma unroll
      for (int t = 0; t < 16; ++t) {
        float val = q ? pnB[t] : pnA[t];
        const float ss = wave_sum(val * val);
        val *= rsqrtf(ss * (1.f / 64.f) + 1e-6f);
        const int m = m0 + t;
        if (hs < 8) QN[(size_t)m * 512 + hs * 64 + lane] = f2bf(val * qg[lane] * (0.125f * 1.4426950408889634f));
        else KN[(size_t)m * 512 + (hs - 8) * 64 + lane] = f2bf(val * kg[lane]);
      }
    }
    {
      bf16x8 o0, o1;
#pragma unroll
      for (int t = 0; t < 8; ++t) { o0[t] = (short)f2bf(pvt[t]); o1[t] = (short)f2bf(pvt[8 + t]); }
      bfr* dst = VT + ((size_t)(bb * 8 + (tid >> 6)) * (TTOK / 16) + (tau0 >> 4)) * 1024 + (tid & 63) * 16;
      *(bf16x8*)dst = o0;
      *(bf16x8*)(dst + 8) = o1;
    }
    LBAR();
  }
  __syncthreads();
}

__device__ __forceinline__ int scan_tok(int b, int d, int s) {
  if (s < CTXL) { int t = d ? (CTXL - 1 - s) : s; return NLAT + b * CTXL + t; }
  int u = s - CTXL; int t = d ? (SEQ - 1 - u) : u; return b * SEQ + t;
}
#define CS 72
#define SLOT_BYTES (64 * CS * 2)
#define F0_STRIDE 68
#define X1_F0 (13 * SLOT_BYTES)
#define X1_ARR (X1_F0 + 64 * F0_STRIDE * 4)

#define MM_FRAGS(As, Bs, a0, a1, b00, b01, b10, b11)                                                     \
  const bf16x8 a0 = *(const bf16x8*)((As) + ((mt * 16 + fr) * CS + fq * 8) * 2);                         \
  const bf16x8 a1 = *(const bf16x8*)((As) + ((mt * 16 + fr) * CS + 32 + fq * 8) * 2);                    \
  const bf16x8 b00 = *(const bf16x8*)((Bs) + ((nt0 * 16 + fr) * CS + fq * 8) * 2);                       \
  const bf16x8 b01 = *(const bf16x8*)((Bs) + ((nt0 * 16 + fr) * CS + 32 + fq * 8) * 2);                  \
  const bf16x8 b10 = *(const bf16x8*)((Bs) + ((nt0 * 16 + 16 + fr) * CS + fq * 8) * 2);                  \
  const bf16x8 b11 = *(const bf16x8*)((Bs) + ((nt0 * 16 + 16 + fr) * CS + 32 + fq * 8) * 2);
#define MM_2TILES(acc0, acc1, a0, a1, b00, b01, b10, b11)                                                \
  acc0 = __builtin_amdgcn_mfma_f32_16x16x32_bf16(a0, b00, acc0, 0, 0, 0);                                \
  acc0 = __builtin_amdgcn_mfma_f32_16x16x32_bf16(a1, b01, acc0, 0, 0, 0);                                \
  acc1 = __builtin_amdgcn_mfma_f32_16x16x32_bf16(a0, b10, acc1, 0, 0, 0);                                \
  acc1 = __builtin_amdgcn_mfma_f32_16x16x32_bf16(a1, b11, acc1, 0, 0, 0);
__device__ __forceinline__ void wr_T(char* slot, int mt, int nt, int fr, int fq, f32x4 v) {
  *(bf16x4*)(slot + ((nt * 16 + fr) * CS + mt * 16 + 4 * fq) * 2) = pack4(v[0], v[1], v[2], v[3]);
}

struct ChunkIn { float lw[8], f0[8], f1[8], f2[8], f3[8], xv[8], be[8]; };
template <bool GDN>
__device__ __forceinline__ void chunk_load(PP pp, int t, ChunkIn& ci) {
  const int tid = tid_opaque(), c = tid & 63, tg = wave_id(tid);
  const int chain = t / NCHUNK, n = t - chain * NCHUNK;
  const int d = chain & 1, h = (chain >> 1) & 3, b = (chain >> 3) & 1;
  const char* S = p.ws + OFF_S;
#pragma unroll
  for (int u = 0; u < 8; ++u) {
    const int m = scan_tok(b, d, n * 64 + tg * 8 + u);
    const size_t o = (size_t)m * 256 + h * 64 + c;
    if (!GDN) {
      ci.lw[u] = ((const float*)(S + S_RWW))[(size_t)d * NTOK * 256 + o];
      ci.f0[u] = ((const float*)(S + S_RWKK))[o];
      ci.f1[u] = ((const float*)(S + S_RWB))[(size_t)d * NTOK * 256 + o];
      ci.f2[u] = ((const float*)(S + S_RWKD))[(size_t)d * NTOK * 256 + o];
      ci.f3[u] = ((const float*)(S + S_RWR))[o];
      ci.xv[u] = ((const float*)(S + S_RWV))[o];
      ci.be[u] = 1.f;
    } else {
      ci.lw[u] = ((const float*)(S + S_GDAB))[(size_t)m * 16 + d * 4 + h];
      ci.be[u] = ((const float*)(S + S_GDAB))[(size_t)m * 16 + 8 + d * 4 + h];
      ci.f0[u] = ((const float*)(S + S_GDK))[o];
      ci.f3[u] = ((const float*)(S + S_GDQ))[o];
      ci.xv[u] = ((const float*)(S + S_GDV))[o];
      ci.f1[u] = 0.f; ci.f2[u] = 0.f;
    }
  }
}
template <bool GDN>
__device__ __forceinline__ void chunk_prep_task(PP pp, int t, int t_next, bool has_next, const ChunkIn& ci, ChunkIn& nx, char* smem) {
  const int chain = t / NCHUNK, n = t - chain * NCHUNK;
  const int d = chain & 1, h = (chain >> 1) & 3, b = (chain >> 3) & 1;
  (void)b; (void)d; (void)h;
  const int tid = tid_opaque(), lane = tid & 63, wv = wave_id(tid);
  const int fr = lane & 15, fq = lane >> 4, mt = wv >> 1, nt0 = (wv & 1) * 2;
  char* S = p.ws + OFF_S;
  char* CH = p.ws + OFF_CH;
  const size_t cc = (size_t)chain * NCHUNK + n;
  char* const p0 = smem;
  char* const p1 = smem + 1 * SLOT_BYTES;
  char* const p2 = smem + 2 * SLOT_BYTES;
  char* const p3 = smem + 3 * SLOT_BYTES;
  char* const p4 = smem + 4 * SLOT_BYTES;
  char* const p5 = smem + 5 * SLOT_BYTES;
  char* const p6 = smem + 6 * SLOT_BYTES;
  char* const p7 = smem + 7 * SLOT_BYTES;
  char* const p8 = smem + 8 * SLOT_BYTES;
  char* const p9 = smem + 9 * SLOT_BYTES;
  char* const p10 = smem + 10 * SLOT_BYTES;
  char* const p11 = smem + 11 * SLOT_BYTES;
  char* const p12 = smem + 12 * SLOT_BYTES;
  float* const F0 = (float*)(smem + X1_F0);
  float* const Lv = (float*)(smem + X1_ARR);
  float* const Lm1v = Lv + 64;
  float* const betav = Lv + 128;
  float* const eLv = Lv + 192;
  float* const gC = Lv + 256;
  float* const gsum = Lv + 320;
  char* const sKt = p0;
  char* const sBh = GDN ? p0 : p1;
  char* const sKh = GDN ? p0 : p2;

  {
    const int c = lane, tg = wv;
    const float* lw = ci.lw; const float* f0 = ci.f0; const float* f1 = ci.f1; const float* f2 = ci.f2; const float* f3 = ci.f3; const float* xv = ci.xv; const float* be = ci.be;
    float cum[8];
    cum[0] = lw[0];
#pragma unroll
    for (int u = 1; u < 8; ++u) cum[u] = cum[u - 1] + lw[u];
    gsum[tg * 64 + c] = cum[7];
    LBAR();
    float off = 0.f, LC = 0.f;
#pragma unroll
    for (int g2 = 0; g2 < 8; ++g2) { const float gs = gsum[g2 * 64 + c]; LC += gs; off += (g2 < tg) ? gs : 0.f; }
    bf16x8 vKtT, vBbT, vKbT, vXT;
#pragma unroll
    for (int u = 0; u < 8; ++u) {
      const int t = tg * 8 + u;
      const float L = off + cum[u], Lm1 = L - lw[u];
      if (!GDN) {
        const float eLm1 = __expf(Lm1), enL = __expf(-L), eL = __expf(L), eCL = __expf(LC - L);
        const float kt = f0[u] * eLm1;
        *(bfr*)(p0 + (t * CS + c) * 2) = f2bf(kt);
        *(bfr*)(p1 + (t * CS + c) * 2) = f2bf(f1[u] * enL);
        *(bfr*)(p2 + (t * CS + c) * 2) = f2bf(f2[u] * enL);
        *(bfr*)(p3 + (t * CS + c) * 2) = f2bf(f3[u] * eL);
        vKtT[u] = (short)f2bf(kt);
        vBbT[u] = (short)f2bf(f1[u] * eCL);
        vKbT[u] = (short)f2bf(f2[u] * eCL);
        vXT[u] = (short)f2bf(xv[u]);
      } else {
        *(bfr*)(p0 + (t * CS + c) * 2) = f2bf(f0[u]);
        *(bfr*)(p3 + (t * CS + c) * 2) = f2bf(f3[u]);
        vKtT[u] = (short)f2bf(f0[u] * __expf(Lm1));
        vBbT[u] = (short)f2bf(be[u] * f0[u] * __expf(LC - Lm1));
        vKbT[u] = (short)f2bf(f0[u] * __expf(LC - L));
        vXT[u] = (short)f2bf(be[u] * xv[u]);
        if (c == 0) { Lv[t] = L; Lm1v[t] = Lm1; betav[t] = be[u]; eLv[t] = __expf(L); }
      }
    }
    *(bf16x8*)(p4 + (c * CS + tg * 8) * 2) = vKtT;
    *(bf16x8*)(p5 + (c * CS + tg * 8) * 2) = vBbT;
    *(bf16x8*)(p6 + (c * CS + tg * 8) * 2) = vKbT;
    *(bf16x8*)(p7 + (c * CS + tg * 8) * 2) = vXT;
    if (tg == 0) gC[c] = __expf(LC);
    if (!GDN && tid < 64) { Lv[tid] = 0.f; Lm1v[tid] = 0.f; betav[tid] = 1.f; eLv[tid] = 1.f; }
  }
  LBAR();
  if (has_next) chunk_load<GDN>(pp, t_next, nx);
  {
    {
      MM_FRAGS(sKt, sBh, a0, a1, b00, b01, b10, b11)
      f32x4 c0 = {0.f, 0.f, 0.f, 0.f}, c1 = c0;
      MM_2TILES(c0, c1, a0, a1, b00, b01, b10, b11)
#pragma unroll
      for (int q = 0; q < 2; ++q) {
        const int sI = (nt0 + q) * 16 + fr;
        const f32x4 cv = q ? c1 : c0;
        f32x4 o;
#pragma unroll
        for (int r = 0; r < 4; ++r) {
          const int tI = mt * 16 + 4 * fq + r;
          float v = cv[r];
          if (GDN) v *= betav[sI] * __expf(fminf(Lm1v[tI] - Lm1v[sI], 0.f));
          o[r] = (sI < tI) ? v : 0.f;
        }
        *(f32x4*)(F0 + sI * F0_STRIDE + mt * 16 + 4 * fq) = o;
        wr_T(p11, mt, nt0 + q, fr, fq, o);
      }
    }
    {
      MM_FRAGS(sKt, sKh, a0, a1, b00, b01, b10, b11)
      f32x4 c0 = {0.f, 0.f, 0.f, 0.f}, c1 = c0;
      MM_2TILES(c0, c1, a0, a1, b00, b01, b10, b11)
#pragma unroll
      for (int q = 0; q < 2; ++q) {
        const int sI = (nt0 + q) * 16 + fr;
        const f32x4 cv = q ? c1 : c0;
        f32x4 o;
#pragma unroll
        for (int r = 0; r < 4; ++r) {
          const int tI = mt * 16 + 4 * fq + r;
          float v = cv[r];
          if (GDN) v *= __expf(fminf(Lm1v[tI] - Lv[sI], 0.f));
          o[r] = (sI < tI) ? v : 0.f;
        }
        wr_T(p9, mt, nt0 + q, fr, fq, o);
      }
    }
    {
      MM_FRAGS(sBh, p3, a0, a1, b00, b01, b10, b11)
      f32x4 c0 = {0.f, 0.f, 0.f, 0.f}, c1 = c0;
      MM_2TILES(c0, c1, a0, a1, b00, b01, b10, b11)
#pragma unroll
      for (int q = 0; q < 2; ++q) {
        const int tI = (nt0 + q) * 16 + fr;
        const f32x4 cv = q ? c1 : c0;
        f32x4 o;
#pragma unroll
        for (int r = 0; r < 4; ++r) {
          const int sI = mt * 16 + 4 * fq + r;
          float v = cv[r];
          if (GDN) v *= betav[sI] * __expf(fminf(Lv[tI] - Lm1v[sI], 0.f));
          o[r] = (sI <= tI) ? v : 0.f;
        }
        wr_T(p10, mt, nt0 + q, fr, fq, o);
      }
    }
  }
  LBAR();
  if (wv < 2) {
    const int base = wv * 32, other = 32 - base, c = lane & 31;
    float tr[32];
#pragma unroll
    for (int j = 0; j < 32; ++j) tr[j] = 0.f;
#pragma unroll
    for (int i = 31; i >= 0; --i) {
      float a0 = (c == i) ? 1.f : 0.f, a1 = 0.f, a2 = 0.f, a3 = 0.f;
#pragma unroll
      for (int jb = ((i + 1) & ~3); jb < 32; jb += 4) {
        const f32x4 a4 = *(const f32x4*)(F0 + (base + i) * F0_STRIDE + base + jb);
        a0 -= a4[0] * tr[jb]; a1 -= a4[1] * tr[jb + 1]; a2 -= a4[2] * tr[jb + 2]; a3 -= a4[3] * tr[jb + 3];
      }
      const float acc = (a0 + a1) + (a2 + a3);
      tr[i] = acc;
      if (lane < 32) {
        *(bfr*)(p8 + ((base + i) * CS + base + c) * 2) = f2bf(acc);
        *(bfr*)(p8 + ((base + i) * CS + other + c) * 2) = (bfr)0;
      }
    }
    if (lane < 32) {
#pragma unroll
      for (int q = 0; q < 4; ++q) {
        bf16x8 o, z;
#pragma unroll
        for (int j = 0; j < 8; ++j) { o[j] = (short)f2bf(tr[8 * q + j]); z[j] = 0; }
        *(bf16x8*)(p12 + ((base + c) * CS + base + 8 * q) * 2) = o;
        *(bf16x8*)(p12 + ((base + c) * CS + other + 8 * q) * 2) = z;
      }
    }
  }
  LBAR();
  {
    MM_FRAGS(p11, p12, a0, a1, b00, b01, b10, b11)
    f32x4 c0 = {0.f, 0.f, 0.f, 0.f}, c1 = c0;
    MM_2TILES(c0, c1, a0, a1, b00, b01, b10, b11)
    wr_T(p1, mt, nt0, fr, fq, c0);
    wr_T(p1, mt, nt0 + 1, fr, fq, c1);
  }
  LBAR();
  if (mt < 2 && nt0 == 2) {
    MM_FRAGS(p8, p1, a0, a1, b00, b01, b10, b11)
    f32x4 c0 = {0.f, 0.f, 0.f, 0.f}, c1 = c0;
    MM_2TILES(c0, c1, a0, a1, b00, b01, b10, b11)
#pragma unroll
    for (int r = 0; r < 4; ++r) {
      *(bfr*)(p8 + ((mt * 16 + 4 * fq + r) * CS + (nt0) * 16 + fr) * 2) = f2bf(-c0[r]);
      *(bfr*)(p8 + ((mt * 16 + 4 * fq + r) * CS + (nt0 + 1) * 16 + fr) * 2) = f2bf(-c1[r]);
    }
  }
  LBAR();
  {
    {
      MM_FRAGS(p8, p5, a0, a1, b00, b01, b10, b11)
      f32x4 c0 = {0.f, 0.f, 0.f, 0.f}, c1 = c0;
      MM_2TILES(c0, c1, a0, a1, b00, b01, b10, b11)
      wr_T(p11, mt, nt0, fr, fq, -c0);
      wr_T(p11, mt, nt0 + 1, fr, fq, -c1);
    }
    {
      MM_FRAGS(p8, p10, a0, a1, b00, b01, b10, b11)
      f32x4 c0 = {0.f, 0.f, 0.f, 0.f}, c1 = c0;
      MM_2TILES(c0, c1, a0, a1, b00, b01, b10, b11)
      wr_T(p12, mt, nt0, fr, fq, -c0);
      wr_T(p12, mt, nt0 + 1, fr, fq, -c1);
    }
  }
  LBAR();
  {
    {
      MM_FRAGS(p4, p11, a0, a1, b00, b01, b10, b11)
      f32x4 c0 = {0.f, 0.f, 0.f, 0.f}, c1 = c0;
      MM_2TILES(c0, c1, a0, a1, b00, b01, b10, b11)
#pragma unroll
      for (int q = 0; q < 2; ++q) {
        const int cp = (nt0 + q) * 16 + fr;
        f32x4 cv = q ? c1 : c0;
#pragma unroll
        for (int r = 0; r < 4; ++r) { const int cI = mt * 16 + 4 * fq + r; if (cI == cp) cv[r] += gC[cI]; }
        wr_T(p10, mt, nt0 + q, fr, fq, cv);
      }
    }
    {
      MM_FRAGS(p9, p11, a0, a1, b00, b01, b10, b11)
      f32x4 c0 = {0.f, 0.f, 0.f, 0.f}, c1 = c0;
      MM_2TILES(c0, c1, a0, a1, b00, b01, b10, b11)
#pragma unroll
      for (int q = 0; q < 2; ++q) {
        const int cp = (nt0 + q) * 16 + fr;
        f32x4 cv = q ? c1 : c0;
        const bf16x4 kb = *(const bf16x4*)(p6 + (cp * CS + mt * 16 + 4 * fq) * 2);
#pragma unroll
        for (int r = 0; r < 4; ++r) cv[r] += __uint_as_float(((unsigned)(unsigned short)kb[r]) << 16);
        wr_T(p8, mt, nt0 + q, fr, fq, cv);
      }
    }
    {
      MM_FRAGS(p4, p12, a0, a1, b00, b01, b10, b11)
      f32x4 c0 = {0.f, 0.f, 0.f, 0.f}, c1 = c0;
      MM_2TILES(c0, c1, a0, a1, b00, b01, b10, b11)
#pragma unroll
      for (int q = 0; q < 2; ++q) {
        const int tI = (nt0 + q) * 16 + fr;
        f32x4 cv = q ? c1 : c0;
        const bf16x4 rt = *(const bf16x4*)(p3 + (tI * CS + mt * 16 + 4 * fq) * 2);
        const float el = eLv[tI];
#pragma unroll
        for (int r = 0; r < 4; ++r) cv[r] += __uint_as_float(((unsigned)(unsigned short)rt[r]) << 16) * el;
        wr_T(p1, mt, nt0 + q, fr, fq, cv);
      }
    }
    {
      f32x4 c0 = {0.f, 0.f, 0.f, 0.f}, c1 = c0;
      {
        MM_FRAGS(sKh, p3, a0, a1, b00, b01, b10, b11)
        MM_2TILES(c0, c1, a0, a1, b00, b01, b10, b11)
      }
#pragma unroll
      for (int q = 0; q < 2; ++q) {
        const int tI = (nt0 + q) * 16 + fr;
#pragma unroll
        for (int r = 0; r < 4; ++r) {
          const int sI = mt * 16 + 4 * fq + r;
          float v = q ? c1[r] : c0[r];
          if (GDN) v *= __expf(fminf(Lv[tI] - Lv[sI], 0.f));
          v = (sI <= tI) ? v : 0.f;
          if (q) c1[r] = v; else c0[r] = v;
        }
      }
      {
        MM_FRAGS(p9, p12, a0, a1, b00, b01, b10, b11)
        MM_2TILES(c0, c1, a0, a1, b00, b01, b10, b11)
      }
      wr_T(p5, mt, nt0, fr, fq, c0);
      wr_T(p5, mt, nt0 + 1, fr, fq, c1);
    }
  }
  LBAR();
  {
    {
      MM_FRAGS(p8, p7, a0, a1, b00, b01, b10, b11)
      f32x4 c0 = {0.f, 0.f, 0.f, 0.f}, c1 = c0;
      MM_2TILES(c0, c1, a0, a1, b00, b01, b10, b11)
      bfr* QT = (bfr*)(CH + cc * CH_REC + CH_QT);
      *(bf16x4*)(QT + ((mt * 4 + nt0) * 64 + lane) * 4) = pack4(c0[0], c0[1], c0[2], c0[3]);
      *(bf16x4*)(QT + ((mt * 4 + nt0 + 1) * 64 + lane) * 4) = pack4(c1[0], c1[1], c1[2], c1[3]);
    }
    {
      MM_FRAGS(p7, p5, a0, a1, b00, b01, b10, b11)
      f32x4 c0 = {0.f, 0.f, 0.f, 0.f}, c1 = c0;
      MM_2TILES(c0, c1, a0, a1, b00, b01, b10, b11)
      bfr* YX = (bfr*)(CH + cc * CH_REC + CH_YX);
      *(bf16x4*)(YX + ((mt * 4 + nt0) * 64 + lane) * 4) = pack4(c0[0], c0[1], c0[2], c0[3]);
      *(bf16x4*)(YX + ((mt * 4 + nt0 + 1) * 64 + lane) * 4) = pack4(c1[0], c1[1], c1[2], c1[3]);
    }
    {
      const int fm = wv >> 1, fa = wv & 1;
      const int row = fm * 16 + fr;
      {
        const bf16x4 lo = *(const bf16x4*)(p10 + (row * CS + 32 * fa + 4 * fq) * 2);
        const bf16x4 hi = *(const bf16x4*)(p10 + (row * CS + 32 * fa + 16 + 4 * fq) * 2);
        bf16x8 f; f[0] = lo[0]; f[1] = lo[1]; f[2] = lo[2]; f[3] = lo[3]; f[4] = hi[0]; f[5] = hi[1]; f[6] = hi[2]; f[7] = hi[3];
        *(bf16x8*)(CH + cc * CH_REC + CH_PT + (size_t)((fm * 2 + fa) * 64 + lane) * 16) = f;
      }
      {
        const bf16x4 lo = *(const bf16x4*)(p1 + (row * CS + 32 * fa + 4 * fq) * 2);
        const bf16x4 hi = *(const bf16x4*)(p1 + (row * CS + 32 * fa + 16 + 4 * fq) * 2);
        bf16x8 f; f[0] = lo[0]; f[1] = lo[1]; f[2] = lo[2]; f[3] = lo[3]; f[4] = hi[0]; f[5] = hi[1]; f[6] = hi[2]; f[7] = hi[3];
        *(bf16x8*)(CH + cc * CH_REC + CH_RYT + (size_t)((fm * 2 + fa) * 64 + lane) * 16) = f;
      }
    }
  }
  LBAR();
}

template <bool GDN>
__device__ __forceinline__ void chunk_prep_loop(PP pp, int t0, int tend, int nb, char* smem) {
  ChunkIn cur, nxt;
  if (t0 < tend) chunk_load<GDN>(pp, t0, cur);
  for (int t = t0; t < tend; t += nb) {
    const bool has_next = (t + nb) < tend;
    chunk_prep_task<GDN>(pp, t, t + nb, has_next, cur, nxt, smem);
    cur = nxt;
  }
}
__device__ __forceinline__ void phase_chunk_prep(PP pp, int bid, int nb, char* smem) {
  __syncthreads();
  const int half = (NCHAIN / 2) * NCHUNK;
  chunk_prep_loop<false>(pp, bid, half, nb, smem);
  const int k0 = (half - bid + nb - 1) / nb;
  chunk_prep_loop<true>(pp, bid + k0 * nb, NCHAIN * NCHUNK, nb, smem);
  __syncthreads();
}

#define X2_BUF 32768
#define X2_BAR() do { asm volatile("s_waitcnt lgkmcnt(0)" ::: "memory"); __builtin_amdgcn_s_barrier(); asm volatile("" ::: "memory"); } while (0)
__device__ __forceinline__ void chunk_seq_chain(PP pp, int chain, char* smem) {
  __syncthreads();
  const int tid = tid_opaque(), lane = tid & 63, wv = wave_id(tid);
  const int d = chain & 1, h = (chain >> 1) & 3, b = (chain >> 3) & 1, ty = chain >> 4;
  const char* CH = p.ws + OFF_CH;
  float* Y = (float*)(p.ws + OFF_S + (ty ? S_YGD : S_YRW)) + (size_t)d * NTOK * 256;
  const size_t c0 = (size_t)chain * NCHUNK;
  if (wv >= 4) {
    const int lw = wv - 4;
    const char* src0 = CH + c0 * CH_REC + (size_t)lane * 16;
#define X2_DMA(n) { const char* s_ = src0 + (size_t)(n) * CH_REC; LAS unsigned char* d_ = (LAS unsigned char*)smem + ((n) & 3) * X2_BUF;       \
      _Pragma("unroll") for (int i = 0; i < 8; ++i) {                                                                                       \
        const int piece = i * 4 + lw;                                                                                                       \
        __builtin_amdgcn_global_load_lds((const unsigned*)(s_ + piece * 1024), (LAS unsigned*)(d_ + piece * 1024), 16, 0, 0); } }
    X2_DMA(0) X2_DMA(1) X2_DMA(2)
    asm volatile("s_waitcnt vmcnt(16)" ::: "memory");
    X2_BAR();
    for (int n = 0; n < NCHUNK; ++n) {
      if (n + 3 < NCHUNK) { X2_DMA(n + 3) asm volatile("s_waitcnt vmcnt(16)" ::: "memory"); }
      else if (n + 2 < NCHUNK) asm volatile("s_waitcnt vmcnt(8)" ::: "memory");
      else asm volatile("s_waitcnt vmcnt(0)" ::: "memory");
      X2_BAR();
    }
#undef X2_DMA
  } else {
    const int vt = wv, fr = lane & 15, fq = lane >> 4;
    f32x4 Sacc[4];
#pragma unroll
    for (int i = 0; i < 4; ++i) Sacc[i] = (f32x4){0.f, 0.f, 0.f, 0.f};
    X2_BAR();
    for (int n = 0; n < NCHUNK; ++n) {
      const char* buf = smem + (n & 3) * X2_BUF;
      bf16x8 sB0, sB1;
#pragma unroll
      for (int j = 0; j < 4; ++j) {
        sB0[j] = (short)f2bf(Sacc[0][j]); sB0[4 + j] = (short)f2bf(Sacc[1][j]);
        sB1[j] = (short)f2bf(Sacc[2][j]); sB1[4 + j] = (short)f2bf(Sacc[3][j]);
      }
#pragma unroll
      for (int m = 0; m < 4; ++m) {
        const bf16x8 pa0 = *(const bf16x8*)(buf + ((m * 2 + 0) * 64 + lane) * 16);
        const bf16x8 pa1 = *(const bf16x8*)(buf + ((m * 2 + 1) * 64 + lane) * 16);
        const bf16x8 ra0 = *(const bf16x8*)(buf + 8192 + ((m * 2 + 0) * 64 + lane) * 16);
        const bf16x8 ra1 = *(const bf16x8*)(buf + 8192 + ((m * 2 + 1) * 64 + lane) * 16);
        const bf16x4 qb = *(const bf16x4*)(buf + 16384 + ((m * 4 + vt) * 64 + lane) * 8);
        const bf16x4 yb = *(const bf16x4*)(buf + 24576 + ((vt * 4 + m) * 64 + lane) * 8);
        f32x4 y = {bf2f(yb[0]), bf2f(yb[1]), bf2f(yb[2]), bf2f(yb[3])};
        y = __builtin_amdgcn_mfma_f32_16x16x32_bf16(sB0, ra0, y, 0, 0, 0);
        y = __builtin_amdgcn_mfma_f32_16x16x32_bf16(sB1, ra1, y, 0, 0, 0);
        f32x4 sn = {bf2f(qb[0]), bf2f(qb[1]), bf2f(qb[2]), bf2f(qb[3])};
        sn = __builtin_amdgcn_mfma_f32_16x16x32_bf16(pa0, sB0, sn, 0, 0, 0);
        sn = __builtin_amdgcn_mfma_f32_16x16x32_bf16(pa1, sB1, sn, 0, 0, 0);
        Sacc[m] = sn;
        {
          const int mm = scan_tok(b, d, n * 64 + m * 16 + fr);
          *(f32x4*)(Y + (size_t)mm * 256 + h * 64 + vt * 16 + 4 * fq) = y;
        }
      }
      X2_BAR();
    }
  }
}

struct NaPair { int mk0, mk1, tau0, tau1, kr0, kr1, ct0, ct1; };
struct NaFrag { bf16x8 k00, k01, k10, k11; bf16x4 v0[4], v1[4]; };

__device__ __forceinline__ void na_load(NaFrag& f, const bfr* KN, const bfr* VT, size_t vt_base, int h, int fr, int fq, const NaPair& pr) {
  const bfr* k0 = KN + (size_t)(pr.mk0 + fr) * 512 + h * 64 + fq * 8;
  const bfr* k1 = KN + (size_t)(pr.mk1 + fr) * 512 + h * 64 + fq * 8;
  f.k00 = *(const bf16x8*)(k0); f.k01 = *(const bf16x8*)(k0 + 32);
  f.k10 = *(const bf16x8*)(k1); f.k11 = *(const bf16x8*)(k1 + 32);
#pragma unroll
  for (int dt = 0; dt < 4; ++dt) {
    const int vo = (dt * 16 + fr) * 16 + fq * 4;
    f.v0[dt] = *(const bf16x4*)(VT + vt_base + (size_t)(pr.tau0 >> 4) * 1024 + vo);
    f.v1[dt] = *(const bf16x4*)(VT + vt_base + (size_t)(pr.tau1 >> 4) * 1024 + vo);
  }
}

__device__ __forceinline__ void na_compute(const NaFrag& f, const bf16x8 qf0, const bf16x8 qf1, bool local, bool vr0, bool vr1,
                                           int dr0, int dr1, int ct0, int ct1, int qc, int fq, const float* bias_h, f32x4 (&O)[4], float& lsum) {
  f32x4 z = {0.f, 0.f, 0.f, 0.f};
  f32x4 st0 = __builtin_amdgcn_mfma_f32_16x16x32_bf16(f.k00, qf0, z, 0, 0, 0);
  st0 = __builtin_amdgcn_mfma_f32_16x16x32_bf16(f.k01, qf1, st0, 0, 0, 0);
  f32x4 st1 = __builtin_amdgcn_mfma_f32_16x16x32_bf16(f.k10, qf0, z, 0, 0, 0);
  st1 = __builtin_amdgcn_mfma_f32_16x16x32_bf16(f.k11, qf1, st1, 0, 0, 0);
  bf16x8 pf;
  if (local) {
    const int cs = min(max(qc - 8, 0), 48);
#pragma unroll
    for (int r = 0; r < 4; ++r) {
      const int kc0 = ct0 * 16 + fq * 4 + r, kc1 = ct1 * 16 + fq * 4 + r;
      float p0 = 0.f, p1 = 0.f;
      if (vr0 && (unsigned)(kc0 - cs) < 16u) p0 = exp2f(st0[r] + bias_h[dr0 * 31 + (kc0 - qc + 15)]);
      if (vr1 && (unsigned)(kc1 - cs) < 16u) p1 = exp2f(st1[r] + bias_h[dr1 * 31 + (kc1 - qc + 15)]);
      lsum += p0 + p1;
      pf[r] = (short)f2bf(p0);
      pf[4 + r] = (short)f2bf(p1);
    }
  } else {
#pragma unroll
    for (int r = 0; r < 4; ++r) {
      const float p0 = exp2f(st0[r]), p1 = exp2f(st1[r]);
      lsum += p0 + p1;
      pf[r] = (short)f2bf(p0);
      pf[4 + r] = (short)f2bf(p1);
    }
  }
#pragma unroll
  for (int dt = 0; dt < 4; ++dt) {
    bf16x8 vf;
    vf[0] = f.v0[dt][0]; vf[1] = f.v0[dt][1]; vf[2] = f.v0[dt][2]; vf[3] = f.v0[dt][3];
    vf[4] = f.v1[dt][0]; vf[5] = f.v1[dt][1]; vf[6] = f.v1[dt][2]; vf[7] = f.v1[dt][3];
    O[dt] = __builtin_amdgcn_mfma_f32_16x16x32_bf16(vf, pf, O[dt], 0, 0, 0);
  }
}

__device__ __forceinline__ void na_block_task(PP pp, int task, const float* bias_lds) {
  const int tid = tid_opaque(), lane = tid & 63, wv = wave_id(tid);
  const int fr = lane & 15, fq = lane >> 4;
  char* S = p.ws + OFF_S;
  const bfr* QN = (const bfr*)(S + S_QN);
  const bfr* KN = (const bfr*)(S + S_KN);
  const bfr* VT = (const bfr*)(S + S_VT);
  bfr* CC = (bfr*)(p.ws + OFF_CC);
  const bool latent = task < 1024;
  int b, h, mqa, mqb, qra = 0, qrb = 0, cgp = 0;
  if (latent) {
    h = task & 7; const int quad = (task >> 3) & 63; b = task >> 9;
    qra = quad * 4 + (wv >> 2) * 2; qrb = qra + 1; cgp = wv & 3;
    mqa = b * SEQ + qra * 64 + cgp * 16; mqb = mqa + 64;
  } else {
    const int u = task - 1024;
    h = u & 7; b = u >> 3;
    mqa = NLAT + b * CTXL + (wv * 2) * 16; mqb = mqa + 16;
  }
  const bf16x8 qa0 = *(const bf16x8*)(QN + (size_t)(mqa + fr) * 512 + h * 64 + fq * 8);
  const bf16x8 qa1 = *(const bf16x8*)(QN + (size_t)(mqa + fr) * 512 + h * 64 + 32 + fq * 8);
  const bf16x8 qb0 = *(const bf16x8*)(QN + (size_t)(mqb + fr) * 512 + h * 64 + fq * 8);
  const bf16x8 qb1 = *(const bf16x8*)(QN + (size_t)(mqb + fr) * 512 + h * 64 + 32 + fq * 8);
  f32x4 Oa[4], Ob[4];
#pragma unroll
  for (int dt = 0; dt < 4; ++dt) { Oa[dt] = (f32x4){0.f, 0.f, 0.f, 0.f}; Ob[dt] = Oa[dt]; }
  float lsa = 0.f, lsb = 0.f;
  const size_t vt_base = (size_t)(b * 8 + h) * 64 * TTOK;
  const int rsa = min(max(qra - 4, 0), SEQ / 64 - 8), rsb = min(max(qrb - 4, 0), SEQ / 64 - 8);
  const int nrows = latent ? (rsb - rsa + 8) : 0;
  const int ct_first = (cgp <= 1) ? 0 : cgp - 1;
  const int nct = (cgp == 0 || cgp == 3) ? 2 : 3;
  const int ntile = nrows * nct;
  const int nlp = (ntile + 1) >> 1;
  const int npair = nlp + 8;
  const int qc = cgp * 16 + fr;
  auto mkpair = [&](int pi) {
    NaPair pr;
    if (pi < nlp) {
      const int i0 = 2 * pi, i1 = min(2 * pi + 1, ntile - 1);
      pr.kr0 = rsa + i0 / nct; pr.ct0 = ct_first + i0 % nct;
      pr.kr1 = rsa + i1 / nct; pr.ct1 = ct_first + i1 % nct;
      if (2 * pi + 1 >= ntile) pr.kr1 = -100;
      const int r1 = rsa + i1 / nct;
      pr.tau0 = pr.kr0 * 64 + pr.ct0 * 16; pr.tau1 = r1 * 64 + pr.ct1 * 16;
      pr.mk0 = b * SEQ + pr.tau0; pr.mk1 = b * SEQ + pr.tau1;
    } else {
      const int c = pi - nlp;
      pr.kr0 = pr.kr1 = pr.ct0 = pr.ct1 = 0;
      pr.tau0 = SEQ + c * 32; pr.tau1 = SEQ + c * 32 + 16;
      pr.mk0 = NLAT + b * CTXL + c * 32; pr.mk1 = pr.mk0 + 16;
    }
    return pr;
  };
  NaFrag fa, fb;
  NaPair pa = mkpair(0), pb;
  na_load(fa, KN, VT, vt_base, h, fr, fq, pa);
  const float* bias_h = bias_lds + h * 465;
#define NA_DO(F, PR, PI)                                                                                          \
  {                                                                                                               \
    const bool loc_ = (PI) < nlp;                                                                                 \
    na_compute(F, qa0, qa1, loc_, (unsigned)(PR.kr0 - rsa) < 8u, (unsigned)(PR.kr1 - rsa) < 8u,                   \
               PR.kr0 - qra + 7, PR.kr1 - qra + 7, PR.ct0, PR.ct1, qc, fq, bias_h, Oa, lsa);                      \
    na_compute(F, qb0, qb1, loc_, (unsigned)(PR.kr0 - rsb) < 8u, (unsigned)(PR.kr1 - rsb) < 8u,                   \
               PR.kr0 - qrb + 7, PR.kr1 - qrb + 7, PR.ct0, PR.ct1, qc, fq, bias_h, Ob, lsb);                      \
  }
  for (int pi = 0; pi < npair; pi += 2) {
    if (pi + 1 < npair) { pb = mkpair(pi + 1); na_load(fb, KN, VT, vt_base, h, fr, fq, pb); }
    NA_DO(fa, pa, pi)
    if (pi + 1 < npair) {
      if (pi + 2 < npair) { pa = mkpair(pi + 2); na_load(fa, KN, VT, vt_base, h, fr, fq, pa); }
      NA_DO(fb, pb, pi + 1)
    }
  }
#undef NA_DO
  lsa += shfl_xor_l(lsa, 16, lane); lsa += shfl_xor_l(lsa, 32, lane);
  lsb += shfl_xor_l(lsb, 16, lane); lsb += shfl_xor_l(lsb, 32, lane);
  const float ia = 1.f / lsa, ib = 1.f / lsb;
#pragma unroll
  for (int dt = 0; dt < 4; ++dt) {
    *(bf16x4*)(CC + (size_t)(mqa + fr) * 1024 + h * 64 + dt * 16 + fq * 4) = pack4(Oa[dt][0] * ia, Oa[dt][1] * ia, Oa[dt][2] * ia, Oa[dt][3] * ia);
    *(bf16x4*)(CC + (size_t)(mqb + fr) * 1024 + h * 64 + dt * 16 + fq * 4) = pack4(Ob[dt][0] * ib, Ob[dt][1] * ib, Ob[dt][2] * ib, Ob[dt][3] * ib);
  }
}

__device__ __forceinline__ void phase_mix(PP pp, int l, int bid, int nb, char* smem) {
  const int tid = tid_opaque();
  const int nscan_blocks = (nb > 32) ? 32 : nb;
  const int first_attn_block = (nb > 32) ? 32 : 0;
  if (bid < nscan_blocks) {
    for (int c = bid; c < NCHAIN; c += nscan_blocks) chunk_seq_chain(pp, c, smem);
  }
  if (bid >= first_attn_block) {
    float* bias = (float*)smem;
    __syncthreads();
    for (int i = tid; i < 8 * 465; i += NTHR) bias[i] = p.na_rpb[(size_t)l * 8 * 465 + i] * 1.4426950408889634f;
    __syncthreads();
    const int ntask = (l == 0) ? 1024 + 16 : 1024;
    const int nab = nb - first_attn_block;
    for (int t = bid - first_attn_block; t < ntask; t += nab) na_block_task(pp, t, bias);
  }
}

__device__ __forceinline__ void phase_post(PP pp, int l, int bid, int nb) {
  const int tid = tid_opaque(), lane = tid & 63, wv = wave_id(tid);
  char* S = p.ws + OFF_S;
  const float* YRW = (const float*)(S + S_YRW);
  const float* YGD = (const float*)(S + S_YGD);
  const float* RWV = (const float*)(S + S_RWV);
  const float* RWG = (const float*)(S + S_RWG);
  const float* BON = (const float*)(S + S_BON);
  const float* P = (const float*)(p.ws + OFF_P);
  bfr* CC = (bfr*)(p.ws + OFF_CC);
  const float* ln_w = p.rw_ln_w + (size_t)l * 256;
  const float* ln_b = p.rw_ln_b + (size_t)l * 256;
  const float* ng = p.gd_norm_g + (size_t)l * 64;
  const int ntok = (l == 0) ? NTOK : NLAT;
  for (int wt = bid * 8 + wv; wt < ntok * 8; wt += nb * 8) {
    int m = wt >> 3, hs = wt & 7;
    if (hs < 4) {
      int c = hs * 64 + lane;
      size_t o = (size_t)m * 256 + c;
      float y = YRW[o] + YRW[(size_t)NTOK * 256 + o];
      float mean = wave_sum(y) * (1.f / 64.f);
      float dv = y - mean;
      float var = wave_sum(dv * dv) * (1.f / 64.f);
      float yn = dv * rsqrtf(var + 64e-5f) * ln_w[c] + ln_b[c];
      float out = (yn + BON[(size_t)m * 4 + hs] * RWV[o]) * RWG[o];
      CC[(size_t)m * 1024 + 512 + c] = f2bf(out);
    } else {
      int c = (hs - 4) * 64 + lane;
      size_t o = (size_t)m * 256 + c;
      float y = YGD[o] + YGD[(size_t)NTOK * 256 + o];
      float ms = wave_sum(y * y) * (1.f / 64.f);
      float z = P[(size_t)m * PINP + B_END + 768 + c];
      float out = y * rsqrtf(ms + 1e-6f) * ng[lane] * siluf_(z);
      CC[(size_t)m * 1024 + 768 + c] = f2bf(out);
    }
  }
}

#define RW_LDS_ROW 36
__device__ __forceinline__ void phase_router(PP pp, int l, int bid, int nb, char* smem) {
  const int tid = tid_opaque(), lane = tid & 63, wv = wave_id(tid);
  const float* xl = p.out;
  const float* xc = (const float*)(p.ws + OFF_CTX);
  const float* mods = (const float*)(p.ws + OFF_MODS) + (size_t)l * 3 * 6144;
  const float* g = p.norm_ffn_g + (size_t)l * 1024;
  const float* rw = p.moe_router_w + (size_t)l * 1024 * 32;
  const float* rb = p.moe_router_b + (size_t)l * 32;
  bfr* H = (bfr*)(p.ws + OFF_H);
  int* cnt = (int*)(p.ws + OFF_CNT);
  int* TOKE = (int*)(p.ws + OFF_TOKE);
  int* TOKP = (int*)(p.ws + OFF_TOKP);
  float* TOKG = (float*)(p.ws + OFF_TOKG);
  float* wl = (float*)smem;
  for (int i = tid; i < 1024 * 8; i += NTHR) {
    int d = i >> 3, q = i & 7;
    *(float4*)(wl + d * RW_LDS_ROW + q * 4) = *(const float4*)(rw + (size_t)d * 32 + q * 4);
  }
  __syncthreads();
  const int ntok = (l == 0) ? NTOK : NLAT;
  const float rbl = rb[lane & 31];
  for (int m0 = (bid * 8 + wv) * 2; m0 < ntok; m0 += nb * 16) {
    float acc0[32], acc1[32];
#pragma unroll
    for (int e = 0; e < 32; ++e) { acc0[e] = 0.f; acc1[e] = 0.f; }
    float hv0[16], hv1[16];
    {
      const int ma = m0, mb = m0 + 1;
      const float* xa = (ma < NLAT) ? xl + (size_t)ma * 1024 : xc + (size_t)(ma - NLAT) * 1024;
      const float* xb = (mb < NLAT) ? xl + (size_t)mb * 1024 : xc + (size_t)(mb - NLAT) * 1024;
      const float* mda = mods + (size_t)mod_row(ma) * 6144 + 3072;
      const float* mdb = mods + (size_t)mod_row(mb) * 6144 + 3072;
      float ssa = 0.f, ssb = 0.f;
#pragma unroll
      for (int i = 0; i < 16; ++i) { hv0[i] = xa[lane + 64 * i]; hv1[i] = xb[lane + 64 * i]; }
#pragma unroll
      for (int i = 0; i < 16; ++i) { ssa += hv0[i] * hv0[i]; ssb += hv1[i] * hv1[i]; }
      ssa = wave_sum(ssa); ssb = wave_sum(ssb);
      const float rsa = rsqrtf(ssa * (1.f / 1024.f) + 1e-6f), rsb = rsqrtf(ssb * (1.f / 1024.f) + 1e-6f);
#pragma unroll
      for (int i = 0; i < 16; ++i) {
        const int d = lane + 64 * i;
        const float gg = g[d];
        hv0[i] = hv0[i] * rsa * gg * (1.f + mda[1024 + d]) + mda[d];
        hv1[i] = hv1[i] * rsb * gg * (1.f + mdb[1024 + d]) + mdb[d];
      }
      float am0 = 0.f, am1 = 0.f;
#pragma unroll
      for (int i = 0; i < 16; ++i) { am0 = fmaxf(am0, fabsf(hv0[i])); am1 = fmaxf(am1, fabsf(hv1[i])); }
      am0 = wave_max(am0); am1 = wave_max(am1);
      const float sc0 = am0 > 0.f ? am0 * (1.f / 127.f) : 1.f, sc1 = am1 > 0.f ? am1 * (1.f / 127.f) : 1.f;
      const float iv0 = 1.f / sc0, iv1 = 1.f / sc1;
      signed char* H8 = (signed char*)(p.ws + OFF_H);
#pragma unroll
      for (int i = 0; i < 16; ++i) {
        const int d = lane + 64 * i;
        H8[(size_t)ma * 1024 + d] = (signed char)(int)fminf(fmaxf(rintf(hv0[i] * iv0), -127.f), 127.f);
        H8[(size_t)mb * 1024 + d] = (signed char)(int)fminf(fmaxf(rintf(hv1[i] * iv1), -127.f), 127.f);
      }
      if (lane == 0) { float* SCL = (float*)(p.ws + OFF_SCL); SCL[ma] = sc0; SCL[mb] = sc1; }
      asm volatile("" ::: "memory");
    }
#pragma unroll
    for (int i = 0; i < 16; ++i) {
      if ((i & 3) == 0) asm volatile("" ::: "memory");
      const float* wr = wl + (lane + 64 * i) * RW_LDS_ROW;
#pragma unroll
      for (int q = 0; q < 8; ++q) {
        const float4 w = *(const float4*)(wr + q * 4);
        acc0[q * 4 + 0] += hv0[i] * w.x; acc0[q * 4 + 1] += hv0[i] * w.y; acc0[q * 4 + 2] += hv0[i] * w.z; acc0[q * 4 + 3] += hv0[i] * w.w;
        acc1[q * 4 + 0] += hv1[i] * w.x; acc1[q * 4 + 1] += hv1[i] * w.y; acc1[q * 4 + 2] += hv1[i] * w.z; acc1[q * 4 + 3] += hv1[i] * w.w;
      }
    }
#define BFLY(A, N, D)                                                                           \
    _Pragma("unroll") for (int i = 0; i < (N); ++i) {                                            \
      const bool up = (lane & (D)) != 0;                                                         \
      const float keep = up ? A[i + (N)] : A[i];                                                 \
      const float send = up ? A[i] : A[i + (N)];                                                 \
      A[i] = keep + shfl_xor_l(send, (D), lane);                                                   \
    }
    BFLY(acc0, 16, 16) BFLY(acc1, 16, 16)
    BFLY(acc0, 8, 8) BFLY(acc1, 8, 8)
    BFLY(acc0, 4, 4) BFLY(acc1, 4, 4)
    BFLY(acc0, 2, 2) BFLY(acc1, 2, 2)
    BFLY(acc0, 1, 1) BFLY(acc1, 1, 1)
#undef BFLY
    float la = acc0[0] + shfl_xor_l(acc0[0], 32, lane);
    float lb = acc1[0] + shfl_xor_l(acc1[0], 32, lane);
    const int my_e = lane & 31;
    la += rbl; lb += rbl;
    (void)my_e;
#pragma unroll
    for (int tkn = 0; tkn < 2; ++tkn) {
      float v = tkn == 0 ? la : lb;
      float tv[4]; int ti[4];
#pragma unroll
      for (int k = 0; k < 4; ++k) {
        float bv = v; int bi = lane & 31;
#pragma unroll
        for (int o = 16; o >= 1; o >>= 1) {
          float ov = shfl_xor_l(bv, o, lane); int oi = shfl_xor_li(bi, o, lane);
          bool take = (ov > bv) || (ov == bv && oi < bi);
          bv = take ? ov : bv; bi = take ? oi : bi;
        }
        tv[k] = bv; ti[k] = bi;
        if ((lane & 31) == bi) v = -3.0e38f;
      }
      float e1 = __expf(tv[1] - tv[0]), e2 = __expf(tv[2] - tv[0]), e3 = __expf(tv[3] - tv[0]);
      float inv = 1.f / (1.f + e1 + e2 + e3);
      const int m = m0 + tkn;
      if (lane < 4) {
        int e = lane == 0 ? ti[0] : lane == 1 ? ti[1] : lane == 2 ? ti[2] : ti[3];
        float gt = (lane == 0 ? 1.f : lane == 1 ? e1 : lane == 2 ? e2 : e3) * inv;
        int pos = atomicAdd(&cnt[e], 1);
        TOKE[(size_t)m * 4 + lane] = e; TOKP[(size_t)m * 4 + lane] = pos; TOKG[(size_t)m * 4 + lane] = gt;
      }
    }
  }
  __syncthreads();
}

__device__ __forceinline__ void moe_offsets(PP pp, int* toff) {
  const int* cnt = (const int*)(p.ws + OFF_CNT);
  if (tid_opaque() == 0) {
    int a = 0;
    for (int e = 0; e < 32; ++e) { toff[e] = a; a += (cnt[e] + 255) >> 8; }
    toff[32] = a;
  }
  __syncthreads();
}

__device__ __forceinline__ void phase_slotfill(PP pp, int l, int bid, int nb, char* smem) {
  int* toff = (int*)smem;
  moe_offsets(pp, toff);
  const int tid = tid_opaque(), lane = tid & 63, wv = wave_id(tid);
  const int* TOKE = (const int*)(p.ws + OFF_TOKE);
  const int* TOKP = (const int*)(p.ws + OFF_TOKP);
  const float* TOKG = (const float*)(p.ws + OFF_TOKG);
  const int* cnt = (const int*)(p.ws + OFF_CNT);
  int* TOKS = (int*)(p.ws + OFF_TOKS);
  float* SLG = (float*)(p.ws + OFF_SLG);
  float* SLS = (float*)(p.ws + OFF_SLS);
  const float* SCL = (const float*)(p.ws + OFF_SCL);
  const signed char* H8 = (const signed char*)(p.ws + OFF_H);
  signed char* XG = (signed char*)(p.ws + OFF_S);
  const int n = ((l == 0) ? NTOK : NLAT) * 4;
  for (int i = bid * 8 + wv; i < n; i += nb * 8) {
    int e = TOKE[i];
    int slot = toff[e] * 256 + TOKP[i];
    if (lane == 0) { TOKS[i] = slot; SLG[slot] = TOKG[i]; SLS[slot] = SCL[i >> 2]; }
    const uint4* src = (const uint4*)(H8 + (size_t)(i >> 2) * 1024);
    uint4* dst = (uint4*)(XG + (size_t)slot * 1024);
    dst[lane] = src[lane];
  }
  for (int e = 0; e < 32; ++e) {
    const int c = cnt[e];
    const int npad = ((c + 255) & ~255) - c;
    const int base = toff[e] * 256 + c;
    for (int r = bid * 8 + wv; r < npad; r += nb * 8) {
      uint4* dst = (uint4*)(XG + (size_t)(base + r) * 1024);
      dst[lane] = make_uint4(0u, 0u, 0u, 0u);
      if (lane == 0) SLS[base + r] = 0.f;
    }
  }
  __syncthreads();
}

struct EpiMoe1 {
  const float* bgu; const float* sw; const float* SLS; bfr* ACT;
  __device__ __forceinline__ void operator()(const i32x4 (&acc)[2][2][4][2], const g8::GUnit& u, int wr, int wc, int fr, int fq) const {
    const float* be = bgu + (size_t)u.e * 2048;
    const float* se = sw + (size_t)u.e * 2048;
    const int slot0 = u.pm * 256 + wr * 64 + fr;
#pragma unroll
    for (int bj = 0; bj < 2; ++bj) {
      const int j0 = u.pn * 128 + bj * 64 + wc * 16 + 4 * fq;
      const f32x4 bg = *(const f32x4*)(be + j0), bl = *(const f32x4*)(be + 1024 + j0);
      const f32x4 sg = *(const f32x4*)(se + j0), sl = *(const f32x4*)(se + 1024 + j0);
#pragma unroll
      for (int ai = 0; ai < 2; ++ai)
#pragma unroll
        for (int m = 0; m < 4; ++m) {
          const int slot = slot0 + ai * 128 + m * 16;
          const float sa = SLS[slot];
          bf16x4 o;
#pragma unroll
          for (int q = 0; q < 4; ++q) {
            const float g = (float)acc[ai][bj][m][0][q] * (sa * sg[q]) + bg[q];
            const float li = (float)acc[ai][bj][m][1][q] * (sa * sl[q]) + bl[q];
            const float gv = fminf(g, 7.f);
            const float lv = fminf(fmaxf(li, -7.f), 7.f);
            o[q] = (short)f2bf(gv * sigmoidf_(1.702f * gv) * (lv + 1.f));
          }
          *(bf16x4*)(ACT + (size_t)slot * 1024 + j0) = o;
        }
    }
  }
};
__device__ __forceinline__ void phase_moe1_impl(PP pp, int l, int bid, int nb, char* smem, int* toff) {
  moe_offsets(pp, toff);
  g8::MoeSched S{toff, 8, 2048, nb, bid};
  EpiMoe1 E{p.moe_b_gu + (size_t)l * 32 * 2048, (const float*)(p.ws + OFF_SW) + (size_t)l * 32 * 2048, (const float*)(p.ws + OFF_SLS), (bfr*)(p.ws + OFF_P)};
  g8::gemm_stream<true>((LAS unsigned char*)smem, p.ws + OFF_S, p.ws + OFF_W + (size_t)l * WL_SIZE + WL_GU, S, E);
}

struct EpiMoe2 {
  const float* bdn; const float* SLG; bfr* YS;
  __device__ __forceinline__ void operator()(const f32x4 (&acc)[2][2][4][2], const g8::GUnit& u, int wr, int wc, int fr, int fq) const {
    const float* be = bdn + (size_t)u.e * 1024;
    const int slot0 = u.pm * 256 + wr * 64 + fr, col0 = u.pn * 256 + wc * 32 + 4 * fq;
#pragma unroll
    for (int ai = 0; ai < 2; ++ai)
#pragma unroll
      for (int m = 0; m < 4; ++m) {
        const int slot = slot0 + ai * 128 + m * 16;
        const float gt = SLG[slot];
#pragma unroll
        for (int bj = 0; bj < 2; ++bj)
#pragma unroll
          for (int n = 0; n < 2; ++n) {
            const f32x4 bv = *(const f32x4*)(be + col0 + bj * 128 + n * 16);
            const f32x4 yv = (acc[ai][bj][m][n] + bv) * gt;
            *(bf16x4*)(YS + (size_t)slot * 1024 + col0 + bj * 128 + n * 16) = pack4(yv[0], yv[1], yv[2], yv[3]);
          }
      }
  }
};
__device__ __forceinline__ void phase_moe2_impl(PP pp, int l, int bid, int nb, char* smem, int* toff) {
  moe_offsets(pp, toff);
  g8::MoeSched S{toff, 4, 1024, nb, bid};
  EpiMoe2 E{p.moe_b_down + (size_t)l * 32 * 1024, (const float*)(p.ws + OFF_SLG), (bfr*)(p.ws + OFF_S)};
  g8::gemm_stream<false>((LAS unsigned char*)smem, p.ws + OFF_P, p.ws + OFF_W + (size_t)l * WL_SIZE + WL_DN, S, E);
}

__device__ __forceinline__ void phase_combine(PP pp, int l, int bid, int nb) {
  const int tid = tid_opaque(), lane = tid & 63, wv = wave_id(tid);
  const bfr* YS = (const bfr*)(p.ws + OFF_S);
  const int* TOKS = (const int*)(p.ws + OFF_TOKS);
  const float* mods = (const float*)(p.ws + OFF_MODS) + (size_t)l * 3 * 6144;
  const float* mods1 = (const float*)(p.ws + OFF_MODS) + (size_t)3 * 6144;
  const float* g1n = p.norm_mix_g + 1024;
  bfr* H = (bfr*)(p.ws + OFF_H);
  float* xl = p.out;
  float* xc = (float*)(p.ws + OFF_CTX);
  const int ntok = (l == 0) ? NTOK : NLAT;
  if (l == 0) {
    int* cnt = (int*)(p.ws + OFF_CNT);
    const int gt = bid * NTHR + tid;
    if (gt < 32) cnt[gt] = 0;
  }
  for (int m = bid * 8 + wv; m < ntok; m += nb * 8) {
    float* xr = (m < NLAT) ? xl + (size_t)m * 1024 : xc + (size_t)(m - NLAT) * 1024;
    const float* g2 = mods + (size_t)mod_row(m) * 6144 + 5120;
    const int s0 = TOKS[(size_t)m * 4], s1 = TOKS[(size_t)m * 4 + 1], s2 = TOKS[(size_t)m * 4 + 2], s3 = TOKS[(size_t)m * 4 + 3];
    float4 xn[4];
    float ss = 0.f;
#pragma unroll
    for (int i = 0; i < 4; ++i) {
      const int d = (lane + 64 * i) * 4;
      const bf16x4 a = *(const bf16x4*)(YS + (size_t)s0 * 1024 + d);
      const bf16x4 b = *(const bf16x4*)(YS + (size_t)s1 * 1024 + d);
      const bf16x4 c = *(const bf16x4*)(YS + (size_t)s2 * 1024 + d);
      const bf16x4 e = *(const bf16x4*)(YS + (size_t)s3 * 1024 + d);
      const float4 gg = *(const float4*)(g2 + d);
      float4 xv = *(const float4*)(xr + d);
      xv.x += gg.x * ((bf2f(a[0]) + bf2f(b[0])) + (bf2f(c[0]) + bf2f(e[0])));
      xv.y += gg.y * ((bf2f(a[1]) + bf2f(b[1])) + (bf2f(c[1]) + bf2f(e[1])));
      xv.z += gg.z * ((bf2f(a[2]) + bf2f(b[2])) + (bf2f(c[2]) + bf2f(e[2])));
      xv.w += gg.w * ((bf2f(a[3]) + bf2f(b[3])) + (bf2f(c[3]) + bf2f(e[3])));
      *(float4*)(xr + d) = xv;
      xn[i] = xv;
      ss += xv.x * xv.x + xv.y * xv.y + xv.z * xv.z + xv.w * xv.w;
    }
    if (l == 0) {
      ss = wave_sum(ss);
      const float rs = rsqrtf(ss * (1.f / 1024.f) + 1e-6f);
      const float* md = mods1 + (size_t)mod_row(m) * 6144;
      float4 hq[4];
#pragma unroll
      for (int i = 0; i < 4; ++i) {
        const int d = (lane + 64 * i) * 4;
        const float4 gg = *(const float4*)(g1n + d);
        const float4 sh = *(const float4*)(md + d);
        const float4 sc = *(const float4*)(md + 1024 + d);
        hq[i] = make_float4(xn[i].x * rs * gg.x * (1.f + sc.x) + sh.x, xn[i].y * rs * gg.y * (1.f + sc.y) + sh.y,
                            xn[i].z * rs * gg.z * (1.f + sc.z) + sh.z, xn[i].w * rs * gg.w * (1.f + sc.w) + sh.w);
      }
      const float qs = quant_row_store(hq, (signed char*)(p.ws + OFF_H) + (size_t)m * 1024, lane);
      if (lane == 0) ((float*)(p.ws + OFF_SCL))[m] = qs;
    }
  }
}

#define XB_TMO      128
#define XB_XCNT(j)  (256  + 64 * (j))
#define XB_XSUB(j)  (1280 + 64 * (j))
#define XB_XGEN(j)  (2304 + 64 * (j))
#define XB_TOP      3328
#define XB_TOPGEN   3392
#define XCD_BAR_WORDS 3456
#define XB_SPIN_CAP (1u << 22)
__device__ __forceinline__ unsigned xb_ld(unsigned* q) { return __hip_atomic_load(q, __ATOMIC_RELAXED, __HIP_MEMORY_SCOPE_AGENT); }
__device__ __forceinline__ unsigned xb_add(unsigned* q, unsigned v) { return __hip_atomic_fetch_add(q, v, __ATOMIC_RELAXED, __HIP_MEMORY_SCOPE_AGENT); }
__device__ __forceinline__ unsigned xb_xcc_id() { return (unsigned)__builtin_amdgcn_s_getreg((3 << 11) | 20) & 0xFu; }
#define XB_SPIN(cond, bar) do { unsigned _sp = 0; while (cond) { __builtin_amdgcn_s_sleep(1); \
    if ((++_sp & 255u) == 0u) { if (xb_ld(&(bar)[XB_TMO])) break; if (_sp > XB_SPIN_CAP) { atomicAdd(&(bar)[XB_TMO], 1u); break; } } } } while (0)
struct XcdBarrier { unsigned* bar; unsigned x; volatile LAS unsigned* st; };
__device__ __forceinline__ XcdBarrier xcd_barrier_post(unsigned* bar, volatile LAS unsigned* st) {
  XcdBarrier b; b.bar = bar; b.x = xb_xcc_id(); b.st = st;
  if (tid_opaque() == 0) (void)xb_add(&bar[XB_XCNT(b.x)], 1u);
  return b;
}
__device__ __forceinline__ void xcd_barrier_complete(unsigned* bar, unsigned x, unsigned& nloc, unsigned& nx) {
  const unsigned G = gridDim.x;
  unsigned sum, cnt, mine, sp = 0u;
  for (;;) {
    sum = 0u; cnt = 0u; mine = 0u;
#pragma unroll
    for (unsigned j = 0; j < 16; ++j) { const unsigned c = xb_ld(&bar[XB_XCNT(j)]); sum += c; cnt += (c > 0u) ? 1u : 0u; mine = (j == x) ? c : mine; }
    if (sum == G) break;
    __builtin_amdgcn_s_sleep(1);
    if ((++sp & 255u) == 0u) { if (xb_ld(&bar[XB_TMO])) break; if (sp > XB_SPIN_CAP) { atomicAdd(&bar[XB_TMO], 1u); break; } }
  }
  nloc = mine > 0u ? mine : 1u; nx = cnt > 0u ? cnt : 1u;
}
__device__ __forceinline__ void xcd_barrier(const XcdBarrier& b) {
  asm volatile("s_waitcnt vmcnt(0)" ::: "memory");
  __syncthreads();
  if (tid_opaque() == 0) {
    unsigned* bar = b.bar;
    __builtin_amdgcn_s_waitcnt(0);
    unsigned nloc = b.st[0], nx = b.st[1];
    if (nloc == 0u) { xcd_barrier_complete(bar, b.x, nloc, nx); b.st[0] = nloc; b.st[1] = nx; }
    const unsigned old = xb_add(&bar[XB_XSUB(b.x)], 1u);
    const unsigned gen = old / nloc;
    if (old + 1u == (gen + 1u) * nloc) {
      __builtin_amdgcn_fence(__ATOMIC_RELEASE, "agent");
      asm volatile("s_waitcnt vmcnt(0)" ::: "memory");
      const unsigned og = xb_add(&bar[XB_TOP], 1u);
      const unsigned tg = og / nx;
      if (og + 1u == (tg + 1u) * nx) xb_add(&bar[XB_TOPGEN], 1u);
      else XB_SPIN(xb_ld(&bar[XB_TOPGEN]) == tg, bar);
      __builtin_amdgcn_fence(__ATOMIC_ACQUIRE, "agent");
      xb_add(&bar[XB_XGEN(b.x)], 1u);
      asm volatile("s_waitcnt vmcnt(0)" ::: "memory");
    } else {
      XB_SPIN(xb_ld(&bar[XB_XGEN(b.x)]) == gen, bar);
      __builtin_amdgcn_fence(__ATOMIC_ACQUIRE, "agent");
      asm volatile("s_waitcnt vmcnt(0)" ::: "memory");
    }
  }
  __syncthreads();
}

extern __shared__ __attribute__((aligned(16))) char dyn_smem[];

__global__ void __launch_bounds__(NTHR) mega(Params p_unused) {
  cg::grid_group grid = cg::this_grid();
  const int bid0 = blockIdx.x, nb0 = gridDim.x;
#if defined(__HIP_DEVICE_COMPILE__)
  PP pp0 = (PP)__builtin_amdgcn_kernarg_segment_ptr();
#else
  PP pp0 = nullptr;
#endif
#define pp ({ PP q_ = pp0; asm volatile("" : "+s"(q_)); q_; })
#define bid opq(bid0)
#define nb opq(nb0)
  int* toff_s = (int*)(dyn_smem + 147456);
  volatile LAS unsigned* xb_st = (volatile LAS unsigned*)(dyn_smem + 147456 + 256);
  {
    unsigned* barw = (unsigned*)(fresh_ws(pp0) + OFF_BAR);
    if (blockIdx.x == 0) for (int i = threadIdx.x; i < XCD_BAR_WORDS; i += NTHR) barw[i] = 0u;
    if (threadIdx.x == 0) { xb_st[0] = 0u; xb_st[1] = 0u; }
  }
  grid.sync();
  const XcdBarrier xb = xcd_barrier_post((unsigned*)(fresh_ws(pp0) + OFF_BAR), xb_st);
#define GSYNC() xcd_barrier(xb)
  phase_ada(pp, bid, nb, dyn_smem);
  phase_convert(pp, 0, bid, nb, dyn_smem);
  phase_convert(pp, 1, bid, nb, dyn_smem);
  GSYNC();
#define LAYER(LV, LAST)                                      \
  {                                                          \
    if ((LV) == 0) { phase_prenorm(pp, opq(LV), bid, nb); GSYNC(); } \
    phase_gemm_in(pp, opq(LV), bid, nb, dyn_smem);           \
    GSYNC();                                                 \
    phase_prep(pp, opq(LV), bid, nb, dyn_smem);              \
    GSYNC();                                                 \
    phase_chunk_prep(pp, bid, nb, dyn_smem);                 \
    GSYNC();                                                 \
    phase_mix(pp, opq(LV), bid, nb, dyn_smem);               \
    GSYNC();                                                 \
    phase_post(pp, opq(LV), bid, nb);                        \
    GSYNC();                                                 \
    phase_gemm_out(pp, opq(LV), bid, nb, dyn_smem);          \
    GSYNC();                                                 \
    phase_router(pp, opq(LV), bid, nb, dyn_smem);            \
    GSYNC();                                                 \
    phase_slotfill(pp, opq(LV), bid, nb, dyn_smem);          \
    GSYNC();                                                 \
    phase_moe1_impl(pp, opq(LV), bid, nb, dyn_smem, toff_s); \
    GSYNC();                                                 \
    phase_moe2_impl(pp, opq(LV), bid, nb, dyn_smem, toff_s); \
    GSYNC();                                                 \
    phase_combine(pp, opq(LV), bid, nb);                     \
    if (!(LAST)) GSYNC();                                    \
  }
  LAYER(0, false)
  LAYER(1, true)
#undef LAYER
#undef GSYNC
#undef bid
#undef nb
#undef pp
}

#undef p
extern "C" void kernel_launch(void* const* d_in, const int* in_sizes, int n_in, void* d_out, int out_size, void* d_ws,
                              size_t ws_size, hipStream_t stream) {
  Params hp{};
  const float** pp = (const float**)&hp;
  for (int i = 0; i < 34; ++i) pp[i] = (const float*)d_in[i];
  hp.out = (float*)d_out;
  hp.ws = (char*)d_ws;
  static int grid_blocks = 0;
  if (!grid_blocks) {
    (void)hipFuncSetAttribute((const void*)mega, hipFuncAttributeMaxDynamicSharedMemorySize, LDS_BYTES);
    int dev = 0, cus = 0, per_cu = 0;
    (void)hipGetDevice(&dev);
    (void)hipDeviceGetAttribute(&cus, hipDeviceAttributeMultiprocessorCount, dev);
    (void)hipOccupancyMaxActiveBlocksPerMultiprocessor(&per_cu, mega, NTHR, LDS_BYTES);
    if (per_cu < 1) per_cu = 1;
    if (per_cu > 1) per_cu = 1;
    grid_blocks = cus * per_cu;
  }
  void* args[] = {&hp};
  (void)hipLaunchCooperativeKernel((void*)mega, dim3(grid_blocks), dim3(NTHR), args, LDS_BYTES, stream);
}
```

```cpp
#include <hip/hip_runtime.h>
#include <hip/hip_bf16.h>
#include <hip/hip_cooperative_groups.h>
#include <stdint.h>
#include <type_traits>
namespace cg = cooperative_groups;

typedef __attribute__((ext_vector_type(8))) short bf16x8;
typedef __attribute__((ext_vector_type(4))) short bf16x4;
typedef __attribute__((ext_vector_type(4))) float f32x4;
typedef __attribute__((ext_vector_type(4))) int i32x4;
typedef unsigned short bfr;

#define D_MODEL 1024
#define NB 2
#define SEQ 16384
#define CTXL 256
#define NLAT (NB * SEQ)
#define NCTX (NB * CTXL)
#define NTOK (NLAT + NCTX)
#define TTOK (SEQ + CTXL)
#define PIN 3472
#define PINP 3584
#define A_END 1536
#define B_END 2432
#define NEXP 32
#define NSLOT_MAX (NTOK * 4 + NEXP * 256)
#define NTHR 512
#define LDS_BYTES (147456 + 512)

constexpr size_t al256(size_t x) { return (x + 255) & ~(size_t)255; }
constexpr size_t WL_IN = 0;
constexpr size_t WL_OUT = WL_IN + (size_t)PINP * 1024 * 2;
constexpr size_t WL_GU = WL_OUT + (size_t)1024 * 1024 * 2;
constexpr size_t WL_DN = WL_GU + (size_t)32 * 2048 * 1024 * 2;
constexpr size_t WL_SIZE = WL_DN + (size_t)32 * 1024 * 1024 * 2;
constexpr size_t OFF_W = 0;
constexpr size_t OFF_MODS = al256(OFF_W + 2 * WL_SIZE);
constexpr size_t OFF_BAR = al256(OFF_MODS + 2 * 3 * 6144 * 4);
constexpr size_t OFF_SW = al256(OFF_BAR + 3456 * 4);
constexpr size_t OFF_SWIN = al256(OFF_SW + (size_t)2 * 32 * 2048 * 4);
constexpr size_t OFF_SLS = al256(OFF_SWIN + (size_t)2 * PINP * 4);
constexpr size_t OFF_SCL = al256(OFF_SLS + (size_t)(NTOK * 4 + 32 * 256) * 4);
constexpr size_t OFF_CTX = al256(OFF_SCL + (size_t)NTOK * 4);
constexpr size_t OFF_CNT = al256(OFF_CTX + (size_t)NCTX * 1024 * 4);
constexpr size_t OFF_TOKE = al256(OFF_CNT + 256);
constexpr size_t OFF_TOKP = al256(OFF_TOKE + (size_t)NTOK * 4 * 4);
constexpr size_t OFF_TOKG = al256(OFF_TOKP + (size_t)NTOK * 4 * 4);
constexpr size_t OFF_TOKS = al256(OFF_TOKG + (size_t)NTOK * 4 * 4);
constexpr size_t OFF_SLT = al256(OFF_TOKS + (size_t)NTOK * 4 * 4);
constexpr size_t OFF_SLG = al256(OFF_SLT + (size_t)NSLOT_MAX * 4);
constexpr size_t OFF_H = al256(OFF_SLG + (size_t)NSLOT_MAX * 4);
constexpr size_t OFF_CC = al256(OFF_H + (size_t)NTOK * 1024 * 2);
constexpr size_t OFF_P = al256(OFF_CC + (size_t)NTOK * 1024 * 2);
constexpr size_t OFF_S = al256(OFF_P + (size_t)NTOK * PINP * 4);
constexpr size_t TOK256F = (size_t)NTOK * 256 * 4;
constexpr size_t S_QN = 0;
constexpr size_t S_KN = S_QN + (size_t)NTOK * 512 * 2;
constexpr size_t S_VT = S_KN + (size_t)NTOK * 512 * 2;
constexpr size_t S_RWR = S_VT + (size_t)NB * 8 * 64 * TTOK * 2;
constexpr size_t S_RWKK = S_RWR + TOK256F;
constexpr size_t S_RWV = S_RWKK + TOK256F;
constexpr size_t S_RWG = S_RWV + TOK256F;
constexpr size_t S_RWW = S_RWG + TOK256F;
constexpr size_t S_RWKD = S_RWW + 2 * TOK256F;
constexpr size_t S_RWB = S_RWKD + 2 * TOK256F;
constexpr size_t S_BON = S_RWB + 2 * TOK256F;
constexpr size_t S_GDQ = al256(S_BON + (size_t)NTOK * 4 * 4);
constexpr size_t S_GDK = S_GDQ + TOK256F;
constexpr size_t S_GDV = S_GDK + TOK256F;
constexpr size_t S_GDAB = S_GDV + TOK256F;
constexpr size_t S_YRW = al256(S_GDAB + (size_t)NTOK * 16 * 4);
constexpr size_t S_YGD = S_YRW + 2 * TOK256F;
constexpr size_t S_END = S_YGD + 2 * TOK256F;
constexpr size_t S_SIZE = (S_END > (size_t)NSLOT_MAX * 1024 * 4) ? S_END : (size_t)NSLOT_MAX * 1024 * 4;
constexpr int NCHUNK = TTOK / 64;
constexpr int NCHAIN = 32;
constexpr size_t OFF_CH = al256(OFF_S + S_SIZE);
constexpr size_t CH_N = (size_t)NCHAIN * NCHUNK;
constexpr size_t CH_REC = 32768, CH_PT = 0, CH_RYT = 8192, CH_QT = 16384, CH_YX = 24576;
constexpr size_t CH_SIZE = CH_N * CH_REC;
constexpr size_t WS_TOTAL = OFF_CH + CH_SIZE;
static_assert(WS_TOTAL <= (size_t)2048 * 1024 * 1024, "workspace exceeds 4x largest tensor");

struct Params {
  const float *x, *c, *ctx, *c_ctx, *ada_w, *ada_b, *norm_mix_g, *norm_ffn_g, *w_in, *w_out;
  const float *na_q_gain, *na_k_gain, *na_rpb;
  const float *rw_mu, *rw_w0, *rw_w_up, *rw_a0, *rw_a_up, *rw_g_up, *rw_k_k, *rw_k_a, *rw_r_k, *rw_ln_w, *rw_ln_b;
  const float *gd_conv_w, *gd_A_log, *gd_dt_bias, *gd_norm_g;
  const float *moe_router_w, *moe_router_b, *moe_w_gu, *moe_b_gu, *moe_w_down, *moe_b_down;
  float* out;
  char* ws;
};

typedef const __attribute__((address_space(4))) Params* PP;
#define p (*pp)
__device__ __forceinline__ char* fresh_ws(PP pp) { return p.ws; }
__device__ __forceinline__ int tid_opaque() { int t = (int)__builtin_amdgcn_workitem_id_x(); asm volatile("" : "+v"(t)); return t; }
__device__ __forceinline__ int opq(int x) { asm volatile("" : "+s"(x)); return x; }
__device__ __forceinline__ int wave_id(int tid) { return __builtin_amdgcn_readfirstlane(tid >> 6); }
__device__ __forceinline__ bfr f2bf(float f) {
  unsigned u = __float_as_uint(f);
  u += 0x7fffu + ((u >> 16) & 1u);
  return (bfr)(u >> 16);
}
__device__ __forceinline__ float bf2f(short v) { return __uint_as_float(((unsigned)(unsigned short)v) << 16); }
__device__ __forceinline__ bf16x4 pack4(float a, float b, float c, float d) {
  bf16x4 o; o[0] = (short)f2bf(a); o[1] = (short)f2bf(b); o[2] = (short)f2bf(c); o[3] = (short)f2bf(d); return o;
}
__device__ __forceinline__ float sigmoidf_(float x) { return 1.f / (1.f + __expf(-x)); }
__device__ __forceinline__ float siluf_(float x) { return x / (1.f + __expf(-x)); }
__device__ __forceinline__ float softplusf_(float x) { return x > 20.f ? x : log1pf(__expf(x)); }
__device__ __forceinline__ float wave_sum(float v) {
  v += __builtin_bit_cast(float, __builtin_amdgcn_update_dpp(0, __builtin_bit_cast(int, v), 0xB1, 0xF, 0xF, true));
  v += __builtin_bit_cast(float, __builtin_amdgcn_update_dpp(0, __builtin_bit_cast(int, v), 0x4E, 0xF, 0xF, true));
  v += __builtin_bit_cast(float, __builtin_amdgcn_update_dpp(0, __builtin_bit_cast(int, v), 0x141, 0xF, 0xF, true));
  v += __builtin_bit_cast(float, __builtin_amdgcn_update_dpp(0, __builtin_bit_cast(int, v), 0x140, 0xF, 0xF, true));
  v += __builtin_bit_cast(float, __builtin_amdgcn_update_dpp(0, __builtin_bit_cast(int, v), 0x142, 0xA, 0xF, false));
  v += __builtin_bit_cast(float, __builtin_amdgcn_update_dpp(0, __builtin_bit_cast(int, v), 0x143, 0xC, 0xF, false));
  return __builtin_bit_cast(float, __builtin_amdgcn_readlane(__builtin_bit_cast(int, v), 63));
}
__device__ __forceinline__ float wave_max(float v) {
  v = fmaxf(v, __builtin_bit_cast(float, __builtin_amdgcn_update_dpp(0, __builtin_bit_cast(int, v), 0xB1, 0xF, 0xF, true)));
  v = fmaxf(v, __builtin_bit_cast(float, __builtin_amdgcn_update_dpp(0, __builtin_bit_cast(int, v), 0x4E, 0xF, 0xF, true)));
  v = fmaxf(v, __builtin_bit_cast(float, __builtin_amdgcn_update_dpp(0, __builtin_bit_cast(int, v), 0x141, 0xF, 0xF, true)));
  v = fmaxf(v, __builtin_bit_cast(float, __builtin_amdgcn_update_dpp(0, __builtin_bit_cast(int, v), 0x140, 0xF, 0xF, true)));
  const float r1 = __builtin_bit_cast(float, __builtin_amdgcn_readlane(__builtin_bit_cast(int, v), 0));
  const float r2 = __builtin_bit_cast(float, __builtin_amdgcn_readlane(__builtin_bit_cast(int, v), 16));
  const float r3 = __builtin_bit_cast(float, __builtin_amdgcn_readlane(__builtin_bit_cast(int, v), 32));
  const float r4 = __builtin_bit_cast(float, __builtin_amdgcn_readlane(__builtin_bit_cast(int, v), 48));
  return fmaxf(fmaxf(r1, r2), fmaxf(r3, r4));
}
__device__ __forceinline__ float shfl_xor_l(float v, int mask, int lane) {
  return __builtin_bit_cast(float, __builtin_amdgcn_ds_bpermute((lane ^ mask) << 2, __builtin_bit_cast(int, v)));
}
__device__ __forceinline__ int shfl_xor_li(int v, int mask, int lane) {
  return __builtin_amdgcn_ds_bpermute((lane ^ mask) << 2, v);
}
__device__ __forceinline__ float row16_sum(float v) {
  v += __builtin_bit_cast(float, __builtin_amdgcn_update_dpp(0, __builtin_bit_cast(int, v), 0xB1, 0xF, 0xF, true));
  v += __builtin_bit_cast(float, __builtin_amdgcn_update_dpp(0, __builtin_bit_cast(int, v), 0x4E, 0xF, 0xF, true));
  v += __builtin_bit_cast(float, __builtin_amdgcn_update_dpp(0, __builtin_bit_cast(int, v), 0x141, 0xF, 0xF, true));
  v += __builtin_bit_cast(float, __builtin_amdgcn_update_dpp(0, __builtin_bit_cast(int, v), 0x140, 0xF, 0xF, true));
  return v;
}
__device__ __forceinline__ float quant_row_store(const float4 (&v)[4], signed char* dst_row, int lane) {
  float am = 0.f;
#pragma unroll
  for (int i = 0; i < 4; ++i) am = fmaxf(fmaxf(am, fmaxf(fabsf(v[i].x), fabsf(v[i].y))), fmaxf(fabsf(v[i].z), fabsf(v[i].w)));
  am = wave_max(am);
  const float sc = am > 0.f ? am * (1.f / 127.f) : 1.f, iv = 1.f / sc;
#pragma unroll
  for (int i = 0; i < 4; ++i) {
    const int q0 = (int)fminf(fmaxf(rintf(v[i].x * iv), -127.f), 127.f), q1 = (int)fminf(fmaxf(rintf(v[i].y * iv), -127.f), 127.f);
    const int q2 = (int)fminf(fmaxf(rintf(v[i].z * iv), -127.f), 127.f), q3 = (int)fminf(fmaxf(rintf(v[i].w * iv), -127.f), 127.f);
    *(unsigned*)(dst_row + (lane + 64 * i) * 4) = (unsigned)(q0 & 0xff) | ((unsigned)(q1 & 0xff) << 8) | ((unsigned)(q2 & 0xff) << 16) | ((unsigned)(q3 & 0xff) << 24);
  }
  return sc;
}
__device__ __forceinline__ int mod_row(int m) { return m < NLAT ? (m >> 14) : 2; }

__device__ __forceinline__ void phase_ada(PP pp, int bid, int nb, char* smem) {
  float* red = (float*)smem;
  float* mods = (float*)(p.ws + OFF_MODS);
  const int tid = tid_opaque();
  for (int task = bid; task < 2 * 96; task += nb) {
    int l = task / 96, cgp = task % 96;
    int col = cgp * 64 + (tid & 63), ks = tid >> 6;
    const float* W = p.ada_w + (size_t)l * 1024 * 6144;
    float a0 = 0.f, a1 = 0.f, a2 = 0.f;
    for (int d = ks * 128; d < ks * 128 + 128; ++d) {
      float w = W[(size_t)d * 6144 + col];
      a0 += siluf_(p.c[d]) * w;
      a1 += siluf_(p.c[1024 + d]) * w;
      a2 += siluf_(p.c_ctx[d]) * w;
    }
    red[(ks * 3 + 0) * 64 + (tid & 63)] = a0;
    red[(ks * 3 + 1) * 64 + (tid & 63)] = a1;
    red[(ks * 3 + 2) * 64 + (tid & 63)] = a2;
    __syncthreads();
    if (tid < 192) {
      int r = tid >> 6, cc = tid & 63;
      float s = 0.f;
      for (int k = 0; k < 8; ++k) s += red[(k * 3 + r) * 64 + cc];
      mods[(size_t)(l * 3 + r) * 6144 + cgp * 64 + cc] = s + p.ada_b[(size_t)l * 6144 + cgp * 64 + cc];
    }
    __syncthreads();
  }
}

__device__ __forceinline__ void convert_tile(const float* src, int N, bfr* dst, int kt, int nt, int mode, float* tile  ) {
  const int tid = tid_opaque();
#pragma unroll
  for (int q = 0; q < 2; ++q) {
    int idx = tid + q * 512;
    int kk = idx >> 4, n4 = idx & 15;
    int n = nt * 64 + n4 * 4;
    float4 v = make_float4(0.f, 0.f, 0.f, 0.f);
    if (n < N) v = *(const float4*)(src + (size_t)(kt * 64 + kk) * N + n);
    tile[kk * 65 + n4 * 4 + 0] = v.x;
    tile[kk * 65 + n4 * 4 + 1] = v.y;
    tile[kk * 65 + n4 * 4 + 2] = v.z;
    tile[kk * 65 + n4 * 4 + 3] = v.w;
  }
  __syncthreads();
  {
    int nn = tid >> 3, kc = tid & 7;
    int n = nt * 64 + nn;
    int row = n;
    if (mode == 1) { int j = n & 1023; row = (j >> 4) * 32 + (j & 15) + ((n >= 1024) ? 16 : 0); }
    bf16x8 o;
#pragma unroll
    for (int j = 0; j < 8; ++j) o[j] = (short)f2bf(tile[(kc * 8 + j) * 65 + nn]);
    *(bf16x8*)(dst + (size_t)row * 1024 + kt * 64 + kc * 8) = o;
  }
  __syncthreads();
}
template <int N, bool INTERLEAVE>
__device__ __forceinline__ void convert_i8(const float* src  , signed char* dst  , float* sw, int ng, char* smem) {
  const int tid = tid_opaque();
  bfr* blk = (bfr*)smem;
  int* cmax = (int*)(smem + 131072);
  if (tid < 64) cmax[tid] = 0;
  __syncthreads();
  {
    const int n4 = tid & 15, kk0 = tid >> 4;
    float m0 = 0.f, m1 = 0.f, m2 = 0.f, m3 = 0.f;
#pragma unroll 4
    for (int ps = 0; ps < 32; ++ps) {
      const int k = ps * 32 + kk0;
      float4 v = make_float4(0.f, 0.f, 0.f, 0.f);
      if (ng * 64 + n4 * 4 < N) v = *(const float4*)(src + (size_t)k * N + ng * 64 + n4 * 4);
      m0 = fmaxf(m0, fabsf(v.x)); m1 = fmaxf(m1, fabsf(v.y)); m2 = fmaxf(m2, fabsf(v.z)); m3 = fmaxf(m3, fabsf(v.w));
      *(bf16x4*)(blk + k * 64 + n4 * 4) = pack4(v.x, v.y, v.z, v.w);
    }
    atomicMax(&cmax[n4 * 4 + 0], __float_as_int(m0)); atomicMax(&cmax[n4 * 4 + 1], __float_as_int(m1));
    atomicMax(&cmax[n4 * 4 + 2], __float_as_int(m2)); atomicMax(&cmax[n4 * 4 + 3], __float_as_int(m3));
  }
  __syncthreads();
  {
    const int nn = tid >> 3, kc = tid & 7;
    const int n = ng * 64 + nn;
    const float am = __int_as_float(cmax[nn]);
    const float sc = am > 0.f ? am * (1.f / 127.f) : 1.f, iv = 1.f / sc;
    const int j = n & 1023;
    const int row = INTERLEAVE ? (j >> 4) * 32 + (j & 15) + ((n >= 1024) ? 16 : 0) : n;
    if (kc == 0) sw[n] = sc;
#pragma unroll 2
    for (int q = 0; q < 8; ++q) {
      const int k0 = (kc + 8 * q) * 16;
      unsigned w[4];
#pragma unroll
      for (int g4 = 0; g4 < 4; ++g4) {
        unsigned acc = 0u;
#pragma unroll
        for (int b = 0; b < 4; ++b) {
          const float v = bf2f((short)blk[(k0 + g4 * 4 + b) * 64 + nn]);
          const int qi = (int)fminf(fmaxf(rintf(v * iv), -127.f), 127.f);
          acc |= ((unsigned)(qi & 0xff)) << (8 * b);
        }
        w[g4] = acc;
      }
      *(uint4*)(dst + (size_t)row * 1024 + k0) = make_uint4(w[0], w[1], w[2], w[3]);
    }
  }
  __syncthreads();
}
__device__ __forceinline__ void phase_convert(PP pp, int l, int part, int bid, int nb, char* smem) {
  float* tile = (float*)smem;
  char* wl = p.ws + OFF_W + (size_t)l * WL_SIZE;
  const int T_IN = 56, T_OUT = 16 * 16, T_GU = 32 * 32, T_DN = 32 * 16 * 16;
  const int t_lo = part == 0 ? 0 : T_IN + T_OUT;
  const int t_hi = part == 0 ? T_IN + T_OUT : T_IN + T_OUT + T_GU + T_DN;
  for (int t = t_lo + bid; t < t_hi; t += nb) {
    if (t < T_IN) {
      convert_i8<PIN, false>(p.w_in + (size_t)l * 1024 * PIN, (signed char*)(wl + WL_IN), (float*)(p.ws + OFF_SWIN) + (size_t)l * PINP, t, smem);
    } else if (t < T_IN + T_OUT) {
      int u = t - T_IN; int kt = u / 16, nt = u % 16;
      convert_tile(p.w_out + (size_t)l * 1024 * 1024, 1024, (bfr*)(wl + WL_OUT), kt, nt, 0, tile);
    } else if (t < T_IN + T_OUT + T_GU) {
      int u = t - T_IN - T_OUT; int e = u / 32, ng = u % 32;
      convert_i8<2048, true>(p.moe_w_gu + ((size_t)l * 32 + e) * 1024 * 2048, (signed char*)(wl + WL_GU) + (size_t)e * 2048 * 1024,
                    (float*)(p.ws + OFF_SW) + ((size_t)l * 32 + e) * 2048, ng, smem);
    } else {
      int u = t - T_IN - T_OUT - T_GU; int e = u / 256; int v = u % 256; int kt = v / 16, nt = v % 16;
      convert_tile(p.moe_w_down + ((size_t)l * 32 + e) * 1024 * 1024, 1024, (bfr*)(wl + WL_DN) + (size_t)e * 1024 * 1024, kt, nt, 0, tile);
    }
  }
}

__device__ __forceinline__ void phase_prenorm(PP pp, int l, int bid, int nb) {
  const int tid = tid_opaque(), lane = tid & 63, wv = wave_id(tid);
  const float* xl = (l == 0) ? p.x : p.out;
  const float* xc = (l == 0) ? p.ctx : (const float*)(p.ws + OFF_CTX);
  const float* mods = (const float*)(p.ws + OFF_MODS) + (size_t)l * 3 * 6144;
  const float* g = p.norm_mix_g + (size_t)l * 1024;
  signed char* H8 = (signed char*)(p.ws + OFF_H);
  float* SCL = (float*)(p.ws + OFF_SCL);
  {
    int* cnt = (int*)(p.ws + OFF_CNT);
    int gt = bid * NTHR + tid;
    if (gt < 32) cnt[gt] = 0;
  }
  for (int m = bid * 8 + wv; m < NTOK; m += nb * 8) {
    const float* xr = (m < NLAT) ? xl + (size_t)m * 1024 : xc + (size_t)(m - NLAT) * 1024;
    const float* md = mods + (size_t)mod_row(m) * 6144;
    float4 v[4];
    float ss = 0.f;
#pragma unroll
    for (int i = 0; i < 4; ++i) {
      v[i] = *(const float4*)(xr + (lane + 64 * i) * 4);
      ss += v[i].x * v[i].x + v[i].y * v[i].y + v[i].z * v[i].z + v[i].w * v[i].w;
    }
    ss = wave_sum(ss);
    float rs = rsqrtf(ss * (1.f / 1024.f) + 1e-6f);
    float4 hq[4];
#pragma unroll
    for (int i = 0; i < 4; ++i) {
      int d = (lane + 64 * i) * 4;
      float4 gg = *(const float4*)(g + d);
      float4 sh = *(const float4*)(md + d);
      float4 sc = *(const float4*)(md + 1024 + d);
      hq[i] = make_float4(v[i].x * rs * gg.x * (1.f + sc.x) + sh.x, v[i].y * rs * gg.y * (1.f + sc.y) + sh.y,
                          v[i].z * rs * gg.z * (1.f + sc.z) + sh.z, v[i].w * rs * gg.w * (1.f + sc.w) + sh.w);
    }
    const float qs = quant_row_store(hq, H8 + (size_t)m * 1024, lane);
    if (lane == 0) SCL[m] = qs;
  }
}

#define LAS __attribute__((address_space(3)))
namespace g8 {
constexpr int BM = 256, BK = 64, HALF = 128, HTB = HALF * BK * 2, STAGE_BYTES = 8 * HTB, KD = 1024;
__device__ __forceinline__ int lds_byte(int r, int c) { const int st = (r >> 4) * 2 + (c >> 5), rr = r & 15, cc = c & 31, ob = rr * 64 + cc * 2; return st * 1024 + (ob ^ (((ob >> 9) & 1) << 5)); }
__device__ __forceinline__ void stage_rc(int b, int& R, int& C) { const int st = b / 1024, sb = b % 1024, swz = sb ^ (((sb >> 9) & 1) << 5); R = (st >> 1) * 16 + swz / 64; C = (st & 1) * 32 + (swz % 64) / 2; }
struct GUnit { int pm, pn, brow0, e; };
__device__ __forceinline__ int unit_index(int i, int c, int G, int total) {
  const int x = c & 7, j = c >> 3, q = total >> 3, r = total & 7;
  const int start = x < r ? x * (q + 1) : r * (q + 1) + (x - r) * q;
  const int size = q + (x < r ? 1 : 0);
  const int li = i * (G >> 3) + j;
  return li < size ? start + li : -1;
}

__device__ __forceinline__ f32x4 mma16(bf16x8 a, bf16x8 b, f32x4 c) { return __builtin_amdgcn_mfma_f32_16x16x32_bf16(a, b, c, 0, 0, 0); }
__device__ __forceinline__ i32x4 mma16(i32x4 a, i32x4 b, i32x4 c) { return __builtin_amdgcn_mfma_i32_16x16x64_i8(a, b, c, 0, 0, 0); }
template <bool I8, class Sched, class Epi>
__device__ __forceinline__ void gemm_stream(LAS unsigned char* lds, const void* Abase, const void* Btbase, const Sched& S, const Epi& E) {
  typedef typename std::conditional<I8, i32x4, f32x4>::type AccT;
  typedef typename std::conditional<I8, i32x4, bf16x8>::type FragT;
  constexpr int KB = I8 ? KD : KD * 2;
  const int tid = tid_opaque(), wid = __builtin_amdgcn_readfirstlane(tid >> 6), lane = tid & 63, wr = wid >> 2, wc = wid & 3, fr = lane & 15, fq = lane >> 4;
  constexpr int nt = KB / 128;
  int R[2], C[2];
  unsigned voffB[2];
#pragma unroll
  for (int i = 0; i < 2; ++i) { stage_rc(tid * 16 + i * 8192, R[i], C[i]); voffB[i] = (unsigned)(R[i] * KB + C[i] * 2); }
#define voffA voffB
  constexpr size_t kstep = (size_t)(BK * 2);
  constexpr size_t hstep = (size_t)HALF * KB;
  const unsigned ldsw = (unsigned)wid * 1024u;
  const int aoff = lds_byte(wr * 64 + fr, fq * 8), boff = lds_byte(wc * 32 + fr, fq * 8);
#define G8_SA(b, h) (((b) * 2 + (h)) * HTB)
#define G8_SB(b, h) ((4 + (b) * 2 + (h)) * HTB)
#define G8_STAGE(bufoff, gbase, v0, v1) do { \
    __builtin_amdgcn_global_load_lds((const unsigned*)((const char*)(gbase) + (v0)), (LAS unsigned*)(lds + (bufoff) + ldsw), 16, 0, 0); \
    __builtin_amdgcn_global_load_lds((const unsigned*)((const char*)(gbase) + (v1)), (LAS unsigned*)(lds + (bufoff) + ldsw + 8192), 16, 0, 0); } while (0)
#define G8_STAGEB(bufoff, gbase) G8_STAGE(bufoff, gbase, voffB[0], voffB[1])
#define G8_STAGEA(bufoff, gbase) G8_STAGE(bufoff, gbase, voffA[0], voffA[1])
#define G8_LDA(dst, b, h) do { _Pragma("unroll") for (int m = 0; m < 4; ++m) _Pragma("unroll") for (int k = 0; k < 2; ++k) dst[m][k] = *(const LAS FragT*)(lds + G8_SA(b, h) + aoff + m * 2048 + k * 1024); } while (0)
#define G8_LDB(dst, b, h) do { _Pragma("unroll") for (int n = 0; n < 2; ++n) _Pragma("unroll") for (int k = 0; k < 2; ++k) dst[n][k] = *(const LAS FragT*)(lds + G8_SB(b, h) + boff + n * 2048 + k * 1024); } while (0)
#define G8_MMA(ai, bj, At, Bt) do { __builtin_amdgcn_s_setprio(1); _Pragma("unroll") for (int m = 0; m < 4; ++m) _Pragma("unroll") for (int n = 0; n < 2; ++n) _Pragma("unroll") for (int k = 0; k < 2; ++k) \
    acc[ai][bj][m][n] = mma16(Bt[n][k], At[m][k], acc[ai][bj][m][n]); __builtin_amdgcn_s_setprio(0); } while (0)
#define G8_WAIT_V(n) asm volatile("s_waitcnt vmcnt(" #n ")" ::: "memory")
#define G8_WAIT_L(n) asm volatile("s_waitcnt lgkmcnt(" #n ")" ::: "memory")
#define G8_BAR __builtin_amdgcn_s_barrier()
#define G8_SCHED __builtin_amdgcn_sched_barrier(0)
  GUnit cur, nxt;
  int ui = 0;
  if (!S.next(0, cur)) return;
  AccT acc[2][2][4][2];
#pragma unroll
  for (int a = 0; a < 2; ++a)
#pragma unroll
    for (int b = 0; b < 2; ++b)
#pragma unroll
      for (int m = 0; m < 4; ++m)
#pragma unroll
        for (int n = 0; n < 2; ++n) acc[a][b][m][n] = AccT{};
  FragT At[4][2], B0[2][2], B1[2][2];
  const char* cA = (const char*)Abase + (size_t)cur.pm * (BM * KB);
  const char* cB = (const char*)Btbase + (size_t)cur.brow0 * KB;
  G8_STAGEB(G8_SB(0, 0), cB); G8_STAGEA(G8_SA(0, 0), cA); G8_STAGEB(G8_SB(0, 1), cB + hstep); G8_STAGEA(G8_SA(0, 1), cA + hstep);
  if (wr == 1) G8_BAR;
  G8_WAIT_V(4); G8_BAR;
  G8_STAGEB(G8_SB(1, 0), cB + kstep); G8_STAGEA(G8_SA(1, 0), cA + kstep); G8_STAGEB(G8_SB(1, 1), cB + hstep + kstep);
  G8_WAIT_V(6); G8_BAR;
  for (;;) {
    const bool has_next = S.next(ui + 1, nxt);
    const char* nA = has_next ? (const char*)Abase + (size_t)nxt.pm * (BM * KB) : cA;
    const char* nB = has_next ? (const char*)Btbase + (size_t)nxt.brow0 * KB : cB;
#pragma unroll 1
    for (int t = 0; t < nt; t += 2) {
      const bool last = (t == nt - 2);
      const char* a1 = cA + (size_t)(t + 1) * kstep;
      const char* a2 = last ? nA : cA + (size_t)(t + 2) * kstep;
      const char* b2 = last ? nB : cB + (size_t)(t + 2) * kstep;
      const char* a3 = a2 + kstep;
      const char* b3 = b2 + kstep;
      G8_LDB(B0, 0, 0); G8_SCHED; G8_LDA(At, 0, 0); G8_STAGEA(G8_SA(1, 1), a1 + hstep);
      G8_WAIT_L(8); G8_BAR; G8_WAIT_L(0); G8_MMA(0, 0, At, B0); G8_BAR; G8_SCHED;
      G8_LDB(B1, 0, 1); G8_STAGEB(G8_SB(0, 0), b2);
      G8_BAR; G8_WAIT_L(0); G8_MMA(0, 1, At, B1); G8_BAR;
      G8_LDA(At, 0, 1); G8_STAGEA(G8_SA(0, 0), a2);
      G8_BAR; G8_WAIT_L(0); G8_MMA(1, 0, At, B0); G8_BAR; G8_SCHED;
      G8_STAGEB(G8_SB(0, 1), b2 + hstep);
      G8_WAIT_V(6); G8_BAR; G8_MMA(1, 1, At, B1); G8_BAR;
      G8_LDB(B0, 1, 0); G8_SCHED; G8_LDA(At, 1, 0); G8_STAGEA(G8_SA(0, 1), a2 + hstep);
      G8_WAIT_L(8); G8_BAR; G8_WAIT_L(0); G8_MMA(0, 0, At, B0); G8_BAR; G8_SCHED;
      G8_LDB(B1, 1, 1); G8_STAGEB(G8_SB(1, 0), b3);
      G8_BAR; G8_WAIT_L(0); G8_MMA(0, 1, At, B1); G8_BAR;
      G8_LDA(At, 1, 1); G8_STAGEA(G8_SA(1, 0), a3);
      G8_BAR; G8_WAIT_L(0); G8_MMA(1, 0, At, B0); G8_BAR; G8_SCHED;
      G8_STAGEB(G8_SB(1, 1), b3 + hstep);
      G8_WAIT_V(6); G8_BAR; G8_MMA(1, 1, At, B1); G8_BAR;
    }
    E(acc, cur, wr, wc, fr, fq);
    if (!has_next) break;
#pragma unroll
    for (int a = 0; a < 2; ++a)
#pragma unroll
      for (int b = 0; b < 2; ++b)
#pragma unroll
        for (int m = 0; m < 4; ++m)
#pragma unroll
          for (int n = 0; n < 2; ++n) acc[a][b][m][n] = AccT{};
    cur = nxt; cA = nA; cB = nB; ++ui;
  }
  G8_WAIT_V(0);
  if (wr == 0) G8_BAR;
  G8_BAR;
#undef G8_SA
#undef G8_SB
#undef G8_STAGE
#undef G8_STAGEB
#undef G8_STAGEA
#undef voffA
#undef G8_LDA
#undef G8_LDB
#undef G8_MMA
#undef G8_WAIT_V
#undef G8_WAIT_L
#undef G8_BAR
#undef G8_SCHED
}

struct DenseSched {
  int nM, nN, G, c;
  __device__ __forceinline__ bool next(int i, GUnit& u) const {
    const int idx = unit_index(i, c, G, nM * nN);
    if (idx < 0) return false;
    u.pm = idx / nN; u.pn = idx - u.pm * nN; u.brow0 = u.pn * BM; u.e = 0;
    return true;
  }
};
struct MoeSched {
  const int* toff; int nN, NE, G, c;
  __device__ __forceinline__ bool next(int i, GUnit& u) const {
    const int idx = unit_index(i, c, G, toff[32] * nN);
    if (idx < 0) return false;
    u.pm = idx / nN; u.pn = idx - u.pm * nN;
    int e = 0;
#pragma unroll 1
    for (int k = 1; k < 32; ++k) e = (u.pm >= toff[k]) ? k : e;
    u.e = e; u.brow0 = e * NE + u.pn * BM;
    return true;
  }
};
}

struct EpiInProj {
  float* P; const float* SCL; const float* sw;
  __device__ __forceinline__ void operator()(const i32x4 (&acc)[2][2][4][2], const g8::GUnit& u, int wr, int wc, int fr, int fq) const {
    const int row0 = u.pm * 256 + wr * 64 + fr, col0 = u.pn * 256 + wc * 32 + 4 * fq;
    f32x4 cs[2][2];
#pragma unroll
    for (int bj = 0; bj < 2; ++bj)
#pragma unroll
      for (int n = 0; n < 2; ++n) cs[bj][n] = *(const f32x4*)(sw + col0 + bj * 128 + n * 16);
#pragma unroll
    for (int ai = 0; ai < 2; ++ai)
#pragma unroll
      for (int m = 0; m < 4; ++m) {
        const int row = row0 + ai * 128 + m * 16;
        const float sa = SCL[row];
        float* rowp = P + (size_t)row * PINP + col0;
#pragma unroll
        for (int bj = 0; bj < 2; ++bj)
#pragma unroll
          for (int n = 0; n < 2; ++n) {
            const i32x4 a = acc[ai][bj][m][n];
            f32x4 o = {(float)a[0], (float)a[1], (float)a[2], (float)a[3]};
            *(f32x4*)(rowp + bj * 128 + n * 16) = o * (cs[bj][n] * sa);
          }
      }
  }
};
__device__ __forceinline__ void phase_gemm_in(PP pp, int l, int bid, int nb, char* smem) {
  g8::DenseSched S{130, 14, nb, bid};
  EpiInProj E{(float*)(p.ws + OFF_P), (const float*)(p.ws + OFF_SCL), (const float*)(p.ws + OFF_SWIN) + (size_t)l * PINP};
  g8::gemm_stream<true>((LAS unsigned char*)smem, p.ws + OFF_H, p.ws + OFF_W + (size_t)l * WL_SIZE + WL_IN, S, E);
}

struct EpiOutProj {
  const float *xl, *xc, *mods; float *ol, *oc;
  __device__ __forceinline__ void operator()(const f32x4 (&acc)[2][2][4][2], const g8::GUnit& u, int wr, int wc, int fr, int fq) const {
    const bool lat = u.pm < 128;
    const float* xin = lat ? xl + (size_t)u.pm * 256 * 1024 : xc + (size_t)(u.pm - 128) * 256 * 1024;
    float* xo = lat ? ol + (size_t)u.pm * 256 * 1024 : oc + (size_t)(u.pm - 128) * 256 * 1024;
    const float* g1 = mods + (size_t)(lat ? (u.pm >> 6) : 2) * 6144 + 2048;
    const int row0 = wr * 64 + fr, col0 = u.pn * 256 + wc * 32 + 4 * fq;
#pragma unroll
    for (int bj = 0; bj < 2; ++bj)
#pragma unroll
      for (int n = 0; n < 2; ++n) {
        const f32x4 gv = *(const f32x4*)(g1 + col0 + bj * 128 + n * 16);
#pragma unroll
        for (int ai = 0; ai < 2; ++ai)
#pragma unroll
          for (int m = 0; m < 4; ++m) {
            const size_t o = (size_t)(row0 + ai * 128 + m * 16) * 1024 + col0 + bj * 128 + n * 16;
            const f32x4 xv = *(const f32x4*)(xin + o);
            *(f32x4*)(xo + o) = xv + gv * acc[ai][bj][m][n];
            if (m & 1) asm volatile("" ::: "memory");
          }
      }
  }
};
__device__ __forceinline__ void phase_gemm_out(PP pp, int l, int bid, int nb, char* smem) {
  g8::DenseSched S{(l == 0) ? 130 : 128, 4, nb, bid};
  EpiOutProj E{(l == 0) ? p.x : p.out, (l == 0) ? p.ctx : (const float*)(p.ws + OFF_CTX),
               (const float*)(p.ws + OFF_MODS) + (size_t)l * 3 * 6144, p.out, (float*)(p.ws + OFF_CTX)};
  g8::gemm_stream<false>((LAS unsigned char*)smem, p.ws + OFF_CC, p.ws + OFF_W + (size_t)l * WL_SIZE + WL_OUT, S, E);
}

#define LBAR() do { asm volatile("s_waitcnt lgkmcnt(0)" ::: "memory"); __builtin_amdgcn_s_barrier(); asm volatile("" ::: "memory"); } while (0)
__device__ __forceinline__ void phase_prep(PP pp, int l, int bid, int nb, char* smem) {
  const int tid = tid_opaque(), lane = tid & 63, wv = wave_id(tid);
  const float* P = (const float*)(p.ws + OFF_P);
  char* S = p.ws + OFF_S;
  bfr* QN = (bfr*)(S + S_QN);
  bfr* KN = (bfr*)(S + S_KN);
  bfr* VT = (bfr*)(S + S_VT);
  float* RWR = (float*)(S + S_RWR);
  float* RWKK = (float*)(S + S_RWKK);
  float* RWV = (float*)(S + S_RWV);
  float* RWG = (float*)(S + S_RWG);
  float* RWW = (float*)(S + S_RWW);
  float* RWKD = (float*)(S + S_RWKD);
  float* RWB = (float*)(S + S_RWB);
  float* BON = (float*)(S + S_BON);
  float* GDQ = (float*)(S + S_GDQ);
  float* GDK = (float*)(S + S_GDK);
  float* GDV = (float*)(S + S_GDV);
  float* GDAB = (float*)(S + S_GDAB);
  const float* mu = p.rw_mu + (size_t)l * 896;
  const float* w0 = p.rw_w0 + (size_t)l * 512;
  const float* w_up = p.rw_w_up + (size_t)l * 2 * 32 * 256;
  const float* a0 = p.rw_a0 + (size_t)l * 512;
  const float* a_up = p.rw_a_up + (size_t)l * 2 * 32 * 256;
  const float* g_up = p.rw_g_up + (size_t)l * 64 * 256;
  const float* k_k = p.rw_k_k + (size_t)l * 256;
  const float* k_a = p.rw_k_a + (size_t)l * 256;
  const float* r_k = p.rw_r_k + (size_t)l * 256;
  const float* conv_w = p.gd_conv_w + (size_t)l * 5 * 768;
  const float* A_log = p.gd_A_log + (size_t)l * 8;
  const float* dt_bias = p.gd_dt_bias + (size_t)l * 8;
  const float* qg = p.na_q_gain + (size_t)l * 64;
  const float* kg = p.na_k_gain + (size_t)l * 64;

  bfr* wl = (bfr*)smem;
  float* lor = (float*)(smem + 192 * 256 * 2);
  __syncthreads();
  for (int i = tid; i < 192 * 256; i += NTHR) {
    const int row = i >> 8, c = i & 255;
    const float v = row < 64 ? g_up[row * 256 + c] : row < 128 ? w_up[(row - 64) * 256 + c] : a_up[(row - 128) * 256 + c];
    wl[i] = f2bf(v);
  }
  __syncthreads();

  for (int tile = bid; tile < NTOK / 16; tile += nb) {
    const int m0 = tile * 16;
    int seq_lo, seq_hi, bb, tau0;
    if (m0 < NLAT) { bb = m0 >> 14; seq_lo = bb << 14; seq_hi = seq_lo + SEQ; tau0 = m0 - seq_lo; }
    else { bb = (m0 - NLAT) >> 8; seq_lo = NLAT + (bb << 8); seq_hi = seq_lo + CTXL; tau0 = SEQ + (m0 - seq_lo); }
    const f32x4 z4 = {0.f, 0.f, 0.f, 0.f};
    int tid_t = tid; asm volatile("" : "+v"(tid_t));
    const int lane_t = tid_t & 63;
    const int cb = lane_t * 4, hh = lane_t >> 4;
    const int lg = tid_t & 31, lt = tid_t >> 5;
    const int sl = lane_t >> 4, sc4 = (lane_t & 15) * 4;
    asm volatile("" ::: "memory");
    const f32x4 mur = *(const f32x4*)(mu + cb), muk = *(const f32x4*)(mu + 256 + cb), muv = *(const f32x4*)(mu + 512 + cb);
    const f32x4 mul = *(const f32x4*)(mu + 768 + lg * 4);

    f32x4 pr[3][4], pl[3];
    {
      const int mt0 = m0 + 2 * wv;
#pragma unroll
      for (int j = 0; j < 3; ++j)
#pragma unroll
        for (int t = 0; t < 4; ++t) {
          const int m = mt0 - 1 + t;
          pr[j][t] = (m >= seq_lo && m < seq_hi) ? *(const f32x4*)(P + (size_t)m * PINP + A_END + j * 256 + cb) : z4;
        }
#pragma unroll
      for (int t = 0; t < 3; ++t) {
        const int m = m0 + lt - 1 + t;
        pl[t] = (m >= seq_lo && m < seq_hi) ? *(const f32x4*)(P + (size_t)m * PINP + A_END + 768 + lg * 4) : z4;
      }
    }
    {
      const f32x4 v = pl[1] + mul * (0.5f * (pl[0] + pl[2]) - pl[1]);
#pragma unroll
      for (int i = 0; i < 4; ++i) {
        const int ch = lg * 4 + i;
        lor[ch * 16 + lt] = ch < 32 ? tanhf(v[i]) : ch < 64 ? v[i] : sigmoidf_(v[i]);
      }
    }
    f32x4 rr[2], rk[2], rv[2];
#pragma unroll
    for (int t = 0; t < 2; ++t) {
      rr[t] = pr[0][t + 1] + mur * (0.5f * (pr[0][t] + pr[0][t + 2]) - pr[0][t + 1]);
      rk[t] = pr[1][t + 1] + muk * (0.5f * (pr[1][t] + pr[1][t + 2]) - pr[1][t + 1]);
      rv[t] = pr[2][t + 1] + muv * (0.5f * (pr[2][t] + pr[2][t + 2]) - pr[2][t + 1]);
    }
    LBAR();
    f32x4 pg[20];
    const bool is_gd = wv < 3, is_na = (wv >= 3 && wv < 7);
    const int sec = is_gd ? wv * 4 + sl : (wv - 3) * 4 + sl;
    if (is_gd) {
#pragma unroll
      for (int t = 0; t < 20; ++t) {
        const int m = m0 - 2 + t;
        pg[t] = (m >= seq_lo && m < seq_hi) ? *(const f32x4*)(P + (size_t)m * PINP + B_END + sec * 64 + sc4) : z4;
      }
    } else if (is_na) {
#pragma unroll
      for (int t = 0; t < 16; ++t) pg[t] = *(const f32x4*)(P + (size_t)(m0 + t) * PINP + sec * 64 + sc4);
#pragma unroll
      for (int t = 16; t < 20; ++t) pg[t] = z4;
    } else {
#pragma unroll
      for (int t = 0; t < 20; ++t) pg[t] = z4;
    }
    asm volatile("" ::: "memory");
    {
      f32x4 gacc[2], wa0[2], wa1[2], aa0[2], aa1[2];
#pragma unroll
      for (int t = 0; t < 2; ++t) { gacc[t] = z4; wa0[t] = z4; wa1[t] = z4; aa0[t] = z4; aa1[t] = z4; }
#pragma unroll 4
      for (int j = 0; j < 64; ++j) {
        const bf16x4 wq = *(const bf16x4*)(wl + j * 256 + cb);
        const f32x4 wgt = {bf2f(wq[0]), bf2f(wq[1]), bf2f(wq[2]), bf2f(wq[3])};
        const float2 sv = *(const float2*)(lor + (64 + j) * 16 + 2 * wv);
        gacc[0] += wgt * sv.x; gacc[1] += wgt * sv.y;
      }
#pragma unroll 2
      for (int j = 0; j < 32; ++j) {
        const bf16x4 q0 = *(const bf16x4*)(wl + (64 + j) * 256 + cb), q1 = *(const bf16x4*)(wl + (96 + j) * 256 + cb);
        const bf16x4 q2 = *(const bf16x4*)(wl + (128 + j) * 256 + cb), q3 = *(const bf16x4*)(wl + (160 + j) * 256 + cb);
        const f32x4 ww0 = {bf2f(q0[0]), bf2f(q0[1]), bf2f(q0[2]), bf2f(q0[3])}, ww1 = {bf2f(q1[0]), bf2f(q1[1]), bf2f(q1[2]), bf2f(q1[3])};
        const f32x4 aw0 = {bf2f(q2[0]), bf2f(q2[1]), bf2f(q2[2]), bf2f(q2[3])}, aw1 = {bf2f(q3[0]), bf2f(q3[1]), bf2f(q3[2]), bf2f(q3[3])};
        const float2 tv = *(const float2*)(lor + j * 16 + 2 * wv);
        const float2 dv = *(const float2*)(lor + (32 + j) * 16 + 2 * wv);
        wa0[0] += ww0 * tv.x; wa0[1] += ww0 * tv.y; wa1[0] += ww1 * tv.x; wa1[1] += ww1 * tv.y;
        aa0[0] += aw0 * dv.x; aa0[1] += aw0 * dv.y; aa1[0] += aw1 * dv.x; aa1[1] += aw1 * dv.y;
      }
      asm volatile("" ::: "memory");
      const f32x4 kkc = *(const f32x4*)(k_k + cb), kac = *(const f32x4*)(k_a + cb), rkc = *(const f32x4*)(r_k + cb);
      const f32x4 w00 = *(const f32x4*)(w0 + cb), w01 = *(const f32x4*)(w0 + 256 + cb), a00 = *(const f32x4*)(a0 + cb), a01 = *(const f32x4*)(a0 + 256 + cb);
#pragma unroll
      for (int t = 0; t < 2; ++t) {
        const int m = m0 + 2 * wv + t;
        const f32x4 r = rr[t], k = rk[t], v = rv[t];
        const f32x4 kkraw = k * kkc;
        const float ssum = row16_sum((kkraw[0] * kkraw[0] + kkraw[1] * kkraw[1]) + (kkraw[2] * kkraw[2] + kkraw[3] * kkraw[3]));
        const f32x4 kk = kkraw * rsqrtf(ssum + 1e-6f);
        float bon = 0.f;
#pragma unroll
        for (int d = 0; d < 2; ++d) {
          const f32x4 wlin = d == 0 ? w00 + wa0[t] : w01 + wa1[t];
          const f32x4 alin = d == 0 ? a00 + aa0[t] : a01 + aa1[t];
          f32x4 lw, kd, bv;
#pragma unroll
          for (int i = 0; i < 4; ++i) {
            const float w_log = -softplusf_(-wlin[i]) - 0.5f;
            const float a = sigmoidf_(alin[i]);
            lw[i] = -__expf(w_log);
            kd[i] = k[i] * (1.f + (a - 1.f) * kac[i]);
            bv[i] = kk[i] * a;
            bon += r[i] * kd[i] * rkc[i];
          }
          const size_t o = ((size_t)d * NTOK + m) * 256 + cb;
          *(f32x4*)(RWW + o) = lw; *(f32x4*)(RWKD + o) = kd; *(f32x4*)(RWB + o) = bv;
        }
        bon = row16_sum(bon);
        const size_t o = (size_t)m * 256 + cb;
        *(f32x4*)(RWR + o) = r; *(f32x4*)(RWKK + o) = kk; *(f32x4*)(RWV + o) = v; *(f32x4*)(RWG + o) = gacc[t];
        if ((lane_t & 15) == 0) BON[(size_t)m * 4 + hh] = bon;
      }
    }
    if (is_gd) {
      f32x4 cw[5];
#pragma unroll
      for (int j = 0; j < 5; ++j) cw[j] = *(const f32x4*)(conv_w + j * 768 + sec * 64 + sc4);
#pragma unroll
      for (int t = 0; t < 16; ++t) {
        f32x4 acc = z4;
#pragma unroll
        for (int j = 0; j < 5; ++j) acc += cw[j] * pg[t + j];
        f32x4 val = {siluf_(acc[0]), siluf_(acc[1]), siluf_(acc[2]), siluf_(acc[3])};
        const int m = m0 + t;
        if (sec < 8) {
          const float ss = row16_sum((val[0] * val[0] + val[1] * val[1]) + (val[2] * val[2] + val[3] * val[3]));
          val = val * rsqrtf(ss + 1e-6f);
          if (sec < 4) *(f32x4*)(GDQ + (size_t)m * 256 + sec * 64 + sc4) = val * 0.125f;
          else *(f32x4*)(GDK + (size_t)m * 256 + (sec - 4) * 64 + sc4) = val;
        } else *(f32x4*)(GDV + (size_t)m * 256 + (sec - 8) * 64 + sc4) = val;
      }
    } else if (is_na) {
      const f32x4 gq = *(const f32x4*)(qg + sc4) * (0.125f * 1.4426950408889634f), gk = *(const f32x4*)(kg + sc4);
#pragma unroll
      for (int t = 0; t < 16; ++t) {
        f32x4 val = pg[t];
        const float ss = row16_sum((val[0] * val[0] + val[1] * val[1]) + (val[2] * val[2] + val[3] * val[3]));
        val = val * rsqrtf(ss * (1.f / 64.f) + 1e-6f);
        const int m = m0 + t;
        if (sec < 8) { const f32x4 o = val * gq; *(bf16x4*)(QN + (size_t)m * 512 + sec * 64 + sc4) = pack4(o[0], o[1], o[2], o[3]); }
        else { const f32x4 o = val * gk; *(bf16x4*)(KN + (size_t)m * 512 + (sec - 8) * 64 + sc4) = pack4(o[0], o[1], o[2], o[3]); }
      }
    }
    if (tid_t < 256) {
      const int t = tid_t >> 4, j = tid_t & 15;
      const int m = m0 + t;
      const float pv = P[(size_t)m * PINP + B_END + 1024 + j];
      float o;
      if (j < 8) o = -__expf(A_log[j]) * softplusf_(pv + dt_bias[j]);
      else o = sigmoidf_(pv);
      GDAB[(size_t)m * 16 + j] = o;
    }
    {
      const int vc = (tid_t & 127) * 4, tq = (tid_t >> 7) * 4;
      f32x4 pv[4];
#pragma unroll
      for (int t = 0; t < 4; ++t) pv[t] = *(const f32x4*)(P + (size_t)(m0 + tq + t) * PINP + 1024 + vc);
#pragma unroll
      for (int i = 0; i < 4; ++i) {
        const int hd = vc + i;
        bfr* dst = VT + ((size_t)(bb * 8 + (hd >> 6)) * (TTOK / 16) + (tau0 >> 4)) * 1024 + (hd & 63) * 16 + tq;
        *(bf16x4*)dst = pack4(pv[0][i], pv[1][i], pv[2][i], pv[3][i]);
      }
    }
    LBAR();
  }
  __syncthreads();
}

__device__ __forceinline__ int scan_tok(int b, int d, int s) {
  if (s < CTXL) { int t = d ? (CTXL - 1 - s) : s; return NLAT + b * CTXL + t; }
  int u = s - CTXL; int t = d ? (SEQ - 1 - u) : u; return b * SEQ + t;
}
#define CS 72
#define SLOT_BYTES (64 * CS * 2)
#define F0_STRIDE 68
#define X1_F0 (13 * SLOT_BYTES)
#define X1_ARR (X1_F0 + 64 * F0_STRIDE * 4)

#define MM_FRAGS(As, Bs, a0, a1, b00, b01, b10, b11)                                                     \
  const bf16x8 a0 = *(const bf16x8*)((As) + ((mt * 16 + fr) * CS + fq * 8) * 2);                         \
  const bf16x8 a1 = *(const bf16x8*)((As) + ((mt * 16 + fr) * CS + 32 + fq * 8) * 2);                    \
  const bf16x8 b00 = *(const bf16x8*)((Bs) + ((nt0 * 16 + fr) * CS + fq * 8) * 2);                       \
  const bf16x8 b01 = *(const bf16x8*)((Bs) + ((nt0 * 16 + fr) * CS + 32 + fq * 8) * 2);                  \
  const bf16x8 b10 = *(const bf16x8*)((Bs) + ((nt0 * 16 + 16 + fr) * CS + fq * 8) * 2);                  \
  const bf16x8 b11 = *(const bf16x8*)((Bs) + ((nt0 * 16 + 16 + fr) * CS + 32 + fq * 8) * 2);
#define MM_2TILES(acc0, acc1, a0, a1, b00, b01, b10, b11)                                                \
  acc0 = __builtin_amdgcn_mfma_f32_16x16x32_bf16(a0, b00, acc0, 0, 0, 0);                                \
  acc0 = __builtin_amdgcn_mfma_f32_16x16x32_bf16(a1, b01, acc0, 0, 0, 0);                                \
  acc1 = __builtin_amdgcn_mfma_f32_16x16x32_bf16(a0, b10, acc1, 0, 0, 0);                                \
  acc1 = __builtin_amdgcn_mfma_f32_16x16x32_bf16(a1, b11, acc1, 0, 0, 0);
__device__ __forceinline__ void wr_T(char* slot, int mt, int nt, int fr, int fq, f32x4 v) {
  *(bf16x4*)(slot + ((nt * 16 + fr) * CS + mt * 16 + 4 * fq) * 2) = pack4(v[0], v[1], v[2], v[3]);
}

struct ChunkIn { float lw[8], f0[8], f1[8], f2[8], f3[8], xv[8], be[8]; };
template <bool GDN>
__device__ __forceinline__ void chunk_load(PP pp, int t, ChunkIn& ci) {
  const int tid = tid_opaque(), c = tid & 63, tg = wave_id(tid);
  const int chain = t / NCHUNK, n = t - chain * NCHUNK;
  const int d = chain & 1, h = (chain >> 1) & 3, b = (chain >> 3) & 1;
  const char* S = p.ws + OFF_S;
#pragma unroll
  for (int u = 0; u < 8; ++u) {
    const int m = scan_tok(b, d, n * 64 + tg * 8 + u);
    const size_t o = (size_t)m * 256 + h * 64 + c;
    if (!GDN) {
      ci.lw[u] = ((const float*)(S + S_RWW))[(size_t)d * NTOK * 256 + o];
      ci.f0[u] = ((const float*)(S + S_RWKK))[o];
      ci.f1[u] = ((const float*)(S + S_RWB))[(size_t)d * NTOK * 256 + o];
      ci.f2[u] = ((const float*)(S + S_RWKD))[(size_t)d * NTOK * 256 + o];
      ci.f3[u] = ((const float*)(S + S_RWR))[o];
      ci.xv[u] = ((const float*)(S + S_RWV))[o];
      ci.be[u] = 1.f;
    } else {
      ci.lw[u] = ((const float*)(S + S_GDAB))[(size_t)m * 16 + d * 4 + h];
      ci.be[u] = ((const float*)(S + S_GDAB))[(size_t)m * 16 + 8 + d * 4 + h];
      ci.f0[u] = ((const float*)(S + S_GDK))[o];
      ci.f3[u] = ((const float*)(S + S_GDQ))[o];
      ci.xv[u] = ((const float*)(S + S_GDV))[o];
      ci.f1[u] = 0.f; ci.f2[u] = 0.f;
    }
  }
}
template <bool GDN>
__device__ __forceinline__ void chunk_prep_task(PP pp, int t, int t_next, bool has_next, const ChunkIn& ci, ChunkIn& nx, char* smem) {
  const int chain = t / NCHUNK, n = t - chain * NCHUNK;
  const int d = chain & 1, h = (chain >> 1) & 3, b = (chain >> 3) & 1;
  (void)b; (void)d; (void)h;
  const int tid = tid_opaque(), lane = tid & 63, wv = wave_id(tid);
  const int fr = lane & 15, fq = lane >> 4, mt = wv >> 1, nt0 = (wv & 1) * 2;
  char* S = p.ws + OFF_S;
  char* CH = p.ws + OFF_CH;
  const size_t cc = (size_t)chain * NCHUNK + n;
  char* const p0 = smem;
  char* const p1 = smem + 1 * SLOT_BYTES;
  char* const p2 = smem + 2 * SLOT_BYTES;
  char* const p3 = smem + 3 * SLOT_BYTES;
  char* const p4 = smem + 4 * SLOT_BYTES;
  char* const p5 = smem + 5 * SLOT_BYTES;
  char* const p6 = smem + 6 * SLOT_BYTES;
  char* const p7 = smem + 7 * SLOT_BYTES;
  char* const p8 = smem + 8 * SLOT_BYTES;
  char* const p9 = smem + 9 * SLOT_BYTES;
  char* const p10 = smem + 10 * SLOT_BYTES;
  char* const p11 = smem + 11 * SLOT_BYTES;
  char* const p12 = smem + 12 * SLOT_BYTES;
  float* const F0 = (float*)(smem + X1_F0);
  float* const Lv = (float*)(smem + X1_ARR);
  float* const Lm1v = Lv + 64;
  float* const betav = Lv + 128;
  float* const eLv = Lv + 192;
  float* const gC = Lv + 256;
  float* const gsum = Lv + 320;
  char* const sKt = p0;
  char* const sBh = GDN ? p0 : p1;
  char* const sKh = GDN ? p0 : p2;

  {
    const int c = lane, tg = wv;
    const float* lw = ci.lw; const float* f0 = ci.f0; const float* f1 = ci.f1; const float* f2 = ci.f2; const float* f3 = ci.f3; const float* xv = ci.xv; const float* be = ci.be;
    float cum[8];
    cum[0] = lw[0];
#pragma unroll
    for (int u = 1; u < 8; ++u) cum[u] = cum[u - 1] + lw[u];
    gsum[tg * 64 + c] = cum[7];
    LBAR();
    float off = 0.f, LC = 0.f;
#pragma unroll
    for (int g2 = 0; g2 < 8; ++g2) { const float gs = gsum[g2 * 64 + c]; LC += gs; off += (g2 < tg) ? gs : 0.f; }
    bf16x8 vKtT, vBbT, vKbT, vXT;
#pragma unroll
    for (int u = 0; u < 8; ++u) {
      const int t = tg * 8 + u;
      const float L = off + cum[u], Lm1 = L - lw[u];
      if (!GDN) {
        const float eLm1 = __expf(Lm1), enL = __expf(-L), eL = __expf(L), eCL = __expf(LC - L);
        const float kt = f0[u] * eLm1;
        *(bfr*)(p0 + (t * CS + c) * 2) = f2bf(kt);
        *(bfr*)(p1 + (t * CS + c) * 2) = f2bf(f1[u] * enL);
        *(bfr*)(p2 + (t * CS + c) * 2) = f2bf(f2[u] * enL);
        *(bfr*)(p3 + (t * CS + c) * 2) = f2bf(f3[u] * eL);
        vKtT[u] = (short)f2bf(kt);
        vBbT[u] = (short)f2bf(f1[u] * eCL);
        vKbT[u] = (short)f2bf(f2[u] * eCL);
        vXT[u] = (short)f2bf(xv[u]);
      } else {
        *(bfr*)(p0 + (t * CS + c) * 2) = f2bf(f0[u]);
        *(bfr*)(p3 + (t * CS + c) * 2) = f2bf(f3[u]);
        vKtT[u] = (short)f2bf(f0[u] * __expf(Lm1));
        vBbT[u] = (short)f2bf(be[u] * f0[u] * __expf(LC - Lm1));
        vKbT[u] = (short)f2bf(f0[u] * __expf(LC - L));
        vXT[u] = (short)f2bf(be[u] * xv[u]);
        if (c == 0) { Lv[t] = L; Lm1v[t] = Lm1; betav[t] = be[u]; eLv[t] = __expf(L); }
      }
    }
    *(bf16x8*)(p4 + (c * CS + tg * 8) * 2) = vKtT;
    *(bf16x8*)(p5 + (c * CS + tg * 8) * 2) = vBbT;
    *(bf16x8*)(p6 + (c * CS + tg * 8) * 2) = vKbT;
    *(bf16x8*)(p7 + (c * CS + tg * 8) * 2) = vXT;
    if (tg == 0) gC[c] = __expf(LC);
    if (!GDN && tid < 64) { Lv[tid] = 0.f; Lm1v[tid] = 0.f; betav[tid] = 1.f; eLv[tid] = 1.f; }
  }
  LBAR();
  if (has_next) chunk_load<GDN>(pp, t_next, nx);
  {
    {
      MM_FRAGS(sKt, sBh, a0, a1, b00, b01, b10, b11)
      f32x4 c0 = {0.f, 0.f, 0.f, 0.f}, c1 = c0;
      MM_2TILES(c0, c1, a0, a1, b00, b01, b10, b11)
#pragma unroll
      for (int q = 0; q < 2; ++q) {
        const int sI = (nt0 + q) * 16 + fr;
        const f32x4 cv = q ? c1 : c0;
        f32x4 o;
#pragma unroll
        for (int r = 0; r < 4; ++r) {
          const int tI = mt * 16 + 4 * fq + r;
          float v = cv[r];
          if (GDN) v *= betav[sI] * __expf(fminf(Lm1v[tI] - Lm1v[sI], 0.f));
          o[r] = (sI < tI) ? v : 0.f;
        }
        *(f32x4*)(F0 + sI * F0_STRIDE + mt * 16 + 4 * fq) = o;
        wr_T(p11, mt, nt0 + q, fr, fq, o);
      }
    }
    {
      MM_FRAGS(sKt, sKh, a0, a1, b00, b01, b10, b11)
      f32x4 c0 = {0.f, 0.f, 0.f, 0.f}, c1 = c0;
      MM_2TILES(c0, c1, a0, a1, b00, b01, b10, b11)
#pragma unroll
      for (int q = 0; q < 2; ++q) {
        const int sI = (nt0 + q) * 16 + fr;
        const f32x4 cv = q ? c1 : c0;
        f32x4 o;
#pragma unroll
        for (int r = 0; r < 4; ++r) {
          const int tI = mt * 16 + 4 * fq + r;
          float v = cv[r];
          if (GDN) v *= __expf(fminf(Lm1v[tI] - Lv[sI], 0.f));
          o[r] = (sI < tI) ? v : 0.f;
        }
        wr_T(p9, mt, nt0 + q, fr, fq, o);
      }
    }
    {
      MM_FRAGS(sBh, p3, a0, a1, b00, b01, b10, b11)
      f32x4 c0 = {0.f, 0.f, 0.f, 0.f}, c1 = c0;
      MM_2TILES(c0, c1, a0, a1, b00, b01, b10, b11)
#pragma unroll
      for (int q = 0; q < 2; ++q) {
        const int tI = (nt0 + q) * 16 + fr;
        const f32x4 cv = q ? c1 : c0;
        f32x4 o;
#pragma unroll
        for (int r = 0; r < 4; ++r) {
          const int sI = mt * 16 + 4 * fq + r;
          float v = cv[r];
          if (GDN) v *= betav[sI] * __expf(fminf(Lv[tI] - Lm1v[sI], 0.f));
          o[r] = (sI <= tI) ? v : 0.f;
        }
        wr_T(p10, mt, nt0 + q, fr, fq, o);
      }
    }
  }
  LBAR();
  if (wv < 2) {
    const int base = wv * 32, other = 32 - base, c = lane & 31;
    float tr[32];
#pragma unroll
    for (int j = 0; j < 32; ++j) tr[j] = 0.f;
#pragma unroll
    for (int i = 31; i >= 0; --i) {
      float a0 = (c == i) ? 1.f : 0.f, a1 = 0.f, a2 = 0.f, a3 = 0.f;
#pragma unroll
      for (int jb = ((i + 1) & ~3); jb < 32; jb += 4) {
        const f32x4 a4 = *(const f32x4*)(F0 + (base + i) * F0_STRIDE + base + jb);
        a0 -= a4[0] * tr[jb]; a1 -= a4[1] * tr[jb + 1]; a2 -= a4[2] * tr[jb + 2]; a3 -= a4[3] * tr[jb + 3];
      }
      const float acc = (a0 + a1) + (a2 + a3);
      tr[i] = acc;
      if (lane < 32) {
        *(bfr*)(p8 + ((base + i) * CS + base + c) * 2) = f2bf(acc);
        *(bfr*)(p8 + ((base + i) * CS + other + c) * 2) = (bfr)0;
      }
    }
    if (lane < 32) {
#pragma unroll
      for (int q = 0; q < 4; ++q) {
        bf16x8 o, z;
#pragma unroll
        for (int j = 0; j < 8; ++j) { o[j] = (short)f2bf(tr[8 * q + j]); z[j] = 0; }
        *(bf16x8*)(p12 + ((base + c) * CS + base + 8 * q) * 2) = o;
        *(bf16x8*)(p12 + ((base + c) * CS + other + 8 * q) * 2) = z;
      }
    }
  }
  LBAR();
  {
    MM_FRAGS(p11, p12, a0, a1, b00, b01, b10, b11)
    f32x4 c0 = {0.f, 0.f, 0.f, 0.f}, c1 = c0;
    MM_2TILES(c0, c1, a0, a1, b00, b01, b10, b11)
    wr_T(p1, mt, nt0, fr, fq, c0);
    wr_T(p1, mt, nt0 + 1, fr, fq, c1);
  }
  LBAR();
  if (mt < 2 && nt0 == 2) {
    MM_FRAGS(p8, p1, a0, a1, b00, b01, b10, b11)
    f32x4 c0 = {0.f, 0.f, 0.f, 0.f}, c1 = c0;
    MM_2TILES(c0, c1, a0, a1, b00, b01, b10, b11)
#pragma unroll
    for (int r = 0; r < 4; ++r) {
      *(bfr*)(p8 + ((mt * 16 + 4 * fq + r) * CS + (nt0) * 16 + fr) * 2) = f2bf(-c0[r]);
      *(bfr*)(p8 + ((mt * 16 + 4 * fq + r) * CS + (nt0 + 1) * 16 + fr) * 2) = f2bf(-c1[r]);
    }
  }
  LBAR();
  {
    {
      MM_FRAGS(p8, p5, a0, a1, b00, b01, b10, b11)
      f32x4 c0 = {0.f, 0.f, 0.f, 0.f}, c1 = c0;
      MM_2TILES(c0, c1, a0, a1, b00, b01, b10, b11)
      wr_T(p11, mt, nt0, fr, fq, -c0);
      wr_T(p11, mt, nt0 + 1, fr, fq, -c1);
    }
    {
      MM_FRAGS(p8, p10, a0, a1, b00, b01, b10, b11)
      f32x4 c0 = {0.f, 0.f, 0.f, 0.f}, c1 = c0;
      MM_2TILES(c0, c1, a0, a1, b00, b01, b10, b11)
      wr_T(p12, mt, nt0, fr, fq, -c0);
      wr_T(p12, mt, nt0 + 1, fr, fq, -c1);
    }
  }
  LBAR();
  {
    {
      MM_FRAGS(p4, p11, a0, a1, b00, b01, b10, b11)
      f32x4 c0 = {0.f, 0.f, 0.f, 0.f}, c1 = c0;
      MM_2TILES(c0, c1, a0, a1, b00, b01, b10, b11)
#pragma unroll
      for (int q = 0; q < 2; ++q) {
        const int cp = (nt0 + q) * 16 + fr;
        f32x4 cv = q ? c1 : c0;
#pragma unroll
        for (int r = 0; r < 4; ++r) { const int cI = mt * 16 + 4 * fq + r; if (cI == cp) cv[r] += gC[cI]; }
        wr_T(p10, mt, nt0 + q, fr, fq, cv);
      }
    }
    {
      MM_FRAGS(p9, p11, a0, a1, b00, b01, b10, b11)
      f32x4 c0 = {0.f, 0.f, 0.f, 0.f}, c1 = c0;
      MM_2TILES(c0, c1, a0, a1, b00, b01, b10, b11)
#pragma unroll
      for (int q = 0; q < 2; ++q) {
        const int cp = (nt0 + q) * 16 + fr;
        f32x4 cv = q ? c1 : c0;
        const bf16x4 kb = *(const bf16x4*)(p6 + (cp * CS + mt * 16 + 4 * fq) * 2);
#pragma unroll
        for (int r = 0; r < 4; ++r) cv[r] += __uint_as_float(((unsigned)(unsigned short)kb[r]) << 16);
        wr_T(p8, mt, nt0 + q, fr, fq, cv);
      }
    }
    {
      MM_FRAGS(p4, p12, a0, a1, b00, b01, b10, b11)
      f32x4 c0 = {0.f, 0.f, 0.f, 0.f}, c1 = c0;
      MM_2TILES(c0, c1, a0, a1, b00, b01, b10, b11)
#pragma unroll
      for (int q = 0; q < 2; ++q) {
        const int tI = (nt0 + q) * 16 + fr;
        f32x4 cv = q ? c1 : c0;
        const bf16x4 rt = *(const bf16x4*)(p3 + (tI * CS + mt * 16 + 4 * fq) * 2);
        const float el = eLv[tI];
#pragma unroll
        for (int r = 0; r < 4; ++r) cv[r] += __uint_as_float(((unsigned)(unsigned short)rt[r]) << 16) * el;
        wr_T(p1, mt, nt0 + q, fr, fq, cv);
      }
    }
    {
      f32x4 c0 = {0.f, 0.f, 0.f, 0.f}, c1 = c0;
      {
        MM_FRAGS(sKh, p3, a0, a1, b00, b01, b10, b11)
        MM_2TILES(c0, c1, a0, a1, b00, b01, b10, b11)
      }
#pragma unroll
      for (int q = 0; q < 2; ++q) {
        const int tI = (nt0 + q) * 16 + fr;
#pragma unroll
        for (int r = 0; r < 4; ++r) {
          const int sI = mt * 16 + 4 * fq + r;
          float v = q ? c1[r] : c0[r];
          if (GDN) v *= __expf(fminf(Lv[tI] - Lv[sI], 0.f));
          v = (sI <= tI) ? v : 0.f;
          if (q) c1[r] = v; else c0[r] = v;
        }
      }
      {
        MM_FRAGS(p9, p12, a0, a1, b00, b01, b10, b11)
        MM_2TILES(c0, c1, a0, a1, b00, b01, b10, b11)
      }
      wr_T(p5, mt, nt0, fr, fq, c0);
      wr_T(p5, mt, nt0 + 1, fr, fq, c1);
    }
  }
  LBAR();
  {
    {
      MM_FRAGS(p8, p7, a0, a1, b00, b01, b10, b11)
      f32x4 c0 = {0.f, 0.f, 0.f, 0.f}, c1 = c0;
      MM_2TILES(c0, c1, a0, a1, b00, b01, b10, b11)
      bfr* QT = (bfr*)(CH + cc * CH_REC + CH_QT);
      *(bf16x4*)(QT + ((mt * 4 + nt0) * 64 + lane) * 4) = pack4(c0[0], c0[1], c0[2], c0[3]);
      *(bf16x4*)(QT + ((mt * 4 + nt0 + 1) * 64 + lane) * 4) = pack4(c1[0], c1[1], c1[2], c1[3]);
    }
    {
      MM_FRAGS(p7, p5, a0, a1, b00, b01, b10, b11)
      f32x4 c0 = {0.f, 0.f, 0.f, 0.f}, c1 = c0;
      MM_2TILES(c0, c1, a0, a1, b00, b01, b10, b11)
      bfr* YX = (bfr*)(CH + cc * CH_REC + CH_YX);
      *(bf16x4*)(YX + ((mt * 4 + nt0) * 64 + lane) * 4) = pack4(c0[0], c0[1], c0[2], c0[3]);
      *(bf16x4*)(YX + ((mt * 4 + nt0 + 1) * 64 + lane) * 4) = pack4(c1[0], c1[1], c1[2], c1[3]);
    }
    {
      const int fm = wv >> 1, fa = wv & 1;
      const int row = fm * 16 + fr;
      {
        const bf16x4 lo = *(const bf16x4*)(p10 + (row * CS + 32 * fa + 4 * fq) * 2);
        const bf16x4 hi = *(const bf16x4*)(p10 + (row * CS + 32 * fa + 16 + 4 * fq) * 2);
        bf16x8 f; f[0] = lo[0]; f[1] = lo[1]; f[2] = lo[2]; f[3] = lo[3]; f[4] = hi[0]; f[5] = hi[1]; f[6] = hi[2]; f[7] = hi[3];
        *(bf16x8*)(CH + cc * CH_REC + CH_PT + (size_t)((fm * 2 + fa) * 64 + lane) * 16) = f;
      }
      {
        const bf16x4 lo = *(const bf16x4*)(p1 + (row * CS + 32 * fa + 4 * fq) * 2);
        const bf16x4 hi = *(const bf16x4*)(p1 + (row * CS + 32 * fa + 16 + 4 * fq) * 2);
        bf16x8 f; f[0] = lo[0]; f[1] = lo[1]; f[2] = lo[2]; f[3] = lo[3]; f[4] = hi[0]; f[5] = hi[1]; f[6] = hi[2]; f[7] = hi[3];
        *(bf16x8*)(CH + cc * CH_REC + CH_RYT + (size_t)((fm * 2 + fa) * 64 + lane) * 16) = f;
      }
    }
  }
  LBAR();
}

template <bool GDN>
__device__ __forceinline__ void chunk_prep_loop(PP pp, int t0, int tend, int nb, char* smem) {
  ChunkIn cur, nxt;
  if (t0 < tend) chunk_load<GDN>(pp, t0, cur);
  for (int t = t0; t < tend; t += nb) {
    const bool has_next = (t + nb) < tend;
    chunk_prep_task<GDN>(pp, t, t + nb, has_next, cur, nxt, smem);
    cur = nxt;
  }
}
__device__ __forceinline__ void phase_chunk_prep(PP pp, int bid, int nb, char* smem) {
  __syncthreads();
  const int half = (NCHAIN / 2) * NCHUNK;
  chunk_prep_loop<false>(pp, bid, half, nb, smem);
  const int k0 = (half - bid + nb - 1) / nb;
  chunk_prep_loop<true>(pp, bid + k0 * nb, NCHAIN * NCHUNK, nb, smem);
  __syncthreads();
}

#define X2_BUF 32768
#define X2_BAR() do { asm volatile("s_waitcnt lgkmcnt(0)" ::: "memory"); __builtin_amdgcn_s_barrier(); asm volatile("" ::: "memory"); } while (0)
__device__ __forceinline__ void chunk_seq_chain(PP pp, int chain, char* smem) {
  __syncthreads();
  const int tid = tid_opaque(), lane = tid & 63, wv = wave_id(tid);
  const int d = chain & 1, h = (chain >> 1) & 3, b = (chain >> 3) & 1, ty = chain >> 4;
  const char* CH = p.ws + OFF_CH;
  float* Y = (float*)(p.ws + OFF_S + (ty ? S_YGD : S_YRW)) + (size_t)d * NTOK * 256;
  const size_t c0 = (size_t)chain * NCHUNK;
  if (wv >= 4) {
    const int lw = wv - 4;
    const char* src0 = CH + c0 * CH_REC + (size_t)lane * 16;
#define X2_DMA(n) { const char* s_ = src0 + (size_t)(n) * CH_REC; LAS unsigned char* d_ = (LAS unsigned char*)smem + ((n) & 3) * X2_BUF;       \
      _Pragma("unroll") for (int i = 0; i < 8; ++i) {                                                                                       \
        const int piece = i * 4 + lw;                                                                                                       \
        __builtin_amdgcn_global_load_lds((const unsigned*)(s_ + piece * 1024), (LAS unsigned*)(d_ + piece * 1024), 16, 0, 0); } }
    X2_DMA(0) X2_DMA(1) X2_DMA(2)
    asm volatile("s_waitcnt vmcnt(16)" ::: "memory");
    X2_BAR();
    for (int n = 0; n < NCHUNK; ++n) {
      if (n + 3 < NCHUNK) { X2_DMA(n + 3) asm volatile("s_waitcnt vmcnt(16)" ::: "memory"); }
      else if (n + 2 < NCHUNK) asm volatile("s_waitcnt vmcnt(8)" ::: "memory");
      else asm volatile("s_waitcnt vmcnt(0)" ::: "memory");
      X2_BAR();
    }
#undef X2_DMA
  } else {
    const int vt = wv, fr = lane & 15, fq = lane >> 4;
    f32x4 Sacc[4];
#pragma unroll
    for (int i = 0; i < 4; ++i) Sacc[i] = (f32x4){0.f, 0.f, 0.f, 0.f};
    X2_BAR();
    for (int n = 0; n < NCHUNK; ++n) {
      const char* buf = smem + (n & 3) * X2_BUF;
      bf16x8 sB0, sB1;
#pragma unroll
      for (int j = 0; j < 4; ++j) {
        sB0[j] = (short)f2bf(Sacc[0][j]); sB0[4 + j] = (short)f2bf(Sacc[1][j]);
        sB1[j] = (short)f2bf(Sacc[2][j]); sB1[4 + j] = (short)f2bf(Sacc[3][j]);
      }
#pragma unroll
      for (int m = 0; m < 4; ++m) {
        const bf16x8 pa0 = *(const bf16x8*)(buf + ((m * 2 + 0) * 64 + lane) * 16);
        const bf16x8 pa1 = *(const bf16x8*)(buf + ((m * 2 + 1) * 64 + lane) * 16);
        const bf16x8 ra0 = *(const bf16x8*)(buf + 8192 + ((m * 2 + 0) * 64 + lane) * 16);
        const bf16x8 ra1 = *(const bf16x8*)(buf + 8192 + ((m * 2 + 1) * 64 + lane) * 16);
        const bf16x4 qb = *(const bf16x4*)(buf + 16384 + ((m * 4 + vt) * 64 + lane) * 8);
        const bf16x4 yb = *(const bf16x4*)(buf + 24576 + ((vt * 4 + m) * 64 + lane) * 8);
        f32x4 y = {bf2f(yb[0]), bf2f(yb[1]), bf2f(yb[2]), bf2f(yb[3])};
        y = __builtin_amdgcn_mfma_f32_16x16x32_bf16(sB0, ra0, y, 0, 0, 0);
        y = __builtin_amdgcn_mfma_f32_16x16x32_bf16(sB1, ra1, y, 0, 0, 0);
        f32x4 sn = {bf2f(qb[0]), bf2f(qb[1]), bf2f(qb[2]), bf2f(qb[3])};
        sn = __builtin_amdgcn_mfma_f32_16x16x32_bf16(pa0, sB0, sn, 0, 0, 0);
        sn = __builtin_amdgcn_mfma_f32_16x16x32_bf16(pa1, sB1, sn, 0, 0, 0);
        Sacc[m] = sn;
        {
          const int mm = scan_tok(b, d, n * 64 + m * 16 + fr);
          *(f32x4*)(Y + (size_t)mm * 256 + h * 64 + vt * 16 + 4 * fq) = y;
        }
      }
      X2_BAR();
    }
  }
}

struct NaPair { int mk0, mk1, tau0, tau1, kr0, kr1, ct0, ct1; };
struct NaFrag { bf16x8 k00, k01, k10, k11; bf16x4 v0[4], v1[4]; };

__device__ __forceinline__ void na_load(NaFrag& f, const bfr* KN, const bfr* VT, size_t vt_base, int h, int fr, int fq, const NaPair& pr) {
  const bfr* k0 = KN + (size_t)(pr.mk0 + fr) * 512 + h * 64 + fq * 8;
  const bfr* k1 = KN + (size_t)(pr.mk1 + fr) * 512 + h * 64 + fq * 8;
  f.k00 = *(const bf16x8*)(k0); f.k01 = *(const bf16x8*)(k0 + 32);
  f.k10 = *(const bf16x8*)(k1); f.k11 = *(const bf16x8*)(k1 + 32);
#pragma unroll
  for (int dt = 0; dt < 4; ++dt) {
    const int vo = (dt * 16 + fr) * 16 + fq * 4;
    f.v0[dt] = *(const bf16x4*)(VT + vt_base + (size_t)(pr.tau0 >> 4) * 1024 + vo);
    f.v1[dt] = *(const bf16x4*)(VT + vt_base + (size_t)(pr.tau1 >> 4) * 1024 + vo);
  }
}

__device__ __forceinline__ void na_compute(const NaFrag& f, const bf16x8 qf0, const bf16x8 qf1, bool local, bool vr0, bool vr1,
                                           int dr0, int dr1, int ct0, int ct1, int qc, int fq, const float* bias_h, f32x4 (&O)[4], float& lsum) {
  f32x4 z = {0.f, 0.f, 0.f, 0.f};
  f32x4 st0 = __builtin_amdgcn_mfma_f32_16x16x32_bf16(f.k00, qf0, z, 0, 0, 0);
  st0 = __builtin_amdgcn_mfma_f32_16x16x32_bf16(f.k01, qf1, st0, 0, 0, 0);
  f32x4 st1 = __builtin_amdgcn_mfma_f32_16x16x32_bf16(f.k10, qf0, z, 0, 0, 0);
  st1 = __builtin_amdgcn_mfma_f32_16x16x32_bf16(f.k11, qf1, st1, 0, 0, 0);
  bf16x8 pf;
  if (local) {
    const int cs = min(max(qc - 8, 0), 48);
#pragma unroll
    for (int r = 0; r < 4; ++r) {
      const int kc0 = ct0 * 16 + fq * 4 + r, kc1 = ct1 * 16 + fq * 4 + r;
      float p0 = 0.f, p1 = 0.f;
      if (vr0 && (unsigned)(kc0 - cs) < 16u) p0 = exp2f(st0[r] + bias_h[dr0 * 31 + (kc0 - qc + 15)]);
      if (vr1 && (unsigned)(kc1 - cs) < 16u) p1 = exp2f(st1[r] + bias_h[dr1 * 31 + (kc1 - qc + 15)]);
      lsum += p0 + p1;
      pf[r] = (short)f2bf(p0);
      pf[4 + r] = (short)f2bf(p1);
    }
  } else {
#pragma unroll
    for (int r = 0; r < 4; ++r) {
      const float p0 = exp2f(st0[r]), p1 = exp2f(st1[r]);
      lsum += p0 + p1;
      pf[r] = (short)f2bf(p0);
      pf[4 + r] = (short)f2bf(p1);
    }
  }
#pragma unroll
  for (int dt = 0; dt < 4; ++dt) {
    bf16x8 vf;
    vf[0] = f.v0[dt][0]; vf[1] = f.v0[dt][1]; vf[2] = f.v0[dt][2]; vf[3] = f.v0[dt][3];
    vf[4] = f.v1[dt][0]; vf[5] = f.v1[dt][1]; vf[6] = f.v1[dt][2]; vf[7] = f.v1[dt][3];
    O[dt] = __builtin_amdgcn_mfma_f32_16x16x32_bf16(vf, pf, O[dt], 0, 0, 0);
  }
}

__device__ __forceinline__ void na_block_task(PP pp, int task, const float* bias_lds) {
  const int tid = tid_opaque(), lane = tid & 63, wv = wave_id(tid);
  const int fr = lane & 15, fq = lane >> 4;
  char* S = p.ws + OFF_S;
  const bfr* QN = (const bfr*)(S + S_QN);
  const bfr* KN = (const bfr*)(S + S_KN);
  const bfr* VT = (const bfr*)(S + S_VT);
  bfr* CC = (bfr*)(p.ws + OFF_CC);
  const bool latent = task < 1024;
  int b, h, mqa, mqb, qra = 0, qrb = 0, cgp = 0;
  if (latent) {
    h = task & 7; const int quad = (task >> 3) & 63; b = task >> 9;
    qra = quad * 4 + (wv >> 2) * 2; qrb = qra + 1; cgp = wv & 3;
    mqa = b * SEQ + qra * 64 + cgp * 16; mqb = mqa + 64;
  } else {
    const int u = task - 1024;
    h = u & 7; b = u >> 3;
    mqa = NLAT + b * CTXL + (wv * 2) * 16; mqb = mqa + 16;
  }
  const bf16x8 qa0 = *(const bf16x8*)(QN + (size_t)(mqa + fr) * 512 + h * 64 + fq * 8);
  const bf16x8 qa1 = *(const bf16x8*)(QN + (size_t)(mqa + fr) * 512 + h * 64 + 32 + fq * 8);
  const bf16x8 qb0 = *(const bf16x8*)(QN + (size_t)(mqb + fr) * 512 + h * 64 + fq * 8);
  const bf16x8 qb1 = *(const bf16x8*)(QN + (size_t)(mqb + fr) * 512 + h * 64 + 32 + fq * 8);
  f32x4 Oa[4], Ob[4];
#pragma unroll
  for (int dt = 0; dt < 4; ++dt) { Oa[dt] = (f32x4){0.f, 0.f, 0.f, 0.f}; Ob[dt] = Oa[dt]; }
  float lsa = 0.f, lsb = 0.f;
  const size_t vt_base = (size_t)(b * 8 + h) * 64 * TTOK;
  const int rsa = min(max(qra - 4, 0), SEQ / 64 - 8), rsb = min(max(qrb - 4, 0), SEQ / 64 - 8);
  const int nrows = latent ? (rsb - rsa + 8) : 0;
  const int ct_first = (cgp <= 1) ? 0 : cgp - 1;
  const int nct = (cgp == 0 || cgp == 3) ? 2 : 3;
  const int ntile = nrows * nct;
  const int nlp = (ntile + 1) >> 1;
  const int npair = nlp + 8;
  const int qc = cgp * 16 + fr;
  auto mkpair = [&](int pi) {
    NaPair pr;
    if (pi < nlp) {
      const int i0 = 2 * pi, i1 = min(2 * pi + 1, ntile - 1);
      pr.kr0 = rsa + i0 / nct; pr.ct0 = ct_first + i0 % nct;
      pr.kr1 = rsa + i1 / nct; pr.ct1 = ct_first + i1 % nct;
      if (2 * pi + 1 >= ntile) pr.kr1 = -100;
      const int r1 = rsa + i1 / nct;
      pr.tau0 = pr.kr0 * 64 + pr.ct0 * 16; pr.tau1 = r1 * 64 + pr.ct1 * 16;
      pr.mk0 = b * SEQ + pr.tau0; pr.mk1 = b * SEQ + pr.tau1;
    } else {
      const int c = pi - nlp;
      pr.kr0 = pr.kr1 = pr.ct0 = pr.ct1 = 0;
      pr.tau0 = SEQ + c * 32; pr.tau1 = SEQ + c * 32 + 16;
      pr.mk0 = NLAT + b * CTXL + c * 32; pr.mk1 = pr.mk0 + 16;
    }
    return pr;
  };
  NaFrag fa, fb;
  NaPair pa = mkpair(0), pb;
  na_load(fa, KN, VT, vt_base, h, fr, fq, pa);
  const float* bias_h = bias_lds + h * 465;
#define NA_DO(F, PR, PI)                                                                                          \
  {                                                                                                               \
    const bool loc_ = (PI) < nlp;                                                                                 \
    na_compute(F, qa0, qa1, loc_, (unsigned)(PR.kr0 - rsa) < 8u, (unsigned)(PR.kr1 - rsa) < 8u,                   \
               PR.kr0 - qra + 7, PR.kr1 - qra + 7, PR.ct0, PR.ct1, qc, fq, bias_h, Oa, lsa);                      \
    na_compute(F, qb0, qb1, loc_, (unsigned)(PR.kr0 - rsb) < 8u, (unsigned)(PR.kr1 - rsb) < 8u,                   \
               PR.kr0 - qrb + 7, PR.kr1 - qrb + 7, PR.ct0, PR.ct1, qc, fq, bias_h, Ob, lsb);                      \
  }
  for (int pi = 0; pi < npair; pi += 2) {
    if (pi + 1 < npair) { pb = mkpair(pi + 1); na_load(fb, KN, VT, vt_base, h, fr, fq, pb); }
    NA_DO(fa, pa, pi)
    if (pi + 1 < npair) {
      if (pi + 2 < npair) { pa = mkpair(pi + 2); na_load(fa, KN, VT, vt_base, h, fr, fq, pa); }
      NA_DO(fb, pb, pi + 1)
    }
  }
#undef NA_DO
  lsa += shfl_xor_l(lsa, 16, lane); lsa += shfl_xor_l(lsa, 32, lane);
  lsb += shfl_xor_l(lsb, 16, lane); lsb += shfl_xor_l(lsb, 32, lane);
  const float ia = 1.f / lsa, ib = 1.f / lsb;
#pragma unroll
  for (int dt = 0; dt < 4; ++dt) {
    *(bf16x4*)(CC + (size_t)(mqa + fr) * 1024 + h * 64 + dt * 16 + fq * 4) = pack4(Oa[dt][0] * ia, Oa[dt][1] * ia, Oa[dt][2] * ia, Oa[dt][3] * ia);
    *(bf16x4*)(CC + (size_t)(mqb + fr) * 1024 + h * 64 + dt * 16 + fq * 4) = pack4(Ob[dt][0] * ib, Ob[dt][1] * ib, Ob[dt][2] * ib, Ob[dt][3] * ib);
  }
}

__device__ __forceinline__ void phase_mix(PP pp, int l, int bid, int nb, char* smem) {
  const int tid = tid_opaque();
  const int nscan_blocks = (nb > 32) ? 32 : nb;
  const int first_attn_block = (nb > 32) ? 32 : 0;
  if (bid < nscan_blocks) {
    for (int c = bid; c < NCHAIN; c += nscan_blocks) chunk_seq_chain(pp, c, smem);
  }
  if (bid >= first_attn_block) {
    float* bias = (float*)smem;
    __syncthreads();
    for (int i = tid; i < 8 * 465; i += NTHR) bias[i] = p.na_rpb[(size_t)l * 8 * 465 + i] * 1.4426950408889634f;
    __syncthreads();
    const int ntask = (l == 0) ? 1024 + 16 : 1024;
    const int nab = nb - first_attn_block;
    for (int t = bid - first_attn_block; t < ntask; t += nab) na_block_task(pp, t, bias);
    __syncthreads();
    phase_convert(pp, l, 1, bid - first_attn_block, nab, smem);
    if (l == 0) phase_convert(pp, 1, 0, bid - first_attn_block, nab, smem);
  }
}

__device__ __forceinline__ void phase_post(PP pp, int l, int bid, int nb) {
  const int tid = tid_opaque(), lane = tid & 63, wv = wave_id(tid);
  char* S = p.ws + OFF_S;
  const float* YRW = (const float*)(S + S_YRW);
  const float* YGD = (const float*)(S + S_YGD);
  const float* RWV = (const float*)(S + S_RWV);
  const float* RWG = (const float*)(S + S_RWG);
  const float* BON = (const float*)(S + S_BON);
  const float* P = (const float*)(p.ws + OFF_P);
  bfr* CC = (bfr*)(p.ws + OFF_CC);
  const float* ln_w = p.rw_ln_w + (size_t)l * 256;
  const float* ln_b = p.rw_ln_b + (size_t)l * 256;
  const float* ng = p.gd_norm_g + (size_t)l * 64;
  const int ntok = (l == 0) ? NTOK : NLAT;
  for (int wt = bid * 8 + wv; wt < ntok * 8; wt += nb * 8) {
    int m = wt >> 3, hs = wt & 7;
    if (hs < 4) {
      int c = hs * 64 + lane;
      size_t o = (size_t)m * 256 + c;
      float y = YRW[o] + YRW[(size_t)NTOK * 256 + o];
      float mean = wave_sum(y) * (1.f / 64.f);
      float dv = y - mean;
      float var = wave_sum(dv * dv) * (1.f / 64.f);
      float yn = dv * rsqrtf(var + 64e-5f) * ln_w[c] + ln_b[c];
      float out = (yn + BON[(size_t)m * 4 + hs] * RWV[o]) * RWG[o];
      CC[(size_t)m * 1024 + 512 + c] = f2bf(out);
    } else {
      int c = (hs - 4) * 64 + lane;
      size_t o = (size_t)m * 256 + c;
      float y = YGD[o] + YGD[(size_t)NTOK * 256 + o];
      float ms = wave_sum(y * y) * (1.f / 64.f);
      float z = P[(size_t)m * PINP + B_END + 768 + c];
      float out = y * rsqrtf(ms + 1e-6f) * ng[lane] * siluf_(z);
      CC[(size_t)m * 1024 + 768 + c] = f2bf(out);
    }
  }
}

#define RW_LDS_ROW 36
__device__ __forceinline__ void phase_router(PP pp, int l, int bid, int nb, char* smem) {
  const int tid = tid_opaque(), lane = tid & 63, wv = wave_id(tid);
  const float* xl = p.out;
  const float* xc = (const float*)(p.ws + OFF_CTX);
  const float* mods = (const float*)(p.ws + OFF_MODS) + (size_t)l * 3 * 6144;
  const float* g = p.norm_ffn_g + (size_t)l * 1024;
  const float* rw = p.moe_router_w + (size_t)l * 1024 * 32;
  const float* rb = p.moe_router_b + (size_t)l * 32;
  bfr* H = (bfr*)(p.ws + OFF_H);
  int* cnt = (int*)(p.ws + OFF_CNT);
  int* TOKE = (int*)(p.ws + OFF_TOKE);
  int* TOKP = (int*)(p.ws + OFF_TOKP);
  float* TOKG = (float*)(p.ws + OFF_TOKG);
  float* wl = (float*)smem;
  for (int i = tid; i < 1024 * 8; i += NTHR) {
    int d = i >> 3, q = i & 7;
    *(float4*)(wl + d * RW_LDS_ROW + q * 4) = *(const float4*)(rw + (size_t)d * 32 + q * 4);
  }
  __syncthreads();
  const int ntok = (l == 0) ? NTOK : NLAT;
  const float rbl = rb[lane & 31];
  for (int m0 = (bid * 8 + wv) * 2; m0 < ntok; m0 += nb * 16) {
    float acc0[32], acc1[32];
#pragma unroll
    for (int e = 0; e < 32; ++e) { acc0[e] = 0.f; acc1[e] = 0.f; }
    float hv0[16], hv1[16];
    {
      const int ma = m0, mb = m0 + 1;
      const float* xa = (ma < NLAT) ? xl + (size_t)ma * 1024 : xc + (size_t)(ma - NLAT) * 1024;
      const float* xb = (mb < NLAT) ? xl + (size_t)mb * 1024 : xc + (size_t)(mb - NLAT) * 1024;
      const float* mda = mods + (size_t)mod_row(ma) * 6144 + 3072;
      const float* mdb = mods + (size_t)mod_row(mb) * 6144 + 3072;
      float ssa = 0.f, ssb = 0.f;
#pragma unroll
      for (int i = 0; i < 16; ++i) { hv0[i] = xa[lane + 64 * i]; hv1[i] = xb[lane + 64 * i]; }
#pragma unroll
      for (int i = 0; i < 16; ++i) { ssa += hv0[i] * hv0[i]; ssb += hv1[i] * hv1[i]; }
      ssa = wave_sum(ssa); ssb = wave_sum(ssb);
      const float rsa = rsqrtf(ssa * (1.f / 1024.f) + 1e-6f), rsb = rsqrtf(ssb * (1.f / 1024.f) + 1e-6f);
#pragma unroll
      for (int i = 0; i < 16; ++i) {
        const int d = lane + 64 * i;
        const float gg = g[d];
        hv0[i] = hv0[i] * rsa * gg * (1.f + mda[1024 + d]) + mda[d];
        hv1[i] = hv1[i] * rsb * gg * (1.f + mdb[1024 + d]) + mdb[d];
      }
      float am0 = 0.f, am1 = 0.f;
#pragma unroll
      for (int i = 0; i < 16; ++i) { am0 = fmaxf(am0, fabsf(hv0[i])); am1 = fmaxf(am1, fabsf(hv1[i])); }
      am0 = wave_max(am0); am1 = wave_max(am1);
      const float sc0 = am0 > 0.f ? am0 * (1.f / 127.f) : 1.f, sc1 = am1 > 0.f ? am1 * (1.f / 127.f) : 1.f;
      const float iv0 = 1.f / sc0, iv1 = 1.f / sc1;
      signed char* H8 = (signed char*)(p.ws + OFF_H);
#pragma unroll
      for (int i = 0; i < 16; ++i) {
        const int d = lane + 64 * i;
        H8[(size_t)ma * 1024 + d] = (signed char)(int)fminf(fmaxf(rintf(hv0[i] * iv0), -127.f), 127.f);
        H8[(size_t)mb * 1024 + d] = (signed char)(int)fminf(fmaxf(rintf(hv1[i] * iv1), -127.f), 127.f);
      }
      if (lane == 0) { float* SCL = (float*)(p.ws + OFF_SCL); SCL[ma] = sc0; SCL[mb] = sc1; }
      asm volatile("" ::: "memory");
    }
#pragma unroll
    for (int i = 0; i < 16; ++i) {
      if ((i & 3) == 0) asm volatile("" ::: "memory");
      const float* wr = wl + (lane + 64 * i) * RW_LDS_ROW;
#pragma unroll
      for (int q = 0; q < 8; ++q) {
        const float4 w = *(const float4*)(wr + q * 4);
        acc0[q * 4 + 0] += hv0[i] * w.x; acc0[q * 4 + 1] += hv0[i] * w.y; acc0[q * 4 + 2] += hv0[i] * w.z; acc0[q * 4 + 3] += hv0[i] * w.w;
        acc1[q * 4 + 0] += hv1[i] * w.x; acc1[q * 4 + 1] += hv1[i] * w.y; acc1[q * 4 + 2] += hv1[i] * w.z; acc1[q * 4 + 3] += hv1[i] * w.w;
      }
    }
#define BFLY(A, N, D)                                                                           \
    _Pragma("unroll") for (int i = 0; i < (N); ++i) {                                            \
      const bool up = (lane & (D)) != 0;                                                         \
      const float keep = up ? A[i + (N)] : A[i];                                                 \
      const float send = up ? A[i] : A[i + (N)];                                                 \
      A[i] = keep + shfl_xor_l(send, (D), lane);                                                   \
    }
    BFLY(acc0, 16, 16) BFLY(acc1, 16, 16)
    BFLY(acc0, 8, 8) BFLY(acc1, 8, 8)
    BFLY(acc0, 4, 4) BFLY(acc1, 4, 4)
    BFLY(acc0, 2, 2) BFLY(acc1, 2, 2)
    BFLY(acc0, 1, 1) BFLY(acc1, 1, 1)
#undef BFLY
    float la = acc0[0] + shfl_xor_l(acc0[0], 32, lane);
    float lb = acc1[0] + shfl_xor_l(acc1[0], 32, lane);
    const int my_e = lane & 31;
    la += rbl; lb += rbl;
    (void)my_e;
#pragma unroll
    for (int tkn = 0; tkn < 2; ++tkn) {
      float v = tkn == 0 ? la : lb;
      float tv[4]; int ti[4];
#pragma unroll
      for (int k = 0; k < 4; ++k) {
        float bv = v; int bi = lane & 31;
#pragma unroll
        for (int o = 16; o >= 1; o >>= 1) {
          float ov = shfl_xor_l(bv, o, lane); int oi = shfl_xor_li(bi, o, lane);
          bool take = (ov > bv) || (ov == bv && oi < bi);
          bv = take ? ov : bv; bi = take ? oi : bi;
        }
        tv[k] = bv; ti[k] = bi;
        if ((lane & 31) == bi) v = -3.0e38f;
      }
      float e1 = __expf(tv[1] - tv[0]), e2 = __expf(tv[2] - tv[0]), e3 = __expf(tv[3] - tv[0]);
      float inv = 1.f / (1.f + e1 + e2 + e3);
      const int m = m0 + tkn;
      if (lane < 4) {
        int e = lane == 0 ? ti[0] : lane == 1 ? ti[1] : lane == 2 ? ti[2] : ti[3];
        float gt = (lane == 0 ? 1.f : lane == 1 ? e1 : lane == 2 ? e2 : e3) * inv;
        int pos = atomicAdd(&cnt[e], 1);
        TOKE[(size_t)m * 4 + lane] = e; TOKP[(size_t)m * 4 + lane] = pos; TOKG[(size_t)m * 4 + lane] = gt;
      }
    }
  }
  __syncthreads();
}

__device__ __forceinline__ void moe_offsets(PP pp, int* toff) {
  const int* cnt = (const int*)(p.ws + OFF_CNT);
  if (tid_opaque() == 0) {
    int a = 0;
    for (int e = 0; e < 32; ++e) { toff[e] = a; a += (cnt[e] + 255) >> 8; }
    toff[32] = a;
  }
  __syncthreads();
}

__device__ __forceinline__ void phase_slotfill(PP pp, int l, int bid, int nb, char* smem) {
  int* toff = (int*)smem;
  moe_offsets(pp, toff);
  const int tid = tid_opaque(), lane = tid & 63, wv = wave_id(tid);
  const int* TOKE = (const int*)(p.ws + OFF_TOKE);
  const int* TOKP = (const int*)(p.ws + OFF_TOKP);
  const float* TOKG = (const float*)(p.ws + OFF_TOKG);
  const int* cnt = (const int*)(p.ws + OFF_CNT);
  int* TOKS = (int*)(p.ws + OFF_TOKS);
  float* SLG = (float*)(p.ws + OFF_SLG);
  float* SLS = (float*)(p.ws + OFF_SLS);
  const float* SCL = (const float*)(p.ws + OFF_SCL);
  const signed char* H8 = (const signed char*)(p.ws + OFF_H);
  signed char* XG = (signed char*)(p.ws + OFF_S);
  const int n = ((l == 0) ? NTOK : NLAT) * 4;
  for (int i = bid * 8 + wv; i < n; i += nb * 8) {
    int e = TOKE[i];
    int slot = toff[e] * 256 + TOKP[i];
    if (lane == 0) { TOKS[i] = slot; SLG[slot] = TOKG[i]; SLS[slot] = SCL[i >> 2]; }
    const uint4* src = (const uint4*)(H8 + (size_t)(i >> 2) * 1024);
    uint4* dst = (uint4*)(XG + (size_t)slot * 1024);
    dst[lane] = src[lane];
  }
  for (int e = 0; e < 32; ++e) {
    const int c = cnt[e];
    const int npad = ((c + 255) & ~255) - c;
    const int base = toff[e] * 256 + c;
    for (int r = bid * 8 + wv; r < npad; r += nb * 8) {
      uint4* dst = (uint4*)(XG + (size_t)(base + r) * 1024);
      dst[lane] = make_uint4(0u, 0u, 0u, 0u);
      if (lane == 0) SLS[base + r] = 0.f;
    }
  }
  __syncthreads();
}

struct EpiMoe1 {
  const float* bgu; const float* sw; const float* SLS; bfr* ACT;
  __device__ __forceinline__ void operator()(const i32x4 (&acc)[2][2][4][2], const g8::GUnit& u, int wr, int wc, int fr, int fq) const {
    const float* be = bgu + (size_t)u.e * 2048;
    const float* se = sw + (size_t)u.e * 2048;
    const int slot0 = u.pm * 256 + wr * 64 + fr;
#pragma unroll
    for (int bj = 0; bj < 2; ++bj) {
      const int j0 = u.pn * 128 + bj * 64 + wc * 16 + 4 * fq;
      const f32x4 bg = *(const f32x4*)(be + j0), bl = *(const f32x4*)(be + 1024 + j0);
      const f32x4 sg = *(const f32x4*)(se + j0), sl = *(const f32x4*)(se + 1024 + j0);
#pragma unroll
      for (int ai = 0; ai < 2; ++ai)
#pragma unroll
        for (int m = 0; m < 4; ++m) {
          const int slot = slot0 + ai * 128 + m * 16;
          const float sa = SLS[slot];
          bf16x4 o;
#pragma unroll
          for (int q = 0; q < 4; ++q) {
            const float g = (float)acc[ai][bj][m][0][q] * (sa * sg[q]) + bg[q];
            const float li = (float)acc[ai][bj][m][1][q] * (sa * sl[q]) + bl[q];
            const float gv = fminf(g, 7.f);
            const float lv = fminf(fmaxf(li, -7.f), 7.f);
            o[q] = (short)f2bf(gv * sigmoidf_(1.702f * gv) * (lv + 1.f));
          }
          *(bf16x4*)(ACT + (size_t)slot * 1024 + j0) = o;
        }
    }
  }
};
__device__ __forceinline__ void phase_moe1_impl(PP pp, int l, int bid, int nb, char* smem, int* toff) {
  moe_offsets(pp, toff);
  g8::MoeSched S{toff, 8, 2048, nb, bid};
  EpiMoe1 E{p.moe_b_gu + (size_t)l * 32 * 2048, (const float*)(p.ws + OFF_SW) + (size_t)l * 32 * 2048, (const float*)(p.ws + OFF_SLS), (bfr*)(p.ws + OFF_P)};
  g8::gemm_stream<true>((LAS unsigned char*)smem, p.ws + OFF_S, p.ws + OFF_W + (size_t)l * WL_SIZE + WL_GU, S, E);
}

struct EpiMoe2 {
  const float* bdn; const float* SLG; bfr* YS;
  __device__ __forceinline__ void operator()(const f32x4 (&acc)[2][2][4][2], const g8::GUnit& u, int wr, int wc, int fr, int fq) const {
    const float* be = bdn + (size_t)u.e * 1024;
    const int slot0 = u.pm * 256 + wr * 64 + fr, col0 = u.pn * 256 + wc * 32 + 4 * fq;
#pragma unroll
    for (int ai = 0; ai < 2; ++ai)
#pragma unroll
      for (int m = 0; m < 4; ++m) {
        const int slot = slot0 + ai * 128 + m * 16;
        const float gt = SLG[slot];
#pragma unroll
        for (int bj = 0; bj < 2; ++bj)
#pragma unroll
          for (int n = 0; n < 2; ++n) {
            const f32x4 bv = *(const f32x4*)(be + col0 + bj * 128 + n * 16);
            const f32x4 yv = (acc[ai][bj][m][n] + bv) * gt;
            *(bf16x4*)(YS + (size_t)slot * 1024 + col0 + bj * 128 + n * 16) = pack4(yv[0], yv[1], yv[2], yv[3]);
          }
      }
  }
};
__device__ __forceinline__ void phase_moe2_impl(PP pp, int l, int bid, int nb, char* smem, int* toff) {
  moe_offsets(pp, toff);
  g8::MoeSched S{toff, 4, 1024, nb, bid};
  EpiMoe2 E{p.moe_b_down + (size_t)l * 32 * 1024, (const float*)(p.ws + OFF_SLG), (bfr*)(p.ws + OFF_S)};
  g8::gemm_stream<false>((LAS unsigned char*)smem, p.ws + OFF_P, p.ws + OFF_W + (size_t)l * WL_SIZE + WL_DN, S, E);
}

__device__ __forceinline__ void phase_combine(PP pp, int l, int bid, int nb) {
  const int tid = tid_opaque(), lane = tid & 63, wv = wave_id(tid);
  const bfr* YS = (const bfr*)(p.ws + OFF_S);
  const int* TOKS = (const int*)(p.ws + OFF_TOKS);
  const float* mods = (const float*)(p.ws + OFF_MODS) + (size_t)l * 3 * 6144;
  const float* mods1 = (const float*)(p.ws + OFF_MODS) + (size_t)3 * 6144;
  const float* g1n = p.norm_mix_g + 1024;
  bfr* H = (bfr*)(p.ws + OFF_H);
  float* xl = p.out;
  float* xc = (float*)(p.ws + OFF_CTX);
  const int ntok = (l == 0) ? NTOK : NLAT;
  if (l == 0) {
    int* cnt = (int*)(p.ws + OFF_CNT);
    const int gt = bid * NTHR + tid;
    if (gt < 32) cnt[gt] = 0;
  }
  for (int m = bid * 8 + wv; m < ntok; m += nb * 8) {
    float* xr = (m < NLAT) ? xl + (size_t)m * 1024 : xc + (size_t)(m - NLAT) * 1024;
    const float* g2 = mods + (size_t)mod_row(m) * 6144 + 5120;
    const int s0 = TOKS[(size_t)m * 4], s1 = TOKS[(size_t)m * 4 + 1], s2 = TOKS[(size_t)m * 4 + 2], s3 = TOKS[(size_t)m * 4 + 3];
    float4 xn[4];
    float ss = 0.f;
#pragma unroll
    for (int i = 0; i < 4; ++i) {
      const int d = (lane + 64 * i) * 4;
      const bf16x4 a = *(const bf16x4*)(YS + (size_t)s0 * 1024 + d);
      const bf16x4 b = *(const bf16x4*)(YS + (size_t)s1 * 1024 + d);
      const bf16x4 c = *(const bf16x4*)(YS + (size_t)s2 * 1024 + d);
      const bf16x4 e = *(const bf16x4*)(YS + (size_t)s3 * 1024 + d);
      const float4 gg = *(const float4*)(g2 + d);
      float4 xv = *(const float4*)(xr + d);
      xv.x += gg.x * ((bf2f(a[0]) + bf2f(b[0])) + (bf2f(c[0]) + bf2f(e[0])));
      xv.y += gg.y * ((bf2f(a[1]) + bf2f(b[1])) + (bf2f(c[1]) + bf2f(e[1])));
      xv.z += gg.z * ((bf2f(a[2]) + bf2f(b[2])) + (bf2f(c[2]) + bf2f(e[2])));
      xv.w += gg.w * ((bf2f(a[3]) + bf2f(b[3])) + (bf2f(c[3]) + bf2f(e[3])));
      *(float4*)(xr + d) = xv;
      xn[i] = xv;
      ss += xv.x * xv.x + xv.y * xv.y + xv.z * xv.z + xv.w * xv.w;
    }
    if (l == 0) {
      ss = wave_sum(ss);
      const float rs = rsqrtf(ss * (1.f / 1024.f) + 1e-6f);
      const float* md = mods1 + (size_t)mod_row(m) * 6144;
      float4 hq[4];
#pragma unroll
      for (int i = 0; i < 4; ++i) {
        const int d = (lane + 64 * i) * 4;
        const float4 gg = *(const float4*)(g1n + d);
        const float4 sh = *(const float4*)(md + d);
        const float4 sc = *(const float4*)(md + 1024 + d);
        hq[i] = make_float4(xn[i].x * rs * gg.x * (1.f + sc.x) + sh.x, xn[i].y * rs * gg.y * (1.f + sc.y) + sh.y,
                            xn[i].z * rs * gg.z * (1.f + sc.z) + sh.z, xn[i].w * rs * gg.w * (1.f + sc.w) + sh.w);
      }
      const float qs = quant_row_store(hq, (signed char*)(p.ws + OFF_H) + (size_t)m * 1024, lane);
      if (lane == 0) ((float*)(p.ws + OFF_SCL))[m] = qs;
    }
  }
}

#define XB_TMO      128
#define XB_XCNT(j)  (256  + 64 * (j))
#define XB_XSUB(j)  (1280 + 64 * (j))
#define XB_XGEN(j)  (2304 + 64 * (j))
#define XB_TOP      3328
#define XB_TOPGEN   3392
#define XCD_BAR_WORDS 3456
#define XB_SPIN_CAP (1u << 22)
__device__ __forceinline__ unsigned xb_ld(unsigned* q) { return __hip_atomic_load(q, __ATOMIC_RELAXED, __HIP_MEMORY_SCOPE_AGENT); }
__device__ __forceinline__ unsigned xb_add(unsigned* q, unsigned v) { return __hip_atomic_fetch_add(q, v, __ATOMIC_RELAXED, __HIP_MEMORY_SCOPE_AGENT); }
__device__ __forceinline__ unsigned xb_xcc_id() { return (unsigned)__builtin_amdgcn_s_getreg((3 << 11) | 20) & 0xFu; }
#define XB_SPIN(cond, bar) do { unsigned _sp = 0; while (cond) { __builtin_amdgcn_s_sleep(1); \
    if ((++_sp & 255u) == 0u) { if (xb_ld(&(bar)[XB_TMO])) break; if (_sp > XB_SPIN_CAP) { atomicAdd(&(bar)[XB_TMO], 1u); break; } } } } while (0)
struct XcdBarrier { unsigned* bar; unsigned x; volatile LAS unsigned* st; };
__device__ __forceinline__ XcdBarrier xcd_barrier_post(unsigned* bar, volatile LAS unsigned* st) {
  XcdBarrier b; b.bar = bar; b.x = xb_xcc_id(); b.st = st;
  if (tid_opaque() == 0) (void)xb_add(&bar[XB_XCNT(b.x)], 1u);
  return b;
}
__device__ __forceinline__ void xcd_barrier_complete(unsigned* bar, unsigned x, unsigned& nloc, unsigned& nx) {
  const unsigned G = gridDim.x;
  unsigned sum, cnt, mine, sp = 0u;
  for (;;) {
    sum = 0u; cnt = 0u; mine = 0u;
#pragma unroll
    for (unsigned j = 0; j < 16; ++j) { const unsigned c = xb_ld(&bar[XB_XCNT(j)]); sum += c; cnt += (c > 0u) ? 1u : 0u; mine = (j == x) ? c : mine; }
    if (sum == G) break;
    __builtin_amdgcn_s_sleep(1);
    if ((++sp & 255u) == 0u) { if (xb_ld(&bar[XB_TMO])) break; if (sp > XB_SPIN_CAP) { atomicAdd(&bar[XB_TMO], 1u); break; } }
  }
  nloc = mine > 0u ? mine : 1u; nx = cnt > 0u ? cnt : 1u;
}
__device__ __forceinline__ void xcd_barrier(const XcdBarrier& b) {
  asm volatile("s_waitcnt vmcnt(0)" ::: "memory");
  __syncthreads();
  if (tid_opaque() == 0) {
    unsigned* bar = b.bar;
    __builtin_amdgcn_s_waitcnt(0);
    unsigned nloc = b.st[0], nx = b.st[1];
    if (nloc == 0u) { xcd_barrier_complete(bar, b.x, nloc, nx); b.st[0] = nloc; b.st[1] = nx; }
    const unsigned old = xb_add(&bar[XB_XSUB(b.x)], 1u);
    const unsigned gen = old / nloc;
    if (old + 1u == (gen + 1u) * nloc) {
      __builtin_amdgcn_fence(__ATOMIC_RELEASE, "agent");
      asm volatile("s_waitcnt vmcnt(0)" ::: "memory");
      const unsigned og = xb_add(&bar[XB_TOP], 1u);
      const unsigned tg = og / nx;
      if (og + 1u == (tg + 1u) * nx) xb_add(&bar[XB_TOPGEN], 1u);
      else XB_SPIN(xb_ld(&bar[XB_TOPGEN]) == tg, bar);
      __builtin_amdgcn_fence(__ATOMIC_ACQUIRE, "agent");
      xb_add(&bar[XB_XGEN(b.x)], 1u);
      asm volatile("s_waitcnt vmcnt(0)" ::: "memory");
    } else {
      XB_SPIN(xb_ld(&bar[XB_XGEN(b.x)]) == gen, bar);
      __builtin_amdgcn_fence(__ATOMIC_ACQUIRE, "agent");
      asm volatile("s_waitcnt vmcnt(0)" ::: "memory");
    }
  }
  __syncthreads();
}

extern __shared__ __attribute__((aligned(16))) char dyn_smem[];

__global__ void __launch_bounds__(NTHR) mega(Params p_unused) {
  cg::grid_group grid = cg::this_grid();
  const int bid0 = blockIdx.x, nb0 = gridDim.x;
#if defined(__HIP_DEVICE_COMPILE__)
  PP pp0 = (PP)__builtin_amdgcn_kernarg_segment_ptr();
#else
  PP pp0 = nullptr;
#endif
#define pp ({ PP q_ = pp0; asm volatile("" : "+s"(q_)); q_; })
#define bid opq(bid0)
#define nb opq(nb0)
  int* toff_s = (int*)(dyn_smem + 147456);
  volatile LAS unsigned* xb_st = (volatile LAS unsigned*)(dyn_smem + 147456 + 256);
  {
    unsigned* barw = (unsigned*)(fresh_ws(pp0) + OFF_BAR);
    if (blockIdx.x == 0) for (int i = threadIdx.x; i < XCD_BAR_WORDS; i += NTHR) barw[i] = 0u;
    if (threadIdx.x == 0) { xb_st[0] = 0u; xb_st[1] = 0u; }
  }
  grid.sync();
  const XcdBarrier xb = xcd_barrier_post((unsigned*)(fresh_ws(pp0) + OFF_BAR), xb_st);
#define GSYNC() xcd_barrier(xb)
  phase_ada(pp, bid, nb, dyn_smem);
  phase_convert(pp, 0, 0, bid, nb, dyn_smem);
  GSYNC();
#define LAYER(LV, LAST)                                      \
  {                                                          \
    if ((LV) == 0) { phase_prenorm(pp, opq(LV), bid, nb); GSYNC(); } \
    phase_gemm_in(pp, opq(LV), bid, nb, dyn_smem);           \
    GSYNC();                                                 \
    phase_prep(pp, opq(LV), bid, nb, dyn_smem);              \
    GSYNC();                                                 \
    phase_chunk_prep(pp, bid, nb, dyn_smem);                 \
    GSYNC();                                                 \
    phase_mix(pp, opq(LV), bid, nb, dyn_smem);               \
    GSYNC();                                                 \
    phase_post(pp, opq(LV), bid, nb);                        \
    GSYNC();                                                 \
    phase_gemm_out(pp, opq(LV), bid, nb, dyn_smem);          \
    GSYNC();                                                 \
    phase_router(pp, opq(LV), bid, nb, dyn_smem);            \
    GSYNC();                                                 \
    phase_slotfill(pp, opq(LV), bid, nb, dyn_smem);          \
    GSYNC();                                                 \
    phase_moe1_impl(pp, opq(LV), bid, nb, dyn_smem, toff_s); \
    GSYNC();                                                 \
    phase_moe2_impl(pp, opq(LV), bid, nb, dyn_smem, toff_s); \
    GSYNC();                                                 \
    phase_combine(pp, opq(LV), bid, nb);                     \
    if (!(LAST)) GSYNC();                                    \
  }
  LAYER(0, false)
  LAYER(1, true)
#undef LAYER
#undef GSYNC
#undef bid
#undef nb
#undef pp
}

#undef p
extern "C" void kernel_launch(void* const* d_in, const int* in_sizes, int n_in, void* d_out, int out_size, void* d_ws,
                              size_t ws_size, hipStream_t stream) {
  Params hp{};
  const float** pp = (const float**)&hp;
  for (int i = 0; i < 34; ++i) pp[i] = (const float*)d_in[i];
  hp.out = (float*)d_out;
  hp.ws = (char*)d_ws;
  static int grid_blocks = 0;
  if (!grid_blocks) {
    (void)hipFuncSetAttribute((const void*)mega, hipFuncAttributeMaxDynamicSharedMemorySize, LDS_BYTES);
    int dev = 0, cus = 0, per_cu = 0;
    (void)hipGetDevice(&dev);
    (void)hipDeviceGetAttribute(&cus, hipDeviceAttributeMultiprocessorCount, dev);
    (void)hipOccupancyMaxActiveBlocksPerMultiprocessor(&per_cu, mega, NTHR, LDS_BYTES);
    if (per_cu < 1) per_cu = 1;
    if (per_cu > 1) per_cu = 1;
    grid_blocks = cus * per_cu;
  }
  void* args[] = {&hp};
  (void)hipLaunchCooperativeKernel((void*)mega, dim3(grid_blocks), dim3(NTHR), args, LDS_BYTES, stream);
}
```

```cpp
#include <hip/hip_runtime.h>
#include <hip/hip_bf16.h>
#include <hip/hip_cooperative_groups.h>
#include <stdint.h>
#include <type_traits>
namespace cg = cooperative_groups;

typedef __attribute__((ext_vector_type(8))) short bf16x8;
typedef __attribute__((ext_vector_type(4))) short bf16x4;
typedef __attribute__((ext_vector_type(4))) float f32x4;
typedef __attribute__((ext_vector_type(4))) int i32x4;
typedef unsigned short bfr;

#define D_MODEL 1024
#define NB 2
#define SEQ 16384
#define CTXL 256
#define NLAT (NB * SEQ)
#define NCTX (NB * CTXL)
#define NTOK (NLAT + NCTX)
#define TTOK (SEQ + CTXL)
#define PIN 3472
#define PINP 3584
#define A_END 1536
#define B_END 2432
#define NEXP 32
#define NSLOT_MAX (NTOK * 4 + NEXP * 256)
#define NTHR 512
#define LDS_BYTES (147456 + 512)

constexpr size_t al256(size_t x) { return (x + 255) & ~(size_t)255; }
constexpr size_t WL_IN = 0;
constexpr size_t WL_OUT = WL_IN + (size_t)PINP * 1024 * 2;
constexpr size_t WL_GU = WL_OUT + (size_t)1024 * 1024 * 2;
constexpr size_t WL_DN = WL_GU + (size_t)32 * 2048 * 1024 * 2;
constexpr size_t WL_SIZE = WL_DN + (size_t)32 * 1024 * 1024 * 2;
constexpr size_t OFF_W = 0;
constexpr size_t OFF_MODS = al256(OFF_W + 2 * WL_SIZE);
constexpr size_t OFF_BAR = al256(OFF_MODS + 2 * 3 * 6144 * 4);
constexpr size_t OFF_SW = al256(OFF_BAR + 3456 * 4);
constexpr size_t OFF_SWIN = al256(OFF_SW + (size_t)2 * 32 * 2048 * 4);
constexpr size_t OFF_SLS = al256(OFF_SWIN + (size_t)2 * PINP * 4);
constexpr size_t OFF_SCL = al256(OFF_SLS + (size_t)(NTOK * 4 + 32 * 256) * 4);
constexpr size_t OFF_CTX = al256(OFF_SCL + (size_t)NTOK * 4);
constexpr size_t OFF_CNT = al256(OFF_CTX + (size_t)NCTX * 1024 * 4);
constexpr size_t OFF_TOKE = al256(OFF_CNT + 256);
constexpr size_t OFF_TOKP = al256(OFF_TOKE + (size_t)NTOK * 4 * 4);
constexpr size_t OFF_TOKG = al256(OFF_TOKP + (size_t)NTOK * 4 * 4);
constexpr size_t OFF_TOKS = al256(OFF_TOKG + (size_t)NTOK * 4 * 4);
constexpr size_t OFF_SLT = al256(OFF_TOKS + (size_t)NTOK * 4 * 4);
constexpr size_t OFF_SLG = al256(OFF_SLT + (size_t)NSLOT_MAX * 4);
constexpr size_t OFF_H = al256(OFF_SLG + (size_t)NSLOT_MAX * 4);
constexpr size_t OFF_CC = al256(OFF_H + (size_t)NTOK * 1024 * 2);
constexpr size_t OFF_P = al256(OFF_CC + (size_t)NTOK * 1024 * 2);
constexpr size_t OFF_S = al256(OFF_P + (size_t)NTOK * PINP * 4);
constexpr size_t TOK256F = (size_t)NTOK * 256 * 4;
constexpr size_t S_QN = 0;
constexpr size_t S_KN = S_QN + (size_t)NTOK * 512 * 2;
constexpr size_t S_VT = S_KN + (size_t)NTOK * 512 * 2;
constexpr size_t S_RWR = S_VT + (size_t)NB * 8 * 64 * TTOK * 2;
constexpr size_t S_RWKK = S_RWR + TOK256F;
constexpr size_t S_RWV = S_RWKK + TOK256F;
constexpr size_t S_RWG = S_RWV + TOK256F;
constexpr size_t S_RWW = S_RWG + TOK256F;
constexpr size_t S_RWKD = S_RWW + 2 * TOK256F;
constexpr size_t S_RWB = S_RWKD + 2 * TOK256F;
constexpr size_t S_BON = S_RWB + 2 * TOK256F;
constexpr size_t S_GDQ = al256(S_BON + (size_t)NTOK * 4 * 4);
constexpr size_t S_GDK = S_GDQ + TOK256F;
constexpr size_t S_GDV = S_GDK + TOK256F;
constexpr size_t S_GDAB = S_GDV + TOK256F;
constexpr size_t S_YRW = al256(S_GDAB + (size_t)NTOK * 16 * 4);
constexpr size_t S_YGD = S_YRW + 2 * TOK256F;
constexpr size_t S_END = S_YGD + 2 * TOK256F;
constexpr size_t S_SIZE = (S_END > (size_t)NSLOT_MAX * 1024 * 4) ? S_END : (size_t)NSLOT_MAX * 1024 * 4;
constexpr int NCHUNK = TTOK / 64;
constexpr int NCHAIN = 32;
constexpr size_t OFF_CH = al256(OFF_S + S_SIZE);
constexpr size_t CH_N = (size_t)NCHAIN * NCHUNK;
constexpr size_t CH_REC = 32768, CH_PT = 0, CH_RYT = 8192, CH_QT = 16384, CH_YX = 24576;
constexpr size_t CH_SIZE = CH_N * CH_REC;
constexpr size_t WS_TOTAL = OFF_CH + CH_SIZE;
static_assert(WS_TOTAL <= (size_t)2048 * 1024 * 1024, "workspace exceeds 4x largest tensor");

struct Params {
  const float *x, *c, *ctx, *c_ctx, *ada_w, *ada_b, *norm_mix_g, *norm_ffn_g, *w_in, *w_out;
  const float *na_q_gain, *na_k_gain, *na_rpb;
  const float *rw_mu, *rw_w0, *rw_w_up, *rw_a0, *rw_a_up, *rw_g_up, *rw_k_k, *rw_k_a, *rw_r_k, *rw_ln_w, *rw_ln_b;
  const float *gd_conv_w, *gd_A_log, *gd_dt_bias, *gd_norm_g;
  const float *moe_router_w, *moe_router_b, *moe_w_gu, *moe_b_gu, *moe_w_down, *moe_b_down;
  float* out;
  char* ws;
};

typedef const __attribute__((address_space(4))) Params* PP;
#define p (*pp)
__device__ __forceinline__ char* fresh_ws(PP pp) { return p.ws; }
__device__ __forceinline__ int tid_opaque() { int t = (int)__builtin_amdgcn_workitem_id_x(); asm volatile("" : "+v"(t)); return t; }
__device__ __forceinline__ int opq(int x) { asm volatile("" : "+s"(x)); return x; }
__device__ __forceinline__ int wave_id(int tid) { return __builtin_amdgcn_readfirstlane(tid >> 6); }
typedef __bf16 bf16v2_t __attribute__((ext_vector_type(2)));
typedef float f32v2_t __attribute__((ext_vector_type(2)));
__device__ __forceinline__ unsigned pk_bf16(float lo, float hi) { f32v2_t v = {lo, hi}; return __builtin_bit_cast(unsigned, __builtin_convertvector(v, bf16v2_t)); }
__device__ __forceinline__ bfr f2bf(float f) { return (bfr)(pk_bf16(f, f) & 0xffffu); }
__device__ __forceinline__ float bf2f(short v) { return __uint_as_float(((unsigned)(unsigned short)v) << 16); }
__device__ __forceinline__ bf16x4 pack4(float a, float b, float c, float d) {
  typedef __attribute__((ext_vector_type(2))) unsigned u32x2;
  u32x2 w; w[0] = pk_bf16(a, b); w[1] = pk_bf16(c, d);
  return __builtin_bit_cast(bf16x4, w);
}
__device__ __forceinline__ float sigmoidf_(float x) { return __builtin_amdgcn_rcpf(1.f + __expf(-x)); }
__device__ __forceinline__ float siluf_(float x) { return x * __builtin_amdgcn_rcpf(1.f + __expf(-x)); }
__device__ __forceinline__ float softplusf_(float x) { const float e = __expf(x); return x > 20.f ? x : (x < -15.f ? e : __logf(1.f + e)); }
__device__ __forceinline__ float wave_sum(float v) {
  v += __builtin_bit_cast(float, __builtin_amdgcn_update_dpp(0, __builtin_bit_cast(int, v), 0xB1, 0xF, 0xF, true));
  v += __builtin_bit_cast(float, __builtin_amdgcn_update_dpp(0, __builtin_bit_cast(int, v), 0x4E, 0xF, 0xF, true));
  v += __builtin_bit_cast(float, __builtin_amdgcn_update_dpp(0, __builtin_bit_cast(int, v), 0x141, 0xF, 0xF, true));
  v += __builtin_bit_cast(float, __builtin_amdgcn_update_dpp(0, __builtin_bit_cast(int, v), 0x140, 0xF, 0xF, true));
  v += __builtin_bit_cast(float, __builtin_amdgcn_update_dpp(0, __builtin_bit_cast(int, v), 0x142, 0xA, 0xF, false));
  v += __builtin_bit_cast(float, __builtin_amdgcn_update_dpp(0, __builtin_bit_cast(int, v), 0x143, 0xC, 0xF, false));
  return __builtin_bit_cast(float, __builtin_amdgcn_readlane(__builtin_bit_cast(int, v), 63));
}
__device__ __forceinline__ float wave_max(float v) {
  v = fmaxf(v, __builtin_bit_cast(float, __builtin_amdgcn_update_dpp(0, __builtin_bit_cast(int, v), 0xB1, 0xF, 0xF, true)));
  v = fmaxf(v, __builtin_bit_cast(float, __builtin_amdgcn_update_dpp(0, __builtin_bit_cast(int, v), 0x4E, 0xF, 0xF, true)));
  v = fmaxf(v, __builtin_bit_cast(float, __builtin_amdgcn_update_dpp(0, __builtin_bit_cast(int, v), 0x141, 0xF, 0xF, true)));
  v = fmaxf(v, __builtin_bit_cast(float, __builtin_amdgcn_update_dpp(0, __builtin_bit_cast(int, v), 0x140, 0xF, 0xF, true)));
  const float r1 = __builtin_bit_cast(float, __builtin_amdgcn_readlane(__builtin_bit_cast(int, v), 0));
  const float r2 = __builtin_bit_cast(float, __builtin_amdgcn_readlane(__builtin_bit_cast(int, v), 16));
  const float r3 = __builtin_bit_cast(float, __builtin_amdgcn_readlane(__builtin_bit_cast(int, v), 32));
  const float r4 = __builtin_bit_cast(float, __builtin_amdgcn_readlane(__builtin_bit_cast(int, v), 48));
  return fmaxf(fmaxf(r1, r2), fmaxf(r3, r4));
}
__device__ __forceinline__ float shfl_xor_l(float v, int mask, int lane) {
  return __builtin_bit_cast(float, __builtin_amdgcn_ds_bpermute((lane ^ mask) << 2, __builtin_bit_cast(int, v)));
}
__device__ __forceinline__ int shfl_xor_li(int v, int mask, int lane) {
  return __builtin_amdgcn_ds_bpermute((lane ^ mask) << 2, v);
}
__device__ __forceinline__ float row16_sum(float v) {
  v += __builtin_bit_cast(float, __builtin_amdgcn_update_dpp(0, __builtin_bit_cast(int, v), 0xB1, 0xF, 0xF, true));
  v += __builtin_bit_cast(float, __builtin_amdgcn_update_dpp(0, __builtin_bit_cast(int, v), 0x4E, 0xF, 0xF, true));
  v += __builtin_bit_cast(float, __builtin_amdgcn_update_dpp(0, __builtin_bit_cast(int, v), 0x141, 0xF, 0xF, true));
  v += __builtin_bit_cast(float, __builtin_amdgcn_update_dpp(0, __builtin_bit_cast(int, v), 0x140, 0xF, 0xF, true));
  return v;
}
__device__ __forceinline__ float quant_row_store(const float4 (&v)[4], signed char* dst_row, int lane) {
  float am = 0.f;
#pragma unroll
  for (int i = 0; i < 4; ++i) am = fmaxf(fmaxf(am, fmaxf(fabsf(v[i].x), fabsf(v[i].y))), fmaxf(fabsf(v[i].z), fabsf(v[i].w)));
  am = wave_max(am);
  const float sc = am > 0.f ? am * (1.f / 127.f) : 1.f, iv = 1.f / sc;
#pragma unroll
  for (int i = 0; i < 4; ++i) {
    const int q0 = (int)fminf(fmaxf(rintf(v[i].x * iv), -127.f), 127.f), q1 = (int)fminf(fmaxf(rintf(v[i].y * iv), -127.f), 127.f);
    const int q2 = (int)fminf(fmaxf(rintf(v[i].z * iv), -127.f), 127.f), q3 = (int)fminf(fmaxf(rintf(v[i].w * iv), -127.f), 127.f);
    *(unsigned*)(dst_row + (lane + 64 * i) * 4) = (unsigned)(q0 & 0xff) | ((unsigned)(q1 & 0xff) << 8) | ((unsigned)(q2 & 0xff) << 16) | ((unsigned)(q3 & 0xff) << 24);
  }
  return sc;
}
__device__ __forceinline__ int mod_row(int m) { return m < NLAT ? (m >> 14) : 2; }

__device__ __forceinline__ void phase_ada(PP pp, int bid, int nb, char* smem) {
  float* red = (float*)smem;
  float* mods = (float*)(p.ws + OFF_MODS);
  const int tid = tid_opaque();
  for (int task = bid; task < 2 * 96; task += nb) {
    int l = task / 96, cgp = task % 96;
    int col = cgp * 64 + (tid & 63), ks = tid >> 6;
    const float* W = p.ada_w + (size_t)l * 1024 * 6144;
    float a0 = 0.f, a1 = 0.f, a2 = 0.f;
    for (int d = ks * 128; d < ks * 128 + 128; ++d) {
      float w = W[(size_t)d * 6144 + col];
      a0 += siluf_(p.c[d]) * w;
      a1 += siluf_(p.c[1024 + d]) * w;
      a2 += siluf_(p.c_ctx[d]) * w;
    }
    red[(ks * 3 + 0) * 64 + (tid & 63)] = a0;
    red[(ks * 3 + 1) * 64 + (tid & 63)] = a1;
    red[(ks * 3 + 2) * 64 + (tid & 63)] = a2;
    __syncthreads();
    if (tid < 192) {
      int r = tid >> 6, cc = tid & 63;
      float s = 0.f;
      for (int k = 0; k < 8; ++k) s += red[(k * 3 + r) * 64 + cc];
      mods[(size_t)(l * 3 + r) * 6144 + cgp * 64 + cc] = s + p.ada_b[(size_t)l * 6144 + cgp * 64 + cc];
    }
    __syncthreads();
  }
}

__device__ __forceinline__ void convert_tile(const float* src, int N, bfr* dst, int kt, int nt, int mode, float* tile  ) {
  const int tid = tid_opaque();
#pragma unroll
  for (int q = 0; q < 2; ++q) {
    int idx = tid + q * 512;
    int kk = idx >> 4, n4 = idx & 15;
    int n = nt * 64 + n4 * 4;
    float4 v = make_float4(0.f, 0.f, 0.f, 0.f);
    if (n < N) v = *(const float4*)(src + (size_t)(kt * 64 + kk) * N + n);
    tile[kk * 65 + n4 * 4 + 0] = v.x;
    tile[kk * 65 + n4 * 4 + 1] = v.y;
    tile[kk * 65 + n4 * 4 + 2] = v.z;
    tile[kk * 65 + n4 * 4 + 3] = v.w;
  }
  __syncthreads();
  {
    int nn = tid >> 3, kc = tid & 7;
    int n = nt * 64 + nn;
    int row = n;
    if (mode == 1) { int j = n & 1023; row = (j >> 4) * 32 + (j & 15) + ((n >= 1024) ? 16 : 0); }
    bf16x8 o;
#pragma unroll
    for (int j = 0; j < 8; ++j) o[j] = (short)f2bf(tile[(kc * 8 + j) * 65 + nn]);
    *(bf16x8*)(dst + (size_t)row * 1024 + kt * 64 + kc * 8) = o;
  }
  __syncthreads();
}
template <int N, bool INTERLEAVE>
__device__ __forceinline__ void convert_i8(const float* src  , signed char* dst  , float* sw, int ng, char* smem) {
  const int tid = tid_opaque();
  bfr* blk = (bfr*)smem;
  int* cmax = (int*)(smem + 131072);
  if (tid < 64) cmax[tid] = 0;
  __syncthreads();
  {
    const int n4 = tid & 15, kk0 = tid >> 4;
    float m0 = 0.f, m1 = 0.f, m2 = 0.f, m3 = 0.f;
#pragma unroll 4
    for (int ps = 0; ps < 32; ++ps) {
      const int k = ps * 32 + kk0;
      float4 v = make_float4(0.f, 0.f, 0.f, 0.f);
      if (ng * 64 + n4 * 4 < N) v = *(const float4*)(src + (size_t)k * N + ng * 64 + n4 * 4);
      m0 = fmaxf(m0, fabsf(v.x)); m1 = fmaxf(m1, fabsf(v.y)); m2 = fmaxf(m2, fabsf(v.z)); m3 = fmaxf(m3, fabsf(v.w));
      *(bf16x4*)(blk + k * 64 + n4 * 4) = pack4(v.x, v.y, v.z, v.w);
    }
    atomicMax(&cmax[n4 * 4 + 0], __float_as_int(m0)); atomicMax(&cmax[n4 * 4 + 1], __float_as_int(m1));
    atomicMax(&cmax[n4 * 4 + 2], __float_as_int(m2)); atomicMax(&cmax[n4 * 4 + 3], __float_as_int(m3));
  }
  __syncthreads();
  {
    const int nn = tid >> 3, kc = tid & 7;
    const int n = ng * 64 + nn;
    const float am = __int_as_float(cmax[nn]);
    const float sc = am > 0.f ? am * (1.f / 127.f) : 1.f, iv = 1.f / sc;
    const int j = n & 1023;
    const int row = INTERLEAVE ? (j >> 4) * 32 + (j & 15) + ((n >= 1024) ? 16 : 0) : n;
    if (kc == 0) sw[n] = sc;
#pragma unroll 2
    for (int q = 0; q < 8; ++q) {
      const int k0 = (kc + 8 * q) * 16;
      unsigned w[4];
#pragma unroll
      for (int g4 = 0; g4 < 4; ++g4) {
        unsigned acc = 0u;
#pragma unroll
        for (int b = 0; b < 4; ++b) {
          const float v = bf2f((short)blk[(k0 + g4 * 4 + b) * 64 + nn]);
          const int qi = (int)fminf(fmaxf(rintf(v * iv), -127.f), 127.f);
          acc |= ((unsigned)(qi & 0xff)) << (8 * b);
        }
        w[g4] = acc;
      }
      *(uint4*)(dst + (size_t)row * 1024 + k0) = make_uint4(w[0], w[1], w[2], w[3]);
    }
  }
  __syncthreads();
}
__device__ __forceinline__ void phase_convert(PP pp, int l, int part, int bid, int nb, char* smem) {
  float* tile = (float*)smem;
  char* wl = p.ws + OFF_W + (size_t)l * WL_SIZE;
  const int T_IN = 56, T_OUT = 16 * 16, T_GU = 32 * 32, T_DN = 32 * 16 * 16;
  const int t_lo = part == 0 ? 0 : T_IN + T_OUT;
  const int t_hi = part == 0 ? T_IN + T_OUT : T_IN + T_OUT + T_GU + T_DN;
  for (int t = t_lo + bid; t < t_hi; t += nb) {
    if (t < T_IN) {
      convert_i8<PIN, false>(p.w_in + (size_t)l * 1024 * PIN, (signed char*)(wl + WL_IN), (float*)(p.ws + OFF_SWIN) + (size_t)l * PINP, t, smem);
    } else if (t < T_IN + T_OUT) {
      int u = t - T_IN; int kt = u / 16, nt = u % 16;
      convert_tile(p.w_out + (size_t)l * 1024 * 1024, 1024, (bfr*)(wl + WL_OUT), kt, nt, 0, tile);
    } else if (t < T_IN + T_OUT + T_GU) {
      int u = t - T_IN - T_OUT; int e = u / 32, ng = u % 32;
      convert_i8<2048, true>(p.moe_w_gu + ((size_t)l * 32 + e) * 1024 * 2048, (signed char*)(wl + WL_GU) + (size_t)e * 2048 * 1024,
                    (float*)(p.ws + OFF_SW) + ((size_t)l * 32 + e) * 2048, ng, smem);
    } else {
      int u = t - T_IN - T_OUT - T_GU; int e = u / 256; int v = u % 256; int kt = v / 16, nt = v % 16;
      convert_tile(p.moe_w_down + ((size_t)l * 32 + e) * 1024 * 1024, 1024, (bfr*)(wl + WL_DN) + (size_t)e * 1024 * 1024, kt, nt, 0, tile);
    }
  }
}

__device__ __forceinline__ void phase_prenorm(PP pp, int l, int bid, int nb) {
  const int tid = tid_opaque(), lane = tid & 63, wv = wave_id(tid);
  const float* xl = (l == 0) ? p.x : p.out;
  const float* xc = (l == 0) ? p.ctx : (const float*)(p.ws + OFF_CTX);
  const float* mods = (const float*)(p.ws + OFF_MODS) + (size_t)l * 3 * 6144;
  const float* g = p.norm_mix_g + (size_t)l * 1024;
  signed char* H8 = (signed char*)(p.ws + OFF_H);
  float* SCL = (float*)(p.ws + OFF_SCL);
  {
    int* cnt = (int*)(p.ws + OFF_CNT);
    int gt = bid * NTHR + tid;
    if (gt < 32) cnt[gt] = 0;
  }
  for (int m = bid * 8 + wv; m < NTOK; m += nb * 8) {
    const float* xr = (m < NLAT) ? xl + (size_t)m * 1024 : xc + (size_t)(m - NLAT) * 1024;
    const float* md = mods + (size_t)mod_row(m) * 6144;
    float4 v[4];
    float ss = 0.f;
#pragma unroll
    for (int i = 0; i < 4; ++i) {
      v[i] = *(const float4*)(xr + (lane + 64 * i) * 4);
      ss += v[i].x * v[i].x + v[i].y * v[i].y + v[i].z * v[i].z + v[i].w * v[i].w;
    }
    ss = wave_sum(ss);
    float rs = rsqrtf(ss * (1.f / 1024.f) + 1e-6f);
    float4 hq[4];
#pragma unroll
    for (int i = 0; i < 4; ++i) {
      int d = (lane + 64 * i) * 4;
      float4 gg = *(const float4*)(g + d);
      float4 sh = *(const float4*)(md + d);
      float4 sc = *(const float4*)(md + 1024 + d);
      hq[i] = make_float4(v[i].x * rs * gg.x * (1.f + sc.x) + sh.x, v[i].y * rs * gg.y * (1.f + sc.y) + sh.y,
                          v[i].z * rs * gg.z * (1.f + sc.z) + sh.z, v[i].w * rs * gg.w * (1.f + sc.w) + sh.w);
    }
    const float qs = quant_row_store(hq, H8 + (size_t)m * 1024, lane);
    if (lane == 0) SCL[m] = qs;
  }
}

#define LAS __attribute__((address_space(3)))
namespace g8 {
constexpr int BM = 256, BK = 64, HALF = 128, HTB = HALF * BK * 2, STAGE_BYTES = 8 * HTB, KD = 1024;
__device__ __forceinline__ int lds_byte(int r, int c) { const int st = (r >> 4) * 2 + (c >> 5), rr = r & 15, cc = c & 31, ob = rr * 64 + cc * 2; return st * 1024 + (ob ^ (((ob >> 9) & 1) << 5)); }
__device__ __forceinline__ void stage_rc(int b, int& R, int& C) { const int st = b / 1024, sb = b % 1024, swz = sb ^ (((sb >> 9) & 1) << 5); R = (st >> 1) * 16 + swz / 64; C = (st & 1) * 32 + (swz % 64) / 2; }
struct GUnit { int pm, pn, brow0, e; };
__device__ __forceinline__ int unit_index(int i, int c, int G, int total) {
  const int x = c & 7, j = c >> 3, q = total >> 3, r = total & 7;
  const int start = x < r ? x * (q + 1) : r * (q + 1) + (x - r) * q;
  const int size = q + (x < r ? 1 : 0);
  const int li = i * (G >> 3) + j;
  return li < size ? start + li : -1;
}

__device__ __forceinline__ f32x4 mma16(bf16x8 a, bf16x8 b, f32x4 c) { return __builtin_amdgcn_mfma_f32_16x16x32_bf16(a, b, c, 0, 0, 0); }
__device__ __forceinline__ i32x4 mma16(i32x4 a, i32x4 b, i32x4 c) { return __builtin_amdgcn_mfma_i32_16x16x64_i8(a, b, c, 0, 0, 0); }
template <bool I8, class Sched, class Epi>
__device__ __forceinline__ void gemm_stream(LAS unsigned char* lds, const void* Abase, const void* Btbase, const Sched& S, const Epi& E) {
  typedef typename std::conditional<I8, i32x4, f32x4>::type AccT;
  typedef typename std::conditional<I8, i32x4, bf16x8>::type FragT;
  constexpr int KB = I8 ? KD : KD * 2;
  const int tid = tid_opaque(), wid = __builtin_amdgcn_readfirstlane(tid >> 6), lane = tid & 63, wr = wid >> 2, wc = wid & 3, fr = lane & 15, fq = lane >> 4;
  constexpr int nt = KB / 128;
  int R[2], C[2];
  unsigned voffB[2];
#pragma unroll
  for (int i = 0; i < 2; ++i) { stage_rc(tid * 16 + i * 8192, R[i], C[i]); voffB[i] = (unsigned)(R[i] * KB + C[i] * 2); }
#define voffA voffB
  constexpr size_t kstep = (size_t)(BK * 2);
  constexpr size_t hstep = (size_t)HALF * KB;
  const unsigned ldsw = (unsigned)wid * 1024u;
  const int aoff = lds_byte(wr * 64 + fr, fq * 8), boff = lds_byte(wc * 32 + fr, fq * 8);
#define G8_SA(b, h) (((b) * 2 + (h)) * HTB)
#define G8_SB(b, h) ((4 + (b) * 2 + (h)) * HTB)
#define G8_STAGE(bufoff, gbase, v0, v1) do { \
    __builtin_amdgcn_global_load_lds((const unsigned*)((const char*)(gbase) + (v0)), (LAS unsigned*)(lds + (bufoff) + ldsw), 16, 0, 0); \
    __builtin_amdgcn_global_load_lds((const unsigned*)((const char*)(gbase) + (v1)), (LAS unsigned*)(lds + (bufoff) + ldsw + 8192), 16, 0, 0); } while (0)
#define G8_STAGEB(bufoff, gbase) G8_STAGE(bufoff, gbase, voffB[0], voffB[1])
#define G8_STAGEA(bufoff, gbase) G8_STAGE(bufoff, gbase, voffA[0], voffA[1])
#define G8_LDA(dst, b, h) do { _Pragma("unroll") for (int m = 0; m < 4; ++m) _Pragma("unroll") for (int k = 0; k < 2; ++k) dst[m][k] = *(const LAS FragT*)(lds + G8_SA(b, h) + aoff + m * 2048 + k * 1024); } while (0)
#define G8_LDB(dst, b, h) do { _Pragma("unroll") for (int n = 0; n < 2; ++n) _Pragma("unroll") for (int k = 0; k < 2; ++k) dst[n][k] = *(const LAS FragT*)(lds + G8_SB(b, h) + boff + n * 2048 + k * 1024); } while (0)
#define G8_MMA(ai, bj, At, Bt) do { __builtin_amdgcn_s_setprio(1); _Pragma("unroll") for (int m = 0; m < 4; ++m) _Pragma("unroll") for (int n = 0; n < 2; ++n) _Pragma("unroll") for (int k = 0; k < 2; ++k) \
    acc[ai][bj][m][n] = mma16(Bt[n][k], At[m][k], acc[ai][bj][m][n]); __builtin_amdgcn_s_setprio(0); } while (0)
#define G8_WAIT_V(n) asm volatile("s_waitcnt vmcnt(" #n ")" ::: "memory")
#define G8_WAIT_L(n) asm volatile("s_waitcnt lgkmcnt(" #n ")" ::: "memory")
#define G8_BAR __builtin_amdgcn_s_barrier()
#define G8_SCHED __builtin_amdgcn_sched_barrier(0)
  GUnit cur, nxt;
  int ui = 0;
  if (!S.next(0, cur)) return;
  AccT acc[2][2][4][2];
#pragma unroll
  for (int a = 0; a < 2; ++a)
#pragma unroll
    for (int b = 0; b < 2; ++b)
#pragma unroll
      for (int m = 0; m < 4; ++m)
#pragma unroll
        for (int n = 0; n < 2; ++n) acc[a][b][m][n] = AccT{};
  FragT At[4][2], B0[2][2], B1[2][2];
  const char* cA = (const char*)Abase + (size_t)cur.pm * (BM * KB);
  const char* cB = (const char*)Btbase + (size_t)cur.brow0 * KB;
  G8_STAGEB(G8_SB(0, 0), cB); G8_STAGEA(G8_SA(0, 0), cA); G8_STAGEB(G8_SB(0, 1), cB + hstep); G8_STAGEA(G8_SA(0, 1), cA + hstep);
  if (wr == 1) G8_BAR;
  G8_WAIT_V(4); G8_BAR;
  G8_STAGEB(G8_SB(1, 0), cB + kstep); G8_STAGEA(G8_SA(1, 0), cA + kstep); G8_STAGEB(G8_SB(1, 1), cB + hstep + kstep);
  G8_WAIT_V(6); G8_BAR;
  for (;;) {
    const bool has_next = S.next(ui + 1, nxt);
    const char* nA = has_next ? (const char*)Abase + (size_t)nxt.pm * (BM * KB) : cA;
    const char* nB = has_next ? (const char*)Btbase + (size_t)nxt.brow0 * KB : cB;
#pragma unroll 1
    for (int t = 0; t < nt; t += 2) {
      const bool last = (t == nt - 2);
      const char* a1 = cA + (size_t)(t + 1) * kstep;
      const char* a2 = last ? nA : cA + (size_t)(t + 2) * kstep;
      const char* b2 = last ? nB : cB + (size_t)(t + 2) * kstep;
      const char* a3 = a2 + kstep;
      const char* b3 = b2 + kstep;
      G8_LDB(B0, 0, 0); G8_SCHED; G8_LDA(At, 0, 0); G8_STAGEA(G8_SA(1, 1), a1 + hstep);
      G8_WAIT_L(8); G8_BAR; G8_WAIT_L(0); G8_MMA(0, 0, At, B0); G8_BAR; G8_SCHED;
      G8_LDB(B1, 0, 1); G8_STAGEB(G8_SB(0, 0), b2);
      G8_BAR; G8_WAIT_L(0); G8_MMA(0, 1, At, B1); G8_BAR;
      G8_LDA(At, 0, 1); G8_STAGEA(G8_SA(0, 0), a2);
      G8_BAR; G8_WAIT_L(0); G8_MMA(1, 0, At, B0); G8_BAR; G8_SCHED;
      G8_STAGEB(G8_SB(0, 1), b2 + hstep);
      G8_WAIT_V(6); G8_BAR; G8_MMA(1, 1, At, B1); G8_BAR;
      G8_LDB(B0, 1, 0); G8_SCHED; G8_LDA(At, 1, 0); G8_STAGEA(G8_SA(0, 1), a2 + hstep);
      G8_WAIT_L(8); G8_BAR; G8_WAIT_L(0); G8_MMA(0, 0, At, B0); G8_BAR; G8_SCHED;
      G8_LDB(B1, 1, 1); G8_STAGEB(G8_SB(1, 0), b3);
      G8_BAR; G8_WAIT_L(0); G8_MMA(0, 1, At, B1); G8_BAR;
      G8_LDA(At, 1, 1); G8_STAGEA(G8_SA(1, 0), a3);
      G8_BAR; G8_WAIT_L(0); G8_MMA(1, 0, At, B0); G8_BAR; G8_SCHED;
      G8_STAGEB(G8_SB(1, 1), b3 + hstep);
      G8_WAIT_V(6); G8_BAR; G8_MMA(1, 1, At, B1); G8_BAR;
    }
    E(acc, cur, wr, wc, fr, fq);
    if (!has_next) break;
#pragma unroll
    for (int a = 0; a < 2; ++a)
#pragma unroll
      for (int b = 0; b < 2; ++b)
#pragma unroll
        for (int m = 0; m < 4; ++m)
#pragma unroll
          for (int n = 0; n < 2; ++n) acc[a][b][m][n] = AccT{};
    cur = nxt; cA = nA; cB = nB; ++ui;
  }
  G8_WAIT_V(0);
  if (wr == 0) G8_BAR;
  G8_BAR;
#undef G8_SA
#undef G8_SB
#undef G8_STAGE
#undef G8_STAGEB
#undef G8_STAGEA
#undef voffA
#undef G8_LDA
#undef G8_LDB
#undef G8_MMA
#undef G8_WAIT_V
#undef G8_WAIT_L
#undef G8_BAR
#undef G8_SCHED
}

struct DenseSched {
  int nM, nN, G, c;
  __device__ __forceinline__ bool next(int i, GUnit& u) const {
    const int idx = unit_index(i, c, G, nM * nN);
    if (idx < 0) return false;
    u.pm = idx / nN; u.pn = idx - u.pm * nN; u.brow0 = u.pn * BM; u.e = 0;
    return true;
  }
};
struct MoeSched {
  const int* toff; int nN, NE, G, c;
  __device__ __forceinline__ bool next(int i, GUnit& u) const {
    const int idx = unit_index(i, c, G, toff[32] * nN);
    if (idx < 0) return false;
    u.pm = idx / nN; u.pn = idx - u.pm * nN;
    int e = 0;
#pragma unroll 1
    for (int k = 1; k < 32; ++k) e = (u.pm >= toff[k]) ? k : e;
    u.e = e; u.brow0 = e * NE + u.pn * BM;
    return true;
  }
};
}

struct EpiInProj {
  float* P; const float* SCL; const float* sw;
  __device__ __forceinline__ void operator()(const i32x4 (&acc)[2][2][4][2], const g8::GUnit& u, int wr, int wc, int fr, int fq) const {
    const int row0 = u.pm * 256 + wr * 64 + fr, col0 = u.pn * 256 + wc * 32 + 4 * fq;
    f32x4 cs[2][2];
#pragma unroll
    for (int bj = 0; bj < 2; ++bj)
#pragma unroll
      for (int n = 0; n < 2; ++n) cs[bj][n] = *(const f32x4*)(sw + col0 + bj * 128 + n * 16);
#pragma unroll
    for (int ai = 0; ai < 2; ++ai)
#pragma unroll
      for (int m = 0; m < 4; ++m) {
        const int row = row0 + ai * 128 + m * 16;
        const float sa = SCL[row];
        float* rowp = P + (size_t)row * PINP + col0;
#pragma unroll
        for (int bj = 0; bj < 2; ++bj)
#pragma unroll
          for (int n = 0; n < 2; ++n) {
            const i32x4 a = acc[ai][bj][m][n];
            f32x4 o = {(float)a[0], (float)a[1], (float)a[2], (float)a[3]};
            *(f32x4*)(rowp + bj * 128 + n * 16) = o * (cs[bj][n] * sa);
          }
      }
  }
};
__device__ __forceinline__ void phase_gemm_in(PP pp, int l, int bid, int nb, char* smem) {
  g8::DenseSched S{130, 14, nb, bid};
  EpiInProj E{(float*)(p.ws + OFF_P), (const float*)(p.ws + OFF_SCL), (const float*)(p.ws + OFF_SWIN) + (size_t)l * PINP};
  g8::gemm_stream<true>((LAS unsigned char*)smem, p.ws + OFF_H, p.ws + OFF_W + (size_t)l * WL_SIZE + WL_IN, S, E);
}

struct EpiOutProj {
  const float *xl, *xc, *mods; float *ol, *oc;
  __device__ __forceinline__ void operator()(const f32x4 (&acc)[2][2][4][2], const g8::GUnit& u, int wr, int wc, int fr, int fq) const {
    const bool lat = u.pm < 128;
    const float* xin = lat ? xl + (size_t)u.pm * 256 * 1024 : xc + (size_t)(u.pm - 128) * 256 * 1024;
    float* xo = lat ? ol + (size_t)u.pm * 256 * 1024 : oc + (size_t)(u.pm - 128) * 256 * 1024;
    const float* g1 = mods + (size_t)(lat ? (u.pm >> 6) : 2) * 6144 + 2048;
    const int row0 = wr * 64 + fr, col0 = u.pn * 256 + wc * 32 + 4 * fq;
#pragma unroll
    for (int bj = 0; bj < 2; ++bj)
#pragma unroll
      for (int n = 0; n < 2; ++n) {
        const f32x4 gv = *(const f32x4*)(g1 + col0 + bj * 128 + n * 16);
#pragma unroll
        for (int ai = 0; ai < 2; ++ai)
#pragma unroll
          for (int m = 0; m < 4; ++m) {
            const size_t o = (size_t)(row0 + ai * 128 + m * 16) * 1024 + col0 + bj * 128 + n * 16;
            const f32x4 xv = *(const f32x4*)(xin + o);
            *(f32x4*)(xo + o) = xv + gv * acc[ai][bj][m][n];
            if (m & 1) asm volatile("" ::: "memory");
          }
      }
  }
};
__device__ __forceinline__ void phase_gemm_out(PP pp, int l, int bid, int nb, char* smem) {
  g8::DenseSched S{(l == 0) ? 130 : 128, 4, nb, bid};
  EpiOutProj E{(l == 0) ? p.x : p.out, (l == 0) ? p.ctx : (const float*)(p.ws + OFF_CTX),
               (const float*)(p.ws + OFF_MODS) + (size_t)l * 3 * 6144, p.out, (float*)(p.ws + OFF_CTX)};
  g8::gemm_stream<false>((LAS unsigned char*)smem, p.ws + OFF_CC, p.ws + OFF_W + (size_t)l * WL_SIZE + WL_OUT, S, E);
}

#define LBAR() do { asm volatile("s_waitcnt lgkmcnt(0)" ::: "memory"); __builtin_amdgcn_s_barrier(); asm volatile("" ::: "memory"); } while (0)
__device__ __forceinline__ void phase_prep(PP pp, int l, int bid, int nb, char* smem) {
  const int tid = tid_opaque(), lane = tid & 63, wv = wave_id(tid);
  const float* P = (const float*)(p.ws + OFF_P);
  char* S = p.ws + OFF_S;
  bfr* QN = (bfr*)(S + S_QN);
  bfr* KN = (bfr*)(S + S_KN);
  bfr* VT = (bfr*)(S + S_VT);
  float* RWR = (float*)(S + S_RWR);
  float* RWKK = (float*)(S + S_RWKK);
  float* RWV = (float*)(S + S_RWV);
  float* RWG = (float*)(S + S_RWG);
  float* RWW = (float*)(S + S_RWW);
  float* RWKD = (float*)(S + S_RWKD);
  float* RWB = (float*)(S + S_RWB);
  float* BON = (float*)(S + S_BON);
  float* GDQ = (float*)(S + S_GDQ);
  float* GDK = (float*)(S + S_GDK);
  float* GDV = (float*)(S + S_GDV);
  float* GDAB = (float*)(S + S_GDAB);
  const float* mu = p.rw_mu + (size_t)l * 896;
  const float* w0 = p.rw_w0 + (size_t)l * 512;
  const float* w_up = p.rw_w_up + (size_t)l * 2 * 32 * 256;
  const float* a0 = p.rw_a0 + (size_t)l * 512;
  const float* a_up = p.rw_a_up + (size_t)l * 2 * 32 * 256;
  const float* g_up = p.rw_g_up + (size_t)l * 64 * 256;
  const float* k_k = p.rw_k_k + (size_t)l * 256;
  const float* k_a = p.rw_k_a + (size_t)l * 256;
  const float* r_k = p.rw_r_k + (size_t)l * 256;
  const float* conv_w = p.gd_conv_w + (size_t)l * 5 * 768;
  const float* A_log = p.gd_A_log + (size_t)l * 8;
  const float* dt_bias = p.gd_dt_bias + (size_t)l * 8;
  const float* qg = p.na_q_gain + (size_t)l * 64;
  const float* kg = p.na_k_gain + (size_t)l * 64;

  bfr* wl = (bfr*)smem;
  float* lor = (float*)(smem + 192 * 256 * 2);
  __syncthreads();
  for (int i = tid; i < 192 * 256; i += NTHR) {
    const int row = i >> 8, c = i & 255;
    const float v = row < 64 ? g_up[row * 256 + c] : row < 128 ? w_up[(row - 64) * 256 + c] : a_up[(row - 128) * 256 + c];
    wl[i] = f2bf(v);
  }
  __syncthreads();

  for (int tile = bid; tile < NTOK / 16; tile += nb) {
    const int m0 = tile * 16;
    int seq_lo, seq_hi, bb, tau0;
    if (m0 < NLAT) { bb = m0 >> 14; seq_lo = bb << 14; seq_hi = seq_lo + SEQ; tau0 = m0 - seq_lo; }
    else { bb = (m0 - NLAT) >> 8; seq_lo = NLAT + (bb << 8); seq_hi = seq_lo + CTXL; tau0 = SEQ + (m0 - seq_lo); }
    const f32x4 z4 = {0.f, 0.f, 0.f, 0.f};
    int tid_t = tid; asm volatile("" : "+v"(tid_t));
    const int lane_t = tid_t & 63;
    const int cb = lane_t * 4, hh = lane_t >> 4;
    const int lg = tid_t & 31, lt = tid_t >> 5;
    const int sl = lane_t >> 4, sc4 = (lane_t & 15) * 4;
    asm volatile("" ::: "memory");
    const f32x4 mur = *(const f32x4*)(mu + cb), muk = *(const f32x4*)(mu + 256 + cb), muv = *(const f32x4*)(mu + 512 + cb);
    const f32x4 mul = *(const f32x4*)(mu + 768 + lg * 4);

    f32x4 pr[3][4], pl[3];
    {
      const int mt0 = m0 + 2 * wv;
#pragma unroll
      for (int j = 0; j < 3; ++j)
#pragma unroll
        for (int t = 0; t < 4; ++t) {
          const int m = mt0 - 1 + t;
          pr[j][t] = (m >= seq_lo && m < seq_hi) ? *(const f32x4*)(P + (size_t)m * PINP + A_END + j * 256 + cb) : z4;
        }
#pragma unroll
      for (int t = 0; t < 3; ++t) {
        const int m = m0 + lt - 1 + t;
        pl[t] = (m >= seq_lo && m < seq_hi) ? *(const f32x4*)(P + (size_t)m * PINP + A_END + 768 + lg * 4) : z4;
      }
    }
    {
      const f32x4 v = pl[1] + mul * (0.5f * (pl[0] + pl[2]) - pl[1]);
#pragma unroll
      for (int i = 0; i < 4; ++i) {
        const int ch = lg * 4 + i;
        lor[ch * 16 + lt] = ch < 32 ? tanhf(v[i]) : ch < 64 ? v[i] : sigmoidf_(v[i]);
      }
    }
    f32x4 rr[2], rk[2], rv[2];
#pragma unroll
    for (int t = 0; t < 2; ++t) {
      rr[t] = pr[0][t + 1] + mur * (0.5f * (pr[0][t] + pr[0][t + 2]) - pr[0][t + 1]);
      rk[t] = pr[1][t + 1] + muk * (0.5f * (pr[1][t] + pr[1][t + 2]) - pr[1][t + 1]);
      rv[t] = pr[2][t + 1] + muv * (0.5f * (pr[2][t] + pr[2][t + 2]) - pr[2][t + 1]);
    }
    LBAR();
    f32x4 pg[20];
    const bool is_gd = wv < 3, is_na = (wv >= 3 && wv < 7);
    const int sec = is_gd ? wv * 4 + sl : (wv - 3) * 4 + sl;
    if (is_gd) {
#pragma unroll
      for (int t = 0; t < 20; ++t) {
        const int m = m0 - 2 + t;
        pg[t] = (m >= seq_lo && m < seq_hi) ? *(const f32x4*)(P + (size_t)m * PINP + B_END + sec * 64 + sc4) : z4;
      }
    } else if (is_na) {
#pragma unroll
      for (int t = 0; t < 16; ++t) pg[t] = *(const f32x4*)(P + (size_t)(m0 + t) * PINP + sec * 64 + sc4);
#pragma unroll
      for (int t = 16; t < 20; ++t) pg[t] = z4;
    } else {
#pragma unroll
      for (int t = 0; t < 20; ++t) pg[t] = z4;
    }
    asm volatile("" ::: "memory");
    {
      f32x4 gacc[2], wa0[2], wa1[2], aa0[2], aa1[2];
#pragma unroll
      for (int t = 0; t < 2; ++t) { gacc[t] = z4; wa0[t] = z4; wa1[t] = z4; aa0[t] = z4; aa1[t] = z4; }
#pragma unroll 4
      for (int j = 0; j < 64; ++j) {
        const bf16x4 wq = *(const bf16x4*)(wl + j * 256 + cb);
        const f32x4 wgt = {bf2f(wq[0]), bf2f(wq[1]), bf2f(wq[2]), bf2f(wq[3])};
        const float2 sv = *(const float2*)(lor + (64 + j) * 16 + 2 * wv);
        gacc[0] += wgt * sv.x; gacc[1] += wgt * sv.y;
      }
#pragma unroll 2
      for (int j = 0; j < 32; ++j) {
        const bf16x4 q0 = *(const bf16x4*)(wl + (64 + j) * 256 + cb), q1 = *(const bf16x4*)(wl + (96 + j) * 256 + cb);
        const bf16x4 q2 = *(const bf16x4*)(wl + (128 + j) * 256 + cb), q3 = *(const bf16x4*)(wl + (160 + j) * 256 + cb);
        const f32x4 ww0 = {bf2f(q0[0]), bf2f(q0[1]), bf2f(q0[2]), bf2f(q0[3])}, ww1 = {bf2f(q1[0]), bf2f(q1[1]), bf2f(q1[2]), bf2f(q1[3])};
        const f32x4 aw0 = {bf2f(q2[0]), bf2f(q2[1]), bf2f(q2[2]), bf2f(q2[3])}, aw1 = {bf2f(q3[0]), bf2f(q3[1]), bf2f(q3[2]), bf2f(q3[3])};
        const float2 tv = *(const float2*)(lor + j * 16 + 2 * wv);
        const float2 dv = *(const float2*)(lor + (32 + j) * 16 + 2 * wv);
        wa0[0] += ww0 * tv.x; wa0[1] += ww0 * tv.y; wa1[0] += ww1 * tv.x; wa1[1] += ww1 * tv.y;
        aa0[0] += aw0 * dv.x; aa0[1] += aw0 * dv.y; aa1[0] += aw1 * dv.x; aa1[1] += aw1 * dv.y;
      }
      asm volatile("" ::: "memory");
      const f32x4 kkc = *(const f32x4*)(k_k + cb), kac = *(const f32x4*)(k_a + cb), rkc = *(const f32x4*)(r_k + cb);
      const f32x4 w00 = *(const f32x4*)(w0 + cb), w01 = *(const f32x4*)(w0 + 256 + cb), a00 = *(const f32x4*)(a0 + cb), a01 = *(const f32x4*)(a0 + 256 + cb);
#pragma unroll
      for (int t = 0; t < 2; ++t) {
        const int m = m0 + 2 * wv + t;
        const f32x4 r = rr[t], k = rk[t], v = rv[t];
        const f32x4 kkraw = k * kkc;
        const float ssum = row16_sum((kkraw[0] * kkraw[0] + kkraw[1] * kkraw[1]) + (kkraw[2] * kkraw[2] + kkraw[3] * kkraw[3]));
        const f32x4 kk = kkraw * rsqrtf(ssum + 1e-6f);
        float bon = 0.f;
#pragma unroll
        for (int d = 0; d < 2; ++d) {
          const f32x4 wlin = d == 0 ? w00 + wa0[t] : w01 + wa1[t];
          const f32x4 alin = d == 0 ? a00 + aa0[t] : a01 + aa1[t];
          f32x4 lw, kd, bv;
#pragma unroll
          for (int i = 0; i < 4; ++i) {
            const float w_log = -softplusf_(-wlin[i]) - 0.5f;
            const float a = sigmoidf_(alin[i]);
            lw[i] = -__expf(w_log);
            kd[i] = k[i] * (1.f + (a - 1.f) * kac[i]);
            bv[i] = kk[i] * a;
            bon += r[i] * kd[i] * rkc[i];
          }
          const size_t o = ((size_t)d * NTOK + m) * 256 + cb;
          *(f32x4*)(RWW + o) = lw; *(f32x4*)(RWKD + o) = kd; *(f32x4*)(RWB + o) = bv;
        }
        bon = row16_sum(bon);
        const size_t o = (size_t)m * 256 + cb;
        *(f32x4*)(RWR + o) = r; *(f32x4*)(RWKK + o) = kk; *(f32x4*)(RWV + o) = v; *(f32x4*)(RWG + o) = gacc[t];
        if ((lane_t & 15) == 0) BON[(size_t)m * 4 + hh] = bon;
      }
    }
    if (is_gd) {
      f32x4 cw[5];
#pragma unroll
      for (int j = 0; j < 5; ++j) cw[j] = *(const f32x4*)(conv_w + j * 768 + sec * 64 + sc4);
#pragma unroll
      for (int t = 0; t < 16; ++t) {
        f32x4 acc = z4;
#pragma unroll
        for (int j = 0; j < 5; ++j) acc += cw[j] * pg[t + j];
        f32x4 val = {siluf_(acc[0]), siluf_(acc[1]), siluf_(acc[2]), siluf_(acc[3])};
        const int m = m0 + t;
        if (sec < 8) {
          const float ss = row16_sum((val[0] * val[0] + val[1] * val[1]) + (val[2] * val[2] + val[3] * val[3]));
          val = val * rsqrtf(ss + 1e-6f);
          if (sec < 4) *(f32x4*)(GDQ + (size_t)m * 256 + sec * 64 + sc4) = val * 0.125f;
          else *(f32x4*)(GDK + (size_t)m * 256 + (sec - 4) * 64 + sc4) = val;
        } else *(f32x4*)(GDV + (size_t)m * 256 + (sec - 8) * 64 + sc4) = val;
      }
    } else if (is_na) {
      const f32x4 gq = *(const f32x4*)(qg + sc4) * (0.125f * 1.4426950408889634f), gk = *(const f32x4*)(kg + sc4);
#pragma unroll
      for (int t = 0; t < 16; ++t) {
        f32x4 val = pg[t];
        const float ss = row16_sum((val[0] * val[0] + val[1] * val[1]) + (val[2] * val[2] + val[3] * val[3]));
        val = val * rsqrtf(ss * (1.f / 64.f) + 1e-6f);
        const int m = m0 + t;
        if (sec < 8) { const f32x4 o = val * gq; *(bf16x4*)(QN + (size_t)m * 512 + sec * 64 + sc4) = pack4(o[0], o[1], o[2], o[3]); }
        else { const f32x4 o = val * gk; *(bf16x4*)(KN + (size_t)m * 512 + (sec - 8) * 64 + sc4) = pack4(o[0], o[1], o[2], o[3]); }
      }
    }
    if (tid_t < 256) {
      const int t = tid_t >> 4, j = tid_t & 15;
      const int m = m0 + t;
      const float pv = P[(size_t)m * PINP + B_END + 1024 + j];
      float o;
      if (j < 8) o = -__expf(A_log[j]) * softplusf_(pv + dt_bias[j]);
      else o = sigmoidf_(pv);
      GDAB[(size_t)m * 16 + j] = o;
    }
    {
      const int vc = (tid_t & 127) * 4, tq = (tid_t >> 7) * 4;
      f32x4 pv[4];
#pragma unroll
      for (int t = 0; t < 4; ++t) pv[t] = *(const f32x4*)(P + (size_t)(m0 + tq + t) * PINP + 1024 + vc);
#pragma unroll
      for (int i = 0; i < 4; ++i) {
        const int hd = vc + i;
        bfr* dst = VT + ((size_t)(bb * 8 + (hd >> 6)) * (TTOK / 16) + (tau0 >> 4)) * 1024 + (hd & 63) * 16 + tq;
        *(bf16x4*)dst = pack4(pv[0][i], pv[1][i], pv[2][i], pv[3][i]);
      }
    }
    LBAR();
  }
  __syncthreads();
}

__device__ __forceinline__ int scan_tok(int b, int d, int s) {
  if (s < CTXL) { int t = d ? (CTXL - 1 - s) : s; return NLAT + b * CTXL + t; }
  int u = s - CTXL; int t = d ? (SEQ - 1 - u) : u; return b * SEQ + t;
}
#define CS 72
#define SLOT_BYTES (64 * CS * 2)
#define F0_STRIDE 68
#define X1_F0 (13 * SLOT_BYTES)
#define X1_ARR (X1_F0 + 64 * F0_STRIDE * 4)

#define MM_FRAGS(As, Bs, a0, a1, b00, b01, b10, b11)                                                     \
  const bf16x8 a0 = *(const bf16x8*)((As) + ((mt * 16 + fr) * CS + fq * 8) * 2);                         \
  const bf16x8 a1 = *(const bf16x8*)((As) + ((mt * 16 + fr) * CS + 32 + fq * 8) * 2);                    \
  const bf16x8 b00 = *(const bf16x8*)((Bs) + ((nt0 * 16 + fr) * CS + fq * 8) * 2);                       \
  const bf16x8 b01 = *(const bf16x8*)((Bs) + ((nt0 * 16 + fr) * CS + 32 + fq * 8) * 2);                  \
  const bf16x8 b10 = *(const bf16x8*)((Bs) + ((nt0 * 16 + 16 + fr) * CS + fq * 8) * 2);                  \
  const bf16x8 b11 = *(const bf16x8*)((Bs) + ((nt0 * 16 + 16 + fr) * CS + 32 + fq * 8) * 2);
#define MM_2TILES(acc0, acc1, a0, a1, b00, b01, b10, b11)                                                \
  acc0 = __builtin_amdgcn_mfma_f32_16x16x32_bf16(a0, b00, acc0, 0, 0, 0);                                \
  acc0 = __builtin_amdgcn_mfma_f32_16x16x32_bf16(a1, b01, acc0, 0, 0, 0);                                \
  acc1 = __builtin_amdgcn_mfma_f32_16x16x32_bf16(a0, b10, acc1, 0, 0, 0);                                \
  acc1 = __builtin_amdgcn_mfma_f32_16x16x32_bf16(a1, b11, acc1, 0, 0, 0);
__device__ __forceinline__ void wr_T(char* slot, int mt, int nt, int fr, int fq, f32x4 v) {
  *(bf16x4*)(slot + ((nt * 16 + fr) * CS + mt * 16 + 4 * fq) * 2) = pack4(v[0], v[1], v[2], v[3]);
}

struct ChunkIn { float lw[8], f0[8], f1[8], f2[8], f3[8], xv[8], be[8]; };
template <bool GDN>
__device__ __forceinline__ void chunk_load(PP pp, int t, ChunkIn& ci) {
  const int tid = tid_opaque(), c = tid & 63, tg = wave_id(tid);
  const int chain = t / NCHUNK, n = t - chain * NCHUNK;
  const int d = chain & 1, h = (chain >> 1) & 3, b = (chain >> 3) & 1;
  const char* S = p.ws + OFF_S;
#pragma unroll
  for (int u = 0; u < 8; ++u) {
    const int m = scan_tok(b, d, n * 64 + tg * 8 + u);
    const size_t o = (size_t)m * 256 + h * 64 + c;
    if (!GDN) {
      ci.lw[u] = ((const float*)(S + S_RWW))[(size_t)d * NTOK * 256 + o];
      ci.f0[u] = ((const float*)(S + S_RWKK))[o];
      ci.f1[u] = ((const float*)(S + S_RWB))[(size_t)d * NTOK * 256 + o];
      ci.f2[u] = ((const float*)(S + S_RWKD))[(size_t)d * NTOK * 256 + o];
      ci.f3[u] = ((const float*)(S + S_RWR))[o];
      ci.xv[u] = ((const float*)(S + S_RWV))[o];
      ci.be[u] = 1.f;
    } else {
      ci.lw[u] = ((const float*)(S + S_GDAB))[(size_t)m * 16 + d * 4 + h];
      ci.be[u] = ((const float*)(S + S_GDAB))[(size_t)m * 16 + 8 + d * 4 + h];
      ci.f0[u] = ((const float*)(S + S_GDK))[o];
      ci.f3[u] = ((const float*)(S + S_GDQ))[o];
      ci.xv[u] = ((const float*)(S + S_GDV))[o];
      ci.f1[u] = 0.f; ci.f2[u] = 0.f;
    }
  }
}
template <bool GDN>
__device__ __forceinline__ void chunk_prep_task(PP pp, int t, int t_next, bool has_next, const ChunkIn& ci, ChunkIn& nx, char* smem) {
  const int chain = t / NCHUNK, n = t - chain * NCHUNK;
  const int d = chain & 1, h = (chain >> 1) & 3, b = (chain >> 3) & 1;
  (void)b; (void)d; (void)h;
  const int tid = tid_opaque(), lane = tid & 63, wv = wave_id(tid);
  const int fr = lane & 15, fq = lane >> 4, mt = wv >> 1, nt0 = (wv & 1) * 2;
  char* S = p.ws + OFF_S;
  char* CH = p.ws + OFF_CH;
  const size_t cc = (size_t)chain * NCHUNK + n;
  char* const p0 = smem;
  char* const p1 = smem + 1 * SLOT_BYTES;
  char* const p2 = smem + 2 * SLOT_BYTES;
  char* const p3 = smem + 3 * SLOT_BYTES;
  char* const p4 = smem + 4 * SLOT_BYTES;
  char* const p5 = smem + 5 * SLOT_BYTES;
  char* const p6 = smem + 6 * SLOT_BYTES;
  char* const p7 = smem + 7 * SLOT_BYTES;
  char* const p8 = smem + 8 * SLOT_BYTES;
  char* const p9 = smem + 9 * SLOT_BYTES;
  char* const p10 = smem + 10 * SLOT_BYTES;
  char* const p11 = smem + 11 * SLOT_BYTES;
  char* const p12 = smem + 12 * SLOT_BYTES;
  float* const F0 = (float*)(smem + X1_F0);
  float* const Lv = (float*)(smem + X1_ARR);
  float* const Lm1v = Lv + 64;
  float* const betav = Lv + 128;
  float* const eLv = Lv + 192;
  float* const gC = Lv + 256;
  float* const gsum = Lv + 320;
  char* const sKt = p0;
  char* const sBh = GDN ? p0 : p1;
  char* const sKh = GDN ? p0 : p2;

  {
    const int c = lane, tg = wv;
    const float* lw = ci.lw; const float* f0 = ci.f0; const float* f1 = ci.f1; const float* f2 = ci.f2; const float* f3 = ci.f3; const float* xv = ci.xv; const float* be = ci.be;
    float cum[8];
    cum[0] = lw[0];
#pragma unroll
    for (int u = 1; u < 8; ++u) cum[u] = cum[u - 1] + lw[u];
    gsum[tg * 64 + c] = cum[7];
    LBAR();
    float off = 0.f, LC = 0.f;
#pragma unroll
    for (int g2 = 0; g2 < 8; ++g2) { const float gs = gsum[g2 * 64 + c]; LC += gs; off += (g2 < tg) ? gs : 0.f; }
    bf16x8 vKtT, vBbT, vKbT, vXT;
#pragma unroll
    for (int u = 0; u < 8; ++u) {
      const int t = tg * 8 + u;
      const float L = off + cum[u], Lm1 = L - lw[u];
      if (!GDN) {
        const float eLm1 = __expf(Lm1), enL = __expf(-L), eL = __expf(L), eCL = __expf(LC - L);
        const float kt = f0[u] * eLm1;
        *(bfr*)(p0 + (t * CS + c) * 2) = f2bf(kt);
        *(bfr*)(p1 + (t * CS + c) * 2) = f2bf(f1[u] * enL);
        *(bfr*)(p2 + (t * CS + c) * 2) = f2bf(f2[u] * enL);
        *(bfr*)(p3 + (t * CS + c) * 2) = f2bf(f3[u] * eL);
        vKtT[u] = (short)f2bf(kt);
        vBbT[u] = (short)f2bf(f1[u] * eCL);
        vKbT[u] = (short)f2bf(f2[u] * eCL);
        vXT[u] = (short)f2bf(xv[u]);
      } else {
        *(bfr*)(p0 + (t * CS + c) * 2) = f2bf(f0[u]);
        *(bfr*)(p3 + (t * CS + c) * 2) = f2bf(f3[u]);
        vKtT[u] = (short)f2bf(f0[u] * __expf(Lm1));
        vBbT[u] = (short)f2bf(be[u] * f0[u] * __expf(LC - Lm1));
        vKbT[u] = (short)f2bf(f0[u] * __expf(LC - L));
        vXT[u] = (short)f2bf(be[u] * xv[u]);
        if (c == 0) { Lv[t] = L; Lm1v[t] = Lm1; betav[t] = be[u]; eLv[t] = __expf(L); }
      }
    }
    *(bf16x8*)(p4 + (c * CS + tg * 8) * 2) = vKtT;
    *(bf16x8*)(p5 + (c * CS + tg * 8) * 2) = vBbT;
    *(bf16x8*)(p6 + (c * CS + tg * 8) * 2) = vKbT;
    *(bf16x8*)(p7 + (c * CS + tg * 8) * 2) = vXT;
    if (tg == 0) gC[c] = __expf(LC);
    if (!GDN && tid < 64) { Lv[tid] = 0.f; Lm1v[tid] = 0.f; betav[tid] = 1.f; eLv[tid] = 1.f; }
  }
  LBAR();
  if (has_next) chunk_load<GDN>(pp, t_next, nx);
  {
    {
      MM_FRAGS(sKt, sBh, a0, a1, b00, b01, b10, b11)
      f32x4 c0 = {0.f, 0.f, 0.f, 0.f}, c1 = c0;
      MM_2TILES(c0, c1, a0, a1, b00, b01, b10, b11)
#pragma unroll
      for (int q = 0; q < 2; ++q) {
        const int sI = (nt0 + q) * 16 + fr;
        const f32x4 cv = q ? c1 : c0;
        f32x4 o;
#pragma unroll
        for (int r = 0; r < 4; ++r) {
          const int tI = mt * 16 + 4 * fq + r;
          float v = cv[r];
          if (GDN) v *= betav[sI] * __expf(fminf(Lm1v[tI] - Lm1v[sI], 0.f));
          o[r] = (sI < tI) ? v : 0.f;
        }
        *(f32x4*)(F0 + sI * F0_STRIDE + mt * 16 + 4 * fq) = o;
        wr_T(p11, mt, nt0 + q, fr, fq, o);
      }
    }
    {
      MM_FRAGS(sKt, sKh, a0, a1, b00, b01, b10, b11)
      f32x4 c0 = {0.f, 0.f, 0.f, 0.f}, c1 = c0;
      MM_2TILES(c0, c1, a0, a1, b00, b01, b10, b11)
#pragma unroll
      for (int q = 0; q < 2; ++q) {
        const int sI = (nt0 + q) * 16 + fr;
        const f32x4 cv = q ? c1 : c0;
        f32x4 o;
#pragma unroll
        for (int r = 0; r < 4; ++r) {
          const int tI = mt * 16 + 4 * fq + r;
          float v = cv[r];
          if (GDN) v *= __expf(fminf(Lm1v[tI] - Lv[sI], 0.f));
          o[r] = (sI < tI) ? v : 0.f;
        }
        wr_T(p9, mt, nt0 + q, fr, fq, o);
      }
    }
    {
      MM_FRAGS(sBh, p3, a0, a1, b00, b01, b10, b11)
      f32x4 c0 = {0.f, 0.f, 0.f, 0.f}, c1 = c0;
      MM_2TILES(c0, c1, a0, a1, b00, b01, b10, b11)
#pragma unroll
      for (int q = 0; q < 2; ++q) {
        const int tI = (nt0 + q) * 16 + fr;
        const f32x4 cv = q ? c1 : c0;
        f32x4 o;
#pragma unroll
        for (int r = 0; r < 4; ++r) {
          const int sI = mt * 16 + 4 * fq + r;
          float v = cv[r];
          if (GDN) v *= betav[sI] * __expf(fminf(Lv[tI] - Lm1v[sI], 0.f));
          o[r] = (sI <= tI) ? v : 0.f;
        }
        wr_T(p10, mt, nt0 + q, fr, fq, o);
      }
    }
  }
  LBAR();
  if (wv < 2) {
    const int base = wv * 32, other = 32 - base, c = lane & 31;
    float tr[32];
#pragma unroll
    for (int j = 0; j < 32; ++j) tr[j] = 0.f;
#pragma unroll
    for (int i = 31; i >= 0; --i) {
      float a0 = (c == i) ? 1.f : 0.f, a1 = 0.f, a2 = 0.f, a3 = 0.f;
#pragma unroll
      for (int jb = ((i + 1) & ~3); jb < 32; jb += 4) {
        const f32x4 a4 = *(const f32x4*)(F0 + (base + i) * F0_STRIDE + base + jb);
        a0 -= a4[0] * tr[jb]; a1 -= a4[1] * tr[jb + 1]; a2 -= a4[2] * tr[jb + 2]; a3 -= a4[3] * tr[jb + 3];
      }
      const float acc = (a0 + a1) + (a2 + a3);
      tr[i] = acc;
      if (lane < 32) {
        *(bfr*)(p8 + ((base + i) * CS + base + c) * 2) = f2bf(acc);
        *(bfr*)(p8 + ((base + i) * CS + other + c) * 2) = (bfr)0;
      }
    }
    if (lane < 32) {
#pragma unroll
      for (int q = 0; q < 4; ++q) {
        bf16x8 o, z;
#pragma unroll
        for (int j = 0; j < 8; ++j) { o[j] = (short)f2bf(tr[8 * q + j]); z[j] = 0; }
        *(bf16x8*)(p12 + ((base + c) * CS + base + 8 * q) * 2) = o;
        *(bf16x8*)(p12 + ((base + c) * CS + other + 8 * q) * 2) = z;
      }
    }
  }
  LBAR();
  {
    MM_FRAGS(p11, p12, a0, a1, b00, b01, b10, b11)
    f32x4 c0 = {0.f, 0.f, 0.f, 0.f}, c1 = c0;
    MM_2TILES(c0, c1, a0, a1, b00, b01, b10, b11)
    wr_T(p1, mt, nt0, fr, fq, c0);
    wr_T(p1, mt, nt0 + 1, fr, fq, c1);
  }
  LBAR();
  if (mt < 2 && nt0 == 2) {
    MM_FRAGS(p8, p1, a0, a1, b00, b01, b10, b11)
    f32x4 c0 = {0.f, 0.f, 0.f, 0.f}, c1 = c0;
    MM_2TILES(c0, c1, a0, a1, b00, b01, b10, b11)
#pragma unroll
    for (int r = 0; r < 4; ++r) {
      *(bfr*)(p8 + ((mt * 16 + 4 * fq + r) * CS + (nt0) * 16 + fr) * 2) = f2bf(-c0[r]);
      *(bfr*)(p8 + ((mt * 16 + 4 * fq + r) * CS + (nt0 + 1) * 16 + fr) * 2) = f2bf(-c1[r]);
    }
  }
  LBAR();
  {
    {
      MM_FRAGS(p8, p5, a0, a1, b00, b01, b10, b11)
      f32x4 c0 = {0.f, 0.f, 0.f, 0.f}, c1 = c0;
      MM_2TILES(c0, c1, a0, a1, b00, b01, b10, b11)
      wr_T(p11, mt, nt0, fr, fq, -c0);
      wr_T(p11, mt, nt0 + 1, fr, fq, -c1);
    }
    {
      MM_FRAGS(p8, p10, a0, a1, b00, b01, b10, b11)
      f32x4 c0 = {0.f, 0.f, 0.f, 0.f}, c1 = c0;
      MM_2TILES(c0, c1, a0, a1, b00, b01, b10, b11)
      wr_T(p12, mt, nt0, fr, fq, -c0);
      wr_T(p12, mt, nt0 + 1, fr, fq, -c1);
    }
  }
  LBAR();
  {
    {
      MM_FRAGS(p4, p11, a0, a1, b00, b01, b10, b11)
      f32x4 c0 = {0.f, 0.f, 0.f, 0.f}, c1 = c0;
      MM_2TILES(c0, c1, a0, a1, b00, b01, b10, b11)
#pragma unroll
      for (int q = 0; q < 2; ++q) {
        const int cp = (nt0 + q) * 16 + fr;
        f32x4 cv = q ? c1 : c0;
#pragma unroll
        for (int r = 0; r < 4; ++r) { const int cI = mt * 16 + 4 * fq + r; if (cI == cp) cv[r] += gC[cI]; }
        wr_T(p10, mt, nt0 + q, fr, fq, cv);
      }
    }
    {
      MM_FRAGS(p9, p11, a0, a1, b00, b01, b10, b11)
      f32x4 c0 = {0.f, 0.f, 0.f, 0.f}, c1 = c0;
      MM_2TILES(c0, c1, a0, a1, b00, b01, b10, b11)
#pragma unroll
      for (int q = 0; q < 2; ++q) {
        const int cp = (nt0 + q) * 16 + fr;
        f32x4 cv = q ? c1 : c0;
        const bf16x4 kb = *(const bf16x4*)(p6 + (cp * CS + mt * 16 + 4 * fq) * 2);
#pragma unroll
        for (int r = 0; r < 4; ++r) cv[r] += __uint_as_float(((unsigned)(unsigned short)kb[r]) << 16);
        wr_T(p8, mt, nt0 + q, fr, fq, cv);
      }
    }
    {
      MM_FRAGS(p4, p12, a0, a1, b00, b01, b10, b11)
      f32x4 c0 = {0.f, 0.f, 0.f, 0.f}, c1 = c0;
      MM_2TILES(c0, c1, a0, a1, b00, b01, b10, b11)
#pragma unroll
      for (int q = 0; q < 2; ++q) {
        const int tI = (nt0 + q) * 16 + fr;
        f32x4 cv = q ? c1 : c0;
        const bf16x4 rt = *(const bf16x4*)(p3 + (tI * CS + mt * 16 + 4 * fq) * 2);
        const float el = eLv[tI];
#pragma unroll
        for (int r = 0; r < 4; ++r) cv[r] += __uint_as_float(((unsigned)(unsigned short)rt[r]) << 16) * el;
        wr_T(p1, mt, nt0 + q, fr, fq, cv);
      }
    }
    {
      f32x4 c0 = {0.f, 0.f, 0.f, 0.f}, c1 = c0;
      {
        MM_FRAGS(sKh, p3, a0, a1, b00, b01, b10, b11)
        MM_2TILES(c0, c1, a0, a1, b00, b01, b10, b11)
      }
#pragma unroll
      for (int q = 0; q < 2; ++q) {
        const int tI = (nt0 + q) * 16 + fr;
#pragma unroll
        for (int r = 0; r < 4; ++r) {
          const int sI = mt * 16 + 4 * fq + r;
          float v = q ? c1[r] : c0[r];
          if (GDN) v *= __expf(fminf(Lv[tI] - Lv[sI], 0.f));
          v = (sI <= tI) ? v : 0.f;
          if (q) c1[r] = v; else c0[r] = v;
        }
      }
      {
        MM_FRAGS(p9, p12, a0, a1, b00, b01, b10, b11)
        MM_2TILES(c0, c1, a0, a1, b00, b01, b10, b11)
      }
      wr_T(p5, mt, nt0, fr, fq, c0);
      wr_T(p5, mt, nt0 + 1, fr, fq, c1);
    }
  }
  LBAR();
  {
    {
      MM_FRAGS(p8, p7, a0, a1, b00, b01, b10, b11)
      f32x4 c0 = {0.f, 0.f, 0.f, 0.f}, c1 = c0;
      MM_2TILES(c0, c1, a0, a1, b00, b01, b10, b11)
      bfr* QT = (bfr*)(CH + cc * CH_REC + CH_QT);
      *(bf16x4*)(QT + ((mt * 4 + nt0) * 64 + lane) * 4) = pack4(c0[0], c0[1], c0[2], c0[3]);
      *(bf16x4*)(QT + ((mt * 4 + nt0 + 1) * 64 + lane) * 4) = pack4(c1[0], c1[1], c1[2], c1[3]);
    }
    {
      MM_FRAGS(p7, p5, a0, a1, b00, b01, b10, b11)
      f32x4 c0 = {0.f, 0.f, 0.f, 0.f}, c1 = c0;
      MM_2TILES(c0, c1, a0, a1, b00, b01, b10, b11)
      bfr* YX = (bfr*)(CH + cc * CH_REC + CH_YX);
      *(bf16x4*)(YX + ((mt * 4 + nt0) * 64 + lane) * 4) = pack4(c0[0], c0[1], c0[2], c0[3]);
      *(bf16x4*)(YX + ((mt * 4 + nt0 + 1) * 64 + lane) * 4) = pack4(c1[0], c1[1], c1[2], c1[3]);
    }
    {
      const int fm = wv >> 1, fa = wv & 1;
      const int row = fm * 16 + fr;
      {
        const bf16x4 lo = *(const bf16x4*)(p10 + (row * CS + 32 * fa + 4 * fq) * 2);
        const bf16x4 hi = *(const bf16x4*)(p10 + (row * CS + 32 * fa + 16 + 4 * fq) * 2);
        bf16x8 f; f[0] = lo[0]; f[1] = lo[1]; f[2] = lo[2]; f[3] = lo[3]; f[4] = hi[0]; f[5] = hi[1]; f[6] = hi[2]; f[7] = hi[3];
        *(bf16x8*)(CH + cc * CH_REC + CH_PT + (size_t)((fm * 2 + fa) * 64 + lane) * 16) = f;
      }
      {
        const bf16x4 lo = *(const bf16x4*)(p1 + (row * CS + 32 * fa + 4 * fq) * 2);
        const bf16x4 hi = *(const bf16x4*)(p1 + (row * CS + 32 * fa + 16 + 4 * fq) * 2);
        bf16x8 f; f[0] = lo[0]; f[1] = lo[1]; f[2] = lo[2]; f[3] = lo[3]; f[4] = hi[0]; f[5] = hi[1]; f[6] = hi[2]; f[7] = hi[3];
        *(bf16x8*)(CH + cc * CH_REC + CH_RYT + (size_t)((fm * 2 + fa) * 64 + lane) * 16) = f;
      }
    }
  }
  LBAR();
}

template <bool GDN>
__device__ __forceinline__ void chunk_prep_loop(PP pp, int t0, int tend, int nb, char* smem) {
  ChunkIn cur, nxt;
  if (t0 < tend) chunk_load<GDN>(pp, t0, cur);
  for (int t = t0; t < tend; t += nb) {
    const bool has_next = (t + nb) < tend;
    chunk_prep_task<GDN>(pp, t, t + nb, has_next, cur, nxt, smem);
    cur = nxt;
  }
}
__device__ __forceinline__ void phase_chunk_prep(PP pp, int bid, int nb, char* smem) {
  __syncthreads();
  const int half = (NCHAIN / 2) * NCHUNK;
  chunk_prep_loop<false>(pp, bid, half, nb, smem);
  const int k0 = (half - bid + nb - 1) / nb;
  chunk_prep_loop<true>(pp, bid + k0 * nb, NCHAIN * NCHUNK, nb, smem);
  __syncthreads();
}

#define X2_BUF 32768
#define X2_BAR() do { asm volatile("s_waitcnt lgkmcnt(0)" ::: "memory"); __builtin_amdgcn_s_barrier(); asm volatile("" ::: "memory"); } while (0)
__device__ __forceinline__ void chunk_seq_chain(PP pp, int chain, char* smem) {
  __syncthreads();
  const int tid = tid_opaque(), lane = tid & 63, wv = wave_id(tid);
  const int d = chain & 1, h = (chain >> 1) & 3, b = (chain >> 3) & 1, ty = chain >> 4;
  const char* CH = p.ws + OFF_CH;
  float* Y = (float*)(p.ws + OFF_S + (ty ? S_YGD : S_YRW)) + (size_t)d * NTOK * 256;
  const size_t c0 = (size_t)chain * NCHUNK;
  if (wv >= 4) {
    const int lw = wv - 4;
    const char* src0 = CH + c0 * CH_REC + (size_t)lane * 16;
#define X2_DMA(n) { const char* s_ = src0 + (size_t)(n) * CH_REC; LAS unsigned char* d_ = (LAS unsigned char*)smem + ((n) & 3) * X2_BUF;       \
      _Pragma("unroll") for (int i = 0; i < 8; ++i) {                                                                                       \
        const int piece = i * 4 + lw;                                                                                                       \
        __builtin_amdgcn_global_load_lds((const unsigned*)(s_ + piece * 1024), (LAS unsigned*)(d_ + piece * 1024), 16, 0, 0); } }
    X2_DMA(0) X2_DMA(1) X2_DMA(2)
    asm volatile("s_waitcnt vmcnt(16)" ::: "memory");
    X2_BAR();
    for (int n = 0; n < NCHUNK; ++n) {
      if (n + 3 < NCHUNK) { X2_DMA(n + 3) asm volatile("s_waitcnt vmcnt(16)" ::: "memory"); }
      else if (n + 2 < NCHUNK) asm volatile("s_waitcnt vmcnt(8)" ::: "memory");
      else asm volatile("s_waitcnt vmcnt(0)" ::: "memory");
      X2_BAR();
    }
#undef X2_DMA
  } else {
    const int vt = wv, fr = lane & 15, fq = lane >> 4;
    f32x4 Sacc[4];
#pragma unroll
    for (int i = 0; i < 4; ++i) Sacc[i] = (f32x4){0.f, 0.f, 0.f, 0.f};
    X2_BAR();
    for (int n = 0; n < NCHUNK; ++n) {
      const char* buf = smem + (n & 3) * X2_BUF;
      bf16x8 sB0, sB1;
#pragma unroll
      for (int j = 0; j < 4; ++j) {
        sB0[j] = (short)f2bf(Sacc[0][j]); sB0[4 + j] = (short)f2bf(Sacc[1][j]);
        sB1[j] = (short)f2bf(Sacc[2][j]); sB1[4 + j] = (short)f2bf(Sacc[3][j]);
      }
#pragma unroll
      for (int m = 0; m < 4; ++m) {
        const bf16x8 pa0 = *(const bf16x8*)(buf + ((m * 2 + 0) * 64 + lane) * 16);
        const bf16x8 pa1 = *(const bf16x8*)(buf + ((m * 2 + 1) * 64 + lane) * 16);
        const bf16x8 ra0 = *(const bf16x8*)(buf + 8192 + ((m * 2 + 0) * 64 + lane) * 16);
        const bf16x8 ra1 = *(const bf16x8*)(buf + 8192 + ((m * 2 + 1) * 64 + lane) * 16);
        const bf16x4 qb = *(const bf16x4*)(buf + 16384 + ((m * 4 + vt) * 64 + lane) * 8);
        const bf16x4 yb = *(const bf16x4*)(buf + 24576 + ((vt * 4 + m) * 64 + lane) * 8);
        f32x4 y = {bf2f(yb[0]), bf2f(yb[1]), bf2f(yb[2]), bf2f(yb[3])};
        y = __builtin_amdgcn_mfma_f32_16x16x32_bf16(sB0, ra0, y, 0, 0, 0);
        y = __builtin_amdgcn_mfma_f32_16x16x32_bf16(sB1, ra1, y, 0, 0, 0);
        f32x4 sn = {bf2f(qb[0]), bf2f(qb[1]), bf2f(qb[2]), bf2f(qb[3])};
        sn = __builtin_amdgcn_mfma_f32_16x16x32_bf16(pa0, sB0, sn, 0, 0, 0);
        sn = __builtin_amdgcn_mfma_f32_16x16x32_bf16(pa1, sB1, sn, 0, 0, 0);
        Sacc[m] = sn;
        {
          const int mm = scan_tok(b, d, n * 64 + m * 16 + fr);
          *(f32x4*)(Y + (size_t)mm * 256 + h * 64 + vt * 16 + 4 * fq) = y;
        }
      }
      X2_BAR();
    }
  }
}

struct NaPair { int mk0, mk1, tau0, tau1, kr0, kr1, ct0, ct1; };
struct NaFrag { bf16x8 k00, k01, k10, k11; bf16x4 v0[4], v1[4]; };

__device__ __forceinline__ void na_load(NaFrag& f, const bfr* KN, const bfr* VT, size_t vt_base, int h, int fr, int fq, const NaPair& pr) {
  const bfr* k0 = KN + (size_t)(pr.mk0 + fr) * 512 + h * 64 + fq * 8;
  const bfr* k1 = KN + (size_t)(pr.mk1 + fr) * 512 + h * 64 + fq * 8;
  f.k00 = *(const bf16x8*)(k0); f.k01 = *(const bf16x8*)(k0 + 32);
  f.k10 = *(const bf16x8*)(k1); f.k11 = *(const bf16x8*)(k1 + 32);
#pragma unroll
  for (int dt = 0; dt < 4; ++dt) {
    const int vo = (dt * 16 + fr) * 16 + fq * 4;
    f.v0[dt] = *(const bf16x4*)(VT + vt_base + (size_t)(pr.tau0 >> 4) * 1024 + vo);
    f.v1[dt] = *(const bf16x4*)(VT + vt_base + (size_t)(pr.tau1 >> 4) * 1024 + vo);
  }
}

__device__ __forceinline__ void na_compute(const NaFrag& f, const bf16x8 qf0, const bf16x8 qf1, bool local, bool vr0, bool vr1,
                                           int dr0, int dr1, int ct0, int ct1, int qc, int fq, const float* bias_h, f32x4 (&O)[4], float& lsum) {
  f32x4 z = {0.f, 0.f, 0.f, 0.f};
  f32x4 st0 = __builtin_amdgcn_mfma_f32_16x16x32_bf16(f.k00, qf0, z, 0, 0, 0);
  st0 = __builtin_amdgcn_mfma_f32_16x16x32_bf16(f.k01, qf1, st0, 0, 0, 0);
  f32x4 st1 = __builtin_amdgcn_mfma_f32_16x16x32_bf16(f.k10, qf0, z, 0, 0, 0);
  st1 = __builtin_amdgcn_mfma_f32_16x16x32_bf16(f.k11, qf1, st1, 0, 0, 0);
  bf16x8 pf;
  if (local) {
    const int cs = min(max(qc - 8, 0), 48);
#pragma unroll
    for (int r = 0; r < 4; ++r) {
      const int kc0 = ct0 * 16 + fq * 4 + r, kc1 = ct1 * 16 + fq * 4 + r;
      float p0 = 0.f, p1 = 0.f;
      if (vr0 && (unsigned)(kc0 - cs) < 16u) p0 = __builtin_amdgcn_exp2f(st0[r] + bias_h[dr0 * 31 + (kc0 - qc + 15)]);
      if (vr1 && (unsigned)(kc1 - cs) < 16u) p1 = __builtin_amdgcn_exp2f(st1[r] + bias_h[dr1 * 31 + (kc1 - qc + 15)]);
      lsum += p0 + p1;
      pf[r] = (short)f2bf(p0);
      pf[4 + r] = (short)f2bf(p1);
    }
  } else {
#pragma unroll
    for (int r = 0; r < 4; ++r) {
      const float p0 = __builtin_amdgcn_exp2f(st0[r]), p1 = __builtin_amdgcn_exp2f(st1[r]);
      lsum += p0 + p1;
      pf[r] = (short)f2bf(p0);
      pf[4 + r] = (short)f2bf(p1);
    }
  }
#pragma unroll
  for (int dt = 0; dt < 4; ++dt) {
    bf16x8 vf;
    vf[0] = f.v0[dt][0]; vf[1] = f.v0[dt][1]; vf[2] = f.v0[dt][2]; vf[3] = f.v0[dt][3];
    vf[4] = f.v1[dt][0]; vf[5] = f.v1[dt][1]; vf[6] = f.v1[dt][2]; vf[7] = f.v1[dt][3];
    O[dt] = __builtin_amdgcn_mfma_f32_16x16x32_bf16(vf, pf, O[dt], 0, 0, 0);
  }
}

__device__ __forceinline__ void na_block_task(PP pp, int task, const float* bias_lds) {
  const int tid = tid_opaque(), lane = tid & 63, wv = wave_id(tid);
  const int fr = lane & 15, fq = lane >> 4;
  char* S = p.ws + OFF_S;
  const bfr* QN = (const bfr*)(S + S_QN);
  const bfr* KN = (const bfr*)(S + S_KN);
  const bfr* VT = (const bfr*)(S + S_VT);
  bfr* CC = (bfr*)(p.ws + OFF_CC);
  const bool latent = task < 1024;
  int b, h, mqa, mqb, qra = 0, qrb = 0, cgp = 0;
  if (latent) {
    h = task & 7; const int quad = (task >> 3) & 63; b = task >> 9;
    qra = quad * 4 + (wv >> 2) * 2; qrb = qra + 1; cgp = wv & 3;
    mqa = b * SEQ + qra * 64 + cgp * 16; mqb = mqa + 64;
  } else {
    const int u = task - 1024;
    h = u & 7; b = u >> 3;
    mqa = NLAT + b * CTXL + (wv * 2) * 16; mqb = mqa + 16;
  }
  const bf16x8 qa0 = *(const bf16x8*)(QN + (size_t)(mqa + fr) * 512 + h * 64 + fq * 8);
  const bf16x8 qa1 = *(const bf16x8*)(QN + (size_t)(mqa + fr) * 512 + h * 64 + 32 + fq * 8);
  const bf16x8 qb0 = *(const bf16x8*)(QN + (size_t)(mqb + fr) * 512 + h * 64 + fq * 8);
  const bf16x8 qb1 = *(const bf16x8*)(QN + (size_t)(mqb + fr) * 512 + h * 64 + 32 + fq * 8);
  f32x4 Oa[4], Ob[4];
#pragma unroll
  for (int dt = 0; dt < 4; ++dt) { Oa[dt] = (f32x4){0.f, 0.f, 0.f, 0.f}; Ob[dt] = Oa[dt]; }
  float lsa = 0.f, lsb = 0.f;
  const size_t vt_base = (size_t)(b * 8 + h) * 64 * TTOK;
  const int rsa = min(max(qra - 4, 0), SEQ / 64 - 8), rsb = min(max(qrb - 4, 0), SEQ / 64 - 8);
  const int nrows = latent ? (rsb - rsa + 8) : 0;
  const int ct_first = (cgp <= 1) ? 0 : cgp - 1;
  const int nct = (cgp == 0 || cgp == 3) ? 2 : 3;
  const int ntile = nrows * nct;
  const int nlp = (ntile + 1) >> 1;
  const int npair = nlp + 8;
  const int qc = cgp * 16 + fr;
  auto mkpair = [&](int pi) {
    NaPair pr;
    if (pi < nlp) {
      const int i0 = 2 * pi, i1 = min(2 * pi + 1, ntile - 1);
      pr.kr0 = rsa + i0 / nct; pr.ct0 = ct_first + i0 % nct;
      pr.kr1 = rsa + i1 / nct; pr.ct1 = ct_first + i1 % nct;
      if (2 * pi + 1 >= ntile) pr.kr1 = -100;
      const int r1 = rsa + i1 / nct;
      pr.tau0 = pr.kr0 * 64 + pr.ct0 * 16; pr.tau1 = r1 * 64 + pr.ct1 * 16;
      pr.mk0 = b * SEQ + pr.tau0; pr.mk1 = b * SEQ + pr.tau1;
    } else {
      const int c = pi - nlp;
      pr.kr0 = pr.kr1 = pr.ct0 = pr.ct1 = 0;
      pr.tau0 = SEQ + c * 32; pr.tau1 = SEQ + c * 32 + 16;
      pr.mk0 = NLAT + b * CTXL + c * 32; pr.mk1 = pr.mk0 + 16;
    }
    return pr;
  };
  NaFrag fa, fb;
  NaPair pa = mkpair(0), pb;
  na_load(fa, KN, VT, vt_base, h, fr, fq, pa);
  const float* bias_h = bias_lds + h * 465;
#define NA_DO(F, PR, PI)                                                                                          \
  {                                                                                                               \
    const bool loc_ = (PI) < nlp;                                                                                 \
    na_compute(F, qa0, qa1, loc_, (unsigned)(PR.kr0 - rsa) < 8u, (unsigned)(PR.kr1 - rsa) < 8u,                   \
               PR.kr0 - qra + 7, PR.kr1 - qra + 7, PR.ct0, PR.ct1, qc, fq, bias_h, Oa, lsa);                      \
    na_compute(F, qb0, qb1, loc_, (unsigned)(PR.kr0 - rsb) < 8u, (unsigned)(PR.kr1 - rsb) < 8u,                   \
               PR.kr0 - qrb + 7, PR.kr1 - qrb + 7, PR.ct0, PR.ct1, qc, fq, bias_h, Ob, lsb);                      \
  }
  for (int pi = 0; pi < npair; pi += 2) {
    if (pi + 1 < npair) { pb = mkpair(pi + 1); na_load(fb, KN, VT, vt_base, h, fr, fq, pb); }
    NA_DO(fa, pa, pi)
    if (pi + 1 < npair) {
      if (pi + 2 < npair) { pa = mkpair(pi + 2); na_load(fa, KN, VT, vt_base, h, fr, fq, pa); }
      NA_DO(fb, pb, pi + 1)
    }
  }
#undef NA_DO
  lsa += shfl_xor_l(lsa, 16, lane); lsa += shfl_xor_l(lsa, 32, lane);
  lsb += shfl_xor_l(lsb, 16, lane); lsb += shfl_xor_l(lsb, 32, lane);
  const float ia = 1.f / lsa, ib = 1.f / lsb;
#pragma unroll
  for (int dt = 0; dt < 4; ++dt) {
    *(bf16x4*)(CC + (size_t)(mqa + fr) * 1024 + h * 64 + dt * 16 + fq * 4) = pack4(Oa[dt][0] * ia, Oa[dt][1] * ia, Oa[dt][2] * ia, Oa[dt][3] * ia);
    *(bf16x4*)(CC + (size_t)(mqb + fr) * 1024 + h * 64 + dt * 16 + fq * 4) = pack4(Ob[dt][0] * ib, Ob[dt][1] * ib, Ob[dt][2] * ib, Ob[dt][3] * ib);
  }
}

__device__ __forceinline__ void phase_mix(PP pp, int l, int bid, int nb, char* smem) {
  const int tid = tid_opaque();
  const int nscan_blocks = (nb > 32) ? 32 : nb;
  const int first_attn_block = (nb > 32) ? 32 : 0;
  if (bid < nscan_blocks) {
    for (int c = bid; c < NCHAIN; c += nscan_blocks) chunk_seq_chain(pp, c, smem);
  }
  if (bid >= first_attn_block) {
    float* bias = (float*)smem;
    __syncthreads();
    for (int i = tid; i < 8 * 465; i += NTHR) bias[i] = p.na_rpb[(size_t)l * 8 * 465 + i] * 1.4426950408889634f;
    __syncthreads();
    const int ntask = (l == 0) ? 1024 + 16 : 1024;
    const int nab = nb - first_attn_block;
    for (int t = bid - first_attn_block; t < ntask; t += nab) na_block_task(pp, t, bias);
    __syncthreads();
    phase_convert(pp, l, 1, bid - first_attn_block, nab, smem);
    if (l == 0) phase_convert(pp, 1, 0, bid - first_attn_block, nab, smem);
  }
}

__device__ __forceinline__ void phase_post(PP pp, int l, int bid, int nb) {
  const int tid = tid_opaque(), lane = tid & 63, wv = wave_id(tid);
  char* S = p.ws + OFF_S;
  const float* YRW = (const float*)(S + S_YRW);
  const float* YGD = (const float*)(S + S_YGD);
  const float* RWV = (const float*)(S + S_RWV);
  const float* RWG = (const float*)(S + S_RWG);
  const float* BON = (const float*)(S + S_BON);
  const float* P = (const float*)(p.ws + OFF_P);
  bfr* CC = (bfr*)(p.ws + OFF_CC);
  const float* ln_w = p.rw_ln_w + (size_t)l * 256;
  const float* ln_b = p.rw_ln_b + (size_t)l * 256;
  const float* ng = p.gd_norm_g + (size_t)l * 64;
  const int ntok = (l == 0) ? NTOK : NLAT;
  for (int wt = bid * 8 + wv; wt < ntok * 8; wt += nb * 8) {
    int m = wt >> 3, hs = wt & 7;
    if (hs < 4) {
      int c = hs * 64 + lane;
      size_t o = (size_t)m * 256 + c;
      float y = YRW[o] + YRW[(size_t)NTOK * 256 + o];
      float mean = wave_sum(y) * (1.f / 64.f);
      float dv = y - mean;
      float var = wave_sum(dv * dv) * (1.f / 64.f);
      float yn = dv * rsqrtf(var + 64e-5f) * ln_w[c] + ln_b[c];
      float out = (yn + BON[(size_t)m * 4 + hs] * RWV[o]) * RWG[o];
      CC[(size_t)m * 1024 + 512 + c] = f2bf(out);
    } else {
      int c = (hs - 4) * 64 + lane;
      size_t o = (size_t)m * 256 + c;
      float y = YGD[o] + YGD[(size_t)NTOK * 256 + o];
      float ms = wave_sum(y * y) * (1.f / 64.f);
      float z = P[(size_t)m * PINP + B_END + 768 + c];
      float out = y * rsqrtf(ms + 1e-6f) * ng[lane] * siluf_(z);
      CC[(size_t)m * 1024 + 768 + c] = f2bf(out);
    }
  }
}

#define RW_LDS_ROW 36
__device__ __forceinline__ void phase_router(PP pp, int l, int bid, int nb, char* smem) {
  const int tid = tid_opaque(), lane = tid & 63, wv = wave_id(tid);
  const float* xl = p.out;
  const float* xc = (const float*)(p.ws + OFF_CTX);
  const float* mods = (const float*)(p.ws + OFF_MODS) + (size_t)l * 3 * 6144;
  const float* g = p.norm_ffn_g + (size_t)l * 1024;
  const float* rw = p.moe_router_w + (size_t)l * 1024 * 32;
  const float* rb = p.moe_router_b + (size_t)l * 32;
  bfr* H = (bfr*)(p.ws + OFF_H);
  int* cnt = (int*)(p.ws + OFF_CNT);
  int* TOKE = (int*)(p.ws + OFF_TOKE);
  int* TOKP = (int*)(p.ws + OFF_TOKP);
  float* TOKG = (float*)(p.ws + OFF_TOKG);
  float* wl = (float*)smem;
  for (int i = tid; i < 1024 * 8; i += NTHR) {
    int d = i >> 3, q = i & 7;
    *(float4*)(wl + d * RW_LDS_ROW + q * 4) = *(const float4*)(rw + (size_t)d * 32 + q * 4);
  }
  __syncthreads();
  const int ntok = (l == 0) ? NTOK : NLAT;
  const float rbl = rb[lane & 31];
  for (int m0 = (bid * 8 + wv) * 2; m0 < ntok; m0 += nb * 16) {
    float acc0[32], acc1[32];
#pragma unroll
    for (int e = 0; e < 32; ++e) { acc0[e] = 0.f; acc1[e] = 0.f; }
    float hv0[16], hv1[16];
    {
      const int ma = m0, mb = m0 + 1;
      const float* xa = (ma < NLAT) ? xl + (size_t)ma * 1024 : xc + (size_t)(ma - NLAT) * 1024;
      const float* xb = (mb < NLAT) ? xl + (size_t)mb * 1024 : xc + (size_t)(mb - NLAT) * 1024;
      const float* mda = mods + (size_t)mod_row(ma) * 6144 + 3072;
      const float* mdb = mods + (size_t)mod_row(mb) * 6144 + 3072;
      float ssa = 0.f, ssb = 0.f;
#pragma unroll
      for (int i = 0; i < 16; ++i) { hv0[i] = xa[lane + 64 * i]; hv1[i] = xb[lane + 64 * i]; }
#pragma unroll
      for (int i = 0; i < 16; ++i) { ssa += hv0[i] * hv0[i]; ssb += hv1[i] * hv1[i]; }
      ssa = wave_sum(ssa); ssb = wave_sum(ssb);
      const float rsa = rsqrtf(ssa * (1.f / 1024.f) + 1e-6f), rsb = rsqrtf(ssb * (1.f / 1024.f) + 1e-6f);
#pragma unroll
      for (int i = 0; i < 16; ++i) {
        const int d = lane + 64 * i;
        const float gg = g[d];
        hv0[i] = hv0[i] * rsa * gg * (1.f + mda[1024 + d]) + mda[d];
        hv1[i] = hv1[i] * rsb * gg * (1.f + mdb[1024 + d]) + mdb[d];
      }
      float am0 = 0.f, am1 = 0.f;
#pragma unroll
      for (int i = 0; i < 16; ++i) { am0 = fmaxf(am0, fabsf(hv0[i])); am1 = fmaxf(am1, fabsf(hv1[i])); }
      am0 = wave_max(am0); am1 = wave_max(am1);
      const float sc0 = am0 > 0.f ? am0 * (1.f / 127.f) : 1.f, sc1 = am1 > 0.f ? am1 * (1.f / 127.f) : 1.f;
      const float iv0 = 1.f / sc0, iv1 = 1.f / sc1;
      signed char* H8 = (signed char*)(p.ws + OFF_H);
#pragma unroll
      for (int i = 0; i < 16; ++i) {
        const int d = lane + 64 * i;
        H8[(size_t)ma * 1024 + d] = (signed char)(int)fminf(fmaxf(rintf(hv0[i] * iv0), -127.f), 127.f);
        H8[(size_t)mb * 1024 + d] = (signed char)(int)fminf(fmaxf(rintf(hv1[i] * iv1), -127.f), 127.f);
      }
      if (lane == 0) { float* SCL = (float*)(p.ws + OFF_SCL); SCL[ma] = sc0; SCL[mb] = sc1; }
      asm volatile("" ::: "memory");
    }
#pragma unroll
    for (int i = 0; i < 16; ++i) {
      if ((i & 3) == 0) asm volatile("" ::: "memory");
      const float* wr = wl + (lane + 64 * i) * RW_LDS_ROW;
#pragma unroll
      for (int q = 0; q < 8; ++q) {
        const float4 w = *(const float4*)(wr + q * 4);
        acc0[q * 4 + 0] += hv0[i] * w.x; acc0[q * 4 + 1] += hv0[i] * w.y; acc0[q * 4 + 2] += hv0[i] * w.z; acc0[q * 4 + 3] += hv0[i] * w.w;
        acc1[q * 4 + 0] += hv1[i] * w.x; acc1[q * 4 + 1] += hv1[i] * w.y; acc1[q * 4 + 2] += hv1[i] * w.z; acc1[q * 4 + 3] += hv1[i] * w.w;
      }
    }
#define BFLY(A, N, D)                                                                           \
    _Pragma("unroll") for (int i = 0; i < (N); ++i) {                                            \
      const bool up = (lane & (D)) != 0;                                                         \
      const float keep = up ? A[i + (N)] : A[i];                                                 \
      const float send = up ? A[i] : A[i + (N)];                                                 \
      A[i] = keep + shfl_xor_l(send, (D), lane);                                                   \
    }
    BFLY(acc0, 16, 16) BFLY(acc1, 16, 16)
    BFLY(acc0, 8, 8) BFLY(acc1, 8, 8)
    BFLY(acc0, 4, 4) BFLY(acc1, 4, 4)
    BFLY(acc0, 2, 2) BFLY(acc1, 2, 2)
    BFLY(acc0, 1, 1) BFLY(acc1, 1, 1)
#undef BFLY
    float la = acc0[0] + shfl_xor_l(acc0[0], 32, lane);
    float lb = acc1[0] + shfl_xor_l(acc1[0], 32, lane);
    const int my_e = lane & 31;
    la += rbl; lb += rbl;
    (void)my_e;
#pragma unroll
    for (int tkn = 0; tkn < 2; ++tkn) {
      float v = tkn == 0 ? la : lb;
      float tv[4]; int ti[4];
#pragma unroll
      for (int k = 0; k < 4; ++k) {
        float bv = v; int bi = lane & 31;
#pragma unroll
        for (int o = 16; o >= 1; o >>= 1) {
          float ov = shfl_xor_l(bv, o, lane); int oi = shfl_xor_li(bi, o, lane);
          bool take = (ov > bv) || (ov == bv && oi < bi);
          bv = take ? ov : bv; bi = take ? oi : bi;
        }
        tv[k] = bv; ti[k] = bi;
        if ((lane & 31) == bi) v = -3.0e38f;
      }
      float e1 = __expf(tv[1] - tv[0]), e2 = __expf(tv[2] - tv[0]), e3 = __expf(tv[3] - tv[0]);
      float inv = 1.f / (1.f + e1 + e2 + e3);
      const int m = m0 + tkn;
      if (lane < 4) {
        int e = lane == 0 ? ti[0] : lane == 1 ? ti[1] : lane == 2 ? ti[2] : ti[3];
        float gt = (lane == 0 ? 1.f : lane == 1 ? e1 : lane == 2 ? e2 : e3) * inv;
        int pos = atomicAdd(&cnt[e], 1);
        TOKE[(size_t)m * 4 + lane] = e; TOKP[(size_t)m * 4 + lane] = pos; TOKG[(size_t)m * 4 + lane] = gt;
      }
    }
  }
  __syncthreads();
}

__device__ __forceinline__ void moe_offsets(PP pp, int* toff) {
  const int* cnt = (const int*)(p.ws + OFF_CNT);
  if (tid_opaque() == 0) {
    int a = 0;
    for (int e = 0; e < 32; ++e) { toff[e] = a; a += (cnt[e] + 255) >> 8; }
    toff[32] = a;
  }
  __syncthreads();
}

__device__ __forceinline__ void phase_slotfill(PP pp, int l, int bid, int nb, char* smem) {
  int* toff = (int*)smem;
  moe_offsets(pp, toff);
  const int tid = tid_opaque(), lane = tid & 63, wv = wave_id(tid);
  const int* TOKE = (const int*)(p.ws + OFF_TOKE);
  const int* TOKP = (const int*)(p.ws + OFF_TOKP);
  const float* TOKG = (const float*)(p.ws + OFF_TOKG);
  const int* cnt = (const int*)(p.ws + OFF_CNT);
  int* TOKS = (int*)(p.ws + OFF_TOKS);
  float* SLG = (float*)(p.ws + OFF_SLG);
  float* SLS = (float*)(p.ws + OFF_SLS);
  const float* SCL = (const float*)(p.ws + OFF_SCL);
  const signed char* H8 = (const signed char*)(p.ws + OFF_H);
  signed char* XG = (signed char*)(p.ws + OFF_S);
  const int n = ((l == 0) ? NTOK : NLAT) * 4;
  for (int i = bid * 8 + wv; i < n; i += nb * 8) {
    int e = TOKE[i];
    int slot = toff[e] * 256 + TOKP[i];
    if (lane == 0) { TOKS[i] = slot; SLG[slot] = TOKG[i]; SLS[slot] = SCL[i >> 2]; }
    const uint4* src = (const uint4*)(H8 + (size_t)(i >> 2) * 1024);
    uint4* dst = (uint4*)(XG + (size_t)slot * 1024);
    dst[lane] = src[lane];
  }
  for (int e = 0; e < 32; ++e) {
    const int c = cnt[e];
    const int npad = ((c + 255) & ~255) - c;
    const int base = toff[e] * 256 + c;
    for (int r = bid * 8 + wv; r < npad; r += nb * 8) {
      uint4* dst = (uint4*)(XG + (size_t)(base + r) * 1024);
      dst[lane] = make_uint4(0u, 0u, 0u, 0u);
      if (lane == 0) SLS[base + r] = 0.f;
    }
  }
  __syncthreads();
}

struct EpiMoe1 {
  const float* bgu; const float* sw; const float* SLS; bfr* ACT;
  __device__ __forceinline__ void operator()(const i32x4 (&acc)[2][2][4][2], const g8::GUnit& u, int wr, int wc, int fr, int fq) const {
    const float* be = bgu + (size_t)u.e * 2048;
    const float* se = sw + (size_t)u.e * 2048;
    const int slot0 = u.pm * 256 + wr * 64 + fr;
#pragma unroll
    for (int bj = 0; bj < 2; ++bj) {
      const int j0 = u.pn * 128 + bj * 64 + wc * 16 + 4 * fq;
      const f32x4 bg = *(const f32x4*)(be + j0), bl = *(const f32x4*)(be + 1024 + j0);
      const f32x4 sg = *(const f32x4*)(se + j0), sl = *(const f32x4*)(se + 1024 + j0);
#pragma unroll
      for (int ai = 0; ai < 2; ++ai)
#pragma unroll
        for (int m = 0; m < 4; ++m) {
          const int slot = slot0 + ai * 128 + m * 16;
          const float sa = SLS[slot];
          bf16x4 o;
#pragma unroll
          for (int q = 0; q < 4; ++q) {
            const float g = (float)acc[ai][bj][m][0][q] * (sa * sg[q]) + bg[q];
            const float li = (float)acc[ai][bj][m][1][q] * (sa * sl[q]) + bl[q];
            const float gv = fminf(g, 7.f);
            const float lv = fminf(fmaxf(li, -7.f), 7.f);
            o[q] = (short)f2bf(gv * sigmoidf_(1.702f * gv) * (lv + 1.f));
          }
          *(bf16x4*)(ACT + (size_t)slot * 1024 + j0) = o;
        }
    }
  }
};
__device__ __forceinline__ void phase_moe1_impl(PP pp, int l, int bid, int nb, char* smem, int* toff) {
  moe_offsets(pp, toff);
  g8::MoeSched S{toff, 8, 2048, nb, bid};
  EpiMoe1 E{p.moe_b_gu + (size_t)l * 32 * 2048, (const float*)(p.ws + OFF_SW) + (size_t)l * 32 * 2048, (const float*)(p.ws + OFF_SLS), (bfr*)(p.ws + OFF_P)};
  g8::gemm_stream<true>((LAS unsigned char*)smem, p.ws + OFF_S, p.ws + OFF_W + (size_t)l * WL_SIZE + WL_GU, S, E);
}

struct EpiMoe2 {
  const float* bdn; const float* SLG; bfr* YS;
  __device__ __forceinline__ void operator()(const f32x4 (&acc)[2][2][4][2], const g8::GUnit& u, int wr, int wc, int fr, int fq) const {
    const float* be = bdn + (size_t)u.e * 1024;
    const int slot0 = u.pm * 256 + wr * 64 + fr, col0 = u.pn * 256 + wc * 32 + 4 * fq;
#pragma unroll
    for (int ai = 0; ai < 2; ++ai)
#pragma unroll
      for (int m = 0; m < 4; ++m) {
        const int slot = slot0 + ai * 128 + m * 16;
        const float gt = SLG[slot];
#pragma unroll
        for (int bj = 0; bj < 2; ++bj)
#pragma unroll
          for (int n = 0; n < 2; ++n) {
            const f32x4 bv = *(const f32x4*)(be + col0 + bj * 128 + n * 16);
            const f32x4 yv = (acc[ai][bj][m][n] + bv) * gt;
            *(bf16x4*)(YS + (size_t)slot * 1024 + col0 + bj * 128 + n * 16) = pack4(yv[0], yv[1], yv[2], yv[3]);
          }
      }
  }
};
__device__ __forceinline__ void phase_moe2_impl(PP pp, int l, int bid, int nb, char* smem, int* toff) {
  moe_offsets(pp, toff);
  g8::MoeSched S{toff, 4, 1024, nb, bid};
  EpiMoe2 E{p.moe_b_down + (size_t)l * 32 * 1024, (const float*)(p.ws + OFF_SLG), (bfr*)(p.ws + OFF_S)};
  g8::gemm_stream<false>((LAS unsigned char*)smem, p.ws + OFF_P, p.ws + OFF_W + (size_t)l * WL_SIZE + WL_DN, S, E);
}

__device__ __forceinline__ void phase_combine(PP pp, int l, int bid, int nb) {
  const int tid = tid_opaque(), lane = tid & 63, wv = wave_id(tid);
  const bfr* YS = (const bfr*)(p.ws + OFF_S);
  const int* TOKS = (const int*)(p.ws + OFF_TOKS);
  const float* mods = (const float*)(p.ws + OFF_MODS) + (size_t)l * 3 * 6144;
  const float* mods1 = (const float*)(p.ws + OFF_MODS) + (size_t)3 * 6144;
  const float* g1n = p.norm_mix_g + 1024;
  bfr* H = (bfr*)(p.ws + OFF_H);
  float* xl = p.out;
  float* xc = (float*)(p.ws + OFF_CTX);
  const int ntok = (l == 0) ? NTOK : NLAT;
  if (l == 0) {
    int* cnt = (int*)(p.ws + OFF_CNT);
    const int gt = bid * NTHR + tid;
    if (gt < 32) cnt[gt] = 0;
  }
  for (int m = bid * 8 + wv; m < ntok; m += nb * 8) {
    float* xr = (m < NLAT) ? xl + (size_t)m * 1024 : xc + (size_t)(m - NLAT) * 1024;
    const float* g2 = mods + (size_t)mod_row(m) * 6144 + 5120;
    const int s0 = TOKS[(size_t)m * 4], s1 = TOKS[(size_t)m * 4 + 1], s2 = TOKS[(size_t)m * 4 + 2], s3 = TOKS[(size_t)m * 4 + 3];
    float4 xn[4];
    float ss = 0.f;
#pragma unroll
    for (int i = 0; i < 4; ++i) {
      const int d = (lane + 64 * i) * 4;
      const bf16x4 a = *(const bf16x4*)(YS + (size_t)s0 * 1024 + d);
      const bf16x4 b = *(const bf16x4*)(YS + (size_t)s1 * 1024 + d);
      const bf16x4 c = *(const bf16x4*)(YS + (size_t)s2 * 1024 + d);
      const bf16x4 e = *(const bf16x4*)(YS + (size_t)s3 * 1024 + d);
      const float4 gg = *(const float4*)(g2 + d);
      float4 xv = *(const float4*)(xr + d);
      xv.x += gg.x * ((bf2f(a[0]) + bf2f(b[0])) + (bf2f(c[0]) + bf2f(e[0])));
      xv.y += gg.y * ((bf2f(a[1]) + bf2f(b[1])) + (bf2f(c[1]) + bf2f(e[1])));
      xv.z += gg.z * ((bf2f(a[2]) + bf2f(b[2])) + (bf2f(c[2]) + bf2f(e[2])));
      xv.w += gg.w * ((bf2f(a[3]) + bf2f(b[3])) + (bf2f(c[3]) + bf2f(e[3])));
      *(float4*)(xr + d) = xv;
      xn[i] = xv;
      ss += xv.x * xv.x + xv.y * xv.y + xv.z * xv.z + xv.w * xv.w;
    }
    if (l == 0) {
      ss = wave_sum(ss);
      const float rs = rsqrtf(ss * (1.f / 1024.f) + 1e-6f);
      const float* md = mods1 + (size_t)mod_row(m) * 6144;
      float4 hq[4];
#pragma unroll
      for (int i = 0; i < 4; ++i) {
        const int d = (lane + 64 * i) * 4;
        const float4 gg = *(const float4*)(g1n + d);
        const float4 sh = *(const float4*)(md + d);
        const float4 sc = *(const float4*)(md + 1024 + d);
        hq[i] = make_float4(xn[i].x * rs * gg.x * (1.f + sc.x) + sh.x, xn[i].y * rs * gg.y * (1.f + sc.y) + sh.y,
                            xn[i].z * rs * gg.z * (1.f + sc.z) + sh.z, xn[i].w * rs * gg.w * (1.f + sc.w) + sh.w);
      }
      const float qs = quant_row_store(hq, (signed char*)(p.ws + OFF_H) + (size_t)m * 1024, lane);
      if (lane == 0) ((float*)(p.ws + OFF_SCL))[m] = qs;
    }
  }
}

#define XB_TMO      128
#define XB_XCNT(j)  (256  + 64 * (j))
#define XB_XSUB(j)  (1280 + 64 * (j))
#define XB_XGEN(j)  (2304 + 64 * (j))
#define XB_TOP      3328
#define XB_TOPGEN   3392
#define XCD_BAR_WORDS 3456
#define XB_SPIN_CAP (1u << 22)
__device__ __forceinline__ unsigned xb_ld(unsigned* q) { return __hip_atomic_load(q, __ATOMIC_RELAXED, __HIP_MEMORY_SCOPE_AGENT); }
__device__ __forceinline__ unsigned xb_add(unsigned* q, unsigned v) { return __hip_atomic_fetch_add(q, v, __ATOMIC_RELAXED, __HIP_MEMORY_SCOPE_AGENT); }
__device__ __forceinline__ unsigned xb_xcc_id() { return (unsigned)__builtin_amdgcn_s_getreg((3 << 11) | 20) & 0xFu; }
#define XB_SPIN(cond, bar) do { unsigned _sp = 0; while (cond) { __builtin_amdgcn_s_sleep(1); \
    if ((++_sp & 255u) == 0u) { if (xb_ld(&(bar)[XB_TMO])) break; if (_sp > XB_SPIN_CAP) { atomicAdd(&(bar)[XB_TMO], 1u); break; } } } } while (0)
struct XcdBarrier { unsigned* bar; unsigned x; volatile LAS unsigned* st; };
__device__ __forceinline__ XcdBarrier xcd_barrier_post(unsigned* bar, volatile LAS unsigned* st) {
  XcdBarrier b; b.bar = bar; b.x = xb_xcc_id(); b.st = st;
  if (tid_opaque() == 0) (void)xb_add(&bar[XB_XCNT(b.x)], 1u);
  return b;
}
__device__ __forceinline__ void xcd_barrier_complete(unsigned* bar, unsigned x, unsigned& nloc, unsigned& nx) {
  const unsigned G = gridDim.x;
  unsigned sum, cnt, mine, sp = 0u;
  for (;;) {
    sum = 0u; cnt = 0u; mine = 0u;
#pragma unroll
    for (unsigned j = 0; j < 16; ++j) { const unsigned c = xb_ld(&bar[XB_XCNT(j)]); sum += c; cnt += (c > 0u) ? 1u : 0u; mine = (j == x) ? c : mine; }
    if (sum == G) break;
    __builtin_amdgcn_s_sleep(1);
    if ((++sp & 255u) == 0u) { if (xb_ld(&bar[XB_TMO])) break; if (sp > XB_SPIN_CAP) { atomicAdd(&bar[XB_TMO], 1u); break; } }
  }
  nloc = mine > 0u ? mine : 1u; nx = cnt > 0u ? cnt : 1u;
}
__device__ __forceinline__ void xcd_barrier(const XcdBarrier& b) {
  asm volatile("s_waitcnt vmcnt(0)" ::: "memory");
  __syncthreads();
  if (tid_opaque() == 0) {
    unsigned* bar = b.bar;
    __builtin_amdgcn_s_waitcnt(0);
    unsigned nloc = b.st[0], nx = b.st[1];
    if (nloc == 0u) { xcd_barrier_complete(bar, b.x, nloc, nx); b.st[0] = nloc; b.st[1] = nx; }
    const unsigned old = xb_add(&bar[XB_XSUB(b.x)], 1u);
    const unsigned gen = old / nloc;
    if (old + 1u == (gen + 1u) * nloc) {
      __builtin_amdgcn_fence(__ATOMIC_RELEASE, "agent");
      asm volatile("s_waitcnt vmcnt(0)" ::: "memory");
      const unsigned og = xb_add(&bar[XB_TOP], 1u);
      const unsigned tg = og / nx;
      if (og + 1u == (tg + 1u) * nx) xb_add(&bar[XB_TOPGEN], 1u);
      else XB_SPIN(xb_ld(&bar[XB_TOPGEN]) == tg, bar);
      __builtin_amdgcn_fence(__ATOMIC_ACQUIRE, "agent");
      xb_add(&bar[XB_XGEN(b.x)], 1u);
      asm volatile("s_waitcnt vmcnt(0)" ::: "memory");
    } else {
      XB_SPIN(xb_ld(&bar[XB_XGEN(b.x)]) == gen, bar);
      __builtin_amdgcn_fence(__ATOMIC_ACQUIRE, "agent");
      asm volatile("s_waitcnt vmcnt(0)" ::: "memory");
    }
  }
  __syncthreads();
}

extern __shared__ __attribute__((aligned(16))) char dyn_smem[];

__global__ void __launch_bounds__(NTHR) mega(Params p_unused) {
  cg::grid_group grid = cg::this_grid();
  const int bid0 = blockIdx.x, nb0 = gridDim.x;
#if defined(__HIP_DEVICE_COMPILE__)
  PP pp0 = (PP)__builtin_amdgcn_kernarg_segment_ptr();
#else
  PP pp0 = nullptr;
#endif
#define pp ({ PP q_ = pp0; asm volatile("" : "+s"(q_)); q_; })
#define bid opq(bid0)
#define nb opq(nb0)
  int* toff_s = (int*)(dyn_smem + 147456);
  volatile LAS unsigned* xb_st = (volatile LAS unsigned*)(dyn_smem + 147456 + 256);
  {
    unsigned* barw = (unsigned*)(fresh_ws(pp0) + OFF_BAR);
    if (blockIdx.x == 0) for (int i = threadIdx.x; i < XCD_BAR_WORDS; i += NTHR) barw[i] = 0u;
    if (threadIdx.x == 0) { xb_st[0] = 0u; xb_st[1] = 0u; }
  }
  grid.sync();
  const XcdBarrier xb = xcd_barrier_post((unsigned*)(fresh_ws(pp0) + OFF_BAR), xb_st);
#define GSYNC() xcd_barrier(xb)
  phase_ada(pp, bid, nb, dyn_smem);
  phase_convert(pp, 0, 0, bid, nb, dyn_smem);
  GSYNC();
#define LAYER(LV, LAST)                                      \
  {                                                          \
    if ((LV) == 0) { phase_prenorm(pp, opq(LV), bid, nb); GSYNC(); } \
    phase_gemm_in(pp, opq(LV), bid, nb, dyn_smem);           \
    GSYNC();                                                 \
    phase_prep(pp, opq(LV), bid, nb, dyn_smem);              \
    GSYNC();                                                 \
    phase_chunk_prep(pp, bid, nb, dyn_smem);                 \
    GSYNC();                                                 \
    phase_mix(pp, opq(LV), bid, nb, dyn_smem);               \
    GSYNC();                                                 \
    phase_post(pp, opq(LV), bid, nb);                        \
    GSYNC();                                                 \
    phase_gemm_out(pp, opq(LV), bid, nb, dyn_smem);          \
    GSYNC();                                                 \
    phase_router(pp, opq(LV), bid, nb, dyn_smem);            \
    GSYNC();                                                 \
    phase_slotfill(pp, opq(LV), bid, nb, dyn_smem);          \
    GSYNC();                                                 \
    phase_moe1_impl(pp, opq(LV), bid, nb, dyn_smem, toff_s); \
    GSYNC();                                                 \
    phase_moe2_impl(pp, opq(LV), bid, nb, dyn_smem, toff_s); \
    GSYNC();                                                 \
    phase_combine(pp, opq(LV), bid, nb);                     \
    if (!(LAST)) GSYNC();                                    \
  }
  LAYER(0, false)
  LAYER(1, true)
#undef LAYER
#undef GSYNC
#undef bid
#undef nb
#undef pp
}

#undef p
extern "C" void kernel_launch(void* const* d_in, const int* in_sizes, int n_in, void* d_out, int out_size, void* d_ws,
                              size_t ws_size, hipStream_t stream) {
  Params hp{};
  const float** pp = (const float**)&hp;
  for (int i = 0; i < 34; ++i) pp[i] = (const float*)d_in[i];
  hp.out = (float*)d_out;
  hp.ws = (char*)d_ws;
  static int grid_blocks = 0;
  if (!grid_blocks) {
    (void)hipFuncSetAttribute((const void*)mega, hipFuncAttributeMaxDynamicSharedMemorySize, LDS_BYTES);
    int dev = 0, cus = 0, per_cu = 0;
    (void)hipGetDevice(&dev);
    (void)hipDeviceGetAttribute(&cus, hipDeviceAttributeMultiprocessorCount, dev);
    (void)hipOccupancyMaxActiveBlocksPerMultiprocessor(&per_cu, mega, NTHR, LDS_BYTES);
    if (per_cu < 1) per_cu = 1;
    if (per_cu > 1) per_cu = 1;
    grid_blocks = cus * per_cu;
  }
  void* args[] = {&hp};
  (void)hipLaunchCooperativeKernel((void*)mega, dim3(grid_blocks), dim3(NTHR), args, LDS_BYTES, stream);
}
```

```cpp
#include <hip/hip_runtime.h>
#include <hip/hip_bf16.h>
#include <hip/hip_cooperative_groups.h>
#include <stdint.h>
#include <type_traits>
namespace cg = cooperative_groups;

typedef __attribute__((ext_vector_type(8))) short bf16x8;
typedef __attribute__((ext_vector_type(4))) short bf16x4;
typedef __attribute__((ext_vector_type(4))) float f32x4;
typedef __attribute__((ext_vector_type(4))) int i32x4;
typedef unsigned short bfr;

#define D_MODEL 1024
#define NB 2
#define SEQ 16384
#define CTXL 256
#define NLAT (NB * SEQ)
#define NCTX (NB * CTXL)
#define NTOK (NLAT + NCTX)
#define TTOK (SEQ + CTXL)
#define PIN 3472
#define PINP 3584
#define A_END 1536
#define B_END 2432
#define NEXP 32
#define NSLOT_MAX (NTOK * 4 + NEXP * 256)
#define NTHR 512
#define LDS_BYTES (147456 + 512)

constexpr size_t al256(size_t x) { return (x + 255) & ~(size_t)255; }
constexpr size_t WL_IN = 0;
constexpr size_t WL_OUT = WL_IN + (size_t)PINP * 1024 * 2;
constexpr size_t WL_GU = WL_OUT + (size_t)1024 * 1024 * 2;
constexpr size_t WL_DN = WL_GU + (size_t)32 * 2048 * 1024 * 2;
constexpr size_t WL_SIZE = WL_DN + (size_t)32 * 1024 * 1024 * 2;
constexpr size_t OFF_W = 0;
constexpr size_t OFF_MODS = al256(OFF_W + 2 * WL_SIZE);
constexpr size_t OFF_BAR = al256(OFF_MODS + 2 * 3 * 6144 * 4);
constexpr size_t OFF_SW = al256(OFF_BAR + 3456 * 4);
constexpr size_t OFF_SWIN = al256(OFF_SW + (size_t)2 * 32 * 2048 * 4);
constexpr size_t OFF_SLS = al256(OFF_SWIN + (size_t)2 * PINP * 4);
constexpr size_t OFF_SCL = al256(OFF_SLS + (size_t)(NTOK * 4 + 32 * 256) * 4);
constexpr size_t OFF_CTX = al256(OFF_SCL + (size_t)NTOK * 4);
constexpr size_t OFF_CNT = al256(OFF_CTX + (size_t)NCTX * 1024 * 4);
constexpr size_t OFF_TOKE = al256(OFF_CNT + 256);
constexpr size_t OFF_TOKP = al256(OFF_TOKE + (size_t)NTOK * 4 * 4);
constexpr size_t OFF_TOKG = al256(OFF_TOKP + (size_t)NTOK * 4 * 4);
constexpr size_t OFF_TOKS = al256(OFF_TOKG + (size_t)NTOK * 4 * 4);
constexpr size_t OFF_SLT = al256(OFF_TOKS + (size_t)NTOK * 4 * 4);
constexpr size_t OFF_SLG = al256(OFF_SLT + (size_t)NSLOT_MAX * 4);
constexpr size_t OFF_H = al256(OFF_SLG + (size_t)NSLOT_MAX * 4);
constexpr size_t OFF_CC = al256(OFF_H + (size_t)NTOK * 1024 * 2);
constexpr size_t OFF_P = al256(OFF_CC + (size_t)NTOK * 1024 * 2);
constexpr size_t OFF_S = al256(OFF_P + (size_t)NTOK * PINP * 4);
constexpr size_t TOK256F = (size_t)NTOK * 256 * 4;
constexpr size_t S_QN = 0;
constexpr size_t S_KN = S_QN + (size_t)NTOK * 512 * 2;
constexpr size_t S_VT = S_KN + (size_t)NTOK * 512 * 2;
constexpr size_t S_RWR = S_VT + (size_t)NB * 8 * 64 * TTOK * 2;
constexpr size_t S_RWKK = S_RWR + TOK256F;
constexpr size_t S_RWV = S_RWKK + TOK256F;
constexpr size_t S_RWG = S_RWV + TOK256F;
constexpr size_t S_RWW = S_RWG + TOK256F;
constexpr size_t S_RWKD = S_RWW + 2 * TOK256F;
constexpr size_t S_RWB = S_RWKD + 2 * TOK256F;
constexpr size_t S_BON = S_RWB + 2 * TOK256F;
constexpr size_t S_GDQ = al256(S_BON + (size_t)NTOK * 4 * 4);
constexpr size_t S_GDK = S_GDQ + TOK256F;
constexpr size_t S_GDV = S_GDK + TOK256F;
constexpr size_t S_GDAB = S_GDV + TOK256F;
constexpr size_t S_YRW = al256(S_GDAB + (size_t)NTOK * 16 * 4);
constexpr size_t S_YGD = S_YRW + 2 * TOK256F;
constexpr size_t S_END = S_YGD + 2 * TOK256F;
constexpr size_t S_SIZE = (S_END > (size_t)NSLOT_MAX * 1024 * 4) ? S_END : (size_t)NSLOT_MAX * 1024 * 4;
constexpr int NCHUNK = TTOK / 64;
constexpr int NCHAIN = 32;
constexpr size_t OFF_CH = al256(OFF_S + S_SIZE);
constexpr size_t CH_N = (size_t)NCHAIN * NCHUNK;
constexpr size_t CH_REC = 32768, CH_PT = 0, CH_RYT = 8192, CH_QT = 16384, CH_YX = 24576;
constexpr size_t CH_SIZE = CH_N * CH_REC;
constexpr size_t WS_TOTAL = OFF_CH + CH_SIZE;
static_assert(WS_TOTAL <= (size_t)2048 * 1024 * 1024, "workspace exceeds 4x largest tensor");

struct Params {
  const float *x, *c, *ctx, *c_ctx, *ada_w, *ada_b, *norm_mix_g, *norm_ffn_g, *w_in, *w_out;
  const float *na_q_gain, *na_k_gain, *na_rpb;
  const float *rw_mu, *rw_w0, *rw_w_up, *rw_a0, *rw_a_up, *rw_g_up, *rw_k_k, *rw_k_a, *rw_r_k, *rw_ln_w, *rw_ln_b;
  const float *gd_conv_w, *gd_A_log, *gd_dt_bias, *gd_norm_g;
  const float *moe_router_w, *moe_router_b, *moe_w_gu, *moe_b_gu, *moe_w_down, *moe_b_down;
  float* out;
  char* ws;
};

typedef const __attribute__((address_space(4))) Params* PP;
#define p (*pp)
__device__ __forceinline__ char* fresh_ws(PP pp) { return p.ws; }
__device__ __forceinline__ int tid_opaque() { int t = (int)__builtin_amdgcn_workitem_id_x(); asm volatile("" : "+v"(t)); return t; }
__device__ __forceinline__ int opq(int x) { asm volatile("" : "+s"(x)); return x; }
__device__ __forceinline__ int wave_id(int tid) { return __builtin_amdgcn_readfirstlane(tid >> 6); }
typedef __bf16 bf16v2_t __attribute__((ext_vector_type(2)));
typedef float f32v2_t __attribute__((ext_vector_type(2)));
__device__ __forceinline__ unsigned pk_bf16(float lo, float hi) { f32v2_t v = {lo, hi}; return __builtin_bit_cast(unsigned, __builtin_convertvector(v, bf16v2_t)); }
__device__ __forceinline__ bfr f2bf(float f) { return (bfr)(pk_bf16(f, f) & 0xffffu); }
__device__ __forceinline__ float bf2f(short v) { return __uint_as_float(((unsigned)(unsigned short)v) << 16); }
__device__ __forceinline__ bf16x4 pack4(float a, float b, float c, float d) {
  typedef __attribute__((ext_vector_type(2))) unsigned u32x2;
  u32x2 w; w[0] = pk_bf16(a, b); w[1] = pk_bf16(c, d);
  return __builtin_bit_cast(bf16x4, w);
}
__device__ __forceinline__ float sigmoidf_(float x) { return __builtin_amdgcn_rcpf(1.f + __expf(-x)); }
__device__ __forceinline__ float siluf_(float x) { return x * __builtin_amdgcn_rcpf(1.f + __expf(-x)); }
__device__ __forceinline__ float softplusf_(float x) { const float e = __expf(x); return x > 20.f ? x : (x < -15.f ? e : __logf(1.f + e)); }
__device__ __forceinline__ float wave_sum(float v) {
  v += __builtin_bit_cast(float, __builtin_amdgcn_update_dpp(0, __builtin_bit_cast(int, v), 0xB1, 0xF, 0xF, true));
  v += __builtin_bit_cast(float, __builtin_amdgcn_update_dpp(0, __builtin_bit_cast(int, v), 0x4E, 0xF, 0xF, true));
  v += __builtin_bit_cast(float, __builtin_amdgcn_update_dpp(0, __builtin_bit_cast(int, v), 0x141, 0xF, 0xF, true));
  v += __builtin_bit_cast(float, __builtin_amdgcn_update_dpp(0, __builtin_bit_cast(int, v), 0x140, 0xF, 0xF, true));
  v += __builtin_bit_cast(float, __builtin_amdgcn_update_dpp(0, __builtin_bit_cast(int, v), 0x142, 0xA, 0xF, false));
  v += __builtin_bit_cast(float, __builtin_amdgcn_update_dpp(0, __builtin_bit_cast(int, v), 0x143, 0xC, 0xF, false));
  return __builtin_bit_cast(float, __builtin_amdgcn_readlane(__builtin_bit_cast(int, v), 63));
}
__device__ __forceinline__ float wave_max(float v) {
  v = fmaxf(v, __builtin_bit_cast(float, __builtin_amdgcn_update_dpp(0, __builtin_bit_cast(int, v), 0xB1, 0xF, 0xF, true)));
  v = fmaxf(v, __builtin_bit_cast(float, __builtin_amdgcn_update_dpp(0, __builtin_bit_cast(int, v), 0x4E, 0xF, 0xF, true)));
  v = fmaxf(v, __builtin_bit_cast(float, __builtin_amdgcn_update_dpp(0, __builtin_bit_cast(int, v), 0x141, 0xF, 0xF, true)));
  v = fmaxf(v, __builtin_bit_cast(float, __builtin_amdgcn_update_dpp(0, __builtin_bit_cast(int, v), 0x140, 0xF, 0xF, true)));
  const float r1 = __builtin_bit_cast(float, __builtin_amdgcn_readlane(__builtin_bit_cast(int, v), 0));
  const float r2 = __builtin_bit_cast(float, __builtin_amdgcn_readlane(__builtin_bit_cast(int, v), 16));
  const float r3 = __builtin_bit_cast(float, __builtin_amdgcn_readlane(__builtin_bit_cast(int, v), 32));
  const float r4 = __builtin_bit_cast(float, __builtin_amdgcn_readlane(__builtin_bit_cast(int, v), 48));
  return fmaxf(fmaxf(r1, r2), fmaxf(r3, r4));
}
__device__ __forceinline__ float shfl_xor_l(float v, int mask, int lane) {
  return __builtin_bit_cast(float, __builtin_amdgcn_ds_bpermute((lane ^ mask) << 2, __builtin_bit_cast(int, v)));
}
__device__ __forceinline__ int shfl_xor_li(int v, int mask, int lane) {
  return __builtin_amdgcn_ds_bpermute((lane ^ mask) << 2, v);
}
__device__ __forceinline__ float row16_sum(float v) {
  v += __builtin_bit_cast(float, __builtin_amdgcn_update_dpp(0, __builtin_bit_cast(int, v), 0xB1, 0xF, 0xF, true));
  v += __builtin_bit_cast(float, __builtin_amdgcn_update_dpp(0, __builtin_bit_cast(int, v), 0x4E, 0xF, 0xF, true));
  v += __builtin_bit_cast(float, __builtin_amdgcn_update_dpp(0, __builtin_bit_cast(int, v), 0x141, 0xF, 0xF, true));
  v += __builtin_bit_cast(float, __builtin_amdgcn_update_dpp(0, __builtin_bit_cast(int, v), 0x140, 0xF, 0xF, true));
  return v;
}
__device__ __forceinline__ float quant_row_store(const float4 (&v)[4], signed char* dst_row, int lane) {
  float am = 0.f;
#pragma unroll
  for (int i = 0; i < 4; ++i) am = fmaxf(fmaxf(am, fmaxf(fabsf(v[i].x), fabsf(v[i].y))), fmaxf(fabsf(v[i].z), fabsf(v[i].w)));
  am = wave_max(am);
  const float sc = am > 0.f ? am * (1.f / 127.f) : 1.f, iv = 1.f / sc;
#pragma unroll
  for (int i = 0; i < 4; ++i) {
    const int q0 = (int)fminf(fmaxf(rintf(v[i].x * iv), -127.f), 127.f), q1 = (int)fminf(fmaxf(rintf(v[i].y * iv), -127.f), 127.f);
    const int q2 = (int)fminf(fmaxf(rintf(v[i].z * iv), -127.f), 127.f), q3 = (int)fminf(fmaxf(rintf(v[i].w * iv), -127.f), 127.f);
    *(unsigned*)(dst_row + (lane + 64 * i) * 4) = (unsigned)(q0 & 0xff) | ((unsigned)(q1 & 0xff) << 8) | ((unsigned)(q2 & 0xff) << 16) | ((unsigned)(q3 & 0xff) << 24);
  }
  return sc;
}
__device__ __forceinline__ int mod_row(int m) { return m < NLAT ? (m >> 14) : 2; }

__device__ __forceinline__ void phase_ada(PP pp, int bid, int nb, char* smem) {
  float* red = (float*)smem;
  float* mods = (float*)(p.ws + OFF_MODS);
  const int tid = tid_opaque();
  for (int task = bid; task < 2 * 96; task += nb) {
    int l = task / 96, cgp = task % 96;
    int col = cgp * 64 + (tid & 63), ks = tid >> 6;
    const float* W = p.ada_w + (size_t)l * 1024 * 6144;
    float a0 = 0.f, a1 = 0.f, a2 = 0.f;
    for (int d = ks * 128; d < ks * 128 + 128; ++d) {
      float w = W[(size_t)d * 6144 + col];
      a0 += siluf_(p.c[d]) * w;
      a1 += siluf_(p.c[1024 + d]) * w;
      a2 += siluf_(p.c_ctx[d]) * w;
    }
    red[(ks * 3 + 0) * 64 + (tid & 63)] = a0;
    red[(ks * 3 + 1) * 64 + (tid & 63)] = a1;
    red[(ks * 3 + 2) * 64 + (tid & 63)] = a2;
    __syncthreads();
    if (tid < 192) {
      int r = tid >> 6, cc = tid & 63;
      float s = 0.f;
      for (int k = 0; k < 8; ++k) s += red[(k * 3 + r) * 64 + cc];
      mods[(size_t)(l * 3 + r) * 6144 + cgp * 64 + cc] = s + p.ada_b[(size_t)l * 6144 + cgp * 64 + cc];
    }
    __syncthreads();
  }
}

__device__ __forceinline__ void convert_tile(const float* src, int N, bfr* dst, int kt, int nt, int mode, float* tile  ) {
  const int tid = tid_opaque();
#pragma unroll
  for (int q = 0; q < 2; ++q) {
    int idx = tid + q * 512;
    int kk = idx >> 4, n4 = idx & 15;
    int n = nt * 64 + n4 * 4;
    float4 v = make_float4(0.f, 0.f, 0.f, 0.f);
    if (n < N) v = *(const float4*)(src + (size_t)(kt * 64 + kk) * N + n);
    tile[kk * 65 + n4 * 4 + 0] = v.x;
    tile[kk * 65 + n4 * 4 + 1] = v.y;
    tile[kk * 65 + n4 * 4 + 2] = v.z;
    tile[kk * 65 + n4 * 4 + 3] = v.w;
  }
  __syncthreads();
  {
    int nn = tid >> 3, kc = tid & 7;
    int n = nt * 64 + nn;
    int row = n;
    if (mode == 1) { int j = n & 1023; row = (j >> 4) * 32 + (j & 15) + ((n >= 1024) ? 16 : 0); }
    bf16x8 o;
#pragma unroll
    for (int j = 0; j < 8; ++j) o[j] = (short)f2bf(tile[(kc * 8 + j) * 65 + nn]);
    *(bf16x8*)(dst + (size_t)row * 1024 + kt * 64 + kc * 8) = o;
  }
  __syncthreads();
}
template <int N, bool INTERLEAVE>
__device__ __forceinline__ void convert_i8(const float* src  , signed char* dst  , float* sw, int ng, char* smem) {
  const int tid = tid_opaque();
  bfr* blk = (bfr*)smem;
  int* cmax = (int*)(smem + 131072);
  if (tid < 64) cmax[tid] = 0;
  __syncthreads();
  {
    const int n4 = tid & 15, kk0 = tid >> 4;
    float m0 = 0.f, m1 = 0.f, m2 = 0.f, m3 = 0.f;
#pragma unroll 4
    for (int ps = 0; ps < 32; ++ps) {
      const int k = ps * 32 + kk0;
      float4 v = make_float4(0.f, 0.f, 0.f, 0.f);
      if (ng * 64 + n4 * 4 < N) v = *(const float4*)(src + (size_t)k * N + ng * 64 + n4 * 4);
      m0 = fmaxf(m0, fabsf(v.x)); m1 = fmaxf(m1, fabsf(v.y)); m2 = fmaxf(m2, fabsf(v.z)); m3 = fmaxf(m3, fabsf(v.w));
      *(bf16x4*)(blk + k * 64 + n4 * 4) = pack4(v.x, v.y, v.z, v.w);
    }
    atomicMax(&cmax[n4 * 4 + 0], __float_as_int(m0)); atomicMax(&cmax[n4 * 4 + 1], __float_as_int(m1));
    atomicMax(&cmax[n4 * 4 + 2], __float_as_int(m2)); atomicMax(&cmax[n4 * 4 + 3], __float_as_int(m3));
  }
  __syncthreads();
  {
    const int nn = tid >> 3, kc = tid & 7;
    const int n = ng * 64 + nn;
    const float am = __int_as_float(cmax[nn]);
    const float sc = am > 0.f ? am * (1.f / 127.f) : 1.f, iv = 1.f / sc;
    const int j = n & 1023;
    const int row = INTERLEAVE ? (j >> 4) * 32 + (j & 15) + ((n >= 1024) ? 16 : 0) : n;
    if (kc == 0) sw[n] = sc;
#pragma unroll 2
    for (int q = 0; q < 8; ++q) {
      const int k0 = (kc + 8 * q) * 16;
      unsigned w[4];
#pragma unroll
      for (int g4 = 0; g4 < 4; ++g4) {
        unsigned acc = 0u;
#pragma unroll
        for (int b = 0; b < 4; ++b) {
          const float v = bf2f((short)blk[(k0 + g4 * 4 + b) * 64 + nn]);
          const int qi = (int)fminf(fmaxf(rintf(v * iv), -127.f), 127.f);
          acc |= ((unsigned)(qi & 0xff)) << (8 * b);
        }
        w[g4] = acc;
      }
      *(uint4*)(dst + (size_t)row * 1024 + k0) = make_uint4(w[0], w[1], w[2], w[3]);
    }
  }
  __syncthreads();
}
__device__ __forceinline__ void phase_convert(PP pp, int l, int part, int bid, int nb, char* smem) {
  float* tile = (float*)smem;
  char* wl = p.ws + OFF_W + (size_t)l * WL_SIZE;
  const int T_IN = 56, T_OUT = 16 * 16, T_GU = 32 * 32, T_DN = 32 * 16 * 16;
  const int t_lo = part == 0 ? 0 : T_IN + T_OUT;
  const int t_hi = part == 0 ? T_IN + T_OUT : T_IN + T_OUT + T_GU + T_DN;
  for (int t = t_lo + bid; t < t_hi; t += nb) {
    if (t < T_IN) {
      convert_i8<PIN, false>(p.w_in + (size_t)l * 1024 * PIN, (signed char*)(wl + WL_IN), (float*)(p.ws + OFF_SWIN) + (size_t)l * PINP, t, smem);
    } else if (t < T_IN + T_OUT) {
      int u = t - T_IN; int kt = u / 16, nt = u % 16;
      convert_tile(p.w_out + (size_t)l * 1024 * 1024, 1024, (bfr*)(wl + WL_OUT), kt, nt, 0, tile);
    } else if (t < T_IN + T_OUT + T_GU) {
      int u = t - T_IN - T_OUT; int e = u / 32, ng = u % 32;
      convert_i8<2048, true>(p.moe_w_gu + ((size_t)l * 32 + e) * 1024 * 2048, (signed char*)(wl + WL_GU) + (size_t)e * 2048 * 1024,
                    (float*)(p.ws + OFF_SW) + ((size_t)l * 32 + e) * 2048, ng, smem);
    } else {
      int u = t - T_IN - T_OUT - T_GU; int e = u / 256; int v = u % 256; int kt = v / 16, nt = v % 16;
      convert_tile(p.moe_w_down + ((size_t)l * 32 + e) * 1024 * 1024, 1024, (bfr*)(wl + WL_DN) + (size_t)e * 1024 * 1024, kt, nt, 0, tile);
    }
  }
}

__device__ __forceinline__ void phase_prenorm(PP pp, int l, int bid, int nb) {
  const int tid = tid_opaque(), lane = tid & 63, wv = wave_id(tid);
  const float* xl = (l == 0) ? p.x : p.out;
  const float* xc = (l == 0) ? p.ctx : (const float*)(p.ws + OFF_CTX);
  const float* mods = (const float*)(p.ws + OFF_MODS) + (size_t)l * 3 * 6144;
  const float* g = p.norm_mix_g + (size_t)l * 1024;
  signed char* H8 = (signed char*)(p.ws + OFF_H);
  float* SCL = (float*)(p.ws + OFF_SCL);
  {
    int* cnt = (int*)(p.ws + OFF_CNT);
    int gt = bid * NTHR + tid;
    if (gt < 32) cnt[gt] = 0;
  }
  for (int m = bid * 8 + wv; m < NTOK; m += nb * 8) {
    const float* xr = (m < NLAT) ? xl + (size_t)m * 1024 : xc + (size_t)(m - NLAT) * 1024;
    const float* md = mods + (size_t)mod_row(m) * 6144;
    float4 v[4];
    float ss = 0.f;
#pragma unroll
    for (int i = 0; i < 4; ++i) {
      v[i] = *(const float4*)(xr + (lane + 64 * i) * 4);
      ss += v[i].x * v[i].x + v[i].y * v[i].y + v[i].z * v[i].z + v[i].w * v[i].w;
    }
    ss = wave_sum(ss);
    float rs = rsqrtf(ss * (1.f / 1024.f) + 1e-6f);
    float4 hq[4];
#pragma unroll
    for (int i = 0; i < 4; ++i) {
      int d = (lane + 64 * i) * 4;
      float4 gg = *(const float4*)(g + d);
      float4 sh = *(const float4*)(md + d);
      float4 sc = *(const float4*)(md + 1024 + d);
      hq[i] = make_float4(v[i].x * rs * gg.x * (1.f + sc.x) + sh.x, v[i].y * rs * gg.y * (1.f + sc.y) + sh.y,
                          v[i].z * rs * gg.z * (1.f + sc.z) + sh.z, v[i].w * rs * gg.w * (1.f + sc.w) + sh.w);
    }
    const float qs = quant_row_store(hq, H8 + (size_t)m * 1024, lane);
    if (lane == 0) SCL[m] = qs;
  }
}

#define LAS __attribute__((address_space(3)))
namespace g8 {
constexpr int BM = 256, BK = 64, HALF = 128, HTB = HALF * BK * 2, STAGE_BYTES = 8 * HTB, KD = 1024;
__device__ __forceinline__ int lds_byte(int r, int c) { const int st = (r >> 4) * 2 + (c >> 5), rr = r & 15, cc = c & 31, ob = rr * 64 + cc * 2; return st * 1024 + (ob ^ (((ob >> 9) & 1) << 5)); }
__device__ __forceinline__ void stage_rc(int b, int& R, int& C) { const int st = b / 1024, sb = b % 1024, swz = sb ^ (((sb >> 9) & 1) << 5); R = (st >> 1) * 16 + swz / 64; C = (st & 1) * 32 + (swz % 64) / 2; }
struct GUnit { int pm, pn, brow0, e; };
__device__ __forceinline__ int unit_index(int i, int c, int G, int total) {
  const int x = c & 7, j = c >> 3, q = total >> 3, r = total & 7;
  const int start = x < r ? x * (q + 1) : r * (q + 1) + (x - r) * q;
  const int size = q + (x < r ? 1 : 0);
  const int li = i * (G >> 3) + j;
  return li < size ? start + li : -1;
}

__device__ __forceinline__ f32x4 mma16(bf16x8 a, bf16x8 b, f32x4 c) { return __builtin_amdgcn_mfma_f32_16x16x32_bf16(a, b, c, 0, 0, 0); }
__device__ __forceinline__ i32x4 mma16(i32x4 a, i32x4 b, i32x4 c) { return __builtin_amdgcn_mfma_i32_16x16x64_i8(a, b, c, 0, 0, 0); }
template <bool I8, class Sched, class Epi>
__device__ __forceinline__ void gemm_stream(LAS unsigned char* lds, const void* Abase, const void* Btbase, const Sched& S, const Epi& E) {
  typedef typename std::conditional<I8, i32x4, f32x4>::type AccT;
  typedef typename std::conditional<I8, i32x4, bf16x8>::type FragT;
  constexpr int KB = I8 ? KD : KD * 2;
  const int tid = tid_opaque(), wid = __builtin_amdgcn_readfirstlane(tid >> 6), lane = tid & 63, wr = wid >> 2, wc = wid & 3, fr = lane & 15, fq = lane >> 4;
  constexpr int nt = KB / 128;
  int R[2], C[2];
  unsigned voffB[2];
#pragma unroll
  for (int i = 0; i < 2; ++i) { stage_rc(tid * 16 + i * 8192, R[i], C[i]); voffB[i] = (unsigned)(R[i] * KB + C[i] * 2); }
#define voffA voffB
  constexpr size_t kstep = (size_t)(BK * 2);
  constexpr size_t hstep = (size_t)HALF * KB;
  const unsigned ldsw = (unsigned)wid * 1024u;
  const int aoff = lds_byte(wr * 64 + fr, fq * 8), boff = lds_byte(wc * 32 + fr, fq * 8);
#define G8_SA(b, h) (((b) * 2 + (h)) * HTB)
#define G8_SB(b, h) ((4 + (b) * 2 + (h)) * HTB)
#define G8_STAGE(bufoff, gbase, v0, v1) do { \
    __builtin_amdgcn_global_load_lds((const unsigned*)((const char*)(gbase) + (v0)), (LAS unsigned*)(lds + (bufoff) + ldsw), 16, 0, 0); \
    __builtin_amdgcn_global_load_lds((const unsigned*)((const char*)(gbase) + (v1)), (LAS unsigned*)(lds + (bufoff) + ldsw + 8192), 16, 0, 0); } while (0)
#define G8_STAGEB(bufoff, gbase) G8_STAGE(bufoff, gbase, voffB[0], voffB[1])
#define G8_STAGEA(bufoff, gbase) G8_STAGE(bufoff, gbase, voffA[0], voffA[1])
#define G8_LDA(dst, b, h) do { _Pragma("unroll") for (int m = 0; m < 4; ++m) _Pragma("unroll") for (int k = 0; k < 2; ++k) dst[m][k] = *(const LAS FragT*)(lds + G8_SA(b, h) + aoff + m * 2048 + k * 1024); } while (0)
#define G8_LDB(dst, b, h) do { _Pragma("unroll") for (int n = 0; n < 2; ++n) _Pragma("unroll") for (int k = 0; k < 2; ++k) dst[n][k] = *(const LAS FragT*)(lds + G8_SB(b, h) + boff + n * 2048 + k * 1024); } while (0)
#define G8_MMA(ai, bj, At, Bt) do { __builtin_amdgcn_s_setprio(1); _Pragma("unroll") for (int m = 0; m < 4; ++m) _Pragma("unroll") for (int n = 0; n < 2; ++n) _Pragma("unroll") for (int k = 0; k < 2; ++k) \
    acc[ai][bj][m][n] = mma16(Bt[n][k], At[m][k], acc[ai][bj][m][n]); __builtin_amdgcn_s_setprio(0); } while (0)
#define G8_WAIT_V(n) asm volatile("s_waitcnt vmcnt(" #n ")" ::: "memory")
#define G8_WAIT_L(n) asm volatile("s_waitcnt lgkmcnt(" #n ")" ::: "memory")
#define G8_BAR __builtin_amdgcn_s_barrier()
#define G8_SCHED __builtin_amdgcn_sched_barrier(0)
  GUnit cur, nxt;
  int ui = 0;
  if (!S.next(0, cur)) return;
  AccT acc[2][2][4][2];
#pragma unroll
  for (int a = 0; a < 2; ++a)
#pragma unroll
    for (int b = 0; b < 2; ++b)
#pragma unroll
      for (int m = 0; m < 4; ++m)
#pragma unroll
        for (int n = 0; n < 2; ++n) acc[a][b][m][n] = AccT{};
  FragT At[4][2], B0[2][2], B1[2][2];
  const char* cA = (const char*)Abase + (size_t)cur.pm * (BM * KB);
  const char* cB = (const char*)Btbase + (size_t)cur.brow0 * KB;
  G8_STAGEB(G8_SB(0, 0), cB); G8_STAGEA(G8_SA(0, 0), cA); G8_STAGEB(G8_SB(0, 1), cB + hstep); G8_STAGEA(G8_SA(0, 1), cA + hstep);
  if (wr == 1) G8_BAR;
  G8_WAIT_V(4); G8_BAR;
  G8_STAGEB(G8_SB(1, 0), cB + kstep); G8_STAGEA(G8_SA(1, 0), cA + kstep); G8_STAGEB(G8_SB(1, 1), cB + hstep + kstep);
  G8_WAIT_V(6); G8_BAR;
  for (;;) {
    const bool has_next = S.next(ui + 1, nxt);
    const char* nA = has_next ? (const char*)Abase + (size_t)nxt.pm * (BM * KB) : cA;
    const char* nB = has_next ? (const char*)Btbase + (size_t)nxt.brow0 * KB : cB;
#pragma unroll 1
    for (int t = 0; t < nt; t += 2) {
      const bool last = (t == nt - 2);
      const char* a1 = cA + (size_t)(t + 1) * kstep;
      const char* a2 = last ? nA : cA + (size_t)(t + 2) * kstep;
      const char* b2 = last ? nB : cB + (size_t)(t + 2) * kstep;
      const char* a3 = a2 + kstep;
      const char* b3 = b2 + kstep;
      G8_LDB(B0, 0, 0); G8_SCHED; G8_LDA(At, 0, 0); G8_STAGEA(G8_SA(1, 1), a1 + hstep);
      G8_WAIT_L(8); G8_BAR; G8_WAIT_L(0); G8_MMA(0, 0, At, B0); G8_BAR; G8_SCHED;
      G8_LDB(B1, 0, 1); G8_STAGEB(G8_SB(0, 0), b2);
      G8_BAR; G8_WAIT_L(0); G8_MMA(0, 1, At, B1); G8_BAR;
      G8_LDA(At, 0, 1); G8_STAGEA(G8_SA(0, 0), a2);
      G8_BAR; G8_WAIT_L(0); G8_MMA(1, 0, At, B0); G8_BAR; G8_SCHED;
      G8_STAGEB(G8_SB(0, 1), b2 + hstep);
      G8_WAIT_V(6); G8_BAR; G8_MMA(1, 1, At, B1); G8_BAR;
      G8_LDB(B0, 1, 0); G8_SCHED; G8_LDA(At, 1, 0); G8_STAGEA(G8_SA(0, 1), a2 + hstep);
      G8_WAIT_L(8); G8_BAR; G8_WAIT_L(0); G8_MMA(0, 0, At, B0); G8_BAR; G8_SCHED;
      G8_LDB(B1, 1, 1); G8_STAGEB(G8_SB(1, 0), b3);
      G8_BAR; G8_WAIT_L(0); G8_MMA(0, 1, At, B1); G8_BAR;
      G8_LDA(At, 1, 1); G8_STAGEA(G8_SA(1, 0), a3);
      G8_BAR; G8_WAIT_L(0); G8_MMA(1, 0, At, B0); G8_BAR; G8_SCHED;
      G8_STAGEB(G8_SB(1, 1), b3 + hstep);
      G8_WAIT_V(6); G8_BAR; G8_MMA(1, 1, At, B1); G8_BAR;
    }
    E(acc, cur, wr, wc, fr, fq);
    if (!has_next) break;
#pragma unroll
    for (int a = 0; a < 2; ++a)
#pragma unroll
      for (int b = 0; b < 2; ++b)
#pragma unroll
        for (int m = 0; m < 4; ++m)
#pragma unroll
          for (int n = 0; n < 2; ++n) acc[a][b][m][n] = AccT{};
    cur = nxt; cA = nA; cB = nB; ++ui;
  }
  G8_WAIT_V(0);
  if (wr == 0) G8_BAR;
  G8_BAR;
#undef G8_SA
#undef G8_SB
#undef G8_STAGE
#undef G8_STAGEB
#undef G8_STAGEA
#undef voffA
#undef G8_LDA
#undef G8_LDB
#undef G8_MMA
#undef G8_WAIT_V
#undef G8_WAIT_L
#undef G8_BAR
#undef G8_SCHED
}

struct DenseSched {
  int nM, nN, G, c;
  __device__ __forceinline__ bool next(int i, GUnit& u) const {
    const int idx = unit_index(i, c, G, nM * nN);
    if (idx < 0) return false;
    u.pm = idx / nN; u.pn = idx - u.pm * nN; u.brow0 = u.pn * BM; u.e = 0;
    return true;
  }
};
struct MoeSched {
  const int* toff; int nN, NE, G, c;
  __device__ __forceinline__ bool next(int i, GUnit& u) const {
    const int idx = unit_index(i, c, G, toff[32] * nN);
    if (idx < 0) return false;
    u.pm = idx / nN; u.pn = idx - u.pm * nN;
    int e = 0;
#pragma unroll 1
    for (int k = 1; k < 32; ++k) e = (u.pm >= toff[k]) ? k : e;
    u.e = e; u.brow0 = e * NE + u.pn * BM;
    return true;
  }
};
}

struct EpiInProj {
  float* P; const float* SCL; const float* sw;
  __device__ __forceinline__ void operator()(const i32x4 (&acc)[2][2][4][2], const g8::GUnit& u, int wr, int wc, int fr, int fq) const {
    const int row0 = u.pm * 256 + wr * 64 + fr, col0 = u.pn * 256 + wc * 32 + 4 * fq;
    f32x4 cs[2][2];
#pragma unroll
    for (int bj = 0; bj < 2; ++bj)
#pragma unroll
      for (int n = 0; n < 2; ++n) cs[bj][n] = *(const f32x4*)(sw + col0 + bj * 128 + n * 16);
    float sav[2][4];
#pragma unroll
    for (int ai = 0; ai < 2; ++ai)
#pragma unroll
      for (int m = 0; m < 4; ++m) sav[ai][m] = SCL[row0 + ai * 128 + m * 16];
#pragma unroll
    for (int ai = 0; ai < 2; ++ai)
#pragma unroll
      for (int m = 0; m < 4; ++m) {
        const int row = row0 + ai * 128 + m * 16;
        const float sa = sav[ai][m];
        float* rowp = P + (size_t)row * PINP + col0;
#pragma unroll
        for (int bj = 0; bj < 2; ++bj)
#pragma unroll
          for (int n = 0; n < 2; ++n) {
            const i32x4 a = acc[ai][bj][m][n];
            f32x4 o = {(float)a[0], (float)a[1], (float)a[2], (float)a[3]};
            *(f32x4*)(rowp + bj * 128 + n * 16) = o * (cs[bj][n] * sa);
          }
      }
  }
};
__device__ __forceinline__ void phase_gemm_in(PP pp, int l, int bid, int nb, char* smem) {
  g8::DenseSched S{130, 14, nb, bid};
  EpiInProj E{(float*)(p.ws + OFF_P), (const float*)(p.ws + OFF_SCL), (const float*)(p.ws + OFF_SWIN) + (size_t)l * PINP};
  g8::gemm_stream<true>((LAS unsigned char*)smem, p.ws + OFF_H, p.ws + OFF_W + (size_t)l * WL_SIZE + WL_IN, S, E);
}

struct EpiOutProj {
  const float *xl, *xc, *mods; float *ol, *oc;
  __device__ __forceinline__ void operator()(const f32x4 (&acc)[2][2][4][2], const g8::GUnit& u, int wr, int wc, int fr, int fq) const {
    const bool lat = u.pm < 128;
    const float* xin = lat ? xl + (size_t)u.pm * 256 * 1024 : xc + (size_t)(u.pm - 128) * 256 * 1024;
    float* xo = lat ? ol + (size_t)u.pm * 256 * 1024 : oc + (size_t)(u.pm - 128) * 256 * 1024;
    const float* g1 = mods + (size_t)(lat ? (u.pm >> 6) : 2) * 6144 + 2048;
    const int row0 = wr * 64 + fr, col0 = u.pn * 256 + wc * 32 + 4 * fq;
#pragma unroll
    for (int bj = 0; bj < 2; ++bj)
#pragma unroll
      for (int n = 0; n < 2; ++n) {
        const f32x4 gv = *(const f32x4*)(g1 + col0 + bj * 128 + n * 16);
        f32x4 xv[2][4];
#pragma unroll
        for (int ai = 0; ai < 2; ++ai)
#pragma unroll
          for (int m = 0; m < 4; ++m) xv[ai][m] = *(const f32x4*)(xin + (size_t)(row0 + ai * 128 + m * 16) * 1024 + col0 + bj * 128 + n * 16);
#pragma unroll
        for (int ai = 0; ai < 2; ++ai)
#pragma unroll
          for (int m = 0; m < 4; ++m)
            *(f32x4*)(xo + (size_t)(row0 + ai * 128 + m * 16) * 1024 + col0 + bj * 128 + n * 16) = xv[ai][m] + gv * acc[ai][bj][m][n];
        asm volatile("" ::: "memory");
      }
  }
};
__device__ __forceinline__ void phase_gemm_out(PP pp, int l, int bid, int nb, char* smem) {
  g8::DenseSched S{(l == 0) ? 130 : 128, 4, nb, bid};
  EpiOutProj E{(l == 0) ? p.x : p.out, (l == 0) ? p.ctx : (const float*)(p.ws + OFF_CTX),
               (const float*)(p.ws + OFF_MODS) + (size_t)l * 3 * 6144, p.out, (float*)(p.ws + OFF_CTX)};
  g8::gemm_stream<false>((LAS unsigned char*)smem, p.ws + OFF_CC, p.ws + OFF_W + (size_t)l * WL_SIZE + WL_OUT, S, E);
}

#define LBAR() do { asm volatile("s_waitcnt lgkmcnt(0)" ::: "memory"); __builtin_amdgcn_s_barrier(); asm volatile("" ::: "memory"); } while (0)
__device__ __forceinline__ void phase_prep(PP pp, int l, int bid, int nb, char* smem) {
  const int tid = tid_opaque(), lane = tid & 63, wv = wave_id(tid);
  const float* P = (const float*)(p.ws + OFF_P);
  char* S = p.ws + OFF_S;
  bfr* QN = (bfr*)(S + S_QN);
  bfr* KN = (bfr*)(S + S_KN);
  bfr* VT = (bfr*)(S + S_VT);
  float* RWR = (float*)(S + S_RWR);
  float* RWKK = (float*)(S + S_RWKK);
  float* RWV = (float*)(S + S_RWV);
  float* RWG = (float*)(S + S_RWG);
  float* RWW = (float*)(S + S_RWW);
  float* RWKD = (float*)(S + S_RWKD);
  float* RWB = (float*)(S + S_RWB);
  float* BON = (float*)(S + S_BON);
  float* GDQ = (float*)(S + S_GDQ);
  float* GDK = (float*)(S + S_GDK);
  float* GDV = (float*)(S + S_GDV);
  float* GDAB = (float*)(S + S_GDAB);
  const float* mu = p.rw_mu + (size_t)l * 896;
  const float* w0 = p.rw_w0 + (size_t)l * 512;
  const float* w_up = p.rw_w_up + (size_t)l * 2 * 32 * 256;
  const float* a0 = p.rw_a0 + (size_t)l * 512;
  const float* a_up = p.rw_a_up + (size_t)l * 2 * 32 * 256;
  const float* g_up = p.rw_g_up + (size_t)l * 64 * 256;
  const float* k_k = p.rw_k_k + (size_t)l * 256;
  const float* k_a = p.rw_k_a + (size_t)l * 256;
  const float* r_k = p.rw_r_k + (size_t)l * 256;
  const float* conv_w = p.gd_conv_w + (size_t)l * 5 * 768;
  const float* A_log = p.gd_A_log + (size_t)l * 8;
  const float* dt_bias = p.gd_dt_bias + (size_t)l * 8;
  const float* qg = p.na_q_gain + (size_t)l * 64;
  const float* kg = p.na_k_gain + (size_t)l * 64;

  bfr* wl = (bfr*)smem;
  float* lor = (float*)(smem + 192 * 256 * 2);
  __syncthreads();
  for (int i = tid; i < 192 * 256; i += NTHR) {
    const int row = i >> 8, c = i & 255;
    const float v = row < 64 ? g_up[row * 256 + c] : row < 128 ? w_up[(row - 64) * 256 + c] : a_up[(row - 128) * 256 + c];
    wl[i] = f2bf(v);
  }
  __syncthreads();

  for (int tile = bid; tile < NTOK / 16; tile += nb) {
    const int m0 = tile * 16;
    int seq_lo, seq_hi, bb, tau0;
    if (m0 < NLAT) { bb = m0 >> 14; seq_lo = bb << 14; seq_hi = seq_lo + SEQ; tau0 = m0 - seq_lo; }
    else { bb = (m0 - NLAT) >> 8; seq_lo = NLAT + (bb << 8); seq_hi = seq_lo + CTXL; tau0 = SEQ + (m0 - seq_lo); }
    const f32x4 z4 = {0.f, 0.f, 0.f, 0.f};
    int tid_t = tid; asm volatile("" : "+v"(tid_t));
    const int lane_t = tid_t & 63;
    const int cb = lane_t * 4, hh = lane_t >> 4;
    const int lg = tid_t & 31, lt = tid_t >> 5;
    const int sl = lane_t >> 4, sc4 = (lane_t & 15) * 4;
    asm volatile("" ::: "memory");
    const f32x4 mur = *(const f32x4*)(mu + cb), muk = *(const f32x4*)(mu + 256 + cb), muv = *(const f32x4*)(mu + 512 + cb);
    const f32x4 mul = *(const f32x4*)(mu + 768 + lg * 4);

    f32x4 pr[3][4], pl[3];
    {
      const int mt0 = m0 + 2 * wv;
#pragma unroll
      for (int j = 0; j < 3; ++j)
#pragma unroll
        for (int t = 0; t < 4; ++t) {
          const int m = mt0 - 1 + t;
          pr[j][t] = (m >= seq_lo && m < seq_hi) ? *(const f32x4*)(P + (size_t)m * PINP + A_END + j * 256 + cb) : z4;
        }
#pragma unroll
      for (int t = 0; t < 3; ++t) {
        const int m = m0 + lt - 1 + t;
        pl[t] = (m >= seq_lo && m < seq_hi) ? *(const f32x4*)(P + (size_t)m * PINP + A_END + 768 + lg * 4) : z4;
      }
    }
    {
      const f32x4 v = pl[1] + mul * (0.5f * (pl[0] + pl[2]) - pl[1]);
#pragma unroll
      for (int i = 0; i < 4; ++i) {
        const int ch = lg * 4 + i;
        lor[ch * 16 + lt] = ch < 32 ? tanhf(v[i]) : ch < 64 ? v[i] : sigmoidf_(v[i]);
      }
    }
    f32x4 rr[2], rk[2], rv[2];
#pragma unroll
    for (int t = 0; t < 2; ++t) {
      rr[t] = pr[0][t + 1] + mur * (0.5f * (pr[0][t] + pr[0][t + 2]) - pr[0][t + 1]);
      rk[t] = pr[1][t + 1] + muk * (0.5f * (pr[1][t] + pr[1][t + 2]) - pr[1][t + 1]);
      rv[t] = pr[2][t + 1] + muv * (0.5f * (pr[2][t] + pr[2][t + 2]) - pr[2][t + 1]);
    }
    LBAR();
    f32x4 pg[20];
    const bool is_gd = wv < 3, is_na = (wv >= 3 && wv < 7);
    const int sec = is_gd ? wv * 4 + sl : (wv - 3) * 4 + sl;
    if (is_gd) {
#pragma unroll
      for (int t = 0; t < 20; ++t) {
        const int m = m0 - 2 + t;
        pg[t] = (m >= seq_lo && m < seq_hi) ? *(const f32x4*)(P + (size_t)m * PINP + B_END + sec * 64 + sc4) : z4;
      }
    } else if (is_na) {
#pragma unroll
      for (int t = 0; t < 16; ++t) pg[t] = *(const f32x4*)(P + (size_t)(m0 + t) * PINP + sec * 64 + sc4);
#pragma unroll
      for (int t = 16; t < 20; ++t) pg[t] = z4;
    } else {
#pragma unroll
      for (int t = 0; t < 20; ++t) pg[t] = z4;
    }
    asm volatile("" ::: "memory");
    {
      f32x4 gacc[2], wa0[2], wa1[2], aa0[2], aa1[2];
#pragma unroll
      for (int t = 0; t < 2; ++t) { gacc[t] = z4; wa0[t] = z4; wa1[t] = z4; aa0[t] = z4; aa1[t] = z4; }
#pragma unroll 4
      for (int j = 0; j < 64; ++j) {
        const bf16x4 wq = *(const bf16x4*)(wl + j * 256 + cb);
        const f32x4 wgt = {bf2f(wq[0]), bf2f(wq[1]), bf2f(wq[2]), bf2f(wq[3])};
        const float2 sv = *(const float2*)(lor + (64 + j) * 16 + 2 * wv);
        gacc[0] += wgt * sv.x; gacc[1] += wgt * sv.y;
      }
#pragma unroll 2
      for (int j = 0; j < 32; ++j) {
        const bf16x4 q0 = *(const bf16x4*)(wl + (64 + j) * 256 + cb), q1 = *(const bf16x4*)(wl + (96 + j) * 256 + cb);
        const bf16x4 q2 = *(const bf16x4*)(wl + (128 + j) * 256 + cb), q3 = *(const bf16x4*)(wl + (160 + j) * 256 + cb);
        const f32x4 ww0 = {bf2f(q0[0]), bf2f(q0[1]), bf2f(q0[2]), bf2f(q0[3])}, ww1 = {bf2f(q1[0]), bf2f(q1[1]), bf2f(q1[2]), bf2f(q1[3])};
        const f32x4 aw0 = {bf2f(q2[0]), bf2f(q2[1]), bf2f(q2[2]), bf2f(q2[3])}, aw1 = {bf2f(q3[0]), bf2f(q3[1]), bf2f(q3[2]), bf2f(q3[3])};
        const float2 tv = *(const float2*)(lor + j * 16 + 2 * wv);
        const float2 dv = *(const float2*)(lor + (32 + j) * 16 + 2 * wv);
        wa0[0] += ww0 * tv.x; wa0[1] += ww0 * tv.y; wa1[0] += ww1 * tv.x; wa1[1] += ww1 * tv.y;
        aa0[0] += aw0 * dv.x; aa0[1] += aw0 * dv.y; aa1[0] += aw1 * dv.x; aa1[1] += aw1 * dv.y;
      }
      asm volatile("" ::: "memory");
      const f32x4 kkc = *(const f32x4*)(k_k + cb), kac = *(const f32x4*)(k_a + cb), rkc = *(const f32x4*)(r_k + cb);
      const f32x4 w00 = *(const f32x4*)(w0 + cb), w01 = *(const f32x4*)(w0 + 256 + cb), a00 = *(const f32x4*)(a0 + cb), a01 = *(const f32x4*)(a0 + 256 + cb);
#pragma unroll
      for (int t = 0; t < 2; ++t) {
        const int m = m0 + 2 * wv + t;
        const f32x4 r = rr[t], k = rk[t], v = rv[t];
        const f32x4 kkraw = k * kkc;
        const float ssum = row16_sum((kkraw[0] * kkraw[0] + kkraw[1] * kkraw[1]) + (kkraw[2] * kkraw[2] + kkraw[3] * kkraw[3]));
        const f32x4 kk = kkraw * rsqrtf(ssum + 1e-6f);
        float bon = 0.f;
#pragma unroll
        for (int d = 0; d < 2; ++d) {
          const f32x4 wlin = d == 0 ? w00 + wa0[t] : w01 + wa1[t];
          const f32x4 alin = d == 0 ? a00 + aa0[t] : a01 + aa1[t];
          f32x4 lw, kd, bv;
#pragma unroll
          for (int i = 0; i < 4; ++i) {
            const float w_log = -softplusf_(-wlin[i]) - 0.5f;
            const float a = sigmoidf_(alin[i]);
            lw[i] = -__expf(w_log);
            kd[i] = k[i] * (1.f + (a - 1.f) * kac[i]);
            bv[i] = kk[i] * a;
            bon += r[i] * kd[i] * rkc[i];
          }
          const size_t o = ((size_t)d * NTOK + m) * 256 + cb;
          *(f32x4*)(RWW + o) = lw; *(f32x4*)(RWKD + o) = kd; *(f32x4*)(RWB + o) = bv;
        }
        bon = row16_sum(bon);
        const size_t o = (size_t)m * 256 + cb;
        *(f32x4*)(RWR + o) = r; *(f32x4*)(RWKK + o) = kk; *(f32x4*)(RWV + o) = v; *(f32x4*)(RWG + o) = gacc[t];
        if ((lane_t & 15) == 0) BON[(size_t)m * 4 + hh] = bon;
      }
    }
    if (is_gd) {
      f32x4 cw[5];
#pragma unroll
      for (int j = 0; j < 5; ++j) cw[j] = *(const f32x4*)(conv_w + j * 768 + sec * 64 + sc4);
#pragma unroll
      for (int t = 0; t < 16; ++t) {
        f32x4 acc = z4;
#pragma unroll
        for (int j = 0; j < 5; ++j) acc += cw[j] * pg[t + j];
        f32x4 val = {siluf_(acc[0]), siluf_(acc[1]), siluf_(acc[2]), siluf_(acc[3])};
        const int m = m0 + t;
        if (sec < 8) {
          const float ss = row16_sum((val[0] * val[0] + val[1] * val[1]) + (val[2] * val[2] + val[3] * val[3]));
          val = val * rsqrtf(ss + 1e-6f);
          if (sec < 4) *(f32x4*)(GDQ + (size_t)m * 256 + sec * 64 + sc4) = val * 0.125f;
          else *(f32x4*)(GDK + (size_t)m * 256 + (sec - 4) * 64 + sc4) = val;
        } else *(f32x4*)(GDV + (size_t)m * 256 + (sec - 8) * 64 + sc4) = val;
      }
    } else if (is_na) {
      const f32x4 gq = *(const f32x4*)(qg + sc4) * (0.125f * 1.4426950408889634f), gk = *(const f32x4*)(kg + sc4);
#pragma unroll
      for (int t = 0; t < 16; ++t) {
        f32x4 val = pg[t];
        const float ss = row16_sum((val[0] * val[0] + val[1] * val[1]) + (val[2] * val[2] + val[3] * val[3]));
        val = val * rsqrtf(ss * (1.f / 64.f) + 1e-6f);
        const int m = m0 + t;
        if (sec < 8) { const f32x4 o = val * gq; *(bf16x4*)(QN + (size_t)m * 512 + sec * 64 + sc4) = pack4(o[0], o[1], o[2], o[3]); }
        else { const f32x4 o = val * gk; *(bf16x4*)(KN + (size_t)m * 512 + (sec - 8) * 64 + sc4) = pack4(o[0], o[1], o[2], o[3]); }
      }
    }
    if (tid_t < 256) {
      const int t = tid_t >> 4, j = tid_t & 15;
      const int m = m0 + t;
      const float pv = P[(size_t)m * PINP + B_END + 1024 + j];
      float o;
      if (j < 8) o = -__expf(A_log[j]) * softplusf_(pv + dt_bias[j]);
      else o = sigmoidf_(pv);
      GDAB[(size_t)m * 16 + j] = o;
    }
    {
      const int vc = (tid_t & 127) * 4, tq = (tid_t >> 7) * 4;
      f32x4 pv[4];
#pragma unroll
      for (int t = 0; t < 4; ++t) pv[t] = *(const f32x4*)(P + (size_t)(m0 + tq + t) * PINP + 1024 + vc);
#pragma unroll
      for (int i = 0; i < 4; ++i) {
        const int hd = vc + i;
        bfr* dst = VT + ((size_t)(bb * 8 + (hd >> 6)) * (TTOK / 16) + (tau0 >> 4)) * 1024 + (hd & 63) * 16 + tq;
        *(bf16x4*)dst = pack4(pv[0][i], pv[1][i], pv[2][i], pv[3][i]);
      }
    }
    LBAR();
  }
  __syncthreads();
}

__device__ __forceinline__ int scan_tok(int b, int d, int s) {
  if (s < CTXL) { int t = d ? (CTXL - 1 - s) : s; return NLAT + b * CTXL + t; }
  int u = s - CTXL; int t = d ? (SEQ - 1 - u) : u; return b * SEQ + t;
}
#define CS 72
#define SLOT_BYTES (64 * CS * 2)
#define F0_STRIDE 68
#define X1_F0 (13 * SLOT_BYTES)
#define X1_ARR (X1_F0 + 64 * F0_STRIDE * 4)

#define MM_FRAGS(As, Bs, a0, a1, b00, b01, b10, b11)                                                     \
  const bf16x8 a0 = *(const bf16x8*)((As) + ((mt * 16 + fr) * CS + fq * 8) * 2);                         \
  const bf16x8 a1 = *(const bf16x8*)((As) + ((mt * 16 + fr) * CS + 32 + fq * 8) * 2);                    \
  const bf16x8 b00 = *(const bf16x8*)((Bs) + ((nt0 * 16 + fr) * CS + fq * 8) * 2);                       \
  const bf16x8 b01 = *(const bf16x8*)((Bs) + ((nt0 * 16 + fr) * CS + 32 + fq * 8) * 2);                  \
  const bf16x8 b10 = *(const bf16x8*)((Bs) + ((nt0 * 16 + 16 + fr) * CS + fq * 8) * 2);                  \
  const bf16x8 b11 = *(const bf16x8*)((Bs) + ((nt0 * 16 + 16 + fr) * CS + 32 + fq * 8) * 2);
#define MM_2TILES(acc0, acc1, a0, a1, b00, b01, b10, b11)                                                \
  acc0 = __builtin_amdgcn_mfma_f32_16x16x32_bf16(a0, b00, acc0, 0, 0, 0);                                \
  acc0 = __builtin_amdgcn_mfma_f32_16x16x32_bf16(a1, b01, acc0, 0, 0, 0);                                \
  acc1 = __builtin_amdgcn_mfma_f32_16x16x32_bf16(a0, b10, acc1, 0, 0, 0);                                \
  acc1 = __builtin_amdgcn_mfma_f32_16x16x32_bf16(a1, b11, acc1, 0, 0, 0);
__device__ __forceinline__ void wr_T(char* slot, int mt, int nt, int fr, int fq, f32x4 v) {
  *(bf16x4*)(slot + ((nt * 16 + fr) * CS + mt * 16 + 4 * fq) * 2) = pack4(v[0], v[1], v[2], v[3]);
}

struct ChunkIn { float lw[8], f0[8], f1[8], f2[8], f3[8], xv[8], be[8]; };
template <bool GDN>
__device__ __forceinline__ void chunk_load(PP pp, int t, ChunkIn& ci) {
  const int tid = tid_opaque(), c = tid & 63, tg = wave_id(tid);
  const int chain = t / NCHUNK, n = t - chain * NCHUNK;
  const int d = chain & 1, h = (chain >> 1) & 3, b = (chain >> 3) & 1;
  const char* S = p.ws + OFF_S;
#pragma unroll
  for (int u = 0; u < 8; ++u) {
    const int m = scan_tok(b, d, n * 64 + tg * 8 + u);
    const size_t o = (size_t)m * 256 + h * 64 + c;
    if (!GDN) {
      ci.lw[u] = ((const float*)(S + S_RWW))[(size_t)d * NTOK * 256 + o];
      ci.f0[u] = ((const float*)(S + S_RWKK))[o];
      ci.f1[u] = ((const float*)(S + S_RWB))[(size_t)d * NTOK * 256 + o];
      ci.f2[u] = ((const float*)(S + S_RWKD))[(size_t)d * NTOK * 256 + o];
      ci.f3[u] = ((const float*)(S + S_RWR))[o];
      ci.xv[u] = ((const float*)(S + S_RWV))[o];
      ci.be[u] = 1.f;
    } else {
      ci.lw[u] = ((const float*)(S + S_GDAB))[(size_t)m * 16 + d * 4 + h];
      ci.be[u] = ((const float*)(S + S_GDAB))[(size_t)m * 16 + 8 + d * 4 + h];
      ci.f0[u] = ((const float*)(S + S_GDK))[o];
      ci.f3[u] = ((const float*)(S + S_GDQ))[o];
      ci.xv[u] = ((const float*)(S + S_GDV))[o];
      ci.f1[u] = 0.f; ci.f2[u] = 0.f;
    }
  }
}
template <bool GDN>
__device__ __forceinline__ void chunk_prep_task(PP pp, int t, int t_next, bool has_next, const ChunkIn& ci, ChunkIn& nx, char* smem) {
  const int chain = t / NCHUNK, n = t - chain * NCHUNK;
  const int d = chain & 1, h = (chain >> 1) & 3, b = (chain >> 3) & 1;
  (void)b; (void)d; (void)h;
  const int tid = tid_opaque(), lane = tid & 63, wv = wave_id(tid);
  const int fr = lane & 15, fq = lane >> 4, mt = wv >> 1, nt0 = (wv & 1) * 2;
  char* S = p.ws + OFF_S;
  char* CH = p.ws + OFF_CH;
  const size_t cc = (size_t)chain * NCHUNK + n;
  char* const p0 = smem;
  char* const p1 = smem + 1 * SLOT_BYTES;
  char* const p2 = smem + 2 * SLOT_BYTES;
  char* const p3 = smem + 3 * SLOT_BYTES;
  char* const p4 = smem + 4 * SLOT_BYTES;
  char* const p5 = smem + 5 * SLOT_BYTES;
  char* const p6 = smem + 6 * SLOT_BYTES;
  char* const p7 = smem + 7 * SLOT_BYTES;
  char* const p8 = smem + 8 * SLOT_BYTES;
  char* const p9 = smem + 9 * SLOT_BYTES;
  char* const p10 = smem + 10 * SLOT_BYTES;
  char* const p11 = smem + 11 * SLOT_BYTES;
  char* const p12 = smem + 12 * SLOT_BYTES;
  float* const F0 = (float*)(smem + X1_F0);
  float* const Lv = (float*)(smem + X1_ARR);
  float* const Lm1v = Lv + 64;
  float* const betav = Lv + 128;
  float* const eLv = Lv + 192;
  float* const gC = Lv + 256;
  float* const gsum = Lv + 320;
  char* const sKt = p0;
  char* const sBh = GDN ? p0 : p1;
  char* const sKh = GDN ? p0 : p2;

  {
    const int c = lane, tg = wv;
    const float* lw = ci.lw; const float* f0 = ci.f0; const float* f1 = ci.f1; const float* f2 = ci.f2; const float* f3 = ci.f3; const float* xv = ci.xv; const float* be = ci.be;
    float cum[8];
    cum[0] = lw[0];
#pragma unroll
    for (int u = 1; u < 8; ++u) cum[u] = cum[u - 1] + lw[u];
    gsum[tg * 64 + c] = cum[7];
    LBAR();
    float off = 0.f, LC = 0.f;
#pragma unroll
    for (int g2 = 0; g2 < 8; ++g2) { const float gs = gsum[g2 * 64 + c]; LC += gs; off += (g2 < tg) ? gs : 0.f; }
    bf16x8 vKtT, vBbT, vKbT, vXT;
#pragma unroll
    for (int u = 0; u < 8; ++u) {
      const int t = tg * 8 + u;
      const float L = off + cum[u], Lm1 = L - lw[u];
      if (!GDN) {
        const float eLm1 = __expf(Lm1), enL = __expf(-L), eL = __expf(L), eCL = __expf(LC - L);
        const float kt = f0[u] * eLm1;
        *(bfr*)(p0 + (t * CS + c) * 2) = f2bf(kt);
        *(bfr*)(p1 + (t * CS + c) * 2) = f2bf(f1[u] * enL);
        *(bfr*)(p2 + (t * CS + c) * 2) = f2bf(f2[u] * enL);
        *(bfr*)(p3 + (t * CS + c) * 2) = f2bf(f3[u] * eL);
        vKtT[u] = (short)f2bf(kt);
        vBbT[u] = (short)f2bf(f1[u] * eCL);
        vKbT[u] = (short)f2bf(f2[u] * eCL);
        vXT[u] = (short)f2bf(xv[u]);
      } else {
        *(bfr*)(p0 + (t * CS + c) * 2) = f2bf(f0[u]);
        *(bfr*)(p3 + (t * CS + c) * 2) = f2bf(f3[u]);
        vKtT[u] = (short)f2bf(f0[u] * __expf(Lm1));
        vBbT[u] = (short)f2bf(be[u] * f0[u] * __expf(LC - Lm1));
        vKbT[u] = (short)f2bf(f0[u] * __expf(LC - L));
        vXT[u] = (short)f2bf(be[u] * xv[u]);
        if (c == 0) { Lv[t] = L; Lm1v[t] = Lm1; betav[t] = be[u]; eLv[t] = __expf(L); }
      }
    }
    *(bf16x8*)(p4 + (c * CS + tg * 8) * 2) = vKtT;
    *(bf16x8*)(p5 + (c * CS + tg * 8) * 2) = vBbT;
    *(bf16x8*)(p6 + (c * CS + tg * 8) * 2) = vKbT;
    *(bf16x8*)(p7 + (c * CS + tg * 8) * 2) = vXT;
    if (tg == 0) gC[c] = __expf(LC);
    if (!GDN && tid < 64) { Lv[tid] = 0.f; Lm1v[tid] = 0.f; betav[tid] = 1.f; eLv[tid] = 1.f; }
  }
  LBAR();
  if (has_next) chunk_load<GDN>(pp, t_next, nx);
  {
    {
      MM_FRAGS(sKt, sBh, a0, a1, b00, b01, b10, b11)
      f32x4 c0 = {0.f, 0.f, 0.f, 0.f}, c1 = c0;
      MM_2TILES(c0, c1, a0, a1, b00, b01, b10, b11)
#pragma unroll
      for (int q = 0; q < 2; ++q) {
        const int sI = (nt0 + q) * 16 + fr;
        const f32x4 cv = q ? c1 : c0;
        f32x4 o;
#pragma unroll
        for (int r = 0; r < 4; ++r) {
          const int tI = mt * 16 + 4 * fq + r;
          float v = cv[r];
          if (GDN) v *= betav[sI] * __expf(fminf(Lm1v[tI] - Lm1v[sI], 0.f));
          o[r] = (sI < tI) ? v : 0.f;
        }
        *(f32x4*)(F0 + sI * F0_STRIDE + mt * 16 + 4 * fq) = o;
        wr_T(p11, mt, nt0 + q, fr, fq, o);
      }
    }
    {
      MM_FRAGS(sKt, sKh, a0, a1, b00, b01, b10, b11)
      f32x4 c0 = {0.f, 0.f, 0.f, 0.f}, c1 = c0;
      MM_2TILES(c0, c1, a0, a1, b00, b01, b10, b11)
#pragma unroll
      for (int q = 0; q < 2; ++q) {
        const int sI = (nt0 + q) * 16 + fr;
        const f32x4 cv = q ? c1 : c0;
        f32x4 o;
#pragma unroll
        for (int r = 0; r < 4; ++r) {
          const int tI = mt * 16 + 4 * fq + r;
          float v = cv[r];
          if (GDN) v *= __expf(fminf(Lm1v[tI] - Lv[sI], 0.f));
          o[r] = (sI < tI) ? v : 0.f;
        }
        wr_T(p9, mt, nt0 + q, fr, fq, o);
      }
    }
    {
      MM_FRAGS(sBh, p3, a0, a1, b00, b01, b10, b11)
      f32x4 c0 = {0.f, 0.f, 0.f, 0.f}, c1 = c0;
      MM_2TILES(c0, c1, a0, a1, b00, b01, b10, b11)
#pragma unroll
      for (int q = 0; q < 2; ++q) {
        const int tI = (nt0 + q) * 16 + fr;
        const f32x4 cv = q ? c1 : c0;
        f32x4 o;
#pragma unroll
        for (int r = 0; r < 4; ++r) {
          const int sI = mt * 16 + 4 * fq + r;
          float v = cv[r];
          if (GDN) v *= betav[sI] * __expf(fminf(Lv[tI] - Lm1v[sI], 0.f));
          o[r] = (sI <= tI) ? v : 0.f;
        }
        wr_T(p10, mt, nt0 + q, fr, fq, o);
      }
    }
  }
  LBAR();
  if (wv < 2) {
    const int base = wv * 32, other = 32 - base, c = lane & 31;
    float tr[32];
#pragma unroll
    for (int j = 0; j < 32; ++j) tr[j] = 0.f;
#pragma unroll
    for (int i = 31; i >= 0; --i) {
      float a0 = (c == i) ? 1.f : 0.f, a1 = 0.f, a2 = 0.f, a3 = 0.f;
#pragma unroll
      for (int jb = ((i + 1) & ~3); jb < 32; jb += 4) {
        const f32x4 a4 = *(const f32x4*)(F0 + (base + i) * F0_STRIDE + base + jb);
        a0 -= a4[0] * tr[jb]; a1 -= a4[1] * tr[jb + 1]; a2 -= a4[2] * tr[jb + 2]; a3 -= a4[3] * tr[jb + 3];
      }
      const float acc = (a0 + a1) + (a2 + a3);
      tr[i] = acc;
      if (lane < 32) {
        *(bfr*)(p8 + ((base + i) * CS + base + c) * 2) = f2bf(acc);
        *(bfr*)(p8 + ((base + i) * CS + other + c) * 2) = (bfr)0;
      }
    }
    if (lane < 32) {
#pragma unroll
      for (int q = 0; q < 4; ++q) {
        bf16x8 o, z;
#pragma unroll
        for (int j = 0; j < 8; ++j) { o[j] = (short)f2bf(tr[8 * q + j]); z[j] = 0; }
        *(bf16x8*)(p12 + ((base + c) * CS + base + 8 * q) * 2) = o;
        *(bf16x8*)(p12 + ((base + c) * CS + other + 8 * q) * 2) = z;
      }
    }
  }
  LBAR();
  {
    MM_FRAGS(p11, p12, a0, a1, b00, b01, b10, b11)
    f32x4 c0 = {0.f, 0.f, 0.f, 0.f}, c1 = c0;
    MM_2TILES(c0, c1, a0, a1, b00, b01, b10, b11)
    wr_T(p1, mt, nt0, fr, fq, c0);
    wr_T(p1, mt, nt0 + 1, fr, fq, c1);
  }
  LBAR();
  if (mt < 2 && nt0 == 2) {
    MM_FRAGS(p8, p1, a0, a1, b00, b01, b10, b11)
    f32x4 c0 = {0.f, 0.f, 0.f, 0.f}, c1 = c0;
    MM_2TILES(c0, c1, a0, a1, b00, b01, b10, b11)
#pragma unroll
    for (int r = 0; r < 4; ++r) {
      *(bfr*)(p8 + ((mt * 16 + 4 * fq + r) * CS + (nt0) * 16 + fr) * 2) = f2bf(-c0[r]);
      *(bfr*)(p8 + ((mt * 16 + 4 * fq + r) * CS + (nt0 + 1) * 16 + fr) * 2) = f2bf(-c1[r]);
    }
  }
  LBAR();
  {
    {
      MM_FRAGS(p8, p5, a0, a1, b00, b01, b10, b11)
      f32x4 c0 = {0.f, 0.f, 0.f, 0.f}, c1 = c0;
      MM_2TILES(c0, c1, a0, a1, b00, b01, b10, b11)
      wr_T(p11, mt, nt0, fr, fq, -c0);
      wr_T(p11, mt, nt0 + 1, fr, fq, -c1);
    }
    {
      MM_FRAGS(p8, p10, a0, a1, b00, b01, b10, b11)
      f32x4 c0 = {0.f, 0.f, 0.f, 0.f}, c1 = c0;
      MM_2TILES(c0, c1, a0, a1, b00, b01, b10, b11)
      wr_T(p12, mt, nt0, fr, fq, -c0);
      wr_T(p12, mt, nt0 + 1, fr, fq, -c1);
    }
  }
  LBAR();
  {
    {
      MM_FRAGS(p4, p11, a0, a1, b00, b01, b10, b11)
      f32x4 c0 = {0.f, 0.f, 0.f, 0.f}, c1 = c0;
      MM_2TILES(c0, c1, a0, a1, b00, b01, b10, b11)
#pragma unroll
      for (int q = 0; q < 2; ++q) {
        const int cp = (nt0 + q) * 16 + fr;
        f32x4 cv = q ? c1 : c0;
#pragma unroll
        for (int r = 0; r < 4; ++r) { const int cI = mt * 16 + 4 * fq + r; if (cI == cp) cv[r] += gC[cI]; }
        wr_T(p10, mt, nt0 + q, fr, fq, cv);
      }
    }
    {
      MM_FRAGS(p9, p11, a0, a1, b00, b01, b10, b11)
      f32x4 c0 = {0.f, 0.f, 0.f, 0.f}, c1 = c0;
      MM_2TILES(c0, c1, a0, a1, b00, b01, b10, b11)
#pragma unroll
      for (int q = 0; q < 2; ++q) {
        const int cp = (nt0 + q) * 16 + fr;
        f32x4 cv = q ? c1 : c0;
        const bf16x4 kb = *(const bf16x4*)(p6 + (cp * CS + mt * 16 + 4 * fq) * 2);
#pragma unroll
        for (int r = 0; r < 4; ++r) cv[r] += __uint_as_float(((unsigned)(unsigned short)kb[r]) << 16);
        wr_T(p8, mt, nt0 + q, fr, fq, cv);
      }
    }
    {
      MM_FRAGS(p4, p12, a0, a1, b00, b01, b10, b11)
      f32x4 c0 = {0.f, 0.f, 0.f, 0.f}, c1 = c0;
      MM_2TILES(c0, c1, a0, a1, b00, b01, b10, b11)
#pragma unroll
      for (int q = 0; q < 2; ++q) {
        const int tI = (nt0 + q) * 16 + fr;
        f32x4 cv = q ? c1 : c0;
        const bf16x4 rt = *(const bf16x4*)(p3 + (tI * CS + mt * 16 + 4 * fq) * 2);
        const float el = eLv[tI];
#pragma unroll
        for (int r = 0; r < 4; ++r) cv[r] += __uint_as_float(((unsigned)(unsigned short)rt[r]) << 16) * el;
        wr_T(p1, mt, nt0 + q, fr, fq, cv);
      }
    }
    {
      f32x4 c0 = {0.f, 0.f, 0.f, 0.f}, c1 = c0;
      {
        MM_FRAGS(sKh, p3, a0, a1, b00, b01, b10, b11)
        MM_2TILES(c0, c1, a0, a1, b00, b01, b10, b11)
      }
#pragma unroll
      for (int q = 0; q < 2; ++q) {
        const int tI = (nt0 + q) * 16 + fr;
#pragma unroll
        for (int r = 0; r < 4; ++r) {
          const int sI = mt * 16 + 4 * fq + r;
          float v = q ? c1[r] : c0[r];
          if (GDN) v *= __expf(fminf(Lv[tI] - Lv[sI], 0.f));
          v = (sI <= tI) ? v : 0.f;
          if (q) c1[r] = v; else c0[r] = v;
        }
      }
      {
        MM_FRAGS(p9, p12, a0, a1, b00, b01, b10, b11)
        MM_2TILES(c0, c1, a0, a1, b00, b01, b10, b11)
      }
      wr_T(p5, mt, nt0, fr, fq, c0);
      wr_T(p5, mt, nt0 + 1, fr, fq, c1);
    }
  }
  LBAR();
  {
    {
      MM_FRAGS(p8, p7, a0, a1, b00, b01, b10, b11)
      f32x4 c0 = {0.f, 0.f, 0.f, 0.f}, c1 = c0;
      MM_2TILES(c0, c1, a0, a1, b00, b01, b10, b11)
      bfr* QT = (bfr*)(CH + cc * CH_REC + CH_QT);
      *(bf16x4*)(QT + ((mt * 4 + nt0) * 64 + lane) * 4) = pack4(c0[0], c0[1], c0[2], c0[3]);
      *(bf16x4*)(QT + ((mt * 4 + nt0 + 1) * 64 + lane) * 4) = pack4(c1[0], c1[1], c1[2], c1[3]);
    }
    {
      MM_FRAGS(p7, p5, a0, a1, b00, b01, b10, b11)
      f32x4 c0 = {0.f, 0.f, 0.f, 0.f}, c1 = c0;
      MM_2TILES(c0, c1, a0, a1, b00, b01, b10, b11)
      bfr* YX = (bfr*)(CH + cc * CH_REC + CH_YX);
      *(bf16x4*)(YX + ((mt * 4 + nt0) * 64 + lane) * 4) = pack4(c0[0], c0[1], c0[2], c0[3]);
      *(bf16x4*)(YX + ((mt * 4 + nt0 + 1) * 64 + lane) * 4) = pack4(c1[0], c1[1], c1[2], c1[3]);
    }
    {
      const int fm = wv >> 1, fa = wv & 1;
      const int row = fm * 16 + fr;
      {
        const bf16x4 lo = *(const bf16x4*)(p10 + (row * CS + 32 * fa + 4 * fq) * 2);
        const bf16x4 hi = *(const bf16x4*)(p10 + (row * CS + 32 * fa + 16 + 4 * fq) * 2);
        bf16x8 f; f[0] = lo[0]; f[1] = lo[1]; f[2] = lo[2]; f[3] = lo[3]; f[4] = hi[0]; f[5] = hi[1]; f[6] = hi[2]; f[7] = hi[3];
        *(bf16x8*)(CH + cc * CH_REC + CH_PT + (size_t)((fm * 2 + fa) * 64 + lane) * 16) = f;
      }
      {
        const bf16x4 lo = *(const bf16x4*)(p1 + (row * CS + 32 * fa + 4 * fq) * 2);
        const bf16x4 hi = *(const bf16x4*)(p1 + (row * CS + 32 * fa + 16 + 4 * fq) * 2);
        bf16x8 f; f[0] = lo[0]; f[1] = lo[1]; f[2] = lo[2]; f[3] = lo[3]; f[4] = hi[0]; f[5] = hi[1]; f[6] = hi[2]; f[7] = hi[3];
        *(bf16x8*)(CH + cc * CH_REC + CH_RYT + (size_t)((fm * 2 + fa) * 64 + lane) * 16) = f;
      }
    }
  }
  LBAR();
}

template <bool GDN>
__device__ __forceinline__ void chunk_prep_loop(PP pp, int t0, int tend, int nb, char* smem) {
  ChunkIn cur, nxt;
  if (t0 < tend) chunk_load<GDN>(pp, t0, cur);
  for (int t = t0; t < tend; t += nb) {
    const bool has_next = (t + nb) < tend;
    chunk_prep_task<GDN>(pp, t, t + nb, has_next, cur, nxt, smem);
    cur = nxt;
  }
}
__device__ __forceinline__ void phase_chunk_prep(PP pp, int bid, int nb, char* smem) {
  __syncthreads();
  const int half = (NCHAIN / 2) * NCHUNK;
  chunk_prep_loop<false>(pp, bid, half, nb, smem);
  const int k0 = (half - bid + nb - 1) / nb;
  chunk_prep_loop<true>(pp, bid + k0 * nb, NCHAIN * NCHUNK, nb, smem);
  __syncthreads();
}

#define X2_BUF 32768
#define X2_BAR() do { asm volatile("s_waitcnt lgkmcnt(0)" ::: "memory"); __builtin_amdgcn_s_barrier(); asm volatile("" ::: "memory"); } while (0)
__device__ __forceinline__ void chunk_seq_chain(PP pp, int chain, char* smem) {
  __syncthreads();
  const int tid = tid_opaque(), lane = tid & 63, wv = wave_id(tid);
  const int d = chain & 1, h = (chain >> 1) & 3, b = (chain >> 3) & 1, ty = chain >> 4;
  const char* CH = p.ws + OFF_CH;
  float* Y = (float*)(p.ws + OFF_S + (ty ? S_YGD : S_YRW)) + (size_t)d * NTOK * 256;
  const size_t c0 = (size_t)chain * NCHUNK;
  if (wv >= 4) {
    const int lw = wv - 4;
    const char* src0 = CH + c0 * CH_REC + (size_t)lane * 16;
#define X2_DMA(n) { const char* s_ = src0 + (size_t)(n) * CH_REC; LAS unsigned char* d_ = (LAS unsigned char*)smem + ((n) & 3) * X2_BUF;       \
      _Pragma("unroll") for (int i = 0; i < 8; ++i) {                                                                                       \
        const int piece = i * 4 + lw;                                                                                                       \
        __builtin_amdgcn_global_load_lds((const unsigned*)(s_ + piece * 1024), (LAS unsigned*)(d_ + piece * 1024), 16, 0, 0); } }
    X2_DMA(0) X2_DMA(1) X2_DMA(2)
    asm volatile("s_waitcnt vmcnt(16)" ::: "memory");
    X2_BAR();
    for (int n = 0; n < NCHUNK; ++n) {
      if (n + 3 < NCHUNK) { X2_DMA(n + 3) asm volatile("s_waitcnt vmcnt(16)" ::: "memory"); }
      else if (n + 2 < NCHUNK) asm volatile("s_waitcnt vmcnt(8)" ::: "memory");
      else asm volatile("s_waitcnt vmcnt(0)" ::: "memory");
      X2_BAR();
    }
#undef X2_DMA
  } else {
    const int vt = wv, fr = lane & 15, fq = lane >> 4;
    f32x4 Sacc[4];
#pragma unroll
    for (int i = 0; i < 4; ++i) Sacc[i] = (f32x4){0.f, 0.f, 0.f, 0.f};
    X2_BAR();
    for (int n = 0; n < NCHUNK; ++n) {
      const char* buf = smem + (n & 3) * X2_BUF;
      bf16x8 sB0, sB1;
#pragma unroll
      for (int j = 0; j < 4; ++j) {
        sB0[j] = (short)f2bf(Sacc[0][j]); sB0[4 + j] = (short)f2bf(Sacc[1][j]);
        sB1[j] = (short)f2bf(Sacc[2][j]); sB1[4 + j] = (short)f2bf(Sacc[3][j]);
      }
#pragma unroll
      for (int m = 0; m < 4; ++m) {
        const bf16x8 pa0 = *(const bf16x8*)(buf + ((m * 2 + 0) * 64 + lane) * 16);
        const bf16x8 pa1 = *(const bf16x8*)(buf + ((m * 2 + 1) * 64 + lane) * 16);
        const bf16x8 ra0 = *(const bf16x8*)(buf + 8192 + ((m * 2 + 0) * 64 + lane) * 16);
        const bf16x8 ra1 = *(const bf16x8*)(buf + 8192 + ((m * 2 + 1) * 64 + lane) * 16);
        const bf16x4 qb = *(const bf16x4*)(buf + 16384 + ((m * 4 + vt) * 64 + lane) * 8);
        const bf16x4 yb = *(const bf16x4*)(buf + 24576 + ((vt * 4 + m) * 64 + lane) * 8);
        f32x4 y = {bf2f(yb[0]), bf2f(yb[1]), bf2f(yb[2]), bf2f(yb[3])};
        y = __builtin_amdgcn_mfma_f32_16x16x32_bf16(sB0, ra0, y, 0, 0, 0);
        y = __builtin_amdgcn_mfma_f32_16x16x32_bf16(sB1, ra1, y, 0, 0, 0);
        f32x4 sn = {bf2f(qb[0]), bf2f(qb[1]), bf2f(qb[2]), bf2f(qb[3])};
        sn = __builtin_amdgcn_mfma_f32_16x16x32_bf16(pa0, sB0, sn, 0, 0, 0);
        sn = __builtin_amdgcn_mfma_f32_16x16x32_bf16(pa1, sB1, sn, 0, 0, 0);
        Sacc[m] = sn;
        {
          const int mm = scan_tok(b, d, n * 64 + m * 16 + fr);
          *(f32x4*)(Y + (size_t)mm * 256 + h * 64 + vt * 16 + 4 * fq) = y;
        }
      }
      X2_BAR();
    }
  }
}

struct NaPair { int mk0, mk1, tau0, tau1, kr0, kr1, ct0, ct1; };
struct NaFrag { bf16x8 k00, k01, k10, k11; bf16x4 v0[4], v1[4]; };

__device__ __forceinline__ void na_load(NaFrag& f, const bfr* KN, const bfr* VT, size_t vt_base, int h, int fr, int fq, const NaPair& pr) {
  const bfr* k0 = KN + (size_t)(pr.mk0 + fr) * 512 + h * 64 + fq * 8;
  const bfr* k1 = KN + (size_t)(pr.mk1 + fr) * 512 + h * 64 + fq * 8;
  f.k00 = *(const bf16x8*)(k0); f.k01 = *(const bf16x8*)(k0 + 32);
  f.k10 = *(const bf16x8*)(k1); f.k11 = *(const bf16x8*)(k1 + 32);
#pragma unroll
  for (int dt = 0; dt < 4; ++dt) {
    const int vo = (dt * 16 + fr) * 16 + fq * 4;
    f.v0[dt] = *(const bf16x4*)(VT + vt_base + (size_t)(pr.tau0 >> 4) * 1024 + vo);
    f.v1[dt] = *(const bf16x4*)(VT + vt_base + (size_t)(pr.tau1 >> 4) * 1024 + vo);
  }
}

__device__ __forceinline__ void na_compute(const NaFrag& f, const bf16x8 qf0, const bf16x8 qf1, bool local, bool vr0, bool vr1,
                                           int dr0, int dr1, int ct0, int ct1, int qc, int fq, const float* bias_h, f32x4 (&O)[4], float& lsum) {
  f32x4 z = {0.f, 0.f, 0.f, 0.f};
  f32x4 st0 = __builtin_amdgcn_mfma_f32_16x16x32_bf16(f.k00, qf0, z, 0, 0, 0);
  st0 = __builtin_amdgcn_mfma_f32_16x16x32_bf16(f.k01, qf1, st0, 0, 0, 0);
  f32x4 st1 = __builtin_amdgcn_mfma_f32_16x16x32_bf16(f.k10, qf0, z, 0, 0, 0);
  st1 = __builtin_amdgcn_mfma_f32_16x16x32_bf16(f.k11, qf1, st1, 0, 0, 0);
  bf16x8 pf;
  if (local) {
    const int cs = min(max(qc - 8, 0), 48);
#pragma unroll
    for (int r = 0; r < 4; ++r) {
      const int kc0 = ct0 * 16 + fq * 4 + r, kc1 = ct1 * 16 + fq * 4 + r;
      float p0 = 0.f, p1 = 0.f;
      if (vr0 && (unsigned)(kc0 - cs) < 16u) p0 = __builtin_amdgcn_exp2f(st0[r] + bias_h[dr0 * 31 + (kc0 - qc + 15)]);
      if (vr1 && (unsigned)(kc1 - cs) < 16u) p1 = __builtin_amdgcn_exp2f(st1[r] + bias_h[dr1 * 31 + (kc1 - qc + 15)]);
      lsum += p0 + p1;
      pf[r] = (short)f2bf(p0);
      pf[4 + r] = (short)f2bf(p1);
    }
  } else {
#pragma unroll
    for (int r = 0; r < 4; ++r) {
      const float p0 = __builtin_amdgcn_exp2f(st0[r]), p1 = __builtin_amdgcn_exp2f(st1[r]);
      lsum += p0 + p1;
      pf[r] = (short)f2bf(p0);
      pf[4 + r] = (short)f2bf(p1);
    }
  }
#pragma unroll
  for (int dt = 0; dt < 4; ++dt) {
    bf16x8 vf;
    vf[0] = f.v0[dt][0]; vf[1] = f.v0[dt][1]; vf[2] = f.v0[dt][2]; vf[3] = f.v0[dt][3];
    vf[4] = f.v1[dt][0]; vf[5] = f.v1[dt][1]; vf[6] = f.v1[dt][2]; vf[7] = f.v1[dt][3];
    O[dt] = __builtin_amdgcn_mfma_f32_16x16x32_bf16(vf, pf, O[dt], 0, 0, 0);
  }
}

__device__ __forceinline__ void na_block_task(PP pp, int task, const float* bias_lds) {
  const int tid = tid_opaque(), lane = tid & 63, wv = wave_id(tid);
  const int fr = lane & 15, fq = lane >> 4;
  char* S = p.ws + OFF_S;
  const bfr* QN = (const bfr*)(S + S_QN);
  const bfr* KN = (const bfr*)(S + S_KN);
  const bfr* VT = (const bfr*)(S + S_VT);
  bfr* CC = (bfr*)(p.ws + OFF_CC);
  const bool latent = task < 1024;
  int b, h, mqa, mqb, qra = 0, qrb = 0, cgp = 0;
  if (latent) {
    h = task & 7; const int quad = (task >> 3) & 63; b = task >> 9;
    qra = quad * 4 + (wv >> 2) * 2; qrb = qra + 1; cgp = wv & 3;
    mqa = b * SEQ + qra * 64 + cgp * 16; mqb = mqa + 64;
  } else {
    const int u = task - 1024;
    h = u & 7; b = u >> 3;
    mqa = NLAT + b * CTXL + (wv * 2) * 16; mqb = mqa + 16;
  }
  const bf16x8 qa0 = *(const bf16x8*)(QN + (size_t)(mqa + fr) * 512 + h * 64 + fq * 8);
  const bf16x8 qa1 = *(const bf16x8*)(QN + (size_t)(mqa + fr) * 512 + h * 64 + 32 + fq * 8);
  const bf16x8 qb0 = *(const bf16x8*)(QN + (size_t)(mqb + fr) * 512 + h * 64 + fq * 8);
  const bf16x8 qb1 = *(const bf16x8*)(QN + (size_t)(mqb + fr) * 512 + h * 64 + 32 + fq * 8);
  f32x4 Oa[4], Ob[4];
#pragma unroll
  for (int dt = 0; dt < 4; ++dt) { Oa[dt] = (f32x4){0.f, 0.f, 0.f, 0.f}; Ob[dt] = Oa[dt]; }
  float lsa = 0.f, lsb = 0.f;
  const size_t vt_base = (size_t)(b * 8 + h) * 64 * TTOK;
  const int rsa = min(max(qra - 4, 0), SEQ / 64 - 8), rsb = min(max(qrb - 4, 0), SEQ / 64 - 8);
  const int nrows = latent ? (rsb - rsa + 8) : 0;
  const int ct_first = (cgp <= 1) ? 0 : cgp - 1;
  const int nct = (cgp == 0 || cgp == 3) ? 2 : 3;
  const int ntile = nrows * nct;
  const int nlp = (ntile + 1) >> 1;
  const int npair = nlp + 8;
  const int qc = cgp * 16 + fr;
  auto mkpair = [&](int pi) {
    NaPair pr;
    if (pi < nlp) {
      const int i0 = 2 * pi, i1 = min(2 * pi + 1, ntile - 1);
      pr.kr0 = rsa + i0 / nct; pr.ct0 = ct_first + i0 % nct;
      pr.kr1 = rsa + i1 / nct; pr.ct1 = ct_first + i1 % nct;
      if (2 * pi + 1 >= ntile) pr.kr1 = -100;
      const int r1 = rsa + i1 / nct;
      pr.tau0 = pr.kr0 * 64 + pr.ct0 * 16; pr.tau1 = r1 * 64 + pr.ct1 * 16;
      pr.mk0 = b * SEQ + pr.tau0; pr.mk1 = b * SEQ + pr.tau1;
    } else {
      const int c = pi - nlp;
      pr.kr0 = pr.kr1 = pr.ct0 = pr.ct1 = 0;
      pr.tau0 = SEQ + c * 32; pr.tau1 = SEQ + c * 32 + 16;
      pr.mk0 = NLAT + b * CTXL + c * 32; pr.mk1 = pr.mk0 + 16;
    }
    return pr;
  };
  NaFrag fa, fb;
  NaPair pa = mkpair(0), pb;
  na_load(fa, KN, VT, vt_base, h, fr, fq, pa);
  const float* bias_h = bias_lds + h * 465;
#define NA_DO(F, PR, PI)                                                                                          \
  {                                                                                                               \
    const bool loc_ = (PI) < nlp;                                                                                 \
    na_compute(F, qa0, qa1, loc_, (unsigned)(PR.kr0 - rsa) < 8u, (unsigned)(PR.kr1 - rsa) < 8u,                   \
               PR.kr0 - qra + 7, PR.kr1 - qra + 7, PR.ct0, PR.ct1, qc, fq, bias_h, Oa, lsa);                      \
    na_compute(F, qb0, qb1, loc_, (unsigned)(PR.kr0 - rsb) < 8u, (unsigned)(PR.kr1 - rsb) < 8u,                   \
               PR.kr0 - qrb + 7, PR.kr1 - qrb + 7, PR.ct0, PR.ct1, qc, fq, bias_h, Ob, lsb);                      \
  }
  for (int pi = 0; pi < npair; pi += 2) {
    if (pi + 1 < npair) { pb = mkpair(pi + 1); na_load(fb, KN, VT, vt_base, h, fr, fq, pb); }
    NA_DO(fa, pa, pi)
    if (pi + 1 < npair) {
      if (pi + 2 < npair) { pa = mkpair(pi + 2); na_load(fa, KN, VT, vt_base, h, fr, fq, pa); }
      NA_DO(fb, pb, pi + 1)
    }
  }
#undef NA_DO
  lsa += shfl_xor_l(lsa, 16, lane); lsa += shfl_xor_l(lsa, 32, lane);
  lsb += shfl_xor_l(lsb, 16, lane); lsb += shfl_xor_l(lsb, 32, lane);
  const float ia = 1.f / lsa, ib = 1.f / lsb;
#pragma unroll
  for (int dt = 0; dt < 4; ++dt) {
    *(bf16x4*)(CC + (size_t)(mqa + fr) * 1024 + h * 64 + dt * 16 + fq * 4) = pack4(Oa[dt][0] * ia, Oa[dt][1] * ia, Oa[dt][2] * ia, Oa[dt][3] * ia);
    *(bf16x4*)(CC + (size_t)(mqb + fr) * 1024 + h * 64 + dt * 16 + fq * 4) = pack4(Ob[dt][0] * ib, Ob[dt][1] * ib, Ob[dt][2] * ib, Ob[dt][3] * ib);
  }
}

__device__ __forceinline__ void phase_mix(PP pp, int l, int bid, int nb, char* smem) {
  const int tid = tid_opaque();
  const int nscan_blocks = (nb > 32) ? 32 : nb;
  const int first_attn_block = (nb > 32) ? 32 : 0;
  if (bid < nscan_blocks) {
    for (int c = bid; c < NCHAIN; c += nscan_blocks) chunk_seq_chain(pp, c, smem);
  }
  if (bid >= first_attn_block) {
    float* bias = (float*)smem;
    __syncthreads();
    for (int i = tid; i < 8 * 465; i += NTHR) bias[i] = p.na_rpb[(size_t)l * 8 * 465 + i] * 1.4426950408889634f;
    __syncthreads();
    const int ntask = (l == 0) ? 1024 + 16 : 1024;
    const int nab = nb - first_attn_block;
    for (int t = bid - first_attn_block; t < ntask; t += nab) na_block_task(pp, t, bias);
    __syncthreads();
    phase_convert(pp, l, 1, bid - first_attn_block, nab, smem);
    if (l == 0) phase_convert(pp, 1, 0, bid - first_attn_block, nab, smem);
  }
}

__device__ __forceinline__ void phase_post(PP pp, int l, int bid, int nb) {
  const int tid = tid_opaque(), lane = tid & 63, wv = wave_id(tid);
  char* S = p.ws + OFF_S;
  const float* YRW = (const float*)(S + S_YRW);
  const float* YGD = (const float*)(S + S_YGD);
  const float* RWV = (const float*)(S + S_RWV);
  const float* RWG = (const float*)(S + S_RWG);
  const float* BON = (const float*)(S + S_BON);
  const float* P = (const float*)(p.ws + OFF_P);
  bfr* CC = (bfr*)(p.ws + OFF_CC);
  const float* ln_w = p.rw_ln_w + (size_t)l * 256;
  const float* ln_b = p.rw_ln_b + (size_t)l * 256;
  const float* ng = p.gd_norm_g + (size_t)l * 64;
  const int ntok = (l == 0) ? NTOK : NLAT;
  const int cb = lane * 4, hh = lane >> 4;
  const f32x4 lw4 = *(const f32x4*)(ln_w + cb), lb4 = *(const f32x4*)(ln_b + cb), ng4 = *(const f32x4*)(ng + (cb & 63));
  for (int m = bid * 8 + wv; m < ntok; m += nb * 8) {
    const size_t o = (size_t)m * 256 + cb;
    const f32x4 y0 = *(const f32x4*)(YRW + o), y1 = *(const f32x4*)(YRW + (size_t)NTOK * 256 + o);
    const f32x4 rv = *(const f32x4*)(RWV + o), rg = *(const f32x4*)(RWG + o);
    const f32x4 g0 = *(const f32x4*)(YGD + o), g1 = *(const f32x4*)(YGD + (size_t)NTOK * 256 + o);
    const f32x4 z = *(const f32x4*)(P + (size_t)m * PINP + B_END + 768 + cb);
    const float bon = BON[(size_t)m * 4 + hh];
    {
      const f32x4 y = y0 + y1;
      const float mean = row16_sum((y[0] + y[1]) + (y[2] + y[3])) * (1.f / 64.f);
      const f32x4 dv = y - mean;
      const float var = row16_sum((dv[0] * dv[0] + dv[1] * dv[1]) + (dv[2] * dv[2] + dv[3] * dv[3])) * (1.f / 64.f);
      const f32x4 out = ((dv * rsqrtf(var + 64e-5f)) * lw4 + lb4 + rv * bon) * rg;
      *(bf16x4*)(CC + (size_t)m * 1024 + 512 + cb) = pack4(out[0], out[1], out[2], out[3]);
    }
    {
      const f32x4 y = g0 + g1;
      const float ms = row16_sum((y[0] * y[0] + y[1] * y[1]) + (y[2] * y[2] + y[3] * y[3])) * (1.f / 64.f);
      const f32x4 sz = {siluf_(z[0]), siluf_(z[1]), siluf_(z[2]), siluf_(z[3])};
      const f32x4 out = (y * rsqrtf(ms + 1e-6f)) * ng4 * sz;
      *(bf16x4*)(CC + (size_t)m * 1024 + 768 + cb) = pack4(out[0], out[1], out[2], out[3]);
    }
  }
}

#define RW_LDS_ROW 36
__device__ __forceinline__ void phase_router(PP pp, int l, int bid, int nb, char* smem) {
  const int tid = tid_opaque(), lane = tid & 63, wv = wave_id(tid);
  const float* xl = p.out;
  const float* xc = (const float*)(p.ws + OFF_CTX);
  const float* mods = (const float*)(p.ws + OFF_MODS) + (size_t)l * 3 * 6144;
  const float* g = p.norm_ffn_g + (size_t)l * 1024;
  const float* rw = p.moe_router_w + (size_t)l * 1024 * 32;
  const float* rb = p.moe_router_b + (size_t)l * 32;
  bfr* H = (bfr*)(p.ws + OFF_H);
  int* cnt = (int*)(p.ws + OFF_CNT);
  int* TOKE = (int*)(p.ws + OFF_TOKE);
  int* TOKP = (int*)(p.ws + OFF_TOKP);
  float* TOKG = (float*)(p.ws + OFF_TOKG);
  float* wl = (float*)smem;
  for (int i = tid; i < 1024 * 8; i += NTHR) {
    int d = i >> 3, q = i & 7;
    *(float4*)(wl + d * RW_LDS_ROW + q * 4) = *(const float4*)(rw + (size_t)d * 32 + q * 4);
  }
  __syncthreads();
  const int ntok = (l == 0) ? NTOK : NLAT;
  const float rbl = rb[lane & 31];
  for (int m0 = (bid * 8 + wv) * 2; m0 < ntok; m0 += nb * 16) {
    float acc0[32], acc1[32];
#pragma unroll
    for (int e = 0; e < 32; ++e) { acc0[e] = 0.f; acc1[e] = 0.f; }
    float hv0[16], hv1[16];
    {
      const int ma = m0, mb = m0 + 1;
      const float* xa = (ma < NLAT) ? xl + (size_t)ma * 1024 : xc + (size_t)(ma - NLAT) * 1024;
      const float* xb = (mb < NLAT) ? xl + (size_t)mb * 1024 : xc + (size_t)(mb - NLAT) * 1024;
      const float* mda = mods + (size_t)mod_row(ma) * 6144 + 3072;
      const float* mdb = mods + (size_t)mod_row(mb) * 6144 + 3072;
      float ssa = 0.f, ssb = 0.f;
#pragma unroll
      for (int i = 0; i < 16; ++i) { hv0[i] = xa[lane + 64 * i]; hv1[i] = xb[lane + 64 * i]; }
#pragma unroll
      for (int i = 0; i < 16; ++i) { ssa += hv0[i] * hv0[i]; ssb += hv1[i] * hv1[i]; }
      ssa = wave_sum(ssa); ssb = wave_sum(ssb);
      const float rsa = rsqrtf(ssa * (1.f / 1024.f) + 1e-6f), rsb = rsqrtf(ssb * (1.f / 1024.f) + 1e-6f);
#pragma unroll
      for (int i = 0; i < 16; ++i) {
        const int d = lane + 64 * i;
        const float gg = g[d];
        hv0[i] = hv0[i] * rsa * gg * (1.f + mda[1024 + d]) + mda[d];
        hv1[i] = hv1[i] * rsb * gg * (1.f + mdb[1024 + d]) + mdb[d];
      }
      float am0 = 0.f, am1 = 0.f;
#pragma unroll
      for (int i = 0; i < 16; ++i) { am0 = fmaxf(am0, fabsf(hv0[i])); am1 = fmaxf(am1, fabsf(hv1[i])); }
      am0 = wave_max(am0); am1 = wave_max(am1);
      const float sc0 = am0 > 0.f ? am0 * (1.f / 127.f) : 1.f, sc1 = am1 > 0.f ? am1 * (1.f / 127.f) : 1.f;
      const float iv0 = 1.f / sc0, iv1 = 1.f / sc1;
      signed char* H8 = (signed char*)(p.ws + OFF_H);
#pragma unroll
      for (int i = 0; i < 16; ++i) {
        const int d = lane + 64 * i;
        H8[(size_t)ma * 1024 + d] = (signed char)(int)fminf(fmaxf(rintf(hv0[i] * iv0), -127.f), 127.f);
        H8[(size_t)mb * 1024 + d] = (signed char)(int)fminf(fmaxf(rintf(hv1[i] * iv1), -127.f), 127.f);
      }
      if (lane == 0) { float* SCL = (float*)(p.ws + OFF_SCL); SCL[ma] = sc0; SCL[mb] = sc1; }
      asm volatile("" ::: "memory");
    }
#pragma unroll
    for (int i = 0; i < 16; ++i) {
      if ((i & 3) == 0) asm volatile("" ::: "memory");
      const float* wr = wl + (lane + 64 * i) * RW_LDS_ROW;
#pragma unroll
      for (int q = 0; q < 8; ++q) {
        const float4 w = *(const float4*)(wr + q * 4);
        acc0[q * 4 + 0] += hv0[i] * w.x; acc0[q * 4 + 1] += hv0[i] * w.y; acc0[q * 4 + 2] += hv0[i] * w.z; acc0[q * 4 + 3] += hv0[i] * w.w;
        acc1[q * 4 + 0] += hv1[i] * w.x; acc1[q * 4 + 1] += hv1[i] * w.y; acc1[q * 4 + 2] += hv1[i] * w.z; acc1[q * 4 + 3] += hv1[i] * w.w;
      }
    }
#define BFLY(A, N, D)                                                                           \
    _Pragma("unroll") for (int i = 0; i < (N); ++i) {                                            \
      const bool up = (lane & (D)) != 0;                                                         \
      const float keep = up ? A[i + (N)] : A[i];                                                 \
      const float send = up ? A[i] : A[i + (N)];                                                 \
      A[i] = keep + shfl_xor_l(send, (D), lane);                                                   \
    }
    BFLY(acc0, 16, 16) BFLY(acc1, 16, 16)
    BFLY(acc0, 8, 8) BFLY(acc1, 8, 8)
    BFLY(acc0, 4, 4) BFLY(acc1, 4, 4)
    BFLY(acc0, 2, 2) BFLY(acc1, 2, 2)
    BFLY(acc0, 1, 1) BFLY(acc1, 1, 1)
#undef BFLY
    float la = acc0[0] + shfl_xor_l(acc0[0], 32, lane);
    float lb = acc1[0] + shfl_xor_l(acc1[0], 32, lane);
    const int my_e = lane & 31;
    la += rbl; lb += rbl;
    (void)my_e;
#pragma unroll
    for (int tkn = 0; tkn < 2; ++tkn) {
      float v = tkn == 0 ? la : lb;
      float tv[4]; int ti[4];
#pragma unroll
      for (int k = 0; k < 4; ++k) {
        float bv = v; int bi = lane & 31;
#pragma unroll
        for (int o = 16; o >= 1; o >>= 1) {
          float ov = shfl_xor_l(bv, o, lane); int oi = shfl_xor_li(bi, o, lane);
          bool take = (ov > bv) || (ov == bv && oi < bi);
          bv = take ? ov : bv; bi = take ? oi : bi;
        }
        tv[k] = bv; ti[k] = bi;
        if ((lane & 31) == bi) v = -3.0e38f;
      }
      float e1 = __expf(tv[1] - tv[0]), e2 = __expf(tv[2] - tv[0]), e3 = __expf(tv[3] - tv[0]);
      float inv = 1.f / (1.f + e1 + e2 + e3);
      const int m = m0 + tkn;
      if (lane < 4) {
        int e = lane == 0 ? ti[0] : lane == 1 ? ti[1] : lane == 2 ? ti[2] : ti[3];
        float gt = (lane == 0 ? 1.f : lane == 1 ? e1 : lane == 2 ? e2 : e3) * inv;
        int pos = atomicAdd(&cnt[e], 1);
        TOKE[(size_t)m * 4 + lane] = e; TOKP[(size_t)m * 4 + lane] = pos; TOKG[(size_t)m * 4 + lane] = gt;
      }
    }
  }
  __syncthreads();
}

__device__ __forceinline__ void moe_offsets(PP pp, int* toff) {
  const int* cnt = (const int*)(p.ws + OFF_CNT);
  if (tid_opaque() == 0) {
    int a = 0;
    for (int e = 0; e < 32; ++e) { toff[e] = a; a += (cnt[e] + 255) >> 8; }
    toff[32] = a;
  }
  __syncthreads();
}

__device__ __forceinline__ void phase_slotfill(PP pp, int l, int bid, int nb, char* smem) {
  int* toff = (int*)smem;
  moe_offsets(pp, toff);
  const int tid = tid_opaque(), lane = tid & 63, wv = wave_id(tid);
  const int* TOKE = (const int*)(p.ws + OFF_TOKE);
  const int* TOKP = (const int*)(p.ws + OFF_TOKP);
  const float* TOKG = (const float*)(p.ws + OFF_TOKG);
  const int* cnt = (const int*)(p.ws + OFF_CNT);
  int* TOKS = (int*)(p.ws + OFF_TOKS);
  float* SLG = (float*)(p.ws + OFF_SLG);
  float* SLS = (float*)(p.ws + OFF_SLS);
  const float* SCL = (const float*)(p.ws + OFF_SCL);
  const signed char* H8 = (const signed char*)(p.ws + OFF_H);
  signed char* XG = (signed char*)(p.ws + OFF_S);
  const int n = ((l == 0) ? NTOK : NLAT) * 4;
  for (int i0 = (bid * 8 + wv) * 4; i0 < n; i0 += nb * 32) {
    const int tok = i0 >> 2;
    int sl4[4];
#pragma unroll
    for (int k = 0; k < 4; ++k) sl4[k] = toff[TOKE[i0 + k]] * 256 + TOKP[i0 + k];
    const uint4 row = *((const uint4*)(H8 + (size_t)tok * 1024) + lane);
    const float scl = SCL[tok];
    float g4[4];
#pragma unroll
    for (int k = 0; k < 4; ++k) g4[k] = TOKG[i0 + k];
#pragma unroll
    for (int k = 0; k < 4; ++k) {
      if (lane == 0) { TOKS[i0 + k] = sl4[k]; SLG[sl4[k]] = g4[k]; SLS[sl4[k]] = scl; }
      *((uint4*)(XG + (size_t)sl4[k] * 1024) + lane) = row;
    }
  }
  for (int e = 0; e < 32; ++e) {
    const int c = cnt[e];
    const int npad = ((c + 255) & ~255) - c;
    const int base = toff[e] * 256 + c;
    for (int r = bid * 8 + wv; r < npad; r += nb * 8) {
      uint4* dst = (uint4*)(XG + (size_t)(base + r) * 1024);
      dst[lane] = make_uint4(0u, 0u, 0u, 0u);
      if (lane == 0) SLS[base + r] = 0.f;
    }
  }
  __syncthreads();
}

struct EpiMoe1 {
  const float* bgu; const float* sw; const float* SLS; bfr* ACT;
  __device__ __forceinline__ void operator()(const i32x4 (&acc)[2][2][4][2], const g8::GUnit& u, int wr, int wc, int fr, int fq) const {
    const float* be = bgu + (size_t)u.e * 2048;
    const float* se = sw + (size_t)u.e * 2048;
    const int slot0 = u.pm * 256 + wr * 64 + fr;
    float sav[2][4];
#pragma unroll
    for (int ai = 0; ai < 2; ++ai)
#pragma unroll
      for (int m = 0; m < 4; ++m) sav[ai][m] = SLS[slot0 + ai * 128 + m * 16];
    f32x4 bgv[2], blv[2], sgv[2], slv[2];
#pragma unroll
    for (int bj = 0; bj < 2; ++bj) {
      const int j0 = u.pn * 128 + bj * 64 + wc * 16 + 4 * fq;
      bgv[bj] = *(const f32x4*)(be + j0); blv[bj] = *(const f32x4*)(be + 1024 + j0);
      sgv[bj] = *(const f32x4*)(se + j0); slv[bj] = *(const f32x4*)(se + 1024 + j0);
    }
#pragma unroll
    for (int bj = 0; bj < 2; ++bj) {
      const int j0 = u.pn * 128 + bj * 64 + wc * 16 + 4 * fq;
      const f32x4 bg = bgv[bj], bl = blv[bj];
      const f32x4 sg = sgv[bj], sl = slv[bj];
#pragma unroll
      for (int ai = 0; ai < 2; ++ai)
#pragma unroll
        for (int m = 0; m < 4; ++m) {
          const int slot = slot0 + ai * 128 + m * 16;
          const float sa = sav[ai][m];
          bf16x4 o;
#pragma unroll
          for (int q = 0; q < 4; ++q) {
            const float g = (float)acc[ai][bj][m][0][q] * (sa * sg[q]) + bg[q];
            const float li = (float)acc[ai][bj][m][1][q] * (sa * sl[q]) + bl[q];
            const float gv = fminf(g, 7.f);
            const float lv = fminf(fmaxf(li, -7.f), 7.f);
            o[q] = (short)f2bf(gv * sigmoidf_(1.702f * gv) * (lv + 1.f));
          }
          *(bf16x4*)(ACT + (size_t)slot * 1024 + j0) = o;
        }
    }
  }
};
__device__ __forceinline__ void phase_moe1_impl(PP pp, int l, int bid, int nb, char* smem, int* toff) {
  moe_offsets(pp, toff);
  g8::MoeSched S{toff, 8, 2048, nb, bid};
  EpiMoe1 E{p.moe_b_gu + (size_t)l * 32 * 2048, (const float*)(p.ws + OFF_SW) + (size_t)l * 32 * 2048, (const float*)(p.ws + OFF_SLS), (bfr*)(p.ws + OFF_P)};
  g8::gemm_stream<true>((LAS unsigned char*)smem, p.ws + OFF_S, p.ws + OFF_W + (size_t)l * WL_SIZE + WL_GU, S, E);
}

struct EpiMoe2 {
  const float* bdn; const float* SLG; bfr* YS;
  __device__ __forceinline__ void operator()(const f32x4 (&acc)[2][2][4][2], const g8::GUnit& u, int wr, int wc, int fr, int fq) const {
    const float* be = bdn + (size_t)u.e * 1024;
    const int slot0 = u.pm * 256 + wr * 64 + fr, col0 = u.pn * 256 + wc * 32 + 4 * fq;
    float gtv[2][4];
#pragma unroll
    for (int ai = 0; ai < 2; ++ai)
#pragma unroll
      for (int m = 0; m < 4; ++m) gtv[ai][m] = SLG[slot0 + ai * 128 + m * 16];
    f32x4 bvv[2][2];
#pragma unroll
    for (int bj = 0; bj < 2; ++bj)
#pragma unroll
      for (int n = 0; n < 2; ++n) bvv[bj][n] = *(const f32x4*)(be + col0 + bj * 128 + n * 16);
#pragma unroll
    for (int ai = 0; ai < 2; ++ai)
#pragma unroll
      for (int m = 0; m < 4; ++m) {
        const int slot = slot0 + ai * 128 + m * 16;
        const float gt = gtv[ai][m];
#pragma unroll
        for (int bj = 0; bj < 2; ++bj)
#pragma unroll
          for (int n = 0; n < 2; ++n) {
            const f32x4 bv = bvv[bj][n];
            const f32x4 yv = (acc[ai][bj][m][n] + bv) * gt;
            *(bf16x4*)(YS + (size_t)slot * 1024 + col0 + bj * 128 + n * 16) = pack4(yv[0], yv[1], yv[2], yv[3]);
          }
      }
  }
};
__device__ __forceinline__ void phase_moe2_impl(PP pp, int l, int bid, int nb, char* smem, int* toff) {
  moe_offsets(pp, toff);
  g8::MoeSched S{toff, 4, 1024, nb, bid};
  EpiMoe2 E{p.moe_b_down + (size_t)l * 32 * 1024, (const float*)(p.ws + OFF_SLG), (bfr*)(p.ws + OFF_S)};
  g8::gemm_stream<false>((LAS unsigned char*)smem, p.ws + OFF_P, p.ws + OFF_W + (size_t)l * WL_SIZE + WL_DN, S, E);
}

__device__ __forceinline__ void phase_combine(PP pp, int l, int bid, int nb) {
  const int tid = tid_opaque(), lane = tid & 63, wv = wave_id(tid);
  const bfr* YS = (const bfr*)(p.ws + OFF_S);
  const int* TOKS = (const int*)(p.ws + OFF_TOKS);
  const float* mods = (const float*)(p.ws + OFF_MODS) + (size_t)l * 3 * 6144;
  const float* mods1 = (const float*)(p.ws + OFF_MODS) + (size_t)3 * 6144;
  const float* g1n = p.norm_mix_g + 1024;
  bfr* H = (bfr*)(p.ws + OFF_H);
  float* xl = p.out;
  float* xc = (float*)(p.ws + OFF_CTX);
  const int ntok = (l == 0) ? NTOK : NLAT;
  if (l == 0) {
    int* cnt = (int*)(p.ws + OFF_CNT);
    const int gt = bid * NTHR + tid;
    if (gt < 32) cnt[gt] = 0;
  }
  for (int m = bid * 8 + wv; m < ntok; m += nb * 8) {
    float* xr = (m < NLAT) ? xl + (size_t)m * 1024 : xc + (size_t)(m - NLAT) * 1024;
    const float* g2 = mods + (size_t)mod_row(m) * 6144 + 5120;
    const int s0 = TOKS[(size_t)m * 4], s1 = TOKS[(size_t)m * 4 + 1], s2 = TOKS[(size_t)m * 4 + 2], s3 = TOKS[(size_t)m * 4 + 3];
    float4 xn[4];
    float ss = 0.f;
#pragma unroll
    for (int i = 0; i < 4; ++i) {
      const int d = (lane + 64 * i) * 4;
      const bf16x4 a = *(const bf16x4*)(YS + (size_t)s0 * 1024 + d);
      const bf16x4 b = *(const bf16x4*)(YS + (size_t)s1 * 1024 + d);
      const bf16x4 c = *(const bf16x4*)(YS + (size_t)s2 * 1024 + d);
      const bf16x4 e = *(const bf16x4*)(YS + (size_t)s3 * 1024 + d);
      const float4 gg = *(const float4*)(g2 + d);
      float4 xv = *(const float4*)(xr + d);
      xv.x += gg.x * ((bf2f(a[0]) + bf2f(b[0])) + (bf2f(c[0]) + bf2f(e[0])));
      xv.y += gg.y * ((bf2f(a[1]) + bf2f(b[1])) + (bf2f(c[1]) + bf2f(e[1])));
      xv.z += gg.z * ((bf2f(a[2]) + bf2f(b[2])) + (bf2f(c[2]) + bf2f(e[2])));
      xv.w += gg.w * ((bf2f(a[3]) + bf2f(b[3])) + (bf2f(c[3]) + bf2f(e[3])));
      *(float4*)(xr + d) = xv;
      xn[i] = xv;
      ss += xv.x * xv.x + xv.y * xv.y + xv.z * xv.z + xv.w * xv.w;
    }
    if (l == 0) {
      ss = wave_sum(ss);
      const float rs = rsqrtf(ss * (1.f / 1024.f) + 1e-6f);
      const float* md = mods1 + (size_t)mod_row(m) * 6144;
      float4 hq[4];
#pragma unroll
      for (int i = 0; i < 4; ++i) {
        const int d = (lane + 64 * i) * 4;
        const float4 gg = *(const float4*)(g1n + d);
        const float4 sh = *(const float4*)(md + d);
        const float4 sc = *(const float4*)(md + 1024 + d);
        hq[i] = make_float4(xn[i].x * rs * gg.x * (1.f + sc.x) + sh.x, xn[i].y * rs * gg.y * (1.f + sc.y) + sh.y,
                            xn[i].z * rs * gg.z * (1.f + sc.z) + sh.z, xn[i].w * rs * gg.w * (1.f + sc.w) + sh.w);
      }
      const float qs = quant_row_store(hq, (signed char*)(p.ws + OFF_H) + (size_t)m * 1024, lane);
      if (lane == 0) ((float*)(p.ws + OFF_SCL))[m] = qs;
    }
  }
}

#define XB_TMO      128
#define XB_XCNT(j)  (256  + 64 * (j))
#define XB_XSUB(j)  (1280 + 64 * (j))
#define XB_XGEN(j)  (2304 + 64 * (j))
#define XB_TOP      3328
#define XB_TOPGEN   3392
#define XCD_BAR_WORDS 3456
#define XB_SPIN_CAP (1u << 22)
__device__ __forceinline__ unsigned xb_ld(unsigned* q) { return __hip_atomic_load(q, __ATOMIC_RELAXED, __HIP_MEMORY_SCOPE_AGENT); }
__device__ __forceinline__ unsigned xb_add(unsigned* q, unsigned v) { return __hip_atomic_fetch_add(q, v, __ATOMIC_RELAXED, __HIP_MEMORY_SCOPE_AGENT); }
__device__ __forceinline__ unsigned xb_xcc_id() { return (unsigned)__builtin_amdgcn_s_getreg((3 << 11) | 20) & 0xFu; }
#define XB_SPIN(cond, bar) do { unsigned _sp = 0; while (cond) { __builtin_amdgcn_s_sleep(1); \
    if ((++_sp & 255u) == 0u) { if (xb_ld(&(bar)[XB_TMO])) break; if (_sp > XB_SPIN_CAP) { atomicAdd(&(bar)[XB_TMO], 1u); break; } } } } while (0)
struct XcdBarrier { unsigned* bar; unsigned x; volatile LAS unsigned* st; };
__device__ __forceinline__ XcdBarrier xcd_barrier_post(unsigned* bar, volatile LAS unsigned* st) {
  XcdBarrier b; b.bar = bar; b.x = xb_xcc_id(); b.st = st;
  if (tid_opaque() == 0) (void)xb_add(&bar[XB_XCNT(b.x)], 1u);
  return b;
}
__device__ __forceinline__ void xcd_barrier_complete(unsigned* bar, unsigned x, unsigned& nloc, unsigned& nx) {
  const unsigned G = gridDim.x;
  unsigned sum, cnt, mine, sp = 0u;
  for (;;) {
    sum = 0u; cnt = 0u; mine = 0u;
#pragma unroll
    for (unsigned j = 0; j < 16; ++j) { const unsigned c = xb_ld(&bar[XB_XCNT(j)]); sum += c; cnt += (c > 0u) ? 1u : 0u; mine = (j == x) ? c : mine; }
    if (sum == G) break;
    __builtin_amdgcn_s_sleep(1);
    if ((++sp & 255u) == 0u) { if (xb_ld(&bar[XB_TMO])) break; if (sp > XB_SPIN_CAP) { atomicAdd(&bar[XB_TMO], 1u); break; } }
  }
  nloc = mine > 0u ? mine : 1u; nx = cnt > 0u ? cnt : 1u;
}
__device__ __forceinline__ void xcd_barrier(const XcdBarrier& b) {
  asm volatile("s_waitcnt vmcnt(0)" ::: "memory");
  __syncthreads();
  if (tid_opaque() == 0) {
    unsigned* bar = b.bar;
    __builtin_amdgcn_s_waitcnt(0);
    unsigned nloc = b.st[0], nx = b.st[1];
    if (nloc == 0u) { xcd_barrier_complete(bar, b.x, nloc, nx); b.st[0] = nloc; b.st[1] = nx; }
    const unsigned old = xb_add(&bar[XB_XSUB(b.x)], 1u);
    const unsigned gen = old / nloc;
    if (old + 1u == (gen + 1u) * nloc) {
      __builtin_amdgcn_fence(__ATOMIC_RELEASE, "agent");
      asm volatile("s_waitcnt vmcnt(0)" ::: "memory");
      const unsigned og = xb_add(&bar[XB_TOP], 1u);
      const unsigned tg = og / nx;
      if (og + 1u == (tg + 1u) * nx) xb_add(&bar[XB_TOPGEN], 1u);
      else XB_SPIN(xb_ld(&bar[XB_TOPGEN]) == tg, bar);
      __builtin_amdgcn_fence(__ATOMIC_ACQUIRE, "agent");
      xb_add(&bar[XB_XGEN(b.x)], 1u);
      asm volatile("s_waitcnt vmcnt(0)" ::: "memory");
    } else {
      XB_SPIN(xb_ld(&bar[XB_XGEN(b.x)]) == gen, bar);
      __builtin_amdgcn_fence(__ATOMIC_ACQUIRE, "agent");
      asm volatile("s_waitcnt vmcnt(0)" ::: "memory");
    }
  }
  __syncthreads();
}

extern __shared__ __attribute__((aligned(16))) char dyn_smem[];

__global__ void __launch_bounds__(NTHR) mega(Params p_unused) {
  cg::grid_group grid = cg::this_grid();
  const int bid0 = blockIdx.x, nb0 = gridDim.x;
#if defined(__HIP_DEVICE_COMPILE__)
  PP pp0 = (PP)__builtin_amdgcn_kernarg_segment_ptr();
#else
  PP pp0 = nullptr;
#endif
#define pp ({ PP q_ = pp0; asm volatile("" : "+s"(q_)); q_; })
#define bid opq(bid0)
#define nb opq(nb0)
  int* toff_s = (int*)(dyn_smem + 147456);
  volatile LAS unsigned* xb_st = (volatile LAS unsigned*)(dyn_smem + 147456 + 256);
  {
    unsigned* barw = (unsigned*)(fresh_ws(pp0) + OFF_BAR);
    if (blockIdx.x == 0) for (int i = threadIdx.x; i < XCD_BAR_WORDS; i += NTHR) barw[i] = 0u;
    if (threadIdx.x == 0) { xb_st[0] = 0u; xb_st[1] = 0u; }
  }
  grid.sync();
  const XcdBarrier xb = xcd_barrier_post((unsigned*)(fresh_ws(pp0) + OFF_BAR), xb_st);
#define GSYNC() xcd_barrier(xb)
  phase_ada(pp, bid, nb, dyn_smem);
  phase_convert(pp, 0, 0, bid, nb, dyn_smem);
  GSYNC();
#define LAYER(LV, LAST)                                      \
  {                                                          \
    if ((LV) == 0) { phase_prenorm(pp, opq(LV), bid, nb); GSYNC(); } \
    phase_gemm_in(pp, opq(LV), bid, nb, dyn_smem);           \
    GSYNC();                                                 \
    phase_prep(pp, opq(LV), bid, nb, dyn_smem);              \
    GSYNC();                                                 \
    phase_chunk_prep(pp, bid, nb, dyn_smem);                 \
    GSYNC();                                                 \
    phase_mix(pp, opq(LV), bid, nb, dyn_smem);               \
    GSYNC();                                                 \
    phase_post(pp, opq(LV), bid, nb);                        \
    GSYNC();                                                 \
    phase_gemm_out(pp, opq(LV), bid, nb, dyn_smem);          \
    GSYNC();                                                 \
    phase_router(pp, opq(LV), bid, nb, dyn_smem);            \
    GSYNC();                                                 \
    phase_slotfill(pp, opq(LV), bid, nb, dyn_smem);          \
    GSYNC();                                                 \
    phase_moe1_impl(pp, opq(LV), bid, nb, dyn_smem, toff_s); \
    GSYNC();                                                 \
    phase_moe2_impl(pp, opq(LV), bid, nb, dyn_smem, toff_s); \
    GSYNC();                                                 \
    phase_combine(pp, opq(LV), bid, nb);                     \
    if (!(LAST)) GSYNC();                                    \
  }
  LAYER(0, false)
  LAYER(1, true)
#undef LAYER
#undef GSYNC
#undef bid
#undef nb
#undef pp
}

#undef p
extern "C" void kernel_launch(void* const* d_in, const int* in_sizes, int n_in, void* d_out, int out_size, void* d_ws,
                              size_t ws_size, hipStream_t stream) {
  Params hp{};
  const float** pp = (const float**)&hp;
  for (int i = 0; i < 34; ++i) pp[i] = (const float*)d_in[i];
  hp.out = (float*)d_out;
  hp.ws = (char*)d_ws;
  static int grid_blocks = 0;
  if (!grid_blocks) {
    (void)hipFuncSetAttribute((const void*)mega, hipFuncAttributeMaxDynamicSharedMemorySize, LDS_BYTES);
    int dev = 0, cus = 0, per_cu = 0;
    (void)hipGetDevice(&dev);
    (void)hipDeviceGetAttribute(&cus, hipDeviceAttributeMultiprocessorCount, dev);
    (void)hipOccupancyMaxActiveBlocksPerMultiprocessor(&per_cu, mega, NTHR, LDS_BYTES);
    if (per_cu < 1) per_cu = 1;
    if (per_cu > 1) per_cu = 1;
    grid_blocks = cus * per_cu;
  }
  void* args[] = {&hp};
  (void)hipLaunchCooperativeKernel((void*)mega, dim3(grid_blocks), dim3(NTHR), args, LDS_BYTES, stream);
}
```

```cpp
#include <hip/hip_runtime.h>
#include <hip/hip_bf16.h>
#include <hip/hip_cooperative_groups.h>
#include <stdint.h>
#include <type_traits>
namespace cg = cooperative_groups;

typedef __attribute__((ext_vector_type(8))) short bf16x8;
typedef __attribute__((ext_vector_type(4))) short bf16x4;
typedef __attribute__((ext_vector_type(4))) float f32x4;
typedef __attribute__((ext_vector_type(4))) int i32x4;
typedef unsigned short bfr;

#define D_MODEL 1024
#define NB 2
#define SEQ 16384
#define CTXL 256
#define NLAT (NB * SEQ)
#define NCTX (NB * CTXL)
#define NTOK (NLAT + NCTX)
#define TTOK (SEQ + CTXL)
#define PIN 3472
#define PINP 3584
#define A_END 1536
#define B_END 2432
#define NEXP 32
#define NSLOT_MAX (NTOK * 4 + NEXP * 256)
#define NTHR 512
#define LDS_BYTES (147456 + 512)

constexpr size_t al256(size_t x) { return (x + 255) & ~(size_t)255; }
constexpr size_t WL_IN = 0;
constexpr size_t WL_OUT = WL_IN + (size_t)PINP * 1024 * 2;
constexpr size_t WL_GU = WL_OUT + (size_t)1024 * 1024 * 2;
constexpr size_t WL_DN = WL_GU + (size_t)32 * 2048 * 1024 * 2;
constexpr size_t WL_SIZE = WL_DN + (size_t)32 * 1024 * 1024 * 2;
constexpr size_t OFF_W = 0;
constexpr size_t OFF_MODS = al256(OFF_W + 2 * WL_SIZE);
constexpr size_t OFF_BAR = al256(OFF_MODS + 2 * 3 * 6144 * 4);
constexpr size_t OFF_SW = al256(OFF_BAR + 3456 * 4);
constexpr size_t OFF_SWIN = al256(OFF_SW + (size_t)2 * 32 * 2048 * 4);
constexpr size_t OFF_SLS = al256(OFF_SWIN + (size_t)2 * PINP * 4);
constexpr size_t OFF_SCL = al256(OFF_SLS + (size_t)(NTOK * 4 + 32 * 256) * 4);
constexpr size_t OFF_CTX = al256(OFF_SCL + (size_t)NTOK * 4);
constexpr size_t OFF_CNT = al256(OFF_CTX + (size_t)NCTX * 1024 * 4);
constexpr size_t OFF_TOKE = al256(OFF_CNT + 256);
constexpr size_t OFF_TOKP = al256(OFF_TOKE + (size_t)NTOK * 4 * 4);
constexpr size_t OFF_TOKG = al256(OFF_TOKP + (size_t)NTOK * 4 * 4);
constexpr size_t OFF_TOKS = al256(OFF_TOKG + (size_t)NTOK * 4 * 4);
constexpr size_t OFF_SLT = al256(OFF_TOKS + (size_t)NTOK * 4 * 4);
constexpr size_t OFF_SLG = al256(OFF_SLT + (size_t)NSLOT_MAX * 4);
constexpr size_t OFF_H = al256(OFF_SLG + (size_t)NSLOT_MAX * 4);
constexpr size_t OFF_CC = al256(OFF_H + (size_t)NTOK * 1024 * 2);
constexpr size_t OFF_P = al256(OFF_CC + (size_t)NTOK * 1024 * 2);
constexpr size_t OFF_S = al256(OFF_P + (size_t)NTOK * PINP * 4);
constexpr size_t TOK256F = (size_t)NTOK * 256 * 4;
constexpr size_t S_QN = 0;
constexpr size_t S_KN = S_QN + (size_t)NTOK * 512 * 2;
constexpr size_t S_VT = S_KN + (size_t)NTOK * 512 * 2;
constexpr size_t S_RWR = S_VT + (size_t)NB * 8 * 64 * TTOK * 2;
constexpr size_t S_RWKK = S_RWR + TOK256F;
constexpr size_t S_RWV = S_RWKK + TOK256F;
constexpr size_t S_RWG = S_RWV + TOK256F;
constexpr size_t S_RWW = S_RWG + TOK256F;
constexpr size_t S_RWKD = S_RWW + 2 * TOK256F;
constexpr size_t S_RWB = S_RWKD + 2 * TOK256F;
constexpr size_t S_BON = S_RWB + 2 * TOK256F;
constexpr size_t S_GDQ = al256(S_BON + (size_t)NTOK * 4 * 4);
constexpr size_t S_GDK = S_GDQ + TOK256F;
constexpr size_t S_GDV = S_GDK + TOK256F;
constexpr size_t S_GDAB = S_GDV + TOK256F;
constexpr size_t S_YRW = al256(S_GDAB + (size_t)NTOK * 16 * 4);
constexpr size_t S_YGD = S_YRW + 2 * TOK256F;
constexpr size_t S_END = S_YGD + 2 * TOK256F;
constexpr size_t S_SIZE = (S_END > (size_t)NSLOT_MAX * 1024 * 4) ? S_END : (size_t)NSLOT_MAX * 1024 * 4;
constexpr int NCHUNK = TTOK / 64;
constexpr int NCHAIN = 32;
constexpr size_t OFF_CH = al256(OFF_S + S_SIZE);
constexpr size_t CH_N = (size_t)NCHAIN * NCHUNK;
constexpr size_t CH_REC = 32768, CH_PT = 0, CH_RYT = 8192, CH_QT = 16384, CH_YX = 24576;
constexpr size_t CH_SIZE = CH_N * CH_REC;
constexpr size_t WS_TOTAL = OFF_CH + CH_SIZE;
static_assert(WS_TOTAL <= (size_t)2048 * 1024 * 1024, "workspace exceeds 4x largest tensor");

struct Params {
  const float *x, *c, *ctx, *c_ctx, *ada_w, *ada_b, *norm_mix_g, *norm_ffn_g, *w_in, *w_out;
  const float *na_q_gain, *na_k_gain, *na_rpb;
  const float *rw_mu, *rw_w0, *rw_w_up, *rw_a0, *rw_a_up, *rw_g_up, *rw_k_k, *rw_k_a, *rw_r_k, *rw_ln_w, *rw_ln_b;
  const float *gd_conv_w, *gd_A_log, *gd_dt_bias, *gd_norm_g;
  const float *moe_router_w, *moe_router_b, *moe_w_gu, *moe_b_gu, *moe_w_down, *moe_b_down;
  float* out;
  char* ws;
};

typedef const __attribute__((address_space(4))) Params* PP;
#define p (*pp)
__device__ __forceinline__ char* fresh_ws(PP pp) { return p.ws; }
__device__ __forceinline__ int tid_opaque() { int t = (int)__builtin_amdgcn_workitem_id_x(); asm volatile("" : "+v"(t)); return t; }
__device__ __forceinline__ int opq(int x) { asm volatile("" : "+s"(x)); return x; }
__device__ __forceinline__ int wave_id(int tid) { return __builtin_amdgcn_readfirstlane(tid >> 6); }
typedef __bf16 bf16v2_t __attribute__((ext_vector_type(2)));
typedef float f32v2_t __attribute__((ext_vector_type(2)));
__device__ __forceinline__ unsigned pk_bf16(float lo, float hi) { f32v2_t v = {lo, hi}; return __builtin_bit_cast(unsigned, __builtin_convertvector(v, bf16v2_t)); }
__device__ __forceinline__ bfr f2bf(float f) { return (bfr)(pk_bf16(f, f) & 0xffffu); }
__device__ __forceinline__ float bf2f(short v) { return __uint_as_float(((unsigned)(unsigned short)v) << 16); }
__device__ __forceinline__ bf16x4 pack4(float a, float b, float c, float d) {
  typedef __attribute__((ext_vector_type(2))) unsigned u32x2;
  u32x2 w; w[0] = pk_bf16(a, b); w[1] = pk_bf16(c, d);
  return __builtin_bit_cast(bf16x4, w);
}
__device__ __forceinline__ float sigmoidf_(float x) { return __builtin_amdgcn_rcpf(1.f + __expf(-x)); }
__device__ __forceinline__ float siluf_(float x) { return x * __builtin_amdgcn_rcpf(1.f + __expf(-x)); }
__device__ __forceinline__ float softplusf_(float x) { const float e = __expf(x); return x > 20.f ? x : (x < -15.f ? e : __logf(1.f + e)); }
__device__ __forceinline__ float wave_sum(float v) {
  v += __builtin_bit_cast(float, __builtin_amdgcn_update_dpp(0, __builtin_bit_cast(int, v), 0xB1, 0xF, 0xF, true));
  v += __builtin_bit_cast(float, __builtin_amdgcn_update_dpp(0, __builtin_bit_cast(int, v), 0x4E, 0xF, 0xF, true));
  v += __builtin_bit_cast(float, __builtin_amdgcn_update_dpp(0, __builtin_bit_cast(int, v), 0x141, 0xF, 0xF, true));
  v += __builtin_bit_cast(float, __builtin_amdgcn_update_dpp(0, __builtin_bit_cast(int, v), 0x140, 0xF, 0xF, true));
  v += __builtin_bit_cast(float, __builtin_amdgcn_update_dpp(0, __builtin_bit_cast(int, v), 0x142, 0xA, 0xF, false));
  v += __builtin_bit_cast(float, __builtin_amdgcn_update_dpp(0, __builtin_bit_cast(int, v), 0x143, 0xC, 0xF, false));
  return __builtin_bit_cast(float, __builtin_amdgcn_readlane(__builtin_bit_cast(int, v), 63));
}
__device__ __forceinline__ float wave_max(float v) {
  v = fmaxf(v, __builtin_bit_cast(float, __builtin_amdgcn_update_dpp(0, __builtin_bit_cast(int, v), 0xB1, 0xF, 0xF, true)));
  v = fmaxf(v, __builtin_bit_cast(float, __builtin_amdgcn_update_dpp(0, __builtin_bit_cast(int, v), 0x4E, 0xF, 0xF, true)));
  v = fmaxf(v, __builtin_bit_cast(float, __builtin_amdgcn_update_dpp(0, __builtin_bit_cast(int, v), 0x141, 0xF, 0xF, true)));
  v = fmaxf(v, __builtin_bit_cast(float, __builtin_amdgcn_update_dpp(0, __builtin_bit_cast(int, v), 0x140, 0xF, 0xF, true)));
  const float r1 = __builtin_bit_cast(float, __builtin_amdgcn_readlane(__builtin_bit_cast(int, v), 0));
  const float r2 = __builtin_bit_cast(float, __builtin_amdgcn_readlane(__builtin_bit_cast(int, v), 16));
  const float r3 = __builtin_bit_cast(float, __builtin_amdgcn_readlane(__builtin_bit_cast(int, v), 32));
  const float r4 = __builtin_bit_cast(float, __builtin_amdgcn_readlane(__builtin_bit_cast(int, v), 48));
  return fmaxf(fmaxf(r1, r2), fmaxf(r3, r4));
}
__device__ __forceinline__ float shfl_xor_l(float v, int mask, int lane) {
  return __builtin_bit_cast(float, __builtin_amdgcn_ds_bpermute((lane ^ mask) << 2, __builtin_bit_cast(int, v)));
}
__device__ __forceinline__ int shfl_xor_li(int v, int mask, int lane) {
  return __builtin_amdgcn_ds_bpermute((lane ^ mask) << 2, v);
}
__device__ __forceinline__ float row16_sum(float v) {
  v += __builtin_bit_cast(float, __builtin_amdgcn_update_dpp(0, __builtin_bit_cast(int, v), 0xB1, 0xF, 0xF, true));
  v += __builtin_bit_cast(float, __builtin_amdgcn_update_dpp(0, __builtin_bit_cast(int, v), 0x4E, 0xF, 0xF, true));
  v += __builtin_bit_cast(float, __builtin_amdgcn_update_dpp(0, __builtin_bit_cast(int, v), 0x141, 0xF, 0xF, true));
  v += __builtin_bit_cast(float, __builtin_amdgcn_update_dpp(0, __builtin_bit_cast(int, v), 0x140, 0xF, 0xF, true));
  return v;
}
__device__ __forceinline__ float quant_row_store(const float4 (&v)[4], signed char* dst_row, int lane) {
  float am = 0.f;
#pragma unroll
  for (int i = 0; i < 4; ++i) am = fmaxf(fmaxf(am, fmaxf(fabsf(v[i].x), fabsf(v[i].y))), fmaxf(fabsf(v[i].z), fabsf(v[i].w)));
  am = wave_max(am);
  const float sc = am > 0.f ? am * (1.f / 127.f) : 1.f, iv = 1.f / sc;
#pragma unroll
  for (int i = 0; i < 4; ++i) {
    const int q0 = (int)fminf(fmaxf(rintf(v[i].x * iv), -127.f), 127.f), q1 = (int)fminf(fmaxf(rintf(v[i].y * iv), -127.f), 127.f);
    const int q2 = (int)fminf(fmaxf(rintf(v[i].z * iv), -127.f), 127.f), q3 = (int)fminf(fmaxf(rintf(v[i].w * iv), -127.f), 127.f);
    *(unsigned*)(dst_row + (lane + 64 * i) * 4) = (unsigned)(q0 & 0xff) | ((unsigned)(q1 & 0xff) << 8) | ((unsigned)(q2 & 0xff) << 16) | ((unsigned)(q3 & 0xff) << 24);
  }
  return sc;
}
__device__ __forceinline__ int mod_row(int m) { return m < NLAT ? (m >> 14) : 2; }

__device__ __forceinline__ void phase_ada(PP pp, int bid, int nb, char* smem) {
  float* red = (float*)smem;
  float* mods = (float*)(p.ws + OFF_MODS);
  const int tid = tid_opaque();
  for (int task = bid; task < 2 * 96; task += nb) {
    int l = task / 96, cgp = task % 96;
    int col = cgp * 64 + (tid & 63), ks = tid >> 6;
    const float* W = p.ada_w + (size_t)l * 1024 * 6144;
    float a0 = 0.f, a1 = 0.f, a2 = 0.f;
    for (int d = ks * 128; d < ks * 128 + 128; ++d) {
      float w = W[(size_t)d * 6144 + col];
      a0 += siluf_(p.c[d]) * w;
      a1 += siluf_(p.c[1024 + d]) * w;
      a2 += siluf_(p.c_ctx[d]) * w;
    }
    red[(ks * 3 + 0) * 64 + (tid & 63)] = a0;
    red[(ks * 3 + 1) * 64 + (tid & 63)] = a1;
    red[(ks * 3 + 2) * 64 + (tid & 63)] = a2;
    __syncthreads();
    if (tid < 192) {
      int r = tid >> 6, cc = tid & 63;
      float s = 0.f;
      for (int k = 0; k < 8; ++k) s += red[(k * 3 + r) * 64 + cc];
      mods[(size_t)(l * 3 + r) * 6144 + cgp * 64 + cc] = s + p.ada_b[(size_t)l * 6144 + cgp * 64 + cc];
    }
    __syncthreads();
  }
}

__device__ __forceinline__ void convert_tile(const float* src, int N, bfr* dst, int kt4  , int nt, float* tile  ) {
  const int tid = tid_opaque();
  float4 v[8];
#pragma unroll
  for (int q = 0; q < 8; ++q) {
    const int idx = tid + q * 512;
    const int kk = idx >> 4, n4 = idx & 15;
    v[q] = *(const float4*)(src + (size_t)(kt4 * 256 + kk) * N + nt * 64 + n4 * 4);
  }
#pragma unroll
  for (int q = 0; q < 8; ++q) {
    const int idx = tid + q * 512;
    const int kk = idx >> 4, n4 = idx & 15;
    tile[kk * 65 + n4 * 4 + 0] = v[q].x; tile[kk * 65 + n4 * 4 + 1] = v[q].y;
    tile[kk * 65 + n4 * 4 + 2] = v[q].z; tile[kk * 65 + n4 * 4 + 3] = v[q].w;
  }
  __syncthreads();
  {
    const int nn = tid >> 3, kc = tid & 7;
    const int n = nt * 64 + nn;
#pragma unroll
    for (int q = 0; q < 4; ++q) {
      const int k0 = (kc + 8 * q) * 8;
      *(bf16x4*)(dst + (size_t)n * 1024 + kt4 * 256 + k0) = pack4(tile[(k0 + 0) * 65 + nn], tile[(k0 + 1) * 65 + nn], tile[(k0 + 2) * 65 + nn], tile[(k0 + 3) * 65 + nn]);
      *(bf16x4*)(dst + (size_t)n * 1024 + kt4 * 256 + k0 + 4) = pack4(tile[(k0 + 4) * 65 + nn], tile[(k0 + 5) * 65 + nn], tile[(k0 + 6) * 65 + nn], tile[(k0 + 7) * 65 + nn]);
    }
  }
  __syncthreads();
}
template <int N, bool INTERLEAVE>
__device__ __forceinline__ void convert_i8(const float* src  , signed char* dst  , float* sw, int ng, char* smem) {
  const int tid = tid_opaque();
  bfr* blk = (bfr*)smem;
  int* cmax = (int*)(smem + 131072);
  if (tid < 64) cmax[tid] = 0;
  __syncthreads();
  {
    const int n4 = tid & 15, kk0 = tid >> 4;
    float m0 = 0.f, m1 = 0.f, m2 = 0.f, m3 = 0.f;
#pragma unroll 8
    for (int ps = 0; ps < 32; ++ps) {
      const int k = ps * 32 + kk0;
      float4 v = make_float4(0.f, 0.f, 0.f, 0.f);
      if (ng * 64 + n4 * 4 < N) v = *(const float4*)(src + (size_t)k * N + ng * 64 + n4 * 4);
      m0 = fmaxf(m0, fabsf(v.x)); m1 = fmaxf(m1, fabsf(v.y)); m2 = fmaxf(m2, fabsf(v.z)); m3 = fmaxf(m3, fabsf(v.w));
      *(bf16x4*)(blk + k * 64 + n4 * 4) = pack4(v.x, v.y, v.z, v.w);
    }
    atomicMax(&cmax[n4 * 4 + 0], __float_as_int(m0)); atomicMax(&cmax[n4 * 4 + 1], __float_as_int(m1));
    atomicMax(&cmax[n4 * 4 + 2], __float_as_int(m2)); atomicMax(&cmax[n4 * 4 + 3], __float_as_int(m3));
  }
  __syncthreads();
  {
    const int nn = tid >> 3, kc = tid & 7;
    const int n = ng * 64 + nn;
    const float am = __int_as_float(cmax[nn]);
    const float sc = am > 0.f ? am * (1.f / 127.f) : 1.f, iv = 1.f / sc;
    const int j = n & 1023;
    const int row = INTERLEAVE ? (j >> 4) * 32 + (j & 15) + ((n >= 1024) ? 16 : 0) : n;
    if (kc == 0) sw[n] = sc;
#pragma unroll 2
    for (int q = 0; q < 8; ++q) {
      const int k0 = (kc + 8 * q) * 16;
      unsigned w[4];
#pragma unroll
      for (int g4 = 0; g4 < 4; ++g4) {
        unsigned acc = 0u;
#pragma unroll
        for (int b = 0; b < 4; ++b) {
          const float v = bf2f((short)blk[(k0 + g4 * 4 + b) * 64 + nn]);
          const int qi = (int)fminf(fmaxf(rintf(v * iv), -127.f), 127.f);
          acc |= ((unsigned)(qi & 0xff)) << (8 * b);
        }
        w[g4] = acc;
      }
      *(uint4*)(dst + (size_t)row * 1024 + k0) = make_uint4(w[0], w[1], w[2], w[3]);
    }
  }
  __syncthreads();
}
__device__ __forceinline__ void phase_convert(PP pp, int l, int part, int bid, int nb, char* smem) {
  float* tile = (float*)smem;
  char* wl = p.ws + OFF_W + (size_t)l * WL_SIZE;
  const int T_IN = 56, T_OUT = 4 * 16, T_GU = 32 * 32, T_DN = 32 * 4 * 16;
  const int t_lo = part == 0 ? 0 : T_IN + T_OUT;
  const int t_hi = part == 0 ? T_IN + T_OUT : T_IN + T_OUT + T_GU + T_DN;
  for (int t = t_lo + bid; t < t_hi; t += nb) {
    if (t < T_IN) {
      convert_i8<PIN, false>(p.w_in + (size_t)l * 1024 * PIN, (signed char*)(wl + WL_IN), (float*)(p.ws + OFF_SWIN) + (size_t)l * PINP, t, smem);
    } else if (t < T_IN + T_OUT) {
      int u = t - T_IN; int kt4 = u / 16, nt = u % 16;
      convert_tile(p.w_out + (size_t)l * 1024 * 1024, 1024, (bfr*)(wl + WL_OUT), kt4, nt, tile);
    } else if (t < T_IN + T_OUT + T_GU) {
      int u = t - T_IN - T_OUT; int e = u / 32, ng = u % 32;
      convert_i8<2048, true>(p.moe_w_gu + ((size_t)l * 32 + e) * 1024 * 2048, (signed char*)(wl + WL_GU) + (size_t)e * 2048 * 1024,
                    (float*)(p.ws + OFF_SW) + ((size_t)l * 32 + e) * 2048, ng, smem);
    } else {
      int u = t - T_IN - T_OUT - T_GU; int e = u / 64; int v = u % 64; int kt4 = v / 16, nt = v % 16;
      convert_tile(p.moe_w_down + ((size_t)l * 32 + e) * 1024 * 1024, 1024, (bfr*)(wl + WL_DN) + (size_t)e * 1024 * 1024, kt4, nt, tile);
    }
  }
}

__device__ __forceinline__ void phase_prenorm(PP pp, int l, int bid, int nb) {
  const int tid = tid_opaque(), lane = tid & 63, wv = wave_id(tid);
  const float* xl = (l == 0) ? p.x : p.out;
  const float* xc = (l == 0) ? p.ctx : (const float*)(p.ws + OFF_CTX);
  const float* mods = (const float*)(p.ws + OFF_MODS) + (size_t)l * 3 * 6144;
  const float* g = p.norm_mix_g + (size_t)l * 1024;
  signed char* H8 = (signed char*)(p.ws + OFF_H);
  float* SCL = (float*)(p.ws + OFF_SCL);
  {
    int* cnt = (int*)(p.ws + OFF_CNT);
    int gt = bid * NTHR + tid;
    if (gt < 32) cnt[gt] = 0;
  }
  for (int m = bid * 8 + wv; m < NTOK; m += nb * 8) {
    const float* xr = (m < NLAT) ? xl + (size_t)m * 1024 : xc + (size_t)(m - NLAT) * 1024;
    const float* md = mods + (size_t)mod_row(m) * 6144;
    float4 v[4];
    float ss = 0.f;
#pragma unroll
    for (int i = 0; i < 4; ++i) {
      v[i] = *(const float4*)(xr + (lane + 64 * i) * 4);
      ss += v[i].x * v[i].x + v[i].y * v[i].y + v[i].z * v[i].z + v[i].w * v[i].w;
    }
    ss = wave_sum(ss);
    float rs = rsqrtf(ss * (1.f / 1024.f) + 1e-6f);
    float4 hq[4];
#pragma unroll
    for (int i = 0; i < 4; ++i) {
      int d = (lane + 64 * i) * 4;
      float4 gg = *(const float4*)(g + d);
      float4 sh = *(const float4*)(md + d);
      float4 sc = *(const float4*)(md + 1024 + d);
      hq[i] = make_float4(v[i].x * rs * gg.x * (1.f + sc.x) + sh.x, v[i].y * rs * gg.y * (1.f + sc.y) + sh.y,
                          v[i].z * rs * gg.z * (1.f + sc.z) + sh.z, v[i].w * rs * gg.w * (1.f + sc.w) + sh.w);
    }
    const float qs = quant_row_store(hq, H8 + (size_t)m * 1024, lane);
    if (lane == 0) SCL[m] = qs;
  }
}

#define LAS __attribute__((address_space(3)))
namespace g8 {
constexpr int BM = 256, BK = 64, HALF = 128, HTB = HALF * BK * 2, STAGE_BYTES = 8 * HTB, KD = 1024;
__device__ __forceinline__ int lds_byte(int r, int c) { const int st = (r >> 4) * 2 + (c >> 5), rr = r & 15, cc = c & 31, ob = rr * 64 + cc * 2; return st * 1024 + (ob ^ (((ob >> 9) & 1) << 5)); }
__device__ __forceinline__ void stage_rc(int b, int& R, int& C) { const int st = b / 1024, sb = b % 1024, swz = sb ^ (((sb >> 9) & 1) << 5); R = (st >> 1) * 16 + swz / 64; C = (st & 1) * 32 + (swz % 64) / 2; }
struct GUnit { int pm, pn, brow0, e; };
__device__ __forceinline__ int unit_index(int i, int c, int G, int total) {
  const int x = c & 7, j = c >> 3, q = total >> 3, r = total & 7;
  const int start = x < r ? x * (q + 1) : r * (q + 1) + (x - r) * q;
  const int size = q + (x < r ? 1 : 0);
  const int li = i * (G >> 3) + j;
  return li < size ? start + li : -1;
}

__device__ __forceinline__ f32x4 mma16(bf16x8 a, bf16x8 b, f32x4 c) { return __builtin_amdgcn_mfma_f32_16x16x32_bf16(a, b, c, 0, 0, 0); }
__device__ __forceinline__ i32x4 mma16(i32x4 a, i32x4 b, i32x4 c) { return __builtin_amdgcn_mfma_i32_16x16x64_i8(a, b, c, 0, 0, 0); }
template <bool I8, class Sched, class Epi>
__device__ __forceinline__ void gemm_stream(LAS unsigned char* lds, const void* Abase, const void* Btbase, const Sched& S, const Epi& E) {
  typedef typename std::conditional<I8, i32x4, f32x4>::type AccT;
  typedef typename std::conditional<I8, i32x4, bf16x8>::type FragT;
  constexpr int KB = I8 ? KD : KD * 2;
  const int tid = tid_opaque(), wid = __builtin_amdgcn_readfirstlane(tid >> 6), lane = tid & 63, wr = wid >> 2, wc = wid & 3, fr = lane & 15, fq = lane >> 4;
  constexpr int nt = KB / 128;
  int R[2], C[2];
  unsigned voffB[2];
#pragma unroll
  for (int i = 0; i < 2; ++i) { stage_rc(tid * 16 + i * 8192, R[i], C[i]); voffB[i] = (unsigned)(R[i] * KB + C[i] * 2); }
#define voffA voffB
  constexpr size_t kstep = (size_t)(BK * 2);
  constexpr size_t hstep = (size_t)HALF * KB;
  const unsigned ldsw = (unsigned)wid * 1024u;
  const int aoff = lds_byte(wr * 64 + fr, fq * 8), boff = lds_byte(wc * 32 + fr, fq * 8);
#define G8_SA(b, h) (((b) * 2 + (h)) * HTB)
#define G8_SB(b, h) ((4 + (b) * 2 + (h)) * HTB)
#define G8_STAGE(bufoff, gbase, v0, v1) do { \
    __builtin_amdgcn_global_load_lds((const unsigned*)((const char*)(gbase) + (v0)), (LAS unsigned*)(lds + (bufoff) + ldsw), 16, 0, 0); \
    __builtin_amdgcn_global_load_lds((const unsigned*)((const char*)(gbase) + (v1)), (LAS unsigned*)(lds + (bufoff) + ldsw + 8192), 16, 0, 0); } while (0)
#define G8_STAGEB(bufoff, gbase) G8_STAGE(bufoff, gbase, voffB[0], voffB[1])
#define G8_STAGEA(bufoff, gbase) G8_STAGE(bufoff, gbase, voffA[0], voffA[1])
#define G8_LDA(dst, b, h) do { _Pragma("unroll") for (int m = 0; m < 4; ++m) _Pragma("unroll") for (int k = 0; k < 2; ++k) dst[m][k] = *(const LAS FragT*)(lds + G8_SA(b, h) + aoff + m * 2048 + k * 1024); } while (0)
#define G8_LDB(dst, b, h) do { _Pragma("unroll") for (int n = 0; n < 2; ++n) _Pragma("unroll") for (int k = 0; k < 2; ++k) dst[n][k] = *(const LAS FragT*)(lds + G8_SB(b, h) + boff + n * 2048 + k * 1024); } while (0)
#define G8_MMA(ai, bj, At, Bt) do { __builtin_amdgcn_s_setprio(1); _Pragma("unroll") for (int m = 0; m < 4; ++m) _Pragma("unroll") for (int n = 0; n < 2; ++n) _Pragma("unroll") for (int k = 0; k < 2; ++k) \
    acc[ai][bj][m][n] = mma16(Bt[n][k], At[m][k], acc[ai][bj][m][n]); __builtin_amdgcn_s_setprio(0); } while (0)
#define G8_WAIT_V(n) asm volatile("s_waitcnt vmcnt(" #n ")" ::: "memory")
#define G8_WAIT_L(n) asm volatile("s_waitcnt lgkmcnt(" #n ")" ::: "memory")
#define G8_BAR __builtin_amdgcn_s_barrier()
#define G8_SCHED __builtin_amdgcn_sched_barrier(0)
  GUnit cur, nxt;
  int ui = 0;
  if (!S.next(0, cur)) return;
  AccT acc[2][2][4][2];
#pragma unroll
  for (int a = 0; a < 2; ++a)
#pragma unroll
    for (int b = 0; b < 2; ++b)
#pragma unroll
      for (int m = 0; m < 4; ++m)
#pragma unroll
        for (int n = 0; n < 2; ++n) acc[a][b][m][n] = AccT{};
  FragT At[4][2], B0[2][2], B1[2][2];
  const char* cA = (const char*)Abase + (size_t)cur.pm * (BM * KB);
  const char* cB = (const char*)Btbase + (size_t)cur.brow0 * KB;
  G8_STAGEB(G8_SB(0, 0), cB); G8_STAGEA(G8_SA(0, 0), cA); G8_STAGEB(G8_SB(0, 1), cB + hstep); G8_STAGEA(G8_SA(0, 1), cA + hstep);
  if (wr == 1) G8_BAR;
  G8_WAIT_V(4); G8_BAR;
  G8_STAGEB(G8_SB(1, 0), cB + kstep); G8_STAGEA(G8_SA(1, 0), cA + kstep); G8_STAGEB(G8_SB(1, 1), cB + hstep + kstep);
  G8_WAIT_V(6); G8_BAR;
  for (;;) {
    const bool has_next = S.next(ui + 1, nxt);
    const char* nA = has_next ? (const char*)Abase + (size_t)nxt.pm * (BM * KB) : cA;
    const char* nB = has_next ? (const char*)Btbase + (size_t)nxt.brow0 * KB : cB;
#pragma unroll 1
    for (int t = 0; t < nt; t += 2) {
      const bool last = (t == nt - 2);
      const char* a1 = cA + (size_t)(t + 1) * kstep;
      const char* a2 = last ? nA : cA + (size_t)(t + 2) * kstep;
      const char* b2 = last ? nB : cB + (size_t)(t + 2) * kstep;
      const char* a3 = a2 + kstep;
      const char* b3 = b2 + kstep;
      G8_LDB(B0, 0, 0); G8_SCHED; G8_LDA(At, 0, 0); G8_STAGEA(G8_SA(1, 1), a1 + hstep);
      G8_WAIT_L(8); G8_BAR; G8_WAIT_L(0); G8_MMA(0, 0, At, B0); G8_BAR; G8_SCHED;
      G8_LDB(B1, 0, 1); G8_STAGEB(G8_SB(0, 0), b2);
      G8_BAR; G8_WAIT_L(0); G8_MMA(0, 1, At, B1); G8_BAR;
      G8_LDA(At, 0, 1); G8_STAGEA(G8_SA(0, 0), a2);
      G8_BAR; G8_WAIT_L(0); G8_MMA(1, 0, At, B0); G8_BAR; G8_SCHED;
      G8_STAGEB(G8_SB(0, 1), b2 + hstep);
      G8_WAIT_V(6); G8_BAR; G8_MMA(1, 1, At, B1); G8_BAR;
      G8_LDB(B0, 1, 0); G8_SCHED; G8_LDA(At, 1, 0); G8_STAGEA(G8_SA(0, 1), a2 + hstep);
      G8_WAIT_L(8); G8_BAR; G8_WAIT_L(0); G8_MMA(0, 0, At, B0); G8_BAR; G8_SCHED;
      G8_LDB(B1, 1, 1); G8_STAGEB(G8_SB(1, 0), b3);
      G8_BAR; G8_WAIT_L(0); G8_MMA(0, 1, At, B1); G8_BAR;
      G8_LDA(At, 1, 1); G8_STAGEA(G8_SA(1, 0), a3);
      G8_BAR; G8_WAIT_L(0); G8_MMA(1, 0, At, B0); G8_BAR; G8_SCHED;
      G8_STAGEB(G8_SB(1, 1), b3 + hstep);
      G8_WAIT_V(6); G8_BAR; G8_MMA(1, 1, At, B1); G8_BAR;
    }
    E(acc, cur, wr, wc, fr, fq);
    if (!has_next) break;
#pragma unroll
    for (int a = 0; a < 2; ++a)
#pragma unroll
      for (int b = 0; b < 2; ++b)
#pragma unroll
        for (int m = 0; m < 4; ++m)
#pragma unroll
          for (int n = 0; n < 2; ++n) acc[a][b][m][n] = AccT{};
    cur = nxt; cA = nA; cB = nB; ++ui;
  }
  G8_WAIT_V(0);
  if (wr == 0) G8_BAR;
  G8_BAR;
#undef G8_SA
#undef G8_SB
#undef G8_STAGE
#undef G8_STAGEB
#undef G8_STAGEA
#undef voffA
#undef G8_LDA
#undef G8_LDB
#undef G8_MMA
#undef G8_WAIT_V
#undef G8_WAIT_L
#undef G8_BAR
#undef G8_SCHED
}

struct DenseSched {
  int nM, nN, G, c;
  __device__ __forceinline__ bool next(int i, GUnit& u) const {
    const int idx = unit_index(i, c, G, nM * nN);
    if (idx < 0) return false;
    u.pm = idx / nN; u.pn = idx - u.pm * nN; u.brow0 = u.pn * BM; u.e = 0;
    return true;
  }
};
struct MoeSched {
  const int* toff; int nN, NE, G, c;
  __device__ __forceinline__ bool next(int i, GUnit& u) const {
    const int idx = unit_index(i, c, G, toff[32] * nN);
    if (idx < 0) return false;
    u.pm = idx / nN; u.pn = idx - u.pm * nN;
    int e = 0;
#pragma unroll 1
    for (int k = 1; k < 32; ++k) e = (u.pm >= toff[k]) ? k : e;
    u.e = e; u.brow0 = e * NE + u.pn * BM;
    return true;
  }
};
}

struct EpiInProj {
  float* P; const float* SCL; const float* sw;
  __device__ __forceinline__ void operator()(const i32x4 (&acc)[2][2][4][2], const g8::GUnit& u, int wr, int wc, int fr, int fq) const {
    const int row0 = u.pm * 256 + wr * 64 + fr, col0 = u.pn * 256 + wc * 32 + 4 * fq;
    f32x4 cs[2][2];
#pragma unroll
    for (int bj = 0; bj < 2; ++bj)
#pragma unroll
      for (int n = 0; n < 2; ++n) cs[bj][n] = *(const f32x4*)(sw + col0 + bj * 128 + n * 16);
    float sav[2][4];
#pragma unroll
    for (int ai = 0; ai < 2; ++ai)
#pragma unroll
      for (int m = 0; m < 4; ++m) sav[ai][m] = SCL[row0 + ai * 128 + m * 16];
#pragma unroll
    for (int ai = 0; ai < 2; ++ai)
#pragma unroll
      for (int m = 0; m < 4; ++m) {
        const int row = row0 + ai * 128 + m * 16;
        const float sa = sav[ai][m];
        float* rowp = P + (size_t)row * PINP + col0;
#pragma unroll
        for (int bj = 0; bj < 2; ++bj)
#pragma unroll
          for (int n = 0; n < 2; ++n) {
            const i32x4 a = acc[ai][bj][m][n];
            f32x4 o = {(float)a[0], (float)a[1], (float)a[2], (float)a[3]};
            *(f32x4*)(rowp + bj * 128 + n * 16) = o * (cs[bj][n] * sa);
          }
      }
  }
};
__device__ __forceinline__ void phase_gemm_in(PP pp, int l, int bid, int nb, char* smem) {
  g8::DenseSched S{130, 14, nb, bid};
  EpiInProj E{(float*)(p.ws + OFF_P), (const float*)(p.ws + OFF_SCL), (const float*)(p.ws + OFF_SWIN) + (size_t)l * PINP};
  g8::gemm_stream<true>((LAS unsigned char*)smem, p.ws + OFF_H, p.ws + OFF_W + (size_t)l * WL_SIZE + WL_IN, S, E);
}

struct EpiOutProj {
  const float *xl, *xc, *mods; float *ol, *oc;
  __device__ __forceinline__ void operator()(const f32x4 (&acc)[2][2][4][2], const g8::GUnit& u, int wr, int wc, int fr, int fq) const {
    const bool lat = u.pm < 128;
    const float* xin = lat ? xl + (size_t)u.pm * 256 * 1024 : xc + (size_t)(u.pm - 128) * 256 * 1024;
    float* xo = lat ? ol + (size_t)u.pm * 256 * 1024 : oc + (size_t)(u.pm - 128) * 256 * 1024;
    const float* g1 = mods + (size_t)(lat ? (u.pm >> 6) : 2) * 6144 + 2048;
    const int row0 = wr * 64 + fr, col0 = u.pn * 256 + wc * 32 + 4 * fq;
#pragma unroll
    for (int bj = 0; bj < 2; ++bj)
#pragma unroll
      for (int n = 0; n < 2; ++n) {
        const f32x4 gv = *(const f32x4*)(g1 + col0 + bj * 128 + n * 16);
        f32x4 xv[2][4];
#pragma unroll
        for (int ai = 0; ai < 2; ++ai)
#pragma unroll
          for (int m = 0; m < 4; ++m) xv[ai][m] = *(const f32x4*)(xin + (size_t)(row0 + ai * 128 + m * 16) * 1024 + col0 + bj * 128 + n * 16);
#pragma unroll
        for (int ai = 0; ai < 2; ++ai)
#pragma unroll
          for (int m = 0; m < 4; ++m)
            *(f32x4*)(xo + (size_t)(row0 + ai * 128 + m * 16) * 1024 + col0 + bj * 128 + n * 16) = xv[ai][m] + gv * acc[ai][bj][m][n];
        asm volatile("" ::: "memory");
      }
  }
};
__device__ __forceinline__ void phase_gemm_out(PP pp, int l, int bid, int nb, char* smem) {
  g8::DenseSched S{(l == 0) ? 130 : 128, 4, nb, bid};
  EpiOutProj E{(l == 0) ? p.x : p.out, (l == 0) ? p.ctx : (const float*)(p.ws + OFF_CTX),
               (const float*)(p.ws + OFF_MODS) + (size_t)l * 3 * 6144, p.out, (float*)(p.ws + OFF_CTX)};
  g8::gemm_stream<false>((LAS unsigned char*)smem, p.ws + OFF_CC, p.ws + OFF_W + (size_t)l * WL_SIZE + WL_OUT, S, E);
}

#define LBAR() do { asm volatile("s_waitcnt lgkmcnt(0)" ::: "memory"); __builtin_amdgcn_s_barrier(); asm volatile("" ::: "memory"); } while (0)
__device__ __forceinline__ void phase_prep(PP pp, int l, int bid, int nb, char* smem) {
  const int tid = tid_opaque(), lane = tid & 63, wv = wave_id(tid);
  const float* P = (const float*)(p.ws + OFF_P);
  char* S = p.ws + OFF_S;
  bfr* QN = (bfr*)(S + S_QN);
  bfr* KN = (bfr*)(S + S_KN);
  bfr* VT = (bfr*)(S + S_VT);
  float* RWR = (float*)(S + S_RWR);
  float* RWKK = (float*)(S + S_RWKK);
  float* RWV = (float*)(S + S_RWV);
  float* RWG = (float*)(S + S_RWG);
  float* RWW = (float*)(S + S_RWW);
  float* RWKD = (float*)(S + S_RWKD);
  float* RWB = (float*)(S + S_RWB);
  float* BON = (float*)(S + S_BON);
  float* GDQ = (float*)(S + S_GDQ);
  float* GDK = (float*)(S + S_GDK);
  float* GDV = (float*)(S + S_GDV);
  float* GDAB = (float*)(S + S_GDAB);
  const float* mu = p.rw_mu + (size_t)l * 896;
  const float* w0 = p.rw_w0 + (size_t)l * 512;
  const float* w_up = p.rw_w_up + (size_t)l * 2 * 32 * 256;
  const float* a0 = p.rw_a0 + (size_t)l * 512;
  const float* a_up = p.rw_a_up + (size_t)l * 2 * 32 * 256;
  const float* g_up = p.rw_g_up + (size_t)l * 64 * 256;
  const float* k_k = p.rw_k_k + (size_t)l * 256;
  const float* k_a = p.rw_k_a + (size_t)l * 256;
  const float* r_k = p.rw_r_k + (size_t)l * 256;
  const float* conv_w = p.gd_conv_w + (size_t)l * 5 * 768;
  const float* A_log = p.gd_A_log + (size_t)l * 8;
  const float* dt_bias = p.gd_dt_bias + (size_t)l * 8;
  const float* qg = p.na_q_gain + (size_t)l * 64;
  const float* kg = p.na_k_gain + (size_t)l * 64;

  bfr* wl = (bfr*)smem;
  float* lor = (float*)(smem + 192 * 256 * 2);
  __syncthreads();
  for (int i = tid; i < 192 * 256; i += NTHR) {
    const int row = i >> 8, c = i & 255;
    const float v = row < 64 ? g_up[row * 256 + c] : row < 128 ? w_up[(row - 64) * 256 + c] : a_up[(row - 128) * 256 + c];
    wl[i] = f2bf(v);
  }
  __syncthreads();

  for (int tile = bid; tile < NTOK / 16; tile += nb) {
    const int m0 = tile * 16;
    int seq_lo, seq_hi, bb, tau0;
    if (m0 < NLAT) { bb = m0 >> 14; seq_lo = bb << 14; seq_hi = seq_lo + SEQ; tau0 = m0 - seq_lo; }
    else { bb = (m0 - NLAT) >> 8; seq_lo = NLAT + (bb << 8); seq_hi = seq_lo + CTXL; tau0 = SEQ + (m0 - seq_lo); }
    const f32x4 z4 = {0.f, 0.f, 0.f, 0.f};
    int tid_t = tid; asm volatile("" : "+v"(tid_t));
    const int lane_t = tid_t & 63;
    const int cb = lane_t * 4, hh = lane_t >> 4;
    const int lg = tid_t & 31, lt = tid_t >> 5;
    const int sl = lane_t >> 4, sc4 = (lane_t & 15) * 4;
    asm volatile("" ::: "memory");
    const f32x4 mur = *(const f32x4*)(mu + cb), muk = *(const f32x4*)(mu + 256 + cb), muv = *(const f32x4*)(mu + 512 + cb);
    const f32x4 mul = *(const f32x4*)(mu + 768 + lg * 4);

    f32x4 pr[3][4], pl[3];
    {
      const int mt0 = m0 + 2 * wv;
#pragma unroll
      for (int j = 0; j < 3; ++j)
#pragma unroll
        for (int t = 0; t < 4; ++t) {
          const int m = mt0 - 1 + t;
          pr[j][t] = (m >= seq_lo && m < seq_hi) ? *(const f32x4*)(P + (size_t)m * PINP + A_END + j * 256 + cb) : z4;
        }
#pragma unroll
      for (int t = 0; t < 3; ++t) {
        const int m = m0 + lt - 1 + t;
        pl[t] = (m >= seq_lo && m < seq_hi) ? *(const f32x4*)(P + (size_t)m * PINP + A_END + 768 + lg * 4) : z4;
      }
    }
    {
      const f32x4 v = pl[1] + mul * (0.5f * (pl[0] + pl[2]) - pl[1]);
#pragma unroll
      for (int i = 0; i < 4; ++i) {
        const int ch = lg * 4 + i;
        lor[ch * 16 + lt] = ch < 32 ? tanhf(v[i]) : ch < 64 ? v[i] : sigmoidf_(v[i]);
      }
    }
    f32x4 rr[2], rk[2], rv[2];
#pragma unroll
    for (int t = 0; t < 2; ++t) {
      rr[t] = pr[0][t + 1] + mur * (0.5f * (pr[0][t] + pr[0][t + 2]) - pr[0][t + 1]);
      rk[t] = pr[1][t + 1] + muk * (0.5f * (pr[1][t] + pr[1][t + 2]) - pr[1][t + 1]);
      rv[t] = pr[2][t + 1] + muv * (0.5f * (pr[2][t] + pr[2][t + 2]) - pr[2][t + 1]);
    }
    LBAR();
    f32x4 pg[20];
    const bool is_gd = wv < 3, is_na = (wv >= 3 && wv < 7);
    const int sec = is_gd ? wv * 4 + sl : (wv - 3) * 4 + sl;
    if (is_gd) {
#pragma unroll
      for (int t = 0; t < 20; ++t) {
        const int m = m0 - 2 + t;
        pg[t] = (m >= seq_lo && m < seq_hi) ? *(const f32x4*)(P + (size_t)m * PINP + B_END + sec * 64 + sc4) : z4;
      }
    } else if (is_na) {
#pragma unroll
      for (int t = 0; t < 16; ++t) pg[t] = *(const f32x4*)(P + (size_t)(m0 + t) * PINP + sec * 64 + sc4);
#pragma unroll
      for (int t = 16; t < 20; ++t) pg[t] = z4;
    } else {
#pragma unroll
      for (int t = 0; t < 20; ++t) pg[t] = z4;
    }
    asm volatile("" ::: "memory");
    {
      f32x4 gacc[2], wa0[2], wa1[2], aa0[2], aa1[2];
#pragma unroll
      for (int t = 0; t < 2; ++t) { gacc[t] = z4; wa0[t] = z4; wa1[t] = z4; aa0[t] = z4; aa1[t] = z4; }
#pragma unroll 4
      for (int j = 0; j < 64; ++j) {
        const bf16x4 wq = *(const bf16x4*)(wl + j * 256 + cb);
        const f32x4 wgt = {bf2f(wq[0]), bf2f(wq[1]), bf2f(wq[2]), bf2f(wq[3])};
        const float2 sv = *(const float2*)(lor + (64 + j) * 16 + 2 * wv);
        gacc[0] += wgt * sv.x; gacc[1] += wgt * sv.y;
      }
#pragma unroll 2
      for (int j = 0; j < 32; ++j) {
        const bf16x4 q0 = *(const bf16x4*)(wl + (64 + j) * 256 + cb), q1 = *(const bf16x4*)(wl + (96 + j) * 256 + cb);
        const bf16x4 q2 = *(const bf16x4*)(wl + (128 + j) * 256 + cb), q3 = *(const bf16x4*)(wl + (160 + j) * 256 + cb);
        const f32x4 ww0 = {bf2f(q0[0]), bf2f(q0[1]), bf2f(q0[2]), bf2f(q0[3])}, ww1 = {bf2f(q1[0]), bf2f(q1[1]), bf2f(q1[2]), bf2f(q1[3])};
        const f32x4 aw0 = {bf2f(q2[0]), bf2f(q2[1]), bf2f(q2[2]), bf2f(q2[3])}, aw1 = {bf2f(q3[0]), bf2f(q3[1]), bf2f(q3[2]), bf2f(q3[3])};
        const float2 tv = *(const float2*)(lor + j * 16 + 2 * wv);
        const float2 dv = *(const float2*)(lor + (32 + j) * 16 + 2 * wv);
        wa0[0] += ww0 * tv.x; wa0[1] += ww0 * tv.y; wa1[0] += ww1 * tv.x; wa1[1] += ww1 * tv.y;
        aa0[0] += aw0 * dv.x; aa0[1] += aw0 * dv.y; aa1[0] += aw1 * dv.x; aa1[1] += aw1 * dv.y;
      }
      asm volatile("" ::: "memory");
      const f32x4 kkc = *(const f32x4*)(k_k + cb), kac = *(const f32x4*)(k_a + cb), rkc = *(const f32x4*)(r_k + cb);
      const f32x4 w00 = *(const f32x4*)(w0 + cb), w01 = *(const f32x4*)(w0 + 256 + cb), a00 = *(const f32x4*)(a0 + cb), a01 = *(const f32x4*)(a0 + 256 + cb);
#pragma unroll
      for (int t = 0; t < 2; ++t) {
        const int m = m0 + 2 * wv + t;
        const f32x4 r = rr[t], k = rk[t], v = rv[t];
        const f32x4 kkraw = k * kkc;
        const float ssum = row16_sum((kkraw[0] * kkraw[0] + kkraw[1] * kkraw[1]) + (kkraw[2] * kkraw[2] + kkraw[3] * kkraw[3]));
        const f32x4 kk = kkraw * rsqrtf(ssum + 1e-6f);
        float bon = 0.f;
#pragma unroll
        for (int d = 0; d < 2; ++d) {
          const f32x4 wlin = d == 0 ? w00 + wa0[t] : w01 + wa1[t];
          const f32x4 alin = d == 0 ? a00 + aa0[t] : a01 + aa1[t];
          f32x4 lw, kd, bv;
#pragma unroll
          for (int i = 0; i < 4; ++i) {
            const float w_log = -softplusf_(-wlin[i]) - 0.5f;
            const float a = sigmoidf_(alin[i]);
            lw[i] = -__expf(w_log);
            kd[i] = k[i] * (1.f + (a - 1.f) * kac[i]);
            bv[i] = kk[i] * a;
            bon += r[i] * kd[i] * rkc[i];
          }
          const size_t o = ((size_t)d * NTOK + m) * 256 + cb;
          *(f32x4*)(RWW + o) = lw; *(f32x4*)(RWKD + o) = kd; *(f32x4*)(RWB + o) = bv;
        }
        bon = row16_sum(bon);
        const size_t o = (size_t)m * 256 + cb;
        *(f32x4*)(RWR + o) = r; *(f32x4*)(RWKK + o) = kk; *(f32x4*)(RWV + o) = v; *(f32x4*)(RWG + o) = gacc[t];
        if ((lane_t & 15) == 0) BON[(size_t)m * 4 + hh] = bon;
      }
    }
    if (is_gd) {
      f32x4 cw[5];
#pragma unroll
      for (int j = 0; j < 5; ++j) cw[j] = *(const f32x4*)(conv_w + j * 768 + sec * 64 + sc4);
#pragma unroll
      for (int t = 0; t < 16; ++t) {
        f32x4 acc = z4;
#pragma unroll
        for (int j = 0; j < 5; ++j) acc += cw[j] * pg[t + j];
        f32x4 val = {siluf_(acc[0]), siluf_(acc[1]), siluf_(acc[2]), siluf_(acc[3])};
        const int m = m0 + t;
        if (sec < 8) {
          const float ss = row16_sum((val[0] * val[0] + val[1] * val[1]) + (val[2] * val[2] + val[3] * val[3]));
          val = val * rsqrtf(ss + 1e-6f);
          if (sec < 4) *(f32x4*)(GDQ + (size_t)m * 256 + sec * 64 + sc4) = val * 0.125f;
          else *(f32x4*)(GDK + (size_t)m * 256 + (sec - 4) * 64 + sc4) = val;
        } else *(f32x4*)(GDV + (size_t)m * 256 + (sec - 8) * 64 + sc4) = val;
      }
    } else if (is_na) {
      const f32x4 gq = *(const f32x4*)(qg + sc4) * (0.125f * 1.4426950408889634f), gk = *(const f32x4*)(kg + sc4);
#pragma unroll
      for (int t = 0; t < 16; ++t) {
        f32x4 val = pg[t];
        const float ss = row16_sum((val[0] * val[0] + val[1] * val[1]) + (val[2] * val[2] + val[3] * val[3]));
        val = val * rsqrtf(ss * (1.f / 64.f) + 1e-6f);
        const int m = m0 + t;
        if (sec < 8) { const f32x4 o = val * gq; *(bf16x4*)(QN + (size_t)m * 512 + sec * 64 + sc4) = pack4(o[0], o[1], o[2], o[3]); }
        else { const f32x4 o = val * gk; *(bf16x4*)(KN + (size_t)m * 512 + (sec - 8) * 64 + sc4) = pack4(o[0], o[1], o[2], o[3]); }
      }
    }
    if (tid_t < 256) {
      const int t = tid_t >> 4, j = tid_t & 15;
      const int m = m0 + t;
      const float pv = P[(size_t)m * PINP + B_END + 1024 + j];
      float o;
      if (j < 8) o = -__expf(A_log[j]) * softplusf_(pv + dt_bias[j]);
      else o = sigmoidf_(pv);
      GDAB[(size_t)m * 16 + j] = o;
    }
    {
      const int vc = (tid_t & 127) * 4, tq = (tid_t >> 7) * 4;
      f32x4 pv[4];
#pragma unroll
      for (int t = 0; t < 4; ++t) pv[t] = *(const f32x4*)(P + (size_t)(m0 + tq + t) * PINP + 1024 + vc);
#pragma unroll
      for (int i = 0; i < 4; ++i) {
        const int hd = vc + i;
        bfr* dst = VT + ((size_t)(bb * 8 + (hd >> 6)) * (TTOK / 16) + (tau0 >> 4)) * 1024 + (hd & 63) * 16 + tq;
        *(bf16x4*)dst = pack4(pv[0][i], pv[1][i], pv[2][i], pv[3][i]);
      }
    }
    LBAR();
  }
  __syncthreads();
}

__device__ __forceinline__ int scan_tok(int b, int d, int s) {
  if (s < CTXL) { int t = d ? (CTXL - 1 - s) : s; return NLAT + b * CTXL + t; }
  int u = s - CTXL; int t = d ? (SEQ - 1 - u) : u; return b * SEQ + t;
}
#define CS 72
#define SLOT_BYTES (64 * CS * 2)
#define F0_STRIDE 68
#define X1_F0 (13 * SLOT_BYTES)
#define X1_ARR (X1_F0 + 64 * F0_STRIDE * 4)

#define MM_FRAGS(As, Bs, a0, a1, b00, b01, b10, b11)                                                     \
  const bf16x8 a0 = *(const bf16x8*)((As) + ((mt * 16 + fr) * CS + fq * 8) * 2);                         \
  const bf16x8 a1 = *(const bf16x8*)((As) + ((mt * 16 + fr) * CS + 32 + fq * 8) * 2);                    \
  const bf16x8 b00 = *(const bf16x8*)((Bs) + ((nt0 * 16 + fr) * CS + fq * 8) * 2);                       \
  const bf16x8 b01 = *(const bf16x8*)((Bs) + ((nt0 * 16 + fr) * CS + 32 + fq * 8) * 2);                  \
  const bf16x8 b10 = *(const bf16x8*)((Bs) + ((nt0 * 16 + 16 + fr) * CS + fq * 8) * 2);                  \
  const bf16x8 b11 = *(const bf16x8*)((Bs) + ((nt0 * 16 + 16 + fr) * CS + 32 + fq * 8) * 2);
#define MM_2TILES(acc0, acc1, a0, a1, b00, b01, b10, b11)                                                \
  acc0 = __builtin_amdgcn_mfma_f32_16x16x32_bf16(a0, b00, acc0, 0, 0, 0);                                \
  acc0 = __builtin_amdgcn_mfma_f32_16x16x32_bf16(a1, b01, acc0, 0, 0, 0);                                \
  acc1 = __builtin_amdgcn_mfma_f32_16x16x32_bf16(a0, b10, acc1, 0, 0, 0);                                \
  acc1 = __builtin_amdgcn_mfma_f32_16x16x32_bf16(a1, b11, acc1, 0, 0, 0);
__device__ __forceinline__ void wr_T(char* slot, int mt, int nt, int fr, int fq, f32x4 v) {
  *(bf16x4*)(slot + ((nt * 16 + fr) * CS + mt * 16 + 4 * fq) * 2) = pack4(v[0], v[1], v[2], v[3]);
}

struct ChunkIn { float lw[8], f0[8], f1[8], f2[8], f3[8], xv[8], be[8]; };
template <bool GDN>
__device__ __forceinline__ void chunk_load(PP pp, int t, ChunkIn& ci) {
  const int tid = tid_opaque(), c = tid & 63, tg = wave_id(tid);
  const int chain = t / NCHUNK, n = t - chain * NCHUNK;
  const int d = chain & 1, h = (chain >> 1) & 3, b = (chain >> 3) & 1;
  const char* S = p.ws + OFF_S;
#pragma unroll
  for (int u = 0; u < 8; ++u) {
    const int m = scan_tok(b, d, n * 64 + tg * 8 + u);
    const size_t o = (size_t)m * 256 + h * 64 + c;
    if (!GDN) {
      ci.lw[u] = ((const float*)(S + S_RWW))[(size_t)d * NTOK * 256 + o];
      ci.f0[u] = ((const float*)(S + S_RWKK))[o];
      ci.f1[u] = ((const float*)(S + S_RWB))[(size_t)d * NTOK * 256 + o];
      ci.f2[u] = ((const float*)(S + S_RWKD))[(size_t)d * NTOK * 256 + o];
      ci.f3[u] = ((const float*)(S + S_RWR))[o];
      ci.xv[u] = ((const float*)(S + S_RWV))[o];
      ci.be[u] = 1.f;
    } else {
      ci.lw[u] = ((const float*)(S + S_GDAB))[(size_t)m * 16 + d * 4 + h];
      ci.be[u] = ((const float*)(S + S_GDAB))[(size_t)m * 16 + 8 + d * 4 + h];
      ci.f0[u] = ((const float*)(S + S_GDK))[o];
      ci.f3[u] = ((const float*)(S + S_GDQ))[o];
      ci.xv[u] = ((const float*)(S + S_GDV))[o];
      ci.f1[u] = 0.f; ci.f2[u] = 0.f;
    }
  }
}
template <bool GDN>
__device__ __forceinline__ void chunk_prep_task(PP pp, int t, int t_next, bool has_next, const ChunkIn& ci, ChunkIn& nx, char* smem) {
  const int chain = t / NCHUNK, n = t - chain * NCHUNK;
  const int d = chain & 1, h = (chain >> 1) & 3, b = (chain >> 3) & 1;
  (void)b; (void)d; (void)h;
  const int tid = tid_opaque(), lane = tid & 63, wv = wave_id(tid);
  const int fr = lane & 15, fq = lane >> 4, mt = wv >> 1, nt0 = (wv & 1) * 2;
  char* S = p.ws + OFF_S;
  char* CH = p.ws + OFF_CH;
  const size_t cc = (size_t)chain * NCHUNK + n;
  char* const p0 = smem;
  char* const p1 = smem + 1 * SLOT_BYTES;
  char* const p2 = smem + 2 * SLOT_BYTES;
  char* const p3 = smem + 3 * SLOT_BYTES;
  char* const p4 = smem + 4 * SLOT_BYTES;
  char* const p5 = smem + 5 * SLOT_BYTES;
  char* const p6 = smem + 6 * SLOT_BYTES;
  char* const p7 = smem + 7 * SLOT_BYTES;
  char* const p8 = smem + 8 * SLOT_BYTES;
  char* const p9 = smem + 9 * SLOT_BYTES;
  char* const p10 = smem + 10 * SLOT_BYTES;
  char* const p11 = smem + 11 * SLOT_BYTES;
  char* const p12 = smem + 12 * SLOT_BYTES;
  float* const F0 = (float*)(smem + X1_F0);
  float* const Lv = (float*)(smem + X1_ARR);
  float* const Lm1v = Lv + 64;
  float* const betav = Lv + 128;
  float* const eLv = Lv + 192;
  float* const gC = Lv + 256;
  float* const gsum = Lv + 320;
  char* const sKt = p0;
  char* const sBh = GDN ? p0 : p1;
  char* const sKh = GDN ? p0 : p2;

  {
    const int c = lane, tg = wv;
    const float* lw = ci.lw; const float* f0 = ci.f0; const float* f1 = ci.f1; const float* f2 = ci.f2; const float* f3 = ci.f3; const float* xv = ci.xv; const float* be = ci.be;
    float cum[8];
    cum[0] = lw[0];
#pragma unroll
    for (int u = 1; u < 8; ++u) cum[u] = cum[u - 1] + lw[u];
    gsum[tg * 64 + c] = cum[7];
    LBAR();
    float off = 0.f, LC = 0.f;
#pragma unroll
    for (int g2 = 0; g2 < 8; ++g2) { const float gs = gsum[g2 * 64 + c]; LC += gs; off += (g2 < tg) ? gs : 0.f; }
    bf16x8 vKtT, vBbT, vKbT, vXT;
#pragma unroll
    for (int u = 0; u < 8; ++u) {
      const int t = tg * 8 + u;
      const float L = off + cum[u], Lm1 = L - lw[u];
      if (!GDN) {
        const float eLm1 = __expf(Lm1), enL = __expf(-L), eL = __expf(L), eCL = __expf(LC - L);
        const float kt = f0[u] * eLm1;
        *(bfr*)(p0 + (t * CS + c) * 2) = f2bf(kt);
        *(bfr*)(p1 + (t * CS + c) * 2) = f2bf(f1[u] * enL);
        *(bfr*)(p2 + (t * CS + c) * 2) = f2bf(f2[u] * enL);
        *(bfr*)(p3 + (t * CS + c) * 2) = f2bf(f3[u] * eL);
        vKtT[u] = (short)f2bf(kt);
        vBbT[u] = (short)f2bf(f1[u] * eCL);
        vKbT[u] = (short)f2bf(f2[u] * eCL);
        vXT[u] = (short)f2bf(xv[u]);
      } else {
        *(bfr*)(p0 + (t * CS + c) * 2) = f2bf(f0[u]);
        *(bfr*)(p3 + (t * CS + c) * 2) = f2bf(f3[u]);
        vKtT[u] = (short)f2bf(f0[u] * __expf(Lm1));
        vBbT[u] = (short)f2bf(be[u] * f0[u] * __expf(LC - Lm1));
        vKbT[u] = (short)f2bf(f0[u] * __expf(LC - L));
        vXT[u] = (short)f2bf(be[u] * xv[u]);
        if (c == 0) { Lv[t] = L; Lm1v[t] = Lm1; betav[t] = be[u]; eLv[t] = __expf(L); }
      }
    }
    *(bf16x8*)(p4 + (c * CS + tg * 8) * 2) = vKtT;
    *(bf16x8*)(p5 + (c * CS + tg * 8) * 2) = vBbT;
    *(bf16x8*)(p6 + (c * CS + tg * 8) * 2) = vKbT;
    *(bf16x8*)(p7 + (c * CS + tg * 8) * 2) = vXT;
    if (tg == 0) gC[c] = __expf(LC);
    if (!GDN && tid < 64) { Lv[tid] = 0.f; Lm1v[tid] = 0.f; betav[tid] = 1.f; eLv[tid] = 1.f; }
  }
  LBAR();
  if (has_next) chunk_load<GDN>(pp, t_next, nx);
  {
    {
      MM_FRAGS(sKt, sBh, a0, a1, b00, b01, b10, b11)
      f32x4 c0 = {0.f, 0.f, 0.f, 0.f}, c1 = c0;
      MM_2TILES(c0, c1, a0, a1, b00, b01, b10, b11)
#pragma unroll
      for (int q = 0; q < 2; ++q) {
        const int sI = (nt0 + q) * 16 + fr;
        const f32x4 cv = q ? c1 : c0;
        f32x4 o;
#pragma unroll
        for (int r = 0; r < 4; ++r) {
          const int tI = mt * 16 + 4 * fq + r;
          float v = cv[r];
          if (GDN) v *= betav[sI] * __expf(fminf(Lm1v[tI] - Lm1v[sI], 0.f));
          o[r] = (sI < tI) ? v : 0.f;
        }
        *(f32x4*)(F0 + sI * F0_STRIDE + mt * 16 + 4 * fq) = o;
        wr_T(p11, mt, nt0 + q, fr, fq, o);
      }
    }
    {
      MM_FRAGS(sKt, sKh, a0, a1, b00, b01, b10, b11)
      f32x4 c0 = {0.f, 0.f, 0.f, 0.f}, c1 = c0;
      MM_2TILES(c0, c1, a0, a1, b00, b01, b10, b11)
#pragma unroll
      for (int q = 0; q < 2; ++q) {
        const int sI = (nt0 + q) * 16 + fr;
        const f32x4 cv = q ? c1 : c0;
        f32x4 o;
#pragma unroll
        for (int r = 0; r < 4; ++r) {
          const int tI = mt * 16 + 4 * fq + r;
          float v = cv[r];
          if (GDN) v *= __expf(fminf(Lm1v[tI] - Lv[sI], 0.f));
          o[r] = (sI < tI) ? v : 0.f;
        }
        wr_T(p9, mt, nt0 + q, fr, fq, o);
      }
    }
    {
      MM_FRAGS(sBh, p3, a0, a1, b00, b01, b10, b11)
      f32x4 c0 = {0.f, 0.f, 0.f, 0.f}, c1 = c0;
      MM_2TILES(c0, c1, a0, a1, b00, b01, b10, b11)
#pragma unroll
      for (int q = 0; q < 2; ++q) {
        const int tI = (nt0 + q) * 16 + fr;
        const f32x4 cv = q ? c1 : c0;
        f32x4 o;
#pragma unroll
        for (int r = 0; r < 4; ++r) {
          const int sI = mt * 16 + 4 * fq + r;
          float v = cv[r];
          if (GDN) v *= betav[sI] * __expf(fminf(Lv[tI] - Lm1v[sI], 0.f));
          o[r] = (sI <= tI) ? v : 0.f;
        }
        wr_T(p10, mt, nt0 + q, fr, fq, o);
      }
    }
  }
  LBAR();
  if (wv < 2) {
    const int base = wv * 32, other = 32 - base, c = lane & 31;
    float tr[32];
#pragma unroll
    for (int j = 0; j < 32; ++j) tr[j] = 0.f;
#pragma unroll
    for (int ip = 15; ip >= 0; --ip) {
      const int i = 2 * ip + 1, i2 = 2 * ip;
      float a0 = (c == i) ? 1.f : 0.f, a1 = 0.f, b0 = (c == i2) ? 1.f : 0.f, b1 = 0.f;
      const float aii = F0[(base + i2) * F0_STRIDE + base + i];
#pragma unroll
      for (int jb = ((i + 1) & ~3); jb < 32; jb += 4) {
        const f32x4 a4 = *(const f32x4*)(F0 + (base + i) * F0_STRIDE + base + jb);
        const f32x4 b4 = *(const f32x4*)(F0 + (base + i2) * F0_STRIDE + base + jb);
        a0 -= a4[0] * tr[jb]; a1 -= a4[1] * tr[jb + 1]; a0 -= a4[2] * tr[jb + 2]; a1 -= a4[3] * tr[jb + 3];
        b0 -= b4[0] * tr[jb]; b1 -= b4[1] * tr[jb + 1]; b0 -= b4[2] * tr[jb + 2]; b1 -= b4[3] * tr[jb + 3];
      }
      const float ti = a0 + a1;
      const float ti2 = (b0 + b1) - aii * ti;
      tr[i] = ti; tr[i2] = ti2;
      if (lane < 32) {
        *(bfr*)(p8 + ((base + i) * CS + base + c) * 2) = f2bf(ti);
        *(bfr*)(p8 + ((base + i) * CS + other + c) * 2) = (bfr)0;
        *(bfr*)(p8 + ((base + i2) * CS + base + c) * 2) = f2bf(ti2);
        *(bfr*)(p8 + ((base + i2) * CS + other + c) * 2) = (bfr)0;
      }
    }
    if (lane < 32) {
#pragma unroll
      for (int q = 0; q < 4; ++q) {
        bf16x8 o, z;
#pragma unroll
        for (int j = 0; j < 8; ++j) { o[j] = (short)f2bf(tr[8 * q + j]); z[j] = 0; }
        *(bf16x8*)(p12 + ((base + c) * CS + base + 8 * q) * 2) = o;
        *(bf16x8*)(p12 + ((base + c) * CS + other + 8 * q) * 2) = z;
      }
    }
  }
  LBAR();
  {
    MM_FRAGS(p11, p12, a0, a1, b00, b01, b10, b11)
    f32x4 c0 = {0.f, 0.f, 0.f, 0.f}, c1 = c0;
    MM_2TILES(c0, c1, a0, a1, b00, b01, b10, b11)
    wr_T(p1, mt, nt0, fr, fq, c0);
    wr_T(p1, mt, nt0 + 1, fr, fq, c1);
  }
  LBAR();
  if (mt < 2 && nt0 == 2) {
    MM_FRAGS(p8, p1, a0, a1, b00, b01, b10, b11)
    f32x4 c0 = {0.f, 0.f, 0.f, 0.f}, c1 = c0;
    MM_2TILES(c0, c1, a0, a1, b00, b01, b10, b11)
#pragma unroll
    for (int r = 0; r < 4; ++r) {
      *(bfr*)(p8 + ((mt * 16 + 4 * fq + r) * CS + (nt0) * 16 + fr) * 2) = f2bf(-c0[r]);
      *(bfr*)(p8 + ((mt * 16 + 4 * fq + r) * CS + (nt0 + 1) * 16 + fr) * 2) = f2bf(-c1[r]);
    }
  }
  LBAR();
  {
    {
      MM_FRAGS(p8, p5, a0, a1, b00, b01, b10, b11)
      f32x4 c0 = {0.f, 0.f, 0.f, 0.f}, c1 = c0;
      MM_2TILES(c0, c1, a0, a1, b00, b01, b10, b11)
      wr_T(p11, mt, nt0, fr, fq, -c0);
      wr_T(p11, mt, nt0 + 1, fr, fq, -c1);
    }
    {
      MM_FRAGS(p8, p10, a0, a1, b00, b01, b10, b11)
      f32x4 c0 = {0.f, 0.f, 0.f, 0.f}, c1 = c0;
      MM_2TILES(c0, c1, a0, a1, b00, b01, b10, b11)
      wr_T(p12, mt, nt0, fr, fq, -c0);
      wr_T(p12, mt, nt0 + 1, fr, fq, -c1);
    }
  }
  LBAR();
  {
    {
      MM_FRAGS(p4, p11, a0, a1, b00, b01, b10, b11)
      f32x4 c0 = {0.f, 0.f, 0.f, 0.f}, c1 = c0;
      MM_2TILES(c0, c1, a0, a1, b00, b01, b10, b11)
#pragma unroll
      for (int q = 0; q < 2; ++q) {
        const int cp = (nt0 + q) * 16 + fr;
        f32x4 cv = q ? c1 : c0;
#pragma unroll
        for (int r = 0; r < 4; ++r) { const int cI = mt * 16 + 4 * fq + r; if (cI == cp) cv[r] += gC[cI]; }
        wr_T(p10, mt, nt0 + q, fr, fq, cv);
      }
    }
    {
      MM_FRAGS(p9, p11, a0, a1, b00, b01, b10, b11)
      f32x4 c0 = {0.f, 0.f, 0.f, 0.f}, c1 = c0;
      MM_2TILES(c0, c1, a0, a1, b00, b01, b10, b11)
#pragma unroll
      for (int q = 0; q < 2; ++q) {
        const int cp = (nt0 + q) * 16 + fr;
        f32x4 cv = q ? c1 : c0;
        const bf16x4 kb = *(const bf16x4*)(p6 + (cp * CS + mt * 16 + 4 * fq) * 2);
#pragma unroll
        for (int r = 0; r < 4; ++r) cv[r] += __uint_as_float(((unsigned)(unsigned short)kb[r]) << 16);
        wr_T(p8, mt, nt0 + q, fr, fq, cv);
      }
    }
    {
      MM_FRAGS(p4, p12, a0, a1, b00, b01, b10, b11)
      f32x4 c0 = {0.f, 0.f, 0.f, 0.f}, c1 = c0;
      MM_2TILES(c0, c1, a0, a1, b00, b01, b10, b11)
#pragma unroll
      for (int q = 0; q < 2; ++q) {
        const int tI = (nt0 + q) * 16 + fr;
        f32x4 cv = q ? c1 : c0;
        const bf16x4 rt = *(const bf16x4*)(p3 + (tI * CS + mt * 16 + 4 * fq) * 2);
        const float el = eLv[tI];
#pragma unroll
        for (int r = 0; r < 4; ++r) cv[r] += __uint_as_float(((unsigned)(unsigned short)rt[r]) << 16) * el;
        wr_T(p1, mt, nt0 + q, fr, fq, cv);
      }
    }
    {
      f32x4 c0 = {0.f, 0.f, 0.f, 0.f}, c1 = c0;
      {
        MM_FRAGS(sKh, p3, a0, a1, b00, b01, b10, b11)
        MM_2TILES(c0, c1, a0, a1, b00, b01, b10, b11)
      }
#pragma unroll
      for (int q = 0; q < 2; ++q) {
        const int tI = (nt0 + q) * 16 + fr;
#pragma unroll
        for (int r = 0; r < 4; ++r) {
          const int sI = mt * 16 + 4 * fq + r;
          float v = q ? c1[r] : c0[r];
          if (GDN) v *= __expf(fminf(Lv[tI] - Lv[sI], 0.f));
          v = (sI <= tI) ? v : 0.f;
          if (q) c1[r] = v; else c0[r] = v;
        }
      }
      {
        MM_FRAGS(p9, p12, a0, a1, b00, b01, b10, b11)
        MM_2TILES(c0, c1, a0, a1, b00, b01, b10, b11)
      }
      wr_T(p5, mt, nt0, fr, fq, c0);
      wr_T(p5, mt, nt0 + 1, fr, fq, c1);
    }
  }
  LBAR();
  {
    {
      MM_FRAGS(p8, p7, a0, a1, b00, b01, b10, b11)
      f32x4 c0 = {0.f, 0.f, 0.f, 0.f}, c1 = c0;
      MM_2TILES(c0, c1, a0, a1, b00, b01, b10, b11)
      bfr* QT = (bfr*)(CH + cc * CH_REC + CH_QT);
      *(bf16x4*)(QT + ((mt * 4 + nt0) * 64 + lane) * 4) = pack4(c0[0], c0[1], c0[2], c0[3]);
      *(bf16x4*)(QT + ((mt * 4 + nt0 + 1) * 64 + lane) * 4) = pack4(c1[0], c1[1], c1[2], c1[3]);
    }
    {
      MM_FRAGS(p7, p5, a0, a1, b00, b01, b10, b11)
      f32x4 c0 = {0.f, 0.f, 0.f, 0.f}, c1 = c0;
      MM_2TILES(c0, c1, a0, a1, b00, b01, b10, b11)
      bfr* YX = (bfr*)(CH + cc * CH_REC + CH_YX);
      *(bf16x4*)(YX + ((mt * 4 + nt0) * 64 + lane) * 4) = pack4(c0[0], c0[1], c0[2], c0[3]);
      *(bf16x4*)(YX + ((mt * 4 + nt0 + 1) * 64 + lane) * 4) = pack4(c1[0], c1[1], c1[2], c1[3]);
    }
    {
      const int fm = wv >> 1, fa = wv & 1;
      const int row = fm * 16 + fr;
      {
        const bf16x4 lo = *(const bf16x4*)(p10 + (row * CS + 32 * fa + 4 * fq) * 2);
        const bf16x4 hi = *(const bf16x4*)(p10 + (row * CS + 32 * fa + 16 + 4 * fq) * 2);
        bf16x8 f; f[0] = lo[0]; f[1] = lo[1]; f[2] = lo[2]; f[3] = lo[3]; f[4] = hi[0]; f[5] = hi[1]; f[6] = hi[2]; f[7] = hi[3];
        *(bf16x8*)(CH + cc * CH_REC + CH_PT + (size_t)((fm * 2 + fa) * 64 + lane) * 16) = f;
      }
      {
        const bf16x4 lo = *(const bf16x4*)(p1 + (row * CS + 32 * fa + 4 * fq) * 2);
        const bf16x4 hi = *(const bf16x4*)(p1 + (row * CS + 32 * fa + 16 + 4 * fq) * 2);
        bf16x8 f; f[0] = lo[0]; f[1] = lo[1]; f[2] = lo[2]; f[3] = lo[3]; f[4] = hi[0]; f[5] = hi[1]; f[6] = hi[2]; f[7] = hi[3];
        *(bf16x8*)(CH + cc * CH_REC + CH_RYT + (size_t)((fm * 2 + fa) * 64 + lane) * 16) = f;
      }
    }
  }
  LBAR();
}

template <bool GDN>
__device__ __forceinline__ void chunk_prep_loop(PP pp, int t0, int tend, int nb, char* smem) {
  ChunkIn cur, nxt;
  if (t0 < tend) chunk_load<GDN>(pp, t0, cur);
  for (int t = t0; t < tend; t += nb) {
    const bool has_next = (t + nb) < tend;
    chunk_prep_task<GDN>(pp, t, t + nb, has_next, cur, nxt, smem);
    cur = nxt;
  }
}
__device__ __forceinline__ void phase_chunk_prep(PP pp, int bid, int nb, char* smem) {
  __syncthreads();
  const int half = (NCHAIN / 2) * NCHUNK;
  chunk_prep_loop<false>(pp, bid, half, nb, smem);
  const int k0 = (half - bid + nb - 1) / nb;
  chunk_prep_loop<true>(pp, bid + k0 * nb, NCHAIN * NCHUNK, nb, smem);
  __syncthreads();
}

#define X2_BUF 32768
#define X2_BAR() do { asm volatile("s_waitcnt lgkmcnt(0)" ::: "memory"); __builtin_amdgcn_s_barrier(); asm volatile("" ::: "memory"); } while (0)
__device__ __forceinline__ void chunk_seq_chain(PP pp, int chain, char* smem) {
  __syncthreads();
  const int tid = tid_opaque(), lane = tid & 63, wv = wave_id(tid);
  const int d = chain & 1, h = (chain >> 1) & 3, b = (chain >> 3) & 1, ty = chain >> 4;
  const char* CH = p.ws + OFF_CH;
  float* Y = (float*)(p.ws + OFF_S + (ty ? S_YGD : S_YRW)) + (size_t)d * NTOK * 256;
  const size_t c0 = (size_t)chain * NCHUNK;
  if (wv >= 4) {
    const int lw = wv - 4;
    const char* src0 = CH + c0 * CH_REC + (size_t)lane * 16;
#define X2_DMA(n) { const char* s_ = src0 + (size_t)(n) * CH_REC; LAS unsigned char* d_ = (LAS unsigned char*)smem + ((n) & 3) * X2_BUF;       \
      _Pragma("unroll") for (int i = 0; i < 8; ++i) {                                                                                       \
        const int piece = i * 4 + lw;                                                                                                       \
        __builtin_amdgcn_global_load_lds((const unsigned*)(s_ + piece * 1024), (LAS unsigned*)(d_ + piece * 1024), 16, 0, 0); } }
    X2_DMA(0) X2_DMA(1) X2_DMA(2)
    asm volatile("s_waitcnt vmcnt(16)" ::: "memory");
    X2_BAR();
    for (int n = 0; n < NCHUNK; ++n) {
      if (n + 3 < NCHUNK) { X2_DMA(n + 3) asm volatile("s_waitcnt vmcnt(16)" ::: "memory"); }
      else if (n + 2 < NCHUNK) asm volatile("s_waitcnt vmcnt(8)" ::: "memory");
      else asm volatile("s_waitcnt vmcnt(0)" ::: "memory");
      X2_BAR();
    }
#undef X2_DMA
  } else {
    const int vt = wv, fr = lane & 15, fq = lane >> 4;
    f32x4 Sacc[4];
#pragma unroll
    for (int i = 0; i < 4; ++i) Sacc[i] = (f32x4){0.f, 0.f, 0.f, 0.f};
    X2_BAR();
    for (int n = 0; n < NCHUNK; ++n) {
      const char* buf = smem + (n & 3) * X2_BUF;
      bf16x8 sB0, sB1;
#pragma unroll
      for (int j = 0; j < 4; ++j) {
        sB0[j] = (short)f2bf(Sacc[0][j]); sB0[4 + j] = (short)f2bf(Sacc[1][j]);
        sB1[j] = (short)f2bf(Sacc[2][j]); sB1[4 + j] = (short)f2bf(Sacc[3][j]);
      }
#pragma unroll
      for (int m = 0; m < 4; ++m) {
        const bf16x8 pa0 = *(const bf16x8*)(buf + ((m * 2 + 0) * 64 + lane) * 16);
        const bf16x8 pa1 = *(const bf16x8*)(buf + ((m * 2 + 1) * 64 + lane) * 16);
        const bf16x8 ra0 = *(const bf16x8*)(buf + 8192 + ((m * 2 + 0) * 64 + lane) * 16);
        const bf16x8 ra1 = *(const bf16x8*)(buf + 8192 + ((m * 2 + 1) * 64 + lane) * 16);
        const bf16x4 qb = *(const bf16x4*)(buf + 16384 + ((m * 4 + vt) * 64 + lane) * 8);
        const bf16x4 yb = *(const bf16x4*)(buf + 24576 + ((vt * 4 + m) * 64 + lane) * 8);
        f32x4 y = {bf2f(yb[0]), bf2f(yb[1]), bf2f(yb[2]), bf2f(yb[3])};
        y = __builtin_amdgcn_mfma_f32_16x16x32_bf16(sB0, ra0, y, 0, 0, 0);
        y = __builtin_amdgcn_mfma_f32_16x16x32_bf16(sB1, ra1, y, 0, 0, 0);
        f32x4 sn = {bf2f(qb[0]), bf2f(qb[1]), bf2f(qb[2]), bf2f(qb[3])};
        sn = __builtin_amdgcn_mfma_f32_16x16x32_bf16(pa0, sB0, sn, 0, 0, 0);
        sn = __builtin_amdgcn_mfma_f32_16x16x32_bf16(pa1, sB1, sn, 0, 0, 0);
        Sacc[m] = sn;
        {
          const int mm = scan_tok(b, d, n * 64 + m * 16 + fr);
          *(f32x4*)(Y + (size_t)mm * 256 + h * 64 + vt * 16 + 4 * fq) = y;
        }
      }
      X2_BAR();
    }
  }
}

struct NaPair { int mk0, mk1, tau0, tau1, kr0, kr1, ct0, ct1; };
struct NaFrag { bf16x8 k00, k01, k10, k11; bf16x4 v0[4], v1[4]; };

__device__ __forceinline__ void na_load(NaFrag& f, const bfr* KN, const bfr* VT, size_t vt_base, int h, int fr, int fq, const NaPair& pr) {
  const bfr* k0 = KN + (size_t)(pr.mk0 + fr) * 512 + h * 64 + fq * 8;
  const bfr* k1 = KN + (size_t)(pr.mk1 + fr) * 512 + h * 64 + fq * 8;
  f.k00 = *(const bf16x8*)(k0); f.k01 = *(const bf16x8*)(k0 + 32);
  f.k10 = *(const bf16x8*)(k1); f.k11 = *(const bf16x8*)(k1 + 32);
#pragma unroll
  for (int dt = 0; dt < 4; ++dt) {
    const int vo = (dt * 16 + fr) * 16 + fq * 4;
    f.v0[dt] = *(const bf16x4*)(VT + vt_base + (size_t)(pr.tau0 >> 4) * 1024 + vo);
    f.v1[dt] = *(const bf16x4*)(VT + vt_base + (size_t)(pr.tau1 >> 4) * 1024 + vo);
  }
}

__device__ __forceinline__ void na_compute(const NaFrag& f, const bf16x8 qf0, const bf16x8 qf1, bool local, bool vr0, bool vr1,
                                           int dr0, int dr1, int ct0, int ct1, int qc, int fq, const float* bias_h, f32x4 (&O)[4], float& lsum) {
  f32x4 z = {0.f, 0.f, 0.f, 0.f};
  f32x4 st0 = __builtin_amdgcn_mfma_f32_16x16x32_bf16(f.k00, qf0, z, 0, 0, 0);
  st0 = __builtin_amdgcn_mfma_f32_16x16x32_bf16(f.k01, qf1, st0, 0, 0, 0);
  f32x4 st1 = __builtin_amdgcn_mfma_f32_16x16x32_bf16(f.k10, qf0, z, 0, 0, 0);
  st1 = __builtin_amdgcn_mfma_f32_16x16x32_bf16(f.k11, qf1, st1, 0, 0, 0);
  bf16x8 pf;
  if (local) {
    const int cs = min(max(qc - 8, 0), 48);
#pragma unroll
    for (int r = 0; r < 4; ++r) {
      const int kc0 = ct0 * 16 + fq * 4 + r, kc1 = ct1 * 16 + fq * 4 + r;
      float p0 = 0.f, p1 = 0.f;
      if (vr0 && (unsigned)(kc0 - cs) < 16u) p0 = __builtin_amdgcn_exp2f(st0[r] + bias_h[dr0 * 31 + (kc0 - qc + 15)]);
      if (vr1 && (unsigned)(kc1 - cs) < 16u) p1 = __builtin_amdgcn_exp2f(st1[r] + bias_h[dr1 * 31 + (kc1 - qc + 15)]);
      lsum += p0 + p1;
      pf[r] = (short)f2bf(p0);
      pf[4 + r] = (short)f2bf(p1);
    }
  } else {
#pragma unroll
    for (int r = 0; r < 4; ++r) {
      const float p0 = __builtin_amdgcn_exp2f(st0[r]), p1 = __builtin_amdgcn_exp2f(st1[r]);
      lsum += p0 + p1;
      pf[r] = (short)f2bf(p0);
      pf[4 + r] = (short)f2bf(p1);
    }
  }
#pragma unroll
  for (int dt = 0; dt < 4; ++dt) {
    bf16x8 vf;
    vf[0] = f.v0[dt][0]; vf[1] = f.v0[dt][1]; vf[2] = f.v0[dt][2]; vf[3] = f.v0[dt][3];
    vf[4] = f.v1[dt][0]; vf[5] = f.v1[dt][1]; vf[6] = f.v1[dt][2]; vf[7] = f.v1[dt][3];
    O[dt] = __builtin_amdgcn_mfma_f32_16x16x32_bf16(vf, pf, O[dt], 0, 0, 0);
  }
}

__device__ __forceinline__ void na_block_task(PP pp, int task, const float* bias_lds) {
  const int tid = tid_opaque(), lane = tid & 63, wv = wave_id(tid);
  const int fr = lane & 15, fq = lane >> 4;
  char* S = p.ws + OFF_S;
  const bfr* QN = (const bfr*)(S + S_QN);
  const bfr* KN = (const bfr*)(S + S_KN);
  const bfr* VT = (const bfr*)(S + S_VT);
  bfr* CC = (bfr*)(p.ws + OFF_CC);
  const bool latent = task < 1024;
  int b, h, mqa, mqb, qra = 0, qrb = 0, cgp = 0;
  if (latent) {
    h = task & 7; const int quad = (task >> 3) & 63; b = task >> 9;
    qra = quad * 4 + (wv >> 2) * 2; qrb = qra + 1; cgp = wv & 3;
    mqa = b * SEQ + qra * 64 + cgp * 16; mqb = mqa + 64;
  } else {
    const int u = task - 1024;
    h = u & 7; b = u >> 3;
    mqa = NLAT + b * CTXL + (wv * 2) * 16; mqb = mqa + 16;
  }
  const bf16x8 qa0 = *(const bf16x8*)(QN + (size_t)(mqa + fr) * 512 + h * 64 + fq * 8);
  const bf16x8 qa1 = *(const bf16x8*)(QN + (size_t)(mqa + fr) * 512 + h * 64 + 32 + fq * 8);
  const bf16x8 qb0 = *(const bf16x8*)(QN + (size_t)(mqb + fr) * 512 + h * 64 + fq * 8);
  const bf16x8 qb1 = *(const bf16x8*)(QN + (size_t)(mqb + fr) * 512 + h * 64 + 32 + fq * 8);
  f32x4 Oa[4], Ob[4];
#pragma unroll
  for (int dt = 0; dt < 4; ++dt) { Oa[dt] = (f32x4){0.f, 0.f, 0.f, 0.f}; Ob[dt] = Oa[dt]; }
  float lsa = 0.f, lsb = 0.f;
  const size_t vt_base = (size_t)(b * 8 + h) * 64 * TTOK;
  const int rsa = min(max(qra - 4, 0), SEQ / 64 - 8), rsb = min(max(qrb - 4, 0), SEQ / 64 - 8);
  const int nrows = latent ? (rsb - rsa + 8) : 0;
  const int ct_first = (cgp <= 1) ? 0 : cgp - 1;
  const int nct = (cgp == 0 || cgp == 3) ? 2 : 3;
  const int ntile = nrows * nct;
  const int nlp = (ntile + 1) >> 1;
  const int npair = nlp + 8;
  const int qc = cgp * 16 + fr;
  auto mkpair = [&](int pi) {
    NaPair pr;
    if (pi < nlp) {
      const int i0 = 2 * pi, i1 = min(2 * pi + 1, ntile - 1);
      pr.kr0 = rsa + i0 / nct; pr.ct0 = ct_first + i0 % nct;
      pr.kr1 = rsa + i1 / nct; pr.ct1 = ct_first + i1 % nct;
      if (2 * pi + 1 >= ntile) pr.kr1 = -100;
      const int r1 = rsa + i1 / nct;
      pr.tau0 = pr.kr0 * 64 + pr.ct0 * 16; pr.tau1 = r1 * 64 + pr.ct1 * 16;
      pr.mk0 = b * SEQ + pr.tau0; pr.mk1 = b * SEQ + pr.tau1;
    } else {
      const int c = pi - nlp;
      pr.kr0 = pr.kr1 = pr.ct0 = pr.ct1 = 0;
      pr.tau0 = SEQ + c * 32; pr.tau1 = SEQ + c * 32 + 16;
      pr.mk0 = NLAT + b * CTXL + c * 32; pr.mk1 = pr.mk0 + 16;
    }
    return pr;
  };
  NaFrag fa, fb;
  NaPair pa = mkpair(0), pb;
  na_load(fa, KN, VT, vt_base, h, fr, fq, pa);
  const float* bias_h = bias_lds + h * 465;
#define NA_DO(F, PR, PI)                                                                                          \
  {                                                                                                               \
    const bool loc_ = (PI) < nlp;                                                                                 \
    na_compute(F, qa0, qa1, loc_, (unsigned)(PR.kr0 - rsa) < 8u, (unsigned)(PR.kr1 - rsa) < 8u,                   \
               PR.kr0 - qra + 7, PR.kr1 - qra + 7, PR.ct0, PR.ct1, qc, fq, bias_h, Oa, lsa);                      \
    na_compute(F, qb0, qb1, loc_, (unsigned)(PR.kr0 - rsb) < 8u, (unsigned)(PR.kr1 - rsb) < 8u,                   \
               PR.kr0 - qrb + 7, PR.kr1 - qrb + 7, PR.ct0, PR.ct1, qc, fq, bias_h, Ob, lsb);                      \
  }
  for (int pi = 0; pi < npair; pi += 2) {
    if (pi + 1 < npair) { pb = mkpair(pi + 1); na_load(fb, KN, VT, vt_base, h, fr, fq, pb); }
    NA_DO(fa, pa, pi)
    if (pi + 1 < npair) {
      if (pi + 2 < npair) { pa = mkpair(pi + 2); na_load(fa, KN, VT, vt_base, h, fr, fq, pa); }
      NA_DO(fb, pb, pi + 1)
    }
  }
#undef NA_DO
  lsa += shfl_xor_l(lsa, 16, lane); lsa += shfl_xor_l(lsa, 32, lane);
  lsb += shfl_xor_l(lsb, 16, lane); lsb += shfl_xor_l(lsb, 32, lane);
  const float ia = 1.f / lsa, ib = 1.f / lsb;
#pragma unroll
  for (int dt = 0; dt < 4; ++dt) {
    *(bf16x4*)(CC + (size_t)(mqa + fr) * 1024 + h * 64 + dt * 16 + fq * 4) = pack4(Oa[dt][0] * ia, Oa[dt][1] * ia, Oa[dt][2] * ia, Oa[dt][3] * ia);
    *(bf16x4*)(CC + (size_t)(mqb + fr) * 1024 + h * 64 + dt * 16 + fq * 4) = pack4(Ob[dt][0] * ib, Ob[dt][1] * ib, Ob[dt][2] * ib, Ob[dt][3] * ib);
  }
}

__device__ __forceinline__ void phase_mix(PP pp, int l, int bid, int nb, char* smem) {
  const int tid = tid_opaque();
  const int nscan_blocks = (nb > 32) ? 32 : nb;
  const int first_attn_block = (nb > 32) ? 32 : 0;
  if (bid < nscan_blocks) {
    for (int c = bid; c < NCHAIN; c += nscan_blocks) chunk_seq_chain(pp, c, smem);
  }
  if (bid >= first_attn_block) {
    float* bias = (float*)smem;
    __syncthreads();
    for (int i = tid; i < 8 * 465; i += NTHR) bias[i] = p.na_rpb[(size_t)l * 8 * 465 + i] * 1.4426950408889634f;
    __syncthreads();
    const int ntask = (l == 0) ? 1024 + 16 : 1024;
    const int nab = nb - first_attn_block;
    for (int t = bid - first_attn_block; t < ntask; t += nab) na_block_task(pp, t, bias);
    __syncthreads();
    phase_convert(pp, l, 1, bid - first_attn_block, nab, smem);
    if (l == 0) phase_convert(pp, 1, 0, bid - first_attn_block, nab, smem);
  }
}

__device__ __forceinline__ void phase_post(PP pp, int l, int bid, int nb) {
  const int tid = tid_opaque(), lane = tid & 63, wv = wave_id(tid);
  char* S = p.ws + OFF_S;
  const float* YRW = (const float*)(S + S_YRW);
  const float* YGD = (const float*)(S + S_YGD);
  const float* RWV = (const float*)(S + S_RWV);
  const float* RWG = (const float*)(S + S_RWG);
  const float* BON = (const float*)(S + S_BON);
  const float* P = (const float*)(p.ws + OFF_P);
  bfr* CC = (bfr*)(p.ws + OFF_CC);
  const float* ln_w = p.rw_ln_w + (size_t)l * 256;
  const float* ln_b = p.rw_ln_b + (size_t)l * 256;
  const float* ng = p.gd_norm_g + (size_t)l * 64;
  const int ntok = (l == 0) ? NTOK : NLAT;
  const int cb = lane * 4, hh = lane >> 4;
  const f32x4 lw4 = *(const f32x4*)(ln_w + cb), lb4 = *(const f32x4*)(ln_b + cb), ng4 = *(const f32x4*)(ng + (cb & 63));
  for (int m = bid * 8 + wv; m < ntok; m += nb * 8) {
    const size_t o = (size_t)m * 256 + cb;
    const f32x4 y0 = *(const f32x4*)(YRW + o), y1 = *(const f32x4*)(YRW + (size_t)NTOK * 256 + o);
    const f32x4 rv = *(const f32x4*)(RWV + o), rg = *(const f32x4*)(RWG + o);
    const f32x4 g0 = *(const f32x4*)(YGD + o), g1 = *(const f32x4*)(YGD + (size_t)NTOK * 256 + o);
    const f32x4 z = *(const f32x4*)(P + (size_t)m * PINP + B_END + 768 + cb);
    const float bon = BON[(size_t)m * 4 + hh];
    {
      const f32x4 y = y0 + y1;
      const float mean = row16_sum((y[0] + y[1]) + (y[2] + y[3])) * (1.f / 64.f);
      const f32x4 dv = y - mean;
      const float var = row16_sum((dv[0] * dv[0] + dv[1] * dv[1]) + (dv[2] * dv[2] + dv[3] * dv[3])) * (1.f / 64.f);
      const f32x4 out = ((dv * rsqrtf(var + 64e-5f)) * lw4 + lb4 + rv * bon) * rg;
      *(bf16x4*)(CC + (size_t)m * 1024 + 512 + cb) = pack4(out[0], out[1], out[2], out[3]);
    }
    {
      const f32x4 y = g0 + g1;
      const float ms = row16_sum((y[0] * y[0] + y[1] * y[1]) + (y[2] * y[2] + y[3] * y[3])) * (1.f / 64.f);
      const f32x4 sz = {siluf_(z[0]), siluf_(z[1]), siluf_(z[2]), siluf_(z[3])};
      const f32x4 out = (y * rsqrtf(ms + 1e-6f)) * ng4 * sz;
      *(bf16x4*)(CC + (size_t)m * 1024 + 768 + cb) = pack4(out[0], out[1], out[2], out[3]);
    }
  }
}

#define RW_LDS_ROW 36
__device__ __forceinline__ void phase_router(PP pp, int l, int bid, int nb, char* smem) {
  const int tid = tid_opaque(), lane = tid & 63, wv = wave_id(tid);
  const float* xl = p.out;
  const float* xc = (const float*)(p.ws + OFF_CTX);
  const float* mods = (const float*)(p.ws + OFF_MODS) + (size_t)l * 3 * 6144;
  const float* g = p.norm_ffn_g + (size_t)l * 1024;
  const float* rw = p.moe_router_w + (size_t)l * 1024 * 32;
  const float* rb = p.moe_router_b + (size_t)l * 32;
  bfr* H = (bfr*)(p.ws + OFF_H);
  int* cnt = (int*)(p.ws + OFF_CNT);
  int* TOKE = (int*)(p.ws + OFF_TOKE);
  int* TOKP = (int*)(p.ws + OFF_TOKP);
  float* TOKG = (float*)(p.ws + OFF_TOKG);
  float* wl = (float*)smem;
  for (int i = tid; i < 1024 * 8; i += NTHR) {
    int d = i >> 3, q = i & 7;
    *(float4*)(wl + d * RW_LDS_ROW + q * 4) = *(const float4*)(rw + (size_t)d * 32 + q * 4);
  }
  __syncthreads();
  const int ntok = (l == 0) ? NTOK : NLAT;
  const float rbl = rb[lane & 31];
  for (int m0 = (bid * 8 + wv) * 2; m0 < ntok; m0 += nb * 16) {
    float acc0[32], acc1[32];
#pragma unroll
    for (int e = 0; e < 32; ++e) { acc0[e] = 0.f; acc1[e] = 0.f; }
    float hv0[16], hv1[16];
    {
      const int ma = m0, mb = m0 + 1;
      const float* xa = (ma < NLAT) ? xl + (size_t)ma * 1024 : xc + (size_t)(ma - NLAT) * 1024;
      const float* xb = (mb < NLAT) ? xl + (size_t)mb * 1024 : xc + (size_t)(mb - NLAT) * 1024;
      const float* mda = mods + (size_t)mod_row(ma) * 6144 + 3072;
      const float* mdb = mods + (size_t)mod_row(mb) * 6144 + 3072;
      float ssa = 0.f, ssb = 0.f;
#pragma unroll
      for (int i = 0; i < 16; ++i) { hv0[i] = xa[lane + 64 * i]; hv1[i] = xb[lane + 64 * i]; }
#pragma unroll
      for (int i = 0; i < 16; ++i) { ssa += hv0[i] * hv0[i]; ssb += hv1[i] * hv1[i]; }
      ssa = wave_sum(ssa); ssb = wave_sum(ssb);
      const float rsa = rsqrtf(ssa * (1.f / 1024.f) + 1e-6f), rsb = rsqrtf(ssb * (1.f / 1024.f) + 1e-6f);
#pragma unroll
      for (int i = 0; i < 16; ++i) {
        const int d = lane + 64 * i;
        const float gg = g[d];
        hv0[i] = hv0[i] * rsa * gg * (1.f + mda[1024 + d]) + mda[d];
        hv1[i] = hv1[i] * rsb * gg * (1.f + mdb[1024 + d]) + mdb[d];
      }
      float am0 = 0.f, am1 = 0.f;
#pragma unroll
      for (int i = 0; i < 16; ++i) { am0 = fmaxf(am0, fabsf(hv0[i])); am1 = fmaxf(am1, fabsf(hv1[i])); }
      am0 = wave_max(am0); am1 = wave_max(am1);
      const float sc0 = am0 > 0.f ? am0 * (1.f / 127.f) : 1.f, sc1 = am1 > 0.f ? am1 * (1.f / 127.f) : 1.f;
      const float iv0 = 1.f / sc0, iv1 = 1.f / sc1;
      signed char* H8 = (signed char*)(p.ws + OFF_H);
#pragma unroll
      for (int i = 0; i < 16; ++i) {
        const int d = lane + 64 * i;
        H8[(size_t)ma * 1024 + d] = (signed char)(int)fminf(fmaxf(rintf(hv0[i] * iv0), -127.f), 127.f);
        H8[(size_t)mb * 1024 + d] = (signed char)(int)fminf(fmaxf(rintf(hv1[i] * iv1), -127.f), 127.f);
      }
      if (lane == 0) { float* SCL = (float*)(p.ws + OFF_SCL); SCL[ma] = sc0; SCL[mb] = sc1; }
      asm volatile("" ::: "memory");
    }
#pragma unroll
    for (int i = 0; i < 16; ++i) {
      if ((i & 3) == 0) asm volatile("" ::: "memory");
      const float* wr = wl + (lane + 64 * i) * RW_LDS_ROW;
#pragma unroll
      for (int q = 0; q < 8; ++q) {
        const float4 w = *(const float4*)(wr + q * 4);
        acc0[q * 4 + 0] += hv0[i] * w.x; acc0[q * 4 + 1] += hv0[i] * w.y; acc0[q * 4 + 2] += hv0[i] * w.z; acc0[q * 4 + 3] += hv0[i] * w.w;
        acc1[q * 4 + 0] += hv1[i] * w.x; acc1[q * 4 + 1] += hv1[i] * w.y; acc1[q * 4 + 2] += hv1[i] * w.z; acc1[q * 4 + 3] += hv1[i] * w.w;
      }
    }
#define BFLY(A, N, D)                                                                           \
    _Pragma("unroll") for (int i = 0; i < (N); ++i) {                                            \
      const bool up = (lane & (D)) != 0;                                                         \
      const float keep = up ? A[i + (N)] : A[i];                                                 \
      const float send = up ? A[i] : A[i + (N)];                                                 \
      A[i] = keep + shfl_xor_l(send, (D), lane);                                                   \
    }
    BFLY(acc0, 16, 16) BFLY(acc1, 16, 16)
    BFLY(acc0, 8, 8) BFLY(acc1, 8, 8)
    BFLY(acc0, 4, 4) BFLY(acc1, 4, 4)
    BFLY(acc0, 2, 2) BFLY(acc1, 2, 2)
    BFLY(acc0, 1, 1) BFLY(acc1, 1, 1)
#undef BFLY
    float la = acc0[0] + shfl_xor_l(acc0[0], 32, lane);
    float lb = acc1[0] + shfl_xor_l(acc1[0], 32, lane);
    const int my_e = lane & 31;
    la += rbl; lb += rbl;
    (void)my_e;
#pragma unroll
    for (int tkn = 0; tkn < 2; ++tkn) {
      float v = tkn == 0 ? la : lb;
      float tv[4]; int ti[4];
#pragma unroll
      for (int k = 0; k < 4; ++k) {
        float bv = v; int bi = lane & 31;
#pragma unroll
        for (int o = 16; o >= 1; o >>= 1) {
          float ov = shfl_xor_l(bv, o, lane); int oi = shfl_xor_li(bi, o, lane);
          bool take = (ov > bv) || (ov == bv && oi < bi);
          bv = take ? ov : bv; bi = take ? oi : bi;
        }
        tv[k] = bv; ti[k] = bi;
        if ((lane & 31) == bi) v = -3.0e38f;
      }
      float e1 = __expf(tv[1] - tv[0]), e2 = __expf(tv[2] - tv[0]), e3 = __expf(tv[3] - tv[0]);
      float inv = 1.f / (1.f + e1 + e2 + e3);
      const int m = m0 + tkn;
      if (lane < 4) {
        int e = lane == 0 ? ti[0] : lane == 1 ? ti[1] : lane == 2 ? ti[2] : ti[3];
        float gt = (lane == 0 ? 1.f : lane == 1 ? e1 : lane == 2 ? e2 : e3) * inv;
        int pos = atomicAdd(&cnt[e], 1);
        TOKE[(size_t)m * 4 + lane] = e; TOKP[(size_t)m * 4 + lane] = pos; TOKG[(size_t)m * 4 + lane] = gt;
      }
    }
  }
  __syncthreads();
}

__device__ __forceinline__ void moe_offsets(PP pp, int* toff) {
  const int* cnt = (const int*)(p.ws + OFF_CNT);
  if (tid_opaque() == 0) {
    int a = 0;
    for (int e = 0; e < 32; ++e) { toff[e] = a; a += (cnt[e] + 255) >> 8; }
    toff[32] = a;
  }
  __syncthreads();
}

__device__ __forceinline__ void phase_slotfill(PP pp, int l, int bid, int nb, char* smem) {
  int* toff = (int*)smem;
  moe_offsets(pp, toff);
  const int tid = tid_opaque(), lane = tid & 63, wv = wave_id(tid);
  const int* TOKE = (const int*)(p.ws + OFF_TOKE);
  const int* TOKP = (const int*)(p.ws + OFF_TOKP);
  const float* TOKG = (const float*)(p.ws + OFF_TOKG);
  const int* cnt = (const int*)(p.ws + OFF_CNT);
  int* TOKS = (int*)(p.ws + OFF_TOKS);
  float* SLG = (float*)(p.ws + OFF_SLG);
  float* SLS = (float*)(p.ws + OFF_SLS);
  const float* SCL = (const float*)(p.ws + OFF_SCL);
  const signed char* H8 = (const signed char*)(p.ws + OFF_H);
  signed char* XG = (signed char*)(p.ws + OFF_S);
  const int n = ((l == 0) ? NTOK : NLAT) * 4;
  for (int i0 = (bid * 8 + wv) * 4; i0 < n; i0 += nb * 32) {
    const int tok = i0 >> 2;
    int sl4[4];
#pragma unroll
    for (int k = 0; k < 4; ++k) sl4[k] = toff[TOKE[i0 + k]] * 256 + TOKP[i0 + k];
    const uint4 row = *((const uint4*)(H8 + (size_t)tok * 1024) + lane);
    const float scl = SCL[tok];
    float g4[4];
#pragma unroll
    for (int k = 0; k < 4; ++k) g4[k] = TOKG[i0 + k];
#pragma unroll
    for (int k = 0; k < 4; ++k) {
      if (lane == 0) { TOKS[i0 + k] = sl4[k]; SLG[sl4[k]] = g4[k]; SLS[sl4[k]] = scl; }
      *((uint4*)(XG + (size_t)sl4[k] * 1024) + lane) = row;
    }
  }
  for (int e = 0; e < 32; ++e) {
    const int c = cnt[e];
    const int npad = ((c + 255) & ~255) - c;
    const int base = toff[e] * 256 + c;
    for (int r = bid * 8 + wv; r < npad; r += nb * 8) {
      uint4* dst = (uint4*)(XG + (size_t)(base + r) * 1024);
      dst[lane] = make_uint4(0u, 0u, 0u, 0u);
      if (lane == 0) SLS[base + r] = 0.f;
    }
  }
  __syncthreads();
}

struct EpiMoe1 {
  const float* bgu; const float* sw; const float* SLS; bfr* ACT;
  __device__ __forceinline__ void operator()(const i32x4 (&acc)[2][2][4][2], const g8::GUnit& u, int wr, int wc, int fr, int fq) const {
    const float* be = bgu + (size_t)u.e * 2048;
    const float* se = sw + (size_t)u.e * 2048;
    const int slot0 = u.pm * 256 + wr * 64 + fr;
    float sav[2][4];
#pragma unroll
    for (int ai = 0; ai < 2; ++ai)
#pragma unroll
      for (int m = 0; m < 4; ++m) sav[ai][m] = SLS[slot0 + ai * 128 + m * 16];
    f32x4 bgv[2], blv[2], sgv[2], slv[2];
#pragma unroll
    for (int bj = 0; bj < 2; ++bj) {
      const int j0 = u.pn * 128 + bj * 64 + wc * 16 + 4 * fq;
      bgv[bj] = *(const f32x4*)(be + j0); blv[bj] = *(const f32x4*)(be + 1024 + j0);
      sgv[bj] = *(const f32x4*)(se + j0); slv[bj] = *(const f32x4*)(se + 1024 + j0);
    }
#pragma unroll
    for (int bj = 0; bj < 2; ++bj) {
      const int j0 = u.pn * 128 + bj * 64 + wc * 16 + 4 * fq;
      const f32x4 bg = bgv[bj], bl = blv[bj];
      const f32x4 sg = sgv[bj], sl = slv[bj];
#pragma unroll
      for (int ai = 0; ai < 2; ++ai)
#pragma unroll
        for (int m = 0; m < 4; ++m) {
          const int slot = slot0 + ai * 128 + m * 16;
          const float sa = sav[ai][m];
          bf16x4 o;
#pragma unroll
          for (int q = 0; q < 4; ++q) {
            const float g = (float)acc[ai][bj][m][0][q] * (sa * sg[q]) + bg[q];
            const float li = (float)acc[ai][bj][m][1][q] * (sa * sl[q]) + bl[q];
            const float gv = fminf(g, 7.f);
            const float lv = fminf(fmaxf(li, -7.f), 7.f);
            o[q] = (short)f2bf(gv * sigmoidf_(1.702f * gv) * (lv + 1.f));
          }
          *(bf16x4*)(ACT + (size_t)slot * 1024 + j0) = o;
        }
    }
  }
};
__device__ __forceinline__ void phase_moe1_impl(PP pp, int l, int bid, int nb, char* smem, int* toff) {
  moe_offsets(pp, toff);
  g8::MoeSched S{toff, 8, 2048, nb, bid};
  EpiMoe1 E{p.moe_b_gu + (size_t)l * 32 * 2048, (const float*)(p.ws + OFF_SW) + (size_t)l * 32 * 2048, (const float*)(p.ws + OFF_SLS), (bfr*)(p.ws + OFF_P)};
  g8::gemm_stream<true>((LAS unsigned char*)smem, p.ws + OFF_S, p.ws + OFF_W + (size_t)l * WL_SIZE + WL_GU, S, E);
}

struct EpiMoe2 {
  const float* bdn; const float* SLG; bfr* YS;
  __device__ __forceinline__ void operator()(const f32x4 (&acc)[2][2][4][2], const g8::GUnit& u, int wr, int wc, int fr, int fq) const {
    const float* be = bdn + (size_t)u.e * 1024;
    const int slot0 = u.pm * 256 + wr * 64 + fr, col0 = u.pn * 256 + wc * 32 + 4 * fq;
    float gtv[2][4];
#pragma unroll
    for (int ai = 0; ai < 2; ++ai)
#pragma unroll
      for (int m = 0; m < 4; ++m) gtv[ai][m] = SLG[slot0 + ai * 128 + m * 16];
    f32x4 bvv[2][2];
#pragma unroll
    for (int bj = 0; bj < 2; ++bj)
#pragma unroll
      for (int n = 0; n < 2; ++n) bvv[bj][n] = *(const f32x4*)(be + col0 + bj * 128 + n * 16);
#pragma unroll
    for (int ai = 0; ai < 2; ++ai)
#pragma unroll
      for (int m = 0; m < 4; ++m) {
        const int slot = slot0 + ai * 128 + m * 16;
        const float gt = gtv[ai][m];
#pragma unroll
        for (int bj = 0; bj < 2; ++bj)
#pragma unroll
          for (int n = 0; n < 2; ++n) {
            const f32x4 bv = bvv[bj][n];
            const f32x4 yv = (acc[ai][bj][m][n] + bv) * gt;
            *(bf16x4*)(YS + (size_t)slot * 1024 + col0 + bj * 128 + n * 16) = pack4(yv[0], yv[1], yv[2], yv[3]);
          }
      }
  }
};
__device__ __forceinline__ void phase_moe2_impl(PP pp, int l, int bid, int nb, char* smem, int* toff) {
  moe_offsets(pp, toff);
  g8::MoeSched S{toff, 4, 1024, nb, bid};
  EpiMoe2 E{p.moe_b_down + (size_t)l * 32 * 1024, (const float*)(p.ws + OFF_SLG), (bfr*)(p.ws + OFF_S)};
  g8::gemm_stream<false>((LAS unsigned char*)smem, p.ws + OFF_P, p.ws + OFF_W + (size_t)l * WL_SIZE + WL_DN, S, E);
}

__device__ __forceinline__ void phase_combine(PP pp, int l, int bid, int nb) {
  const int tid = tid_opaque(), lane = tid & 63, wv = wave_id(tid);
  const bfr* YS = (const bfr*)(p.ws + OFF_S);
  const int* TOKS = (const int*)(p.ws + OFF_TOKS);
  const float* mods = (const float*)(p.ws + OFF_MODS) + (size_t)l * 3 * 6144;
  const float* mods1 = (const float*)(p.ws + OFF_MODS) + (size_t)3 * 6144;
  const float* g1n = p.norm_mix_g + 1024;
  bfr* H = (bfr*)(p.ws + OFF_H);
  float* xl = p.out;
  float* xc = (float*)(p.ws + OFF_CTX);
  const int ntok = (l == 0) ? NTOK : NLAT;
  if (l == 0) {
    int* cnt = (int*)(p.ws + OFF_CNT);
    const int gt = bid * NTHR + tid;
    if (gt < 32) cnt[gt] = 0;
  }
  for (int m = bid * 8 + wv; m < ntok; m += nb * 8) {
    float* xr = (m < NLAT) ? xl + (size_t)m * 1024 : xc + (size_t)(m - NLAT) * 1024;
    const float* g2 = mods + (size_t)mod_row(m) * 6144 + 5120;
    const int s0 = TOKS[(size_t)m * 4], s1 = TOKS[(size_t)m * 4 + 1], s2 = TOKS[(size_t)m * 4 + 2], s3 = TOKS[(size_t)m * 4 + 3];
    float4 xn[4];
    float ss = 0.f;
#pragma unroll
    for (int i = 0; i < 4; ++i) {
      const int d = (lane + 64 * i) * 4;
      const bf16x4 a = *(const bf16x4*)(YS + (size_t)s0 * 1024 + d);
      const bf16x4 b = *(const bf16x4*)(YS + (size_t)s1 * 1024 + d);
      const bf16x4 c = *(const bf16x4*)(YS + (size_t)s2 * 1024 + d);
      const bf16x4 e = *(const bf16x4*)(YS + (size_t)s3 * 1024 + d);
      const float4 gg = *(const float4*)(g2 + d);
      float4 xv = *(const float4*)(xr + d);
      xv.x += gg.x * ((bf2f(a[0]) + bf2f(b[0])) + (bf2f(c[0]) + bf2f(e[0])));
      xv.y += gg.y * ((bf2f(a[1]) + bf2f(b[1])) + (bf2f(c[1]) + bf2f(e[1])));
      xv.z += gg.z * ((bf2f(a[2]) + bf2f(b[2])) + (bf2f(c[2]) + bf2f(e[2])));
      xv.w += gg.w * ((bf2f(a[3]) + bf2f(b[3])) + (bf2f(c[3]) + bf2f(e[3])));
      *(float4*)(xr + d) = xv;
      xn[i] = xv;
      ss += xv.x * xv.x + xv.y * xv.y + xv.z * xv.z + xv.w * xv.w;
    }
    if (l == 0) {
      ss = wave_sum(ss);
      const float rs = rsqrtf(ss * (1.f / 1024.f) + 1e-6f);
      const float* md = mods1 + (size_t)mod_row(m) * 6144;
      float4 hq[4];
#pragma unroll
      for (int i = 0; i < 4; ++i) {
        const int d = (lane + 64 * i) * 4;
        const float4 gg = *(const float4*)(g1n + d);
        const float4 sh = *(const float4*)(md + d);
        const float4 sc = *(const float4*)(md + 1024 + d);
        hq[i] = make_float4(xn[i].x * rs * gg.x * (1.f + sc.x) + sh.x, xn[i].y * rs * gg.y * (1.f + sc.y) + sh.y,
                            xn[i].z * rs * gg.z * (1.f + sc.z) + sh.z, xn[i].w * rs * gg.w * (1.f + sc.w) + sh.w);
      }
      const float qs = quant_row_store(hq, (signed char*)(p.ws + OFF_H) + (size_t)m * 1024, lane);
      if (lane == 0) ((float*)(p.ws + OFF_SCL))[m] = qs;
    }
  }
}

#define XB_TMO      128
#define XB_XCNT(j)  (256  + 64 * (j))
#define XB_XSUB(j)  (1280 + 64 * (j))
#define XB_XGEN(j)  (2304 + 64 * (j))
#define XB_TOP      3328
#define XB_TOPGEN   3392
#define XCD_BAR_WORDS 3456
#define XB_SPIN_CAP (1u << 22)
__device__ __forceinline__ unsigned xb_ld(unsigned* q) { return __hip_atomic_load(q, __ATOMIC_RELAXED, __HIP_MEMORY_SCOPE_AGENT); }
__device__ __forceinline__ unsigned xb_add(unsigned* q, unsigned v) { return __hip_atomic_fetch_add(q, v, __ATOMIC_RELAXED, __HIP_MEMORY_SCOPE_AGENT); }
__device__ __forceinline__ unsigned xb_xcc_id() { return (unsigned)__builtin_amdgcn_s_getreg((3 << 11) | 20) & 0xFu; }
#define XB_SPIN(cond, bar) do { unsigned _sp = 0; while (cond) { __builtin_amdgcn_s_sleep(1); \
    if ((++_sp & 255u) == 0u) { if (xb_ld(&(bar)[XB_TMO])) break; if (_sp > XB_SPIN_CAP) { atomicAdd(&(bar)[XB_TMO], 1u); break; } } } } while (0)
struct XcdBarrier { unsigned* bar; unsigned x; volatile LAS unsigned* st; };
__device__ __forceinline__ XcdBarrier xcd_barrier_post(unsigned* bar, volatile LAS unsigned* st) {
  XcdBarrier b; b.bar = bar; b.x = xb_xcc_id(); b.st = st;
  if (tid_opaque() == 0) (void)xb_add(&bar[XB_XCNT(b.x)], 1u);
  return b;
}
__device__ __forceinline__ void xcd_barrier_complete(unsigned* bar, unsigned x, unsigned& nloc, unsigned& nx) {
  const unsigned G = gridDim.x;
  unsigned sum, cnt, mine, sp = 0u;
  for (;;) {
    sum = 0u; cnt = 0u; mine = 0u;
#pragma unroll
    for (unsigned j = 0; j < 16; ++j) { const unsigned c = xb_ld(&bar[XB_XCNT(j)]); sum += c; cnt += (c > 0u) ? 1u : 0u; mine = (j == x) ? c : mine; }
    if (sum == G) break;
    __builtin_amdgcn_s_sleep(1);
    if ((++sp & 255u) == 0u) { if (xb_ld(&bar[XB_TMO])) break; if (sp > XB_SPIN_CAP) { atomicAdd(&bar[XB_TMO], 1u); break; } }
  }
  nloc = mine > 0u ? mine : 1u; nx = cnt > 0u ? cnt : 1u;
}
__device__ __forceinline__ void xcd_barrier(const XcdBarrier& b) {
  asm volatile("s_waitcnt vmcnt(0)" ::: "memory");
  __syncthreads();
  if (tid_opaque() == 0) {
    unsigned* bar = b.bar;
    __builtin_amdgcn_s_waitcnt(0);
    unsigned nloc = b.st[0], nx = b.st[1];
    if (nloc == 0u) { xcd_barrier_complete(bar, b.x, nloc, nx); b.st[0] = nloc; b.st[1] = nx; }
    const unsigned old = xb_add(&bar[XB_XSUB(b.x)], 1u);
    const unsigned gen = old / nloc;
    if (old + 1u == (gen + 1u) * nloc) {
      __builtin_amdgcn_fence(__ATOMIC_RELEASE, "agent");
      asm volatile("s_waitcnt vmcnt(0)" ::: "memory");
      const unsigned og = xb_add(&bar[XB_TOP], 1u);
      const unsigned tg = og / nx;
      if (og + 1u == (tg + 1u) * nx) xb_add(&bar[XB_TOPGEN], 1u);
      else XB_SPIN(xb_ld(&bar[XB_TOPGEN]) == tg, bar);
      __builtin_amdgcn_fence(__ATOMIC_ACQUIRE, "agent");
      xb_add(&bar[XB_XGEN(b.x)], 1u);
      asm volatile("s_waitcnt vmcnt(0)" ::: "memory");
    } else {
      XB_SPIN(xb_ld(&bar[XB_XGEN(b.x)]) == gen, bar);
      __builtin_amdgcn_fence(__ATOMIC_ACQUIRE, "agent");
      asm volatile("s_waitcnt vmcnt(0)" ::: "memory");
    }
  }
  __syncthreads();
}

extern __shared__ __attribute__((aligned(16))) char dyn_smem[];

__global__ void __launch_bounds__(NTHR) mega(Params p_unused) {
  cg::grid_group grid = cg::this_grid();
  const int bid0 = blockIdx.x, nb0 = gridDim.x;
#if defined(__HIP_DEVICE_COMPILE__)
  PP pp0 = (PP)__builtin_amdgcn_kernarg_segment_ptr();
#else
  PP pp0 = nullptr;
#endif
#define pp ({ PP q_ = pp0; asm volatile("" : "+s"(q_)); q_; })
#define bid opq(bid0)
#define nb opq(nb0)
  int* toff_s = (int*)(dyn_smem + 147456);
  volatile LAS unsigned* xb_st = (volatile LAS unsigned*)(dyn_smem + 147456 + 256);
  {
    unsigned* barw = (unsigned*)(fresh_ws(pp0) + OFF_BAR);
    if (blockIdx.x == 0) for (int i = threadIdx.x; i < XCD_BAR_WORDS; i += NTHR) barw[i] = 0u;
    if (threadIdx.x == 0) { xb_st[0] = 0u; xb_st[1] = 0u; }
  }
  grid.sync();
  const XcdBarrier xb = xcd_barrier_post((unsigned*)(fresh_ws(pp0) + OFF_BAR), xb_st);
#define GSYNC() xcd_barrier(xb)
  phase_ada(pp, bid, nb, dyn_smem);
  phase_convert(pp, 0, 0, bid, nb, dyn_smem);
  GSYNC();
#define LAYER(LV, LAST)                                      \
  {                                                          \
    if ((LV) == 0) { phase_prenorm(pp, opq(LV), bid, nb); GSYNC(); } \
    phase_gemm_in(pp, opq(LV), bid, nb, dyn_smem);           \
    GSYNC();                                                 \
    phase_prep(pp, opq(LV), bid, nb, dyn_smem);              \
    GSYNC();                                                 \
    phase_chunk_prep(pp, bid, nb, dyn_smem);                 \
    GSYNC();                                                 \
    phase_mix(pp, opq(LV), bid, nb, dyn_smem);               \
    GSYNC();                                                 \
    phase_post(pp, opq(LV), bid, nb);                        \
    GSYNC();                                                 \
    phase_gemm_out(pp, opq(LV), bid, nb, dyn_smem);          \
    GSYNC();                                                 \
    phase_router(pp, opq(LV), bid, nb, dyn_smem);            \
    GSYNC();                                                 \
    phase_slotfill(pp, opq(LV), bid, nb, dyn_smem);          \
    GSYNC();                                                 \
    phase_moe1_impl(pp, opq(LV), bid, nb, dyn_smem, toff_s); \
    GSYNC();                                                 \
    phase_moe2_impl(pp, opq(LV), bid, nb, dyn_smem, toff_s); \
    GSYNC();                                                 \
    phase_combine(pp, opq(LV), bid, nb);                     \
    if (!(LAST)) GSYNC();                                    \
  }
  LAYER(0, false)
  LAYER(1, true)
#undef LAYER
#undef GSYNC
#undef bid
#undef nb
#undef pp
}

#undef p
extern "C" void kernel_launch(void* const* d_in, const int* in_sizes, int n_in, void* d_out, int out_size, void* d_ws,
                              size_t ws_size, hipStream_t stream) {
  Params hp{};
  const float** pp = (const float**)&hp;
  for (int i = 0; i < 34; ++i) pp[i] = (const float*)d_in[i];
  hp.out = (float*)d_out;
  hp.ws = (char*)d_ws;
  static int grid_blocks = 0;
  if (!grid_blocks) {
    (void)hipFuncSetAttribute((const void*)mega, hipFuncAttributeMaxDynamicSharedMemorySize, LDS_BYTES);
    int dev = 0, cus = 0, per_cu = 0;
    (void)hipGetDevice(&dev);
    (void)hipDeviceGetAttribute(&cus, hipDeviceAttributeMultiprocessorCount, dev);
    (void)hipOccupancyMaxActiveBlocksPerMultiprocessor(&per_cu, mega, NTHR, LDS_BYTES);
    if (per_cu < 1) per_cu = 1;
    if (per_cu > 1) per_cu = 1;
    grid_blocks = cus * per_cu;
  }
  void* args[] = {&hp};
  (void)hipLaunchCooperativeKernel((void*)mega, dim3(grid_blocks), dim3(NTHR), args, LDS_BYTES, stream);
}
```

```cpp
#include <hip/hip_runtime.h>
#include <hip/hip_bf16.h>
#include <hip/hip_cooperative_groups.h>
#include <stdint.h>
#include <type_traits>
namespace cg = cooperative_groups;

typedef __attribute__((ext_vector_type(8))) short bf16x8;
typedef __attribute__((ext_vector_type(4))) short bf16x4;
typedef __attribute__((ext_vector_type(4))) float f32x4;
typedef __attribute__((ext_vector_type(4))) int i32x4;
typedef unsigned short bfr;

#define D_MODEL 1024
#define NB 2
#define SEQ 16384
#define CTXL 256
#define NLAT (NB * SEQ)
#define NCTX (NB * CTXL)
#define NTOK (NLAT + NCTX)
#define TTOK (SEQ + CTXL)
#define PIN 3472
#define PINP 3584
#define A_END 1536
#define B_END 2432
#define NEXP 32
#define NSLOT_MAX (NTOK * 4 + NEXP * 256)
#define NTHR 512
#define LDS_BYTES (147456 + 512)

constexpr size_t al256(size_t x) { return (x + 255) & ~(size_t)255; }
constexpr size_t WL_IN = 0;
constexpr size_t WL_OUT = WL_IN + (size_t)PINP * 1024 * 2;
constexpr size_t WL_GU = WL_OUT + (size_t)1024 * 1024 * 2;
constexpr size_t WL_DN = WL_GU + (size_t)32 * 2048 * 1024 * 2;
constexpr size_t WL_SIZE = WL_DN + (size_t)32 * 1024 * 1024 * 2;
constexpr size_t OFF_W = 0;
constexpr size_t OFF_MODS = al256(OFF_W + 2 * WL_SIZE);
constexpr size_t OFF_BAR = al256(OFF_MODS + 2 * 3 * 6144 * 4);
constexpr size_t OFF_SW = al256(OFF_BAR + 3456 * 4);
constexpr size_t OFF_SWIN = al256(OFF_SW + (size_t)2 * 32 * 2048 * 4);
constexpr size_t OFF_SLS = al256(OFF_SWIN + (size_t)2 * PINP * 4);
constexpr size_t OFF_SCL = al256(OFF_SLS + (size_t)(NTOK * 4 + 32 * 256) * 4);
constexpr size_t OFF_CTX = al256(OFF_SCL + (size_t)NTOK * 4);
constexpr size_t OFF_CNT = al256(OFF_CTX + (size_t)NCTX * 1024 * 4);
constexpr size_t OFF_TOKE = al256(OFF_CNT + 256);
constexpr size_t OFF_TOKP = al256(OFF_TOKE + (size_t)NTOK * 4 * 4);
constexpr size_t OFF_TOKG = al256(OFF_TOKP + (size_t)NTOK * 4 * 4);
constexpr size_t OFF_TOKS = al256(OFF_TOKG + (size_t)NTOK * 4 * 4);
constexpr size_t OFF_SLT = al256(OFF_TOKS + (size_t)NTOK * 4 * 4);
constexpr size_t OFF_SLG = al256(OFF_SLT + (size_t)NSLOT_MAX * 4);
constexpr size_t OFF_H = al256(OFF_SLG + (size_t)NSLOT_MAX * 4);
constexpr size_t OFF_CC = al256(OFF_H + (size_t)NTOK * 1024 * 2);
constexpr size_t OFF_P = al256(OFF_CC + (size_t)NTOK * 1024 * 2);
constexpr size_t OFF_S = al256(OFF_P + (size_t)NTOK * PINP * 4);
constexpr size_t TOK256F = (size_t)NTOK * 256 * 4;
constexpr size_t S_QN = 0;
constexpr size_t S_KN = S_QN + (size_t)NTOK * 512 * 2;
constexpr size_t S_VT = S_KN + (size_t)NTOK * 512 * 2;
constexpr size_t S_RWR = S_VT + (size_t)NB * 8 * 64 * TTOK * 2;
constexpr size_t S_RWKK = S_RWR + TOK256F;
constexpr size_t S_RWV = S_RWKK + TOK256F;
constexpr size_t S_RWG = S_RWV + TOK256F;
constexpr size_t S_RWW = S_RWG + TOK256F;
constexpr size_t S_RWKD = S_RWW + 2 * TOK256F;
constexpr size_t S_RWB = S_RWKD + 2 * TOK256F;
constexpr size_t S_BON = S_RWB + 2 * TOK256F;
constexpr size_t S_GDQ = al256(S_BON + (size_t)NTOK * 4 * 4);
constexpr size_t S_GDK = S_GDQ + TOK256F;
constexpr size_t S_GDV = S_GDK + TOK256F;
constexpr size_t S_GDAB = S_GDV + TOK256F;
constexpr size_t S_YRW = al256(S_GDAB + (size_t)NTOK * 16 * 4);
constexpr size_t S_YGD = S_YRW + 2 * TOK256F;
constexpr size_t S_END = S_YGD + 2 * TOK256F;
constexpr size_t S_SIZE = (S_END > (size_t)NSLOT_MAX * 1024 * 4) ? S_END : (size_t)NSLOT_MAX * 1024 * 4;
constexpr int NCHUNK = TTOK / 64;
constexpr int NCHAIN = 32;
constexpr size_t OFF_CH = al256(OFF_S + S_SIZE);
constexpr size_t CH_N = (size_t)NCHAIN * NCHUNK;
constexpr size_t CH_REC = 32768, CH_PT = 0, CH_RYT = 8192, CH_QT = 16384, CH_YX = 24576;
constexpr size_t CH_SIZE = CH_N * CH_REC;
constexpr size_t WS_TOTAL = OFF_CH + CH_SIZE;
static_assert(WS_TOTAL <= (size_t)2048 * 1024 * 1024, "workspace exceeds 4x largest tensor");

struct Params {
  const float *x, *c, *ctx, *c_ctx, *ada_w, *ada_b, *norm_mix_g, *norm_ffn_g, *w_in, *w_out;
  const float *na_q_gain, *na_k_gain, *na_rpb;
  const float *rw_mu, *rw_w0, *rw_w_up, *rw_a0, *rw_a_up, *rw_g_up, *rw_k_k, *rw_k_a, *rw_r_k, *rw_ln_w, *rw_ln_b;
  const float *gd_conv_w, *gd_A_log, *gd_dt_bias, *gd_norm_g;
  const float *moe_router_w, *moe_router_b, *moe_w_gu, *moe_b_gu, *moe_w_down, *moe_b_down;
  float* out;
  char* ws;
};

typedef const __attribute__((address_space(4))) Params* PP;
#define p (*pp)
__device__ __forceinline__ char* fresh_ws(PP pp) { return p.ws; }
__device__ __forceinline__ int tid_opaque() { int t = (int)__builtin_amdgcn_workitem_id_x(); asm volatile("" : "+v"(t)); return t; }
__device__ __forceinline__ int opq(int x) { asm volatile("" : "+s"(x)); return x; }
__device__ __forceinline__ int wave_id(int tid) { return __builtin_amdgcn_readfirstlane(tid >> 6); }
typedef __bf16 bf16v2_t __attribute__((ext_vector_type(2)));
typedef float f32v2_t __attribute__((ext_vector_type(2)));
__device__ __forceinline__ unsigned pk_bf16(float lo, float hi) { f32v2_t v = {lo, hi}; return __builtin_bit_cast(unsigned, __builtin_convertvector(v, bf16v2_t)); }
__device__ __forceinline__ bfr f2bf(float f) { return (bfr)(pk_bf16(f, f) & 0xffffu); }
__device__ __forceinline__ float bf2f(short v) { return __uint_as_float(((unsigned)(unsigned short)v) << 16); }
__device__ __forceinline__ bf16x4 pack4(float a, float b, float c, float d) {
  typedef __attribute__((ext_vector_type(2))) unsigned u32x2;
  u32x2 w; w[0] = pk_bf16(a, b); w[1] = pk_bf16(c, d);
  return __builtin_bit_cast(bf16x4, w);
}
__device__ __forceinline__ float sigmoidf_(float x) { return __builtin_amdgcn_rcpf(1.f + __expf(-x)); }
__device__ __forceinline__ float siluf_(float x) { return x * __builtin_amdgcn_rcpf(1.f + __expf(-x)); }
__device__ __forceinline__ float softplusf_(float x) { const float e = __expf(fminf(x, 20.f)); const float lg = __logf(1.f + e); const float r = x < -15.f ? e : lg; return x > 20.f ? x : r; }
__device__ __forceinline__ float wave_sum(float v) {
  v += __builtin_bit_cast(float, __builtin_amdgcn_update_dpp(0, __builtin_bit_cast(int, v), 0xB1, 0xF, 0xF, true));
  v += __builtin_bit_cast(float, __builtin_amdgcn_update_dpp(0, __builtin_bit_cast(int, v), 0x4E, 0xF, 0xF, true));
  v += __builtin_bit_cast(float, __builtin_amdgcn_update_dpp(0, __builtin_bit_cast(int, v), 0x141, 0xF, 0xF, true));
  v += __builtin_bit_cast(float, __builtin_amdgcn_update_dpp(0, __builtin_bit_cast(int, v), 0x140, 0xF, 0xF, true));
  v += __builtin_bit_cast(float, __builtin_amdgcn_update_dpp(0, __builtin_bit_cast(int, v), 0x142, 0xA, 0xF, false));
  v += __builtin_bit_cast(float, __builtin_amdgcn_update_dpp(0, __builtin_bit_cast(int, v), 0x143, 0xC, 0xF, false));
  return __builtin_bit_cast(float, __builtin_amdgcn_readlane(__builtin_bit_cast(int, v), 63));
}
__device__ __forceinline__ float wave_max(float v) {
  v = fmaxf(v, __builtin_bit_cast(float, __builtin_amdgcn_update_dpp(0, __builtin_bit_cast(int, v), 0xB1, 0xF, 0xF, true)));
  v = fmaxf(v, __builtin_bit_cast(float, __builtin_amdgcn_update_dpp(0, __builtin_bit_cast(int, v), 0x4E, 0xF, 0xF, true)));
  v = fmaxf(v, __builtin_bit_cast(float, __builtin_amdgcn_update_dpp(0, __builtin_bit_cast(int, v), 0x141, 0xF, 0xF, true)));
  v = fmaxf(v, __builtin_bit_cast(float, __builtin_amdgcn_update_dpp(0, __builtin_bit_cast(int, v), 0x140, 0xF, 0xF, true)));
  const float r1 = __builtin_bit_cast(float, __builtin_amdgcn_readlane(__builtin_bit_cast(int, v), 0));
  const float r2 = __builtin_bit_cast(float, __builtin_amdgcn_readlane(__builtin_bit_cast(int, v), 16));
  const float r3 = __builtin_bit_cast(float, __builtin_amdgcn_readlane(__builtin_bit_cast(int, v), 32));
  const float r4 = __builtin_bit_cast(float, __builtin_amdgcn_readlane(__builtin_bit_cast(int, v), 48));
  return fmaxf(fmaxf(r1, r2), fmaxf(r3, r4));
}
__device__ __forceinline__ float shfl_xor_l(float v, int mask, int lane) {
  return __builtin_bit_cast(float, __builtin_amdgcn_ds_bpermute((lane ^ mask) << 2, __builtin_bit_cast(int, v)));
}
__device__ __forceinline__ int shfl_xor_li(int v, int mask, int lane) {
  return __builtin_amdgcn_ds_bpermute((lane ^ mask) << 2, v);
}
__device__ __forceinline__ float row16_sum(float v) {
  v += __builtin_bit_cast(float, __builtin_amdgcn_update_dpp(0, __builtin_bit_cast(int, v), 0xB1, 0xF, 0xF, true));
  v += __builtin_bit_cast(float, __builtin_amdgcn_update_dpp(0, __builtin_bit_cast(int, v), 0x4E, 0xF, 0xF, true));
  v += __builtin_bit_cast(float, __builtin_amdgcn_update_dpp(0, __builtin_bit_cast(int, v), 0x141, 0xF, 0xF, true));
  v += __builtin_bit_cast(float, __builtin_amdgcn_update_dpp(0, __builtin_bit_cast(int, v), 0x140, 0xF, 0xF, true));
  return v;
}
__device__ __forceinline__ float quant_row_store(const float4 (&v)[4], signed char* dst_row, int lane) {
  float am = 0.f;
#pragma unroll
  for (int i = 0; i < 4; ++i) am = fmaxf(fmaxf(am, fmaxf(fabsf(v[i].x), fabsf(v[i].y))), fmaxf(fabsf(v[i].z), fabsf(v[i].w)));
  am = wave_max(am);
  const float sc = am > 0.f ? am * (1.f / 127.f) : 1.f, iv = 1.f / sc;
#pragma unroll
  for (int i = 0; i < 4; ++i) {
    const int q0 = (int)fminf(fmaxf(rintf(v[i].x * iv), -127.f), 127.f), q1 = (int)fminf(fmaxf(rintf(v[i].y * iv), -127.f), 127.f);
    const int q2 = (int)fminf(fmaxf(rintf(v[i].z * iv), -127.f), 127.f), q3 = (int)fminf(fmaxf(rintf(v[i].w * iv), -127.f), 127.f);
    *(unsigned*)(dst_row + (lane + 64 * i) * 4) = (unsigned)(q0 & 0xff) | ((unsigned)(q1 & 0xff) << 8) | ((unsigned)(q2 & 0xff) << 16) | ((unsigned)(q3 & 0xff) << 24);
  }
  return sc;
}
__device__ __forceinline__ int mod_row(int m) { return m < NLAT ? (m >> 14) : 2; }

__device__ __forceinline__ void phase_ada(PP pp, int bid, int nb, char* smem) {
  float* red = (float*)smem;
  float* mods = (float*)(p.ws + OFF_MODS);
  const int tid = tid_opaque();
  for (int task = bid; task < 2 * 96; task += nb) {
    int l = task / 96, cgp = task % 96;
    int col = cgp * 64 + (tid & 63), ks = tid >> 6;
    const float* W = p.ada_w + (size_t)l * 1024 * 6144;
    float a0 = 0.f, a1 = 0.f, a2 = 0.f;
    for (int d = ks * 128; d < ks * 128 + 128; ++d) {
      float w = W[(size_t)d * 6144 + col];
      a0 += siluf_(p.c[d]) * w;
      a1 += siluf_(p.c[1024 + d]) * w;
      a2 += siluf_(p.c_ctx[d]) * w;
    }
    red[(ks * 3 + 0) * 64 + (tid & 63)] = a0;
    red[(ks * 3 + 1) * 64 + (tid & 63)] = a1;
    red[(ks * 3 + 2) * 64 + (tid & 63)] = a2;
    __syncthreads();
    if (tid < 192) {
      int r = tid >> 6, cc = tid & 63;
      float s = 0.f;
      for (int k = 0; k < 8; ++k) s += red[(k * 3 + r) * 64 + cc];
      mods[(size_t)(l * 3 + r) * 6144 + cgp * 64 + cc] = s + p.ada_b[(size_t)l * 6144 + cgp * 64 + cc];
    }
    __syncthreads();
  }
}

__device__ __forceinline__ void convert_tile(const float* src, int N, bfr* dst, int kt4  , int nt, float* tile  ) {
  const int tid = tid_opaque();
  float4 v[8];
#pragma unroll
  for (int q = 0; q < 8; ++q) {
    const int idx = tid + q * 512;
    const int kk = idx >> 4, n4 = idx & 15;
    v[q] = *(const float4*)(src + (size_t)(kt4 * 256 + kk) * N + nt * 64 + n4 * 4);
  }
#pragma unroll
  for (int q = 0; q < 8; ++q) {
    const int idx = tid + q * 512;
    const int kk = idx >> 4, n4 = idx & 15;
    tile[kk * 65 + n4 * 4 + 0] = v[q].x; tile[kk * 65 + n4 * 4 + 1] = v[q].y;
    tile[kk * 65 + n4 * 4 + 2] = v[q].z; tile[kk * 65 + n4 * 4 + 3] = v[q].w;
  }
  __syncthreads();
  {
    const int nn = tid >> 3, kc = tid & 7;
    const int n = nt * 64 + nn;
#pragma unroll
    for (int q = 0; q < 4; ++q) {
      const int k0 = (kc + 8 * q) * 8;
      *(bf16x4*)(dst + (size_t)n * 1024 + kt4 * 256 + k0) = pack4(tile[(k0 + 0) * 65 + nn], tile[(k0 + 1) * 65 + nn], tile[(k0 + 2) * 65 + nn], tile[(k0 + 3) * 65 + nn]);
      *(bf16x4*)(dst + (size_t)n * 1024 + kt4 * 256 + k0 + 4) = pack4(tile[(k0 + 4) * 65 + nn], tile[(k0 + 5) * 65 + nn], tile[(k0 + 6) * 65 + nn], tile[(k0 + 7) * 65 + nn]);
    }
  }
  __syncthreads();
}
template <int N, bool INTERLEAVE>
__device__ __forceinline__ void convert_i8(const float* src  , signed char* dst  , float* sw, int ng, char* smem) {
  const int tid = tid_opaque();
  bfr* blk = (bfr*)smem;
  int* cmax = (int*)(smem + 131072);
  if (tid < 64) cmax[tid] = 0;
  __syncthreads();
  {
    const int n4 = tid & 15, kk0 = tid >> 4;
    float m0 = 0.f, m1 = 0.f, m2 = 0.f, m3 = 0.f;
#pragma unroll 8
    for (int ps = 0; ps < 32; ++ps) {
      const int k = ps * 32 + kk0;
      float4 v = make_float4(0.f, 0.f, 0.f, 0.f);
      if (ng * 64 + n4 * 4 < N) v = *(const float4*)(src + (size_t)k * N + ng * 64 + n4 * 4);
      m0 = fmaxf(m0, fabsf(v.x)); m1 = fmaxf(m1, fabsf(v.y)); m2 = fmaxf(m2, fabsf(v.z)); m3 = fmaxf(m3, fabsf(v.w));
      *(bf16x4*)(blk + k * 64 + n4 * 4) = pack4(v.x, v.y, v.z, v.w);
    }
    atomicMax(&cmax[n4 * 4 + 0], __float_as_int(m0)); atomicMax(&cmax[n4 * 4 + 1], __float_as_int(m1));
    atomicMax(&cmax[n4 * 4 + 2], __float_as_int(m2)); atomicMax(&cmax[n4 * 4 + 3], __float_as_int(m3));
  }
  __syncthreads();
  {
    const int nn = tid >> 3, kc = tid & 7;
    const int n = ng * 64 + nn;
    const float am = __int_as_float(cmax[nn]);
    const float sc = am > 0.f ? am * (1.f / 127.f) : 1.f, iv = 1.f / sc;
    const int j = n & 1023;
    const int row = INTERLEAVE ? (j >> 4) * 32 + (j & 15) + ((n >= 1024) ? 16 : 0) : n;
    if (kc == 0) sw[n] = sc;
#pragma unroll 2
    for (int q = 0; q < 8; ++q) {
      const int k0 = (kc + 8 * q) * 16;
      unsigned w[4];
#pragma unroll
      for (int g4 = 0; g4 < 4; ++g4) {
        unsigned acc = 0u;
#pragma unroll
        for (int b = 0; b < 4; ++b) {
          const float v = bf2f((short)blk[(k0 + g4 * 4 + b) * 64 + nn]);
          const int qi = (int)fminf(fmaxf(rintf(v * iv), -127.f), 127.f);
          acc |= ((unsigned)(qi & 0xff)) << (8 * b);
        }
        w[g4] = acc;
      }
      *(uint4*)(dst + (size_t)row * 1024 + k0) = make_uint4(w[0], w[1], w[2], w[3]);
    }
  }
  __syncthreads();
}
__device__ __forceinline__ void phase_convert(PP pp, int l, int part, int bid, int nb, char* smem) {
  float* tile = (float*)smem;
  char* wl = p.ws + OFF_W + (size_t)l * WL_SIZE;
  const int T_IN = 56, T_OUT = 4 * 16, T_GU = 32 * 32, T_DN = 32 * 4 * 16;
  const int t_lo = part == 0 ? 0 : T_IN + T_OUT;
  const int t_hi = part == 0 ? T_IN + T_OUT : T_IN + T_OUT + T_GU + T_DN;
  for (int t = t_lo + bid; t < t_hi; t += nb) {
    if (t < T_IN) {
      convert_i8<PIN, false>(p.w_in + (size_t)l * 1024 * PIN, (signed char*)(wl + WL_IN), (float*)(p.ws + OFF_SWIN) + (size_t)l * PINP, t, smem);
    } else if (t < T_IN + T_OUT) {
      int u = t - T_IN; int kt4 = u / 16, nt = u % 16;
      convert_tile(p.w_out + (size_t)l * 1024 * 1024, 1024, (bfr*)(wl + WL_OUT), kt4, nt, tile);
    } else if (t < T_IN + T_OUT + T_GU) {
      int u = t - T_IN - T_OUT; int e = u / 32, ng = u % 32;
      convert_i8<2048, true>(p.moe_w_gu + ((size_t)l * 32 + e) * 1024 * 2048, (signed char*)(wl + WL_GU) + (size_t)e * 2048 * 1024,
                    (float*)(p.ws + OFF_SW) + ((size_t)l * 32 + e) * 2048, ng, smem);
    } else {
      int u = t - T_IN - T_OUT - T_GU; int e = u / 64; int v = u % 64; int kt4 = v / 16, nt = v % 16;
      convert_tile(p.moe_w_down + ((size_t)l * 32 + e) * 1024 * 1024, 1024, (bfr*)(wl + WL_DN) + (size_t)e * 1024 * 1024, kt4, nt, tile);
    }
  }
}

__device__ __forceinline__ void phase_prenorm(PP pp, int l, int bid, int nb) {
  const int tid = tid_opaque(), lane = tid & 63, wv = wave_id(tid);
  const float* xl = (l == 0) ? p.x : p.out;
  const float* xc = (l == 0) ? p.ctx : (const float*)(p.ws + OFF_CTX);
  const float* mods = (const float*)(p.ws + OFF_MODS) + (size_t)l * 3 * 6144;
  const float* g = p.norm_mix_g + (size_t)l * 1024;
  signed char* H8 = (signed char*)(p.ws + OFF_H);
  float* SCL = (float*)(p.ws + OFF_SCL);
  {
    int* cnt = (int*)(p.ws + OFF_CNT);
    int gt = bid * NTHR + tid;
    if (gt < 32) cnt[gt] = 0;
  }
  for (int m = bid * 8 + wv; m < NTOK; m += nb * 8) {
    const float* xr = (m < NLAT) ? xl + (size_t)m * 1024 : xc + (size_t)(m - NLAT) * 1024;
    const float* md = mods + (size_t)mod_row(m) * 6144;
    float4 v[4];
    float ss = 0.f;
#pragma unroll
    for (int i = 0; i < 4; ++i) {
      v[i] = *(const float4*)(xr + (lane + 64 * i) * 4);
      ss += v[i].x * v[i].x + v[i].y * v[i].y + v[i].z * v[i].z + v[i].w * v[i].w;
    }
    ss = wave_sum(ss);
    float rs = rsqrtf(ss * (1.f / 1024.f) + 1e-6f);
    float4 hq[4];
#pragma unroll
    for (int i = 0; i < 4; ++i) {
      int d = (lane + 64 * i) * 4;
      float4 gg = *(const float4*)(g + d);
      float4 sh = *(const float4*)(md + d);
      float4 sc = *(const float4*)(md + 1024 + d);
      hq[i] = make_float4(v[i].x * rs * gg.x * (1.f + sc.x) + sh.x, v[i].y * rs * gg.y * (1.f + sc.y) + sh.y,
                          v[i].z * rs * gg.z * (1.f + sc.z) + sh.z, v[i].w * rs * gg.w * (1.f + sc.w) + sh.w);
    }
    const float qs = quant_row_store(hq, H8 + (size_t)m * 1024, lane);
    if (lane == 0) SCL[m] = qs;
  }
}

#define LAS __attribute__((address_space(3)))
namespace g8 {
constexpr int BM = 256, BK = 64, HALF = 128, HTB = HALF * BK * 2, STAGE_BYTES = 8 * HTB, KD = 1024;
__device__ __forceinline__ int lds_byte(int r, int c) { const int st = (r >> 4) * 2 + (c >> 5), rr = r & 15, cc = c & 31, ob = rr * 64 + cc * 2; return st * 1024 + (ob ^ (((ob >> 9) & 1) << 5)); }
__device__ __forceinline__ void stage_rc(int b, int& R, int& C) { const int st = b / 1024, sb = b % 1024, swz = sb ^ (((sb >> 9) & 1) << 5); R = (st >> 1) * 16 + swz / 64; C = (st & 1) * 32 + (swz % 64) / 2; }
struct GUnit { int pm, pn, brow0, e; };
__device__ __forceinline__ int unit_index(int i, int c, int G, int total) {
  const int x = c & 7, j = c >> 3, q = total >> 3, r = total & 7;
  const int start = x < r ? x * (q + 1) : r * (q + 1) + (x - r) * q;
  const int size = q + (x < r ? 1 : 0);
  const int li = i * (G >> 3) + j;
  return li < size ? start + li : -1;
}

__device__ __forceinline__ f32x4 mma16(bf16x8 a, bf16x8 b, f32x4 c) { return __builtin_amdgcn_mfma_f32_16x16x32_bf16(a, b, c, 0, 0, 0); }
__device__ __forceinline__ i32x4 mma16(i32x4 a, i32x4 b, i32x4 c) { return __builtin_amdgcn_mfma_i32_16x16x64_i8(a, b, c, 0, 0, 0); }
template <bool I8, class Sched, class Epi>
__device__ __forceinline__ void gemm_stream(LAS unsigned char* lds, const void* Abase, const void* Btbase, const Sched& S, const Epi& E) {
  typedef typename std::conditional<I8, i32x4, f32x4>::type AccT;
  typedef typename std::conditional<I8, i32x4, bf16x8>::type FragT;
  constexpr int KB = I8 ? KD : KD * 2;
  const int tid = tid_opaque(), wid = __builtin_amdgcn_readfirstlane(tid >> 6), lane = tid & 63, wr = wid >> 2, wc = wid & 3, fr = lane & 15, fq = lane >> 4;
  constexpr int nt = KB / 128;
  int R[2], C[2];
  unsigned voffB[2];
#pragma unroll
  for (int i = 0; i < 2; ++i) { stage_rc(tid * 16 + i * 8192, R[i], C[i]); voffB[i] = (unsigned)(R[i] * KB + C[i] * 2); }
#define voffA voffB
  constexpr size_t kstep = (size_t)(BK * 2);
  constexpr size_t hstep = (size_t)HALF * KB;
  const unsigned ldsw = (unsigned)wid * 1024u;
  const int aoff = lds_byte(wr * 64 + fr, fq * 8), boff = lds_byte(wc * 32 + fr, fq * 8);
#define G8_SA(b, h) (((b) * 2 + (h)) * HTB)
#define G8_SB(b, h) ((4 + (b) * 2 + (h)) * HTB)
#define G8_STAGE(bufoff, gbase, v0, v1) do { \
    __builtin_amdgcn_global_load_lds((const unsigned*)((const char*)(gbase) + (v0)), (LAS unsigned*)(lds + (bufoff) + ldsw), 16, 0, 0); \
    __builtin_amdgcn_global_load_lds((const unsigned*)((const char*)(gbase) + (v1)), (LAS unsigned*)(lds + (bufoff) + ldsw + 8192), 16, 0, 0); } while (0)
#define G8_STAGEB(bufoff, gbase) G8_STAGE(bufoff, gbase, voffB[0], voffB[1])
#define G8_STAGEA(bufoff, gbase) G8_STAGE(bufoff, gbase, voffA[0], voffA[1])
#define G8_LDA(dst, b, h) do { _Pragma("unroll") for (int m = 0; m < 4; ++m) _Pragma("unroll") for (int k = 0; k < 2; ++k) dst[m][k] = *(const LAS FragT*)(lds + G8_SA(b, h) + aoff + m * 2048 + k * 1024); } while (0)
#define G8_LDB(dst, b, h) do { _Pragma("unroll") for (int n = 0; n < 2; ++n) _Pragma("unroll") for (int k = 0; k < 2; ++k) dst[n][k] = *(const LAS FragT*)(lds + G8_SB(b, h) + boff + n * 2048 + k * 1024); } while (0)
#define G8_MMA(ai, bj, At, Bt) do { __builtin_amdgcn_s_setprio(1); _Pragma("unroll") for (int m = 0; m < 4; ++m) _Pragma("unroll") for (int n = 0; n < 2; ++n) _Pragma("unroll") for (int k = 0; k < 2; ++k) \
    acc[ai][bj][m][n] = mma16(Bt[n][k], At[m][k], acc[ai][bj][m][n]); __builtin_amdgcn_s_setprio(0); } while (0)
#define G8_WAIT_V(n) asm volatile("s_waitcnt vmcnt(" #n ")" ::: "memory")
#define G8_WAIT_L(n) asm volatile("s_waitcnt lgkmcnt(" #n ")" ::: "memory")
#define G8_BAR __builtin_amdgcn_s_barrier()
#define G8_SCHED __builtin_amdgcn_sched_barrier(0)
  GUnit cur, nxt;
  int ui = 0;
  if (!S.next(0, cur)) return;
  AccT acc[2][2][4][2];
#pragma unroll
  for (int a = 0; a < 2; ++a)
#pragma unroll
    for (int b = 0; b < 2; ++b)
#pragma unroll
      for (int m = 0; m < 4; ++m)
#pragma unroll
        for (int n = 0; n < 2; ++n) acc[a][b][m][n] = AccT{};
  FragT At[4][2], B0[2][2], B1[2][2];
  const char* cA = (const char*)Abase + (size_t)cur.pm * (BM * KB);
  const char* cB = (const char*)Btbase + (size_t)cur.brow0 * KB;
  G8_STAGEB(G8_SB(0, 0), cB); G8_STAGEA(G8_SA(0, 0), cA); G8_STAGEB(G8_SB(0, 1), cB + hstep); G8_STAGEA(G8_SA(0, 1), cA + hstep);
  if (wr == 1) G8_BAR;
  G8_WAIT_V(4); G8_BAR;
  G8_STAGEB(G8_SB(1, 0), cB + kstep); G8_STAGEA(G8_SA(1, 0), cA + kstep); G8_STAGEB(G8_SB(1, 1), cB + hstep + kstep);
  G8_WAIT_V(6); G8_BAR;
  for (;;) {
    const bool has_next = S.next(ui + 1, nxt);
    const char* nA = has_next ? (const char*)Abase + (size_t)nxt.pm * (BM * KB) : cA;
    const char* nB = has_next ? (const char*)Btbase + (size_t)nxt.brow0 * KB : cB;
#pragma unroll 1
    for (int t = 0; t < nt; t += 2) {
      const bool last = (t == nt - 2);
      const char* a1 = cA + (size_t)(t + 1) * kstep;
      const char* a2 = last ? nA : cA + (size_t)(t + 2) * kstep;
      const char* b2 = last ? nB : cB + (size_t)(t + 2) * kstep;
      const char* a3 = a2 + kstep;
      const char* b3 = b2 + kstep;
      G8_LDB(B0, 0, 0); G8_SCHED; G8_LDA(At, 0, 0); G8_STAGEA(G8_SA(1, 1), a1 + hstep);
      G8_WAIT_L(8); G8_BAR; G8_WAIT_L(0); G8_MMA(0, 0, At, B0); G8_BAR; G8_SCHED;
      G8_LDB(B1, 0, 1); G8_STAGEB(G8_SB(0, 0), b2);
      G8_BAR; G8_WAIT_L(0); G8_MMA(0, 1, At, B1); G8_BAR;
      G8_LDA(At, 0, 1); G8_STAGEA(G8_SA(0, 0), a2);
      G8_BAR; G8_WAIT_L(0); G8_MMA(1, 0, At, B0); G8_BAR; G8_SCHED;
      G8_STAGEB(G8_SB(0, 1), b2 + hstep);
      G8_WAIT_V(6); G8_BAR; G8_MMA(1, 1, At, B1); G8_BAR;
      G8_LDB(B0, 1, 0); G8_SCHED; G8_LDA(At, 1, 0); G8_STAGEA(G8_SA(0, 1), a2 + hstep);
      G8_WAIT_L(8); G8_BAR; G8_WAIT_L(0); G8_MMA(0, 0, At, B0); G8_BAR; G8_SCHED;
      G8_LDB(B1, 1, 1); G8_STAGEB(G8_SB(1, 0), b3);
      G8_BAR; G8_WAIT_L(0); G8_MMA(0, 1, At, B1); G8_BAR;
      G8_LDA(At, 1, 1); G8_STAGEA(G8_SA(1, 0), a3);
      G8_BAR; G8_WAIT_L(0); G8_MMA(1, 0, At, B0); G8_BAR; G8_SCHED;
      G8_STAGEB(G8_SB(1, 1), b3 + hstep);
      G8_WAIT_V(6); G8_BAR; G8_MMA(1, 1, At, B1); G8_BAR;
    }
    E(acc, cur, wr, wc, fr, fq);
    if (!has_next) break;
#pragma unroll
    for (int a = 0; a < 2; ++a)
#pragma unroll
      for (int b = 0; b < 2; ++b)
#pragma unroll
        for (int m = 0; m < 4; ++m)
#pragma unroll
          for (int n = 0; n < 2; ++n) acc[a][b][m][n] = AccT{};
    cur = nxt; cA = nA; cB = nB; ++ui;
  }
  G8_WAIT_V(0);
  if (wr == 0) G8_BAR;
  G8_BAR;
#undef G8_SA
#undef G8_SB
#undef G8_STAGE
#undef G8_STAGEB
#undef G8_STAGEA
#undef voffA
#undef G8_LDA
#undef G8_LDB
#undef G8_MMA
#undef G8_WAIT_V
#undef G8_WAIT_L
#undef G8_BAR
#undef G8_SCHED
}

struct DenseSched {
  int nM, nN, G, c;
  __device__ __forceinline__ bool next(int i, GUnit& u) const {
    const int idx = unit_index(i, c, G, nM * nN);
    if (idx < 0) return false;
    u.pm = idx / nN; u.pn = idx - u.pm * nN; u.brow0 = u.pn * BM; u.e = 0;
    return true;
  }
};
struct MoeSched {
  const int* toff; int nN, NE, G, c;
  __device__ __forceinline__ bool next(int i, GUnit& u) const {
    const int idx = unit_index(i, c, G, toff[32] * nN);
    if (idx < 0) return false;
    u.pm = idx / nN; u.pn = idx - u.pm * nN;
    int e = 0;
#pragma unroll 1
    for (int k = 1; k < 32; ++k) e = (u.pm >= toff[k]) ? k : e;
    u.e = e; u.brow0 = e * NE + u.pn * BM;
    return true;
  }
};
}

struct EpiInProj {
  float* P; const float* SCL; const float* sw;
  __device__ __forceinline__ void operator()(const i32x4 (&acc)[2][2][4][2], const g8::GUnit& u, int wr, int wc, int fr, int fq) const {
    const int row0 = u.pm * 256 + wr * 64 + fr, col0 = u.pn * 256 + wc * 32 + 4 * fq;
    f32x4 cs[2][2];
#pragma unroll
    for (int bj = 0; bj < 2; ++bj)
#pragma unroll
      for (int n = 0; n < 2; ++n) cs[bj][n] = *(const f32x4*)(sw + col0 + bj * 128 + n * 16);
    float sav[2][4];
#pragma unroll
    for (int ai = 0; ai < 2; ++ai)
#pragma unroll
      for (int m = 0; m < 4; ++m) sav[ai][m] = SCL[row0 + ai * 128 + m * 16];
#pragma unroll
    for (int ai = 0; ai < 2; ++ai)
#pragma unroll
      for (int m = 0; m < 4; ++m) {
        const int row = row0 + ai * 128 + m * 16;
        const float sa = sav[ai][m];
        float* rowp = P + (size_t)row * PINP + col0;
#pragma unroll
        for (int bj = 0; bj < 2; ++bj)
#pragma unroll
          for (int n = 0; n < 2; ++n) {
            const i32x4 a = acc[ai][bj][m][n];
            f32x4 o = {(float)a[0], (float)a[1], (float)a[2], (float)a[3]};
            *(f32x4*)(rowp + bj * 128 + n * 16) = o * (cs[bj][n] * sa);
          }
      }
  }
};
__device__ __forceinline__ void phase_gemm_in(PP pp, int l, int bid, int nb, char* smem) {
  g8::DenseSched S{130, 14, nb, bid};
  EpiInProj E{(float*)(p.ws + OFF_P), (const float*)(p.ws + OFF_SCL), (const float*)(p.ws + OFF_SWIN) + (size_t)l * PINP};
  g8::gemm_stream<true>((LAS unsigned char*)smem, p.ws + OFF_H, p.ws + OFF_W + (size_t)l * WL_SIZE + WL_IN, S, E);
}

struct EpiOutProj {
  const float *xl, *xc, *mods; float *ol, *oc;
  __device__ __forceinline__ void operator()(const f32x4 (&acc)[2][2][4][2], const g8::GUnit& u, int wr, int wc, int fr, int fq) const {
    const bool lat = u.pm < 128;
    const float* xin = lat ? xl + (size_t)u.pm * 256 * 1024 : xc + (size_t)(u.pm - 128) * 256 * 1024;
    float* xo = lat ? ol + (size_t)u.pm * 256 * 1024 : oc + (size_t)(u.pm - 128) * 256 * 1024;
    const float* g1 = mods + (size_t)(lat ? (u.pm >> 6) : 2) * 6144 + 2048;
    const int row0 = wr * 64 + fr, col0 = u.pn * 256 + wc * 32 + 4 * fq;
#pragma unroll
    for (int bj = 0; bj < 2; ++bj)
#pragma unroll
      for (int n = 0; n < 2; ++n) {
        const f32x4 gv = *(const f32x4*)(g1 + col0 + bj * 128 + n * 16);
        f32x4 xv[2][4];
#pragma unroll
        for (int ai = 0; ai < 2; ++ai)
#pragma unroll
          for (int m = 0; m < 4; ++m) xv[ai][m] = *(const f32x4*)(xin + (size_t)(row0 + ai * 128 + m * 16) * 1024 + col0 + bj * 128 + n * 16);
#pragma unroll
        for (int ai = 0; ai < 2; ++ai)
#pragma unroll
          for (int m = 0; m < 4; ++m)
            *(f32x4*)(xo + (size_t)(row0 + ai * 128 + m * 16) * 1024 + col0 + bj * 128 + n * 16) = xv[ai][m] + gv * acc[ai][bj][m][n];
        asm volatile("" ::: "memory");
      }
  }
};
__device__ __forceinline__ void phase_gemm_out(PP pp, int l, int bid, int nb, char* smem) {
  g8::DenseSched S{(l == 0) ? 130 : 128, 4, nb, bid};
  EpiOutProj E{(l == 0) ? p.x : p.out, (l == 0) ? p.ctx : (const float*)(p.ws + OFF_CTX),
               (const float*)(p.ws + OFF_MODS) + (size_t)l * 3 * 6144, p.out, (float*)(p.ws + OFF_CTX)};
  g8::gemm_stream<false>((LAS unsigned char*)smem, p.ws + OFF_CC, p.ws + OFF_W + (size_t)l * WL_SIZE + WL_OUT, S, E);
}

#define LBAR() do { asm volatile("s_waitcnt lgkmcnt(0)" ::: "memory"); __builtin_amdgcn_s_barrier(); asm volatile("" ::: "memory"); } while (0)
__device__ __forceinline__ void phase_prep(PP pp, int l, int bid, int nb, char* smem) {
  const int tid = tid_opaque(), lane = tid & 63, wv = wave_id(tid);
  const float* P = (const float*)(p.ws + OFF_P);
  char* S = p.ws + OFF_S;
  bfr* QN = (bfr*)(S + S_QN);
  bfr* KN = (bfr*)(S + S_KN);
  bfr* VT = (bfr*)(S + S_VT);
  float* RWR = (float*)(S + S_RWR);
  float* RWKK = (float*)(S + S_RWKK);
  float* RWV = (float*)(S + S_RWV);
  float* RWG = (float*)(S + S_RWG);
  float* RWW = (float*)(S + S_RWW);
  float* RWKD = (float*)(S + S_RWKD);
  float* RWB = (float*)(S + S_RWB);
  float* BON = (float*)(S + S_BON);
  float* GDQ = (float*)(S + S_GDQ);
  float* GDK = (float*)(S + S_GDK);
  float* GDV = (float*)(S + S_GDV);
  float* GDAB = (float*)(S + S_GDAB);
  const float* mu = p.rw_mu + (size_t)l * 896;
  const float* w0 = p.rw_w0 + (size_t)l * 512;
  const float* w_up = p.rw_w_up + (size_t)l * 2 * 32 * 256;
  const float* a0 = p.rw_a0 + (size_t)l * 512;
  const float* a_up = p.rw_a_up + (size_t)l * 2 * 32 * 256;
  const float* g_up = p.rw_g_up + (size_t)l * 64 * 256;
  const float* k_k = p.rw_k_k + (size_t)l * 256;
  const float* k_a = p.rw_k_a + (size_t)l * 256;
  const float* r_k = p.rw_r_k + (size_t)l * 256;
  const float* conv_w = p.gd_conv_w + (size_t)l * 5 * 768;
  const float* A_log = p.gd_A_log + (size_t)l * 8;
  const float* dt_bias = p.gd_dt_bias + (size_t)l * 8;
  const float* qg = p.na_q_gain + (size_t)l * 64;
  const float* kg = p.na_k_gain + (size_t)l * 64;

  bfr* wl = (bfr*)smem;
  float* lor = (float*)(smem + 192 * 256 * 2);
  __syncthreads();
  for (int i = tid; i < 192 * 256; i += NTHR) {
    const int row = i >> 8, c = i & 255;
    const float v = row < 64 ? g_up[row * 256 + c] : row < 128 ? w_up[(row - 64) * 256 + c] : a_up[(row - 128) * 256 + c];
    wl[i] = f2bf(v);
  }
  __syncthreads();

  for (int tile = bid; tile < NTOK / 16; tile += nb) {
    const int m0 = tile * 16;
    int seq_lo, seq_hi, bb, tau0;
    if (m0 < NLAT) { bb = m0 >> 14; seq_lo = bb << 14; seq_hi = seq_lo + SEQ; tau0 = m0 - seq_lo; }
    else { bb = (m0 - NLAT) >> 8; seq_lo = NLAT + (bb << 8); seq_hi = seq_lo + CTXL; tau0 = SEQ + (m0 - seq_lo); }
    const f32x4 z4 = {0.f, 0.f, 0.f, 0.f};
    int tid_t = tid; asm volatile("" : "+v"(tid_t));
    const int lane_t = tid_t & 63;
    const int cb = lane_t * 4, hh = lane_t >> 4;
    const int lg = tid_t & 31, lt = tid_t >> 5;
    const int sl = lane_t >> 4, sc4 = (lane_t & 15) * 4;
    asm volatile("" ::: "memory");
    const f32x4 mur = *(const f32x4*)(mu + cb), muk = *(const f32x4*)(mu + 256 + cb), muv = *(const f32x4*)(mu + 512 + cb);
    const f32x4 mul = *(const f32x4*)(mu + 768 + lg * 4);

    f32x4 pr[3][4], pl[3];
    {
      const int mt0 = m0 + 2 * wv;
#pragma unroll
      for (int j = 0; j < 3; ++j)
#pragma unroll
        for (int t = 0; t < 4; ++t) {
          const int m = mt0 - 1 + t;
          const int mc = min(max(m, seq_lo), seq_hi - 1);
          const f32x4 ld = *(const f32x4*)(P + (size_t)mc * PINP + A_END + j * 256 + cb);
          pr[j][t] = (m == mc) ? ld : z4;
        }
#pragma unroll
      for (int t = 0; t < 3; ++t) {
        const int m = m0 + lt - 1 + t;
        const int mc = min(max(m, seq_lo), seq_hi - 1);
        const f32x4 ld = *(const f32x4*)(P + (size_t)mc * PINP + A_END + 768 + lg * 4);
        pl[t] = (m == mc) ? ld : z4;
      }
    }
    {
      const f32x4 v = pl[1] + mul * (0.5f * (pl[0] + pl[2]) - pl[1]);
#pragma unroll
      for (int i = 0; i < 4; ++i) {
        const int ch = lg * 4 + i;
        lor[ch * 16 + lt] = ch < 32 ? tanhf(v[i]) : ch < 64 ? v[i] : sigmoidf_(v[i]);
      }
    }
    f32x4 rr[2], rk[2], rv[2];
#pragma unroll
    for (int t = 0; t < 2; ++t) {
      rr[t] = pr[0][t + 1] + mur * (0.5f * (pr[0][t] + pr[0][t + 2]) - pr[0][t + 1]);
      rk[t] = pr[1][t + 1] + muk * (0.5f * (pr[1][t] + pr[1][t + 2]) - pr[1][t + 1]);
      rv[t] = pr[2][t + 1] + muv * (0.5f * (pr[2][t] + pr[2][t + 2]) - pr[2][t + 1]);
    }
    LBAR();
    f32x4 pg[20];
    const bool is_gd = wv < 3, is_na = (wv >= 3 && wv < 7);
    const int sec = is_gd ? wv * 4 + sl : (wv - 3) * 4 + sl;
    if (is_gd) {
#pragma unroll
      for (int t = 0; t < 20; ++t) {
        const int m = m0 - 2 + t;
        const int mc = min(max(m, seq_lo), seq_hi - 1);
        const f32x4 ld = *(const f32x4*)(P + (size_t)mc * PINP + B_END + sec * 64 + sc4);
        pg[t] = (m == mc) ? ld : z4;
      }
    } else if (is_na) {
#pragma unroll
      for (int t = 0; t < 16; ++t) pg[t] = *(const f32x4*)(P + (size_t)(m0 + t) * PINP + sec * 64 + sc4);
#pragma unroll
      for (int t = 16; t < 20; ++t) pg[t] = z4;
    } else {
#pragma unroll
      for (int t = 0; t < 20; ++t) pg[t] = z4;
    }
    asm volatile("" ::: "memory");
    {
      f32x4 gacc[2], wa0[2], wa1[2], aa0[2], aa1[2];
#pragma unroll
      for (int t = 0; t < 2; ++t) { gacc[t] = z4; wa0[t] = z4; wa1[t] = z4; aa0[t] = z4; aa1[t] = z4; }
#pragma unroll 4
      for (int j = 0; j < 64; ++j) {
        const bf16x4 wq = *(const bf16x4*)(wl + j * 256 + cb);
        const f32x4 wgt = {bf2f(wq[0]), bf2f(wq[1]), bf2f(wq[2]), bf2f(wq[3])};
        const float2 sv = *(const float2*)(lor + (64 + j) * 16 + 2 * wv);
        gacc[0] += wgt * sv.x; gacc[1] += wgt * sv.y;
      }
#pragma unroll 2
      for (int j = 0; j < 32; ++j) {
        const bf16x4 q0 = *(const bf16x4*)(wl + (64 + j) * 256 + cb), q1 = *(const bf16x4*)(wl + (96 + j) * 256 + cb);
        const bf16x4 q2 = *(const bf16x4*)(wl + (128 + j) * 256 + cb), q3 = *(const bf16x4*)(wl + (160 + j) * 256 + cb);
        const f32x4 ww0 = {bf2f(q0[0]), bf2f(q0[1]), bf2f(q0[2]), bf2f(q0[3])}, ww1 = {bf2f(q1[0]), bf2f(q1[1]), bf2f(q1[2]), bf2f(q1[3])};
        const f32x4 aw0 = {bf2f(q2[0]), bf2f(q2[1]), bf2f(q2[2]), bf2f(q2[3])}, aw1 = {bf2f(q3[0]), bf2f(q3[1]), bf2f(q3[2]), bf2f(q3[3])};
        const float2 tv = *(const float2*)(lor + j * 16 + 2 * wv);
        const float2 dv = *(const float2*)(lor + (32 + j) * 16 + 2 * wv);
        wa0[0] += ww0 * tv.x; wa0[1] += ww0 * tv.y; wa1[0] += ww1 * tv.x; wa1[1] += ww1 * tv.y;
        aa0[0] += aw0 * dv.x; aa0[1] += aw0 * dv.y; aa1[0] += aw1 * dv.x; aa1[1] += aw1 * dv.y;
      }
      asm volatile("" ::: "memory");
      const f32x4 kkc = *(const f32x4*)(k_k + cb), kac = *(const f32x4*)(k_a + cb), rkc = *(const f32x4*)(r_k + cb);
      const f32x4 w00 = *(const f32x4*)(w0 + cb), w01 = *(const f32x4*)(w0 + 256 + cb), a00 = *(const f32x4*)(a0 + cb), a01 = *(const f32x4*)(a0 + 256 + cb);
#pragma unroll
      for (int t = 0; t < 2; ++t) {
        const int m = m0 + 2 * wv + t;
        const f32x4 r = rr[t], k = rk[t], v = rv[t];
        const f32x4 kkraw = k * kkc;
        const float ssum = row16_sum((kkraw[0] * kkraw[0] + kkraw[1] * kkraw[1]) + (kkraw[2] * kkraw[2] + kkraw[3] * kkraw[3]));
        const f32x4 kk = kkraw * rsqrtf(ssum + 1e-6f);
        float bon = 0.f;
#pragma unroll
        for (int d = 0; d < 2; ++d) {
          const f32x4 wlin = d == 0 ? w00 + wa0[t] : w01 + wa1[t];
          const f32x4 alin = d == 0 ? a00 + aa0[t] : a01 + aa1[t];
          f32x4 lw, kd, bv;
#pragma unroll
          for (int i = 0; i < 4; ++i) {
            const float w_log = -softplusf_(-wlin[i]) - 0.5f;
            const float a = sigmoidf_(alin[i]);
            lw[i] = -__expf(w_log);
            kd[i] = k[i] * (1.f + (a - 1.f) * kac[i]);
            bv[i] = kk[i] * a;
            bon += r[i] * kd[i] * rkc[i];
          }
          const size_t o = ((size_t)d * NTOK + m) * 256 + cb;
          *(f32x4*)(RWW + o) = lw; *(f32x4*)(RWKD + o) = kd; *(f32x4*)(RWB + o) = bv;
        }
        bon = row16_sum(bon);
        const size_t o = (size_t)m * 256 + cb;
        *(f32x4*)(RWR + o) = r; *(f32x4*)(RWKK + o) = kk; *(f32x4*)(RWV + o) = v; *(f32x4*)(RWG + o) = gacc[t];
        if ((lane_t & 15) == 0) BON[(size_t)m * 4 + hh] = bon;
      }
    }
    if (is_gd) {
      f32x4 cw[5];
#pragma unroll
      for (int j = 0; j < 5; ++j) cw[j] = *(const f32x4*)(conv_w + j * 768 + sec * 64 + sc4);
#pragma unroll
      for (int t = 0; t < 16; ++t) {
        f32x4 acc = z4;
#pragma unroll
        for (int j = 0; j < 5; ++j) acc += cw[j] * pg[t + j];
        f32x4 val = {siluf_(acc[0]), siluf_(acc[1]), siluf_(acc[2]), siluf_(acc[3])};
        const int m = m0 + t;
        if (sec < 8) {
          const float ss = row16_sum((val[0] * val[0] + val[1] * val[1]) + (val[2] * val[2] + val[3] * val[3]));
          val = val * rsqrtf(ss + 1e-6f);
          if (sec < 4) *(f32x4*)(GDQ + (size_t)m * 256 + sec * 64 + sc4) = val * 0.125f;
          else *(f32x4*)(GDK + (size_t)m * 256 + (sec - 4) * 64 + sc4) = val;
        } else *(f32x4*)(GDV + (size_t)m * 256 + (sec - 8) * 64 + sc4) = val;
      }
    } else if (is_na) {
      const f32x4 gq = *(const f32x4*)(qg + sc4) * (0.125f * 1.4426950408889634f), gk = *(const f32x4*)(kg + sc4);
#pragma unroll
      for (int t = 0; t < 16; ++t) {
        f32x4 val = pg[t];
        const float ss = row16_sum((val[0] * val[0] + val[1] * val[1]) + (val[2] * val[2] + val[3] * val[3]));
        val = val * rsqrtf(ss * (1.f / 64.f) + 1e-6f);
        const int m = m0 + t;
        if (sec < 8) { const f32x4 o = val * gq; *(bf16x4*)(QN + (size_t)m * 512 + sec * 64 + sc4) = pack4(o[0], o[1], o[2], o[3]); }
        else { const f32x4 o = val * gk; *(bf16x4*)(KN + (size_t)m * 512 + (sec - 8) * 64 + sc4) = pack4(o[0], o[1], o[2], o[3]); }
      }
    }
    if (tid_t < 256) {
      const int t = tid_t >> 4, j = tid_t & 15;
      const int m = m0 + t;
      const float pv = P[(size_t)m * PINP + B_END + 1024 + j];
      float o;
      if (j < 8) o = -__expf(A_log[j]) * softplusf_(pv + dt_bias[j]);
      else o = sigmoidf_(pv);
      GDAB[(size_t)m * 16 + j] = o;
    }
    {
      const int vc = (tid_t & 127) * 4, tq = (tid_t >> 7) * 4;
      f32x4 pv[4];
#pragma unroll
      for (int t = 0; t < 4; ++t) pv[t] = *(const f32x4*)(P + (size_t)(m0 + tq + t) * PINP + 1024 + vc);
#pragma unroll
      for (int i = 0; i < 4; ++i) {
        const int hd = vc + i;
        bfr* dst = VT + ((size_t)(bb * 8 + (hd >> 6)) * (TTOK / 16) + (tau0 >> 4)) * 1024 + (hd & 63) * 16 + tq;
        *(bf16x4*)dst = pack4(pv[0][i], pv[1][i], pv[2][i], pv[3][i]);
      }
    }
    LBAR();
  }
  __syncthreads();
}

__device__ __forceinline__ int scan_tok(int b, int d, int s) {
  if (s < CTXL) { int t = d ? (CTXL - 1 - s) : s; return NLAT + b * CTXL + t; }
  int u = s - CTXL; int t = d ? (SEQ - 1 - u) : u; return b * SEQ + t;
}
#define CS 72
#define SLOT_BYTES (64 * CS * 2)
#define F0_STRIDE 68
#define X1_F0 (13 * SLOT_BYTES)
#define X1_ARR (X1_F0 + 64 * F0_STRIDE * 4)

#define MM_FRAGS(As, Bs, a0, a1, b00, b01, b10, b11)                                                     \
  const bf16x8 a0 = *(const bf16x8*)((As) + ((mt * 16 + fr) * CS + fq * 8) * 2);                         \
  const bf16x8 a1 = *(const bf16x8*)((As) + ((mt * 16 + fr) * CS + 32 + fq * 8) * 2);                    \
  const bf16x8 b00 = *(const bf16x8*)((Bs) + ((nt0 * 16 + fr) * CS + fq * 8) * 2);                       \
  const bf16x8 b01 = *(const bf16x8*)((Bs) + ((nt0 * 16 + fr) * CS + 32 + fq * 8) * 2);                  \
  const bf16x8 b10 = *(const bf16x8*)((Bs) + ((nt0 * 16 + 16 + fr) * CS + fq * 8) * 2);                  \
  const bf16x8 b11 = *(const bf16x8*)((Bs) + ((nt0 * 16 + 16 + fr) * CS + 32 + fq * 8) * 2);
#define MM_2TILES(acc0, acc1, a0, a1, b00, b01, b10, b11)                                                \
  acc0 = __builtin_amdgcn_mfma_f32_16x16x32_bf16(a0, b00, acc0, 0, 0, 0);                                \
  acc0 = __builtin_amdgcn_mfma_f32_16x16x32_bf16(a1, b01, acc0, 0, 0, 0);                                \
  acc1 = __builtin_amdgcn_mfma_f32_16x16x32_bf16(a0, b10, acc1, 0, 0, 0);                                \
  acc1 = __builtin_amdgcn_mfma_f32_16x16x32_bf16(a1, b11, acc1, 0, 0, 0);
__device__ __forceinline__ void wr_T(char* slot, int mt, int nt, int fr, int fq, f32x4 v) {
  *(bf16x4*)(slot + ((nt * 16 + fr) * CS + mt * 16 + 4 * fq) * 2) = pack4(v[0], v[1], v[2], v[3]);
}

struct ChunkIn { float lw[8], f0[8], f1[8], f2[8], f3[8], xv[8], be[8]; };
template <bool GDN>
__device__ __forceinline__ void chunk_load(PP pp, int t, ChunkIn& ci) {
  const int tid = tid_opaque(), c = tid & 63, tg = wave_id(tid);
  const int chain = t / NCHUNK, n = t - chain * NCHUNK;
  const int d = chain & 1, h = (chain >> 1) & 3, b = (chain >> 3) & 1;
  const char* S = p.ws + OFF_S;
#pragma unroll
  for (int u = 0; u < 8; ++u) {
    const int m = scan_tok(b, d, n * 64 + tg * 8 + u);
    const size_t o = (size_t)m * 256 + h * 64 + c;
    if (!GDN) {
      ci.lw[u] = ((const float*)(S + S_RWW))[(size_t)d * NTOK * 256 + o];
      ci.f0[u] = ((const float*)(S + S_RWKK))[o];
      ci.f1[u] = ((const float*)(S + S_RWB))[(size_t)d * NTOK * 256 + o];
      ci.f2[u] = ((const float*)(S + S_RWKD))[(size_t)d * NTOK * 256 + o];
      ci.f3[u] = ((const float*)(S + S_RWR))[o];
      ci.xv[u] = ((const float*)(S + S_RWV))[o];
      ci.be[u] = 1.f;
    } else {
      ci.lw[u] = ((const float*)(S + S_GDAB))[(size_t)m * 16 + d * 4 + h];
      ci.be[u] = ((const float*)(S + S_GDAB))[(size_t)m * 16 + 8 + d * 4 + h];
      ci.f0[u] = ((const float*)(S + S_GDK))[o];
      ci.f3[u] = ((const float*)(S + S_GDQ))[o];
      ci.xv[u] = ((const float*)(S + S_GDV))[o];
      ci.f1[u] = 0.f; ci.f2[u] = 0.f;
    }
  }
}
template <bool GDN>
__device__ __forceinline__ void chunk_prep_task(PP pp, int t, int t_next, bool has_next, const ChunkIn& ci, ChunkIn& nx, char* smem) {
  const int chain = t / NCHUNK, n = t - chain * NCHUNK;
  const int d = chain & 1, h = (chain >> 1) & 3, b = (chain >> 3) & 1;
  (void)b; (void)d; (void)h;
  const int tid = tid_opaque(), lane = tid & 63, wv = wave_id(tid);
  const int fr = lane & 15, fq = lane >> 4, mt = wv >> 1, nt0 = (wv & 1) * 2;
  char* S = p.ws + OFF_S;
  char* CH = p.ws + OFF_CH;
  const size_t cc = (size_t)chain * NCHUNK + n;
  char* const p0 = smem;
  char* const p1 = smem + 1 * SLOT_BYTES;
  char* const p2 = smem + 2 * SLOT_BYTES;
  char* const p3 = smem + 3 * SLOT_BYTES;
  char* const p4 = smem + 4 * SLOT_BYTES;
  char* const p5 = smem + 5 * SLOT_BYTES;
  char* const p6 = smem + 6 * SLOT_BYTES;
  char* const p7 = smem + 7 * SLOT_BYTES;
  char* const p8 = smem + 8 * SLOT_BYTES;
  char* const p9 = smem + 9 * SLOT_BYTES;
  char* const p10 = smem + 10 * SLOT_BYTES;
  char* const p11 = smem + 11 * SLOT_BYTES;
  char* const p12 = smem + 12 * SLOT_BYTES;
  float* const F0 = (float*)(smem + X1_F0);
  float* const Lv = (float*)(smem + X1_ARR);
  float* const Lm1v = Lv + 64;
  float* const betav = Lv + 128;
  float* const eLv = Lv + 192;
  float* const gC = Lv + 256;
  float* const gsum = Lv + 320;
  char* const sKt = p0;
  char* const sBh = GDN ? p0 : p1;
  char* const sKh = GDN ? p0 : p2;

  {
    const int c = lane, tg = wv;
    const float* lw = ci.lw; const float* f0 = ci.f0; const float* f1 = ci.f1; const float* f2 = ci.f2; const float* f3 = ci.f3; const float* xv = ci.xv; const float* be = ci.be;
    float cum[8];
    cum[0] = lw[0];
#pragma unroll
    for (int u = 1; u < 8; ++u) cum[u] = cum[u - 1] + lw[u];
    gsum[tg * 64 + c] = cum[7];
    LBAR();
    float off = 0.f, LC = 0.f;
#pragma unroll
    for (int g2 = 0; g2 < 8; ++g2) { const float gs = gsum[g2 * 64 + c]; LC += gs; off += (g2 < tg) ? gs : 0.f; }
    bf16x8 vKtT, vBbT, vKbT, vXT;
#pragma unroll
    for (int u = 0; u < 8; ++u) {
      const int t = tg * 8 + u;
      const float L = off + cum[u], Lm1 = L - lw[u];
      if (!GDN) {
        const float eLm1 = __expf(Lm1), enL = __expf(-L), eL = __expf(L), eCL = __expf(LC - L);
        const float kt = f0[u] * eLm1;
        *(bfr*)(p0 + (t * CS + c) * 2) = f2bf(kt);
        *(bfr*)(p1 + (t * CS + c) * 2) = f2bf(f1[u] * enL);
        *(bfr*)(p2 + (t * CS + c) * 2) = f2bf(f2[u] * enL);
        *(bfr*)(p3 + (t * CS + c) * 2) = f2bf(f3[u] * eL);
        vKtT[u] = (short)f2bf(kt);
        vBbT[u] = (short)f2bf(f1[u] * eCL);
        vKbT[u] = (short)f2bf(f2[u] * eCL);
        vXT[u] = (short)f2bf(xv[u]);
      } else {
        *(bfr*)(p0 + (t * CS + c) * 2) = f2bf(f0[u]);
        *(bfr*)(p3 + (t * CS + c) * 2) = f2bf(f3[u]);
        vKtT[u] = (short)f2bf(f0[u] * __expf(Lm1));
        vBbT[u] = (short)f2bf(be[u] * f0[u] * __expf(LC - Lm1));
        vKbT[u] = (short)f2bf(f0[u] * __expf(LC - L));
        vXT[u] = (short)f2bf(be[u] * xv[u]);
        if (c == 0) { Lv[t] = L; Lm1v[t] = Lm1; betav[t] = be[u]; eLv[t] = __expf(L); }
      }
    }
    *(bf16x8*)(p4 + (c * CS + tg * 8) * 2) = vKtT;
    *(bf16x8*)(p5 + (c * CS + tg * 8) * 2) = vBbT;
    *(bf16x8*)(p6 + (c * CS + tg * 8) * 2) = vKbT;
    *(bf16x8*)(p7 + (c * CS + tg * 8) * 2) = vXT;
    if (tg == 0) gC[c] = __expf(LC);
    if (!GDN && tid < 64) { Lv[tid] = 0.f; Lm1v[tid] = 0.f; betav[tid] = 1.f; eLv[tid] = 1.f; }
  }
  LBAR();
  if (has_next) chunk_load<GDN>(pp, t_next, nx);
  {
    {
      MM_FRAGS(sKt, sBh, a0, a1, b00, b01, b10, b11)
      f32x4 c0 = {0.f, 0.f, 0.f, 0.f}, c1 = c0;
      MM_2TILES(c0, c1, a0, a1, b00, b01, b10, b11)
#pragma unroll
      for (int q = 0; q < 2; ++q) {
        const int sI = (nt0 + q) * 16 + fr;
        const f32x4 cv = q ? c1 : c0;
        f32x4 o;
#pragma unroll
        for (int r = 0; r < 4; ++r) {
          const int tI = mt * 16 + 4 * fq + r;
          float v = cv[r];
          if (GDN) v *= betav[sI] * __expf(fminf(Lm1v[tI] - Lm1v[sI], 0.f));
          o[r] = (sI < tI) ? v : 0.f;
        }
        *(f32x4*)(F0 + sI * F0_STRIDE + mt * 16 + 4 * fq) = o;
        wr_T(p11, mt, nt0 + q, fr, fq, o);
      }
    }
    {
      MM_FRAGS(sKt, sKh, a0, a1, b00, b01, b10, b11)
      f32x4 c0 = {0.f, 0.f, 0.f, 0.f}, c1 = c0;
      MM_2TILES(c0, c1, a0, a1, b00, b01, b10, b11)
#pragma unroll
      for (int q = 0; q < 2; ++q) {
        const int sI = (nt0 + q) * 16 + fr;
        const f32x4 cv = q ? c1 : c0;
        f32x4 o;
#pragma unroll
        for (int r = 0; r < 4; ++r) {
          const int tI = mt * 16 + 4 * fq + r;
          float v = cv[r];
          if (GDN) v *= __expf(fminf(Lm1v[tI] - Lv[sI], 0.f));
          o[r] = (sI < tI) ? v : 0.f;
        }
        wr_T(p9, mt, nt0 + q, fr, fq, o);
      }
    }
    {
      MM_FRAGS(sBh, p3, a0, a1, b00, b01, b10, b11)
      f32x4 c0 = {0.f, 0.f, 0.f, 0.f}, c1 = c0;
      MM_2TILES(c0, c1, a0, a1, b00, b01, b10, b11)
#pragma unroll
      for (int q = 0; q < 2; ++q) {
        const int tI = (nt0 + q) * 16 + fr;
        const f32x4 cv = q ? c1 : c0;
        f32x4 o;
#pragma unroll
        for (int r = 0; r < 4; ++r) {
          const int sI = mt * 16 + 4 * fq + r;
          float v = cv[r];
          if (GDN) v *= betav[sI] * __expf(fminf(Lv[tI] - Lm1v[sI], 0.f));
          o[r] = (sI <= tI) ? v : 0.f;
        }
        wr_T(p10, mt, nt0 + q, fr, fq, o);
      }
    }
  }
  LBAR();
  if (wv < 2) {
    const int base = wv * 32, other = 32 - base, c = lane & 31;
    float tr[32];
#pragma unroll
    for (int j = 0; j < 32; ++j) tr[j] = 0.f;
#pragma unroll
    for (int ip = 15; ip >= 0; --ip) {
      const int i = 2 * ip + 1, i2 = 2 * ip;
      float a0 = (c == i) ? 1.f : 0.f, a1 = 0.f, b0 = (c == i2) ? 1.f : 0.f, b1 = 0.f;
      const float aii = F0[(base + i2) * F0_STRIDE + base + i];
#pragma unroll
      for (int jb = ((i + 1) & ~3); jb < 32; jb += 4) {
        const f32x4 a4 = *(const f32x4*)(F0 + (base + i) * F0_STRIDE + base + jb);
        const f32x4 b4 = *(const f32x4*)(F0 + (base + i2) * F0_STRIDE + base + jb);
        a0 -= a4[0] * tr[jb]; a1 -= a4[1] * tr[jb + 1]; a0 -= a4[2] * tr[jb + 2]; a1 -= a4[3] * tr[jb + 3];
        b0 -= b4[0] * tr[jb]; b1 -= b4[1] * tr[jb + 1]; b0 -= b4[2] * tr[jb + 2]; b1 -= b4[3] * tr[jb + 3];
      }
      const float ti = a0 + a1;
      const float ti2 = (b0 + b1) - aii * ti;
      tr[i] = ti; tr[i2] = ti2;
      if (lane < 32) {
        *(bfr*)(p8 + ((base + i) * CS + base + c) * 2) = f2bf(ti);
        *(bfr*)(p8 + ((base + i) * CS + other + c) * 2) = (bfr)0;
        *(bfr*)(p8 + ((base + i2) * CS + base + c) * 2) = f2bf(ti2);
        *(bfr*)(p8 + ((base + i2) * CS + other + c) * 2) = (bfr)0;
      }
    }
    if (lane < 32) {
#pragma unroll
      for (int q = 0; q < 4; ++q) {
        bf16x8 o, z;
#pragma unroll
        for (int j = 0; j < 8; ++j) { o[j] = (short)f2bf(tr[8 * q + j]); z[j] = 0; }
        *(bf16x8*)(p12 + ((base + c) * CS + base + 8 * q) * 2) = o;
        *(bf16x8*)(p12 + ((base + c) * CS + other + 8 * q) * 2) = z;
      }
    }
  }
  LBAR();
  {
    MM_FRAGS(p11, p12, a0, a1, b00, b01, b10, b11)
    f32x4 c0 = {0.f, 0.f, 0.f, 0.f}, c1 = c0;
    MM_2TILES(c0, c1, a0, a1, b00, b01, b10, b11)
    wr_T(p1, mt, nt0, fr, fq, c0);
    wr_T(p1, mt, nt0 + 1, fr, fq, c1);
  }
  LBAR();
  if (mt < 2 && nt0 == 2) {
    MM_FRAGS(p8, p1, a0, a1, b00, b01, b10, b11)
    f32x4 c0 = {0.f, 0.f, 0.f, 0.f}, c1 = c0;
    MM_2TILES(c0, c1, a0, a1, b00, b01, b10, b11)
#pragma unroll
    for (int r = 0; r < 4; ++r) {
      *(bfr*)(p8 + ((mt * 16 + 4 * fq + r) * CS + (nt0) * 16 + fr) * 2) = f2bf(-c0[r]);
      *(bfr*)(p8 + ((mt * 16 + 4 * fq + r) * CS + (nt0 + 1) * 16 + fr) * 2) = f2bf(-c1[r]);
    }
  }
  LBAR();
  {
    {
      MM_FRAGS(p8, p5, a0, a1, b00, b01, b10, b11)
      f32x4 c0 = {0.f, 0.f, 0.f, 0.f}, c1 = c0;
      MM_2TILES(c0, c1, a0, a1, b00, b01, b10, b11)
      wr_T(p11, mt, nt0, fr, fq, -c0);
      wr_T(p11, mt, nt0 + 1, fr, fq, -c1);
    }
    {
      MM_FRAGS(p8, p10, a0, a1, b00, b01, b10, b11)
      f32x4 c0 = {0.f, 0.f, 0.f, 0.f}, c1 = c0;
      MM_2TILES(c0, c1, a0, a1, b00, b01, b10, b11)
      wr_T(p12, mt, nt0, fr, fq, -c0);
      wr_T(p12, mt, nt0 + 1, fr, fq, -c1);
    }
  }
  LBAR();
  {
    {
      MM_FRAGS(p4, p11, a0, a1, b00, b01, b10, b11)
      f32x4 c0 = {0.f, 0.f, 0.f, 0.f}, c1 = c0;
      MM_2TILES(c0, c1, a0, a1, b00, b01, b10, b11)
#pragma unroll
      for (int q = 0; q < 2; ++q) {
        const int cp = (nt0 + q) * 16 + fr;
        f32x4 cv = q ? c1 : c0;
#pragma unroll
        for (int r = 0; r < 4; ++r) { const int cI = mt * 16 + 4 * fq + r; if (cI == cp) cv[r] += gC[cI]; }
        wr_T(p10, mt, nt0 + q, fr, fq, cv);
      }
    }
    {
      MM_FRAGS(p9, p11, a0, a1, b00, b01, b10, b11)
      f32x4 c0 = {0.f, 0.f, 0.f, 0.f}, c1 = c0;
      MM_2TILES(c0, c1, a0, a1, b00, b01, b10, b11)
#pragma unroll
      for (int q = 0; q < 2; ++q) {
        const int cp = (nt0 + q) * 16 + fr;
        f32x4 cv = q ? c1 : c0;
        const bf16x4 kb = *(const bf16x4*)(p6 + (cp * CS + mt * 16 + 4 * fq) * 2);
#pragma unroll
        for (int r = 0; r < 4; ++r) cv[r] += __uint_as_float(((unsigned)(unsigned short)kb[r]) << 16);
        wr_T(p8, mt, nt0 + q, fr, fq, cv);
      }
    }
    {
      MM_FRAGS(p4, p12, a0, a1, b00, b01, b10, b11)
      f32x4 c0 = {0.f, 0.f, 0.f, 0.f}, c1 = c0;
      MM_2TILES(c0, c1, a0, a1, b00, b01, b10, b11)
#pragma unroll
      for (int q = 0; q < 2; ++q) {
        const int tI = (nt0 + q) * 16 + fr;
        f32x4 cv = q ? c1 : c0;
        const bf16x4 rt = *(const bf16x4*)(p3 + (tI * CS + mt * 16 + 4 * fq) * 2);
        const float el = eLv[tI];
#pragma unroll
        for (int r = 0; r < 4; ++r) cv[r] += __uint_as_float(((unsigned)(unsigned short)rt[r]) << 16) * el;
        wr_T(p1, mt, nt0 + q, fr, fq, cv);
      }
    }
    {
      f32x4 c0 = {0.f, 0.f, 0.f, 0.f}, c1 = c0;
      {
        MM_FRAGS(sKh, p3, a0, a1, b00, b01, b10, b11)
        MM_2TILES(c0, c1, a0, a1, b00, b01, b10, b11)
      }
#pragma unroll
      for (int q = 0; q < 2; ++q) {
        const int tI = (nt0 + q) * 16 + fr;
#pragma unroll
        for (int r = 0; r < 4; ++r) {
          const int sI = mt * 16 + 4 * fq + r;
          float v = q ? c1[r] : c0[r];
          if (GDN) v *= __expf(fminf(Lv[tI] - Lv[sI], 0.f));
          v = (sI <= tI) ? v : 0.f;
          if (q) c1[r] = v; else c0[r] = v;
        }
      }
      {
        MM_FRAGS(p9, p12, a0, a1, b00, b01, b10, b11)
        MM_2TILES(c0, c1, a0, a1, b00, b01, b10, b11)
      }
      wr_T(p5, mt, nt0, fr, fq, c0);
      wr_T(p5, mt, nt0 + 1, fr, fq, c1);
    }
  }
  LBAR();
  {
    {
      MM_FRAGS(p8, p7, a0, a1, b00, b01, b10, b11)
      f32x4 c0 = {0.f, 0.f, 0.f, 0.f}, c1 = c0;
      MM_2TILES(c0, c1, a0, a1, b00, b01, b10, b11)
      bfr* QT = (bfr*)(CH + cc * CH_REC + CH_QT);
      *(bf16x4*)(QT + ((mt * 4 + nt0) * 64 + lane) * 4) = pack4(c0[0], c0[1], c0[2], c0[3]);
      *(bf16x4*)(QT + ((mt * 4 + nt0 + 1) * 64 + lane) * 4) = pack4(c1[0], c1[1], c1[2], c1[3]);
    }
    {
      MM_FRAGS(p7, p5, a0, a1, b00, b01, b10, b11)
      f32x4 c0 = {0.f, 0.f, 0.f, 0.f}, c1 = c0;
      MM_2TILES(c0, c1, a0, a1, b00, b01, b10, b11)
      bfr* YX = (bfr*)(CH + cc * CH_REC + CH_YX);
      *(bf16x4*)(YX + ((mt * 4 + nt0) * 64 + lane) * 4) = pack4(c0[0], c0[1], c0[2], c0[3]);
      *(bf16x4*)(YX + ((mt * 4 + nt0 + 1) * 64 + lane) * 4) = pack4(c1[0], c1[1], c1[2], c1[3]);
    }
    {
      const int fm = wv >> 1, fa = wv & 1;
      const int row = fm * 16 + fr;
      {
        const bf16x4 lo = *(const bf16x4*)(p10 + (row * CS + 32 * fa + 4 * fq) * 2);
        const bf16x4 hi = *(const bf16x4*)(p10 + (row * CS + 32 * fa + 16 + 4 * fq) * 2);
        bf16x8 f; f[0] = lo[0]; f[1] = lo[1]; f[2] = lo[2]; f[3] = lo[3]; f[4] = hi[0]; f[5] = hi[1]; f[6] = hi[2]; f[7] = hi[3];
        *(bf16x8*)(CH + cc * CH_REC + CH_PT + (size_t)((fm * 2 + fa) * 64 + lane) * 16) = f;
      }
      {
        const bf16x4 lo = *(const bf16x4*)(p1 + (row * CS + 32 * fa + 4 * fq) * 2);
        const bf16x4 hi = *(const bf16x4*)(p1 + (row * CS + 32 * fa + 16 + 4 * fq) * 2);
        bf16x8 f; f[0] = lo[0]; f[1] = lo[1]; f[2] = lo[2]; f[3] = lo[3]; f[4] = hi[0]; f[5] = hi[1]; f[6] = hi[2]; f[7] = hi[3];
        *(bf16x8*)(CH + cc * CH_REC + CH_RYT + (size_t)((fm * 2 + fa) * 64 + lane) * 16) = f;
      }
    }
  }
  LBAR();
}

template <bool GDN>
__device__ __forceinline__ void chunk_prep_loop(PP pp, int t0, int tend, int nb, char* smem) {
  ChunkIn cur, nxt;
  if (t0 < tend) chunk_load<GDN>(pp, t0, cur);
  for (int t = t0; t < tend; t += nb) {
    const bool has_next = (t + nb) < tend;
    chunk_prep_task<GDN>(pp, t, t + nb, has_next, cur, nxt, smem);
    cur = nxt;
  }
}
__device__ __forceinline__ void phase_chunk_prep(PP pp, int bid, int nb, char* smem) {
  __syncthreads();
  const int half = (NCHAIN / 2) * NCHUNK;
  chunk_prep_loop<false>(pp, bid, half, nb, smem);
  const int k0 = (half - bid + nb - 1) / nb;
  chunk_prep_loop<true>(pp, bid + k0 * nb, NCHAIN * NCHUNK, nb, smem);
  __syncthreads();
}

#define X2_BUF 32768
#define X2_BAR() do { asm volatile("s_waitcnt lgkmcnt(0)" ::: "memory"); __builtin_amdgcn_s_barrier(); asm volatile("" ::: "memory"); } while (0)
__device__ __forceinline__ void chunk_seq_chain(PP pp, int chain, char* smem) {
  __syncthreads();
  const int tid = tid_opaque(), lane = tid & 63, wv = wave_id(tid);
  const int d = chain & 1, h = (chain >> 1) & 3, b = (chain >> 3) & 1, ty = chain >> 4;
  const char* CH = p.ws + OFF_CH;
  float* Y = (float*)(p.ws + OFF_S + (ty ? S_YGD : S_YRW)) + (size_t)d * NTOK * 256;
  const size_t c0 = (size_t)chain * NCHUNK;
  if (wv >= 4) {
    const int lw = wv - 4;
    const char* src0 = CH + c0 * CH_REC + (size_t)lane * 16;
#define X2_DMA(n) { const char* s_ = src0 + (size_t)(n) * CH_REC; LAS unsigned char* d_ = (LAS unsigned char*)smem + ((n) & 3) * X2_BUF;       \
      _Pragma("unroll") for (int i = 0; i < 8; ++i) {                                                                                       \
        const int piece = i * 4 + lw;                                                                                                       \
        __builtin_amdgcn_global_load_lds((const unsigned*)(s_ + piece * 1024), (LAS unsigned*)(d_ + piece * 1024), 16, 0, 0); } }
    X2_DMA(0) X2_DMA(1) X2_DMA(2)
    asm volatile("s_waitcnt vmcnt(16)" ::: "memory");
    X2_BAR();
    for (int n = 0; n < NCHUNK; ++n) {
      if (n + 3 < NCHUNK) { X2_DMA(n + 3) asm volatile("s_waitcnt vmcnt(16)" ::: "memory"); }
      else if (n + 2 < NCHUNK) asm volatile("s_waitcnt vmcnt(8)" ::: "memory");
      else asm volatile("s_waitcnt vmcnt(0)" ::: "memory");
      X2_BAR();
    }
#undef X2_DMA
  } else {
    const int vt = wv, fr = lane & 15, fq = lane >> 4;
    f32x4 Sacc[4];
#pragma unroll
    for (int i = 0; i < 4; ++i) Sacc[i] = (f32x4){0.f, 0.f, 0.f, 0.f};
    X2_BAR();
    for (int n = 0; n < NCHUNK; ++n) {
      const char* buf = smem + (n & 3) * X2_BUF;
      bf16x8 sB0, sB1;
#pragma unroll
      for (int j = 0; j < 4; ++j) {
        sB0[j] = (short)f2bf(Sacc[0][j]); sB0[4 + j] = (short)f2bf(Sacc[1][j]);
        sB1[j] = (short)f2bf(Sacc[2][j]); sB1[4 + j] = (short)f2bf(Sacc[3][j]);
      }
#pragma unroll
      for (int m = 0; m < 4; ++m) {
        const bf16x8 pa0 = *(const bf16x8*)(buf + ((m * 2 + 0) * 64 + lane) * 16);
        const bf16x8 pa1 = *(const bf16x8*)(buf + ((m * 2 + 1) * 64 + lane) * 16);
        const bf16x8 ra0 = *(const bf16x8*)(buf + 8192 + ((m * 2 + 0) * 64 + lane) * 16);
        const bf16x8 ra1 = *(const bf16x8*)(buf + 8192 + ((m * 2 + 1) * 64 + lane) * 16);
        const bf16x4 qb = *(const bf16x4*)(buf + 16384 + ((m * 4 + vt) * 64 + lane) * 8);
        const bf16x4 yb = *(const bf16x4*)(buf + 24576 + ((vt * 4 + m) * 64 + lane) * 8);
        f32x4 y = {bf2f(yb[0]), bf2f(yb[1]), bf2f(yb[2]), bf2f(yb[3])};
        y = __builtin_amdgcn_mfma_f32_16x16x32_bf16(sB0, ra0, y, 0, 0, 0);
        y = __builtin_amdgcn_mfma_f32_16x16x32_bf16(sB1, ra1, y, 0, 0, 0);
        f32x4 sn = {bf2f(qb[0]), bf2f(qb[1]), bf2f(qb[2]), bf2f(qb[3])};
        sn = __builtin_amdgcn_mfma_f32_16x16x32_bf16(pa0, sB0, sn, 0, 0, 0);
        sn = __builtin_amdgcn_mfma_f32_16x16x32_bf16(pa1, sB1, sn, 0, 0, 0);
        Sacc[m] = sn;
        {
          const int mm = scan_tok(b, d, n * 64 + m * 16 + fr);
          *(f32x4*)(Y + (size_t)mm * 256 + h * 64 + vt * 16 + 4 * fq) = y;
        }
      }
      X2_BAR();
    }
  }
}

struct NaPair { int mk0, mk1, tau0, tau1, kr0, kr1, ct0, ct1; };
struct NaFrag { bf16x8 k00, k01, k10, k11; bf16x4 v0[4], v1[4]; };

__device__ __forceinline__ void na_load(NaFrag& f, const bfr* KN, const bfr* VT, size_t vt_base, int h, int fr, int fq, const NaPair& pr) {
  const bfr* k0 = KN + (size_t)(pr.mk0 + fr) * 512 + h * 64 + fq * 8;
  const bfr* k1 = KN + (size_t)(pr.mk1 + fr) * 512 + h * 64 + fq * 8;
  f.k00 = *(const bf16x8*)(k0); f.k01 = *(const bf16x8*)(k0 + 32);
  f.k10 = *(const bf16x8*)(k1); f.k11 = *(const bf16x8*)(k1 + 32);
#pragma unroll
  for (int dt = 0; dt < 4; ++dt) {
    const int vo = (dt * 16 + fr) * 16 + fq * 4;
    f.v0[dt] = *(const bf16x4*)(VT + vt_base + (size_t)(pr.tau0 >> 4) * 1024 + vo);
    f.v1[dt] = *(const bf16x4*)(VT + vt_base + (size_t)(pr.tau1 >> 4) * 1024 + vo);
  }
}

__device__ __forceinline__ void na_compute(const NaFrag& f, const bf16x8 qf0, const bf16x8 qf1, bool local, bool vr0, bool vr1,
                                           int dr0, int dr1, int ct0, int ct1, int qc, int fq, const float* bias_h, f32x4 (&O)[4], float& lsum) {
  f32x4 z = {0.f, 0.f, 0.f, 0.f};
  f32x4 st0 = __builtin_amdgcn_mfma_f32_16x16x32_bf16(f.k00, qf0, z, 0, 0, 0);
  st0 = __builtin_amdgcn_mfma_f32_16x16x32_bf16(f.k01, qf1, st0, 0, 0, 0);
  f32x4 st1 = __builtin_amdgcn_mfma_f32_16x16x32_bf16(f.k10, qf0, z, 0, 0, 0);
  st1 = __builtin_amdgcn_mfma_f32_16x16x32_bf16(f.k11, qf1, st1, 0, 0, 0);
  bf16x8 pf;
  if (local) {
    const int cs = min(max(qc - 8, 0), 48);
#pragma unroll
    for (int r = 0; r < 4; ++r) {
      const int kc0 = ct0 * 16 + fq * 4 + r, kc1 = ct1 * 16 + fq * 4 + r;
      float p0 = 0.f, p1 = 0.f;
      if (vr0 && (unsigned)(kc0 - cs) < 16u) p0 = __builtin_amdgcn_exp2f(st0[r] + bias_h[dr0 * 31 + (kc0 - qc + 15)]);
      if (vr1 && (unsigned)(kc1 - cs) < 16u) p1 = __builtin_amdgcn_exp2f(st1[r] + bias_h[dr1 * 31 + (kc1 - qc + 15)]);
      lsum += p0 + p1;
      pf[r] = (short)f2bf(p0);
      pf[4 + r] = (short)f2bf(p1);
    }
  } else {
#pragma unroll
    for (int r = 0; r < 4; ++r) {
      const float p0 = __builtin_amdgcn_exp2f(st0[r]), p1 = __builtin_amdgcn_exp2f(st1[r]);
      lsum += p0 + p1;
      pf[r] = (short)f2bf(p0);
      pf[4 + r] = (short)f2bf(p1);
    }
  }
#pragma unroll
  for (int dt = 0; dt < 4; ++dt) {
    bf16x8 vf;
    vf[0] = f.v0[dt][0]; vf[1] = f.v0[dt][1]; vf[2] = f.v0[dt][2]; vf[3] = f.v0[dt][3];
    vf[4] = f.v1[dt][0]; vf[5] = f.v1[dt][1]; vf[6] = f.v1[dt][2]; vf[7] = f.v1[dt][3];
    O[dt] = __builtin_amdgcn_mfma_f32_16x16x32_bf16(vf, pf, O[dt], 0, 0, 0);
  }
}

__device__ __forceinline__ void na_block_task(PP pp, int task, const float* bias_lds) {
  const int tid = tid_opaque(), lane = tid & 63, wv = wave_id(tid);
  const int fr = lane & 15, fq = lane >> 4;
  char* S = p.ws + OFF_S;
  const bfr* QN = (const bfr*)(S + S_QN);
  const bfr* KN = (const bfr*)(S + S_KN);
  const bfr* VT = (const bfr*)(S + S_VT);
  bfr* CC = (bfr*)(p.ws + OFF_CC);
  const bool latent = task < 1024;
  int b, h, mqa, mqb, qra = 0, qrb = 0, cgp = 0;
  if (latent) {
    h = task & 7; const int quad = (task >> 3) & 63; b = task >> 9;
    qra = quad * 4 + (wv >> 2) * 2; qrb = qra + 1; cgp = wv & 3;
    mqa = b * SEQ + qra * 64 + cgp * 16; mqb = mqa + 64;
  } else {
    const int u = task - 1024;
    h = u & 7; b = u >> 3;
    mqa = NLAT + b * CTXL + (wv * 2) * 16; mqb = mqa + 16;
  }
  const bf16x8 qa0 = *(const bf16x8*)(QN + (size_t)(mqa + fr) * 512 + h * 64 + fq * 8);
  const bf16x8 qa1 = *(const bf16x8*)(QN + (size_t)(mqa + fr) * 512 + h * 64 + 32 + fq * 8);
  const bf16x8 qb0 = *(const bf16x8*)(QN + (size_t)(mqb + fr) * 512 + h * 64 + fq * 8);
  const bf16x8 qb1 = *(const bf16x8*)(QN + (size_t)(mqb + fr) * 512 + h * 64 + 32 + fq * 8);
  f32x4 Oa[4], Ob[4];
#pragma unroll
  for (int dt = 0; dt < 4; ++dt) { Oa[dt] = (f32x4){0.f, 0.f, 0.f, 0.f}; Ob[dt] = Oa[dt]; }
  float lsa = 0.f, lsb = 0.f;
  const size_t vt_base = (size_t)(b * 8 + h) * 64 * TTOK;
  const int rsa = min(max(qra - 4, 0), SEQ / 64 - 8), rsb = min(max(qrb - 4, 0), SEQ / 64 - 8);
  const int nrows = latent ? (rsb - rsa + 8) : 0;
  const int ct_first = (cgp <= 1) ? 0 : cgp - 1;
  const int nct = (cgp == 0 || cgp == 3) ? 2 : 3;
  const int ntile = nrows * nct;
  const int nlp = (ntile + 1) >> 1;
  const int npair = nlp + 8;
  const int qc = cgp * 16 + fr;
  auto mkpair = [&](int pi) {
    NaPair pr;
    if (pi < nlp) {
      const int i0 = 2 * pi, i1 = min(2 * pi + 1, ntile - 1);
      pr.kr0 = rsa + i0 / nct; pr.ct0 = ct_first + i0 % nct;
      pr.kr1 = rsa + i1 / nct; pr.ct1 = ct_first + i1 % nct;
      if (2 * pi + 1 >= ntile) pr.kr1 = -100;
      const int r1 = rsa + i1 / nct;
      pr.tau0 = pr.kr0 * 64 + pr.ct0 * 16; pr.tau1 = r1 * 64 + pr.ct1 * 16;
      pr.mk0 = b * SEQ + pr.tau0; pr.mk1 = b * SEQ + pr.tau1;
    } else {
      const int c = pi - nlp;
      pr.kr0 = pr.kr1 = pr.ct0 = pr.ct1 = 0;
      pr.tau0 = SEQ + c * 32; pr.tau1 = SEQ + c * 32 + 16;
      pr.mk0 = NLAT + b * CTXL + c * 32; pr.mk1 = pr.mk0 + 16;
    }
    return pr;
  };
  NaFrag fa, fb;
  NaPair pa = mkpair(0), pb;
  na_load(fa, KN, VT, vt_base, h, fr, fq, pa);
  const float* bias_h = bias_lds + h * 465;
#define NA_DO(F, PR, PI)                                                                                          \
  {                                                                                                               \
    const bool loc_ = (PI) < nlp;                                                                                 \
    na_compute(F, qa0, qa1, loc_, (unsigned)(PR.kr0 - rsa) < 8u, (unsigned)(PR.kr1 - rsa) < 8u,                   \
               PR.kr0 - qra + 7, PR.kr1 - qra + 7, PR.ct0, PR.ct1, qc, fq, bias_h, Oa, lsa);                      \
    na_compute(F, qb0, qb1, loc_, (unsigned)(PR.kr0 - rsb) < 8u, (unsigned)(PR.kr1 - rsb) < 8u,                   \
               PR.kr0 - qrb + 7, PR.kr1 - qrb + 7, PR.ct0, PR.ct1, qc, fq, bias_h, Ob, lsb);                      \
  }
  for (int pi = 0; pi < npair; pi += 2) {
    if (pi + 1 < npair) { pb = mkpair(pi + 1); na_load(fb, KN, VT, vt_base, h, fr, fq, pb); }
    NA_DO(fa, pa, pi)
    if (pi + 1 < npair) {
      if (pi + 2 < npair) { pa = mkpair(pi + 2); na_load(fa, KN, VT, vt_base, h, fr, fq, pa); }
      NA_DO(fb, pb, pi + 1)
    }
  }
#undef NA_DO
  lsa += shfl_xor_l(lsa, 16, lane); lsa += shfl_xor_l(lsa, 32, lane);
  lsb += shfl_xor_l(lsb, 16, lane); lsb += shfl_xor_l(lsb, 32, lane);
  const float ia = 1.f / lsa, ib = 1.f / lsb;
#pragma unroll
  for (int dt = 0; dt < 4; ++dt) {
    *(bf16x4*)(CC + (size_t)(mqa + fr) * 1024 + h * 64 + dt * 16 + fq * 4) = pack4(Oa[dt][0] * ia, Oa[dt][1] * ia, Oa[dt][2] * ia, Oa[dt][3] * ia);
    *(bf16x4*)(CC + (size_t)(mqb + fr) * 1024 + h * 64 + dt * 16 + fq * 4) = pack4(Ob[dt][0] * ib, Ob[dt][1] * ib, Ob[dt][2] * ib, Ob[dt][3] * ib);
  }
}

__device__ __forceinline__ void phase_mix(PP pp, int l, int bid, int nb, char* smem) {
  const int tid = tid_opaque();
  const int nscan_blocks = (nb > 32) ? 32 : nb;
  const int first_attn_block = (nb > 32) ? 32 : 0;
  if (bid < nscan_blocks) {
    for (int c = bid; c < NCHAIN; c += nscan_blocks) chunk_seq_chain(pp, c, smem);
  }
  if (bid >= first_attn_block) {
    float* bias = (float*)smem;
    __syncthreads();
    for (int i = tid; i < 8 * 465; i += NTHR) bias[i] = p.na_rpb[(size_t)l * 8 * 465 + i] * 1.4426950408889634f;
    __syncthreads();
    const int ntask = (l == 0) ? 1024 + 16 : 1024;
    const int nab = nb - first_attn_block;
    for (int t = bid - first_attn_block; t < ntask; t += nab) na_block_task(pp, t, bias);
    __syncthreads();
    phase_convert(pp, l, 1, bid - first_attn_block, nab, smem);
    if (l == 0) phase_convert(pp, 1, 0, bid - first_attn_block, nab, smem);
  }
}

__device__ __forceinline__ void phase_post(PP pp, int l, int bid, int nb) {
  const int tid = tid_opaque(), lane = tid & 63, wv = wave_id(tid);
  char* S = p.ws + OFF_S;
  const float* YRW = (const float*)(S + S_YRW);
  const float* YGD = (const float*)(S + S_YGD);
  const float* RWV = (const float*)(S + S_RWV);
  const float* RWG = (const float*)(S + S_RWG);
  const float* BON = (const float*)(S + S_BON);
  const float* P = (const float*)(p.ws + OFF_P);
  bfr* CC = (bfr*)(p.ws + OFF_CC);
  const float* ln_w = p.rw_ln_w + (size_t)l * 256;
  const float* ln_b = p.rw_ln_b + (size_t)l * 256;
  const float* ng = p.gd_norm_g + (size_t)l * 64;
  const int ntok = (l == 0) ? NTOK : NLAT;
  const int cb = lane * 4, hh = lane >> 4;
  const f32x4 lw4 = *(const f32x4*)(ln_w + cb), lb4 = *(const f32x4*)(ln_b + cb), ng4 = *(const f32x4*)(ng + (cb & 63));
  for (int m = bid * 8 + wv; m < ntok; m += nb * 8) {
    const size_t o = (size_t)m * 256 + cb;
    const f32x4 y0 = *(const f32x4*)(YRW + o), y1 = *(const f32x4*)(YRW + (size_t)NTOK * 256 + o);
    const f32x4 rv = *(const f32x4*)(RWV + o), rg = *(const f32x4*)(RWG + o);
    const f32x4 g0 = *(const f32x4*)(YGD + o), g1 = *(const f32x4*)(YGD + (size_t)NTOK * 256 + o);
    const f32x4 z = *(const f32x4*)(P + (size_t)m * PINP + B_END + 768 + cb);
    const float bon = BON[(size_t)m * 4 + hh];
    {
      const f32x4 y = y0 + y1;
      const float mean = row16_sum((y[0] + y[1]) + (y[2] + y[3])) * (1.f / 64.f);
      const f32x4 dv = y - mean;
      const float var = row16_sum((dv[0] * dv[0] + dv[1] * dv[1]) + (dv[2] * dv[2] + dv[3] * dv[3])) * (1.f / 64.f);
      const f32x4 out = ((dv * rsqrtf(var + 64e-5f)) * lw4 + lb4 + rv * bon) * rg;
      *(bf16x4*)(CC + (size_t)m * 1024 + 512 + cb) = pack4(out[0], out[1], out[2], out[3]);
    }
    {
      const f32x4 y = g0 + g1;
      const float ms = row16_sum((y[0] * y[0] + y[1] * y[1]) + (y[2] * y[2] + y[3] * y[3])) * (1.f / 64.f);
      const f32x4 sz = {siluf_(z[0]), siluf_(z[1]), siluf_(z[2]), siluf_(z[3])};
      const f32x4 out = (y * rsqrtf(ms + 1e-6f)) * ng4 * sz;
      *(bf16x4*)(CC + (size_t)m * 1024 + 768 + cb) = pack4(out[0], out[1], out[2], out[3]);
    }
  }
}

#define RW_LDS_ROW 36
__device__ __forceinline__ void phase_router(PP pp, int l, int bid, int nb, char* smem) {
  const int tid = tid_opaque(), lane = tid & 63, wv = wave_id(tid);
  const float* xl = p.out;
  const float* xc = (const float*)(p.ws + OFF_CTX);
  const float* mods = (const float*)(p.ws + OFF_MODS) + (size_t)l * 3 * 6144;
  const float* g = p.norm_ffn_g + (size_t)l * 1024;
  const float* rw = p.moe_router_w + (size_t)l * 1024 * 32;
  const float* rb = p.moe_router_b + (size_t)l * 32;
  bfr* H = (bfr*)(p.ws + OFF_H);
  int* cnt = (int*)(p.ws + OFF_CNT);
  int* TOKE = (int*)(p.ws + OFF_TOKE);
  int* TOKP = (int*)(p.ws + OFF_TOKP);
  float* TOKG = (float*)(p.ws + OFF_TOKG);
  float* wl = (float*)smem;
  for (int i = tid; i < 1024 * 8; i += NTHR) {
    int d = i >> 3, q = i & 7;
    *(float4*)(wl + d * RW_LDS_ROW + q * 4) = *(const float4*)(rw + (size_t)d * 32 + q * 4);
  }
  __syncthreads();
  const int ntok = (l == 0) ? NTOK : NLAT;
  const float rbl = rb[lane & 31];
  for (int m0 = (bid * 8 + wv) * 2; m0 < ntok; m0 += nb * 16) {
    float acc0[32], acc1[32];
#pragma unroll
    for (int e = 0; e < 32; ++e) { acc0[e] = 0.f; acc1[e] = 0.f; }
    float hv0[16], hv1[16];
    {
      const int ma = m0, mb = m0 + 1;
      const float* xa = (ma < NLAT) ? xl + (size_t)ma * 1024 : xc + (size_t)(ma - NLAT) * 1024;
      const float* xb = (mb < NLAT) ? xl + (size_t)mb * 1024 : xc + (size_t)(mb - NLAT) * 1024;
      const float* mda = mods + (size_t)mod_row(ma) * 6144 + 3072;
      const float* mdb = mods + (size_t)mod_row(mb) * 6144 + 3072;
      float ssa = 0.f, ssb = 0.f;
#pragma unroll
      for (int i = 0; i < 16; ++i) { hv0[i] = xa[lane + 64 * i]; hv1[i] = xb[lane + 64 * i]; }
#pragma unroll
      for (int i = 0; i < 16; ++i) { ssa += hv0[i] * hv0[i]; ssb += hv1[i] * hv1[i]; }
      ssa = wave_sum(ssa); ssb = wave_sum(ssb);
      const float rsa = rsqrtf(ssa * (1.f / 1024.f) + 1e-6f), rsb = rsqrtf(ssb * (1.f / 1024.f) + 1e-6f);
#pragma unroll
      for (int i = 0; i < 16; ++i) {
        const int d = lane + 64 * i;
        const float gg = g[d];
        hv0[i] = hv0[i] * rsa * gg * (1.f + mda[1024 + d]) + mda[d];
        hv1[i] = hv1[i] * rsb * gg * (1.f + mdb[1024 + d]) + mdb[d];
      }
      float am0 = 0.f, am1 = 0.f;
#pragma unroll
      for (int i = 0; i < 16; ++i) { am0 = fmaxf(am0, fabsf(hv0[i])); am1 = fmaxf(am1, fabsf(hv1[i])); }
      am0 = wave_max(am0); am1 = wave_max(am1);
      const float sc0 = am0 > 0.f ? am0 * (1.f / 127.f) : 1.f, sc1 = am1 > 0.f ? am1 * (1.f / 127.f) : 1.f;
      const float iv0 = 1.f / sc0, iv1 = 1.f / sc1;
      signed char* H8 = (signed char*)(p.ws + OFF_H);
#pragma unroll
      for (int i = 0; i < 16; ++i) {
        const int d = lane + 64 * i;
        H8[(size_t)ma * 1024 + d] = (signed char)(int)fminf(fmaxf(rintf(hv0[i] * iv0), -127.f), 127.f);
        H8[(size_t)mb * 1024 + d] = (signed char)(int)fminf(fmaxf(rintf(hv1[i] * iv1), -127.f), 127.f);
      }
      if (lane == 0) { float* SCL = (float*)(p.ws + OFF_SCL); SCL[ma] = sc0; SCL[mb] = sc1; }
      asm volatile("" ::: "memory");
    }
#pragma unroll
    for (int i = 0; i < 16; ++i) {
      if ((i & 3) == 0) asm volatile("" ::: "memory");
      const float* wr = wl + (lane + 64 * i) * RW_LDS_ROW;
#pragma unroll
      for (int q = 0; q < 8; ++q) {
        const float4 w = *(const float4*)(wr + q * 4);
        acc0[q * 4 + 0] += hv0[i] * w.x; acc0[q * 4 + 1] += hv0[i] * w.y; acc0[q * 4 + 2] += hv0[i] * w.z; acc0[q * 4 + 3] += hv0[i] * w.w;
        acc1[q * 4 + 0] += hv1[i] * w.x; acc1[q * 4 + 1] += hv1[i] * w.y; acc1[q * 4 + 2] += hv1[i] * w.z; acc1[q * 4 + 3] += hv1[i] * w.w;
      }
    }
#define BFLY(A, N, D)                                                                           \
    _Pragma("unroll") for (int i = 0; i < (N); ++i) {                                            \
      const bool up = (lane & (D)) != 0;                                                         \
      const float keep = up ? A[i + (N)] : A[i];                                                 \
      const float send = up ? A[i] : A[i + (N)];                                                 \
      A[i] = keep + shfl_xor_l(send, (D), lane);                                                   \
    }
    BFLY(acc0, 16, 16) BFLY(acc1, 16, 16)
    BFLY(acc0, 8, 8) BFLY(acc1, 8, 8)
    BFLY(acc0, 4, 4) BFLY(acc1, 4, 4)
    BFLY(acc0, 2, 2) BFLY(acc1, 2, 2)
    BFLY(acc0, 1, 1) BFLY(acc1, 1, 1)
#undef BFLY
    float la = acc0[0] + shfl_xor_l(acc0[0], 32, lane);
    float lb = acc1[0] + shfl_xor_l(acc1[0], 32, lane);
    const int my_e = lane & 31;
    la += rbl; lb += rbl;
    (void)my_e;
#pragma unroll
    for (int tkn = 0; tkn < 2; ++tkn) {
      float v = tkn == 0 ? la : lb;
      float tv[4]; int ti[4];
#pragma unroll
      for (int k = 0; k < 4; ++k) {
        float bv = v; int bi = lane & 31;
#pragma unroll
        for (int o = 16; o >= 1; o >>= 1) {
          float ov = shfl_xor_l(bv, o, lane); int oi = shfl_xor_li(bi, o, lane);
          bool take = (ov > bv) || (ov == bv && oi < bi);
          bv = take ? ov : bv; bi = take ? oi : bi;
        }
        tv[k] = bv; ti[k] = bi;
        if ((lane & 31) == bi) v = -3.0e38f;
      }
      float e1 = __expf(tv[1] - tv[0]), e2 = __expf(tv[2] - tv[0]), e3 = __expf(tv[3] - tv[0]);
      float inv = 1.f / (1.f + e1 + e2 + e3);
      const int m = m0 + tkn;
      if (lane < 4) {
        int e = lane == 0 ? ti[0] : lane == 1 ? ti[1] : lane == 2 ? ti[2] : ti[3];
        float gt = (lane == 0 ? 1.f : lane == 1 ? e1 : lane == 2 ? e2 : e3) * inv;
        int pos = atomicAdd(&cnt[e], 1);
        TOKE[(size_t)m * 4 + lane] = e; TOKP[(size_t)m * 4 + lane] = pos; TOKG[(size_t)m * 4 + lane] = gt;
      }
    }
  }
  __syncthreads();
}

__device__ __forceinline__ void moe_offsets(PP pp, int* toff) {
  const int* cnt = (const int*)(p.ws + OFF_CNT);
  if (tid_opaque() == 0) {
    int a = 0;
    for (int e = 0; e < 32; ++e) { toff[e] = a; a += (cnt[e] + 255) >> 8; }
    toff[32] = a;
  }
  __syncthreads();
}

__device__ __forceinline__ void phase_slotfill(PP pp, int l, int bid, int nb, char* smem) {
  int* toff = (int*)smem;
  moe_offsets(pp, toff);
  const int tid = tid_opaque(), lane = tid & 63, wv = wave_id(tid);
  const int* TOKE = (const int*)(p.ws + OFF_TOKE);
  const int* TOKP = (const int*)(p.ws + OFF_TOKP);
  const float* TOKG = (const float*)(p.ws + OFF_TOKG);
  const int* cnt = (const int*)(p.ws + OFF_CNT);
  int* TOKS = (int*)(p.ws + OFF_TOKS);
  float* SLG = (float*)(p.ws + OFF_SLG);
  float* SLS = (float*)(p.ws + OFF_SLS);
  const float* SCL = (const float*)(p.ws + OFF_SCL);
  const signed char* H8 = (const signed char*)(p.ws + OFF_H);
  signed char* XG = (signed char*)(p.ws + OFF_S);
  const int n = ((l == 0) ? NTOK : NLAT) * 4;
  for (int i0 = (bid * 8 + wv) * 4; i0 < n; i0 += nb * 32) {
    const int tok = i0 >> 2;
    int sl4[4];
#pragma unroll
    for (int k = 0; k < 4; ++k) sl4[k] = toff[TOKE[i0 + k]] * 256 + TOKP[i0 + k];
    const uint4 row = *((const uint4*)(H8 + (size_t)tok * 1024) + lane);
    const float scl = SCL[tok];
    float g4[4];
#pragma unroll
    for (int k = 0; k < 4; ++k) g4[k] = TOKG[i0 + k];
#pragma unroll
    for (int k = 0; k < 4; ++k) {
      if (lane == 0) { TOKS[i0 + k] = sl4[k]; SLG[sl4[k]] = g4[k]; SLS[sl4[k]] = scl; }
      *((uint4*)(XG + (size_t)sl4[k] * 1024) + lane) = row;
    }
  }
  for (int e = 0; e < 32; ++e) {
    const int c = cnt[e];
    const int npad = ((c + 255) & ~255) - c;
    const int base = toff[e] * 256 + c;
    for (int r = bid * 8 + wv; r < npad; r += nb * 8) {
      uint4* dst = (uint4*)(XG + (size_t)(base + r) * 1024);
      dst[lane] = make_uint4(0u, 0u, 0u, 0u);
      if (lane == 0) SLS[base + r] = 0.f;
    }
  }
  __syncthreads();
}

struct EpiMoe1 {
  const float* bgu; const float* sw; const float* SLS; bfr* ACT;
  __device__ __forceinline__ void operator()(const i32x4 (&acc)[2][2][4][2], const g8::GUnit& u, int wr, int wc, int fr, int fq) const {
    const float* be = bgu + (size_t)u.e * 2048;
    const float* se = sw + (size_t)u.e * 2048;
    const int slot0 = u.pm * 256 + wr * 64 + fr;
    float sav[2][4];
#pragma unroll
    for (int ai = 0; ai < 2; ++ai)
#pragma unroll
      for (int m = 0; m < 4; ++m) sav[ai][m] = SLS[slot0 + ai * 128 + m * 16];
    f32x4 bgv[2], blv[2], sgv[2], slv[2];
#pragma unroll
    for (int bj = 0; bj < 2; ++bj) {
      const int j0 = u.pn * 128 + bj * 64 + wc * 16 + 4 * fq;
      bgv[bj] = *(const f32x4*)(be + j0); blv[bj] = *(const f32x4*)(be + 1024 + j0);
      sgv[bj] = *(const f32x4*)(se + j0); slv[bj] = *(const f32x4*)(se + 1024 + j0);
    }
#pragma unroll
    for (int bj = 0; bj < 2; ++bj) {
      const int j0 = u.pn * 128 + bj * 64 + wc * 16 + 4 * fq;
      const f32x4 bg = bgv[bj], bl = blv[bj];
      const f32x4 sg = sgv[bj], sl = slv[bj];
#pragma unroll
      for (int ai = 0; ai < 2; ++ai)
#pragma unroll
        for (int m = 0; m < 4; ++m) {
          const int slot = slot0 + ai * 128 + m * 16;
          const float sa = sav[ai][m];
          bf16x4 o;
#pragma unroll
          for (int q = 0; q < 4; ++q) {
            const float g = (float)acc[ai][bj][m][0][q] * (sa * sg[q]) + bg[q];
            const float li = (float)acc[ai][bj][m][1][q] * (sa * sl[q]) + bl[q];
            const float gv = fminf(g, 7.f);
            const float lv = fminf(fmaxf(li, -7.f), 7.f);
            o[q] = (short)f2bf(gv * sigmoidf_(1.702f * gv) * (lv + 1.f));
          }
          *(bf16x4*)(ACT + (size_t)slot * 1024 + j0) = o;
        }
    }
  }
};
__device__ __forceinline__ void phase_moe1_impl(PP pp, int l, int bid, int nb, char* smem, int* toff) {
  moe_offsets(pp, toff);
  g8::MoeSched S{toff, 8, 2048, nb, bid};
  EpiMoe1 E{p.moe_b_gu + (size_t)l * 32 * 2048, (const float*)(p.ws + OFF_SW) + (size_t)l * 32 * 2048, (const float*)(p.ws + OFF_SLS), (bfr*)(p.ws + OFF_P)};
  g8::gemm_stream<true>((LAS unsigned char*)smem, p.ws + OFF_S, p.ws + OFF_W + (size_t)l * WL_SIZE + WL_GU, S, E);
}

struct EpiMoe2 {
  const float* bdn; const float* SLG; bfr* YS;
  __device__ __forceinline__ void operator()(const f32x4 (&acc)[2][2][4][2], const g8::GUnit& u, int wr, int wc, int fr, int fq) const {
    const float* be = bdn + (size_t)u.e * 1024;
    const int slot0 = u.pm * 256 + wr * 64 + fr, col0 = u.pn * 256 + wc * 32 + 4 * fq;
    float gtv[2][4];
#pragma unroll
    for (int ai = 0; ai < 2; ++ai)
#pragma unroll
      for (int m = 0; m < 4; ++m) gtv[ai][m] = SLG[slot0 + ai * 128 + m * 16];
    f32x4 bvv[2][2];
#pragma unroll
    for (int bj = 0; bj < 2; ++bj)
#pragma unroll
      for (int n = 0; n < 2; ++n) bvv[bj][n] = *(const f32x4*)(be + col0 + bj * 128 + n * 16);
#pragma unroll
    for (int ai = 0; ai < 2; ++ai)
#pragma unroll
      for (int m = 0; m < 4; ++m) {
        const int slot = slot0 + ai * 128 + m * 16;
        const float gt = gtv[ai][m];
#pragma unroll
        for (int bj = 0; bj < 2; ++bj)
#pragma unroll
          for (int n = 0; n < 2; ++n) {
            const f32x4 bv = bvv[bj][n];
            const f32x4 yv = (acc[ai][bj][m][n] + bv) * gt;
            *(bf16x4*)(YS + (size_t)slot * 1024 + col0 + bj * 128 + n * 16) = pack4(yv[0], yv[1], yv[2], yv[3]);
          }
      }
  }
};
__device__ __forceinline__ void phase_moe2_impl(PP pp, int l, int bid, int nb, char* smem, int* toff) {
  moe_offsets(pp, toff);
  g8::MoeSched S{toff, 4, 1024, nb, bid};
  EpiMoe2 E{p.moe_b_down + (size_t)l * 32 * 1024, (const float*)(p.ws + OFF_SLG), (bfr*)(p.ws + OFF_S)};
  g8::gemm_stream<false>((LAS unsigned char*)smem, p.ws + OFF_P, p.ws + OFF_W + (size_t)l * WL_SIZE + WL_DN, S, E);
}

__device__ __forceinline__ void phase_combine(PP pp, int l, int bid, int nb) {
  const int tid = tid_opaque(), lane = tid & 63, wv = wave_id(tid);
  const bfr* YS = (const bfr*)(p.ws + OFF_S);
  const int* TOKS = (const int*)(p.ws + OFF_TOKS);
  const float* mods = (const float*)(p.ws + OFF_MODS) + (size_t)l * 3 * 6144;
  const float* mods1 = (const float*)(p.ws + OFF_MODS) + (size_t)3 * 6144;
  const float* g1n = p.norm_mix_g + 1024;
  bfr* H = (bfr*)(p.ws + OFF_H);
  float* xl = p.out;
  float* xc = (float*)(p.ws + OFF_CTX);
  const int ntok = (l == 0) ? NTOK : NLAT;
  if (l == 0) {
    int* cnt = (int*)(p.ws + OFF_CNT);
    const int gt = bid * NTHR + tid;
    if (gt < 32) cnt[gt] = 0;
  }
  for (int m = bid * 8 + wv; m < ntok; m += nb * 8) {
    float* xr = (m < NLAT) ? xl + (size_t)m * 1024 : xc + (size_t)(m - NLAT) * 1024;
    const float* g2 = mods + (size_t)mod_row(m) * 6144 + 5120;
    const int s0 = TOKS[(size_t)m * 4], s1 = TOKS[(size_t)m * 4 + 1], s2 = TOKS[(size_t)m * 4 + 2], s3 = TOKS[(size_t)m * 4 + 3];
    float4 xn[4];
    float ss = 0.f;
#pragma unroll
    for (int i = 0; i < 4; ++i) {
      const int d = (lane + 64 * i) * 4;
      const bf16x4 a = *(const bf16x4*)(YS + (size_t)s0 * 1024 + d);
      const bf16x4 b = *(const bf16x4*)(YS + (size_t)s1 * 1024 + d);
      const bf16x4 c = *(const bf16x4*)(YS + (size_t)s2 * 1024 + d);
      const bf16x4 e = *(const bf16x4*)(YS + (size_t)s3 * 1024 + d);
      const float4 gg = *(const float4*)(g2 + d);
      float4 xv = *(const float4*)(xr + d);
      xv.x += gg.x * ((bf2f(a[0]) + bf2f(b[0])) + (bf2f(c[0]) + bf2f(e[0])));
      xv.y += gg.y * ((bf2f(a[1]) + bf2f(b[1])) + (bf2f(c[1]) + bf2f(e[1])));
      xv.z += gg.z * ((bf2f(a[2]) + bf2f(b[2])) + (bf2f(c[2]) + bf2f(e[2])));
      xv.w += gg.w * ((bf2f(a[3]) + bf2f(b[3])) + (bf2f(c[3]) + bf2f(e[3])));
      *(float4*)(xr + d) = xv;
      xn[i] = xv;
      ss += xv.x * xv.x + xv.y * xv.y + xv.z * xv.z + xv.w * xv.w;
    }
    if (l == 0) {
      ss = wave_sum(ss);
      const float rs = rsqrtf(ss * (1.f / 1024.f) + 1e-6f);
      const float* md = mods1 + (size_t)mod_row(m) * 6144;
      float4 hq[4];
#pragma unroll
      for (int i = 0; i < 4; ++i) {
        const int d = (lane + 64 * i) * 4;
        const float4 gg = *(const float4*)(g1n + d);
        const float4 sh = *(const float4*)(md + d);
        const float4 sc = *(const float4*)(md + 1024 + d);
        hq[i] = make_float4(xn[i].x * rs * gg.x * (1.f + sc.x) + sh.x, xn[i].y * rs * gg.y * (1.f + sc.y) + sh.y,
                            xn[i].z * rs * gg.z * (1.f + sc.z) + sh.z, xn[i].w * rs * gg.w * (1.f + sc.w) + sh.w);
      }
      const float qs = quant_row_store(hq, (signed char*)(p.ws + OFF_H) + (size_t)m * 1024, lane);
      if (lane == 0) ((float*)(p.ws + OFF_SCL))[m] = qs;
    }
  }
}

#define XB_TMO      128
#define XB_XCNT(j)  (256  + 64 * (j))
#define XB_XSUB(j)  (1280 + 64 * (j))
#define XB_XGEN(j)  (2304 + 64 * (j))
#define XB_TOP      3328
#define XB_TOPGEN   3392
#define XCD_BAR_WORDS 3456
#define XB_SPIN_CAP (1u << 22)
__device__ __forceinline__ unsigned xb_ld(unsigned* q) { return __hip_atomic_load(q, __ATOMIC_RELAXED, __HIP_MEMORY_SCOPE_AGENT); }
__device__ __forceinline__ unsigned xb_add(unsigned* q, unsigned v) { return __hip_atomic_fetch_add(q, v, __ATOMIC_RELAXED, __HIP_MEMORY_SCOPE_AGENT); }
__device__ __forceinline__ unsigned xb_xcc_id() { return (unsigned)__builtin_amdgcn_s_getreg((3 << 11) | 20) & 0xFu; }
#define XB_SPIN(cond, bar) do { unsigned _sp = 0; while (cond) { __builtin_amdgcn_s_sleep(1); \
    if ((++_sp & 255u) == 0u) { if (xb_ld(&(bar)[XB_TMO])) break; if (_sp > XB_SPIN_CAP) { atomicAdd(&(bar)[XB_TMO], 1u); break; } } } } while (0)
struct XcdBarrier { unsigned* bar; unsigned x; volatile LAS unsigned* st; };
__device__ __forceinline__ XcdBarrier xcd_barrier_post(unsigned* bar, volatile LAS unsigned* st) {
  XcdBarrier b; b.bar = bar; b.x = xb_xcc_id(); b.st = st;
  if (tid_opaque() == 0) (void)xb_add(&bar[XB_XCNT(b.x)], 1u);
  return b;
}
__device__ __forceinline__ void xcd_barrier_complete(unsigned* bar, unsigned x, unsigned& nloc, unsigned& nx) {
  const unsigned G = gridDim.x;
  unsigned sum, cnt, mine, sp = 0u;
  for (;;) {
    sum = 0u; cnt = 0u; mine = 0u;
#pragma unroll
    for (unsigned j = 0; j < 16; ++j) { const unsigned c = xb_ld(&bar[XB_XCNT(j)]); sum += c; cnt += (c > 0u) ? 1u : 0u; mine = (j == x) ? c : mine; }
    if (sum == G) break;
    __builtin_amdgcn_s_sleep(1);
    if ((++sp & 255u) == 0u) { if (xb_ld(&bar[XB_TMO])) break; if (sp > XB_SPIN_CAP) { atomicAdd(&bar[XB_TMO], 1u); break; } }
  }
  nloc = mine > 0u ? mine : 1u; nx = cnt > 0u ? cnt : 1u;
}
__device__ __forceinline__ void xcd_barrier(const XcdBarrier& b) {
  asm volatile("s_waitcnt vmcnt(0)" ::: "memory");
  __syncthreads();
  if (tid_opaque() == 0) {
    unsigned* bar = b.bar;
    __builtin_amdgcn_s_waitcnt(0);
    unsigned nloc = b.st[0], nx = b.st[1];
    if (nloc == 0u) { xcd_barrier_complete(bar, b.x, nloc, nx); b.st[0] = nloc; b.st[1] = nx; }
    const unsigned old = xb_add(&bar[XB_XSUB(b.x)], 1u);
    const unsigned gen = old / nloc;
    if (old + 1u == (gen + 1u) * nloc) {
      __builtin_amdgcn_fence(__ATOMIC_RELEASE, "agent");
      asm volatile("s_waitcnt vmcnt(0)" ::: "memory");
      const unsigned og = xb_add(&bar[XB_TOP], 1u);
      const unsigned tg = og / nx;
      if (og + 1u == (tg + 1u) * nx) xb_add(&bar[XB_TOPGEN], 1u);
      else XB_SPIN(xb_ld(&bar[XB_TOPGEN]) == tg, bar);
      __builtin_amdgcn_fence(__ATOMIC_ACQUIRE, "agent");
      xb_add(&bar[XB_XGEN(b.x)], 1u);
      asm volatile("s_waitcnt vmcnt(0)" ::: "memory");
    } else {
      XB_SPIN(xb_ld(&bar[XB_XGEN(b.x)]) == gen, bar);
      __builtin_amdgcn_fence(__ATOMIC_ACQUIRE, "agent");
      asm volatile("s_waitcnt vmcnt(0)" ::: "memory");
    }
  }
  __syncthreads();
}

extern __shared__ __attribute__((aligned(16))) char dyn_smem[];

__global__ void __launch_bounds__(NTHR) mega(Params p_unused) {
  cg::grid_group grid = cg::this_grid();
  const int bid0 = blockIdx.x, nb0 = gridDim.x;
#if defined(__HIP_DEVICE_COMPILE__)
  PP pp0 = (PP)__builtin_amdgcn_kernarg_segment_ptr();
#else
  PP pp0 = nullptr;
#endif
#define pp ({ PP q_ = pp0; asm volatile("" : "+s"(q_)); q_; })
#define bid opq(bid0)
#define nb opq(nb0)
  int* toff_s = (int*)(dyn_smem + 147456);
  volatile LAS unsigned* xb_st = (volatile LAS unsigned*)(dyn_smem + 147456 + 256);
  {
    unsigned* barw = (unsigned*)(fresh_ws(pp0) + OFF_BAR);
    if (blockIdx.x == 0) for (int i = threadIdx.x; i < XCD_BAR_WORDS; i += NTHR) barw[i] = 0u;
    if (threadIdx.x == 0) { xb_st[0] = 0u; xb_st[1] = 0u; }
  }
  grid.sync();
  const XcdBarrier xb = xcd_barrier_post((unsigned*)(fresh_ws(pp0) + OFF_BAR), xb_st);
#define GSYNC() xcd_barrier(xb)
  phase_ada(pp, bid, nb, dyn_smem);
  phase_convert(pp, 0, 0, bid, nb, dyn_smem);
  GSYNC();
#define LAYER(LV, LAST)                                      \
  {                                                          \
    if ((LV) == 0) { phase_prenorm(pp, opq(LV), bid, nb); GSYNC(); } \
    phase_gemm_in(pp, opq(LV), bid, nb, dyn_smem);           \
    GSYNC();                                                 \
    phase_prep(pp, opq(LV), bid, nb, dyn_smem);              \
    GSYNC();                                                 \
    phase_chunk_prep(pp, bid, nb, dyn_smem);                 \
    GSYNC();                                                 \
    phase_mix(pp, opq(LV), bid, nb, dyn_smem);               \
    GSYNC();                                                 \
    phase_post(pp, opq(LV), bid, nb);                        \
    GSYNC();                                                 \
    phase_gemm_out(pp, opq(LV), bid, nb, dyn_smem);          \
    GSYNC();                                                 \
    phase_router(pp, opq(LV), bid, nb, dyn_smem);            \
    GSYNC();                                                 \
    phase_slotfill(pp, opq(LV), bid, nb, dyn_smem);          \
    GSYNC();                                                 \
    phase_moe1_impl(pp, opq(LV), bid, nb, dyn_smem, toff_s); \
    GSYNC();                                                 \
    phase_moe2_impl(pp, opq(LV), bid, nb, dyn_smem, toff_s); \
    GSYNC();                                                 \
    phase_combine(pp, opq(LV), bid, nb);                     \
    if (!(LAST)) GSYNC();                                    \
  }
  LAYER(0, false)
  LAYER(1, true)
#undef LAYER
#undef GSYNC
#undef bid
#undef nb
#undef pp
}

#undef p
extern "C" void kernel_launch(void* const* d_in, const int* in_sizes, int n_in, void* d_out, int out_size, void* d_ws,
                              size_t ws_size, hipStream_t stream) {
  Params hp{};
  const float** pp = (const float**)&hp;
  for (int i = 0; i < 34; ++i) pp[i] = (const float*)d_in[i];
  hp.out = (float*)d_out;
  hp.ws = (char*)d_ws;
  static int grid_blocks = 0;
  if (!grid_blocks) {
    (void)hipFuncSetAttribute((const void*)mega, hipFuncAttributeMaxDynamicSharedMemorySize, LDS_BYTES);
    int dev = 0, cus = 0, per_cu = 0;
    (void)hipGetDevice(&dev);
    (void)hipDeviceGetAttribute(&cus, hipDeviceAttributeMultiprocessorCount, dev);
    (void)hipOccupancyMaxActiveBlocksPerMultiprocessor(&per_cu, mega, NTHR, LDS_BYTES);
    if (per_cu < 1) per_cu = 1;
    if (per_cu > 1) per_cu = 1;
    grid_blocks = cus * per_cu;
  }
  void* args[] = {&hp};
  (void)hipLaunchCooperativeKernel((void*)mega, dim3(grid_blocks), dim3(NTHR), args, LDS_BYTES, stream);
}
```

```cpp
#include <hip/hip_runtime.h>
#include <hip/hip_bf16.h>
#include <hip/hip_cooperative_groups.h>
#include <stdint.h>
#include <type_traits>
namespace cg = cooperative_groups;

typedef __attribute__((ext_vector_type(8))) short bf16x8;
typedef __attribute__((ext_vector_type(4))) short bf16x4;
typedef __attribute__((ext_vector_type(4))) float f32x4;
typedef __attribute__((ext_vector_type(4))) int i32x4;
typedef unsigned short bfr;

#define D_MODEL 1024
#define NB 2
#define SEQ 16384
#define CTXL 256
#define NLAT (NB * SEQ)
#define NCTX (NB * CTXL)
#define NTOK (NLAT + NCTX)
#define TTOK (SEQ + CTXL)
#define PIN 3472
#define PINP 3584
#define A_END 1536
#define B_END 2432
#define NEXP 32
#define NSLOT_MAX (NTOK * 4 + NEXP * 256)
#define NTHR 512
#define LDS_BYTES (147456 + 3072)

constexpr size_t al256(size_t x) { return (x + 255) & ~(size_t)255; }
constexpr size_t WL_IN = 0;
constexpr size_t WL_OUT = WL_IN + (size_t)PINP * 1024 * 2;
constexpr size_t WL_GU = WL_OUT + (size_t)1024 * 1024 * 2;
constexpr size_t WL_DN = WL_GU + (size_t)32 * 2048 * 1024 * 2;
constexpr size_t WL_SIZE = WL_DN + (size_t)32 * 1024 * 1024 * 2;
constexpr size_t OFF_W = 0;
constexpr size_t OFF_MODS = al256(OFF_W + 2 * WL_SIZE);
constexpr size_t OFF_BAR = al256(OFF_MODS + 2 * 3 * 6144 * 4);
constexpr size_t OFF_SW = al256(OFF_BAR + 3456 * 4);
constexpr size_t OFF_SWIN = al256(OFF_SW + (size_t)2 * 32 * 2048 * 4);
constexpr size_t OFF_SLS = al256(OFF_SWIN + (size_t)2 * PINP * 4);
constexpr size_t OFF_SCL = al256(OFF_SLS + (size_t)(NTOK * 4 + 32 * 256) * 4);
constexpr size_t OFF_CTX = al256(OFF_SCL + (size_t)NTOK * 4);
constexpr size_t OFF_CNT = al256(OFF_CTX + (size_t)NCTX * 1024 * 4);
constexpr size_t OFF_TOKE = al256(OFF_CNT + 256);
constexpr size_t OFF_TOKP = al256(OFF_TOKE + (size_t)NTOK * 4 * 4);
constexpr size_t OFF_TOKG = al256(OFF_TOKP + (size_t)NTOK * 4 * 4);
constexpr size_t OFF_TOKS = al256(OFF_TOKG + (size_t)NTOK * 4 * 4);
constexpr size_t OFF_SLT = al256(OFF_TOKS + (size_t)NTOK * 4 * 4);
constexpr size_t OFF_SLG = al256(OFF_SLT + (size_t)NSLOT_MAX * 4);
constexpr size_t OFF_H = al256(OFF_SLG + (size_t)NSLOT_MAX * 4);
constexpr size_t OFF_CC = al256(OFF_H + (size_t)NTOK * 1024 * 2);
constexpr size_t OFF_P = al256(OFF_CC + (size_t)NTOK * 1024 * 2);
constexpr size_t OFF_S = al256(OFF_P + (size_t)NTOK * PINP * 4);
constexpr size_t TOK256F = (size_t)NTOK * 256 * 4;
constexpr size_t S_QN = 0;
constexpr size_t S_KN = S_QN + (size_t)NTOK * 512 * 2;
constexpr size_t S_VT = S_KN + (size_t)NTOK * 512 * 2;
constexpr size_t S_RWR = S_VT + (size_t)NB * 8 * 64 * TTOK * 2;
constexpr size_t S_RWKK = S_RWR + TOK256F;
constexpr size_t S_RWV = S_RWKK + TOK256F;
constexpr size_t S_RWG = S_RWV + TOK256F;
constexpr size_t S_RWW = S_RWG + TOK256F;
constexpr size_t S_RWKD = S_RWW + 2 * TOK256F;
constexpr size_t S_RWB = S_RWKD + 2 * TOK256F;
constexpr size_t S_BON = S_RWB + 2 * TOK256F;
constexpr size_t S_GDQ = al256(S_BON + (size_t)NTOK * 4 * 4);
constexpr size_t S_GDK = S_GDQ + TOK256F;
constexpr size_t S_GDV = S_GDK + TOK256F;
constexpr size_t S_GDAB = S_GDV + TOK256F;
constexpr size_t S_YRW = al256(S_GDAB + (size_t)NTOK * 16 * 4);
constexpr size_t S_YGD = S_YRW + 2 * TOK256F;
constexpr size_t S_END = S_YGD + 2 * TOK256F;
constexpr size_t S_SIZE = (S_END > (size_t)NSLOT_MAX * 1024 * 4) ? S_END : (size_t)NSLOT_MAX * 1024 * 4;
constexpr int NCHUNK = TTOK / 64;
constexpr int NCHAIN = 32;
constexpr size_t OFF_CH = al256(OFF_S + S_SIZE);
constexpr size_t CH_N = (size_t)NCHAIN * NCHUNK;
constexpr size_t CH_REC = 32768, CH_PT = 0, CH_RYT = 8192, CH_QT = 16384, CH_YX = 24576;
constexpr size_t CH_SIZE = CH_N * CH_REC;
constexpr size_t WS_TOTAL = OFF_CH + CH_SIZE;
static_assert(WS_TOTAL <= (size_t)2048 * 1024 * 1024, "workspace exceeds 4x largest tensor");

struct Params {
  const float *x, *c, *ctx, *c_ctx, *ada_w, *ada_b, *norm_mix_g, *norm_ffn_g, *w_in, *w_out;
  const float *na_q_gain, *na_k_gain, *na_rpb;
  const float *rw_mu, *rw_w0, *rw_w_up, *rw_a0, *rw_a_up, *rw_g_up, *rw_k_k, *rw_k_a, *rw_r_k, *rw_ln_w, *rw_ln_b;
  const float *gd_conv_w, *gd_A_log, *gd_dt_bias, *gd_norm_g;
  const float *moe_router_w, *moe_router_b, *moe_w_gu, *moe_b_gu, *moe_w_down, *moe_b_down;
  float* out;
  char* ws;
};

typedef const __attribute__((address_space(4))) Params* PP;
#define p (*pp)
__device__ __forceinline__ char* fresh_ws(PP pp) { return p.ws; }
__device__ __forceinline__ int tid_opaque() { int t = (int)__builtin_amdgcn_workitem_id_x(); asm volatile("" : "+v"(t)); return t; }
__device__ __forceinline__ int opq(int x) { asm volatile("" : "+s"(x)); return x; }
__device__ __forceinline__ int wave_id(int tid) { return __builtin_amdgcn_readfirstlane(tid >> 6); }
typedef __bf16 bf16v2_t __attribute__((ext_vector_type(2)));
typedef float f32v2_t __attribute__((ext_vector_type(2)));
__device__ __forceinline__ unsigned pk_bf16(float lo, float hi) { f32v2_t v = {lo, hi}; return __builtin_bit_cast(unsigned, __builtin_convertvector(v, bf16v2_t)); }
__device__ __forceinline__ bfr f2bf(float f) { return (bfr)(pk_bf16(f, f) & 0xffffu); }
__device__ __forceinline__ float bf2f(short v) { return __uint_as_float(((unsigned)(unsigned short)v) << 16); }
__device__ __forceinline__ bf16x4 pack4(float a, float b, float c, float d) {
  typedef __attribute__((ext_vector_type(2))) unsigned u32x2;
  u32x2 w; w[0] = pk_bf16(a, b); w[1] = pk_bf16(c, d);
  return __builtin_bit_cast(bf16x4, w);
}
__device__ __forceinline__ float sigmoidf_(float x) { return __builtin_amdgcn_rcpf(1.f + __expf(-x)); }
__device__ __forceinline__ float siluf_(float x) { return x * __builtin_amdgcn_rcpf(1.f + __expf(-x)); }
__device__ __forceinline__ float softplusf_(float x) { const float e = __expf(fminf(x, 20.f)); const float lg = __logf(1.f + e); const float r = x < -15.f ? e : lg; return x > 20.f ? x : r; }
__device__ __forceinline__ float wave_sum(float v) {
  v += __builtin_bit_cast(float, __builtin_amdgcn_update_dpp(0, __builtin_bit_cast(int, v), 0xB1, 0xF, 0xF, true));
  v += __builtin_bit_cast(float, __builtin_amdgcn_update_dpp(0, __builtin_bit_cast(int, v), 0x4E, 0xF, 0xF, true));
  v += __builtin_bit_cast(float, __builtin_amdgcn_update_dpp(0, __builtin_bit_cast(int, v), 0x141, 0xF, 0xF, true));
  v += __builtin_bit_cast(float, __builtin_amdgcn_update_dpp(0, __builtin_bit_cast(int, v), 0x140, 0xF, 0xF, true));
  v += __builtin_bit_cast(float, __builtin_amdgcn_update_dpp(0, __builtin_bit_cast(int, v), 0x142, 0xA, 0xF, false));
  v += __builtin_bit_cast(float, __builtin_amdgcn_update_dpp(0, __builtin_bit_cast(int, v), 0x143, 0xC, 0xF, false));
  return __builtin_bit_cast(float, __builtin_amdgcn_readlane(__builtin_bit_cast(int, v), 63));
}
__device__ __forceinline__ float wave_max(float v) {
  v = fmaxf(v, __builtin_bit_cast(float, __builtin_amdgcn_update_dpp(0, __builtin_bit_cast(int, v), 0xB1, 0xF, 0xF, true)));
  v = fmaxf(v, __builtin_bit_cast(float, __builtin_amdgcn_update_dpp(0, __builtin_bit_cast(int, v), 0x4E, 0xF, 0xF, true)));
  v = fmaxf(v, __builtin_bit_cast(float, __builtin_amdgcn_update_dpp(0, __builtin_bit_cast(int, v), 0x141, 0xF, 0xF, true)));
  v = fmaxf(v, __builtin_bit_cast(float, __builtin_amdgcn_update_dpp(0, __builtin_bit_cast(int, v), 0x140, 0xF, 0xF, true)));
  const float r1 = __builtin_bit_cast(float, __builtin_amdgcn_readlane(__builtin_bit_cast(int, v), 0));
  const float r2 = __builtin_bit_cast(float, __builtin_amdgcn_readlane(__builtin_bit_cast(int, v), 16));
  const float r3 = __builtin_bit_cast(float, __builtin_amdgcn_readlane(__builtin_bit_cast(int, v), 32));
  const float r4 = __builtin_bit_cast(float, __builtin_amdgcn_readlane(__builtin_bit_cast(int, v), 48));
  return fmaxf(fmaxf(r1, r2), fmaxf(r3, r4));
}
__device__ __forceinline__ float shfl_xor_l(float v, int mask, int lane) {
  return __builtin_bit_cast(float, __builtin_amdgcn_ds_bpermute((lane ^ mask) << 2, __builtin_bit_cast(int, v)));
}
__device__ __forceinline__ int shfl_xor_li(int v, int mask, int lane) {
  return __builtin_amdgcn_ds_bpermute((lane ^ mask) << 2, v);
}
__device__ __forceinline__ float row16_sum(float v) {
  v += __builtin_bit_cast(float, __builtin_amdgcn_update_dpp(0, __builtin_bit_cast(int, v), 0xB1, 0xF, 0xF, true));
  v += __builtin_bit_cast(float, __builtin_amdgcn_update_dpp(0, __builtin_bit_cast(int, v), 0x4E, 0xF, 0xF, true));
  v += __builtin_bit_cast(float, __builtin_amdgcn_update_dpp(0, __builtin_bit_cast(int, v), 0x141, 0xF, 0xF, true));
  v += __builtin_bit_cast(float, __builtin_amdgcn_update_dpp(0, __builtin_bit_cast(int, v), 0x140, 0xF, 0xF, true));
  return v;
}
__device__ __forceinline__ float quant_row_store(const float4 (&v)[4], signed char* dst_row, int lane) {
  float am = 0.f;
#pragma unroll
  for (int i = 0; i < 4; ++i) am = fmaxf(fmaxf(am, fmaxf(fabsf(v[i].x), fabsf(v[i].y))), fmaxf(fabsf(v[i].z), fabsf(v[i].w)));
  am = wave_max(am);
  const float sc = am > 0.f ? am * (1.f / 127.f) : 1.f, iv = 1.f / sc;
#pragma unroll
  for (int i = 0; i < 4; ++i) {
    const int q0 = (int)fminf(fmaxf(rintf(v[i].x * iv), -127.f), 127.f), q1 = (int)fminf(fmaxf(rintf(v[i].y * iv), -127.f), 127.f);
    const int q2 = (int)fminf(fmaxf(rintf(v[i].z * iv), -127.f), 127.f), q3 = (int)fminf(fmaxf(rintf(v[i].w * iv), -127.f), 127.f);
    *(unsigned*)(dst_row + (lane + 64 * i) * 4) = (unsigned)(q0 & 0xff) | ((unsigned)(q1 & 0xff) << 8) | ((unsigned)(q2 & 0xff) << 16) | ((unsigned)(q3 & 0xff) << 24);
  }
  return sc;
}
__device__ __forceinline__ int mod_row(int m) { return m < NLAT ? (m >> 14) : 2; }

__device__ __forceinline__ void phase_ada(PP pp, int bid, int nb, char* smem) {
  float* red = (float*)smem;
  float* mods = (float*)(p.ws + OFF_MODS);
  const int tid = tid_opaque();
  for (int task = bid; task < 2 * 96; task += nb) {
    int l = task / 96, cgp = task % 96;
    int col = cgp * 64 + (tid & 63), ks = tid >> 6;
    const float* W = p.ada_w + (size_t)l * 1024 * 6144;
    float a0 = 0.f, a1 = 0.f, a2 = 0.f;
    for (int d = ks * 128; d < ks * 128 + 128; ++d) {
      float w = W[(size_t)d * 6144 + col];
      a0 += siluf_(p.c[d]) * w;
      a1 += siluf_(p.c[1024 + d]) * w;
      a2 += siluf_(p.c_ctx[d]) * w;
    }
    red[(ks * 3 + 0) * 64 + (tid & 63)] = a0;
    red[(ks * 3 + 1) * 64 + (tid & 63)] = a1;
    red[(ks * 3 + 2) * 64 + (tid & 63)] = a2;
    __syncthreads();
    if (tid < 192) {
      int r = tid >> 6, cc = tid & 63;
      float s = 0.f;
      for (int k = 0; k < 8; ++k) s += red[(k * 3 + r) * 64 + cc];
      mods[(size_t)(l * 3 + r) * 6144 + cgp * 64 + cc] = s + p.ada_b[(size_t)l * 6144 + cgp * 64 + cc];
    }
    __syncthreads();
  }
}

__device__ __forceinline__ void convert_tile(const float* src, int N, bfr* dst, int kt4  , int nt, float* tile  ) {
  const int tid = tid_opaque();
  float4 v[8];
#pragma unroll
  for (int q = 0; q < 8; ++q) {
    const int idx = tid + q * 512;
    const int kk = idx >> 4, n4 = idx & 15;
    v[q] = *(const float4*)(src + (size_t)(kt4 * 256 + kk) * N + nt * 64 + n4 * 4);
  }
#pragma unroll
  for (int q = 0; q < 8; ++q) {
    const int idx = tid + q * 512;
    const int kk = idx >> 4, n4 = idx & 15;
    tile[kk * 65 + n4 * 4 + 0] = v[q].x; tile[kk * 65 + n4 * 4 + 1] = v[q].y;
    tile[kk * 65 + n4 * 4 + 2] = v[q].z; tile[kk * 65 + n4 * 4 + 3] = v[q].w;
  }
  __syncthreads();
  {
    const int nn = tid >> 3, kc = tid & 7;
    const int n = nt * 64 + nn;
#pragma unroll
    for (int q = 0; q < 4; ++q) {
      const int k0 = (kc + 8 * q) * 8;
      *(bf16x4*)(dst + (size_t)n * 1024 + kt4 * 256 + k0) = pack4(tile[(k0 + 0) * 65 + nn], tile[(k0 + 1) * 65 + nn], tile[(k0 + 2) * 65 + nn], tile[(k0 + 3) * 65 + nn]);
      *(bf16x4*)(dst + (size_t)n * 1024 + kt4 * 256 + k0 + 4) = pack4(tile[(k0 + 4) * 65 + nn], tile[(k0 + 5) * 65 + nn], tile[(k0 + 6) * 65 + nn], tile[(k0 + 7) * 65 + nn]);
    }
  }
  __syncthreads();
}
template <int N, bool INTERLEAVE>
__device__ __forceinline__ void convert_i8(const float* src  , signed char* dst  , float* sw, int ng, char* smem) {
  const int tid = tid_opaque();
  bfr* blk = (bfr*)smem;
  int* cmax = (int*)(smem + 131072);
  if (tid < 64) cmax[tid] = 0;
  __syncthreads();
  {
    const int n4 = tid & 15, kk0 = tid >> 4;
    float m0 = 0.f, m1 = 0.f, m2 = 0.f, m3 = 0.f;
#pragma unroll 8
    for (int ps = 0; ps < 32; ++ps) {
      const int k = ps * 32 + kk0;
      float4 v = make_float4(0.f, 0.f, 0.f, 0.f);
      if (ng * 64 + n4 * 4 < N) v = *(const float4*)(src + (size_t)k * N + ng * 64 + n4 * 4);
      m0 = fmaxf(m0, fabsf(v.x)); m1 = fmaxf(m1, fabsf(v.y)); m2 = fmaxf(m2, fabsf(v.z)); m3 = fmaxf(m3, fabsf(v.w));
      *(bf16x4*)(blk + k * 64 + n4 * 4) = pack4(v.x, v.y, v.z, v.w);
    }
    atomicMax(&cmax[n4 * 4 + 0], __float_as_int(m0)); atomicMax(&cmax[n4 * 4 + 1], __float_as_int(m1));
    atomicMax(&cmax[n4 * 4 + 2], __float_as_int(m2)); atomicMax(&cmax[n4 * 4 + 3], __float_as_int(m3));
  }
  __syncthreads();
  {
    const int nn = tid >> 3, kc = tid & 7;
    const int n = ng * 64 + nn;
    const float am = __int_as_float(cmax[nn]);
    const float sc = am > 0.f ? am * (1.f / 127.f) : 1.f, iv = 1.f / sc;
    const int j = n & 1023;
    const int row = INTERLEAVE ? (j >> 4) * 32 + (j & 15) + ((n >= 1024) ? 16 : 0) : n;
    if (kc == 0) sw[n] = sc;
#pragma unroll 2
    for (int q = 0; q < 8; ++q) {
      const int k0 = (kc + 8 * q) * 16;
      unsigned w[4];
#pragma unroll
      for (int g4 = 0; g4 < 4; ++g4) {
        unsigned acc = 0u;
#pragma unroll
        for (int b = 0; b < 4; ++b) {
          const float v = bf2f((short)blk[(k0 + g4 * 4 + b) * 64 + nn]);
          const int qi = (int)fminf(fmaxf(rintf(v * iv), -127.f), 127.f);
          acc |= ((unsigned)(qi & 0xff)) << (8 * b);
        }
        w[g4] = acc;
      }
      *(uint4*)(dst + (size_t)row * 1024 + k0) = make_uint4(w[0], w[1], w[2], w[3]);
    }
  }
  __syncthreads();
}
__device__ __forceinline__ void phase_convert(PP pp, int l, int part, int bid, int nb, char* smem) {
  float* tile = (float*)smem;
  char* wl = p.ws + OFF_W + (size_t)l * WL_SIZE;
  const int T_IN = 56, T_OUT = 4 * 16, T_GU = 32 * 32, T_DN = 32 * 4 * 16;
  const int t_lo = part == 0 ? 0 : T_IN + T_OUT;
  const int t_hi = part == 0 ? T_IN + T_OUT : T_IN + T_OUT + T_GU + T_DN;
  for (int t = t_lo + bid; t < t_hi; t += nb) {
    if (t < T_IN) {
      convert_i8<PIN, false>(p.w_in + (size_t)l * 1024 * PIN, (signed char*)(wl + WL_IN), (float*)(p.ws + OFF_SWIN) + (size_t)l * PINP, t, smem);
    } else if (t < T_IN + T_OUT) {
      int u = t - T_IN; int kt4 = u / 16, nt = u % 16;
      convert_tile(p.w_out + (size_t)l * 1024 * 1024, 1024, (bfr*)(wl + WL_OUT), kt4, nt, tile);
    } else if (t < T_IN + T_OUT + T_GU) {
      int u = t - T_IN - T_OUT; int e = u / 32, ng = u % 32;
      convert_i8<2048, true>(p.moe_w_gu + ((size_t)l * 32 + e) * 1024 * 2048, (signed char*)(wl + WL_GU) + (size_t)e * 2048 * 1024,
                    (float*)(p.ws + OFF_SW) + ((size_t)l * 32 + e) * 2048, ng, smem);
    } else {
      int u = t - T_IN - T_OUT - T_GU; int e = u / 64; int v = u % 64; int kt4 = v / 16, nt = v % 16;
      convert_tile(p.moe_w_down + ((size_t)l * 32 + e) * 1024 * 1024, 1024, (bfr*)(wl + WL_DN) + (size_t)e * 1024 * 1024, kt4, nt, tile);
    }
  }
}

__device__ __forceinline__ void phase_prenorm(PP pp, int l, int bid, int nb) {
  const int tid = tid_opaque(), lane = tid & 63, wv = wave_id(tid);
  const float* xl = (l == 0) ? p.x : p.out;
  const float* xc = (l == 0) ? p.ctx : (const float*)(p.ws + OFF_CTX);
  const float* mods = (const float*)(p.ws + OFF_MODS) + (size_t)l * 3 * 6144;
  const float* g = p.norm_mix_g + (size_t)l * 1024;
  signed char* H8 = (signed char*)(p.ws + OFF_H);
  float* SCL = (float*)(p.ws + OFF_SCL);
  {
    int* cnt = (int*)(p.ws + OFF_CNT);
    int gt = bid * NTHR + tid;
    if (gt < 32) cnt[gt] = 0;
  }
  for (int m = bid * 8 + wv; m < NTOK; m += nb * 8) {
    const float* xr = (m < NLAT) ? xl + (size_t)m * 1024 : xc + (size_t)(m - NLAT) * 1024;
    const float* md = mods + (size_t)mod_row(m) * 6144;
    float4 v[4];
    float ss = 0.f;
#pragma unroll
    for (int i = 0; i < 4; ++i) {
      v[i] = *(const float4*)(xr + (lane + 64 * i) * 4);
      ss += v[i].x * v[i].x + v[i].y * v[i].y + v[i].z * v[i].z + v[i].w * v[i].w;
    }
    ss = wave_sum(ss);
    float rs = rsqrtf(ss * (1.f / 1024.f) + 1e-6f);
    float4 hq[4];
#pragma unroll
    for (int i = 0; i < 4; ++i) {
      int d = (lane + 64 * i) * 4;
      float4 gg = *(const float4*)(g + d);
      float4 sh = *(const float4*)(md + d);
      float4 sc = *(const float4*)(md + 1024 + d);
      hq[i] = make_float4(v[i].x * rs * gg.x * (1.f + sc.x) + sh.x, v[i].y * rs * gg.y * (1.f + sc.y) + sh.y,
                          v[i].z * rs * gg.z * (1.f + sc.z) + sh.z, v[i].w * rs * gg.w * (1.f + sc.w) + sh.w);
    }
    const float qs = quant_row_store(hq, H8 + (size_t)m * 1024, lane);
    if (lane == 0) SCL[m] = qs;
  }
}

#define LAS __attribute__((address_space(3)))
namespace g8 {
constexpr int BM = 256, BK = 64, HALF = 128, HTB = HALF * BK * 2, STAGE_BYTES = 8 * HTB, KD = 1024;
__device__ __forceinline__ int lds_byte(int r, int c) { const int st = (r >> 4) * 2 + (c >> 5), rr = r & 15, cc = c & 31, ob = rr * 64 + cc * 2; return st * 1024 + (ob ^ (((ob >> 9) & 1) << 5)); }
__device__ __forceinline__ void stage_rc(int b, int& R, int& C) { const int st = b / 1024, sb = b % 1024, swz = sb ^ (((sb >> 9) & 1) << 5); R = (st >> 1) * 16 + swz / 64; C = (st & 1) * 32 + (swz % 64) / 2; }
struct GUnit { int pm, pn, brow0, e; };
__device__ __forceinline__ int unit_index(int i, int c, int G, int total) {
  const int x = c & 7, j = c >> 3, q = total >> 3, r = total & 7;
  const int start = x < r ? x * (q + 1) : r * (q + 1) + (x - r) * q;
  const int size = q + (x < r ? 1 : 0);
  const int li = i * (G >> 3) + j;
  return li < size ? start + li : -1;
}

__device__ __forceinline__ f32x4 mma16(bf16x8 a, bf16x8 b, f32x4 c) { return __builtin_amdgcn_mfma_f32_16x16x32_bf16(a, b, c, 0, 0, 0); }
__device__ __forceinline__ i32x4 mma16(i32x4 a, i32x4 b, i32x4 c) { return __builtin_amdgcn_mfma_i32_16x16x64_i8(a, b, c, 0, 0, 0); }
template <bool I8, class Sched, class Epi>
__device__ __forceinline__ void gemm_stream(LAS unsigned char* lds, const void* Abase, const void* Btbase, const Sched& S, const Epi& E) {
  typedef typename std::conditional<I8, i32x4, f32x4>::type AccT;
  typedef typename std::conditional<I8, i32x4, bf16x8>::type FragT;
  constexpr int KB = I8 ? KD : KD * 2;
  const int tid = tid_opaque(), wid = __builtin_amdgcn_readfirstlane(tid >> 6), lane = tid & 63, wr = wid >> 2, wc = wid & 3, fr = lane & 15, fq = lane >> 4;
  constexpr int nt = KB / 128;
  int R[2], C[2];
  unsigned voffB[2];
#pragma unroll
  for (int i = 0; i < 2; ++i) { stage_rc(tid * 16 + i * 8192, R[i], C[i]); voffB[i] = (unsigned)(R[i] * KB + C[i] * 2); }
#define voffA voffB
  constexpr size_t kstep = (size_t)(BK * 2);
  constexpr size_t hstep = (size_t)HALF * KB;
  const unsigned ldsw = (unsigned)wid * 1024u;
  const int aoff = lds_byte(wr * 64 + fr, fq * 8), boff = lds_byte(wc * 32 + fr, fq * 8);
#define G8_SA(b, h) (((b) * 2 + (h)) * HTB)
#define G8_SB(b, h) ((4 + (b) * 2 + (h)) * HTB)
#define G8_STAGE(bufoff, gbase, v0, v1) do { \
    __builtin_amdgcn_global_load_lds((const unsigned*)((const char*)(gbase) + (v0)), (LAS unsigned*)(lds + (bufoff) + ldsw), 16, 0, 0); \
    __builtin_amdgcn_global_load_lds((const unsigned*)((const char*)(gbase) + (v1)), (LAS unsigned*)(lds + (bufoff) + ldsw + 8192), 16, 0, 0); } while (0)
#define G8_STAGEB(bufoff, gbase) G8_STAGE(bufoff, gbase, voffB[0], voffB[1])
#define G8_STAGEA(bufoff, gbase) G8_STAGE(bufoff, gbase, voffA[0], voffA[1])
#define G8_LDA(dst, b, h) do { _Pragma("unroll") for (int m = 0; m < 4; ++m) _Pragma("unroll") for (int k = 0; k < 2; ++k) dst[m][k] = *(const LAS FragT*)(lds + G8_SA(b, h) + aoff + m * 2048 + k * 1024); } while (0)
#define G8_LDB(dst, b, h) do { _Pragma("unroll") for (int n = 0; n < 2; ++n) _Pragma("unroll") for (int k = 0; k < 2; ++k) dst[n][k] = *(const LAS FragT*)(lds + G8_SB(b, h) + boff + n * 2048 + k * 1024); } while (0)
#define G8_MMA(ai, bj, At, Bt) do { __builtin_amdgcn_s_setprio(1); _Pragma("unroll") for (int m = 0; m < 4; ++m) _Pragma("unroll") for (int n = 0; n < 2; ++n) _Pragma("unroll") for (int k = 0; k < 2; ++k) \
    acc[ai][bj][m][n] = mma16(Bt[n][k], At[m][k], acc[ai][bj][m][n]); __builtin_amdgcn_s_setprio(0); } while (0)
#define G8_WAIT_V(n) asm volatile("s_waitcnt vmcnt(" #n ")" ::: "memory")
#define G8_WAIT_L(n) asm volatile("s_waitcnt lgkmcnt(" #n ")" ::: "memory")
#define G8_BAR __builtin_amdgcn_s_barrier()
#define G8_SCHED __builtin_amdgcn_sched_barrier(0)
  GUnit cur, nxt;
  int ui = 0;
  if (!S.next(0, cur)) return;
  AccT acc[2][2][4][2];
#pragma unroll
  for (int a = 0; a < 2; ++a)
#pragma unroll
    for (int b = 0; b < 2; ++b)
#pragma unroll
      for (int m = 0; m < 4; ++m)
#pragma unroll
        for (int n = 0; n < 2; ++n) acc[a][b][m][n] = AccT{};
  FragT At[4][2], B0[2][2], B1[2][2];
  const char* cA = (const char*)Abase + (size_t)cur.pm * (BM * KB);
  const char* cB = (const char*)Btbase + (size_t)cur.brow0 * KB;
  G8_STAGEB(G8_SB(0, 0), cB); G8_STAGEA(G8_SA(0, 0), cA); G8_STAGEB(G8_SB(0, 1), cB + hstep); G8_STAGEA(G8_SA(0, 1), cA + hstep);
  if (wr == 1) G8_BAR;
  G8_WAIT_V(4); G8_BAR;
  G8_STAGEB(G8_SB(1, 0), cB + kstep); G8_STAGEA(G8_SA(1, 0), cA + kstep); G8_STAGEB(G8_SB(1, 1), cB + hstep + kstep);
  G8_WAIT_V(6); G8_BAR;
  for (;;) {
    const bool has_next = S.next(ui + 1, nxt);
    const char* nA = has_next ? (const char*)Abase + (size_t)nxt.pm * (BM * KB) : cA;
    const char* nB = has_next ? (const char*)Btbase + (size_t)nxt.brow0 * KB : cB;
#pragma unroll 1
    for (int t = 0; t < nt; t += 2) {
      const bool last = (t == nt - 2);
      const char* a1 = cA + (size_t)(t + 1) * kstep;
      const char* a2 = last ? nA : cA + (size_t)(t + 2) * kstep;
      const char* b2 = last ? nB : cB + (size_t)(t + 2) * kstep;
      const char* a3 = a2 + kstep;
      const char* b3 = b2 + kstep;
      G8_LDB(B0, 0, 0); G8_SCHED; G8_LDA(At, 0, 0); G8_STAGEA(G8_SA(1, 1), a1 + hstep);
      G8_WAIT_L(8); G8_BAR; G8_WAIT_L(0); G8_MMA(0, 0, At, B0); G8_BAR; G8_SCHED;
      G8_LDB(B1, 0, 1); G8_STAGEB(G8_SB(0, 0), b2);
      G8_BAR; G8_WAIT_L(0); G8_MMA(0, 1, At, B1); G8_BAR;
      G8_LDA(At, 0, 1); G8_STAGEA(G8_SA(0, 0), a2);
      G8_BAR; G8_WAIT_L(0); G8_MMA(1, 0, At, B0); G8_BAR; G8_SCHED;
      G8_STAGEB(G8_SB(0, 1), b2 + hstep);
      G8_WAIT_V(6); G8_BAR; G8_MMA(1, 1, At, B1); G8_BAR;
      G8_LDB(B0, 1, 0); G8_SCHED; G8_LDA(At, 1, 0); G8_STAGEA(G8_SA(0, 1), a2 + hstep);
      G8_WAIT_L(8); G8_BAR; G8_WAIT_L(0); G8_MMA(0, 0, At, B0); G8_BAR; G8_SCHED;
      G8_LDB(B1, 1, 1); G8_STAGEB(G8_SB(1, 0), b3);
      G8_BAR; G8_WAIT_L(0); G8_MMA(0, 1, At, B1); G8_BAR;
      G8_LDA(At, 1, 1); G8_STAGEA(G8_SA(1, 0), a3);
      G8_BAR; G8_WAIT_L(0); G8_MMA(1, 0, At, B0); G8_BAR; G8_SCHED;
      G8_STAGEB(G8_SB(1, 1), b3 + hstep);
      G8_WAIT_V(6); G8_BAR; G8_MMA(1, 1, At, B1); G8_BAR;
    }
    E(acc, cur, wr, wc, fr, fq);
    if (!has_next) break;
#pragma unroll
    for (int a = 0; a < 2; ++a)
#pragma unroll
      for (int b = 0; b < 2; ++b)
#pragma unroll
        for (int m = 0; m < 4; ++m)
#pragma unroll
          for (int n = 0; n < 2; ++n) acc[a][b][m][n] = AccT{};
    cur = nxt; cA = nA; cB = nB; ++ui;
  }
  G8_WAIT_V(0);
  if (wr == 0) G8_BAR;
  G8_BAR;
#undef G8_SA
#undef G8_SB
#undef G8_STAGE
#undef G8_STAGEB
#undef G8_STAGEA
#undef voffA
#undef G8_LDA
#undef G8_LDB
#undef G8_MMA
#undef G8_WAIT_V
#undef G8_WAIT_L
#undef G8_BAR
#undef G8_SCHED
}

struct DenseSched {
  int nM, nN, G, c;
  __device__ __forceinline__ bool next(int i, GUnit& u) const {
    const int idx = unit_index(i, c, G, nM * nN);
    if (idx < 0) return false;
    u.pm = idx / nN; u.pn = idx - u.pm * nN; u.brow0 = u.pn * BM; u.e = 0;
    return true;
  }
};
struct MoeSched {
  const int* toff; int nN, NE, G, c;
  __device__ __forceinline__ bool next(int i, GUnit& u) const {
    const int idx = unit_index(i, c, G, toff[32] * nN);
    if (idx < 0) return false;
    u.pm = idx / nN; u.pn = idx - u.pm * nN;
    const int e = toff[128 + u.pm];
    u.e = e; u.brow0 = e * NE + u.pn * BM;
    return true;
  }
};
}

struct EpiInProj {
  float* P; const float* SCL; const float* sw;
  __device__ __forceinline__ void operator()(const i32x4 (&acc)[2][2][4][2], const g8::GUnit& u, int wr, int wc, int fr, int fq) const {
    const int row0 = u.pm * 256 + wr * 64 + fr, col0 = u.pn * 256 + wc * 32 + 4 * fq;
    f32x4 cs[2][2];
#pragma unroll
    for (int bj = 0; bj < 2; ++bj)
#pragma unroll
      for (int n = 0; n < 2; ++n) cs[bj][n] = *(const f32x4*)(sw + col0 + bj * 128 + n * 16);
    float sav[2][4];
#pragma unroll
    for (int ai = 0; ai < 2; ++ai)
#pragma unroll
      for (int m = 0; m < 4; ++m) sav[ai][m] = SCL[row0 + ai * 128 + m * 16];
#pragma unroll
    for (int ai = 0; ai < 2; ++ai)
#pragma unroll
      for (int m = 0; m < 4; ++m) {
        const int row = row0 + ai * 128 + m * 16;
        const float sa = sav[ai][m];
        float* rowp = P + (size_t)row * PINP + col0;
#pragma unroll
        for (int bj = 0; bj < 2; ++bj)
#pragma unroll
          for (int n = 0; n < 2; ++n) {
            const i32x4 a = acc[ai][bj][m][n];
            f32x4 o = {(float)a[0], (float)a[1], (float)a[2], (float)a[3]};
            *(f32x4*)(rowp + bj * 128 + n * 16) = o * (cs[bj][n] * sa);
          }
      }
  }
};
__device__ __forceinline__ void phase_gemm_in(PP pp, int l, int bid, int nb, char* smem) {
  g8::DenseSched S{130, 14, nb, bid};
  EpiInProj E{(float*)(p.ws + OFF_P), (const float*)(p.ws + OFF_SCL), (const float*)(p.ws + OFF_SWIN) + (size_t)l * PINP};
  g8::gemm_stream<true>((LAS unsigned char*)smem, p.ws + OFF_H, p.ws + OFF_W + (size_t)l * WL_SIZE + WL_IN, S, E);
}

struct EpiOutProj {
  const float *xl, *xc, *mods; float *ol, *oc;
  __device__ __forceinline__ void operator()(const f32x4 (&acc)[2][2][4][2], const g8::GUnit& u, int wr, int wc, int fr, int fq) const {
    const bool lat = u.pm < 128;
    const float* xin = lat ? xl + (size_t)u.pm * 256 * 1024 : xc + (size_t)(u.pm - 128) * 256 * 1024;
    float* xo = lat ? ol + (size_t)u.pm * 256 * 1024 : oc + (size_t)(u.pm - 128) * 256 * 1024;
    const float* g1 = mods + (size_t)(lat ? (u.pm >> 6) : 2) * 6144 + 2048;
    const int row0 = wr * 64 + fr, col0 = u.pn * 256 + wc * 32 + 4 * fq;
#pragma unroll
    for (int bj = 0; bj < 2; ++bj)
#pragma unroll
      for (int n = 0; n < 2; ++n) {
        const f32x4 gv = *(const f32x4*)(g1 + col0 + bj * 128 + n * 16);
        f32x4 xv[2][4];
#pragma unroll
        for (int ai = 0; ai < 2; ++ai)
#pragma unroll
          for (int m = 0; m < 4; ++m) xv[ai][m] = *(const f32x4*)(xin + (size_t)(row0 + ai * 128 + m * 16) * 1024 + col0 + bj * 128 + n * 16);
#pragma unroll
        for (int ai = 0; ai < 2; ++ai)
#pragma unroll
          for (int m = 0; m < 4; ++m)
            *(f32x4*)(xo + (size_t)(row0 + ai * 128 + m * 16) * 1024 + col0 + bj * 128 + n * 16) = xv[ai][m] + gv * acc[ai][bj][m][n];
        asm volatile("" ::: "memory");
      }
  }
};
__device__ __forceinline__ void phase_gemm_out(PP pp, int l, int bid, int nb, char* smem) {
  g8::DenseSched S{(l == 0) ? 130 : 128, 4, nb, bid};
  EpiOutProj E{(l == 0) ? p.x : p.out, (l == 0) ? p.ctx : (const float*)(p.ws + OFF_CTX),
               (const float*)(p.ws + OFF_MODS) + (size_t)l * 3 * 6144, p.out, (float*)(p.ws + OFF_CTX)};
  g8::gemm_stream<false>((LAS unsigned char*)smem, p.ws + OFF_CC, p.ws + OFF_W + (size_t)l * WL_SIZE + WL_OUT, S, E);
}

#define LBAR() do { asm volatile("s_waitcnt lgkmcnt(0)" ::: "memory"); __builtin_amdgcn_s_barrier(); asm volatile("" ::: "memory"); } while (0)
__device__ __forceinline__ void phase_prep(PP pp, int l, int bid, int nb, char* smem) {
  const int tid = tid_opaque(), lane = tid & 63, wv = wave_id(tid);
  const float* P = (const float*)(p.ws + OFF_P);
  char* S = p.ws + OFF_S;
  bfr* QN = (bfr*)(S + S_QN);
  bfr* KN = (bfr*)(S + S_KN);
  bfr* VT = (bfr*)(S + S_VT);
  float* RWR = (float*)(S + S_RWR);
  float* RWKK = (float*)(S + S_RWKK);
  float* RWV = (float*)(S + S_RWV);
  float* RWG = (float*)(S + S_RWG);
  float* RWW = (float*)(S + S_RWW);
  float* RWKD = (float*)(S + S_RWKD);
  float* RWB = (float*)(S + S_RWB);
  float* BON = (float*)(S + S_BON);
  float* GDQ = (float*)(S + S_GDQ);
  float* GDK = (float*)(S + S_GDK);
  float* GDV = (float*)(S + S_GDV);
  float* GDAB = (float*)(S + S_GDAB);
  const float* mu = p.rw_mu + (size_t)l * 896;
  const float* w0 = p.rw_w0 + (size_t)l * 512;
  const float* w_up = p.rw_w_up + (size_t)l * 2 * 32 * 256;
  const float* a0 = p.rw_a0 + (size_t)l * 512;
  const float* a_up = p.rw_a_up + (size_t)l * 2 * 32 * 256;
  const float* g_up = p.rw_g_up + (size_t)l * 64 * 256;
  const float* k_k = p.rw_k_k + (size_t)l * 256;
  const float* k_a = p.rw_k_a + (size_t)l * 256;
  const float* r_k = p.rw_r_k + (size_t)l * 256;
  const float* conv_w = p.gd_conv_w + (size_t)l * 5 * 768;
  const float* A_log = p.gd_A_log + (size_t)l * 8;
  const float* dt_bias = p.gd_dt_bias + (size_t)l * 8;
  const float* qg = p.na_q_gain + (size_t)l * 64;
  const float* kg = p.na_k_gain + (size_t)l * 64;

  bfr* wl = (bfr*)smem;
  float* lor = (float*)(smem + 192 * 256 * 2);
  __syncthreads();
  for (int i = tid; i < 192 * 256; i += NTHR) {
    const int row = i >> 8, c = i & 255;
    const float v = row < 64 ? g_up[row * 256 + c] : row < 128 ? w_up[(row - 64) * 256 + c] : a_up[(row - 128) * 256 + c];
    wl[i] = f2bf(v);
  }
  __syncthreads();

  for (int tile = bid; tile < NTOK / 16; tile += nb) {
    const int m0 = tile * 16;
    int seq_lo, seq_hi, bb, tau0;
    if (m0 < NLAT) { bb = m0 >> 14; seq_lo = bb << 14; seq_hi = seq_lo + SEQ; tau0 = m0 - seq_lo; }
    else { bb = (m0 - NLAT) >> 8; seq_lo = NLAT + (bb << 8); seq_hi = seq_lo + CTXL; tau0 = SEQ + (m0 - seq_lo); }
    const f32x4 z4 = {0.f, 0.f, 0.f, 0.f};
    int tid_t = tid; asm volatile("" : "+v"(tid_t));
    const int lane_t = tid_t & 63;
    const int cb = lane_t * 4, hh = lane_t >> 4;
    const int lg = tid_t & 31, lt = tid_t >> 5;
    const int sl = lane_t >> 4, sc4 = (lane_t & 15) * 4;
    asm volatile("" ::: "memory");
    const f32x4 mur = *(const f32x4*)(mu + cb), muk = *(const f32x4*)(mu + 256 + cb), muv = *(const f32x4*)(mu + 512 + cb);
    const f32x4 mul = *(const f32x4*)(mu + 768 + lg * 4);

    f32x4 pr[3][4], pl[3];
    {
      const int mt0 = m0 + 2 * wv;
#pragma unroll
      for (int j = 0; j < 3; ++j)
#pragma unroll
        for (int t = 0; t < 4; ++t) {
          const int m = mt0 - 1 + t;
          const int mc = min(max(m, seq_lo), seq_hi - 1);
          const f32x4 ld = *(const f32x4*)(P + (size_t)mc * PINP + A_END + j * 256 + cb);
          pr[j][t] = (m == mc) ? ld : z4;
        }
#pragma unroll
      for (int t = 0; t < 3; ++t) {
        const int m = m0 + lt - 1 + t;
        const int mc = min(max(m, seq_lo), seq_hi - 1);
        const f32x4 ld = *(const f32x4*)(P + (size_t)mc * PINP + A_END + 768 + lg * 4);
        pl[t] = (m == mc) ? ld : z4;
      }
    }
    {
      const f32x4 v = pl[1] + mul * (0.5f * (pl[0] + pl[2]) - pl[1]);
#pragma unroll
      for (int i = 0; i < 4; ++i) {
        const int ch = lg * 4 + i;
        lor[ch * 16 + lt] = ch < 32 ? tanhf(v[i]) : ch < 64 ? v[i] : sigmoidf_(v[i]);
      }
    }
    f32x4 rr[2], rk[2], rv[2];
#pragma unroll
    for (int t = 0; t < 2; ++t) {
      rr[t] = pr[0][t + 1] + mur * (0.5f * (pr[0][t] + pr[0][t + 2]) - pr[0][t + 1]);
      rk[t] = pr[1][t + 1] + muk * (0.5f * (pr[1][t] + pr[1][t + 2]) - pr[1][t + 1]);
      rv[t] = pr[2][t + 1] + muv * (0.5f * (pr[2][t] + pr[2][t + 2]) - pr[2][t + 1]);
    }
    LBAR();
    f32x4 pg[20];
    const bool is_gd = wv < 3, is_na = (wv >= 3 && wv < 7);
    const int sec = is_gd ? wv * 4 + sl : (wv - 3) * 4 + sl;
    if (is_gd) {
#pragma unroll
      for (int t = 0; t < 20; ++t) {
        const int m = m0 - 2 + t;
        const int mc = min(max(m, seq_lo), seq_hi - 1);
        const f32x4 ld = *(const f32x4*)(P + (size_t)mc * PINP + B_END + sec * 64 + sc4);
        pg[t] = (m == mc) ? ld : z4;
      }
    } else if (is_na) {
#pragma unroll
      for (int t = 0; t < 16; ++t) pg[t] = *(const f32x4*)(P + (size_t)(m0 + t) * PINP + sec * 64 + sc4);
#pragma unroll
      for (int t = 16; t < 20; ++t) pg[t] = z4;
    } else {
#pragma unroll
      for (int t = 0; t < 20; ++t) pg[t] = z4;
    }
    asm volatile("" ::: "memory");
    {
      f32x4 gacc[2], wa0[2], wa1[2], aa0[2], aa1[2];
#pragma unroll
      for (int t = 0; t < 2; ++t) { gacc[t] = z4; wa0[t] = z4; wa1[t] = z4; aa0[t] = z4; aa1[t] = z4; }
#pragma unroll 4
      for (int j = 0; j < 64; ++j) {
        const bf16x4 wq = *(const bf16x4*)(wl + j * 256 + cb);
        const f32x4 wgt = {bf2f(wq[0]), bf2f(wq[1]), bf2f(wq[2]), bf2f(wq[3])};
        const float2 sv = *(const float2*)(lor + (64 + j) * 16 + 2 * wv);
        gacc[0] += wgt * sv.x; gacc[1] += wgt * sv.y;
      }
#pragma unroll 2
      for (int j = 0; j < 32; ++j) {
        const bf16x4 q0 = *(const bf16x4*)(wl + (64 + j) * 256 + cb), q1 = *(const bf16x4*)(wl + (96 + j) * 256 + cb);
        const bf16x4 q2 = *(const bf16x4*)(wl + (128 + j) * 256 + cb), q3 = *(const bf16x4*)(wl + (160 + j) * 256 + cb);
        const f32x4 ww0 = {bf2f(q0[0]), bf2f(q0[1]), bf2f(q0[2]), bf2f(q0[3])}, ww1 = {bf2f(q1[0]), bf2f(q1[1]), bf2f(q1[2]), bf2f(q1[3])};
        const f32x4 aw0 = {bf2f(q2[0]), bf2f(q2[1]), bf2f(q2[2]), bf2f(q2[3])}, aw1 = {bf2f(q3[0]), bf2f(q3[1]), bf2f(q3[2]), bf2f(q3[3])};
        const float2 tv = *(const float2*)(lor + j * 16 + 2 * wv);
        const float2 dv = *(const float2*)(lor + (32 + j) * 16 + 2 * wv);
        wa0[0] += ww0 * tv.x; wa0[1] += ww0 * tv.y; wa1[0] += ww1 * tv.x; wa1[1] += ww1 * tv.y;
        aa0[0] += aw0 * dv.x; aa0[1] += aw0 * dv.y; aa1[0] += aw1 * dv.x; aa1[1] += aw1 * dv.y;
      }
      asm volatile("" ::: "memory");
      const f32x4 kkc = *(const f32x4*)(k_k + cb), kac = *(const f32x4*)(k_a + cb), rkc = *(const f32x4*)(r_k + cb);
      const f32x4 w00 = *(const f32x4*)(w0 + cb), w01 = *(const f32x4*)(w0 + 256 + cb), a00 = *(const f32x4*)(a0 + cb), a01 = *(const f32x4*)(a0 + 256 + cb);
#pragma unroll
      for (int t = 0; t < 2; ++t) {
        const int m = m0 + 2 * wv + t;
        const f32x4 r = rr[t], k = rk[t], v = rv[t];
        const f32x4 kkraw = k * kkc;
        const float ssum = row16_sum((kkraw[0] * kkraw[0] + kkraw[1] * kkraw[1]) + (kkraw[2] * kkraw[2] + kkraw[3] * kkraw[3]));
        const f32x4 kk = kkraw * rsqrtf(ssum + 1e-6f);
        float bon = 0.f;
#pragma unroll
        for (int d = 0; d < 2; ++d) {
          const f32x4 wlin = d == 0 ? w00 + wa0[t] : w01 + wa1[t];
          const f32x4 alin = d == 0 ? a00 + aa0[t] : a01 + aa1[t];
          f32x4 lw, kd, bv;
#pragma unroll
          for (int i = 0; i < 4; ++i) {
            const float w_log = -softplusf_(-wlin[i]) - 0.5f;
            const float a = sigmoidf_(alin[i]);
            lw[i] = -__expf(w_log);
            kd[i] = k[i] * (1.f + (a - 1.f) * kac[i]);
            bv[i] = kk[i] * a;
            bon += r[i] * kd[i] * rkc[i];
          }
          const size_t o = ((size_t)d * NTOK + m) * 256 + cb;
          *(f32x4*)(RWW + o) = lw; *(f32x4*)(RWKD + o) = kd; *(f32x4*)(RWB + o) = bv;
        }
        bon = row16_sum(bon);
        const size_t o = (size_t)m * 256 + cb;
        *(f32x4*)(RWR + o) = r; *(f32x4*)(RWKK + o) = kk; *(f32x4*)(RWV + o) = v; *(f32x4*)(RWG + o) = gacc[t];
        if ((lane_t & 15) == 0) BON[(size_t)m * 4 + hh] = bon;
      }
    }
    if (is_gd) {
      f32x4 cw[5];
#pragma unroll
      for (int j = 0; j < 5; ++j) cw[j] = *(const f32x4*)(conv_w + j * 768 + sec * 64 + sc4);
#pragma unroll
      for (int t = 0; t < 16; ++t) {
        f32x4 acc = z4;
#pragma unroll
        for (int j = 0; j < 5; ++j) acc += cw[j] * pg[t + j];
        f32x4 val = {siluf_(acc[0]), siluf_(acc[1]), siluf_(acc[2]), siluf_(acc[3])};
        const int m = m0 + t;
        if (sec < 8) {
          const float ss = row16_sum((val[0] * val[0] + val[1] * val[1]) + (val[2] * val[2] + val[3] * val[3]));
          val = val * rsqrtf(ss + 1e-6f);
          if (sec < 4) *(f32x4*)(GDQ + (size_t)m * 256 + sec * 64 + sc4) = val * 0.125f;
          else *(f32x4*)(GDK + (size_t)m * 256 + (sec - 4) * 64 + sc4) = val;
        } else *(f32x4*)(GDV + (size_t)m * 256 + (sec - 8) * 64 + sc4) = val;
      }
    } else if (is_na) {
      const f32x4 gq = *(const f32x4*)(qg + sc4) * (0.125f * 1.4426950408889634f), gk = *(const f32x4*)(kg + sc4);
#pragma unroll
      for (int t = 0; t < 16; ++t) {
        f32x4 val = pg[t];
        const float ss = row16_sum((val[0] * val[0] + val[1] * val[1]) + (val[2] * val[2] + val[3] * val[3]));
        val = val * rsqrtf(ss * (1.f / 64.f) + 1e-6f);
        const int m = m0 + t;
        if (sec < 8) { const f32x4 o = val * gq; *(bf16x4*)(QN + (size_t)m * 512 + sec * 64 + sc4) = pack4(o[0], o[1], o[2], o[3]); }
        else { const f32x4 o = val * gk; *(bf16x4*)(KN + (size_t)m * 512 + (sec - 8) * 64 + sc4) = pack4(o[0], o[1], o[2], o[3]); }
      }
    }
    if (tid_t < 256) {
      const int t = tid_t >> 4, j = tid_t & 15;
      const int m = m0 + t;
      const float pv = P[(size_t)m * PINP + B_END + 1024 + j];
      float o;
      if (j < 8) o = -__expf(A_log[j]) * softplusf_(pv + dt_bias[j]);
      else o = sigmoidf_(pv);
      GDAB[(size_t)m * 16 + j] = o;
    }
    {
      const int vc = (tid_t & 127) * 4, tq = (tid_t >> 7) * 4;
      f32x4 pv[4];
#pragma unroll
      for (int t = 0; t < 4; ++t) pv[t] = *(const f32x4*)(P + (size_t)(m0 + tq + t) * PINP + 1024 + vc);
#pragma unroll
      for (int i = 0; i < 4; ++i) {
        const int hd = vc + i;
        bfr* dst = VT + ((size_t)(bb * 8 + (hd >> 6)) * (TTOK / 16) + (tau0 >> 4)) * 1024 + (hd & 63) * 16 + tq;
        *(bf16x4*)dst = pack4(pv[0][i], pv[1][i], pv[2][i], pv[3][i]);
      }
    }
    LBAR();
  }
  __syncthreads();
}

__device__ __forceinline__ int scan_tok(int b, int d, int s) {
  if (s < CTXL) { int t = d ? (CTXL - 1 - s) : s; return NLAT + b * CTXL + t; }
  int u = s - CTXL; int t = d ? (SEQ - 1 - u) : u; return b * SEQ + t;
}
#define CS 72
#define SLOT_BYTES (64 * CS * 2)
#define F0_STRIDE 68
#define X1_F0 (13 * SLOT_BYTES)
#define X1_ARR (X1_F0 + 64 * F0_STRIDE * 4)

#define MM_FRAGS(As, Bs, a0, a1, b00, b01, b10, b11)                                                     \
  const bf16x8 a0 = *(const bf16x8*)((As) + ((mt * 16 + fr) * CS + fq * 8) * 2);                         \
  const bf16x8 a1 = *(const bf16x8*)((As) + ((mt * 16 + fr) * CS + 32 + fq * 8) * 2);                    \
  const bf16x8 b00 = *(const bf16x8*)((Bs) + ((nt0 * 16 + fr) * CS + fq * 8) * 2);                       \
  const bf16x8 b01 = *(const bf16x8*)((Bs) + ((nt0 * 16 + fr) * CS + 32 + fq * 8) * 2);                  \
  const bf16x8 b10 = *(const bf16x8*)((Bs) + ((nt0 * 16 + 16 + fr) * CS + fq * 8) * 2);                  \
  const bf16x8 b11 = *(const bf16x8*)((Bs) + ((nt0 * 16 + 16 + fr) * CS + 32 + fq * 8) * 2);
#define MM_2TILES(acc0, acc1, a0, a1, b00, b01, b10, b11)                                                \
  acc0 = __builtin_amdgcn_mfma_f32_16x16x32_bf16(a0, b00, acc0, 0, 0, 0);                                \
  acc0 = __builtin_amdgcn_mfma_f32_16x16x32_bf16(a1, b01, acc0, 0, 0, 0);                                \
  acc1 = __builtin_amdgcn_mfma_f32_16x16x32_bf16(a0, b10, acc1, 0, 0, 0);                                \
  acc1 = __builtin_amdgcn_mfma_f32_16x16x32_bf16(a1, b11, acc1, 0, 0, 0);
__device__ __forceinline__ void wr_T(char* slot, int mt, int nt, int fr, int fq, f32x4 v) {
  *(bf16x4*)(slot + ((nt * 16 + fr) * CS + mt * 16 + 4 * fq) * 2) = pack4(v[0], v[1], v[2], v[3]);
}

struct ChunkIn { float lw[8], f0[8], f1[8], f2[8], f3[8], xv[8], be[8]; };
template <bool GDN>
__device__ __forceinline__ void chunk_load(PP pp, int t, ChunkIn& ci) {
  const int tid = tid_opaque(), c = tid & 63, tg = wave_id(tid);
  const int chain = t / NCHUNK, n = t - chain * NCHUNK;
  const int d = chain & 1, h = (chain >> 1) & 3, b = (chain >> 3) & 1;
  const char* S = p.ws + OFF_S;
#pragma unroll
  for (int u = 0; u < 8; ++u) {
    const int m = scan_tok(b, d, n * 64 + tg * 8 + u);
    const size_t o = (size_t)m * 256 + h * 64 + c;
    if (!GDN) {
      ci.lw[u] = ((const float*)(S + S_RWW))[(size_t)d * NTOK * 256 + o];
      ci.f0[u] = ((const float*)(S + S_RWKK))[o];
      ci.f1[u] = ((const float*)(S + S_RWB))[(size_t)d * NTOK * 256 + o];
      ci.f2[u] = ((const float*)(S + S_RWKD))[(size_t)d * NTOK * 256 + o];
      ci.f3[u] = ((const float*)(S + S_RWR))[o];
      ci.xv[u] = ((const float*)(S + S_RWV))[o];
      ci.be[u] = 1.f;
    } else {
      ci.lw[u] = ((const float*)(S + S_GDAB))[(size_t)m * 16 + d * 4 + h];
      ci.be[u] = ((const float*)(S + S_GDAB))[(size_t)m * 16 + 8 + d * 4 + h];
      ci.f0[u] = ((const float*)(S + S_GDK))[o];
      ci.f3[u] = ((const float*)(S + S_GDQ))[o];
      ci.xv[u] = ((const float*)(S + S_GDV))[o];
      ci.f1[u] = 0.f; ci.f2[u] = 0.f;
    }
  }
}
template <bool GDN>
__device__ __forceinline__ void chunk_prep_task(PP pp, int t, int t_next, bool has_next, const ChunkIn& ci, ChunkIn& nx, char* smem) {
  const int chain = t / NCHUNK, n = t - chain * NCHUNK;
  const int d = chain & 1, h = (chain >> 1) & 3, b = (chain >> 3) & 1;
  (void)b; (void)d; (void)h;
  const int tid = tid_opaque(), lane = tid & 63, wv = wave_id(tid);
  const int fr = lane & 15, fq = lane >> 4, mt = wv >> 1, nt0 = (wv & 1) * 2;
  char* S = p.ws + OFF_S;
  char* CH = p.ws + OFF_CH;
  const size_t cc = (size_t)chain * NCHUNK + n;
  char* const p0 = smem;
  char* const p1 = smem + 1 * SLOT_BYTES;
  char* const p2 = smem + 2 * SLOT_BYTES;
  char* const p3 = smem + 3 * SLOT_BYTES;
  char* const p4 = smem + 4 * SLOT_BYTES;
  char* const p5 = smem + 5 * SLOT_BYTES;
  char* const p6 = smem + 6 * SLOT_BYTES;
  char* const p7 = smem + 7 * SLOT_BYTES;
  char* const p8 = smem + 8 * SLOT_BYTES;
  char* const p9 = smem + 9 * SLOT_BYTES;
  char* const p10 = smem + 10 * SLOT_BYTES;
  char* const p11 = smem + 11 * SLOT_BYTES;
  char* const p12 = smem + 12 * SLOT_BYTES;
  float* const F0 = (float*)(smem + X1_F0);
  float* const Lv = (float*)(smem + X1_ARR);
  float* const Lm1v = Lv + 64;
  float* const betav = Lv + 128;
  float* const eLv = Lv + 192;
  float* const gC = Lv + 256;
  float* const gsum = Lv + 320;
  char* const sKt = p0;
  char* const sBh = GDN ? p0 : p1;
  char* const sKh = GDN ? p0 : p2;

  {
    const int c = lane, tg = wv;
    const float* lw = ci.lw; const float* f0 = ci.f0; const float* f1 = ci.f1; const float* f2 = ci.f2; const float* f3 = ci.f3; const float* xv = ci.xv; const float* be = ci.be;
    float cum[8];
    cum[0] = lw[0];
#pragma unroll
    for (int u = 1; u < 8; ++u) cum[u] = cum[u - 1] + lw[u];
    gsum[tg * 64 + c] = cum[7];
    LBAR();
    float off = 0.f, LC = 0.f;
#pragma unroll
    for (int g2 = 0; g2 < 8; ++g2) { const float gs = gsum[g2 * 64 + c]; LC += gs; off += (g2 < tg) ? gs : 0.f; }
    bf16x8 vKtT, vBbT, vKbT, vXT;
#pragma unroll
    for (int u = 0; u < 8; ++u) {
      const int t = tg * 8 + u;
      const float L = off + cum[u], Lm1 = L - lw[u];
      if (!GDN) {
        const float eLm1 = __expf(Lm1), enL = __expf(-L), eL = __expf(L), eCL = __expf(LC - L);
        const float kt = f0[u] * eLm1;
        *(bfr*)(p0 + (t * CS + c) * 2) = f2bf(kt);
        *(bfr*)(p1 + (t * CS + c) * 2) = f2bf(f1[u] * enL);
        *(bfr*)(p2 + (t * CS + c) * 2) = f2bf(f2[u] * enL);
        *(bfr*)(p3 + (t * CS + c) * 2) = f2bf(f3[u] * eL);
        vKtT[u] = (short)f2bf(kt);
        vBbT[u] = (short)f2bf(f1[u] * eCL);
        vKbT[u] = (short)f2bf(f2[u] * eCL);
        vXT[u] = (short)f2bf(xv[u]);
      } else {
        *(bfr*)(p0 + (t * CS + c) * 2) = f2bf(f0[u]);
        *(bfr*)(p3 + (t * CS + c) * 2) = f2bf(f3[u]);
        vKtT[u] = (short)f2bf(f0[u] * __expf(Lm1));
        vBbT[u] = (short)f2bf(be[u] * f0[u] * __expf(LC - Lm1));
        vKbT[u] = (short)f2bf(f0[u] * __expf(LC - L));
        vXT[u] = (short)f2bf(be[u] * xv[u]);
        if (c == 0) { Lv[t] = L; Lm1v[t] = Lm1; betav[t] = be[u]; eLv[t] = __expf(L); }
      }
    }
    *(bf16x8*)(p4 + (c * CS + tg * 8) * 2) = vKtT;
    *(bf16x8*)(p5 + (c * CS + tg * 8) * 2) = vBbT;
    *(bf16x8*)(p6 + (c * CS + tg * 8) * 2) = vKbT;
    *(bf16x8*)(p7 + (c * CS + tg * 8) * 2) = vXT;
    if (tg == 0) gC[c] = __expf(LC);
    if (!GDN && tid < 64) { Lv[tid] = 0.f; Lm1v[tid] = 0.f; betav[tid] = 1.f; eLv[tid] = 1.f; }
  }
  LBAR();
  if (has_next) chunk_load<GDN>(pp, t_next, nx);
  {
    {
      MM_FRAGS(sKt, sBh, a0, a1, b00, b01, b10, b11)
      f32x4 c0 = {0.f, 0.f, 0.f, 0.f}, c1 = c0;
      MM_2TILES(c0, c1, a0, a1, b00, b01, b10, b11)
#pragma unroll
      for (int q = 0; q < 2; ++q) {
        const int sI = (nt0 + q) * 16 + fr;
        const f32x4 cv = q ? c1 : c0;
        f32x4 o;
#pragma unroll
        for (int r = 0; r < 4; ++r) {
          const int tI = mt * 16 + 4 * fq + r;
          float v = cv[r];
          if (GDN) v *= betav[sI] * __expf(fminf(Lm1v[tI] - Lm1v[sI], 0.f));
          o[r] = (sI < tI) ? v : 0.f;
        }
        *(f32x4*)(F0 + sI * F0_STRIDE + mt * 16 + 4 * fq) = o;
        wr_T(p11, mt, nt0 + q, fr, fq, o);
      }
    }
    {
      MM_FRAGS(sKt, sKh, a0, a1, b00, b01, b10, b11)
      f32x4 c0 = {0.f, 0.f, 0.f, 0.f}, c1 = c0;
      MM_2TILES(c0, c1, a0, a1, b00, b01, b10, b11)
#pragma unroll
      for (int q = 0; q < 2; ++q) {
        const int sI = (nt0 + q) * 16 + fr;
        const f32x4 cv = q ? c1 : c0;
        f32x4 o;
#pragma unroll
        for (int r = 0; r < 4; ++r) {
          const int tI = mt * 16 + 4 * fq + r;
          float v = cv[r];
          if (GDN) v *= __expf(fminf(Lm1v[tI] - Lv[sI], 0.f));
          o[r] = (sI < tI) ? v : 0.f;
        }
        wr_T(p9, mt, nt0 + q, fr, fq, o);
      }
    }
    {
      MM_FRAGS(sBh, p3, a0, a1, b00, b01, b10, b11)
      f32x4 c0 = {0.f, 0.f, 0.f, 0.f}, c1 = c0;
      MM_2TILES(c0, c1, a0, a1, b00, b01, b10, b11)
#pragma unroll
      for (int q = 0; q < 2; ++q) {
        const int tI = (nt0 + q) * 16 + fr;
        const f32x4 cv = q ? c1 : c0;
        f32x4 o;
#pragma unroll
        for (int r = 0; r < 4; ++r) {
          const int sI = mt * 16 + 4 * fq + r;
          float v = cv[r];
          if (GDN) v *= betav[sI] * __expf(fminf(Lv[tI] - Lm1v[sI], 0.f));
          o[r] = (sI <= tI) ? v : 0.f;
        }
        wr_T(p10, mt, nt0 + q, fr, fq, o);
      }
    }
  }
  LBAR();
  if (wv < 2) {
    const int base = wv * 32, other = 32 - base, c = lane & 31;
    float tr[32];
#pragma unroll
    for (int j = 0; j < 32; ++j) tr[j] = 0.f;
#pragma unroll
    for (int ip = 15; ip >= 0; --ip) {
      const int i = 2 * ip + 1, i2 = 2 * ip;
      float a0 = (c == i) ? 1.f : 0.f, a1 = 0.f, b0 = (c == i2) ? 1.f : 0.f, b1 = 0.f;
      const float aii = F0[(base + i2) * F0_STRIDE + base + i];
#pragma unroll
      for (int jb = ((i + 1) & ~3); jb < 32; jb += 4) {
        const f32x4 a4 = *(const f32x4*)(F0 + (base + i) * F0_STRIDE + base + jb);
        const f32x4 b4 = *(const f32x4*)(F0 + (base + i2) * F0_STRIDE + base + jb);
        a0 -= a4[0] * tr[jb]; a1 -= a4[1] * tr[jb + 1]; a0 -= a4[2] * tr[jb + 2]; a1 -= a4[3] * tr[jb + 3];
        b0 -= b4[0] * tr[jb]; b1 -= b4[1] * tr[jb + 1]; b0 -= b4[2] * tr[jb + 2]; b1 -= b4[3] * tr[jb + 3];
      }
      const float ti = a0 + a1;
      const float ti2 = (b0 + b1) - aii * ti;
      tr[i] = ti; tr[i2] = ti2;
      if (lane < 32) {
        *(bfr*)(p8 + ((base + i) * CS + base + c) * 2) = f2bf(ti);
        *(bfr*)(p8 + ((base + i) * CS + other + c) * 2) = (bfr)0;
        *(bfr*)(p8 + ((base + i2) * CS + base + c) * 2) = f2bf(ti2);
        *(bfr*)(p8 + ((base + i2) * CS + other + c) * 2) = (bfr)0;
      }
    }
    if (lane < 32) {
#pragma unroll
      for (int q = 0; q < 4; ++q) {
        bf16x8 o, z;
#pragma unroll
        for (int j = 0; j < 8; ++j) { o[j] = (short)f2bf(tr[8 * q + j]); z[j] = 0; }
        *(bf16x8*)(p12 + ((base + c) * CS + base + 8 * q) * 2) = o;
        *(bf16x8*)(p12 + ((base + c) * CS + other + 8 * q) * 2) = z;
      }
    }
  }
  LBAR();
  {
    MM_FRAGS(p11, p12, a0, a1, b00, b01, b10, b11)
    f32x4 c0 = {0.f, 0.f, 0.f, 0.f}, c1 = c0;
    MM_2TILES(c0, c1, a0, a1, b00, b01, b10, b11)
    wr_T(p1, mt, nt0, fr, fq, c0);
    wr_T(p1, mt, nt0 + 1, fr, fq, c1);
  }
  LBAR();
  if (mt < 2 && nt0 == 2) {
    MM_FRAGS(p8, p1, a0, a1, b00, b01, b10, b11)
    f32x4 c0 = {0.f, 0.f, 0.f, 0.f}, c1 = c0;
    MM_2TILES(c0, c1, a0, a1, b00, b01, b10, b11)
#pragma unroll
    for (int r = 0; r < 4; ++r) {
      *(bfr*)(p8 + ((mt * 16 + 4 * fq + r) * CS + (nt0) * 16 + fr) * 2) = f2bf(-c0[r]);
      *(bfr*)(p8 + ((mt * 16 + 4 * fq + r) * CS + (nt0 + 1) * 16 + fr) * 2) = f2bf(-c1[r]);
    }
  }
  LBAR();
  {
    {
      MM_FRAGS(p8, p5, a0, a1, b00, b01, b10, b11)
      f32x4 c0 = {0.f, 0.f, 0.f, 0.f}, c1 = c0;
      MM_2TILES(c0, c1, a0, a1, b00, b01, b10, b11)
      wr_T(p11, mt, nt0, fr, fq, -c0);
      wr_T(p11, mt, nt0 + 1, fr, fq, -c1);
    }
    {
      MM_FRAGS(p8, p10, a0, a1, b00, b01, b10, b11)
      f32x4 c0 = {0.f, 0.f, 0.f, 0.f}, c1 = c0;
      MM_2TILES(c0, c1, a0, a1, b00, b01, b10, b11)
      wr_T(p12, mt, nt0, fr, fq, -c0);
      wr_T(p12, mt, nt0 + 1, fr, fq, -c1);
    }
  }
  LBAR();
  {
    {
      MM_FRAGS(p4, p11, a0, a1, b00, b01, b10, b11)
      f32x4 c0 = {0.f, 0.f, 0.f, 0.f}, c1 = c0;
      MM_2TILES(c0, c1, a0, a1, b00, b01, b10, b11)
#pragma unroll
      for (int q = 0; q < 2; ++q) {
        const int cp = (nt0 + q) * 16 + fr;
        f32x4 cv = q ? c1 : c0;
#pragma unroll
        for (int r = 0; r < 4; ++r) { const int cI = mt * 16 + 4 * fq + r; if (cI == cp) cv[r] += gC[cI]; }
        wr_T(p10, mt, nt0 + q, fr, fq, cv);
      }
    }
    {
      MM_FRAGS(p9, p11, a0, a1, b00, b01, b10, b11)
      f32x4 c0 = {0.f, 0.f, 0.f, 0.f}, c1 = c0;
      MM_2TILES(c0, c1, a0, a1, b00, b01, b10, b11)
#pragma unroll
      for (int q = 0; q < 2; ++q) {
        const int cp = (nt0 + q) * 16 + fr;
        f32x4 cv = q ? c1 : c0;
        const bf16x4 kb = *(const bf16x4*)(p6 + (cp * CS + mt * 16 + 4 * fq) * 2);
#pragma unroll
        for (int r = 0; r < 4; ++r) cv[r] += __uint_as_float(((unsigned)(unsigned short)kb[r]) << 16);
        wr_T(p8, mt, nt0 + q, fr, fq, cv);
      }
    }
    {
      MM_FRAGS(p4, p12, a0, a1, b00, b01, b10, b11)
      f32x4 c0 = {0.f, 0.f, 0.f, 0.f}, c1 = c0;
      MM_2TILES(c0, c1, a0, a1, b00, b01, b10, b11)
#pragma unroll
      for (int q = 0; q < 2; ++q) {
        const int tI = (nt0 + q) * 16 + fr;
        f32x4 cv = q ? c1 : c0;
        const bf16x4 rt = *(const bf16x4*)(p3 + (tI * CS + mt * 16 + 4 * fq) * 2);
        const float el = eLv[tI];
#pragma unroll
        for (int r = 0; r < 4; ++r) cv[r] += __uint_as_float(((unsigned)(unsigned short)rt[r]) << 16) * el;
        wr_T(p1, mt, nt0 + q, fr, fq, cv);
      }
    }
    {
      f32x4 c0 = {0.f, 0.f, 0.f, 0.f}, c1 = c0;
      {
        MM_FRAGS(sKh, p3, a0, a1, b00, b01, b10, b11)
        MM_2TILES(c0, c1, a0, a1, b00, b01, b10, b11)
      }
#pragma unroll
      for (int q = 0; q < 2; ++q) {
        const int tI = (nt0 + q) * 16 + fr;
#pragma unroll
        for (int r = 0; r < 4; ++r) {
          const int sI = mt * 16 + 4 * fq + r;
          float v = q ? c1[r] : c0[r];
          if (GDN) v *= __expf(fminf(Lv[tI] - Lv[sI], 0.f));
          v = (sI <= tI) ? v : 0.f;
          if (q) c1[r] = v; else c0[r] = v;
        }
      }
      {
        MM_FRAGS(p9, p12, a0, a1, b00, b01, b10, b11)
        MM_2TILES(c0, c1, a0, a1, b00, b01, b10, b11)
      }
      wr_T(p5, mt, nt0, fr, fq, c0);
      wr_T(p5, mt, nt0 + 1, fr, fq, c1);
    }
  }
  LBAR();
  {
    {
      MM_FRAGS(p8, p7, a0, a1, b00, b01, b10, b11)
      f32x4 c0 = {0.f, 0.f, 0.f, 0.f}, c1 = c0;
      MM_2TILES(c0, c1, a0, a1, b00, b01, b10, b11)
      bfr* QT = (bfr*)(CH + cc * CH_REC + CH_QT);
      *(bf16x4*)(QT + ((mt * 4 + nt0) * 64 + lane) * 4) = pack4(c0[0], c0[1], c0[2], c0[3]);
      *(bf16x4*)(QT + ((mt * 4 + nt0 + 1) * 64 + lane) * 4) = pack4(c1[0], c1[1], c1[2], c1[3]);
    }
    {
      MM_FRAGS(p7, p5, a0, a1, b00, b01, b10, b11)
      f32x4 c0 = {0.f, 0.f, 0.f, 0.f}, c1 = c0;
      MM_2TILES(c0, c1, a0, a1, b00, b01, b10, b11)
      bfr* YX = (bfr*)(CH + cc * CH_REC + CH_YX);
      *(bf16x4*)(YX + ((mt * 4 + nt0) * 64 + lane) * 4) = pack4(c0[0], c0[1], c0[2], c0[3]);
      *(bf16x4*)(YX + ((mt * 4 + nt0 + 1) * 64 + lane) * 4) = pack4(c1[0], c1[1], c1[2], c1[3]);
    }
    {
      const int fm = wv >> 1, fa = wv & 1;
      const int row = fm * 16 + fr;
      {
        const bf16x4 lo = *(const bf16x4*)(p10 + (row * CS + 32 * fa + 4 * fq) * 2);
        const bf16x4 hi = *(const bf16x4*)(p10 + (row * CS + 32 * fa + 16 + 4 * fq) * 2);
        bf16x8 f; f[0] = lo[0]; f[1] = lo[1]; f[2] = lo[2]; f[3] = lo[3]; f[4] = hi[0]; f[5] = hi[1]; f[6] = hi[2]; f[7] = hi[3];
        *(bf16x8*)(CH + cc * CH_REC + CH_PT + (size_t)((fm * 2 + fa) * 64 + lane) * 16) = f;
      }
      {
        const bf16x4 lo = *(const bf16x4*)(p1 + (row * CS + 32 * fa + 4 * fq) * 2);
        const bf16x4 hi = *(const bf16x4*)(p1 + (row * CS + 32 * fa + 16 + 4 * fq) * 2);
        bf16x8 f; f[0] = lo[0]; f[1] = lo[1]; f[2] = lo[2]; f[3] = lo[3]; f[4] = hi[0]; f[5] = hi[1]; f[6] = hi[2]; f[7] = hi[3];
        *(bf16x8*)(CH + cc * CH_REC + CH_RYT + (size_t)((fm * 2 + fa) * 64 + lane) * 16) = f;
      }
    }
  }
  LBAR();
}

template <bool GDN>
__device__ __forceinline__ void chunk_prep_loop(PP pp, int t0, int tend, int nb, char* smem) {
  ChunkIn cur, nxt;
  if (t0 < tend) chunk_load<GDN>(pp, t0, cur);
  for (int t = t0; t < tend; t += nb) {
    const bool has_next = (t + nb) < tend;
    chunk_prep_task<GDN>(pp, t, t + nb, has_next, cur, nxt, smem);
    cur = nxt;
  }
}
__device__ __forceinline__ void phase_chunk_prep(PP pp, int bid, int nb, char* smem) {
  __syncthreads();
  const int half = (NCHAIN / 2) * NCHUNK;
  chunk_prep_loop<false>(pp, bid, half, nb, smem);
  const int k0 = (half - bid + nb - 1) / nb;
  chunk_prep_loop<true>(pp, bid + k0 * nb, NCHAIN * NCHUNK, nb, smem);
  __syncthreads();
}

#define X2_BUF 32768
#define X2_BAR() do { asm volatile("s_waitcnt lgkmcnt(0)" ::: "memory"); __builtin_amdgcn_s_barrier(); asm volatile("" ::: "memory"); } while (0)
__device__ __forceinline__ void chunk_seq_chain(PP pp, int chain, char* smem) {
  __syncthreads();
  const int tid = tid_opaque(), lane = tid & 63, wv = wave_id(tid);
  const int d = chain & 1, h = (chain >> 1) & 3, b = (chain >> 3) & 1, ty = chain >> 4;
  const char* CH = p.ws + OFF_CH;
  float* Y = (float*)(p.ws + OFF_S + (ty ? S_YGD : S_YRW)) + (size_t)d * NTOK * 256;
  const size_t c0 = (size_t)chain * NCHUNK;
  if (wv >= 4) {
    const int lw = wv - 4;
    const char* src0 = CH + c0 * CH_REC + (size_t)lane * 16;
#define X2_DMA(n) { const char* s_ = src0 + (size_t)(n) * CH_REC; LAS unsigned char* d_ = (LAS unsigned char*)smem + ((n) & 3) * X2_BUF;       \
      _Pragma("unroll") for (int i = 0; i < 8; ++i) {                                                                                       \
        const int piece = i * 4 + lw;                                                                                                       \
        __builtin_amdgcn_global_load_lds((const unsigned*)(s_ + piece * 1024), (LAS unsigned*)(d_ + piece * 1024), 16, 0, 0); } }
    X2_DMA(0) X2_DMA(1) X2_DMA(2)
    asm volatile("s_waitcnt vmcnt(16)" ::: "memory");
    X2_BAR();
    for (int n = 0; n < NCHUNK; ++n) {
      if (n + 3 < NCHUNK) { X2_DMA(n + 3) asm volatile("s_waitcnt vmcnt(16)" ::: "memory"); }
      else if (n + 2 < NCHUNK) asm volatile("s_waitcnt vmcnt(8)" ::: "memory");
      else asm volatile("s_waitcnt vmcnt(0)" ::: "memory");
      X2_BAR();
    }
#undef X2_DMA
  } else {
    const int vt = wv, fr = lane & 15, fq = lane >> 4;
    f32x4 Sacc[4];
#pragma unroll
    for (int i = 0; i < 4; ++i) Sacc[i] = (f32x4){0.f, 0.f, 0.f, 0.f};
    X2_BAR();
    for (int n = 0; n < NCHUNK; ++n) {
      const char* buf = smem + (n & 3) * X2_BUF;
      bf16x8 sB0, sB1;
#pragma unroll
      for (int j = 0; j < 4; ++j) {
        sB0[j] = (short)f2bf(Sacc[0][j]); sB0[4 + j] = (short)f2bf(Sacc[1][j]);
        sB1[j] = (short)f2bf(Sacc[2][j]); sB1[4 + j] = (short)f2bf(Sacc[3][j]);
      }
#pragma unroll
      for (int m = 0; m < 4; ++m) {
        const bf16x8 pa0 = *(const bf16x8*)(buf + ((m * 2 + 0) * 64 + lane) * 16);
        const bf16x8 pa1 = *(const bf16x8*)(buf + ((m * 2 + 1) * 64 + lane) * 16);
        const bf16x8 ra0 = *(const bf16x8*)(buf + 8192 + ((m * 2 + 0) * 64 + lane) * 16);
        const bf16x8 ra1 = *(const bf16x8*)(buf + 8192 + ((m * 2 + 1) * 64 + lane) * 16);
        const bf16x4 qb = *(const bf16x4*)(buf + 16384 + ((m * 4 + vt) * 64 + lane) * 8);
        const bf16x4 yb = *(const bf16x4*)(buf + 24576 + ((vt * 4 + m) * 64 + lane) * 8);
        f32x4 y = {bf2f(yb[0]), bf2f(yb[1]), bf2f(yb[2]), bf2f(yb[3])};
        y = __builtin_amdgcn_mfma_f32_16x16x32_bf16(sB0, ra0, y, 0, 0, 0);
        y = __builtin_amdgcn_mfma_f32_16x16x32_bf16(sB1, ra1, y, 0, 0, 0);
        f32x4 sn = {bf2f(qb[0]), bf2f(qb[1]), bf2f(qb[2]), bf2f(qb[3])};
        sn = __builtin_amdgcn_mfma_f32_16x16x32_bf16(pa0, sB0, sn, 0, 0, 0);
        sn = __builtin_amdgcn_mfma_f32_16x16x32_bf16(pa1, sB1, sn, 0, 0, 0);
        Sacc[m] = sn;
        {
          const int mm = scan_tok(b, d, n * 64 + m * 16 + fr);
          *(f32x4*)(Y + (size_t)mm * 256 + h * 64 + vt * 16 + 4 * fq) = y;
        }
      }
      X2_BAR();
    }
  }
}

struct NaPair { int mk0, mk1, tau0, tau1, kr0, kr1, ct0, ct1; };
struct NaFrag { bf16x8 k00, k01, k10, k11; bf16x4 v0[4], v1[4]; };

__device__ __forceinline__ void na_load(NaFrag& f, const bfr* KN, const bfr* VT, size_t vt_base, int h, int fr, int fq, const NaPair& pr) {
  const bfr* k0 = KN + (size_t)(pr.mk0 + fr) * 512 + h * 64 + fq * 8;
  const bfr* k1 = KN + (size_t)(pr.mk1 + fr) * 512 + h * 64 + fq * 8;
  f.k00 = *(const bf16x8*)(k0); f.k01 = *(const bf16x8*)(k0 + 32);
  f.k10 = *(const bf16x8*)(k1); f.k11 = *(const bf16x8*)(k1 + 32);
#pragma unroll
  for (int dt = 0; dt < 4; ++dt) {
    const int vo = (dt * 16 + fr) * 16 + fq * 4;
    f.v0[dt] = *(const bf16x4*)(VT + vt_base + (size_t)(pr.tau0 >> 4) * 1024 + vo);
    f.v1[dt] = *(const bf16x4*)(VT + vt_base + (size_t)(pr.tau1 >> 4) * 1024 + vo);
  }
}

__device__ __forceinline__ void na_compute(const NaFrag& f, const bf16x8 qf0, const bf16x8 qf1, bool local, bool vr0, bool vr1,
                                           int dr0, int dr1, int ct0, int ct1, int qc, int fq, const float* bias_h, f32x4 (&O)[4], float& lsum) {
  f32x4 z = {0.f, 0.f, 0.f, 0.f};
  f32x4 st0 = __builtin_amdgcn_mfma_f32_16x16x32_bf16(f.k00, qf0, z, 0, 0, 0);
  st0 = __builtin_amdgcn_mfma_f32_16x16x32_bf16(f.k01, qf1, st0, 0, 0, 0);
  f32x4 st1 = __builtin_amdgcn_mfma_f32_16x16x32_bf16(f.k10, qf0, z, 0, 0, 0);
  st1 = __builtin_amdgcn_mfma_f32_16x16x32_bf16(f.k11, qf1, st1, 0, 0, 0);
  bf16x8 pf;
  if (local) {
    const int cs = min(max(qc - 8, 0), 48);
#pragma unroll
    for (int r = 0; r < 4; ++r) {
      const int kc0 = ct0 * 16 + fq * 4 + r, kc1 = ct1 * 16 + fq * 4 + r;
      float p0 = 0.f, p1 = 0.f;
      if (vr0 && (unsigned)(kc0 - cs) < 16u) p0 = __builtin_amdgcn_exp2f(st0[r] + bias_h[dr0 * 31 + (kc0 - qc + 15)]);
      if (vr1 && (unsigned)(kc1 - cs) < 16u) p1 = __builtin_amdgcn_exp2f(st1[r] + bias_h[dr1 * 31 + (kc1 - qc + 15)]);
      lsum += p0 + p1;
      pf[r] = (short)f2bf(p0);
      pf[4 + r] = (short)f2bf(p1);
    }
  } else {
#pragma unroll
    for (int r = 0; r < 4; ++r) {
      const float p0 = __builtin_amdgcn_exp2f(st0[r]), p1 = __builtin_amdgcn_exp2f(st1[r]);
      lsum += p0 + p1;
      pf[r] = (short)f2bf(p0);
      pf[4 + r] = (short)f2bf(p1);
    }
  }
#pragma unroll
  for (int dt = 0; dt < 4; ++dt) {
    bf16x8 vf;
    vf[0] = f.v0[dt][0]; vf[1] = f.v0[dt][1]; vf[2] = f.v0[dt][2]; vf[3] = f.v0[dt][3];
    vf[4] = f.v1[dt][0]; vf[5] = f.v1[dt][1]; vf[6] = f.v1[dt][2]; vf[7] = f.v1[dt][3];
    O[dt] = __builtin_amdgcn_mfma_f32_16x16x32_bf16(vf, pf, O[dt], 0, 0, 0);
  }
}

__device__ __forceinline__ void na_block_task(PP pp, int task, const float* bias_lds) {
  const int tid = tid_opaque(), lane = tid & 63, wv = wave_id(tid);
  const int fr = lane & 15, fq = lane >> 4;
  char* S = p.ws + OFF_S;
  const bfr* QN = (const bfr*)(S + S_QN);
  const bfr* KN = (const bfr*)(S + S_KN);
  const bfr* VT = (const bfr*)(S + S_VT);
  bfr* CC = (bfr*)(p.ws + OFF_CC);
  const bool latent = task < 1024;
  int b, h, mqa, mqb, qra = 0, qrb = 0, cgp = 0;
  if (latent) {
    h = task & 7; const int quad = (task >> 3) & 63; b = task >> 9;
    qra = quad * 4 + (wv >> 2) * 2; qrb = qra + 1; cgp = wv & 3;
    mqa = b * SEQ + qra * 64 + cgp * 16; mqb = mqa + 64;
  } else {
    const int u = task - 1024;
    h = u & 7; b = u >> 3;
    mqa = NLAT + b * CTXL + (wv * 2) * 16; mqb = mqa + 16;
  }
  const bf16x8 qa0 = *(const bf16x8*)(QN + (size_t)(mqa + fr) * 512 + h * 64 + fq * 8);
  const bf16x8 qa1 = *(const bf16x8*)(QN + (size_t)(mqa + fr) * 512 + h * 64 + 32 + fq * 8);
  const bf16x8 qb0 = *(const bf16x8*)(QN + (size_t)(mqb + fr) * 512 + h * 64 + fq * 8);
  const bf16x8 qb1 = *(const bf16x8*)(QN + (size_t)(mqb + fr) * 512 + h * 64 + 32 + fq * 8);
  f32x4 Oa[4], Ob[4];
#pragma unroll
  for (int dt = 0; dt < 4; ++dt) { Oa[dt] = (f32x4){0.f, 0.f, 0.f, 0.f}; Ob[dt] = Oa[dt]; }
  float lsa = 0.f, lsb = 0.f;
  const size_t vt_base = (size_t)(b * 8 + h) * 64 * TTOK;
  const int rsa = min(max(qra - 4, 0), SEQ / 64 - 8), rsb = min(max(qrb - 4, 0), SEQ / 64 - 8);
  const int nrows = latent ? (rsb - rsa + 8) : 0;
  const int ct_first = (cgp <= 1) ? 0 : cgp - 1;
  const int nct = (cgp == 0 || cgp == 3) ? 2 : 3;
  const int ntile = nrows * nct;
  const int nlp = (ntile + 1) >> 1;
  const int npair = nlp + 8;
  const int qc = cgp * 16 + fr;
  auto mkpair = [&](int pi) {
    NaPair pr;
    if (pi < nlp) {
      const int i0 = 2 * pi, i1 = min(2 * pi + 1, ntile - 1);
      pr.kr0 = rsa + i0 / nct; pr.ct0 = ct_first + i0 % nct;
      pr.kr1 = rsa + i1 / nct; pr.ct1 = ct_first + i1 % nct;
      if (2 * pi + 1 >= ntile) pr.kr1 = -100;
      const int r1 = rsa + i1 / nct;
      pr.tau0 = pr.kr0 * 64 + pr.ct0 * 16; pr.tau1 = r1 * 64 + pr.ct1 * 16;
      pr.mk0 = b * SEQ + pr.tau0; pr.mk1 = b * SEQ + pr.tau1;
    } else {
      const int c = pi - nlp;
      pr.kr0 = pr.kr1 = pr.ct0 = pr.ct1 = 0;
      pr.tau0 = SEQ + c * 32; pr.tau1 = SEQ + c * 32 + 16;
      pr.mk0 = NLAT + b * CTXL + c * 32; pr.mk1 = pr.mk0 + 16;
    }
    return pr;
  };
  NaFrag fa, fb;
  NaPair pa = mkpair(0), pb;
  na_load(fa, KN, VT, vt_base, h, fr, fq, pa);
  const float* bias_h = bias_lds + h * 465;
#define NA_DO(F, PR, PI)                                                                                          \
  {                                                                                                               \
    const bool loc_ = (PI) < nlp;                                                                                 \
    na_compute(F, qa0, qa1, loc_, (unsigned)(PR.kr0 - rsa) < 8u, (unsigned)(PR.kr1 - rsa) < 8u,                   \
               PR.kr0 - qra + 7, PR.kr1 - qra + 7, PR.ct0, PR.ct1, qc, fq, bias_h, Oa, lsa);                      \
    na_compute(F, qb0, qb1, loc_, (unsigned)(PR.kr0 - rsb) < 8u, (unsigned)(PR.kr1 - rsb) < 8u,                   \
               PR.kr0 - qrb + 7, PR.kr1 - qrb + 7, PR.ct0, PR.ct1, qc, fq, bias_h, Ob, lsb);                      \
  }
  for (int pi = 0; pi < npair; pi += 2) {
    if (pi + 1 < npair) { pb = mkpair(pi + 1); na_load(fb, KN, VT, vt_base, h, fr, fq, pb); }
    NA_DO(fa, pa, pi)
    if (pi + 1 < npair) {
      if (pi + 2 < npair) { pa = mkpair(pi + 2); na_load(fa, KN, VT, vt_base, h, fr, fq, pa); }
      NA_DO(fb, pb, pi + 1)
    }
  }
#undef NA_DO
  lsa += shfl_xor_l(lsa, 16, lane); lsa += shfl_xor_l(lsa, 32, lane);
  lsb += shfl_xor_l(lsb, 16, lane); lsb += shfl_xor_l(lsb, 32, lane);
  const float ia = 1.f / lsa, ib = 1.f / lsb;
#pragma unroll
  for (int dt = 0; dt < 4; ++dt) {
    *(bf16x4*)(CC + (size_t)(mqa + fr) * 1024 + h * 64 + dt * 16 + fq * 4) = pack4(Oa[dt][0] * ia, Oa[dt][1] * ia, Oa[dt][2] * ia, Oa[dt][3] * ia);
    *(bf16x4*)(CC + (size_t)(mqb + fr) * 1024 + h * 64 + dt * 16 + fq * 4) = pack4(Ob[dt][0] * ib, Ob[dt][1] * ib, Ob[dt][2] * ib, Ob[dt][3] * ib);
  }
}

__device__ __forceinline__ void phase_mix(PP pp, int l, int bid, int nb, char* smem) {
  const int tid = tid_opaque();
  const int nscan_blocks = (nb > 32) ? 32 : nb;
  const int first_attn_block = (nb > 32) ? 32 : 0;
  if (bid < nscan_blocks) {
    for (int c = bid; c < NCHAIN; c += nscan_blocks) chunk_seq_chain(pp, c, smem);
  }
  if (bid >= first_attn_block) {
    float* bias = (float*)smem;
    __syncthreads();
    for (int i = tid; i < 8 * 465; i += NTHR) bias[i] = p.na_rpb[(size_t)l * 8 * 465 + i] * 1.4426950408889634f;
    __syncthreads();
    const int ntask = (l == 0) ? 1024 + 16 : 1024;
    const int nab = nb - first_attn_block;
    for (int t = bid - first_attn_block; t < ntask; t += nab) na_block_task(pp, t, bias);
    __syncthreads();
    phase_convert(pp, l, 1, bid - first_attn_block, nab, smem);
    if (l == 0) phase_convert(pp, 1, 0, bid - first_attn_block, nab, smem);
  }
}

__device__ __forceinline__ void phase_post(PP pp, int l, int bid, int nb) {
  const int tid = tid_opaque(), lane = tid & 63, wv = wave_id(tid);
  char* S = p.ws + OFF_S;
  const float* YRW = (const float*)(S + S_YRW);
  const float* YGD = (const float*)(S + S_YGD);
  const float* RWV = (const float*)(S + S_RWV);
  const float* RWG = (const float*)(S + S_RWG);
  const float* BON = (const float*)(S + S_BON);
  const float* P = (const float*)(p.ws + OFF_P);
  bfr* CC = (bfr*)(p.ws + OFF_CC);
  const float* ln_w = p.rw_ln_w + (size_t)l * 256;
  const float* ln_b = p.rw_ln_b + (size_t)l * 256;
  const float* ng = p.gd_norm_g + (size_t)l * 64;
  const int ntok = (l == 0) ? NTOK : NLAT;
  const int cb = lane * 4, hh = lane >> 4;
  const f32x4 lw4 = *(const f32x4*)(ln_w + cb), lb4 = *(const f32x4*)(ln_b + cb), ng4 = *(const f32x4*)(ng + (cb & 63));
  for (int m = bid * 8 + wv; m < ntok; m += nb * 8) {
    const size_t o = (size_t)m * 256 + cb;
    const f32x4 y0 = *(const f32x4*)(YRW + o), y1 = *(const f32x4*)(YRW + (size_t)NTOK * 256 + o);
    const f32x4 rv = *(const f32x4*)(RWV + o), rg = *(const f32x4*)(RWG + o);
    const f32x4 g0 = *(const f32x4*)(YGD + o), g1 = *(const f32x4*)(YGD + (size_t)NTOK * 256 + o);
    const f32x4 z = *(const f32x4*)(P + (size_t)m * PINP + B_END + 768 + cb);
    const float bon = BON[(size_t)m * 4 + hh];
    {
      const f32x4 y = y0 + y1;
      const float mean = row16_sum((y[0] + y[1]) + (y[2] + y[3])) * (1.f / 64.f);
      const f32x4 dv = y - mean;
      const float var = row16_sum((dv[0] * dv[0] + dv[1] * dv[1]) + (dv[2] * dv[2] + dv[3] * dv[3])) * (1.f / 64.f);
      const f32x4 out = ((dv * rsqrtf(var + 64e-5f)) * lw4 + lb4 + rv * bon) * rg;
      *(bf16x4*)(CC + (size_t)m * 1024 + 512 + cb) = pack4(out[0], out[1], out[2], out[3]);
    }
    {
      const f32x4 y = g0 + g1;
      const float ms = row16_sum((y[0] * y[0] + y[1] * y[1]) + (y[2] * y[2] + y[3] * y[3])) * (1.f / 64.f);
      const f32x4 sz = {siluf_(z[0]), siluf_(z[1]), siluf_(z[2]), siluf_(z[3])};
      const f32x4 out = (y * rsqrtf(ms + 1e-6f)) * ng4 * sz;
      *(bf16x4*)(CC + (size_t)m * 1024 + 768 + cb) = pack4(out[0], out[1], out[2], out[3]);
    }
  }
}

#define RW_LDS_ROW 36
__device__ __forceinline__ void phase_router(PP pp, int l, int bid, int nb, char* smem) {
  const int tid = tid_opaque(), lane = tid & 63, wv = wave_id(tid);
  const float* xl = p.out;
  const float* xc = (const float*)(p.ws + OFF_CTX);
  const float* mods = (const float*)(p.ws + OFF_MODS) + (size_t)l * 3 * 6144;
  const float* g = p.norm_ffn_g + (size_t)l * 1024;
  const float* rw = p.moe_router_w + (size_t)l * 1024 * 32;
  const float* rb = p.moe_router_b + (size_t)l * 32;
  bfr* H = (bfr*)(p.ws + OFF_H);
  int* cnt = (int*)(p.ws + OFF_CNT);
  int* TOKE = (int*)(p.ws + OFF_TOKE);
  int* TOKP = (int*)(p.ws + OFF_TOKP);
  float* TOKG = (float*)(p.ws + OFF_TOKG);
  float* wl = (float*)smem;
  for (int i = tid; i < 1024 * 8; i += NTHR) {
    int d = i >> 3, q = i & 7;
    *(float4*)(wl + d * RW_LDS_ROW + q * 4) = *(const float4*)(rw + (size_t)d * 32 + q * 4);
  }
  __syncthreads();
  const int ntok = (l == 0) ? NTOK : NLAT;
  const float rbl = rb[lane & 31];
  for (int m0 = (bid * 8 + wv) * 2; m0 < ntok; m0 += nb * 16) {
    float acc0[32], acc1[32];
#pragma unroll
    for (int e = 0; e < 32; ++e) { acc0[e] = 0.f; acc1[e] = 0.f; }
    float hv0[16], hv1[16];
    {
      const int ma = m0, mb = m0 + 1;
      const float* xa = (ma < NLAT) ? xl + (size_t)ma * 1024 : xc + (size_t)(ma - NLAT) * 1024;
      const float* xb = (mb < NLAT) ? xl + (size_t)mb * 1024 : xc + (size_t)(mb - NLAT) * 1024;
      const float* mda = mods + (size_t)mod_row(ma) * 6144 + 3072;
      const float* mdb = mods + (size_t)mod_row(mb) * 6144 + 3072;
      float ssa = 0.f, ssb = 0.f;
#pragma unroll
      for (int i = 0; i < 16; ++i) { hv0[i] = xa[lane + 64 * i]; hv1[i] = xb[lane + 64 * i]; }
#pragma unroll
      for (int i = 0; i < 16; ++i) { ssa += hv0[i] * hv0[i]; ssb += hv1[i] * hv1[i]; }
      ssa = wave_sum(ssa); ssb = wave_sum(ssb);
      const float rsa = rsqrtf(ssa * (1.f / 1024.f) + 1e-6f), rsb = rsqrtf(ssb * (1.f / 1024.f) + 1e-6f);
#pragma unroll
      for (int i = 0; i < 16; ++i) {
        const int d = lane + 64 * i;
        const float gg = g[d];
        hv0[i] = hv0[i] * rsa * gg * (1.f + mda[1024 + d]) + mda[d];
        hv1[i] = hv1[i] * rsb * gg * (1.f + mdb[1024 + d]) + mdb[d];
      }
      float am0 = 0.f, am1 = 0.f;
#pragma unroll
      for (int i = 0; i < 16; ++i) { am0 = fmaxf(am0, fabsf(hv0[i])); am1 = fmaxf(am1, fabsf(hv1[i])); }
      am0 = wave_max(am0); am1 = wave_max(am1);
      const float sc0 = am0 > 0.f ? am0 * (1.f / 127.f) : 1.f, sc1 = am1 > 0.f ? am1 * (1.f / 127.f) : 1.f;
      const float iv0 = 1.f / sc0, iv1 = 1.f / sc1;
      signed char* H8 = (signed char*)(p.ws + OFF_H);
#pragma unroll
      for (int i = 0; i < 16; ++i) {
        const int d = lane + 64 * i;
        H8[(size_t)ma * 1024 + d] = (signed char)(int)fminf(fmaxf(rintf(hv0[i] * iv0), -127.f), 127.f);
        H8[(size_t)mb * 1024 + d] = (signed char)(int)fminf(fmaxf(rintf(hv1[i] * iv1), -127.f), 127.f);
      }
      if (lane == 0) { float* SCL = (float*)(p.ws + OFF_SCL); SCL[ma] = sc0; SCL[mb] = sc1; }
      asm volatile("" ::: "memory");
    }
#pragma unroll
    for (int i = 0; i < 16; ++i) {
      if ((i & 3) == 0) asm volatile("" ::: "memory");
      const float* wr = wl + (lane + 64 * i) * RW_LDS_ROW;
#pragma unroll
      for (int q = 0; q < 8; ++q) {
        const float4 w = *(const float4*)(wr + q * 4);
        acc0[q * 4 + 0] += hv0[i] * w.x; acc0[q * 4 + 1] += hv0[i] * w.y; acc0[q * 4 + 2] += hv0[i] * w.z; acc0[q * 4 + 3] += hv0[i] * w.w;
        acc1[q * 4 + 0] += hv1[i] * w.x; acc1[q * 4 + 1] += hv1[i] * w.y; acc1[q * 4 + 2] += hv1[i] * w.z; acc1[q * 4 + 3] += hv1[i] * w.w;
      }
    }
#define BFLY(A, N, D)                                                                           \
    _Pragma("unroll") for (int i = 0; i < (N); ++i) {                                            \
      const bool up = (lane & (D)) != 0;                                                         \
      const float keep = up ? A[i + (N)] : A[i];                                                 \
      const float send = up ? A[i] : A[i + (N)];                                                 \
      A[i] = keep + shfl_xor_l(send, (D), lane);                                                   \
    }
    BFLY(acc0, 16, 16) BFLY(acc1, 16, 16)
    BFLY(acc0, 8, 8) BFLY(acc1, 8, 8)
    BFLY(acc0, 4, 4) BFLY(acc1, 4, 4)
    BFLY(acc0, 2, 2) BFLY(acc1, 2, 2)
    BFLY(acc0, 1, 1) BFLY(acc1, 1, 1)
#undef BFLY
    float la = acc0[0] + shfl_xor_l(acc0[0], 32, lane);
    float lb = acc1[0] + shfl_xor_l(acc1[0], 32, lane);
    const int my_e = lane & 31;
    la += rbl; lb += rbl;
    (void)my_e;
#pragma unroll
    for (int tkn = 0; tkn < 2; ++tkn) {
      float v = tkn == 0 ? la : lb;
      float tv[4]; int ti[4];
#pragma unroll
      for (int k = 0; k < 4; ++k) {
        float bv = v; int bi = lane & 31;
#pragma unroll
        for (int o = 16; o >= 1; o >>= 1) {
          float ov = shfl_xor_l(bv, o, lane); int oi = shfl_xor_li(bi, o, lane);
          bool take = (ov > bv) || (ov == bv && oi < bi);
          bv = take ? ov : bv; bi = take ? oi : bi;
        }
        tv[k] = bv; ti[k] = bi;
        if ((lane & 31) == bi) v = -3.0e38f;
      }
      float e1 = __expf(tv[1] - tv[0]), e2 = __expf(tv[2] - tv[0]), e3 = __expf(tv[3] - tv[0]);
      float inv = 1.f / (1.f + e1 + e2 + e3);
      const int m = m0 + tkn;
      if (lane < 4) {
        int e = lane == 0 ? ti[0] : lane == 1 ? ti[1] : lane == 2 ? ti[2] : ti[3];
        float gt = (lane == 0 ? 1.f : lane == 1 ? e1 : lane == 2 ? e2 : e3) * inv;
        int pos = atomicAdd(&cnt[e], 1);
        TOKE[(size_t)m * 4 + lane] = e; TOKP[(size_t)m * 4 + lane] = pos; TOKG[(size_t)m * 4 + lane] = gt;
      }
    }
  }
  __syncthreads();
}

__device__ __forceinline__ void moe_offsets(PP pp, int* toff) {
  const int* cnt = (const int*)(p.ws + OFF_CNT);
  if (tid_opaque() == 0) {
    int a = 0;
    for (int e = 0; e < 32; ++e) { toff[e] = a; a += (cnt[e] + 255) >> 8; }
    toff[32] = a;
  }
  __syncthreads();
}
__device__ __forceinline__ void moe_tile_experts(int* toff) {
  int* texp = toff + 128;
  const int ntile = toff[32];
  for (int mt = tid_opaque(); mt < ntile; mt += NTHR) {
    int e = 0;
#pragma unroll 1
    for (int k = 1; k < 32; ++k) e = (mt >= toff[k]) ? k : e;
    texp[mt] = e;
  }
  __syncthreads();
}

__device__ __forceinline__ void phase_slotfill(PP pp, int l, int bid, int nb, char* smem) {
  int* toff = (int*)smem;
  moe_offsets(pp, toff);
  const int tid = tid_opaque(), lane = tid & 63, wv = wave_id(tid);
  const int* TOKE = (const int*)(p.ws + OFF_TOKE);
  const int* TOKP = (const int*)(p.ws + OFF_TOKP);
  const float* TOKG = (const float*)(p.ws + OFF_TOKG);
  const int* cnt = (const int*)(p.ws + OFF_CNT);
  int* TOKS = (int*)(p.ws + OFF_TOKS);
  float* SLG = (float*)(p.ws + OFF_SLG);
  float* SLS = (float*)(p.ws + OFF_SLS);
  const float* SCL = (const float*)(p.ws + OFF_SCL);
  const signed char* H8 = (const signed char*)(p.ws + OFF_H);
  signed char* XG = (signed char*)(p.ws + OFF_S);
  const int n = ((l == 0) ? NTOK : NLAT) * 4;
  for (int i0 = (bid * 8 + wv) * 4; i0 < n; i0 += nb * 32) {
    const int tok = i0 >> 2;
    int sl4[4];
#pragma unroll
    for (int k = 0; k < 4; ++k) sl4[k] = toff[TOKE[i0 + k]] * 256 + TOKP[i0 + k];
    const uint4 row = *((const uint4*)(H8 + (size_t)tok * 1024) + lane);
    const float scl = SCL[tok];
    float g4[4];
#pragma unroll
    for (int k = 0; k < 4; ++k) g4[k] = TOKG[i0 + k];
#pragma unroll
    for (int k = 0; k < 4; ++k) {
      if (lane == 0) { TOKS[i0 + k] = sl4[k]; SLG[sl4[k]] = g4[k]; SLS[sl4[k]] = scl; }
      *((uint4*)(XG + (size_t)sl4[k] * 1024) + lane) = row;
    }
  }
  for (int e = 0; e < 32; ++e) {
    const int c = cnt[e];
    const int npad = ((c + 255) & ~255) - c;
    const int base = toff[e] * 256 + c;
    for (int r = bid * 8 + wv; r < npad; r += nb * 8) {
      uint4* dst = (uint4*)(XG + (size_t)(base + r) * 1024);
      dst[lane] = make_uint4(0u, 0u, 0u, 0u);
      if (lane == 0) SLS[base + r] = 0.f;
    }
  }
  __syncthreads();
}

struct EpiMoe1 {
  const float* bgu; const float* sw; const float* SLS; bfr* ACT;
  __device__ __forceinline__ void operator()(const i32x4 (&acc)[2][2][4][2], const g8::GUnit& u, int wr, int wc, int fr, int fq) const {
    const float* be = bgu + (size_t)u.e * 2048;
    const float* se = sw + (size_t)u.e * 2048;
    const int slot0 = u.pm * 256 + wr * 64 + fr;
    float sav[2][4];
#pragma unroll
    for (int ai = 0; ai < 2; ++ai)
#pragma unroll
      for (int m = 0; m < 4; ++m) sav[ai][m] = SLS[slot0 + ai * 128 + m * 16];
    f32x4 bgv[2], blv[2], sgv[2], slv[2];
#pragma unroll
    for (int bj = 0; bj < 2; ++bj) {
      const int j0 = u.pn * 128 + bj * 64 + wc * 16 + 4 * fq;
      bgv[bj] = *(const f32x4*)(be + j0); blv[bj] = *(const f32x4*)(be + 1024 + j0);
      sgv[bj] = *(const f32x4*)(se + j0); slv[bj] = *(const f32x4*)(se + 1024 + j0);
    }
#pragma unroll
    for (int bj = 0; bj < 2; ++bj) {
      const int j0 = u.pn * 128 + bj * 64 + wc * 16 + 4 * fq;
      const f32x4 bg = bgv[bj], bl = blv[bj];
      const f32x4 sg = sgv[bj], sl = slv[bj];
#pragma unroll
      for (int ai = 0; ai < 2; ++ai)
#pragma unroll
        for (int m = 0; m < 4; ++m) {
          const int slot = slot0 + ai * 128 + m * 16;
          const float sa = sav[ai][m];
          bf16x4 o;
#pragma unroll
          for (int q = 0; q < 4; ++q) {
            const float g = (float)acc[ai][bj][m][0][q] * (sa * sg[q]) + bg[q];
            const float li = (float)acc[ai][bj][m][1][q] * (sa * sl[q]) + bl[q];
            const float gv = fminf(g, 7.f);
            const float lv = fminf(fmaxf(li, -7.f), 7.f);
            o[q] = (short)f2bf(gv * sigmoidf_(1.702f * gv) * (lv + 1.f));
          }
          *(bf16x4*)(ACT + (size_t)slot * 1024 + j0) = o;
        }
    }
  }
};
__device__ __forceinline__ void phase_moe1_impl(PP pp, int l, int bid, int nb, char* smem, int* toff) {
  moe_offsets(pp, toff);
  moe_tile_experts(toff);
  g8::MoeSched S{toff, 8, 2048, nb, bid};
  EpiMoe1 E{p.moe_b_gu + (size_t)l * 32 * 2048, (const float*)(p.ws + OFF_SW) + (size_t)l * 32 * 2048, (const float*)(p.ws + OFF_SLS), (bfr*)(p.ws + OFF_P)};
  g8::gemm_stream<true>((LAS unsigned char*)smem, p.ws + OFF_S, p.ws + OFF_W + (size_t)l * WL_SIZE + WL_GU, S, E);
}

struct EpiMoe2 {
  const float* bdn; const float* SLG; bfr* YS;
  __device__ __forceinline__ void operator()(const f32x4 (&acc)[2][2][4][2], const g8::GUnit& u, int wr, int wc, int fr, int fq) const {
    const float* be = bdn + (size_t)u.e * 1024;
    const int slot0 = u.pm * 256 + wr * 64 + fr, col0 = u.pn * 256 + wc * 32 + 4 * fq;
    float gtv[2][4];
#pragma unroll
    for (int ai = 0; ai < 2; ++ai)
#pragma unroll
      for (int m = 0; m < 4; ++m) gtv[ai][m] = SLG[slot0 + ai * 128 + m * 16];
    f32x4 bvv[2][2];
#pragma unroll
    for (int bj = 0; bj < 2; ++bj)
#pragma unroll
      for (int n = 0; n < 2; ++n) bvv[bj][n] = *(const f32x4*)(be + col0 + bj * 128 + n * 16);
#pragma unroll
    for (int ai = 0; ai < 2; ++ai)
#pragma unroll
      for (int m = 0; m < 4; ++m) {
        const int slot = slot0 + ai * 128 + m * 16;
        const float gt = gtv[ai][m];
#pragma unroll
        for (int bj = 0; bj < 2; ++bj)
#pragma unroll
          for (int n = 0; n < 2; ++n) {
            const f32x4 bv = bvv[bj][n];
            const f32x4 yv = (acc[ai][bj][m][n] + bv) * gt;
            *(bf16x4*)(YS + (size_t)slot * 1024 + col0 + bj * 128 + n * 16) = pack4(yv[0], yv[1], yv[2], yv[3]);
          }
      }
  }
};
__device__ __forceinline__ void phase_moe2_impl(PP pp, int l, int bid, int nb, char* smem, int* toff) {
  moe_offsets(pp, toff);
  moe_tile_experts(toff);
  g8::MoeSched S{toff, 4, 1024, nb, bid};
  EpiMoe2 E{p.moe_b_down + (size_t)l * 32 * 1024, (const float*)(p.ws + OFF_SLG), (bfr*)(p.ws + OFF_S)};
  g8::gemm_stream<false>((LAS unsigned char*)smem, p.ws + OFF_P, p.ws + OFF_W + (size_t)l * WL_SIZE + WL_DN, S, E);
}

__device__ __forceinline__ void phase_combine(PP pp, int l, int bid, int nb) {
  const int tid = tid_opaque(), lane = tid & 63, wv = wave_id(tid);
  const bfr* YS = (const bfr*)(p.ws + OFF_S);
  const int* TOKS = (const int*)(p.ws + OFF_TOKS);
  const float* mods = (const float*)(p.ws + OFF_MODS) + (size_t)l * 3 * 6144;
  const float* mods1 = (const float*)(p.ws + OFF_MODS) + (size_t)3 * 6144;
  const float* g1n = p.norm_mix_g + 1024;
  bfr* H = (bfr*)(p.ws + OFF_H);
  float* xl = p.out;
  float* xc = (float*)(p.ws + OFF_CTX);
  const int ntok = (l == 0) ? NTOK : NLAT;
  if (l == 0) {
    int* cnt = (int*)(p.ws + OFF_CNT);
    const int gt = bid * NTHR + tid;
    if (gt < 32) cnt[gt] = 0;
  }
  for (int m = bid * 8 + wv; m < ntok; m += nb * 8) {
    float* xr = (m < NLAT) ? xl + (size_t)m * 1024 : xc + (size_t)(m - NLAT) * 1024;
    const float* g2 = mods + (size_t)mod_row(m) * 6144 + 5120;
    const int s0 = TOKS[(size_t)m * 4], s1 = TOKS[(size_t)m * 4 + 1], s2 = TOKS[(size_t)m * 4 + 2], s3 = TOKS[(size_t)m * 4 + 3];
    float4 xn[4];
    float ss = 0.f;
#pragma unroll
    for (int i = 0; i < 4; ++i) {
      const int d = (lane + 64 * i) * 4;
      const bf16x4 a = *(const bf16x4*)(YS + (size_t)s0 * 1024 + d);
      const bf16x4 b = *(const bf16x4*)(YS + (size_t)s1 * 1024 + d);
      const bf16x4 c = *(const bf16x4*)(YS + (size_t)s2 * 1024 + d);
      const bf16x4 e = *(const bf16x4*)(YS + (size_t)s3 * 1024 + d);
      const float4 gg = *(const float4*)(g2 + d);
      float4 xv = *(const float4*)(xr + d);
      xv.x += gg.x * ((bf2f(a[0]) + bf2f(b[0])) + (bf2f(c[0]) + bf2f(e[0])));
      xv.y += gg.y * ((bf2f(a[1]) + bf2f(b[1])) + (bf2f(c[1]) + bf2f(e[1])));
      xv.z += gg.z * ((bf2f(a[2]) + bf2f(b[2])) + (bf2f(c[2]) + bf2f(e[2])));
      xv.w += gg.w * ((bf2f(a[3]) + bf2f(b[3])) + (bf2f(c[3]) + bf2f(e[3])));
      *(float4*)(xr + d) = xv;
      xn[i] = xv;
      ss += xv.x * xv.x + xv.y * xv.y + xv.z * xv.z + xv.w * xv.w;
    }
    if (l == 0) {
      ss = wave_sum(ss);
      const float rs = rsqrtf(ss * (1.f / 1024.f) + 1e-6f);
      const float* md = mods1 + (size_t)mod_row(m) * 6144;
      float4 hq[4];
#pragma unroll
      for (int i = 0; i < 4; ++i) {
        const int d = (lane + 64 * i) * 4;
        const float4 gg = *(const float4*)(g1n + d);
        const float4 sh = *(const float4*)(md + d);
        const float4 sc = *(const float4*)(md + 1024 + d);
        hq[i] = make_float4(xn[i].x * rs * gg.x * (1.f + sc.x) + sh.x, xn[i].y * rs * gg.y * (1.f + sc.y) + sh.y,
                            xn[i].z * rs * gg.z * (1.f + sc.z) + sh.z, xn[i].w * rs * gg.w * (1.f + sc.w) + sh.w);
      }
      const float qs = quant_row_store(hq, (signed char*)(p.ws + OFF_H) + (size_t)m * 1024, lane);
      if (lane == 0) ((float*)(p.ws + OFF_SCL))[m] = qs;
    }
  }
}

#define XB_TMO      128
#define XB_XCNT(j)  (256  + 64 * (j))
#define XB_XSUB(j)  (1280 + 64 * (j))
#define XB_XGEN(j)  (2304 + 64 * (j))
#define XB_TOP      3328
#define XB_TOPGEN   3392
#define XCD_BAR_WORDS 3456
#define XB_SPIN_CAP (1u << 22)
__device__ __forceinline__ unsigned xb_ld(unsigned* q) { return __hip_atomic_load(q, __ATOMIC_RELAXED, __HIP_MEMORY_SCOPE_AGENT); }
__device__ __forceinline__ unsigned xb_add(unsigned* q, unsigned v) { return __hip_atomic_fetch_add(q, v, __ATOMIC_RELAXED, __HIP_MEMORY_SCOPE_AGENT); }
__device__ __forceinline__ unsigned xb_xcc_id() { return (unsigned)__builtin_amdgcn_s_getreg((3 << 11) | 20) & 0xFu; }
#define XB_SPIN(cond, bar) do { unsigned _sp = 0; while (cond) { __builtin_amdgcn_s_sleep(1); \
    if ((++_sp & 255u) == 0u) { if (xb_ld(&(bar)[XB_TMO])) break; if (_sp > XB_SPIN_CAP) { atomicAdd(&(bar)[XB_TMO], 1u); break; } } } } while (0)
struct XcdBarrier { unsigned* bar; unsigned x; volatile LAS unsigned* st; };
__device__ __forceinline__ XcdBarrier xcd_barrier_post(unsigned* bar, volatile LAS unsigned* st) {
  XcdBarrier b; b.bar = bar; b.x = xb_xcc_id(); b.st = st;
  if (tid_opaque() == 0) (void)xb_add(&bar[XB_XCNT(b.x)], 1u);
  return b;
}
__device__ __forceinline__ void xcd_barrier_complete(unsigned* bar, unsigned x, unsigned& nloc, unsigned& nx) {
  const unsigned G = gridDim.x;
  unsigned sum, cnt, mine, sp = 0u;
  for (;;) {
    sum = 0u; cnt = 0u; mine = 0u;
#pragma unroll
    for (unsigned j = 0; j < 16; ++j) { const unsigned c = xb_ld(&bar[XB_XCNT(j)]); sum += c; cnt += (c > 0u) ? 1u : 0u; mine = (j == x) ? c : mine; }
    if (sum == G) break;
    __builtin_amdgcn_s_sleep(1);
    if ((++sp & 255u) == 0u) { if (xb_ld(&bar[XB_TMO])) break; if (sp > XB_SPIN_CAP) { atomicAdd(&bar[XB_TMO], 1u); break; } }
  }
  nloc = mine > 0u ? mine : 1u; nx = cnt > 0u ? cnt : 1u;
}
__device__ __forceinline__ void xcd_barrier(const XcdBarrier& b) {
  asm volatile("s_waitcnt vmcnt(0)" ::: "memory");
  __syncthreads();
  if (tid_opaque() == 0) {
    unsigned* bar = b.bar;
    __builtin_amdgcn_s_waitcnt(0);
    unsigned nloc = b.st[0], nx = b.st[1];
    if (nloc == 0u) { xcd_barrier_complete(bar, b.x, nloc, nx); b.st[0] = nloc; b.st[1] = nx; }
    const unsigned old = xb_add(&bar[XB_XSUB(b.x)], 1u);
    const unsigned gen = old / nloc;
    if (old + 1u == (gen + 1u) * nloc) {
      __builtin_amdgcn_fence(__ATOMIC_RELEASE, "agent");
      asm volatile("s_waitcnt vmcnt(0)" ::: "memory");
      const unsigned og = xb_add(&bar[XB_TOP], 1u);
      const unsigned tg = og / nx;
      if (og + 1u == (tg + 1u) * nx) xb_add(&bar[XB_TOPGEN], 1u);
      else XB_SPIN(xb_ld(&bar[XB_TOPGEN]) == tg, bar);
      __builtin_amdgcn_fence(__ATOMIC_ACQUIRE, "agent");
      xb_add(&bar[XB_XGEN(b.x)], 1u);
      asm volatile("s_waitcnt vmcnt(0)" ::: "memory");
    } else {
      XB_SPIN(xb_ld(&bar[XB_XGEN(b.x)]) == gen, bar);
      __builtin_amdgcn_fence(__ATOMIC_ACQUIRE, "agent");
      asm volatile("s_waitcnt vmcnt(0)" ::: "memory");
    }
  }
  __syncthreads();
}

extern __shared__ __attribute__((aligned(16))) char dyn_smem[];

__global__ void __launch_bounds__(NTHR) mega(Params p_unused) {
  cg::grid_group grid = cg::this_grid();
  const int bid0 = blockIdx.x, nb0 = gridDim.x;
#if defined(__HIP_DEVICE_COMPILE__)
  PP pp0 = (PP)__builtin_amdgcn_kernarg_segment_ptr();
#else
  PP pp0 = nullptr;
#endif
#define pp ({ PP q_ = pp0; asm volatile("" : "+s"(q_)); q_; })
#define bid opq(bid0)
#define nb opq(nb0)
  int* toff_s = (int*)(dyn_smem + 147456);
  volatile LAS unsigned* xb_st = (volatile LAS unsigned*)(dyn_smem + 147456 + 256);
  {
    unsigned* barw = (unsigned*)(fresh_ws(pp0) + OFF_BAR);
    if (blockIdx.x == 0) for (int i = threadIdx.x; i < XCD_BAR_WORDS; i += NTHR) barw[i] = 0u;
    if (threadIdx.x == 0) { xb_st[0] = 0u; xb_st[1] = 0u; }
  }
  grid.sync();
  const XcdBarrier xb = xcd_barrier_post((unsigned*)(fresh_ws(pp0) + OFF_BAR), xb_st);
#define GSYNC() xcd_barrier(xb)
  phase_ada(pp, bid, nb, dyn_smem);
  phase_convert(pp, 0, 0, bid, nb, dyn_smem);
  GSYNC();
#define LAYER(LV, LAST)                                      \
  {                                                          \
    if ((LV) == 0) { phase_prenorm(pp, opq(LV), bid, nb); GSYNC(); } \
    phase_gemm_in(pp, opq(LV), bid, nb, dyn_smem);           \
    GSYNC();                                                 \
    phase_prep(pp, opq(LV), bid, nb, dyn_smem);              \
    GSYNC();                                                 \
    phase_chunk_prep(pp, bid, nb, dyn_smem);                 \
    GSYNC();                                                 \
    phase_mix(pp, opq(LV), bid, nb, dyn_smem);               \
    GSYNC();                                                 \
    phase_post(pp, opq(LV), bid, nb);                        \
    GSYNC();                                                 \
    phase_gemm_out(pp, opq(LV), bid, nb, dyn_smem);          \
    GSYNC();                                                 \
    phase_router(pp, opq(LV), bid, nb, dyn_smem);            \
    GSYNC();                                                 \
    phase_slotfill(pp, opq(LV), bid, nb, dyn_smem);          \
    GSYNC();                                                 \
    phase_moe1_impl(pp, opq(LV), bid, nb, dyn_smem, toff_s); \
    GSYNC();                                                 \
    phase_moe2_impl(pp, opq(LV), bid, nb, dyn_smem, toff_s); \
    GSYNC();                                                 \
    phase_combine(pp, opq(LV), bid, nb);                     \
    if (!(LAST)) GSYNC();                                    \
  }
  LAYER(0, false)
  LAYER(1, true)
#undef LAYER
#undef GSYNC
#undef bid
#undef nb
#undef pp
}

#undef p
extern "C" void kernel_launch(void* const* d_in, const int* in_sizes, int n_in, void* d_out, int out_size, void* d_ws,
                              size_t ws_size, hipStream_t stream) {
  Params hp{};
  const float** pp = (const float**)&hp;
  for (int i = 0; i < 34; ++i) pp[i] = (const float*)d_in[i];
  hp.out = (float*)d_out;
  hp.ws = (char*)d_ws;
  static int grid_blocks = 0;
  if (!grid_blocks) {
    (void)hipFuncSetAttribute((const void*)mega, hipFuncAttributeMaxDynamicSharedMemorySize, LDS_BYTES);
    int dev = 0, cus = 0, per_cu = 0;
    (void)hipGetDevice(&dev);
    (void)hipDeviceGetAttribute(&cus, hipDeviceAttributeMultiprocessorCount, dev);
    (void)hipOccupancyMaxActiveBlocksPerMultiprocessor(&per_cu, mega, NTHR, LDS_BYTES);
    if (per_cu < 1) per_cu = 1;
    if (per_cu > 1) per_cu = 1;
    grid_blocks = cus * per_cu;
  }
  void* args[] = {&hp};
  (void)hipLaunchCooperativeKernel((void*)mega, dim3(grid_blocks), dim3(NTHR), args, LDS_BYTES, stream);
}
```

```cpp
#include <hip/hip_runtime.h>
#include <hip/hip_bf16.h>
#include <hip/hip_cooperative_groups.h>
#include <stdint.h>
#include <type_traits>
namespace cg = cooperative_groups;

typedef __attribute__((ext_vector_type(8))) short bf16x8;
typedef __attribute__((ext_vector_type(4))) short bf16x4;
typedef __attribute__((ext_vector_type(4))) float f32x4;
typedef __attribute__((ext_vector_type(4))) int i32x4;
typedef unsigned short bfr;

#define D_MODEL 1024
#define NB 2
#define SEQ 16384
#define CTXL 256
#define NLAT (NB * SEQ)
#define NCTX (NB * CTXL)
#define NTOK (NLAT + NCTX)
#define TTOK (SEQ + CTXL)
#define PIN 3472
#define PINP 3584
#define A_END 1536
#define B_END 2432
#define NEXP 32
#define NSLOT_MAX (NTOK * 4 + NEXP * 256)
#define NTHR 512
#define LDS_BYTES (147456 + 3072)

constexpr size_t al256(size_t x) { return (x + 255) & ~(size_t)255; }
constexpr size_t WL_IN = 0;
constexpr size_t WL_OUT = WL_IN + (size_t)PINP * 1024 * 2;
constexpr size_t WL_GU = WL_OUT + (size_t)1024 * 1024 * 2;
constexpr size_t WL_DN = WL_GU + (size_t)32 * 2048 * 1024 * 2;
constexpr size_t WL_SIZE = WL_DN + (size_t)32 * 1024 * 1024 * 2;
constexpr size_t OFF_W = 0;
constexpr size_t OFF_MODS = al256(OFF_W + 2 * WL_SIZE);
constexpr size_t OFF_BAR = al256(OFF_MODS + 2 * 3 * 6144 * 4);
constexpr size_t OFF_SW = al256(OFF_BAR + 3456 * 4);
constexpr size_t OFF_SWIN = al256(OFF_SW + (size_t)2 * 32 * 2048 * 4);
constexpr size_t OFF_SLS = al256(OFF_SWIN + (size_t)2 * PINP * 4);
constexpr size_t OFF_SCL = al256(OFF_SLS + (size_t)(NTOK * 4 + 32 * 256) * 4);
constexpr size_t OFF_CTX = al256(OFF_SCL + (size_t)NTOK * 4);
constexpr size_t OFF_CNT = al256(OFF_CTX + (size_t)NCTX * 1024 * 4);
constexpr size_t OFF_TOKE = al256(OFF_CNT + 256);
constexpr size_t OFF_TOKP = al256(OFF_TOKE + (size_t)NTOK * 4 * 4);
constexpr size_t OFF_TOKG = al256(OFF_TOKP + (size_t)NTOK * 4 * 4);
constexpr size_t OFF_TOKS = al256(OFF_TOKG + (size_t)NTOK * 4 * 4);
constexpr size_t OFF_SLT = al256(OFF_TOKS + (size_t)NTOK * 4 * 4);
constexpr size_t OFF_SLG = al256(OFF_SLT + (size_t)NSLOT_MAX * 4);
constexpr size_t OFF_H = al256(OFF_SLG + (size_t)NSLOT_MAX * 4);
constexpr size_t OFF_CC = al256(OFF_H + (size_t)NTOK * 1024 * 2);
constexpr size_t OFF_P = al256(OFF_CC + (size_t)NTOK * 1024 * 2);
constexpr size_t OFF_S = al256(OFF_P + (size_t)NTOK * PINP * 4);
constexpr size_t TOK256F = (size_t)NTOK * 256 * 4;
constexpr size_t S_QN = 0;
constexpr size_t S_KN = S_QN + (size_t)NTOK * 512 * 2;
constexpr size_t S_VT = S_KN + (size_t)NTOK * 512 * 2;
constexpr size_t S_RWR = S_VT + (size_t)NB * 8 * 64 * TTOK * 2;
constexpr size_t S_RWKK = S_RWR + TOK256F;
constexpr size_t S_RWV = S_RWKK + TOK256F;
constexpr size_t S_RWG = S_RWV + TOK256F;
constexpr size_t S_RWW = S_RWG + TOK256F;
constexpr size_t S_RWKD = S_RWW + 2 * TOK256F;
constexpr size_t S_RWB = S_RWKD + 2 * TOK256F;
constexpr size_t S_BON = S_RWB + 2 * TOK256F;
constexpr size_t S_GDQ = al256(S_BON + (size_t)NTOK * 4 * 4);
constexpr size_t S_GDK = S_GDQ + TOK256F;
constexpr size_t S_GDV = S_GDK + TOK256F;
constexpr size_t S_GDAB = S_GDV + TOK256F;
constexpr size_t S_YRW = al256(S_GDAB + (size_t)NTOK * 16 * 4);
constexpr size_t S_YGD = S_YRW + 2 * TOK256F;
constexpr size_t S_END = S_YGD + 2 * TOK256F;
constexpr size_t S_SIZE = (S_END > (size_t)NSLOT_MAX * 1024 * 4) ? S_END : (size_t)NSLOT_MAX * 1024 * 4;
constexpr int NCHUNK = TTOK / 64;
constexpr int NCHAIN = 32;
constexpr size_t OFF_CH = al256(OFF_S + S_SIZE);
constexpr size_t CH_N = (size_t)NCHAIN * NCHUNK;
constexpr size_t CH_REC = 32768, CH_PT = 0, CH_RYT = 8192, CH_QT = 16384, CH_YX = 24576;
constexpr size_t CH_SIZE = CH_N * CH_REC;
constexpr size_t WS_TOTAL = OFF_CH + CH_SIZE;
static_assert(WS_TOTAL <= (size_t)2048 * 1024 * 1024, "workspace exceeds 4x largest tensor");

struct Params {
  const float *x, *c, *ctx, *c_ctx, *ada_w, *ada_b, *norm_mix_g, *norm_ffn_g, *w_in, *w_out;
  const float *na_q_gain, *na_k_gain, *na_rpb;
  const float *rw_mu, *rw_w0, *rw_w_up, *rw_a0, *rw_a_up, *rw_g_up, *rw_k_k, *rw_k_a, *rw_r_k, *rw_ln_w, *rw_ln_b;
  const float *gd_conv_w, *gd_A_log, *gd_dt_bias, *gd_norm_g;
  const float *moe_router_w, *moe_router_b, *moe_w_gu, *moe_b_gu, *moe_w_down, *moe_b_down;
  float* out;
  char* ws;
};

typedef const __attribute__((address_space(4))) Params* PP;
#define p (*pp)
__device__ __forceinline__ char* fresh_ws(PP pp) { return p.ws; }
__device__ __forceinline__ int tid_opaque() { int t = (int)__builtin_amdgcn_workitem_id_x(); asm volatile("" : "+v"(t)); return t; }
__device__ __forceinline__ int opq(int x) { asm volatile("" : "+s"(x)); return x; }
__device__ __forceinline__ int wave_id(int tid) { return __builtin_amdgcn_readfirstlane(tid >> 6); }
typedef __bf16 bf16v2_t __attribute__((ext_vector_type(2)));
typedef float f32v2_t __attribute__((ext_vector_type(2)));
__device__ __forceinline__ unsigned pk_bf16(float lo, float hi) { f32v2_t v = {lo, hi}; return __builtin_bit_cast(unsigned, __builtin_convertvector(v, bf16v2_t)); }
__device__ __forceinline__ bfr f2bf(float f) { return (bfr)(pk_bf16(f, f) & 0xffffu); }
__device__ __forceinline__ float bf2f(short v) { return __uint_as_float(((unsigned)(unsigned short)v) << 16); }
__device__ __forceinline__ bf16x4 pack4(float a, float b, float c, float d) {
  typedef __attribute__((ext_vector_type(2))) unsigned u32x2;
  u32x2 w; w[0] = pk_bf16(a, b); w[1] = pk_bf16(c, d);
  return __builtin_bit_cast(bf16x4, w);
}
__device__ __forceinline__ float sigmoidf_(float x) { return __builtin_amdgcn_rcpf(1.f + __expf(-x)); }
__device__ __forceinline__ float siluf_(float x) { return x * __builtin_amdgcn_rcpf(1.f + __expf(-x)); }
__device__ __forceinline__ float softplusf_(float x) { const float e = __expf(fminf(x, 20.f)); const float lg = __logf(1.f + e); const float r = x < -15.f ? e : lg; return x > 20.f ? x : r; }
__device__ __forceinline__ float wave_sum(float v) {
  v += __builtin_bit_cast(float, __builtin_amdgcn_update_dpp(0, __builtin_bit_cast(int, v), 0xB1, 0xF, 0xF, true));
  v += __builtin_bit_cast(float, __builtin_amdgcn_update_dpp(0, __builtin_bit_cast(int, v), 0x4E, 0xF, 0xF, true));
  v += __builtin_bit_cast(float, __builtin_amdgcn_update_dpp(0, __builtin_bit_cast(int, v), 0x141, 0xF, 0xF, true));
  v += __builtin_bit_cast(float, __builtin_amdgcn_update_dpp(0, __builtin_bit_cast(int, v), 0x140, 0xF, 0xF, true));
  v += __builtin_bit_cast(float, __builtin_amdgcn_update_dpp(0, __builtin_bit_cast(int, v), 0x142, 0xA, 0xF, false));
  v += __builtin_bit_cast(float, __builtin_amdgcn_update_dpp(0, __builtin_bit_cast(int, v), 0x143, 0xC, 0xF, false));
  return __builtin_bit_cast(float, __builtin_amdgcn_readlane(__builtin_bit_cast(int, v), 63));
}
__device__ __forceinline__ float wave_max(float v) {
  v = fmaxf(v, __builtin_bit_cast(float, __builtin_amdgcn_update_dpp(0, __builtin_bit_cast(int, v), 0xB1, 0xF, 0xF, true)));
  v = fmaxf(v, __builtin_bit_cast(float, __builtin_amdgcn_update_dpp(0, __builtin_bit_cast(int, v), 0x4E, 0xF, 0xF, true)));
  v = fmaxf(v, __builtin_bit_cast(float, __builtin_amdgcn_update_dpp(0, __builtin_bit_cast(int, v), 0x141, 0xF, 0xF, true)));
  v = fmaxf(v, __builtin_bit_cast(float, __builtin_amdgcn_update_dpp(0, __builtin_bit_cast(int, v), 0x140, 0xF, 0xF, true)));
  const float r1 = __builtin_bit_cast(float, __builtin_amdgcn_readlane(__builtin_bit_cast(int, v), 0));
  const float r2 = __builtin_bit_cast(float, __builtin_amdgcn_readlane(__builtin_bit_cast(int, v), 16));
  const float r3 = __builtin_bit_cast(float, __builtin_amdgcn_readlane(__builtin_bit_cast(int, v), 32));
  const float r4 = __builtin_bit_cast(float, __builtin_amdgcn_readlane(__builtin_bit_cast(int, v), 48));
  return fmaxf(fmaxf(r1, r2), fmaxf(r3, r4));
}
__device__ __forceinline__ float shfl_xor_l(float v, int mask, int lane) {
  return __builtin_bit_cast(float, __builtin_amdgcn_ds_bpermute((lane ^ mask) << 2, __builtin_bit_cast(int, v)));
}
__device__ __forceinline__ int shfl_xor_li(int v, int mask, int lane) {
  return __builtin_amdgcn_ds_bpermute((lane ^ mask) << 2, v);
}
__device__ __forceinline__ float row16_sum(float v) {
  v += __builtin_bit_cast(float, __builtin_amdgcn_update_dpp(0, __builtin_bit_cast(int, v), 0xB1, 0xF, 0xF, true));
  v += __builtin_bit_cast(float, __builtin_amdgcn_update_dpp(0, __builtin_bit_cast(int, v), 0x4E, 0xF, 0xF, true));
  v += __builtin_bit_cast(float, __builtin_amdgcn_update_dpp(0, __builtin_bit_cast(int, v), 0x141, 0xF, 0xF, true));
  v += __builtin_bit_cast(float, __builtin_amdgcn_update_dpp(0, __builtin_bit_cast(int, v), 0x140, 0xF, 0xF, true));
  return v;
}
__device__ __forceinline__ float quant_row_store(const float4 (&v)[4], signed char* dst_row, int lane) {
  float am = 0.f;
#pragma unroll
  for (int i = 0; i < 4; ++i) am = fmaxf(fmaxf(am, fmaxf(fabsf(v[i].x), fabsf(v[i].y))), fmaxf(fabsf(v[i].z), fabsf(v[i].w)));
  am = wave_max(am);
  const float sc = am > 0.f ? am * (1.f / 127.f) : 1.f, iv = 1.f / sc;
#pragma unroll
  for (int i = 0; i < 4; ++i) {
    const int q0 = (int)fminf(fmaxf(rintf(v[i].x * iv), -127.f), 127.f), q1 = (int)fminf(fmaxf(rintf(v[i].y * iv), -127.f), 127.f);
    const int q2 = (int)fminf(fmaxf(rintf(v[i].z * iv), -127.f), 127.f), q3 = (int)fminf(fmaxf(rintf(v[i].w * iv), -127.f), 127.f);
    *(unsigned*)(dst_row + (lane + 64 * i) * 4) = (unsigned)(q0 & 0xff) | ((unsigned)(q1 & 0xff) << 8) | ((unsigned)(q2 & 0xff) << 16) | ((unsigned)(q3 & 0xff) << 24);
  }
  return sc;
}
__device__ __forceinline__ float ldbf1(const bfr* q, size_t i) { return bf2f((short)q[i]); }
__device__ __forceinline__ f32x4 ldbf4(const bfr* q) { const bf16x4 v = *(const bf16x4*)q; return (f32x4){bf2f(v[0]), bf2f(v[1]), bf2f(v[2]), bf2f(v[3])}; }
__device__ __forceinline__ int mod_row(int m) { return m < NLAT ? (m >> 14) : 2; }

__device__ __forceinline__ void phase_ada(PP pp, int bid, int nb, char* smem) {
  float* red = (float*)smem;
  float* mods = (float*)(p.ws + OFF_MODS);
  const int tid = tid_opaque();
  for (int task = bid; task < 2 * 96; task += nb) {
    int l = task / 96, cgp = task % 96;
    int col = cgp * 64 + (tid & 63), ks = tid >> 6;
    const float* W = p.ada_w + (size_t)l * 1024 * 6144;
    float a0 = 0.f, a1 = 0.f, a2 = 0.f;
    for (int d = ks * 128; d < ks * 128 + 128; ++d) {
      float w = W[(size_t)d * 6144 + col];
      a0 += siluf_(p.c[d]) * w;
      a1 += siluf_(p.c[1024 + d]) * w;
      a2 += siluf_(p.c_ctx[d]) * w;
    }
    red[(ks * 3 + 0) * 64 + (tid & 63)] = a0;
    red[(ks * 3 + 1) * 64 + (tid & 63)] = a1;
    red[(ks * 3 + 2) * 64 + (tid & 63)] = a2;
    __syncthreads();
    if (tid < 192) {
      int r = tid >> 6, cc = tid & 63;
      float s = 0.f;
      for (int k = 0; k < 8; ++k) s += red[(k * 3 + r) * 64 + cc];
      mods[(size_t)(l * 3 + r) * 6144 + cgp * 64 + cc] = s + p.ada_b[(size_t)l * 6144 + cgp * 64 + cc];
    }
    __syncthreads();
  }
}

__device__ __forceinline__ void convert_tile(const float* src, int N, bfr* dst, int kt4  , int nt, float* tile  ) {
  const int tid = tid_opaque();
  float4 v[8];
#pragma unroll
  for (int q = 0; q < 8; ++q) {
    const int idx = tid + q * 512;
    const int kk = idx >> 4, n4 = idx & 15;
    v[q] = *(const float4*)(src + (size_t)(kt4 * 256 + kk) * N + nt * 64 + n4 * 4);
  }
#pragma unroll
  for (int q = 0; q < 8; ++q) {
    const int idx = tid + q * 512;
    const int kk = idx >> 4, n4 = idx & 15;
    tile[kk * 65 + n4 * 4 + 0] = v[q].x; tile[kk * 65 + n4 * 4 + 1] = v[q].y;
    tile[kk * 65 + n4 * 4 + 2] = v[q].z; tile[kk * 65 + n4 * 4 + 3] = v[q].w;
  }
  __syncthreads();
  {
    const int nn = tid >> 3, kc = tid & 7;
    const int n = nt * 64 + nn;
#pragma unroll
    for (int q = 0; q < 4; ++q) {
      const int k0 = (kc + 8 * q) * 8;
      *(bf16x4*)(dst + (size_t)n * 1024 + kt4 * 256 + k0) = pack4(tile[(k0 + 0) * 65 + nn], tile[(k0 + 1) * 65 + nn], tile[(k0 + 2) * 65 + nn], tile[(k0 + 3) * 65 + nn]);
      *(bf16x4*)(dst + (size_t)n * 1024 + kt4 * 256 + k0 + 4) = pack4(tile[(k0 + 4) * 65 + nn], tile[(k0 + 5) * 65 + nn], tile[(k0 + 6) * 65 + nn], tile[(k0 + 7) * 65 + nn]);
    }
  }
  __syncthreads();
}
template <int N, bool INTERLEAVE>
__device__ __forceinline__ void convert_i8(const float* src  , signed char* dst  , float* sw, int ng, char* smem) {
  const int tid = tid_opaque();
  bfr* blk = (bfr*)smem;
  int* cmax = (int*)(smem + 131072);
  if (tid < 64) cmax[tid] = 0;
  __syncthreads();
  {
    const int n4 = tid & 15, kk0 = tid >> 4;
    float m0 = 0.f, m1 = 0.f, m2 = 0.f, m3 = 0.f;
#pragma unroll 8
    for (int ps = 0; ps < 32; ++ps) {
      const int k = ps * 32 + kk0;
      float4 v = make_float4(0.f, 0.f, 0.f, 0.f);
      if (ng * 64 + n4 * 4 < N) v = *(const float4*)(src + (size_t)k * N + ng * 64 + n4 * 4);
      m0 = fmaxf(m0, fabsf(v.x)); m1 = fmaxf(m1, fabsf(v.y)); m2 = fmaxf(m2, fabsf(v.z)); m3 = fmaxf(m3, fabsf(v.w));
      *(bf16x4*)(blk + k * 64 + n4 * 4) = pack4(v.x, v.y, v.z, v.w);
    }
    atomicMax(&cmax[n4 * 4 + 0], __float_as_int(m0)); atomicMax(&cmax[n4 * 4 + 1], __float_as_int(m1));
    atomicMax(&cmax[n4 * 4 + 2], __float_as_int(m2)); atomicMax(&cmax[n4 * 4 + 3], __float_as_int(m3));
  }
  __syncthreads();
  {
    const int nn = tid >> 3, kc = tid & 7;
    const int n = ng * 64 + nn;
    const float am = __int_as_float(cmax[nn]);
    const float sc = am > 0.f ? am * (1.f / 127.f) : 1.f, iv = 1.f / sc;
    const int j = n & 1023;
    const int row = INTERLEAVE ? (j >> 4) * 32 + (j & 15) + ((n >= 1024) ? 16 : 0) : n;
    if (kc == 0) sw[n] = sc;
#pragma unroll 2
    for (int q = 0; q < 8; ++q) {
      const int k0 = (kc + 8 * q) * 16;
      unsigned w[4];
#pragma unroll
      for (int g4 = 0; g4 < 4; ++g4) {
        unsigned acc = 0u;
#pragma unroll
        for (int b = 0; b < 4; ++b) {
          const float v = bf2f((short)blk[(k0 + g4 * 4 + b) * 64 + nn]);
          const int qi = (int)fminf(fmaxf(rintf(v * iv), -127.f), 127.f);
          acc |= ((unsigned)(qi & 0xff)) << (8 * b);
        }
        w[g4] = acc;
      }
      *(uint4*)(dst + (size_t)row * 1024 + k0) = make_uint4(w[0], w[1], w[2], w[3]);
    }
  }
  __syncthreads();
}
__device__ __forceinline__ void phase_convert(PP pp, int l, int part, int bid, int nb, char* smem) {
  float* tile = (float*)smem;
  char* wl = p.ws + OFF_W + (size_t)l * WL_SIZE;
  const int T_IN = 56, T_OUT = 4 * 16, T_GU = 32 * 32, T_DN = 32 * 4 * 16;
  const int t_lo = part == 0 ? 0 : T_IN + T_OUT;
  const int t_hi = part == 0 ? T_IN + T_OUT : T_IN + T_OUT + T_GU + T_DN;
  for (int t = t_lo + bid; t < t_hi; t += nb) {
    if (t < T_IN) {
      convert_i8<PIN, false>(p.w_in + (size_t)l * 1024 * PIN, (signed char*)(wl + WL_IN), (float*)(p.ws + OFF_SWIN) + (size_t)l * PINP, t, smem);
    } else if (t < T_IN + T_OUT) {
      int u = t - T_IN; int kt4 = u / 16, nt = u % 16;
      convert_tile(p.w_out + (size_t)l * 1024 * 1024, 1024, (bfr*)(wl + WL_OUT), kt4, nt, tile);
    } else if (t < T_IN + T_OUT + T_GU) {
      int u = t - T_IN - T_OUT; int e = u / 32, ng = u % 32;
      convert_i8<2048, true>(p.moe_w_gu + ((size_t)l * 32 + e) * 1024 * 2048, (signed char*)(wl + WL_GU) + (size_t)e * 2048 * 1024,
                    (float*)(p.ws + OFF_SW) + ((size_t)l * 32 + e) * 2048, ng, smem);
    } else {
      int u = t - T_IN - T_OUT - T_GU; int e = u / 64; int v = u % 64; int kt4 = v / 16, nt = v % 16;
      convert_tile(p.moe_w_down + ((size_t)l * 32 + e) * 1024 * 1024, 1024, (bfr*)(wl + WL_DN) + (size_t)e * 1024 * 1024, kt4, nt, tile);
    }
  }
}

__device__ __forceinline__ void phase_prenorm(PP pp, int l, int bid, int nb) {
  const int tid = tid_opaque(), lane = tid & 63, wv = wave_id(tid);
  const float* xl = (l == 0) ? p.x : p.out;
  const float* xc = (l == 0) ? p.ctx : (const float*)(p.ws + OFF_CTX);
  const float* mods = (const float*)(p.ws + OFF_MODS) + (size_t)l * 3 * 6144;
  const float* g = p.norm_mix_g + (size_t)l * 1024;
  signed char* H8 = (signed char*)(p.ws + OFF_H);
  float* SCL = (float*)(p.ws + OFF_SCL);
  {
    int* cnt = (int*)(p.ws + OFF_CNT);
    int gt = bid * NTHR + tid;
    if (gt < 32) cnt[gt] = 0;
  }
  for (int m = bid * 8 + wv; m < NTOK; m += nb * 8) {
    const float* xr = (m < NLAT) ? xl + (size_t)m * 1024 : xc + (size_t)(m - NLAT) * 1024;
    const float* md = mods + (size_t)mod_row(m) * 6144;
    float4 v[4];
    float ss = 0.f;
#pragma unroll
    for (int i = 0; i < 4; ++i) {
      v[i] = *(const float4*)(xr + (lane + 64 * i) * 4);
      ss += v[i].x * v[i].x + v[i].y * v[i].y + v[i].z * v[i].z + v[i].w * v[i].w;
    }
    ss = wave_sum(ss);
    float rs = rsqrtf(ss * (1.f / 1024.f) + 1e-6f);
    float4 hq[4];
#pragma unroll
    for (int i = 0; i < 4; ++i) {
      int d = (lane + 64 * i) * 4;
      float4 gg = *(const float4*)(g + d);
      float4 sh = *(const float4*)(md + d);
      float4 sc = *(const float4*)(md + 1024 + d);
      hq[i] = make_float4(v[i].x * rs * gg.x * (1.f + sc.x) + sh.x, v[i].y * rs * gg.y * (1.f + sc.y) + sh.y,
                          v[i].z * rs * gg.z * (1.f + sc.z) + sh.z, v[i].w * rs * gg.w * (1.f + sc.w) + sh.w);
    }
    const float qs = quant_row_store(hq, H8 + (size_t)m * 1024, lane);
    if (lane == 0) SCL[m] = qs;
  }
}

#define LAS __attribute__((address_space(3)))
namespace g8 {
constexpr int BM = 256, BK = 64, HALF = 128, HTB = HALF * BK * 2, STAGE_BYTES = 8 * HTB, KD = 1024;
__device__ __forceinline__ int lds_byte(int r, int c) { const int st = (r >> 4) * 2 + (c >> 5), rr = r & 15, cc = c & 31, ob = rr * 64 + cc * 2; return st * 1024 + (ob ^ (((ob >> 9) & 1) << 5)); }
__device__ __forceinline__ void stage_rc(int b, int& R, int& C) { const int st = b / 1024, sb = b % 1024, swz = sb ^ (((sb >> 9) & 1) << 5); R = (st >> 1) * 16 + swz / 64; C = (st & 1) * 32 + (swz % 64) / 2; }
struct GUnit { int pm, pn, brow0, e; };
__device__ __forceinline__ int unit_index(int i, int c, int G, int total) {
  const int x = c & 7, j = c >> 3, q = total >> 3, r = total & 7;
  const int start = x < r ? x * (q + 1) : r * (q + 1) + (x - r) * q;
  const int size = q + (x < r ? 1 : 0);
  const int li = i * (G >> 3) + j;
  return li < size ? start + li : -1;
}

__device__ __forceinline__ f32x4 mma16(bf16x8 a, bf16x8 b, f32x4 c) { return __builtin_amdgcn_mfma_f32_16x16x32_bf16(a, b, c, 0, 0, 0); }
__device__ __forceinline__ i32x4 mma16(i32x4 a, i32x4 b, i32x4 c) { return __builtin_amdgcn_mfma_i32_16x16x64_i8(a, b, c, 0, 0, 0); }
template <bool I8, class Sched, class Epi>
__device__ __forceinline__ void gemm_stream(LAS unsigned char* lds, const void* Abase, const void* Btbase, const Sched& S, const Epi& E) {
  typedef typename std::conditional<I8, i32x4, f32x4>::type AccT;
  typedef typename std::conditional<I8, i32x4, bf16x8>::type FragT;
  constexpr int KB = I8 ? KD : KD * 2;
  const int tid = tid_opaque(), wid = __builtin_amdgcn_readfirstlane(tid >> 6), lane = tid & 63, wr = wid >> 2, wc = wid & 3, fr = lane & 15, fq = lane >> 4;
  constexpr int nt = KB / 128;
  int R[2], C[2];
  unsigned voffB[2];
#pragma unroll
  for (int i = 0; i < 2; ++i) { stage_rc(tid * 16 + i * 8192, R[i], C[i]); voffB[i] = (unsigned)(R[i] * KB + C[i] * 2); }
#define voffA voffB
  constexpr size_t kstep = (size_t)(BK * 2);
  constexpr size_t hstep = (size_t)HALF * KB;
  const unsigned ldsw = (unsigned)wid * 1024u;
  const int aoff = lds_byte(wr * 64 + fr, fq * 8), boff = lds_byte(wc * 32 + fr, fq * 8);
#define G8_SA(b, h) (((b) * 2 + (h)) * HTB)
#define G8_SB(b, h) ((4 + (b) * 2 + (h)) * HTB)
#define G8_STAGE(bufoff, gbase, v0, v1) do { \
    __builtin_amdgcn_global_load_lds((const unsigned*)((const char*)(gbase) + (v0)), (LAS unsigned*)(lds + (bufoff) + ldsw), 16, 0, 0); \
    __builtin_amdgcn_global_load_lds((const unsigned*)((const char*)(gbase) + (v1)), (LAS unsigned*)(lds + (bufoff) + ldsw + 8192), 16, 0, 0); } while (0)
#define G8_STAGEB(bufoff, gbase) G8_STAGE(bufoff, gbase, voffB[0], voffB[1])
#define G8_STAGEA(bufoff, gbase) G8_STAGE(bufoff, gbase, voffA[0], voffA[1])
#define G8_LDA(dst, b, h) do { _Pragma("unroll") for (int m = 0; m < 4; ++m) _Pragma("unroll") for (int k = 0; k < 2; ++k) dst[m][k] = *(const LAS FragT*)(lds + G8_SA(b, h) + aoff + m * 2048 + k * 1024); } while (0)
#define G8_LDB(dst, b, h) do { _Pragma("unroll") for (int n = 0; n < 2; ++n) _Pragma("unroll") for (int k = 0; k < 2; ++k) dst[n][k] = *(const LAS FragT*)(lds + G8_SB(b, h) + boff + n * 2048 + k * 1024); } while (0)
#define G8_MMA(ai, bj, At, Bt) do { __builtin_amdgcn_s_setprio(1); _Pragma("unroll") for (int m = 0; m < 4; ++m) _Pragma("unroll") for (int n = 0; n < 2; ++n) _Pragma("unroll") for (int k = 0; k < 2; ++k) \
    acc[ai][bj][m][n] = mma16(Bt[n][k], At[m][k], acc[ai][bj][m][n]); __builtin_amdgcn_s_setprio(0); } while (0)
#define G8_WAIT_V(n) asm volatile("s_waitcnt vmcnt(" #n ")" ::: "memory")
#define G8_WAIT_L(n) asm volatile("s_waitcnt lgkmcnt(" #n ")" ::: "memory")
#define G8_BAR __builtin_amdgcn_s_barrier()
#define G8_SCHED __builtin_amdgcn_sched_barrier(0)
  GUnit cur, nxt;
  int ui = 0;
  if (!S.next(0, cur)) return;
  AccT acc[2][2][4][2];
#pragma unroll
  for (int a = 0; a < 2; ++a)
#pragma unroll
    for (int b = 0; b < 2; ++b)
#pragma unroll
      for (int m = 0; m < 4; ++m)
#pragma unroll
        for (int n = 0; n < 2; ++n) acc[a][b][m][n] = AccT{};
  FragT At[4][2], B0[2][2], B1[2][2];
  const char* cA = (const char*)Abase + (size_t)cur.pm * (BM * KB);
  const char* cB = (const char*)Btbase + (size_t)cur.brow0 * KB;
  G8_STAGEB(G8_SB(0, 0), cB); G8_STAGEA(G8_SA(0, 0), cA); G8_STAGEB(G8_SB(0, 1), cB + hstep); G8_STAGEA(G8_SA(0, 1), cA + hstep);
  if (wr == 1) G8_BAR;
  G8_WAIT_V(4); G8_BAR;
  G8_STAGEB(G8_SB(1, 0), cB + kstep); G8_STAGEA(G8_SA(1, 0), cA + kstep); G8_STAGEB(G8_SB(1, 1), cB + hstep + kstep);
  G8_WAIT_V(6); G8_BAR;
  for (;;) {
    const bool has_next = S.next(ui + 1, nxt);
    const char* nA = has_next ? (const char*)Abase + (size_t)nxt.pm * (BM * KB) : cA;
    const char* nB = has_next ? (const char*)Btbase + (size_t)nxt.brow0 * KB : cB;
#pragma unroll 1
    for (int t = 0; t < nt; t += 2) {
      const bool last = (t == nt - 2);
      const char* a1 = cA + (size_t)(t + 1) * kstep;
      const char* a2 = last ? nA : cA + (size_t)(t + 2) * kstep;
      const char* b2 = last ? nB : cB + (size_t)(t + 2) * kstep;
      const char* a3 = a2 + kstep;
      const char* b3 = b2 + kstep;
      G8_LDB(B0, 0, 0); G8_SCHED; G8_LDA(At, 0, 0); G8_STAGEA(G8_SA(1, 1), a1 + hstep);
      G8_WAIT_L(8); G8_BAR; G8_WAIT_L(0); G8_MMA(0, 0, At, B0); G8_BAR; G8_SCHED;
      G8_LDB(B1, 0, 1); G8_STAGEB(G8_SB(0, 0), b2);
      G8_BAR; G8_WAIT_L(0); G8_MMA(0, 1, At, B1); G8_BAR;
      G8_LDA(At, 0, 1); G8_STAGEA(G8_SA(0, 0), a2);
      G8_BAR; G8_WAIT_L(0); G8_MMA(1, 0, At, B0); G8_BAR; G8_SCHED;
      G8_STAGEB(G8_SB(0, 1), b2 + hstep);
      G8_WAIT_V(6); G8_BAR; G8_MMA(1, 1, At, B1); G8_BAR;
      G8_LDB(B0, 1, 0); G8_SCHED; G8_LDA(At, 1, 0); G8_STAGEA(G8_SA(0, 1), a2 + hstep);
      G8_WAIT_L(8); G8_BAR; G8_WAIT_L(0); G8_MMA(0, 0, At, B0); G8_BAR; G8_SCHED;
      G8_LDB(B1, 1, 1); G8_STAGEB(G8_SB(1, 0), b3);
      G8_BAR; G8_WAIT_L(0); G8_MMA(0, 1, At, B1); G8_BAR;
      G8_LDA(At, 1, 1); G8_STAGEA(G8_SA(1, 0), a3);
      G8_BAR; G8_WAIT_L(0); G8_MMA(1, 0, At, B0); G8_BAR; G8_SCHED;
      G8_STAGEB(G8_SB(1, 1), b3 + hstep);
      G8_WAIT_V(6); G8_BAR; G8_MMA(1, 1, At, B1); G8_BAR;
    }
    E(acc, cur, wr, wc, fr, fq);
    if (!has_next) break;
#pragma unroll
    for (int a = 0; a < 2; ++a)
#pragma unroll
      for (int b = 0; b < 2; ++b)
#pragma unroll
        for (int m = 0; m < 4; ++m)
#pragma unroll
          for (int n = 0; n < 2; ++n) acc[a][b][m][n] = AccT{};
    cur = nxt; cA = nA; cB = nB; ++ui;
  }
  G8_WAIT_V(0);
  if (wr == 0) G8_BAR;
  G8_BAR;
#undef G8_SA
#undef G8_SB
#undef G8_STAGE
#undef G8_STAGEB
#undef G8_STAGEA
#undef voffA
#undef G8_LDA
#undef G8_LDB
#undef G8_MMA
#undef G8_WAIT_V
#undef G8_WAIT_L
#undef G8_BAR
#undef G8_SCHED
}

struct DenseSched {
  int nM, nN, G, c;
  __device__ __forceinline__ bool next(int i, GUnit& u) const {
    const int idx = unit_index(i, c, G, nM * nN);
    if (idx < 0) return false;
    u.pm = idx / nN; u.pn = idx - u.pm * nN; u.brow0 = u.pn * BM; u.e = 0;
    return true;
  }
};
struct MoeSched {
  const int* toff; int nN, NE, G, c;
  __device__ __forceinline__ bool next(int i, GUnit& u) const {
    const int idx = unit_index(i, c, G, toff[32] * nN);
    if (idx < 0) return false;
    u.pm = idx / nN; u.pn = idx - u.pm * nN;
    const int e = toff[128 + u.pm];
    u.e = e; u.brow0 = e * NE + u.pn * BM;
    return true;
  }
};
}

struct EpiInProj {
  bfr* P; const float* SCL; const float* sw;
  __device__ __forceinline__ void operator()(const i32x4 (&acc)[2][2][4][2], const g8::GUnit& u, int wr, int wc, int fr, int fq) const {
    const int row0 = u.pm * 256 + wr * 64 + fr, col0 = u.pn * 256 + wc * 32 + 4 * fq;
    f32x4 cs[2][2];
#pragma unroll
    for (int bj = 0; bj < 2; ++bj)
#pragma unroll
      for (int n = 0; n < 2; ++n) cs[bj][n] = *(const f32x4*)(sw + col0 + bj * 128 + n * 16);
    float sav[2][4];
#pragma unroll
    for (int ai = 0; ai < 2; ++ai)
#pragma unroll
      for (int m = 0; m < 4; ++m) sav[ai][m] = SCL[row0 + ai * 128 + m * 16];
#pragma unroll
    for (int ai = 0; ai < 2; ++ai)
#pragma unroll
      for (int m = 0; m < 4; ++m) {
        const int row = row0 + ai * 128 + m * 16;
        const float sa = sav[ai][m];
        bfr* rowp = P + (size_t)row * PINP + col0;
#pragma unroll
        for (int bj = 0; bj < 2; ++bj)
#pragma unroll
          for (int n = 0; n < 2; ++n) {
            const i32x4 a = acc[ai][bj][m][n];
            f32x4 o = {(float)a[0], (float)a[1], (float)a[2], (float)a[3]};
            o = o * (cs[bj][n] * sa);
            *(bf16x4*)(rowp + bj * 128 + n * 16) = pack4(o[0], o[1], o[2], o[3]);
          }
      }
  }
};
__device__ __forceinline__ void phase_gemm_in(PP pp, int l, int bid, int nb, char* smem) {
  g8::DenseSched S{130, 14, nb, bid};
  EpiInProj E{(bfr*)(p.ws + OFF_P), (const float*)(p.ws + OFF_SCL), (const float*)(p.ws + OFF_SWIN) + (size_t)l * PINP};
  g8::gemm_stream<true>((LAS unsigned char*)smem, p.ws + OFF_H, p.ws + OFF_W + (size_t)l * WL_SIZE + WL_IN, S, E);
}

struct EpiOutProj {
  const float *xl, *xc, *mods; float *ol, *oc;
  __device__ __forceinline__ void operator()(const f32x4 (&acc)[2][2][4][2], const g8::GUnit& u, int wr, int wc, int fr, int fq) const {
    const bool lat = u.pm < 128;
    const float* xin = lat ? xl + (size_t)u.pm * 256 * 1024 : xc + (size_t)(u.pm - 128) * 256 * 1024;
    float* xo = lat ? ol + (size_t)u.pm * 256 * 1024 : oc + (size_t)(u.pm - 128) * 256 * 1024;
    const float* g1 = mods + (size_t)(lat ? (u.pm >> 6) : 2) * 6144 + 2048;
    const int row0 = wr * 64 + fr, col0 = u.pn * 256 + wc * 32 + 4 * fq;
#pragma unroll
    for (int bj = 0; bj < 2; ++bj)
#pragma unroll
      for (int n = 0; n < 2; ++n) {
        const f32x4 gv = *(const f32x4*)(g1 + col0 + bj * 128 + n * 16);
        f32x4 xv[2][4];
#pragma unroll
        for (int ai = 0; ai < 2; ++ai)
#pragma unroll
          for (int m = 0; m < 4; ++m) xv[ai][m] = *(const f32x4*)(xin + (size_t)(row0 + ai * 128 + m * 16) * 1024 + col0 + bj * 128 + n * 16);
#pragma unroll
        for (int ai = 0; ai < 2; ++ai)
#pragma unroll
          for (int m = 0; m < 4; ++m)
            *(f32x4*)(xo + (size_t)(row0 + ai * 128 + m * 16) * 1024 + col0 + bj * 128 + n * 16) = xv[ai][m] + gv * acc[ai][bj][m][n];
        asm volatile("" ::: "memory");
      }
  }
};
__device__ __forceinline__ void phase_gemm_out(PP pp, int l, int bid, int nb, char* smem) {
  g8::DenseSched S{(l == 0) ? 130 : 128, 4, nb, bid};
  EpiOutProj E{(l == 0) ? p.x : p.out, (l == 0) ? p.ctx : (const float*)(p.ws + OFF_CTX),
               (const float*)(p.ws + OFF_MODS) + (size_t)l * 3 * 6144, p.out, (float*)(p.ws + OFF_CTX)};
  g8::gemm_stream<false>((LAS unsigned char*)smem, p.ws + OFF_CC, p.ws + OFF_W + (size_t)l * WL_SIZE + WL_OUT, S, E);
}

#define LBAR() do { asm volatile("s_waitcnt lgkmcnt(0)" ::: "memory"); __builtin_amdgcn_s_barrier(); asm volatile("" ::: "memory"); } while (0)
__device__ __forceinline__ void phase_prep(PP pp, int l, int bid, int nb, char* smem) {
  const int tid = tid_opaque(), lane = tid & 63, wv = wave_id(tid);
  const bfr* P = (const bfr*)(p.ws + OFF_P);
  char* S = p.ws + OFF_S;
  bfr* QN = (bfr*)(S + S_QN);
  bfr* KN = (bfr*)(S + S_KN);
  bfr* VT = (bfr*)(S + S_VT);
  bfr* RWR = (bfr*)(S + S_RWR);
  bfr* RWKK = (bfr*)(S + S_RWKK);
  bfr* RWV = (bfr*)(S + S_RWV);
  bfr* RWG = (bfr*)(S + S_RWG);
  float* RWW = (float*)(S + S_RWW);
  bfr* RWKD = (bfr*)(S + S_RWKD);
  bfr* RWB = (bfr*)(S + S_RWB);
  float* BON = (float*)(S + S_BON);
  bfr* GDQ = (bfr*)(S + S_GDQ);
  bfr* GDK = (bfr*)(S + S_GDK);
  bfr* GDV = (bfr*)(S + S_GDV);
  float* GDAB = (float*)(S + S_GDAB);
  const float* mu = p.rw_mu + (size_t)l * 896;
  const float* w0 = p.rw_w0 + (size_t)l * 512;
  const float* w_up = p.rw_w_up + (size_t)l * 2 * 32 * 256;
  const float* a0 = p.rw_a0 + (size_t)l * 512;
  const float* a_up = p.rw_a_up + (size_t)l * 2 * 32 * 256;
  const float* g_up = p.rw_g_up + (size_t)l * 64 * 256;
  const float* k_k = p.rw_k_k + (size_t)l * 256;
  const float* k_a = p.rw_k_a + (size_t)l * 256;
  const float* r_k = p.rw_r_k + (size_t)l * 256;
  const float* conv_w = p.gd_conv_w + (size_t)l * 5 * 768;
  const float* A_log = p.gd_A_log + (size_t)l * 8;
  const float* dt_bias = p.gd_dt_bias + (size_t)l * 8;
  const float* qg = p.na_q_gain + (size_t)l * 64;
  const float* kg = p.na_k_gain + (size_t)l * 64;

  bfr* wl = (bfr*)smem;
  float* lor = (float*)(smem + 192 * 256 * 2);
  __syncthreads();
  for (int i = tid; i < 192 * 256; i += NTHR) {
    const int row = i >> 8, c = i & 255;
    const float v = row < 64 ? g_up[row * 256 + c] : row < 128 ? w_up[(row - 64) * 256 + c] : a_up[(row - 128) * 256 + c];
    wl[i] = f2bf(v);
  }
  __syncthreads();

  for (int tile = bid; tile < NTOK / 16; tile += nb) {
    const int m0 = tile * 16;
    int seq_lo, seq_hi, bb, tau0;
    if (m0 < NLAT) { bb = m0 >> 14; seq_lo = bb << 14; seq_hi = seq_lo + SEQ; tau0 = m0 - seq_lo; }
    else { bb = (m0 - NLAT) >> 8; seq_lo = NLAT + (bb << 8); seq_hi = seq_lo + CTXL; tau0 = SEQ + (m0 - seq_lo); }
    const f32x4 z4 = {0.f, 0.f, 0.f, 0.f};
    int tid_t = tid; asm volatile("" : "+v"(tid_t));
    const int lane_t = tid_t & 63;
    const int cb = lane_t * 4, hh = lane_t >> 4;
    const int lg = tid_t & 31, lt = tid_t >> 5;
    const int sl = lane_t >> 4, sc4 = (lane_t & 15) * 4;
    asm volatile("" ::: "memory");
    const f32x4 mur = *(const f32x4*)(mu + cb), muk = *(const f32x4*)(mu + 256 + cb), muv = *(const f32x4*)(mu + 512 + cb);
    const f32x4 mul = *(const f32x4*)(mu + 768 + lg * 4);

    f32x4 pr[3][4], pl[3];
    {
      const int mt0 = m0 + 2 * wv;
#pragma unroll
      for (int j = 0; j < 3; ++j)
#pragma unroll
        for (int t = 0; t < 4; ++t) {
          const int m = mt0 - 1 + t;
          const int mc = min(max(m, seq_lo), seq_hi - 1);
          const f32x4 ld = ldbf4(P + (size_t)mc * PINP + A_END + j * 256 + cb);
          pr[j][t] = (m == mc) ? ld : z4;
        }
#pragma unroll
      for (int t = 0; t < 3; ++t) {
        const int m = m0 + lt - 1 + t;
        const int mc = min(max(m, seq_lo), seq_hi - 1);
        const f32x4 ld = ldbf4(P + (size_t)mc * PINP + A_END + 768 + lg * 4);
        pl[t] = (m == mc) ? ld : z4;
      }
    }
    {
      const f32x4 v = pl[1] + mul * (0.5f * (pl[0] + pl[2]) - pl[1]);
#pragma unroll
      for (int i = 0; i < 4; ++i) {
        const int ch = lg * 4 + i;
        lor[ch * 16 + lt] = ch < 32 ? tanhf(v[i]) : ch < 64 ? v[i] : sigmoidf_(v[i]);
      }
    }
    f32x4 rr[2], rk[2], rv[2];
#pragma unroll
    for (int t = 0; t < 2; ++t) {
      rr[t] = pr[0][t + 1] + mur * (0.5f * (pr[0][t] + pr[0][t + 2]) - pr[0][t + 1]);
      rk[t] = pr[1][t + 1] + muk * (0.5f * (pr[1][t] + pr[1][t + 2]) - pr[1][t + 1]);
      rv[t] = pr[2][t + 1] + muv * (0.5f * (pr[2][t] + pr[2][t + 2]) - pr[2][t + 1]);
    }
    LBAR();
    f32x4 pg[20];
    const bool is_gd = wv < 3, is_na = (wv >= 3 && wv < 7);
    const int sec = is_gd ? wv * 4 + sl : (wv - 3) * 4 + sl;
    if (is_gd) {
#pragma unroll
      for (int t = 0; t < 20; ++t) {
        const int m = m0 - 2 + t;
        const int mc = min(max(m, seq_lo), seq_hi - 1);
        const f32x4 ld = ldbf4(P + (size_t)mc * PINP + B_END + sec * 64 + sc4);
        pg[t] = (m == mc) ? ld : z4;
      }
    } else if (is_na) {
#pragma unroll
      for (int t = 0; t < 16; ++t) pg[t] = ldbf4(P + (size_t)(m0 + t) * PINP + sec * 64 + sc4);
#pragma unroll
      for (int t = 16; t < 20; ++t) pg[t] = z4;
    } else {
#pragma unroll
      for (int t = 0; t < 20; ++t) pg[t] = z4;
    }
    asm volatile("" ::: "memory");
    {
      f32x4 gacc[2], wa0[2], wa1[2], aa0[2], aa1[2];
#pragma unroll
      for (int t = 0; t < 2; ++t) { gacc[t] = z4; wa0[t] = z4; wa1[t] = z4; aa0[t] = z4; aa1[t] = z4; }
#pragma unroll 4
      for (int j = 0; j < 64; ++j) {
        const bf16x4 wq = *(const bf16x4*)(wl + j * 256 + cb);
        const f32x4 wgt = {bf2f(wq[0]), bf2f(wq[1]), bf2f(wq[2]), bf2f(wq[3])};
        const float2 sv = *(const float2*)(lor + (64 + j) * 16 + 2 * wv);
        gacc[0] += wgt * sv.x; gacc[1] += wgt * sv.y;
      }
#pragma unroll 2
      for (int j = 0; j < 32; ++j) {
        const bf16x4 q0 = *(const bf16x4*)(wl + (64 + j) * 256 + cb), q1 = *(const bf16x4*)(wl + (96 + j) * 256 + cb);
        const bf16x4 q2 = *(const bf16x4*)(wl + (128 + j) * 256 + cb), q3 = *(const bf16x4*)(wl + (160 + j) * 256 + cb);
        const f32x4 ww0 = {bf2f(q0[0]), bf2f(q0[1]), bf2f(q0[2]), bf2f(q0[3])}, ww1 = {bf2f(q1[0]), bf2f(q1[1]), bf2f(q1[2]), bf2f(q1[3])};
        const f32x4 aw0 = {bf2f(q2[0]), bf2f(q2[1]), bf2f(q2[2]), bf2f(q2[3])}, aw1 = {bf2f(q3[0]), bf2f(q3[1]), bf2f(q3[2]), bf2f(q3[3])};
        const float2 tv = *(const float2*)(lor + j * 16 + 2 * wv);
        const float2 dv = *(const float2*)(lor + (32 + j) * 16 + 2 * wv);
        wa0[0] += ww0 * tv.x; wa0[1] += ww0 * tv.y; wa1[0] += ww1 * tv.x; wa1[1] += ww1 * tv.y;
        aa0[0] += aw0 * dv.x; aa0[1] += aw0 * dv.y; aa1[0] += aw1 * dv.x; aa1[1] += aw1 * dv.y;
      }
      asm volatile("" ::: "memory");
      const f32x4 kkc = *(const f32x4*)(k_k + cb), kac = *(const f32x4*)(k_a + cb), rkc = *(const f32x4*)(r_k + cb);
      const f32x4 w00 = *(const f32x4*)(w0 + cb), w01 = *(const f32x4*)(w0 + 256 + cb), a00 = *(const f32x4*)(a0 + cb), a01 = *(const f32x4*)(a0 + 256 + cb);
#pragma unroll
      for (int t = 0; t < 2; ++t) {
        const int m = m0 + 2 * wv + t;
        const f32x4 r = rr[t], k = rk[t], v = rv[t];
        const f32x4 kkraw = k * kkc;
        const float ssum = row16_sum((kkraw[0] * kkraw[0] + kkraw[1] * kkraw[1]) + (kkraw[2] * kkraw[2] + kkraw[3] * kkraw[3]));
        const f32x4 kk = kkraw * rsqrtf(ssum + 1e-6f);
        float bon = 0.f;
#pragma unroll
        for (int d = 0; d < 2; ++d) {
          const f32x4 wlin = d == 0 ? w00 + wa0[t] : w01 + wa1[t];
          const f32x4 alin = d == 0 ? a00 + aa0[t] : a01 + aa1[t];
          f32x4 lw, kd, bv;
#pragma unroll
          for (int i = 0; i < 4; ++i) {
            const float w_log = -softplusf_(-wlin[i]) - 0.5f;
            const float a = sigmoidf_(alin[i]);
            lw[i] = -__expf(w_log);
            kd[i] = k[i] * (1.f + (a - 1.f) * kac[i]);
            bv[i] = kk[i] * a;
            bon += r[i] * kd[i] * rkc[i];
          }
          const size_t o = ((size_t)d * NTOK + m) * 256 + cb;
          *(f32x4*)(RWW + o) = lw; *(bf16x4*)(RWKD + o) = pack4(kd[0], kd[1], kd[2], kd[3]); *(bf16x4*)(RWB + o) = pack4(bv[0], bv[1], bv[2], bv[3]);
        }
        bon = row16_sum(bon);
        const size_t o = (size_t)m * 256 + cb;
        *(bf16x4*)(RWR + o) = pack4(r[0], r[1], r[2], r[3]); *(bf16x4*)(RWKK + o) = pack4(kk[0], kk[1], kk[2], kk[3]);
        *(bf16x4*)(RWV + o) = pack4(v[0], v[1], v[2], v[3]); *(bf16x4*)(RWG + o) = pack4(gacc[t][0], gacc[t][1], gacc[t][2], gacc[t][3]);
        if ((lane_t & 15) == 0) BON[(size_t)m * 4 + hh] = bon;
      }
    }
    if (is_gd) {
      f32x4 cw[5];
#pragma unroll
      for (int j = 0; j < 5; ++j) cw[j] = *(const f32x4*)(conv_w + j * 768 + sec * 64 + sc4);
#pragma unroll
      for (int t = 0; t < 16; ++t) {
        f32x4 acc = z4;
#pragma unroll
        for (int j = 0; j < 5; ++j) acc += cw[j] * pg[t + j];
        f32x4 val = {siluf_(acc[0]), siluf_(acc[1]), siluf_(acc[2]), siluf_(acc[3])};
        const int m = m0 + t;
        if (sec < 8) {
          const float ss = row16_sum((val[0] * val[0] + val[1] * val[1]) + (val[2] * val[2] + val[3] * val[3]));
          val = val * rsqrtf(ss + 1e-6f);
          if (sec < 4) { const f32x4 vq = val * 0.125f; *(bf16x4*)(GDQ + (size_t)m * 256 + sec * 64 + sc4) = pack4(vq[0], vq[1], vq[2], vq[3]); }
          else *(bf16x4*)(GDK + (size_t)m * 256 + (sec - 4) * 64 + sc4) = pack4(val[0], val[1], val[2], val[3]);
        } else *(bf16x4*)(GDV + (size_t)m * 256 + (sec - 8) * 64 + sc4) = pack4(val[0], val[1], val[2], val[3]);
      }
    } else if (is_na) {
      const f32x4 gq = *(const f32x4*)(qg + sc4) * (0.125f * 1.4426950408889634f), gk = *(const f32x4*)(kg + sc4);
#pragma unroll
      for (int t = 0; t < 16; ++t) {
        f32x4 val = pg[t];
        const float ss = row16_sum((val[0] * val[0] + val[1] * val[1]) + (val[2] * val[2] + val[3] * val[3]));
        val = val * rsqrtf(ss * (1.f / 64.f) + 1e-6f);
        const int m = m0 + t;
        if (sec < 8) { const f32x4 o = val * gq; *(bf16x4*)(QN + (size_t)m * 512 + sec * 64 + sc4) = pack4(o[0], o[1], o[2], o[3]); }
        else { const f32x4 o = val * gk; *(bf16x4*)(KN + (size_t)m * 512 + (sec - 8) * 64 + sc4) = pack4(o[0], o[1], o[2], o[3]); }
      }
    }
    if (tid_t < 256) {
      const int t = tid_t >> 4, j = tid_t & 15;
      const int m = m0 + t;
      const float pv = bf2f((short)P[(size_t)m * PINP + B_END + 1024 + j]);
      float o;
      if (j < 8) o = -__expf(A_log[j]) * softplusf_(pv + dt_bias[j]);
      else o = sigmoidf_(pv);
      GDAB[(size_t)m * 16 + j] = o;
    }
    {
      const int vc = (tid_t & 127) * 4, tq = (tid_t >> 7) * 4;
      f32x4 pv[4];
#pragma unroll
      for (int t = 0; t < 4; ++t) pv[t] = ldbf4(P + (size_t)(m0 + tq + t) * PINP + 1024 + vc);
#pragma unroll
      for (int i = 0; i < 4; ++i) {
        const int hd = vc + i;
        bfr* dst = VT + ((size_t)(bb * 8 + (hd >> 6)) * (TTOK / 16) + (tau0 >> 4)) * 1024 + (hd & 63) * 16 + tq;
        *(bf16x4*)dst = pack4(pv[0][i], pv[1][i], pv[2][i], pv[3][i]);
      }
    }
    LBAR();
  }
  __syncthreads();
}

__device__ __forceinline__ int scan_tok(int b, int d, int s) {
  if (s < CTXL) { int t = d ? (CTXL - 1 - s) : s; return NLAT + b * CTXL + t; }
  int u = s - CTXL; int t = d ? (SEQ - 1 - u) : u; return b * SEQ + t;
}
#define CS 72
#define SLOT_BYTES (64 * CS * 2)
#define F0_STRIDE 68
#define X1_F0 (13 * SLOT_BYTES)
#define X1_ARR (X1_F0 + 64 * F0_STRIDE * 4)

#define MM_FRAGS(As, Bs, a0, a1, b00, b01, b10, b11)                                                     \
  const bf16x8 a0 = *(const bf16x8*)((As) + ((mt * 16 + fr) * CS + fq * 8) * 2);                         \
  const bf16x8 a1 = *(const bf16x8*)((As) + ((mt * 16 + fr) * CS + 32 + fq * 8) * 2);                    \
  const bf16x8 b00 = *(const bf16x8*)((Bs) + ((nt0 * 16 + fr) * CS + fq * 8) * 2);                       \
  const bf16x8 b01 = *(const bf16x8*)((Bs) + ((nt0 * 16 + fr) * CS + 32 + fq * 8) * 2);                  \
  const bf16x8 b10 = *(const bf16x8*)((Bs) + ((nt0 * 16 + 16 + fr) * CS + fq * 8) * 2);                  \
  const bf16x8 b11 = *(const bf16x8*)((Bs) + ((nt0 * 16 + 16 + fr) * CS + 32 + fq * 8) * 2);
#define MM_2TILES(acc0, acc1, a0, a1, b00, b01, b10, b11)                                                \
  acc0 = __builtin_amdgcn_mfma_f32_16x16x32_bf16(a0, b00, acc0, 0, 0, 0);                                \
  acc0 = __builtin_amdgcn_mfma_f32_16x16x32_bf16(a1, b01, acc0, 0, 0, 0);                                \
  acc1 = __builtin_amdgcn_mfma_f32_16x16x32_bf16(a0, b10, acc1, 0, 0, 0);                                \
  acc1 = __builtin_amdgcn_mfma_f32_16x16x32_bf16(a1, b11, acc1, 0, 0, 0);
__device__ __forceinline__ void wr_T(char* slot, int mt, int nt, int fr, int fq, f32x4 v) {
  *(bf16x4*)(slot + ((nt * 16 + fr) * CS + mt * 16 + 4 * fq) * 2) = pack4(v[0], v[1], v[2], v[3]);
}

struct ChunkIn { float lw[8], f0[8], f1[8], f2[8], f3[8], xv[8], be[8]; };
template <bool GDN>
__device__ __forceinline__ void chunk_load(PP pp, int t, ChunkIn& ci) {
  const int tid = tid_opaque(), c = tid & 63, tg = wave_id(tid);
  const int chain = t / NCHUNK, n = t - chain * NCHUNK;
  const int d = chain & 1, h = (chain >> 1) & 3, b = (chain >> 3) & 1;
  const char* S = p.ws + OFF_S;
#pragma unroll
  for (int u = 0; u < 8; ++u) {
    const int m = scan_tok(b, d, n * 64 + tg * 8 + u);
    const size_t o = (size_t)m * 256 + h * 64 + c;
    if (!GDN) {
      ci.lw[u] = ((const float*)(S + S_RWW))[(size_t)d * NTOK * 256 + o];
      ci.f0[u] = ldbf1((const bfr*)(S + S_RWKK), o);
      ci.f1[u] = ldbf1((const bfr*)(S + S_RWB), (size_t)d * NTOK * 256 + o);
      ci.f2[u] = ldbf1((const bfr*)(S + S_RWKD), (size_t)d * NTOK * 256 + o);
      ci.f3[u] = ldbf1((const bfr*)(S + S_RWR), o);
      ci.xv[u] = ldbf1((const bfr*)(S + S_RWV), o);
      ci.be[u] = 1.f;
    } else {
      ci.lw[u] = ((const float*)(S + S_GDAB))[(size_t)m * 16 + d * 4 + h];
      ci.be[u] = ((const float*)(S + S_GDAB))[(size_t)m * 16 + 8 + d * 4 + h];
      ci.f0[u] = ldbf1((const bfr*)(S + S_GDK), o);
      ci.f3[u] = ldbf1((const bfr*)(S + S_GDQ), o);
      ci.xv[u] = ldbf1((const bfr*)(S + S_GDV), o);
      ci.f1[u] = 0.f; ci.f2[u] = 0.f;
    }
  }
}
template <bool GDN>
__device__ __forceinline__ void chunk_prep_task(PP pp, int t, int t_next, bool has_next, const ChunkIn& ci, ChunkIn& nx, char* smem) {
  const int chain = t / NCHUNK, n = t - chain * NCHUNK;
  const int d = chain & 1, h = (chain >> 1) & 3, b = (chain >> 3) & 1;
  (void)b; (void)d; (void)h;
  const int tid = tid_opaque(), lane = tid & 63, wv = wave_id(tid);
  const int fr = lane & 15, fq = lane >> 4, mt = wv >> 1, nt0 = (wv & 1) * 2;
  char* S = p.ws + OFF_S;
  char* CH = p.ws + OFF_CH;
  const size_t cc = (size_t)chain * NCHUNK + n;
  char* const p0 = smem;
  char* const p1 = smem + 1 * SLOT_BYTES;
  char* const p2 = smem + 2 * SLOT_BYTES;
  char* const p3 = smem + 3 * SLOT_BYTES;
  char* const p4 = smem + 4 * SLOT_BYTES;
  char* const p5 = smem + 5 * SLOT_BYTES;
  char* const p6 = smem + 6 * SLOT_BYTES;
  char* const p7 = smem + 7 * SLOT_BYTES;
  char* const p8 = smem + 8 * SLOT_BYTES;
  char* const p9 = smem + 9 * SLOT_BYTES;
  char* const p10 = smem + 10 * SLOT_BYTES;
  char* const p11 = smem + 11 * SLOT_BYTES;
  char* const p12 = smem + 12 * SLOT_BYTES;
  float* const F0 = (float*)(smem + X1_F0);
  float* const Lv = (float*)(smem + X1_ARR);
  float* const Lm1v = Lv + 64;
  float* const betav = Lv + 128;
  float* const eLv = Lv + 192;
  float* const gC = Lv + 256;
  float* const gsum = Lv + 320;
  char* const sKt = p0;
  char* const sBh = GDN ? p0 : p1;
  char* const sKh = GDN ? p0 : p2;

  {
    const int c = lane, tg = wv;
    const float* lw = ci.lw; const float* f0 = ci.f0; const float* f1 = ci.f1; const float* f2 = ci.f2; const float* f3 = ci.f3; const float* xv = ci.xv; const float* be = ci.be;
    float cum[8];
    cum[0] = lw[0];
#pragma unroll
    for (int u = 1; u < 8; ++u) cum[u] = cum[u - 1] + lw[u];
    gsum[tg * 64 + c] = cum[7];
    LBAR();
    float off = 0.f, LC = 0.f;
#pragma unroll
    for (int g2 = 0; g2 < 8; ++g2) { const float gs = gsum[g2 * 64 + c]; LC += gs; off += (g2 < tg) ? gs : 0.f; }
    bf16x8 vKtT, vBbT, vKbT, vXT;
#pragma unroll
    for (int u = 0; u < 8; ++u) {
      const int t = tg * 8 + u;
      const float L = off + cum[u], Lm1 = L - lw[u];
      if (!GDN) {
        const float eLm1 = __expf(Lm1), enL = __expf(-L), eL = __expf(L), eCL = __expf(LC - L);
        const float kt = f0[u] * eLm1;
        *(bfr*)(p0 + (t * CS + c) * 2) = f2bf(kt);
        *(bfr*)(p1 + (t * CS + c) * 2) = f2bf(f1[u] * enL);
        *(bfr*)(p2 + (t * CS + c) * 2) = f2bf(f2[u] * enL);
        *(bfr*)(p3 + (t * CS + c) * 2) = f2bf(f3[u] * eL);
        vKtT[u] = (short)f2bf(kt);
        vBbT[u] = (short)f2bf(f1[u] * eCL);
        vKbT[u] = (short)f2bf(f2[u] * eCL);
        vXT[u] = (short)f2bf(xv[u]);
      } else {
        *(bfr*)(p0 + (t * CS + c) * 2) = f2bf(f0[u]);
        *(bfr*)(p3 + (t * CS + c) * 2) = f2bf(f3[u]);
        vKtT[u] = (short)f2bf(f0[u] * __expf(Lm1));
        vBbT[u] = (short)f2bf(be[u] * f0[u] * __expf(LC - Lm1));
        vKbT[u] = (short)f2bf(f0[u] * __expf(LC - L));
        vXT[u] = (short)f2bf(be[u] * xv[u]);
        if (c == 0) { Lv[t] = L; Lm1v[t] = Lm1; betav[t] = be[u]; eLv[t] = __expf(L); }
      }
    }
    *(bf16x8*)(p4 + (c * CS + tg * 8) * 2) = vKtT;
    *(bf16x8*)(p5 + (c * CS + tg * 8) * 2) = vBbT;
    *(bf16x8*)(p6 + (c * CS + tg * 8) * 2) = vKbT;
    *(bf16x8*)(p7 + (c * CS + tg * 8) * 2) = vXT;
    if (tg == 0) gC[c] = __expf(LC);
    if (!GDN && tid < 64) { Lv[tid] = 0.f; Lm1v[tid] = 0.f; betav[tid] = 1.f; eLv[tid] = 1.f; }
  }
  LBAR();
  if (has_next) chunk_load<GDN>(pp, t_next, nx);
  {
    {
      MM_FRAGS(sKt, sBh, a0, a1, b00, b01, b10, b11)
      f32x4 c0 = {0.f, 0.f, 0.f, 0.f}, c1 = c0;
      MM_2TILES(c0, c1, a0, a1, b00, b01, b10, b11)
#pragma unroll
      for (int q = 0; q < 2; ++q) {
        const int sI = (nt0 + q) * 16 + fr;
        const f32x4 cv = q ? c1 : c0;
        f32x4 o;
#pragma unroll
        for (int r = 0; r < 4; ++r) {
          const int tI = mt * 16 + 4 * fq + r;
          float v = cv[r];
          if (GDN) v *= betav[sI] * __expf(fminf(Lm1v[tI] - Lm1v[sI], 0.f));
          o[r] = (sI < tI) ? v : 0.f;
        }
        *(f32x4*)(F0 + sI * F0_STRIDE + mt * 16 + 4 * fq) = o;
        wr_T(p11, mt, nt0 + q, fr, fq, o);
      }
    }
    {
      MM_FRAGS(sKt, sKh, a0, a1, b00, b01, b10, b11)
      f32x4 c0 = {0.f, 0.f, 0.f, 0.f}, c1 = c0;
      MM_2TILES(c0, c1, a0, a1, b00, b01, b10, b11)
#pragma unroll
      for (int q = 0; q < 2; ++q) {
        const int sI = (nt0 + q) * 16 + fr;
        const f32x4 cv = q ? c1 : c0;
        f32x4 o;
#pragma unroll
        for (int r = 0; r < 4; ++r) {
          const int tI = mt * 16 + 4 * fq + r;
          float v = cv[r];
          if (GDN) v *= __expf(fminf(Lm1v[tI] - Lv[sI], 0.f));
          o[r] = (sI < tI) ? v : 0.f;
        }
        wr_T(p9, mt, nt0 + q, fr, fq, o);
      }
    }
    {
      MM_FRAGS(sBh, p3, a0, a1, b00, b01, b10, b11)
      f32x4 c0 = {0.f, 0.f, 0.f, 0.f}, c1 = c0;
      MM_2TILES(c0, c1, a0, a1, b00, b01, b10, b11)
#pragma unroll
      for (int q = 0; q < 2; ++q) {
        const int tI = (nt0 + q) * 16 + fr;
        const f32x4 cv = q ? c1 : c0;
        f32x4 o;
#pragma unroll
        for (int r = 0; r < 4; ++r) {
          const int sI = mt * 16 + 4 * fq + r;
          float v = cv[r];
          if (GDN) v *= betav[sI] * __expf(fminf(Lv[tI] - Lm1v[sI], 0.f));
          o[r] = (sI <= tI) ? v : 0.f;
        }
        wr_T(p10, mt, nt0 + q, fr, fq, o);
      }
    }
  }
  LBAR();
  if (wv < 2) {
    const int base = wv * 32, other = 32 - base, c = lane & 31;
    float tr[32];
#pragma unroll
    for (int j = 0; j < 32; ++j) tr[j] = 0.f;
#pragma unroll
    for (int ip = 15; ip >= 0; --ip) {
      const int i = 2 * ip + 1, i2 = 2 * ip;
      float a0 = (c == i) ? 1.f : 0.f, a1 = 0.f, b0 = (c == i2) ? 1.f : 0.f, b1 = 0.f;
      const float aii = F0[(base + i2) * F0_STRIDE + base + i];
#pragma unroll
      for (int jb = ((i + 1) & ~3); jb < 32; jb += 4) {
        const f32x4 a4 = *(const f32x4*)(F0 + (base + i) * F0_STRIDE + base + jb);
        const f32x4 b4 = *(const f32x4*)(F0 + (base + i2) * F0_STRIDE + base + jb);
        a0 -= a4[0] * tr[jb]; a1 -= a4[1] * tr[jb + 1]; a0 -= a4[2] * tr[jb + 2]; a1 -= a4[3] * tr[jb + 3];
        b0 -= b4[0] * tr[jb]; b1 -= b4[1] * tr[jb + 1]; b0 -= b4[2] * tr[jb + 2]; b1 -= b4[3] * tr[jb + 3];
      }
      const float ti = a0 + a1;
      const float ti2 = (b0 + b1) - aii * ti;
      tr[i] = ti; tr[i2] = ti2;
      if (lane < 32) {
        *(bfr*)(p8 + ((base + i) * CS + base + c) * 2) = f2bf(ti);
        *(bfr*)(p8 + ((base + i) * CS + other + c) * 2) = (bfr)0;
        *(bfr*)(p8 + ((base + i2) * CS + base + c) * 2) = f2bf(ti2);
        *(bfr*)(p8 + ((base + i2) * CS + other + c) * 2) = (bfr)0;
      }
    }
    if (lane < 32) {
#pragma unroll
      for (int q = 0; q < 4; ++q) {
        bf16x8 o, z;
#pragma unroll
        for (int j = 0; j < 8; ++j) { o[j] = (short)f2bf(tr[8 * q + j]); z[j] = 0; }
        *(bf16x8*)(p12 + ((base + c) * CS + base + 8 * q) * 2) = o;
        *(bf16x8*)(p12 + ((base + c) * CS + other + 8 * q) * 2) = z;
      }
    }
  }
  LBAR();
  {
    MM_FRAGS(p11, p12, a0, a1, b00, b01, b10, b11)
    f32x4 c0 = {0.f, 0.f, 0.f, 0.f}, c1 = c0;
    MM_2TILES(c0, c1, a0, a1, b00, b01, b10, b11)
    wr_T(p1, mt, nt0, fr, fq, c0);
    wr_T(p1, mt, nt0 + 1, fr, fq, c1);
  }
  LBAR();
  if (mt < 2 && nt0 == 2) {
    MM_FRAGS(p8, p1, a0, a1, b00, b01, b10, b11)
    f32x4 c0 = {0.f, 0.f, 0.f, 0.f}, c1 = c0;
    MM_2TILES(c0, c1, a0, a1, b00, b01, b10, b11)
#pragma unroll
    for (int r = 0; r < 4; ++r) {
      *(bfr*)(p8 + ((mt * 16 + 4 * fq + r) * CS + (nt0) * 16 + fr) * 2) = f2bf(-c0[r]);
      *(bfr*)(p8 + ((mt * 16 + 4 * fq + r) * CS + (nt0 + 1) * 16 + fr) * 2) = f2bf(-c1[r]);
    }
  }
  LBAR();
  {
    {
      MM_FRAGS(p8, p5, a0, a1, b00, b01, b10, b11)
      f32x4 c0 = {0.f, 0.f, 0.f, 0.f}, c1 = c0;
      MM_2TILES(c0, c1, a0, a1, b00, b01, b10, b11)
      wr_T(p11, mt, nt0, fr, fq, -c0);
      wr_T(p11, mt, nt0 + 1, fr, fq, -c1);
    }
    {
      MM_FRAGS(p8, p10, a0, a1, b00, b01, b10, b11)
      f32x4 c0 = {0.f, 0.f, 0.f, 0.f}, c1 = c0;
      MM_2TILES(c0, c1, a0, a1, b00, b01, b10, b11)
      wr_T(p12, mt, nt0, fr, fq, -c0);
      wr_T(p12, mt, nt0 + 1, fr, fq, -c1);
    }
  }
  LBAR();
  {
    {
      MM_FRAGS(p4, p11, a0, a1, b00, b01, b10, b11)
      f32x4 c0 = {0.f, 0.f, 0.f, 0.f}, c1 = c0;
      MM_2TILES(c0, c1, a0, a1, b00, b01, b10, b11)
#pragma unroll
      for (int q = 0; q < 2; ++q) {
        const int cp = (nt0 + q) * 16 + fr;
        f32x4 cv = q ? c1 : c0;
#pragma unroll
        for (int r = 0; r < 4; ++r) { const int cI = mt * 16 + 4 * fq + r; if (cI == cp) cv[r] += gC[cI]; }
        wr_T(p10, mt, nt0 + q, fr, fq, cv);
      }
    }
    {
      MM_FRAGS(p9, p11, a0, a1, b00, b01, b10, b11)
      f32x4 c0 = {0.f, 0.f, 0.f, 0.f}, c1 = c0;
      MM_2TILES(c0, c1, a0, a1, b00, b01, b10, b11)
#pragma unroll
      for (int q = 0; q < 2; ++q) {
        const int cp = (nt0 + q) * 16 + fr;
        f32x4 cv = q ? c1 : c0;
        const bf16x4 kb = *(const bf16x4*)(p6 + (cp * CS + mt * 16 + 4 * fq) * 2);
#pragma unroll
        for (int r = 0; r < 4; ++r) cv[r] += __uint_as_float(((unsigned)(unsigned short)kb[r]) << 16);
        wr_T(p8, mt, nt0 + q, fr, fq, cv);
      }
    }
    {
      MM_FRAGS(p4, p12, a0, a1, b00, b01, b10, b11)
      f32x4 c0 = {0.f, 0.f, 0.f, 0.f}, c1 = c0;
      MM_2TILES(c0, c1, a0, a1, b00, b01, b10, b11)
#pragma unroll
      for (int q = 0; q < 2; ++q) {
        const int tI = (nt0 + q) * 16 + fr;
        f32x4 cv = q ? c1 : c0;
        const bf16x4 rt = *(const bf16x4*)(p3 + (tI * CS + mt * 16 + 4 * fq) * 2);
        const float el = eLv[tI];
#pragma unroll
        for (int r = 0; r < 4; ++r) cv[r] += __uint_as_float(((unsigned)(unsigned short)rt[r]) << 16) * el;
        wr_T(p1, mt, nt0 + q, fr, fq, cv);
      }
    }
    {
      f32x4 c0 = {0.f, 0.f, 0.f, 0.f}, c1 = c0;
      {
        MM_FRAGS(sKh, p3, a0, a1, b00, b01, b10, b11)
        MM_2TILES(c0, c1, a0, a1, b00, b01, b10, b11)
      }
#pragma unroll
      for (int q = 0; q < 2; ++q) {
        const int tI = (nt0 + q) * 16 + fr;
#pragma unroll
        for (int r = 0; r < 4; ++r) {
          const int sI = mt * 16 + 4 * fq + r;
          float v = q ? c1[r] : c0[r];
          if (GDN) v *= __expf(fminf(Lv[tI] - Lv[sI], 0.f));
          v = (sI <= tI) ? v : 0.f;
          if (q) c1[r] = v; else c0[r] = v;
        }
      }
      {
        MM_FRAGS(p9, p12, a0, a1, b00, b01, b10, b11)
        MM_2TILES(c0, c1, a0, a1, b00, b01, b10, b11)
      }
      wr_T(p5, mt, nt0, fr, fq, c0);
      wr_T(p5, mt, nt0 + 1, fr, fq, c1);
    }
  }
  LBAR();
  {
    {
      MM_FRAGS(p8, p7, a0, a1, b00, b01, b10, b11)
      f32x4 c0 = {0.f, 0.f, 0.f, 0.f}, c1 = c0;
      MM_2TILES(c0, c1, a0, a1, b00, b01, b10, b11)
      bfr* QT = (bfr*)(CH + cc * CH_REC + CH_QT);
      *(bf16x4*)(QT + ((mt * 4 + nt0) * 64 + lane) * 4) = pack4(c0[0], c0[1], c0[2], c0[3]);
      *(bf16x4*)(QT + ((mt * 4 + nt0 + 1) * 64 + lane) * 4) = pack4(c1[0], c1[1], c1[2], c1[3]);
    }
    {
      MM_FRAGS(p7, p5, a0, a1, b00, b01, b10, b11)
      f32x4 c0 = {0.f, 0.f, 0.f, 0.f}, c1 = c0;
      MM_2TILES(c0, c1, a0, a1, b00, b01, b10, b11)
      bfr* YX = (bfr*)(CH + cc * CH_REC + CH_YX);
      *(bf16x4*)(YX + ((mt * 4 + nt0) * 64 + lane) * 4) = pack4(c0[0], c0[1], c0[2], c0[3]);
      *(bf16x4*)(YX + ((mt * 4 + nt0 + 1) * 64 + lane) * 4) = pack4(c1[0], c1[1], c1[2], c1[3]);
    }
    {
      const int fm = wv >> 1, fa = wv & 1;
      const int row = fm * 16 + fr;
      {
        const bf16x4 lo = *(const bf16x4*)(p10 + (row * CS + 32 * fa + 4 * fq) * 2);
        const bf16x4 hi = *(const bf16x4*)(p10 + (row * CS + 32 * fa + 16 + 4 * fq) * 2);
        bf16x8 f; f[0] = lo[0]; f[1] = lo[1]; f[2] = lo[2]; f[3] = lo[3]; f[4] = hi[0]; f[5] = hi[1]; f[6] = hi[2]; f[7] = hi[3];
        *(bf16x8*)(CH + cc * CH_REC + CH_PT + (size_t)((fm * 2 + fa) * 64 + lane) * 16) = f;
      }
      {
        const bf16x4 lo = *(const bf16x4*)(p1 + (row * CS + 32 * fa + 4 * fq) * 2);
        const bf16x4 hi = *(const bf16x4*)(p1 + (row * CS + 32 * fa + 16 + 4 * fq) * 2);
        bf16x8 f; f[0] = lo[0]; f[1] = lo[1]; f[2] = lo[2]; f[3] = lo[3]; f[4] = hi[0]; f[5] = hi[1]; f[6] = hi[2]; f[7] = hi[3];
        *(bf16x8*)(CH + cc * CH_REC + CH_RYT + (size_t)((fm * 2 + fa) * 64 + lane) * 16) = f;
      }
    }
  }
  LBAR();
}

template <bool GDN>
__device__ __forceinline__ void chunk_prep_loop(PP pp, int t0, int tend, int nb, char* smem) {
  ChunkIn cur, nxt;
  if (t0 < tend) chunk_load<GDN>(pp, t0, cur);
  for (int t = t0; t < tend; t += nb) {
    const bool has_next = (t + nb) < tend;
    chunk_prep_task<GDN>(pp, t, t + nb, has_next, cur, nxt, smem);
    cur = nxt;
  }
}
__device__ __forceinline__ void phase_chunk_prep(PP pp, int bid, int nb, char* smem) {
  __syncthreads();
  const int half = (NCHAIN / 2) * NCHUNK;
  chunk_prep_loop<false>(pp, bid, half, nb, smem);
  const int k0 = (half - bid + nb - 1) / nb;
  chunk_prep_loop<true>(pp, bid + k0 * nb, NCHAIN * NCHUNK, nb, smem);
  __syncthreads();
}

#define X2_BUF 32768
#define X2_BAR() do { asm volatile("s_waitcnt lgkmcnt(0)" ::: "memory"); __builtin_amdgcn_s_barrier(); asm volatile("" ::: "memory"); } while (0)
__device__ __forceinline__ void chunk_seq_chain(PP pp, int chain, char* smem) {
  __syncthreads();
  const int tid = tid_opaque(), lane = tid & 63, wv = wave_id(tid);
  const int d = chain & 1, h = (chain >> 1) & 3, b = (chain >> 3) & 1, ty = chain >> 4;
  const char* CH = p.ws + OFF_CH;
  bfr* Y = (bfr*)(p.ws + OFF_S + (ty ? S_YGD : S_YRW)) + (size_t)d * NTOK * 256;
  const size_t c0 = (size_t)chain * NCHUNK;
  if (wv >= 4) {
    const int lw = wv - 4;
    const char* src0 = CH + c0 * CH_REC + (size_t)lane * 16;
#define X2_DMA(n) { const char* s_ = src0 + (size_t)(n) * CH_REC; LAS unsigned char* d_ = (LAS unsigned char*)smem + ((n) & 3) * X2_BUF;       \
      _Pragma("unroll") for (int i = 0; i < 8; ++i) {                                                                                       \
        const int piece = i * 4 + lw;                                                                                                       \
        __builtin_amdgcn_global_load_lds((const unsigned*)(s_ + piece * 1024), (LAS unsigned*)(d_ + piece * 1024), 16, 0, 0); } }
    X2_DMA(0) X2_DMA(1) X2_DMA(2)
    asm volatile("s_waitcnt vmcnt(16)" ::: "memory");
    X2_BAR();
    for (int n = 0; n < NCHUNK; ++n) {
      if (n + 3 < NCHUNK) { X2_DMA(n + 3) asm volatile("s_waitcnt vmcnt(16)" ::: "memory"); }
      else if (n + 2 < NCHUNK) asm volatile("s_waitcnt vmcnt(8)" ::: "memory");
      else asm volatile("s_waitcnt vmcnt(0)" ::: "memory");
      X2_BAR();
    }
#undef X2_DMA
  } else {
    const int vt = wv, fr = lane & 15, fq = lane >> 4;
    f32x4 Sacc[4];
#pragma unroll
    for (int i = 0; i < 4; ++i) Sacc[i] = (f32x4){0.f, 0.f, 0.f, 0.f};
    X2_BAR();
    for (int n = 0; n < NCHUNK; ++n) {
      const char* buf = smem + (n & 3) * X2_BUF;
      bf16x8 sB0, sB1;
#pragma unroll
      for (int j = 0; j < 4; ++j) {
        sB0[j] = (short)f2bf(Sacc[0][j]); sB0[4 + j] = (short)f2bf(Sacc[1][j]);
        sB1[j] = (short)f2bf(Sacc[2][j]); sB1[4 + j] = (short)f2bf(Sacc[3][j]);
      }
#pragma unroll
      for (int m = 0; m < 4; ++m) {
        const bf16x8 pa0 = *(const bf16x8*)(buf + ((m * 2 + 0) * 64 + lane) * 16);
        const bf16x8 pa1 = *(const bf16x8*)(buf + ((m * 2 + 1) * 64 + lane) * 16);
        const bf16x8 ra0 = *(const bf16x8*)(buf + 8192 + ((m * 2 + 0) * 64 + lane) * 16);
        const bf16x8 ra1 = *(const bf16x8*)(buf + 8192 + ((m * 2 + 1) * 64 + lane) * 16);
        const bf16x4 qb = *(const bf16x4*)(buf + 16384 + ((m * 4 + vt) * 64 + lane) * 8);
        const bf16x4 yb = *(const bf16x4*)(buf + 24576 + ((vt * 4 + m) * 64 + lane) * 8);
        f32x4 y = {bf2f(yb[0]), bf2f(yb[1]), bf2f(yb[2]), bf2f(yb[3])};
        y = __builtin_amdgcn_mfma_f32_16x16x32_bf16(sB0, ra0, y, 0, 0, 0);
        y = __builtin_amdgcn_mfma_f32_16x16x32_bf16(sB1, ra1, y, 0, 0, 0);
        f32x4 sn = {bf2f(qb[0]), bf2f(qb[1]), bf2f(qb[2]), bf2f(qb[3])};
        sn = __builtin_amdgcn_mfma_f32_16x16x32_bf16(pa0, sB0, sn, 0, 0, 0);
        sn = __builtin_amdgcn_mfma_f32_16x16x32_bf16(pa1, sB1, sn, 0, 0, 0);
        Sacc[m] = sn;
        {
          const int mm = scan_tok(b, d, n * 64 + m * 16 + fr);
          *(bf16x4*)(Y + (size_t)mm * 256 + h * 64 + vt * 16 + 4 * fq) = pack4(y[0], y[1], y[2], y[3]);
        }
      }
      X2_BAR();
    }
  }
}

struct NaPair { int mk0, mk1, tau0, tau1, kr0, kr1, ct0, ct1; };
struct NaFrag { bf16x8 k00, k01, k10, k11; bf16x4 v0[4], v1[4]; };

__device__ __forceinline__ void na_load(NaFrag& f, const bfr* KN, const bfr* VT, size_t vt_base, int h, int fr, int fq, const NaPair& pr) {
  const bfr* k0 = KN + (size_t)(pr.mk0 + fr) * 512 + h * 64 + fq * 8;
  const bfr* k1 = KN + (size_t)(pr.mk1 + fr) * 512 + h * 64 + fq * 8;
  f.k00 = *(const bf16x8*)(k0); f.k01 = *(const bf16x8*)(k0 + 32);
  f.k10 = *(const bf16x8*)(k1); f.k11 = *(const bf16x8*)(k1 + 32);
#pragma unroll
  for (int dt = 0; dt < 4; ++dt) {
    const int vo = (dt * 16 + fr) * 16 + fq * 4;
    f.v0[dt] = *(const bf16x4*)(VT + vt_base + (size_t)(pr.tau0 >> 4) * 1024 + vo);
    f.v1[dt] = *(const bf16x4*)(VT + vt_base + (size_t)(pr.tau1 >> 4) * 1024 + vo);
  }
}

__device__ __forceinline__ void na_compute(const NaFrag& f, const bf16x8 qf0, const bf16x8 qf1, bool local, bool vr0, bool vr1,
                                           int dr0, int dr1, int ct0, int ct1, int qc, int fq, const float* bias_h, f32x4 (&O)[4], float& lsum) {
  f32x4 z = {0.f, 0.f, 0.f, 0.f};
  f32x4 st0 = __builtin_amdgcn_mfma_f32_16x16x32_bf16(f.k00, qf0, z, 0, 0, 0);
  st0 = __builtin_amdgcn_mfma_f32_16x16x32_bf16(f.k01, qf1, st0, 0, 0, 0);
  f32x4 st1 = __builtin_amdgcn_mfma_f32_16x16x32_bf16(f.k10, qf0, z, 0, 0, 0);
  st1 = __builtin_amdgcn_mfma_f32_16x16x32_bf16(f.k11, qf1, st1, 0, 0, 0);
  bf16x8 pf;
  if (local) {
    const int cs = min(max(qc - 8, 0), 48);
#pragma unroll
    for (int r = 0; r < 4; ++r) {
      const int kc0 = ct0 * 16 + fq * 4 + r, kc1 = ct1 * 16 + fq * 4 + r;
      float p0 = 0.f, p1 = 0.f;
      if (vr0 && (unsigned)(kc0 - cs) < 16u) p0 = __builtin_amdgcn_exp2f(st0[r] + bias_h[dr0 * 31 + (kc0 - qc + 15)]);
      if (vr1 && (unsigned)(kc1 - cs) < 16u) p1 = __builtin_amdgcn_exp2f(st1[r] + bias_h[dr1 * 31 + (kc1 - qc + 15)]);
      lsum += p0 + p1;
      pf[r] = (short)f2bf(p0);
      pf[4 + r] = (short)f2bf(p1);
    }
  } else {
#pragma unroll
    for (int r = 0; r < 4; ++r) {
      const float p0 = __builtin_amdgcn_exp2f(st0[r]), p1 = __builtin_amdgcn_exp2f(st1[r]);
      lsum += p0 + p1;
      pf[r] = (short)f2bf(p0);
      pf[4 + r] = (short)f2bf(p1);
    }
  }
#pragma unroll
  for (int dt = 0; dt < 4; ++dt) {
    bf16x8 vf;
    vf[0] = f.v0[dt][0]; vf[1] = f.v0[dt][1]; vf[2] = f.v0[dt][2]; vf[3] = f.v0[dt][3];
    vf[4] = f.v1[dt][0]; vf[5] = f.v1[dt][1]; vf[6] = f.v1[dt][2]; vf[7] = f.v1[dt][3];
    O[dt] = __builtin_amdgcn_mfma_f32_16x16x32_bf16(vf, pf, O[dt], 0, 0, 0);
  }
}

__device__ __forceinline__ void na_block_task(PP pp, int task, const float* bias_lds) {
  const int tid = tid_opaque(), lane = tid & 63, wv = wave_id(tid);
  const int fr = lane & 15, fq = lane >> 4;
  char* S = p.ws + OFF_S;
  const bfr* QN = (const bfr*)(S + S_QN);
  const bfr* KN = (const bfr*)(S + S_KN);
  const bfr* VT = (const bfr*)(S + S_VT);
  bfr* CC = (bfr*)(p.ws + OFF_CC);
  const bool latent = task < 1024;
  int b, h, mqa, mqb, qra = 0, qrb = 0, cgp = 0;
  if (latent) {
    h = task & 7; const int quad = (task >> 3) & 63; b = task >> 9;
    qra = quad * 4 + (wv >> 2) * 2; qrb = qra + 1; cgp = wv & 3;
    mqa = b * SEQ + qra * 64 + cgp * 16; mqb = mqa + 64;
  } else {
    const int u = task - 1024;
    h = u & 7; b = u >> 3;
    mqa = NLAT + b * CTXL + (wv * 2) * 16; mqb = mqa + 16;
  }
  const bf16x8 qa0 = *(const bf16x8*)(QN + (size_t)(mqa + fr) * 512 + h * 64 + fq * 8);
  const bf16x8 qa1 = *(const bf16x8*)(QN + (size_t)(mqa + fr) * 512 + h * 64 + 32 + fq * 8);
  const bf16x8 qb0 = *(const bf16x8*)(QN + (size_t)(mqb + fr) * 512 + h * 64 + fq * 8);
  const bf16x8 qb1 = *(const bf16x8*)(QN + (size_t)(mqb + fr) * 512 + h * 64 + 32 + fq * 8);
  f32x4 Oa[4], Ob[4];
#pragma unroll
  for (int dt = 0; dt < 4; ++dt) { Oa[dt] = (f32x4){0.f, 0.f, 0.f, 0.f}; Ob[dt] = Oa[dt]; }
  float lsa = 0.f, lsb = 0.f;
  const size_t vt_base = (size_t)(b * 8 + h) * 64 * TTOK;
  const int rsa = min(max(qra - 4, 0), SEQ / 64 - 8), rsb = min(max(qrb - 4, 0), SEQ / 64 - 8);
  const int nrows = latent ? (rsb - rsa + 8) : 0;
  const int ct_first = (cgp <= 1) ? 0 : cgp - 1;
  const int nct = (cgp == 0 || cgp == 3) ? 2 : 3;
  const int ntile = nrows * nct;
  const int nlp = (ntile + 1) >> 1;
  const int npair = nlp + 8;
  const int qc = cgp * 16 + fr;
  auto mkpair = [&](int pi) {
    NaPair pr;
    if (pi < nlp) {
      const int i0 = 2 * pi, i1 = min(2 * pi + 1, ntile - 1);
      pr.kr0 = rsa + i0 / nct; pr.ct0 = ct_first + i0 % nct;
      pr.kr1 = rsa + i1 / nct; pr.ct1 = ct_first + i1 % nct;
      if (2 * pi + 1 >= ntile) pr.kr1 = -100;
      const int r1 = rsa + i1 / nct;
      pr.tau0 = pr.kr0 * 64 + pr.ct0 * 16; pr.tau1 = r1 * 64 + pr.ct1 * 16;
      pr.mk0 = b * SEQ + pr.tau0; pr.mk1 = b * SEQ + pr.tau1;
    } else {
      const int c = pi - nlp;
      pr.kr0 = pr.kr1 = pr.ct0 = pr.ct1 = 0;
      pr.tau0 = SEQ + c * 32; pr.tau1 = SEQ + c * 32 + 16;
      pr.mk0 = NLAT + b * CTXL + c * 32; pr.mk1 = pr.mk0 + 16;
    }
    return pr;
  };
  NaFrag fa, fb;
  NaPair pa = mkpair(0), pb;
  na_load(fa, KN, VT, vt_base, h, fr, fq, pa);
  const float* bias_h = bias_lds + h * 465;
#define NA_DO(F, PR, PI)                                                                                          \
  {                                                                                                               \
    const bool loc_ = (PI) < nlp;                                                                                 \
    na_compute(F, qa0, qa1, loc_, (unsigned)(PR.kr0 - rsa) < 8u, (unsigned)(PR.kr1 - rsa) < 8u,                   \
               PR.kr0 - qra + 7, PR.kr1 - qra + 7, PR.ct0, PR.ct1, qc, fq, bias_h, Oa, lsa);                      \
    na_compute(F, qb0, qb1, loc_, (unsigned)(PR.kr0 - rsb) < 8u, (unsigned)(PR.kr1 - rsb) < 8u,                   \
               PR.kr0 - qrb + 7, PR.kr1 - qrb + 7, PR.ct0, PR.ct1, qc, fq, bias_h, Ob, lsb);                      \
  }
  for (int pi = 0; pi < npair; pi += 2) {
    if (pi + 1 < npair) { pb = mkpair(pi + 1); na_load(fb, KN, VT, vt_base, h, fr, fq, pb); }
    NA_DO(fa, pa, pi)
    if (pi + 1 < npair) {
      if (pi + 2 < npair) { pa = mkpair(pi + 2); na_load(fa, KN, VT, vt_base, h, fr, fq, pa); }
      NA_DO(fb, pb, pi + 1)
    }
  }
#undef NA_DO
  lsa += shfl_xor_l(lsa, 16, lane); lsa += shfl_xor_l(lsa, 32, lane);
  lsb += shfl_xor_l(lsb, 16, lane); lsb += shfl_xor_l(lsb, 32, lane);
  const float ia = 1.f / lsa, ib = 1.f / lsb;
#pragma unroll
  for (int dt = 0; dt < 4; ++dt) {
    *(bf16x4*)(CC + (size_t)(mqa + fr) * 1024 + h * 64 + dt * 16 + fq * 4) = pack4(Oa[dt][0] * ia, Oa[dt][1] * ia, Oa[dt][2] * ia, Oa[dt][3] * ia);
    *(bf16x4*)(CC + (size_t)(mqb + fr) * 1024 + h * 64 + dt * 16 + fq * 4) = pack4(Ob[dt][0] * ib, Ob[dt][1] * ib, Ob[dt][2] * ib, Ob[dt][3] * ib);
  }
}

__device__ __forceinline__ void phase_mix(PP pp, int l, int bid, int nb, char* smem) {
  const int tid = tid_opaque();
  const int nscan_blocks = (nb > 32) ? 32 : nb;
  const int first_attn_block = (nb > 32) ? 32 : 0;
  if (bid < nscan_blocks) {
    for (int c = bid; c < NCHAIN; c += nscan_blocks) chunk_seq_chain(pp, c, smem);
  }
  if (bid >= first_attn_block) {
    float* bias = (float*)smem;
    __syncthreads();
    for (int i = tid; i < 8 * 465; i += NTHR) bias[i] = p.na_rpb[(size_t)l * 8 * 465 + i] * 1.4426950408889634f;
    __syncthreads();
    const int ntask = (l == 0) ? 1024 + 16 : 1024;
    const int nab = nb - first_attn_block;
    for (int t = bid - first_attn_block; t < ntask; t += nab) na_block_task(pp, t, bias);
    __syncthreads();
    phase_convert(pp, l, 1, bid - first_attn_block, nab, smem);
    if (l == 0) phase_convert(pp, 1, 0, bid - first_attn_block, nab, smem);
  }
}

__device__ __forceinline__ void phase_post(PP pp, int l, int bid, int nb) {
  const int tid = tid_opaque(), lane = tid & 63, wv = wave_id(tid);
  char* S = p.ws + OFF_S;
  const bfr* YRW = (const bfr*)(S + S_YRW);
  const bfr* YGD = (const bfr*)(S + S_YGD);
  const bfr* RWV = (const bfr*)(S + S_RWV);
  const bfr* RWG = (const bfr*)(S + S_RWG);
  const float* BON = (const float*)(S + S_BON);
  const bfr* P = (const bfr*)(p.ws + OFF_P);
  bfr* CC = (bfr*)(p.ws + OFF_CC);
  const float* ln_w = p.rw_ln_w + (size_t)l * 256;
  const float* ln_b = p.rw_ln_b + (size_t)l * 256;
  const float* ng = p.gd_norm_g + (size_t)l * 64;
  const int ntok = (l == 0) ? NTOK : NLAT;
  const int cb = lane * 4, hh = lane >> 4;
  const f32x4 lw4 = *(const f32x4*)(ln_w + cb), lb4 = *(const f32x4*)(ln_b + cb), ng4 = *(const f32x4*)(ng + (cb & 63));
  for (int m = bid * 8 + wv; m < ntok; m += nb * 8) {
    const size_t o = (size_t)m * 256 + cb;
    const f32x4 y0 = ldbf4(YRW + o), y1 = ldbf4(YRW + (size_t)NTOK * 256 + o);
    const f32x4 rv = ldbf4(RWV + o), rg = ldbf4(RWG + o);
    const f32x4 g0 = ldbf4(YGD + o), g1 = ldbf4(YGD + (size_t)NTOK * 256 + o);
    const f32x4 z = ldbf4(P + (size_t)m * PINP + B_END + 768 + cb);
    const float bon = BON[(size_t)m * 4 + hh];
    {
      const f32x4 y = y0 + y1;
      const float mean = row16_sum((y[0] + y[1]) + (y[2] + y[3])) * (1.f / 64.f);
      const f32x4 dv = y - mean;
      const float var = row16_sum((dv[0] * dv[0] + dv[1] * dv[1]) + (dv[2] * dv[2] + dv[3] * dv[3])) * (1.f / 64.f);
      const f32x4 out = ((dv * rsqrtf(var + 64e-5f)) * lw4 + lb4 + rv * bon) * rg;
      *(bf16x4*)(CC + (size_t)m * 1024 + 512 + cb) = pack4(out[0], out[1], out[2], out[3]);
    }
    {
      const f32x4 y = g0 + g1;
      const float ms = row16_sum((y[0] * y[0] + y[1] * y[1]) + (y[2] * y[2] + y[3] * y[3])) * (1.f / 64.f);
      const f32x4 sz = {siluf_(z[0]), siluf_(z[1]), siluf_(z[2]), siluf_(z[3])};
      const f32x4 out = (y * rsqrtf(ms + 1e-6f)) * ng4 * sz;
      *(bf16x4*)(CC + (size_t)m * 1024 + 768 + cb) = pack4(out[0], out[1], out[2], out[3]);
    }
  }
}

#define RW_LDS_ROW 36
__device__ __forceinline__ void phase_router(PP pp, int l, int bid, int nb, char* smem) {
  const int tid = tid_opaque(), lane = tid & 63, wv = wave_id(tid);
  const float* xl = p.out;
  const float* xc = (const float*)(p.ws + OFF_CTX);
  const float* mods = (const float*)(p.ws + OFF_MODS) + (size_t)l * 3 * 6144;
  const float* g = p.norm_ffn_g + (size_t)l * 1024;
  const float* rw = p.moe_router_w + (size_t)l * 1024 * 32;
  const float* rb = p.moe_router_b + (size_t)l * 32;
  bfr* H = (bfr*)(p.ws + OFF_H);
  int* cnt = (int*)(p.ws + OFF_CNT);
  int* TOKE = (int*)(p.ws + OFF_TOKE);
  int* TOKP = (int*)(p.ws + OFF_TOKP);
  float* TOKG = (float*)(p.ws + OFF_TOKG);
  float* wl = (float*)smem;
  for (int i = tid; i < 1024 * 8; i += NTHR) {
    int d = i >> 3, q = i & 7;
    *(float4*)(wl + d * RW_LDS_ROW + q * 4) = *(const float4*)(rw + (size_t)d * 32 + q * 4);
  }
  __syncthreads();
  const int ntok = (l == 0) ? NTOK : NLAT;
  const float rbl = rb[lane & 31];
  for (int m0 = (bid * 8 + wv) * 2; m0 < ntok; m0 += nb * 16) {
    float acc0[32], acc1[32];
#pragma unroll
    for (int e = 0; e < 32; ++e) { acc0[e] = 0.f; acc1[e] = 0.f; }
    float hv0[16], hv1[16];
    {
      const int ma = m0, mb = m0 + 1;
      const float* xa = (ma < NLAT) ? xl + (size_t)ma * 1024 : xc + (size_t)(ma - NLAT) * 1024;
      const float* xb = (mb < NLAT) ? xl + (size_t)mb * 1024 : xc + (size_t)(mb - NLAT) * 1024;
      const float* mda = mods + (size_t)mod_row(ma) * 6144 + 3072;
      const float* mdb = mods + (size_t)mod_row(mb) * 6144 + 3072;
      float ssa = 0.f, ssb = 0.f;
#pragma unroll
      for (int i = 0; i < 16; ++i) { hv0[i] = xa[lane + 64 * i]; hv1[i] = xb[lane + 64 * i]; }
#pragma unroll
      for (int i = 0; i < 16; ++i) { ssa += hv0[i] * hv0[i]; ssb += hv1[i] * hv1[i]; }
      ssa = wave_sum(ssa); ssb = wave_sum(ssb);
      const float rsa = rsqrtf(ssa * (1.f / 1024.f) + 1e-6f), rsb = rsqrtf(ssb * (1.f / 1024.f) + 1e-6f);
#pragma unroll
      for (int i = 0; i < 16; ++i) {
        const int d = lane + 64 * i;
        const float gg = g[d];
        hv0[i] = hv0[i] * rsa * gg * (1.f + mda[1024 + d]) + mda[d];
        hv1[i] = hv1[i] * rsb * gg * (1.f + mdb[1024 + d]) + mdb[d];
      }
      float am0 = 0.f, am1 = 0.f;
#pragma unroll
      for (int i = 0; i < 16; ++i) { am0 = fmaxf(am0, fabsf(hv0[i])); am1 = fmaxf(am1, fabsf(hv1[i])); }
      am0 = wave_max(am0); am1 = wave_max(am1);
      const float sc0 = am0 > 0.f ? am0 * (1.f / 127.f) : 1.f, sc1 = am1 > 0.f ? am1 * (1.f / 127.f) : 1.f;
      const float iv0 = 1.f / sc0, iv1 = 1.f / sc1;
      signed char* H8 = (signed char*)(p.ws + OFF_H);
#pragma unroll
      for (int i = 0; i < 16; ++i) {
        const int d = lane + 64 * i;
        H8[(size_t)ma * 1024 + d] = (signed char)(int)fminf(fmaxf(rintf(hv0[i] * iv0), -127.f), 127.f);
        H8[(size_t)mb * 1024 + d] = (signed char)(int)fminf(fmaxf(rintf(hv1[i] * iv1), -127.f), 127.f);
      }
      if (lane == 0) { float* SCL = (float*)(p.ws + OFF_SCL); SCL[ma] = sc0; SCL[mb] = sc1; }
      asm volatile("" ::: "memory");
    }
#pragma unroll
    for (int i = 0; i < 16; ++i) {
      if ((i & 3) == 0) asm volatile("" ::: "memory");
      const float* wr = wl + (lane + 64 * i) * RW_LDS_ROW;
#pragma unroll
      for (int q = 0; q < 8; ++q) {
        const float4 w = *(const float4*)(wr + q * 4);
        acc0[q * 4 + 0] += hv0[i] * w.x; acc0[q * 4 + 1] += hv0[i] * w.y; acc0[q * 4 + 2] += hv0[i] * w.z; acc0[q * 4 + 3] += hv0[i] * w.w;
        acc1[q * 4 + 0] += hv1[i] * w.x; acc1[q * 4 + 1] += hv1[i] * w.y; acc1[q * 4 + 2] += hv1[i] * w.z; acc1[q * 4 + 3] += hv1[i] * w.w;
      }
    }
#define BFLY(A, N, D)                                                                           \
    _Pragma("unroll") for (int i = 0; i < (N); ++i) {                                            \
      const bool up = (lane & (D)) != 0;                                                         \
      const float keep = up ? A[i + (N)] : A[i];                                                 \
      const float send = up ? A[i] : A[i + (N)];                                                 \
      A[i] = keep + shfl_xor_l(send, (D), lane);                                                   \
    }
    BFLY(acc0, 16, 16) BFLY(acc1, 16, 16)
    BFLY(acc0, 8, 8) BFLY(acc1, 8, 8)
    BFLY(acc0, 4, 4) BFLY(acc1, 4, 4)
    BFLY(acc0, 2, 2) BFLY(acc1, 2, 2)
    BFLY(acc0, 1, 1) BFLY(acc1, 1, 1)
#undef BFLY
    float la = acc0[0] + shfl_xor_l(acc0[0], 32, lane);
    float lb = acc1[0] + shfl_xor_l(acc1[0], 32, lane);
    const int my_e = lane & 31;
    la += rbl; lb += rbl;
    (void)my_e;
#pragma unroll
    for (int tkn = 0; tkn < 2; ++tkn) {
      float v = tkn == 0 ? la : lb;
      float tv[4]; int ti[4];
#pragma unroll
      for (int k = 0; k < 4; ++k) {
        float bv = v; int bi = lane & 31;
#pragma unroll
        for (int o = 16; o >= 1; o >>= 1) {
          float ov = shfl_xor_l(bv, o, lane); int oi = shfl_xor_li(bi, o, lane);
          bool take = (ov > bv) || (ov == bv && oi < bi);
          bv = take ? ov : bv; bi = take ? oi : bi;
        }
        tv[k] = bv; ti[k] = bi;
        if ((lane & 31) == bi) v = -3.0e38f;
      }
      float e1 = __expf(tv[1] - tv[0]), e2 = __expf(tv[2] - tv[0]), e3 = __expf(tv[3] - tv[0]);
      float inv = 1.f / (1.f + e1 + e2 + e3);
      const int m = m0 + tkn;
      if (lane < 4) {
        int e = lane == 0 ? ti[0] : lane == 1 ? ti[1] : lane == 2 ? ti[2] : ti[3];
        float gt = (lane == 0 ? 1.f : lane == 1 ? e1 : lane == 2 ? e2 : e3) * inv;
        int pos = atomicAdd(&cnt[e], 1);
        TOKE[(size_t)m * 4 + lane] = e; TOKP[(size_t)m * 4 + lane] = pos; TOKG[(size_t)m * 4 + lane] = gt;
      }
    }
  }
  __syncthreads();
}

__device__ __forceinline__ void moe_offsets(PP pp, int* toff) {
  const int* cnt = (const int*)(p.ws + OFF_CNT);
  if (tid_opaque() == 0) {
    int a = 0;
    for (int e = 0; e < 32; ++e) { toff[e] = a; a += (cnt[e] + 255) >> 8; }
    toff[32] = a;
  }
  __syncthreads();
}
__device__ __forceinline__ void moe_tile_experts(int* toff) {
  int* texp = toff + 128;
  const int ntile = toff[32];
  for (int mt = tid_opaque(); mt < ntile; mt += NTHR) {
    int e = 0;
#pragma unroll 1
    for (int k = 1; k < 32; ++k) e = (mt >= toff[k]) ? k : e;
    texp[mt] = e;
  }
  __syncthreads();
}

__device__ __forceinline__ void phase_slotfill(PP pp, int l, int bid, int nb, char* smem) {
  int* toff = (int*)smem;
  moe_offsets(pp, toff);
  const int tid = tid_opaque(), lane = tid & 63, wv = wave_id(tid);
  const int* TOKE = (const int*)(p.ws + OFF_TOKE);
  const int* TOKP = (const int*)(p.ws + OFF_TOKP);
  const float* TOKG = (const float*)(p.ws + OFF_TOKG);
  const int* cnt = (const int*)(p.ws + OFF_CNT);
  int* TOKS = (int*)(p.ws + OFF_TOKS);
  float* SLG = (float*)(p.ws + OFF_SLG);
  float* SLS = (float*)(p.ws + OFF_SLS);
  const float* SCL = (const float*)(p.ws + OFF_SCL);
  const signed char* H8 = (const signed char*)(p.ws + OFF_H);
  signed char* XG = (signed char*)(p.ws + OFF_S);
  const int n = ((l == 0) ? NTOK : NLAT) * 4;
  for (int i0 = (bid * 8 + wv) * 4; i0 < n; i0 += nb * 32) {
    const int tok = i0 >> 2;
    int sl4[4];
#pragma unroll
    for (int k = 0; k < 4; ++k) sl4[k] = toff[TOKE[i0 + k]] * 256 + TOKP[i0 + k];
    const uint4 row = *((const uint4*)(H8 + (size_t)tok * 1024) + lane);
    const float scl = SCL[tok];
    float g4[4];
#pragma unroll
    for (int k = 0; k < 4; ++k) g4[k] = TOKG[i0 + k];
#pragma unroll
    for (int k = 0; k < 4; ++k) {
      if (lane == 0) { TOKS[i0 + k] = sl4[k]; SLG[sl4[k]] = g4[k]; SLS[sl4[k]] = scl; }
      *((uint4*)(XG + (size_t)sl4[k] * 1024) + lane) = row;
    }
  }
  for (int e = 0; e < 32; ++e) {
    const int c = cnt[e];
    const int npad = ((c + 255) & ~255) - c;
    const int base = toff[e] * 256 + c;
    for (int r = bid * 8 + wv; r < npad; r += nb * 8) {
      uint4* dst = (uint4*)(XG + (size_t)(base + r) * 1024);
      dst[lane] = make_uint4(0u, 0u, 0u, 0u);
      if (lane == 0) SLS[base + r] = 0.f;
    }
  }
  __syncthreads();
}

struct EpiMoe1 {
  const float* bgu; const float* sw; const float* SLS; bfr* ACT;
  __device__ __forceinline__ void operator()(const i32x4 (&acc)[2][2][4][2], const g8::GUnit& u, int wr, int wc, int fr, int fq) const {
    const float* be = bgu + (size_t)u.e * 2048;
    const float* se = sw + (size_t)u.e * 2048;
    const int slot0 = u.pm * 256 + wr * 64 + fr;
    float sav[2][4];
#pragma unroll
    for (int ai = 0; ai < 2; ++ai)
#pragma unroll
      for (int m = 0; m < 4; ++m) sav[ai][m] = SLS[slot0 + ai * 128 + m * 16];
    f32x4 bgv[2], blv[2], sgv[2], slv[2];
#pragma unroll
    for (int bj = 0; bj < 2; ++bj) {
      const int j0 = u.pn * 128 + bj * 64 + wc * 16 + 4 * fq;
      bgv[bj] = *(const f32x4*)(be + j0); blv[bj] = *(const f32x4*)(be + 1024 + j0);
      sgv[bj] = *(const f32x4*)(se + j0); slv[bj] = *(const f32x4*)(se + 1024 + j0);
    }
#pragma unroll
    for (int bj = 0; bj < 2; ++bj) {
      const int j0 = u.pn * 128 + bj * 64 + wc * 16 + 4 * fq;
      const f32x4 bg = bgv[bj], bl = blv[bj];
      const f32x4 sg = sgv[bj], sl = slv[bj];
#pragma unroll
      for (int ai = 0; ai < 2; ++ai)
#pragma unroll
        for (int m = 0; m < 4; ++m) {
          const int slot = slot0 + ai * 128 + m * 16;
          const float sa = sav[ai][m];
          bf16x4 o;
#pragma unroll
          for (int q = 0; q < 4; ++q) {
            const float g = (float)acc[ai][bj][m][0][q] * (sa * sg[q]) + bg[q];
            const float li = (float)acc[ai][bj][m][1][q] * (sa * sl[q]) + bl[q];
            const float gv = fminf(g, 7.f);
            const float lv = fminf(fmaxf(li, -7.f), 7.f);
            o[q] = (short)f2bf(gv * sigmoidf_(1.702f * gv) * (lv + 1.f));
          }
          *(bf16x4*)(ACT + (size_t)slot * 1024 + j0) = o;
        }
    }
  }
};
__device__ __forceinline__ void phase_moe1_impl(PP pp, int l, int bid, int nb, char* smem, int* toff) {
  moe_offsets(pp, toff);
  moe_tile_experts(toff);
  g8::MoeSched S{toff, 8, 2048, nb, bid};
  EpiMoe1 E{p.moe_b_gu + (size_t)l * 32 * 2048, (const float*)(p.ws + OFF_SW) + (size_t)l * 32 * 2048, (const float*)(p.ws + OFF_SLS), (bfr*)(p.ws + OFF_P)};
  g8::gemm_stream<true>((LAS unsigned char*)smem, p.ws + OFF_S, p.ws + OFF_W + (size_t)l * WL_SIZE + WL_GU, S, E);
}

struct EpiMoe2 {
  const float* bdn; const float* SLG; bfr* YS;
  __device__ __forceinline__ void operator()(const f32x4 (&acc)[2][2][4][2], const g8::GUnit& u, int wr, int wc, int fr, int fq) const {
    const float* be = bdn + (size_t)u.e * 1024;
    const int slot0 = u.pm * 256 + wr * 64 + fr, col0 = u.pn * 256 + wc * 32 + 4 * fq;
    float gtv[2][4];
#pragma unroll
    for (int ai = 0; ai < 2; ++ai)
#pragma unroll
      for (int m = 0; m < 4; ++m) gtv[ai][m] = SLG[slot0 + ai * 128 + m * 16];
    f32x4 bvv[2][2];
#pragma unroll
    for (int bj = 0; bj < 2; ++bj)
#pragma unroll
      for (int n = 0; n < 2; ++n) bvv[bj][n] = *(const f32x4*)(be + col0 + bj * 128 + n * 16);
#pragma unroll
    for (int ai = 0; ai < 2; ++ai)
#pragma unroll
      for (int m = 0; m < 4; ++m) {
        const int slot = slot0 + ai * 128 + m * 16;
        const float gt = gtv[ai][m];
#pragma unroll
        for (int bj = 0; bj < 2; ++bj)
#pragma unroll
          for (int n = 0; n < 2; ++n) {
            const f32x4 bv = bvv[bj][n];
            const f32x4 yv = (acc[ai][bj][m][n] + bv) * gt;
            *(bf16x4*)(YS + (size_t)slot * 1024 + col0 + bj * 128 + n * 16) = pack4(yv[0], yv[1], yv[2], yv[3]);
          }
      }
  }
};
__device__ __forceinline__ void phase_moe2_impl(PP pp, int l, int bid, int nb, char* smem, int* toff) {
  moe_offsets(pp, toff);
  moe_tile_experts(toff);
  g8::MoeSched S{toff, 4, 1024, nb, bid};
  EpiMoe2 E{p.moe_b_down + (size_t)l * 32 * 1024, (const float*)(p.ws + OFF_SLG), (bfr*)(p.ws + OFF_S)};
  g8::gemm_stream<false>((LAS unsigned char*)smem, p.ws + OFF_P, p.ws + OFF_W + (size_t)l * WL_SIZE + WL_DN, S, E);
}

__device__ __forceinline__ void phase_combine(PP pp, int l, int bid, int nb) {
  const int tid = tid_opaque(), lane = tid & 63, wv = wave_id(tid);
  const bfr* YS = (const bfr*)(p.ws + OFF_S);
  const int* TOKS = (const int*)(p.ws + OFF_TOKS);
  const float* mods = (const float*)(p.ws + OFF_MODS) + (size_t)l * 3 * 6144;
  const float* mods1 = (const float*)(p.ws + OFF_MODS) + (size_t)3 * 6144;
  const float* g1n = p.norm_mix_g + 1024;
  bfr* H = (bfr*)(p.ws + OFF_H);
  float* xl = p.out;
  float* xc = (float*)(p.ws + OFF_CTX);
  const int ntok = (l == 0) ? NTOK : NLAT;
  if (l == 0) {
    int* cnt = (int*)(p.ws + OFF_CNT);
    const int gt = bid * NTHR + tid;
    if (gt < 32) cnt[gt] = 0;
  }
  for (int m = bid * 8 + wv; m < ntok; m += nb * 8) {
    float* xr = (m < NLAT) ? xl + (size_t)m * 1024 : xc + (size_t)(m - NLAT) * 1024;
    const float* g2 = mods + (size_t)mod_row(m) * 6144 + 5120;
    const int s0 = TOKS[(size_t)m * 4], s1 = TOKS[(size_t)m * 4 + 1], s2 = TOKS[(size_t)m * 4 + 2], s3 = TOKS[(size_t)m * 4 + 3];
    float4 xn[4];
    float ss = 0.f;
#pragma unroll
    for (int i = 0; i < 4; ++i) {
      const int d = (lane + 64 * i) * 4;
      const bf16x4 a = *(const bf16x4*)(YS + (size_t)s0 * 1024 + d);
      const bf16x4 b = *(const bf16x4*)(YS + (size_t)s1 * 1024 + d);
      const bf16x4 c = *(const bf16x4*)(YS + (size_t)s2 * 1024 + d);
      const bf16x4 e = *(const bf16x4*)(YS + (size_t)s3 * 1024 + d);
      const float4 gg = *(const float4*)(g2 + d);
      float4 xv = *(const float4*)(xr + d);
      xv.x += gg.x * ((bf2f(a[0]) + bf2f(b[0])) + (bf2f(c[0]) + bf2f(e[0])));
      xv.y += gg.y * ((bf2f(a[1]) + bf2f(b[1])) + (bf2f(c[1]) + bf2f(e[1])));
      xv.z += gg.z * ((bf2f(a[2]) + bf2f(b[2])) + (bf2f(c[2]) + bf2f(e[2])));
      xv.w += gg.w * ((bf2f(a[3]) + bf2f(b[3])) + (bf2f(c[3]) + bf2f(e[3])));
      *(float4*)(xr + d) = xv;
      xn[i] = xv;
      ss += xv.x * xv.x + xv.y * xv.y + xv.z * xv.z + xv.w * xv.w;
    }
    if (l == 0) {
      ss = wave_sum(ss);
      const float rs = rsqrtf(ss * (1.f / 1024.f) + 1e-6f);
      const float* md = mods1 + (size_t)mod_row(m) * 6144;
      float4 hq[4];
#pragma unroll
      for (int i = 0; i < 4; ++i) {
        const int d = (lane + 64 * i) * 4;
        const float4 gg = *(const float4*)(g1n + d);
        const float4 sh = *(const float4*)(md + d);
        const float4 sc = *(const float4*)(md + 1024 + d);
        hq[i] = make_float4(xn[i].x * rs * gg.x * (1.f + sc.x) + sh.x, xn[i].y * rs * gg.y * (1.f + sc.y) + sh.y,
                            xn[i].z * rs * gg.z * (1.f + sc.z) + sh.z, xn[i].w * rs * gg.w * (1.f + sc.w) + sh.w);
      }
      const float qs = quant_row_store(hq, (signed char*)(p.ws + OFF_H) + (size_t)m * 1024, lane);
      if (lane == 0) ((float*)(p.ws + OFF_SCL))[m] = qs;
    }
  }
}

#define XB_TMO      128
#define XB_XCNT(j)  (256  + 64 * (j))
#define XB_XSUB(j)  (1280 + 64 * (j))
#define XB_XGEN(j)  (2304 + 64 * (j))
#define XB_TOP      3328
#define XB_TOPGEN   3392
#define XCD_BAR_WORDS 3456
#define XB_SPIN_CAP (1u << 22)
__device__ __forceinline__ unsigned xb_ld(unsigned* q) { return __hip_atomic_load(q, __ATOMIC_RELAXED, __HIP_MEMORY_SCOPE_AGENT); }
__device__ __forceinline__ unsigned xb_add(unsigned* q, unsigned v) { return __hip_atomic_fetch_add(q, v, __ATOMIC_RELAXED, __HIP_MEMORY_SCOPE_AGENT); }
__device__ __forceinline__ unsigned xb_xcc_id() { return (unsigned)__builtin_amdgcn_s_getreg((3 << 11) | 20) & 0xFu; }
#define XB_SPIN(cond, bar) do { unsigned _sp = 0; while (cond) { __builtin_amdgcn_s_sleep(1); \
    if ((++_sp & 255u) == 0u) { if (xb_ld(&(bar)[XB_TMO])) break; if (_sp > XB_SPIN_CAP) { atomicAdd(&(bar)[XB_TMO], 1u); break; } } } } while (0)
struct XcdBarrier { unsigned* bar; unsigned x; volatile LAS unsigned* st; };
__device__ __forceinline__ XcdBarrier xcd_barrier_post(unsigned* bar, volatile LAS unsigned* st) {
  XcdBarrier b; b.bar = bar; b.x = xb_xcc_id(); b.st = st;
  if (tid_opaque() == 0) (void)xb_add(&bar[XB_XCNT(b.x)], 1u);
  return b;
}
__device__ __forceinline__ void xcd_barrier_complete(unsigned* bar, unsigned x, unsigned& nloc, unsigned& nx) {
  const unsigned G = gridDim.x;
  unsigned sum, cnt, mine, sp = 0u;
  for (;;) {
    sum = 0u; cnt = 0u; mine = 0u;
#pragma unroll
    for (unsigned j = 0; j < 16; ++j) { const unsigned c = xb_ld(&bar[XB_XCNT(j)]); sum += c; cnt += (c > 0u) ? 1u : 0u; mine = (j == x) ? c : mine; }
    if (sum == G) break;
    __builtin_amdgcn_s_sleep(1);
    if ((++sp & 255u) == 0u) { if (xb_ld(&bar[XB_TMO])) break; if (sp > XB_SPIN_CAP) { atomicAdd(&bar[XB_TMO], 1u); break; } }
  }
  nloc = mine > 0u ? mine : 1u; nx = cnt > 0u ? cnt : 1u;
}
__device__ __forceinline__ void xcd_barrier(const XcdBarrier& b) {
  asm volatile("s_waitcnt vmcnt(0)" ::: "memory");
  __syncthreads();
  if (tid_opaque() == 0) {
    unsigned* bar = b.bar;
    __builtin_amdgcn_s_waitcnt(0);
    unsigned nloc = b.st[0], nx = b.st[1];
    if (nloc == 0u) { xcd_barrier_complete(bar, b.x, nloc, nx); b.st[0] = nloc; b.st[1] = nx; }
    const unsigned old = xb_add(&bar[XB_XSUB(b.x)], 1u);
    const unsigned gen = old / nloc;
    if (old + 1u == (gen + 1u) * nloc) {
      __builtin_amdgcn_fence(__ATOMIC_RELEASE, "agent");
      asm volatile("s_waitcnt vmcnt(0)" ::: "memory");
      const unsigned og = xb_add(&bar[XB_TOP], 1u);
      const unsigned tg = og / nx;
      if (og + 1u == (tg + 1u) * nx) xb_add(&bar[XB_TOPGEN], 1u);
      else XB_SPIN(xb_ld(&bar[XB_TOPGEN]) == tg, bar);
      __builtin_amdgcn_fence(__ATOMIC_ACQUIRE, "agent");
      xb_add(&bar[XB_XGEN(b.x)], 1u);
      asm volatile("s_waitcnt vmcnt(0)" ::: "memory");
    } else {
      XB_SPIN(xb_ld(&bar[XB_XGEN(b.x)]) == gen, bar);
      __builtin_amdgcn_fence(__ATOMIC_ACQUIRE, "agent");
      asm volatile("s_waitcnt vmcnt(0)" ::: "memory");
    }
  }
  __syncthreads();
}

extern __shared__ __attribute__((aligned(16))) char dyn_smem[];

__global__ void __launch_bounds__(NTHR) mega(Params p_unused) {
  cg::grid_group grid = cg::this_grid();
  const int bid0 = blockIdx.x, nb0 = gridDim.x;
#if defined(__HIP_DEVICE_COMPILE__)
  PP pp0 = (PP)__builtin_amdgcn_kernarg_segment_ptr();
#else
  PP pp0 = nullptr;
#endif
#define pp ({ PP q_ = pp0; asm volatile("" : "+s"(q_)); q_; })
#define bid opq(bid0)
#define nb opq(nb0)
  int* toff_s = (int*)(dyn_smem + 147456);
  volatile LAS unsigned* xb_st = (volatile LAS unsigned*)(dyn_smem + 147456 + 256);
  {
    unsigned* barw = (unsigned*)(fresh_ws(pp0) + OFF_BAR);
    if (blockIdx.x == 0) for (int i = threadIdx.x; i < XCD_BAR_WORDS; i += NTHR) barw[i] = 0u;
    if (threadIdx.x == 0) { xb_st[0] = 0u; xb_st[1] = 0u; }
  }
  grid.sync();
  const XcdBarrier xb = xcd_barrier_post((unsigned*)(fresh_ws(pp0) + OFF_BAR), xb_st);
#define GSYNC() xcd_barrier(xb)
  phase_ada(pp, bid, nb, dyn_smem);
  phase_convert(pp, 0, 0, bid, nb, dyn_smem);
  GSYNC();
#define LAYER(LV, LAST)                                      \
  {                                                          \
    if ((LV) == 0) { phase_prenorm(pp, opq(LV), bid, nb); GSYNC(); } \
    phase_gemm_in(pp, opq(LV), bid, nb, dyn_smem);           \
    GSYNC();                                                 \
    phase_prep(pp, opq(LV), bid, nb, dyn_smem);              \
    GSYNC();                                                 \
    phase_chunk_prep(pp, bid, nb, dyn_smem);                 \
    GSYNC();                                                 \
    phase_mix(pp, opq(LV), bid, nb, dyn_smem);               \
    GSYNC();                                                 \
    phase_post(pp, opq(LV), bid, nb);                        \
    GSYNC();                                                 \
    phase_gemm_out(pp, opq(LV), bid, nb, dyn_smem);          \
    GSYNC();                                                 \
    phase_router(pp, opq(LV), bid, nb, dyn_smem);            \
    GSYNC();                                                 \
    phase_slotfill(pp, opq(LV), bid, nb, dyn_smem);          \
    GSYNC();                                                 \
    phase_moe1_impl(pp, opq(LV), bid, nb, dyn_smem, toff_s); \
    GSYNC();                                                 \
    phase_moe2_impl(pp, opq(LV), bid, nb, dyn_smem, toff_s); \
    GSYNC();                                                 \
    phase_combine(pp, opq(LV), bid, nb);                     \
    if (!(LAST)) GSYNC();                                    \
  }
  LAYER(0, false)
  LAYER(1, true)
#undef LAYER
#undef GSYNC
#undef bid
#undef nb
#undef pp
}

#undef p
extern "C" void kernel_launch(void* const* d_in, const int* in_sizes, int n_in, void* d_out, int out_size, void* d_ws,
                              size_t ws_size, hipStream_t stream) {
  Params hp{};
  const float** pp = (const float**)&hp;
  for (int i = 0; i < 34; ++i) pp[i] = (const float*)d_in[i];
  hp.out = (float*)d_out;
  hp.ws = (char*)d_ws;
  static int grid_blocks = 0;
  if (!grid_blocks) {
    (void)hipFuncSetAttribute((const void*)mega, hipFuncAttributeMaxDynamicSharedMemorySize, LDS_BYTES);
    int dev = 0, cus = 0, per_cu = 0;
    (void)hipGetDevice(&dev);
    (void)hipDeviceGetAttribute(&cus, hipDeviceAttributeMultiprocessorCount, dev);
    (void)hipOccupancyMaxActiveBlocksPerMultiprocessor(&per_cu, mega, NTHR, LDS_BYTES);
    if (per_cu < 1) per_cu = 1;
    if (per_cu > 1) per_cu = 1;
    grid_blocks = cus * per_cu;
  }
  void* args[] = {&hp};
  (void)hipLaunchCooperativeKernel((void*)mega, dim3(grid_blocks), dim3(NTHR), args, LDS_BYTES, stream);
}
```

```cpp
#include <hip/hip_runtime.h>
#include <hip/hip_bf16.h>
#include <hip/hip_cooperative_groups.h>
#include <stdint.h>
#include <type_traits>
namespace cg = cooperative_groups;

typedef __attribute__((ext_vector_type(8))) short bf16x8;
typedef __attribute__((ext_vector_type(4))) short bf16x4;
typedef __attribute__((ext_vector_type(4))) float f32x4;
typedef __attribute__((ext_vector_type(4))) int i32x4;
typedef unsigned short bfr;

#define D_MODEL 1024
#define NB 2
#define SEQ 16384
#define CTXL 256
#define NLAT (NB * SEQ)
#define NCTX (NB * CTXL)
#define NTOK (NLAT + NCTX)
#define TTOK (SEQ + CTXL)
#define PIN 3472
#define PINP 3584
#define A_END 1536
#define B_END 2432
#define NEXP 32
#define NSLOT_MAX (NTOK * 4 + NEXP * 256)
#define NTHR 512
#define LDS_BYTES (147456 + 3072)

constexpr size_t al256(size_t x) { return (x + 255) & ~(size_t)255; }
constexpr size_t WL_IN = 0;
constexpr size_t WL_OUT = WL_IN + (size_t)PINP * 1024 * 2;
constexpr size_t WL_GU = WL_OUT + (size_t)1024 * 1024 * 2;
constexpr size_t WL_DN = WL_GU + (size_t)32 * 2048 * 1024 * 2;
constexpr size_t WL_SIZE = WL_DN + (size_t)32 * 1024 * 1024 * 2;
constexpr size_t OFF_W = 0;
constexpr size_t OFF_MODS = al256(OFF_W + 2 * WL_SIZE);
constexpr size_t OFF_BAR = al256(OFF_MODS + 2 * 3 * 6144 * 4);
constexpr size_t OFF_SW = al256(OFF_BAR + 3456 * 4);
constexpr size_t OFF_SWIN = al256(OFF_SW + (size_t)2 * 32 * 2048 * 4);
constexpr size_t OFF_SLS = al256(OFF_SWIN + (size_t)2 * PINP * 4);
constexpr size_t OFF_SCL = al256(OFF_SLS + (size_t)(NTOK * 4 + 32 * 256) * 4);
constexpr size_t OFF_CTX = al256(OFF_SCL + (size_t)NTOK * 4);
constexpr size_t OFF_CNT = al256(OFF_CTX + (size_t)NCTX * 1024 * 4);
constexpr size_t OFF_TOKE = al256(OFF_CNT + 256);
constexpr size_t OFF_TOKP = al256(OFF_TOKE + (size_t)NTOK * 4 * 4);
constexpr size_t OFF_TOKG = al256(OFF_TOKP + (size_t)NTOK * 4 * 4);
constexpr size_t OFF_TOKS = al256(OFF_TOKG + (size_t)NTOK * 4 * 4);
constexpr size_t OFF_SLT = al256(OFF_TOKS + (size_t)NTOK * 4 * 4);
constexpr size_t OFF_SLG = al256(OFF_SLT + (size_t)NSLOT_MAX * 4);
constexpr size_t OFF_H = al256(OFF_SLG + (size_t)NSLOT_MAX * 4);
constexpr size_t OFF_CC = al256(OFF_H + (size_t)NTOK * 1024 * 2);
constexpr size_t OFF_P = al256(OFF_CC + (size_t)NTOK * 1024 * 2);
constexpr size_t OFF_S = al256(OFF_P + (size_t)NTOK * PINP * 4);
constexpr size_t TOK256F = (size_t)NTOK * 256 * 4;
constexpr size_t S_QN = 0;
constexpr size_t S_KN = S_QN + (size_t)NTOK * 512 * 2;
constexpr size_t S_VT = S_KN + (size_t)NTOK * 512 * 2;
constexpr size_t S_RWR = S_VT + (size_t)NB * 8 * 64 * TTOK * 2;
constexpr size_t S_RWKK = S_RWR + TOK256F;
constexpr size_t S_RWV = S_RWKK + TOK256F;
constexpr size_t S_RWG = S_RWV + TOK256F;
constexpr size_t S_RWW = S_RWG + TOK256F;
constexpr size_t S_RWKD = S_RWW + 2 * TOK256F;
constexpr size_t S_RWB = S_RWKD + 2 * TOK256F;
constexpr size_t S_BON = S_RWB + 2 * TOK256F;
constexpr size_t S_GDQ = al256(S_BON + (size_t)NTOK * 4 * 4);
constexpr size_t S_GDK = S_GDQ + TOK256F;
constexpr size_t S_GDV = S_GDK + TOK256F;
constexpr size_t S_GDAB = S_GDV + TOK256F;
constexpr size_t S_YRW = al256(S_GDAB + (size_t)NTOK * 16 * 4);
constexpr size_t S_YGD = S_YRW + 2 * TOK256F;
constexpr size_t S_END = S_YGD + 2 * TOK256F;
constexpr size_t S_SIZE = (S_END > (size_t)NSLOT_MAX * 1024 * 4) ? S_END : (size_t)NSLOT_MAX * 1024 * 4;
constexpr int NCHUNK = TTOK / 64;
constexpr int NCHAIN = 32;
constexpr size_t OFF_CH = al256(OFF_S + S_SIZE);
constexpr size_t CH_N = (size_t)NCHAIN * NCHUNK;
constexpr size_t CH_REC = 32768, CH_PT = 0, CH_RYT = 8192, CH_QT = 16384, CH_YX = 24576;
constexpr size_t CH_SIZE = CH_N * CH_REC;
constexpr size_t WS_TOTAL = OFF_CH + CH_SIZE;
static_assert(WS_TOTAL <= (size_t)2048 * 1024 * 1024, "workspace exceeds 4x largest tensor");

struct Params {
  const float *x, *c, *ctx, *c_ctx, *ada_w, *ada_b, *norm_mix_g, *norm_ffn_g, *w_in, *w_out;
  const float *na_q_gain, *na_k_gain, *na_rpb;
  const float *rw_mu, *rw_w0, *rw_w_up, *rw_a0, *rw_a_up, *rw_g_up, *rw_k_k, *rw_k_a, *rw_r_k, *rw_ln_w, *rw_ln_b;
  const float *gd_conv_w, *gd_A_log, *gd_dt_bias, *gd_norm_g;
  const float *moe_router_w, *moe_router_b, *moe_w_gu, *moe_b_gu, *moe_w_down, *moe_b_down;
  float* out;
  char* ws;
};

typedef const __attribute__((address_space(4))) Params* PP;
#define p (*pp)
__device__ __forceinline__ char* fresh_ws(PP pp) { return p.ws; }
__device__ __forceinline__ int tid_opaque() { int t = (int)__builtin_amdgcn_workitem_id_x(); asm volatile("" : "+v"(t)); return t; }
__device__ __forceinline__ int opq(int x) { asm volatile("" : "+s"(x)); return x; }
__device__ __forceinline__ int wave_id(int tid) { return __builtin_amdgcn_readfirstlane(tid >> 6); }
typedef __bf16 bf16v2_t __attribute__((ext_vector_type(2)));
typedef float f32v2_t __attribute__((ext_vector_type(2)));
__device__ __forceinline__ unsigned pk_bf16(float lo, float hi) { f32v2_t v = {lo, hi}; return __builtin_bit_cast(unsigned, __builtin_convertvector(v, bf16v2_t)); }
__device__ __forceinline__ bfr f2bf(float f) { return (bfr)(pk_bf16(f, f) & 0xffffu); }
__device__ __forceinline__ float bf2f(short v) { return __uint_as_float(((unsigned)(unsigned short)v) << 16); }
__device__ __forceinline__ bf16x4 pack4(float a, float b, float c, float d) {
  typedef __attribute__((ext_vector_type(2))) unsigned u32x2;
  u32x2 w; w[0] = pk_bf16(a, b); w[1] = pk_bf16(c, d);
  return __builtin_bit_cast(bf16x4, w);
}
__device__ __forceinline__ float sigmoidf_(float x) { return __builtin_amdgcn_rcpf(1.f + __expf(-x)); }
__device__ __forceinline__ float siluf_(float x) { return x * __builtin_amdgcn_rcpf(1.f + __expf(-x)); }
__device__ __forceinline__ float softplusf_(float x) { const float e = __expf(fminf(x, 20.f)); const float lg = __logf(1.f + e); const float r = x < -15.f ? e : lg; return x > 20.f ? x : r; }
__device__ __forceinline__ float wave_sum(float v) {
  v += __builtin_bit_cast(float, __builtin_amdgcn_update_dpp(0, __builtin_bit_cast(int, v), 0xB1, 0xF, 0xF, true));
  v += __builtin_bit_cast(float, __builtin_amdgcn_update_dpp(0, __builtin_bit_cast(int, v), 0x4E, 0xF, 0xF, true));
  v += __builtin_bit_cast(float, __builtin_amdgcn_update_dpp(0, __builtin_bit_cast(int, v), 0x141, 0xF, 0xF, true));
  v += __builtin_bit_cast(float, __builtin_amdgcn_update_dpp(0, __builtin_bit_cast(int, v), 0x140, 0xF, 0xF, true));
  v += __builtin_bit_cast(float, __builtin_amdgcn_update_dpp(0, __builtin_bit_cast(int, v), 0x142, 0xA, 0xF, false));
  v += __builtin_bit_cast(float, __builtin_amdgcn_update_dpp(0, __builtin_bit_cast(int, v), 0x143, 0xC, 0xF, false));
  return __builtin_bit_cast(float, __builtin_amdgcn_readlane(__builtin_bit_cast(int, v), 63));
}
__device__ __forceinline__ float wave_max(float v) {
  v = fmaxf(v, __builtin_bit_cast(float, __builtin_amdgcn_update_dpp(0, __builtin_bit_cast(int, v), 0xB1, 0xF, 0xF, true)));
  v = fmaxf(v, __builtin_bit_cast(float, __builtin_amdgcn_update_dpp(0, __builtin_bit_cast(int, v), 0x4E, 0xF, 0xF, true)));
  v = fmaxf(v, __builtin_bit_cast(float, __builtin_amdgcn_update_dpp(0, __builtin_bit_cast(int, v), 0x141, 0xF, 0xF, true)));
  v = fmaxf(v, __builtin_bit_cast(float, __builtin_amdgcn_update_dpp(0, __builtin_bit_cast(int, v), 0x140, 0xF, 0xF, true)));
  const float r1 = __builtin_bit_cast(float, __builtin_amdgcn_readlane(__builtin_bit_cast(int, v), 0));
  const float r2 = __builtin_bit_cast(float, __builtin_amdgcn_readlane(__builtin_bit_cast(int, v), 16));
  const float r3 = __builtin_bit_cast(float, __builtin_amdgcn_readlane(__builtin_bit_cast(int, v), 32));
  const float r4 = __builtin_bit_cast(float, __builtin_amdgcn_readlane(__builtin_bit_cast(int, v), 48));
  return fmaxf(fmaxf(r1, r2), fmaxf(r3, r4));
}
__device__ __forceinline__ float shfl_xor_l(float v, int mask, int lane) {
  return __builtin_bit_cast(float, __builtin_amdgcn_ds_bpermute((lane ^ mask) << 2, __builtin_bit_cast(int, v)));
}
__device__ __forceinline__ int shfl_xor_li(int v, int mask, int lane) {
  return __builtin_amdgcn_ds_bpermute((lane ^ mask) << 2, v);
}
__device__ __forceinline__ float row16_sum(float v) {
  v += __builtin_bit_cast(float, __builtin_amdgcn_update_dpp(0, __builtin_bit_cast(int, v), 0xB1, 0xF, 0xF, true));
  v += __builtin_bit_cast(float, __builtin_amdgcn_update_dpp(0, __builtin_bit_cast(int, v), 0x4E, 0xF, 0xF, true));
  v += __builtin_bit_cast(float, __builtin_amdgcn_update_dpp(0, __builtin_bit_cast(int, v), 0x141, 0xF, 0xF, true));
  v += __builtin_bit_cast(float, __builtin_amdgcn_update_dpp(0, __builtin_bit_cast(int, v), 0x140, 0xF, 0xF, true));
  return v;
}
__device__ __forceinline__ float quant_row_store(const float4 (&v)[4], signed char* dst_row, int lane) {
  float am = 0.f;
#pragma unroll
  for (int i = 0; i < 4; ++i) am = fmaxf(fmaxf(am, fmaxf(fabsf(v[i].x), fabsf(v[i].y))), fmaxf(fabsf(v[i].z), fabsf(v[i].w)));
  am = wave_max(am);
  const float sc = am > 0.f ? am * (1.f / 127.f) : 1.f, iv = 1.f / sc;
#pragma unroll
  for (int i = 0; i < 4; ++i) {
    const int q0 = (int)fminf(fmaxf(rintf(v[i].x * iv), -127.f), 127.f), q1 = (int)fminf(fmaxf(rintf(v[i].y * iv), -127.f), 127.f);
    const int q2 = (int)fminf(fmaxf(rintf(v[i].z * iv), -127.f), 127.f), q3 = (int)fminf(fmaxf(rintf(v[i].w * iv), -127.f), 127.f);
    *(unsigned*)(dst_row + (lane + 64 * i) * 4) = (unsigned)(q0 & 0xff) | ((unsigned)(q1 & 0xff) << 8) | ((unsigned)(q2 & 0xff) << 16) | ((unsigned)(q3 & 0xff) << 24);
  }
  return sc;
}
__device__ __forceinline__ float ldbf1(const bfr* q, size_t i) { return bf2f((short)q[i]); }
__device__ __forceinline__ f32x4 ldbf4(const bfr* q) { const bf16x4 v = *(const bf16x4*)q; return (f32x4){bf2f(v[0]), bf2f(v[1]), bf2f(v[2]), bf2f(v[3])}; }
__device__ __forceinline__ int mod_row(int m) { return m < NLAT ? (m >> 14) : 2; }

__device__ __forceinline__ void phase_ada(PP pp, int bid, int nb, char* smem) {
  float* red = (float*)smem;
  float* mods = (float*)(p.ws + OFF_MODS);
  const int tid = tid_opaque();
  for (int task = bid; task < 2 * 96; task += nb) {
    int l = task / 96, cgp = task % 96;
    int col = cgp * 64 + (tid & 63), ks = tid >> 6;
    const float* W = p.ada_w + (size_t)l * 1024 * 6144;
    float a0 = 0.f, a1 = 0.f, a2 = 0.f;
    for (int d = ks * 128; d < ks * 128 + 128; ++d) {
      float w = W[(size_t)d * 6144 + col];
      a0 += siluf_(p.c[d]) * w;
      a1 += siluf_(p.c[1024 + d]) * w;
      a2 += siluf_(p.c_ctx[d]) * w;
    }
    red[(ks * 3 + 0) * 64 + (tid & 63)] = a0;
    red[(ks * 3 + 1) * 64 + (tid & 63)] = a1;
    red[(ks * 3 + 2) * 64 + (tid & 63)] = a2;
    __syncthreads();
    if (tid < 192) {
      int r = tid >> 6, cc = tid & 63;
      float s = 0.f;
      for (int k = 0; k < 8; ++k) s += red[(k * 3 + r) * 64 + cc];
      mods[(size_t)(l * 3 + r) * 6144 + cgp * 64 + cc] = s + p.ada_b[(size_t)l * 6144 + cgp * 64 + cc];
    }
    __syncthreads();
  }
}

__device__ __forceinline__ void convert_tile(const float* src, int N, bfr* dst, int kt4  , int nt, float* tile  ) {
  const int tid = tid_opaque();
  float4 v[8];
#pragma unroll
  for (int q = 0; q < 8; ++q) {
    const int idx = tid + q * 512;
    const int kk = idx >> 4, n4 = idx & 15;
    v[q] = *(const float4*)(src + (size_t)(kt4 * 256 + kk) * N + nt * 64 + n4 * 4);
  }
#pragma unroll
  for (int q = 0; q < 8; ++q) {
    const int idx = tid + q * 512;
    const int kk = idx >> 4, n4 = idx & 15;
    tile[kk * 65 + n4 * 4 + 0] = v[q].x; tile[kk * 65 + n4 * 4 + 1] = v[q].y;
    tile[kk * 65 + n4 * 4 + 2] = v[q].z; tile[kk * 65 + n4 * 4 + 3] = v[q].w;
  }
  __syncthreads();
  {
    const int nn = tid >> 3, kc = tid & 7;
    const int n = nt * 64 + nn;
#pragma unroll
    for (int q = 0; q < 4; ++q) {
      const int k0 = (kc + 8 * q) * 8;
      *(bf16x4*)(dst + (size_t)n * 1024 + kt4 * 256 + k0) = pack4(tile[(k0 + 0) * 65 + nn], tile[(k0 + 1) * 65 + nn], tile[(k0 + 2) * 65 + nn], tile[(k0 + 3) * 65 + nn]);
      *(bf16x4*)(dst + (size_t)n * 1024 + kt4 * 256 + k0 + 4) = pack4(tile[(k0 + 4) * 65 + nn], tile[(k0 + 5) * 65 + nn], tile[(k0 + 6) * 65 + nn], tile[(k0 + 7) * 65 + nn]);
    }
  }
  __syncthreads();
}
template <int N, bool INTERLEAVE>
__device__ __forceinline__ void convert_i8(const float* src  , signed char* dst  , float* sw, int ng, char* smem) {
  const int tid = tid_opaque();
  bfr* blk = (bfr*)smem;
  int* cmax = (int*)(smem + 131072);
  if (tid < 64) cmax[tid] = 0;
  __syncthreads();
  {
    const int n4 = tid & 15, kk0 = tid >> 4;
    float m0 = 0.f, m1 = 0.f, m2 = 0.f, m3 = 0.f;
#pragma unroll 8
    for (int ps = 0; ps < 32; ++ps) {
      const int k = ps * 32 + kk0;
      const int ncol = ng * 64 + n4 * 4;
      const int ncl = (N % 64 == 0) ? ncol : min(ncol, N - 4);
      float4 v = *(const float4*)(src + (size_t)k * N + ncl);
      if (N % 64 != 0 && ncol != ncl) v = make_float4(0.f, 0.f, 0.f, 0.f);
      m0 = fmaxf(m0, fabsf(v.x)); m1 = fmaxf(m1, fabsf(v.y)); m2 = fmaxf(m2, fabsf(v.z)); m3 = fmaxf(m3, fabsf(v.w));
      *(bf16x4*)(blk + k * 64 + n4 * 4) = pack4(v.x, v.y, v.z, v.w);
    }
    atomicMax(&cmax[n4 * 4 + 0], __float_as_int(m0)); atomicMax(&cmax[n4 * 4 + 1], __float_as_int(m1));
    atomicMax(&cmax[n4 * 4 + 2], __float_as_int(m2)); atomicMax(&cmax[n4 * 4 + 3], __float_as_int(m3));
  }
  __syncthreads();
  {
    const int nn = tid >> 3, kc = tid & 7;
    const int n = ng * 64 + nn;
    const float am = __int_as_float(cmax[nn]);
    const float sc = am > 0.f ? am * (1.f / 127.f) : 1.f, iv = 1.f / sc;
    const int j = n & 1023;
    const int row = INTERLEAVE ? (j >> 4) * 32 + (j & 15) + ((n >= 1024) ? 16 : 0) : n;
    if (kc == 0) sw[n] = sc;
#pragma unroll 2
    for (int q = 0; q < 8; ++q) {
      const int k0 = (kc + 8 * q) * 16;
      unsigned w[4];
#pragma unroll
      for (int g4 = 0; g4 < 4; ++g4) {
        unsigned acc = 0u;
#pragma unroll
        for (int b = 0; b < 4; ++b) {
          const float v = bf2f((short)blk[(k0 + g4 * 4 + b) * 64 + nn]);
          const int qi = (int)fminf(fmaxf(rintf(v * iv), -127.f), 127.f);
          acc |= ((unsigned)(qi & 0xff)) << (8 * b);
        }
        w[g4] = acc;
      }
      *(uint4*)(dst + (size_t)row * 1024 + k0) = make_uint4(w[0], w[1], w[2], w[3]);
    }
  }
  __syncthreads();
}
__device__ __forceinline__ void phase_convert(PP pp, int l, int part, int bid, int nb, char* smem) {
  float* tile = (float*)smem;
  char* wl = p.ws + OFF_W + (size_t)l * WL_SIZE;
  const int T_IN = 56, T_OUT = 4 * 16, T_GU = 32 * 32, T_DN = 32 * 4 * 16;
  const int t_lo = part == 0 ? 0 : T_IN + T_OUT;
  const int t_hi = part == 0 ? T_IN + T_OUT : T_IN + T_OUT + T_GU + T_DN;
  for (int t = t_lo + bid; t < t_hi; t += nb) {
    if (t < T_IN) {
      convert_i8<PIN, false>(p.w_in + (size_t)l * 1024 * PIN, (signed char*)(wl + WL_IN), (float*)(p.ws + OFF_SWIN) + (size_t)l * PINP, t, smem);
    } else if (t < T_IN + T_OUT) {
      int u = t - T_IN; int kt4 = u / 16, nt = u % 16;
      convert_tile(p.w_out + (size_t)l * 1024 * 1024, 1024, (bfr*)(wl + WL_OUT), kt4, nt, tile);
    } else if (t < T_IN + T_OUT + T_GU) {
      int u = t - T_IN - T_OUT; int e = u / 32, ng = u % 32;
      convert_i8<2048, true>(p.moe_w_gu + ((size_t)l * 32 + e) * 1024 * 2048, (signed char*)(wl + WL_GU) + (size_t)e * 2048 * 1024,
                    (float*)(p.ws + OFF_SW) + ((size_t)l * 32 + e) * 2048, ng, smem);
    } else {
      int u = t - T_IN - T_OUT - T_GU; int e = u / 64; int v = u % 64; int kt4 = v / 16, nt = v % 16;
      convert_tile(p.moe_w_down + ((size_t)l * 32 + e) * 1024 * 1024, 1024, (bfr*)(wl + WL_DN) + (size_t)e * 1024 * 1024, kt4, nt, tile);
    }
  }
}

__device__ __forceinline__ void phase_prenorm(PP pp, int l, int bid, int nb) {
  const int tid = tid_opaque(), lane = tid & 63, wv = wave_id(tid);
  const float* xl = (l == 0) ? p.x : p.out;
  const float* xc = (l == 0) ? p.ctx : (const float*)(p.ws + OFF_CTX);
  const float* mods = (const float*)(p.ws + OFF_MODS) + (size_t)l * 3 * 6144;
  const float* g = p.norm_mix_g + (size_t)l * 1024;
  signed char* H8 = (signed char*)(p.ws + OFF_H);
  float* SCL = (float*)(p.ws + OFF_SCL);
  {
    int* cnt = (int*)(p.ws + OFF_CNT);
    int gt = bid * NTHR + tid;
    if (gt < 32) cnt[gt] = 0;
  }
  for (int m = bid * 8 + wv; m < NTOK; m += nb * 8) {
    const float* xr = (m < NLAT) ? xl + (size_t)m * 1024 : xc + (size_t)(m - NLAT) * 1024;
    const float* md = mods + (size_t)mod_row(m) * 6144;
    float4 v[4];
    float ss = 0.f;
#pragma unroll
    for (int i = 0; i < 4; ++i) {
      v[i] = *(const float4*)(xr + (lane + 64 * i) * 4);
      ss += v[i].x * v[i].x + v[i].y * v[i].y + v[i].z * v[i].z + v[i].w * v[i].w;
    }
    ss = wave_sum(ss);
    float rs = rsqrtf(ss * (1.f / 1024.f) + 1e-6f);
    float4 hq[4];
#pragma unroll
    for (int i = 0; i < 4; ++i) {
      int d = (lane + 64 * i) * 4;
      float4 gg = *(const float4*)(g + d);
      float4 sh = *(const float4*)(md + d);
      float4 sc = *(const float4*)(md + 1024 + d);
      hq[i] = make_float4(v[i].x * rs * gg.x * (1.f + sc.x) + sh.x, v[i].y * rs * gg.y * (1.f + sc.y) + sh.y,
                          v[i].z * rs * gg.z * (1.f + sc.z) + sh.z, v[i].w * rs * gg.w * (1.f + sc.w) + sh.w);
    }
    const float qs = quant_row_store(hq, H8 + (size_t)m * 1024, lane);
    if (lane == 0) SCL[m] = qs;
  }
}

#define LAS __attribute__((address_space(3)))
namespace g8 {
constexpr int BM = 256, BK = 64, HALF = 128, HTB = HALF * BK * 2, STAGE_BYTES = 8 * HTB, KD = 1024;
__device__ __forceinline__ int lds_byte(int r, int c) { const int st = (r >> 4) * 2 + (c >> 5), rr = r & 15, cc = c & 31, ob = rr * 64 + cc * 2; return st * 1024 + (ob ^ (((ob >> 9) & 1) << 5)); }
__device__ __forceinline__ void stage_rc(int b, int& R, int& C) { const int st = b / 1024, sb = b % 1024, swz = sb ^ (((sb >> 9) & 1) << 5); R = (st >> 1) * 16 + swz / 64; C = (st & 1) * 32 + (swz % 64) / 2; }
struct GUnit { int pm, pn, brow0, e; };
__device__ __forceinline__ int unit_index(int i, int c, int G, int total) {
  const int x = c & 7, j = c >> 3, q = total >> 3, r = total & 7;
  const int start = x < r ? x * (q + 1) : r * (q + 1) + (x - r) * q;
  const int size = q + (x < r ? 1 : 0);
  const int li = i * (G >> 3) + j;
  return li < size ? start + li : -1;
}

__device__ __forceinline__ f32x4 mma16(bf16x8 a, bf16x8 b, f32x4 c) { return __builtin_amdgcn_mfma_f32_16x16x32_bf16(a, b, c, 0, 0, 0); }
__device__ __forceinline__ i32x4 mma16(i32x4 a, i32x4 b, i32x4 c) { return __builtin_amdgcn_mfma_i32_16x16x64_i8(a, b, c, 0, 0, 0); }
template <bool I8, class Sched, class Epi>
__device__ __forceinline__ void gemm_stream(LAS unsigned char* lds, const void* Abase, const void* Btbase, const Sched& S, const Epi& E) {
  typedef typename std::conditional<I8, i32x4, f32x4>::type AccT;
  typedef typename std::conditional<I8, i32x4, bf16x8>::type FragT;
  constexpr int KB = I8 ? KD : KD * 2;
  const int tid = tid_opaque(), wid = __builtin_amdgcn_readfirstlane(tid >> 6), lane = tid & 63, wr = wid >> 2, wc = wid & 3, fr = lane & 15, fq = lane >> 4;
  constexpr int nt = KB / 128;
  int R[2], C[2];
  unsigned voffB[2];
#pragma unroll
  for (int i = 0; i < 2; ++i) { stage_rc(tid * 16 + i * 8192, R[i], C[i]); voffB[i] = (unsigned)(R[i] * KB + C[i] * 2); }
#define voffA voffB
  constexpr size_t kstep = (size_t)(BK * 2);
  constexpr size_t hstep = (size_t)HALF * KB;
  const unsigned ldsw = (unsigned)wid * 1024u;
  const int aoff = lds_byte(wr * 64 + fr, fq * 8), boff = lds_byte(wc * 32 + fr, fq * 8);
#define G8_SA(b, h) (((b) * 2 + (h)) * HTB)
#define G8_SB(b, h) ((4 + (b) * 2 + (h)) * HTB)
#define G8_STAGE(bufoff, gbase, v0, v1) do { \
    __builtin_amdgcn_global_load_lds((const unsigned*)((const char*)(gbase) + (v0)), (LAS unsigned*)(lds + (bufoff) + ldsw), 16, 0, 0); \
    __builtin_amdgcn_global_load_lds((const unsigned*)((const char*)(gbase) + (v1)), (LAS unsigned*)(lds + (bufoff) + ldsw + 8192), 16, 0, 0); } while (0)
#define G8_STAGEB(bufoff, gbase) G8_STAGE(bufoff, gbase, voffB[0], voffB[1])
#define G8_STAGEA(bufoff, gbase) G8_STAGE(bufoff, gbase, voffA[0], voffA[1])
#define G8_LDA(dst, b, h) do { _Pragma("unroll") for (int m = 0; m < 4; ++m) _Pragma("unroll") for (int k = 0; k < 2; ++k) dst[m][k] = *(const LAS FragT*)(lds + G8_SA(b, h) + aoff + m * 2048 + k * 1024); } while (0)
#define G8_LDB(dst, b, h) do { _Pragma("unroll") for (int n = 0; n < 2; ++n) _Pragma("unroll") for (int k = 0; k < 2; ++k) dst[n][k] = *(const LAS FragT*)(lds + G8_SB(b, h) + boff + n * 2048 + k * 1024); } while (0)
#define G8_MMA(ai, bj, At, Bt) do { __builtin_amdgcn_s_setprio(1); _Pragma("unroll") for (int m = 0; m < 4; ++m) _Pragma("unroll") for (int n = 0; n < 2; ++n) _Pragma("unroll") for (int k = 0; k < 2; ++k) \
    acc[ai][bj][m][n] = mma16(Bt[n][k], At[m][k], acc[ai][bj][m][n]); __builtin_amdgcn_s_setprio(0); } while (0)
#define G8_WAIT_V(n) asm volatile("s_waitcnt vmcnt(" #n ")" ::: "memory")
#define G8_WAIT_L(n) asm volatile("s_waitcnt lgkmcnt(" #n ")" ::: "memory")
#define G8_BAR __builtin_amdgcn_s_barrier()
#define G8_SCHED __builtin_amdgcn_sched_barrier(0)
  GUnit cur, nxt;
  int ui = 0;
  if (!S.next(0, cur)) return;
  AccT acc[2][2][4][2];
#pragma unroll
  for (int a = 0; a < 2; ++a)
#pragma unroll
    for (int b = 0; b < 2; ++b)
#pragma unroll
      for (int m = 0; m < 4; ++m)
#pragma unroll
        for (int n = 0; n < 2; ++n) acc[a][b][m][n] = AccT{};
  FragT At[4][2], B0[2][2], B1[2][2];
  const char* cA = (const char*)Abase + (size_t)cur.pm * (BM * KB);
  const char* cB = (const char*)Btbase + (size_t)cur.brow0 * KB;
  G8_STAGEB(G8_SB(0, 0), cB); G8_STAGEA(G8_SA(0, 0), cA); G8_STAGEB(G8_SB(0, 1), cB + hstep); G8_STAGEA(G8_SA(0, 1), cA + hstep);
  if (wr == 1) G8_BAR;
  G8_WAIT_V(4); G8_BAR;
  G8_STAGEB(G8_SB(1, 0), cB + kstep); G8_STAGEA(G8_SA(1, 0), cA + kstep); G8_STAGEB(G8_SB(1, 1), cB + hstep + kstep);
  G8_WAIT_V(6); G8_BAR;
  for (;;) {
    const bool has_next = S.next(ui + 1, nxt);
    const char* nA = has_next ? (const char*)Abase + (size_t)nxt.pm * (BM * KB) : cA;
    const char* nB = has_next ? (const char*)Btbase + (size_t)nxt.brow0 * KB : cB;
#pragma unroll 1
    for (int t = 0; t < nt; t += 2) {
      const bool last = (t == nt - 2);
      const char* a1 = cA + (size_t)(t + 1) * kstep;
      const char* a2 = last ? nA : cA + (size_t)(t + 2) * kstep;
      const char* b2 = last ? nB : cB + (size_t)(t + 2) * kstep;
      const char* a3 = a2 + kstep;
      const char* b3 = b2 + kstep;
      G8_LDB(B0, 0, 0); G8_SCHED; G8_LDA(At, 0, 0); G8_STAGEA(G8_SA(1, 1), a1 + hstep);
      G8_WAIT_L(8); G8_BAR; G8_WAIT_L(0); G8_MMA(0, 0, At, B0); G8_BAR; G8_SCHED;
      G8_LDB(B1, 0, 1); G8_STAGEB(G8_SB(0, 0), b2);
      G8_BAR; G8_WAIT_L(0); G8_MMA(0, 1, At, B1); G8_BAR;
      G8_LDA(At, 0, 1); G8_STAGEA(G8_SA(0, 0), a2);
      G8_BAR; G8_WAIT_L(0); G8_MMA(1, 0, At, B0); G8_BAR; G8_SCHED;
      G8_STAGEB(G8_SB(0, 1), b2 + hstep);
      G8_WAIT_V(6); G8_BAR; G8_MMA(1, 1, At, B1); G8_BAR;
      G8_LDB(B0, 1, 0); G8_SCHED; G8_LDA(At, 1, 0); G8_STAGEA(G8_SA(0, 1), a2 + hstep);
      G8_WAIT_L(8); G8_BAR; G8_WAIT_L(0); G8_MMA(0, 0, At, B0); G8_BAR; G8_SCHED;
      G8_LDB(B1, 1, 1); G8_STAGEB(G8_SB(1, 0), b3);
      G8_BAR; G8_WAIT_L(0); G8_MMA(0, 1, At, B1); G8_BAR;
      G8_LDA(At, 1, 1); G8_STAGEA(G8_SA(1, 0), a3);
      G8_BAR; G8_WAIT_L(0); G8_MMA(1, 0, At, B0); G8_BAR; G8_SCHED;
      G8_STAGEB(G8_SB(1, 1), b3 + hstep);
      G8_WAIT_V(6); G8_BAR; G8_MMA(1, 1, At, B1); G8_BAR;
    }
    E(acc, cur, wr, wc, fr, fq);
    if (!has_next) break;
#pragma unroll
    for (int a = 0; a < 2; ++a)
#pragma unroll
      for (int b = 0; b < 2; ++b)
#pragma unroll
        for (int m = 0; m < 4; ++m)
#pragma unroll
          for (int n = 0; n < 2; ++n) acc[a][b][m][n] = AccT{};
    cur = nxt; cA = nA; cB = nB; ++ui;
  }
  G8_WAIT_V(0);
  if (wr == 0) G8_BAR;
  G8_BAR;
#undef G8_SA
#undef G8_SB
#undef G8_STAGE
#undef G8_STAGEB
#undef G8_STAGEA
#undef voffA
#undef G8_LDA
#undef G8_LDB
#undef G8_MMA
#undef G8_WAIT_V
#undef G8_WAIT_L
#undef G8_BAR
#undef G8_SCHED
}

struct DenseSched {
  int nM, nN, G, c;
  __device__ __forceinline__ bool next(int i, GUnit& u) const {
    const int idx = unit_index(i, c, G, nM * nN);
    if (idx < 0) return false;
    u.pm = idx / nN; u.pn = idx - u.pm * nN; u.brow0 = u.pn * BM; u.e = 0;
    return true;
  }
};
struct MoeSched {
  const int* toff; int nN, NE, G, c;
  __device__ __forceinline__ bool next(int i, GUnit& u) const {
    const int idx = unit_index(i, c, G, toff[32] * nN);
    if (idx < 0) return false;
    u.pm = idx / nN; u.pn = idx - u.pm * nN;
    const int e = toff[128 + u.pm];
    u.e = e; u.brow0 = e * NE + u.pn * BM;
    return true;
  }
};
}

struct EpiInProj {
  bfr* P; const float* SCL; const float* sw;
  __device__ __forceinline__ void operator()(const i32x4 (&acc)[2][2][4][2], const g8::GUnit& u, int wr, int wc, int fr, int fq) const {
    const int row0 = u.pm * 256 + wr * 64 + fr, col0 = u.pn * 256 + wc * 32 + 4 * fq;
    f32x4 cs[2][2];
#pragma unroll
    for (int bj = 0; bj < 2; ++bj)
#pragma unroll
      for (int n = 0; n < 2; ++n) cs[bj][n] = *(const f32x4*)(sw + col0 + bj * 128 + n * 16);
    float sav[2][4];
#pragma unroll
    for (int ai = 0; ai < 2; ++ai)
#pragma unroll
      for (int m = 0; m < 4; ++m) sav[ai][m] = SCL[row0 + ai * 128 + m * 16];
#pragma unroll
    for (int ai = 0; ai < 2; ++ai)
#pragma unroll
      for (int m = 0; m < 4; ++m) {
        const int row = row0 + ai * 128 + m * 16;
        const float sa = sav[ai][m];
        bfr* rowp = P + (size_t)row * PINP + col0;
#pragma unroll
        for (int bj = 0; bj < 2; ++bj)
#pragma unroll
          for (int n = 0; n < 2; ++n) {
            const i32x4 a = acc[ai][bj][m][n];
            f32x4 o = {(float)a[0], (float)a[1], (float)a[2], (float)a[3]};
            o = o * (cs[bj][n] * sa);
            *(bf16x4*)(rowp + bj * 128 + n * 16) = pack4(o[0], o[1], o[2], o[3]);
          }
      }
  }
};
__device__ __forceinline__ void phase_gemm_in(PP pp, int l, int bid, int nb, char* smem) {
  g8::DenseSched S{130, 14, nb, bid};
  EpiInProj E{(bfr*)(p.ws + OFF_P), (const float*)(p.ws + OFF_SCL), (const float*)(p.ws + OFF_SWIN) + (size_t)l * PINP};
  g8::gemm_stream<true>((LAS unsigned char*)smem, p.ws + OFF_H, p.ws + OFF_W + (size_t)l * WL_SIZE + WL_IN, S, E);
}

struct EpiOutProj {
  const float *xl, *xc, *mods; float *ol, *oc;
  __device__ __forceinline__ void operator()(const f32x4 (&acc)[2][2][4][2], const g8::GUnit& u, int wr, int wc, int fr, int fq) const {
    const bool lat = u.pm < 128;
    const float* xin = lat ? xl + (size_t)u.pm * 256 * 1024 : xc + (size_t)(u.pm - 128) * 256 * 1024;
    float* xo = lat ? ol + (size_t)u.pm * 256 * 1024 : oc + (size_t)(u.pm - 128) * 256 * 1024;
    const float* g1 = mods + (size_t)(lat ? (u.pm >> 6) : 2) * 6144 + 2048;
    const int row0 = wr * 64 + fr, col0 = u.pn * 256 + wc * 32 + 4 * fq;
#pragma unroll
    for (int bj = 0; bj < 2; ++bj)
#pragma unroll
      for (int n = 0; n < 2; ++n) {
        const f32x4 gv = *(const f32x4*)(g1 + col0 + bj * 128 + n * 16);
        f32x4 xv[2][4];
#pragma unroll
        for (int ai = 0; ai < 2; ++ai)
#pragma unroll
          for (int m = 0; m < 4; ++m) xv[ai][m] = *(const f32x4*)(xin + (size_t)(row0 + ai * 128 + m * 16) * 1024 + col0 + bj * 128 + n * 16);
#pragma unroll
        for (int ai = 0; ai < 2; ++ai)
#pragma unroll
          for (int m = 0; m < 4; ++m)
            *(f32x4*)(xo + (size_t)(row0 + ai * 128 + m * 16) * 1024 + col0 + bj * 128 + n * 16) = xv[ai][m] + gv * acc[ai][bj][m][n];
        asm volatile("" ::: "memory");
      }
  }
};
__device__ __forceinline__ void phase_gemm_out(PP pp, int l, int bid, int nb, char* smem) {
  g8::DenseSched S{(l == 0) ? 130 : 128, 4, nb, bid};
  EpiOutProj E{(l == 0) ? p.x : p.out, (l == 0) ? p.ctx : (const float*)(p.ws + OFF_CTX),
               (const float*)(p.ws + OFF_MODS) + (size_t)l * 3 * 6144, p.out, (float*)(p.ws + OFF_CTX)};
  g8::gemm_stream<false>((LAS unsigned char*)smem, p.ws + OFF_CC, p.ws + OFF_W + (size_t)l * WL_SIZE + WL_OUT, S, E);
}

#define LBAR() do { asm volatile("s_waitcnt lgkmcnt(0)" ::: "memory"); __builtin_amdgcn_s_barrier(); asm volatile("" ::: "memory"); } while (0)
__device__ __forceinline__ void phase_prep(PP pp, int l, int bid, int nb, char* smem) {
  const int tid = tid_opaque(), lane = tid & 63, wv = wave_id(tid);
  const bfr* P = (const bfr*)(p.ws + OFF_P);
  char* S = p.ws + OFF_S;
  bfr* QN = (bfr*)(S + S_QN);
  bfr* KN = (bfr*)(S + S_KN);
  bfr* VT = (bfr*)(S + S_VT);
  bfr* RWR = (bfr*)(S + S_RWR);
  bfr* RWKK = (bfr*)(S + S_RWKK);
  bfr* RWV = (bfr*)(S + S_RWV);
  bfr* RWG = (bfr*)(S + S_RWG);
  float* RWW = (float*)(S + S_RWW);
  bfr* RWKD = (bfr*)(S + S_RWKD);
  bfr* RWB = (bfr*)(S + S_RWB);
  float* BON = (float*)(S + S_BON);
  bfr* GDQ = (bfr*)(S + S_GDQ);
  bfr* GDK = (bfr*)(S + S_GDK);
  bfr* GDV = (bfr*)(S + S_GDV);
  float* GDAB = (float*)(S + S_GDAB);
  const float* mu = p.rw_mu + (size_t)l * 896;
  const float* w0 = p.rw_w0 + (size_t)l * 512;
  const float* w_up = p.rw_w_up + (size_t)l * 2 * 32 * 256;
  const float* a0 = p.rw_a0 + (size_t)l * 512;
  const float* a_up = p.rw_a_up + (size_t)l * 2 * 32 * 256;
  const float* g_up = p.rw_g_up + (size_t)l * 64 * 256;
  const float* k_k = p.rw_k_k + (size_t)l * 256;
  const float* k_a = p.rw_k_a + (size_t)l * 256;
  const float* r_k = p.rw_r_k + (size_t)l * 256;
  const float* conv_w = p.gd_conv_w + (size_t)l * 5 * 768;
  const float* A_log = p.gd_A_log + (size_t)l * 8;
  const float* dt_bias = p.gd_dt_bias + (size_t)l * 8;
  const float* qg = p.na_q_gain + (size_t)l * 64;
  const float* kg = p.na_k_gain + (size_t)l * 64;

  bfr* wl = (bfr*)smem;
  float* lor = (float*)(smem + 192 * 256 * 2);
  __syncthreads();
  for (int i = tid; i < 192 * 256; i += NTHR) {
    const int row = i >> 8, c = i & 255;
    const float v = row < 64 ? g_up[row * 256 + c] : row < 128 ? w_up[(row - 64) * 256 + c] : a_up[(row - 128) * 256 + c];
    wl[i] = f2bf(v);
  }
  __syncthreads();

  for (int tile = bid; tile < NTOK / 16; tile += nb) {
    const int m0 = tile * 16;
    int seq_lo, seq_hi, bb, tau0;
    if (m0 < NLAT) { bb = m0 >> 14; seq_lo = bb << 14; seq_hi = seq_lo + SEQ; tau0 = m0 - seq_lo; }
    else { bb = (m0 - NLAT) >> 8; seq_lo = NLAT + (bb << 8); seq_hi = seq_lo + CTXL; tau0 = SEQ + (m0 - seq_lo); }
    const f32x4 z4 = {0.f, 0.f, 0.f, 0.f};
    int tid_t = tid; asm volatile("" : "+v"(tid_t));
    const int lane_t = tid_t & 63;
    const int cb = lane_t * 4, hh = lane_t >> 4;
    const int lg = tid_t & 31, lt = tid_t >> 5;
    const int sl = lane_t >> 4, sc4 = (lane_t & 15) * 4;
    asm volatile("" ::: "memory");
    const f32x4 mur = *(const f32x4*)(mu + cb), muk = *(const f32x4*)(mu + 256 + cb), muv = *(const f32x4*)(mu + 512 + cb);
    const f32x4 mul = *(const f32x4*)(mu + 768 + lg * 4);

    f32x4 pr[3][4], pl[3];
    {
      const int mt0 = m0 + 2 * wv;
#pragma unroll
      for (int j = 0; j < 3; ++j)
#pragma unroll
        for (int t = 0; t < 4; ++t) {
          const int m = mt0 - 1 + t;
          const int mc = min(max(m, seq_lo), seq_hi - 1);
          const f32x4 ld = ldbf4(P + (size_t)mc * PINP + A_END + j * 256 + cb);
          pr[j][t] = (m == mc) ? ld : z4;
        }
#pragma unroll
      for (int t = 0; t < 3; ++t) {
        const int m = m0 + lt - 1 + t;
        const int mc = min(max(m, seq_lo), seq_hi - 1);
        const f32x4 ld = ldbf4(P + (size_t)mc * PINP + A_END + 768 + lg * 4);
        pl[t] = (m == mc) ? ld : z4;
      }
    }
    {
      const f32x4 v = pl[1] + mul * (0.5f * (pl[0] + pl[2]) - pl[1]);
#pragma unroll
      for (int i = 0; i < 4; ++i) {
        const int ch = lg * 4 + i;
        lor[ch * 16 + lt] = ch < 32 ? tanhf(v[i]) : ch < 64 ? v[i] : sigmoidf_(v[i]);
      }
    }
    f32x4 rr[2], rk[2], rv[2];
#pragma unroll
    for (int t = 0; t < 2; ++t) {
      rr[t] = pr[0][t + 1] + mur * (0.5f * (pr[0][t] + pr[0][t + 2]) - pr[0][t + 1]);
      rk[t] = pr[1][t + 1] + muk * (0.5f * (pr[1][t] + pr[1][t + 2]) - pr[1][t + 1]);
      rv[t] = pr[2][t + 1] + muv * (0.5f * (pr[2][t] + pr[2][t + 2]) - pr[2][t + 1]);
    }
    LBAR();
    f32x4 pg[20];
    const bool is_gd = wv < 3, is_na = (wv >= 3 && wv < 7);
    const int sec = is_gd ? wv * 4 + sl : (wv - 3) * 4 + sl;
    if (is_gd) {
#pragma unroll
      for (int t = 0; t < 20; ++t) {
        const int m = m0 - 2 + t;
        const int mc = min(max(m, seq_lo), seq_hi - 1);
        const f32x4 ld = ldbf4(P + (size_t)mc * PINP + B_END + sec * 64 + sc4);
        pg[t] = (m == mc) ? ld : z4;
      }
    } else if (is_na) {
#pragma unroll
      for (int t = 0; t < 16; ++t) pg[t] = ldbf4(P + (size_t)(m0 + t) * PINP + sec * 64 + sc4);
#pragma unroll
      for (int t = 16; t < 20; ++t) pg[t] = z4;
    } else {
#pragma unroll
      for (int t = 0; t < 20; ++t) pg[t] = z4;
    }
    asm volatile("" ::: "memory");
    {
      f32x4 gacc[2], wa0[2], wa1[2], aa0[2], aa1[2];
#pragma unroll
      for (int t = 0; t < 2; ++t) { gacc[t] = z4; wa0[t] = z4; wa1[t] = z4; aa0[t] = z4; aa1[t] = z4; }
#pragma unroll 4
      for (int j = 0; j < 64; ++j) {
        const bf16x4 wq = *(const bf16x4*)(wl + j * 256 + cb);
        const f32x4 wgt = {bf2f(wq[0]), bf2f(wq[1]), bf2f(wq[2]), bf2f(wq[3])};
        const float2 sv = *(const float2*)(lor + (64 + j) * 16 + 2 * wv);
        gacc[0] += wgt * sv.x; gacc[1] += wgt * sv.y;
      }
#pragma unroll 2
      for (int j = 0; j < 32; ++j) {
        const bf16x4 q0 = *(const bf16x4*)(wl + (64 + j) * 256 + cb), q1 = *(const bf16x4*)(wl + (96 + j) * 256 + cb);
        const bf16x4 q2 = *(const bf16x4*)(wl + (128 + j) * 256 + cb), q3 = *(const bf16x4*)(wl + (160 + j) * 256 + cb);
        const f32x4 ww0 = {bf2f(q0[0]), bf2f(q0[1]), bf2f(q0[2]), bf2f(q0[3])}, ww1 = {bf2f(q1[0]), bf2f(q1[1]), bf2f(q1[2]), bf2f(q1[3])};
        const f32x4 aw0 = {bf2f(q2[0]), bf2f(q2[1]), bf2f(q2[2]), bf2f(q2[3])}, aw1 = {bf2f(q3[0]), bf2f(q3[1]), bf2f(q3[2]), bf2f(q3[3])};
        const float2 tv = *(const float2*)(lor + j * 16 + 2 * wv);
        const float2 dv = *(const float2*)(lor + (32 + j) * 16 + 2 * wv);
        wa0[0] += ww0 * tv.x; wa0[1] += ww0 * tv.y; wa1[0] += ww1 * tv.x; wa1[1] += ww1 * tv.y;
        aa0[0] += aw0 * dv.x; aa0[1] += aw0 * dv.y; aa1[0] += aw1 * dv.x; aa1[1] += aw1 * dv.y;
      }
      asm volatile("" ::: "memory");
      const f32x4 kkc = *(const f32x4*)(k_k + cb), kac = *(const f32x4*)(k_a + cb), rkc = *(const f32x4*)(r_k + cb);
      const f32x4 w00 = *(const f32x4*)(w0 + cb), w01 = *(const f32x4*)(w0 + 256 + cb), a00 = *(const f32x4*)(a0 + cb), a01 = *(const f32x4*)(a0 + 256 + cb);
#pragma unroll
      for (int t = 0; t < 2; ++t) {
        const int m = m0 + 2 * wv + t;
        const f32x4 r = rr[t], k = rk[t], v = rv[t];
        const f32x4 kkraw = k * kkc;
        const float ssum = row16_sum((kkraw[0] * kkraw[0] + kkraw[1] * kkraw[1]) + (kkraw[2] * kkraw[2] + kkraw[3] * kkraw[3]));
        const f32x4 kk = kkraw * rsqrtf(ssum + 1e-6f);
        float bon = 0.f;
#pragma unroll
        for (int d = 0; d < 2; ++d) {
          const f32x4 wlin = d == 0 ? w00 + wa0[t] : w01 + wa1[t];
          const f32x4 alin = d == 0 ? a00 + aa0[t] : a01 + aa1[t];
          f32x4 lw, kd, bv;
#pragma unroll
          for (int i = 0; i < 4; ++i) {
            const float w_log = -softplusf_(-wlin[i]) - 0.5f;
            const float a = sigmoidf_(alin[i]);
            lw[i] = -__expf(w_log);
            kd[i] = k[i] * (1.f + (a - 1.f) * kac[i]);
            bv[i] = kk[i] * a;
            bon += r[i] * kd[i] * rkc[i];
          }
          const size_t o = ((size_t)d * NTOK + m) * 256 + cb;
          *(f32x4*)(RWW + o) = lw; *(bf16x4*)(RWKD + o) = pack4(kd[0], kd[1], kd[2], kd[3]); *(bf16x4*)(RWB + o) = pack4(bv[0], bv[1], bv[2], bv[3]);
        }
        bon = row16_sum(bon);
        const size_t o = (size_t)m * 256 + cb;
        *(bf16x4*)(RWR + o) = pack4(r[0], r[1], r[2], r[3]); *(bf16x4*)(RWKK + o) = pack4(kk[0], kk[1], kk[2], kk[3]);
        *(bf16x4*)(RWV + o) = pack4(v[0], v[1], v[2], v[3]); *(bf16x4*)(RWG + o) = pack4(gacc[t][0], gacc[t][1], gacc[t][2], gacc[t][3]);
        if ((lane_t & 15) == 0) BON[(size_t)m * 4 + hh] = bon;
      }
    }
    if (is_gd) {
      f32x4 cw[5];
#pragma unroll
      for (int j = 0; j < 5; ++j) cw[j] = *(const f32x4*)(conv_w + j * 768 + sec * 64 + sc4);
#pragma unroll
      for (int t = 0; t < 16; ++t) {
        f32x4 acc = z4;
#pragma unroll
        for (int j = 0; j < 5; ++j) acc += cw[j] * pg[t + j];
        f32x4 val = {siluf_(acc[0]), siluf_(acc[1]), siluf_(acc[2]), siluf_(acc[3])};
        const int m = m0 + t;
        if (sec < 8) {
          const float ss = row16_sum((val[0] * val[0] + val[1] * val[1]) + (val[2] * val[2] + val[3] * val[3]));
          val = val * rsqrtf(ss + 1e-6f);
          if (sec < 4) { const f32x4 vq = val * 0.125f; *(bf16x4*)(GDQ + (size_t)m * 256 + sec * 64 + sc4) = pack4(vq[0], vq[1], vq[2], vq[3]); }
          else *(bf16x4*)(GDK + (size_t)m * 256 + (sec - 4) * 64 + sc4) = pack4(val[0], val[1], val[2], val[3]);
        } else *(bf16x4*)(GDV + (size_t)m * 256 + (sec - 8) * 64 + sc4) = pack4(val[0], val[1], val[2], val[3]);
      }
    } else if (is_na) {
      const f32x4 gq = *(const f32x4*)(qg + sc4) * (0.125f * 1.4426950408889634f), gk = *(const f32x4*)(kg + sc4);
#pragma unroll
      for (int t = 0; t < 16; ++t) {
        f32x4 val = pg[t];
        const float ss = row16_sum((val[0] * val[0] + val[1] * val[1]) + (val[2] * val[2] + val[3] * val[3]));
        val = val * rsqrtf(ss * (1.f / 64.f) + 1e-6f);
        const int m = m0 + t;
        if (sec < 8) { const f32x4 o = val * gq; *(bf16x4*)(QN + (size_t)m * 512 + sec * 64 + sc4) = pack4(o[0], o[1], o[2], o[3]); }
        else { const f32x4 o = val * gk; *(bf16x4*)(KN + (size_t)m * 512 + (sec - 8) * 64 + sc4) = pack4(o[0], o[1], o[2], o[3]); }
      }
    }
    if (tid_t < 256) {
      const int t = tid_t >> 4, j = tid_t & 15;
      const int m = m0 + t;
      const float pv = bf2f((short)P[(size_t)m * PINP + B_END + 1024 + j]);
      float o;
      if (j < 8) o = -__expf(A_log[j]) * softplusf_(pv + dt_bias[j]);
      else o = sigmoidf_(pv);
      GDAB[(size_t)m * 16 + j] = o;
    }
    {
      const int vc = (tid_t & 127) * 4, tq = (tid_t >> 7) * 4;
      f32x4 pv[4];
#pragma unroll
      for (int t = 0; t < 4; ++t) pv[t] = ldbf4(P + (size_t)(m0 + tq + t) * PINP + 1024 + vc);
#pragma unroll
      for (int i = 0; i < 4; ++i) {
        const int hd = vc + i;
        bfr* dst = VT + ((size_t)(bb * 8 + (hd >> 6)) * (TTOK / 16) + (tau0 >> 4)) * 1024 + (hd & 63) * 16 + tq;
        *(bf16x4*)dst = pack4(pv[0][i], pv[1][i], pv[2][i], pv[3][i]);
      }
    }
    LBAR();
  }
  __syncthreads();
}

__device__ __forceinline__ int scan_tok(int b, int d, int s) {
  if (s < CTXL) { int t = d ? (CTXL - 1 - s) : s; return NLAT + b * CTXL + t; }
  int u = s - CTXL; int t = d ? (SEQ - 1 - u) : u; return b * SEQ + t;
}
#define CS 72
#define SLOT_BYTES (64 * CS * 2)
#define F0_STRIDE 68
#define X1_F0 (13 * SLOT_BYTES)
#define X1_ARR (X1_F0 + 64 * F0_STRIDE * 4)

#define MM_FRAGS(As, Bs, a0, a1, b00, b01, b10, b11)                                                     \
  const bf16x8 a0 = *(const bf16x8*)((As) + ((mt * 16 + fr) * CS + fq * 8) * 2);                         \
  const bf16x8 a1 = *(const bf16x8*)((As) + ((mt * 16 + fr) * CS + 32 + fq * 8) * 2);                    \
  const bf16x8 b00 = *(const bf16x8*)((Bs) + ((nt0 * 16 + fr) * CS + fq * 8) * 2);                       \
  const bf16x8 b01 = *(const bf16x8*)((Bs) + ((nt0 * 16 + fr) * CS + 32 + fq * 8) * 2);                  \
  const bf16x8 b10 = *(const bf16x8*)((Bs) + ((nt0 * 16 + 16 + fr) * CS + fq * 8) * 2);                  \
  const bf16x8 b11 = *(const bf16x8*)((Bs) + ((nt0 * 16 + 16 + fr) * CS + 32 + fq * 8) * 2);
#define MM_2TILES(acc0, acc1, a0, a1, b00, b01, b10, b11)                                                \
  acc0 = __builtin_amdgcn_mfma_f32_16x16x32_bf16(a0, b00, acc0, 0, 0, 0);                                \
  acc0 = __builtin_amdgcn_mfma_f32_16x16x32_bf16(a1, b01, acc0, 0, 0, 0);                                \
  acc1 = __builtin_amdgcn_mfma_f32_16x16x32_bf16(a0, b10, acc1, 0, 0, 0);                                \
  acc1 = __builtin_amdgcn_mfma_f32_16x16x32_bf16(a1, b11, acc1, 0, 0, 0);
__device__ __forceinline__ void wr_T(char* slot, int mt, int nt, int fr, int fq, f32x4 v) {
  *(bf16x4*)(slot + ((nt * 16 + fr) * CS + mt * 16 + 4 * fq) * 2) = pack4(v[0], v[1], v[2], v[3]);
}

struct ChunkIn { float lw[8], f0[8], f1[8], f2[8], f3[8], xv[8], be[8]; };
template <bool GDN>
__device__ __forceinline__ void chunk_load(PP pp, int t, ChunkIn& ci) {
  const int tid = tid_opaque(), c = tid & 63, tg = wave_id(tid);
  const int chain = t / NCHUNK, n = t - chain * NCHUNK;
  const int d = chain & 1, h = (chain >> 1) & 3, b = (chain >> 3) & 1;
  const char* S = p.ws + OFF_S;
#pragma unroll
  for (int u = 0; u < 8; ++u) {
    const int m = scan_tok(b, d, n * 64 + tg * 8 + u);
    const size_t o = (size_t)m * 256 + h * 64 + c;
    if (!GDN) {
      ci.lw[u] = ((const float*)(S + S_RWW))[(size_t)d * NTOK * 256 + o];
      ci.f0[u] = ldbf1((const bfr*)(S + S_RWKK), o);
      ci.f1[u] = ldbf1((const bfr*)(S + S_RWB), (size_t)d * NTOK * 256 + o);
      ci.f2[u] = ldbf1((const bfr*)(S + S_RWKD), (size_t)d * NTOK * 256 + o);
      ci.f3[u] = ldbf1((const bfr*)(S + S_RWR), o);
      ci.xv[u] = ldbf1((const bfr*)(S + S_RWV), o);
      ci.be[u] = 1.f;
    } else {
      ci.lw[u] = ((const float*)(S + S_GDAB))[(size_t)m * 16 + d * 4 + h];
      ci.be[u] = ((const float*)(S + S_GDAB))[(size_t)m * 16 + 8 + d * 4 + h];
      ci.f0[u] = ldbf1((const bfr*)(S + S_GDK), o);
      ci.f3[u] = ldbf1((const bfr*)(S + S_GDQ), o);
      ci.xv[u] = ldbf1((const bfr*)(S + S_GDV), o);
      ci.f1[u] = 0.f; ci.f2[u] = 0.f;
    }
  }
}
template <bool GDN>
__device__ __forceinline__ void chunk_prep_task(PP pp, int t, int t_next, bool has_next, const ChunkIn& ci, ChunkIn& nx, char* smem) {
  const int chain = t / NCHUNK, n = t - chain * NCHUNK;
  const int d = chain & 1, h = (chain >> 1) & 3, b = (chain >> 3) & 1;
  (void)b; (void)d; (void)h;
  const int tid = tid_opaque(), lane = tid & 63, wv = wave_id(tid);
  const int fr = lane & 15, fq = lane >> 4, mt = wv >> 1, nt0 = (wv & 1) * 2;
  char* S = p.ws + OFF_S;
  char* CH = p.ws + OFF_CH;
  const size_t cc = (size_t)chain * NCHUNK + n;
  char* const p0 = smem;
  char* const p1 = smem + 1 * SLOT_BYTES;
  char* const p2 = smem + 2 * SLOT_BYTES;
  char* const p3 = smem + 3 * SLOT_BYTES;
  char* const p4 = smem + 4 * SLOT_BYTES;
  char* const p5 = smem + 5 * SLOT_BYTES;
  char* const p6 = smem + 6 * SLOT_BYTES;
  char* const p7 = smem + 7 * SLOT_BYTES;
  char* const p8 = smem + 8 * SLOT_BYTES;
  char* const p9 = smem + 9 * SLOT_BYTES;
  char* const p10 = smem + 10 * SLOT_BYTES;
  char* const p11 = smem + 11 * SLOT_BYTES;
  char* const p12 = smem + 12 * SLOT_BYTES;
  float* const F0 = (float*)(smem + X1_F0);
  float* const Lv = (float*)(smem + X1_ARR);
  float* const Lm1v = Lv + 64;
  float* const betav = Lv + 128;
  float* const eLv = Lv + 192;
  float* const gC = Lv + 256;
  float* const gsum = Lv + 320;
  char* const sKt = p0;
  char* const sBh = GDN ? p0 : p1;
  char* const sKh = GDN ? p0 : p2;

  {
    const int c = lane, tg = wv;
    const float* lw = ci.lw; const float* f0 = ci.f0; const float* f1 = ci.f1; const float* f2 = ci.f2; const float* f3 = ci.f3; const float* xv = ci.xv; const float* be = ci.be;
    float cum[8];
    cum[0] = lw[0];
#pragma unroll
    for (int u = 1; u < 8; ++u) cum[u] = cum[u - 1] + lw[u];
    gsum[tg * 64 + c] = cum[7];
    LBAR();
    float off = 0.f, LC = 0.f;
#pragma unroll
    for (int g2 = 0; g2 < 8; ++g2) { const float gs = gsum[g2 * 64 + c]; LC += gs; off += (g2 < tg) ? gs : 0.f; }
    bf16x8 vKtT, vBbT, vKbT, vXT;
#pragma unroll
    for (int u = 0; u < 8; ++u) {
      const int t = tg * 8 + u;
      const float L = off + cum[u], Lm1 = L - lw[u];
      if (!GDN) {
        const float eLm1 = __expf(Lm1), enL = __expf(-L), eL = __expf(L), eCL = __expf(LC - L);
        const float kt = f0[u] * eLm1;
        *(bfr*)(p0 + (t * CS + c) * 2) = f2bf(kt);
        *(bfr*)(p1 + (t * CS + c) * 2) = f2bf(f1[u] * enL);
        *(bfr*)(p2 + (t * CS + c) * 2) = f2bf(f2[u] * enL);
        *(bfr*)(p3 + (t * CS + c) * 2) = f2bf(f3[u] * eL);
        vKtT[u] = (short)f2bf(kt);
        vBbT[u] = (short)f2bf(f1[u] * eCL);
        vKbT[u] = (short)f2bf(f2[u] * eCL);
        vXT[u] = (short)f2bf(xv[u]);
      } else {
        *(bfr*)(p0 + (t * CS + c) * 2) = f2bf(f0[u]);
        *(bfr*)(p3 + (t * CS + c) * 2) = f2bf(f3[u]);
        vKtT[u] = (short)f2bf(f0[u] * __expf(Lm1));
        vBbT[u] = (short)f2bf(be[u] * f0[u] * __expf(LC - Lm1));
        vKbT[u] = (short)f2bf(f0[u] * __expf(LC - L));
        vXT[u] = (short)f2bf(be[u] * xv[u]);
        if (c == 0) { Lv[t] = L; Lm1v[t] = Lm1; betav[t] = be[u]; eLv[t] = __expf(L); }
      }
    }
    *(bf16x8*)(p4 + (c * CS + tg * 8) * 2) = vKtT;
    *(bf16x8*)(p5 + (c * CS + tg * 8) * 2) = vBbT;
    *(bf16x8*)(p6 + (c * CS + tg * 8) * 2) = vKbT;
    *(bf16x8*)(p7 + (c * CS + tg * 8) * 2) = vXT;
    if (tg == 0) gC[c] = __expf(LC);
    if (!GDN && tid < 64) { Lv[tid] = 0.f; Lm1v[tid] = 0.f; betav[tid] = 1.f; eLv[tid] = 1.f; }
  }
  LBAR();
  if (has_next) chunk_load<GDN>(pp, t_next, nx);
  {
    {
      MM_FRAGS(sKt, sBh, a0, a1, b00, b01, b10, b11)
      f32x4 c0 = {0.f, 0.f, 0.f, 0.f}, c1 = c0;
      MM_2TILES(c0, c1, a0, a1, b00, b01, b10, b11)
#pragma unroll
      for (int q = 0; q < 2; ++q) {
        const int sI = (nt0 + q) * 16 + fr;
        const f32x4 cv = q ? c1 : c0;
        f32x4 o;
#pragma unroll
        for (int r = 0; r < 4; ++r) {
          const int tI = mt * 16 + 4 * fq + r;
          float v = cv[r];
          if (GDN) v *= betav[sI] * __expf(fminf(Lm1v[tI] - Lm1v[sI], 0.f));
          o[r] = (sI < tI) ? v : 0.f;
        }
        *(f32x4*)(F0 + sI * F0_STRIDE + mt * 16 + 4 * fq) = o;
        wr_T(p11, mt, nt0 + q, fr, fq, o);
      }
    }
    {
      MM_FRAGS(sKt, sKh, a0, a1, b00, b01, b10, b11)
      f32x4 c0 = {0.f, 0.f, 0.f, 0.f}, c1 = c0;
      MM_2TILES(c0, c1, a0, a1, b00, b01, b10, b11)
#pragma unroll
      for (int q = 0; q < 2; ++q) {
        const int sI = (nt0 + q) * 16 + fr;
        const f32x4 cv = q ? c1 : c0;
        f32x4 o;
#pragma unroll
        for (int r = 0; r < 4; ++r) {
          const int tI = mt * 16 + 4 * fq + r;
          float v = cv[r];
          if (GDN) v *= __expf(fminf(Lm1v[tI] - Lv[sI], 0.f));
          o[r] = (sI < tI) ? v : 0.f;
        }
        wr_T(p9, mt, nt0 + q, fr, fq, o);
      }
    }
    {
      MM_FRAGS(sBh, p3, a0, a1, b00, b01, b10, b11)
      f32x4 c0 = {0.f, 0.f, 0.f, 0.f}, c1 = c0;
      MM_2TILES(c0, c1, a0, a1, b00, b01, b10, b11)
#pragma unroll
      for (int q = 0; q < 2; ++q) {
        const int tI = (nt0 + q) * 16 + fr;
        const f32x4 cv = q ? c1 : c0;
        f32x4 o;
#pragma unroll
        for (int r = 0; r < 4; ++r) {
          const int sI = mt * 16 + 4 * fq + r;
          float v = cv[r];
          if (GDN) v *= betav[sI] * __expf(fminf(Lv[tI] - Lm1v[sI], 0.f));
          o[r] = (sI <= tI) ? v : 0.f;
        }
        wr_T(p10, mt, nt0 + q, fr, fq, o);
      }
    }
  }
  LBAR();
  if (wv < 2) {
    const int base = wv * 32, other = 32 - base, c = lane & 31;
    float tr[32];
#pragma unroll
    for (int j = 0; j < 32; ++j) tr[j] = 0.f;
#pragma unroll
    for (int ip = 15; ip >= 0; --ip) {
      const int i = 2 * ip + 1, i2 = 2 * ip;
      float a0 = (c == i) ? 1.f : 0.f, a1 = 0.f, b0 = (c == i2) ? 1.f : 0.f, b1 = 0.f;
      const float aii = F0[(base + i2) * F0_STRIDE + base + i];
#pragma unroll
      for (int jb = ((i + 1) & ~3); jb < 32; jb += 4) {
        const f32x4 a4 = *(const f32x4*)(F0 + (base + i) * F0_STRIDE + base + jb);
        const f32x4 b4 = *(const f32x4*)(F0 + (base + i2) * F0_STRIDE + base + jb);
        a0 -= a4[0] * tr[jb]; a1 -= a4[1] * tr[jb + 1]; a0 -= a4[2] * tr[jb + 2]; a1 -= a4[3] * tr[jb + 3];
        b0 -= b4[0] * tr[jb]; b1 -= b4[1] * tr[jb + 1]; b0 -= b4[2] * tr[jb + 2]; b1 -= b4[3] * tr[jb + 3];
      }
      const float ti = a0 + a1;
      const float ti2 = (b0 + b1) - aii * ti;
      tr[i] = ti; tr[i2] = ti2;
      if (lane < 32) {
        *(bfr*)(p8 + ((base + i) * CS + base + c) * 2) = f2bf(ti);
        *(bfr*)(p8 + ((base + i) * CS + other + c) * 2) = (bfr)0;
        *(bfr*)(p8 + ((base + i2) * CS + base + c) * 2) = f2bf(ti2);
        *(bfr*)(p8 + ((base + i2) * CS + other + c) * 2) = (bfr)0;
      }
    }
    if (lane < 32) {
#pragma unroll
      for (int q = 0; q < 4; ++q) {
        bf16x8 o, z;
#pragma unroll
        for (int j = 0; j < 8; ++j) { o[j] = (short)f2bf(tr[8 * q + j]); z[j] = 0; }
        *(bf16x8*)(p12 + ((base + c) * CS + base + 8 * q) * 2) = o;
        *(bf16x8*)(p12 + ((base + c) * CS + other + 8 * q) * 2) = z;
      }
    }
  }
  LBAR();
  {
    MM_FRAGS(p11, p12, a0, a1, b00, b01, b10, b11)
    f32x4 c0 = {0.f, 0.f, 0.f, 0.f}, c1 = c0;
    MM_2TILES(c0, c1, a0, a1, b00, b01, b10, b11)
    wr_T(p1, mt, nt0, fr, fq, c0);
    wr_T(p1, mt, nt0 + 1, fr, fq, c1);
  }
  LBAR();
  if (mt < 2 && nt0 == 2) {
    MM_FRAGS(p8, p1, a0, a1, b00, b01, b10, b11)
    f32x4 c0 = {0.f, 0.f, 0.f, 0.f}, c1 = c0;
    MM_2TILES(c0, c1, a0, a1, b00, b01, b10, b11)
#pragma unroll
    for (int r = 0; r < 4; ++r) {
      *(bfr*)(p8 + ((mt * 16 + 4 * fq + r) * CS + (nt0) * 16 + fr) * 2) = f2bf(-c0[r]);
      *(bfr*)(p8 + ((mt * 16 + 4 * fq + r) * CS + (nt0 + 1) * 16 + fr) * 2) = f2bf(-c1[r]);
    }
  }
  LBAR();
  {
    {
      MM_FRAGS(p8, p5, a0, a1, b00, b01, b10, b11)
      f32x4 c0 = {0.f, 0.f, 0.f, 0.f}, c1 = c0;
      MM_2TILES(c0, c1, a0, a1, b00, b01, b10, b11)
      wr_T(p11, mt, nt0, fr, fq, -c0);
      wr_T(p11, mt, nt0 + 1, fr, fq, -c1);
    }
    {
      MM_FRAGS(p8, p10, a0, a1, b00, b01, b10, b11)
      f32x4 c0 = {0.f, 0.f, 0.f, 0.f}, c1 = c0;
      MM_2TILES(c0, c1, a0, a1, b00, b01, b10, b11)
      wr_T(p12, mt, nt0, fr, fq, -c0);
      wr_T(p12, mt, nt0 + 1, fr, fq, -c1);
    }
  }
  LBAR();
  {
    {
      MM_FRAGS(p4, p11, a0, a1, b00, b01, b10, b11)
      f32x4 c0 = {0.f, 0.f, 0.f, 0.f}, c1 = c0;
      MM_2TILES(c0, c1, a0, a1, b00, b01, b10, b11)
#pragma unroll
      for (int q = 0; q < 2; ++q) {
        const int cp = (nt0 + q) * 16 + fr;
        f32x4 cv = q ? c1 : c0;
#pragma unroll
        for (int r = 0; r < 4; ++r) { const int cI = mt * 16 + 4 * fq + r; if (cI == cp) cv[r] += gC[cI]; }
        wr_T(p10, mt, nt0 + q, fr, fq, cv);
      }
    }
    {
      MM_FRAGS(p9, p11, a0, a1, b00, b01, b10, b11)
      f32x4 c0 = {0.f, 0.f, 0.f, 0.f}, c1 = c0;
      MM_2TILES(c0, c1, a0, a1, b00, b01, b10, b11)
#pragma unroll
      for (int q = 0; q < 2; ++q) {
        const int cp = (nt0 + q) * 16 + fr;
        f32x4 cv = q ? c1 : c0;
        const bf16x4 kb = *(const bf16x4*)(p6 + (cp * CS + mt * 16 + 4 * fq) * 2);
#pragma unroll
        for (int r = 0; r < 4; ++r) cv[r] += __uint_as_float(((unsigned)(unsigned short)kb[r]) << 16);
        wr_T(p8, mt, nt0 + q, fr, fq, cv);
      }
    }
    {
      MM_FRAGS(p4, p12, a0, a1, b00, b01, b10, b11)
      f32x4 c0 = {0.f, 0.f, 0.f, 0.f}, c1 = c0;
      MM_2TILES(c0, c1, a0, a1, b00, b01, b10, b11)
#pragma unroll
      for (int q = 0; q < 2; ++q) {
        const int tI = (nt0 + q) * 16 + fr;
        f32x4 cv = q ? c1 : c0;
        const bf16x4 rt = *(const bf16x4*)(p3 + (tI * CS + mt * 16 + 4 * fq) * 2);
        const float el = eLv[tI];
#pragma unroll
        for (int r = 0; r < 4; ++r) cv[r] += __uint_as_float(((unsigned)(unsigned short)rt[r]) << 16) * el;
        wr_T(p1, mt, nt0 + q, fr, fq, cv);
      }
    }
    {
      f32x4 c0 = {0.f, 0.f, 0.f, 0.f}, c1 = c0;
      {
        MM_FRAGS(sKh, p3, a0, a1, b00, b01, b10, b11)
        MM_2TILES(c0, c1, a0, a1, b00, b01, b10, b11)
      }
#pragma unroll
      for (int q = 0; q < 2; ++q) {
        const int tI = (nt0 + q) * 16 + fr;
#pragma unroll
        for (int r = 0; r < 4; ++r) {
          const int sI = mt * 16 + 4 * fq + r;
          float v = q ? c1[r] : c0[r];
          if (GDN) v *= __expf(fminf(Lv[tI] - Lv[sI], 0.f));
          v = (sI <= tI) ? v : 0.f;
          if (q) c1[r] = v; else c0[r] = v;
        }
      }
      {
        MM_FRAGS(p9, p12, a0, a1, b00, b01, b10, b11)
        MM_2TILES(c0, c1, a0, a1, b00, b01, b10, b11)
      }
      wr_T(p5, mt, nt0, fr, fq, c0);
      wr_T(p5, mt, nt0 + 1, fr, fq, c1);
    }
  }
  LBAR();
  {
    {
      MM_FRAGS(p8, p7, a0, a1, b00, b01, b10, b11)
      f32x4 c0 = {0.f, 0.f, 0.f, 0.f}, c1 = c0;
      MM_2TILES(c0, c1, a0, a1, b00, b01, b10, b11)
      bfr* QT = (bfr*)(CH + cc * CH_REC + CH_QT);
      *(bf16x4*)(QT + ((mt * 4 + nt0) * 64 + lane) * 4) = pack4(c0[0], c0[1], c0[2], c0[3]);
      *(bf16x4*)(QT + ((mt * 4 + nt0 + 1) * 64 + lane) * 4) = pack4(c1[0], c1[1], c1[2], c1[3]);
    }
    {
      MM_FRAGS(p7, p5, a0, a1, b00, b01, b10, b11)
      f32x4 c0 = {0.f, 0.f, 0.f, 0.f}, c1 = c0;
      MM_2TILES(c0, c1, a0, a1, b00, b01, b10, b11)
      bfr* YX = (bfr*)(CH + cc * CH_REC + CH_YX);
      *(bf16x4*)(YX + ((mt * 4 + nt0) * 64 + lane) * 4) = pack4(c0[0], c0[1], c0[2], c0[3]);
      *(bf16x4*)(YX + ((mt * 4 + nt0 + 1) * 64 + lane) * 4) = pack4(c1[0], c1[1], c1[2], c1[3]);
    }
    {
      const int fm = wv >> 1, fa = wv & 1;
      const int row = fm * 16 + fr;
      {
        const bf16x4 lo = *(const bf16x4*)(p10 + (row * CS + 32 * fa + 4 * fq) * 2);
        const bf16x4 hi = *(const bf16x4*)(p10 + (row * CS + 32 * fa + 16 + 4 * fq) * 2);
        bf16x8 f; f[0] = lo[0]; f[1] = lo[1]; f[2] = lo[2]; f[3] = lo[3]; f[4] = hi[0]; f[5] = hi[1]; f[6] = hi[2]; f[7] = hi[3];
        *(bf16x8*)(CH + cc * CH_REC + CH_PT + (size_t)((fm * 2 + fa) * 64 + lane) * 16) = f;
      }
      {
        const bf16x4 lo = *(const bf16x4*)(p1 + (row * CS + 32 * fa + 4 * fq) * 2);
        const bf16x4 hi = *(const bf16x4*)(p1 + (row * CS + 32 * fa + 16 + 4 * fq) * 2);
        bf16x8 f; f[0] = lo[0]; f[1] = lo[1]; f[2] = lo[2]; f[3] = lo[3]; f[4] = hi[0]; f[5] = hi[1]; f[6] = hi[2]; f[7] = hi[3];
        *(bf16x8*)(CH + cc * CH_REC + CH_RYT + (size_t)((fm * 2 + fa) * 64 + lane) * 16) = f;
      }
    }
  }
  LBAR();
}

template <bool GDN>
__device__ __forceinline__ void chunk_prep_loop(PP pp, int t0, int tend, int nb, char* smem) {
  ChunkIn cur, nxt;
  if (t0 < tend) chunk_load<GDN>(pp, t0, cur);
  for (int t = t0; t < tend; t += nb) {
    const bool has_next = (t + nb) < tend;
    chunk_prep_task<GDN>(pp, t, t + nb, has_next, cur, nxt, smem);
    cur = nxt;
  }
}
__device__ __forceinline__ void phase_chunk_prep(PP pp, int bid, int nb, char* smem) {
  __syncthreads();
  const int half = (NCHAIN / 2) * NCHUNK;
  chunk_prep_loop<false>(pp, bid, half, nb, smem);
  const int k0 = (half - bid + nb - 1) / nb;
  chunk_prep_loop<true>(pp, bid + k0 * nb, NCHAIN * NCHUNK, nb, smem);
  __syncthreads();
}

#define X2_BUF 32768
#define X2_BAR() do { asm volatile("s_waitcnt lgkmcnt(0)" ::: "memory"); __builtin_amdgcn_s_barrier(); asm volatile("" ::: "memory"); } while (0)
__device__ __forceinline__ void chunk_seq_chain(PP pp, int chain, char* smem) {
  __syncthreads();
  const int tid = tid_opaque(), lane = tid & 63, wv = wave_id(tid);
  const int d = chain & 1, h = (chain >> 1) & 3, b = (chain >> 3) & 1, ty = chain >> 4;
  const char* CH = p.ws + OFF_CH;
  bfr* Y = (bfr*)(p.ws + OFF_S + (ty ? S_YGD : S_YRW)) + (size_t)d * NTOK * 256;
  const size_t c0 = (size_t)chain * NCHUNK;
  if (wv >= 4) {
    const int lw = wv - 4;
    const char* src0 = CH + c0 * CH_REC + (size_t)lane * 16;
#define X2_DMA(n) { const char* s_ = src0 + (size_t)(n) * CH_REC; LAS unsigned char* d_ = (LAS unsigned char*)smem + ((n) & 3) * X2_BUF;       \
      _Pragma("unroll") for (int i = 0; i < 8; ++i) {                                                                                       \
        const int piece = i * 4 + lw;                                                                                                       \
        __builtin_amdgcn_global_load_lds((const unsigned*)(s_ + piece * 1024), (LAS unsigned*)(d_ + piece * 1024), 16, 0, 0); } }
    X2_DMA(0) X2_DMA(1) X2_DMA(2)
    asm volatile("s_waitcnt vmcnt(16)" ::: "memory");
    X2_BAR();
    for (int n = 0; n < NCHUNK; ++n) {
      if (n + 3 < NCHUNK) { X2_DMA(n + 3) asm volatile("s_waitcnt vmcnt(16)" ::: "memory"); }
      else if (n + 2 < NCHUNK) asm volatile("s_waitcnt vmcnt(8)" ::: "memory");
      else asm volatile("s_waitcnt vmcnt(0)" ::: "memory");
      X2_BAR();
    }
#undef X2_DMA
  } else {
    const int vt = wv, fr = lane & 15, fq = lane >> 4;
    f32x4 Sacc[4];
#pragma unroll
    for (int i = 0; i < 4; ++i) Sacc[i] = (f32x4){0.f, 0.f, 0.f, 0.f};
    X2_BAR();
    for (int n = 0; n < NCHUNK; ++n) {
      const char* buf = smem + (n & 3) * X2_BUF;
      bf16x8 sB0, sB1;
#pragma unroll
      for (int j = 0; j < 4; ++j) {
        sB0[j] = (short)f2bf(Sacc[0][j]); sB0[4 + j] = (short)f2bf(Sacc[1][j]);
        sB1[j] = (short)f2bf(Sacc[2][j]); sB1[4 + j] = (short)f2bf(Sacc[3][j]);
      }
#pragma unroll
      for (int m = 0; m < 4; ++m) {
        const bf16x8 pa0 = *(const bf16x8*)(buf + ((m * 2 + 0) * 64 + lane) * 16);
        const bf16x8 pa1 = *(const bf16x8*)(buf + ((m * 2 + 1) * 64 + lane) * 16);
        const bf16x8 ra0 = *(const bf16x8*)(buf + 8192 + ((m * 2 + 0) * 64 + lane) * 16);
        const bf16x8 ra1 = *(const bf16x8*)(buf + 8192 + ((m * 2 + 1) * 64 + lane) * 16);
        const bf16x4 qb = *(const bf16x4*)(buf + 16384 + ((m * 4 + vt) * 64 + lane) * 8);
        const bf16x4 yb = *(const bf16x4*)(buf + 24576 + ((vt * 4 + m) * 64 + lane) * 8);
        f32x4 y = {bf2f(yb[0]), bf2f(yb[1]), bf2f(yb[2]), bf2f(yb[3])};
        y = __builtin_amdgcn_mfma_f32_16x16x32_bf16(sB0, ra0, y, 0, 0, 0);
        y = __builtin_amdgcn_mfma_f32_16x16x32_bf16(sB1, ra1, y, 0, 0, 0);
        f32x4 sn = {bf2f(qb[0]), bf2f(qb[1]), bf2f(qb[2]), bf2f(qb[3])};
        sn = __builtin_amdgcn_mfma_f32_16x16x32_bf16(pa0, sB0, sn, 0, 0, 0);
        sn = __builtin_amdgcn_mfma_f32_16x16x32_bf16(pa1, sB1, sn, 0, 0, 0);
        Sacc[m] = sn;
        {
          const int mm = scan_tok(b, d, n * 64 + m * 16 + fr);
          *(bf16x4*)(Y + (size_t)mm * 256 + h * 64 + vt * 16 + 4 * fq) = pack4(y[0], y[1], y[2], y[3]);
        }
      }
      X2_BAR();
    }
  }
}

struct NaPair { int mk0, mk1, tau0, tau1, kr0, kr1, ct0, ct1; };
struct NaFrag { bf16x8 k00, k01, k10, k11; bf16x4 v0[4], v1[4]; };

__device__ __forceinline__ void na_load(NaFrag& f, const bfr* KN, const bfr* VT, size_t vt_base, int h, int fr, int fq, const NaPair& pr) {
  const bfr* k0 = KN + (size_t)(pr.mk0 + fr) * 512 + h * 64 + fq * 8;
  const bfr* k1 = KN + (size_t)(pr.mk1 + fr) * 512 + h * 64 + fq * 8;
  f.k00 = *(const bf16x8*)(k0); f.k01 = *(const bf16x8*)(k0 + 32);
  f.k10 = *(const bf16x8*)(k1); f.k11 = *(const bf16x8*)(k1 + 32);
#pragma unroll
  for (int dt = 0; dt < 4; ++dt) {
    const int vo = (dt * 16 + fr) * 16 + fq * 4;
    f.v0[dt] = *(const bf16x4*)(VT + vt_base + (size_t)(pr.tau0 >> 4) * 1024 + vo);
    f.v1[dt] = *(const bf16x4*)(VT + vt_base + (size_t)(pr.tau1 >> 4) * 1024 + vo);
  }
}

__device__ __forceinline__ void na_compute(const NaFrag& f, const bf16x8 qf0, const bf16x8 qf1, bool local, bool vr0, bool vr1,
                                           int dr0, int dr1, int ct0, int ct1, int qc, int fq, const float* bias_h, f32x4 (&O)[4], float& lsum) {
  f32x4 z = {0.f, 0.f, 0.f, 0.f};
  f32x4 st0 = __builtin_amdgcn_mfma_f32_16x16x32_bf16(f.k00, qf0, z, 0, 0, 0);
  st0 = __builtin_amdgcn_mfma_f32_16x16x32_bf16(f.k01, qf1, st0, 0, 0, 0);
  f32x4 st1 = __builtin_amdgcn_mfma_f32_16x16x32_bf16(f.k10, qf0, z, 0, 0, 0);
  st1 = __builtin_amdgcn_mfma_f32_16x16x32_bf16(f.k11, qf1, st1, 0, 0, 0);
  bf16x8 pf;
  if (local) {
    const int cs = min(max(qc - 8, 0), 48);
#pragma unroll
    for (int r = 0; r < 4; ++r) {
      const int kc0 = ct0 * 16 + fq * 4 + r, kc1 = ct1 * 16 + fq * 4 + r;
      float p0 = 0.f, p1 = 0.f;
      if (vr0 && (unsigned)(kc0 - cs) < 16u) p0 = __builtin_amdgcn_exp2f(st0[r] + bias_h[dr0 * 31 + (kc0 - qc + 15)]);
      if (vr1 && (unsigned)(kc1 - cs) < 16u) p1 = __builtin_amdgcn_exp2f(st1[r] + bias_h[dr1 * 31 + (kc1 - qc + 15)]);
      lsum += p0 + p1;
      pf[r] = (short)f2bf(p0);
      pf[4 + r] = (short)f2bf(p1);
    }
  } else {
#pragma unroll
    for (int r = 0; r < 4; ++r) {
      const float p0 = __builtin_amdgcn_exp2f(st0[r]), p1 = __builtin_amdgcn_exp2f(st1[r]);
      lsum += p0 + p1;
      pf[r] = (short)f2bf(p0);
      pf[4 + r] = (short)f2bf(p1);
    }
  }
#pragma unroll
  for (int dt = 0; dt < 4; ++dt) {
    bf16x8 vf;
    vf[0] = f.v0[dt][0]; vf[1] = f.v0[dt][1]; vf[2] = f.v0[dt][2]; vf[3] = f.v0[dt][3];
    vf[4] = f.v1[dt][0]; vf[5] = f.v1[dt][1]; vf[6] = f.v1[dt][2]; vf[7] = f.v1[dt][3];
    O[dt] = __builtin_amdgcn_mfma_f32_16x16x32_bf16(vf, pf, O[dt], 0, 0, 0);
  }
}

__device__ __forceinline__ void na_block_task(PP pp, int task, const float* bias_lds) {
  const int tid = tid_opaque(), lane = tid & 63, wv = wave_id(tid);
  const int fr = lane & 15, fq = lane >> 4;
  char* S = p.ws + OFF_S;
  const bfr* QN = (const bfr*)(S + S_QN);
  const bfr* KN = (const bfr*)(S + S_KN);
  const bfr* VT = (const bfr*)(S + S_VT);
  bfr* CC = (bfr*)(p.ws + OFF_CC);
  const bool latent = task < 1024;
  int b, h, mqa, mqb, qra = 0, qrb = 0, cgp = 0;
  if (latent) {
    h = task & 7; const int quad = (task >> 3) & 63; b = task >> 9;
    qra = quad * 4 + (wv >> 2) * 2; qrb = qra + 1; cgp = wv & 3;
    mqa = b * SEQ + qra * 64 + cgp * 16; mqb = mqa + 64;
  } else {
    const int u = task - 1024;
    h = u & 7; b = u >> 3;
    mqa = NLAT + b * CTXL + (wv * 2) * 16; mqb = mqa + 16;
  }
  const bf16x8 qa0 = *(const bf16x8*)(QN + (size_t)(mqa + fr) * 512 + h * 64 + fq * 8);
  const bf16x8 qa1 = *(const bf16x8*)(QN + (size_t)(mqa + fr) * 512 + h * 64 + 32 + fq * 8);
  const bf16x8 qb0 = *(const bf16x8*)(QN + (size_t)(mqb + fr) * 512 + h * 64 + fq * 8);
  const bf16x8 qb1 = *(const bf16x8*)(QN + (size_t)(mqb + fr) * 512 + h * 64 + 32 + fq * 8);
  f32x4 Oa[4], Ob[4];
#pragma unroll
  for (int dt = 0; dt < 4; ++dt) { Oa[dt] = (f32x4){0.f, 0.f, 0.f, 0.f}; Ob[dt] = Oa[dt]; }
  float lsa = 0.f, lsb = 0.f;
  const size_t vt_base = (size_t)(b * 8 + h) * 64 * TTOK;
  const int rsa = min(max(qra - 4, 0), SEQ / 64 - 8), rsb = min(max(qrb - 4, 0), SEQ / 64 - 8);
  const int nrows = latent ? (rsb - rsa + 8) : 0;
  const int ct_first = (cgp <= 1) ? 0 : cgp - 1;
  const int nct = (cgp == 0 || cgp == 3) ? 2 : 3;
  const int ntile = nrows * nct;
  const int nlp = (ntile + 1) >> 1;
  const int npair = nlp + 8;
  const int qc = cgp * 16 + fr;
  auto mkpair = [&](int pi) {
    NaPair pr;
    if (pi < nlp) {
      const int i0 = 2 * pi, i1 = min(2 * pi + 1, ntile - 1);
      pr.kr0 = rsa + i0 / nct; pr.ct0 = ct_first + i0 % nct;
      pr.kr1 = rsa + i1 / nct; pr.ct1 = ct_first + i1 % nct;
      if (2 * pi + 1 >= ntile) pr.kr1 = -100;
      const int r1 = rsa + i1 / nct;
      pr.tau0 = pr.kr0 * 64 + pr.ct0 * 16; pr.tau1 = r1 * 64 + pr.ct1 * 16;
      pr.mk0 = b * SEQ + pr.tau0; pr.mk1 = b * SEQ + pr.tau1;
    } else {
      const int c = pi - nlp;
      pr.kr0 = pr.kr1 = pr.ct0 = pr.ct1 = 0;
      pr.tau0 = SEQ + c * 32; pr.tau1 = SEQ + c * 32 + 16;
      pr.mk0 = NLAT + b * CTXL + c * 32; pr.mk1 = pr.mk0 + 16;
    }
    return pr;
  };
  NaFrag fa, fb;
  NaPair pa = mkpair(0), pb;
  na_load(fa, KN, VT, vt_base, h, fr, fq, pa);
  const float* bias_h = bias_lds + h * 465;
#define NA_DO(F, PR, PI)                                                                                          \
  {                                                                                                               \
    const bool loc_ = (PI) < nlp;                                                                                 \
    na_compute(F, qa0, qa1, loc_, (unsigned)(PR.kr0 - rsa) < 8u, (unsigned)(PR.kr1 - rsa) < 8u,                   \
               PR.kr0 - qra + 7, PR.kr1 - qra + 7, PR.ct0, PR.ct1, qc, fq, bias_h, Oa, lsa);                      \
    na_compute(F, qb0, qb1, loc_, (unsigned)(PR.kr0 - rsb) < 8u, (unsigned)(PR.kr1 - rsb) < 8u,                   \
               PR.kr0 - qrb + 7, PR.kr1 - qrb + 7, PR.ct0, PR.ct1, qc, fq, bias_h, Ob, lsb);                      \
  }
  for (int pi = 0; pi < npair; pi += 2) {
    if (pi + 1 < npair) { pb = mkpair(pi + 1); na_load(fb, KN, VT, vt_base, h, fr, fq, pb); }
    NA_DO(fa, pa, pi)
    if (pi + 1 < npair) {
      if (pi + 2 < npair) { pa = mkpair(pi + 2); na_load(fa, KN, VT, vt_base, h, fr, fq, pa); }
      NA_DO(fb, pb, pi + 1)
    }
  }
#undef NA_DO
  lsa += shfl_xor_l(lsa, 16, lane); lsa += shfl_xor_l(lsa, 32, lane);
  lsb += shfl_xor_l(lsb, 16, lane); lsb += shfl_xor_l(lsb, 32, lane);
  const float ia = 1.f / lsa, ib = 1.f / lsb;
#pragma unroll
  for (int dt = 0; dt < 4; ++dt) {
    *(bf16x4*)(CC + (size_t)(mqa + fr) * 1024 + h * 64 + dt * 16 + fq * 4) = pack4(Oa[dt][0] * ia, Oa[dt][1] * ia, Oa[dt][2] * ia, Oa[dt][3] * ia);
    *(bf16x4*)(CC + (size_t)(mqb + fr) * 1024 + h * 64 + dt * 16 + fq * 4) = pack4(Ob[dt][0] * ib, Ob[dt][1] * ib, Ob[dt][2] * ib, Ob[dt][3] * ib);
  }
}

__device__ __forceinline__ void phase_mix(PP pp, int l, int bid, int nb, char* smem) {
  const int tid = tid_opaque();
  const int nscan_blocks = (nb > 32) ? 32 : nb;
  const int first_attn_block = (nb > 32) ? 32 : 0;
  if (bid < nscan_blocks) {
    for (int c = bid; c < NCHAIN; c += nscan_blocks) chunk_seq_chain(pp, c, smem);
  }
  if (bid >= first_attn_block) {
    float* bias = (float*)smem;
    __syncthreads();
    for (int i = tid; i < 8 * 465; i += NTHR) bias[i] = p.na_rpb[(size_t)l * 8 * 465 + i] * 1.4426950408889634f;
    __syncthreads();
    const int ntask = (l == 0) ? 1024 + 16 : 1024;
    const int nab = nb - first_attn_block;
    for (int t = bid - first_attn_block; t < ntask; t += nab) na_block_task(pp, t, bias);
    __syncthreads();
    phase_convert(pp, l, 1, bid - first_attn_block, nab, smem);
    if (l == 0) phase_convert(pp, 1, 0, bid - first_attn_block, nab, smem);
  }
}

__device__ __forceinline__ void phase_post(PP pp, int l, int bid, int nb) {
  const int tid = tid_opaque(), lane = tid & 63, wv = wave_id(tid);
  char* S = p.ws + OFF_S;
  const bfr* YRW = (const bfr*)(S + S_YRW);
  const bfr* YGD = (const bfr*)(S + S_YGD);
  const bfr* RWV = (const bfr*)(S + S_RWV);
  const bfr* RWG = (const bfr*)(S + S_RWG);
  const float* BON = (const float*)(S + S_BON);
  const bfr* P = (const bfr*)(p.ws + OFF_P);
  bfr* CC = (bfr*)(p.ws + OFF_CC);
  const float* ln_w = p.rw_ln_w + (size_t)l * 256;
  const float* ln_b = p.rw_ln_b + (size_t)l * 256;
  const float* ng = p.gd_norm_g + (size_t)l * 64;
  const int ntok = (l == 0) ? NTOK : NLAT;
  const int cb = lane * 4, hh = lane >> 4;
  const f32x4 lw4 = *(const f32x4*)(ln_w + cb), lb4 = *(const f32x4*)(ln_b + cb), ng4 = *(const f32x4*)(ng + (cb & 63));
  for (int m = bid * 8 + wv; m < ntok; m += nb * 8) {
    const size_t o = (size_t)m * 256 + cb;
    const f32x4 y0 = ldbf4(YRW + o), y1 = ldbf4(YRW + (size_t)NTOK * 256 + o);
    const f32x4 rv = ldbf4(RWV + o), rg = ldbf4(RWG + o);
    const f32x4 g0 = ldbf4(YGD + o), g1 = ldbf4(YGD + (size_t)NTOK * 256 + o);
    const f32x4 z = ldbf4(P + (size_t)m * PINP + B_END + 768 + cb);
    const float bon = BON[(size_t)m * 4 + hh];
    {
      const f32x4 y = y0 + y1;
      const float mean = row16_sum((y[0] + y[1]) + (y[2] + y[3])) * (1.f / 64.f);
      const f32x4 dv = y - mean;
      const float var = row16_sum((dv[0] * dv[0] + dv[1] * dv[1]) + (dv[2] * dv[2] + dv[3] * dv[3])) * (1.f / 64.f);
      const f32x4 out = ((dv * rsqrtf(var + 64e-5f)) * lw4 + lb4 + rv * bon) * rg;
      *(bf16x4*)(CC + (size_t)m * 1024 + 512 + cb) = pack4(out[0], out[1], out[2], out[3]);
    }
    {
      const f32x4 y = g0 + g1;
      const float ms = row16_sum((y[0] * y[0] + y[1] * y[1]) + (y[2] * y[2] + y[3] * y[3])) * (1.f / 64.f);
      const f32x4 sz = {siluf_(z[0]), siluf_(z[1]), siluf_(z[2]), siluf_(z[3])};
      const f32x4 out = (y * rsqrtf(ms + 1e-6f)) * ng4 * sz;
      *(bf16x4*)(CC + (size_t)m * 1024 + 768 + cb) = pack4(out[0], out[1], out[2], out[3]);
    }
  }
}

#define RW_LDS_ROW 36
__device__ __forceinline__ void phase_router(PP pp, int l, int bid, int nb, char* smem) {
  const int tid = tid_opaque(), lane = tid & 63, wv = wave_id(tid);
  const float* xl = p.out;
  const float* xc = (const float*)(p.ws + OFF_CTX);
  const float* mods = (const float*)(p.ws + OFF_MODS) + (size_t)l * 3 * 6144;
  const float* g = p.norm_ffn_g + (size_t)l * 1024;
  const float* rw = p.moe_router_w + (size_t)l * 1024 * 32;
  const float* rb = p.moe_router_b + (size_t)l * 32;
  bfr* H = (bfr*)(p.ws + OFF_H);
  int* cnt = (int*)(p.ws + OFF_CNT);
  int* TOKE = (int*)(p.ws + OFF_TOKE);
  int* TOKP = (int*)(p.ws + OFF_TOKP);
  float* TOKG = (float*)(p.ws + OFF_TOKG);
  float* wl = (float*)smem;
  for (int i = tid; i < 1024 * 8; i += NTHR) {
    int d = i >> 3, q = i & 7;
    *(float4*)(wl + d * RW_LDS_ROW + q * 4) = *(const float4*)(rw + (size_t)d * 32 + q * 4);
  }
  __syncthreads();
  const int ntok = (l == 0) ? NTOK : NLAT;
  const float rbl = rb[lane & 31];
  for (int m0 = (bid * 8 + wv) * 2; m0 < ntok; m0 += nb * 16) {
    float acc0[32], acc1[32];
#pragma unroll
    for (int e = 0; e < 32; ++e) { acc0[e] = 0.f; acc1[e] = 0.f; }
    float hv0[16], hv1[16];
    {
      const int ma = m0, mb = m0 + 1;
      const float* xa = (ma < NLAT) ? xl + (size_t)ma * 1024 : xc + (size_t)(ma - NLAT) * 1024;
      const float* xb = (mb < NLAT) ? xl + (size_t)mb * 1024 : xc + (size_t)(mb - NLAT) * 1024;
      const float* mda = mods + (size_t)mod_row(ma) * 6144 + 3072;
      const float* mdb = mods + (size_t)mod_row(mb) * 6144 + 3072;
      float ssa = 0.f, ssb = 0.f;
#pragma unroll
      for (int i = 0; i < 16; ++i) { hv0[i] = xa[lane + 64 * i]; hv1[i] = xb[lane + 64 * i]; }
#pragma unroll
      for (int i = 0; i < 16; ++i) { ssa += hv0[i] * hv0[i]; ssb += hv1[i] * hv1[i]; }
      ssa = wave_sum(ssa); ssb = wave_sum(ssb);
      const float rsa = rsqrtf(ssa * (1.f / 1024.f) + 1e-6f), rsb = rsqrtf(ssb * (1.f / 1024.f) + 1e-6f);
#pragma unroll
      for (int i = 0; i < 16; ++i) {
        const int d = lane + 64 * i;
        const float gg = g[d];
        hv0[i] = hv0[i] * rsa * gg * (1.f + mda[1024 + d]) + mda[d];
        hv1[i] = hv1[i] * rsb * gg * (1.f + mdb[1024 + d]) + mdb[d];
      }
      float am0 = 0.f, am1 = 0.f;
#pragma unroll
      for (int i = 0; i < 16; ++i) { am0 = fmaxf(am0, fabsf(hv0[i])); am1 = fmaxf(am1, fabsf(hv1[i])); }
      am0 = wave_max(am0); am1 = wave_max(am1);
      const float sc0 = am0 > 0.f ? am0 * (1.f / 127.f) : 1.f, sc1 = am1 > 0.f ? am1 * (1.f / 127.f) : 1.f;
      const float iv0 = 1.f / sc0, iv1 = 1.f / sc1;
      signed char* H8 = (signed char*)(p.ws + OFF_H);
#pragma unroll
      for (int i = 0; i < 16; ++i) {
        const int d = lane + 64 * i;
        H8[(size_t)ma * 1024 + d] = (signed char)(int)fminf(fmaxf(rintf(hv0[i] * iv0), -127.f), 127.f);
        H8[(size_t)mb * 1024 + d] = (signed char)(int)fminf(fmaxf(rintf(hv1[i] * iv1), -127.f), 127.f);
      }
      if (lane == 0) { float* SCL = (float*)(p.ws + OFF_SCL); SCL[ma] = sc0; SCL[mb] = sc1; }
      asm volatile("" ::: "memory");
    }
#pragma unroll
    for (int i = 0; i < 16; ++i) {
      if ((i & 3) == 0) asm volatile("" ::: "memory");
      const float* wr = wl + (lane + 64 * i) * RW_LDS_ROW;
#pragma unroll
      for (int q = 0; q < 8; ++q) {
        const float4 w = *(const float4*)(wr + q * 4);
        acc0[q * 4 + 0] += hv0[i] * w.x; acc0[q * 4 + 1] += hv0[i] * w.y; acc0[q * 4 + 2] += hv0[i] * w.z; acc0[q * 4 + 3] += hv0[i] * w.w;
        acc1[q * 4 + 0] += hv1[i] * w.x; acc1[q * 4 + 1] += hv1[i] * w.y; acc1[q * 4 + 2] += hv1[i] * w.z; acc1[q * 4 + 3] += hv1[i] * w.w;
      }
    }
#define BFLY(A, N, D)                                                                           \
    _Pragma("unroll") for (int i = 0; i < (N); ++i) {                                            \
      const bool up = (lane & (D)) != 0;                                                         \
      const float keep = up ? A[i + (N)] : A[i];                                                 \
      const float send = up ? A[i] : A[i + (N)];                                                 \
      A[i] = keep + shfl_xor_l(send, (D), lane);                                                   \
    }
    BFLY(acc0, 16, 16) BFLY(acc1, 16, 16)
    BFLY(acc0, 8, 8) BFLY(acc1, 8, 8)
    BFLY(acc0, 4, 4) BFLY(acc1, 4, 4)
    BFLY(acc0, 2, 2) BFLY(acc1, 2, 2)
    BFLY(acc0, 1, 1) BFLY(acc1, 1, 1)
#undef BFLY
    float la = acc0[0] + shfl_xor_l(acc0[0], 32, lane);
    float lb = acc1[0] + shfl_xor_l(acc1[0], 32, lane);
    const int my_e = lane & 31;
    la += rbl; lb += rbl;
    (void)my_e;
#pragma unroll
    for (int tkn = 0; tkn < 2; ++tkn) {
      float v = tkn == 0 ? la : lb;
      float tv[4]; int ti[4];
#pragma unroll
      for (int k = 0; k < 4; ++k) {
        float bv = v; int bi = lane & 31;
#pragma unroll
        for (int o = 16; o >= 1; o >>= 1) {
          float ov = shfl_xor_l(bv, o, lane); int oi = shfl_xor_li(bi, o, lane);
          bool take = (ov > bv) || (ov == bv && oi < bi);
          bv = take ? ov : bv; bi = take ? oi : bi;
        }
        tv[k] = bv; ti[k] = bi;
        if ((lane & 31) == bi) v = -3.0e38f;
      }
      float e1 = __expf(tv[1] - tv[0]), e2 = __expf(tv[2] - tv[0]), e3 = __expf(tv[3] - tv[0]);
      float inv = 1.f / (1.f + e1 + e2 + e3);
      const int m = m0 + tkn;
      if (lane < 4) {
        int e = lane == 0 ? ti[0] : lane == 1 ? ti[1] : lane == 2 ? ti[2] : ti[3];
        float gt = (lane == 0 ? 1.f : lane == 1 ? e1 : lane == 2 ? e2 : e3) * inv;
        int pos = atomicAdd(&cnt[e], 1);
        TOKE[(size_t)m * 4 + lane] = e; TOKP[(size_t)m * 4 + lane] = pos; TOKG[(size_t)m * 4 + lane] = gt;
      }
    }
  }
  __syncthreads();
}

__device__ __forceinline__ void moe_offsets(PP pp, int* toff) {
  const int* cnt = (const int*)(p.ws + OFF_CNT);
  if (tid_opaque() == 0) {
    int a = 0;
    for (int e = 0; e < 32; ++e) { toff[e] = a; a += (cnt[e] + 255) >> 8; }
    toff[32] = a;
  }
  __syncthreads();
}
__device__ __forceinline__ void moe_tile_experts(int* toff) {
  int* texp = toff + 128;
  const int ntile = toff[32];
  for (int mt = tid_opaque(); mt < ntile; mt += NTHR) {
    int e = 0;
#pragma unroll 1
    for (int k = 1; k < 32; ++k) e = (mt >= toff[k]) ? k : e;
    texp[mt] = e;
  }
  __syncthreads();
}

__device__ __forceinline__ void phase_slotfill(PP pp, int l, int bid, int nb, char* smem) {
  int* toff = (int*)smem;
  moe_offsets(pp, toff);
  const int tid = tid_opaque(), lane = tid & 63, wv = wave_id(tid);
  const int* TOKE = (const int*)(p.ws + OFF_TOKE);
  const int* TOKP = (const int*)(p.ws + OFF_TOKP);
  const float* TOKG = (const float*)(p.ws + OFF_TOKG);
  const int* cnt = (const int*)(p.ws + OFF_CNT);
  int* TOKS = (int*)(p.ws + OFF_TOKS);
  float* SLG = (float*)(p.ws + OFF_SLG);
  float* SLS = (float*)(p.ws + OFF_SLS);
  const float* SCL = (const float*)(p.ws + OFF_SCL);
  const signed char* H8 = (const signed char*)(p.ws + OFF_H);
  signed char* XG = (signed char*)(p.ws + OFF_S);
  const int n = ((l == 0) ? NTOK : NLAT) * 4;
  for (int i0 = (bid * 8 + wv) * 4; i0 < n; i0 += nb * 32) {
    const int tok = i0 >> 2;
    int sl4[4];
#pragma unroll
    for (int k = 0; k < 4; ++k) sl4[k] = toff[TOKE[i0 + k]] * 256 + TOKP[i0 + k];
    const uint4 row = *((const uint4*)(H8 + (size_t)tok * 1024) + lane);
    const float scl = SCL[tok];
    float g4[4];
#pragma unroll
    for (int k = 0; k < 4; ++k) g4[k] = TOKG[i0 + k];
#pragma unroll
    for (int k = 0; k < 4; ++k) {
      if (lane == 0) { TOKS[i0 + k] = sl4[k]; SLG[sl4[k]] = g4[k]; SLS[sl4[k]] = scl; }
      *((uint4*)(XG + (size_t)sl4[k] * 1024) + lane) = row;
    }
  }
  for (int e = 0; e < 32; ++e) {
    const int c = cnt[e];
    const int npad = ((c + 255) & ~255) - c;
    const int base = toff[e] * 256 + c;
    for (int r = bid * 8 + wv; r < npad; r += nb * 8) {
      uint4* dst = (uint4*)(XG + (size_t)(base + r) * 1024);
      dst[lane] = make_uint4(0u, 0u, 0u, 0u);
      if (lane == 0) SLS[base + r] = 0.f;
    }
  }
  __syncthreads();
}

struct EpiMoe1 {
  const float* bgu; const float* sw; const float* SLS; bfr* ACT;
  __device__ __forceinline__ void operator()(const i32x4 (&acc)[2][2][4][2], const g8::GUnit& u, int wr, int wc, int fr, int fq) const {
    const float* be = bgu + (size_t)u.e * 2048;
    const float* se = sw + (size_t)u.e * 2048;
    const int slot0 = u.pm * 256 + wr * 64 + fr;
    float sav[2][4];
#pragma unroll
    for (int ai = 0; ai < 2; ++ai)
#pragma unroll
      for (int m = 0; m < 4; ++m) sav[ai][m] = SLS[slot0 + ai * 128 + m * 16];
    f32x4 bgv[2], blv[2], sgv[2], slv[2];
#pragma unroll
    for (int bj = 0; bj < 2; ++bj) {
      const int j0 = u.pn * 128 + bj * 64 + wc * 16 + 4 * fq;
      bgv[bj] = *(const f32x4*)(be + j0); blv[bj] = *(const f32x4*)(be + 1024 + j0);
      sgv[bj] = *(const f32x4*)(se + j0); slv[bj] = *(const f32x4*)(se + 1024 + j0);
    }
#pragma unroll
    for (int bj = 0; bj < 2; ++bj) {
      const int j0 = u.pn * 128 + bj * 64 + wc * 16 + 4 * fq;
      const f32x4 bg = bgv[bj], bl = blv[bj];
      const f32x4 sg = sgv[bj], sl = slv[bj];
#pragma unroll
      for (int ai = 0; ai < 2; ++ai)
#pragma unroll
        for (int m = 0; m < 4; ++m) {
          const int slot = slot0 + ai * 128 + m * 16;
          const float sa = sav[ai][m];
          bf16x4 o;
#pragma unroll
          for (int q = 0; q < 4; ++q) {
            const float g = (float)acc[ai][bj][m][0][q] * (sa * sg[q]) + bg[q];
            const float li = (float)acc[ai][bj][m][1][q] * (sa * sl[q]) + bl[q];
            const float gv = fminf(g, 7.f);
            const float lv = fminf(fmaxf(li, -7.f), 7.f);
            o[q] = (short)f2bf(gv * sigmoidf_(1.702f * gv) * (lv + 1.f));
          }
          *(bf16x4*)(ACT + (size_t)slot * 1024 + j0) = o;
        }
    }
  }
};
__device__ __forceinline__ void phase_moe1_impl(PP pp, int l, int bid, int nb, char* smem, int* toff) {
  moe_offsets(pp, toff);
  moe_tile_experts(toff);
  g8::MoeSched S{toff, 8, 2048, nb, bid};
  EpiMoe1 E{p.moe_b_gu + (size_t)l * 32 * 2048, (const float*)(p.ws + OFF_SW) + (size_t)l * 32 * 2048, (const float*)(p.ws + OFF_SLS), (bfr*)(p.ws + OFF_P)};
  g8::gemm_stream<true>((LAS unsigned char*)smem, p.ws + OFF_S, p.ws + OFF_W + (size_t)l * WL_SIZE + WL_GU, S, E);
}

struct EpiMoe2 {
  const float* bdn; const float* SLG; bfr* YS;
  __device__ __forceinline__ void operator()(const f32x4 (&acc)[2][2][4][2], const g8::GUnit& u, int wr, int wc, int fr, int fq) const {
    const float* be = bdn + (size_t)u.e * 1024;
    const int slot0 = u.pm * 256 + wr * 64 + fr, col0 = u.pn * 256 + wc * 32 + 4 * fq;
    float gtv[2][4];
#pragma unroll
    for (int ai = 0; ai < 2; ++ai)
#pragma unroll
      for (int m = 0; m < 4; ++m) gtv[ai][m] = SLG[slot0 + ai * 128 + m * 16];
    f32x4 bvv[2][2];
#pragma unroll
    for (int bj = 0; bj < 2; ++bj)
#pragma unroll
      for (int n = 0; n < 2; ++n) bvv[bj][n] = *(const f32x4*)(be + col0 + bj * 128 + n * 16);
#pragma unroll
    for (int ai = 0; ai < 2; ++ai)
#pragma unroll
      for (int m = 0; m < 4; ++m) {
        const int slot = slot0 + ai * 128 + m * 16;
        const float gt = gtv[ai][m];
#pragma unroll
        for (int bj = 0; bj < 2; ++bj)
#pragma unroll
          for (int n = 0; n < 2; ++n) {
            const f32x4 bv = bvv[bj][n];
            const f32x4 yv = (acc[ai][bj][m][n] + bv) * gt;
            *(bf16x4*)(YS + (size_t)slot * 1024 + col0 + bj * 128 + n * 16) = pack4(yv[0], yv[1], yv[2], yv[3]);
          }
      }
  }
};
__device__ __forceinline__ void phase_moe2_impl(PP pp, int l, int bid, int nb, char* smem, int* toff) {
  moe_offsets(pp, toff);
  moe_tile_experts(toff);
  g8::MoeSched S{toff, 4, 1024, nb, bid};
  EpiMoe2 E{p.moe_b_down + (size_t)l * 32 * 1024, (const float*)(p.ws + OFF_SLG), (bfr*)(p.ws + OFF_S)};
  g8::gemm_stream<false>((LAS unsigned char*)smem, p.ws + OFF_P, p.ws + OFF_W + (size_t)l * WL_SIZE + WL_DN, S, E);
}

__device__ __forceinline__ void phase_combine(PP pp, int l, int bid, int nb) {
  const int tid = tid_opaque(), lane = tid & 63, wv = wave_id(tid);
  const bfr* YS = (const bfr*)(p.ws + OFF_S);
  const int* TOKS = (const int*)(p.ws + OFF_TOKS);
  const float* mods = (const float*)(p.ws + OFF_MODS) + (size_t)l * 3 * 6144;
  const float* mods1 = (const float*)(p.ws + OFF_MODS) + (size_t)3 * 6144;
  const float* g1n = p.norm_mix_g + 1024;
  bfr* H = (bfr*)(p.ws + OFF_H);
  float* xl = p.out;
  float* xc = (float*)(p.ws + OFF_CTX);
  const int ntok = (l == 0) ? NTOK : NLAT;
  if (l == 0) {
    int* cnt = (int*)(p.ws + OFF_CNT);
    const int gt = bid * NTHR + tid;
    if (gt < 32) cnt[gt] = 0;
  }
  for (int m = bid * 8 + wv; m < ntok; m += nb * 8) {
    float* xr = (m < NLAT) ? xl + (size_t)m * 1024 : xc + (size_t)(m - NLAT) * 1024;
    const float* g2 = mods + (size_t)mod_row(m) * 6144 + 5120;
    const int s0 = TOKS[(size_t)m * 4], s1 = TOKS[(size_t)m * 4 + 1], s2 = TOKS[(size_t)m * 4 + 2], s3 = TOKS[(size_t)m * 4 + 3];
    float4 xn[4];
    float ss = 0.f;
#pragma unroll
    for (int i = 0; i < 4; ++i) {
      const int d = (lane + 64 * i) * 4;
      const bf16x4 a = *(const bf16x4*)(YS + (size_t)s0 * 1024 + d);
      const bf16x4 b = *(const bf16x4*)(YS + (size_t)s1 * 1024 + d);
      const bf16x4 c = *(const bf16x4*)(YS + (size_t)s2 * 1024 + d);
      const bf16x4 e = *(const bf16x4*)(YS + (size_t)s3 * 1024 + d);
      const float4 gg = *(const float4*)(g2 + d);
      float4 xv = *(const float4*)(xr + d);
      xv.x += gg.x * ((bf2f(a[0]) + bf2f(b[0])) + (bf2f(c[0]) + bf2f(e[0])));
      xv.y += gg.y * ((bf2f(a[1]) + bf2f(b[1])) + (bf2f(c[1]) + bf2f(e[1])));
      xv.z += gg.z * ((bf2f(a[2]) + bf2f(b[2])) + (bf2f(c[2]) + bf2f(e[2])));
      xv.w += gg.w * ((bf2f(a[3]) + bf2f(b[3])) + (bf2f(c[3]) + bf2f(e[3])));
      *(float4*)(xr + d) = xv;
      xn[i] = xv;
      ss += xv.x * xv.x + xv.y * xv.y + xv.z * xv.z + xv.w * xv.w;
    }
    if (l == 0) {
      ss = wave_sum(ss);
      const float rs = rsqrtf(ss * (1.f / 1024.f) + 1e-6f);
      const float* md = mods1 + (size_t)mod_row(m) * 6144;
      float4 hq[4];
#pragma unroll
      for (int i = 0; i < 4; ++i) {
        const int d = (lane + 64 * i) * 4;
        const float4 gg = *(const float4*)(g1n + d);
        const float4 sh = *(const float4*)(md + d);
        const float4 sc = *(const float4*)(md + 1024 + d);
        hq[i] = make_float4(xn[i].x * rs * gg.x * (1.f + sc.x) + sh.x, xn[i].y * rs * gg.y * (1.f + sc.y) + sh.y,
                            xn[i].z * rs * gg.z * (1.f + sc.z) + sh.z, xn[i].w * rs * gg.w * (1.f + sc.w) + sh.w);
      }
      const float qs = quant_row_store(hq, (signed char*)(p.ws + OFF_H) + (size_t)m * 1024, lane);
      if (lane == 0) ((float*)(p.ws + OFF_SCL))[m] = qs;
    }
  }
}

#define XB_TMO      128
#define XB_XCNT(j)  (256  + 64 * (j))
#define XB_XSUB(j)  (1280 + 64 * (j))
#define XB_XGEN(j)  (2304 + 64 * (j))
#define XB_TOP      3328
#define XB_TOPGEN   3392
#define XCD_BAR_WORDS 3456
#define XB_SPIN_CAP (1u << 22)
__device__ __forceinline__ unsigned xb_ld(unsigned* q) { return __hip_atomic_load(q, __ATOMIC_RELAXED, __HIP_MEMORY_SCOPE_AGENT); }
__device__ __forceinline__ unsigned xb_add(unsigned* q, unsigned v) { return __hip_atomic_fetch_add(q, v, __ATOMIC_RELAXED, __HIP_MEMORY_SCOPE_AGENT); }
__device__ __forceinline__ unsigned xb_xcc_id() { return (unsigned)__builtin_amdgcn_s_getreg((3 << 11) | 20) & 0xFu; }
#define XB_SPIN(cond, bar) do { unsigned _sp = 0; while (cond) { __builtin_amdgcn_s_sleep(1); \
    if ((++_sp & 255u) == 0u) { if (xb_ld(&(bar)[XB_TMO])) break; if (_sp > XB_SPIN_CAP) { atomicAdd(&(bar)[XB_TMO], 1u); break; } } } } while (0)
struct XcdBarrier { unsigned* bar; unsigned x; volatile LAS unsigned* st; };
__device__ __forceinline__ XcdBarrier xcd_barrier_post(unsigned* bar, volatile LAS unsigned* st) {
  XcdBarrier b; b.bar = bar; b.x = xb_xcc_id(); b.st = st;
  if (tid_opaque() == 0) (void)xb_add(&bar[XB_XCNT(b.x)], 1u);
  return b;
}
__device__ __forceinline__ void xcd_barrier_complete(unsigned* bar, unsigned x, unsigned& nloc, unsigned& nx) {
  const unsigned G = gridDim.x;
  unsigned sum, cnt, mine, sp = 0u;
  for (;;) {
    sum = 0u; cnt = 0u; mine = 0u;
#pragma unroll
    for (unsigned j = 0; j < 16; ++j) { const unsigned c = xb_ld(&bar[XB_XCNT(j)]); sum += c; cnt += (c > 0u) ? 1u : 0u; mine = (j == x) ? c : mine; }
    if (sum == G) break;
    __builtin_amdgcn_s_sleep(1);
    if ((++sp & 255u) == 0u) { if (xb_ld(&bar[XB_TMO])) break; if (sp > XB_SPIN_CAP) { atomicAdd(&bar[XB_TMO], 1u); break; } }
  }
  nloc = mine > 0u ? mine : 1u; nx = cnt > 0u ? cnt : 1u;
}
__device__ __forceinline__ void xcd_barrier(const XcdBarrier& b) {
  asm volatile("s_waitcnt vmcnt(0)" ::: "memory");
  __syncthreads();
  if (tid_opaque() == 0) {
    unsigned* bar = b.bar;
    __builtin_amdgcn_s_waitcnt(0);
    unsigned nloc = b.st[0], nx = b.st[1];
    if (nloc == 0u) { xcd_barrier_complete(bar, b.x, nloc, nx); b.st[0] = nloc; b.st[1] = nx; }
    const unsigned old = xb_add(&bar[XB_XSUB(b.x)], 1u);
    const unsigned gen = old / nloc;
    if (old + 1u == (gen + 1u) * nloc) {
      __builtin_amdgcn_fence(__ATOMIC_RELEASE, "agent");
      asm volatile("s_waitcnt vmcnt(0)" ::: "memory");
      const unsigned og = xb_add(&bar[XB_TOP], 1u);
      const unsigned tg = og / nx;
      if (og + 1u == (tg + 1u) * nx) xb_add(&bar[XB_TOPGEN], 1u);
      else XB_SPIN(xb_ld(&bar[XB_TOPGEN]) == tg, bar);
      __builtin_amdgcn_fence(__ATOMIC_ACQUIRE, "agent");
      xb_add(&bar[XB_XGEN(b.x)], 1u);
      asm volatile("s_waitcnt vmcnt(0)" ::: "memory");
    } else {
      XB_SPIN(xb_ld(&bar[XB_XGEN(b.x)]) == gen, bar);
      __builtin_amdgcn_fence(__ATOMIC_ACQUIRE, "agent");
      asm volatile("s_waitcnt vmcnt(0)" ::: "memory");
    }
  }
  __syncthreads();
}

extern __shared__ __attribute__((aligned(16))) char dyn_smem[];

__global__ void __launch_bounds__(NTHR) mega(Params p_unused) {
  cg::grid_group grid = cg::this_grid();
  const int bid0 = blockIdx.x, nb0 = gridDim.x;
#if defined(__HIP_DEVICE_COMPILE__)
  PP pp0 = (PP)__builtin_amdgcn_kernarg_segment_ptr();
#else
  PP pp0 = nullptr;
#endif
#define pp ({ PP q_ = pp0; asm volatile("" : "+s"(q_)); q_; })
#define bid opq(bid0)
#define nb opq(nb0)
  int* toff_s = (int*)(dyn_smem + 147456);
  volatile LAS unsigned* xb_st = (volatile LAS unsigned*)(dyn_smem + 147456 + 256);
  {
    unsigned* barw = (unsigned*)(fresh_ws(pp0) + OFF_BAR);
    if (blockIdx.x == 0) for (int i = threadIdx.x; i < XCD_BAR_WORDS; i += NTHR) barw[i] = 0u;
    if (threadIdx.x == 0) { xb_st[0] = 0u; xb_st[1] = 0u; }
  }
  grid.sync();
  const XcdBarrier xb = xcd_barrier_post((unsigned*)(fresh_ws(pp0) + OFF_BAR), xb_st);
#define GSYNC() xcd_barrier(xb)
  phase_ada(pp, bid, nb, dyn_smem);
  phase_convert(pp, 0, 0, bid, nb, dyn_smem);
  GSYNC();
#define LAYER(LV, LAST)                                      \
  {                                                          \
    if ((LV) == 0) { phase_prenorm(pp, opq(LV), bid, nb); GSYNC(); } \
    phase_gemm_in(pp, opq(LV), bid, nb, dyn_smem);           \
    GSYNC();                                                 \
    phase_prep(pp, opq(LV), bid, nb, dyn_smem);              \
    GSYNC();                                                 \
    phase_chunk_prep(pp, bid, nb, dyn_smem);                 \
    GSYNC();                                                 \
    phase_mix(pp, opq(LV), bid, nb, dyn_smem);               \
    GSYNC();                                                 \
    phase_post(pp, opq(LV), bid, nb);                        \
    GSYNC();                                                 \
    phase_gemm_out(pp, opq(LV), bid, nb, dyn_smem);          \
    GSYNC();                                                 \
    phase_router(pp, opq(LV), bid, nb, dyn_smem);            \
    GSYNC();                                                 \
    phase_slotfill(pp, opq(LV), bid, nb, dyn_smem);          \
    GSYNC();                                                 \
    phase_moe1_impl(pp, opq(LV), bid, nb, dyn_smem, toff_s); \
    GSYNC();                                                 \
    phase_moe2_impl(pp, opq(LV), bid, nb, dyn_smem, toff_s); \
    GSYNC();                                                 \
    phase_combine(pp, opq(LV), bid, nb);                     \
    if (!(LAST)) GSYNC();                                    \
  }
  LAYER(0, false)
  LAYER(1, true)
#undef LAYER
#undef GSYNC
#undef bid
#undef nb
#undef pp
}

#undef p
extern "C" void kernel_launch(void* const* d_in, const int* in_sizes, int n_in, void* d_out, int out_size, void* d_ws,
                              size_t ws_size, hipStream_t stream) {
  Params hp{};
  const float** pp = (const float**)&hp;
  for (int i = 0; i < 34; ++i) pp[i] = (const float*)d_in[i];
  hp.out = (float*)d_out;
  hp.ws = (char*)d_ws;
  static int grid_blocks = 0;
  if (!grid_blocks) {
    (void)hipFuncSetAttribute((const void*)mega, hipFuncAttributeMaxDynamicSharedMemorySize, LDS_BYTES);
    int dev = 0, cus = 0, per_cu = 0;
    (void)hipGetDevice(&dev);
    (void)hipDeviceGetAttribute(&cus, hipDeviceAttributeMultiprocessorCount, dev);
    (void)hipOccupancyMaxActiveBlocksPerMultiprocessor(&per_cu, mega, NTHR, LDS_BYTES);
    if (per_cu < 1) per_cu = 1;
    if (per_cu > 1) per_cu = 1;
    grid_blocks = cus * per_cu;
  }
  void* args[] = {&hp};
  (void)hipLaunchCooperativeKernel((void*)mega, dim3(grid_blocks), dim3(NTHR), args, LDS_BYTES, stream);
}
```

```cpp
#include <hip/hip_runtime.h>
#include <hip/hip_bf16.h>
#include <hip/hip_cooperative_groups.h>
#include <stdint.h>
#include <type_traits>
namespace cg = cooperative_groups;

typedef __attribute__((ext_vector_type(8))) short bf16x8;
typedef __attribute__((ext_vector_type(4))) short bf16x4;
typedef __attribute__((ext_vector_type(4))) float f32x4;
typedef __attribute__((ext_vector_type(4))) int i32x4;
typedef unsigned short bfr;

#define D_MODEL 1024
#define NB 2
#define SEQ 16384
#define CTXL 256
#define NLAT (NB * SEQ)
#define NCTX (NB * CTXL)
#define NTOK (NLAT + NCTX)
#define TTOK (SEQ + CTXL)
#define PIN 3472
#define PINP 3584
#define A_END 1536
#define B_END 2432
#define NEXP 32
#define NSLOT_MAX (NTOK * 4 + NEXP * 256)
#define NTHR 512
#define LDS_BYTES (147456 + 3072)

constexpr size_t al256(size_t x) { return (x + 255) & ~(size_t)255; }
constexpr size_t WL_IN = 0;
constexpr size_t WL_OUT = WL_IN + (size_t)PINP * 1024 * 2;
constexpr size_t WL_GU = WL_OUT + (size_t)1024 * 1024 * 2;
constexpr size_t WL_DN = WL_GU + (size_t)32 * 2048 * 1024 * 2;
constexpr size_t WL_SIZE = WL_DN + (size_t)32 * 1024 * 1024 * 2;
constexpr size_t OFF_W = 0;
constexpr size_t OFF_MODS = al256(OFF_W + 2 * WL_SIZE);
constexpr size_t OFF_BAR = al256(OFF_MODS + 2 * 3 * 6144 * 4);
constexpr size_t OFF_SW = al256(OFF_BAR + 3456 * 4);
constexpr size_t OFF_SWIN = al256(OFF_SW + (size_t)2 * 32 * 2048 * 4);
constexpr size_t OFF_SLS = al256(OFF_SWIN + (size_t)2 * PINP * 4);
constexpr size_t OFF_SCL = al256(OFF_SLS + (size_t)(NTOK * 4 + 32 * 256) * 4);
constexpr size_t OFF_CTX = al256(OFF_SCL + (size_t)NTOK * 4);
constexpr size_t OFF_CNT = al256(OFF_CTX + (size_t)NCTX * 1024 * 4);
constexpr size_t OFF_TOKE = al256(OFF_CNT + 256);
constexpr size_t OFF_TOKP = al256(OFF_TOKE + (size_t)NTOK * 4 * 4);
constexpr size_t OFF_TOKG = al256(OFF_TOKP + (size_t)NTOK * 4 * 4);
constexpr size_t OFF_TOKS = al256(OFF_TOKG + (size_t)NTOK * 4 * 4);
constexpr size_t OFF_SLT = al256(OFF_TOKS + (size_t)NTOK * 4 * 4);
constexpr size_t OFF_SLG = al256(OFF_SLT + (size_t)NSLOT_MAX * 4);
constexpr size_t OFF_H = al256(OFF_SLG + (size_t)NSLOT_MAX * 4);
constexpr size_t OFF_CC = al256(OFF_H + (size_t)NTOK * 1024 * 2);
constexpr size_t OFF_P = al256(OFF_CC + (size_t)NTOK * 1024 * 2);
constexpr size_t OFF_S = al256(OFF_P + (size_t)NTOK * PINP * 4);
constexpr size_t TOK256F = (size_t)NTOK * 256 * 4;
constexpr size_t S_QN = 0;
constexpr size_t S_KN = S_QN + (size_t)NTOK * 512 * 2;
constexpr size_t S_VT = S_KN + (size_t)NTOK * 512 * 2;
constexpr size_t S_RWR = S_VT + (size_t)NB * 8 * 64 * TTOK * 2;
constexpr size_t S_RWKK = S_RWR + TOK256F;
constexpr size_t S_RWV = S_RWKK + TOK256F;
constexpr size_t S_RWG = S_RWV + TOK256F;
constexpr size_t S_RWW = S_RWG + TOK256F;
constexpr size_t S_RWKD = S_RWW + 2 * TOK256F;
constexpr size_t S_RWB = S_RWKD + 2 * TOK256F;
constexpr size_t S_BON = S_RWB + 2 * TOK256F;
constexpr size_t S_GDQ = al256(S_BON + (size_t)NTOK * 4 * 4);
constexpr size_t S_GDK = S_GDQ + TOK256F;
constexpr size_t S_GDV = S_GDK + TOK256F;
constexpr size_t S_GDAB = S_GDV + TOK256F;
constexpr size_t S_YRW = al256(S_GDAB + (size_t)NTOK * 16 * 4);
constexpr size_t S_YGD = S_YRW + 2 * TOK256F;
constexpr size_t S_END = S_YGD + 2 * TOK256F;
constexpr size_t S_SIZE = (S_END > (size_t)NSLOT_MAX * 1024 * 4) ? S_END : (size_t)NSLOT_MAX * 1024 * 4;
constexpr int NCHUNK = TTOK / 64;
constexpr int NCHAIN = 32;
constexpr size_t OFF_CH = al256(OFF_S + S_SIZE);
constexpr size_t CH_N = (size_t)NCHAIN * NCHUNK;
constexpr size_t CH_REC = 32768, CH_PT = 0, CH_RYT = 8192, CH_QT = 16384, CH_YX = 24576;
constexpr size_t CH_SIZE = CH_N * CH_REC;
constexpr size_t WS_TOTAL = OFF_CH + CH_SIZE;
static_assert(WS_TOTAL <= (size_t)2048 * 1024 * 1024, "workspace exceeds 4x largest tensor");

struct Params {
  const float *x, *c, *ctx, *c_ctx, *ada_w, *ada_b, *norm_mix_g, *norm_ffn_g, *w_in, *w_out;
  const float *na_q_gain, *na_k_gain, *na_rpb;
  const float *rw_mu, *rw_w0, *rw_w_up, *rw_a0, *rw_a_up, *rw_g_up, *rw_k_k, *rw_k_a, *rw_r_k, *rw_ln_w, *rw_ln_b;
  const float *gd_conv_w, *gd_A_log, *gd_dt_bias, *gd_norm_g;
  const float *moe_router_w, *moe_router_b, *moe_w_gu, *moe_b_gu, *moe_w_down, *moe_b_down;
  float* out;
  char* ws;
};

typedef const __attribute__((address_space(4))) Params* PP;
#define p (*pp)
__device__ __forceinline__ char* fresh_ws(PP pp) { return p.ws; }
__device__ __forceinline__ int tid_opaque() { int t = (int)__builtin_amdgcn_workitem_id_x(); asm volatile("" : "+v"(t)); return t; }
__device__ __forceinline__ int opq(int x) { asm volatile("" : "+s"(x)); return x; }
__device__ __forceinline__ int wave_id(int tid) { return __builtin_amdgcn_readfirstlane(tid >> 6); }
typedef __bf16 bf16v2_t __attribute__((ext_vector_type(2)));
typedef float f32v2_t __attribute__((ext_vector_type(2)));
__device__ __forceinline__ unsigned pk_bf16(float lo, float hi) { f32v2_t v = {lo, hi}; return __builtin_bit_cast(unsigned, __builtin_convertvector(v, bf16v2_t)); }
__device__ __forceinline__ bfr f2bf(float f) { return (bfr)(pk_bf16(f, f) & 0xffffu); }
__device__ __forceinline__ float bf2f(short v) { return __uint_as_float(((unsigned)(unsigned short)v) << 16); }
__device__ __forceinline__ bf16x4 pack4(float a, float b, float c, float d) {
  typedef __attribute__((ext_vector_type(2))) unsigned u32x2;
  u32x2 w; w[0] = pk_bf16(a, b); w[1] = pk_bf16(c, d);
  return __builtin_bit_cast(bf16x4, w);
}
__device__ __forceinline__ float sigmoidf_(float x) { return __builtin_amdgcn_rcpf(1.f + __expf(-x)); }
__device__ __forceinline__ float siluf_(float x) { return x * __builtin_amdgcn_rcpf(1.f + __expf(-x)); }
__device__ __forceinline__ float softplusf_(float x) { const float e = __expf(fminf(x, 20.f)); const float lg = __logf(1.f + e); const float r = x < -15.f ? e : lg; return x > 20.f ? x : r; }
__device__ __forceinline__ float wave_sum(float v) {
  v += __builtin_bit_cast(float, __builtin_amdgcn_update_dpp(0, __builtin_bit_cast(int, v), 0xB1, 0xF, 0xF, true));
  v += __builtin_bit_cast(float, __builtin_amdgcn_update_dpp(0, __builtin_bit_cast(int, v), 0x4E, 0xF, 0xF, true));
  v += __builtin_bit_cast(float, __builtin_amdgcn_update_dpp(0, __builtin_bit_cast(int, v), 0x141, 0xF, 0xF, true));
  v += __builtin_bit_cast(float, __builtin_amdgcn_update_dpp(0, __builtin_bit_cast(int, v), 0x140, 0xF, 0xF, true));
  v += __builtin_bit_cast(float, __builtin_amdgcn_update_dpp(0, __builtin_bit_cast(int, v), 0x142, 0xA, 0xF, false));
  v += __builtin_bit_cast(float, __builtin_amdgcn_update_dpp(0, __builtin_bit_cast(int, v), 0x143, 0xC, 0xF, false));
  return __builtin_bit_cast(float, __builtin_amdgcn_readlane(__builtin_bit_cast(int, v), 63));
}
__device__ __forceinline__ float wave_max(float v) {
  v = fmaxf(v, __builtin_bit_cast(float, __builtin_amdgcn_update_dpp(0, __builtin_bit_cast(int, v), 0xB1, 0xF, 0xF, true)));
  v = fmaxf(v, __builtin_bit_cast(float, __builtin_amdgcn_update_dpp(0, __builtin_bit_cast(int, v), 0x4E, 0xF, 0xF, true)));
  v = fmaxf(v, __builtin_bit_cast(float, __builtin_amdgcn_update_dpp(0, __builtin_bit_cast(int, v), 0x141, 0xF, 0xF, true)));
  v = fmaxf(v, __builtin_bit_cast(float, __builtin_amdgcn_update_dpp(0, __builtin_bit_cast(int, v), 0x140, 0xF, 0xF, true)));
  const float r1 = __builtin_bit_cast(float, __builtin_amdgcn_readlane(__builtin_bit_cast(int, v), 0));
  const float r2 = __builtin_bit_cast(float, __builtin_amdgcn_readlane(__builtin_bit_cast(int, v), 16));
  const float r3 = __builtin_bit_cast(float, __builtin_amdgcn_readlane(__builtin_bit_cast(int, v), 32));
  const float r4 = __builtin_bit_cast(float, __builtin_amdgcn_readlane(__builtin_bit_cast(int, v), 48));
  return fmaxf(fmaxf(r1, r2), fmaxf(r3, r4));
}
__device__ __forceinline__ float shfl_xor_l(float v, int mask, int lane) {
  return __builtin_bit_cast(float, __builtin_amdgcn_ds_bpermute((lane ^ mask) << 2, __builtin_bit_cast(int, v)));
}
__device__ __forceinline__ int shfl_xor_li(int v, int mask, int lane) {
  return __builtin_amdgcn_ds_bpermute((lane ^ mask) << 2, v);
}
__device__ __forceinline__ float row16_sum(float v) {
  v += __builtin_bit_cast(float, __builtin_amdgcn_update_dpp(0, __builtin_bit_cast(int, v), 0xB1, 0xF, 0xF, true));
  v += __builtin_bit_cast(float, __builtin_amdgcn_update_dpp(0, __builtin_bit_cast(int, v), 0x4E, 0xF, 0xF, true));
  v += __builtin_bit_cast(float, __builtin_amdgcn_update_dpp(0, __builtin_bit_cast(int, v), 0x141, 0xF, 0xF, true));
  v += __builtin_bit_cast(float, __builtin_amdgcn_update_dpp(0, __builtin_bit_cast(int, v), 0x140, 0xF, 0xF, true));
  return v;
}
__device__ __forceinline__ float quant_row_store(const float4 (&v)[4], signed char* dst_row, int lane) {
  float am = 0.f;
#pragma unroll
  for (int i = 0; i < 4; ++i) am = fmaxf(fmaxf(am, fmaxf(fabsf(v[i].x), fabsf(v[i].y))), fmaxf(fabsf(v[i].z), fabsf(v[i].w)));
  am = wave_max(am);
  const float sc = am > 0.f ? am * (1.f / 127.f) : 1.f, iv = 1.f / sc;
#pragma unroll
  for (int i = 0; i < 4; ++i) {
    const int q0 = (int)fminf(fmaxf(rintf(v[i].x * iv), -127.f), 127.f), q1 = (int)fminf(fmaxf(rintf(v[i].y * iv), -127.f), 127.f);
    const int q2 = (int)fminf(fmaxf(rintf(v[i].z * iv), -127.f), 127.f), q3 = (int)fminf(fmaxf(rintf(v[i].w * iv), -127.f), 127.f);
    *(unsigned*)(dst_row + (lane + 64 * i) * 4) = (unsigned)(q0 & 0xff) | ((unsigned)(q1 & 0xff) << 8) | ((unsigned)(q2 & 0xff) << 16) | ((unsigned)(q3 & 0xff) << 24);
  }
  return sc;
}
__device__ __forceinline__ float ldbf1(const bfr* q, size_t i) { return bf2f((short)q[i]); }
__device__ __forceinline__ f32x4 ldbf4(const bfr* q) { const bf16x4 v = *(const bf16x4*)q; return (f32x4){bf2f(v[0]), bf2f(v[1]), bf2f(v[2]), bf2f(v[3])}; }
__device__ __forceinline__ int mod_row(int m) { return m < NLAT ? (m >> 14) : 2; }

__device__ __forceinline__ void phase_ada(PP pp, int bid, int nb, char* smem) {
  float* red = (float*)smem;
  float* mods = (float*)(p.ws + OFF_MODS);
  const int tid = tid_opaque();
  for (int task = bid; task < 2 * 96; task += nb) {
    int l = task / 96, cgp = task % 96;
    int col = cgp * 64 + (tid & 63), ks = tid >> 6;
    const float* W = p.ada_w + (size_t)l * 1024 * 6144;
    float a0 = 0.f, a1 = 0.f, a2 = 0.f;
    for (int d = ks * 128; d < ks * 128 + 128; ++d) {
      float w = W[(size_t)d * 6144 + col];
      a0 += siluf_(p.c[d]) * w;
      a1 += siluf_(p.c[1024 + d]) * w;
      a2 += siluf_(p.c_ctx[d]) * w;
    }
    red[(ks * 3 + 0) * 64 + (tid & 63)] = a0;
    red[(ks * 3 + 1) * 64 + (tid & 63)] = a1;
    red[(ks * 3 + 2) * 64 + (tid & 63)] = a2;
    __syncthreads();
    if (tid < 192) {
      int r = tid >> 6, cc = tid & 63;
      float s = 0.f;
      for (int k = 0; k < 8; ++k) s += red[(k * 3 + r) * 64 + cc];
      mods[(size_t)(l * 3 + r) * 6144 + cgp * 64 + cc] = s + p.ada_b[(size_t)l * 6144 + cgp * 64 + cc];
    }
    __syncthreads();
  }
}

__device__ __forceinline__ void convert_tile(const float* src, int N, bfr* dst, int kt4  , int nt, float* tile  ) {
  const int tid = tid_opaque();
  float4 v[8];
#pragma unroll
  for (int q = 0; q < 8; ++q) {
    const int idx = tid + q * 512;
    const int kk = idx >> 4, n4 = idx & 15;
    v[q] = *(const float4*)(src + (size_t)(kt4 * 256 + kk) * N + nt * 64 + n4 * 4);
  }
#pragma unroll
  for (int q = 0; q < 8; ++q) {
    const int idx = tid + q * 512;
    const int kk = idx >> 4, n4 = idx & 15;
    tile[kk * 65 + n4 * 4 + 0] = v[q].x; tile[kk * 65 + n4 * 4 + 1] = v[q].y;
    tile[kk * 65 + n4 * 4 + 2] = v[q].z; tile[kk * 65 + n4 * 4 + 3] = v[q].w;
  }
  __syncthreads();
  {
    const int nn = tid >> 3, kc = tid & 7;
    const int n = nt * 64 + nn;
#pragma unroll
    for (int q = 0; q < 4; ++q) {
      const int k0 = (kc + 8 * q) * 8;
      *(bf16x4*)(dst + (size_t)n * 1024 + kt4 * 256 + k0) = pack4(tile[(k0 + 0) * 65 + nn], tile[(k0 + 1) * 65 + nn], tile[(k0 + 2) * 65 + nn], tile[(k0 + 3) * 65 + nn]);
      *(bf16x4*)(dst + (size_t)n * 1024 + kt4 * 256 + k0 + 4) = pack4(tile[(k0 + 4) * 65 + nn], tile[(k0 + 5) * 65 + nn], tile[(k0 + 6) * 65 + nn], tile[(k0 + 7) * 65 + nn]);
    }
  }
  __syncthreads();
}
template <int N, bool INTERLEAVE>
__device__ __forceinline__ void convert_i8(const float* src  , signed char* dst  , float* sw, int ng, char* smem) {
  const int tid = tid_opaque();
  bfr* blk = (bfr*)smem;
  int* cmax = (int*)(smem + 131072);
  if (tid < 64) cmax[tid] = 0;
  __syncthreads();
  {
    const int n4 = tid & 15, kk0 = tid >> 4;
    float m0 = 0.f, m1 = 0.f, m2 = 0.f, m3 = 0.f;
#pragma unroll 8
    for (int ps = 0; ps < 32; ++ps) {
      const int k = ps * 32 + kk0;
      const int ncol = ng * 64 + n4 * 4;
      const int ncl = (N % 64 == 0) ? ncol : min(ncol, N - 4);
      float4 v = *(const float4*)(src + (size_t)k * N + ncl);
      if (N % 64 != 0 && ncol != ncl) v = make_float4(0.f, 0.f, 0.f, 0.f);
      m0 = fmaxf(m0, fabsf(v.x)); m1 = fmaxf(m1, fabsf(v.y)); m2 = fmaxf(m2, fabsf(v.z)); m3 = fmaxf(m3, fabsf(v.w));
      *(bf16x4*)(blk + k * 64 + n4 * 4) = pack4(v.x, v.y, v.z, v.w);
    }
    atomicMax(&cmax[n4 * 4 + 0], __float_as_int(m0)); atomicMax(&cmax[n4 * 4 + 1], __float_as_int(m1));
    atomicMax(&cmax[n4 * 4 + 2], __float_as_int(m2)); atomicMax(&cmax[n4 * 4 + 3], __float_as_int(m3));
  }
  __syncthreads();
  {
    const int nn = tid >> 3, kc = tid & 7;
    const int n = ng * 64 + nn;
    const float am = __int_as_float(cmax[nn]);
    const float sc = am > 0.f ? am * (1.f / 127.f) : 1.f, iv = 1.f / sc;
    const int j = n & 1023;
    const int row = INTERLEAVE ? (j >> 4) * 32 + (j & 15) + ((n >= 1024) ? 16 : 0) : n;
    if (kc == 0) sw[n] = sc;
#pragma unroll 2
    for (int q = 0; q < 8; ++q) {
      const int k0 = (kc + 8 * q) * 16;
      unsigned w[4];
#pragma unroll
      for (int g4 = 0; g4 < 4; ++g4) {
        unsigned acc = 0u;
#pragma unroll
        for (int b = 0; b < 4; ++b) {
          const float v = bf2f((short)blk[(k0 + g4 * 4 + b) * 64 + nn]);
          const int qi = (int)fminf(fmaxf(rintf(v * iv), -127.f), 127.f);
          acc |= ((unsigned)(qi & 0xff)) << (8 * b);
        }
        w[g4] = acc;
      }
      *(uint4*)(dst + (size_t)row * 1024 + k0) = make_uint4(w[0], w[1], w[2], w[3]);
    }
  }
  __syncthreads();
}
__device__ __forceinline__ void phase_convert(PP pp, int l, int part, int bid, int nb, char* smem) {
  float* tile = (float*)smem;
  char* wl = p.ws + OFF_W + (size_t)l * WL_SIZE;
  const int T_IN = 56, T_OUT = 4 * 16, T_GU = 32 * 32, T_DN = 32 * 4 * 16;
  const int t_lo = part == 0 ? 0 : T_IN + T_OUT;
  const int t_hi = part == 0 ? T_IN + T_OUT : T_IN + T_OUT + T_GU + T_DN;
  for (int t = t_lo + bid; t < t_hi; t += nb) {
    if (t < T_IN) {
      convert_i8<PIN, false>(p.w_in + (size_t)l * 1024 * PIN, (signed char*)(wl + WL_IN), (float*)(p.ws + OFF_SWIN) + (size_t)l * PINP, t, smem);
    } else if (t < T_IN + T_OUT) {
      int u = t - T_IN; int kt4 = u / 16, nt = u % 16;
      convert_tile(p.w_out + (size_t)l * 1024 * 1024, 1024, (bfr*)(wl + WL_OUT), kt4, nt, tile);
    } else if (t < T_IN + T_OUT + T_GU) {
      int u = t - T_IN - T_OUT; int e = u / 32, ng = u % 32;
      convert_i8<2048, true>(p.moe_w_gu + ((size_t)l * 32 + e) * 1024 * 2048, (signed char*)(wl + WL_GU) + (size_t)e * 2048 * 1024,
                    (float*)(p.ws + OFF_SW) + ((size_t)l * 32 + e) * 2048, ng, smem);
    } else {
      int u = t - T_IN - T_OUT - T_GU; int e = u / 64; int v = u % 64; int kt4 = v / 16, nt = v % 16;
      convert_tile(p.moe_w_down + ((size_t)l * 32 + e) * 1024 * 1024, 1024, (bfr*)(wl + WL_DN) + (size_t)e * 1024 * 1024, kt4, nt, tile);
    }
  }
}

__device__ __forceinline__ void phase_prenorm(PP pp, int l, int bid, int nb) {
  const int tid = tid_opaque(), lane = tid & 63, wv = wave_id(tid);
  const float* xl = (l == 0) ? p.x : p.out;
  const float* xc = (l == 0) ? p.ctx : (const float*)(p.ws + OFF_CTX);
  const float* mods = (const float*)(p.ws + OFF_MODS) + (size_t)l * 3 * 6144;
  const float* g = p.norm_mix_g + (size_t)l * 1024;
  signed char* H8 = (signed char*)(p.ws + OFF_H);
  float* SCL = (float*)(p.ws + OFF_SCL);
  {
    int* cnt = (int*)(p.ws + OFF_CNT);
    int gt = bid * NTHR + tid;
    if (gt < 32) cnt[gt] = 0;
  }
  for (int m = bid * 8 + wv; m < NTOK; m += nb * 8) {
    const float* xr = (m < NLAT) ? xl + (size_t)m * 1024 : xc + (size_t)(m - NLAT) * 1024;
    const float* md = mods + (size_t)mod_row(m) * 6144;
    float4 v[4];
    float ss = 0.f;
#pragma unroll
    for (int i = 0; i < 4; ++i) {
      v[i] = *(const float4*)(xr + (lane + 64 * i) * 4);
      ss += v[i].x * v[i].x + v[i].y * v[i].y + v[i].z * v[i].z + v[i].w * v[i].w;
    }
    ss = wave_sum(ss);
    float rs = rsqrtf(ss * (1.f / 1024.f) + 1e-6f);
    float4 hq[4];
#pragma unroll
    for (int i = 0; i < 4; ++i) {
      int d = (lane + 64 * i) * 4;
      float4 gg = *(const float4*)(g + d);
      float4 sh = *(const float4*)(md + d);
      float4 sc = *(const float4*)(md + 1024 + d);
      hq[i] = make_float4(v[i].x * rs * gg.x * (1.f + sc.x) + sh.x, v[i].y * rs * gg.y * (1.f + sc.y) + sh.y,
                          v[i].z * rs * gg.z * (1.f + sc.z) + sh.z, v[i].w * rs * gg.w * (1.f + sc.w) + sh.w);
    }
    const float qs = quant_row_store(hq, H8 + (size_t)m * 1024, lane);
    if (lane == 0) SCL[m] = qs;
  }
}

#define LAS __attribute__((address_space(3)))
namespace g8 {
constexpr int BM = 256, BK = 64, HALF = 128, HTB = HALF * BK * 2, STAGE_BYTES = 8 * HTB, KD = 1024;
__device__ __forceinline__ int lds_byte(int r, int c) { const int st = (r >> 4) * 2 + (c >> 5), rr = r & 15, cc = c & 31, ob = rr * 64 + cc * 2; return st * 1024 + (ob ^ (((ob >> 9) & 1) << 5)); }
__device__ __forceinline__ void stage_rc(int b, int& R, int& C) { const int st = b / 1024, sb = b % 1024, swz = sb ^ (((sb >> 9) & 1) << 5); R = (st >> 1) * 16 + swz / 64; C = (st & 1) * 32 + (swz % 64) / 2; }
struct GUnit { int pm, pn, brow0, e; };
__device__ __forceinline__ int unit_index(int i, int c, int G, int total) {
  const int x = c & 7, j = c >> 3, q = total >> 3, r = total & 7;
  const int start = x < r ? x * (q + 1) : r * (q + 1) + (x - r) * q;
  const int size = q + (x < r ? 1 : 0);
  const int li = i * (G >> 3) + j;
  return li < size ? start + li : -1;
}

__device__ __forceinline__ f32x4 mma16(bf16x8 a, bf16x8 b, f32x4 c) { return __builtin_amdgcn_mfma_f32_16x16x32_bf16(a, b, c, 0, 0, 0); }
__device__ __forceinline__ i32x4 mma16(i32x4 a, i32x4 b, i32x4 c) { return __builtin_amdgcn_mfma_i32_16x16x64_i8(a, b, c, 0, 0, 0); }
template <bool I8, bool GATHER, class Sched, class Epi>
__device__ __forceinline__ void gemm_stream(LAS unsigned char* lds, const void* Abase, const void* Btbase, const Sched& S, const Epi& E, const int* slt = nullptr) {
  typedef typename std::conditional<I8, i32x4, f32x4>::type AccT;
  typedef typename std::conditional<I8, i32x4, bf16x8>::type FragT;
  constexpr int KB = I8 ? KD : KD * 2;
  const int tid = tid_opaque(), wid = __builtin_amdgcn_readfirstlane(tid >> 6), lane = tid & 63, wr = wid >> 2, wc = wid & 3, fr = lane & 15, fq = lane >> 4;
  constexpr int nt = KB / 128;
  int R[2], C[2];
  unsigned voffB[2];
#pragma unroll
  for (int i = 0; i < 2; ++i) { stage_rc(tid * 16 + i * 8192, R[i], C[i]); voffB[i] = (unsigned)(R[i] * KB + C[i] * 2); }
#define voffA voffB
  constexpr size_t kstep = (size_t)(BK * 2);
  constexpr size_t hstep = (size_t)HALF * KB;
  const unsigned ldsw = (unsigned)wid * 1024u;
  const int aoff = lds_byte(wr * 64 + fr, fq * 8), boff = lds_byte(wc * 32 + fr, fq * 8);
#define G8_SA(b, h) (((b) * 2 + (h)) * HTB)
#define G8_SB(b, h) ((4 + (b) * 2 + (h)) * HTB)
#define G8_STAGE(bufoff, gbase, v0, v1) do { \
    __builtin_amdgcn_global_load_lds((const unsigned*)((const char*)(gbase) + (v0)), (LAS unsigned*)(lds + (bufoff) + ldsw), 16, 0, 0); \
    __builtin_amdgcn_global_load_lds((const unsigned*)((const char*)(gbase) + (v1)), (LAS unsigned*)(lds + (bufoff) + ldsw + 8192), 16, 0, 0); } while (0)
#define G8_STAGEB(bufoff, gbase) G8_STAGE(bufoff, gbase, voffB[0], voffB[1])
#define G8_STAGEA_U(bufoff, base_u, hsel) G8_STAGE(bufoff, (base_u) + (hsel) * hstep, voffA[0], voffA[1])
#define G8_STAGEA_G(bufoff, koff, o0, o1) G8_STAGE(bufoff, (const char*)Abase + (koff), o0, o1)
#define G8_LDA(dst, b, h) do { _Pragma("unroll") for (int m = 0; m < 4; ++m) _Pragma("unroll") for (int k = 0; k < 2; ++k) dst[m][k] = *(const LAS FragT*)(lds + G8_SA(b, h) + aoff + m * 2048 + k * 1024); } while (0)
#define G8_LDB(dst, b, h) do { _Pragma("unroll") for (int n = 0; n < 2; ++n) _Pragma("unroll") for (int k = 0; k < 2; ++k) dst[n][k] = *(const LAS FragT*)(lds + G8_SB(b, h) + boff + n * 2048 + k * 1024); } while (0)
#define G8_MMA(ai, bj, At, Bt) do { __builtin_amdgcn_s_setprio(1); _Pragma("unroll") for (int m = 0; m < 4; ++m) _Pragma("unroll") for (int n = 0; n < 2; ++n) _Pragma("unroll") for (int k = 0; k < 2; ++k) \
    acc[ai][bj][m][n] = mma16(Bt[n][k], At[m][k], acc[ai][bj][m][n]); __builtin_amdgcn_s_setprio(0); } while (0)
#define G8_WAIT_V(n) asm volatile("s_waitcnt vmcnt(" #n ")" ::: "memory")
#define G8_WAIT_L(n) asm volatile("s_waitcnt lgkmcnt(" #n ")" ::: "memory")
#define G8_BAR __builtin_amdgcn_s_barrier()
#define G8_SCHED __builtin_amdgcn_sched_barrier(0)
  GUnit cur, nxt;
  int ui = 0;
  if (!S.next(0, cur)) return;
  AccT acc[2][2][4][2];
#pragma unroll
  for (int a = 0; a < 2; ++a)
#pragma unroll
    for (int b = 0; b < 2; ++b)
#pragma unroll
      for (int m = 0; m < 4; ++m)
#pragma unroll
        for (int n = 0; n < 2; ++n) acc[a][b][m][n] = AccT{};
  FragT At[4][2], B0[2][2], B1[2][2];
  const char* cA = (const char*)Abase + (size_t)cur.pm * (BM * KB);
  unsigned gA00 = 0, gA01 = 0, gA10 = 0, gA11 = 0, gN00 = 0, gN01 = 0, gN10 = 0, gN11 = 0;
  if (GATHER) {
    const int* sr = slt + cur.pm * BM;
    gA00 = (unsigned)sr[R[0]] * KB + C[0] * 2; gA01 = (unsigned)sr[R[1]] * KB + C[1] * 2;
    gA10 = (unsigned)sr[HALF + R[0]] * KB + C[0] * 2; gA11 = (unsigned)sr[HALF + R[1]] * KB + C[1] * 2;
  }
  const char* cB = (const char*)Btbase + (size_t)cur.brow0 * KB;
  G8_STAGEB(G8_SB(0, 0), cB);
  if (GATHER) G8_STAGEA_G(G8_SA(0, 0), 0, gA00, gA01); else G8_STAGEA_U(G8_SA(0, 0), cA, 0);
  G8_STAGEB(G8_SB(0, 1), cB + hstep);
  if (GATHER) G8_STAGEA_G(G8_SA(0, 1), 0, gA10, gA11); else G8_STAGEA_U(G8_SA(0, 1), cA, 1);
  if (wr == 1) G8_BAR;
  G8_WAIT_V(4); G8_BAR;
  G8_STAGEB(G8_SB(1, 0), cB + kstep);
  if (GATHER) G8_STAGEA_G(G8_SA(1, 0), kstep, gA00, gA01); else G8_STAGEA_U(G8_SA(1, 0), cA + kstep, 0);
  G8_STAGEB(G8_SB(1, 1), cB + hstep + kstep);
  G8_WAIT_V(6); G8_BAR;
  for (;;) {
    const bool has_next = S.next(ui + 1, nxt);
    const char* nA = has_next ? (const char*)Abase + (size_t)nxt.pm * (BM * KB) : cA;
    if (GATHER) {
      if (has_next) {
        const int* sr = slt + nxt.pm * BM;
        gN00 = (unsigned)sr[R[0]] * KB + C[0] * 2; gN01 = (unsigned)sr[R[1]] * KB + C[1] * 2;
        gN10 = (unsigned)sr[HALF + R[0]] * KB + C[0] * 2; gN11 = (unsigned)sr[HALF + R[1]] * KB + C[1] * 2;
      } else { gN00 = gA00; gN01 = gA01; gN10 = gA10; gN11 = gA11; }
    }
    const char* nB = has_next ? (const char*)Btbase + (size_t)nxt.brow0 * KB : cB;
#pragma unroll 1
    for (int t = 0; t < nt; t += 2) {
      const bool last = (t == nt - 2);
      const char* a1 = cA + (size_t)(t + 1) * kstep;
      const char* a2 = last ? nA : cA + (size_t)(t + 2) * kstep;
      const char* b2 = last ? nB : cB + (size_t)(t + 2) * kstep;
      const char* a3 = a2 + kstep;
      const char* b3 = b2 + kstep;
      const size_t k1 = (size_t)(t + 1) * kstep, k2 = last ? 0 : (size_t)(t + 2) * kstep, k3 = k2 + kstep;
      const unsigned w00 = last ? gN00 : gA00, w01 = last ? gN01 : gA01, w10 = last ? gN10 : gA10, w11 = last ? gN11 : gA11;
      G8_LDB(B0, 0, 0); G8_SCHED; G8_LDA(At, 0, 0); if (GATHER) G8_STAGEA_G(G8_SA(1, 1), k1, gA10, gA11); else G8_STAGEA_U(G8_SA(1, 1), a1, 1);
      G8_WAIT_L(8); G8_BAR; G8_WAIT_L(0); G8_MMA(0, 0, At, B0); G8_BAR; G8_SCHED;
      G8_LDB(B1, 0, 1); G8_STAGEB(G8_SB(0, 0), b2);
      G8_BAR; G8_WAIT_L(0); G8_MMA(0, 1, At, B1); G8_BAR;
      G8_LDA(At, 0, 1); if (GATHER) G8_STAGEA_G(G8_SA(0, 0), k2, w00, w01); else G8_STAGEA_U(G8_SA(0, 0), a2, 0);
      G8_BAR; G8_WAIT_L(0); G8_MMA(1, 0, At, B0); G8_BAR; G8_SCHED;
      G8_STAGEB(G8_SB(0, 1), b2 + hstep);
      G8_WAIT_V(6); G8_BAR; G8_MMA(1, 1, At, B1); G8_BAR;
      G8_LDB(B0, 1, 0); G8_SCHED; G8_LDA(At, 1, 0); if (GATHER) G8_STAGEA_G(G8_SA(0, 1), k2, w10, w11); else G8_STAGEA_U(G8_SA(0, 1), a2, 1);
      G8_WAIT_L(8); G8_BAR; G8_WAIT_L(0); G8_MMA(0, 0, At, B0); G8_BAR; G8_SCHED;
      G8_LDB(B1, 1, 1); G8_STAGEB(G8_SB(1, 0), b3);
      G8_BAR; G8_WAIT_L(0); G8_MMA(0, 1, At, B1); G8_BAR;
      G8_LDA(At, 1, 1); if (GATHER) G8_STAGEA_G(G8_SA(1, 0), k3, w00, w01); else G8_STAGEA_U(G8_SA(1, 0), a3, 0);
      G8_BAR; G8_WAIT_L(0); G8_MMA(1, 0, At, B0); G8_BAR; G8_SCHED;
      G8_STAGEB(G8_SB(1, 1), b3 + hstep);
      G8_WAIT_V(6); G8_BAR; G8_MMA(1, 1, At, B1); G8_BAR;
    }
    E(acc, cur, wr, wc, fr, fq);
    if (!has_next) break;
#pragma unroll
    for (int a = 0; a < 2; ++a)
#pragma unroll
      for (int b = 0; b < 2; ++b)
#pragma unroll
        for (int m = 0; m < 4; ++m)
#pragma unroll
          for (int n = 0; n < 2; ++n) acc[a][b][m][n] = AccT{};
    cur = nxt; cA = nA; cB = nB; ++ui;
    gA00 = gN00; gA01 = gN01; gA10 = gN10; gA11 = gN11;
  }
  G8_WAIT_V(0);
  if (wr == 0) G8_BAR;
  G8_BAR;
#undef G8_SA
#undef G8_SB
#undef G8_STAGE
#undef G8_STAGEB
#undef G8_STAGEA_U
#undef G8_STAGEA_G
#undef voffA
#undef G8_LDA
#undef G8_LDB
#undef G8_MMA
#undef G8_WAIT_V
#undef G8_WAIT_L
#undef G8_BAR
#undef G8_SCHED
}

struct DenseSched {
  int nM, nN, G, c;
  __device__ __forceinline__ bool next(int i, GUnit& u) const {
    const int idx = unit_index(i, c, G, nM * nN);
    if (idx < 0) return false;
    u.pm = idx / nN; u.pn = idx - u.pm * nN; u.brow0 = u.pn * BM; u.e = 0;
    return true;
  }
};
struct MoeSched {
  const int* toff; int nN, NE, G, c;
  __device__ __forceinline__ bool next(int i, GUnit& u) const {
    const int idx = unit_index(i, c, G, toff[32] * nN);
    if (idx < 0) return false;
    u.pm = idx / nN; u.pn = idx - u.pm * nN;
    const int e = toff[128 + u.pm];
    u.e = e; u.brow0 = e * NE + u.pn * BM;
    return true;
  }
};
}

struct EpiInProj {
  bfr* P; const float* SCL; const float* sw;
  __device__ __forceinline__ void operator()(const i32x4 (&acc)[2][2][4][2], const g8::GUnit& u, int wr, int wc, int fr, int fq) const {
    const int row0 = u.pm * 256 + wr * 64 + fr, col0 = u.pn * 256 + wc * 32 + 4 * fq;
    f32x4 cs[2][2];
#pragma unroll
    for (int bj = 0; bj < 2; ++bj)
#pragma unroll
      for (int n = 0; n < 2; ++n) cs[bj][n] = *(const f32x4*)(sw + col0 + bj * 128 + n * 16);
    float sav[2][4];
#pragma unroll
    for (int ai = 0; ai < 2; ++ai)
#pragma unroll
      for (int m = 0; m < 4; ++m) sav[ai][m] = SCL[row0 + ai * 128 + m * 16];
#pragma unroll
    for (int ai = 0; ai < 2; ++ai)
#pragma unroll
      for (int m = 0; m < 4; ++m) {
        const int row = row0 + ai * 128 + m * 16;
        const float sa = sav[ai][m];
        bfr* rowp = P + (size_t)row * PINP + col0;
#pragma unroll
        for (int bj = 0; bj < 2; ++bj)
#pragma unroll
          for (int n = 0; n < 2; ++n) {
            const i32x4 a = acc[ai][bj][m][n];
            f32x4 o = {(float)a[0], (float)a[1], (float)a[2], (float)a[3]};
            o = o * (cs[bj][n] * sa);
            *(bf16x4*)(rowp + bj * 128 + n * 16) = pack4(o[0], o[1], o[2], o[3]);
          }
      }
  }
};
__device__ __forceinline__ void phase_gemm_in(PP pp, int l, int bid, int nb, char* smem) {
  g8::DenseSched S{130, 14, nb, bid};
  EpiInProj E{(bfr*)(p.ws + OFF_P), (const float*)(p.ws + OFF_SCL), (const float*)(p.ws + OFF_SWIN) + (size_t)l * PINP};
  g8::gemm_stream<true, false>((LAS unsigned char*)smem, p.ws + OFF_H, p.ws + OFF_W + (size_t)l * WL_SIZE + WL_IN, S, E);
}

struct EpiOutProj {
  const float *xl, *xc, *mods; float *ol, *oc;
  __device__ __forceinline__ void operator()(const f32x4 (&acc)[2][2][4][2], const g8::GUnit& u, int wr, int wc, int fr, int fq) const {
    const bool lat = u.pm < 128;
    const float* xin = lat ? xl + (size_t)u.pm * 256 * 1024 : xc + (size_t)(u.pm - 128) * 256 * 1024;
    float* xo = lat ? ol + (size_t)u.pm * 256 * 1024 : oc + (size_t)(u.pm - 128) * 256 * 1024;
    const float* g1 = mods + (size_t)(lat ? (u.pm >> 6) : 2) * 6144 + 2048;
    const int row0 = wr * 64 + fr, col0 = u.pn * 256 + wc * 32 + 4 * fq;
#pragma unroll
    for (int bj = 0; bj < 2; ++bj)
#pragma unroll
      for (int n = 0; n < 2; ++n) {
        const f32x4 gv = *(const f32x4*)(g1 + col0 + bj * 128 + n * 16);
        f32x4 xv[2][4];
#pragma unroll
        for (int ai = 0; ai < 2; ++ai)
#pragma unroll
          for (int m = 0; m < 4; ++m) xv[ai][m] = *(const f32x4*)(xin + (size_t)(row0 + ai * 128 + m * 16) * 1024 + col0 + bj * 128 + n * 16);
#pragma unroll
        for (int ai = 0; ai < 2; ++ai)
#pragma unroll
          for (int m = 0; m < 4; ++m)
            *(f32x4*)(xo + (size_t)(row0 + ai * 128 + m * 16) * 1024 + col0 + bj * 128 + n * 16) = xv[ai][m] + gv * acc[ai][bj][m][n];
        asm volatile("" ::: "memory");
      }
  }
};
__device__ __forceinline__ void phase_gemm_out(PP pp, int l, int bid, int nb, char* smem) {
  g8::DenseSched S{(l == 0) ? 130 : 128, 4, nb, bid};
  EpiOutProj E{(l == 0) ? p.x : p.out, (l == 0) ? p.ctx : (const float*)(p.ws + OFF_CTX),
               (const float*)(p.ws + OFF_MODS) + (size_t)l * 3 * 6144, p.out, (float*)(p.ws + OFF_CTX)};
  g8::gemm_stream<false, false>((LAS unsigned char*)smem, p.ws + OFF_CC, p.ws + OFF_W + (size_t)l * WL_SIZE + WL_OUT, S, E);
}

#define LBAR() do { asm volatile("s_waitcnt lgkmcnt(0)" ::: "memory"); __builtin_amdgcn_s_barrier(); asm volatile("" ::: "memory"); } while (0)
__device__ __forceinline__ void phase_prep(PP pp, int l, int bid, int nb, char* smem) {
  const int tid = tid_opaque(), lane = tid & 63, wv = wave_id(tid);
  const bfr* P = (const bfr*)(p.ws + OFF_P);
  char* S = p.ws + OFF_S;
  bfr* QN = (bfr*)(S + S_QN);
  bfr* KN = (bfr*)(S + S_KN);
  bfr* VT = (bfr*)(S + S_VT);
  bfr* RWR = (bfr*)(S + S_RWR);
  bfr* RWKK = (bfr*)(S + S_RWKK);
  bfr* RWV = (bfr*)(S + S_RWV);
  bfr* RWG = (bfr*)(S + S_RWG);
  float* RWW = (float*)(S + S_RWW);
  bfr* RWKD = (bfr*)(S + S_RWKD);
  bfr* RWB = (bfr*)(S + S_RWB);
  float* BON = (float*)(S + S_BON);
  bfr* GDQ = (bfr*)(S + S_GDQ);
  bfr* GDK = (bfr*)(S + S_GDK);
  bfr* GDV = (bfr*)(S + S_GDV);
  float* GDAB = (float*)(S + S_GDAB);
  const float* mu = p.rw_mu + (size_t)l * 896;
  const float* w0 = p.rw_w0 + (size_t)l * 512;
  const float* w_up = p.rw_w_up + (size_t)l * 2 * 32 * 256;
  const float* a0 = p.rw_a0 + (size_t)l * 512;
  const float* a_up = p.rw_a_up + (size_t)l * 2 * 32 * 256;
  const float* g_up = p.rw_g_up + (size_t)l * 64 * 256;
  const float* k_k = p.rw_k_k + (size_t)l * 256;
  const float* k_a = p.rw_k_a + (size_t)l * 256;
  const float* r_k = p.rw_r_k + (size_t)l * 256;
  const float* conv_w = p.gd_conv_w + (size_t)l * 5 * 768;
  const float* A_log = p.gd_A_log + (size_t)l * 8;
  const float* dt_bias = p.gd_dt_bias + (size_t)l * 8;
  const float* qg = p.na_q_gain + (size_t)l * 64;
  const float* kg = p.na_k_gain + (size_t)l * 64;

  bfr* wl = (bfr*)smem;
  float* lor = (float*)(smem + 192 * 256 * 2);
  __syncthreads();
  for (int i = tid; i < 192 * 256; i += NTHR) {
    const int row = i >> 8, c = i & 255;
    const float v = row < 64 ? g_up[row * 256 + c] : row < 128 ? w_up[(row - 64) * 256 + c] : a_up[(row - 128) * 256 + c];
    wl[i] = f2bf(v);
  }
  __syncthreads();

  for (int tile = bid; tile < NTOK / 16; tile += nb) {
    const int m0 = tile * 16;
    int seq_lo, seq_hi, bb, tau0;
    if (m0 < NLAT) { bb = m0 >> 14; seq_lo = bb << 14; seq_hi = seq_lo + SEQ; tau0 = m0 - seq_lo; }
    else { bb = (m0 - NLAT) >> 8; seq_lo = NLAT + (bb << 8); seq_hi = seq_lo + CTXL; tau0 = SEQ + (m0 - seq_lo); }
    const f32x4 z4 = {0.f, 0.f, 0.f, 0.f};
    int tid_t = tid; asm volatile("" : "+v"(tid_t));
    const int lane_t = tid_t & 63;
    const int cb = lane_t * 4, hh = lane_t >> 4;
    const int lg = tid_t & 31, lt = tid_t >> 5;
    const int sl = lane_t >> 4, sc4 = (lane_t & 15) * 4;
    asm volatile("" ::: "memory");
    const f32x4 mur = *(const f32x4*)(mu + cb), muk = *(const f32x4*)(mu + 256 + cb), muv = *(const f32x4*)(mu + 512 + cb);
    const f32x4 mul = *(const f32x4*)(mu + 768 + lg * 4);

    f32x4 pr[3][4], pl[3];
    {
      const int mt0 = m0 + 2 * wv;
#pragma unroll
      for (int j = 0; j < 3; ++j)
#pragma unroll
        for (int t = 0; t < 4; ++t) {
          const int m = mt0 - 1 + t;
          const int mc = min(max(m, seq_lo), seq_hi - 1);
          const f32x4 ld = ldbf4(P + (size_t)mc * PINP + A_END + j * 256 + cb);
          pr[j][t] = (m == mc) ? ld : z4;
        }
#pragma unroll
      for (int t = 0; t < 3; ++t) {
        const int m = m0 + lt - 1 + t;
        const int mc = min(max(m, seq_lo), seq_hi - 1);
        const f32x4 ld = ldbf4(P + (size_t)mc * PINP + A_END + 768 + lg * 4);
        pl[t] = (m == mc) ? ld : z4;
      }
    }
    {
      const f32x4 v = pl[1] + mul * (0.5f * (pl[0] + pl[2]) - pl[1]);
#pragma unroll
      for (int i = 0; i < 4; ++i) {
        const int ch = lg * 4 + i;
        lor[ch * 16 + lt] = ch < 32 ? tanhf(v[i]) : ch < 64 ? v[i] : sigmoidf_(v[i]);
      }
    }
    f32x4 rr[2], rk[2], rv[2];
#pragma unroll
    for (int t = 0; t < 2; ++t) {
      rr[t] = pr[0][t + 1] + mur * (0.5f * (pr[0][t] + pr[0][t + 2]) - pr[0][t + 1]);
      rk[t] = pr[1][t + 1] + muk * (0.5f * (pr[1][t] + pr[1][t + 2]) - pr[1][t + 1]);
      rv[t] = pr[2][t + 1] + muv * (0.5f * (pr[2][t] + pr[2][t + 2]) - pr[2][t + 1]);
    }
    LBAR();
    f32x4 pg[20];
    const bool is_gd = wv < 3, is_na = (wv >= 3 && wv < 7);
    const int sec = is_gd ? wv * 4 + sl : (wv - 3) * 4 + sl;
    if (is_gd) {
#pragma unroll
      for (int t = 0; t < 20; ++t) {
        const int m = m0 - 2 + t;
        const int mc = min(max(m, seq_lo), seq_hi - 1);
        const f32x4 ld = ldbf4(P + (size_t)mc * PINP + B_END + sec * 64 + sc4);
        pg[t] = (m == mc) ? ld : z4;
      }
    } else if (is_na) {
#pragma unroll
      for (int t = 0; t < 16; ++t) pg[t] = ldbf4(P + (size_t)(m0 + t) * PINP + sec * 64 + sc4);
#pragma unroll
      for (int t = 16; t < 20; ++t) pg[t] = z4;
    } else {
#pragma unroll
      for (int t = 0; t < 20; ++t) pg[t] = z4;
    }
    asm volatile("" ::: "memory");
    {
      f32x4 gacc[2], wa0[2], wa1[2], aa0[2], aa1[2];
#pragma unroll
      for (int t = 0; t < 2; ++t) { gacc[t] = z4; wa0[t] = z4; wa1[t] = z4; aa0[t] = z4; aa1[t] = z4; }
#pragma unroll 4
      for (int j = 0; j < 64; ++j) {
        const bf16x4 wq = *(const bf16x4*)(wl + j * 256 + cb);
        const f32x4 wgt = {bf2f(wq[0]), bf2f(wq[1]), bf2f(wq[2]), bf2f(wq[3])};
        const float2 sv = *(const float2*)(lor + (64 + j) * 16 + 2 * wv);
        gacc[0] += wgt * sv.x; gacc[1] += wgt * sv.y;
      }
#pragma unroll 2
      for (int j = 0; j < 32; ++j) {
        const bf16x4 q0 = *(const bf16x4*)(wl + (64 + j) * 256 + cb), q1 = *(const bf16x4*)(wl + (96 + j) * 256 + cb);
        const bf16x4 q2 = *(const bf16x4*)(wl + (128 + j) * 256 + cb), q3 = *(const bf16x4*)(wl + (160 + j) * 256 + cb);
        const f32x4 ww0 = {bf2f(q0[0]), bf2f(q0[1]), bf2f(q0[2]), bf2f(q0[3])}, ww1 = {bf2f(q1[0]), bf2f(q1[1]), bf2f(q1[2]), bf2f(q1[3])};
        const f32x4 aw0 = {bf2f(q2[0]), bf2f(q2[1]), bf2f(q2[2]), bf2f(q2[3])}, aw1 = {bf2f(q3[0]), bf2f(q3[1]), bf2f(q3[2]), bf2f(q3[3])};
        const float2 tv = *(const float2*)(lor + j * 16 + 2 * wv);
        const float2 dv = *(const float2*)(lor + (32 + j) * 16 + 2 * wv);
        wa0[0] += ww0 * tv.x; wa0[1] += ww0 * tv.y; wa1[0] += ww1 * tv.x; wa1[1] += ww1 * tv.y;
        aa0[0] += aw0 * dv.x; aa0[1] += aw0 * dv.y; aa1[0] += aw1 * dv.x; aa1[1] += aw1 * dv.y;
      }
      asm volatile("" ::: "memory");
      const f32x4 kkc = *(const f32x4*)(k_k + cb), kac = *(const f32x4*)(k_a + cb), rkc = *(const f32x4*)(r_k + cb);
      const f32x4 w00 = *(const f32x4*)(w0 + cb), w01 = *(const f32x4*)(w0 + 256 + cb), a00 = *(const f32x4*)(a0 + cb), a01 = *(const f32x4*)(a0 + 256 + cb);
#pragma unroll
      for (int t = 0; t < 2; ++t) {
        const int m = m0 + 2 * wv + t;
        const f32x4 r = rr[t], k = rk[t], v = rv[t];
        const f32x4 kkraw = k * kkc;
        const float ssum = row16_sum((kkraw[0] * kkraw[0] + kkraw[1] * kkraw[1]) + (kkraw[2] * kkraw[2] + kkraw[3] * kkraw[3]));
        const f32x4 kk = kkraw * rsqrtf(ssum + 1e-6f);
        float bon = 0.f;
#pragma unroll
        for (int d = 0; d < 2; ++d) {
          const f32x4 wlin = d == 0 ? w00 + wa0[t] : w01 + wa1[t];
          const f32x4 alin = d == 0 ? a00 + aa0[t] : a01 + aa1[t];
          f32x4 lw, kd, bv;
#pragma unroll
          for (int i = 0; i < 4; ++i) {
            const float w_log = -softplusf_(-wlin[i]) - 0.5f;
            const float a = sigmoidf_(alin[i]);
            lw[i] = -__expf(w_log);
            kd[i] = k[i] * (1.f + (a - 1.f) * kac[i]);
            bv[i] = kk[i] * a;
            bon += r[i] * kd[i] * rkc[i];
          }
          const size_t o = ((size_t)d * NTOK + m) * 256 + cb;
          *(f32x4*)(RWW + o) = lw; *(bf16x4*)(RWKD + o) = pack4(kd[0], kd[1], kd[2], kd[3]); *(bf16x4*)(RWB + o) = pack4(bv[0], bv[1], bv[2], bv[3]);
        }
        bon = row16_sum(bon);
        const size_t o = (size_t)m * 256 + cb;
        *(bf16x4*)(RWR + o) = pack4(r[0], r[1], r[2], r[3]); *(bf16x4*)(RWKK + o) = pack4(kk[0], kk[1], kk[2], kk[3]);
        *(bf16x4*)(RWV + o) = pack4(v[0], v[1], v[2], v[3]); *(bf16x4*)(RWG + o) = pack4(gacc[t][0], gacc[t][1], gacc[t][2], gacc[t][3]);
        if ((lane_t & 15) == 0) BON[(size_t)m * 4 + hh] = bon;
      }
    }
    if (is_gd) {
      f32x4 cw[5];
#pragma unroll
      for (int j = 0; j < 5; ++j) cw[j] = *(const f32x4*)(conv_w + j * 768 + sec * 64 + sc4);
#pragma unroll
      for (int t = 0; t < 16; ++t) {
        f32x4 acc = z4;
#pragma unroll
        for (int j = 0; j < 5; ++j) acc += cw[j] * pg[t + j];
        f32x4 val = {siluf_(acc[0]), siluf_(acc[1]), siluf_(acc[2]), siluf_(acc[3])};
        const int m = m0 + t;
        if (sec < 8) {
          const float ss = row16_sum((val[0] * val[0] + val[1] * val[1]) + (val[2] * val[2] + val[3] * val[3]));
          val = val * rsqrtf(ss + 1e-6f);
          if (sec < 4) { const f32x4 vq = val * 0.125f; *(bf16x4*)(GDQ + (size_t)m * 256 + sec * 64 + sc4) = pack4(vq[0], vq[1], vq[2], vq[3]); }
          else *(bf16x4*)(GDK + (size_t)m * 256 + (sec - 4) * 64 + sc4) = pack4(val[0], val[1], val[2], val[3]);
        } else *(bf16x4*)(GDV + (size_t)m * 256 + (sec - 8) * 64 + sc4) = pack4(val[0], val[1], val[2], val[3]);
      }
    } else if (is_na) {
      const f32x4 gq = *(const f32x4*)(qg + sc4) * (0.125f * 1.4426950408889634f), gk = *(const f32x4*)(kg + sc4);
#pragma unroll
      for (int t = 0; t < 16; ++t) {
        f32x4 val = pg[t];
        const float ss = row16_sum((val[0] * val[0] + val[1] * val[1]) + (val[2] * val[2] + val[3] * val[3]));
        val = val * rsqrtf(ss * (1.f / 64.f) + 1e-6f);
        const int m = m0 + t;
        if (sec < 8) { const f32x4 o = val * gq; *(bf16x4*)(QN + (size_t)m * 512 + sec * 64 + sc4) = pack4(o[0], o[1], o[2], o[3]); }
        else { const f32x4 o = val * gk; *(bf16x4*)(KN + (size_t)m * 512 + (sec - 8) * 64 + sc4) = pack4(o[0], o[1], o[2], o[3]); }
      }
    }
    if (tid_t < 256) {
      const int t = tid_t >> 4, j = tid_t & 15;
      const int m = m0 + t;
      const float pv = bf2f((short)P[(size_t)m * PINP + B_END + 1024 + j]);
      float o;
      if (j < 8) o = -__expf(A_log[j]) * softplusf_(pv + dt_bias[j]);
      else o = sigmoidf_(pv);
      GDAB[(size_t)m * 16 + j] = o;
    }
    {
      const int vc = (tid_t & 127) * 4, tq = (tid_t >> 7) * 4;
      f32x4 pv[4];
#pragma unroll
      for (int t = 0; t < 4; ++t) pv[t] = ldbf4(P + (size_t)(m0 + tq + t) * PINP + 1024 + vc);
#pragma unroll
      for (int i = 0; i < 4; ++i) {
        const int hd = vc + i;
        bfr* dst = VT + ((size_t)(bb * 8 + (hd >> 6)) * (TTOK / 16) + (tau0 >> 4)) * 1024 + (hd & 63) * 16 + tq;
        *(bf16x4*)dst = pack4(pv[0][i], pv[1][i], pv[2][i], pv[3][i]);
      }
    }
    LBAR();
  }
  __syncthreads();
}

__device__ __forceinline__ int scan_tok(int b, int d, int s) {
  if (s < CTXL) { int t = d ? (CTXL - 1 - s) : s; return NLAT + b * CTXL + t; }
  int u = s - CTXL; int t = d ? (SEQ - 1 - u) : u; return b * SEQ + t;
}
#define CS 72
#define SLOT_BYTES (64 * CS * 2)
#define F0_STRIDE 68
#define X1_F0 (13 * SLOT_BYTES)
#define X1_ARR (X1_F0 + 64 * F0_STRIDE * 4)

#define MM_FRAGS(As, Bs, a0, a1, b00, b01, b10, b11)                                                     \
  const bf16x8 a0 = *(const bf16x8*)((As) + ((mt * 16 + fr) * CS + fq * 8) * 2);                         \
  const bf16x8 a1 = *(const bf16x8*)((As) + ((mt * 16 + fr) * CS + 32 + fq * 8) * 2);                    \
  const bf16x8 b00 = *(const bf16x8*)((Bs) + ((nt0 * 16 + fr) * CS + fq * 8) * 2);                       \
  const bf16x8 b01 = *(const bf16x8*)((Bs) + ((nt0 * 16 + fr) * CS + 32 + fq * 8) * 2);                  \
  const bf16x8 b10 = *(const bf16x8*)((Bs) + ((nt0 * 16 + 16 + fr) * CS + fq * 8) * 2);                  \
  const bf16x8 b11 = *(const bf16x8*)((Bs) + ((nt0 * 16 + 16 + fr) * CS + 32 + fq * 8) * 2);
#define MM_2TILES(acc0, acc1, a0, a1, b00, b01, b10, b11)                                                \
  acc0 = __builtin_amdgcn_mfma_f32_16x16x32_bf16(a0, b00, acc0, 0, 0, 0);                                \
  acc0 = __builtin_amdgcn_mfma_f32_16x16x32_bf16(a1, b01, acc0, 0, 0, 0);                                \
  acc1 = __builtin_amdgcn_mfma_f32_16x16x32_bf16(a0, b10, acc1, 0, 0, 0);                                \
  acc1 = __builtin_amdgcn_mfma_f32_16x16x32_bf16(a1, b11, acc1, 0, 0, 0);
__device__ __forceinline__ void wr_T(char* slot, int mt, int nt, int fr, int fq, f32x4 v) {
  *(bf16x4*)(slot + ((nt * 16 + fr) * CS + mt * 16 + 4 * fq) * 2) = pack4(v[0], v[1], v[2], v[3]);
}

struct ChunkIn { float lw[8], f0[8], f1[8], f2[8], f3[8], xv[8], be[8]; };
template <bool GDN>
__device__ __forceinline__ void chunk_load(PP pp, int t, ChunkIn& ci) {
  const int tid = tid_opaque(), c = tid & 63, tg = wave_id(tid);
  const int chain = t / NCHUNK, n = t - chain * NCHUNK;
  const int d = chain & 1, h = (chain >> 1) & 3, b = (chain >> 3) & 1;
  const char* S = p.ws + OFF_S;
#pragma unroll
  for (int u = 0; u < 8; ++u) {
    const int m = scan_tok(b, d, n * 64 + tg * 8 + u);
    const size_t o = (size_t)m * 256 + h * 64 + c;
    if (!GDN) {
      ci.lw[u] = ((const float*)(S + S_RWW))[(size_t)d * NTOK * 256 + o];
      ci.f0[u] = ldbf1((const bfr*)(S + S_RWKK), o);
      ci.f1[u] = ldbf1((const bfr*)(S + S_RWB), (size_t)d * NTOK * 256 + o);
      ci.f2[u] = ldbf1((const bfr*)(S + S_RWKD), (size_t)d * NTOK * 256 + o);
      ci.f3[u] = ldbf1((const bfr*)(S + S_RWR), o);
      ci.xv[u] = ldbf1((const bfr*)(S + S_RWV), o);
      ci.be[u] = 1.f;
    } else {
      ci.lw[u] = ((const float*)(S + S_GDAB))[(size_t)m * 16 + d * 4 + h];
      ci.be[u] = ((const float*)(S + S_GDAB))[(size_t)m * 16 + 8 + d * 4 + h];
      ci.f0[u] = ldbf1((const bfr*)(S + S_GDK), o);
      ci.f3[u] = ldbf1((const bfr*)(S + S_GDQ), o);
      ci.xv[u] = ldbf1((const bfr*)(S + S_GDV), o);
      ci.f1[u] = 0.f; ci.f2[u] = 0.f;
    }
  }
}
template <bool GDN>
__device__ __forceinline__ void chunk_prep_task(PP pp, int t, int t_next, bool has_next, const ChunkIn& ci, ChunkIn& nx, char* smem) {
  const int chain = t / NCHUNK, n = t - chain * NCHUNK;
  const int d = chain & 1, h = (chain >> 1) & 3, b = (chain >> 3) & 1;
  (void)b; (void)d; (void)h;
  const int tid = tid_opaque(), lane = tid & 63, wv = wave_id(tid);
  const int fr = lane & 15, fq = lane >> 4, mt = wv >> 1, nt0 = (wv & 1) * 2;
  char* S = p.ws + OFF_S;
  char* CH = p.ws + OFF_CH;
  const size_t cc = (size_t)chain * NCHUNK + n;
  char* const p0 = smem;
  char* const p1 = smem + 1 * SLOT_BYTES;
  char* const p2 = smem + 2 * SLOT_BYTES;
  char* const p3 = smem + 3 * SLOT_BYTES;
  char* const p4 = smem + 4 * SLOT_BYTES;
  char* const p5 = smem + 5 * SLOT_BYTES;
  char* const p6 = smem + 6 * SLOT_BYTES;
  char* const p7 = smem + 7 * SLOT_BYTES;
  char* const p8 = smem + 8 * SLOT_BYTES;
  char* const p9 = smem + 9 * SLOT_BYTES;
  char* const p10 = smem + 10 * SLOT_BYTES;
  char* const p11 = smem + 11 * SLOT_BYTES;
  char* const p12 = smem + 12 * SLOT_BYTES;
  float* const F0 = (float*)(smem + X1_F0);
  float* const Lv = (float*)(smem + X1_ARR);
  float* const Lm1v = Lv + 64;
  float* const betav = Lv + 128;
  float* const eLv = Lv + 192;
  float* const gC = Lv + 256;
  float* const gsum = Lv + 320;
  char* const sKt = p0;
  char* const sBh = GDN ? p0 : p1;
  char* const sKh = GDN ? p0 : p2;

  {
    const int c = lane, tg = wv;
    const float* lw = ci.lw; const float* f0 = ci.f0; const float* f1 = ci.f1; const float* f2 = ci.f2; const float* f3 = ci.f3; const float* xv = ci.xv; const float* be = ci.be;
    float cum[8];
    cum[0] = lw[0];
#pragma unroll
    for (int u = 1; u < 8; ++u) cum[u] = cum[u - 1] + lw[u];
    gsum[tg * 64 + c] = cum[7];
    LBAR();
    float off = 0.f, LC = 0.f;
#pragma unroll
    for (int g2 = 0; g2 < 8; ++g2) { const float gs = gsum[g2 * 64 + c]; LC += gs; off += (g2 < tg) ? gs : 0.f; }
    bf16x8 vKtT, vBbT, vKbT, vXT;
#pragma unroll
    for (int u = 0; u < 8; ++u) {
      const int t = tg * 8 + u;
      const float L = off + cum[u], Lm1 = L - lw[u];
      if (!GDN) {
        const float eLm1 = __expf(Lm1), enL = __expf(-L), eL = __expf(L), eCL = __expf(LC - L);
        const float kt = f0[u] * eLm1;
        *(bfr*)(p0 + (t * CS + c) * 2) = f2bf(kt);
        *(bfr*)(p1 + (t * CS + c) * 2) = f2bf(f1[u] * enL);
        *(bfr*)(p2 + (t * CS + c) * 2) = f2bf(f2[u] * enL);
        *(bfr*)(p3 + (t * CS + c) * 2) = f2bf(f3[u] * eL);
        vKtT[u] = (short)f2bf(kt);
        vBbT[u] = (short)f2bf(f1[u] * eCL);
        vKbT[u] = (short)f2bf(f2[u] * eCL);
        vXT[u] = (short)f2bf(xv[u]);
      } else {
        *(bfr*)(p0 + (t * CS + c) * 2) = f2bf(f0[u]);
        *(bfr*)(p3 + (t * CS + c) * 2) = f2bf(f3[u]);
        vKtT[u] = (short)f2bf(f0[u] * __expf(Lm1));
        vBbT[u] = (short)f2bf(be[u] * f0[u] * __expf(LC - Lm1));
        vKbT[u] = (short)f2bf(f0[u] * __expf(LC - L));
        vXT[u] = (short)f2bf(be[u] * xv[u]);
        if (c == 0) { Lv[t] = L; Lm1v[t] = Lm1; betav[t] = be[u]; eLv[t] = __expf(L); }
      }
    }
    *(bf16x8*)(p4 + (c * CS + tg * 8) * 2) = vKtT;
    *(bf16x8*)(p5 + (c * CS + tg * 8) * 2) = vBbT;
    *(bf16x8*)(p6 + (c * CS + tg * 8) * 2) = vKbT;
    *(bf16x8*)(p7 + (c * CS + tg * 8) * 2) = vXT;
    if (tg == 0) gC[c] = __expf(LC);
    if (!GDN && tid < 64) { Lv[tid] = 0.f; Lm1v[tid] = 0.f; betav[tid] = 1.f; eLv[tid] = 1.f; }
  }
  LBAR();
  if (has_next) chunk_load<GDN>(pp, t_next, nx);
  {
    {
      MM_FRAGS(sKt, sBh, a0, a1, b00, b01, b10, b11)
      f32x4 c0 = {0.f, 0.f, 0.f, 0.f}, c1 = c0;
      MM_2TILES(c0, c1, a0, a1, b00, b01, b10, b11)
#pragma unroll
      for (int q = 0; q < 2; ++q) {
        const int sI = (nt0 + q) * 16 + fr;
        const f32x4 cv = q ? c1 : c0;
        f32x4 o;
#pragma unroll
        for (int r = 0; r < 4; ++r) {
          const int tI = mt * 16 + 4 * fq + r;
          float v = cv[r];
          if (GDN) v *= betav[sI] * __expf(fminf(Lm1v[tI] - Lm1v[sI], 0.f));
          o[r] = (sI < tI) ? v : 0.f;
        }
        *(f32x4*)(F0 + sI * F0_STRIDE + mt * 16 + 4 * fq) = o;
        wr_T(p11, mt, nt0 + q, fr, fq, o);
      }
    }
    {
      MM_FRAGS(sKt, sKh, a0, a1, b00, b01, b10, b11)
      f32x4 c0 = {0.f, 0.f, 0.f, 0.f}, c1 = c0;
      MM_2TILES(c0, c1, a0, a1, b00, b01, b10, b11)
#pragma unroll
      for (int q = 0; q < 2; ++q) {
        const int sI = (nt0 + q) * 16 + fr;
        const f32x4 cv = q ? c1 : c0;
        f32x4 o;
#pragma unroll
        for (int r = 0; r < 4; ++r) {
          const int tI = mt * 16 + 4 * fq + r;
          float v = cv[r];
          if (GDN) v *= __expf(fminf(Lm1v[tI] - Lv[sI], 0.f));
          o[r] = (sI < tI) ? v : 0.f;
        }
        wr_T(p9, mt, nt0 + q, fr, fq, o);
      }
    }
    {
      MM_FRAGS(sBh, p3, a0, a1, b00, b01, b10, b11)
      f32x4 c0 = {0.f, 0.f, 0.f, 0.f}, c1 = c0;
      MM_2TILES(c0, c1, a0, a1, b00, b01, b10, b11)
#pragma unroll
      for (int q = 0; q < 2; ++q) {
        const int tI = (nt0 + q) * 16 + fr;
        const f32x4 cv = q ? c1 : c0;
        f32x4 o;
#pragma unroll
        for (int r = 0; r < 4; ++r) {
          const int sI = mt * 16 + 4 * fq + r;
          float v = cv[r];
          if (GDN) v *= betav[sI] * __expf(fminf(Lv[tI] - Lm1v[sI], 0.f));
          o[r] = (sI <= tI) ? v : 0.f;
        }
        wr_T(p10, mt, nt0 + q, fr, fq, o);
      }
    }
  }
  LBAR();
  if (wv < 2) {
    const int base = wv * 32, other = 32 - base, c = lane & 31;
    float tr[32];
#pragma unroll
    for (int j = 0; j < 32; ++j) tr[j] = 0.f;
#pragma unroll
    for (int ip = 15; ip >= 0; --ip) {
      const int i = 2 * ip + 1, i2 = 2 * ip;
      float a0 = (c == i) ? 1.f : 0.f, a1 = 0.f, b0 = (c == i2) ? 1.f : 0.f, b1 = 0.f;
      const float aii = F0[(base + i2) * F0_STRIDE + base + i];
#pragma unroll
      for (int jb = ((i + 1) & ~3); jb < 32; jb += 4) {
        const f32x4 a4 = *(const f32x4*)(F0 + (base + i) * F0_STRIDE + base + jb);
        const f32x4 b4 = *(const f32x4*)(F0 + (base + i2) * F0_STRIDE + base + jb);
        a0 -= a4[0] * tr[jb]; a1 -= a4[1] * tr[jb + 1]; a0 -= a4[2] * tr[jb + 2]; a1 -= a4[3] * tr[jb + 3];
        b0 -= b4[0] * tr[jb]; b1 -= b4[1] * tr[jb + 1]; b0 -= b4[2] * tr[jb + 2]; b1 -= b4[3] * tr[jb + 3];
      }
      const float ti = a0 + a1;
      const float ti2 = (b0 + b1) - aii * ti;
      tr[i] = ti; tr[i2] = ti2;
      if (lane < 32) {
        *(bfr*)(p8 + ((base + i) * CS + base + c) * 2) = f2bf(ti);
        *(bfr*)(p8 + ((base + i) * CS + other + c) * 2) = (bfr)0;
        *(bfr*)(p8 + ((base + i2) * CS + base + c) * 2) = f2bf(ti2);
        *(bfr*)(p8 + ((base + i2) * CS + other + c) * 2) = (bfr)0;
      }
    }
    if (lane < 32) {
#pragma unroll
      for (int q = 0; q < 4; ++q) {
        bf16x8 o, z;
#pragma unroll
        for (int j = 0; j < 8; ++j) { o[j] = (short)f2bf(tr[8 * q + j]); z[j] = 0; }
        *(bf16x8*)(p12 + ((base + c) * CS + base + 8 * q) * 2) = o;
        *(bf16x8*)(p12 + ((base + c) * CS + other + 8 * q) * 2) = z;
      }
    }
  }
  LBAR();
  {
    MM_FRAGS(p11, p12, a0, a1, b00, b01, b10, b11)
    f32x4 c0 = {0.f, 0.f, 0.f, 0.f}, c1 = c0;
    MM_2TILES(c0, c1, a0, a1, b00, b01, b10, b11)
    wr_T(p1, mt, nt0, fr, fq, c0);
    wr_T(p1, mt, nt0 + 1, fr, fq, c1);
  }
  LBAR();
  if (mt < 2 && nt0 == 2) {
    MM_FRAGS(p8, p1, a0, a1, b00, b01, b10, b11)
    f32x4 c0 = {0.f, 0.f, 0.f, 0.f}, c1 = c0;
    MM_2TILES(c0, c1, a0, a1, b00, b01, b10, b11)
#pragma unroll
    for (int r = 0; r < 4; ++r) {
      *(bfr*)(p8 + ((mt * 16 + 4 * fq + r) * CS + (nt0) * 16 + fr) * 2) = f2bf(-c0[r]);
      *(bfr*)(p8 + ((mt * 16 + 4 * fq + r) * CS + (nt0 + 1) * 16 + fr) * 2) = f2bf(-c1[r]);
    }
  }
  LBAR();
  {
    {
      MM_FRAGS(p8, p5, a0, a1, b00, b01, b10, b11)
      f32x4 c0 = {0.f, 0.f, 0.f, 0.f}, c1 = c0;
      MM_2TILES(c0, c1, a0, a1, b00, b01, b10, b11)
      wr_T(p11, mt, nt0, fr, fq, -c0);
      wr_T(p11, mt, nt0 + 1, fr, fq, -c1);
    }
    {
      MM_FRAGS(p8, p10, a0, a1, b00, b01, b10, b11)
      f32x4 c0 = {0.f, 0.f, 0.f, 0.f}, c1 = c0;
      MM_2TILES(c0, c1, a0, a1, b00, b01, b10, b11)
      wr_T(p12, mt, nt0, fr, fq, -c0);
      wr_T(p12, mt, nt0 + 1, fr, fq, -c1);
    }
  }
  LBAR();
  {
    {
      MM_FRAGS(p4, p11, a0, a1, b00, b01, b10, b11)
      f32x4 c0 = {0.f, 0.f, 0.f, 0.f}, c1 = c0;
      MM_2TILES(c0, c1, a0, a1, b00, b01, b10, b11)
#pragma unroll
      for (int q = 0; q < 2; ++q) {
        const int cp = (nt0 + q) * 16 + fr;
        f32x4 cv = q ? c1 : c0;
#pragma unroll
        for (int r = 0; r < 4; ++r) { const int cI = mt * 16 + 4 * fq + r; if (cI == cp) cv[r] += gC[cI]; }
        wr_T(p10, mt, nt0 + q, fr, fq, cv);
      }
    }
    {
      MM_FRAGS(p9, p11, a0, a1, b00, b01, b10, b11)
      f32x4 c0 = {0.f, 0.f, 0.f, 0.f}, c1 = c0;
      MM_2TILES(c0, c1, a0, a1, b00, b01, b10, b11)
#pragma unroll
      for (int q = 0; q < 2; ++q) {
        const int cp = (nt0 + q) * 16 + fr;
        f32x4 cv = q ? c1 : c0;
        const bf16x4 kb = *(const bf16x4*)(p6 + (cp * CS + mt * 16 + 4 * fq) * 2);
#pragma unroll
        for (int r = 0; r < 4; ++r) cv[r] += __uint_as_float(((unsigned)(unsigned short)kb[r]) << 16);
        wr_T(p8, mt, nt0 + q, fr, fq, cv);
      }
    }
    {
      MM_FRAGS(p4, p12, a0, a1, b00, b01, b10, b11)
      f32x4 c0 = {0.f, 0.f, 0.f, 0.f}, c1 = c0;
      MM_2TILES(c0, c1, a0, a1, b00, b01, b10, b11)
#pragma unroll
      for (int q = 0; q < 2; ++q) {
        const int tI = (nt0 + q) * 16 + fr;
        f32x4 cv = q ? c1 : c0;
        const bf16x4 rt = *(const bf16x4*)(p3 + (tI * CS + mt * 16 + 4 * fq) * 2);
        const float el = eLv[tI];
#pragma unroll
        for (int r = 0; r < 4; ++r) cv[r] += __uint_as_float(((unsigned)(unsigned short)rt[r]) << 16) * el;
        wr_T(p1, mt, nt0 + q, fr, fq, cv);
      }
    }
    {
      f32x4 c0 = {0.f, 0.f, 0.f, 0.f}, c1 = c0;
      {
        MM_FRAGS(sKh, p3, a0, a1, b00, b01, b10, b11)
        MM_2TILES(c0, c1, a0, a1, b00, b01, b10, b11)
      }
#pragma unroll
      for (int q = 0; q < 2; ++q) {
        const int tI = (nt0 + q) * 16 + fr;
#pragma unroll
        for (int r = 0; r < 4; ++r) {
          const int sI = mt * 16 + 4 * fq + r;
          float v = q ? c1[r] : c0[r];
          if (GDN) v *= __expf(fminf(Lv[tI] - Lv[sI], 0.f));
          v = (sI <= tI) ? v : 0.f;
          if (q) c1[r] = v; else c0[r] = v;
        }
      }
      {
        MM_FRAGS(p9, p12, a0, a1, b00, b01, b10, b11)
        MM_2TILES(c0, c1, a0, a1, b00, b01, b10, b11)
      }
      wr_T(p5, mt, nt0, fr, fq, c0);
      wr_T(p5, mt, nt0 + 1, fr, fq, c1);
    }
  }
  LBAR();
  {
    {
      MM_FRAGS(p8, p7, a0, a1, b00, b01, b10, b11)
      f32x4 c0 = {0.f, 0.f, 0.f, 0.f}, c1 = c0;
      MM_2TILES(c0, c1, a0, a1, b00, b01, b10, b11)
      bfr* QT = (bfr*)(CH + cc * CH_REC + CH_QT);
      *(bf16x4*)(QT + ((mt * 4 + nt0) * 64 + lane) * 4) = pack4(c0[0], c0[1], c0[2], c0[3]);
      *(bf16x4*)(QT + ((mt * 4 + nt0 + 1) * 64 + lane) * 4) = pack4(c1[0], c1[1], c1[2], c1[3]);
    }
    {
      MM_FRAGS(p7, p5, a0, a1, b00, b01, b10, b11)
      f32x4 c0 = {0.f, 0.f, 0.f, 0.f}, c1 = c0;
      MM_2TILES(c0, c1, a0, a1, b00, b01, b10, b11)
      bfr* YX = (bfr*)(CH + cc * CH_REC + CH_YX);
      *(bf16x4*)(YX + ((mt * 4 + nt0) * 64 + lane) * 4) = pack4(c0[0], c0[1], c0[2], c0[3]);
      *(bf16x4*)(YX + ((mt * 4 + nt0 + 1) * 64 + lane) * 4) = pack4(c1[0], c1[1], c1[2], c1[3]);
    }
    {
      const int fm = wv >> 1, fa = wv & 1;
      const int row = fm * 16 + fr;
      {
        const bf16x4 lo = *(const bf16x4*)(p10 + (row * CS + 32 * fa + 4 * fq) * 2);
        const bf16x4 hi = *(const bf16x4*)(p10 + (row * CS + 32 * fa + 16 + 4 * fq) * 2);
        bf16x8 f; f[0] = lo[0]; f[1] = lo[1]; f[2] = lo[2]; f[3] = lo[3]; f[4] = hi[0]; f[5] = hi[1]; f[6] = hi[2]; f[7] = hi[3];
        *(bf16x8*)(CH + cc * CH_REC + CH_PT + (size_t)((fm * 2 + fa) * 64 + lane) * 16) = f;
      }
      {
        const bf16x4 lo = *(const bf16x4*)(p1 + (row * CS + 32 * fa + 4 * fq) * 2);
        const bf16x4 hi = *(const bf16x4*)(p1 + (row * CS + 32 * fa + 16 + 4 * fq) * 2);
        bf16x8 f; f[0] = lo[0]; f[1] = lo[1]; f[2] = lo[2]; f[3] = lo[3]; f[4] = hi[0]; f[5] = hi[1]; f[6] = hi[2]; f[7] = hi[3];
        *(bf16x8*)(CH + cc * CH_REC + CH_RYT + (size_t)((fm * 2 + fa) * 64 + lane) * 16) = f;
      }
    }
  }
  LBAR();
}

template <bool GDN>
__device__ __forceinline__ void chunk_prep_loop(PP pp, int t0, int tend, int nb, char* smem) {
  ChunkIn cur, nxt;
  if (t0 < tend) chunk_load<GDN>(pp, t0, cur);
  for (int t = t0; t < tend; t += nb) {
    const bool has_next = (t + nb) < tend;
    chunk_prep_task<GDN>(pp, t, t + nb, has_next, cur, nxt, smem);
    cur = nxt;
  }
}
__device__ __forceinline__ void phase_chunk_prep(PP pp, int bid, int nb, char* smem) {
  __syncthreads();
  const int half = (NCHAIN / 2) * NCHUNK;
  chunk_prep_loop<false>(pp, bid, half, nb, smem);
  const int k0 = (half - bid + nb - 1) / nb;
  chunk_prep_loop<true>(pp, bid + k0 * nb, NCHAIN * NCHUNK, nb, smem);
  __syncthreads();
}

#define X2_BUF 32768
#define X2_BAR() do { asm volatile("s_waitcnt lgkmcnt(0)" ::: "memory"); __builtin_amdgcn_s_barrier(); asm volatile("" ::: "memory"); } while (0)
__device__ __forceinline__ void chunk_seq_chain(PP pp, int chain, char* smem) {
  __syncthreads();
  const int tid = tid_opaque(), lane = tid & 63, wv = wave_id(tid);
  const int d = chain & 1, h = (chain >> 1) & 3, b = (chain >> 3) & 1, ty = chain >> 4;
  const char* CH = p.ws + OFF_CH;
  bfr* Y = (bfr*)(p.ws + OFF_S + (ty ? S_YGD : S_YRW)) + (size_t)d * NTOK * 256;
  const size_t c0 = (size_t)chain * NCHUNK;
  if (wv >= 4) {
    const int lw = wv - 4;
    const char* src0 = CH + c0 * CH_REC + (size_t)lane * 16;
#define X2_DMA(n) { const char* s_ = src0 + (size_t)(n) * CH_REC; LAS unsigned char* d_ = (LAS unsigned char*)smem + ((n) & 3) * X2_BUF;       \
      _Pragma("unroll") for (int i = 0; i < 8; ++i) {                                                                                       \
        const int piece = i * 4 + lw;                                                                                                       \
        __builtin_amdgcn_global_load_lds((const unsigned*)(s_ + piece * 1024), (LAS unsigned*)(d_ + piece * 1024), 16, 0, 0); } }
    X2_DMA(0) X2_DMA(1) X2_DMA(2)
    asm volatile("s_waitcnt vmcnt(16)" ::: "memory");
    X2_BAR();
    for (int n = 0; n < NCHUNK; ++n) {
      if (n + 3 < NCHUNK) { X2_DMA(n + 3) asm volatile("s_waitcnt vmcnt(16)" ::: "memory"); }
      else if (n + 2 < NCHUNK) asm volatile("s_waitcnt vmcnt(8)" ::: "memory");
      else asm volatile("s_waitcnt vmcnt(0)" ::: "memory");
      X2_BAR();
    }
#undef X2_DMA
  } else {
    const int vt = wv, fr = lane & 15, fq = lane >> 4;
    f32x4 Sacc[4];
#pragma unroll
    for (int i = 0; i < 4; ++i) Sacc[i] = (f32x4){0.f, 0.f, 0.f, 0.f};
    X2_BAR();
    for (int n = 0; n < NCHUNK; ++n) {
      const char* buf = smem + (n & 3) * X2_BUF;
      bf16x8 sB0, sB1;
#pragma unroll
      for (int j = 0; j < 4; ++j) {
        sB0[j] = (short)f2bf(Sacc[0][j]); sB0[4 + j] = (short)f2bf(Sacc[1][j]);
        sB1[j] = (short)f2bf(Sacc[2][j]); sB1[4 + j] = (short)f2bf(Sacc[3][j]);
      }
#pragma unroll
      for (int m = 0; m < 4; ++m) {
        const bf16x8 pa0 = *(const bf16x8*)(buf + ((m * 2 + 0) * 64 + lane) * 16);
        const bf16x8 pa1 = *(const bf16x8*)(buf + ((m * 2 + 1) * 64 + lane) * 16);
        const bf16x8 ra0 = *(const bf16x8*)(buf + 8192 + ((m * 2 + 0) * 64 + lane) * 16);
        const bf16x8 ra1 = *(const bf16x8*)(buf + 8192 + ((m * 2 + 1) * 64 + lane) * 16);
        const bf16x4 qb = *(const bf16x4*)(buf + 16384 + ((m * 4 + vt) * 64 + lane) * 8);
        const bf16x4 yb = *(const bf16x4*)(buf + 24576 + ((vt * 4 + m) * 64 + lane) * 8);
        f32x4 y = {bf2f(yb[0]), bf2f(yb[1]), bf2f(yb[2]), bf2f(yb[3])};
        y = __builtin_amdgcn_mfma_f32_16x16x32_bf16(sB0, ra0, y, 0, 0, 0);
        y = __builtin_amdgcn_mfma_f32_16x16x32_bf16(sB1, ra1, y, 0, 0, 0);
        f32x4 sn = {bf2f(qb[0]), bf2f(qb[1]), bf2f(qb[2]), bf2f(qb[3])};
        sn = __builtin_amdgcn_mfma_f32_16x16x32_bf16(pa0, sB0, sn, 0, 0, 0);
        sn = __builtin_amdgcn_mfma_f32_16x16x32_bf16(pa1, sB1, sn, 0, 0, 0);
        Sacc[m] = sn;
        {
          const int mm = scan_tok(b, d, n * 64 + m * 16 + fr);
          *(bf16x4*)(Y + (size_t)mm * 256 + h * 64 + vt * 16 + 4 * fq) = pack4(y[0], y[1], y[2], y[3]);
        }
      }
      X2_BAR();
    }
  }
}

struct NaPair { int mk0, mk1, tau0, tau1, kr0, kr1, ct0, ct1; };
struct NaFrag { bf16x8 k00, k01, k10, k11; bf16x4 v0[4], v1[4]; };

__device__ __forceinline__ void na_load(NaFrag& f, const bfr* KN, const bfr* VT, size_t vt_base, int h, int fr, int fq, const NaPair& pr) {
  const bfr* k0 = KN + (size_t)(pr.mk0 + fr) * 512 + h * 64 + fq * 8;
  const bfr* k1 = KN + (size_t)(pr.mk1 + fr) * 512 + h * 64 + fq * 8;
  f.k00 = *(const bf16x8*)(k0); f.k01 = *(const bf16x8*)(k0 + 32);
  f.k10 = *(const bf16x8*)(k1); f.k11 = *(const bf16x8*)(k1 + 32);
#pragma unroll
  for (int dt = 0; dt < 4; ++dt) {
    const int vo = (dt * 16 + fr) * 16 + fq * 4;
    f.v0[dt] = *(const bf16x4*)(VT + vt_base + (size_t)(pr.tau0 >> 4) * 1024 + vo);
    f.v1[dt] = *(const bf16x4*)(VT + vt_base + (size_t)(pr.tau1 >> 4) * 1024 + vo);
  }
}

__device__ __forceinline__ void na_compute(const NaFrag& f, const bf16x8 qf0, const bf16x8 qf1, bool local, bool vr0, bool vr1,
                                           int dr0, int dr1, int ct0, int ct1, int qc, int fq, const float* bias_h, f32x4 (&O)[4], float& lsum) {
  f32x4 z = {0.f, 0.f, 0.f, 0.f};
  f32x4 st0 = __builtin_amdgcn_mfma_f32_16x16x32_bf16(f.k00, qf0, z, 0, 0, 0);
  st0 = __builtin_amdgcn_mfma_f32_16x16x32_bf16(f.k01, qf1, st0, 0, 0, 0);
  f32x4 st1 = __builtin_amdgcn_mfma_f32_16x16x32_bf16(f.k10, qf0, z, 0, 0, 0);
  st1 = __builtin_amdgcn_mfma_f32_16x16x32_bf16(f.k11, qf1, st1, 0, 0, 0);
  bf16x8 pf;
  if (local) {
    const int cs = min(max(qc - 8, 0), 48);
#pragma unroll
    for (int r = 0; r < 4; ++r) {
      const int kc0 = ct0 * 16 + fq * 4 + r, kc1 = ct1 * 16 + fq * 4 + r;
      float p0 = 0.f, p1 = 0.f;
      if (vr0 && (unsigned)(kc0 - cs) < 16u) p0 = __builtin_amdgcn_exp2f(st0[r] + bias_h[dr0 * 31 + (kc0 - qc + 15)]);
      if (vr1 && (unsigned)(kc1 - cs) < 16u) p1 = __builtin_amdgcn_exp2f(st1[r] + bias_h[dr1 * 31 + (kc1 - qc + 15)]);
      lsum += p0 + p1;
      pf[r] = (short)f2bf(p0);
      pf[4 + r] = (short)f2bf(p1);
    }
  } else {
#pragma unroll
    for (int r = 0; r < 4; ++r) {
      const float p0 = __builtin_amdgcn_exp2f(st0[r]), p1 = __builtin_amdgcn_exp2f(st1[r]);
      lsum += p0 + p1;
      pf[r] = (short)f2bf(p0);
      pf[4 + r] = (short)f2bf(p1);
    }
  }
#pragma unroll
  for (int dt = 0; dt < 4; ++dt) {
    bf16x8 vf;
    vf[0] = f.v0[dt][0]; vf[1] = f.v0[dt][1]; vf[2] = f.v0[dt][2]; vf[3] = f.v0[dt][3];
    vf[4] = f.v1[dt][0]; vf[5] = f.v1[dt][1]; vf[6] = f.v1[dt][2]; vf[7] = f.v1[dt][3];
    O[dt] = __builtin_amdgcn_mfma_f32_16x16x32_bf16(vf, pf, O[dt], 0, 0, 0);
  }
}

__device__ __forceinline__ void na_block_task(PP pp, int task, const float* bias_lds) {
  const int tid = tid_opaque(), lane = tid & 63, wv = wave_id(tid);
  const int fr = lane & 15, fq = lane >> 4;
  char* S = p.ws + OFF_S;
  const bfr* QN = (const bfr*)(S + S_QN);
  const bfr* KN = (const bfr*)(S + S_KN);
  const bfr* VT = (const bfr*)(S + S_VT);
  bfr* CC = (bfr*)(p.ws + OFF_CC);
  const bool latent = task < 1024;
  int b, h, mqa, mqb, qra = 0, qrb = 0, cgp = 0;
  if (latent) {
    h = task & 7; const int quad = (task >> 3) & 63; b = task >> 9;
    qra = quad * 4 + (wv >> 2) * 2; qrb = qra + 1; cgp = wv & 3;
    mqa = b * SEQ + qra * 64 + cgp * 16; mqb = mqa + 64;
  } else {
    const int u = task - 1024;
    h = u & 7; b = u >> 3;
    mqa = NLAT + b * CTXL + (wv * 2) * 16; mqb = mqa + 16;
  }
  const bf16x8 qa0 = *(const bf16x8*)(QN + (size_t)(mqa + fr) * 512 + h * 64 + fq * 8);
  const bf16x8 qa1 = *(const bf16x8*)(QN + (size_t)(mqa + fr) * 512 + h * 64 + 32 + fq * 8);
  const bf16x8 qb0 = *(const bf16x8*)(QN + (size_t)(mqb + fr) * 512 + h * 64 + fq * 8);
  const bf16x8 qb1 = *(const bf16x8*)(QN + (size_t)(mqb + fr) * 512 + h * 64 + 32 + fq * 8);
  f32x4 Oa[4], Ob[4];
#pragma unroll
  for (int dt = 0; dt < 4; ++dt) { Oa[dt] = (f32x4){0.f, 0.f, 0.f, 0.f}; Ob[dt] = Oa[dt]; }
  float lsa = 0.f, lsb = 0.f;
  const size_t vt_base = (size_t)(b * 8 + h) * 64 * TTOK;
  const int rsa = min(max(qra - 4, 0), SEQ / 64 - 8), rsb = min(max(qrb - 4, 0), SEQ / 64 - 8);
  const int nrows = latent ? (rsb - rsa + 8) : 0;
  const int ct_first = (cgp <= 1) ? 0 : cgp - 1;
  const int nct = (cgp == 0 || cgp == 3) ? 2 : 3;
  const int ntile = nrows * nct;
  const int nlp = (ntile + 1) >> 1;
  const int npair = nlp + 8;
  const int qc = cgp * 16 + fr;
  auto mkpair = [&](int pi) {
    NaPair pr;
    if (pi < nlp) {
      const int i0 = 2 * pi, i1 = min(2 * pi + 1, ntile - 1);
      pr.kr0 = rsa + i0 / nct; pr.ct0 = ct_first + i0 % nct;
      pr.kr1 = rsa + i1 / nct; pr.ct1 = ct_first + i1 % nct;
      if (2 * pi + 1 >= ntile) pr.kr1 = -100;
      const int r1 = rsa + i1 / nct;
      pr.tau0 = pr.kr0 * 64 + pr.ct0 * 16; pr.tau1 = r1 * 64 + pr.ct1 * 16;
      pr.mk0 = b * SEQ + pr.tau0; pr.mk1 = b * SEQ + pr.tau1;
    } else {
      const int c = pi - nlp;
      pr.kr0 = pr.kr1 = pr.ct0 = pr.ct1 = 0;
      pr.tau0 = SEQ + c * 32; pr.tau1 = SEQ + c * 32 + 16;
      pr.mk0 = NLAT + b * CTXL + c * 32; pr.mk1 = pr.mk0 + 16;
    }
    return pr;
  };
  NaFrag fa, fb;
  NaPair pa = mkpair(0), pb;
  na_load(fa, KN, VT, vt_base, h, fr, fq, pa);
  const float* bias_h = bias_lds + h * 465;
#define NA_DO(F, PR, PI)                                                                                          \
  {                                                                                                               \
    const bool loc_ = (PI) < nlp;                                                                                 \
    na_compute(F, qa0, qa1, loc_, (unsigned)(PR.kr0 - rsa) < 8u, (unsigned)(PR.kr1 - rsa) < 8u,                   \
               PR.kr0 - qra + 7, PR.kr1 - qra + 7, PR.ct0, PR.ct1, qc, fq, bias_h, Oa, lsa);                      \
    na_compute(F, qb0, qb1, loc_, (unsigned)(PR.kr0 - rsb) < 8u, (unsigned)(PR.kr1 - rsb) < 8u,                   \
               PR.kr0 - qrb + 7, PR.kr1 - qrb + 7, PR.ct0, PR.ct1, qc, fq, bias_h, Ob, lsb);                      \
  }
  for (int pi = 0; pi < npair; pi += 2) {
    if (pi + 1 < npair) { pb = mkpair(pi + 1); na_load(fb, KN, VT, vt_base, h, fr, fq, pb); }
    NA_DO(fa, pa, pi)
    if (pi + 1 < npair) {
      if (pi + 2 < npair) { pa = mkpair(pi + 2); na_load(fa, KN, VT, vt_base, h, fr, fq, pa); }
      NA_DO(fb, pb, pi + 1)
    }
  }
#undef NA_DO
  lsa += shfl_xor_l(lsa, 16, lane); lsa += shfl_xor_l(lsa, 32, lane);
  lsb += shfl_xor_l(lsb, 16, lane); lsb += shfl_xor_l(lsb, 32, lane);
  const float ia = 1.f / lsa, ib = 1.f / lsb;
#pragma unroll
  for (int dt = 0; dt < 4; ++dt) {
    *(bf16x4*)(CC + (size_t)(mqa + fr) * 1024 + h * 64 + dt * 16 + fq * 4) = pack4(Oa[dt][0] * ia, Oa[dt][1] * ia, Oa[dt][2] * ia, Oa[dt][3] * ia);
    *(bf16x4*)(CC + (size_t)(mqb + fr) * 1024 + h * 64 + dt * 16 + fq * 4) = pack4(Ob[dt][0] * ib, Ob[dt][1] * ib, Ob[dt][2] * ib, Ob[dt][3] * ib);
  }
}

__device__ __forceinline__ void phase_mix(PP pp, int l, int bid, int nb, char* smem) {
  const int tid = tid_opaque();
  const int nscan_blocks = (nb > 32) ? 32 : nb;
  const int first_attn_block = (nb > 32) ? 32 : 0;
  if (bid < nscan_blocks) {
    for (int c = bid; c < NCHAIN; c += nscan_blocks) chunk_seq_chain(pp, c, smem);
  }
  if (bid >= first_attn_block) {
    float* bias = (float*)smem;
    __syncthreads();
    for (int i = tid; i < 8 * 465; i += NTHR) bias[i] = p.na_rpb[(size_t)l * 8 * 465 + i] * 1.4426950408889634f;
    __syncthreads();
    const int ntask = (l == 0) ? 1024 + 16 : 1024;
    const int nab = nb - first_attn_block;
    for (int t = bid - first_attn_block; t < ntask; t += nab) na_block_task(pp, t, bias);
    __syncthreads();
    phase_convert(pp, l, 1, bid - first_attn_block, nab, smem);
    if (l == 0) phase_convert(pp, 1, 0, bid - first_attn_block, nab, smem);
  }
}

__device__ __forceinline__ void phase_post(PP pp, int l, int bid, int nb) {
  const int tid = tid_opaque(), lane = tid & 63, wv = wave_id(tid);
  char* S = p.ws + OFF_S;
  const bfr* YRW = (const bfr*)(S + S_YRW);
  const bfr* YGD = (const bfr*)(S + S_YGD);
  const bfr* RWV = (const bfr*)(S + S_RWV);
  const bfr* RWG = (const bfr*)(S + S_RWG);
  const float* BON = (const float*)(S + S_BON);
  const bfr* P = (const bfr*)(p.ws + OFF_P);
  bfr* CC = (bfr*)(p.ws + OFF_CC);
  const float* ln_w = p.rw_ln_w + (size_t)l * 256;
  const float* ln_b = p.rw_ln_b + (size_t)l * 256;
  const float* ng = p.gd_norm_g + (size_t)l * 64;
  const int ntok = (l == 0) ? NTOK : NLAT;
  const int cb = lane * 4, hh = lane >> 4;
  const f32x4 lw4 = *(const f32x4*)(ln_w + cb), lb4 = *(const f32x4*)(ln_b + cb), ng4 = *(const f32x4*)(ng + (cb & 63));
  for (int m = bid * 8 + wv; m < ntok; m += nb * 8) {
    const size_t o = (size_t)m * 256 + cb;
    const f32x4 y0 = ldbf4(YRW + o), y1 = ldbf4(YRW + (size_t)NTOK * 256 + o);
    const f32x4 rv = ldbf4(RWV + o), rg = ldbf4(RWG + o);
    const f32x4 g0 = ldbf4(YGD + o), g1 = ldbf4(YGD + (size_t)NTOK * 256 + o);
    const f32x4 z = ldbf4(P + (size_t)m * PINP + B_END + 768 + cb);
    const float bon = BON[(size_t)m * 4 + hh];
    {
      const f32x4 y = y0 + y1;
      const float mean = row16_sum((y[0] + y[1]) + (y[2] + y[3])) * (1.f / 64.f);
      const f32x4 dv = y - mean;
      const float var = row16_sum((dv[0] * dv[0] + dv[1] * dv[1]) + (dv[2] * dv[2] + dv[3] * dv[3])) * (1.f / 64.f);
      const f32x4 out = ((dv * rsqrtf(var + 64e-5f)) * lw4 + lb4 + rv * bon) * rg;
      *(bf16x4*)(CC + (size_t)m * 1024 + 512 + cb) = pack4(out[0], out[1], out[2], out[3]);
    }
    {
      const f32x4 y = g0 + g1;
      const float ms = row16_sum((y[0] * y[0] + y[1] * y[1]) + (y[2] * y[2] + y[3] * y[3])) * (1.f / 64.f);
      const f32x4 sz = {siluf_(z[0]), siluf_(z[1]), siluf_(z[2]), siluf_(z[3])};
      const f32x4 out = (y * rsqrtf(ms + 1e-6f)) * ng4 * sz;
      *(bf16x4*)(CC + (size_t)m * 1024 + 768 + cb) = pack4(out[0], out[1], out[2], out[3]);
    }
  }
}

#define RW_LDS_ROW 36
__device__ __forceinline__ void phase_router(PP pp, int l, int bid, int nb, char* smem) {
  const int tid = tid_opaque(), lane = tid & 63, wv = wave_id(tid);
  const float* xl = p.out;
  const float* xc = (const float*)(p.ws + OFF_CTX);
  const float* mods = (const float*)(p.ws + OFF_MODS) + (size_t)l * 3 * 6144;
  const float* g = p.norm_ffn_g + (size_t)l * 1024;
  const float* rw = p.moe_router_w + (size_t)l * 1024 * 32;
  const float* rb = p.moe_router_b + (size_t)l * 32;
  bfr* H = (bfr*)(p.ws + OFF_H);
  int* cnt = (int*)(p.ws + OFF_CNT);
  int* TOKE = (int*)(p.ws + OFF_TOKE);
  int* TOKP = (int*)(p.ws + OFF_TOKP);
  float* TOKG = (float*)(p.ws + OFF_TOKG);
  float* wl = (float*)smem;
  for (int i = tid; i < 1024 * 8; i += NTHR) {
    int d = i >> 3, q = i & 7;
    *(float4*)(wl + d * RW_LDS_ROW + q * 4) = *(const float4*)(rw + (size_t)d * 32 + q * 4);
  }
  __syncthreads();
  const int ntok = (l == 0) ? NTOK : NLAT;
  const float rbl = rb[lane & 31];
  for (int m0 = (bid * 8 + wv) * 2; m0 < ntok; m0 += nb * 16) {
    float acc0[32], acc1[32];
#pragma unroll
    for (int e = 0; e < 32; ++e) { acc0[e] = 0.f; acc1[e] = 0.f; }
    float hv0[16], hv1[16];
    {
      const int ma = m0, mb = m0 + 1;
      const float* xa = (ma < NLAT) ? xl + (size_t)ma * 1024 : xc + (size_t)(ma - NLAT) * 1024;
      const float* xb = (mb < NLAT) ? xl + (size_t)mb * 1024 : xc + (size_t)(mb - NLAT) * 1024;
      const float* mda = mods + (size_t)mod_row(ma) * 6144 + 3072;
      const float* mdb = mods + (size_t)mod_row(mb) * 6144 + 3072;
      float ssa = 0.f, ssb = 0.f;
#pragma unroll
      for (int i = 0; i < 16; ++i) { hv0[i] = xa[lane + 64 * i]; hv1[i] = xb[lane + 64 * i]; }
#pragma unroll
      for (int i = 0; i < 16; ++i) { ssa += hv0[i] * hv0[i]; ssb += hv1[i] * hv1[i]; }
      ssa = wave_sum(ssa); ssb = wave_sum(ssb);
      const float rsa = rsqrtf(ssa * (1.f / 1024.f) + 1e-6f), rsb = rsqrtf(ssb * (1.f / 1024.f) + 1e-6f);
#pragma unroll
      for (int i = 0; i < 16; ++i) {
        const int d = lane + 64 * i;
        const float gg = g[d];
        hv0[i] = hv0[i] * rsa * gg * (1.f + mda[1024 + d]) + mda[d];
        hv1[i] = hv1[i] * rsb * gg * (1.f + mdb[1024 + d]) + mdb[d];
      }
      float am0 = 0.f, am1 = 0.f;
#pragma unroll
      for (int i = 0; i < 16; ++i) { am0 = fmaxf(am0, fabsf(hv0[i])); am1 = fmaxf(am1, fabsf(hv1[i])); }
      am0 = wave_max(am0); am1 = wave_max(am1);
      const float sc0 = am0 > 0.f ? am0 * (1.f / 127.f) : 1.f, sc1 = am1 > 0.f ? am1 * (1.f / 127.f) : 1.f;
      const float iv0 = 1.f / sc0, iv1 = 1.f / sc1;
      signed char* H8 = (signed char*)(p.ws + OFF_H);
#pragma unroll
      for (int i = 0; i < 16; ++i) {
        const int d = lane + 64 * i;
        H8[(size_t)ma * 1024 + d] = (signed char)(int)fminf(fmaxf(rintf(hv0[i] * iv0), -127.f), 127.f);
        H8[(size_t)mb * 1024 + d] = (signed char)(int)fminf(fmaxf(rintf(hv1[i] * iv1), -127.f), 127.f);
      }
      if (lane == 0) { float* SCL = (float*)(p.ws + OFF_SCL); SCL[ma] = sc0; SCL[mb] = sc1; }
      asm volatile("" ::: "memory");
    }
#pragma unroll
    for (int i = 0; i < 16; ++i) {
      if ((i & 3) == 0) asm volatile("" ::: "memory");
      const float* wr = wl + (lane + 64 * i) * RW_LDS_ROW;
#pragma unroll
      for (int q = 0; q < 8; ++q) {
        const float4 w = *(const float4*)(wr + q * 4);
        acc0[q * 4 + 0] += hv0[i] * w.x; acc0[q * 4 + 1] += hv0[i] * w.y; acc0[q * 4 + 2] += hv0[i] * w.z; acc0[q * 4 + 3] += hv0[i] * w.w;
        acc1[q * 4 + 0] += hv1[i] * w.x; acc1[q * 4 + 1] += hv1[i] * w.y; acc1[q * 4 + 2] += hv1[i] * w.z; acc1[q * 4 + 3] += hv1[i] * w.w;
      }
    }
#define BFLY(A, N, D)                                                                           \
    _Pragma("unroll") for (int i = 0; i < (N); ++i) {                                            \
      const bool up = (lane & (D)) != 0;                                                         \
      const float keep = up ? A[i + (N)] : A[i];                                                 \
      const float send = up ? A[i] : A[i + (N)];                                                 \
      A[i] = keep + shfl_xor_l(send, (D), lane);                                                   \
    }
    BFLY(acc0, 16, 16) BFLY(acc1, 16, 16)
    BFLY(acc0, 8, 8) BFLY(acc1, 8, 8)
    BFLY(acc0, 4, 4) BFLY(acc1, 4, 4)
    BFLY(acc0, 2, 2) BFLY(acc1, 2, 2)
    BFLY(acc0, 1, 1) BFLY(acc1, 1, 1)
#undef BFLY
    float la = acc0[0] + shfl_xor_l(acc0[0], 32, lane);
    float lb = acc1[0] + shfl_xor_l(acc1[0], 32, lane);
    const int my_e = lane & 31;
    la += rbl; lb += rbl;
    (void)my_e;
#pragma unroll
    for (int tkn = 0; tkn < 2; ++tkn) {
      float v = tkn == 0 ? la : lb;
      float tv[4]; int ti[4];
#pragma unroll
      for (int k = 0; k < 4; ++k) {
        float bv = v; int bi = lane & 31;
#pragma unroll
        for (int o = 16; o >= 1; o >>= 1) {
          float ov = shfl_xor_l(bv, o, lane); int oi = shfl_xor_li(bi, o, lane);
          bool take = (ov > bv) || (ov == bv && oi < bi);
          bv = take ? ov : bv; bi = take ? oi : bi;
        }
        tv[k] = bv; ti[k] = bi;
        if ((lane & 31) == bi) v = -3.0e38f;
      }
      float e1 = __expf(tv[1] - tv[0]), e2 = __expf(tv[2] - tv[0]), e3 = __expf(tv[3] - tv[0]);
      float inv = 1.f / (1.f + e1 + e2 + e3);
      const int m = m0 + tkn;
      if (lane < 4) {
        int e = lane == 0 ? ti[0] : lane == 1 ? ti[1] : lane == 2 ? ti[2] : ti[3];
        float gt = (lane == 0 ? 1.f : lane == 1 ? e1 : lane == 2 ? e2 : e3) * inv;
        int pos = atomicAdd(&cnt[e], 1);
        TOKE[(size_t)m * 4 + lane] = e; TOKP[(size_t)m * 4 + lane] = pos; TOKG[(size_t)m * 4 + lane] = gt;
      }
    }
  }
  __syncthreads();
}

__device__ __forceinline__ void moe_offsets(PP pp, int* toff) {
  const int* cnt = (const int*)(p.ws + OFF_CNT);
  if (tid_opaque() == 0) {
    int a = 0;
    for (int e = 0; e < 32; ++e) { toff[e] = a; a += (cnt[e] + 255) >> 8; }
    toff[32] = a;
  }
  __syncthreads();
}
__device__ __forceinline__ void moe_tile_experts(int* toff) {
  int* texp = toff + 128;
  const int ntile = toff[32];
  for (int mt = tid_opaque(); mt < ntile; mt += NTHR) {
    int e = 0;
#pragma unroll 1
    for (int k = 1; k < 32; ++k) e = (mt >= toff[k]) ? k : e;
    texp[mt] = e;
  }
  __syncthreads();
}

__device__ __forceinline__ void phase_slotfill(PP pp, int l, int bid, int nb, char* smem) {
  int* toff = (int*)smem;
  moe_offsets(pp, toff);
  const int tid = tid_opaque(), lane = tid & 63, wv = wave_id(tid);
  const int* TOKE = (const int*)(p.ws + OFF_TOKE);
  const int* TOKP = (const int*)(p.ws + OFF_TOKP);
  const float* TOKG = (const float*)(p.ws + OFF_TOKG);
  const int* cnt = (const int*)(p.ws + OFF_CNT);
  int* TOKS = (int*)(p.ws + OFF_TOKS);
  float* SLG = (float*)(p.ws + OFF_SLG);
  float* SLS = (float*)(p.ws + OFF_SLS);
  const float* SCL = (const float*)(p.ws + OFF_SCL);
  const signed char* H8 = (const signed char*)(p.ws + OFF_H);
  signed char* XG = (signed char*)(p.ws + OFF_S);
  const int n = ((l == 0) ? NTOK : NLAT) * 4;
  int* SLT = (int*)(p.ws + OFF_SLT);
  for (int i = bid * NTHR + tid; i < n; i += nb * NTHR) {
    const int slot = toff[TOKE[i]] * 256 + TOKP[i];
    TOKS[i] = slot; SLT[slot] = i >> 2; SLG[slot] = TOKG[i]; SLS[slot] = SCL[i >> 2];
  }
  for (int e = 0; e < 32; ++e) {
    const int c = cnt[e];
    const int npad = ((c + 255) & ~255) - c;
    const int base = toff[e] * 256 + c;
    for (int r = bid * NTHR + tid; r < npad; r += nb * NTHR) { SLT[base + r] = 0; SLS[base + r] = 0.f; }
  }
  __syncthreads();
}

struct EpiMoe1 {
  const float* bgu; const float* sw; const float* SLS; bfr* ACT;
  __device__ __forceinline__ void operator()(const i32x4 (&acc)[2][2][4][2], const g8::GUnit& u, int wr, int wc, int fr, int fq) const {
    const float* be = bgu + (size_t)u.e * 2048;
    const float* se = sw + (size_t)u.e * 2048;
    const int slot0 = u.pm * 256 + wr * 64 + fr;
    float sav[2][4];
#pragma unroll
    for (int ai = 0; ai < 2; ++ai)
#pragma unroll
      for (int m = 0; m < 4; ++m) sav[ai][m] = SLS[slot0 + ai * 128 + m * 16];
    f32x4 bgv[2], blv[2], sgv[2], slv[2];
#pragma unroll
    for (int bj = 0; bj < 2; ++bj) {
      const int j0 = u.pn * 128 + bj * 64 + wc * 16 + 4 * fq;
      bgv[bj] = *(const f32x4*)(be + j0); blv[bj] = *(const f32x4*)(be + 1024 + j0);
      sgv[bj] = *(const f32x4*)(se + j0); slv[bj] = *(const f32x4*)(se + 1024 + j0);
    }
#pragma unroll
    for (int bj = 0; bj < 2; ++bj) {
      const int j0 = u.pn * 128 + bj * 64 + wc * 16 + 4 * fq;
      const f32x4 bg = bgv[bj], bl = blv[bj];
      const f32x4 sg = sgv[bj], sl = slv[bj];
#pragma unroll
      for (int ai = 0; ai < 2; ++ai)
#pragma unroll
        for (int m = 0; m < 4; ++m) {
          const int slot = slot0 + ai * 128 + m * 16;
          const float sa = sav[ai][m];
          bf16x4 o;
#pragma unroll
          for (int q = 0; q < 4; ++q) {
            const float g = (float)acc[ai][bj][m][0][q] * (sa * sg[q]) + bg[q];
            const float li = (float)acc[ai][bj][m][1][q] * (sa * sl[q]) + bl[q];
            const float gv = fminf(g, 7.f);
            const float lv = fminf(fmaxf(li, -7.f), 7.f);
            o[q] = (short)f2bf(gv * sigmoidf_(1.702f * gv) * (lv + 1.f));
          }
          *(bf16x4*)(ACT + (size_t)slot * 1024 + j0) = o;
        }
    }
  }
};
__device__ __forceinline__ void phase_moe1_impl(PP pp, int l, int bid, int nb, char* smem, int* toff) {
  moe_offsets(pp, toff);
  moe_tile_experts(toff);
  g8::MoeSched S{toff, 8, 2048, nb, bid};
  EpiMoe1 E{p.moe_b_gu + (size_t)l * 32 * 2048, (const float*)(p.ws + OFF_SW) + (size_t)l * 32 * 2048, (const float*)(p.ws + OFF_SLS), (bfr*)(p.ws + OFF_P)};
  g8::gemm_stream<true, true>((LAS unsigned char*)smem, p.ws + OFF_H, p.ws + OFF_W + (size_t)l * WL_SIZE + WL_GU, S, E, (const int*)(p.ws + OFF_SLT));
}

struct EpiMoe2 {
  const float* bdn; const float* SLG; bfr* YS;
  __device__ __forceinline__ void operator()(const f32x4 (&acc)[2][2][4][2], const g8::GUnit& u, int wr, int wc, int fr, int fq) const {
    const float* be = bdn + (size_t)u.e * 1024;
    const int slot0 = u.pm * 256 + wr * 64 + fr, col0 = u.pn * 256 + wc * 32 + 4 * fq;
    float gtv[2][4];
#pragma unroll
    for (int ai = 0; ai < 2; ++ai)
#pragma unroll
      for (int m = 0; m < 4; ++m) gtv[ai][m] = SLG[slot0 + ai * 128 + m * 16];
    f32x4 bvv[2][2];
#pragma unroll
    for (int bj = 0; bj < 2; ++bj)
#pragma unroll
      for (int n = 0; n < 2; ++n) bvv[bj][n] = *(const f32x4*)(be + col0 + bj * 128 + n * 16);
#pragma unroll
    for (int ai = 0; ai < 2; ++ai)
#pragma unroll
      for (int m = 0; m < 4; ++m) {
        const int slot = slot0 + ai * 128 + m * 16;
        const float gt = gtv[ai][m];
#pragma unroll
        for (int bj = 0; bj < 2; ++bj)
#pragma unroll
          for (int n = 0; n < 2; ++n) {
            const f32x4 bv = bvv[bj][n];
            const f32x4 yv = (acc[ai][bj][m][n] + bv) * gt;
            *(bf16x4*)(YS + (size_t)slot * 1024 + col0 + bj * 128 + n * 16) = pack4(yv[0], yv[1], yv[2], yv[3]);
          }
      }
  }
};
__device__ __forceinline__ void phase_moe2_impl(PP pp, int l, int bid, int nb, char* smem, int* toff) {
  moe_offsets(pp, toff);
  moe_tile_experts(toff);
  g8::MoeSched S{toff, 4, 1024, nb, bid};
  EpiMoe2 E{p.moe_b_down + (size_t)l * 32 * 1024, (const float*)(p.ws + OFF_SLG), (bfr*)(p.ws + OFF_S)};
  g8::gemm_stream<false, false>((LAS unsigned char*)smem, p.ws + OFF_P, p.ws + OFF_W + (size_t)l * WL_SIZE + WL_DN, S, E);
}

__device__ __forceinline__ void phase_combine(PP pp, int l, int bid, int nb) {
  const int tid = tid_opaque(), lane = tid & 63, wv = wave_id(tid);
  const bfr* YS = (const bfr*)(p.ws + OFF_S);
  const int* TOKS = (const int*)(p.ws + OFF_TOKS);
  const float* mods = (const float*)(p.ws + OFF_MODS) + (size_t)l * 3 * 6144;
  const float* mods1 = (const float*)(p.ws + OFF_MODS) + (size_t)3 * 6144;
  const float* g1n = p.norm_mix_g + 1024;
  bfr* H = (bfr*)(p.ws + OFF_H);
  float* xl = p.out;
  float* xc = (float*)(p.ws + OFF_CTX);
  const int ntok = (l == 0) ? NTOK : NLAT;
  if (l == 0) {
    int* cnt = (int*)(p.ws + OFF_CNT);
    const int gt = bid * NTHR + tid;
    if (gt < 32) cnt[gt] = 0;
  }
  for (int m = bid * 8 + wv; m < ntok; m += nb * 8) {
    float* xr = (m < NLAT) ? xl + (size_t)m * 1024 : xc + (size_t)(m - NLAT) * 1024;
    const float* g2 = mods + (size_t)mod_row(m) * 6144 + 5120;
    const int s0 = TOKS[(size_t)m * 4], s1 = TOKS[(size_t)m * 4 + 1], s2 = TOKS[(size_t)m * 4 + 2], s3 = TOKS[(size_t)m * 4 + 3];
    float4 xn[4];
    float ss = 0.f;
#pragma unroll
    for (int i = 0; i < 4; ++i) {
      const int d = (lane + 64 * i) * 4;
      const bf16x4 a = *(const bf16x4*)(YS + (size_t)s0 * 1024 + d);
      const bf16x4 b = *(const bf16x4*)(YS + (size_t)s1 * 1024 + d);
      const bf16x4 c = *(const bf16x4*)(YS + (size_t)s2 * 1024 + d);
      const bf16x4 e = *(const bf16x4*)(YS + (size_t)s3 * 1024 + d);
      const float4 gg = *(const float4*)(g2 + d);
      float4 xv = *(const float4*)(xr + d);
      xv.x += gg.x * ((bf2f(a[0]) + bf2f(b[0])) + (bf2f(c[0]) + bf2f(e[0])));
      xv.y += gg.y * ((bf2f(a[1]) + bf2f(b[1])) + (bf2f(c[1]) + bf2f(e[1])));
      xv.z += gg.z * ((bf2f(a[2]) + bf2f(b[2])) + (bf2f(c[2]) + bf2f(e[2])));
      xv.w += gg.w * ((bf2f(a[3]) + bf2f(b[3])) + (bf2f(c[3]) + bf2f(e[3])));
      *(float4*)(xr + d) = xv;
      xn[i] = xv;
      ss += xv.x * xv.x + xv.y * xv.y + xv.z * xv.z + xv.w * xv.w;
    }
    if (l == 0) {
      ss = wave_sum(ss);
      const float rs = rsqrtf(ss * (1.f / 1024.f) + 1e-6f);
      const float* md = mods1 + (size_t)mod_row(m) * 6144;
      float4 hq[4];
#pragma unroll
      for (int i = 0; i < 4; ++i) {
        const int d = (lane + 64 * i) * 4;
        const float4 gg = *(const float4*)(g1n + d);
        const float4 sh = *(const float4*)(md + d);
        const float4 sc = *(const float4*)(md + 1024 + d);
        hq[i] = make_float4(xn[i].x * rs * gg.x * (1.f + sc.x) + sh.x, xn[i].y * rs * gg.y * (1.f + sc.y) + sh.y,
                            xn[i].z * rs * gg.z * (1.f + sc.z) + sh.z, xn[i].w * rs * gg.w * (1.f + sc.w) + sh.w);
      }
      const float qs = quant_row_store(hq, (signed char*)(p.ws + OFF_H) + (size_t)m * 1024, lane);
      if (lane == 0) ((float*)(p.ws + OFF_SCL))[m] = qs;
    }
  }
}

#define XB_TMO      128
#define XB_XCNT(j)  (256  + 64 * (j))
#define XB_XSUB(j)  (1280 + 64 * (j))
#define XB_XGEN(j)  (2304 + 64 * (j))
#define XB_TOP      3328
#define XB_TOPGEN   3392
#define XCD_BAR_WORDS 3456
#define XB_SPIN_CAP (1u << 22)
__device__ __forceinline__ unsigned xb_ld(unsigned* q) { return __hip_atomic_load(q, __ATOMIC_RELAXED, __HIP_MEMORY_SCOPE_AGENT); }
__device__ __forceinline__ unsigned xb_add(unsigned* q, unsigned v) { return __hip_atomic_fetch_add(q, v, __ATOMIC_RELAXED, __HIP_MEMORY_SCOPE_AGENT); }
__device__ __forceinline__ unsigned xb_xcc_id() { return (unsigned)__builtin_amdgcn_s_getreg((3 << 11) | 20) & 0xFu; }
#define XB_SPIN(cond, bar) do { unsigned _sp = 0; while (cond) { __builtin_amdgcn_s_sleep(1); \
    if ((++_sp & 255u) == 0u) { if (xb_ld(&(bar)[XB_TMO])) break; if (_sp > XB_SPIN_CAP) { atomicAdd(&(bar)[XB_TMO], 1u); break; } } } } while (0)
struct XcdBarrier { unsigned* bar; unsigned x; volatile LAS unsigned* st; };
__device__ __forceinline__ XcdBarrier xcd_barrier_post(unsigned* bar, volatile LAS unsigned* st) {
  XcdBarrier b; b.bar = bar; b.x = xb_xcc_id(); b.st = st;
  if (tid_opaque() == 0) (void)xb_add(&bar[XB_XCNT(b.x)], 1u);
  return b;
}
__device__ __forceinline__ void xcd_barrier_complete(unsigned* bar, unsigned x, unsigned& nloc, unsigned& nx) {
  const unsigned G = gridDim.x;
  unsigned sum, cnt, mine, sp = 0u;
  for (;;) {
    sum = 0u; cnt = 0u; mine = 0u;
#pragma unroll
    for (unsigned j = 0; j < 16; ++j) { const unsigned c = xb_ld(&bar[XB_XCNT(j)]); sum += c; cnt += (c > 0u) ? 1u : 0u; mine = (j == x) ? c : mine; }
    if (sum == G) break;
    __builtin_amdgcn_s_sleep(1);
    if ((++sp & 255u) == 0u) { if (xb_ld(&bar[XB_TMO])) break; if (sp > XB_SPIN_CAP) { atomicAdd(&bar[XB_TMO], 1u); break; } }
  }
  nloc = mine > 0u ? mine : 1u; nx = cnt > 0u ? cnt : 1u;
}
__device__ __forceinline__ void xcd_barrier(const XcdBarrier& b) {
  asm volatile("s_waitcnt vmcnt(0)" ::: "memory");
  __syncthreads();
  if (tid_opaque() == 0) {
    unsigned* bar = b.bar;
    __builtin_amdgcn_s_waitcnt(0);
    unsigned nloc = b.st[0], nx = b.st[1];
    if (nloc == 0u) { xcd_barrier_complete(bar, b.x, nloc, nx); b.st[0] = nloc; b.st[1] = nx; }
    const unsigned old = xb_add(&bar[XB_XSUB(b.x)], 1u);
    const unsigned gen = old / nloc;
    if (old + 1u == (gen + 1u) * nloc) {
      __builtin_amdgcn_fence(__ATOMIC_RELEASE, "agent");
      asm volatile("s_waitcnt vmcnt(0)" ::: "memory");
      const unsigned og = xb_add(&bar[XB_TOP], 1u);
      const unsigned tg = og / nx;
      if (og + 1u == (tg + 1u) * nx) xb_add(&bar[XB_TOPGEN], 1u);
      else XB_SPIN(xb_ld(&bar[XB_TOPGEN]) == tg, bar);
      __builtin_amdgcn_fence(__ATOMIC_ACQUIRE, "agent");
      xb_add(&bar[XB_XGEN(b.x)], 1u);
      asm volatile("s_waitcnt vmcnt(0)" ::: "memory");
    } else {
      XB_SPIN(xb_ld(&bar[XB_XGEN(b.x)]) == gen, bar);
      __builtin_amdgcn_fence(__ATOMIC_ACQUIRE, "agent");
      asm volatile("s_waitcnt vmcnt(0)" ::: "memory");
    }
  }
  __syncthreads();
}

extern __shared__ __attribute__((aligned(16))) char dyn_smem[];

__global__ void __launch_bounds__(NTHR) mega(Params p_unused) {
  cg::grid_group grid = cg::this_grid();
  const int bid0 = blockIdx.x, nb0 = gridDim.x;
#if defined(__HIP_DEVICE_COMPILE__)
  PP pp0 = (PP)__builtin_amdgcn_kernarg_segment_ptr();
#else
  PP pp0 = nullptr;
#endif
#define pp ({ PP q_ = pp0; asm volatile("" : "+s"(q_)); q_; })
#define bid opq(bid0)
#define nb opq(nb0)
  int* toff_s = (int*)(dyn_smem + 147456);
  volatile LAS unsigned* xb_st = (volatile LAS unsigned*)(dyn_smem + 147456 + 256);
  {
    unsigned* barw = (unsigned*)(fresh_ws(pp0) + OFF_BAR);
    if (blockIdx.x == 0) for (int i = threadIdx.x; i < XCD_BAR_WORDS; i += NTHR) barw[i] = 0u;
    if (threadIdx.x == 0) { xb_st[0] = 0u; xb_st[1] = 0u; }
  }
  grid.sync();
  const XcdBarrier xb = xcd_barrier_post((unsigned*)(fresh_ws(pp0) + OFF_BAR), xb_st);
#define GSYNC() xcd_barrier(xb)
  phase_ada(pp, bid, nb, dyn_smem);
  phase_convert(pp, 0, 0, bid, nb, dyn_smem);
  GSYNC();
#define LAYER(LV, LAST)                                      \
  {                                                          \
    if ((LV) == 0) { phase_prenorm(pp, opq(LV), bid, nb); GSYNC(); } \
    phase_gemm_in(pp, opq(LV), bid, nb, dyn_smem);           \
    GSYNC();                                                 \
    phase_prep(pp, opq(LV), bid, nb, dyn_smem);              \
    GSYNC();                                                 \
    phase_chunk_prep(pp, bid, nb, dyn_smem);                 \
    GSYNC();                                                 \
    phase_mix(pp, opq(LV), bid, nb, dyn_smem);               \
    GSYNC();                                                 \
    phase_post(pp, opq(LV), bid, nb);                        \
    GSYNC();                                                 \
    phase_gemm_out(pp, opq(LV), bid, nb, dyn_smem);          \
    GSYNC();                                                 \
    phase_router(pp, opq(LV), bid, nb, dyn_smem);            \
    GSYNC();                                                 \
    phase_slotfill(pp, opq(LV), bid, nb, dyn_smem);          \
    GSYNC();                                                 \
    phase_moe1_impl(pp, opq(LV), bid, nb, dyn_smem, toff_s); \
    GSYNC();                                                 \
    phase_moe2_impl(pp, opq(LV), bid, nb, dyn_smem, toff_s); \
    GSYNC();                                                 \
    phase_combine(pp, opq(LV), bid, nb);                     \
    if (!(LAST)) GSYNC();                                    \
  }
  LAYER(0, false)
  LAYER(1, true)
#undef LAYER
#undef GSYNC
#undef bid
#undef nb
#undef pp
}

#undef p
extern "C" void kernel_launch(void* const* d_in, const int* in_sizes, int n_in, void* d_out, int out_size, void* d_ws,
                              size_t ws_size, hipStream_t stream) {
  Params hp{};
  const float** pp = (const float**)&hp;
  for (int i = 0; i < 34; ++i) pp[i] = (const float*)d_in[i];
  hp.out = (float*)d_out;
  hp.ws = (char*)d_ws;
  static int grid_blocks = 0;
  if (!grid_blocks) {
    (void)hipFuncSetAttribute((const void*)mega, hipFuncAttributeMaxDynamicSharedMemorySize, LDS_BYTES);
    int dev = 0, cus = 0, per_cu = 0;
    (void)hipGetDevice(&dev);
    (void)hipDeviceGetAttribute(&cus, hipDeviceAttributeMultiprocessorCount, dev);
    (void)hipOccupancyMaxActiveBlocksPerMultiprocessor(&per_cu, mega, NTHR, LDS_BYTES);
    if (per_cu < 1) per_cu = 1;
    if (per_cu > 1) per_cu = 1;
    grid_blocks = cus * per_cu;
  }
  void* args[] = {&hp};
  (void)hipLaunchCooperativeKernel((void*)mega, dim3(grid_blocks), dim3(NTHR), args, LDS_BYTES, stream);
}
```

```cpp
#include <hip/hip_runtime.h>
#include <hip/hip_bf16.h>
#include <hip/hip_cooperative_groups.h>
#include <stdint.h>
#include <type_traits>
namespace cg = cooperative_groups;

typedef __attribute__((ext_vector_type(8))) short bf16x8;
typedef __attribute__((ext_vector_type(4))) short bf16x4;
typedef __attribute__((ext_vector_type(4))) float f32x4;
typedef __attribute__((ext_vector_type(4))) int i32x4;
typedef unsigned short bfr;

#define D_MODEL 1024
#define NB 2
#define SEQ 16384
#define CTXL 256
#define NLAT (NB * SEQ)
#define NCTX (NB * CTXL)
#define NTOK (NLAT + NCTX)
#define TTOK (SEQ + CTXL)
#define PIN 3472
#define PINP 3584
#define A_END 1536
#define B_END 2432
#define NEXP 32
#define NSLOT_MAX (NTOK * 4 + NEXP * 256)
#define NTHR 512
#define LDS_BYTES (147456 + 3072)

constexpr size_t al256(size_t x) { return (x + 255) & ~(size_t)255; }
constexpr size_t WL_IN = 0;
constexpr size_t WL_OUT = WL_IN + (size_t)PINP * 1024 * 2;
constexpr size_t WL_GU = WL_OUT + (size_t)1024 * 1024 * 2;
constexpr size_t WL_DN = WL_GU + (size_t)32 * 2048 * 1024 * 2;
constexpr size_t WL_SIZE = WL_DN + (size_t)32 * 1024 * 1024 * 2;
constexpr size_t OFF_W = 0;
constexpr size_t OFF_MODS = al256(OFF_W + 2 * WL_SIZE);
constexpr size_t OFF_BAR = al256(OFF_MODS + 2 * 3 * 6144 * 4);
constexpr size_t OFF_SW = al256(OFF_BAR + 3456 * 4);
constexpr size_t OFF_SWIN = al256(OFF_SW + (size_t)2 * 32 * 2048 * 4);
constexpr size_t OFF_SLS = al256(OFF_SWIN + (size_t)2 * PINP * 4);
constexpr size_t OFF_SCL = al256(OFF_SLS + (size_t)(NTOK * 4 + 32 * 256) * 4);
constexpr size_t OFF_CTX = al256(OFF_SCL + (size_t)NTOK * 4);
constexpr size_t OFF_CNT = al256(OFF_CTX + (size_t)NCTX * 1024 * 4);
constexpr size_t OFF_TOKE = al256(OFF_CNT + 256);
constexpr size_t OFF_TOKP = al256(OFF_TOKE + (size_t)NTOK * 4 * 4);
constexpr size_t OFF_TOKG = al256(OFF_TOKP + (size_t)NTOK * 4 * 4);
constexpr size_t OFF_TOKS = al256(OFF_TOKG + (size_t)NTOK * 4 * 4);
constexpr size_t OFF_SLT = al256(OFF_TOKS + (size_t)NTOK * 4 * 4);
constexpr size_t OFF_SLG = al256(OFF_SLT + (size_t)NSLOT_MAX * 4);
constexpr size_t OFF_H = al256(OFF_SLG + (size_t)NSLOT_MAX * 4);
constexpr size_t OFF_CC = al256(OFF_H + (size_t)NTOK * 1024 * 2);
constexpr size_t OFF_P = al256(OFF_CC + (size_t)NTOK * 1024 * 2);
constexpr size_t OFF_S = al256(OFF_P + (size_t)NTOK * PINP * 4);
constexpr size_t TOK256F = (size_t)NTOK * 256 * 4;
constexpr size_t S_QN = 0;
constexpr size_t S_KN = S_QN + (size_t)NTOK * 512 * 2;
constexpr size_t S_VT = S_KN + (size_t)NTOK * 512 * 2;
constexpr size_t S_RWR = S_VT + (size_t)NB * 8 * 64 * TTOK * 2;
constexpr size_t S_RWKK = S_RWR + TOK256F;
constexpr size_t S_RWV = S_RWKK + TOK256F;
constexpr size_t S_RWG = S_RWV + TOK256F;
constexpr size_t S_RWW = S_RWG + TOK256F;
constexpr size_t S_RWKD = S_RWW + 2 * TOK256F;
constexpr size_t S_RWB = S_RWKD + 2 * TOK256F;
constexpr size_t S_BON = S_RWB + 2 * TOK256F;
constexpr size_t S_GDQ = al256(S_BON + (size_t)NTOK * 4 * 4);
constexpr size_t S_GDK = S_GDQ + TOK256F;
constexpr size_t S_GDV = S_GDK + TOK256F;
constexpr size_t S_GDAB = S_GDV + TOK256F;
constexpr size_t S_YRW = al256(S_GDAB + (size_t)NTOK * 16 * 4);
constexpr size_t S_YGD = S_YRW + 2 * TOK256F;
constexpr size_t S_END = S_YGD + 2 * TOK256F;
constexpr size_t S_SIZE = (S_END > (size_t)NSLOT_MAX * 1024 * 4) ? S_END : (size_t)NSLOT_MAX * 1024 * 4;
constexpr int NCHUNK = TTOK / 64;
constexpr int NCHAIN = 32;
constexpr size_t OFF_CH = al256(OFF_S + S_SIZE);
constexpr size_t CH_N = (size_t)NCHAIN * NCHUNK;
constexpr size_t CH_REC = 32768, CH_PT = 0, CH_RYT = 8192, CH_QT = 16384, CH_YX = 24576;
constexpr size_t CH_SIZE = CH_N * CH_REC;
constexpr size_t WS_TOTAL = OFF_CH + CH_SIZE;
static_assert(WS_TOTAL <= (size_t)2048 * 1024 * 1024, "workspace exceeds 4x largest tensor");

struct Params {
  const float *x, *c, *ctx, *c_ctx, *ada_w, *ada_b, *norm_mix_g, *norm_ffn_g, *w_in, *w_out;
  const float *na_q_gain, *na_k_gain, *na_rpb;
  const float *rw_mu, *rw_w0, *rw_w_up, *rw_a0, *rw_a_up, *rw_g_up, *rw_k_k, *rw_k_a, *rw_r_k, *rw_ln_w, *rw_ln_b;
  const float *gd_conv_w, *gd_A_log, *gd_dt_bias, *gd_norm_g;
  const float *moe_router_w, *moe_router_b, *moe_w_gu, *moe_b_gu, *moe_w_down, *moe_b_down;
  float* out;
  char* ws;
};

typedef const __attribute__((address_space(4))) Params* PP;
#define p (*pp)
__device__ __forceinline__ char* fresh_ws(PP pp) { return p.ws; }
__device__ __forceinline__ int tid_opaque() { int t = (int)__builtin_amdgcn_workitem_id_x(); asm volatile("" : "+v"(t)); return t; }
__device__ __forceinline__ int opq(int x) { asm volatile("" : "+s"(x)); return x; }
__device__ __forceinline__ int wave_id(int tid) { return __builtin_amdgcn_readfirstlane(tid >> 6); }
typedef __bf16 bf16v2_t __attribute__((ext_vector_type(2)));
typedef float f32v2_t __attribute__((ext_vector_type(2)));
__device__ __forceinline__ unsigned pk_bf16(float lo, float hi) { f32v2_t v = {lo, hi}; return __builtin_bit_cast(unsigned, __builtin_convertvector(v, bf16v2_t)); }
__device__ __forceinline__ bfr f2bf(float f) { return (bfr)(pk_bf16(f, f) & 0xffffu); }
__device__ __forceinline__ float bf2f(short v) { return __uint_as_float(((unsigned)(unsigned short)v) << 16); }
__device__ __forceinline__ bf16x4 pack4(float a, float b, float c, float d) {
  typedef __attribute__((ext_vector_type(2))) unsigned u32x2;
  u32x2 w; w[0] = pk_bf16(a, b); w[1] = pk_bf16(c, d);
  return __builtin_bit_cast(bf16x4, w);
}
__device__ __forceinline__ bf16x8 pack8(f32x4 a, f32x4 b) {
  const bf16x4 lo = pack4(a[0], a[1], a[2], a[3]), hi = pack4(b[0], b[1], b[2], b[3]);
  return __builtin_shufflevector(lo, hi, 0, 1, 2, 3, 4, 5, 6, 7);
}
__device__ __forceinline__ int perm_row32(int n) { return (n & ~31) | (((n >> 2) & 1) << 4) | (((n >> 3) & 3) << 2) | (n & 3); }
__device__ __forceinline__ float sigmoidf_(float x) { return __builtin_amdgcn_rcpf(1.f + __expf(-x)); }
__device__ __forceinline__ float siluf_(float x) { return x * __builtin_amdgcn_rcpf(1.f + __expf(-x)); }
__device__ __forceinline__ float softplusf_(float x) { const float e = __expf(fminf(x, 20.f)); const float lg = __logf(1.f + e); const float r = x < -15.f ? e : lg; return x > 20.f ? x : r; }
__device__ __forceinline__ float wave_sum(float v) {
  v += __builtin_bit_cast(float, __builtin_amdgcn_update_dpp(0, __builtin_bit_cast(int, v), 0xB1, 0xF, 0xF, true));
  v += __builtin_bit_cast(float, __builtin_amdgcn_update_dpp(0, __builtin_bit_cast(int, v), 0x4E, 0xF, 0xF, true));
  v += __builtin_bit_cast(float, __builtin_amdgcn_update_dpp(0, __builtin_bit_cast(int, v), 0x141, 0xF, 0xF, true));
  v += __builtin_bit_cast(float, __builtin_amdgcn_update_dpp(0, __builtin_bit_cast(int, v), 0x140, 0xF, 0xF, true));
  v += __builtin_bit_cast(float, __builtin_amdgcn_update_dpp(0, __builtin_bit_cast(int, v), 0x142, 0xA, 0xF, false));
  v += __builtin_bit_cast(float, __builtin_amdgcn_update_dpp(0, __builtin_bit_cast(int, v), 0x143, 0xC, 0xF, false));
  return __builtin_bit_cast(float, __builtin_amdgcn_readlane(__builtin_bit_cast(int, v), 63));
}
__device__ __forceinline__ float wave_max(float v) {
  v = fmaxf(v, __builtin_bit_cast(float, __builtin_amdgcn_update_dpp(0, __builtin_bit_cast(int, v), 0xB1, 0xF, 0xF, true)));
  v = fmaxf(v, __builtin_bit_cast(float, __builtin_amdgcn_update_dpp(0, __builtin_bit_cast(int, v), 0x4E, 0xF, 0xF, true)));
  v = fmaxf(v, __builtin_bit_cast(float, __builtin_amdgcn_update_dpp(0, __builtin_bit_cast(int, v), 0x141, 0xF, 0xF, true)));
  v = fmaxf(v, __builtin_bit_cast(float, __builtin_amdgcn_update_dpp(0, __builtin_bit_cast(int, v), 0x140, 0xF, 0xF, true)));
  const float r1 = __builtin_bit_cast(float, __builtin_amdgcn_readlane(__builtin_bit_cast(int, v), 0));
  const float r2 = __builtin_bit_cast(float, __builtin_amdgcn_readlane(__builtin_bit_cast(int, v), 16));
  const float r3 = __builtin_bit_cast(float, __builtin_amdgcn_readlane(__builtin_bit_cast(int, v), 32));
  const float r4 = __builtin_bit_cast(float, __builtin_amdgcn_readlane(__builtin_bit_cast(int, v), 48));
  return fmaxf(fmaxf(r1, r2), fmaxf(r3, r4));
}
__device__ __forceinline__ float shfl_xor_l(float v, int mask, int lane) {
  return __builtin_bit_cast(float, __builtin_amdgcn_ds_bpermute((lane ^ mask) << 2, __builtin_bit_cast(int, v)));
}
__device__ __forceinline__ int shfl_xor_li(int v, int mask, int lane) {
  return __builtin_amdgcn_ds_bpermute((lane ^ mask) << 2, v);
}
__device__ __forceinline__ float row16_sum(float v) {
  v += __builtin_bit_cast(float, __builtin_amdgcn_update_dpp(0, __builtin_bit_cast(int, v), 0xB1, 0xF, 0xF, true));
  v += __builtin_bit_cast(float, __builtin_amdgcn_update_dpp(0, __builtin_bit_cast(int, v), 0x4E, 0xF, 0xF, true));
  v += __builtin_bit_cast(float, __builtin_amdgcn_update_dpp(0, __builtin_bit_cast(int, v), 0x141, 0xF, 0xF, true));
  v += __builtin_bit_cast(float, __builtin_amdgcn_update_dpp(0, __builtin_bit_cast(int, v), 0x140, 0xF, 0xF, true));
  return v;
}
__device__ __forceinline__ float quant_row_store(const float4 (&v)[4], signed char* dst_row, int lane) {
  float am = 0.f;
#pragma unroll
  for (int i = 0; i < 4; ++i) am = fmaxf(fmaxf(am, fmaxf(fabsf(v[i].x), fabsf(v[i].y))), fmaxf(fabsf(v[i].z), fabsf(v[i].w)));
  am = wave_max(am);
  const float sc = am > 0.f ? am * (1.f / 127.f) : 1.f, iv = 1.f / sc;
#pragma unroll
  for (int i = 0; i < 4; ++i) {
    const int q0 = (int)fminf(fmaxf(rintf(v[i].x * iv), -127.f), 127.f), q1 = (int)fminf(fmaxf(rintf(v[i].y * iv), -127.f), 127.f);
    const int q2 = (int)fminf(fmaxf(rintf(v[i].z * iv), -127.f), 127.f), q3 = (int)fminf(fmaxf(rintf(v[i].w * iv), -127.f), 127.f);
    *(unsigned*)(dst_row + (lane + 64 * i) * 4) = (unsigned)(q0 & 0xff) | ((unsigned)(q1 & 0xff) << 8) | ((unsigned)(q2 & 0xff) << 16) | ((unsigned)(q3 & 0xff) << 24);
  }
  return sc;
}
__device__ __forceinline__ float ldbf1(const bfr* q, size_t i) { return bf2f((short)q[i]); }
__device__ __forceinline__ f32x4 ldbf4(const bfr* q) { const bf16x4 v = *(const bf16x4*)q; return (f32x4){bf2f(v[0]), bf2f(v[1]), bf2f(v[2]), bf2f(v[3])}; }
__device__ __forceinline__ int mod_row(int m) { return m < NLAT ? (m >> 14) : 2; }

__device__ __forceinline__ void phase_ada(PP pp, int bid, int nb, char* smem) {
  float* red = (float*)smem;
  float* mods = (float*)(p.ws + OFF_MODS);
  const int tid = tid_opaque();
  for (int task = bid; task < 2 * 96; task += nb) {
    int l = task / 96, cgp = task % 96;
    int col = cgp * 64 + (tid & 63), ks = tid >> 6;
    const float* W = p.ada_w + (size_t)l * 1024 * 6144;
    float a0 = 0.f, a1 = 0.f, a2 = 0.f;
    for (int d = ks * 128; d < ks * 128 + 128; ++d) {
      float w = W[(size_t)d * 6144 + col];
      a0 += siluf_(p.c[d]) * w;
      a1 += siluf_(p.c[1024 + d]) * w;
      a2 += siluf_(p.c_ctx[d]) * w;
    }
    red[(ks * 3 + 0) * 64 + (tid & 63)] = a0;
    red[(ks * 3 + 1) * 64 + (tid & 63)] = a1;
    red[(ks * 3 + 2) * 64 + (tid & 63)] = a2;
    __syncthreads();
    if (tid < 192) {
      int r = tid >> 6, cc = tid & 63;
      float s = 0.f;
      for (int k = 0; k < 8; ++k) s += red[(k * 3 + r) * 64 + cc];
      mods[(size_t)(l * 3 + r) * 6144 + cgp * 64 + cc] = s + p.ada_b[(size_t)l * 6144 + cgp * 64 + cc];
    }
    __syncthreads();
  }
}

template <bool PERM>
__device__ __forceinline__ void convert_tile(const float* src, int N, bfr* dst, int kt4  , int nt, float* tile  ) {
  const int tid = tid_opaque();
  float4 v[8];
#pragma unroll
  for (int q = 0; q < 8; ++q) {
    const int idx = tid + q * 512;
    const int kk = idx >> 4, n4 = idx & 15;
    v[q] = *(const float4*)(src + (size_t)(kt4 * 256 + kk) * N + nt * 64 + n4 * 4);
  }
#pragma unroll
  for (int q = 0; q < 8; ++q) {
    const int idx = tid + q * 512;
    const int kk = idx >> 4, n4 = idx & 15;
    tile[kk * 65 + n4 * 4 + 0] = v[q].x; tile[kk * 65 + n4 * 4 + 1] = v[q].y;
    tile[kk * 65 + n4 * 4 + 2] = v[q].z; tile[kk * 65 + n4 * 4 + 3] = v[q].w;
  }
  __syncthreads();
  {
    const int nn = tid >> 3, kc = tid & 7;
    const int n = PERM ? perm_row32(nt * 64 + nn) : nt * 64 + nn;
#pragma unroll
    for (int q = 0; q < 4; ++q) {
      const int k0 = (kc + 8 * q) * 8;
      *(bf16x4*)(dst + (size_t)n * 1024 + kt4 * 256 + k0) = pack4(tile[(k0 + 0) * 65 + nn], tile[(k0 + 1) * 65 + nn], tile[(k0 + 2) * 65 + nn], tile[(k0 + 3) * 65 + nn]);
      *(bf16x4*)(dst + (size_t)n * 1024 + kt4 * 256 + k0 + 4) = pack4(tile[(k0 + 4) * 65 + nn], tile[(k0 + 5) * 65 + nn], tile[(k0 + 6) * 65 + nn], tile[(k0 + 7) * 65 + nn]);
    }
  }
  __syncthreads();
}
template <int N, bool INTERLEAVE>
__device__ __forceinline__ void convert_i8(const float* src  , signed char* dst  , float* sw, int ng, char* smem) {
  const int tid = tid_opaque();
  bfr* blk = (bfr*)smem;
  int* cmax = (int*)(smem + 131072);
  if (tid < 64) cmax[tid] = 0;
  __syncthreads();
  {
    const int n4 = tid & 15, kk0 = tid >> 4;
    float m0 = 0.f, m1 = 0.f, m2 = 0.f, m3 = 0.f;
#pragma unroll 8
    for (int ps = 0; ps < 32; ++ps) {
      const int k = ps * 32 + kk0;
      const int ncol = ng * 64 + n4 * 4;
      const int ncl = (N % 64 == 0) ? ncol : min(ncol, N - 4);
      float4 v = *(const float4*)(src + (size_t)k * N + ncl);
      if (N % 64 != 0 && ncol != ncl) v = make_float4(0.f, 0.f, 0.f, 0.f);
      m0 = fmaxf(m0, fabsf(v.x)); m1 = fmaxf(m1, fabsf(v.y)); m2 = fmaxf(m2, fabsf(v.z)); m3 = fmaxf(m3, fabsf(v.w));
      *(bf16x4*)(blk + k * 64 + n4 * 4) = pack4(v.x, v.y, v.z, v.w);
    }
    atomicMax(&cmax[n4 * 4 + 0], __float_as_int(m0)); atomicMax(&cmax[n4 * 4 + 1], __float_as_int(m1));
    atomicMax(&cmax[n4 * 4 + 2], __float_as_int(m2)); atomicMax(&cmax[n4 * 4 + 3], __float_as_int(m3));
  }
  __syncthreads();
  {
    const int nn = tid >> 3, kc = tid & 7;
    const int n = ng * 64 + nn;
    const float am = __int_as_float(cmax[nn]);
    const float sc = am > 0.f ? am * (1.f / 127.f) : 1.f, iv = 1.f / sc;
    const int j = n & 1023;
    const int row = INTERLEAVE ? (j >> 7) * 256 + ((j >> 2) & 1) * 128 + ((j >> 5) & 3) * 32 + ((n >= 1024) ? 16 : 0) + ((j >> 3) & 3) * 4 + (j & 3) : perm_row32(n);
    if (kc == 0) sw[n] = sc;
#pragma unroll 2
    for (int q = 0; q < 8; ++q) {
      const int k0 = (kc + 8 * q) * 16;
      unsigned w[4];
#pragma unroll
      for (int g4 = 0; g4 < 4; ++g4) {
        unsigned acc = 0u;
#pragma unroll
        for (int b = 0; b < 4; ++b) {
          const float v = bf2f((short)blk[(k0 + g4 * 4 + b) * 64 + nn]);
          const int qi = (int)fminf(fmaxf(rintf(v * iv), -127.f), 127.f);
          acc |= ((unsigned)(qi & 0xff)) << (8 * b);
        }
        w[g4] = acc;
      }
      *(uint4*)(dst + (size_t)row * 1024 + k0) = make_uint4(w[0], w[1], w[2], w[3]);
    }
  }
  __syncthreads();
}
__device__ __forceinline__ void phase_convert(PP pp, int l, int part, int bid, int nb, char* smem) {
  float* tile = (float*)smem;
  char* wl = p.ws + OFF_W + (size_t)l * WL_SIZE;
  const int T_IN = 56, T_OUT = 4 * 16, T_GU = 32 * 32, T_DN = 32 * 4 * 16;
  const int t_lo = part == 0 ? 0 : T_IN + T_OUT;
  const int t_hi = part == 0 ? T_IN + T_OUT : T_IN + T_OUT + T_GU + T_DN;
  for (int t = t_lo + bid; t < t_hi; t += nb) {
    if (t < T_IN) {
      convert_i8<PIN, false>(p.w_in + (size_t)l * 1024 * PIN, (signed char*)(wl + WL_IN), (float*)(p.ws + OFF_SWIN) + (size_t)l * PINP, t, smem);
    } else if (t < T_IN + T_OUT) {
      int u = t - T_IN; int kt4 = u / 16, nt = u % 16;
      convert_tile<false>(p.w_out + (size_t)l * 1024 * 1024, 1024, (bfr*)(wl + WL_OUT), kt4, nt, tile);
    } else if (t < T_IN + T_OUT + T_GU) {
      int u = t - T_IN - T_OUT; int e = u / 32, ng = u % 32;
      convert_i8<2048, true>(p.moe_w_gu + ((size_t)l * 32 + e) * 1024 * 2048, (signed char*)(wl + WL_GU) + (size_t)e * 2048 * 1024,
                    (float*)(p.ws + OFF_SW) + ((size_t)l * 32 + e) * 2048, ng, smem);
    } else {
      int u = t - T_IN - T_OUT - T_GU; int e = u / 64; int v = u % 64; int kt4 = v / 16, nt = v % 16;
      convert_tile<true>(p.moe_w_down + ((size_t)l * 32 + e) * 1024 * 1024, 1024, (bfr*)(wl + WL_DN) + (size_t)e * 1024 * 1024, kt4, nt, tile);
    }
  }
}

__device__ __forceinline__ void phase_prenorm(PP pp, int l, int bid, int nb) {
  const int tid = tid_opaque(), lane = tid & 63, wv = wave_id(tid);
  const float* xl = (l == 0) ? p.x : p.out;
  const float* xc = (l == 0) ? p.ctx : (const float*)(p.ws + OFF_CTX);
  const float* mods = (const float*)(p.ws + OFF_MODS) + (size_t)l * 3 * 6144;
  const float* g = p.norm_mix_g + (size_t)l * 1024;
  signed char* H8 = (signed char*)(p.ws + OFF_H);
  float* SCL = (float*)(p.ws + OFF_SCL);
  {
    int* cnt = (int*)(p.ws + OFF_CNT);
    int gt = bid * NTHR + tid;
    if (gt < 32) cnt[gt] = 0;
  }
  for (int m = bid * 8 + wv; m < NTOK; m += nb * 8) {
    const float* xr = (m < NLAT) ? xl + (size_t)m * 1024 : xc + (size_t)(m - NLAT) * 1024;
    const float* md = mods + (size_t)mod_row(m) * 6144;
    float4 v[4];
    float ss = 0.f;
#pragma unroll
    for (int i = 0; i < 4; ++i) {
      v[i] = *(const float4*)(xr + (lane + 64 * i) * 4);
      ss += v[i].x * v[i].x + v[i].y * v[i].y + v[i].z * v[i].z + v[i].w * v[i].w;
    }
    ss = wave_sum(ss);
    float rs = rsqrtf(ss * (1.f / 1024.f) + 1e-6f);
    float4 hq[4];
#pragma unroll
    for (int i = 0; i < 4; ++i) {
      int d = (lane + 64 * i) * 4;
      float4 gg = *(const float4*)(g + d);
      float4 sh = *(const float4*)(md + d);
      float4 sc = *(const float4*)(md + 1024 + d);
      hq[i] = make_float4(v[i].x * rs * gg.x * (1.f + sc.x) + sh.x, v[i].y * rs * gg.y * (1.f + sc.y) + sh.y,
                          v[i].z * rs * gg.z * (1.f + sc.z) + sh.z, v[i].w * rs * gg.w * (1.f + sc.w) + sh.w);
    }
    const float qs = quant_row_store(hq, H8 + (size_t)m * 1024, lane);
    if (lane == 0) SCL[m] = qs;
  }
}

#define LAS __attribute__((address_space(3)))
namespace g8 {
constexpr int BM = 256, BK = 64, HALF = 128, HTB = HALF * BK * 2, STAGE_BYTES = 8 * HTB, KD = 1024;
__device__ __forceinline__ int lds_byte(int r, int c) { const int st = (r >> 4) * 2 + (c >> 5), rr = r & 15, cc = c & 31, ob = rr * 64 + cc * 2; return st * 1024 + (ob ^ (((ob >> 9) & 1) << 5)); }
__device__ __forceinline__ void stage_rc(int b, int& R, int& C) { const int st = b / 1024, sb = b % 1024, swz = sb ^ (((sb >> 9) & 1) << 5); R = (st >> 1) * 16 + swz / 64; C = (st & 1) * 32 + (swz % 64) / 2; }
struct GUnit { int pm, pn, brow0, e; };
__device__ __forceinline__ int unit_index(int i, int c, int G, int total) {
  const int x = c & 7, j = c >> 3, q = total >> 3, r = total & 7;
  const int start = x < r ? x * (q + 1) : r * (q + 1) + (x - r) * q;
  const int size = q + (x < r ? 1 : 0);
  const int li = i * (G >> 3) + j;
  return li < size ? start + li : -1;
}

__device__ __forceinline__ f32x4 mma16(bf16x8 a, bf16x8 b, f32x4 c) { return __builtin_amdgcn_mfma_f32_16x16x32_bf16(a, b, c, 0, 0, 0); }
__device__ __forceinline__ i32x4 mma16(i32x4 a, i32x4 b, i32x4 c) { return __builtin_amdgcn_mfma_i32_16x16x64_i8(a, b, c, 0, 0, 0); }
template <bool I8, bool GATHER, class Sched, class Epi>
__device__ __forceinline__ void gemm_stream(LAS unsigned char* lds, const void* Abase, const void* Btbase, const Sched& S, const Epi& E, const int* slt = nullptr) {
  typedef typename std::conditional<I8, i32x4, f32x4>::type AccT;
  typedef typename std::conditional<I8, i32x4, bf16x8>::type FragT;
  constexpr int KB = I8 ? KD : KD * 2;
  const int tid = tid_opaque(), wid = __builtin_amdgcn_readfirstlane(tid >> 6), lane = tid & 63, wr = wid >> 2, wc = wid & 3, fr = lane & 15, fq = lane >> 4;
  constexpr int nt = KB / 128;
  int R[2], C[2];
  unsigned voffB[2];
#pragma unroll
  for (int i = 0; i < 2; ++i) { stage_rc(tid * 16 + i * 8192, R[i], C[i]); voffB[i] = (unsigned)(R[i] * KB + C[i] * 2); }
#define voffA voffB
  constexpr size_t kstep = (size_t)(BK * 2);
  constexpr size_t hstep = (size_t)HALF * KB;
  const unsigned ldsw = (unsigned)wid * 1024u;
  const int aoff = lds_byte(wr * 64 + fr, fq * 8), boff = lds_byte(wc * 32 + fr, fq * 8);
#define G8_SA(b, h) (((b) * 2 + (h)) * HTB)
#define G8_SB(b, h) ((4 + (b) * 2 + (h)) * HTB)
#define G8_STAGE(bufoff, gbase, v0, v1) do { \
    __builtin_amdgcn_global_load_lds((const unsigned*)((const char*)(gbase) + (v0)), (LAS unsigned*)(lds + (bufoff) + ldsw), 16, 0, 0); \
    __builtin_amdgcn_global_load_lds((const unsigned*)((const char*)(gbase) + (v1)), (LAS unsigned*)(lds + (bufoff) + ldsw + 8192), 16, 0, 0); } while (0)
#define G8_STAGEB(bufoff, gbase) G8_STAGE(bufoff, gbase, voffB[0], voffB[1])
#define G8_STAGEA_U(bufoff, base_u, hsel) G8_STAGE(bufoff, (base_u) + (hsel) * hstep, voffA[0], voffA[1])
#define G8_STAGEA_G(bufoff, koff, o0, o1) G8_STAGE(bufoff, (const char*)Abase + (koff), o0, o1)
#define G8_LDA(dst, b, h) do { _Pragma("unroll") for (int m = 0; m < 4; ++m) _Pragma("unroll") for (int k = 0; k < 2; ++k) dst[m][k] = *(const LAS FragT*)(lds + G8_SA(b, h) + aoff + m * 2048 + k * 1024); } while (0)
#define G8_LDB(dst, b, h) do { _Pragma("unroll") for (int n = 0; n < 2; ++n) _Pragma("unroll") for (int k = 0; k < 2; ++k) dst[n][k] = *(const LAS FragT*)(lds + G8_SB(b, h) + boff + n * 2048 + k * 1024); } while (0)
#define G8_MMA(ai, bj, At, Bt) do { __builtin_amdgcn_s_setprio(1); _Pragma("unroll") for (int m = 0; m < 4; ++m) _Pragma("unroll") for (int n = 0; n < 2; ++n) _Pragma("unroll") for (int k = 0; k < 2; ++k) \
    acc[ai][bj][m][n] = mma16(Bt[n][k], At[m][k], acc[ai][bj][m][n]); __builtin_amdgcn_s_setprio(0); } while (0)
#define G8_WAIT_V(n) asm volatile("s_waitcnt vmcnt(" #n ")" ::: "memory")
#define G8_WAIT_L(n) asm volatile("s_waitcnt lgkmcnt(" #n ")" ::: "memory")
#define G8_BAR __builtin_amdgcn_s_barrier()
#define G8_SCHED __builtin_amdgcn_sched_barrier(0)
  GUnit cur, nxt;
  int ui = 0;
  if (!S.next(0, cur)) return;
  AccT acc[2][2][4][2];
#pragma unroll
  for (int a = 0; a < 2; ++a)
#pragma unroll
    for (int b = 0; b < 2; ++b)
#pragma unroll
      for (int m = 0; m < 4; ++m)
#pragma unroll
        for (int n = 0; n < 2; ++n) acc[a][b][m][n] = AccT{};
  FragT At[4][2], B0[2][2], B1[2][2];
  const char* cA = (const char*)Abase + (size_t)cur.pm * (BM * KB);
  unsigned gA00 = 0, gA01 = 0, gA10 = 0, gA11 = 0, gN00 = 0, gN01 = 0, gN10 = 0, gN11 = 0;
  if (GATHER) {
    const int* sr = slt + cur.pm * BM;
    gA00 = (unsigned)sr[R[0]] * KB + C[0] * 2; gA01 = (unsigned)sr[R[1]] * KB + C[1] * 2;
    gA10 = (unsigned)sr[HALF + R[0]] * KB + C[0] * 2; gA11 = (unsigned)sr[HALF + R[1]] * KB + C[1] * 2;
  }
  const char* cB = (const char*)Btbase + (size_t)cur.brow0 * KB;
  G8_STAGEB(G8_SB(0, 0), cB);
  if (GATHER) G8_STAGEA_G(G8_SA(0, 0), 0, gA00, gA01); else G8_STAGEA_U(G8_SA(0, 0), cA, 0);
  G8_STAGEB(G8_SB(0, 1), cB + hstep);
  if (GATHER) G8_STAGEA_G(G8_SA(0, 1), 0, gA10, gA11); else G8_STAGEA_U(G8_SA(0, 1), cA, 1);
  if (wr == 1) G8_BAR;
  G8_WAIT_V(4); G8_BAR;
  G8_STAGEB(G8_SB(1, 0), cB + kstep);
  if (GATHER) G8_STAGEA_G(G8_SA(1, 0), kstep, gA00, gA01); else G8_STAGEA_U(G8_SA(1, 0), cA + kstep, 0);
  G8_STAGEB(G8_SB(1, 1), cB + hstep + kstep);
  G8_WAIT_V(6); G8_BAR;
  for (;;) {
    const bool has_next = S.next(ui + 1, nxt);
    const char* nA = has_next ? (const char*)Abase + (size_t)nxt.pm * (BM * KB) : cA;
    if (GATHER) {
      if (has_next) {
        const int* sr = slt + nxt.pm * BM;
        gN00 = (unsigned)sr[R[0]] * KB + C[0] * 2; gN01 = (unsigned)sr[R[1]] * KB + C[1] * 2;
        gN10 = (unsigned)sr[HALF + R[0]] * KB + C[0] * 2; gN11 = (unsigned)sr[HALF + R[1]] * KB + C[1] * 2;
      } else { gN00 = gA00; gN01 = gA01; gN10 = gA10; gN11 = gA11; }
    }
    const char* nB = has_next ? (const char*)Btbase + (size_t)nxt.brow0 * KB : cB;
#pragma unroll 1
    for (int t = 0; t < nt; t += 2) {
      const bool last = (t == nt - 2);
      const char* a1 = cA + (size_t)(t + 1) * kstep;
      const char* a2 = last ? nA : cA + (size_t)(t + 2) * kstep;
      const char* b2 = last ? nB : cB + (size_t)(t + 2) * kstep;
      const char* a3 = a2 + kstep;
      const char* b3 = b2 + kstep;
      const size_t k1 = (size_t)(t + 1) * kstep, k2 = last ? 0 : (size_t)(t + 2) * kstep, k3 = k2 + kstep;
      const unsigned w00 = last ? gN00 : gA00, w01 = last ? gN01 : gA01, w10 = last ? gN10 : gA10, w11 = last ? gN11 : gA11;
      G8_LDB(B0, 0, 0); G8_SCHED; G8_LDA(At, 0, 0); if (GATHER) G8_STAGEA_G(G8_SA(1, 1), k1, gA10, gA11); else G8_STAGEA_U(G8_SA(1, 1), a1, 1);
      G8_WAIT_L(8); G8_BAR; G8_WAIT_L(0); G8_MMA(0, 0, At, B0); G8_BAR; G8_SCHED;
      G8_LDB(B1, 0, 1); G8_STAGEB(G8_SB(0, 0), b2);
      G8_BAR; G8_WAIT_L(0); G8_MMA(0, 1, At, B1); G8_BAR;
      G8_LDA(At, 0, 1); if (GATHER) G8_STAGEA_G(G8_SA(0, 0), k2, w00, w01); else G8_STAGEA_U(G8_SA(0, 0), a2, 0);
      G8_BAR; G8_WAIT_L(0); G8_MMA(1, 0, At, B0); G8_BAR; G8_SCHED;
      G8_STAGEB(G8_SB(0, 1), b2 + hstep);
      G8_WAIT_V(6); G8_BAR; G8_MMA(1, 1, At, B1); G8_BAR;
      G8_LDB(B0, 1, 0); G8_SCHED; G8_LDA(At, 1, 0); if (GATHER) G8_STAGEA_G(G8_SA(0, 1), k2, w10, w11); else G8_STAGEA_U(G8_SA(0, 1), a2, 1);
      G8_WAIT_L(8); G8_BAR; G8_WAIT_L(0); G8_MMA(0, 0, At, B0); G8_BAR; G8_SCHED;
      G8_LDB(B1, 1, 1); G8_STAGEB(G8_SB(1, 0), b3);
      G8_BAR; G8_WAIT_L(0); G8_MMA(0, 1, At, B1); G8_BAR;
      G8_LDA(At, 1, 1); if (GATHER) G8_STAGEA_G(G8_SA(1, 0), k3, w00, w01); else G8_STAGEA_U(G8_SA(1, 0), a3, 0);
      G8_BAR; G8_WAIT_L(0); G8_MMA(1, 0, At, B0); G8_BAR; G8_SCHED;
      G8_STAGEB(G8_SB(1, 1), b3 + hstep);
      G8_WAIT_V(6); G8_BAR; G8_MMA(1, 1, At, B1); G8_BAR;
    }
    E(acc, cur, wr, wc, fr, fq);
    if (!has_next) break;
#pragma unroll
    for (int a = 0; a < 2; ++a)
#pragma unroll
      for (int b = 0; b < 2; ++b)
#pragma unroll
        for (int m = 0; m < 4; ++m)
#pragma unroll
          for (int n = 0; n < 2; ++n) acc[a][b][m][n] = AccT{};
    cur = nxt; cA = nA; cB = nB; ++ui;
    gA00 = gN00; gA01 = gN01; gA10 = gN10; gA11 = gN11;
  }
  G8_WAIT_V(0);
  if (wr == 0) G8_BAR;
  G8_BAR;
#undef G8_SA
#undef G8_SB
#undef G8_STAGE
#undef G8_STAGEB
#undef G8_STAGEA_U
#undef G8_STAGEA_G
#undef voffA
#undef G8_LDA
#undef G8_LDB
#undef G8_MMA
#undef G8_WAIT_V
#undef G8_WAIT_L
#undef G8_BAR
#undef G8_SCHED
}

struct DenseSched {
  int nM, nN, G, c;
  __device__ __forceinline__ bool next(int i, GUnit& u) const {
    const int idx = unit_index(i, c, G, nM * nN);
    if (idx < 0) return false;
    u.pm = idx / nN; u.pn = idx - u.pm * nN; u.brow0 = u.pn * BM; u.e = 0;
    return true;
  }
};
struct MoeSched {
  const int* toff; int nN, NE, G, c;
  __device__ __forceinline__ bool next(int i, GUnit& u) const {
    const int idx = unit_index(i, c, G, toff[32] * nN);
    if (idx < 0) return false;
    u.pm = idx / nN; u.pn = idx - u.pm * nN;
    const int e = toff[128 + u.pm];
    u.e = e; u.brow0 = e * NE + u.pn * BM;
    return true;
  }
};
}

struct EpiInProj {
  bfr* P; const float* SCL; const float* sw;
  __device__ __forceinline__ void operator()(const i32x4 (&acc)[2][2][4][2], const g8::GUnit& u, int wr, int wc, int fr, int fq) const {
    const int row0 = u.pm * 256 + wr * 64 + fr, col0 = u.pn * 256 + wc * 32 + 8 * fq;
    f32x4 cs[2][2];
#pragma unroll
    for (int bj = 0; bj < 2; ++bj)
#pragma unroll
      for (int n = 0; n < 2; ++n) cs[bj][n] = *(const f32x4*)(sw + col0 + bj * 128 + n * 4);
    float sav[2][4];
#pragma unroll
    for (int ai = 0; ai < 2; ++ai)
#pragma unroll
      for (int m = 0; m < 4; ++m) sav[ai][m] = SCL[row0 + ai * 128 + m * 16];
#pragma unroll
    for (int ai = 0; ai < 2; ++ai)
#pragma unroll
      for (int m = 0; m < 4; ++m) {
        const int row = row0 + ai * 128 + m * 16;
        const float sa = sav[ai][m];
        bfr* rowp = P + (size_t)row * PINP + col0;
#pragma unroll
        for (int bj = 0; bj < 2; ++bj) {
          const i32x4 a0 = acc[ai][bj][m][0], a1 = acc[ai][bj][m][1];
          f32x4 o0 = {(float)a0[0], (float)a0[1], (float)a0[2], (float)a0[3]};
          f32x4 o1 = {(float)a1[0], (float)a1[1], (float)a1[2], (float)a1[3]};
          o0 = o0 * (cs[bj][0] * sa); o1 = o1 * (cs[bj][1] * sa);
          *(bf16x8*)(rowp + bj * 128) = pack8(o0, o1);
        }
      }
  }
};
__device__ __forceinline__ void phase_gemm_in(PP pp, int l, int bid, int nb, char* smem) {
  g8::DenseSched S{130, 14, nb, bid};
  EpiInProj E{(bfr*)(p.ws + OFF_P), (const float*)(p.ws + OFF_SCL), (const float*)(p.ws + OFF_SWIN) + (size_t)l * PINP};
  g8::gemm_stream<true, false>((LAS unsigned char*)smem, p.ws + OFF_H, p.ws + OFF_W + (size_t)l * WL_SIZE + WL_IN, S, E);
}

struct EpiOutProj {
  const float *xl, *xc, *mods; float *ol, *oc;
  __device__ __forceinline__ void operator()(const f32x4 (&acc)[2][2][4][2], const g8::GUnit& u, int wr, int wc, int fr, int fq) const {
    const bool lat = u.pm < 128;
    const float* xin = lat ? xl + (size_t)u.pm * 256 * 1024 : xc + (size_t)(u.pm - 128) * 256 * 1024;
    float* xo = lat ? ol + (size_t)u.pm * 256 * 1024 : oc + (size_t)(u.pm - 128) * 256 * 1024;
    const float* g1 = mods + (size_t)(lat ? (u.pm >> 6) : 2) * 6144 + 2048;
    const int row0 = wr * 64 + fr, col0 = u.pn * 256 + wc * 32 + 4 * fq;
#pragma unroll
    for (int bj = 0; bj < 2; ++bj)
#pragma unroll
      for (int n = 0; n < 2; ++n) {
        const f32x4 gv = *(const f32x4*)(g1 + col0 + bj * 128 + n * 16);
        f32x4 xv[2][4];
#pragma unroll
        for (int ai = 0; ai < 2; ++ai)
#pragma unroll
          for (int m = 0; m < 4; ++m) xv[ai][m] = *(const f32x4*)(xin + (size_t)(row0 + ai * 128 + m * 16) * 1024 + col0 + bj * 128 + n * 16);
#pragma unroll
        for (int ai = 0; ai < 2; ++ai)
#pragma unroll
          for (int m = 0; m < 4; ++m)
            *(f32x4*)(xo + (size_t)(row0 + ai * 128 + m * 16) * 1024 + col0 + bj * 128 + n * 16) = xv[ai][m] + gv * acc[ai][bj][m][n];
        asm volatile("" ::: "memory");
      }
  }
};
__device__ __forceinline__ void phase_gemm_out(PP pp, int l, int bid, int nb, char* smem) {
  g8::DenseSched S{(l == 0) ? 130 : 128, 4, nb, bid};
  EpiOutProj E{(l == 0) ? p.x : p.out, (l == 0) ? p.ctx : (const float*)(p.ws + OFF_CTX),
               (const float*)(p.ws + OFF_MODS) + (size_t)l * 3 * 6144, p.out, (float*)(p.ws + OFF_CTX)};
  g8::gemm_stream<false, false>((LAS unsigned char*)smem, p.ws + OFF_CC, p.ws + OFF_W + (size_t)l * WL_SIZE + WL_OUT, S, E);
}

#define LBAR() do { asm volatile("s_waitcnt lgkmcnt(0)" ::: "memory"); __builtin_amdgcn_s_barrier(); asm volatile("" ::: "memory"); } while (0)
__device__ __forceinline__ void phase_prep(PP pp, int l, int bid, int nb, char* smem) {
  const int tid = tid_opaque(), lane = tid & 63, wv = wave_id(tid);
  const bfr* P = (const bfr*)(p.ws + OFF_P);
  char* S = p.ws + OFF_S;
  bfr* QN = (bfr*)(S + S_QN);
  bfr* KN = (bfr*)(S + S_KN);
  bfr* VT = (bfr*)(S + S_VT);
  bfr* RWR = (bfr*)(S + S_RWR);
  bfr* RWKK = (bfr*)(S + S_RWKK);
  bfr* RWV = (bfr*)(S + S_RWV);
  bfr* RWG = (bfr*)(S + S_RWG);
  float* RWW = (float*)(S + S_RWW);
  bfr* RWKD = (bfr*)(S + S_RWKD);
  bfr* RWB = (bfr*)(S + S_RWB);
  float* BON = (float*)(S + S_BON);
  bfr* GDQ = (bfr*)(S + S_GDQ);
  bfr* GDK = (bfr*)(S + S_GDK);
  bfr* GDV = (bfr*)(S + S_GDV);
  float* GDAB = (float*)(S + S_GDAB);
  const float* mu = p.rw_mu + (size_t)l * 896;
  const float* w0 = p.rw_w0 + (size_t)l * 512;
  const float* w_up = p.rw_w_up + (size_t)l * 2 * 32 * 256;
  const float* a0 = p.rw_a0 + (size_t)l * 512;
  const float* a_up = p.rw_a_up + (size_t)l * 2 * 32 * 256;
  const float* g_up = p.rw_g_up + (size_t)l * 64 * 256;
  const float* k_k = p.rw_k_k + (size_t)l * 256;
  const float* k_a = p.rw_k_a + (size_t)l * 256;
  const float* r_k = p.rw_r_k + (size_t)l * 256;
  const float* conv_w = p.gd_conv_w + (size_t)l * 5 * 768;
  const float* A_log = p.gd_A_log + (size_t)l * 8;
  const float* dt_bias = p.gd_dt_bias + (size_t)l * 8;
  const float* qg = p.na_q_gain + (size_t)l * 64;
  const float* kg = p.na_k_gain + (size_t)l * 64;

  bfr* wl = (bfr*)smem;
  float* lor = (float*)(smem + 192 * 256 * 2);
  __syncthreads();
  for (int i = tid; i < 192 * 256; i += NTHR) {
    const int row = i >> 8, c = i & 255;
    const float v = row < 64 ? g_up[row * 256 + c] : row < 128 ? w_up[(row - 64) * 256 + c] : a_up[(row - 128) * 256 + c];
    wl[i] = f2bf(v);
  }
  __syncthreads();

  for (int tile = bid; tile < NTOK / 16; tile += nb) {
    const int m0 = tile * 16;
    int seq_lo, seq_hi, bb, tau0;
    if (m0 < NLAT) { bb = m0 >> 14; seq_lo = bb << 14; seq_hi = seq_lo + SEQ; tau0 = m0 - seq_lo; }
    else { bb = (m0 - NLAT) >> 8; seq_lo = NLAT + (bb << 8); seq_hi = seq_lo + CTXL; tau0 = SEQ + (m0 - seq_lo); }
    const f32x4 z4 = {0.f, 0.f, 0.f, 0.f};
    int tid_t = tid; asm volatile("" : "+v"(tid_t));
    const int lane_t = tid_t & 63;
    const int cb = lane_t * 4, hh = lane_t >> 4;
    const int lg = tid_t & 31, lt = tid_t >> 5;
    const int sl = lane_t >> 4, sc4 = (lane_t & 15) * 4;
    asm volatile("" ::: "memory");
    const f32x4 mur = *(const f32x4*)(mu + cb), muk = *(const f32x4*)(mu + 256 + cb), muv = *(const f32x4*)(mu + 512 + cb);
    const f32x4 mul = *(const f32x4*)(mu + 768 + lg * 4);

    f32x4 pr[3][4], pl[3];
    {
      const int mt0 = m0 + 2 * wv;
#pragma unroll
      for (int j = 0; j < 3; ++j)
#pragma unroll
        for (int t = 0; t < 4; ++t) {
          const int m = mt0 - 1 + t;
          const int mc = min(max(m, seq_lo), seq_hi - 1);
          const f32x4 ld = ldbf4(P + (size_t)mc * PINP + A_END + j * 256 + cb);
          pr[j][t] = (m == mc) ? ld : z4;
        }
#pragma unroll
      for (int t = 0; t < 3; ++t) {
        const int m = m0 + lt - 1 + t;
        const int mc = min(max(m, seq_lo), seq_hi - 1);
        const f32x4 ld = ldbf4(P + (size_t)mc * PINP + A_END + 768 + lg * 4);
        pl[t] = (m == mc) ? ld : z4;
      }
    }
    {
      const f32x4 v = pl[1] + mul * (0.5f * (pl[0] + pl[2]) - pl[1]);
#pragma unroll
      for (int i = 0; i < 4; ++i) {
        const int ch = lg * 4 + i;
        lor[ch * 16 + lt] = ch < 32 ? tanhf(v[i]) : ch < 64 ? v[i] : sigmoidf_(v[i]);
      }
    }
    f32x4 rr[2], rk[2], rv[2];
#pragma unroll
    for (int t = 0; t < 2; ++t) {
      rr[t] = pr[0][t + 1] + mur * (0.5f * (pr[0][t] + pr[0][t + 2]) - pr[0][t + 1]);
      rk[t] = pr[1][t + 1] + muk * (0.5f * (pr[1][t] + pr[1][t + 2]) - pr[1][t + 1]);
      rv[t] = pr[2][t + 1] + muv * (0.5f * (pr[2][t] + pr[2][t + 2]) - pr[2][t + 1]);
    }
    LBAR();
    f32x4 pg[20];
    const bool is_gd = wv < 3, is_na = (wv >= 3 && wv < 7);
    const int sec = is_gd ? wv * 4 + sl : (wv - 3) * 4 + sl;
    if (is_gd) {
#pragma unroll
      for (int t = 0; t < 20; ++t) {
        const int m = m0 - 2 + t;
        const int mc = min(max(m, seq_lo), seq_hi - 1);
        const f32x4 ld = ldbf4(P + (size_t)mc * PINP + B_END + sec * 64 + sc4);
        pg[t] = (m == mc) ? ld : z4;
      }
    } else if (is_na) {
#pragma unroll
      for (int t = 0; t < 16; ++t) pg[t] = ldbf4(P + (size_t)(m0 + t) * PINP + sec * 64 + sc4);
#pragma unroll
      for (int t = 16; t < 20; ++t) pg[t] = z4;
    } else {
#pragma unroll
      for (int t = 0; t < 20; ++t) pg[t] = z4;
    }
    asm volatile("" ::: "memory");
    {
      f32x4 gacc[2], wa0[2], wa1[2], aa0[2], aa1[2];
#pragma unroll
      for (int t = 0; t < 2; ++t) { gacc[t] = z4; wa0[t] = z4; wa1[t] = z4; aa0[t] = z4; aa1[t] = z4; }
#pragma unroll 4
      for (int j = 0; j < 64; ++j) {
        const bf16x4 wq = *(const bf16x4*)(wl + j * 256 + cb);
        const f32x4 wgt = {bf2f(wq[0]), bf2f(wq[1]), bf2f(wq[2]), bf2f(wq[3])};
        const float2 sv = *(const float2*)(lor + (64 + j) * 16 + 2 * wv);
        gacc[0] += wgt * sv.x; gacc[1] += wgt * sv.y;
      }
#pragma unroll 2
      for (int j = 0; j < 32; ++j) {
        const bf16x4 q0 = *(const bf16x4*)(wl + (64 + j) * 256 + cb), q1 = *(const bf16x4*)(wl + (96 + j) * 256 + cb);
        const bf16x4 q2 = *(const bf16x4*)(wl + (128 + j) * 256 + cb), q3 = *(const bf16x4*)(wl + (160 + j) * 256 + cb);
        const f32x4 ww0 = {bf2f(q0[0]), bf2f(q0[1]), bf2f(q0[2]), bf2f(q0[3])}, ww1 = {bf2f(q1[0]), bf2f(q1[1]), bf2f(q1[2]), bf2f(q1[3])};
        const f32x4 aw0 = {bf2f(q2[0]), bf2f(q2[1]), bf2f(q2[2]), bf2f(q2[3])}, aw1 = {bf2f(q3[0]), bf2f(q3[1]), bf2f(q3[2]), bf2f(q3[3])};
        const float2 tv = *(const float2*)(lor + j * 16 + 2 * wv);
        const float2 dv = *(const float2*)(lor + (32 + j) * 16 + 2 * wv);
        wa0[0] += ww0 * tv.x; wa0[1] += ww0 * tv.y; wa1[0] += ww1 * tv.x; wa1[1] += ww1 * tv.y;
        aa0[0] += aw0 * dv.x; aa0[1] += aw0 * dv.y; aa1[0] += aw1 * dv.x; aa1[1] += aw1 * dv.y;
      }
      asm volatile("" ::: "memory");
      const f32x4 kkc = *(const f32x4*)(k_k + cb), kac = *(const f32x4*)(k_a + cb), rkc = *(const f32x4*)(r_k + cb);
      const f32x4 w00 = *(const f32x4*)(w0 + cb), w01 = *(const f32x4*)(w0 + 256 + cb), a00 = *(const f32x4*)(a0 + cb), a01 = *(const f32x4*)(a0 + 256 + cb);
#pragma unroll
      for (int t = 0; t < 2; ++t) {
        const int m = m0 + 2 * wv + t;
        const f32x4 r = rr[t], k = rk[t], v = rv[t];
        const f32x4 kkraw = k * kkc;
        const float ssum = row16_sum((kkraw[0] * kkraw[0] + kkraw[1] * kkraw[1]) + (kkraw[2] * kkraw[2] + kkraw[3] * kkraw[3]));
        const f32x4 kk = kkraw * rsqrtf(ssum + 1e-6f);
        float bon = 0.f;
#pragma unroll
        for (int d = 0; d < 2; ++d) {
          const f32x4 wlin = d == 0 ? w00 + wa0[t] : w01 + wa1[t];
          const f32x4 alin = d == 0 ? a00 + aa0[t] : a01 + aa1[t];
          f32x4 lw, kd, bv;
#pragma unroll
          for (int i = 0; i < 4; ++i) {
            const float w_log = -softplusf_(-wlin[i]) - 0.5f;
            const float a = sigmoidf_(alin[i]);
            lw[i] = -__expf(w_log);
            kd[i] = k[i] * (1.f + (a - 1.f) * kac[i]);
            bv[i] = kk[i] * a;
            bon += r[i] * kd[i] * rkc[i];
          }
          const size_t o = ((size_t)d * NTOK + m) * 256 + cb;
          *(f32x4*)(RWW + o) = lw; *(bf16x4*)(RWKD + o) = pack4(kd[0], kd[1], kd[2], kd[3]); *(bf16x4*)(RWB + o) = pack4(bv[0], bv[1], bv[2], bv[3]);
        }
        bon = row16_sum(bon);
        const size_t o = (size_t)m * 256 + cb;
        *(bf16x4*)(RWR + o) = pack4(r[0], r[1], r[2], r[3]); *(bf16x4*)(RWKK + o) = pack4(kk[0], kk[1], kk[2], kk[3]);
        *(bf16x4*)(RWV + o) = pack4(v[0], v[1], v[2], v[3]); *(bf16x4*)(RWG + o) = pack4(gacc[t][0], gacc[t][1], gacc[t][2], gacc[t][3]);
        if ((lane_t & 15) == 0) BON[(size_t)m * 4 + hh] = bon;
      }
    }
    if (is_gd) {
      f32x4 cw[5];
#pragma unroll
      for (int j = 0; j < 5; ++j) cw[j] = *(const f32x4*)(conv_w + j * 768 + sec * 64 + sc4);
#pragma unroll
      for (int t = 0; t < 16; ++t) {
        f32x4 acc = z4;
#pragma unroll
        for (int j = 0; j < 5; ++j) acc += cw[j] * pg[t + j];
        f32x4 val = {siluf_(acc[0]), siluf_(acc[1]), siluf_(acc[2]), siluf_(acc[3])};
        const int m = m0 + t;
        if (sec < 8) {
          const float ss = row16_sum((val[0] * val[0] + val[1] * val[1]) + (val[2] * val[2] + val[3] * val[3]));
          val = val * rsqrtf(ss + 1e-6f);
          if (sec < 4) { const f32x4 vq = val * 0.125f; *(bf16x4*)(GDQ + (size_t)m * 256 + sec * 64 + sc4) = pack4(vq[0], vq[1], vq[2], vq[3]); }
          else *(bf16x4*)(GDK + (size_t)m * 256 + (sec - 4) * 64 + sc4) = pack4(val[0], val[1], val[2], val[3]);
        } else *(bf16x4*)(GDV + (size_t)m * 256 + (sec - 8) * 64 + sc4) = pack4(val[0], val[1], val[2], val[3]);
      }
    } else if (is_na) {
      const f32x4 gq = *(const f32x4*)(qg + sc4) * (0.125f * 1.4426950408889634f), gk = *(const f32x4*)(kg + sc4);
#pragma unroll
      for (int t = 0; t < 16; ++t) {
        f32x4 val = pg[t];
        const float ss = row16_sum((val[0] * val[0] + val[1] * val[1]) + (val[2] * val[2] + val[3] * val[3]));
        val = val * rsqrtf(ss * (1.f / 64.f) + 1e-6f);
        const int m = m0 + t;
        if (sec < 8) { const f32x4 o = val * gq; *(bf16x4*)(QN + (size_t)m * 512 + sec * 64 + sc4) = pack4(o[0], o[1], o[2], o[3]); }
        else { const f32x4 o = val * gk; *(bf16x4*)(KN + (size_t)m * 512 + (sec - 8) * 64 + sc4) = pack4(o[0], o[1], o[2], o[3]); }
      }
    }
    if (tid_t < 256) {
      const int t = tid_t >> 4, j = tid_t & 15;
      const int m = m0 + t;
      const float pv = bf2f((short)P[(size_t)m * PINP + B_END + 1024 + j]);
      float o;
      if (j < 8) o = -__expf(A_log[j]) * softplusf_(pv + dt_bias[j]);
      else o = sigmoidf_(pv);
      GDAB[(size_t)m * 16 + j] = o;
    }
    {
      const int vc = (tid_t & 127) * 4, tq = (tid_t >> 7) * 4;
      f32x4 pv[4];
#pragma unroll
      for (int t = 0; t < 4; ++t) pv[t] = ldbf4(P + (size_t)(m0 + tq + t) * PINP + 1024 + vc);
#pragma unroll
      for (int i = 0; i < 4; ++i) {
        const int hd = vc + i;
        bfr* dst = VT + ((size_t)(bb * 8 + (hd >> 6)) * (TTOK / 16) + (tau0 >> 4)) * 1024 + (hd & 63) * 16 + tq;
        *(bf16x4*)dst = pack4(pv[0][i], pv[1][i], pv[2][i], pv[3][i]);
      }
    }
    LBAR();
  }
  __syncthreads();
}

__device__ __forceinline__ int scan_tok(int b, int d, int s) {
  if (s < CTXL) { int t = d ? (CTXL - 1 - s) : s; return NLAT + b * CTXL + t; }
  int u = s - CTXL; int t = d ? (SEQ - 1 - u) : u; return b * SEQ + t;
}
#define CS 72
#define SLOT_BYTES (64 * CS * 2)
#define F0_STRIDE 68
#define X1_F0 (13 * SLOT_BYTES)
#define X1_ARR (X1_F0 + 64 * F0_STRIDE * 4)

#define MM_FRAGS(As, Bs, a0, a1, b00, b01, b10, b11)                                                     \
  const bf16x8 a0 = *(const bf16x8*)((As) + ((mt * 16 + fr) * CS + fq * 8) * 2);                         \
  const bf16x8 a1 = *(const bf16x8*)((As) + ((mt * 16 + fr) * CS + 32 + fq * 8) * 2);                    \
  const bf16x8 b00 = *(const bf16x8*)((Bs) + ((nt0 * 16 + fr) * CS + fq * 8) * 2);                       \
  const bf16x8 b01 = *(const bf16x8*)((Bs) + ((nt0 * 16 + fr) * CS + 32 + fq * 8) * 2);                  \
  const bf16x8 b10 = *(const bf16x8*)((Bs) + ((nt0 * 16 + 16 + fr) * CS + fq * 8) * 2);                  \
  const bf16x8 b11 = *(const bf16x8*)((Bs) + ((nt0 * 16 + 16 + fr) * CS + 32 + fq * 8) * 2);
#define MM_2TILES(acc0, acc1, a0, a1, b00, b01, b10, b11)                                                \
  acc0 = __builtin_amdgcn_mfma_f32_16x16x32_bf16(a0, b00, acc0, 0, 0, 0);                                \
  acc0 = __builtin_amdgcn_mfma_f32_16x16x32_bf16(a1, b01, acc0, 0, 0, 0);                                \
  acc1 = __builtin_amdgcn_mfma_f32_16x16x32_bf16(a0, b10, acc1, 0, 0, 0);                                \
  acc1 = __builtin_amdgcn_mfma_f32_16x16x32_bf16(a1, b11, acc1, 0, 0, 0);
__device__ __forceinline__ void wr_T(char* slot, int mt, int nt, int fr, int fq, f32x4 v) {
  *(bf16x4*)(slot + ((nt * 16 + fr) * CS + mt * 16 + 4 * fq) * 2) = pack4(v[0], v[1], v[2], v[3]);
}

struct ChunkIn { float lw[8], f0[8], f1[8], f2[8], f3[8], xv[8], be[8]; };
template <bool GDN>
__device__ __forceinline__ void chunk_load(PP pp, int t, ChunkIn& ci) {
  const int tid = tid_opaque(), c = tid & 63, tg = wave_id(tid);
  const int chain = t / NCHUNK, n = t - chain * NCHUNK;
  const int d = chain & 1, h = (chain >> 1) & 3, b = (chain >> 3) & 1;
  const char* S = p.ws + OFF_S;
#pragma unroll
  for (int u = 0; u < 8; ++u) {
    const int m = scan_tok(b, d, n * 64 + tg * 8 + u);
    const size_t o = (size_t)m * 256 + h * 64 + c;
    if (!GDN) {
      ci.lw[u] = ((const float*)(S + S_RWW))[(size_t)d * NTOK * 256 + o];
      ci.f0[u] = ldbf1((const bfr*)(S + S_RWKK), o);
      ci.f1[u] = ldbf1((const bfr*)(S + S_RWB), (size_t)d * NTOK * 256 + o);
      ci.f2[u] = ldbf1((const bfr*)(S + S_RWKD), (size_t)d * NTOK * 256 + o);
      ci.f3[u] = ldbf1((const bfr*)(S + S_RWR), o);
      ci.xv[u] = ldbf1((const bfr*)(S + S_RWV), o);
      ci.be[u] = 1.f;
    } else {
      ci.lw[u] = ((const float*)(S + S_GDAB))[(size_t)m * 16 + d * 4 + h];
      ci.be[u] = ((const float*)(S + S_GDAB))[(size_t)m * 16 + 8 + d * 4 + h];
      ci.f0[u] = ldbf1((const bfr*)(S + S_GDK), o);
      ci.f3[u] = ldbf1((const bfr*)(S + S_GDQ), o);
      ci.xv[u] = ldbf1((const bfr*)(S + S_GDV), o);
      ci.f1[u] = 0.f; ci.f2[u] = 0.f;
    }
  }
}
template <bool GDN>
__device__ __forceinline__ void chunk_prep_task(PP pp, int t, int t_next, bool has_next, const ChunkIn& ci, ChunkIn& nx, char* smem) {
  const int chain = t / NCHUNK, n = t - chain * NCHUNK;
  const int d = chain & 1, h = (chain >> 1) & 3, b = (chain >> 3) & 1;
  (void)b; (void)d; (void)h;
  const int tid = tid_opaque(), lane = tid & 63, wv = wave_id(tid);
  const int fr = lane & 15, fq = lane >> 4, mt = wv >> 1, nt0 = (wv & 1) * 2;
  char* S = p.ws + OFF_S;
  char* CH = p.ws + OFF_CH;
  const size_t cc = (size_t)chain * NCHUNK + n;
  char* const p0 = smem;
  char* const p1 = smem + 1 * SLOT_BYTES;
  char* const p2 = smem + 2 * SLOT_BYTES;
  char* const p3 = smem + 3 * SLOT_BYTES;
  char* const p4 = smem + 4 * SLOT_BYTES;
  char* const p5 = smem + 5 * SLOT_BYTES;
  char* const p6 = smem + 6 * SLOT_BYTES;
  char* const p7 = smem + 7 * SLOT_BYTES;
  char* const p8 = smem + 8 * SLOT_BYTES;
  char* const p9 = smem + 9 * SLOT_BYTES;
  char* const p10 = smem + 10 * SLOT_BYTES;
  char* const p11 = smem + 11 * SLOT_BYTES;
  char* const p12 = smem + 12 * SLOT_BYTES;
  float* const F0 = (float*)(smem + X1_F0);
  float* const Lv = (float*)(smem + X1_ARR);
  float* const Lm1v = Lv + 64;
  float* const betav = Lv + 128;
  float* const eLv = Lv + 192;
  float* const gC = Lv + 256;
  float* const gsum = Lv + 320;
  char* const sKt = p0;
  char* const sBh = GDN ? p0 : p1;
  char* const sKh = GDN ? p0 : p2;

  {
    const int c = lane, tg = wv;
    const float* lw = ci.lw; const float* f0 = ci.f0; const float* f1 = ci.f1; const float* f2 = ci.f2; const float* f3 = ci.f3; const float* xv = ci.xv; const float* be = ci.be;
    float cum[8];
    cum[0] = lw[0];
#pragma unroll
    for (int u = 1; u < 8; ++u) cum[u] = cum[u - 1] + lw[u];
    gsum[tg * 64 + c] = cum[7];
    LBAR();
    float off = 0.f, LC = 0.f;
#pragma unroll
    for (int g2 = 0; g2 < 8; ++g2) { const float gs = gsum[g2 * 64 + c]; LC += gs; off += (g2 < tg) ? gs : 0.f; }
    bf16x8 vKtT, vBbT, vKbT, vXT;
#pragma unroll
    for (int u = 0; u < 8; ++u) {
      const int t = tg * 8 + u;
      const float L = off + cum[u], Lm1 = L - lw[u];
      if (!GDN) {
        const float eLm1 = __expf(Lm1), enL = __expf(-L), eL = __expf(L), eCL = __expf(LC - L);
        const float kt = f0[u] * eLm1;
        *(bfr*)(p0 + (t * CS + c) * 2) = f2bf(kt);
        *(bfr*)(p1 + (t * CS + c) * 2) = f2bf(f1[u] * enL);
        *(bfr*)(p2 + (t * CS + c) * 2) = f2bf(f2[u] * enL);
        *(bfr*)(p3 + (t * CS + c) * 2) = f2bf(f3[u] * eL);
        vKtT[u] = (short)f2bf(kt);
        vBbT[u] = (short)f2bf(f1[u] * eCL);
        vKbT[u] = (short)f2bf(f2[u] * eCL);
        vXT[u] = (short)f2bf(xv[u]);
      } else {
        *(bfr*)(p0 + (t * CS + c) * 2) = f2bf(f0[u]);
        *(bfr*)(p3 + (t * CS + c) * 2) = f2bf(f3[u]);
        vKtT[u] = (short)f2bf(f0[u] * __expf(Lm1));
        vBbT[u] = (short)f2bf(be[u] * f0[u] * __expf(LC - Lm1));
        vKbT[u] = (short)f2bf(f0[u] * __expf(LC - L));
        vXT[u] = (short)f2bf(be[u] * xv[u]);
        if (c == 0) { Lv[t] = L; Lm1v[t] = Lm1; betav[t] = be[u]; eLv[t] = __expf(L); }
      }
    }
    *(bf16x8*)(p4 + (c * CS + tg * 8) * 2) = vKtT;
    *(bf16x8*)(p5 + (c * CS + tg * 8) * 2) = vBbT;
    *(bf16x8*)(p6 + (c * CS + tg * 8) * 2) = vKbT;
    *(bf16x8*)(p7 + (c * CS + tg * 8) * 2) = vXT;
    if (tg == 0) gC[c] = __expf(LC);
    if (!GDN && tid < 64) { Lv[tid] = 0.f; Lm1v[tid] = 0.f; betav[tid] = 1.f; eLv[tid] = 1.f; }
  }
  LBAR();
  if (has_next) chunk_load<GDN>(pp, t_next, nx);
  {
    {
      MM_FRAGS(sKt, sBh, a0, a1, b00, b01, b10, b11)
      f32x4 c0 = {0.f, 0.f, 0.f, 0.f}, c1 = c0;
      MM_2TILES(c0, c1, a0, a1, b00, b01, b10, b11)
#pragma unroll
      for (int q = 0; q < 2; ++q) {
        const int sI = (nt0 + q) * 16 + fr;
        const f32x4 cv = q ? c1 : c0;
        f32x4 o;
#pragma unroll
        for (int r = 0; r < 4; ++r) {
          const int tI = mt * 16 + 4 * fq + r;
          float v = cv[r];
          if (GDN) v *= betav[sI] * __expf(fminf(Lm1v[tI] - Lm1v[sI], 0.f));
          o[r] = (sI < tI) ? v : 0.f;
        }
        *(f32x4*)(F0 + sI * F0_STRIDE + mt * 16 + 4 * fq) = o;
        wr_T(p11, mt, nt0 + q, fr, fq, o);
      }
    }
    {
      MM_FRAGS(sKt, sKh, a0, a1, b00, b01, b10, b11)
      f32x4 c0 = {0.f, 0.f, 0.f, 0.f}, c1 = c0;
      MM_2TILES(c0, c1, a0, a1, b00, b01, b10, b11)
#pragma unroll
      for (int q = 0; q < 2; ++q) {
        const int sI = (nt0 + q) * 16 + fr;
        const f32x4 cv = q ? c1 : c0;
        f32x4 o;
#pragma unroll
        for (int r = 0; r < 4; ++r) {
          const int tI = mt * 16 + 4 * fq + r;
          float v = cv[r];
          if (GDN) v *= __expf(fminf(Lm1v[tI] - Lv[sI], 0.f));
          o[r] = (sI < tI) ? v : 0.f;
        }
        wr_T(p9, mt, nt0 + q, fr, fq, o);
      }
    }
    {
      MM_FRAGS(sBh, p3, a0, a1, b00, b01, b10, b11)
      f32x4 c0 = {0.f, 0.f, 0.f, 0.f}, c1 = c0;
      MM_2TILES(c0, c1, a0, a1, b00, b01, b10, b11)
#pragma unroll
      for (int q = 0; q < 2; ++q) {
        const int tI = (nt0 + q) * 16 + fr;
        const f32x4 cv = q ? c1 : c0;
        f32x4 o;
#pragma unroll
        for (int r = 0; r < 4; ++r) {
          const int sI = mt * 16 + 4 * fq + r;
          float v = cv[r];
          if (GDN) v *= betav[sI] * __expf(fminf(Lv[tI] - Lm1v[sI], 0.f));
          o[r] = (sI <= tI) ? v : 0.f;
        }
        wr_T(p10, mt, nt0 + q, fr, fq, o);
      }
    }
  }
  LBAR();
  if (wv < 2) {
    const int base = wv * 32, other = 32 - base, c = lane & 31;
    float tr[32];
#pragma unroll
    for (int j = 0; j < 32; ++j) tr[j] = 0.f;
#pragma unroll
    for (int ip = 15; ip >= 0; --ip) {
      const int i = 2 * ip + 1, i2 = 2 * ip;
      float a0 = (c == i) ? 1.f : 0.f, a1 = 0.f, b0 = (c == i2) ? 1.f : 0.f, b1 = 0.f;
      const float aii = F0[(base + i2) * F0_STRIDE + base + i];
#pragma unroll
      for (int jb = ((i + 1) & ~3); jb < 32; jb += 4) {
        const f32x4 a4 = *(const f32x4*)(F0 + (base + i) * F0_STRIDE + base + jb);
        const f32x4 b4 = *(const f32x4*)(F0 + (base + i2) * F0_STRIDE + base + jb);
        a0 -= a4[0] * tr[jb]; a1 -= a4[1] * tr[jb + 1]; a0 -= a4[2] * tr[jb + 2]; a1 -= a4[3] * tr[jb + 3];
        b0 -= b4[0] * tr[jb]; b1 -= b4[1] * tr[jb + 1]; b0 -= b4[2] * tr[jb + 2]; b1 -= b4[3] * tr[jb + 3];
      }
      const float ti = a0 + a1;
      const float ti2 = (b0 + b1) - aii * ti;
      tr[i] = ti; tr[i2] = ti2;
      if (lane < 32) {
        *(bfr*)(p8 + ((base + i) * CS + base + c) * 2) = f2bf(ti);
        *(bfr*)(p8 + ((base + i) * CS + other + c) * 2) = (bfr)0;
        *(bfr*)(p8 + ((base + i2) * CS + base + c) * 2) = f2bf(ti2);
        *(bfr*)(p8 + ((base + i2) * CS + other + c) * 2) = (bfr)0;
      }
    }
    if (lane < 32) {
#pragma unroll
      for (int q = 0; q < 4; ++q) {
        bf16x8 o, z;
#pragma unroll
        for (int j = 0; j < 8; ++j) { o[j] = (short)f2bf(tr[8 * q + j]); z[j] = 0; }
        *(bf16x8*)(p12 + ((base + c) * CS + base + 8 * q) * 2) = o;
        *(bf16x8*)(p12 + ((base + c) * CS + other + 8 * q) * 2) = z;
      }
    }
  }
  LBAR();
  {
    MM_FRAGS(p11, p12, a0, a1, b00, b01, b10, b11)
    f32x4 c0 = {0.f, 0.f, 0.f, 0.f}, c1 = c0;
    MM_2TILES(c0, c1, a0, a1, b00, b01, b10, b11)
    wr_T(p1, mt, nt0, fr, fq, c0);
    wr_T(p1, mt, nt0 + 1, fr, fq, c1);
  }
  LBAR();
  if (mt < 2 && nt0 == 2) {
    MM_FRAGS(p8, p1, a0, a1, b00, b01, b10, b11)
    f32x4 c0 = {0.f, 0.f, 0.f, 0.f}, c1 = c0;
    MM_2TILES(c0, c1, a0, a1, b00, b01, b10, b11)
#pragma unroll
    for (int r = 0; r < 4; ++r) {
      *(bfr*)(p8 + ((mt * 16 + 4 * fq + r) * CS + (nt0) * 16 + fr) * 2) = f2bf(-c0[r]);
      *(bfr*)(p8 + ((mt * 16 + 4 * fq + r) * CS + (nt0 + 1) * 16 + fr) * 2) = f2bf(-c1[r]);
    }
  }
  LBAR();
  {
    {
      MM_FRAGS(p8, p5, a0, a1, b00, b01, b10, b11)
      f32x4 c0 = {0.f, 0.f, 0.f, 0.f}, c1 = c0;
      MM_2TILES(c0, c1, a0, a1, b00, b01, b10, b11)
      wr_T(p11, mt, nt0, fr, fq, -c0);
      wr_T(p11, mt, nt0 + 1, fr, fq, -c1);
    }
    {
      MM_FRAGS(p8, p10, a0, a1, b00, b01, b10, b11)
      f32x4 c0 = {0.f, 0.f, 0.f, 0.f}, c1 = c0;
      MM_2TILES(c0, c1, a0, a1, b00, b01, b10, b11)
      wr_T(p12, mt, nt0, fr, fq, -c0);
      wr_T(p12, mt, nt0 + 1, fr, fq, -c1);
    }
  }
  LBAR();
  {
    {
      MM_FRAGS(p4, p11, a0, a1, b00, b01, b10, b11)
      f32x4 c0 = {0.f, 0.f, 0.f, 0.f}, c1 = c0;
      MM_2TILES(c0, c1, a0, a1, b00, b01, b10, b11)
#pragma unroll
      for (int q = 0; q < 2; ++q) {
        const int cp = (nt0 + q) * 16 + fr;
        f32x4 cv = q ? c1 : c0;
#pragma unroll
        for (int r = 0; r < 4; ++r) { const int cI = mt * 16 + 4 * fq + r; if (cI == cp) cv[r] += gC[cI]; }
        wr_T(p10, mt, nt0 + q, fr, fq, cv);
      }
    }
    {
      MM_FRAGS(p9, p11, a0, a1, b00, b01, b10, b11)
      f32x4 c0 = {0.f, 0.f, 0.f, 0.f}, c1 = c0;
      MM_2TILES(c0, c1, a0, a1, b00, b01, b10, b11)
#pragma unroll
      for (int q = 0; q < 2; ++q) {
        const int cp = (nt0 + q) * 16 + fr;
        f32x4 cv = q ? c1 : c0;
        const bf16x4 kb = *(const bf16x4*)(p6 + (cp * CS + mt * 16 + 4 * fq) * 2);
#pragma unroll
        for (int r = 0; r < 4; ++r) cv[r] += __uint_as_float(((unsigned)(unsigned short)kb[r]) << 16);
        wr_T(p8, mt, nt0 + q, fr, fq, cv);
      }
    }
    {
      MM_FRAGS(p4, p12, a0, a1, b00, b01, b10, b11)
      f32x4 c0 = {0.f, 0.f, 0.f, 0.f}, c1 = c0;
      MM_2TILES(c0, c1, a0, a1, b00, b01, b10, b11)
#pragma unroll
      for (int q = 0; q < 2; ++q) {
        const int tI = (nt0 + q) * 16 + fr;
        f32x4 cv = q ? c1 : c0;
        const bf16x4 rt = *(const bf16x4*)(p3 + (tI * CS + mt * 16 + 4 * fq) * 2);
        const float el = eLv[tI];
#pragma unroll
        for (int r = 0; r < 4; ++r) cv[r] += __uint_as_float(((unsigned)(unsigned short)rt[r]) << 16) * el;
        wr_T(p1, mt, nt0 + q, fr, fq, cv);
      }
    }
    {
      f32x4 c0 = {0.f, 0.f, 0.f, 0.f}, c1 = c0;
      {
        MM_FRAGS(sKh, p3, a0, a1, b00, b01, b10, b11)
        MM_2TILES(c0, c1, a0, a1, b00, b01, b10, b11)
      }
#pragma unroll
      for (int q = 0; q < 2; ++q) {
        const int tI = (nt0 + q) * 16 + fr;
#pragma unroll
        for (int r = 0; r < 4; ++r) {
          const int sI = mt * 16 + 4 * fq + r;
          float v = q ? c1[r] : c0[r];
          if (GDN) v *= __expf(fminf(Lv[tI] - Lv[sI], 0.f));
          v = (sI <= tI) ? v : 0.f;
          if (q) c1[r] = v; else c0[r] = v;
        }
      }
      {
        MM_FRAGS(p9, p12, a0, a1, b00, b01, b10, b11)
        MM_2TILES(c0, c1, a0, a1, b00, b01, b10, b11)
      }
      wr_T(p5, mt, nt0, fr, fq, c0);
      wr_T(p5, mt, nt0 + 1, fr, fq, c1);
    }
  }
  LBAR();
  {
    {
      MM_FRAGS(p8, p7, a0, a1, b00, b01, b10, b11)
      f32x4 c0 = {0.f, 0.f, 0.f, 0.f}, c1 = c0;
      MM_2TILES(c0, c1, a0, a1, b00, b01, b10, b11)
      bfr* QT = (bfr*)(CH + cc * CH_REC + CH_QT);
      *(bf16x4*)(QT + ((mt * 4 + nt0) * 64 + lane) * 4) = pack4(c0[0], c0[1], c0[2], c0[3]);
      *(bf16x4*)(QT + ((mt * 4 + nt0 + 1) * 64 + lane) * 4) = pack4(c1[0], c1[1], c1[2], c1[3]);
    }
    {
      MM_FRAGS(p7, p5, a0, a1, b00, b01, b10, b11)
      f32x4 c0 = {0.f, 0.f, 0.f, 0.f}, c1 = c0;
      MM_2TILES(c0, c1, a0, a1, b00, b01, b10, b11)
      bfr* YX = (bfr*)(CH + cc * CH_REC + CH_YX);
      *(bf16x4*)(YX + ((mt * 4 + nt0) * 64 + lane) * 4) = pack4(c0[0], c0[1], c0[2], c0[3]);
      *(bf16x4*)(YX + ((mt * 4 + nt0 + 1) * 64 + lane) * 4) = pack4(c1[0], c1[1], c1[2], c1[3]);
    }
    {
      const int fm = wv >> 1, fa = wv & 1;
      const int row = fm * 16 + fr;
      {
        const bf16x4 lo = *(const bf16x4*)(p10 + (row * CS + 32 * fa + 4 * fq) * 2);
        const bf16x4 hi = *(const bf16x4*)(p10 + (row * CS + 32 * fa + 16 + 4 * fq) * 2);
        bf16x8 f; f[0] = lo[0]; f[1] = lo[1]; f[2] = lo[2]; f[3] = lo[3]; f[4] = hi[0]; f[5] = hi[1]; f[6] = hi[2]; f[7] = hi[3];
        *(bf16x8*)(CH + cc * CH_REC + CH_PT + (size_t)((fm * 2 + fa) * 64 + lane) * 16) = f;
      }
      {
        const bf16x4 lo = *(const bf16x4*)(p1 + (row * CS + 32 * fa + 4 * fq) * 2);
        const bf16x4 hi = *(const bf16x4*)(p1 + (row * CS + 32 * fa + 16 + 4 * fq) * 2);
        bf16x8 f; f[0] = lo[0]; f[1] = lo[1]; f[2] = lo[2]; f[3] = lo[3]; f[4] = hi[0]; f[5] = hi[1]; f[6] = hi[2]; f[7] = hi[3];
        *(bf16x8*)(CH + cc * CH_REC + CH_RYT + (size_t)((fm * 2 + fa) * 64 + lane) * 16) = f;
      }
    }
  }
  LBAR();
}

template <bool GDN>
__device__ __forceinline__ void chunk_prep_loop(PP pp, int t0, int tend, int nb, char* smem) {
  ChunkIn cur, nxt;
  if (t0 < tend) chunk_load<GDN>(pp, t0, cur);
  for (int t = t0; t < tend; t += nb) {
    const bool has_next = (t + nb) < tend;
    chunk_prep_task<GDN>(pp, t, t + nb, has_next, cur, nxt, smem);
    cur = nxt;
  }
}
__device__ __forceinline__ void phase_chunk_prep(PP pp, int bid, int nb, char* smem) {
  __syncthreads();
  const int half = (NCHAIN / 2) * NCHUNK;
  chunk_prep_loop<false>(pp, bid, half, nb, smem);
  const int k0 = (half - bid + nb - 1) / nb;
  chunk_prep_loop<true>(pp, bid + k0 * nb, NCHAIN * NCHUNK, nb, smem);
  __syncthreads();
}

#define X2_BUF 32768
#define X2_BAR() do { asm volatile("s_waitcnt lgkmcnt(0)" ::: "memory"); __builtin_amdgcn_s_barrier(); asm volatile("" ::: "memory"); } while (0)
__device__ __forceinline__ void chunk_seq_chain(PP pp, int chain, char* smem) {
  __syncthreads();
  const int tid = tid_opaque(), lane = tid & 63, wv = wave_id(tid);
  const int d = chain & 1, h = (chain >> 1) & 3, b = (chain >> 3) & 1, ty = chain >> 4;
  const char* CH = p.ws + OFF_CH;
  bfr* Y = (bfr*)(p.ws + OFF_S + (ty ? S_YGD : S_YRW)) + (size_t)d * NTOK * 256;
  const size_t c0 = (size_t)chain * NCHUNK;
  if (wv >= 4) {
    const int lw = wv - 4;
    const char* src0 = CH + c0 * CH_REC + (size_t)lane * 16;
#define X2_DMA(n) { const char* s_ = src0 + (size_t)(n) * CH_REC; LAS unsigned char* d_ = (LAS unsigned char*)smem + ((n) & 3) * X2_BUF;       \
      _Pragma("unroll") for (int i = 0; i < 8; ++i) {                                                                                       \
        const int piece = i * 4 + lw;                                                                                                       \
        __builtin_amdgcn_global_load_lds((const unsigned*)(s_ + piece * 1024), (LAS unsigned*)(d_ + piece * 1024), 16, 0, 0); } }
    X2_DMA(0) X2_DMA(1) X2_DMA(2)
    asm volatile("s_waitcnt vmcnt(16)" ::: "memory");
    X2_BAR();
    for (int n = 0; n < NCHUNK; ++n) {
      if (n + 3 < NCHUNK) { X2_DMA(n + 3) asm volatile("s_waitcnt vmcnt(16)" ::: "memory"); }
      else if (n + 2 < NCHUNK) asm volatile("s_waitcnt vmcnt(8)" ::: "memory");
      else asm volatile("s_waitcnt vmcnt(0)" ::: "memory");
      X2_BAR();
    }
#undef X2_DMA
  } else {
    const int vt = wv, fr = lane & 15, fq = lane >> 4;
    f32x4 Sacc[4];
#pragma unroll
    for (int i = 0; i < 4; ++i) Sacc[i] = (f32x4){0.f, 0.f, 0.f, 0.f};
    X2_BAR();
    for (int n = 0; n < NCHUNK; ++n) {
      const char* buf = smem + (n & 3) * X2_BUF;
      bf16x8 sB0, sB1;
#pragma unroll
      for (int j = 0; j < 4; ++j) {
        sB0[j] = (short)f2bf(Sacc[0][j]); sB0[4 + j] = (short)f2bf(Sacc[1][j]);
        sB1[j] = (short)f2bf(Sacc[2][j]); sB1[4 + j] = (short)f2bf(Sacc[3][j]);
      }
#pragma unroll
      for (int m = 0; m < 4; ++m) {
        const bf16x8 pa0 = *(const bf16x8*)(buf + ((m * 2 + 0) * 64 + lane) * 16);
        const bf16x8 pa1 = *(const bf16x8*)(buf + ((m * 2 + 1) * 64 + lane) * 16);
        const bf16x8 ra0 = *(const bf16x8*)(buf + 8192 + ((m * 2 + 0) * 64 + lane) * 16);
        const bf16x8 ra1 = *(const bf16x8*)(buf + 8192 + ((m * 2 + 1) * 64 + lane) * 16);
        const bf16x4 qb = *(const bf16x4*)(buf + 16384 + ((m * 4 + vt) * 64 + lane) * 8);
        const bf16x4 yb = *(const bf16x4*)(buf + 24576 + ((vt * 4 + m) * 64 + lane) * 8);
        f32x4 y = {bf2f(yb[0]), bf2f(yb[1]), bf2f(yb[2]), bf2f(yb[3])};
        y = __builtin_amdgcn_mfma_f32_16x16x32_bf16(sB0, ra0, y, 0, 0, 0);
        y = __builtin_amdgcn_mfma_f32_16x16x32_bf16(sB1, ra1, y, 0, 0, 0);
        f32x4 sn = {bf2f(qb[0]), bf2f(qb[1]), bf2f(qb[2]), bf2f(qb[3])};
        sn = __builtin_amdgcn_mfma_f32_16x16x32_bf16(pa0, sB0, sn, 0, 0, 0);
        sn = __builtin_amdgcn_mfma_f32_16x16x32_bf16(pa1, sB1, sn, 0, 0, 0);
        Sacc[m] = sn;
        {
          const int mm = scan_tok(b, d, n * 64 + m * 16 + fr);
          *(bf16x4*)(Y + (size_t)mm * 256 + h * 64 + vt * 16 + 4 * fq) = pack4(y[0], y[1], y[2], y[3]);
        }
      }
      X2_BAR();
    }
  }
}

struct NaPair { int mk0, mk1, tau0, tau1, kr0, kr1, ct0, ct1; };
struct NaFrag { bf16x8 k00, k01, k10, k11; bf16x4 v0[4], v1[4]; };

__device__ __forceinline__ void na_load(NaFrag& f, const bfr* KN, const bfr* VT, size_t vt_base, int h, int fr, int fq, const NaPair& pr) {
  const bfr* k0 = KN + (size_t)(pr.mk0 + fr) * 512 + h * 64 + fq * 8;
  const bfr* k1 = KN + (size_t)(pr.mk1 + fr) * 512 + h * 64 + fq * 8;
  f.k00 = *(const bf16x8*)(k0); f.k01 = *(const bf16x8*)(k0 + 32);
  f.k10 = *(const bf16x8*)(k1); f.k11 = *(const bf16x8*)(k1 + 32);
#pragma unroll
  for (int dt = 0; dt < 4; ++dt) {
    const int vo = (dt * 16 + fr) * 16 + fq * 4;
    f.v0[dt] = *(const bf16x4*)(VT + vt_base + (size_t)(pr.tau0 >> 4) * 1024 + vo);
    f.v1[dt] = *(const bf16x4*)(VT + vt_base + (size_t)(pr.tau1 >> 4) * 1024 + vo);
  }
}

__device__ __forceinline__ void na_compute(const NaFrag& f, const bf16x8 qf0, const bf16x8 qf1, bool local, bool vr0, bool vr1,
                                           int dr0, int dr1, int ct0, int ct1, int qc, int fq, const float* bias_h, f32x4 (&O)[4], float& lsum) {
  f32x4 z = {0.f, 0.f, 0.f, 0.f};
  f32x4 st0 = __builtin_amdgcn_mfma_f32_16x16x32_bf16(f.k00, qf0, z, 0, 0, 0);
  st0 = __builtin_amdgcn_mfma_f32_16x16x32_bf16(f.k01, qf1, st0, 0, 0, 0);
  f32x4 st1 = __builtin_amdgcn_mfma_f32_16x16x32_bf16(f.k10, qf0, z, 0, 0, 0);
  st1 = __builtin_amdgcn_mfma_f32_16x16x32_bf16(f.k11, qf1, st1, 0, 0, 0);
  bf16x8 pf;
  if (local) {
    const int cs = min(max(qc - 8, 0), 48);
#pragma unroll
    for (int r = 0; r < 4; ++r) {
      const int kc0 = ct0 * 16 + fq * 4 + r, kc1 = ct1 * 16 + fq * 4 + r;
      float p0 = 0.f, p1 = 0.f;
      if (vr0 && (unsigned)(kc0 - cs) < 16u) p0 = __builtin_amdgcn_exp2f(st0[r] + bias_h[dr0 * 31 + (kc0 - qc + 15)]);
      if (vr1 && (unsigned)(kc1 - cs) < 16u) p1 = __builtin_amdgcn_exp2f(st1[r] + bias_h[dr1 * 31 + (kc1 - qc + 15)]);
      lsum += p0 + p1;
      pf[r] = (short)f2bf(p0);
      pf[4 + r] = (short)f2bf(p1);
    }
  } else {
#pragma unroll
    for (int r = 0; r < 4; ++r) {
      const float p0 = __builtin_amdgcn_exp2f(st0[r]), p1 = __builtin_amdgcn_exp2f(st1[r]);
      lsum += p0 + p1;
      pf[r] = (short)f2bf(p0);
      pf[4 + r] = (short)f2bf(p1);
    }
  }
#pragma unroll
  for (int dt = 0; dt < 4; ++dt) {
    bf16x8 vf;
    vf[0] = f.v0[dt][0]; vf[1] = f.v0[dt][1]; vf[2] = f.v0[dt][2]; vf[3] = f.v0[dt][3];
    vf[4] = f.v1[dt][0]; vf[5] = f.v1[dt][1]; vf[6] = f.v1[dt][2]; vf[7] = f.v1[dt][3];
    O[dt] = __builtin_amdgcn_mfma_f32_16x16x32_bf16(vf, pf, O[dt], 0, 0, 0);
  }
}

__device__ __forceinline__ void na_block_task(PP pp, int task, const float* bias_lds) {
  const int tid = tid_opaque(), lane = tid & 63, wv = wave_id(tid);
  const int fr = lane & 15, fq = lane >> 4;
  char* S = p.ws + OFF_S;
  const bfr* QN = (const bfr*)(S + S_QN);
  const bfr* KN = (const bfr*)(S + S_KN);
  const bfr* VT = (const bfr*)(S + S_VT);
  bfr* CC = (bfr*)(p.ws + OFF_CC);
  const bool latent = task < 1024;
  int b, h, mqa, mqb, qra = 0, qrb = 0, cgp = 0;
  if (latent) {
    h = task & 7; const int quad = (task >> 3) & 63; b = task >> 9;
    qra = quad * 4 + (wv >> 2) * 2; qrb = qra + 1; cgp = wv & 3;
    mqa = b * SEQ + qra * 64 + cgp * 16; mqb = mqa + 64;
  } else {
    const int u = task - 1024;
    h = u & 7; b = u >> 3;
    mqa = NLAT + b * CTXL + (wv * 2) * 16; mqb = mqa + 16;
  }
  const bf16x8 qa0 = *(const bf16x8*)(QN + (size_t)(mqa + fr) * 512 + h * 64 + fq * 8);
  const bf16x8 qa1 = *(const bf16x8*)(QN + (size_t)(mqa + fr) * 512 + h * 64 + 32 + fq * 8);
  const bf16x8 qb0 = *(const bf16x8*)(QN + (size_t)(mqb + fr) * 512 + h * 64 + fq * 8);
  const bf16x8 qb1 = *(const bf16x8*)(QN + (size_t)(mqb + fr) * 512 + h * 64 + 32 + fq * 8);
  f32x4 Oa[4], Ob[4];
#pragma unroll
  for (int dt = 0; dt < 4; ++dt) { Oa[dt] = (f32x4){0.f, 0.f, 0.f, 0.f}; Ob[dt] = Oa[dt]; }
  float lsa = 0.f, lsb = 0.f;
  const size_t vt_base = (size_t)(b * 8 + h) * 64 * TTOK;
  const int rsa = min(max(qra - 4, 0), SEQ / 64 - 8), rsb = min(max(qrb - 4, 0), SEQ / 64 - 8);
  const int nrows = latent ? (rsb - rsa + 8) : 0;
  const int ct_first = (cgp <= 1) ? 0 : cgp - 1;
  const int nct = (cgp == 0 || cgp == 3) ? 2 : 3;
  const int ntile = nrows * nct;
  const int nlp = (ntile + 1) >> 1;
  const int npair = nlp + 8;
  const int qc = cgp * 16 + fr;
  auto mkpair = [&](int pi) {
    NaPair pr;
    if (pi < nlp) {
      const int i0 = 2 * pi, i1 = min(2 * pi + 1, ntile - 1);
      pr.kr0 = rsa + i0 / nct; pr.ct0 = ct_first + i0 % nct;
      pr.kr1 = rsa + i1 / nct; pr.ct1 = ct_first + i1 % nct;
      if (2 * pi + 1 >= ntile) pr.kr1 = -100;
      const int r1 = rsa + i1 / nct;
      pr.tau0 = pr.kr0 * 64 + pr.ct0 * 16; pr.tau1 = r1 * 64 + pr.ct1 * 16;
      pr.mk0 = b * SEQ + pr.tau0; pr.mk1 = b * SEQ + pr.tau1;
    } else {
      const int c = pi - nlp;
      pr.kr0 = pr.kr1 = pr.ct0 = pr.ct1 = 0;
      pr.tau0 = SEQ + c * 32; pr.tau1 = SEQ + c * 32 + 16;
      pr.mk0 = NLAT + b * CTXL + c * 32; pr.mk1 = pr.mk0 + 16;
    }
    return pr;
  };
  NaFrag fa, fb;
  NaPair pa = mkpair(0), pb;
  na_load(fa, KN, VT, vt_base, h, fr, fq, pa);
  const float* bias_h = bias_lds + h * 465;
#define NA_DO(F, PR, PI)                                                                                          \
  {                                                                                                               \
    const bool loc_ = (PI) < nlp;                                                                                 \
    na_compute(F, qa0, qa1, loc_, (unsigned)(PR.kr0 - rsa) < 8u, (unsigned)(PR.kr1 - rsa) < 8u,                   \
               PR.kr0 - qra + 7, PR.kr1 - qra + 7, PR.ct0, PR.ct1, qc, fq, bias_h, Oa, lsa);                      \
    na_compute(F, qb0, qb1, loc_, (unsigned)(PR.kr0 - rsb) < 8u, (unsigned)(PR.kr1 - rsb) < 8u,                   \
               PR.kr0 - qrb + 7, PR.kr1 - qrb + 7, PR.ct0, PR.ct1, qc, fq, bias_h, Ob, lsb);                      \
  }
  for (int pi = 0; pi < npair; pi += 2) {
    if (pi + 1 < npair) { pb = mkpair(pi + 1); na_load(fb, KN, VT, vt_base, h, fr, fq, pb); }
    NA_DO(fa, pa, pi)
    if (pi + 1 < npair) {
      if (pi + 2 < npair) { pa = mkpair(pi + 2); na_load(fa, KN, VT, vt_base, h, fr, fq, pa); }
      NA_DO(fb, pb, pi + 1)
    }
  }
#undef NA_DO
  lsa += shfl_xor_l(lsa, 16, lane); lsa += shfl_xor_l(lsa, 32, lane);
  lsb += shfl_xor_l(lsb, 16, lane); lsb += shfl_xor_l(lsb, 32, lane);
  const float ia = 1.f / lsa, ib = 1.f / lsb;
#pragma unroll
  for (int dt = 0; dt < 4; ++dt) {
    *(bf16x4*)(CC + (size_t)(mqa + fr) * 1024 + h * 64 + dt * 16 + fq * 4) = pack4(Oa[dt][0] * ia, Oa[dt][1] * ia, Oa[dt][2] * ia, Oa[dt][3] * ia);
    *(bf16x4*)(CC + (size_t)(mqb + fr) * 1024 + h * 64 + dt * 16 + fq * 4) = pack4(Ob[dt][0] * ib, Ob[dt][1] * ib, Ob[dt][2] * ib, Ob[dt][3] * ib);
  }
}

__device__ __forceinline__ void phase_mix(PP pp, int l, int bid, int nb, char* smem) {
  const int tid = tid_opaque();
  const int nscan_blocks = (nb > 32) ? 32 : nb;
  const int first_attn_block = (nb > 32) ? 32 : 0;
  if (bid < nscan_blocks) {
    for (int c = bid; c < NCHAIN; c += nscan_blocks) chunk_seq_chain(pp, c, smem);
  }
  if (bid >= first_attn_block) {
    float* bias = (float*)smem;
    __syncthreads();
    for (int i = tid; i < 8 * 465; i += NTHR) bias[i] = p.na_rpb[(size_t)l * 8 * 465 + i] * 1.4426950408889634f;
    __syncthreads();
    const int ntask = (l == 0) ? 1024 + 16 : 1024;
    const int nab = nb - first_attn_block;
    for (int t = bid - first_attn_block; t < ntask; t += nab) na_block_task(pp, t, bias);
    __syncthreads();
    phase_convert(pp, l, 1, bid - first_attn_block, nab, smem);
    if (l == 0) phase_convert(pp, 1, 0, bid - first_attn_block, nab, smem);
  }
}

__device__ __forceinline__ void phase_post(PP pp, int l, int bid, int nb) {
  const int tid = tid_opaque(), lane = tid & 63, wv = wave_id(tid);
  char* S = p.ws + OFF_S;
  const bfr* YRW = (const bfr*)(S + S_YRW);
  const bfr* YGD = (const bfr*)(S + S_YGD);
  const bfr* RWV = (const bfr*)(S + S_RWV);
  const bfr* RWG = (const bfr*)(S + S_RWG);
  const float* BON = (const float*)(S + S_BON);
  const bfr* P = (const bfr*)(p.ws + OFF_P);
  bfr* CC = (bfr*)(p.ws + OFF_CC);
  const float* ln_w = p.rw_ln_w + (size_t)l * 256;
  const float* ln_b = p.rw_ln_b + (size_t)l * 256;
  const float* ng = p.gd_norm_g + (size_t)l * 64;
  const int ntok = (l == 0) ? NTOK : NLAT;
  const int cb = lane * 4, hh = lane >> 4;
  const f32x4 lw4 = *(const f32x4*)(ln_w + cb), lb4 = *(const f32x4*)(ln_b + cb), ng4 = *(const f32x4*)(ng + (cb & 63));
  for (int m = bid * 8 + wv; m < ntok; m += nb * 8) {
    const size_t o = (size_t)m * 256 + cb;
    const f32x4 y0 = ldbf4(YRW + o), y1 = ldbf4(YRW + (size_t)NTOK * 256 + o);
    const f32x4 rv = ldbf4(RWV + o), rg = ldbf4(RWG + o);
    const f32x4 g0 = ldbf4(YGD + o), g1 = ldbf4(YGD + (size_t)NTOK * 256 + o);
    const f32x4 z = ldbf4(P + (size_t)m * PINP + B_END + 768 + cb);
    const float bon = BON[(size_t)m * 4 + hh];
    {
      const f32x4 y = y0 + y1;
      const float mean = row16_sum((y[0] + y[1]) + (y[2] + y[3])) * (1.f / 64.f);
      const f32x4 dv = y - mean;
      const float var = row16_sum((dv[0] * dv[0] + dv[1] * dv[1]) + (dv[2] * dv[2] + dv[3] * dv[3])) * (1.f / 64.f);
      const f32x4 out = ((dv * rsqrtf(var + 64e-5f)) * lw4 + lb4 + rv * bon) * rg;
      *(bf16x4*)(CC + (size_t)m * 1024 + 512 + cb) = pack4(out[0], out[1], out[2], out[3]);
    }
    {
      const f32x4 y = g0 + g1;
      const float ms = row16_sum((y[0] * y[0] + y[1] * y[1]) + (y[2] * y[2] + y[3] * y[3])) * (1.f / 64.f);
      const f32x4 sz = {siluf_(z[0]), siluf_(z[1]), siluf_(z[2]), siluf_(z[3])};
      const f32x4 out = (y * rsqrtf(ms + 1e-6f)) * ng4 * sz;
      *(bf16x4*)(CC + (size_t)m * 1024 + 768 + cb) = pack4(out[0], out[1], out[2], out[3]);
    }
  }
}

#define RW_LDS_ROW 36
__device__ __forceinline__ void phase_router(PP pp, int l, int bid, int nb, char* smem) {
  const int tid = tid_opaque(), lane = tid & 63, wv = wave_id(tid);
  const float* xl = p.out;
  const float* xc = (const float*)(p.ws + OFF_CTX);
  const float* mods = (const float*)(p.ws + OFF_MODS) + (size_t)l * 3 * 6144;
  const float* g = p.norm_ffn_g + (size_t)l * 1024;
  const float* rw = p.moe_router_w + (size_t)l * 1024 * 32;
  const float* rb = p.moe_router_b + (size_t)l * 32;
  bfr* H = (bfr*)(p.ws + OFF_H);
  int* cnt = (int*)(p.ws + OFF_CNT);
  int* TOKE = (int*)(p.ws + OFF_TOKE);
  int* TOKP = (int*)(p.ws + OFF_TOKP);
  float* TOKG = (float*)(p.ws + OFF_TOKG);
  float* wl = (float*)smem;
  for (int i = tid; i < 1024 * 8; i += NTHR) {
    int d = i >> 3, q = i & 7;
    *(float4*)(wl + d * RW_LDS_ROW + q * 4) = *(const float4*)(rw + (size_t)d * 32 + q * 4);
  }
  __syncthreads();
  const int ntok = (l == 0) ? NTOK : NLAT;
  const float rbl = rb[lane & 31];
  for (int m0 = (bid * 8 + wv) * 2; m0 < ntok; m0 += nb * 16) {
    float acc0[32], acc1[32];
#pragma unroll
    for (int e = 0; e < 32; ++e) { acc0[e] = 0.f; acc1[e] = 0.f; }
    float hv0[16], hv1[16];
    {
      const int ma = m0, mb = m0 + 1;
      const float* xa = (ma < NLAT) ? xl + (size_t)ma * 1024 : xc + (size_t)(ma - NLAT) * 1024;
      const float* xb = (mb < NLAT) ? xl + (size_t)mb * 1024 : xc + (size_t)(mb - NLAT) * 1024;
      const float* mda = mods + (size_t)mod_row(ma) * 6144 + 3072;
      const float* mdb = mods + (size_t)mod_row(mb) * 6144 + 3072;
      float ssa = 0.f, ssb = 0.f;
#pragma unroll
      for (int i = 0; i < 16; ++i) { hv0[i] = xa[lane + 64 * i]; hv1[i] = xb[lane + 64 * i]; }
#pragma unroll
      for (int i = 0; i < 16; ++i) { ssa += hv0[i] * hv0[i]; ssb += hv1[i] * hv1[i]; }
      ssa = wave_sum(ssa); ssb = wave_sum(ssb);
      const float rsa = rsqrtf(ssa * (1.f / 1024.f) + 1e-6f), rsb = rsqrtf(ssb * (1.f / 1024.f) + 1e-6f);
#pragma unroll
      for (int i = 0; i < 16; ++i) {
        const int d = lane + 64 * i;
        const float gg = g[d];
        hv0[i] = hv0[i] * rsa * gg * (1.f + mda[1024 + d]) + mda[d];
        hv1[i] = hv1[i] * rsb * gg * (1.f + mdb[1024 + d]) + mdb[d];
      }
      float am0 = 0.f, am1 = 0.f;
#pragma unroll
      for (int i = 0; i < 16; ++i) { am0 = fmaxf(am0, fabsf(hv0[i])); am1 = fmaxf(am1, fabsf(hv1[i])); }
      am0 = wave_max(am0); am1 = wave_max(am1);
      const float sc0 = am0 > 0.f ? am0 * (1.f / 127.f) : 1.f, sc1 = am1 > 0.f ? am1 * (1.f / 127.f) : 1.f;
      const float iv0 = 1.f / sc0, iv1 = 1.f / sc1;
      signed char* H8 = (signed char*)(p.ws + OFF_H);
#pragma unroll
      for (int i = 0; i < 16; ++i) {
        const int d = lane + 64 * i;
        H8[(size_t)ma * 1024 + d] = (signed char)(int)fminf(fmaxf(rintf(hv0[i] * iv0), -127.f), 127.f);
        H8[(size_t)mb * 1024 + d] = (signed char)(int)fminf(fmaxf(rintf(hv1[i] * iv1), -127.f), 127.f);
      }
      if (lane == 0) { float* SCL = (float*)(p.ws + OFF_SCL); SCL[ma] = sc0; SCL[mb] = sc1; }
      asm volatile("" ::: "memory");
    }
#pragma unroll
    for (int i = 0; i < 16; ++i) {
      if ((i & 3) == 0) asm volatile("" ::: "memory");
      const float* wr = wl + (lane + 64 * i) * RW_LDS_ROW;
#pragma unroll
      for (int q = 0; q < 8; ++q) {
        const float4 w = *(const float4*)(wr + q * 4);
        acc0[q * 4 + 0] += hv0[i] * w.x; acc0[q * 4 + 1] += hv0[i] * w.y; acc0[q * 4 + 2] += hv0[i] * w.z; acc0[q * 4 + 3] += hv0[i] * w.w;
        acc1[q * 4 + 0] += hv1[i] * w.x; acc1[q * 4 + 1] += hv1[i] * w.y; acc1[q * 4 + 2] += hv1[i] * w.z; acc1[q * 4 + 3] += hv1[i] * w.w;
      }
    }
#define BFLY(A, N, D)                                                                           \
    _Pragma("unroll") for (int i = 0; i < (N); ++i) {                                            \
      const bool up = (lane & (D)) != 0;                                                         \
      const float keep = up ? A[i + (N)] : A[i];                                                 \
      const float send = up ? A[i] : A[i + (N)];                                                 \
      A[i] = keep + shfl_xor_l(send, (D), lane);                                                   \
    }
    BFLY(acc0, 16, 16) BFLY(acc1, 16, 16)
    BFLY(acc0, 8, 8) BFLY(acc1, 8, 8)
    BFLY(acc0, 4, 4) BFLY(acc1, 4, 4)
    BFLY(acc0, 2, 2) BFLY(acc1, 2, 2)
    BFLY(acc0, 1, 1) BFLY(acc1, 1, 1)
#undef BFLY
    float la = acc0[0] + shfl_xor_l(acc0[0], 32, lane);
    float lb = acc1[0] + shfl_xor_l(acc1[0], 32, lane);
    const int my_e = lane & 31;
    la += rbl; lb += rbl;
    (void)my_e;
#pragma unroll
    for (int tkn = 0; tkn < 2; ++tkn) {
      float v = tkn == 0 ? la : lb;
      float tv[4]; int ti[4];
#pragma unroll
      for (int k = 0; k < 4; ++k) {
        float bv = v; int bi = lane & 31;
#pragma unroll
        for (int o = 16; o >= 1; o >>= 1) {
          float ov = shfl_xor_l(bv, o, lane); int oi = shfl_xor_li(bi, o, lane);
          bool take = (ov > bv) || (ov == bv && oi < bi);
          bv = take ? ov : bv; bi = take ? oi : bi;
        }
        tv[k] = bv; ti[k] = bi;
        if ((lane & 31) == bi) v = -3.0e38f;
      }
      float e1 = __expf(tv[1] - tv[0]), e2 = __expf(tv[2] - tv[0]), e3 = __expf(tv[3] - tv[0]);
      float inv = 1.f / (1.f + e1 + e2 + e3);
      const int m = m0 + tkn;
      if (lane < 4) {
        int e = lane == 0 ? ti[0] : lane == 1 ? ti[1] : lane == 2 ? ti[2] : ti[3];
        float gt = (lane == 0 ? 1.f : lane == 1 ? e1 : lane == 2 ? e2 : e3) * inv;
        int pos = atomicAdd(&cnt[e], 1);
        TOKE[(size_t)m * 4 + lane] = e; TOKP[(size_t)m * 4 + lane] = pos; TOKG[(size_t)m * 4 + lane] = gt;
      }
    }
  }
  __syncthreads();
}

__device__ __forceinline__ void moe_offsets(PP pp, int* toff) {
  const int* cnt = (const int*)(p.ws + OFF_CNT);
  if (tid_opaque() == 0) {
    int a = 0;
    for (int e = 0; e < 32; ++e) { toff[e] = a; a += (cnt[e] + 255) >> 8; }
    toff[32] = a;
  }
  __syncthreads();
}
__device__ __forceinline__ void moe_tile_experts(int* toff) {
  int* texp = toff + 128;
  const int ntile = toff[32];
  for (int mt = tid_opaque(); mt < ntile; mt += NTHR) {
    int e = 0;
#pragma unroll 1
    for (int k = 1; k < 32; ++k) e = (mt >= toff[k]) ? k : e;
    texp[mt] = e;
  }
  __syncthreads();
}

__device__ __forceinline__ void phase_slotfill(PP pp, int l, int bid, int nb, char* smem) {
  int* toff = (int*)smem;
  moe_offsets(pp, toff);
  const int tid = tid_opaque(), lane = tid & 63, wv = wave_id(tid);
  const int* TOKE = (const int*)(p.ws + OFF_TOKE);
  const int* TOKP = (const int*)(p.ws + OFF_TOKP);
  const float* TOKG = (const float*)(p.ws + OFF_TOKG);
  const int* cnt = (const int*)(p.ws + OFF_CNT);
  int* TOKS = (int*)(p.ws + OFF_TOKS);
  float* SLG = (float*)(p.ws + OFF_SLG);
  float* SLS = (float*)(p.ws + OFF_SLS);
  const float* SCL = (const float*)(p.ws + OFF_SCL);
  const signed char* H8 = (const signed char*)(p.ws + OFF_H);
  signed char* XG = (signed char*)(p.ws + OFF_S);
  const int n = ((l == 0) ? NTOK : NLAT) * 4;
  int* SLT = (int*)(p.ws + OFF_SLT);
  for (int i = bid * NTHR + tid; i < n; i += nb * NTHR) {
    const int slot = toff[TOKE[i]] * 256 + TOKP[i];
    TOKS[i] = slot; SLT[slot] = i >> 2; SLG[slot] = TOKG[i]; SLS[slot] = SCL[i >> 2];
  }
  for (int e = 0; e < 32; ++e) {
    const int c = cnt[e];
    const int npad = ((c + 255) & ~255) - c;
    const int base = toff[e] * 256 + c;
    for (int r = bid * NTHR + tid; r < npad; r += nb * NTHR) { SLT[base + r] = 0; SLS[base + r] = 0.f; }
  }
  __syncthreads();
}

struct EpiMoe1 {
  const float* bgu; const float* sw; const float* SLS; bfr* ACT;
  __device__ __forceinline__ void operator()(const i32x4 (&acc)[2][2][4][2], const g8::GUnit& u, int wr, int wc, int fr, int fq) const {
    const float* be = bgu + (size_t)u.e * 2048;
    const float* se = sw + (size_t)u.e * 2048;
    const int slot0 = u.pm * 256 + wr * 64 + fr;
    float sav[2][4];
#pragma unroll
    for (int ai = 0; ai < 2; ++ai)
#pragma unroll
      for (int m = 0; m < 4; ++m) sav[ai][m] = SLS[slot0 + ai * 128 + m * 16];
    const int j0 = u.pn * 128 + wc * 32 + fq * 8;
    f32x4 bgv[2], blv[2], sgv[2], slv[2];
#pragma unroll
    for (int bj = 0; bj < 2; ++bj) {
      bgv[bj] = *(const f32x4*)(be + j0 + bj * 4); blv[bj] = *(const f32x4*)(be + 1024 + j0 + bj * 4);
      sgv[bj] = *(const f32x4*)(se + j0 + bj * 4); slv[bj] = *(const f32x4*)(se + 1024 + j0 + bj * 4);
    }
#pragma unroll
    for (int ai = 0; ai < 2; ++ai)
#pragma unroll
      for (int m = 0; m < 4; ++m) {
        const int slot = slot0 + ai * 128 + m * 16;
        const float sa = sav[ai][m];
        f32x4 ov[2];
#pragma unroll
        for (int bj = 0; bj < 2; ++bj) {
          const f32x4 bg = bgv[bj], bl = blv[bj];
          const f32x4 sg = sgv[bj], sl = slv[bj];
#pragma unroll
          for (int q = 0; q < 4; ++q) {
            const float g = (float)acc[ai][bj][m][0][q] * (sa * sg[q]) + bg[q];
            const float li = (float)acc[ai][bj][m][1][q] * (sa * sl[q]) + bl[q];
            const float gv = fminf(g, 7.f);
            const float lv = fminf(fmaxf(li, -7.f), 7.f);
            ov[bj][q] = gv * sigmoidf_(1.702f * gv) * (lv + 1.f);
          }
        }
        *(bf16x8*)(ACT + (size_t)slot * 1024 + j0) = pack8(ov[0], ov[1]);
      }
  }
};
__device__ __forceinline__ void phase_moe1_impl(PP pp, int l, int bid, int nb, char* smem, int* toff) {
  moe_offsets(pp, toff);
  moe_tile_experts(toff);
  g8::MoeSched S{toff, 8, 2048, nb, bid};
  EpiMoe1 E{p.moe_b_gu + (size_t)l * 32 * 2048, (const float*)(p.ws + OFF_SW) + (size_t)l * 32 * 2048, (const float*)(p.ws + OFF_SLS), (bfr*)(p.ws + OFF_P)};
  g8::gemm_stream<true, true>((LAS unsigned char*)smem, p.ws + OFF_H, p.ws + OFF_W + (size_t)l * WL_SIZE + WL_GU, S, E, (const int*)(p.ws + OFF_SLT));
}

struct EpiMoe2 {
  const float* bdn; const float* SLG; bfr* YS;
  __device__ __forceinline__ void operator()(const f32x4 (&acc)[2][2][4][2], const g8::GUnit& u, int wr, int wc, int fr, int fq) const {
    const float* be = bdn + (size_t)u.e * 1024;
    const int slot0 = u.pm * 256 + wr * 64 + fr, col0 = u.pn * 256 + wc * 32 + 8 * fq;
    float gtv[2][4];
#pragma unroll
    for (int ai = 0; ai < 2; ++ai)
#pragma unroll
      for (int m = 0; m < 4; ++m) gtv[ai][m] = SLG[slot0 + ai * 128 + m * 16];
    f32x4 bvv[2][2];
#pragma unroll
    for (int bj = 0; bj < 2; ++bj)
#pragma unroll
      for (int n = 0; n < 2; ++n) bvv[bj][n] = *(const f32x4*)(be + col0 + bj * 128 + n * 4);
#pragma unroll
    for (int ai = 0; ai < 2; ++ai)
#pragma unroll
      for (int m = 0; m < 4; ++m) {
        const int slot = slot0 + ai * 128 + m * 16;
        const float gt = gtv[ai][m];
#pragma unroll
        for (int bj = 0; bj < 2; ++bj) {
          const f32x4 y0 = (acc[ai][bj][m][0] + bvv[bj][0]) * gt;
          const f32x4 y1 = (acc[ai][bj][m][1] + bvv[bj][1]) * gt;
          *(bf16x8*)(YS + (size_t)slot * 1024 + col0 + bj * 128) = pack8(y0, y1);
        }
      }
  }
};
__device__ __forceinline__ void phase_moe2_impl(PP pp, int l, int bid, int nb, char* smem, int* toff) {
  moe_offsets(pp, toff);
  moe_tile_experts(toff);
  g8::MoeSched S{toff, 4, 1024, nb, bid};
  EpiMoe2 E{p.moe_b_down + (size_t)l * 32 * 1024, (const float*)(p.ws + OFF_SLG), (bfr*)(p.ws + OFF_S)};
  g8::gemm_stream<false, false>((LAS unsigned char*)smem, p.ws + OFF_P, p.ws + OFF_W + (size_t)l * WL_SIZE + WL_DN, S, E);
}

__device__ __forceinline__ void phase_combine(PP pp, int l, int bid, int nb) {
  const int tid = tid_opaque(), lane = tid & 63, wv = wave_id(tid);
  const bfr* YS = (const bfr*)(p.ws + OFF_S);
  const int* TOKS = (const int*)(p.ws + OFF_TOKS);
  const float* mods = (const float*)(p.ws + OFF_MODS) + (size_t)l * 3 * 6144;
  const float* mods1 = (const float*)(p.ws + OFF_MODS) + (size_t)3 * 6144;
  const float* g1n = p.norm_mix_g + 1024;
  bfr* H = (bfr*)(p.ws + OFF_H);
  float* xl = p.out;
  float* xc = (float*)(p.ws + OFF_CTX);
  const int ntok = (l == 0) ? NTOK : NLAT;
  if (l == 0) {
    int* cnt = (int*)(p.ws + OFF_CNT);
    const int gt = bid * NTHR + tid;
    if (gt < 32) cnt[gt] = 0;
  }
  for (int m = bid * 8 + wv; m < ntok; m += nb * 8) {
    float* xr = (m < NLAT) ? xl + (size_t)m * 1024 : xc + (size_t)(m - NLAT) * 1024;
    const float* g2 = mods + (size_t)mod_row(m) * 6144 + 5120;
    const int s0 = TOKS[(size_t)m * 4], s1 = TOKS[(size_t)m * 4 + 1], s2 = TOKS[(size_t)m * 4 + 2], s3 = TOKS[(size_t)m * 4 + 3];
    float4 xn[4];
    float ss = 0.f;
#pragma unroll
    for (int i = 0; i < 4; ++i) {
      const int d = (lane + 64 * i) * 4;
      const bf16x4 a = *(const bf16x4*)(YS + (size_t)s0 * 1024 + d);
      const bf16x4 b = *(const bf16x4*)(YS + (size_t)s1 * 1024 + d);
      const bf16x4 c = *(const bf16x4*)(YS + (size_t)s2 * 1024 + d);
      const bf16x4 e = *(const bf16x4*)(YS + (size_t)s3 * 1024 + d);
      const float4 gg = *(const float4*)(g2 + d);
      float4 xv = *(const float4*)(xr + d);
      xv.x += gg.x * ((bf2f(a[0]) + bf2f(b[0])) + (bf2f(c[0]) + bf2f(e[0])));
      xv.y += gg.y * ((bf2f(a[1]) + bf2f(b[1])) + (bf2f(c[1]) + bf2f(e[1])));
      xv.z += gg.z * ((bf2f(a[2]) + bf2f(b[2])) + (bf2f(c[2]) + bf2f(e[2])));
      xv.w += gg.w * ((bf2f(a[3]) + bf2f(b[3])) + (bf2f(c[3]) + bf2f(e[3])));
      *(float4*)(xr + d) = xv;
      xn[i] = xv;
      ss += xv.x * xv.x + xv.y * xv.y + xv.z * xv.z + xv.w * xv.w;
    }
    if (l == 0) {
      ss = wave_sum(ss);
      const float rs = rsqrtf(ss * (1.f / 1024.f) + 1e-6f);
      const float* md = mods1 + (size_t)mod_row(m) * 6144;
      float4 hq[4];
#pragma unroll
      for (int i = 0; i < 4; ++i) {
        const int d = (lane + 64 * i) * 4;
        const float4 gg = *(const float4*)(g1n + d);
        const float4 sh = *(const float4*)(md + d);
        const float4 sc = *(const float4*)(md + 1024 + d);
        hq[i] = make_float4(xn[i].x * rs * gg.x * (1.f + sc.x) + sh.x, xn[i].y * rs * gg.y * (1.f + sc.y) + sh.y,
                            xn[i].z * rs * gg.z * (1.f + sc.z) + sh.z, xn[i].w * rs * gg.w * (1.f + sc.w) + sh.w);
      }
      const float qs = quant_row_store(hq, (signed char*)(p.ws + OFF_H) + (size_t)m * 1024, lane);
      if (lane == 0) ((float*)(p.ws + OFF_SCL))[m] = qs;
    }
  }
}

#define XB_TMO      128
#define XB_XCNT(j)  (256  + 64 * (j))
#define XB_XSUB(j)  (1280 + 64 * (j))
#define XB_XGEN(j)  (2304 + 64 * (j))
#define XB_TOP      3328
#define XB_TOPGEN   3392
#define XCD_BAR_WORDS 3456
#define XB_SPIN_CAP (1u << 22)
__device__ __forceinline__ unsigned xb_ld(unsigned* q) { return __hip_atomic_load(q, __ATOMIC_RELAXED, __HIP_MEMORY_SCOPE_AGENT); }
__device__ __forceinline__ unsigned xb_add(unsigned* q, unsigned v) { return __hip_atomic_fetch_add(q, v, __ATOMIC_RELAXED, __HIP_MEMORY_SCOPE_AGENT); }
__device__ __forceinline__ unsigned xb_xcc_id() { return (unsigned)__builtin_amdgcn_s_getreg((3 << 11) | 20) & 0xFu; }
#define XB_SPIN(cond, bar) do { unsigned _sp = 0; while (cond) { __builtin_amdgcn_s_sleep(1); \
    if ((++_sp & 255u) == 0u) { if (xb_ld(&(bar)[XB_TMO])) break; if (_sp > XB_SPIN_CAP) { atomicAdd(&(bar)[XB_TMO], 1u); break; } } } } while (0)
struct XcdBarrier { unsigned* bar; unsigned x; volatile LAS unsigned* st; };
__device__ __forceinline__ XcdBarrier xcd_barrier_post(unsigned* bar, volatile LAS unsigned* st) {
  XcdBarrier b; b.bar = bar; b.x = xb_xcc_id(); b.st = st;
  if (tid_opaque() == 0) (void)xb_add(&bar[XB_XCNT(b.x)], 1u);
  return b;
}
__device__ __forceinline__ void xcd_barrier_complete(unsigned* bar, unsigned x, unsigned& nloc, unsigned& nx) {
  const unsigned G = gridDim.x;
  unsigned sum, cnt, mine, sp = 0u;
  for (;;) {
    sum = 0u; cnt = 0u; mine = 0u;
#pragma unroll
    for (unsigned j = 0; j < 16; ++j) { const unsigned c = xb_ld(&bar[XB_XCNT(j)]); sum += c; cnt += (c > 0u) ? 1u : 0u; mine = (j == x) ? c : mine; }
    if (sum == G) break;
    __builtin_amdgcn_s_sleep(1);
    if ((++sp & 255u) == 0u) { if (xb_ld(&bar[XB_TMO])) break; if (sp > XB_SPIN_CAP) { atomicAdd(&bar[XB_TMO], 1u); break; } }
  }
  nloc = mine > 0u ? mine : 1u; nx = cnt > 0u ? cnt : 1u;
}
__device__ __forceinline__ void xcd_barrier(const XcdBarrier& b) {
  asm volatile("s_waitcnt vmcnt(0)" ::: "memory");
  __syncthreads();
  if (tid_opaque() == 0) {
    unsigned* bar = b.bar;
    __builtin_amdgcn_s_waitcnt(0);
    unsigned nloc = b.st[0], nx = b.st[1];
    if (nloc == 0u) { xcd_barrier_complete(bar, b.x, nloc, nx); b.st[0] = nloc; b.st[1] = nx; }
    const unsigned old = xb_add(&bar[XB_XSUB(b.x)], 1u);
    const unsigned gen = old / nloc;
    if (old + 1u == (gen + 1u) * nloc) {
      __builtin_amdgcn_fence(__ATOMIC_RELEASE, "agent");
      asm volatile("s_waitcnt vmcnt(0)" ::: "memory");
      const unsigned og = xb_add(&bar[XB_TOP], 1u);
      const unsigned tg = og / nx;
      if (og + 1u == (tg + 1u) * nx) xb_add(&bar[XB_TOPGEN], 1u);
      else XB_SPIN(xb_ld(&bar[XB_TOPGEN]) == tg, bar);
      __builtin_amdgcn_fence(__ATOMIC_ACQUIRE, "agent");
      xb_add(&bar[XB_XGEN(b.x)], 1u);
      asm volatile("s_waitcnt vmcnt(0)" ::: "memory");
    } else {
      XB_SPIN(xb_ld(&bar[XB_XGEN(b.x)]) == gen, bar);
      __builtin_amdgcn_fence(__ATOMIC_ACQUIRE, "agent");
      asm volatile("s_waitcnt vmcnt(0)" ::: "memory");
    }
  }
  __syncthreads();
}

extern __shared__ __attribute__((aligned(16))) char dyn_smem[];

__global__ void __launch_bounds__(NTHR) mega(Params p_unused) {
  cg::grid_group grid = cg::this_grid();
  const int bid0 = blockIdx.x, nb0 = gridDim.x;
#if defined(__HIP_DEVICE_COMPILE__)
  PP pp0 = (PP)__builtin_amdgcn_kernarg_segment_ptr();
#else
  PP pp0 = nullptr;
#endif
#define pp ({ PP q_ = pp0; asm volatile("" : "+s"(q_)); q_; })
#define bid opq(bid0)
#define nb opq(nb0)
  int* toff_s = (int*)(dyn_smem + 147456);
  volatile LAS unsigned* xb_st = (volatile LAS unsigned*)(dyn_smem + 147456 + 256);
  {
    unsigned* barw = (unsigned*)(fresh_ws(pp0) + OFF_BAR);
    if (blockIdx.x == 0) for (int i = threadIdx.x; i < XCD_BAR_WORDS; i += NTHR) barw[i] = 0u;
    if (threadIdx.x == 0) { xb_st[0] = 0u; xb_st[1] = 0u; }
  }
  grid.sync();
  const XcdBarrier xb = xcd_barrier_post((unsigned*)(fresh_ws(pp0) + OFF_BAR), xb_st);
#define GSYNC() xcd_barrier(xb)
  phase_ada(pp, bid, nb, dyn_smem);
  phase_convert(pp, 0, 0, bid, nb, dyn_smem);
  GSYNC();
#define LAYER(LV, LAST)                                      \
  {                                                          \
    if ((LV) == 0) { phase_prenorm(pp, opq(LV), bid, nb); GSYNC(); } \
    phase_gemm_in(pp, opq(LV), bid, nb, dyn_smem);           \
    GSYNC();                                                 \
    phase_prep(pp, opq(LV), bid, nb, dyn_smem);              \
    GSYNC();                                                 \
    phase_chunk_prep(pp, bid, nb, dyn_smem);                 \
    GSYNC();                                                 \
    phase_mix(pp, opq(LV), bid, nb, dyn_smem);               \
    GSYNC();                                                 \
    phase_post(pp, opq(LV), bid, nb);                        \
    GSYNC();                                                 \
    phase_gemm_out(pp, opq(LV), bid, nb, dyn_smem);          \
    GSYNC();                                                 \
    phase_router(pp, opq(LV), bid, nb, dyn_smem);            \
    GSYNC();                                                 \
    phase_slotfill(pp, opq(LV), bid, nb, dyn_smem);          \
    GSYNC();                                                 \
    phase_moe1_impl(pp, opq(LV), bid, nb, dyn_smem, toff_s); \
    GSYNC();                                                 \
    phase_moe2_impl(pp, opq(LV), bid, nb, dyn_smem, toff_s); \
    GSYNC();                                                 \
    phase_combine(pp, opq(LV), bid, nb);                     \
    if (!(LAST)) GSYNC();                                    \
  }
  LAYER(0, false)
  LAYER(1, true)
#undef LAYER
#undef GSYNC
#undef bid
#undef nb
#undef pp
}

#undef p
extern "C" void kernel_launch(void* const* d_in, const int* in_sizes, int n_in, void* d_out, int out_size, void* d_ws,
                              size_t ws_size, hipStream_t stream) {
  Params hp{};
  const float** pp = (const float**)&hp;
  for (int i = 0; i < 34; ++i) pp[i] = (const float*)d_in[i];
  hp.out = (float*)d_out;
  hp.ws = (char*)d_ws;
  static int grid_blocks = 0;
  if (!grid_blocks) {
    (void)hipFuncSetAttribute((const void*)mega, hipFuncAttributeMaxDynamicSharedMemorySize, LDS_BYTES);
    int dev = 0, cus = 0, per_cu = 0;
    (void)hipGetDevice(&dev);
    (void)hipDeviceGetAttribute(&cus, hipDeviceAttributeMultiprocessorCount, dev);
    (void)hipOccupancyMaxActiveBlocksPerMultiprocessor(&per_cu, mega, NTHR, LDS_BYTES);
    if (per_cu < 1) per_cu = 1;
    if (per_cu > 1) per_cu = 1;
    grid_blocks = cus * per_cu;
  }
  void* args[] = {&hp};
  (void)hipLaunchCooperativeKernel((void*)mega, dim3(grid_blocks), dim3(NTHR), args, LDS_BYTES, stream);
}
```

```cpp
#include <hip/hip_runtime.h>
#include <hip/hip_bf16.h>
#include <hip/hip_cooperative_groups.h>
#include <stdint.h>
#include <type_traits>
namespace cg = cooperative_groups;

typedef __attribute__((ext_vector_type(8))) short bf16x8;
typedef __attribute__((ext_vector_type(4))) short bf16x4;
typedef __attribute__((ext_vector_type(4))) float f32x4;
typedef __attribute__((ext_vector_type(4))) int i32x4;
typedef unsigned short bfr;

#define D_MODEL 1024
#define NB 2
#define SEQ 16384
#define CTXL 256
#define NLAT (NB * SEQ)
#define NCTX (NB * CTXL)
#define NTOK (NLAT + NCTX)
#define TTOK (SEQ + CTXL)
#define PIN 3472
#define PINP 3584
#define A_END 1536
#define B_END 2432
#define NEXP 32
#define NSLOT_MAX (NTOK * 4 + NEXP * 256)
#define NTHR 512
#define LDS_BYTES (147456 + 3072)

constexpr size_t al256(size_t x) { return (x + 255) & ~(size_t)255; }
constexpr size_t WL_IN = 0;
constexpr size_t WL_OUT = WL_IN + (size_t)PINP * 1024 * 2;
constexpr size_t WL_GU = WL_OUT + (size_t)1024 * 1024 * 2;
constexpr size_t WL_DN = WL_GU + (size_t)32 * 2048 * 1024 * 2;
constexpr size_t WL_SIZE = WL_DN + (size_t)32 * 1024 * 1024 * 2;
constexpr size_t OFF_W = 0;
constexpr size_t OFF_MODS = al256(OFF_W + 2 * WL_SIZE);
constexpr size_t OFF_BAR = al256(OFF_MODS + 2 * 3 * 6144 * 4);
constexpr size_t OFF_SW = al256(OFF_BAR + 3456 * 4);
constexpr size_t OFF_SWIN = al256(OFF_SW + (size_t)2 * 32 * 2048 * 4);
constexpr size_t OFF_SLS = al256(OFF_SWIN + (size_t)2 * PINP * 4);
constexpr size_t OFF_SCL = al256(OFF_SLS + (size_t)(NTOK * 4 + 32 * 256) * 4);
constexpr size_t OFF_CTX = al256(OFF_SCL + (size_t)NTOK * 4);
constexpr size_t OFF_CNT = al256(OFF_CTX + (size_t)NCTX * 1024 * 4);
constexpr size_t OFF_TOKE = al256(OFF_CNT + 256);
constexpr size_t OFF_TOKP = al256(OFF_TOKE + (size_t)NTOK * 4 * 4);
constexpr size_t OFF_TOKG = al256(OFF_TOKP + (size_t)NTOK * 4 * 4);
constexpr size_t OFF_TOKS = al256(OFF_TOKG + (size_t)NTOK * 4 * 4);
constexpr size_t OFF_SLT = al256(OFF_TOKS + (size_t)NTOK * 4 * 4);
constexpr size_t OFF_SLG = al256(OFF_SLT + (size_t)NSLOT_MAX * 4);
constexpr size_t OFF_H = al256(OFF_SLG + (size_t)NSLOT_MAX * 4);
constexpr size_t OFF_CC = al256(OFF_H + (size_t)NTOK * 1024 * 2);
constexpr size_t OFF_P = al256(OFF_CC + (size_t)NTOK * 1024 * 2);
constexpr size_t OFF_S = al256(OFF_P + (size_t)NTOK * PINP * 4);
constexpr size_t TOK256F = (size_t)NTOK * 256 * 4;
constexpr size_t S_QN = 0;
constexpr size_t S_KN = S_QN + (size_t)NTOK * 512 * 2;
constexpr size_t S_VT = S_KN + (size_t)NTOK * 512 * 2;
constexpr size_t S_RWR = S_VT + (size_t)NB * 8 * 64 * TTOK * 2;
constexpr size_t S_RWKK = S_RWR + TOK256F;
constexpr size_t S_RWV = S_RWKK + TOK256F;
constexpr size_t S_RWG = S_RWV + TOK256F;
constexpr size_t S_RWW = S_RWG + TOK256F;
constexpr size_t S_RWKD = S_RWW + 2 * TOK256F;
constexpr size_t S_RWB = S_RWKD + 2 * TOK256F;
constexpr size_t S_BON = S_RWB + 2 * TOK256F;
constexpr size_t S_GDQ = al256(S_BON + (size_t)NTOK * 4 * 4);
constexpr size_t S_GDK = S_GDQ + TOK256F;
constexpr size_t S_GDV = S_GDK + TOK256F;
constexpr size_t S_GDAB = S_GDV + TOK256F;
constexpr size_t S_YRW = al256(S_GDAB + (size_t)NTOK * 16 * 4);
constexpr size_t S_YGD = S_YRW + 2 * TOK256F;
constexpr size_t S_END = S_YGD + 2 * TOK256F;
constexpr size_t S_SIZE = (S_END > (size_t)NSLOT_MAX * 1024 * 4) ? S_END : (size_t)NSLOT_MAX * 1024 * 4;
constexpr int NCHUNK = TTOK / 64;
constexpr int NCHAIN = 32;
constexpr size_t OFF_CH = al256(OFF_S + S_SIZE);
constexpr size_t CH_N = (size_t)NCHAIN * NCHUNK;
constexpr size_t CH_REC = 32768, CH_PT = 0, CH_RYT = 8192, CH_QT = 16384, CH_YX = 24576;
constexpr size_t CH_SIZE = CH_N * CH_REC;
constexpr size_t WS_TOTAL = OFF_CH + CH_SIZE;
static_assert(WS_TOTAL <= (size_t)2048 * 1024 * 1024, "workspace exceeds 4x largest tensor");

struct Params {
  const float *x, *c, *ctx, *c_ctx, *ada_w, *ada_b, *norm_mix_g, *norm_ffn_g, *w_in, *w_out;
  const float *na_q_gain, *na_k_gain, *na_rpb;
  const float *rw_mu, *rw_w0, *rw_w_up, *rw_a0, *rw_a_up, *rw_g_up, *rw_k_k, *rw_k_a, *rw_r_k, *rw_ln_w, *rw_ln_b;
  const float *gd_conv_w, *gd_A_log, *gd_dt_bias, *gd_norm_g;
  const float *moe_router_w, *moe_router_b, *moe_w_gu, *moe_b_gu, *moe_w_down, *moe_b_down;
  float* out;
  char* ws;
};

typedef const __attribute__((address_space(4))) Params* PP;
#define p (*pp)
__device__ __forceinline__ char* fresh_ws(PP pp) { return p.ws; }
__device__ __forceinline__ int tid_opaque() { int t = (int)__builtin_amdgcn_workitem_id_x(); asm volatile("" : "+v"(t)); return t; }
__device__ __forceinline__ int opq(int x) { asm volatile("" : "+s"(x)); return x; }
__device__ __forceinline__ int wave_id(int tid) { return __builtin_amdgcn_readfirstlane(tid >> 6); }
typedef __bf16 bf16v2_t __attribute__((ext_vector_type(2)));
typedef float f32v2_t __attribute__((ext_vector_type(2)));
__device__ __forceinline__ unsigned pk_bf16(float lo, float hi) { f32v2_t v = {lo, hi}; return __builtin_bit_cast(unsigned, __builtin_convertvector(v, bf16v2_t)); }
__device__ __forceinline__ bfr f2bf(float f) { return (bfr)(pk_bf16(f, f) & 0xffffu); }
__device__ __forceinline__ float bf2f(short v) { return __uint_as_float(((unsigned)(unsigned short)v) << 16); }
__device__ __forceinline__ bf16x4 pack4(float a, float b, float c, float d) {
  typedef __attribute__((ext_vector_type(2))) unsigned u32x2;
  u32x2 w; w[0] = pk_bf16(a, b); w[1] = pk_bf16(c, d);
  return __builtin_bit_cast(bf16x4, w);
}
__device__ __forceinline__ bf16x8 pack8(f32x4 a, f32x4 b) {
  const bf16x4 lo = pack4(a[0], a[1], a[2], a[3]), hi = pack4(b[0], b[1], b[2], b[3]);
  return __builtin_shufflevector(lo, hi, 0, 1, 2, 3, 4, 5, 6, 7);
}
__device__ __forceinline__ int perm_row32(int n) { return (n & ~31) | (((n >> 2) & 1) << 4) | (((n >> 3) & 3) << 2) | (n & 3); }
__device__ __forceinline__ float sigmoidf_(float x) { return __builtin_amdgcn_rcpf(1.f + __expf(-x)); }
__device__ __forceinline__ float siluf_(float x) { return x * __builtin_amdgcn_rcpf(1.f + __expf(-x)); }
__device__ __forceinline__ float softplusf_(float x) { const float e = __expf(fminf(x, 20.f)); const float lg = __logf(1.f + e); const float r = x < -15.f ? e : lg; return x > 20.f ? x : r; }
__device__ __forceinline__ float wave_sum(float v) {
  v += __builtin_bit_cast(float, __builtin_amdgcn_update_dpp(0, __builtin_bit_cast(int, v), 0xB1, 0xF, 0xF, true));
  v += __builtin_bit_cast(float, __builtin_amdgcn_update_dpp(0, __builtin_bit_cast(int, v), 0x4E, 0xF, 0xF, true));
  v += __builtin_bit_cast(float, __builtin_amdgcn_update_dpp(0, __builtin_bit_cast(int, v), 0x141, 0xF, 0xF, true));
  v += __builtin_bit_cast(float, __builtin_amdgcn_update_dpp(0, __builtin_bit_cast(int, v), 0x140, 0xF, 0xF, true));
  v += __builtin_bit_cast(float, __builtin_amdgcn_update_dpp(0, __builtin_bit_cast(int, v), 0x142, 0xA, 0xF, false));
  v += __builtin_bit_cast(float, __builtin_amdgcn_update_dpp(0, __builtin_bit_cast(int, v), 0x143, 0xC, 0xF, false));
  return __builtin_bit_cast(float, __builtin_amdgcn_readlane(__builtin_bit_cast(int, v), 63));
}
__device__ __forceinline__ float wave_max(float v) {
  v = fmaxf(v, __builtin_bit_cast(float, __builtin_amdgcn_update_dpp(0, __builtin_bit_cast(int, v), 0xB1, 0xF, 0xF, true)));
  v = fmaxf(v, __builtin_bit_cast(float, __builtin_amdgcn_update_dpp(0, __builtin_bit_cast(int, v), 0x4E, 0xF, 0xF, true)));
  v = fmaxf(v, __builtin_bit_cast(float, __builtin_amdgcn_update_dpp(0, __builtin_bit_cast(int, v), 0x141, 0xF, 0xF, true)));
  v = fmaxf(v, __builtin_bit_cast(float, __builtin_amdgcn_update_dpp(0, __builtin_bit_cast(int, v), 0x140, 0xF, 0xF, true)));
  const float r1 = __builtin_bit_cast(float, __builtin_amdgcn_readlane(__builtin_bit_cast(int, v), 0));
  const float r2 = __builtin_bit_cast(float, __builtin_amdgcn_readlane(__builtin_bit_cast(int, v), 16));
  const float r3 = __builtin_bit_cast(float, __builtin_amdgcn_readlane(__builtin_bit_cast(int, v), 32));
  const float r4 = __builtin_bit_cast(float, __builtin_amdgcn_readlane(__builtin_bit_cast(int, v), 48));
  return fmaxf(fmaxf(r1, r2), fmaxf(r3, r4));
}
__device__ __forceinline__ float shfl_xor_l(float v, int mask, int lane) {
  return __builtin_bit_cast(float, __builtin_amdgcn_ds_bpermute((lane ^ mask) << 2, __builtin_bit_cast(int, v)));
}
__device__ __forceinline__ int shfl_xor_li(int v, int mask, int lane) {
  return __builtin_amdgcn_ds_bpermute((lane ^ mask) << 2, v);
}
__device__ __forceinline__ float row16_sum(float v) {
  v += __builtin_bit_cast(float, __builtin_amdgcn_update_dpp(0, __builtin_bit_cast(int, v), 0xB1, 0xF, 0xF, true));
  v += __builtin_bit_cast(float, __builtin_amdgcn_update_dpp(0, __builtin_bit_cast(int, v), 0x4E, 0xF, 0xF, true));
  v += __builtin_bit_cast(float, __builtin_amdgcn_update_dpp(0, __builtin_bit_cast(int, v), 0x141, 0xF, 0xF, true));
  v += __builtin_bit_cast(float, __builtin_amdgcn_update_dpp(0, __builtin_bit_cast(int, v), 0x140, 0xF, 0xF, true));
  return v;
}
__device__ __forceinline__ float quant_row_store(const float4 (&v)[4], signed char* dst_row, int lane) {
  float am = 0.f;
#pragma unroll
  for (int i = 0; i < 4; ++i) am = fmaxf(fmaxf(am, fmaxf(fabsf(v[i].x), fabsf(v[i].y))), fmaxf(fabsf(v[i].z), fabsf(v[i].w)));
  am = wave_max(am);
  const float sc = am > 0.f ? am * (1.f / 127.f) : 1.f, iv = 1.f / sc;
#pragma unroll
  for (int i = 0; i < 4; ++i) {
    const int q0 = (int)fminf(fmaxf(rintf(v[i].x * iv), -127.f), 127.f), q1 = (int)fminf(fmaxf(rintf(v[i].y * iv), -127.f), 127.f);
    const int q2 = (int)fminf(fmaxf(rintf(v[i].z * iv), -127.f), 127.f), q3 = (int)fminf(fmaxf(rintf(v[i].w * iv), -127.f), 127.f);
    *(unsigned*)(dst_row + (lane + 64 * i) * 4) = (unsigned)(q0 & 0xff) | ((unsigned)(q1 & 0xff) << 8) | ((unsigned)(q2 & 0xff) << 16) | ((unsigned)(q3 & 0xff) << 24);
  }
  return sc;
}
__device__ __forceinline__ float ldbf1(const bfr* q, size_t i) { return bf2f((short)q[i]); }
__device__ __forceinline__ f32x4 ldbf4(const bfr* q) { const bf16x4 v = *(const bf16x4*)q; return (f32x4){bf2f(v[0]), bf2f(v[1]), bf2f(v[2]), bf2f(v[3])}; }
__device__ __forceinline__ int mod_row(int m) { return m < NLAT ? (m >> 14) : 2; }

__device__ __forceinline__ void phase_ada(PP pp, int bid, int nb, char* smem) {
  float* red = (float*)smem;
  float* mods = (float*)(p.ws + OFF_MODS);
  const int tid = tid_opaque();
  for (int task = bid; task < 2 * 96; task += nb) {
    int l = task / 96, cgp = task % 96;
    int col = cgp * 64 + (tid & 63), ks = tid >> 6;
    const float* W = p.ada_w + (size_t)l * 1024 * 6144;
    float a0 = 0.f, a1 = 0.f, a2 = 0.f;
    for (int d = ks * 128; d < ks * 128 + 128; ++d) {
      float w = W[(size_t)d * 6144 + col];
      a0 += siluf_(p.c[d]) * w;
      a1 += siluf_(p.c[1024 + d]) * w;
      a2 += siluf_(p.c_ctx[d]) * w;
    }
    red[(ks * 3 + 0) * 64 + (tid & 63)] = a0;
    red[(ks * 3 + 1) * 64 + (tid & 63)] = a1;
    red[(ks * 3 + 2) * 64 + (tid & 63)] = a2;
    __syncthreads();
    if (tid < 192) {
      int r = tid >> 6, cc = tid & 63;
      float s = 0.f;
      for (int k = 0; k < 8; ++k) s += red[(k * 3 + r) * 64 + cc];
      mods[(size_t)(l * 3 + r) * 6144 + cgp * 64 + cc] = s + p.ada_b[(size_t)l * 6144 + cgp * 64 + cc];
    }
    __syncthreads();
  }
}

template <bool PERM>
__device__ __forceinline__ void convert_tile(const float* src, int N, bfr* dst, int kt4  , int nt, float* tile  ) {
  const int tid = tid_opaque();
  float4 v[8];
#pragma unroll
  for (int q = 0; q < 8; ++q) {
    const int idx = tid + q * 512;
    const int kk = idx >> 4, n4 = idx & 15;
    v[q] = *(const float4*)(src + (size_t)(kt4 * 256 + kk) * N + nt * 64 + n4 * 4);
  }
#pragma unroll
  for (int q = 0; q < 8; ++q) {
    const int idx = tid + q * 512;
    const int kk = idx >> 4, n4 = idx & 15;
    tile[kk * 65 + n4 * 4 + 0] = v[q].x; tile[kk * 65 + n4 * 4 + 1] = v[q].y;
    tile[kk * 65 + n4 * 4 + 2] = v[q].z; tile[kk * 65 + n4 * 4 + 3] = v[q].w;
  }
  __syncthreads();
  {
    const int nn = tid >> 3, kc = tid & 7;
    const int n = PERM ? perm_row32(nt * 64 + nn) : nt * 64 + nn;
#pragma unroll
    for (int q = 0; q < 4; ++q) {
      const int k0 = (kc + 8 * q) * 8;
      *(bf16x4*)(dst + (size_t)n * 1024 + kt4 * 256 + k0) = pack4(tile[(k0 + 0) * 65 + nn], tile[(k0 + 1) * 65 + nn], tile[(k0 + 2) * 65 + nn], tile[(k0 + 3) * 65 + nn]);
      *(bf16x4*)(dst + (size_t)n * 1024 + kt4 * 256 + k0 + 4) = pack4(tile[(k0 + 4) * 65 + nn], tile[(k0 + 5) * 65 + nn], tile[(k0 + 6) * 65 + nn], tile[(k0 + 7) * 65 + nn]);
    }
  }
  __syncthreads();
}
template <int N, bool INTERLEAVE>
__device__ __forceinline__ void convert_i8(const float* src  , signed char* dst  , float* sw, int ng, char* smem) {
  const int tid = tid_opaque();
  bfr* blk = (bfr*)smem;
  int* cmax = (int*)(smem + 131072);
  if (tid < 64) cmax[tid] = 0;
  __syncthreads();
  {
    const int n4 = tid & 15, kk0 = tid >> 4;
    float m0 = 0.f, m1 = 0.f, m2 = 0.f, m3 = 0.f;
#pragma unroll 8
    for (int ps = 0; ps < 32; ++ps) {
      const int k = ps * 32 + kk0;
      const int ncol = ng * 64 + n4 * 4;
      const int ncl = (N % 64 == 0) ? ncol : min(ncol, N - 4);
      float4 v = *(const float4*)(src + (size_t)k * N + ncl);
      if (N % 64 != 0 && ncol != ncl) v = make_float4(0.f, 0.f, 0.f, 0.f);
      m0 = fmaxf(m0, fabsf(v.x)); m1 = fmaxf(m1, fabsf(v.y)); m2 = fmaxf(m2, fabsf(v.z)); m3 = fmaxf(m3, fabsf(v.w));
      *(bf16x4*)(blk + k * 64 + n4 * 4) = pack4(v.x, v.y, v.z, v.w);
    }
    atomicMax(&cmax[n4 * 4 + 0], __float_as_int(m0)); atomicMax(&cmax[n4 * 4 + 1], __float_as_int(m1));
    atomicMax(&cmax[n4 * 4 + 2], __float_as_int(m2)); atomicMax(&cmax[n4 * 4 + 3], __float_as_int(m3));
  }
  __syncthreads();
  {
    const int nn = tid >> 3, kc = tid & 7;
    const int n = ng * 64 + nn;
    const float am = __int_as_float(cmax[nn]);
    const float sc = am > 0.f ? am * (1.f / 127.f) : 1.f, iv = 1.f / sc;
    const int j = n & 1023;
    const int row = INTERLEAVE ? (j >> 7) * 256 + ((j >> 2) & 1) * 128 + ((j >> 5) & 3) * 32 + ((n >= 1024) ? 16 : 0) + ((j >> 3) & 3) * 4 + (j & 3) : perm_row32(n);
    if (kc == 0) sw[n] = sc;
#pragma unroll 2
    for (int q = 0; q < 8; ++q) {
      const int k0 = (kc + 8 * q) * 16;
      unsigned w[4];
#pragma unroll
      for (int g4 = 0; g4 < 4; ++g4) {
        unsigned acc = 0u;
#pragma unroll
        for (int b = 0; b < 4; ++b) {
          const float v = bf2f((short)blk[(k0 + g4 * 4 + b) * 64 + nn]);
          const int qi = (int)fminf(fmaxf(rintf(v * iv), -127.f), 127.f);
          acc |= ((unsigned)(qi & 0xff)) << (8 * b);
        }
        w[g4] = acc;
      }
      *(uint4*)(dst + (size_t)row * 1024 + k0) = make_uint4(w[0], w[1], w[2], w[3]);
    }
  }
  __syncthreads();
}
__device__ __forceinline__ void phase_convert(PP pp, int l, int part, int bid, int nb, char* smem) {
  float* tile = (float*)smem;
  char* wl = p.ws + OFF_W + (size_t)l * WL_SIZE;
  const int T_IN = 56, T_OUT = 4 * 16, T_GU = 32 * 32, T_DN = 32 * 4 * 16;
  const int t_lo = part == 0 ? 0 : T_IN + T_OUT;
  const int t_hi = part == 0 ? T_IN + T_OUT : T_IN + T_OUT + T_GU + T_DN;
  for (int t = t_lo + bid; t < t_hi; t += nb) {
    if (t < T_IN) {
      convert_i8<PIN, false>(p.w_in + (size_t)l * 1024 * PIN, (signed char*)(wl + WL_IN), (float*)(p.ws + OFF_SWIN) + (size_t)l * PINP, t, smem);
    } else if (t < T_IN + T_OUT) {
      int u = t - T_IN; int kt4 = u / 16, nt = u % 16;
      convert_tile<false>(p.w_out + (size_t)l * 1024 * 1024, 1024, (bfr*)(wl + WL_OUT), kt4, nt, tile);
    } else if (t < T_IN + T_OUT + T_GU) {
      int u = t - T_IN - T_OUT; int e = u / 32, ng = u % 32;
      convert_i8<2048, true>(p.moe_w_gu + ((size_t)l * 32 + e) * 1024 * 2048, (signed char*)(wl + WL_GU) + (size_t)e * 2048 * 1024,
                    (float*)(p.ws + OFF_SW) + ((size_t)l * 32 + e) * 2048, ng, smem);
    } else {
      int u = t - T_IN - T_OUT - T_GU; int e = u / 64; int v = u % 64; int kt4 = v / 16, nt = v % 16;
      convert_tile<true>(p.moe_w_down + ((size_t)l * 32 + e) * 1024 * 1024, 1024, (bfr*)(wl + WL_DN) + (size_t)e * 1024 * 1024, kt4, nt, tile);
    }
  }
}

__device__ __forceinline__ void phase_prenorm(PP pp, int l, int bid, int nb) {
  const int tid = tid_opaque(), lane = tid & 63, wv = wave_id(tid);
  const float* xl = (l == 0) ? p.x : p.out;
  const float* xc = (l == 0) ? p.ctx : (const float*)(p.ws + OFF_CTX);
  const float* mods = (const float*)(p.ws + OFF_MODS) + (size_t)l * 3 * 6144;
  const float* g = p.norm_mix_g + (size_t)l * 1024;
  signed char* H8 = (signed char*)(p.ws + OFF_H);
  float* SCL = (float*)(p.ws + OFF_SCL);
  {
    int* cnt = (int*)(p.ws + OFF_CNT);
    int gt = bid * NTHR + tid;
    if (gt < 32) cnt[gt] = 0;
  }
  for (int m = bid * 8 + wv; m < NTOK; m += nb * 8) {
    const float* xr = (m < NLAT) ? xl + (size_t)m * 1024 : xc + (size_t)(m - NLAT) * 1024;
    const float* md = mods + (size_t)mod_row(m) * 6144;
    float4 v[4];
    float ss = 0.f;
#pragma unroll
    for (int i = 0; i < 4; ++i) {
      v[i] = *(const float4*)(xr + (lane + 64 * i) * 4);
      ss += v[i].x * v[i].x + v[i].y * v[i].y + v[i].z * v[i].z + v[i].w * v[i].w;
    }
    ss = wave_sum(ss);
    float rs = rsqrtf(ss * (1.f / 1024.f) + 1e-6f);
    float4 hq[4];
#pragma unroll
    for (int i = 0; i < 4; ++i) {
      int d = (lane + 64 * i) * 4;
      float4 gg = *(const float4*)(g + d);
      float4 sh = *(const float4*)(md + d);
      float4 sc = *(const float4*)(md + 1024 + d);
      hq[i] = make_float4(v[i].x * rs * gg.x * (1.f + sc.x) + sh.x, v[i].y * rs * gg.y * (1.f + sc.y) + sh.y,
                          v[i].z * rs * gg.z * (1.f + sc.z) + sh.z, v[i].w * rs * gg.w * (1.f + sc.w) + sh.w);
    }
    const float qs = quant_row_store(hq, H8 + (size_t)m * 1024, lane);
    if (lane == 0) SCL[m] = qs;
  }
}

#define LAS __attribute__((address_space(3)))
namespace g8 {
constexpr int BM = 256, BK = 64, HALF = 128, HTB = HALF * BK * 2, STAGE_BYTES = 8 * HTB, KD = 1024;
__device__ __forceinline__ int lds_byte(int r, int c) { const int st = (r >> 4) * 2 + (c >> 5), rr = r & 15, cc = c & 31, ob = rr * 64 + cc * 2; return st * 1024 + (ob ^ (((ob >> 9) & 1) << 5)); }
__device__ __forceinline__ void stage_rc(int b, int& R, int& C) { const int st = b / 1024, sb = b % 1024, swz = sb ^ (((sb >> 9) & 1) << 5); R = (st >> 1) * 16 + swz / 64; C = (st & 1) * 32 + (swz % 64) / 2; }
struct GUnit { int pm, pn, brow0, e; };
__device__ __forceinline__ int unit_index(int i, int c, int G, int total) {
  const int x = c & 7, j = c >> 3, q = total >> 3, r = total & 7;
  const int start = x < r ? x * (q + 1) : r * (q + 1) + (x - r) * q;
  const int size = q + (x < r ? 1 : 0);
  const int li = i * (G >> 3) + j;
  return li < size ? start + li : -1;
}

__device__ __forceinline__ f32x4 mma16(bf16x8 a, bf16x8 b, f32x4 c) { return __builtin_amdgcn_mfma_f32_16x16x32_bf16(a, b, c, 0, 0, 0); }
__device__ __forceinline__ i32x4 mma16(i32x4 a, i32x4 b, i32x4 c) { return __builtin_amdgcn_mfma_i32_16x16x64_i8(a, b, c, 0, 0, 0); }
template <bool I8, bool GATHER, class Sched, class Epi>
__device__ __forceinline__ void gemm_stream(LAS unsigned char* lds, const void* Abase, const void* Btbase, const Sched& S, const Epi& E, const int* slt = nullptr) {
  typedef typename std::conditional<I8, i32x4, f32x4>::type AccT;
  typedef typename std::conditional<I8, i32x4, bf16x8>::type FragT;
  constexpr int KB = I8 ? KD : KD * 2;
  const int tid = tid_opaque(), wid = __builtin_amdgcn_readfirstlane(tid >> 6), lane = tid & 63, wr = wid >> 2, wc = wid & 3, fr = lane & 15, fq = lane >> 4;
  constexpr int nt = KB / 128;
  int R[2], C[2];
  unsigned voffB[2];
#pragma unroll
  for (int i = 0; i < 2; ++i) { stage_rc(tid * 16 + i * 8192, R[i], C[i]); voffB[i] = (unsigned)(R[i] * KB + C[i] * 2); }
#define voffA voffB
  constexpr size_t kstep = (size_t)(BK * 2);
  constexpr size_t hstep = (size_t)HALF * KB;
  const unsigned ldsw = (unsigned)wid * 1024u;
  const int aoff = lds_byte(wr * 64 + fr, fq * 8), boff = lds_byte(wc * 32 + fr, fq * 8);
#define G8_SA(b, h) (((b) * 2 + (h)) * HTB)
#define G8_SB(b, h) ((4 + (b) * 2 + (h)) * HTB)
#define G8_STAGE(bufoff, gbase, v0, v1) do { \
    __builtin_amdgcn_global_load_lds((const unsigned*)((const char*)(gbase) + (v0)), (LAS unsigned*)(lds + (bufoff) + ldsw), 16, 0, 0); \
    __builtin_amdgcn_global_load_lds((const unsigned*)((const char*)(gbase) + (v1)), (LAS unsigned*)(lds + (bufoff) + ldsw + 8192), 16, 0, 0); } while (0)
#define G8_STAGEB(bufoff, gbase) G8_STAGE(bufoff, gbase, voffB[0], voffB[1])
#define G8_STAGEA_U(bufoff, base_u, hsel) G8_STAGE(bufoff, (base_u) + (hsel) * hstep, voffA[0], voffA[1])
#define G8_STAGEA_G(bufoff, koff, o0, o1) G8_STAGE(bufoff, (const char*)Abase + (koff), o0, o1)
#define G8_LDA(dst, b, h) do { _Pragma("unroll") for (int m = 0; m < 4; ++m) _Pragma("unroll") for (int k = 0; k < 2; ++k) dst[m][k] = *(const LAS FragT*)(lds + G8_SA(b, h) + aoff + m * 2048 + k * 1024); } while (0)
#define G8_LDB(dst, b, h) do { _Pragma("unroll") for (int n = 0; n < 2; ++n) _Pragma("unroll") for (int k = 0; k < 2; ++k) dst[n][k] = *(const LAS FragT*)(lds + G8_SB(b, h) + boff + n * 2048 + k * 1024); } while (0)
#define G8_MMA(ai, bj, At, Bt) do { __builtin_amdgcn_s_setprio(1); _Pragma("unroll") for (int m = 0; m < 4; ++m) _Pragma("unroll") for (int n = 0; n < 2; ++n) _Pragma("unroll") for (int k = 0; k < 2; ++k) \
    acc[ai][bj][m][n] = mma16(Bt[n][k], At[m][k], acc[ai][bj][m][n]); __builtin_amdgcn_s_setprio(0); } while (0)
#define G8_WAIT_V(n) asm volatile("s_waitcnt vmcnt(" #n ")" ::: "memory")
#define G8_WAIT_L(n) asm volatile("s_waitcnt lgkmcnt(" #n ")" ::: "memory")
#define G8_BAR __builtin_amdgcn_s_barrier()
#define G8_SCHED __builtin_amdgcn_sched_barrier(0)
  GUnit cur, nxt;
  int ui = 0;
  if (!S.next(0, cur)) return;
  AccT acc[2][2][4][2];
#pragma unroll
  for (int a = 0; a < 2; ++a)
#pragma unroll
    for (int b = 0; b < 2; ++b)
#pragma unroll
      for (int m = 0; m < 4; ++m)
#pragma unroll
        for (int n = 0; n < 2; ++n) acc[a][b][m][n] = AccT{};
  FragT At[4][2], B0[2][2], B1[2][2];
  const char* cA = (const char*)Abase + (size_t)cur.pm * (BM * KB);
  unsigned gA00 = 0, gA01 = 0, gA10 = 0, gA11 = 0, gN00 = 0, gN01 = 0, gN10 = 0, gN11 = 0;
  if (GATHER) {
    const int* sr = slt + cur.pm * BM;
    gA00 = (unsigned)sr[R[0]] * KB + C[0] * 2; gA01 = (unsigned)sr[R[1]] * KB + C[1] * 2;
    gA10 = (unsigned)sr[HALF + R[0]] * KB + C[0] * 2; gA11 = (unsigned)sr[HALF + R[1]] * KB + C[1] * 2;
  }
  const char* cB = (const char*)Btbase + (size_t)cur.brow0 * KB;
  G8_STAGEB(G8_SB(0, 0), cB);
  if (GATHER) G8_STAGEA_G(G8_SA(0, 0), 0, gA00, gA01); else G8_STAGEA_U(G8_SA(0, 0), cA, 0);
  G8_STAGEB(G8_SB(0, 1), cB + hstep);
  if (GATHER) G8_STAGEA_G(G8_SA(0, 1), 0, gA10, gA11); else G8_STAGEA_U(G8_SA(0, 1), cA, 1);
  if (wr == 1) G8_BAR;
  G8_WAIT_V(4); G8_BAR;
  G8_STAGEB(G8_SB(1, 0), cB + kstep);
  if (GATHER) G8_STAGEA_G(G8_SA(1, 0), kstep, gA00, gA01); else G8_STAGEA_U(G8_SA(1, 0), cA + kstep, 0);
  G8_STAGEB(G8_SB(1, 1), cB + hstep + kstep);
  G8_WAIT_V(6); G8_BAR;
  for (;;) {
    const bool has_next = S.next(ui + 1, nxt);
    const char* nA = has_next ? (const char*)Abase + (size_t)nxt.pm * (BM * KB) : cA;
    if (GATHER) {
      if (has_next) {
        const int* sr = slt + nxt.pm * BM;
        gN00 = (unsigned)sr[R[0]] * KB + C[0] * 2; gN01 = (unsigned)sr[R[1]] * KB + C[1] * 2;
        gN10 = (unsigned)sr[HALF + R[0]] * KB + C[0] * 2; gN11 = (unsigned)sr[HALF + R[1]] * KB + C[1] * 2;
      } else { gN00 = gA00; gN01 = gA01; gN10 = gA10; gN11 = gA11; }
    }
    const char* nB = has_next ? (const char*)Btbase + (size_t)nxt.brow0 * KB : cB;
#pragma unroll 1
    for (int t = 0; t < nt; t += 2) {
      const bool last = (t == nt - 2);
      const char* a1 = cA + (size_t)(t + 1) * kstep;
      const char* a2 = last ? nA : cA + (size_t)(t + 2) * kstep;
      const char* b2 = last ? nB : cB + (size_t)(t + 2) * kstep;
      const char* a3 = a2 + kstep;
      const char* b3 = b2 + kstep;
      const size_t k1 = (size_t)(t + 1) * kstep, k2 = last ? 0 : (size_t)(t + 2) * kstep, k3 = k2 + kstep;
      const unsigned w00 = last ? gN00 : gA00, w01 = last ? gN01 : gA01, w10 = last ? gN10 : gA10, w11 = last ? gN11 : gA11;
      G8_LDB(B0, 0, 0); G8_SCHED; G8_LDA(At, 0, 0); if (GATHER) G8_STAGEA_G(G8_SA(1, 1), k1, gA10, gA11); else G8_STAGEA_U(G8_SA(1, 1), a1, 1);
      G8_WAIT_L(8); G8_BAR; G8_WAIT_L(0); G8_MMA(0, 0, At, B0); G8_BAR; G8_SCHED;
      G8_LDB(B1, 0, 1); G8_STAGEB(G8_SB(0, 0), b2);
      G8_BAR; G8_WAIT_L(0); G8_MMA(0, 1, At, B1); G8_BAR;
      G8_LDA(At, 0, 1); if (GATHER) G8_STAGEA_G(G8_SA(0, 0), k2, w00, w01); else G8_STAGEA_U(G8_SA(0, 0), a2, 0);
      G8_BAR; G8_WAIT_L(0); G8_MMA(1, 0, At, B0); G8_BAR; G8_SCHED;
      G8_STAGEB(G8_SB(0, 1), b2 + hstep);
      G8_WAIT_V(6); G8_BAR; G8_MMA(1, 1, At, B1); G8_BAR;
      G8_LDB(B0, 1, 0); G8_SCHED; G8_LDA(At, 1, 0); if (GATHER) G8_STAGEA_G(G8_SA(0, 1), k2, w10, w11); else G8_STAGEA_U(G8_SA(0, 1), a2, 1);
      G8_WAIT_L(8); G8_BAR; G8_WAIT_L(0); G8_MMA(0, 0, At, B0); G8_BAR; G8_SCHED;
      G8_LDB(B1, 1, 1); G8_STAGEB(G8_SB(1, 0), b3);
      G8_BAR; G8_WAIT_L(0); G8_MMA(0, 1, At, B1); G8_BAR;
      G8_LDA(At, 1, 1); if (GATHER) G8_STAGEA_G(G8_SA(1, 0), k3, w00, w01); else G8_STAGEA_U(G8_SA(1, 0), a3, 0);
      G8_BAR; G8_WAIT_L(0); G8_MMA(1, 0, At, B0); G8_BAR; G8_SCHED;
      G8_STAGEB(G8_SB(1, 1), b3 + hstep);
      G8_WAIT_V(6); G8_BAR; G8_MMA(1, 1, At, B1); G8_BAR;
    }
    E(acc, cur, wr, wc, fr, fq);
    if (!has_next) break;
#pragma unroll
    for (int a = 0; a < 2; ++a)
#pragma unroll
      for (int b = 0; b < 2; ++b)
#pragma unroll
        for (int m = 0; m < 4; ++m)
#pragma unroll
          for (int n = 0; n < 2; ++n) acc[a][b][m][n] = AccT{};
    cur = nxt; cA = nA; cB = nB; ++ui;
    gA00 = gN00; gA01 = gN01; gA10 = gN10; gA11 = gN11;
  }
  G8_WAIT_V(0);
  if (wr == 0) G8_BAR;
  G8_BAR;
#undef G8_SA
#undef G8_SB
#undef G8_STAGE
#undef G8_STAGEB
#undef G8_STAGEA_U
#undef G8_STAGEA_G
#undef voffA
#undef G8_LDA
#undef G8_LDB
#undef G8_MMA
#undef G8_WAIT_V
#undef G8_WAIT_L
#undef G8_BAR
#undef G8_SCHED
}

struct DenseSched {
  int nM, nN, G, c;
  __device__ __forceinline__ bool next(int i, GUnit& u) const {
    const int idx = unit_index(i, c, G, nM * nN);
    if (idx < 0) return false;
    u.pm = idx / nN; u.pn = idx - u.pm * nN; u.brow0 = u.pn * BM; u.e = 0;
    return true;
  }
};
struct MoeSched {
  const int* toff; int nN, NE, G, c;
  __device__ __forceinline__ bool next(int i, GUnit& u) const {
    const int idx = unit_index(i, c, G, toff[32] * nN);
    if (idx < 0) return false;
    u.pm = idx / nN; u.pn = idx - u.pm * nN;
    const int e = toff[128 + u.pm];
    u.e = e; u.brow0 = e * NE + u.pn * BM;
    return true;
  }
};
}

struct EpiInProj {
  bfr* P; const float* SCL; const float* sw;
  __device__ __forceinline__ void operator()(const i32x4 (&acc)[2][2][4][2], const g8::GUnit& u, int wr, int wc, int fr, int fq) const {
    const int row0 = u.pm * 256 + wr * 64 + fr, col0 = u.pn * 256 + wc * 32 + 8 * fq;
    f32x4 cs[2][2];
#pragma unroll
    for (int bj = 0; bj < 2; ++bj)
#pragma unroll
      for (int n = 0; n < 2; ++n) cs[bj][n] = *(const f32x4*)(sw + col0 + bj * 128 + n * 4);
    float sav[2][4];
#pragma unroll
    for (int ai = 0; ai < 2; ++ai)
#pragma unroll
      for (int m = 0; m < 4; ++m) sav[ai][m] = SCL[row0 + ai * 128 + m * 16];
#pragma unroll
    for (int ai = 0; ai < 2; ++ai)
#pragma unroll
      for (int m = 0; m < 4; ++m) {
        const int row = row0 + ai * 128 + m * 16;
        const float sa = sav[ai][m];
        bfr* rowp = P + (size_t)row * PINP + col0;
#pragma unroll
        for (int bj = 0; bj < 2; ++bj) {
          const i32x4 a0 = acc[ai][bj][m][0], a1 = acc[ai][bj][m][1];
          f32x4 o0 = {(float)a0[0], (float)a0[1], (float)a0[2], (float)a0[3]};
          f32x4 o1 = {(float)a1[0], (float)a1[1], (float)a1[2], (float)a1[3]};
          o0 = o0 * (cs[bj][0] * sa); o1 = o1 * (cs[bj][1] * sa);
          *(bf16x8*)(rowp + bj * 128) = pack8(o0, o1);
        }
      }
  }
};
__device__ __forceinline__ void phase_gemm_in(PP pp, int l, int bid, int nb, char* smem) {
  g8::DenseSched S{130, 14, nb, bid};
  EpiInProj E{(bfr*)(p.ws + OFF_P), (const float*)(p.ws + OFF_SCL), (const float*)(p.ws + OFF_SWIN) + (size_t)l * PINP};
  g8::gemm_stream<true, false>((LAS unsigned char*)smem, p.ws + OFF_H, p.ws + OFF_W + (size_t)l * WL_SIZE + WL_IN, S, E);
}

struct EpiOutProj {
  const float *xl, *xc, *mods; float *ol, *oc;
  __device__ __forceinline__ void operator()(const f32x4 (&acc)[2][2][4][2], const g8::GUnit& u, int wr, int wc, int fr, int fq) const {
    const bool lat = u.pm < 128;
    const float* xin = lat ? xl + (size_t)u.pm * 256 * 1024 : xc + (size_t)(u.pm - 128) * 256 * 1024;
    float* xo = lat ? ol + (size_t)u.pm * 256 * 1024 : oc + (size_t)(u.pm - 128) * 256 * 1024;
    const float* g1 = mods + (size_t)(lat ? (u.pm >> 6) : 2) * 6144 + 2048;
    const int row0 = wr * 64 + fr, col0 = u.pn * 256 + wc * 32 + 4 * fq;
#pragma unroll
    for (int bj = 0; bj < 2; ++bj)
#pragma unroll
      for (int n = 0; n < 2; ++n) {
        const f32x4 gv = *(const f32x4*)(g1 + col0 + bj * 128 + n * 16);
        f32x4 xv[2][4];
#pragma unroll
        for (int ai = 0; ai < 2; ++ai)
#pragma unroll
          for (int m = 0; m < 4; ++m) xv[ai][m] = *(const f32x4*)(xin + (size_t)(row0 + ai * 128 + m * 16) * 1024 + col0 + bj * 128 + n * 16);
#pragma unroll
        for (int ai = 0; ai < 2; ++ai)
#pragma unroll
          for (int m = 0; m < 4; ++m)
            *(f32x4*)(xo + (size_t)(row0 + ai * 128 + m * 16) * 1024 + col0 + bj * 128 + n * 16) = xv[ai][m] + gv * acc[ai][bj][m][n];
        asm volatile("" ::: "memory");
      }
  }
};
__device__ __forceinline__ void phase_gemm_out(PP pp, int l, int bid, int nb, char* smem) {
  g8::DenseSched S{(l == 0) ? 130 : 128, 4, nb, bid};
  EpiOutProj E{(l == 0) ? p.x : p.out, (l == 0) ? p.ctx : (const float*)(p.ws + OFF_CTX),
               (const float*)(p.ws + OFF_MODS) + (size_t)l * 3 * 6144, p.out, (float*)(p.ws + OFF_CTX)};
  g8::gemm_stream<false, false>((LAS unsigned char*)smem, p.ws + OFF_CC, p.ws + OFF_W + (size_t)l * WL_SIZE + WL_OUT, S, E);
}

#define LBAR() do { asm volatile("s_waitcnt lgkmcnt(0)" ::: "memory"); __builtin_amdgcn_s_barrier(); asm volatile("" ::: "memory"); } while (0)
__device__ __forceinline__ void phase_prep(PP pp, int l, int bid, int nb, char* smem) {
  const int tid = tid_opaque(), lane = tid & 63, wv = wave_id(tid);
  const bfr* P = (const bfr*)(p.ws + OFF_P);
  char* S = p.ws + OFF_S;
  bfr* QN = (bfr*)(S + S_QN);
  bfr* KN = (bfr*)(S + S_KN);
  bfr* VT = (bfr*)(S + S_VT);
  bfr* RWR = (bfr*)(S + S_RWR);
  bfr* RWKK = (bfr*)(S + S_RWKK);
  bfr* RWV = (bfr*)(S + S_RWV);
  bfr* RWG = (bfr*)(S + S_RWG);
  float* RWW = (float*)(S + S_RWW);
  bfr* RWKD = (bfr*)(S + S_RWKD);
  bfr* RWB = (bfr*)(S + S_RWB);
  float* BON = (float*)(S + S_BON);
  bfr* GDQ = (bfr*)(S + S_GDQ);
  bfr* GDK = (bfr*)(S + S_GDK);
  bfr* GDV = (bfr*)(S + S_GDV);
  float* GDAB = (float*)(S + S_GDAB);
  const float* mu = p.rw_mu + (size_t)l * 896;
  const float* w0 = p.rw_w0 + (size_t)l * 512;
  const float* w_up = p.rw_w_up + (size_t)l * 2 * 32 * 256;
  const float* a0 = p.rw_a0 + (size_t)l * 512;
  const float* a_up = p.rw_a_up + (size_t)l * 2 * 32 * 256;
  const float* g_up = p.rw_g_up + (size_t)l * 64 * 256;
  const float* k_k = p.rw_k_k + (size_t)l * 256;
  const float* k_a = p.rw_k_a + (size_t)l * 256;
  const float* r_k = p.rw_r_k + (size_t)l * 256;
  const float* conv_w = p.gd_conv_w + (size_t)l * 5 * 768;
  const float* A_log = p.gd_A_log + (size_t)l * 8;
  const float* dt_bias = p.gd_dt_bias + (size_t)l * 8;
  const float* qg = p.na_q_gain + (size_t)l * 64;
  const float* kg = p.na_k_gain + (size_t)l * 64;

  bfr* wl = (bfr*)smem;
  float* lor = (float*)(smem + 192 * 256 * 2);
  __syncthreads();
  for (int i = tid; i < 192 * 256; i += NTHR) {
    const int row = i >> 8, c = i & 255;
    const float v = row < 64 ? g_up[row * 256 + c] : row < 128 ? w_up[(row - 64) * 256 + c] : a_up[(row - 128) * 256 + c];
    wl[i] = f2bf(v);
  }
  __syncthreads();

  for (int tile = bid; tile < NTOK / 16; tile += nb) {
    const int m0 = tile * 16;
    int seq_lo, seq_hi, bb, tau0;
    if (m0 < NLAT) { bb = m0 >> 14; seq_lo = bb << 14; seq_hi = seq_lo + SEQ; tau0 = m0 - seq_lo; }
    else { bb = (m0 - NLAT) >> 8; seq_lo = NLAT + (bb << 8); seq_hi = seq_lo + CTXL; tau0 = SEQ + (m0 - seq_lo); }
    const f32x4 z4 = {0.f, 0.f, 0.f, 0.f};
    int tid_t = tid; asm volatile("" : "+v"(tid_t));
    const int lane_t = tid_t & 63;
    const int cb = lane_t * 4, hh = lane_t >> 4;
    const int lg = tid_t & 31, lt = tid_t >> 5;
    const int sl = lane_t >> 4, sc4 = (lane_t & 15) * 4;
    asm volatile("" ::: "memory");
    const f32x4 mur = *(const f32x4*)(mu + cb), muk = *(const f32x4*)(mu + 256 + cb), muv = *(const f32x4*)(mu + 512 + cb);
    const f32x4 mul = *(const f32x4*)(mu + 768 + lg * 4);

    f32x4 pr[3][4], pl[3];
    {
      const int mt0 = m0 + 2 * wv;
#pragma unroll
      for (int j = 0; j < 3; ++j)
#pragma unroll
        for (int t = 0; t < 4; ++t) {
          const int m = mt0 - 1 + t;
          const int mc = min(max(m, seq_lo), seq_hi - 1);
          const f32x4 ld = ldbf4(P + (size_t)mc * PINP + A_END + j * 256 + cb);
          pr[j][t] = (m == mc) ? ld : z4;
        }
#pragma unroll
      for (int t = 0; t < 3; ++t) {
        const int m = m0 + lt - 1 + t;
        const int mc = min(max(m, seq_lo), seq_hi - 1);
        const f32x4 ld = ldbf4(P + (size_t)mc * PINP + A_END + 768 + lg * 4);
        pl[t] = (m == mc) ? ld : z4;
      }
    }
    {
      const f32x4 v = pl[1] + mul * (0.5f * (pl[0] + pl[2]) - pl[1]);
#pragma unroll
      for (int i = 0; i < 4; ++i) {
        const int ch = lg * 4 + i;
        lor[ch * 16 + lt] = ch < 32 ? tanhf(v[i]) : ch < 64 ? v[i] : sigmoidf_(v[i]);
      }
    }
    f32x4 rr[2], rk[2], rv[2];
#pragma unroll
    for (int t = 0; t < 2; ++t) {
      rr[t] = pr[0][t + 1] + mur * (0.5f * (pr[0][t] + pr[0][t + 2]) - pr[0][t + 1]);
      rk[t] = pr[1][t + 1] + muk * (0.5f * (pr[1][t] + pr[1][t + 2]) - pr[1][t + 1]);
      rv[t] = pr[2][t + 1] + muv * (0.5f * (pr[2][t] + pr[2][t + 2]) - pr[2][t + 1]);
    }
    LBAR();
    bf16x4 pgr[20], pvr[4];
    const bf16x4 zr = {0, 0, 0, 0};
    const bool is_gd = wv < 3, is_na = (wv >= 3 && wv < 7);
    const int sec = is_gd ? wv * 4 + sl : (wv - 3) * 4 + sl;
    if (is_gd) {
#pragma unroll
      for (int t = 0; t < 20; ++t) {
        const int m = m0 - 2 + t;
        const int mc = min(max(m, seq_lo), seq_hi - 1);
        pgr[t] = *(const bf16x4*)(P + (size_t)mc * PINP + B_END + sec * 64 + sc4);
      }
    } else if (is_na) {
#pragma unroll
      for (int t = 0; t < 16; ++t) pgr[t] = *(const bf16x4*)(P + (size_t)(m0 + t) * PINP + sec * 64 + sc4);
#pragma unroll
      for (int t = 16; t < 20; ++t) pgr[t] = zr;
    } else {
#pragma unroll
      for (int t = 0; t < 20; ++t) pgr[t] = zr;
    }
    {
      const int vc = (tid_t & 127) * 4, tq = (tid_t >> 7) * 4;
#pragma unroll
      for (int t = 0; t < 4; ++t) pvr[t] = *(const bf16x4*)(P + (size_t)(m0 + tq + t) * PINP + 1024 + vc);
    }
    asm volatile("" ::: "memory");
    {
      f32x4 gacc[2], wa0[2], wa1[2], aa0[2], aa1[2];
#pragma unroll
      for (int t = 0; t < 2; ++t) { gacc[t] = z4; wa0[t] = z4; wa1[t] = z4; aa0[t] = z4; aa1[t] = z4; }
#pragma unroll 4
      for (int j = 0; j < 64; ++j) {
        const bf16x4 wq = *(const bf16x4*)(wl + j * 256 + cb);
        const f32x4 wgt = {bf2f(wq[0]), bf2f(wq[1]), bf2f(wq[2]), bf2f(wq[3])};
        const float2 sv = *(const float2*)(lor + (64 + j) * 16 + 2 * wv);
        gacc[0] += wgt * sv.x; gacc[1] += wgt * sv.y;
      }
#pragma unroll 2
      for (int j = 0; j < 32; ++j) {
        const bf16x4 q0 = *(const bf16x4*)(wl + (64 + j) * 256 + cb), q1 = *(const bf16x4*)(wl + (96 + j) * 256 + cb);
        const bf16x4 q2 = *(const bf16x4*)(wl + (128 + j) * 256 + cb), q3 = *(const bf16x4*)(wl + (160 + j) * 256 + cb);
        const f32x4 ww0 = {bf2f(q0[0]), bf2f(q0[1]), bf2f(q0[2]), bf2f(q0[3])}, ww1 = {bf2f(q1[0]), bf2f(q1[1]), bf2f(q1[2]), bf2f(q1[3])};
        const f32x4 aw0 = {bf2f(q2[0]), bf2f(q2[1]), bf2f(q2[2]), bf2f(q2[3])}, aw1 = {bf2f(q3[0]), bf2f(q3[1]), bf2f(q3[2]), bf2f(q3[3])};
        const float2 tv = *(const float2*)(lor + j * 16 + 2 * wv);
        const float2 dv = *(const float2*)(lor + (32 + j) * 16 + 2 * wv);
        wa0[0] += ww0 * tv.x; wa0[1] += ww0 * tv.y; wa1[0] += ww1 * tv.x; wa1[1] += ww1 * tv.y;
        aa0[0] += aw0 * dv.x; aa0[1] += aw0 * dv.y; aa1[0] += aw1 * dv.x; aa1[1] += aw1 * dv.y;
      }
      asm volatile("" ::: "memory");
      const f32x4 kkc = *(const f32x4*)(k_k + cb), kac = *(const f32x4*)(k_a + cb), rkc = *(const f32x4*)(r_k + cb);
      const f32x4 w00 = *(const f32x4*)(w0 + cb), w01 = *(const f32x4*)(w0 + 256 + cb), a00 = *(const f32x4*)(a0 + cb), a01 = *(const f32x4*)(a0 + 256 + cb);
#pragma unroll
      for (int t = 0; t < 2; ++t) {
        const int m = m0 + 2 * wv + t;
        const f32x4 r = rr[t], k = rk[t], v = rv[t];
        const f32x4 kkraw = k * kkc;
        const float ssum = row16_sum((kkraw[0] * kkraw[0] + kkraw[1] * kkraw[1]) + (kkraw[2] * kkraw[2] + kkraw[3] * kkraw[3]));
        const f32x4 kk = kkraw * rsqrtf(ssum + 1e-6f);
        float bon = 0.f;
#pragma unroll
        for (int d = 0; d < 2; ++d) {
          const f32x4 wlin = d == 0 ? w00 + wa0[t] : w01 + wa1[t];
          const f32x4 alin = d == 0 ? a00 + aa0[t] : a01 + aa1[t];
          f32x4 lw, kd, bv;
#pragma unroll
          for (int i = 0; i < 4; ++i) {
            const float w_log = -softplusf_(-wlin[i]) - 0.5f;
            const float a = sigmoidf_(alin[i]);
            lw[i] = -__expf(w_log);
            kd[i] = k[i] * (1.f + (a - 1.f) * kac[i]);
            bv[i] = kk[i] * a;
            bon += r[i] * kd[i] * rkc[i];
          }
          const size_t o = ((size_t)d * NTOK + m) * 256 + cb;
          *(f32x4*)(RWW + o) = lw; *(bf16x4*)(RWKD + o) = pack4(kd[0], kd[1], kd[2], kd[3]); *(bf16x4*)(RWB + o) = pack4(bv[0], bv[1], bv[2], bv[3]);
        }
        bon = row16_sum(bon);
        const size_t o = (size_t)m * 256 + cb;
        *(bf16x4*)(RWR + o) = pack4(r[0], r[1], r[2], r[3]); *(bf16x4*)(RWKK + o) = pack4(kk[0], kk[1], kk[2], kk[3]);
        *(bf16x4*)(RWV + o) = pack4(v[0], v[1], v[2], v[3]); *(bf16x4*)(RWG + o) = pack4(gacc[t][0], gacc[t][1], gacc[t][2], gacc[t][3]);
        if ((lane_t & 15) == 0) BON[(size_t)m * 4 + hh] = bon;
      }
    }
    if (is_gd) {
      f32x4 cw[5];
#pragma unroll
      for (int j = 0; j < 5; ++j) cw[j] = *(const f32x4*)(conv_w + j * 768 + sec * 64 + sc4);
      f32x4 pg[20];
#pragma unroll
      for (int t = 0; t < 20; ++t) {
        const int m = m0 - 2 + t;
        const bool inr = (m >= seq_lo) && (m < seq_hi);
        const f32x4 cv = {bf2f(pgr[t][0]), bf2f(pgr[t][1]), bf2f(pgr[t][2]), bf2f(pgr[t][3])};
        pg[t] = inr ? cv : z4;
      }
#pragma unroll
      for (int t = 0; t < 16; ++t) {
        f32x4 acc = z4;
#pragma unroll
        for (int j = 0; j < 5; ++j) acc += cw[j] * pg[t + j];
        f32x4 val = {siluf_(acc[0]), siluf_(acc[1]), siluf_(acc[2]), siluf_(acc[3])};
        const int m = m0 + t;
        if (sec < 8) {
          const float ss = row16_sum((val[0] * val[0] + val[1] * val[1]) + (val[2] * val[2] + val[3] * val[3]));
          val = val * rsqrtf(ss + 1e-6f);
          if (sec < 4) { const f32x4 vq = val * 0.125f; *(bf16x4*)(GDQ + (size_t)m * 256 + sec * 64 + sc4) = pack4(vq[0], vq[1], vq[2], vq[3]); }
          else *(bf16x4*)(GDK + (size_t)m * 256 + (sec - 4) * 64 + sc4) = pack4(val[0], val[1], val[2], val[3]);
        } else *(bf16x4*)(GDV + (size_t)m * 256 + (sec - 8) * 64 + sc4) = pack4(val[0], val[1], val[2], val[3]);
      }
    } else if (is_na) {
      const f32x4 gq = *(const f32x4*)(qg + sc4) * (0.125f * 1.4426950408889634f), gk = *(const f32x4*)(kg + sc4);
#pragma unroll
      for (int t = 0; t < 16; ++t) {
        f32x4 val = {bf2f(pgr[t][0]), bf2f(pgr[t][1]), bf2f(pgr[t][2]), bf2f(pgr[t][3])};
        const float ss = row16_sum((val[0] * val[0] + val[1] * val[1]) + (val[2] * val[2] + val[3] * val[3]));
        val = val * rsqrtf(ss * (1.f / 64.f) + 1e-6f);
        const int m = m0 + t;
        if (sec < 8) { const f32x4 o = val * gq; *(bf16x4*)(QN + (size_t)m * 512 + sec * 64 + sc4) = pack4(o[0], o[1], o[2], o[3]); }
        else { const f32x4 o = val * gk; *(bf16x4*)(KN + (size_t)m * 512 + (sec - 8) * 64 + sc4) = pack4(o[0], o[1], o[2], o[3]); }
      }
    }
    if (tid_t < 256) {
      const int t = tid_t >> 4, j = tid_t & 15;
      const int m = m0 + t;
      const float pv = bf2f((short)P[(size_t)m * PINP + B_END + 1024 + j]);
      float o;
      if (j < 8) o = -__expf(A_log[j]) * softplusf_(pv + dt_bias[j]);
      else o = sigmoidf_(pv);
      GDAB[(size_t)m * 16 + j] = o;
    }
    {
      const int vc = (tid_t & 127) * 4, tq = (tid_t >> 7) * 4;
#pragma unroll
      for (int i = 0; i < 4; ++i) {
        const int hd = vc + i;
        bfr* dst = VT + ((size_t)(bb * 8 + (hd >> 6)) * (TTOK / 16) + (tau0 >> 4)) * 1024 + (hd & 63) * 16 + tq;
        const bf16x4 o = {pvr[0][i], pvr[1][i], pvr[2][i], pvr[3][i]};
        *(bf16x4*)dst = o;
      }
    }
    LBAR();
  }
  __syncthreads();
}

__device__ __forceinline__ int scan_tok(int b, int d, int s) {
  if (s < CTXL) { int t = d ? (CTXL - 1 - s) : s; return NLAT + b * CTXL + t; }
  int u = s - CTXL; int t = d ? (SEQ - 1 - u) : u; return b * SEQ + t;
}
#define CS 72
#define SLOT_BYTES (64 * CS * 2)
#define F0_STRIDE 68
#define X1_F0 (13 * SLOT_BYTES)
#define X1_ARR (X1_F0 + 64 * F0_STRIDE * 4)

#define MM_FRAGS(As, Bs, a0, a1, b00, b01, b10, b11)                                                     \
  const bf16x8 a0 = *(const bf16x8*)((As) + ((mt * 16 + fr) * CS + fq * 8) * 2);                         \
  const bf16x8 a1 = *(const bf16x8*)((As) + ((mt * 16 + fr) * CS + 32 + fq * 8) * 2);                    \
  const bf16x8 b00 = *(const bf16x8*)((Bs) + ((nt0 * 16 + fr) * CS + fq * 8) * 2);                       \
  const bf16x8 b01 = *(const bf16x8*)((Bs) + ((nt0 * 16 + fr) * CS + 32 + fq * 8) * 2);                  \
  const bf16x8 b10 = *(const bf16x8*)((Bs) + ((nt0 * 16 + 16 + fr) * CS + fq * 8) * 2);                  \
  const bf16x8 b11 = *(const bf16x8*)((Bs) + ((nt0 * 16 + 16 + fr) * CS + 32 + fq * 8) * 2);
#define MM_2TILES(acc0, acc1, a0, a1, b00, b01, b10, b11)                                                \
  acc0 = __builtin_amdgcn_mfma_f32_16x16x32_bf16(a0, b00, acc0, 0, 0, 0);                                \
  acc0 = __builtin_amdgcn_mfma_f32_16x16x32_bf16(a1, b01, acc0, 0, 0, 0);                                \
  acc1 = __builtin_amdgcn_mfma_f32_16x16x32_bf16(a0, b10, acc1, 0, 0, 0);                                \
  acc1 = __builtin_amdgcn_mfma_f32_16x16x32_bf16(a1, b11, acc1, 0, 0, 0);
__device__ __forceinline__ void wr_T(char* slot, int mt, int nt, int fr, int fq, f32x4 v) {
  *(bf16x4*)(slot + ((nt * 16 + fr) * CS + mt * 16 + 4 * fq) * 2) = pack4(v[0], v[1], v[2], v[3]);
}

struct ChunkIn { float lw[8], be[8]; unsigned f0[8], f1[8], f2[8], f3[8], xv[8]; };
template <bool GDN>
__device__ __forceinline__ void chunk_load(PP pp, int t, ChunkIn& ci) {
  const int tid = tid_opaque(), c = tid & 63, tg = wave_id(tid);
  const int chain = t / NCHUNK, n = t - chain * NCHUNK;
  const int d = chain & 1, h = (chain >> 1) & 3, b = (chain >> 3) & 1;
  const char* S = p.ws + OFF_S;
#pragma unroll
  for (int u = 0; u < 8; ++u) {
    const int m = scan_tok(b, d, n * 64 + tg * 8 + u);
    const size_t o = (size_t)m * 256 + h * 64 + c;
    if (!GDN) {
      ci.lw[u] = ((const float*)(S + S_RWW))[(size_t)d * NTOK * 256 + o];
      ci.f0[u] = ((const unsigned short*)(S + S_RWKK))[o];
      ci.f1[u] = ((const unsigned short*)(S + S_RWB))[(size_t)d * NTOK * 256 + o];
      ci.f2[u] = ((const unsigned short*)(S + S_RWKD))[(size_t)d * NTOK * 256 + o];
      ci.f3[u] = ((const unsigned short*)(S + S_RWR))[o];
      ci.xv[u] = ((const unsigned short*)(S + S_RWV))[o];
      ci.be[u] = 1.f;
    } else {
      ci.lw[u] = ((const float*)(S + S_GDAB))[(size_t)m * 16 + d * 4 + h];
      ci.be[u] = ((const float*)(S + S_GDAB))[(size_t)m * 16 + 8 + d * 4 + h];
      ci.f0[u] = ((const unsigned short*)(S + S_GDK))[o];
      ci.f3[u] = ((const unsigned short*)(S + S_GDQ))[o];
      ci.xv[u] = ((const unsigned short*)(S + S_GDV))[o];
      ci.f1[u] = 0u; ci.f2[u] = 0u;
    }
  }
}
template <bool GDN>
__device__ __forceinline__ void chunk_prep_task(PP pp, int t, int t_next, bool has_next, const ChunkIn& ci, ChunkIn& nx, char* smem) {
  const int chain = t / NCHUNK, n = t - chain * NCHUNK;
  const int d = chain & 1, h = (chain >> 1) & 3, b = (chain >> 3) & 1;
  (void)b; (void)d; (void)h;
  const int tid = tid_opaque(), lane = tid & 63, wv = wave_id(tid);
  const int fr = lane & 15, fq = lane >> 4, mt = wv >> 1, nt0 = (wv & 1) * 2;
  char* S = p.ws + OFF_S;
  char* CH = p.ws + OFF_CH;
  const size_t cc = (size_t)chain * NCHUNK + n;
  char* const p0 = smem;
  char* const p1 = smem + 1 * SLOT_BYTES;
  char* const p2 = smem + 2 * SLOT_BYTES;
  char* const p3 = smem + 3 * SLOT_BYTES;
  char* const p4 = smem + 4 * SLOT_BYTES;
  char* const p5 = smem + 5 * SLOT_BYTES;
  char* const p6 = smem + 6 * SLOT_BYTES;
  char* const p7 = smem + 7 * SLOT_BYTES;
  char* const p8 = smem + 8 * SLOT_BYTES;
  char* const p9 = smem + 9 * SLOT_BYTES;
  char* const p10 = smem + 10 * SLOT_BYTES;
  char* const p11 = smem + 11 * SLOT_BYTES;
  char* const p12 = smem + 12 * SLOT_BYTES;
  float* const F0 = (float*)(smem + X1_F0);
  float* const Lv = (float*)(smem + X1_ARR);
  float* const Lm1v = Lv + 64;
  float* const betav = Lv + 128;
  float* const eLv = Lv + 192;
  float* const gC = Lv + 256;
  float* const gsum = Lv + 320;
  char* const sKt = p0;
  char* const sBh = GDN ? p0 : p1;
  char* const sKh = GDN ? p0 : p2;

  {
    const int c = lane, tg = wv;
    const float* lw = ci.lw; const float* be = ci.be;
    float f0[8], f1[8], f2[8], f3[8], xv[8];
#pragma unroll
    for (int u = 0; u < 8; ++u) {
      f0[u] = __uint_as_float(ci.f0[u] << 16); f1[u] = __uint_as_float(ci.f1[u] << 16); f2[u] = __uint_as_float(ci.f2[u] << 16);
      f3[u] = __uint_as_float(ci.f3[u] << 16); xv[u] = __uint_as_float(ci.xv[u] << 16);
    }
    float cum[8];
    cum[0] = lw[0];
#pragma unroll
    for (int u = 1; u < 8; ++u) cum[u] = cum[u - 1] + lw[u];
    gsum[tg * 64 + c] = cum[7];
    LBAR();
    float off = 0.f, LC = 0.f;
#pragma unroll
    for (int g2 = 0; g2 < 8; ++g2) { const float gs = gsum[g2 * 64 + c]; LC += gs; off += (g2 < tg) ? gs : 0.f; }
    bf16x8 vKtT, vBbT, vKbT, vXT;
#pragma unroll
    for (int u = 0; u < 8; ++u) {
      const int t = tg * 8 + u;
      const float L = off + cum[u], Lm1 = L - lw[u];
      if (!GDN) {
        const float eLm1 = __expf(Lm1), enL = __expf(-L), eL = __expf(L), eCL = __expf(LC - L);
        const float kt = f0[u] * eLm1;
        *(bfr*)(p0 + (t * CS + c) * 2) = f2bf(kt);
        *(bfr*)(p1 + (t * CS + c) * 2) = f2bf(f1[u] * enL);
        *(bfr*)(p2 + (t * CS + c) * 2) = f2bf(f2[u] * enL);
        *(bfr*)(p3 + (t * CS + c) * 2) = f2bf(f3[u] * eL);
        vKtT[u] = (short)f2bf(kt);
        vBbT[u] = (short)f2bf(f1[u] * eCL);
        vKbT[u] = (short)f2bf(f2[u] * eCL);
        vXT[u] = (short)f2bf(xv[u]);
      } else {
        *(bfr*)(p0 + (t * CS + c) * 2) = f2bf(f0[u]);
        *(bfr*)(p3 + (t * CS + c) * 2) = f2bf(f3[u]);
        vKtT[u] = (short)f2bf(f0[u] * __expf(Lm1));
        vBbT[u] = (short)f2bf(be[u] * f0[u] * __expf(LC - Lm1));
        vKbT[u] = (short)f2bf(f0[u] * __expf(LC - L));
        vXT[u] = (short)f2bf(be[u] * xv[u]);
        if (c == 0) { Lv[t] = L; Lm1v[t] = Lm1; betav[t] = be[u]; eLv[t] = __expf(L); }
      }
    }
    *(bf16x8*)(p4 + (c * CS + tg * 8) * 2) = vKtT;
    *(bf16x8*)(p5 + (c * CS + tg * 8) * 2) = vBbT;
    *(bf16x8*)(p6 + (c * CS + tg * 8) * 2) = vKbT;
    *(bf16x8*)(p7 + (c * CS + tg * 8) * 2) = vXT;
    if (tg == 0) gC[c] = __expf(LC);
    if (!GDN && tid < 64) { Lv[tid] = 0.f; Lm1v[tid] = 0.f; betav[tid] = 1.f; eLv[tid] = 1.f; }
  }
  LBAR();
  if (has_next) chunk_load<GDN>(pp, t_next, nx);
  {
    {
      MM_FRAGS(sKt, sBh, a0, a1, b00, b01, b10, b11)
      f32x4 c0 = {0.f, 0.f, 0.f, 0.f}, c1 = c0;
      MM_2TILES(c0, c1, a0, a1, b00, b01, b10, b11)
#pragma unroll
      for (int q = 0; q < 2; ++q) {
        const int sI = (nt0 + q) * 16 + fr;
        const f32x4 cv = q ? c1 : c0;
        f32x4 o;
#pragma unroll
        for (int r = 0; r < 4; ++r) {
          const int tI = mt * 16 + 4 * fq + r;
          float v = cv[r];
          if (GDN) v *= betav[sI] * __expf(fminf(Lm1v[tI] - Lm1v[sI], 0.f));
          o[r] = (sI < tI) ? v : 0.f;
        }
        *(f32x4*)(F0 + sI * F0_STRIDE + mt * 16 + 4 * fq) = o;
        wr_T(p11, mt, nt0 + q, fr, fq, o);
      }
    }
    {
      MM_FRAGS(sKt, sKh, a0, a1, b00, b01, b10, b11)
      f32x4 c0 = {0.f, 0.f, 0.f, 0.f}, c1 = c0;
      MM_2TILES(c0, c1, a0, a1, b00, b01, b10, b11)
#pragma unroll
      for (int q = 0; q < 2; ++q) {
        const int sI = (nt0 + q) * 16 + fr;
        const f32x4 cv = q ? c1 : c0;
        f32x4 o;
#pragma unroll
        for (int r = 0; r < 4; ++r) {
          const int tI = mt * 16 + 4 * fq + r;
          float v = cv[r];
          if (GDN) v *= __expf(fminf(Lm1v[tI] - Lv[sI], 0.f));
          o[r] = (sI < tI) ? v : 0.f;
        }
        wr_T(p9, mt, nt0 + q, fr, fq, o);
      }
    }
    {
      MM_FRAGS(sBh, p3, a0, a1, b00, b01, b10, b11)
      f32x4 c0 = {0.f, 0.f, 0.f, 0.f}, c1 = c0;
      MM_2TILES(c0, c1, a0, a1, b00, b01, b10, b11)
#pragma unroll
      for (int q = 0; q < 2; ++q) {
        const int tI = (nt0 + q) * 16 + fr;
        const f32x4 cv = q ? c1 : c0;
        f32x4 o;
#pragma unroll
        for (int r = 0; r < 4; ++r) {
          const int sI = mt * 16 + 4 * fq + r;
          float v = cv[r];
          if (GDN) v *= betav[sI] * __expf(fminf(Lv[tI] - Lm1v[sI], 0.f));
          o[r] = (sI <= tI) ? v : 0.f;
        }
        wr_T(p10, mt, nt0 + q, fr, fq, o);
      }
    }
  }
  LBAR();
  if (wv < 2) {
    const int base = wv * 32, other = 32 - base, c = lane & 31;
    float tr[32];
#pragma unroll
    for (int j = 0; j < 32; ++j) tr[j] = 0.f;
#pragma unroll
    for (int ip = 15; ip >= 0; --ip) {
      const int i = 2 * ip + 1, i2 = 2 * ip;
      float a0 = (c == i) ? 1.f : 0.f, a1 = 0.f, b0 = (c == i2) ? 1.f : 0.f, b1 = 0.f;
      const float aii = F0[(base + i2) * F0_STRIDE + base + i];
#pragma unroll
      for (int jb = ((i + 1) & ~3); jb < 32; jb += 4) {
        const f32x4 a4 = *(const f32x4*)(F0 + (base + i) * F0_STRIDE + base + jb);
        const f32x4 b4 = *(const f32x4*)(F0 + (base + i2) * F0_STRIDE + base + jb);
        a0 -= a4[0] * tr[jb]; a1 -= a4[1] * tr[jb + 1]; a0 -= a4[2] * tr[jb + 2]; a1 -= a4[3] * tr[jb + 3];
        b0 -= b4[0] * tr[jb]; b1 -= b4[1] * tr[jb + 1]; b0 -= b4[2] * tr[jb + 2]; b1 -= b4[3] * tr[jb + 3];
      }
      const float ti = a0 + a1;
      const float ti2 = (b0 + b1) - aii * ti;
      tr[i] = ti; tr[i2] = ti2;
      if (lane < 32) {
        *(bfr*)(p8 + ((base + i) * CS + base + c) * 2) = f2bf(ti);
        *(bfr*)(p8 + ((base + i) * CS + other + c) * 2) = (bfr)0;
        *(bfr*)(p8 + ((base + i2) * CS + base + c) * 2) = f2bf(ti2);
        *(bfr*)(p8 + ((base + i2) * CS + other + c) * 2) = (bfr)0;
      }
    }
    if (lane < 32) {
#pragma unroll
      for (int q = 0; q < 4; ++q) {
        bf16x8 o, z;
#pragma unroll
        for (int j = 0; j < 8; ++j) { o[j] = (short)f2bf(tr[8 * q + j]); z[j] = 0; }
        *(bf16x8*)(p12 + ((base + c) * CS + base + 8 * q) * 2) = o;
        *(bf16x8*)(p12 + ((base + c) * CS + other + 8 * q) * 2) = z;
      }
    }
  }
  LBAR();
  {
    MM_FRAGS(p11, p12, a0, a1, b00, b01, b10, b11)
    f32x4 c0 = {0.f, 0.f, 0.f, 0.f}, c1 = c0;
    MM_2TILES(c0, c1, a0, a1, b00, b01, b10, b11)
    wr_T(p1, mt, nt0, fr, fq, c0);
    wr_T(p1, mt, nt0 + 1, fr, fq, c1);
  }
  LBAR();
  if (mt < 2 && nt0 == 2) {
    MM_FRAGS(p8, p1, a0, a1, b00, b01, b10, b11)
    f32x4 c0 = {0.f, 0.f, 0.f, 0.f}, c1 = c0;
    MM_2TILES(c0, c1, a0, a1, b00, b01, b10, b11)
#pragma unroll
    for (int r = 0; r < 4; ++r) {
      *(bfr*)(p8 + ((mt * 16 + 4 * fq + r) * CS + (nt0) * 16 + fr) * 2) = f2bf(-c0[r]);
      *(bfr*)(p8 + ((mt * 16 + 4 * fq + r) * CS + (nt0 + 1) * 16 + fr) * 2) = f2bf(-c1[r]);
    }
  }
  LBAR();
  {
    {
      MM_FRAGS(p8, p5, a0, a1, b00, b01, b10, b11)
      f32x4 c0 = {0.f, 0.f, 0.f, 0.f}, c1 = c0;
      MM_2TILES(c0, c1, a0, a1, b00, b01, b10, b11)
      wr_T(p11, mt, nt0, fr, fq, -c0);
      wr_T(p11, mt, nt0 + 1, fr, fq, -c1);
    }
    {
      MM_FRAGS(p8, p10, a0, a1, b00, b01, b10, b11)
      f32x4 c0 = {0.f, 0.f, 0.f, 0.f}, c1 = c0;
      MM_2TILES(c0, c1, a0, a1, b00, b01, b10, b11)
      wr_T(p12, mt, nt0, fr, fq, -c0);
      wr_T(p12, mt, nt0 + 1, fr, fq, -c1);
    }
  }
  LBAR();
  {
    {
      MM_FRAGS(p4, p11, a0, a1, b00, b01, b10, b11)
      f32x4 c0 = {0.f, 0.f, 0.f, 0.f}, c1 = c0;
      MM_2TILES(c0, c1, a0, a1, b00, b01, b10, b11)
#pragma unroll
      for (int q = 0; q < 2; ++q) {
        const int cp = (nt0 + q) * 16 + fr;
        f32x4 cv = q ? c1 : c0;
#pragma unroll
        for (int r = 0; r < 4; ++r) { const int cI = mt * 16 + 4 * fq + r; if (cI == cp) cv[r] += gC[cI]; }
        wr_T(p10, mt, nt0 + q, fr, fq, cv);
      }
    }
    {
      MM_FRAGS(p9, p11, a0, a1, b00, b01, b10, b11)
      f32x4 c0 = {0.f, 0.f, 0.f, 0.f}, c1 = c0;
      MM_2TILES(c0, c1, a0, a1, b00, b01, b10, b11)
#pragma unroll
      for (int q = 0; q < 2; ++q) {
        const int cp = (nt0 + q) * 16 + fr;
        f32x4 cv = q ? c1 : c0;
        const bf16x4 kb = *(const bf16x4*)(p6 + (cp * CS + mt * 16 + 4 * fq) * 2);
#pragma unroll
        for (int r = 0; r < 4; ++r) cv[r] += __uint_as_float(((unsigned)(unsigned short)kb[r]) << 16);
        wr_T(p8, mt, nt0 + q, fr, fq, cv);
      }
    }
    {
      MM_FRAGS(p4, p12, a0, a1, b00, b01, b10, b11)
      f32x4 c0 = {0.f, 0.f, 0.f, 0.f}, c1 = c0;
      MM_2TILES(c0, c1, a0, a1, b00, b01, b10, b11)
#pragma unroll
      for (int q = 0; q < 2; ++q) {
        const int tI = (nt0 + q) * 16 + fr;
        f32x4 cv = q ? c1 : c0;
        const bf16x4 rt = *(const bf16x4*)(p3 + (tI * CS + mt * 16 + 4 * fq) * 2);
        const float el = eLv[tI];
#pragma unroll
        for (int r = 0; r < 4; ++r) cv[r] += __uint_as_float(((unsigned)(unsigned short)rt[r]) << 16) * el;
        wr_T(p1, mt, nt0 + q, fr, fq, cv);
      }
    }
    {
      f32x4 c0 = {0.f, 0.f, 0.f, 0.f}, c1 = c0;
      {
        MM_FRAGS(sKh, p3, a0, a1, b00, b01, b10, b11)
        MM_2TILES(c0, c1, a0, a1, b00, b01, b10, b11)
      }
#pragma unroll
      for (int q = 0; q < 2; ++q) {
        const int tI = (nt0 + q) * 16 + fr;
#pragma unroll
        for (int r = 0; r < 4; ++r) {
          const int sI = mt * 16 + 4 * fq + r;
          float v = q ? c1[r] : c0[r];
          if (GDN) v *= __expf(fminf(Lv[tI] - Lv[sI], 0.f));
          v = (sI <= tI) ? v : 0.f;
          if (q) c1[r] = v; else c0[r] = v;
        }
      }
      {
        MM_FRAGS(p9, p12, a0, a1, b00, b01, b10, b11)
        MM_2TILES(c0, c1, a0, a1, b00, b01, b10, b11)
      }
      wr_T(p5, mt, nt0, fr, fq, c0);
      wr_T(p5, mt, nt0 + 1, fr, fq, c1);
    }
  }
  LBAR();
  {
    {
      MM_FRAGS(p8, p7, a0, a1, b00, b01, b10, b11)
      f32x4 c0 = {0.f, 0.f, 0.f, 0.f}, c1 = c0;
      MM_2TILES(c0, c1, a0, a1, b00, b01, b10, b11)
      bfr* QT = (bfr*)(CH + cc * CH_REC + CH_QT);
      *(bf16x4*)(QT + ((mt * 4 + nt0) * 64 + lane) * 4) = pack4(c0[0], c0[1], c0[2], c0[3]);
      *(bf16x4*)(QT + ((mt * 4 + nt0 + 1) * 64 + lane) * 4) = pack4(c1[0], c1[1], c1[2], c1[3]);
    }
    {
      MM_FRAGS(p7, p5, a0, a1, b00, b01, b10, b11)
      f32x4 c0 = {0.f, 0.f, 0.f, 0.f}, c1 = c0;
      MM_2TILES(c0, c1, a0, a1, b00, b01, b10, b11)
      bfr* YX = (bfr*)(CH + cc * CH_REC + CH_YX);
      *(bf16x4*)(YX + ((mt * 4 + nt0) * 64 + lane) * 4) = pack4(c0[0], c0[1], c0[2], c0[3]);
      *(bf16x4*)(YX + ((mt * 4 + nt0 + 1) * 64 + lane) * 4) = pack4(c1[0], c1[1], c1[2], c1[3]);
    }
    {
      const int fm = wv >> 1, fa = wv & 1;
      const int row = fm * 16 + fr;
      {
        const bf16x4 lo = *(const bf16x4*)(p10 + (row * CS + 32 * fa + 4 * fq) * 2);
        const bf16x4 hi = *(const bf16x4*)(p10 + (row * CS + 32 * fa + 16 + 4 * fq) * 2);
        bf16x8 f; f[0] = lo[0]; f[1] = lo[1]; f[2] = lo[2]; f[3] = lo[3]; f[4] = hi[0]; f[5] = hi[1]; f[6] = hi[2]; f[7] = hi[3];
        *(bf16x8*)(CH + cc * CH_REC + CH_PT + (size_t)((fm * 2 + fa) * 64 + lane) * 16) = f;
      }
      {
        const bf16x4 lo = *(const bf16x4*)(p1 + (row * CS + 32 * fa + 4 * fq) * 2);
        const bf16x4 hi = *(const bf16x4*)(p1 + (row * CS + 32 * fa + 16 + 4 * fq) * 2);
        bf16x8 f; f[0] = lo[0]; f[1] = lo[1]; f[2] = lo[2]; f[3] = lo[3]; f[4] = hi[0]; f[5] = hi[1]; f[6] = hi[2]; f[7] = hi[3];
        *(bf16x8*)(CH + cc * CH_REC + CH_RYT + (size_t)((fm * 2 + fa) * 64 + lane) * 16) = f;
      }
    }
  }
  LBAR();
}

template <bool GDN>
__device__ __forceinline__ void chunk_prep_loop(PP pp, int t0, int tend, int nb, char* smem) {
  ChunkIn cur, nxt;
  if (t0 < tend) chunk_load<GDN>(pp, t0, cur);
  for (int t = t0; t < tend; t += nb) {
    const bool has_next = (t + nb) < tend;
    chunk_prep_task<GDN>(pp, t, t + nb, has_next, cur, nxt, smem);
    cur = nxt;
  }
}
__device__ __forceinline__ void phase_chunk_prep(PP pp, int bid, int nb, char* smem) {
  __syncthreads();
  const int half = (NCHAIN / 2) * NCHUNK;
  chunk_prep_loop<false>(pp, bid, half, nb, smem);
  const int k0 = (half - bid + nb - 1) / nb;
  chunk_prep_loop<true>(pp, bid + k0 * nb, NCHAIN * NCHUNK, nb, smem);
  __syncthreads();
}

#define X2_BUF 32768
#define X2_BAR() do { asm volatile("s_waitcnt lgkmcnt(0)" ::: "memory"); __builtin_amdgcn_s_barrier(); asm volatile("" ::: "memory"); } while (0)
__device__ __forceinline__ void chunk_seq_chain(PP pp, int chain, char* smem) {
  __syncthreads();
  const int tid = tid_opaque(), lane = tid & 63, wv = wave_id(tid);
  const int d = chain & 1, h = (chain >> 1) & 3, b = (chain >> 3) & 1, ty = chain >> 4;
  const char* CH = p.ws + OFF_CH;
  bfr* Y = (bfr*)(p.ws + OFF_S + (ty ? S_YGD : S_YRW)) + (size_t)d * NTOK * 256;
  const size_t c0 = (size_t)chain * NCHUNK;
  if (wv >= 4) {
    const int lw = wv - 4;
    const char* src0 = CH + c0 * CH_REC + (size_t)lane * 16;
#define X2_DMA(n) { const char* s_ = src0 + (size_t)(n) * CH_REC; LAS unsigned char* d_ = (LAS unsigned char*)smem + ((n) & 3) * X2_BUF;       \
      _Pragma("unroll") for (int i = 0; i < 8; ++i) {                                                                                       \
        const int piece = i * 4 + lw;                                                                                                       \
        __builtin_amdgcn_global_load_lds((const unsigned*)(s_ + piece * 1024), (LAS unsigned*)(d_ + piece * 1024), 16, 0, 0); } }
    X2_DMA(0) X2_DMA(1) X2_DMA(2)
    asm volatile("s_waitcnt vmcnt(16)" ::: "memory");
    X2_BAR();
    for (int n = 0; n < NCHUNK; ++n) {
      if (n + 3 < NCHUNK) { X2_DMA(n + 3) asm volatile("s_waitcnt vmcnt(16)" ::: "memory"); }
      else if (n + 2 < NCHUNK) asm volatile("s_waitcnt vmcnt(8)" ::: "memory");
      else asm volatile("s_waitcnt vmcnt(0)" ::: "memory");
      X2_BAR();
    }
#undef X2_DMA
  } else {
    const int vt = wv, fr = lane & 15, fq = lane >> 4;
    f32x4 Sacc[4];
#pragma unroll
    for (int i = 0; i < 4; ++i) Sacc[i] = (f32x4){0.f, 0.f, 0.f, 0.f};
    X2_BAR();
    for (int n = 0; n < NCHUNK; ++n) {
      const char* buf = smem + (n & 3) * X2_BUF;
      bf16x8 sB0, sB1;
#pragma unroll
      for (int j = 0; j < 4; ++j) {
        sB0[j] = (short)f2bf(Sacc[0][j]); sB0[4 + j] = (short)f2bf(Sacc[1][j]);
        sB1[j] = (short)f2bf(Sacc[2][j]); sB1[4 + j] = (short)f2bf(Sacc[3][j]);
      }
#pragma unroll
      for (int m = 0; m < 4; ++m) {
        const bf16x8 pa0 = *(const bf16x8*)(buf + ((m * 2 + 0) * 64 + lane) * 16);
        const bf16x8 pa1 = *(const bf16x8*)(buf + ((m * 2 + 1) * 64 + lane) * 16);
        const bf16x8 ra0 = *(const bf16x8*)(buf + 8192 + ((m * 2 + 0) * 64 + lane) * 16);
        const bf16x8 ra1 = *(const bf16x8*)(buf + 8192 + ((m * 2 + 1) * 64 + lane) * 16);
        const bf16x4 qb = *(const bf16x4*)(buf + 16384 + ((m * 4 + vt) * 64 + lane) * 8);
        const bf16x4 yb = *(const bf16x4*)(buf + 24576 + ((vt * 4 + m) * 64 + lane) * 8);
        f32x4 y = {bf2f(yb[0]), bf2f(yb[1]), bf2f(yb[2]), bf2f(yb[3])};
        y = __builtin_amdgcn_mfma_f32_16x16x32_bf16(sB0, ra0, y, 0, 0, 0);
        y = __builtin_amdgcn_mfma_f32_16x16x32_bf16(sB1, ra1, y, 0, 0, 0);
        f32x4 sn = {bf2f(qb[0]), bf2f(qb[1]), bf2f(qb[2]), bf2f(qb[3])};
        sn = __builtin_amdgcn_mfma_f32_16x16x32_bf16(pa0, sB0, sn, 0, 0, 0);
        sn = __builtin_amdgcn_mfma_f32_16x16x32_bf16(pa1, sB1, sn, 0, 0, 0);
        Sacc[m] = sn;
        {
          const int mm = scan_tok(b, d, n * 64 + m * 16 + fr);
          *(bf16x4*)(Y + (size_t)mm * 256 + h * 64 + vt * 16 + 4 * fq) = pack4(y[0], y[1], y[2], y[3]);
        }
      }
      X2_BAR();
    }
  }
}

struct NaPair { int mk0, mk1, tau0, tau1, kr0, kr1, ct0, ct1; };
struct NaFrag { bf16x8 k00, k01, k10, k11; bf16x4 v0[4], v1[4]; };

__device__ __forceinline__ void na_load(NaFrag& f, const bfr* KN, const bfr* VT, size_t vt_base, int h, int fr, int fq, const NaPair& pr) {
  const bfr* k0 = KN + (size_t)(pr.mk0 + fr) * 512 + h * 64 + fq * 8;
  const bfr* k1 = KN + (size_t)(pr.mk1 + fr) * 512 + h * 64 + fq * 8;
  f.k00 = *(const bf16x8*)(k0); f.k01 = *(const bf16x8*)(k0 + 32);
  f.k10 = *(const bf16x8*)(k1); f.k11 = *(const bf16x8*)(k1 + 32);
#pragma unroll
  for (int dt = 0; dt < 4; ++dt) {
    const int vo = (dt * 16 + fr) * 16 + fq * 4;
    f.v0[dt] = *(const bf16x4*)(VT + vt_base + (size_t)(pr.tau0 >> 4) * 1024 + vo);
    f.v1[dt] = *(const bf16x4*)(VT + vt_base + (size_t)(pr.tau1 >> 4) * 1024 + vo);
  }
}

__device__ __forceinline__ void na_compute(const NaFrag& f, const bf16x8 qf0, const bf16x8 qf1, bool local, bool vr0, bool vr1,
                                           int dr0, int dr1, int ct0, int ct1, int qc, int fq, const float* bias_h, f32x4 (&O)[4], float& lsum) {
  f32x4 z = {0.f, 0.f, 0.f, 0.f};
  f32x4 st0 = __builtin_amdgcn_mfma_f32_16x16x32_bf16(f.k00, qf0, z, 0, 0, 0);
  st0 = __builtin_amdgcn_mfma_f32_16x16x32_bf16(f.k01, qf1, st0, 0, 0, 0);
  f32x4 st1 = __builtin_amdgcn_mfma_f32_16x16x32_bf16(f.k10, qf0, z, 0, 0, 0);
  st1 = __builtin_amdgcn_mfma_f32_16x16x32_bf16(f.k11, qf1, st1, 0, 0, 0);
  bf16x8 pf;
  if (local) {
    const int cs = min(max(qc - 8, 0), 48);
    const int kb0 = ct0 * 16 + fq * 4, kb1 = ct1 * 16 + fq * 4;
    const float* bp0 = bias_h + min(max(dr0 * 31 + kb0 - qc + 15, -32), 493);
    const float* bp1 = bias_h + min(max(dr1 * 31 + kb1 - qc + 15, -32), 493);
    const float b00 = bp0[0], b01 = bp0[1], b02 = bp0[2], b03 = bp0[3];
    const float b10 = bp1[0], b11 = bp1[1], b12 = bp1[2], b13 = bp1[3];
    const float bb0[4] = {b00, b01, b02, b03}, bb1[4] = {b10, b11, b12, b13};
#pragma unroll
    for (int r = 0; r < 4; ++r) {
      const bool ok0 = vr0 && (unsigned)(kb0 + r - cs) < 16u, ok1 = vr1 && (unsigned)(kb1 + r - cs) < 16u;
      const float e0 = __builtin_amdgcn_exp2f(st0[r] + bb0[r]), e1 = __builtin_amdgcn_exp2f(st1[r] + bb1[r]);
      const float p0 = ok0 ? e0 : 0.f, p1 = ok1 ? e1 : 0.f;
      lsum += p0 + p1;
      pf[r] = (short)f2bf(p0);
      pf[4 + r] = (short)f2bf(p1);
    }
  } else {
#pragma unroll
    for (int r = 0; r < 4; ++r) {
      const float p0 = __builtin_amdgcn_exp2f(st0[r]), p1 = __builtin_amdgcn_exp2f(st1[r]);
      lsum += p0 + p1;
      pf[r] = (short)f2bf(p0);
      pf[4 + r] = (short)f2bf(p1);
    }
  }
#pragma unroll
  for (int dt = 0; dt < 4; ++dt) {
    bf16x8 vf;
    vf[0] = f.v0[dt][0]; vf[1] = f.v0[dt][1]; vf[2] = f.v0[dt][2]; vf[3] = f.v0[dt][3];
    vf[4] = f.v1[dt][0]; vf[5] = f.v1[dt][1]; vf[6] = f.v1[dt][2]; vf[7] = f.v1[dt][3];
    O[dt] = __builtin_amdgcn_mfma_f32_16x16x32_bf16(vf, pf, O[dt], 0, 0, 0);
  }
}

__device__ __forceinline__ void na_block_task(PP pp, int task, const float* bias_lds) {
  const int tid = tid_opaque(), lane = tid & 63, wv = wave_id(tid);
  const int fr = lane & 15, fq = lane >> 4;
  char* S = p.ws + OFF_S;
  const bfr* QN = (const bfr*)(S + S_QN);
  const bfr* KN = (const bfr*)(S + S_KN);
  const bfr* VT = (const bfr*)(S + S_VT);
  bfr* CC = (bfr*)(p.ws + OFF_CC);
  const bool latent = task < 1024;
  int b, h, mqa, mqb, qra = 0, qrb = 0, cgp = 0;
  if (latent) {
    h = task & 7; const int quad = (task >> 3) & 63; b = task >> 9;
    qra = quad * 4 + (wv >> 2) * 2; qrb = qra + 1; cgp = wv & 3;
    mqa = b * SEQ + qra * 64 + cgp * 16; mqb = mqa + 64;
  } else {
    const int u = task - 1024;
    h = u & 7; b = u >> 3;
    mqa = NLAT + b * CTXL + (wv * 2) * 16; mqb = mqa + 16;
  }
  const bf16x8 qa0 = *(const bf16x8*)(QN + (size_t)(mqa + fr) * 512 + h * 64 + fq * 8);
  const bf16x8 qa1 = *(const bf16x8*)(QN + (size_t)(mqa + fr) * 512 + h * 64 + 32 + fq * 8);
  const bf16x8 qb0 = *(const bf16x8*)(QN + (size_t)(mqb + fr) * 512 + h * 64 + fq * 8);
  const bf16x8 qb1 = *(const bf16x8*)(QN + (size_t)(mqb + fr) * 512 + h * 64 + 32 + fq * 8);
  f32x4 Oa[4], Ob[4];
#pragma unroll
  for (int dt = 0; dt < 4; ++dt) { Oa[dt] = (f32x4){0.f, 0.f, 0.f, 0.f}; Ob[dt] = Oa[dt]; }
  float lsa = 0.f, lsb = 0.f;
  const size_t vt_base = (size_t)(b * 8 + h) * 64 * TTOK;
  const int rsa = min(max(qra - 4, 0), SEQ / 64 - 8), rsb = min(max(qrb - 4, 0), SEQ / 64 - 8);
  const int nrows = latent ? (rsb - rsa + 8) : 0;
  const int ct_first = (cgp <= 1) ? 0 : cgp - 1;
  const int nct = (cgp == 0 || cgp == 3) ? 2 : 3;
  const int ntile = nrows * nct;
  const int nlp = (ntile + 1) >> 1;
  const int npair = nlp + 8;
  const int qc = cgp * 16 + fr;
  auto mkpair = [&](int pi) {
    NaPair pr;
    if (pi < nlp) {
      const int i0 = 2 * pi, i1 = min(2 * pi + 1, ntile - 1);
      const int q0 = (nct == 2) ? (i0 >> 1) : ((i0 * 21846) >> 16), q1 = (nct == 2) ? (i1 >> 1) : ((i1 * 21846) >> 16);
      pr.kr0 = rsa + q0; pr.ct0 = ct_first + i0 - q0 * nct;
      pr.kr1 = rsa + q1; pr.ct1 = ct_first + i1 - q1 * nct;
      if (2 * pi + 1 >= ntile) pr.kr1 = -100;
      const int r1 = rsa + q1;
      pr.tau0 = pr.kr0 * 64 + pr.ct0 * 16; pr.tau1 = r1 * 64 + pr.ct1 * 16;
      pr.mk0 = b * SEQ + pr.tau0; pr.mk1 = b * SEQ + pr.tau1;
    } else {
      const int c = pi - nlp;
      pr.kr0 = pr.kr1 = pr.ct0 = pr.ct1 = 0;
      pr.tau0 = SEQ + c * 32; pr.tau1 = SEQ + c * 32 + 16;
      pr.mk0 = NLAT + b * CTXL + c * 32; pr.mk1 = pr.mk0 + 16;
    }
    return pr;
  };
  NaFrag fa, fb;
  NaPair pa = mkpair(0), pb;
  na_load(fa, KN, VT, vt_base, h, fr, fq, pa);
  const float* bias_h = bias_lds + h * 465;
#define NA_DO(F, PR, PI)                                                                                          \
  {                                                                                                               \
    const bool loc_ = (PI) < nlp;                                                                                 \
    na_compute(F, qa0, qa1, loc_, (unsigned)(PR.kr0 - rsa) < 8u, (unsigned)(PR.kr1 - rsa) < 8u,                   \
               PR.kr0 - qra + 7, PR.kr1 - qra + 7, PR.ct0, PR.ct1, qc, fq, bias_h, Oa, lsa);                      \
    na_compute(F, qb0, qb1, loc_, (unsigned)(PR.kr0 - rsb) < 8u, (unsigned)(PR.kr1 - rsb) < 8u,                   \
               PR.kr0 - qrb + 7, PR.kr1 - qrb + 7, PR.ct0, PR.ct1, qc, fq, bias_h, Ob, lsb);                      \
  }
  for (int pi = 0; pi < npair; pi += 2) {
    pb = mkpair(min(pi + 1, npair - 1)); na_load(fb, KN, VT, vt_base, h, fr, fq, pb);
    NA_DO(fa, pa, pi)
    pa = mkpair(min(pi + 2, npair - 1)); na_load(fa, KN, VT, vt_base, h, fr, fq, pa);
    if (pi + 1 < npair) NA_DO(fb, pb, pi + 1)
  }
#undef NA_DO
  lsa += shfl_xor_l(lsa, 16, lane); lsa += shfl_xor_l(lsa, 32, lane);
  lsb += shfl_xor_l(lsb, 16, lane); lsb += shfl_xor_l(lsb, 32, lane);
  const float ia = 1.f / lsa, ib = 1.f / lsb;
#pragma unroll
  for (int dt = 0; dt < 4; ++dt) {
    *(bf16x4*)(CC + (size_t)(mqa + fr) * 1024 + h * 64 + dt * 16 + fq * 4) = pack4(Oa[dt][0] * ia, Oa[dt][1] * ia, Oa[dt][2] * ia, Oa[dt][3] * ia);
    *(bf16x4*)(CC + (size_t)(mqb + fr) * 1024 + h * 64 + dt * 16 + fq * 4) = pack4(Ob[dt][0] * ib, Ob[dt][1] * ib, Ob[dt][2] * ib, Ob[dt][3] * ib);
  }
}

__device__ __forceinline__ void phase_mix(PP pp, int l, int bid, int nb, char* smem) {
  const int tid = tid_opaque();
  const int nscan_blocks = (nb > 32) ? 32 : nb;
  const int first_attn_block = (nb > 32) ? 32 : 0;
  if (bid < nscan_blocks) {
    for (int c = bid; c < NCHAIN; c += nscan_blocks) chunk_seq_chain(pp, c, smem);
  }
  if (bid >= first_attn_block) {
    float* bias = (float*)smem + 64;
    __syncthreads();
    for (int i = tid; i < 8 * 465 + 128; i += NTHR) { const int j = i - 64; bias[j] = ((unsigned)j < 8u * 465u) ? p.na_rpb[(size_t)l * 8 * 465 + j] * 1.4426950408889634f : 0.f; }
    __syncthreads();
    const int ntask = (l == 0) ? 1024 + 16 : 1024;
    const int nab = nb - first_attn_block;
    for (int t = bid - first_attn_block; t < ntask; t += nab) na_block_task(pp, t, bias);
    __syncthreads();
    phase_convert(pp, l, 1, bid - first_attn_block, nab, smem);
    if (l == 0) phase_convert(pp, 1, 0, bid - first_attn_block, nab, smem);
  }
}

__device__ __forceinline__ void phase_post(PP pp, int l, int bid, int nb) {
  const int tid = tid_opaque(), lane = tid & 63, wv = wave_id(tid);
  char* S = p.ws + OFF_S;
  const bfr* YRW = (const bfr*)(S + S_YRW);
  const bfr* YGD = (const bfr*)(S + S_YGD);
  const bfr* RWV = (const bfr*)(S + S_RWV);
  const bfr* RWG = (const bfr*)(S + S_RWG);
  const float* BON = (const float*)(S + S_BON);
  const bfr* P = (const bfr*)(p.ws + OFF_P);
  bfr* CC = (bfr*)(p.ws + OFF_CC);
  const float* ln_w = p.rw_ln_w + (size_t)l * 256;
  const float* ln_b = p.rw_ln_b + (size_t)l * 256;
  const float* ng = p.gd_norm_g + (size_t)l * 64;
  const int ntok = (l == 0) ? NTOK : NLAT;
  const int cb = lane * 4, hh = lane >> 4;
  const f32x4 lw4 = *(const f32x4*)(ln_w + cb), lb4 = *(const f32x4*)(ln_b + cb), ng4 = *(const f32x4*)(ng + (cb & 63));
  for (int m = bid * 8 + wv; m < ntok; m += nb * 8) {
    const size_t o = (size_t)m * 256 + cb;
    const f32x4 y0 = ldbf4(YRW + o), y1 = ldbf4(YRW + (size_t)NTOK * 256 + o);
    const f32x4 rv = ldbf4(RWV + o), rg = ldbf4(RWG + o);
    const f32x4 g0 = ldbf4(YGD + o), g1 = ldbf4(YGD + (size_t)NTOK * 256 + o);
    const f32x4 z = ldbf4(P + (size_t)m * PINP + B_END + 768 + cb);
    const float bon = BON[(size_t)m * 4 + hh];
    {
      const f32x4 y = y0 + y1;
      const float mean = row16_sum((y[0] + y[1]) + (y[2] + y[3])) * (1.f / 64.f);
      const f32x4 dv = y - mean;
      const float var = row16_sum((dv[0] * dv[0] + dv[1] * dv[1]) + (dv[2] * dv[2] + dv[3] * dv[3])) * (1.f / 64.f);
      const f32x4 out = ((dv * rsqrtf(var + 64e-5f)) * lw4 + lb4 + rv * bon) * rg;
      *(bf16x4*)(CC + (size_t)m * 1024 + 512 + cb) = pack4(out[0], out[1], out[2], out[3]);
    }
    {
      const f32x4 y = g0 + g1;
      const float ms = row16_sum((y[0] * y[0] + y[1] * y[1]) + (y[2] * y[2] + y[3] * y[3])) * (1.f / 64.f);
      const f32x4 sz = {siluf_(z[0]), siluf_(z[1]), siluf_(z[2]), siluf_(z[3])};
      const f32x4 out = (y * rsqrtf(ms + 1e-6f)) * ng4 * sz;
      *(bf16x4*)(CC + (size_t)m * 1024 + 768 + cb) = pack4(out[0], out[1], out[2], out[3]);
    }
  }
}

#define RW_LDS_ROW 36
__device__ __forceinline__ void phase_router(PP pp, int l, int bid, int nb, char* smem) {
  const int tid = tid_opaque(), lane = tid & 63, wv = wave_id(tid);
  const float* xl = p.out;
  const float* xc = (const float*)(p.ws + OFF_CTX);
  const float* mods = (const float*)(p.ws + OFF_MODS) + (size_t)l * 3 * 6144;
  const float* g = p.norm_ffn_g + (size_t)l * 1024;
  const float* rw = p.moe_router_w + (size_t)l * 1024 * 32;
  const float* rb = p.moe_router_b + (size_t)l * 32;
  bfr* H = (bfr*)(p.ws + OFF_H);
  int* cnt = (int*)(p.ws + OFF_CNT);
  int* TOKE = (int*)(p.ws + OFF_TOKE);
  int* TOKP = (int*)(p.ws + OFF_TOKP);
  float* TOKG = (float*)(p.ws + OFF_TOKG);
  float* wl = (float*)smem;
  for (int i = tid; i < 1024 * 8; i += NTHR) {
    int d = i >> 3, q = i & 7;
    *(float4*)(wl + d * RW_LDS_ROW + q * 4) = *(const float4*)(rw + (size_t)d * 32 + q * 4);
  }
  __syncthreads();
  const int ntok = (l == 0) ? NTOK : NLAT;
  const float rbl = rb[lane & 31];
  for (int m0 = (bid * 8 + wv) * 2; m0 < ntok; m0 += nb * 16) {
    float acc0[32], acc1[32];
#pragma unroll
    for (int e = 0; e < 32; ++e) { acc0[e] = 0.f; acc1[e] = 0.f; }
    float hv0[16], hv1[16];
    {
      const int ma = m0, mb = m0 + 1;
      const float* xa = (ma < NLAT) ? xl + (size_t)ma * 1024 : xc + (size_t)(ma - NLAT) * 1024;
      const float* xb = (mb < NLAT) ? xl + (size_t)mb * 1024 : xc + (size_t)(mb - NLAT) * 1024;
      const float* mda = mods + (size_t)mod_row(ma) * 6144 + 3072;
      const float* mdb = mods + (size_t)mod_row(mb) * 6144 + 3072;
      float ssa = 0.f, ssb = 0.f;
#pragma unroll
      for (int i = 0; i < 16; ++i) { hv0[i] = xa[lane + 64 * i]; hv1[i] = xb[lane + 64 * i]; }
#pragma unroll
      for (int i = 0; i < 16; ++i) { ssa += hv0[i] * hv0[i]; ssb += hv1[i] * hv1[i]; }
      ssa = wave_sum(ssa); ssb = wave_sum(ssb);
      const float rsa = rsqrtf(ssa * (1.f / 1024.f) + 1e-6f), rsb = rsqrtf(ssb * (1.f / 1024.f) + 1e-6f);
#pragma unroll
      for (int i = 0; i < 16; ++i) {
        const int d = lane + 64 * i;
        const float gg = g[d];
        hv0[i] = hv0[i] * rsa * gg * (1.f + mda[1024 + d]) + mda[d];
        hv1[i] = hv1[i] * rsb * gg * (1.f + mdb[1024 + d]) + mdb[d];
      }
      float am0 = 0.f, am1 = 0.f;
#pragma unroll
      for (int i = 0; i < 16; ++i) { am0 = fmaxf(am0, fabsf(hv0[i])); am1 = fmaxf(am1, fabsf(hv1[i])); }
      am0 = wave_max(am0); am1 = wave_max(am1);
      const float sc0 = am0 > 0.f ? am0 * (1.f / 127.f) : 1.f, sc1 = am1 > 0.f ? am1 * (1.f / 127.f) : 1.f;
      const float iv0 = 1.f / sc0, iv1 = 1.f / sc1;
      signed char* H8 = (signed char*)(p.ws + OFF_H);
#pragma unroll
      for (int i = 0; i < 16; ++i) {
        const int d = lane + 64 * i;
        H8[(size_t)ma * 1024 + d] = (signed char)(int)fminf(fmaxf(rintf(hv0[i] * iv0), -127.f), 127.f);
        H8[(size_t)mb * 1024 + d] = (signed char)(int)fminf(fmaxf(rintf(hv1[i] * iv1), -127.f), 127.f);
      }
      if (lane == 0) { float* SCL = (float*)(p.ws + OFF_SCL); SCL[ma] = sc0; SCL[mb] = sc1; }
      asm volatile("" ::: "memory");
    }
#pragma unroll
    for (int i = 0; i < 16; ++i) {
      if ((i & 3) == 0) asm volatile("" ::: "memory");
      const float* wr = wl + (lane + 64 * i) * RW_LDS_ROW;
#pragma unroll
      for (int q = 0; q < 8; ++q) {
        const float4 w = *(const float4*)(wr + q * 4);
        acc0[q * 4 + 0] += hv0[i] * w.x; acc0[q * 4 + 1] += hv0[i] * w.y; acc0[q * 4 + 2] += hv0[i] * w.z; acc0[q * 4 + 3] += hv0[i] * w.w;
        acc1[q * 4 + 0] += hv1[i] * w.x; acc1[q * 4 + 1] += hv1[i] * w.y; acc1[q * 4 + 2] += hv1[i] * w.z; acc1[q * 4 + 3] += hv1[i] * w.w;
      }
    }
#define BFLY(A, N, D)                                                                           \
    _Pragma("unroll") for (int i = 0; i < (N); ++i) {                                            \
      const bool up = (lane & (D)) != 0;                                                         \
      const float keep = up ? A[i + (N)] : A[i];                                                 \
      const float send = up ? A[i] : A[i + (N)];                                                 \
      A[i] = keep + shfl_xor_l(send, (D), lane);                                                   \
    }
    BFLY(acc0, 16, 16) BFLY(acc1, 16, 16)
    BFLY(acc0, 8, 8) BFLY(acc1, 8, 8)
    BFLY(acc0, 4, 4) BFLY(acc1, 4, 4)
    BFLY(acc0, 2, 2) BFLY(acc1, 2, 2)
    BFLY(acc0, 1, 1) BFLY(acc1, 1, 1)
#undef BFLY
    float la = acc0[0] + shfl_xor_l(acc0[0], 32, lane);
    float lb = acc1[0] + shfl_xor_l(acc1[0], 32, lane);
    const int my_e = lane & 31;
    la += rbl; lb += rbl;
    (void)my_e;
#pragma unroll
    for (int tkn = 0; tkn < 2; ++tkn) {
      float v = tkn == 0 ? la : lb;
      float tv[4]; int ti[4];
#pragma unroll
      for (int k = 0; k < 4; ++k) {
        float bv = v; int bi = lane & 31;
#pragma unroll
        for (int o = 16; o >= 1; o >>= 1) {
          float ov = shfl_xor_l(bv, o, lane); int oi = shfl_xor_li(bi, o, lane);
          bool take = (ov > bv) || (ov == bv && oi < bi);
          bv = take ? ov : bv; bi = take ? oi : bi;
        }
        tv[k] = bv; ti[k] = bi;
        if ((lane & 31) == bi) v = -3.0e38f;
      }
      float e1 = __expf(tv[1] - tv[0]), e2 = __expf(tv[2] - tv[0]), e3 = __expf(tv[3] - tv[0]);
      float inv = 1.f / (1.f + e1 + e2 + e3);
      const int m = m0 + tkn;
      if (lane < 4) {
        int e = lane == 0 ? ti[0] : lane == 1 ? ti[1] : lane == 2 ? ti[2] : ti[3];
        float gt = (lane == 0 ? 1.f : lane == 1 ? e1 : lane == 2 ? e2 : e3) * inv;
        int pos = atomicAdd(&cnt[e], 1);
        TOKE[(size_t)m * 4 + lane] = e; TOKP[(size_t)m * 4 + lane] = pos; TOKG[(size_t)m * 4 + lane] = gt;
      }
    }
  }
  __syncthreads();
}

__device__ __forceinline__ void moe_offsets(PP pp, int* toff) {
  const int* cnt = (const int*)(p.ws + OFF_CNT);
  if (tid_opaque() == 0) {
    int a = 0;
    for (int e = 0; e < 32; ++e) { toff[e] = a; a += (cnt[e] + 255) >> 8; }
    toff[32] = a;
  }
  __syncthreads();
}
__device__ __forceinline__ void moe_tile_experts(int* toff) {
  int* texp = toff + 128;
  const int ntile = toff[32];
  for (int mt = tid_opaque(); mt < ntile; mt += NTHR) {
    int e = 0;
#pragma unroll 1
    for (int k = 1; k < 32; ++k) e = (mt >= toff[k]) ? k : e;
    texp[mt] = e;
  }
  __syncthreads();
}

__device__ __forceinline__ void phase_slotfill(PP pp, int l, int bid, int nb, char* smem) {
  int* toff = (int*)smem;
  moe_offsets(pp, toff);
  const int tid = tid_opaque(), lane = tid & 63, wv = wave_id(tid);
  const int* TOKE = (const int*)(p.ws + OFF_TOKE);
  const int* TOKP = (const int*)(p.ws + OFF_TOKP);
  const float* TOKG = (const float*)(p.ws + OFF_TOKG);
  const int* cnt = (const int*)(p.ws + OFF_CNT);
  int* TOKS = (int*)(p.ws + OFF_TOKS);
  float* SLG = (float*)(p.ws + OFF_SLG);
  float* SLS = (float*)(p.ws + OFF_SLS);
  const float* SCL = (const float*)(p.ws + OFF_SCL);
  const signed char* H8 = (const signed char*)(p.ws + OFF_H);
  signed char* XG = (signed char*)(p.ws + OFF_S);
  const int n = ((l == 0) ? NTOK : NLAT) * 4;
  int* SLT = (int*)(p.ws + OFF_SLT);
  for (int i = bid * NTHR + tid; i < n; i += nb * NTHR) {
    const int slot = toff[TOKE[i]] * 256 + TOKP[i];
    TOKS[i] = slot; SLT[slot] = i >> 2; SLG[slot] = TOKG[i]; SLS[slot] = SCL[i >> 2];
  }
  for (int e = 0; e < 32; ++e) {
    const int c = cnt[e];
    const int npad = ((c + 255) & ~255) - c;
    const int base = toff[e] * 256 + c;
    for (int r = bid * NTHR + tid; r < npad; r += nb * NTHR) { SLT[base + r] = 0; SLS[base + r] = 0.f; }
  }
  __syncthreads();
}

struct EpiMoe1 {
  const float* bgu; const float* sw; const float* SLS; bfr* ACT;
  __device__ __forceinline__ void operator()(const i32x4 (&acc)[2][2][4][2], const g8::GUnit& u, int wr, int wc, int fr, int fq) const {
    const float* be = bgu + (size_t)u.e * 2048;
    const float* se = sw + (size_t)u.e * 2048;
    const int slot0 = u.pm * 256 + wr * 64 + fr;
    float sav[2][4];
#pragma unroll
    for (int ai = 0; ai < 2; ++ai)
#pragma unroll
      for (int m = 0; m < 4; ++m) sav[ai][m] = SLS[slot0 + ai * 128 + m * 16];
    const int j0 = u.pn * 128 + wc * 32 + fq * 8;
    f32x4 bgv[2], blv[2], sgv[2], slv[2];
#pragma unroll
    for (int bj = 0; bj < 2; ++bj) {
      bgv[bj] = *(const f32x4*)(be + j0 + bj * 4); blv[bj] = *(const f32x4*)(be + 1024 + j0 + bj * 4);
      sgv[bj] = *(const f32x4*)(se + j0 + bj * 4); slv[bj] = *(const f32x4*)(se + 1024 + j0 + bj * 4);
    }
#pragma unroll
    for (int ai = 0; ai < 2; ++ai)
#pragma unroll
      for (int m = 0; m < 4; ++m) {
        const int slot = slot0 + ai * 128 + m * 16;
        const float sa = sav[ai][m];
        f32x4 ov[2];
#pragma unroll
        for (int bj = 0; bj < 2; ++bj) {
          const f32x4 bg = bgv[bj], bl = blv[bj];
          const f32x4 sg = sgv[bj], sl = slv[bj];
#pragma unroll
          for (int q = 0; q < 4; ++q) {
            const float g = (float)acc[ai][bj][m][0][q] * (sa * sg[q]) + bg[q];
            const float li = (float)acc[ai][bj][m][1][q] * (sa * sl[q]) + bl[q];
            const float gv = fminf(g, 7.f);
            const float lv = fminf(fmaxf(li, -7.f), 7.f);
            ov[bj][q] = gv * sigmoidf_(1.702f * gv) * (lv + 1.f);
          }
        }
        *(bf16x8*)(ACT + (size_t)slot * 1024 + j0) = pack8(ov[0], ov[1]);
      }
  }
};
__device__ __forceinline__ void phase_moe1_impl(PP pp, int l, int bid, int nb, char* smem, int* toff) {
  moe_offsets(pp, toff);
  moe_tile_experts(toff);
  g8::MoeSched S{toff, 8, 2048, nb, bid};
  EpiMoe1 E{p.moe_b_gu + (size_t)l * 32 * 2048, (const float*)(p.ws + OFF_SW) + (size_t)l * 32 * 2048, (const float*)(p.ws + OFF_SLS), (bfr*)(p.ws + OFF_P)};
  g8::gemm_stream<true, true>((LAS unsigned char*)smem, p.ws + OFF_H, p.ws + OFF_W + (size_t)l * WL_SIZE + WL_GU, S, E, (const int*)(p.ws + OFF_SLT));
}

struct EpiMoe2 {
  const float* bdn; const float* SLG; bfr* YS;
  __device__ __forceinline__ void operator()(const f32x4 (&acc)[2][2][4][2], const g8::GUnit& u, int wr, int wc, int fr, int fq) const {
    const float* be = bdn + (size_t)u.e * 1024;
    const int slot0 = u.pm * 256 + wr * 64 + fr, col0 = u.pn * 256 + wc * 32 + 8 * fq;
    float gtv[2][4];
#pragma unroll
    for (int ai = 0; ai < 2; ++ai)
#pragma unroll
      for (int m = 0; m < 4; ++m) gtv[ai][m] = SLG[slot0 + ai * 128 + m * 16];
    f32x4 bvv[2][2];
#pragma unroll
    for (int bj = 0; bj < 2; ++bj)
#pragma unroll
      for (int n = 0; n < 2; ++n) bvv[bj][n] = *(const f32x4*)(be + col0 + bj * 128 + n * 4);
#pragma unroll
    for (int ai = 0; ai < 2; ++ai)
#pragma unroll
      for (int m = 0; m < 4; ++m) {
        const int slot = slot0 + ai * 128 + m * 16;
        const float gt = gtv[ai][m];
#pragma unroll
        for (int bj = 0; bj < 2; ++bj) {
          const f32x4 y0 = (acc[ai][bj][m][0] + bvv[bj][0]) * gt;
          const f32x4 y1 = (acc[ai][bj][m][1] + bvv[bj][1]) * gt;
          *(bf16x8*)(YS + (size_t)slot * 1024 + col0 + bj * 128) = pack8(y0, y1);
        }
      }
  }
};
__device__ __forceinline__ void phase_moe2_impl(PP pp, int l, int bid, int nb, char* smem, int* toff) {
  moe_offsets(pp, toff);
  moe_tile_experts(toff);
  g8::MoeSched S{toff, 4, 1024, nb, bid};
  EpiMoe2 E{p.moe_b_down + (size_t)l * 32 * 1024, (const float*)(p.ws + OFF_SLG), (bfr*)(p.ws + OFF_S)};
  g8::gemm_stream<false, false>((LAS unsigned char*)smem, p.ws + OFF_P, p.ws + OFF_W + (size_t)l * WL_SIZE + WL_DN, S, E);
}

__device__ __forceinline__ void phase_combine(PP pp, int l, int bid, int nb) {
  const int tid = tid_opaque(), lane = tid & 63, wv = wave_id(tid);
  const bfr* YS = (const bfr*)(p.ws + OFF_S);
  const int* TOKS = (const int*)(p.ws + OFF_TOKS);
  const float* mods = (const float*)(p.ws + OFF_MODS) + (size_t)l * 3 * 6144;
  const float* mods1 = (const float*)(p.ws + OFF_MODS) + (size_t)3 * 6144;
  const float* g1n = p.norm_mix_g + 1024;
  bfr* H = (bfr*)(p.ws + OFF_H);
  float* xl = p.out;
  float* xc = (float*)(p.ws + OFF_CTX);
  const int ntok = (l == 0) ? NTOK : NLAT;
  if (l == 0) {
    int* cnt = (int*)(p.ws + OFF_CNT);
    const int gt = bid * NTHR + tid;
    if (gt < 32) cnt[gt] = 0;
  }
  for (int m = bid * 8 + wv; m < ntok; m += nb * 8) {
    float* xr = (m < NLAT) ? xl + (size_t)m * 1024 : xc + (size_t)(m - NLAT) * 1024;
    const float* g2 = mods + (size_t)mod_row(m) * 6144 + 5120;
    const int s0 = TOKS[(size_t)m * 4], s1 = TOKS[(size_t)m * 4 + 1], s2 = TOKS[(size_t)m * 4 + 2], s3 = TOKS[(size_t)m * 4 + 3];
    float4 xn[4];
    float ss = 0.f;
#pragma unroll
    for (int i = 0; i < 4; ++i) {
      const int d = (lane + 64 * i) * 4;
      const bf16x4 a = *(const bf16x4*)(YS + (size_t)s0 * 1024 + d);
      const bf16x4 b = *(const bf16x4*)(YS + (size_t)s1 * 1024 + d);
      const bf16x4 c = *(const bf16x4*)(YS + (size_t)s2 * 1024 + d);
      const bf16x4 e = *(const bf16x4*)(YS + (size_t)s3 * 1024 + d);
      const float4 gg = *(const float4*)(g2 + d);
      float4 xv = *(const float4*)(xr + d);
      xv.x += gg.x * ((bf2f(a[0]) + bf2f(b[0])) + (bf2f(c[0]) + bf2f(e[0])));
      xv.y += gg.y * ((bf2f(a[1]) + bf2f(b[1])) + (bf2f(c[1]) + bf2f(e[1])));
      xv.z += gg.z * ((bf2f(a[2]) + bf2f(b[2])) + (bf2f(c[2]) + bf2f(e[2])));
      xv.w += gg.w * ((bf2f(a[3]) + bf2f(b[3])) + (bf2f(c[3]) + bf2f(e[3])));
      *(float4*)(xr + d) = xv;
      xn[i] = xv;
      ss += xv.x * xv.x + xv.y * xv.y + xv.z * xv.z + xv.w * xv.w;
    }
    if (l == 0) {
      ss = wave_sum(ss);
      const float rs = rsqrtf(ss * (1.f / 1024.f) + 1e-6f);
      const float* md = mods1 + (size_t)mod_row(m) * 6144;
      float4 hq[4];
#pragma unroll
      for (int i = 0; i < 4; ++i) {
        const int d = (lane + 64 * i) * 4;
        const float4 gg = *(const float4*)(g1n + d);
        const float4 sh = *(const float4*)(md + d);
        const float4 sc = *(const float4*)(md + 1024 + d);
        hq[i] = make_float4(xn[i].x * rs * gg.x * (1.f + sc.x) + sh.x, xn[i].y * rs * gg.y * (1.f + sc.y) + sh.y,
                            xn[i].z * rs * gg.z * (1.f + sc.z) + sh.z, xn[i].w * rs * gg.w * (1.f + sc.w) + sh.w);
      }
      const float qs = quant_row_store(hq, (signed char*)(p.ws + OFF_H) + (size_t)m * 1024, lane);
      if (lane == 0) ((float*)(p.ws + OFF_SCL))[m] = qs;
    }
  }
}

#define XB_TMO      128
#define XB_XCNT(j)  (256  + 64 * (j))
#define XB_XSUB(j)  (1280 + 64 * (j))
#define XB_XGEN(j)  (2304 + 64 * (j))
#define XB_TOP      3328
#define XB_TOPGEN   3392
#define XCD_BAR_WORDS 3456
#define XB_SPIN_CAP (1u << 22)
__device__ __forceinline__ unsigned xb_ld(unsigned* q) { return __hip_atomic_load(q, __ATOMIC_RELAXED, __HIP_MEMORY_SCOPE_AGENT); }
__device__ __forceinline__ unsigned xb_add(unsigned* q, unsigned v) { return __hip_atomic_fetch_add(q, v, __ATOMIC_RELAXED, __HIP_MEMORY_SCOPE_AGENT); }
__device__ __forceinline__ unsigned xb_xcc_id() { return (unsigned)__builtin_amdgcn_s_getreg((3 << 11) | 20) & 0xFu; }
#define XB_SPIN(cond, bar) do { unsigned _sp = 0; while (cond) { __builtin_amdgcn_s_sleep(1); \
    if ((++_sp & 255u) == 0u) { if (xb_ld(&(bar)[XB_TMO])) break; if (_sp > XB_SPIN_CAP) { atomicAdd(&(bar)[XB_TMO], 1u); break; } } } } while (0)
struct XcdBarrier { unsigned* bar; unsigned x; volatile LAS unsigned* st; };
__device__ __forceinline__ XcdBarrier xcd_barrier_post(unsigned* bar, volatile LAS unsigned* st) {
  XcdBarrier b; b.bar = bar; b.x = xb_xcc_id(); b.st = st;
  if (tid_opaque() == 0) (void)xb_add(&bar[XB_XCNT(b.x)], 1u);
  return b;
}
__device__ __forceinline__ void xcd_barrier_complete(unsigned* bar, unsigned x, unsigned& nloc, unsigned& nx) {
  const unsigned G = gridDim.x;
  unsigned sum, cnt, mine, sp = 0u;
  for (;;) {
    sum = 0u; cnt = 0u; mine = 0u;
#pragma unroll
    for (unsigned j = 0; j < 16; ++j) { const unsigned c = xb_ld(&bar[XB_XCNT(j)]); sum += c; cnt += (c > 0u) ? 1u : 0u; mine = (j == x) ? c : mine; }
    if (sum == G) break;
    __builtin_amdgcn_s_sleep(1);
    if ((++sp & 255u) == 0u) { if (xb_ld(&bar[XB_TMO])) break; if (sp > XB_SPIN_CAP) { atomicAdd(&bar[XB_TMO], 1u); break; } }
  }
  nloc = mine > 0u ? mine : 1u; nx = cnt > 0u ? cnt : 1u;
}
__device__ __forceinline__ void xcd_barrier(const XcdBarrier& b) {
  asm volatile("s_waitcnt vmcnt(0)" ::: "memory");
  __syncthreads();
  if (tid_opaque() == 0) {
    unsigned* bar = b.bar;
    __builtin_amdgcn_s_waitcnt(0);
    unsigned nloc = b.st[0], nx = b.st[1];
    if (nloc == 0u) { xcd_barrier_complete(bar, b.x, nloc, nx); b.st[0] = nloc; b.st[1] = nx; }
    const unsigned old = xb_add(&bar[XB_XSUB(b.x)], 1u);
    const unsigned gen = old / nloc;
    if (old + 1u == (gen + 1u) * nloc) {
      __builtin_amdgcn_fence(__ATOMIC_RELEASE, "agent");
      asm volatile("s_waitcnt vmcnt(0)" ::: "memory");
      const unsigned og = xb_add(&bar[XB_TOP], 1u);
      const unsigned tg = og / nx;
      if (og + 1u == (tg + 1u) * nx) xb_add(&bar[XB_TOPGEN], 1u);
      else XB_SPIN(xb_ld(&bar[XB_TOPGEN]) == tg, bar);
      __builtin_amdgcn_fence(__ATOMIC_ACQUIRE, "agent");
      xb_add(&bar[XB_XGEN(b.x)], 1u);
      asm volatile("s_waitcnt vmcnt(0)" ::: "memory");
    } else {
      XB_SPIN(xb_ld(&bar[XB_XGEN(b.x)]) == gen, bar);
      __builtin_amdgcn_fence(__ATOMIC_ACQUIRE, "agent");
      asm volatile("s_waitcnt vmcnt(0)" ::: "memory");
    }
  }
  __syncthreads();
}

extern __shared__ __attribute__((aligned(16))) char dyn_smem[];

__global__ void __launch_bounds__(NTHR) mega(Params p_unused) {
  cg::grid_group grid = cg::this_grid();
  const int bid0 = blockIdx.x, nb0 = gridDim.x;
#if defined(__HIP_DEVICE_COMPILE__)
  PP pp0 = (PP)__builtin_amdgcn_kernarg_segment_ptr();
#else
  PP pp0 = nullptr;
#endif
#define pp ({ PP q_ = pp0; asm volatile("" : "+s"(q_)); q_; })
#define bid opq(bid0)
#define nb opq(nb0)
  int* toff_s = (int*)(dyn_smem + 147456);
  volatile LAS unsigned* xb_st = (volatile LAS unsigned*)(dyn_smem + 147456 + 256);
  {
    unsigned* barw = (unsigned*)(fresh_ws(pp0) + OFF_BAR);
    if (blockIdx.x == 0) for (int i = threadIdx.x; i < XCD_BAR_WORDS; i += NTHR) barw[i] = 0u;
    if (threadIdx.x == 0) { xb_st[0] = 0u; xb_st[1] = 0u; }
  }
  grid.sync();
  const XcdBarrier xb = xcd_barrier_post((unsigned*)(fresh_ws(pp0) + OFF_BAR), xb_st);
#define GSYNC() xcd_barrier(xb)
  phase_ada(pp, bid, nb, dyn_smem);
  phase_convert(pp, 0, 0, bid, nb, dyn_smem);
  GSYNC();
#define LAYER(LV, LAST)                                      \
  {                                                          \
    if ((LV) == 0) { phase_prenorm(pp, opq(LV), bid, nb); GSYNC(); } \
    phase_gemm_in(pp, opq(LV), bid, nb, dyn_smem);           \
    GSYNC();                                                 \
    phase_prep(pp, opq(LV), bid, nb, dyn_smem);              \
    GSYNC();                                                 \
    phase_chunk_prep(pp, bid, nb, dyn_smem);                 \
    GSYNC();                                                 \
    phase_mix(pp, opq(LV), bid, nb, dyn_smem);               \
    GSYNC();                                                 \
    phase_post(pp, opq(LV), bid, nb);                        \
    GSYNC();                                                 \
    phase_gemm_out(pp, opq(LV), bid, nb, dyn_smem);          \
    GSYNC();                                                 \
    phase_router(pp, opq(LV), bid, nb, dyn_smem);            \
    GSYNC();                                                 \
    phase_slotfill(pp, opq(LV), bid, nb, dyn_smem);          \
    GSYNC();                                                 \
    phase_moe1_impl(pp, opq(LV), bid, nb, dyn_smem, toff_s); \
    GSYNC();                                                 \
    phase_moe2_impl(pp, opq(LV), bid, nb, dyn_smem, toff_s); \
    GSYNC();                                                 \
    phase_combine(pp, opq(LV), bid, nb);                     \
    if (!(LAST)) GSYNC();                                    \
  }
  LAYER(0, false)
  LAYER(1, true)
#undef LAYER
#undef GSYNC
#undef bid
#undef nb
#undef pp
}

#undef p
extern "C" void kernel_launch(void* const* d_in, const int* in_sizes, int n_in, void* d_out, int out_size, void* d_ws,
                              size_t ws_size, hipStream_t stream) {
  Params hp{};
  const float** pp = (const float**)&hp;
  for (int i = 0; i < 34; ++i) pp[i] = (const float*)d_in[i];
  hp.out = (float*)d_out;
  hp.ws = (char*)d_ws;
  static int grid_blocks = 0;
  if (!grid_blocks) {
    (void)hipFuncSetAttribute((const void*)mega, hipFuncAttributeMaxDynamicSharedMemorySize, LDS_BYTES);
    int dev = 0, cus = 0, per_cu = 0;
    (void)hipGetDevice(&dev);
    (void)hipDeviceGetAttribute(&cus, hipDeviceAttributeMultiprocessorCount, dev);
    (void)hipOccupancyMaxActiveBlocksPerMultiprocessor(&per_cu, mega, NTHR, LDS_BYTES);
    if (per_cu < 1) per_cu = 1;
    if (per_cu > 1) per_cu = 1;
    grid_blocks = cus * per_cu;
  }
  void* args[] = {&hp};
  (void)hipLaunchCooperativeKernel((void*)mega, dim3(grid_blocks), dim3(NTHR), args, LDS_BYTES, stream);
}
```

```cpp
#include <hip/hip_runtime.h>
#include <hip/hip_bf16.h>
#include <hip/hip_cooperative_groups.h>
#include <stdint.h>
#include <type_traits>
namespace cg = cooperative_groups;

typedef __attribute__((ext_vector_type(8))) short bf16x8;
typedef __attribute__((ext_vector_type(4))) short bf16x4;
typedef __attribute__((ext_vector_type(4))) float f32x4;
typedef __attribute__((ext_vector_type(4))) int i32x4;
typedef unsigned short bfr;

#define D_MODEL 1024
#define NB 2
#define SEQ 16384
#define CTXL 256
#define NLAT (NB * SEQ)
#define NCTX (NB * CTXL)
#define NTOK (NLAT + NCTX)
#define TTOK (SEQ + CTXL)
#define PIN 3472
#define PINP 3584
#define A_END 1536
#define B_END 2432
#define NEXP 32
#define NSLOT_MAX (NTOK * 4 + NEXP * 256)
#define NTHR 512
#define LDS_BYTES (147456 + 3072)

constexpr size_t al256(size_t x) { return (x + 255) & ~(size_t)255; }
constexpr size_t WL_IN = 0;
constexpr size_t WL_OUT = WL_IN + (size_t)PINP * 1024 * 2;
constexpr size_t WL_GU = WL_OUT + (size_t)1024 * 1024 * 2;
constexpr size_t WL_DN = WL_GU + (size_t)32 * 2048 * 1024 * 2;
constexpr size_t WL_SIZE = WL_DN + (size_t)32 * 1024 * 1024 * 2;
constexpr size_t OFF_W = 0;
constexpr size_t OFF_MODS = al256(OFF_W + 2 * WL_SIZE);
constexpr size_t OFF_BAR = al256(OFF_MODS + 2 * 3 * 6144 * 4);
constexpr size_t OFF_SW = al256(OFF_BAR + 3456 * 4);
constexpr size_t OFF_SWIN = al256(OFF_SW + (size_t)2 * 32 * 2048 * 4);
constexpr size_t OFF_SLS = al256(OFF_SWIN + (size_t)2 * PINP * 4);
constexpr size_t OFF_SCL = al256(OFF_SLS + (size_t)(NTOK * 4 + 32 * 256) * 4);
constexpr size_t OFF_CTX = al256(OFF_SCL + (size_t)NTOK * 4);
constexpr size_t OFF_CNT = al256(OFF_CTX + (size_t)NCTX * 1024 * 4);
constexpr size_t OFF_TOKE = al256(OFF_CNT + 256);
constexpr size_t OFF_TOKP = al256(OFF_TOKE + (size_t)NTOK * 4 * 4);
constexpr size_t OFF_TOKG = al256(OFF_TOKP + (size_t)NTOK * 4 * 4);
constexpr size_t OFF_TOKS = al256(OFF_TOKG + (size_t)NTOK * 4 * 4);
constexpr size_t OFF_SLT = al256(OFF_TOKS + (size_t)NTOK * 4 * 4);
constexpr size_t OFF_SLG = al256(OFF_SLT + (size_t)NSLOT_MAX * 4);
constexpr size_t OFF_H = al256(OFF_SLG + (size_t)NSLOT_MAX * 4);
constexpr size_t OFF_CC = al256(OFF_H + (size_t)NTOK * 1024 * 2);
constexpr size_t OFF_P = al256(OFF_CC + (size_t)NTOK * 1024 * 2);
constexpr size_t OFF_S = al256(OFF_P + (size_t)NTOK * PINP * 4);
constexpr size_t TOK256F = (size_t)NTOK * 256 * 4;
constexpr size_t S_QN = 0;
constexpr size_t S_KN = S_QN + (size_t)NTOK * 512 * 2;
constexpr size_t S_VT = S_KN + (size_t)NTOK * 512 * 2;
constexpr size_t S_RWR = S_VT + (size_t)NB * 8 * 64 * TTOK * 2;
constexpr size_t S_RWKK = S_RWR + TOK256F;
constexpr size_t S_RWV = S_RWKK + TOK256F;
constexpr size_t S_RWG = S_RWV + TOK256F;
constexpr size_t S_RWW = S_RWG + TOK256F;
constexpr size_t S_RWKD = S_RWW + 2 * TOK256F;
constexpr size_t S_RWB = S_RWKD + 2 * TOK256F;
constexpr size_t S_BON = S_RWB + 2 * TOK256F;
constexpr size_t S_GDQ = al256(S_BON + (size_t)NTOK * 4 * 4);
constexpr size_t S_GDK = S_GDQ + TOK256F;
constexpr size_t S_GDV = S_GDK + TOK256F;
constexpr size_t S_GDAB = S_GDV + TOK256F;
constexpr size_t S_YRW = al256(S_GDAB + (size_t)NTOK * 16 * 4);
constexpr size_t S_YGD = S_YRW + 2 * TOK256F;
constexpr size_t S_END = S_YGD + 2 * TOK256F;
constexpr size_t S_SIZE = (S_END > (size_t)NSLOT_MAX * 1024 * 4) ? S_END : (size_t)NSLOT_MAX * 1024 * 4;
constexpr int NCHUNK = TTOK / 64;
constexpr int NCHAIN = 32;
constexpr size_t OFF_CH = al256(OFF_S + S_SIZE);
constexpr size_t CH_N = (size_t)NCHAIN * NCHUNK;
constexpr size_t CH_REC = 32768, CH_PT = 0, CH_RYT = 8192, CH_QT = 16384, CH_YX = 24576;
constexpr size_t CH_SIZE = CH_N * CH_REC;
constexpr size_t WS_TOTAL = OFF_CH + CH_SIZE;
static_assert(WS_TOTAL <= (size_t)2048 * 1024 * 1024, "workspace exceeds 4x largest tensor");

struct Params {
  const float *x, *c, *ctx, *c_ctx, *ada_w, *ada_b, *norm_mix_g, *norm_ffn_g, *w_in, *w_out;
  const float *na_q_gain, *na_k_gain, *na_rpb;
  const float *rw_mu, *rw_w0, *rw_w_up, *rw_a0, *rw_a_up, *rw_g_up, *rw_k_k, *rw_k_a, *rw_r_k, *rw_ln_w, *rw_ln_b;
  const float *gd_conv_w, *gd_A_log, *gd_dt_bias, *gd_norm_g;
  const float *moe_router_w, *moe_router_b, *moe_w_gu, *moe_b_gu, *moe_w_down, *moe_b_down;
  float* out;
  char* ws;
};

typedef const __attribute__((address_space(4))) Params* PP;
#define p (*pp)
__device__ __forceinline__ char* fresh_ws(PP pp) { return p.ws; }
__device__ __forceinline__ int tid_opaque() { int t = (int)__builtin_amdgcn_workitem_id_x(); asm volatile("" : "+v"(t)); return t; }
__device__ __forceinline__ int opq(int x) { asm volatile("" : "+s"(x)); return x; }
__device__ __forceinline__ int wave_id(int tid) { return __builtin_amdgcn_readfirstlane(tid >> 6); }
typedef __bf16 bf16v2_t __attribute__((ext_vector_type(2)));
typedef float f32v2_t __attribute__((ext_vector_type(2)));
__device__ __forceinline__ unsigned pk_bf16(float lo, float hi) { f32v2_t v = {lo, hi}; return __builtin_bit_cast(unsigned, __builtin_convertvector(v, bf16v2_t)); }
__device__ __forceinline__ bfr f2bf(float f) { return (bfr)(pk_bf16(f, f) & 0xffffu); }
__device__ __forceinline__ float bf2f(short v) { return __uint_as_float(((unsigned)(unsigned short)v) << 16); }
__device__ __forceinline__ bf16x4 pack4(float a, float b, float c, float d) {
  typedef __attribute__((ext_vector_type(2))) unsigned u32x2;
  u32x2 w; w[0] = pk_bf16(a, b); w[1] = pk_bf16(c, d);
  return __builtin_bit_cast(bf16x4, w);
}
__device__ __forceinline__ bf16x8 pack8(f32x4 a, f32x4 b) {
  const bf16x4 lo = pack4(a[0], a[1], a[2], a[3]), hi = pack4(b[0], b[1], b[2], b[3]);
  return __builtin_shufflevector(lo, hi, 0, 1, 2, 3, 4, 5, 6, 7);
}
__device__ __forceinline__ int perm_row32(int n) { return (n & ~31) | (((n >> 2) & 1) << 4) | (((n >> 3) & 3) << 2) | (n & 3); }
__device__ __forceinline__ float sigmoidf_(float x) { return __builtin_amdgcn_rcpf(1.f + __expf(-x)); }
__device__ __forceinline__ float siluf_(float x) { return x * __builtin_amdgcn_rcpf(1.f + __expf(-x)); }
__device__ __forceinline__ float softplusf_(float x) { const float e = __expf(fminf(x, 20.f)); const float lg = __logf(1.f + e); const float r = x < -15.f ? e : lg; return x > 20.f ? x : r; }
__device__ __forceinline__ float wave_sum(float v) {
  v += __builtin_bit_cast(float, __builtin_amdgcn_update_dpp(0, __builtin_bit_cast(int, v), 0xB1, 0xF, 0xF, true));
  v += __builtin_bit_cast(float, __builtin_amdgcn_update_dpp(0, __builtin_bit_cast(int, v), 0x4E, 0xF, 0xF, true));
  v += __builtin_bit_cast(float, __builtin_amdgcn_update_dpp(0, __builtin_bit_cast(int, v), 0x141, 0xF, 0xF, true));
  v += __builtin_bit_cast(float, __builtin_amdgcn_update_dpp(0, __builtin_bit_cast(int, v), 0x140, 0xF, 0xF, true));
  v += __builtin_bit_cast(float, __builtin_amdgcn_update_dpp(0, __builtin_bit_cast(int, v), 0x142, 0xA, 0xF, false));
  v += __builtin_bit_cast(float, __builtin_amdgcn_update_dpp(0, __builtin_bit_cast(int, v), 0x143, 0xC, 0xF, false));
  return __builtin_bit_cast(float, __builtin_amdgcn_readlane(__builtin_bit_cast(int, v), 63));
}
__device__ __forceinline__ float wave_max(float v) {
  v = fmaxf(v, __builtin_bit_cast(float, __builtin_amdgcn_update_dpp(0, __builtin_bit_cast(int, v), 0xB1, 0xF, 0xF, true)));
  v = fmaxf(v, __builtin_bit_cast(float, __builtin_amdgcn_update_dpp(0, __builtin_bit_cast(int, v), 0x4E, 0xF, 0xF, true)));
  v = fmaxf(v, __builtin_bit_cast(float, __builtin_amdgcn_update_dpp(0, __builtin_bit_cast(int, v), 0x141, 0xF, 0xF, true)));
  v = fmaxf(v, __builtin_bit_cast(float, __builtin_amdgcn_update_dpp(0, __builtin_bit_cast(int, v), 0x140, 0xF, 0xF, true)));
  const float r1 = __builtin_bit_cast(float, __builtin_amdgcn_readlane(__builtin_bit_cast(int, v), 0));
  const float r2 = __builtin_bit_cast(float, __builtin_amdgcn_readlane(__builtin_bit_cast(int, v), 16));
  const float r3 = __builtin_bit_cast(float, __builtin_amdgcn_readlane(__builtin_bit_cast(int, v), 32));
  const float r4 = __builtin_bit_cast(float, __builtin_amdgcn_readlane(__builtin_bit_cast(int, v), 48));
  return fmaxf(fmaxf(r1, r2), fmaxf(r3, r4));
}
__device__ __forceinline__ float shfl_xor_l(float v, int mask, int lane) {
  return __builtin_bit_cast(float, __builtin_amdgcn_ds_bpermute((lane ^ mask) << 2, __builtin_bit_cast(int, v)));
}
__device__ __forceinline__ int shfl_xor_li(int v, int mask, int lane) {
  return __builtin_amdgcn_ds_bpermute((lane ^ mask) << 2, v);
}
__device__ __forceinline__ float row16_sum(float v) {
  v += __builtin_bit_cast(float, __builtin_amdgcn_update_dpp(0, __builtin_bit_cast(int, v), 0xB1, 0xF, 0xF, true));
  v += __builtin_bit_cast(float, __builtin_amdgcn_update_dpp(0, __builtin_bit_cast(int, v), 0x4E, 0xF, 0xF, true));
  v += __builtin_bit_cast(float, __builtin_amdgcn_update_dpp(0, __builtin_bit_cast(int, v), 0x141, 0xF, 0xF, true));
  v += __builtin_bit_cast(float, __builtin_amdgcn_update_dpp(0, __builtin_bit_cast(int, v), 0x140, 0xF, 0xF, true));
  return v;
}
__device__ __forceinline__ float quant_row_store(const float4 (&v)[4], signed char* dst_row, int lane) {
  float am = 0.f;
#pragma unroll
  for (int i = 0; i < 4; ++i) am = fmaxf(fmaxf(am, fmaxf(fabsf(v[i].x), fabsf(v[i].y))), fmaxf(fabsf(v[i].z), fabsf(v[i].w)));
  am = wave_max(am);
  const float sc = am > 0.f ? am * (1.f / 127.f) : 1.f, iv = 1.f / sc;
#pragma unroll
  for (int i = 0; i < 4; ++i) {
    const int q0 = (int)fminf(fmaxf(rintf(v[i].x * iv), -127.f), 127.f), q1 = (int)fminf(fmaxf(rintf(v[i].y * iv), -127.f), 127.f);
    const int q2 = (int)fminf(fmaxf(rintf(v[i].z * iv), -127.f), 127.f), q3 = (int)fminf(fmaxf(rintf(v[i].w * iv), -127.f), 127.f);
    *(unsigned*)(dst_row + (lane + 64 * i) * 4) = (unsigned)(q0 & 0xff) | ((unsigned)(q1 & 0xff) << 8) | ((unsigned)(q2 & 0xff) << 16) | ((unsigned)(q3 & 0xff) << 24);
  }
  return sc;
}
__device__ __forceinline__ float ldbf1(const bfr* q, size_t i) { return bf2f((short)q[i]); }
__device__ __forceinline__ f32x4 ldbf4(const bfr* q) { const bf16x4 v = *(const bf16x4*)q; return (f32x4){bf2f(v[0]), bf2f(v[1]), bf2f(v[2]), bf2f(v[3])}; }
__device__ __forceinline__ int mod_row(int m) { return m < NLAT ? (m >> 14) : 2; }

__device__ __forceinline__ void phase_ada(PP pp, int bid, int nb, char* smem) {
  float* red = (float*)smem;
  float* mods = (float*)(p.ws + OFF_MODS);
  const int tid = tid_opaque();
  for (int task = bid; task < 2 * 96; task += nb) {
    int l = task / 96, cgp = task % 96;
    int col = cgp * 64 + (tid & 63), ks = tid >> 6;
    const float* W = p.ada_w + (size_t)l * 1024 * 6144;
    float a0 = 0.f, a1 = 0.f, a2 = 0.f;
    for (int d = ks * 128; d < ks * 128 + 128; ++d) {
      float w = W[(size_t)d * 6144 + col];
      a0 += siluf_(p.c[d]) * w;
      a1 += siluf_(p.c[1024 + d]) * w;
      a2 += siluf_(p.c_ctx[d]) * w;
    }
    red[(ks * 3 + 0) * 64 + (tid & 63)] = a0;
    red[(ks * 3 + 1) * 64 + (tid & 63)] = a1;
    red[(ks * 3 + 2) * 64 + (tid & 63)] = a2;
    __syncthreads();
    if (tid < 192) {
      int r = tid >> 6, cc = tid & 63;
      float s = 0.f;
      for (int k = 0; k < 8; ++k) s += red[(k * 3 + r) * 64 + cc];
      mods[(size_t)(l * 3 + r) * 6144 + cgp * 64 + cc] = s + p.ada_b[(size_t)l * 6144 + cgp * 64 + cc];
    }
    __syncthreads();
  }
}

template <bool PERM>
__device__ __forceinline__ void convert_tile(const float* src, int N, bfr* dst, int kt4  , int nt, float* tile  ) {
  const int tid = tid_opaque();
  float4 v[8];
#pragma unroll
  for (int q = 0; q < 8; ++q) {
    const int idx = tid + q * 512;
    const int kk = idx >> 4, n4 = idx & 15;
    v[q] = *(const float4*)(src + (size_t)(kt4 * 256 + kk) * N + nt * 64 + n4 * 4);
  }
#pragma unroll
  for (int q = 0; q < 8; ++q) {
    const int idx = tid + q * 512;
    const int kk = idx >> 4, n4 = idx & 15;
    tile[kk * 65 + n4 * 4 + 0] = v[q].x; tile[kk * 65 + n4 * 4 + 1] = v[q].y;
    tile[kk * 65 + n4 * 4 + 2] = v[q].z; tile[kk * 65 + n4 * 4 + 3] = v[q].w;
  }
  __syncthreads();
  {
    const int nn = tid >> 3, kc = tid & 7;
    const int n = PERM ? perm_row32(nt * 64 + nn) : nt * 64 + nn;
#pragma unroll
    for (int q = 0; q < 4; ++q) {
      const int k0 = (kc + 8 * q) * 8;
      *(bf16x4*)(dst + (size_t)n * 1024 + kt4 * 256 + k0) = pack4(tile[(k0 + 0) * 65 + nn], tile[(k0 + 1) * 65 + nn], tile[(k0 + 2) * 65 + nn], tile[(k0 + 3) * 65 + nn]);
      *(bf16x4*)(dst + (size_t)n * 1024 + kt4 * 256 + k0 + 4) = pack4(tile[(k0 + 4) * 65 + nn], tile[(k0 + 5) * 65 + nn], tile[(k0 + 6) * 65 + nn], tile[(k0 + 7) * 65 + nn]);
    }
  }
  __syncthreads();
}
template <int N, bool INTERLEAVE>
__device__ __forceinline__ void convert_i8(const float* src  , signed char* dst  , float* sw, int ng, char* smem) {
  const int tid = tid_opaque();
  bfr* blk = (bfr*)smem;
  int* cmax = (int*)(smem + 131072);
  if (tid < 64) cmax[tid] = 0;
  __syncthreads();
  {
    const int n4 = tid & 15, kk0 = tid >> 4;
    float m0 = 0.f, m1 = 0.f, m2 = 0.f, m3 = 0.f;
#pragma unroll 8
    for (int ps = 0; ps < 32; ++ps) {
      const int k = ps * 32 + kk0;
      const int ncol = ng * 64 + n4 * 4;
      const int ncl = (N % 64 == 0) ? ncol : min(ncol, N - 4);
      float4 v = *(const float4*)(src + (size_t)k * N + ncl);
      if (N % 64 != 0 && ncol != ncl) v = make_float4(0.f, 0.f, 0.f, 0.f);
      m0 = fmaxf(m0, fabsf(v.x)); m1 = fmaxf(m1, fabsf(v.y)); m2 = fmaxf(m2, fabsf(v.z)); m3 = fmaxf(m3, fabsf(v.w));
      *(bf16x4*)(blk + k * 64 + n4 * 4) = pack4(v.x, v.y, v.z, v.w);
    }
    atomicMax(&cmax[n4 * 4 + 0], __float_as_int(m0)); atomicMax(&cmax[n4 * 4 + 1], __float_as_int(m1));
    atomicMax(&cmax[n4 * 4 + 2], __float_as_int(m2)); atomicMax(&cmax[n4 * 4 + 3], __float_as_int(m3));
  }
  __syncthreads();
  {
    const int nn = tid >> 3, kc = tid & 7;
    const int n = ng * 64 + nn;
    const float am = __int_as_float(cmax[nn]);
    const float sc = am > 0.f ? am * (1.f / 127.f) : 1.f, iv = 1.f / sc;
    const int j = n & 1023;
    const int row = INTERLEAVE ? (j >> 7) * 256 + ((j >> 2) & 1) * 128 + ((j >> 5) & 3) * 32 + ((n >= 1024) ? 16 : 0) + ((j >> 3) & 3) * 4 + (j & 3) : perm_row32(n);
    if (kc == 0) sw[n] = sc;
#pragma unroll 2
    for (int q = 0; q < 8; ++q) {
      const int k0 = (kc + 8 * q) * 16;
      unsigned w[4];
#pragma unroll
      for (int g4 = 0; g4 < 4; ++g4) {
        unsigned acc = 0u;
#pragma unroll
        for (int b = 0; b < 4; ++b) {
          const float v = bf2f((short)blk[(k0 + g4 * 4 + b) * 64 + nn]);
          const int qi = (int)fminf(fmaxf(rintf(v * iv), -127.f), 127.f);
          acc |= ((unsigned)(qi & 0xff)) << (8 * b);
        }
        w[g4] = acc;
      }
      *(uint4*)(dst + (size_t)row * 1024 + k0) = make_uint4(w[0], w[1], w[2], w[3]);
    }
  }
  __syncthreads();
}
__device__ __forceinline__ void phase_convert(PP pp, int l, int part, int bid, int nb, char* smem) {
  float* tile = (float*)smem;
  char* wl = p.ws + OFF_W + (size_t)l * WL_SIZE;
  const int T_IN = 56, T_OUT = 4 * 16, T_GU = 32 * 32, T_DN = 32 * 4 * 16;
  const int t_lo = part == 0 ? 0 : T_IN + T_OUT;
  const int t_hi = part == 0 ? T_IN + T_OUT : T_IN + T_OUT + T_GU + T_DN;
  for (int t = t_lo + bid; t < t_hi; t += nb) {
    if (t < T_IN) {
      convert_i8<PIN, false>(p.w_in + (size_t)l * 1024 * PIN, (signed char*)(wl + WL_IN), (float*)(p.ws + OFF_SWIN) + (size_t)l * PINP, t, smem);
    } else if (t < T_IN + T_OUT) {
      int u = t - T_IN; int kt4 = u / 16, nt = u % 16;
      convert_tile<false>(p.w_out + (size_t)l * 1024 * 1024, 1024, (bfr*)(wl + WL_OUT), kt4, nt, tile);
    } else if (t < T_IN + T_OUT + T_GU) {
      int u = t - T_IN - T_OUT; int e = u / 32, ng = u % 32;
      convert_i8<2048, true>(p.moe_w_gu + ((size_t)l * 32 + e) * 1024 * 2048, (signed char*)(wl + WL_GU) + (size_t)e * 2048 * 1024,
                    (float*)(p.ws + OFF_SW) + ((size_t)l * 32 + e) * 2048, ng, smem);
    } else {
      int u = t - T_IN - T_OUT - T_GU; int e = u / 64; int v = u % 64; int kt4 = v / 16, nt = v % 16;
      convert_tile<true>(p.moe_w_down + ((size_t)l * 32 + e) * 1024 * 1024, 1024, (bfr*)(wl + WL_DN) + (size_t)e * 1024 * 1024, kt4, nt, tile);
    }
  }
}

__device__ __forceinline__ void phase_prenorm(PP pp, int l, int bid, int nb) {
  const int tid = tid_opaque(), lane = tid & 63, wv = wave_id(tid);
  const float* xl = (l == 0) ? p.x : p.out;
  const float* xc = (l == 0) ? p.ctx : (const float*)(p.ws + OFF_CTX);
  const float* mods = (const float*)(p.ws + OFF_MODS) + (size_t)l * 3 * 6144;
  const float* g = p.norm_mix_g + (size_t)l * 1024;
  signed char* H8 = (signed char*)(p.ws + OFF_H);
  float* SCL = (float*)(p.ws + OFF_SCL);
  {
    int* cnt = (int*)(p.ws + OFF_CNT);
    int gt = bid * NTHR + tid;
    if (gt < 32) cnt[gt] = 0;
  }
  for (int m = bid * 8 + wv; m < NTOK; m += nb * 8) {
    const float* xr = (m < NLAT) ? xl + (size_t)m * 1024 : xc + (size_t)(m - NLAT) * 1024;
    const float* md = mods + (size_t)mod_row(m) * 6144;
    float4 v[4];
    float ss = 0.f;
#pragma unroll
    for (int i = 0; i < 4; ++i) {
      v[i] = *(const float4*)(xr + (lane + 64 * i) * 4);
      ss += v[i].x * v[i].x + v[i].y * v[i].y + v[i].z * v[i].z + v[i].w * v[i].w;
    }
    ss = wave_sum(ss);
    float rs = rsqrtf(ss * (1.f / 1024.f) + 1e-6f);
    float4 hq[4];
#pragma unroll
    for (int i = 0; i < 4; ++i) {
      int d = (lane + 64 * i) * 4;
      float4 gg = *(const float4*)(g + d);
      float4 sh = *(const float4*)(md + d);
      float4 sc = *(const float4*)(md + 1024 + d);
      hq[i] = make_float4(v[i].x * rs * gg.x * (1.f + sc.x) + sh.x, v[i].y * rs * gg.y * (1.f + sc.y) + sh.y,
                          v[i].z * rs * gg.z * (1.f + sc.z) + sh.z, v[i].w * rs * gg.w * (1.f + sc.w) + sh.w);
    }
    const float qs = quant_row_store(hq, H8 + (size_t)m * 1024, lane);
    if (lane == 0) SCL[m] = qs;
  }
}

#define LAS __attribute__((address_space(3)))
namespace g8 {
constexpr int BM = 256, BK = 64, HALF = 128, HTB = HALF * BK * 2, STAGE_BYTES = 8 * HTB, KD = 1024;
__device__ __forceinline__ int lds_byte(int r, int c) { const int st = (r >> 4) * 2 + (c >> 5), rr = r & 15, cc = c & 31, ob = rr * 64 + cc * 2; return st * 1024 + (ob ^ (((ob >> 9) & 1) << 5)); }
__device__ __forceinline__ void stage_rc(int b, int& R, int& C) { const int st = b / 1024, sb = b % 1024, swz = sb ^ (((sb >> 9) & 1) << 5); R = (st >> 1) * 16 + swz / 64; C = (st & 1) * 32 + (swz % 64) / 2; }
struct GUnit { int pm, pn, brow0, e; };
__device__ __forceinline__ int unit_index(int i, int c, int G, int total) {
  const int x = c & 7, j = c >> 3, q = total >> 3, r = total & 7;
  const int start = x < r ? x * (q + 1) : r * (q + 1) + (x - r) * q;
  const int size = q + (x < r ? 1 : 0);
  const int li = i * (G >> 3) + j;
  return li < size ? start + li : -1;
}

__device__ __forceinline__ f32x4 mma16(bf16x8 a, bf16x8 b, f32x4 c) { return __builtin_amdgcn_mfma_f32_16x16x32_bf16(a, b, c, 0, 0, 0); }
__device__ __forceinline__ i32x4 mma16(i32x4 a, i32x4 b, i32x4 c) { return __builtin_amdgcn_mfma_i32_16x16x64_i8(a, b, c, 0, 0, 0); }
template <bool I8, bool GATHER, class Sched, class Epi>
__device__ __forceinline__ void gemm_stream(LAS unsigned char* lds, const void* Abase, const void* Btbase, const Sched& S, const Epi& E, const int* slt = nullptr) {
  typedef typename std::conditional<I8, i32x4, f32x4>::type AccT;
  typedef typename std::conditional<I8, i32x4, bf16x8>::type FragT;
  constexpr int KB = I8 ? KD : KD * 2;
  const int tid = tid_opaque(), wid = __builtin_amdgcn_readfirstlane(tid >> 6), lane = tid & 63, wr = wid >> 2, wc = wid & 3, fr = lane & 15, fq = lane >> 4;
  constexpr int nt = KB / 128;
  int R[2], C[2];
  unsigned voffB[2];
#pragma unroll
  for (int i = 0; i < 2; ++i) { stage_rc(tid * 16 + i * 8192, R[i], C[i]); voffB[i] = (unsigned)(R[i] * KB + C[i] * 2); }
#define voffA voffB
  constexpr size_t kstep = (size_t)(BK * 2);
  constexpr size_t hstep = (size_t)HALF * KB;
  const unsigned ldsw = (unsigned)wid * 1024u;
  const int aoff = lds_byte(wr * 64 + fr, fq * 8), boff = lds_byte(wc * 32 + fr, fq * 8);
#define G8_SA(b, h) (((b) * 2 + (h)) * HTB)
#define G8_SB(b, h) ((4 + (b) * 2 + (h)) * HTB)
#define G8_STAGE(bufoff, gbase, v0, v1) do { \
    __builtin_amdgcn_global_load_lds((const unsigned*)((const char*)(gbase) + (v0)), (LAS unsigned*)(lds + (bufoff) + ldsw), 16, 0, 0); \
    __builtin_amdgcn_global_load_lds((const unsigned*)((const char*)(gbase) + (v1)), (LAS unsigned*)(lds + (bufoff) + ldsw + 8192), 16, 0, 0); } while (0)
#define G8_STAGEB(bufoff, gbase) G8_STAGE(bufoff, gbase, voffB[0], voffB[1])
#define G8_STAGEA_U(bufoff, base_u, hsel) G8_STAGE(bufoff, (base_u) + (hsel) * hstep, voffA[0], voffA[1])
#define G8_STAGEA_G(bufoff, koff, o0, o1) G8_STAGE(bufoff, (const char*)Abase + (koff), o0, o1)
#define G8_LDA(dst, b, h) do { _Pragma("unroll") for (int m = 0; m < 4; ++m) _Pragma("unroll") for (int k = 0; k < 2; ++k) dst[m][k] = *(const LAS FragT*)(lds + G8_SA(b, h) + aoff + m * 2048 + k * 1024); } while (0)
#define G8_LDB(dst, b, h) do { _Pragma("unroll") for (int n = 0; n < 2; ++n) _Pragma("unroll") for (int k = 0; k < 2; ++k) dst[n][k] = *(const LAS FragT*)(lds + G8_SB(b, h) + boff + n * 2048 + k * 1024); } while (0)
#define G8_MMA(ai, bj, At, Bt) do { __builtin_amdgcn_s_setprio(1); _Pragma("unroll") for (int m = 0; m < 4; ++m) _Pragma("unroll") for (int n = 0; n < 2; ++n) _Pragma("unroll") for (int k = 0; k < 2; ++k) \
    acc[ai][bj][m][n] = mma16(Bt[n][k], At[m][k], acc[ai][bj][m][n]); __builtin_amdgcn_s_setprio(0); } while (0)
#define G8_WAIT_V(n) asm volatile("s_waitcnt vmcnt(" #n ")" ::: "memory")
#define G8_WAIT_L(n) asm volatile("s_waitcnt lgkmcnt(" #n ")" ::: "memory")
#define G8_BAR __builtin_amdgcn_s_barrier()
#define G8_SCHED __builtin_amdgcn_sched_barrier(0)
  GUnit cur, nxt;
  int ui = 0;
  if (!S.next(0, cur)) return;
  AccT acc[2][2][4][2];
#pragma unroll
  for (int a = 0; a < 2; ++a)
#pragma unroll
    for (int b = 0; b < 2; ++b)
#pragma unroll
      for (int m = 0; m < 4; ++m)
#pragma unroll
        for (int n = 0; n < 2; ++n) acc[a][b][m][n] = AccT{};
  FragT At[4][2], B0[2][2], B1[2][2];
  const char* cA = (const char*)Abase + (size_t)cur.pm * (BM * KB);
  unsigned gA00 = 0, gA01 = 0, gA10 = 0, gA11 = 0, gN00 = 0, gN01 = 0, gN10 = 0, gN11 = 0;
  if (GATHER) {
    const int* sr = slt + cur.pm * BM;
    gA00 = (unsigned)sr[R[0]] * KB + C[0] * 2; gA01 = (unsigned)sr[R[1]] * KB + C[1] * 2;
    gA10 = (unsigned)sr[HALF + R[0]] * KB + C[0] * 2; gA11 = (unsigned)sr[HALF + R[1]] * KB + C[1] * 2;
  }
  const char* cB = (const char*)Btbase + (size_t)cur.brow0 * KB;
  G8_STAGEB(G8_SB(0, 0), cB);
  if (GATHER) G8_STAGEA_G(G8_SA(0, 0), 0, gA00, gA01); else G8_STAGEA_U(G8_SA(0, 0), cA, 0);
  G8_STAGEB(G8_SB(0, 1), cB + hstep);
  if (GATHER) G8_STAGEA_G(G8_SA(0, 1), 0, gA10, gA11); else G8_STAGEA_U(G8_SA(0, 1), cA, 1);
  if (wr == 1) G8_BAR;
  G8_WAIT_V(4); G8_BAR;
  G8_STAGEB(G8_SB(1, 0), cB + kstep);
  if (GATHER) G8_STAGEA_G(G8_SA(1, 0), kstep, gA00, gA01); else G8_STAGEA_U(G8_SA(1, 0), cA + kstep, 0);
  G8_STAGEB(G8_SB(1, 1), cB + hstep + kstep);
  G8_WAIT_V(6); G8_BAR;
  for (;;) {
    const bool has_next = S.next(ui + 1, nxt);
    const char* nA = has_next ? (const char*)Abase + (size_t)nxt.pm * (BM * KB) : cA;
    if (GATHER) {
      if (has_next) {
        const int* sr = slt + nxt.pm * BM;
        gN00 = (unsigned)sr[R[0]] * KB + C[0] * 2; gN01 = (unsigned)sr[R[1]] * KB + C[1] * 2;
        gN10 = (unsigned)sr[HALF + R[0]] * KB + C[0] * 2; gN11 = (unsigned)sr[HALF + R[1]] * KB + C[1] * 2;
      } else { gN00 = gA00; gN01 = gA01; gN10 = gA10; gN11 = gA11; }
    }
    const char* nB = has_next ? (const char*)Btbase + (size_t)nxt.brow0 * KB : cB;
#pragma unroll 1
    for (int t = 0; t < nt; t += 2) {
      const bool last = (t == nt - 2);
      const char* a1 = cA + (size_t)(t + 1) * kstep;
      const char* a2 = last ? nA : cA + (size_t)(t + 2) * kstep;
      const char* b2 = last ? nB : cB + (size_t)(t + 2) * kstep;
      const char* a3 = a2 + kstep;
      const char* b3 = b2 + kstep;
      const size_t k1 = (size_t)(t + 1) * kstep, k2 = last ? 0 : (size_t)(t + 2) * kstep, k3 = k2 + kstep;
      const unsigned w00 = last ? gN00 : gA00, w01 = last ? gN01 : gA01, w10 = last ? gN10 : gA10, w11 = last ? gN11 : gA11;
      G8_LDB(B0, 0, 0); G8_SCHED; G8_LDA(At, 0, 0); if (GATHER) G8_STAGEA_G(G8_SA(1, 1), k1, gA10, gA11); else G8_STAGEA_U(G8_SA(1, 1), a1, 1);
      G8_WAIT_L(8); G8_BAR; G8_WAIT_L(0); G8_MMA(0, 0, At, B0); G8_BAR; G8_SCHED;
      G8_LDB(B1, 0, 1); G8_STAGEB(G8_SB(0, 0), b2);
      G8_BAR; G8_WAIT_L(0); G8_MMA(0, 1, At, B1); G8_BAR;
      G8_LDA(At, 0, 1); if (GATHER) G8_STAGEA_G(G8_SA(0, 0), k2, w00, w01); else G8_STAGEA_U(G8_SA(0, 0), a2, 0);
      G8_BAR; G8_WAIT_L(0); G8_MMA(1, 0, At, B0); G8_BAR; G8_SCHED;
      G8_STAGEB(G8_SB(0, 1), b2 + hstep);
      G8_WAIT_V(6); G8_BAR; G8_MMA(1, 1, At, B1); G8_BAR;
      G8_LDB(B0, 1, 0); G8_SCHED; G8_LDA(At, 1, 0); if (GATHER) G8_STAGEA_G(G8_SA(0, 1), k2, w10, w11); else G8_STAGEA_U(G8_SA(0, 1), a2, 1);
      G8_WAIT_L(8); G8_BAR; G8_WAIT_L(0); G8_MMA(0, 0, At, B0); G8_BAR; G8_SCHED;
      G8_LDB(B1, 1, 1); G8_STAGEB(G8_SB(1, 0), b3);
      G8_BAR; G8_WAIT_L(0); G8_MMA(0, 1, At, B1); G8_BAR;
      G8_LDA(At, 1, 1); if (GATHER) G8_STAGEA_G(G8_SA(1, 0), k3, w00, w01); else G8_STAGEA_U(G8_SA(1, 0), a3, 0);
      G8_BAR; G8_WAIT_L(0); G8_MMA(1, 0, At, B0); G8_BAR; G8_SCHED;
      G8_STAGEB(G8_SB(1, 1), b3 + hstep);
      G8_WAIT_V(6); G8_BAR; G8_MMA(1, 1, At, B1); G8_BAR;
    }
    E(acc, cur, wr, wc, fr, fq);
    if (!has_next) break;
#pragma unroll
    for (int a = 0; a < 2; ++a)
#pragma unroll
      for (int b = 0; b < 2; ++b)
#pragma unroll
        for (int m = 0; m < 4; ++m)
#pragma unroll
          for (int n = 0; n < 2; ++n) acc[a][b][m][n] = AccT{};
    cur = nxt; cA = nA; cB = nB; ++ui;
    gA00 = gN00; gA01 = gN01; gA10 = gN10; gA11 = gN11;
  }
  G8_WAIT_V(0);
  if (wr == 0) G8_BAR;
  G8_BAR;
#undef G8_SA
#undef G8_SB
#undef G8_STAGE
#undef G8_STAGEB
#undef G8_STAGEA_U
#undef G8_STAGEA_G
#undef voffA
#undef G8_LDA
#undef G8_LDB
#undef G8_MMA
#undef G8_WAIT_V
#undef G8_WAIT_L
#undef G8_BAR
#undef G8_SCHED
}

struct DenseSched {
  int nM, nN, G, c;
  __device__ __forceinline__ bool next(int i, GUnit& u) const {
    const int idx = unit_index(i, c, G, nM * nN);
    if (idx < 0) return false;
    u.pm = idx / nN; u.pn = idx - u.pm * nN; u.brow0 = u.pn * BM; u.e = 0;
    return true;
  }
};
struct MoeSched {
  const int* toff; int nN, NE, G, c;
  __device__ __forceinline__ bool next(int i, GUnit& u) const {
    const int idx = unit_index(i, c, G, toff[32] * nN);
    if (idx < 0) return false;
    u.pm = idx / nN; u.pn = idx - u.pm * nN;
    const int e = toff[128 + u.pm];
    u.e = e; u.brow0 = e * NE + u.pn * BM;
    return true;
  }
};
}

struct EpiInProj {
  bfr* P; const float* SCL; const float* sw;
  __device__ __forceinline__ void operator()(const i32x4 (&acc)[2][2][4][2], const g8::GUnit& u, int wr, int wc, int fr, int fq) const {
    const int row0 = u.pm * 256 + wr * 64 + fr, col0 = u.pn * 256 + wc * 32 + 8 * fq;
    f32x4 cs[2][2];
#pragma unroll
    for (int bj = 0; bj < 2; ++bj)
#pragma unroll
      for (int n = 0; n < 2; ++n) cs[bj][n] = *(const f32x4*)(sw + col0 + bj * 128 + n * 4);
    float sav[2][4];
#pragma unroll
    for (int ai = 0; ai < 2; ++ai)
#pragma unroll
      for (int m = 0; m < 4; ++m) sav[ai][m] = SCL[row0 + ai * 128 + m * 16];
#pragma unroll
    for (int ai = 0; ai < 2; ++ai)
#pragma unroll
      for (int m = 0; m < 4; ++m) {
        const int row = row0 + ai * 128 + m * 16;
        const float sa = sav[ai][m];
        bfr* rowp = P + (size_t)row * PINP + col0;
#pragma unroll
        for (int bj = 0; bj < 2; ++bj) {
          const i32x4 a0 = acc[ai][bj][m][0], a1 = acc[ai][bj][m][1];
          f32x4 o0 = {(float)a0[0], (float)a0[1], (float)a0[2], (float)a0[3]};
          f32x4 o1 = {(float)a1[0], (float)a1[1], (float)a1[2], (float)a1[3]};
          o0 = o0 * (cs[bj][0] * sa); o1 = o1 * (cs[bj][1] * sa);
          *(bf16x8*)(rowp + bj * 128) = pack8(o0, o1);
        }
      }
  }
};
__device__ __forceinline__ void phase_gemm_in(PP pp, int l, int bid, int nb, char* smem) {
  g8::DenseSched S{130, 14, nb, bid};
  EpiInProj E{(bfr*)(p.ws + OFF_P), (const float*)(p.ws + OFF_SCL), (const float*)(p.ws + OFF_SWIN) + (size_t)l * PINP};
  g8::gemm_stream<true, false>((LAS unsigned char*)smem, p.ws + OFF_H, p.ws + OFF_W + (size_t)l * WL_SIZE + WL_IN, S, E);
}

struct EpiOutProj {
  const float *xl, *xc, *mods; float *ol, *oc;
  __device__ __forceinline__ void operator()(const f32x4 (&acc)[2][2][4][2], const g8::GUnit& u, int wr, int wc, int fr, int fq) const {
    const bool lat = u.pm < 128;
    const float* xin = lat ? xl + (size_t)u.pm * 256 * 1024 : xc + (size_t)(u.pm - 128) * 256 * 1024;
    float* xo = lat ? ol + (size_t)u.pm * 256 * 1024 : oc + (size_t)(u.pm - 128) * 256 * 1024;
    const float* g1 = mods + (size_t)(lat ? (u.pm >> 6) : 2) * 6144 + 2048;
    const int row0 = wr * 64 + fr, col0 = u.pn * 256 + wc * 32 + 4 * fq;
#pragma unroll
    for (int bj = 0; bj < 2; ++bj)
#pragma unroll
      for (int n = 0; n < 2; ++n) {
        const f32x4 gv = *(const f32x4*)(g1 + col0 + bj * 128 + n * 16);
        f32x4 xv[2][4];
#pragma unroll
        for (int ai = 0; ai < 2; ++ai)
#pragma unroll
          for (int m = 0; m < 4; ++m) xv[ai][m] = *(const f32x4*)(xin + (size_t)(row0 + ai * 128 + m * 16) * 1024 + col0 + bj * 128 + n * 16);
#pragma unroll
        for (int ai = 0; ai < 2; ++ai)
#pragma unroll
          for (int m = 0; m < 4; ++m)
            *(f32x4*)(xo + (size_t)(row0 + ai * 128 + m * 16) * 1024 + col0 + bj * 128 + n * 16) = xv[ai][m] + gv * acc[ai][bj][m][n];
        asm volatile("" ::: "memory");
      }
  }
};
__device__ __forceinline__ void phase_gemm_out(PP pp, int l, int bid, int nb, char* smem) {
  g8::DenseSched S{(l == 0) ? 130 : 128, 4, nb, bid};
  EpiOutProj E{(l == 0) ? p.x : p.out, (l == 0) ? p.ctx : (const float*)(p.ws + OFF_CTX),
               (const float*)(p.ws + OFF_MODS) + (size_t)l * 3 * 6144, p.out, (float*)(p.ws + OFF_CTX)};
  g8::gemm_stream<false, false>((LAS unsigned char*)smem, p.ws + OFF_CC, p.ws + OFF_W + (size_t)l * WL_SIZE + WL_OUT, S, E);
}

#define LBAR() do { asm volatile("s_waitcnt lgkmcnt(0)" ::: "memory"); __builtin_amdgcn_s_barrier(); asm volatile("" ::: "memory"); } while (0)
__device__ __forceinline__ void phase_prep(PP pp, int l, int bid, int nb, char* smem) {
  const int tid = tid_opaque(), lane = tid & 63, wv = wave_id(tid);
  const bfr* P = (const bfr*)(p.ws + OFF_P);
  char* S = p.ws + OFF_S;
  bfr* QN = (bfr*)(S + S_QN);
  bfr* KN = (bfr*)(S + S_KN);
  bfr* VT = (bfr*)(S + S_VT);
  bfr* RWR = (bfr*)(S + S_RWR);
  bfr* RWKK = (bfr*)(S + S_RWKK);
  bfr* RWV = (bfr*)(S + S_RWV);
  bfr* RWG = (bfr*)(S + S_RWG);
  float* RWW = (float*)(S + S_RWW);
  bfr* RWKD = (bfr*)(S + S_RWKD);
  bfr* RWB = (bfr*)(S + S_RWB);
  float* BON = (float*)(S + S_BON);
  bfr* GDQ = (bfr*)(S + S_GDQ);
  bfr* GDK = (bfr*)(S + S_GDK);
  bfr* GDV = (bfr*)(S + S_GDV);
  float* GDAB = (float*)(S + S_GDAB);
  const float* mu = p.rw_mu + (size_t)l * 896;
  const float* w0 = p.rw_w0 + (size_t)l * 512;
  const float* w_up = p.rw_w_up + (size_t)l * 2 * 32 * 256;
  const float* a0 = p.rw_a0 + (size_t)l * 512;
  const float* a_up = p.rw_a_up + (size_t)l * 2 * 32 * 256;
  const float* g_up = p.rw_g_up + (size_t)l * 64 * 256;
  const float* k_k = p.rw_k_k + (size_t)l * 256;
  const float* k_a = p.rw_k_a + (size_t)l * 256;
  const float* r_k = p.rw_r_k + (size_t)l * 256;
  const float* conv_w = p.gd_conv_w + (size_t)l * 5 * 768;
  const float* A_log = p.gd_A_log + (size_t)l * 8;
  const float* dt_bias = p.gd_dt_bias + (size_t)l * 8;
  const float* qg = p.na_q_gain + (size_t)l * 64;
  const float* kg = p.na_k_gain + (size_t)l * 64;

  bfr* wl = (bfr*)smem;
  float* lor = (float*)(smem + 192 * 256 * 2);
  __syncthreads();
  for (int i = tid; i < 192 * 256; i += NTHR) {
    const int row = i >> 8, c = i & 255;
    const float v = row < 64 ? g_up[row * 256 + c] : row < 128 ? w_up[(row - 64) * 256 + c] : a_up[(row - 128) * 256 + c];
    wl[i] = f2bf(v);
  }
  __syncthreads();

  for (int tile = bid; tile < NTOK / 16; tile += nb) {
    const int m0 = tile * 16;
    int seq_lo, seq_hi, bb, tau0;
    if (m0 < NLAT) { bb = m0 >> 14; seq_lo = bb << 14; seq_hi = seq_lo + SEQ; tau0 = m0 - seq_lo; }
    else { bb = (m0 - NLAT) >> 8; seq_lo = NLAT + (bb << 8); seq_hi = seq_lo + CTXL; tau0 = SEQ + (m0 - seq_lo); }
    const f32x4 z4 = {0.f, 0.f, 0.f, 0.f};
    int tid_t = tid; asm volatile("" : "+v"(tid_t));
    const int lane_t = tid_t & 63;
    const int cb = lane_t * 4, hh = lane_t >> 4;
    const int lg = tid_t & 31, lt = tid_t >> 5;
    const int sl = lane_t >> 4, sc4 = (lane_t & 15) * 4;
    asm volatile("" ::: "memory");
    const f32x4 mur = *(const f32x4*)(mu + cb), muk = *(const f32x4*)(mu + 256 + cb), muv = *(const f32x4*)(mu + 512 + cb);
    const f32x4 mul = *(const f32x4*)(mu + 768 + lg * 4);

    f32x4 pr[3][4], pl[3];
    {
      const int mt0 = m0 + 2 * wv;
#pragma unroll
      for (int j = 0; j < 3; ++j)
#pragma unroll
        for (int t = 0; t < 4; ++t) {
          const int m = mt0 - 1 + t;
          const int mc = min(max(m, seq_lo), seq_hi - 1);
          const f32x4 ld = ldbf4(P + (size_t)mc * PINP + A_END + j * 256 + cb);
          pr[j][t] = (m == mc) ? ld : z4;
        }
#pragma unroll
      for (int t = 0; t < 3; ++t) {
        const int m = m0 + lt - 1 + t;
        const int mc = min(max(m, seq_lo), seq_hi - 1);
        const f32x4 ld = ldbf4(P + (size_t)mc * PINP + A_END + 768 + lg * 4);
        pl[t] = (m == mc) ? ld : z4;
      }
    }
    {
      const f32x4 v = pl[1] + mul * (0.5f * (pl[0] + pl[2]) - pl[1]);
#pragma unroll
      for (int i = 0; i < 4; ++i) {
        const int ch = lg * 4 + i;
        lor[ch * 16 + lt] = ch < 32 ? tanhf(v[i]) : ch < 64 ? v[i] : sigmoidf_(v[i]);
      }
    }
    f32x4 rr[2], rk[2], rv[2];
#pragma unroll
    for (int t = 0; t < 2; ++t) {
      rr[t] = pr[0][t + 1] + mur * (0.5f * (pr[0][t] + pr[0][t + 2]) - pr[0][t + 1]);
      rk[t] = pr[1][t + 1] + muk * (0.5f * (pr[1][t] + pr[1][t + 2]) - pr[1][t + 1]);
      rv[t] = pr[2][t + 1] + muv * (0.5f * (pr[2][t] + pr[2][t + 2]) - pr[2][t + 1]);
    }
    LBAR();
    bf16x4 pgr[20], pvr[4];
    const bf16x4 zr = {0, 0, 0, 0};
    const bool is_gd = wv < 3, is_na = (wv >= 3 && wv < 7);
    const int sec = is_gd ? wv * 4 + sl : (wv - 3) * 4 + sl;
    if (is_gd) {
#pragma unroll
      for (int t = 0; t < 20; ++t) {
        const int m = m0 - 2 + t;
        const int mc = min(max(m, seq_lo), seq_hi - 1);
        pgr[t] = *(const bf16x4*)(P + (size_t)mc * PINP + B_END + sec * 64 + sc4);
      }
    } else if (is_na) {
#pragma unroll
      for (int t = 0; t < 16; ++t) pgr[t] = *(const bf16x4*)(P + (size_t)(m0 + t) * PINP + sec * 64 + sc4);
#pragma unroll
      for (int t = 16; t < 20; ++t) pgr[t] = zr;
    } else {
#pragma unroll
      for (int t = 0; t < 20; ++t) pgr[t] = zr;
    }
    {
      const int vc = (tid_t & 127) * 4, tq = (tid_t >> 7) * 4;
#pragma unroll
      for (int t = 0; t < 4; ++t) pvr[t] = *(const bf16x4*)(P + (size_t)(m0 + tq + t) * PINP + 1024 + vc);
    }
    asm volatile("" ::: "memory");
    {
      f32x4 gacc[2], wa0[2], wa1[2], aa0[2], aa1[2];
#pragma unroll
      for (int t = 0; t < 2; ++t) { gacc[t] = z4; wa0[t] = z4; wa1[t] = z4; aa0[t] = z4; aa1[t] = z4; }
#pragma unroll 4
      for (int j = 0; j < 64; ++j) {
        const bf16x4 wq = *(const bf16x4*)(wl + j * 256 + cb);
        const f32x4 wgt = {bf2f(wq[0]), bf2f(wq[1]), bf2f(wq[2]), bf2f(wq[3])};
        const float2 sv = *(const float2*)(lor + (64 + j) * 16 + 2 * wv);
        gacc[0] += wgt * sv.x; gacc[1] += wgt * sv.y;
      }
#pragma unroll 2
      for (int j = 0; j < 32; ++j) {
        const bf16x4 q0 = *(const bf16x4*)(wl + (64 + j) * 256 + cb), q1 = *(const bf16x4*)(wl + (96 + j) * 256 + cb);
        const bf16x4 q2 = *(const bf16x4*)(wl + (128 + j) * 256 + cb), q3 = *(const bf16x4*)(wl + (160 + j) * 256 + cb);
        const f32x4 ww0 = {bf2f(q0[0]), bf2f(q0[1]), bf2f(q0[2]), bf2f(q0[3])}, ww1 = {bf2f(q1[0]), bf2f(q1[1]), bf2f(q1[2]), bf2f(q1[3])};
        const f32x4 aw0 = {bf2f(q2[0]), bf2f(q2[1]), bf2f(q2[2]), bf2f(q2[3])}, aw1 = {bf2f(q3[0]), bf2f(q3[1]), bf2f(q3[2]), bf2f(q3[3])};
        const float2 tv = *(const float2*)(lor + j * 16 + 2 * wv);
        const float2 dv = *(const float2*)(lor + (32 + j) * 16 + 2 * wv);
        wa0[0] += ww0 * tv.x; wa0[1] += ww0 * tv.y; wa1[0] += ww1 * tv.x; wa1[1] += ww1 * tv.y;
        aa0[0] += aw0 * dv.x; aa0[1] += aw0 * dv.y; aa1[0] += aw1 * dv.x; aa1[1] += aw1 * dv.y;
      }
      asm volatile("" ::: "memory");
      const f32x4 kkc = *(const f32x4*)(k_k + cb), kac = *(const f32x4*)(k_a + cb), rkc = *(const f32x4*)(r_k + cb);
      const f32x4 w00 = *(const f32x4*)(w0 + cb), w01 = *(const f32x4*)(w0 + 256 + cb), a00 = *(const f32x4*)(a0 + cb), a01 = *(const f32x4*)(a0 + 256 + cb);
#pragma unroll
      for (int t = 0; t < 2; ++t) {
        const int m = m0 + 2 * wv + t;
        const f32x4 r = rr[t], k = rk[t], v = rv[t];
        const f32x4 kkraw = k * kkc;
        const float ssum = row16_sum((kkraw[0] * kkraw[0] + kkraw[1] * kkraw[1]) + (kkraw[2] * kkraw[2] + kkraw[3] * kkraw[3]));
        const f32x4 kk = kkraw * rsqrtf(ssum + 1e-6f);
        float bon = 0.f;
#pragma unroll
        for (int d = 0; d < 2; ++d) {
          const f32x4 wlin = d == 0 ? w00 + wa0[t] : w01 + wa1[t];
          const f32x4 alin = d == 0 ? a00 + aa0[t] : a01 + aa1[t];
          f32x4 lw, kd, bv;
#pragma unroll
          for (int i = 0; i < 4; ++i) {
            const float w_log = -softplusf_(-wlin[i]) - 0.5f;
            const float a = sigmoidf_(alin[i]);
            lw[i] = -__expf(w_log);
            kd[i] = k[i] * (1.f + (a - 1.f) * kac[i]);
            bv[i] = kk[i] * a;
            bon += r[i] * kd[i] * rkc[i];
          }
          const size_t o = ((size_t)d * NTOK + m) * 256 + cb;
          *(f32x4*)(RWW + o) = lw; *(bf16x4*)(RWKD + o) = pack4(kd[0], kd[1], kd[2], kd[3]); *(bf16x4*)(RWB + o) = pack4(bv[0], bv[1], bv[2], bv[3]);
        }
        bon = row16_sum(bon);
        const size_t o = (size_t)m * 256 + cb;
        *(bf16x4*)(RWR + o) = pack4(r[0], r[1], r[2], r[3]); *(bf16x4*)(RWKK + o) = pack4(kk[0], kk[1], kk[2], kk[3]);
        *(bf16x4*)(RWV + o) = pack4(v[0], v[1], v[2], v[3]); *(bf16x4*)(RWG + o) = pack4(gacc[t][0], gacc[t][1], gacc[t][2], gacc[t][3]);
        if ((lane_t & 15) == 0) BON[(size_t)m * 4 + hh] = bon;
      }
    }
    if (is_gd) {
      f32x4 cw[5];
#pragma unroll
      for (int j = 0; j < 5; ++j) cw[j] = *(const f32x4*)(conv_w + j * 768 + sec * 64 + sc4);
      f32x4 pg[20];
#pragma unroll
      for (int t = 0; t < 20; ++t) {
        const int m = m0 - 2 + t;
        const bool inr = (m >= seq_lo) && (m < seq_hi);
        const f32x4 cv = {bf2f(pgr[t][0]), bf2f(pgr[t][1]), bf2f(pgr[t][2]), bf2f(pgr[t][3])};
        pg[t] = inr ? cv : z4;
      }
#pragma unroll
      for (int t = 0; t < 16; ++t) {
        f32x4 acc = z4;
#pragma unroll
        for (int j = 0; j < 5; ++j) acc += cw[j] * pg[t + j];
        f32x4 val = {siluf_(acc[0]), siluf_(acc[1]), siluf_(acc[2]), siluf_(acc[3])};
        const int m = m0 + t;
        if (sec < 8) {
          const float ss = row16_sum((val[0] * val[0] + val[1] * val[1]) + (val[2] * val[2] + val[3] * val[3]));
          val = val * rsqrtf(ss + 1e-6f);
          if (sec < 4) { const f32x4 vq = val * 0.125f; *(bf16x4*)(GDQ + (size_t)m * 256 + sec * 64 + sc4) = pack4(vq[0], vq[1], vq[2], vq[3]); }
          else *(bf16x4*)(GDK + (size_t)m * 256 + (sec - 4) * 64 + sc4) = pack4(val[0], val[1], val[2], val[3]);
        } else *(bf16x4*)(GDV + (size_t)m * 256 + (sec - 8) * 64 + sc4) = pack4(val[0], val[1], val[2], val[3]);
      }
    } else if (is_na) {
      const f32x4 gq = *(const f32x4*)(qg + sc4) * (0.125f * 1.4426950408889634f), gk = *(const f32x4*)(kg + sc4);
#pragma unroll
      for (int t = 0; t < 16; ++t) {
        f32x4 val = {bf2f(pgr[t][0]), bf2f(pgr[t][1]), bf2f(pgr[t][2]), bf2f(pgr[t][3])};
        const float ss = row16_sum((val[0] * val[0] + val[1] * val[1]) + (val[2] * val[2] + val[3] * val[3]));
        val = val * rsqrtf(ss * (1.f / 64.f) + 1e-6f);
        const int m = m0 + t;
        if (sec < 8) { const f32x4 o = val * gq; *(bf16x4*)(QN + (size_t)m * 512 + sec * 64 + sc4) = pack4(o[0], o[1], o[2], o[3]); }
        else { const f32x4 o = val * gk; *(bf16x4*)(KN + (size_t)m * 512 + (sec - 8) * 64 + sc4) = pack4(o[0], o[1], o[2], o[3]); }
      }
    }
    if (tid_t < 256) {
      const int t = tid_t >> 4, j = tid_t & 15;
      const int m = m0 + t;
      const float pv = bf2f((short)P[(size_t)m * PINP + B_END + 1024 + j]);
      float o;
      if (j < 8) o = -__expf(A_log[j]) * softplusf_(pv + dt_bias[j]);
      else o = sigmoidf_(pv);
      GDAB[(size_t)m * 16 + j] = o;
    }
    {
      const int vc = (tid_t & 127) * 4, tq = (tid_t >> 7) * 4;
#pragma unroll
      for (int i = 0; i < 4; ++i) {
        const int hd = vc + i;
        bfr* dst = VT + ((size_t)(bb * 8 + (hd >> 6)) * (TTOK / 16) + (tau0 >> 4)) * 1024 + (hd & 63) * 16 + tq;
        const bf16x4 o = {pvr[0][i], pvr[1][i], pvr[2][i], pvr[3][i]};
        *(bf16x4*)dst = o;
      }
    }
    LBAR();
  }
  __syncthreads();
}

__device__ __forceinline__ int scan_tok(int b, int d, int s) {
  if (s < CTXL) { int t = d ? (CTXL - 1 - s) : s; return NLAT + b * CTXL + t; }
  int u = s - CTXL; int t = d ? (SEQ - 1 - u) : u; return b * SEQ + t;
}
#define CS 72
#define SLOT_BYTES (64 * CS * 2)
#define F0_STRIDE 68
#define X1_F0 (13 * SLOT_BYTES)
#define X1_ARR (X1_F0 + 64 * F0_STRIDE * 4)

#define MM_FRAGS(As, Bs, a0, a1, b00, b01, b10, b11)                                                     \
  const bf16x8 a0 = *(const bf16x8*)((As) + ((mt * 16 + fr) * CS + fq * 8) * 2);                         \
  const bf16x8 a1 = *(const bf16x8*)((As) + ((mt * 16 + fr) * CS + 32 + fq * 8) * 2);                    \
  const bf16x8 b00 = *(const bf16x8*)((Bs) + ((nt0 * 16 + fr) * CS + fq * 8) * 2);                       \
  const bf16x8 b01 = *(const bf16x8*)((Bs) + ((nt0 * 16 + fr) * CS + 32 + fq * 8) * 2);                  \
  const bf16x8 b10 = *(const bf16x8*)((Bs) + ((nt0 * 16 + 16 + fr) * CS + fq * 8) * 2);                  \
  const bf16x8 b11 = *(const bf16x8*)((Bs) + ((nt0 * 16 + 16 + fr) * CS + 32 + fq * 8) * 2);
#define MM_2TILES(acc0, acc1, a0, a1, b00, b01, b10, b11)                                                \
  acc0 = __builtin_amdgcn_mfma_f32_16x16x32_bf16(a0, b00, acc0, 0, 0, 0);                                \
  acc0 = __builtin_amdgcn_mfma_f32_16x16x32_bf16(a1, b01, acc0, 0, 0, 0);                                \
  acc1 = __builtin_amdgcn_mfma_f32_16x16x32_bf16(a0, b10, acc1, 0, 0, 0);                                \
  acc1 = __builtin_amdgcn_mfma_f32_16x16x32_bf16(a1, b11, acc1, 0, 0, 0);
__device__ __forceinline__ void wr_T(char* slot, int mt, int nt, int fr, int fq, f32x4 v) {
  *(bf16x4*)(slot + ((nt * 16 + fr) * CS + mt * 16 + 4 * fq) * 2) = pack4(v[0], v[1], v[2], v[3]);
}

struct ChunkIn { float lw[8], be[8]; unsigned f0[8], f1[8], f2[8], f3[8], xv[8]; };
template <bool GDN>
__device__ __forceinline__ void chunk_load(PP pp, int t, ChunkIn& ci) {
  const int tid = tid_opaque(), c = tid & 63, tg = wave_id(tid);
  const int chain = t / NCHUNK, n = t - chain * NCHUNK;
  const int d = chain & 1, h = (chain >> 1) & 3, b = (chain >> 3) & 1;
  const char* S = p.ws + OFF_S;
#pragma unroll
  for (int u = 0; u < 8; ++u) {
    const int m = scan_tok(b, d, n * 64 + tg * 8 + u);
    const size_t o = (size_t)m * 256 + h * 64 + c;
    if (!GDN) {
      ci.lw[u] = ((const float*)(S + S_RWW))[(size_t)d * NTOK * 256 + o];
      ci.f0[u] = ((const unsigned short*)(S + S_RWKK))[o];
      ci.f1[u] = ((const unsigned short*)(S + S_RWB))[(size_t)d * NTOK * 256 + o];
      ci.f2[u] = ((const unsigned short*)(S + S_RWKD))[(size_t)d * NTOK * 256 + o];
      ci.f3[u] = ((const unsigned short*)(S + S_RWR))[o];
      ci.xv[u] = ((const unsigned short*)(S + S_RWV))[o];
      ci.be[u] = 1.f;
    } else {
      ci.lw[u] = ((const float*)(S + S_GDAB))[(size_t)m * 16 + d * 4 + h];
      ci.be[u] = ((const float*)(S + S_GDAB))[(size_t)m * 16 + 8 + d * 4 + h];
      ci.f0[u] = ((const unsigned short*)(S + S_GDK))[o];
      ci.f3[u] = ((const unsigned short*)(S + S_GDQ))[o];
      ci.xv[u] = ((const unsigned short*)(S + S_GDV))[o];
      ci.f1[u] = 0u; ci.f2[u] = 0u;
    }
  }
}
template <bool GDN>
__device__ __forceinline__ void chunk_prep_task(PP pp, int t, int t_next, bool has_next, const ChunkIn& ci, ChunkIn& nx, char* smem) {
  const int chain = t / NCHUNK, n = t - chain * NCHUNK;
  const int d = chain & 1, h = (chain >> 1) & 3, b = (chain >> 3) & 1;
  (void)b; (void)d; (void)h;
  const int tid = tid_opaque(), lane = tid & 63, wv = wave_id(tid);
  const int fr = lane & 15, fq = lane >> 4, mt = wv >> 1, nt0 = (wv & 1) * 2;
  char* S = p.ws + OFF_S;
  char* CH = p.ws + OFF_CH;
  const size_t cc = (size_t)chain * NCHUNK + n;
  char* const p0 = smem;
  char* const p1 = smem + 1 * SLOT_BYTES;
  char* const p2 = smem + 2 * SLOT_BYTES;
  char* const p3 = smem + 3 * SLOT_BYTES;
  char* const p4 = smem + 4 * SLOT_BYTES;
  char* const p5 = smem + 5 * SLOT_BYTES;
  char* const p6 = smem + 6 * SLOT_BYTES;
  char* const p7 = smem + 7 * SLOT_BYTES;
  char* const p8 = smem + 8 * SLOT_BYTES;
  char* const p9 = smem + 9 * SLOT_BYTES;
  char* const p10 = smem + 10 * SLOT_BYTES;
  char* const p11 = smem + 11 * SLOT_BYTES;
  char* const p12 = smem + 12 * SLOT_BYTES;
  float* const F0 = (float*)(smem + X1_F0);
  float* const Lv = (float*)(smem + X1_ARR);
  float* const Lm1v = Lv + 64;
  float* const betav = Lv + 128;
  float* const eLv = Lv + 192;
  float* const gC = Lv + 256;
  float* const gsum = Lv + 320;
  char* const sKt = p0;
  char* const sBh = GDN ? p0 : p1;
  char* const sKh = GDN ? p0 : p2;

  {
    const int c = lane, tg = wv;
    const float* lw = ci.lw; const float* be = ci.be;
    float f0[8], f1[8], f2[8], f3[8], xv[8];
#pragma unroll
    for (int u = 0; u < 8; ++u) {
      f0[u] = __uint_as_float(ci.f0[u] << 16); f1[u] = __uint_as_float(ci.f1[u] << 16); f2[u] = __uint_as_float(ci.f2[u] << 16);
      f3[u] = __uint_as_float(ci.f3[u] << 16); xv[u] = __uint_as_float(ci.xv[u] << 16);
    }
    float cum[8];
    cum[0] = lw[0];
#pragma unroll
    for (int u = 1; u < 8; ++u) cum[u] = cum[u - 1] + lw[u];
    gsum[tg * 64 + c] = cum[7];
    LBAR();
    float off = 0.f, LC = 0.f;
#pragma unroll
    for (int g2 = 0; g2 < 8; ++g2) { const float gs = gsum[g2 * 64 + c]; LC += gs; off += (g2 < tg) ? gs : 0.f; }
    bf16x8 vKtT, vBbT, vKbT, vXT;
#pragma unroll
    for (int u = 0; u < 8; ++u) {
      const int t = tg * 8 + u;
      const float L = off + cum[u], Lm1 = L - lw[u];
      if (!GDN) {
        const float eLm1 = __expf(Lm1), enL = __expf(-L), eL = __expf(L), eCL = __expf(LC - L);
        const float kt = f0[u] * eLm1;
        *(bfr*)(p0 + (t * CS + c) * 2) = f2bf(kt);
        *(bfr*)(p1 + (t * CS + c) * 2) = f2bf(f1[u] * enL);
        *(bfr*)(p2 + (t * CS + c) * 2) = f2bf(f2[u] * enL);
        *(bfr*)(p3 + (t * CS + c) * 2) = f2bf(f3[u] * eL);
        vKtT[u] = (short)f2bf(kt);
        vBbT[u] = (short)f2bf(f1[u] * eCL);
        vKbT[u] = (short)f2bf(f2[u] * eCL);
        vXT[u] = (short)f2bf(xv[u]);
      } else {
        *(bfr*)(p0 + (t * CS + c) * 2) = f2bf(f0[u]);
        *(bfr*)(p3 + (t * CS + c) * 2) = f2bf(f3[u]);
        vKtT[u] = (short)f2bf(f0[u] * __expf(Lm1));
        vBbT[u] = (short)f2bf(be[u] * f0[u] * __expf(LC - Lm1));
        vKbT[u] = (short)f2bf(f0[u] * __expf(LC - L));
        vXT[u] = (short)f2bf(be[u] * xv[u]);
        if (c == 0) { Lv[t] = L; Lm1v[t] = Lm1; betav[t] = be[u]; eLv[t] = __expf(L); }
      }
    }
    *(bf16x8*)(p4 + (c * CS + tg * 8) * 2) = vKtT;
    *(bf16x8*)(p5 + (c * CS + tg * 8) * 2) = vBbT;
    *(bf16x8*)(p6 + (c * CS + tg * 8) * 2) = vKbT;
    *(bf16x8*)(p7 + (c * CS + tg * 8) * 2) = vXT;
    if (tg == 0) gC[c] = __expf(LC);
    if (!GDN && tid < 64) { Lv[tid] = 0.f; Lm1v[tid] = 0.f; betav[tid] = 1.f; eLv[tid] = 1.f; }
  }
  LBAR();
  if (has_next) chunk_load<GDN>(pp, t_next, nx);
  {
    {
      MM_FRAGS(sKt, sBh, a0, a1, b00, b01, b10, b11)
      f32x4 c0 = {0.f, 0.f, 0.f, 0.f}, c1 = c0;
      MM_2TILES(c0, c1, a0, a1, b00, b01, b10, b11)
#pragma unroll
      for (int q = 0; q < 2; ++q) {
        const int sI = (nt0 + q) * 16 + fr;
        const f32x4 cv = q ? c1 : c0;
        f32x4 o;
#pragma unroll
        for (int r = 0; r < 4; ++r) {
          const int tI = mt * 16 + 4 * fq + r;
          float v = cv[r];
          if (GDN) v *= betav[sI] * __expf(fminf(Lm1v[tI] - Lm1v[sI], 0.f));
          o[r] = (sI < tI) ? v : 0.f;
        }
        *(f32x4*)(F0 + sI * F0_STRIDE + mt * 16 + 4 * fq) = o;
        wr_T(p11, mt, nt0 + q, fr, fq, o);
      }
    }
    {
      MM_FRAGS(sKt, sKh, a0, a1, b00, b01, b10, b11)
      f32x4 c0 = {0.f, 0.f, 0.f, 0.f}, c1 = c0;
      MM_2TILES(c0, c1, a0, a1, b00, b01, b10, b11)
#pragma unroll
      for (int q = 0; q < 2; ++q) {
        const int sI = (nt0 + q) * 16 + fr;
        const f32x4 cv = q ? c1 : c0;
        f32x4 o;
#pragma unroll
        for (int r = 0; r < 4; ++r) {
          const int tI = mt * 16 + 4 * fq + r;
          float v = cv[r];
          if (GDN) v *= __expf(fminf(Lm1v[tI] - Lv[sI], 0.f));
          o[r] = (sI < tI) ? v : 0.f;
        }
        wr_T(p9, mt, nt0 + q, fr, fq, o);
      }
    }
    {
      MM_FRAGS(sBh, p3, a0, a1, b00, b01, b10, b11)
      f32x4 c0 = {0.f, 0.f, 0.f, 0.f}, c1 = c0;
      MM_2TILES(c0, c1, a0, a1, b00, b01, b10, b11)
#pragma unroll
      for (int q = 0; q < 2; ++q) {
        const int tI = (nt0 + q) * 16 + fr;
        const f32x4 cv = q ? c1 : c0;
        f32x4 o;
#pragma unroll
        for (int r = 0; r < 4; ++r) {
          const int sI = mt * 16 + 4 * fq + r;
          float v = cv[r];
          if (GDN) v *= betav[sI] * __expf(fminf(Lv[tI] - Lm1v[sI], 0.f));
          o[r] = (sI <= tI) ? v : 0.f;
        }
        wr_T(p10, mt, nt0 + q, fr, fq, o);
      }
    }
  }
  LBAR();
  if (wv < 2) {
    const int base = wv * 32, other = 32 - base, c = lane & 31;
    float tr[32];
#pragma unroll
    for (int j = 0; j < 32; ++j) tr[j] = 0.f;
#pragma unroll
    for (int ip = 15; ip >= 0; --ip) {
      const int i = 2 * ip + 1, i2 = 2 * ip;
      float a0 = (c == i) ? 1.f : 0.f, a1 = 0.f, b0 = (c == i2) ? 1.f : 0.f, b1 = 0.f;
      const float aii = F0[(base + i2) * F0_STRIDE + base + i];
#pragma unroll
      for (int jb = ((i + 1) & ~3); jb < 32; jb += 4) {
        const f32x4 a4 = *(const f32x4*)(F0 + (base + i) * F0_STRIDE + base + jb);
        const f32x4 b4 = *(const f32x4*)(F0 + (base + i2) * F0_STRIDE + base + jb);
        a0 -= a4[0] * tr[jb]; a1 -= a4[1] * tr[jb + 1]; a0 -= a4[2] * tr[jb + 2]; a1 -= a4[3] * tr[jb + 3];
        b0 -= b4[0] * tr[jb]; b1 -= b4[1] * tr[jb + 1]; b0 -= b4[2] * tr[jb + 2]; b1 -= b4[3] * tr[jb + 3];
      }
      const float ti = a0 + a1;
      const float ti2 = (b0 + b1) - aii * ti;
      tr[i] = ti; tr[i2] = ti2;
      if (lane < 32) {
        *(bfr*)(p8 + ((base + i) * CS + base + c) * 2) = f2bf(ti);
        *(bfr*)(p8 + ((base + i) * CS + other + c) * 2) = (bfr)0;
        *(bfr*)(p8 + ((base + i2) * CS + base + c) * 2) = f2bf(ti2);
        *(bfr*)(p8 + ((base + i2) * CS + other + c) * 2) = (bfr)0;
      }
    }
    if (lane < 32) {
#pragma unroll
      for (int q = 0; q < 4; ++q) {
        bf16x8 o, z;
#pragma unroll
        for (int j = 0; j < 8; ++j) { o[j] = (short)f2bf(tr[8 * q + j]); z[j] = 0; }
        *(bf16x8*)(p12 + ((base + c) * CS + base + 8 * q) * 2) = o;
        *(bf16x8*)(p12 + ((base + c) * CS + other + 8 * q) * 2) = z;
      }
    }
  }
  LBAR();
  {
    MM_FRAGS(p11, p12, a0, a1, b00, b01, b10, b11)
    f32x4 c0 = {0.f, 0.f, 0.f, 0.f}, c1 = c0;
    MM_2TILES(c0, c1, a0, a1, b00, b01, b10, b11)
    wr_T(p1, mt, nt0, fr, fq, c0);
    wr_T(p1, mt, nt0 + 1, fr, fq, c1);
  }
  LBAR();
  if (mt < 2 && nt0 == 2) {
    MM_FRAGS(p8, p1, a0, a1, b00, b01, b10, b11)
    f32x4 c0 = {0.f, 0.f, 0.f, 0.f}, c1 = c0;
    MM_2TILES(c0, c1, a0, a1, b00, b01, b10, b11)
#pragma unroll
    for (int r = 0; r < 4; ++r) {
      *(bfr*)(p8 + ((mt * 16 + 4 * fq + r) * CS + (nt0) * 16 + fr) * 2) = f2bf(-c0[r]);
      *(bfr*)(p8 + ((mt * 16 + 4 * fq + r) * CS + (nt0 + 1) * 16 + fr) * 2) = f2bf(-c1[r]);
    }
  }
  LBAR();
  {
    {
      MM_FRAGS(p8, p5, a0, a1, b00, b01, b10, b11)
      f32x4 c0 = {0.f, 0.f, 0.f, 0.f}, c1 = c0;
      MM_2TILES(c0, c1, a0, a1, b00, b01, b10, b11)
      wr_T(p11, mt, nt0, fr, fq, -c0);
      wr_T(p11, mt, nt0 + 1, fr, fq, -c1);
    }
    {
      MM_FRAGS(p8, p10, a0, a1, b00, b01, b10, b11)
      f32x4 c0 = {0.f, 0.f, 0.f, 0.f}, c1 = c0;
      MM_2TILES(c0, c1, a0, a1, b00, b01, b10, b11)
      wr_T(p12, mt, nt0, fr, fq, -c0);
      wr_T(p12, mt, nt0 + 1, fr, fq, -c1);
    }
  }
  LBAR();
  {
    {
      MM_FRAGS(p4, p11, a0, a1, b00, b01, b10, b11)
      f32x4 c0 = {0.f, 0.f, 0.f, 0.f}, c1 = c0;
      MM_2TILES(c0, c1, a0, a1, b00, b01, b10, b11)
#pragma unroll
      for (int q = 0; q < 2; ++q) {
        const int cp = (nt0 + q) * 16 + fr;
        f32x4 cv = q ? c1 : c0;
#pragma unroll
        for (int r = 0; r < 4; ++r) { const int cI = mt * 16 + 4 * fq + r; if (cI == cp) cv[r] += gC[cI]; }
        wr_T(p10, mt, nt0 + q, fr, fq, cv);
      }
    }
    {
      MM_FRAGS(p9, p11, a0, a1, b00, b01, b10, b11)
      f32x4 c0 = {0.f, 0.f, 0.f, 0.f}, c1 = c0;
      MM_2TILES(c0, c1, a0, a1, b00, b01, b10, b11)
#pragma unroll
      for (int q = 0; q < 2; ++q) {
        const int cp = (nt0 + q) * 16 + fr;
        f32x4 cv = q ? c1 : c0;
        const bf16x4 kb = *(const bf16x4*)(p6 + (cp * CS + mt * 16 + 4 * fq) * 2);
#pragma unroll
        for (int r = 0; r < 4; ++r) cv[r] += __uint_as_float(((unsigned)(unsigned short)kb[r]) << 16);
        wr_T(p8, mt, nt0 + q, fr, fq, cv);
      }
    }
    {
      MM_FRAGS(p4, p12, a0, a1, b00, b01, b10, b11)
      f32x4 c0 = {0.f, 0.f, 0.f, 0.f}, c1 = c0;
      MM_2TILES(c0, c1, a0, a1, b00, b01, b10, b11)
#pragma unroll
      for (int q = 0; q < 2; ++q) {
        const int tI = (nt0 + q) * 16 + fr;
        f32x4 cv = q ? c1 : c0;
        const bf16x4 rt = *(const bf16x4*)(p3 + (tI * CS + mt * 16 + 4 * fq) * 2);
        const float el = eLv[tI];
#pragma unroll
        for (int r = 0; r < 4; ++r) cv[r] += __uint_as_float(((unsigned)(unsigned short)rt[r]) << 16) * el;
        wr_T(p1, mt, nt0 + q, fr, fq, cv);
      }
    }
    {
      f32x4 c0 = {0.f, 0.f, 0.f, 0.f}, c1 = c0;
      {
        MM_FRAGS(sKh, p3, a0, a1, b00, b01, b10, b11)
        MM_2TILES(c0, c1, a0, a1, b00, b01, b10, b11)
      }
#pragma unroll
      for (int q = 0; q < 2; ++q) {
        const int tI = (nt0 + q) * 16 + fr;
#pragma unroll
        for (int r = 0; r < 4; ++r) {
          const int sI = mt * 16 + 4 * fq + r;
          float v = q ? c1[r] : c0[r];
          if (GDN) v *= __expf(fminf(Lv[tI] - Lv[sI], 0.f));
          v = (sI <= tI) ? v : 0.f;
          if (q) c1[r] = v; else c0[r] = v;
        }
      }
      {
        MM_FRAGS(p9, p12, a0, a1, b00, b01, b10, b11)
        MM_2TILES(c0, c1, a0, a1, b00, b01, b10, b11)
      }
      wr_T(p5, mt, nt0, fr, fq, c0);
      wr_T(p5, mt, nt0 + 1, fr, fq, c1);
    }
  }
  LBAR();
  {
    {
      MM_FRAGS(p8, p7, a0, a1, b00, b01, b10, b11)
      f32x4 c0 = {0.f, 0.f, 0.f, 0.f}, c1 = c0;
      MM_2TILES(c0, c1, a0, a1, b00, b01, b10, b11)
      bfr* QT = (bfr*)(CH + cc * CH_REC + CH_QT);
      *(bf16x4*)(QT + ((mt * 4 + nt0) * 64 + lane) * 4) = pack4(c0[0], c0[1], c0[2], c0[3]);
      *(bf16x4*)(QT + ((mt * 4 + nt0 + 1) * 64 + lane) * 4) = pack4(c1[0], c1[1], c1[2], c1[3]);
    }
    {
      MM_FRAGS(p7, p5, a0, a1, b00, b01, b10, b11)
      f32x4 c0 = {0.f, 0.f, 0.f, 0.f}, c1 = c0;
      MM_2TILES(c0, c1, a0, a1, b00, b01, b10, b11)
      bfr* YX = (bfr*)(CH + cc * CH_REC + CH_YX);
      *(bf16x4*)(YX + ((mt * 4 + nt0) * 64 + lane) * 4) = pack4(c0[0], c0[1], c0[2], c0[3]);
      *(bf16x4*)(YX + ((mt * 4 + nt0 + 1) * 64 + lane) * 4) = pack4(c1[0], c1[1], c1[2], c1[3]);
    }
    {
      const int fm = wv >> 1, fa = wv & 1;
      const int row = fm * 16 + fr;
      {
        const bf16x4 lo = *(const bf16x4*)(p10 + (row * CS + 32 * fa + 4 * fq) * 2);
        const bf16x4 hi = *(const bf16x4*)(p10 + (row * CS + 32 * fa + 16 + 4 * fq) * 2);
        bf16x8 f; f[0] = lo[0]; f[1] = lo[1]; f[2] = lo[2]; f[3] = lo[3]; f[4] = hi[0]; f[5] = hi[1]; f[6] = hi[2]; f[7] = hi[3];
        *(bf16x8*)(CH + cc * CH_REC + CH_PT + (size_t)((fm * 2 + fa) * 64 + lane) * 16) = f;
      }
      {
        const bf16x4 lo = *(const bf16x4*)(p1 + (row * CS + 32 * fa + 4 * fq) * 2);
        const bf16x4 hi = *(const bf16x4*)(p1 + (row * CS + 32 * fa + 16 + 4 * fq) * 2);
        bf16x8 f; f[0] = lo[0]; f[1] = lo[1]; f[2] = lo[2]; f[3] = lo[3]; f[4] = hi[0]; f[5] = hi[1]; f[6] = hi[2]; f[7] = hi[3];
        *(bf16x8*)(CH + cc * CH_REC + CH_RYT + (size_t)((fm * 2 + fa) * 64 + lane) * 16) = f;
      }
    }
  }
  LBAR();
}

template <bool GDN>
__device__ __forceinline__ void chunk_prep_loop(PP pp, int t0, int tend, int nb, char* smem) {
  ChunkIn cur, nxt;
  if (t0 < tend) chunk_load<GDN>(pp, t0, cur);
  for (int t = t0; t < tend; t += nb) {
    const bool has_next = (t + nb) < tend;
    chunk_prep_task<GDN>(pp, t, t + nb, has_next, cur, nxt, smem);
    cur = nxt;
  }
}
__device__ __forceinline__ void phase_chunk_prep(PP pp, int bid, int nb, char* smem) {
  __syncthreads();
  const int half = (NCHAIN / 2) * NCHUNK;
  chunk_prep_loop<false>(pp, bid, half, nb, smem);
  const int k0 = (half - bid + nb - 1) / nb;
  chunk_prep_loop<true>(pp, bid + k0 * nb, NCHAIN * NCHUNK, nb, smem);
  __syncthreads();
}

#define X2_BUF 32768
#define X2_BAR() do { asm volatile("s_waitcnt lgkmcnt(0)" ::: "memory"); __builtin_amdgcn_s_barrier(); asm volatile("" ::: "memory"); } while (0)
__device__ __forceinline__ void chunk_seq_chain(PP pp, int chain, char* smem) {
  __syncthreads();
  const int tid = tid_opaque(), lane = tid & 63, wv = wave_id(tid);
  const int d = chain & 1, h = (chain >> 1) & 3, b = (chain >> 3) & 1, ty = chain >> 4;
  const char* CH = p.ws + OFF_CH;
  bfr* Y = (bfr*)(p.ws + OFF_S + (ty ? S_YGD : S_YRW)) + (size_t)d * NTOK * 256;
  const size_t c0 = (size_t)chain * NCHUNK;
  if (wv >= 4) {
    const int lw = wv - 4;
    const char* src0 = CH + c0 * CH_REC + (size_t)lane * 16;
#define X2_DMA(n) { const char* s_ = src0 + (size_t)(n) * CH_REC; LAS unsigned char* d_ = (LAS unsigned char*)smem + ((n) & 3) * X2_BUF;       \
      _Pragma("unroll") for (int i = 0; i < 8; ++i) {                                                                                       \
        const int piece = i * 4 + lw;                                                                                                       \
        __builtin_amdgcn_global_load_lds((const unsigned*)(s_ + piece * 1024), (LAS unsigned*)(d_ + piece * 1024), 16, 0, 0); } }
    X2_DMA(0) X2_DMA(1) X2_DMA(2)
    asm volatile("s_waitcnt vmcnt(16)" ::: "memory");
    X2_BAR();
    for (int n = 0; n < NCHUNK; ++n) {
      if (n + 3 < NCHUNK) { X2_DMA(n + 3) asm volatile("s_waitcnt vmcnt(16)" ::: "memory"); }
      else if (n + 2 < NCHUNK) asm volatile("s_waitcnt vmcnt(8)" ::: "memory");
      else asm volatile("s_waitcnt vmcnt(0)" ::: "memory");
      X2_BAR();
    }
#undef X2_DMA
  } else {
    const int vt = wv, fr = lane & 15, fq = lane >> 4;
    f32x4 Sacc[4];
#pragma unroll
    for (int i = 0; i < 4; ++i) Sacc[i] = (f32x4){0.f, 0.f, 0.f, 0.f};
    X2_BAR();
    for (int n = 0; n < NCHUNK; ++n) {
      const char* buf = smem + (n & 3) * X2_BUF;
      bf16x8 sB0, sB1;
#pragma unroll
      for (int j = 0; j < 4; ++j) {
        sB0[j] = (short)f2bf(Sacc[0][j]); sB0[4 + j] = (short)f2bf(Sacc[1][j]);
        sB1[j] = (short)f2bf(Sacc[2][j]); sB1[4 + j] = (short)f2bf(Sacc[3][j]);
      }
#pragma unroll
      for (int m = 0; m < 4; ++m) {
        const bf16x8 pa0 = *(const bf16x8*)(buf + ((m * 2 + 0) * 64 + lane) * 16);
        const bf16x8 pa1 = *(const bf16x8*)(buf + ((m * 2 + 1) * 64 + lane) * 16);
        const bf16x8 ra0 = *(const bf16x8*)(buf + 8192 + ((m * 2 + 0) * 64 + lane) * 16);
        const bf16x8 ra1 = *(const bf16x8*)(buf + 8192 + ((m * 2 + 1) * 64 + lane) * 16);
        const bf16x4 qb = *(const bf16x4*)(buf + 16384 + ((m * 4 + vt) * 64 + lane) * 8);
        const bf16x4 yb = *(const bf16x4*)(buf + 24576 + ((vt * 4 + m) * 64 + lane) * 8);
        f32x4 y = {bf2f(yb[0]), bf2f(yb[1]), bf2f(yb[2]), bf2f(yb[3])};
        y = __builtin_amdgcn_mfma_f32_16x16x32_bf16(sB0, ra0, y, 0, 0, 0);
        y = __builtin_amdgcn_mfma_f32_16x16x32_bf16(sB1, ra1, y, 0, 0, 0);
        f32x4 sn = {bf2f(qb[0]), bf2f(qb[1]), bf2f(qb[2]), bf2f(qb[3])};
        sn = __builtin_amdgcn_mfma_f32_16x16x32_bf16(pa0, sB0, sn, 0, 0, 0);
        sn = __builtin_amdgcn_mfma_f32_16x16x32_bf16(pa1, sB1, sn, 0, 0, 0);
        Sacc[m] = sn;
        {
          const int mm = scan_tok(b, d, n * 64 + m * 16 + fr);
          *(bf16x4*)(Y + (size_t)mm * 256 + h * 64 + vt * 16 + 4 * fq) = pack4(y[0], y[1], y[2], y[3]);
        }
      }
      X2_BAR();
    }
  }
}

struct NaPair { int mk0, mk1, tau0, tau1, kr0, kr1, ct0, ct1; };
struct NaFrag { bf16x8 k00, k01, k10, k11; bf16x4 v0[4], v1[4]; };

__device__ __forceinline__ void na_load(NaFrag& f, const bfr* KN, const bfr* VT, size_t vt_base, int h, int fr, int fq, const NaPair& pr) {
  const bfr* k0 = KN + (size_t)(pr.mk0 + fr) * 512 + h * 64 + fq * 8;
  const bfr* k1 = KN + (size_t)(pr.mk1 + fr) * 512 + h * 64 + fq * 8;
  f.k00 = *(const bf16x8*)(k0); f.k01 = *(const bf16x8*)(k0 + 32);
  f.k10 = *(const bf16x8*)(k1); f.k11 = *(const bf16x8*)(k1 + 32);
#pragma unroll
  for (int dt = 0; dt < 4; ++dt) {
    const int vo = (dt * 16 + fr) * 16 + fq * 4;
    f.v0[dt] = *(const bf16x4*)(VT + vt_base + (size_t)(pr.tau0 >> 4) * 1024 + vo);
    f.v1[dt] = *(const bf16x4*)(VT + vt_base + (size_t)(pr.tau1 >> 4) * 1024 + vo);
  }
}

__device__ __forceinline__ void na_compute(const NaFrag& f, const bf16x8 qf0, const bf16x8 qf1, bool local, bool vr0, bool vr1,
                                           int dr0, int dr1, int ct0, int ct1, int qc, int fq, const float* bias_h, f32x4 (&O)[4], float& lsum) {
  f32x4 z = {0.f, 0.f, 0.f, 0.f};
  f32x4 st0 = __builtin_amdgcn_mfma_f32_16x16x32_bf16(f.k00, qf0, z, 0, 0, 0);
  st0 = __builtin_amdgcn_mfma_f32_16x16x32_bf16(f.k01, qf1, st0, 0, 0, 0);
  f32x4 st1 = __builtin_amdgcn_mfma_f32_16x16x32_bf16(f.k10, qf0, z, 0, 0, 0);
  st1 = __builtin_amdgcn_mfma_f32_16x16x32_bf16(f.k11, qf1, st1, 0, 0, 0);
  bf16x8 pf;
  if (local) {
    const int cs = min(max(qc - 8, 0), 48);
    const int kb0 = ct0 * 16 + fq * 4, kb1 = ct1 * 16 + fq * 4;
    const float* bp0 = bias_h + min(max(dr0 * 31 + kb0 - qc + 15, -32), 493);
    const float* bp1 = bias_h + min(max(dr1 * 31 + kb1 - qc + 15, -32), 493);
    const float b00 = bp0[0], b01 = bp0[1], b02 = bp0[2], b03 = bp0[3];
    const float b10 = bp1[0], b11 = bp1[1], b12 = bp1[2], b13 = bp1[3];
    const float bb0[4] = {b00, b01, b02, b03}, bb1[4] = {b10, b11, b12, b13};
#pragma unroll
    for (int r = 0; r < 4; ++r) {
      const bool ok0 = vr0 && (unsigned)(kb0 + r - cs) < 16u, ok1 = vr1 && (unsigned)(kb1 + r - cs) < 16u;
      const float e0 = __builtin_amdgcn_exp2f(st0[r] + bb0[r]), e1 = __builtin_amdgcn_exp2f(st1[r] + bb1[r]);
      const float p0 = ok0 ? e0 : 0.f, p1 = ok1 ? e1 : 0.f;
      lsum += p0 + p1;
      pf[r] = (short)f2bf(p0);
      pf[4 + r] = (short)f2bf(p1);
    }
  } else {
#pragma unroll
    for (int r = 0; r < 4; ++r) {
      const float p0 = __builtin_amdgcn_exp2f(st0[r]), p1 = __builtin_amdgcn_exp2f(st1[r]);
      lsum += p0 + p1;
      pf[r] = (short)f2bf(p0);
      pf[4 + r] = (short)f2bf(p1);
    }
  }
#pragma unroll
  for (int dt = 0; dt < 4; ++dt) {
    bf16x8 vf;
    vf[0] = f.v0[dt][0]; vf[1] = f.v0[dt][1]; vf[2] = f.v0[dt][2]; vf[3] = f.v0[dt][3];
    vf[4] = f.v1[dt][0]; vf[5] = f.v1[dt][1]; vf[6] = f.v1[dt][2]; vf[7] = f.v1[dt][3];
    O[dt] = __builtin_amdgcn_mfma_f32_16x16x32_bf16(vf, pf, O[dt], 0, 0, 0);
  }
}

__device__ __forceinline__ void na_block_task(PP pp, int task, const float* bias_lds) {
  const int tid = tid_opaque(), lane = tid & 63, wv = wave_id(tid);
  const int fr = lane & 15, fq = lane >> 4;
  char* S = p.ws + OFF_S;
  const bfr* QN = (const bfr*)(S + S_QN);
  const bfr* KN = (const bfr*)(S + S_KN);
  const bfr* VT = (const bfr*)(S + S_VT);
  bfr* CC = (bfr*)(p.ws + OFF_CC);
  const bool latent = task < 1024;
  int b, h, mqa, mqb, qra = 0, qrb = 0, cgp = 0;
  if (latent) {
    h = task & 7; const int quad = (task >> 3) & 63; b = task >> 9;
    qra = quad * 4 + (wv >> 2) * 2; qrb = qra + 1; cgp = wv & 3;
    mqa = b * SEQ + qra * 64 + cgp * 16; mqb = mqa + 64;
  } else {
    const int u = task - 1024;
    h = u & 7; b = u >> 3;
    mqa = NLAT + b * CTXL + (wv * 2) * 16; mqb = mqa + 16;
  }
  const bf16x8 qa0 = *(const bf16x8*)(QN + (size_t)(mqa + fr) * 512 + h * 64 + fq * 8);
  const bf16x8 qa1 = *(const bf16x8*)(QN + (size_t)(mqa + fr) * 512 + h * 64 + 32 + fq * 8);
  const bf16x8 qb0 = *(const bf16x8*)(QN + (size_t)(mqb + fr) * 512 + h * 64 + fq * 8);
  const bf16x8 qb1 = *(const bf16x8*)(QN + (size_t)(mqb + fr) * 512 + h * 64 + 32 + fq * 8);
  f32x4 Oa[4], Ob[4];
#pragma unroll
  for (int dt = 0; dt < 4; ++dt) { Oa[dt] = (f32x4){0.f, 0.f, 0.f, 0.f}; Ob[dt] = Oa[dt]; }
  float lsa = 0.f, lsb = 0.f;
  const size_t vt_base = (size_t)(b * 8 + h) * 64 * TTOK;
  const int rsa = min(max(qra - 4, 0), SEQ / 64 - 8), rsb = min(max(qrb - 4, 0), SEQ / 64 - 8);
  const int nrows = latent ? (rsb - rsa + 8) : 0;
  const int ct_first = (cgp <= 1) ? 0 : cgp - 1;
  const int nct = (cgp == 0 || cgp == 3) ? 2 : 3;
  const int ntile = nrows * nct;
  const int nlp = (ntile + 1) >> 1;
  const int npair = nlp + 8;
  const int qc = cgp * 16 + fr;
  auto mkpair = [&](int pi) {
    NaPair pr;
    if (pi < nlp) {
      const int i0 = 2 * pi, i1 = min(2 * pi + 1, ntile - 1);
      const int q0 = (nct == 2) ? (i0 >> 1) : ((i0 * 21846) >> 16), q1 = (nct == 2) ? (i1 >> 1) : ((i1 * 21846) >> 16);
      pr.kr0 = rsa + q0; pr.ct0 = ct_first + i0 - q0 * nct;
      pr.kr1 = rsa + q1; pr.ct1 = ct_first + i1 - q1 * nct;
      if (2 * pi + 1 >= ntile) pr.kr1 = -100;
      const int r1 = rsa + q1;
      pr.tau0 = pr.kr0 * 64 + pr.ct0 * 16; pr.tau1 = r1 * 64 + pr.ct1 * 16;
      pr.mk0 = b * SEQ + pr.tau0; pr.mk1 = b * SEQ + pr.tau1;
    } else {
      const int c = pi - nlp;
      pr.kr0 = pr.kr1 = pr.ct0 = pr.ct1 = 0;
      pr.tau0 = SEQ + c * 32; pr.tau1 = SEQ + c * 32 + 16;
      pr.mk0 = NLAT + b * CTXL + c * 32; pr.mk1 = pr.mk0 + 16;
    }
    return pr;
  };
  NaFrag fa, fb;
  NaPair pa = mkpair(0), pb;
  na_load(fa, KN, VT, vt_base, h, fr, fq, pa);
  const float* bias_h = bias_lds + h * 465;
#define NA_DO(F, PR, PI)                                                                                          \
  {                                                                                                               \
    const bool loc_ = (PI) < nlp;                                                                                 \
    na_compute(F, qa0, qa1, loc_, (unsigned)(PR.kr0 - rsa) < 8u, (unsigned)(PR.kr1 - rsa) < 8u,                   \
               PR.kr0 - qra + 7, PR.kr1 - qra + 7, PR.ct0, PR.ct1, qc, fq, bias_h, Oa, lsa);                      \
    na_compute(F, qb0, qb1, loc_, (unsigned)(PR.kr0 - rsb) < 8u, (unsigned)(PR.kr1 - rsb) < 8u,                   \
               PR.kr0 - qrb + 7, PR.kr1 - qrb + 7, PR.ct0, PR.ct1, qc, fq, bias_h, Ob, lsb);                      \
  }
  for (int pi = 0; pi < npair; pi += 2) {
    pb = mkpair(min(pi + 1, npair - 1)); na_load(fb, KN, VT, vt_base, h, fr, fq, pb);
    NA_DO(fa, pa, pi)
    pa = mkpair(min(pi + 2, npair - 1)); na_load(fa, KN, VT, vt_base, h, fr, fq, pa);
    if (pi + 1 < npair) NA_DO(fb, pb, pi + 1)
  }
#undef NA_DO
  lsa += shfl_xor_l(lsa, 16, lane); lsa += shfl_xor_l(lsa, 32, lane);
  lsb += shfl_xor_l(lsb, 16, lane); lsb += shfl_xor_l(lsb, 32, lane);
  const float ia = 1.f / lsa, ib = 1.f / lsb;
#pragma unroll
  for (int dt = 0; dt < 4; ++dt) {
    *(bf16x4*)(CC + (size_t)(mqa + fr) * 1024 + h * 64 + dt * 16 + fq * 4) = pack4(Oa[dt][0] * ia, Oa[dt][1] * ia, Oa[dt][2] * ia, Oa[dt][3] * ia);
    *(bf16x4*)(CC + (size_t)(mqb + fr) * 1024 + h * 64 + dt * 16 + fq * 4) = pack4(Ob[dt][0] * ib, Ob[dt][1] * ib, Ob[dt][2] * ib, Ob[dt][3] * ib);
  }
}

__device__ __forceinline__ void phase_mix(PP pp, int l, int bid, int nb, char* smem) {
  const int tid = tid_opaque();
  const int nscan_blocks = (nb > 32) ? 32 : nb;
  const int first_attn_block = (nb > 32) ? 32 : 0;
  if (bid < nscan_blocks) {
    for (int c = bid; c < NCHAIN; c += nscan_blocks) chunk_seq_chain(pp, c, smem);
  }
  if (bid >= first_attn_block) {
    float* bias = (float*)smem + 64;
    __syncthreads();
    for (int i = tid; i < 8 * 465 + 128; i += NTHR) { const int j = i - 64; bias[j] = ((unsigned)j < 8u * 465u) ? p.na_rpb[(size_t)l * 8 * 465 + j] * 1.4426950408889634f : 0.f; }
    __syncthreads();
    const int ntask = (l == 0) ? 1024 + 16 : 1024;
    const int nab = nb - first_attn_block;
    for (int t = bid - first_attn_block; t < ntask; t += nab) na_block_task(pp, t, bias);
    __syncthreads();
    phase_convert(pp, l, 1, bid - first_attn_block, nab, smem);
    if (l == 0) phase_convert(pp, 1, 0, bid - first_attn_block, nab, smem);
  }
}

__device__ __forceinline__ void phase_post(PP pp, int l, int bid, int nb) {
  const int tid = tid_opaque(), lane = tid & 63, wv = wave_id(tid);
  char* S = p.ws + OFF_S;
  const bfr* YRW = (const bfr*)(S + S_YRW);
  const bfr* YGD = (const bfr*)(S + S_YGD);
  const bfr* RWV = (const bfr*)(S + S_RWV);
  const bfr* RWG = (const bfr*)(S + S_RWG);
  const float* BON = (const float*)(S + S_BON);
  const bfr* P = (const bfr*)(p.ws + OFF_P);
  bfr* CC = (bfr*)(p.ws + OFF_CC);
  const float* ln_w = p.rw_ln_w + (size_t)l * 256;
  const float* ln_b = p.rw_ln_b + (size_t)l * 256;
  const float* ng = p.gd_norm_g + (size_t)l * 64;
  const int ntok = (l == 0) ? NTOK : NLAT;
  const int cb = lane * 4, hh = lane >> 4;
  const f32x4 lw4 = *(const f32x4*)(ln_w + cb), lb4 = *(const f32x4*)(ln_b + cb), ng4 = *(const f32x4*)(ng + (cb & 63));
  for (int m = bid * 8 + wv; m < ntok; m += nb * 8) {
    const size_t o = (size_t)m * 256 + cb;
    const f32x4 y0 = ldbf4(YRW + o), y1 = ldbf4(YRW + (size_t)NTOK * 256 + o);
    const f32x4 rv = ldbf4(RWV + o), rg = ldbf4(RWG + o);
    const f32x4 g0 = ldbf4(YGD + o), g1 = ldbf4(YGD + (size_t)NTOK * 256 + o);
    const f32x4 z = ldbf4(P + (size_t)m * PINP + B_END + 768 + cb);
    const float bon = BON[(size_t)m * 4 + hh];
    {
      const f32x4 y = y0 + y1;
      const float mean = row16_sum((y[0] + y[1]) + (y[2] + y[3])) * (1.f / 64.f);
      const f32x4 dv = y - mean;
      const float var = row16_sum((dv[0] * dv[0] + dv[1] * dv[1]) + (dv[2] * dv[2] + dv[3] * dv[3])) * (1.f / 64.f);
      const f32x4 out = ((dv * rsqrtf(var + 64e-5f)) * lw4 + lb4 + rv * bon) * rg;
      *(bf16x4*)(CC + (size_t)m * 1024 + 512 + cb) = pack4(out[0], out[1], out[2], out[3]);
    }
    {
      const f32x4 y = g0 + g1;
      const float ms = row16_sum((y[0] * y[0] + y[1] * y[1]) + (y[2] * y[2] + y[3] * y[3])) * (1.f / 64.f);
      const f32x4 sz = {siluf_(z[0]), siluf_(z[1]), siluf_(z[2]), siluf_(z[3])};
      const f32x4 out = (y * rsqrtf(ms + 1e-6f)) * ng4 * sz;
      *(bf16x4*)(CC + (size_t)m * 1024 + 768 + cb) = pack4(out[0], out[1], out[2], out[3]);
    }
  }
}

#define RW_LDS_ROW 36
__device__ __forceinline__ void phase_router(PP pp, int l, int bid, int nb, char* smem) {
  const int tid = tid_opaque(), lane = tid & 63, wv = wave_id(tid);
  const float* xl = p.out;
  const float* xc = (const float*)(p.ws + OFF_CTX);
  const float* mods = (const float*)(p.ws + OFF_MODS) + (size_t)l * 3 * 6144;
  const float* g = p.norm_ffn_g + (size_t)l * 1024;
  const float* rw = p.moe_router_w + (size_t)l * 1024 * 32;
  const float* rb = p.moe_router_b + (size_t)l * 32;
  bfr* H = (bfr*)(p.ws + OFF_H);
  int* cnt = (int*)(p.ws + OFF_CNT);
  int* TOKE = (int*)(p.ws + OFF_TOKE);
  int* TOKP = (int*)(p.ws + OFF_TOKP);
  float* TOKG = (float*)(p.ws + OFF_TOKG);
  float* wl = (float*)smem;
  for (int i = tid; i < 1024 * 8; i += NTHR) {
    int d = i >> 3, q = i & 7;
    *(float4*)(wl + d * RW_LDS_ROW + q * 4) = *(const float4*)(rw + (size_t)d * 32 + q * 4);
  }
  __syncthreads();
  const int ntok = (l == 0) ? NTOK : NLAT;
  const float rbl = rb[lane & 31];
  for (int m0 = (bid * 8 + wv) * 2; m0 < ntok; m0 += nb * 16) {
    float acc0[32], acc1[32];
#pragma unroll
    for (int e = 0; e < 32; ++e) { acc0[e] = 0.f; acc1[e] = 0.f; }
    float hv0[16], hv1[16];
    {
      const int ma = m0, mb = m0 + 1;
      const float* xa = (ma < NLAT) ? xl + (size_t)ma * 1024 : xc + (size_t)(ma - NLAT) * 1024;
      const float* xb = (mb < NLAT) ? xl + (size_t)mb * 1024 : xc + (size_t)(mb - NLAT) * 1024;
      const float* mda = mods + (size_t)mod_row(ma) * 6144 + 3072;
      const float* mdb = mods + (size_t)mod_row(mb) * 6144 + 3072;
      float ssa = 0.f, ssb = 0.f;
#pragma unroll
      for (int i = 0; i < 16; ++i) { hv0[i] = xa[lane + 64 * i]; hv1[i] = xb[lane + 64 * i]; }
#pragma unroll
      for (int i = 0; i < 16; ++i) { ssa += hv0[i] * hv0[i]; ssb += hv1[i] * hv1[i]; }
      ssa = wave_sum(ssa); ssb = wave_sum(ssb);
      const float rsa = rsqrtf(ssa * (1.f / 1024.f) + 1e-6f), rsb = rsqrtf(ssb * (1.f / 1024.f) + 1e-6f);
#pragma unroll
      for (int i = 0; i < 16; ++i) {
        const int d = lane + 64 * i;
        const float gg = g[d];
        hv0[i] = hv0[i] * rsa * gg * (1.f + mda[1024 + d]) + mda[d];
        hv1[i] = hv1[i] * rsb * gg * (1.f + mdb[1024 + d]) + mdb[d];
      }
      float am0 = 0.f, am1 = 0.f;
#pragma unroll
      for (int i = 0; i < 16; ++i) { am0 = fmaxf(am0, fabsf(hv0[i])); am1 = fmaxf(am1, fabsf(hv1[i])); }
      am0 = wave_max(am0); am1 = wave_max(am1);
      const float sc0 = am0 > 0.f ? am0 * (1.f / 127.f) : 1.f, sc1 = am1 > 0.f ? am1 * (1.f / 127.f) : 1.f;
      const float iv0 = 1.f / sc0, iv1 = 1.f / sc1;
      signed char* H8 = (signed char*)(p.ws + OFF_H);
#pragma unroll
      for (int i = 0; i < 16; ++i) {
        const int d = lane + 64 * i;
        H8[(size_t)ma * 1024 + d] = (signed char)(int)fminf(fmaxf(rintf(hv0[i] * iv0), -127.f), 127.f);
        H8[(size_t)mb * 1024 + d] = (signed char)(int)fminf(fmaxf(rintf(hv1[i] * iv1), -127.f), 127.f);
      }
      if (lane == 0) { float* SCL = (float*)(p.ws + OFF_SCL); SCL[ma] = sc0; SCL[mb] = sc1; }
      asm volatile("" ::: "memory");
    }
#pragma unroll
    for (int i = 0; i < 16; ++i) {
      if ((i & 3) == 0) asm volatile("" ::: "memory");
      const float* wr = wl + (lane + 64 * i) * RW_LDS_ROW;
#pragma unroll
      for (int q = 0; q < 8; ++q) {
        const float4 w = *(const float4*)(wr + q * 4);
        acc0[q * 4 + 0] += hv0[i] * w.x; acc0[q * 4 + 1] += hv0[i] * w.y; acc0[q * 4 + 2] += hv0[i] * w.z; acc0[q * 4 + 3] += hv0[i] * w.w;
        acc1[q * 4 + 0] += hv1[i] * w.x; acc1[q * 4 + 1] += hv1[i] * w.y; acc1[q * 4 + 2] += hv1[i] * w.z; acc1[q * 4 + 3] += hv1[i] * w.w;
      }
    }
#define BFLY(A, N, D)                                                                           \
    _Pragma("unroll") for (int i = 0; i < (N); ++i) {                                            \
      const bool up = (lane & (D)) != 0;                                                         \
      const float keep = up ? A[i + (N)] : A[i];                                                 \
      const float send = up ? A[i] : A[i + (N)];                                                 \
      A[i] = keep + shfl_xor_l(send, (D), lane);                                                   \
    }
    BFLY(acc0, 16, 16) BFLY(acc1, 16, 16)
    BFLY(acc0, 8, 8) BFLY(acc1, 8, 8)
    BFLY(acc0, 4, 4) BFLY(acc1, 4, 4)
    BFLY(acc0, 2, 2) BFLY(acc1, 2, 2)
    BFLY(acc0, 1, 1) BFLY(acc1, 1, 1)
#undef BFLY
    float la = acc0[0] + shfl_xor_l(acc0[0], 32, lane);
    float lb = acc1[0] + shfl_xor_l(acc1[0], 32, lane);
    const int my_e = lane & 31;
    la += rbl; lb += rbl;
    (void)my_e;
#pragma unroll
    for (int tkn = 0; tkn < 2; ++tkn) {
      float v = tkn == 0 ? la : lb;
      float tv[4]; int ti[4];
#pragma unroll
      for (int k = 0; k < 4; ++k) {
        float bv = v; int bi = lane & 31;
#pragma unroll
        for (int o = 16; o >= 1; o >>= 1) {
          float ov = shfl_xor_l(bv, o, lane); int oi = shfl_xor_li(bi, o, lane);
          bool take = (ov > bv) || (ov == bv && oi < bi);
          bv = take ? ov : bv; bi = take ? oi : bi;
        }
        tv[k] = bv; ti[k] = bi;
        if ((lane & 31) == bi) v = -3.0e38f;
      }
      float e1 = __expf(tv[1] - tv[0]), e2 = __expf(tv[2] - tv[0]), e3 = __expf(tv[3] - tv[0]);
      float inv = 1.f / (1.f + e1 + e2 + e3);
      const int m = m0 + tkn;
      if (lane < 4) {
        int e = lane == 0 ? ti[0] : lane == 1 ? ti[1] : lane == 2 ? ti[2] : ti[3];
        float gt = (lane == 0 ? 1.f : lane == 1 ? e1 : lane == 2 ? e2 : e3) * inv;
        int pos = atomicAdd(&cnt[e], 1);
        TOKE[(size_t)m * 4 + lane] = e; TOKP[(size_t)m * 4 + lane] = pos; TOKG[(size_t)m * 4 + lane] = gt;
      }
    }
  }
  __syncthreads();
}

__device__ __forceinline__ void moe_offsets(PP pp, int* toff) {
  const int* cnt = (const int*)(p.ws + OFF_CNT);
  if (tid_opaque() == 0) {
    int a = 0;
    for (int e = 0; e < 32; ++e) { const int c = cnt[e]; toff[e] = a; toff[96 + e] = c; a += (c + 255) >> 8; }
    toff[32] = a;
  }
  __syncthreads();
}
__device__ __forceinline__ void moe_tile_experts(int* toff) {
  int* texp = toff + 128;
  const int ntile = toff[32];
  for (int mt = tid_opaque(); mt < ntile; mt += NTHR) {
    int e = 0;
#pragma unroll 1
    for (int k = 1; k < 32; ++k) e = (mt >= toff[k]) ? k : e;
    texp[mt] = e;
  }
  __syncthreads();
}

__device__ __forceinline__ void phase_slotfill(PP pp, int l, int bid, int nb, char* smem) {
  int* toff = (int*)smem;
  moe_offsets(pp, toff);
  const int tid = tid_opaque(), lane = tid & 63, wv = wave_id(tid);
  const int* TOKE = (const int*)(p.ws + OFF_TOKE);
  const int* TOKP = (const int*)(p.ws + OFF_TOKP);
  const float* TOKG = (const float*)(p.ws + OFF_TOKG);
  const int* cnt = (const int*)(p.ws + OFF_CNT);
  int* TOKS = (int*)(p.ws + OFF_TOKS);
  float* SLG = (float*)(p.ws + OFF_SLG);
  float* SLS = (float*)(p.ws + OFF_SLS);
  const float* SCL = (const float*)(p.ws + OFF_SCL);
  const signed char* H8 = (const signed char*)(p.ws + OFF_H);
  signed char* XG = (signed char*)(p.ws + OFF_S);
  const int n = ((l == 0) ? NTOK : NLAT) * 4;
  int* SLT = (int*)(p.ws + OFF_SLT);
  for (int i = bid * NTHR + tid; i < n; i += nb * NTHR) {
    const int slot = toff[TOKE[i]] * 256 + TOKP[i];
    TOKS[i] = slot; SLT[slot] = i >> 2; SLG[slot] = TOKG[i]; SLS[slot] = SCL[i >> 2];
  }
  for (int gi = bid * NTHR + tid; gi < 32 * 256; gi += nb * NTHR) {
    const int e = gi >> 8, r = gi & 255;
    const int c = toff[96 + e];
    const int npad = ((c + 255) & ~255) - c;
    if (r < npad) { const int base = toff[e] * 256 + c; SLT[base + r] = 0; SLS[base + r] = 0.f; }
  }
  __syncthreads();
}

struct EpiMoe1 {
  const float* bgu; const float* sw; const float* SLS; bfr* ACT;
  __device__ __forceinline__ void operator()(const i32x4 (&acc)[2][2][4][2], const g8::GUnit& u, int wr, int wc, int fr, int fq) const {
    const float* be = bgu + (size_t)u.e * 2048;
    const float* se = sw + (size_t)u.e * 2048;
    const int slot0 = u.pm * 256 + wr * 64 + fr;
    float sav[2][4];
#pragma unroll
    for (int ai = 0; ai < 2; ++ai)
#pragma unroll
      for (int m = 0; m < 4; ++m) sav[ai][m] = SLS[slot0 + ai * 128 + m * 16];
    const int j0 = u.pn * 128 + wc * 32 + fq * 8;
    f32x4 bgv[2], blv[2], sgv[2], slv[2];
#pragma unroll
    for (int bj = 0; bj < 2; ++bj) {
      bgv[bj] = *(const f32x4*)(be + j0 + bj * 4); blv[bj] = *(const f32x4*)(be + 1024 + j0 + bj * 4);
      sgv[bj] = *(const f32x4*)(se + j0 + bj * 4); slv[bj] = *(const f32x4*)(se + 1024 + j0 + bj * 4);
    }
#pragma unroll
    for (int ai = 0; ai < 2; ++ai)
#pragma unroll
      for (int m = 0; m < 4; ++m) {
        const int slot = slot0 + ai * 128 + m * 16;
        const float sa = sav[ai][m];
        f32x4 ov[2];
#pragma unroll
        for (int bj = 0; bj < 2; ++bj) {
          const f32x4 bg = bgv[bj], bl = blv[bj];
          const f32x4 sg = sgv[bj], sl = slv[bj];
#pragma unroll
          for (int q = 0; q < 4; ++q) {
            const float g = (float)acc[ai][bj][m][0][q] * (sa * sg[q]) + bg[q];
            const float li = (float)acc[ai][bj][m][1][q] * (sa * sl[q]) + bl[q];
            const float gv = fminf(g, 7.f);
            const float lv = fminf(fmaxf(li, -7.f), 7.f);
            ov[bj][q] = gv * sigmoidf_(1.702f * gv) * (lv + 1.f);
          }
        }
        *(bf16x8*)(ACT + (size_t)slot * 1024 + j0) = pack8(ov[0], ov[1]);
      }
  }
};
__device__ __forceinline__ void phase_moe1_impl(PP pp, int l, int bid, int nb, char* smem, int* toff) {
  moe_offsets(pp, toff);
  moe_tile_experts(toff);
  g8::MoeSched S{toff, 8, 2048, nb, bid};
  EpiMoe1 E{p.moe_b_gu + (size_t)l * 32 * 2048, (const float*)(p.ws + OFF_SW) + (size_t)l * 32 * 2048, (const float*)(p.ws + OFF_SLS), (bfr*)(p.ws + OFF_P)};
  g8::gemm_stream<true, true>((LAS unsigned char*)smem, p.ws + OFF_H, p.ws + OFF_W + (size_t)l * WL_SIZE + WL_GU, S, E, (const int*)(p.ws + OFF_SLT));
}

struct EpiMoe2 {
  const float* bdn; const float* SLG; bfr* YS;
  __device__ __forceinline__ void operator()(const f32x4 (&acc)[2][2][4][2], const g8::GUnit& u, int wr, int wc, int fr, int fq) const {
    const float* be = bdn + (size_t)u.e * 1024;
    const int slot0 = u.pm * 256 + wr * 64 + fr, col0 = u.pn * 256 + wc * 32 + 8 * fq;
    float gtv[2][4];
#pragma unroll
    for (int ai = 0; ai < 2; ++ai)
#pragma unroll
      for (int m = 0; m < 4; ++m) gtv[ai][m] = SLG[slot0 + ai * 128 + m * 16];
    f32x4 bvv[2][2];
#pragma unroll
    for (int bj = 0; bj < 2; ++bj)
#pragma unroll
      for (int n = 0; n < 2; ++n) bvv[bj][n] = *(const f32x4*)(be + col0 + bj * 128 + n * 4);
#pragma unroll
    for (int ai = 0; ai < 2; ++ai)
#pragma unroll
      for (int m = 0; m < 4; ++m) {
        const int slot = slot0 + ai * 128 + m * 16;
        const float gt = gtv[ai][m];
#pragma unroll
        for (int bj = 0; bj < 2; ++bj) {
          const f32x4 y0 = (acc[ai][bj][m][0] + bvv[bj][0]) * gt;
          const f32x4 y1 = (acc[ai][bj][m][1] + bvv[bj][1]) * gt;
          *(bf16x8*)(YS + (size_t)slot * 1024 + col0 + bj * 128) = pack8(y0, y1);
        }
      }
  }
};
__device__ __forceinline__ void phase_moe2_impl(PP pp, int l, int bid, int nb, char* smem, int* toff) {
  moe_offsets(pp, toff);
  moe_tile_experts(toff);
  g8::MoeSched S{toff, 4, 1024, nb, bid};
  EpiMoe2 E{p.moe_b_down + (size_t)l * 32 * 1024, (const float*)(p.ws + OFF_SLG), (bfr*)(p.ws + OFF_S)};
  g8::gemm_stream<false, false>((LAS unsigned char*)smem, p.ws + OFF_P, p.ws + OFF_W + (size_t)l * WL_SIZE + WL_DN, S, E);
}

__device__ __forceinline__ void phase_combine(PP pp, int l, int bid, int nb) {
  const int tid = tid_opaque(), lane = tid & 63, wv = wave_id(tid);
  const bfr* YS = (const bfr*)(p.ws + OFF_S);
  const int* TOKS = (const int*)(p.ws + OFF_TOKS);
  const float* mods = (const float*)(p.ws + OFF_MODS) + (size_t)l * 3 * 6144;
  const float* mods1 = (const float*)(p.ws + OFF_MODS) + (size_t)3 * 6144;
  const float* g1n = p.norm_mix_g + 1024;
  bfr* H = (bfr*)(p.ws + OFF_H);
  float* xl = p.out;
  float* xc = (float*)(p.ws + OFF_CTX);
  const int ntok = (l == 0) ? NTOK : NLAT;
  if (l == 0) {
    int* cnt = (int*)(p.ws + OFF_CNT);
    const int gt = bid * NTHR + tid;
    if (gt < 32) cnt[gt] = 0;
  }
  for (int m = bid * 8 + wv; m < ntok; m += nb * 8) {
    float* xr = (m < NLAT) ? xl + (size_t)m * 1024 : xc + (size_t)(m - NLAT) * 1024;
    const float* g2 = mods + (size_t)mod_row(m) * 6144 + 5120;
    const int s0 = TOKS[(size_t)m * 4], s1 = TOKS[(size_t)m * 4 + 1], s2 = TOKS[(size_t)m * 4 + 2], s3 = TOKS[(size_t)m * 4 + 3];
    float4 xn[4];
    float ss = 0.f;
#pragma unroll
    for (int i = 0; i < 4; ++i) {
      const int d = (lane + 64 * i) * 4;
      const bf16x4 a = *(const bf16x4*)(YS + (size_t)s0 * 1024 + d);
      const bf16x4 b = *(const bf16x4*)(YS + (size_t)s1 * 1024 + d);
      const bf16x4 c = *(const bf16x4*)(YS + (size_t)s2 * 1024 + d);
      const bf16x4 e = *(const bf16x4*)(YS + (size_t)s3 * 1024 + d);
      const float4 gg = *(const float4*)(g2 + d);
      float4 xv = *(const float4*)(xr + d);
      xv.x += gg.x * ((bf2f(a[0]) + bf2f(b[0])) + (bf2f(c[0]) + bf2f(e[0])));
      xv.y += gg.y * ((bf2f(a[1]) + bf2f(b[1])) + (bf2f(c[1]) + bf2f(e[1])));
      xv.z += gg.z * ((bf2f(a[2]) + bf2f(b[2])) + (bf2f(c[2]) + bf2f(e[2])));
      xv.w += gg.w * ((bf2f(a[3]) + bf2f(b[3])) + (bf2f(c[3]) + bf2f(e[3])));
      *(float4*)(xr + d) = xv;
      xn[i] = xv;
      ss += xv.x * xv.x + xv.y * xv.y + xv.z * xv.z + xv.w * xv.w;
    }
    if (l == 0) {
      ss = wave_sum(ss);
      const float rs = rsqrtf(ss * (1.f / 1024.f) + 1e-6f);
      const float* md = mods1 + (size_t)mod_row(m) * 6144;
      float4 hq[4];
#pragma unroll
      for (int i = 0; i < 4; ++i) {
        const int d = (lane + 64 * i) * 4;
        const float4 gg = *(const float4*)(g1n + d);
        const float4 sh = *(const float4*)(md + d);
        const float4 sc = *(const float4*)(md + 1024 + d);
        hq[i] = make_float4(xn[i].x * rs * gg.x * (1.f + sc.x) + sh.x, xn[i].y * rs * gg.y * (1.f + sc.y) + sh.y,
                            xn[i].z * rs * gg.z * (1.f + sc.z) + sh.z, xn[i].w * rs * gg.w * (1.f + sc.w) + sh.w);
      }
      const float qs = quant_row_store(hq, (signed char*)(p.ws + OFF_H) + (size_t)m * 1024, lane);
      if (lane == 0) ((float*)(p.ws + OFF_SCL))[m] = qs;
    }
  }
}

#define XB_TMO      128
#define XB_XCNT(j)  (256  + 64 * (j))
#define XB_XSUB(j)  (1280 + 64 * (j))
#define XB_XGEN(j)  (2304 + 64 * (j))
#define XB_TOP      3328
#define XB_TOPGEN   3392
#define XCD_BAR_WORDS 3456
#define XB_SPIN_CAP (1u << 22)
__device__ __forceinline__ unsigned xb_ld(unsigned* q) { return __hip_atomic_load(q, __ATOMIC_RELAXED, __HIP_MEMORY_SCOPE_AGENT); }
__device__ __forceinline__ unsigned xb_add(unsigned* q, unsigned v) { return __hip_atomic_fetch_add(q, v, __ATOMIC_RELAXED, __HIP_MEMORY_SCOPE_AGENT); }
__device__ __forceinline__ unsigned xb_xcc_id() { return (unsigned)__builtin_amdgcn_s_getreg((3 << 11) | 20) & 0xFu; }
#define XB_SPIN(cond, bar) do { unsigned _sp = 0; while (cond) { __builtin_amdgcn_s_sleep(1); \
    if ((++_sp & 255u) == 0u) { if (xb_ld(&(bar)[XB_TMO])) break; if (_sp > XB_SPIN_CAP) { atomicAdd(&(bar)[XB_TMO], 1u); break; } } } } while (0)
struct XcdBarrier { unsigned* bar; unsigned x; volatile LAS unsigned* st; };
__device__ __forceinline__ XcdBarrier xcd_barrier_post(unsigned* bar, volatile LAS unsigned* st) {
  XcdBarrier b; b.bar = bar; b.x = xb_xcc_id(); b.st = st;
  if (tid_opaque() == 0) (void)xb_add(&bar[XB_XCNT(b.x)], 1u);
  return b;
}
__device__ __forceinline__ void xcd_barrier_complete(unsigned* bar, unsigned x, unsigned& nloc, unsigned& nx) {
  const unsigned G = gridDim.x;
  unsigned sum, cnt, mine, sp = 0u;
  for (;;) {
    sum = 0u; cnt = 0u; mine = 0u;
#pragma unroll
    for (unsigned j = 0; j < 16; ++j) { const unsigned c = xb_ld(&bar[XB_XCNT(j)]); sum += c; cnt += (c > 0u) ? 1u : 0u; mine = (j == x) ? c : mine; }
    if (sum == G) break;
    __builtin_amdgcn_s_sleep(1);
    if ((++sp & 255u) == 0u) { if (xb_ld(&bar[XB_TMO])) break; if (sp > XB_SPIN_CAP) { atomicAdd(&bar[XB_TMO], 1u); break; } }
  }
  nloc = mine > 0u ? mine : 1u; nx = cnt > 0u ? cnt : 1u;
}
__device__ __forceinline__ void xcd_barrier(const XcdBarrier& b) {
  asm volatile("s_waitcnt vmcnt(0)" ::: "memory");
  __syncthreads();
  if (tid_opaque() == 0) {
    unsigned* bar = b.bar;
    __builtin_amdgcn_s_waitcnt(0);
    unsigned nloc = b.st[0], nx = b.st[1];
    if (nloc == 0u) { xcd_barrier_complete(bar, b.x, nloc, nx); b.st[0] = nloc; b.st[1] = nx; }
    const unsigned old = xb_add(&bar[XB_XSUB(b.x)], 1u);
    const unsigned gen = old / nloc;
    if (old + 1u == (gen + 1u) * nloc) {
      __builtin_amdgcn_fence(__ATOMIC_RELEASE, "agent");
      asm volatile("s_waitcnt vmcnt(0)" ::: "memory");
      const unsigned og = xb_add(&bar[XB_TOP], 1u);
      const unsigned tg = og / nx;
      if (og + 1u == (tg + 1u) * nx) xb_add(&bar[XB_TOPGEN], 1u);
      else XB_SPIN(xb_ld(&bar[XB_TOPGEN]) == tg, bar);
      __builtin_amdgcn_fence(__ATOMIC_ACQUIRE, "agent");
      xb_add(&bar[XB_XGEN(b.x)], 1u);
      asm volatile("s_waitcnt vmcnt(0)" ::: "memory");
    } else {
      XB_SPIN(xb_ld(&bar[XB_XGEN(b.x)]) == gen, bar);
      __builtin_amdgcn_fence(__ATOMIC_ACQUIRE, "agent");
      asm volatile("s_waitcnt vmcnt(0)" ::: "memory");
    }
  }
  __syncthreads();
}

extern __shared__ __attribute__((aligned(16))) char dyn_smem[];

__global__ void __launch_bounds__(NTHR) mega(Params p_unused) {
  cg::grid_group grid = cg::this_grid();
  const int bid0 = blockIdx.x, nb0 = gridDim.x;
#if defined(__HIP_DEVICE_COMPILE__)
  PP pp0 = (PP)__builtin_amdgcn_kernarg_segment_ptr();
#else
  PP pp0 = nullptr;
#endif
#define pp ({ PP q_ = pp0; asm volatile("" : "+s"(q_)); q_; })
#define bid opq(bid0)
#define nb opq(nb0)
  int* toff_s = (int*)(dyn_smem + 147456);
  volatile LAS unsigned* xb_st = (volatile LAS unsigned*)(dyn_smem + 147456 + 256);
  {
    unsigned* barw = (unsigned*)(fresh_ws(pp0) + OFF_BAR);
    if (blockIdx.x == 0) for (int i = threadIdx.x; i < XCD_BAR_WORDS; i += NTHR) barw[i] = 0u;
    if (threadIdx.x == 0) { xb_st[0] = 0u; xb_st[1] = 0u; }
  }
  grid.sync();
  const XcdBarrier xb = xcd_barrier_post((unsigned*)(fresh_ws(pp0) + OFF_BAR), xb_st);
#define GSYNC() xcd_barrier(xb)
  phase_ada(pp, bid, nb, dyn_smem);
  phase_convert(pp, 0, 0, bid, nb, dyn_smem);
  GSYNC();
#define LAYER(LV, LAST)                                      \
  {                                                          \
    if ((LV) == 0) { phase_prenorm(pp, opq(LV), bid, nb); GSYNC(); } \
    phase_gemm_in(pp, opq(LV), bid, nb, dyn_smem);           \
    GSYNC();                                                 \
    phase_prep(pp, opq(LV), bid, nb, dyn_smem);              \
    GSYNC();                                                 \
    phase_chunk_prep(pp, bid, nb, dyn_smem);                 \
    GSYNC();                                                 \
    phase_mix(pp, opq(LV), bid, nb, dyn_smem);               \
    GSYNC();                                                 \
    phase_post(pp, opq(LV), bid, nb);                        \
    GSYNC();                                                 \
    phase_gemm_out(pp, opq(LV), bid, nb, dyn_smem);          \
    GSYNC();                                                 \
    phase_router(pp, opq(LV), bid, nb, dyn_smem);            \
    GSYNC();                                                 \
    phase_slotfill(pp, opq(LV), bid, nb, dyn_smem);          \
    GSYNC();                                                 \
    phase_moe1_impl(pp, opq(LV), bid, nb, dyn_smem, toff_s); \
    GSYNC();                                                 \
    phase_moe2_impl(pp, opq(LV), bid, nb, dyn_smem, toff_s); \
    GSYNC();                                                 \
    phase_combine(pp, opq(LV), bid, nb);                     \
    if (!(LAST)) GSYNC();                                    \
  }
  LAYER(0, false)
  LAYER(1, true)
#undef LAYER
#undef GSYNC
#undef bid
#undef nb
#undef pp
}

#undef p
extern "C" void kernel_launch(void* const* d_in, const int* in_sizes, int n_in, void* d_out, int out_size, void* d_ws,
                              size_t ws_size, hipStream_t stream) {
  Params hp{};
  const float** pp = (const float**)&hp;
  for (int i = 0; i < 34; ++i) pp[i] = (const float*)d_in[i];
  hp.out = (float*)d_out;
  hp.ws = (char*)d_ws;
  static int grid_blocks = 0;
  if (!grid_blocks) {
    (void)hipFuncSetAttribute((const void*)mega, hipFuncAttributeMaxDynamicSharedMemorySize, LDS_BYTES);
    int dev = 0, cus = 0, per_cu = 0;
    (void)hipGetDevice(&dev);
    (void)hipDeviceGetAttribute(&cus, hipDeviceAttributeMultiprocessorCount, dev);
    (void)hipOccupancyMaxActiveBlocksPerMultiprocessor(&per_cu, mega, NTHR, LDS_BYTES);
    if (per_cu < 1) per_cu = 1;
    if (per_cu > 1) per_cu = 1;
    grid_blocks = cus * per_cu;
  }
  void* args[] = {&hp};
  (void)hipLaunchCooperativeKernel((void*)mega, dim3(grid_blocks), dim3(NTHR), args, LDS_BYTES, stream);
}
```

```cpp
#include <hip/hip_runtime.h>
#include <hip/hip_bf16.h>
#include <hip/hip_cooperative_groups.h>
#include <stdint.h>
#include <type_traits>
namespace cg = cooperative_groups;

typedef __attribute__((ext_vector_type(8))) short bf16x8;
typedef __attribute__((ext_vector_type(4))) short bf16x4;
typedef __attribute__((ext_vector_type(4))) float f32x4;
typedef __attribute__((ext_vector_type(4))) int i32x4;
typedef unsigned short bfr;

#define D_MODEL 1024
#define NB 2
#define SEQ 16384
#define CTXL 256
#define NLAT (NB * SEQ)
#define NCTX (NB * CTXL)
#define NTOK (NLAT + NCTX)
#define TTOK (SEQ + CTXL)
#define PIN 3472
#define PINP 3584
#define A_END 1536
#define B_END 2432
#define NEXP 32
#define NSLOT_MAX (NTOK * 4 + NEXP * 256)
#define NTHR 512
#define LDS_BYTES (147456 + 3072 + 8192)

constexpr size_t al256(size_t x) { return (x + 255) & ~(size_t)255; }
constexpr size_t WL_IN = 0;
constexpr size_t WL_OUT = WL_IN + (size_t)PINP * 1024 * 2;
constexpr size_t WL_GU = WL_OUT + (size_t)1024 * 1024 * 2;
constexpr size_t WL_DN = WL_GU + (size_t)32 * 2048 * 1024 * 2;
constexpr size_t WL_SIZE = WL_DN + (size_t)32 * 1024 * 1024 * 2;
constexpr size_t OFF_W = 0;
constexpr size_t OFF_MODS = al256(OFF_W + 2 * WL_SIZE);
constexpr size_t OFF_BAR = al256(OFF_MODS + 2 * 3 * 6144 * 4);
constexpr size_t OFF_SW = al256(OFF_BAR + 3456 * 4);
constexpr size_t OFF_SWIN = al256(OFF_SW + (size_t)2 * 32 * 2048 * 4);
constexpr size_t OFF_SLS = al256(OFF_SWIN + (size_t)2 * PINP * 4);
constexpr size_t OFF_SCL = al256(OFF_SLS + (size_t)(NTOK * 4 + 32 * 256) * 4);
constexpr size_t OFF_CTX = al256(OFF_SCL + (size_t)NTOK * 4);
constexpr size_t OFF_CNT = al256(OFF_CTX + (size_t)NCTX * 1024 * 4);
constexpr size_t OFF_BASE = al256(OFF_CNT + 256);
constexpr size_t OFF_TOKE = al256(OFF_BASE + (size_t)512 * 32 * 4);
constexpr size_t OFF_TOKP = al256(OFF_TOKE + (size_t)NTOK * 4 * 4);
constexpr size_t OFF_TOKG = al256(OFF_TOKP + (size_t)NTOK * 4 * 4);
constexpr size_t OFF_TOKS = al256(OFF_TOKG + (size_t)NTOK * 4 * 4);
constexpr size_t OFF_SLT = al256(OFF_TOKS + (size_t)NTOK * 4 * 4);
constexpr size_t OFF_SLG = al256(OFF_SLT + (size_t)NSLOT_MAX * 4);
constexpr size_t OFF_H = al256(OFF_SLG + (size_t)NSLOT_MAX * 4);
constexpr size_t OFF_CC = al256(OFF_H + (size_t)NTOK * 1024 * 2);
constexpr size_t OFF_P = al256(OFF_CC + (size_t)NTOK * 1024 * 2);
constexpr size_t OFF_S = al256(OFF_P + (size_t)NTOK * PINP * 4);
constexpr size_t TOK256F = (size_t)NTOK * 256 * 4;
constexpr size_t S_QN = 0;
constexpr size_t S_KN = S_QN + (size_t)NTOK * 512 * 2;
constexpr size_t S_VT = S_KN + (size_t)NTOK * 512 * 2;
constexpr size_t S_RWR = S_VT + (size_t)NB * 8 * 64 * TTOK * 2;
constexpr size_t S_RWKK = S_RWR + TOK256F;
constexpr size_t S_RWV = S_RWKK + TOK256F;
constexpr size_t S_RWG = S_RWV + TOK256F;
constexpr size_t S_RWW = S_RWG + TOK256F;
constexpr size_t S_RWKD = S_RWW + 2 * TOK256F;
constexpr size_t S_RWB = S_RWKD + 2 * TOK256F;
constexpr size_t S_BON = S_RWB + 2 * TOK256F;
constexpr size_t S_GDQ = al256(S_BON + (size_t)NTOK * 4 * 4);
constexpr size_t S_GDK = S_GDQ + TOK256F;
constexpr size_t S_GDV = S_GDK + TOK256F;
constexpr size_t S_GDAB = S_GDV + TOK256F;
constexpr size_t S_YRW = al256(S_GDAB + (size_t)NTOK * 16 * 4);
constexpr size_t S_YGD = S_YRW + 2 * TOK256F;
constexpr size_t S_END = S_YGD + 2 * TOK256F;
constexpr size_t S_SIZE = (S_END > (size_t)NSLOT_MAX * 1024 * 4) ? S_END : (size_t)NSLOT_MAX * 1024 * 4;
constexpr int NCHUNK = TTOK / 64;
constexpr int NCHAIN = 32;
constexpr size_t OFF_CH = al256(OFF_S + S_SIZE);
constexpr size_t CH_N = (size_t)NCHAIN * NCHUNK;
constexpr size_t CH_REC = 32768, CH_PT = 0, CH_RYT = 8192, CH_QT = 16384, CH_YX = 24576;
constexpr size_t CH_SIZE = CH_N * CH_REC;
constexpr size_t WS_TOTAL = OFF_CH + CH_SIZE;
static_assert(WS_TOTAL <= (size_t)2048 * 1024 * 1024, "workspace exceeds 4x largest tensor");

struct Params {
  const float *x, *c, *ctx, *c_ctx, *ada_w, *ada_b, *norm_mix_g, *norm_ffn_g, *w_in, *w_out;
  const float *na_q_gain, *na_k_gain, *na_rpb;
  const float *rw_mu, *rw_w0, *rw_w_up, *rw_a0, *rw_a_up, *rw_g_up, *rw_k_k, *rw_k_a, *rw_r_k, *rw_ln_w, *rw_ln_b;
  const float *gd_conv_w, *gd_A_log, *gd_dt_bias, *gd_norm_g;
  const float *moe_router_w, *moe_router_b, *moe_w_gu, *moe_b_gu, *moe_w_down, *moe_b_down;
  float* out;
  char* ws;
};

typedef const __attribute__((address_space(4))) Params* PP;
#define p (*pp)
__device__ __forceinline__ char* fresh_ws(PP pp) { return p.ws; }
__device__ __forceinline__ int tid_opaque() { int t = (int)__builtin_amdgcn_workitem_id_x(); asm volatile("" : "+v"(t)); return t; }
__device__ __forceinline__ int opq(int x) { asm volatile("" : "+s"(x)); return x; }
__device__ __forceinline__ int wave_id(int tid) { return __builtin_amdgcn_readfirstlane(tid >> 6); }
typedef __bf16 bf16v2_t __attribute__((ext_vector_type(2)));
typedef float f32v2_t __attribute__((ext_vector_type(2)));
__device__ __forceinline__ unsigned pk_bf16(float lo, float hi) { f32v2_t v = {lo, hi}; return __builtin_bit_cast(unsigned, __builtin_convertvector(v, bf16v2_t)); }
__device__ __forceinline__ bfr f2bf(float f) { return (bfr)(pk_bf16(f, f) & 0xffffu); }
__device__ __forceinline__ float bf2f(short v) { return __uint_as_float(((unsigned)(unsigned short)v) << 16); }
__device__ __forceinline__ bf16x4 pack4(float a, float b, float c, float d) {
  typedef __attribute__((ext_vector_type(2))) unsigned u32x2;
  u32x2 w; w[0] = pk_bf16(a, b); w[1] = pk_bf16(c, d);
  return __builtin_bit_cast(bf16x4, w);
}
__device__ __forceinline__ bf16x8 pack8(f32x4 a, f32x4 b) {
  const bf16x4 lo = pack4(a[0], a[1], a[2], a[3]), hi = pack4(b[0], b[1], b[2], b[3]);
  return __builtin_shufflevector(lo, hi, 0, 1, 2, 3, 4, 5, 6, 7);
}
__device__ __forceinline__ int perm_row32(int n) { return (n & ~31) | (((n >> 2) & 1) << 4) | (((n >> 3) & 3) << 2) | (n & 3); }
__device__ __forceinline__ float sigmoidf_(float x) { return __builtin_amdgcn_rcpf(1.f + __expf(-x)); }
__device__ __forceinline__ float siluf_(float x) { return x * __builtin_amdgcn_rcpf(1.f + __expf(-x)); }
__device__ __forceinline__ float softplusf_(float x) { const float e = __expf(fminf(x, 20.f)); const float lg = __logf(1.f + e); const float r = x < -15.f ? e : lg; return x > 20.f ? x : r; }
__device__ __forceinline__ float wave_sum(float v) {
  v += __builtin_bit_cast(float, __builtin_amdgcn_update_dpp(0, __builtin_bit_cast(int, v), 0xB1, 0xF, 0xF, true));
  v += __builtin_bit_cast(float, __builtin_amdgcn_update_dpp(0, __builtin_bit_cast(int, v), 0x4E, 0xF, 0xF, true));
  v += __builtin_bit_cast(float, __builtin_amdgcn_update_dpp(0, __builtin_bit_cast(int, v), 0x141, 0xF, 0xF, true));
  v += __builtin_bit_cast(float, __builtin_amdgcn_update_dpp(0, __builtin_bit_cast(int, v), 0x140, 0xF, 0xF, true));
  v += __builtin_bit_cast(float, __builtin_amdgcn_update_dpp(0, __builtin_bit_cast(int, v), 0x142, 0xA, 0xF, false));
  v += __builtin_bit_cast(float, __builtin_amdgcn_update_dpp(0, __builtin_bit_cast(int, v), 0x143, 0xC, 0xF, false));
  return __builtin_bit_cast(float, __builtin_amdgcn_readlane(__builtin_bit_cast(int, v), 63));
}
__device__ __forceinline__ float wave_max(float v) {
  v = fmaxf(v, __builtin_bit_cast(float, __builtin_amdgcn_update_dpp(0, __builtin_bit_cast(int, v), 0xB1, 0xF, 0xF, true)));
  v = fmaxf(v, __builtin_bit_cast(float, __builtin_amdgcn_update_dpp(0, __builtin_bit_cast(int, v), 0x4E, 0xF, 0xF, true)));
  v = fmaxf(v, __builtin_bit_cast(float, __builtin_amdgcn_update_dpp(0, __builtin_bit_cast(int, v), 0x141, 0xF, 0xF, true)));
  v = fmaxf(v, __builtin_bit_cast(float, __builtin_amdgcn_update_dpp(0, __builtin_bit_cast(int, v), 0x140, 0xF, 0xF, true)));
  const float r1 = __builtin_bit_cast(float, __builtin_amdgcn_readlane(__builtin_bit_cast(int, v), 0));
  const float r2 = __builtin_bit_cast(float, __builtin_amdgcn_readlane(__builtin_bit_cast(int, v), 16));
  const float r3 = __builtin_bit_cast(float, __builtin_amdgcn_readlane(__builtin_bit_cast(int, v), 32));
  const float r4 = __builtin_bit_cast(float, __builtin_amdgcn_readlane(__builtin_bit_cast(int, v), 48));
  return fmaxf(fmaxf(r1, r2), fmaxf(r3, r4));
}
__device__ __forceinline__ float shfl_xor_l(float v, int mask, int lane) {
  return __builtin_bit_cast(float, __builtin_amdgcn_ds_bpermute((lane ^ mask) << 2, __builtin_bit_cast(int, v)));
}
__device__ __forceinline__ int shfl_xor_li(int v, int mask, int lane) {
  return __builtin_amdgcn_ds_bpermute((lane ^ mask) << 2, v);
}
__device__ __forceinline__ float row16_sum(float v) {
  v += __builtin_bit_cast(float, __builtin_amdgcn_update_dpp(0, __builtin_bit_cast(int, v), 0xB1, 0xF, 0xF, true));
  v += __builtin_bit_cast(float, __builtin_amdgcn_update_dpp(0, __builtin_bit_cast(int, v), 0x4E, 0xF, 0xF, true));
  v += __builtin_bit_cast(float, __builtin_amdgcn_update_dpp(0, __builtin_bit_cast(int, v), 0x141, 0xF, 0xF, true));
  v += __builtin_bit_cast(float, __builtin_amdgcn_update_dpp(0, __builtin_bit_cast(int, v), 0x140, 0xF, 0xF, true));
  return v;
}
__device__ __forceinline__ float quant_row_store(const float4 (&v)[4], signed char* dst_row, int lane) {
  float am = 0.f;
#pragma unroll
  for (int i = 0; i < 4; ++i) am = fmaxf(fmaxf(am, fmaxf(fabsf(v[i].x), fabsf(v[i].y))), fmaxf(fabsf(v[i].z), fabsf(v[i].w)));
  am = wave_max(am);
  const float sc = am > 0.f ? am * (1.f / 127.f) : 1.f, iv = 1.f / sc;
#pragma unroll
  for (int i = 0; i < 4; ++i) {
    const int q0 = (int)fminf(fmaxf(rintf(v[i].x * iv), -127.f), 127.f), q1 = (int)fminf(fmaxf(rintf(v[i].y * iv), -127.f), 127.f);
    const int q2 = (int)fminf(fmaxf(rintf(v[i].z * iv), -127.f), 127.f), q3 = (int)fminf(fmaxf(rintf(v[i].w * iv), -127.f), 127.f);
    *(unsigned*)(dst_row + (lane + 64 * i) * 4) = (unsigned)(q0 & 0xff) | ((unsigned)(q1 & 0xff) << 8) | ((unsigned)(q2 & 0xff) << 16) | ((unsigned)(q3 & 0xff) << 24);
  }
  return sc;
}
__device__ __forceinline__ float ldbf1(const bfr* q, size_t i) { return bf2f((short)q[i]); }
__device__ __forceinline__ f32x4 ldbf4(const bfr* q) { const bf16x4 v = *(const bf16x4*)q; return (f32x4){bf2f(v[0]), bf2f(v[1]), bf2f(v[2]), bf2f(v[3])}; }
__device__ __forceinline__ int mod_row(int m) { return m < NLAT ? (m >> 14) : 2; }

__device__ __forceinline__ void phase_ada(PP pp, int bid, int nb, char* smem) {
  float* red = (float*)smem;
  float* mods = (float*)(p.ws + OFF_MODS);
  const int tid = tid_opaque();
  for (int task = bid; task < 2 * 96; task += nb) {
    int l = task / 96, cgp = task % 96;
    int col = cgp * 64 + (tid & 63), ks = tid >> 6;
    const float* W = p.ada_w + (size_t)l * 1024 * 6144;
    float a0 = 0.f, a1 = 0.f, a2 = 0.f;
    for (int d = ks * 128; d < ks * 128 + 128; ++d) {
      float w = W[(size_t)d * 6144 + col];
      a0 += siluf_(p.c[d]) * w;
      a1 += siluf_(p.c[1024 + d]) * w;
      a2 += siluf_(p.c_ctx[d]) * w;
    }
    red[(ks * 3 + 0) * 64 + (tid & 63)] = a0;
    red[(ks * 3 + 1) * 64 + (tid & 63)] = a1;
    red[(ks * 3 + 2) * 64 + (tid & 63)] = a2;
    __syncthreads();
    if (tid < 192) {
      int r = tid >> 6, cc = tid & 63;
      float s = 0.f;
      for (int k = 0; k < 8; ++k) s += red[(k * 3 + r) * 64 + cc];
      mods[(size_t)(l * 3 + r) * 6144 + cgp * 64 + cc] = s + p.ada_b[(size_t)l * 6144 + cgp * 64 + cc];
    }
    __syncthreads();
  }
}

template <bool PERM>
__device__ __forceinline__ void convert_tile(const float* src, int N, bfr* dst, int kt4  , int nt, float* tile  ) {
  const int tid = tid_opaque();
  float4 v[8];
#pragma unroll
  for (int q = 0; q < 8; ++q) {
    const int idx = tid + q * 512;
    const int kk = idx >> 4, n4 = idx & 15;
    v[q] = *(const float4*)(src + (size_t)(kt4 * 256 + kk) * N + nt * 64 + n4 * 4);
  }
#pragma unroll
  for (int q = 0; q < 8; ++q) {
    const int idx = tid + q * 512;
    const int kk = idx >> 4, n4 = idx & 15;
    tile[kk * 65 + n4 * 4 + 0] = v[q].x; tile[kk * 65 + n4 * 4 + 1] = v[q].y;
    tile[kk * 65 + n4 * 4 + 2] = v[q].z; tile[kk * 65 + n4 * 4 + 3] = v[q].w;
  }
  __syncthreads();
  {
    const int nn = tid >> 3, kc = tid & 7;
    const int n = PERM ? perm_row32(nt * 64 + nn) : nt * 64 + nn;
#pragma unroll
    for (int q = 0; q < 4; ++q) {
      const int k0 = (kc + 8 * q) * 8;
      *(bf16x4*)(dst + (size_t)n * 1024 + kt4 * 256 + k0) = pack4(tile[(k0 + 0) * 65 + nn], tile[(k0 + 1) * 65 + nn], tile[(k0 + 2) * 65 + nn], tile[(k0 + 3) * 65 + nn]);
      *(bf16x4*)(dst + (size_t)n * 1024 + kt4 * 256 + k0 + 4) = pack4(tile[(k0 + 4) * 65 + nn], tile[(k0 + 5) * 65 + nn], tile[(k0 + 6) * 65 + nn], tile[(k0 + 7) * 65 + nn]);
    }
  }
  __syncthreads();
}
template <int N, bool INTERLEAVE>
__device__ __forceinline__ void convert_i8(const float* src  , signed char* dst  , float* sw, int ng, char* smem) {
  const int tid = tid_opaque();
  bfr* blk = (bfr*)smem;
  int* cmax = (int*)(smem + 131072);
  if (tid < 64) cmax[tid] = 0;
  __syncthreads();
  {
    const int n4 = tid & 15, kk0 = tid >> 4;
    float m0 = 0.f, m1 = 0.f, m2 = 0.f, m3 = 0.f;
#pragma unroll 8
    for (int ps = 0; ps < 32; ++ps) {
      const int k = ps * 32 + kk0;
      const int ncol = ng * 64 + n4 * 4;
      const int ncl = (N % 64 == 0) ? ncol : min(ncol, N - 4);
      float4 v = *(const float4*)(src + (size_t)k * N + ncl);
      if (N % 64 != 0 && ncol != ncl) v = make_float4(0.f, 0.f, 0.f, 0.f);
      m0 = fmaxf(m0, fabsf(v.x)); m1 = fmaxf(m1, fabsf(v.y)); m2 = fmaxf(m2, fabsf(v.z)); m3 = fmaxf(m3, fabsf(v.w));
      *(bf16x4*)(blk + k * 64 + n4 * 4) = pack4(v.x, v.y, v.z, v.w);
    }
    atomicMax(&cmax[n4 * 4 + 0], __float_as_int(m0)); atomicMax(&cmax[n4 * 4 + 1], __float_as_int(m1));
    atomicMax(&cmax[n4 * 4 + 2], __float_as_int(m2)); atomicMax(&cmax[n4 * 4 + 3], __float_as_int(m3));
  }
  __syncthreads();
  {
    const int nn = tid >> 3, kc = tid & 7;
    const int n = ng * 64 + nn;
    const float am = __int_as_float(cmax[nn]);
    const float sc = am > 0.f ? am * (1.f / 127.f) : 1.f, iv = 1.f / sc;
    const int j = n & 1023;
    const int row = INTERLEAVE ? (j >> 7) * 256 + ((j >> 2) & 1) * 128 + ((j >> 5) & 3) * 32 + ((n >= 1024) ? 16 : 0) + ((j >> 3) & 3) * 4 + (j & 3) : perm_row32(n);
    if (kc == 0) sw[n] = sc;
#pragma unroll 2
    for (int q = 0; q < 8; ++q) {
      const int k0 = (kc + 8 * q) * 16;
      unsigned w[4];
#pragma unroll
      for (int g4 = 0; g4 < 4; ++g4) {
        unsigned acc = 0u;
#pragma unroll
        for (int b = 0; b < 4; ++b) {
          const float v = bf2f((short)blk[(k0 + g4 * 4 + b) * 64 + nn]);
          const int qi = (int)fminf(fmaxf(rintf(v * iv), -127.f), 127.f);
          acc |= ((unsigned)(qi & 0xff)) << (8 * b);
        }
        w[g4] = acc;
      }
      *(uint4*)(dst + (size_t)row * 1024 + k0) = make_uint4(w[0], w[1], w[2], w[3]);
    }
  }
  __syncthreads();
}
__device__ __forceinline__ void phase_convert(PP pp, int l, int part, int bid, int nb, char* smem) {
  float* tile = (float*)smem;
  char* wl = p.ws + OFF_W + (size_t)l * WL_SIZE;
  const int T_IN = 56, T_OUT = 4 * 16, T_GU = 32 * 32, T_DN = 32 * 4 * 16;
  const int t_lo = part == 0 ? 0 : T_IN + T_OUT;
  const int t_hi = part == 0 ? T_IN + T_OUT : T_IN + T_OUT + T_GU + T_DN;
  for (int t = t_lo + bid; t < t_hi; t += nb) {
    if (t < T_IN) {
      convert_i8<PIN, false>(p.w_in + (size_t)l * 1024 * PIN, (signed char*)(wl + WL_IN), (float*)(p.ws + OFF_SWIN) + (size_t)l * PINP, t, smem);
    } else if (t < T_IN + T_OUT) {
      int u = t - T_IN; int kt4 = u / 16, nt = u % 16;
      convert_tile<false>(p.w_out + (size_t)l * 1024 * 1024, 1024, (bfr*)(wl + WL_OUT), kt4, nt, tile);
    } else if (t < T_IN + T_OUT + T_GU) {
      int u = t - T_IN - T_OUT; int e = u / 32, ng = u % 32;
      convert_i8<2048, true>(p.moe_w_gu + ((size_t)l * 32 + e) * 1024 * 2048, (signed char*)(wl + WL_GU) + (size_t)e * 2048 * 1024,
                    (float*)(p.ws + OFF_SW) + ((size_t)l * 32 + e) * 2048, ng, smem);
    } else {
      int u = t - T_IN - T_OUT - T_GU; int e = u / 64; int v = u % 64; int kt4 = v / 16, nt = v % 16;
      convert_tile<true>(p.moe_w_down + ((size_t)l * 32 + e) * 1024 * 1024, 1024, (bfr*)(wl + WL_DN) + (size_t)e * 1024 * 1024, kt4, nt, tile);
    }
  }
}

__device__ __forceinline__ void phase_prenorm(PP pp, int l, int bid, int nb) {
  const int tid = tid_opaque(), lane = tid & 63, wv = wave_id(tid);
  const float* xl = (l == 0) ? p.x : p.out;
  const float* xc = (l == 0) ? p.ctx : (const float*)(p.ws + OFF_CTX);
  const float* mods = (const float*)(p.ws + OFF_MODS) + (size_t)l * 3 * 6144;
  const float* g = p.norm_mix_g + (size_t)l * 1024;
  signed char* H8 = (signed char*)(p.ws + OFF_H);
  float* SCL = (float*)(p.ws + OFF_SCL);
  {
    int* cnt = (int*)(p.ws + OFF_CNT);
    int gt = bid * NTHR + tid;
    if (gt < 32) cnt[gt] = 0;
  }
  for (int m = bid * 8 + wv; m < NTOK; m += nb * 8) {
    const float* xr = (m < NLAT) ? xl + (size_t)m * 1024 : xc + (size_t)(m - NLAT) * 1024;
    const float* md = mods + (size_t)mod_row(m) * 6144;
    float4 v[4];
    float ss = 0.f;
#pragma unroll
    for (int i = 0; i < 4; ++i) {
      v[i] = *(const float4*)(xr + (lane + 64 * i) * 4);
      ss += v[i].x * v[i].x + v[i].y * v[i].y + v[i].z * v[i].z + v[i].w * v[i].w;
    }
    ss = wave_sum(ss);
    float rs = rsqrtf(ss * (1.f / 1024.f) + 1e-6f);
    float4 hq[4];
#pragma unroll
    for (int i = 0; i < 4; ++i) {
      int d = (lane + 64 * i) * 4;
      float4 gg = *(const float4*)(g + d);
      float4 sh = *(const float4*)(md + d);
      float4 sc = *(const float4*)(md + 1024 + d);
      hq[i] = make_float4(v[i].x * rs * gg.x * (1.f + sc.x) + sh.x, v[i].y * rs * gg.y * (1.f + sc.y) + sh.y,
                          v[i].z * rs * gg.z * (1.f + sc.z) + sh.z, v[i].w * rs * gg.w * (1.f + sc.w) + sh.w);
    }
    const float qs = quant_row_store(hq, H8 + (size_t)m * 1024, lane);
    if (lane == 0) SCL[m] = qs;
  }
}

#define LAS __attribute__((address_space(3)))
namespace g8 {
constexpr int BM = 256, BK = 64, HALF = 128, HTB = HALF * BK * 2, STAGE_BYTES = 8 * HTB, KD = 1024;
__device__ __forceinline__ int lds_byte(int r, int c) { const int st = (r >> 4) * 2 + (c >> 5), rr = r & 15, cc = c & 31, ob = rr * 64 + cc * 2; return st * 1024 + (ob ^ (((ob >> 9) & 1) << 5)); }
__device__ __forceinline__ void stage_rc(int b, int& R, int& C) { const int st = b / 1024, sb = b % 1024, swz = sb ^ (((sb >> 9) & 1) << 5); R = (st >> 1) * 16 + swz / 64; C = (st & 1) * 32 + (swz % 64) / 2; }
struct GUnit { int pm, pn, brow0, e; };
__device__ __forceinline__ int unit_index(int i, int c, int G, int total) {
  const int x = c & 7, j = c >> 3, q = total >> 3, r = total & 7;
  const int start = x < r ? x * (q + 1) : r * (q + 1) + (x - r) * q;
  const int size = q + (x < r ? 1 : 0);
  const int li = i * (G >> 3) + j;
  return li < size ? start + li : -1;
}

__device__ __forceinline__ f32x4 mma16(bf16x8 a, bf16x8 b, f32x4 c) { return __builtin_amdgcn_mfma_f32_16x16x32_bf16(a, b, c, 0, 0, 0); }
__device__ __forceinline__ i32x4 mma16(i32x4 a, i32x4 b, i32x4 c) { return __builtin_amdgcn_mfma_i32_16x16x64_i8(a, b, c, 0, 0, 0); }
template <bool I8, bool GATHER, class Sched, class Epi>
__device__ __forceinline__ void gemm_stream(LAS unsigned char* lds, const void* Abase, const void* Btbase, const Sched& S, const Epi& E, const int* slt = nullptr) {
  typedef typename std::conditional<I8, i32x4, f32x4>::type AccT;
  typedef typename std::conditional<I8, i32x4, bf16x8>::type FragT;
  constexpr int KB = I8 ? KD : KD * 2;
  const int tid = tid_opaque(), wid = __builtin_amdgcn_readfirstlane(tid >> 6), lane = tid & 63, wr = wid >> 2, wc = wid & 3, fr = lane & 15, fq = lane >> 4;
  constexpr int nt = KB / 128;
  int R[2], C[2];
  unsigned voffB[2];
#pragma unroll
  for (int i = 0; i < 2; ++i) { stage_rc(tid * 16 + i * 8192, R[i], C[i]); voffB[i] = (unsigned)(R[i] * KB + C[i] * 2); }
#define voffA voffB
  constexpr size_t kstep = (size_t)(BK * 2);
  constexpr size_t hstep = (size_t)HALF * KB;
  const unsigned ldsw = (unsigned)wid * 1024u;
  const int aoff = lds_byte(wr * 64 + fr, fq * 8), boff = lds_byte(wc * 32 + fr, fq * 8);
#define G8_SA(b, h) (((b) * 2 + (h)) * HTB)
#define G8_SB(b, h) ((4 + (b) * 2 + (h)) * HTB)
#define G8_STAGE(bufoff, gbase, v0, v1) do { \
    __builtin_amdgcn_global_load_lds((const unsigned*)((const char*)(gbase) + (v0)), (LAS unsigned*)(lds + (bufoff) + ldsw), 16, 0, 0); \
    __builtin_amdgcn_global_load_lds((const unsigned*)((const char*)(gbase) + (v1)), (LAS unsigned*)(lds + (bufoff) + ldsw + 8192), 16, 0, 0); } while (0)
#define G8_STAGEB(bufoff, gbase) G8_STAGE(bufoff, gbase, voffB[0], voffB[1])
#define G8_STAGEA_U(bufoff, base_u, hsel) G8_STAGE(bufoff, (base_u) + (hsel) * hstep, voffA[0], voffA[1])
#define G8_STAGEA_G(bufoff, koff, o0, o1) G8_STAGE(bufoff, (const char*)Abase + (koff), o0, o1)
#define G8_LDA(dst, b, h) do { _Pragma("unroll") for (int m = 0; m < 4; ++m) _Pragma("unroll") for (int k = 0; k < 2; ++k) dst[m][k] = *(const LAS FragT*)(lds + G8_SA(b, h) + aoff + m * 2048 + k * 1024); } while (0)
#define G8_LDB(dst, b, h) do { _Pragma("unroll") for (int n = 0; n < 2; ++n) _Pragma("unroll") for (int k = 0; k < 2; ++k) dst[n][k] = *(const LAS FragT*)(lds + G8_SB(b, h) + boff + n * 2048 + k * 1024); } while (0)
#define G8_MMA(ai, bj, At, Bt) do { __builtin_amdgcn_s_setprio(1); _Pragma("unroll") for (int m = 0; m < 4; ++m) _Pragma("unroll") for (int n = 0; n < 2; ++n) _Pragma("unroll") for (int k = 0; k < 2; ++k) \
    acc[ai][bj][m][n] = mma16(Bt[n][k], At[m][k], acc[ai][bj][m][n]); __builtin_amdgcn_s_setprio(0); } while (0)
#define G8_WAIT_V(n) asm volatile("s_waitcnt vmcnt(" #n ")" ::: "memory")
#define G8_WAIT_L(n) asm volatile("s_waitcnt lgkmcnt(" #n ")" ::: "memory")
#define G8_BAR __builtin_amdgcn_s_barrier()
#define G8_SCHED __builtin_amdgcn_sched_barrier(0)
  GUnit cur, nxt;
  int ui = 0;
  if (!S.next(0, cur)) return;
  AccT acc[2][2][4][2];
#pragma unroll
  for (int a = 0; a < 2; ++a)
#pragma unroll
    for (int b = 0; b < 2; ++b)
#pragma unroll
      for (int m = 0; m < 4; ++m)
#pragma unroll
        for (int n = 0; n < 2; ++n) acc[a][b][m][n] = AccT{};
  FragT At[4][2], B0[2][2], B1[2][2];
  const char* cA = (const char*)Abase + (size_t)cur.pm * (BM * KB);
  unsigned gA00 = 0, gA01 = 0, gA10 = 0, gA11 = 0, gN00 = 0, gN01 = 0, gN10 = 0, gN11 = 0;
  if (GATHER) {
    const int* sr = slt + cur.pm * BM;
    gA00 = (unsigned)sr[R[0]] * KB + C[0] * 2; gA01 = (unsigned)sr[R[1]] * KB + C[1] * 2;
    gA10 = (unsigned)sr[HALF + R[0]] * KB + C[0] * 2; gA11 = (unsigned)sr[HALF + R[1]] * KB + C[1] * 2;
  }
  const char* cB = (const char*)Btbase + (size_t)cur.brow0 * KB;
  G8_STAGEB(G8_SB(0, 0), cB);
  if (GATHER) G8_STAGEA_G(G8_SA(0, 0), 0, gA00, gA01); else G8_STAGEA_U(G8_SA(0, 0), cA, 0);
  G8_STAGEB(G8_SB(0, 1), cB + hstep);
  if (GATHER) G8_STAGEA_G(G8_SA(0, 1), 0, gA10, gA11); else G8_STAGEA_U(G8_SA(0, 1), cA, 1);
  if (wr == 1) G8_BAR;
  G8_WAIT_V(4); G8_BAR;
  G8_STAGEB(G8_SB(1, 0), cB + kstep);
  if (GATHER) G8_STAGEA_G(G8_SA(1, 0), kstep, gA00, gA01); else G8_STAGEA_U(G8_SA(1, 0), cA + kstep, 0);
  G8_STAGEB(G8_SB(1, 1), cB + hstep + kstep);
  G8_WAIT_V(6); G8_BAR;
  for (;;) {
    const bool has_next = S.next(ui + 1, nxt);
    const char* nA = has_next ? (const char*)Abase + (size_t)nxt.pm * (BM * KB) : cA;
    if (GATHER) {
      if (has_next) {
        const int* sr = slt + nxt.pm * BM;
        gN00 = (unsigned)sr[R[0]] * KB + C[0] * 2; gN01 = (unsigned)sr[R[1]] * KB + C[1] * 2;
        gN10 = (unsigned)sr[HALF + R[0]] * KB + C[0] * 2; gN11 = (unsigned)sr[HALF + R[1]] * KB + C[1] * 2;
      } else { gN00 = gA00; gN01 = gA01; gN10 = gA10; gN11 = gA11; }
    }
    const char* nB = has_next ? (const char*)Btbase + (size_t)nxt.brow0 * KB : cB;
#pragma unroll 1
    for (int t = 0; t < nt; t += 2) {
      const bool last = (t == nt - 2);
      const char* a1 = cA + (size_t)(t + 1) * kstep;
      const char* a2 = last ? nA : cA + (size_t)(t + 2) * kstep;
      const char* b2 = last ? nB : cB + (size_t)(t + 2) * kstep;
      const char* a3 = a2 + kstep;
      const char* b3 = b2 + kstep;
      const size_t k1 = (size_t)(t + 1) * kstep, k2 = last ? 0 : (size_t)(t + 2) * kstep, k3 = k2 + kstep;
      const unsigned w00 = last ? gN00 : gA00, w01 = last ? gN01 : gA01, w10 = last ? gN10 : gA10, w11 = last ? gN11 : gA11;
      G8_LDB(B0, 0, 0); G8_SCHED; G8_LDA(At, 0, 0); if (GATHER) G8_STAGEA_G(G8_SA(1, 1), k1, gA10, gA11); else G8_STAGEA_U(G8_SA(1, 1), a1, 1);
      G8_WAIT_L(8); G8_BAR; G8_WAIT_L(0); G8_MMA(0, 0, At, B0); G8_BAR; G8_SCHED;
      G8_LDB(B1, 0, 1); G8_STAGEB(G8_SB(0, 0), b2);
      G8_BAR; G8_WAIT_L(0); G8_MMA(0, 1, At, B1); G8_BAR;
      G8_LDA(At, 0, 1); if (GATHER) G8_STAGEA_G(G8_SA(0, 0), k2, w00, w01); else G8_STAGEA_U(G8_SA(0, 0), a2, 0);
      G8_BAR; G8_WAIT_L(0); G8_MMA(1, 0, At, B0); G8_BAR; G8_SCHED;
      G8_STAGEB(G8_SB(0, 1), b2 + hstep);
      G8_WAIT_V(6); G8_BAR; G8_MMA(1, 1, At, B1); G8_BAR;
      G8_LDB(B0, 1, 0); G8_SCHED; G8_LDA(At, 1, 0); if (GATHER) G8_STAGEA_G(G8_SA(0, 1), k2, w10, w11); else G8_STAGEA_U(G8_SA(0, 1), a2, 1);
      G8_WAIT_L(8); G8_BAR; G8_WAIT_L(0); G8_MMA(0, 0, At, B0); G8_BAR; G8_SCHED;
      G8_LDB(B1, 1, 1); G8_STAGEB(G8_SB(1, 0), b3);
      G8_BAR; G8_WAIT_L(0); G8_MMA(0, 1, At, B1); G8_BAR;
      G8_LDA(At, 1, 1); if (GATHER) G8_STAGEA_G(G8_SA(1, 0), k3, w00, w01); else G8_STAGEA_U(G8_SA(1, 0), a3, 0);
      G8_BAR; G8_WAIT_L(0); G8_MMA(1, 0, At, B0); G8_BAR; G8_SCHED;
      G8_STAGEB(G8_SB(1, 1), b3 + hstep);
      G8_WAIT_V(6); G8_BAR; G8_MMA(1, 1, At, B1); G8_BAR;
    }
    E(acc, cur, wr, wc, fr, fq);
    if (!has_next) break;
#pragma unroll
    for (int a = 0; a < 2; ++a)
#pragma unroll
      for (int b = 0; b < 2; ++b)
#pragma unroll
        for (int m = 0; m < 4; ++m)
#pragma unroll
          for (int n = 0; n < 2; ++n) acc[a][b][m][n] = AccT{};
    cur = nxt; cA = nA; cB = nB; ++ui;
    gA00 = gN00; gA01 = gN01; gA10 = gN10; gA11 = gN11;
  }
  G8_WAIT_V(0);
  if (wr == 0) G8_BAR;
  G8_BAR;
#undef G8_SA
#undef G8_SB
#undef G8_STAGE
#undef G8_STAGEB
#undef G8_STAGEA_U
#undef G8_STAGEA_G
#undef voffA
#undef G8_LDA
#undef G8_LDB
#undef G8_MMA
#undef G8_WAIT_V
#undef G8_WAIT_L
#undef G8_BAR
#undef G8_SCHED
}

struct DenseSched {
  int nM, nN, G, c;
  __device__ __forceinline__ bool next(int i, GUnit& u) const {
    const int idx = unit_index(i, c, G, nM * nN);
    if (idx < 0) return false;
    u.pm = idx / nN; u.pn = idx - u.pm * nN; u.brow0 = u.pn * BM; u.e = 0;
    return true;
  }
};
struct MoeSched {
  const int* toff; int nN, NE, G, c;
  __device__ __forceinline__ bool next(int i, GUnit& u) const {
    const int idx = unit_index(i, c, G, toff[32] * nN);
    if (idx < 0) return false;
    u.pm = idx / nN; u.pn = idx - u.pm * nN;
    const int e = toff[128 + u.pm];
    u.e = e; u.brow0 = e * NE + u.pn * BM;
    return true;
  }
};
}

struct EpiInProj {
  bfr* P; const float* SCL; const float* sw;
  __device__ __forceinline__ void operator()(const i32x4 (&acc)[2][2][4][2], const g8::GUnit& u, int wr, int wc, int fr, int fq) const {
    const int row0 = u.pm * 256 + wr * 64 + fr, col0 = u.pn * 256 + wc * 32 + 8 * fq;
    f32x4 cs[2][2];
#pragma unroll
    for (int bj = 0; bj < 2; ++bj)
#pragma unroll
      for (int n = 0; n < 2; ++n) cs[bj][n] = *(const f32x4*)(sw + col0 + bj * 128 + n * 4);
    float sav[2][4];
#pragma unroll
    for (int ai = 0; ai < 2; ++ai)
#pragma unroll
      for (int m = 0; m < 4; ++m) sav[ai][m] = SCL[row0 + ai * 128 + m * 16];
#pragma unroll
    for (int ai = 0; ai < 2; ++ai)
#pragma unroll
      for (int m = 0; m < 4; ++m) {
        const int row = row0 + ai * 128 + m * 16;
        const float sa = sav[ai][m];
        bfr* rowp = P + (size_t)row * PINP + col0;
#pragma unroll
        for (int bj = 0; bj < 2; ++bj) {
          const i32x4 a0 = acc[ai][bj][m][0], a1 = acc[ai][bj][m][1];
          f32x4 o0 = {(float)a0[0], (float)a0[1], (float)a0[2], (float)a0[3]};
          f32x4 o1 = {(float)a1[0], (float)a1[1], (float)a1[2], (float)a1[3]};
          o0 = o0 * (cs[bj][0] * sa); o1 = o1 * (cs[bj][1] * sa);
          *(bf16x8*)(rowp + bj * 128) = pack8(o0, o1);
        }
      }
  }
};
__device__ __forceinline__ void phase_gemm_in(PP pp, int l, int bid, int nb, char* smem) {
  g8::DenseSched S{130, 14, nb, bid};
  EpiInProj E{(bfr*)(p.ws + OFF_P), (const float*)(p.ws + OFF_SCL), (const float*)(p.ws + OFF_SWIN) + (size_t)l * PINP};
  g8::gemm_stream<true, false>((LAS unsigned char*)smem, p.ws + OFF_H, p.ws + OFF_W + (size_t)l * WL_SIZE + WL_IN, S, E);
}

struct EpiOutProj {
  const float *xl, *xc, *mods; float *ol, *oc;
  __device__ __forceinline__ void operator()(const f32x4 (&acc)[2][2][4][2], const g8::GUnit& u, int wr, int wc, int fr, int fq) const {
    const bool lat = u.pm < 128;
    const float* xin = lat ? xl + (size_t)u.pm * 256 * 1024 : xc + (size_t)(u.pm - 128) * 256 * 1024;
    float* xo = lat ? ol + (size_t)u.pm * 256 * 1024 : oc + (size_t)(u.pm - 128) * 256 * 1024;
    const float* g1 = mods + (size_t)(lat ? (u.pm >> 6) : 2) * 6144 + 2048;
    const int row0 = wr * 64 + fr, col0 = u.pn * 256 + wc * 32 + 4 * fq;
#pragma unroll
    for (int bj = 0; bj < 2; ++bj)
#pragma unroll
      for (int n = 0; n < 2; ++n) {
        const f32x4 gv = *(const f32x4*)(g1 + col0 + bj * 128 + n * 16);
        f32x4 xv[2][4];
#pragma unroll
        for (int ai = 0; ai < 2; ++ai)
#pragma unroll
          for (int m = 0; m < 4; ++m) xv[ai][m] = *(const f32x4*)(xin + (size_t)(row0 + ai * 128 + m * 16) * 1024 + col0 + bj * 128 + n * 16);
#pragma unroll
        for (int ai = 0; ai < 2; ++ai)
#pragma unroll
          for (int m = 0; m < 4; ++m)
            *(f32x4*)(xo + (size_t)(row0 + ai * 128 + m * 16) * 1024 + col0 + bj * 128 + n * 16) = xv[ai][m] + gv * acc[ai][bj][m][n];
        asm volatile("" ::: "memory");
      }
  }
};
__device__ __forceinline__ void phase_gemm_out(PP pp, int l, int bid, int nb, char* smem) {
  g8::DenseSched S{(l == 0) ? 130 : 128, 4, nb, bid};
  EpiOutProj E{(l == 0) ? p.x : p.out, (l == 0) ? p.ctx : (const float*)(p.ws + OFF_CTX),
               (const float*)(p.ws + OFF_MODS) + (size_t)l * 3 * 6144, p.out, (float*)(p.ws + OFF_CTX)};
  g8::gemm_stream<false, false>((LAS unsigned char*)smem, p.ws + OFF_CC, p.ws + OFF_W + (size_t)l * WL_SIZE + WL_OUT, S, E);
}

#define LBAR() do { asm volatile("s_waitcnt lgkmcnt(0)" ::: "memory"); __builtin_amdgcn_s_barrier(); asm volatile("" ::: "memory"); } while (0)
__device__ __forceinline__ void phase_prep(PP pp, int l, int bid, int nb, char* smem) {
  const int tid = tid_opaque(), lane = tid & 63, wv = wave_id(tid);
  const bfr* P = (const bfr*)(p.ws + OFF_P);
  char* S = p.ws + OFF_S;
  bfr* QN = (bfr*)(S + S_QN);
  bfr* KN = (bfr*)(S + S_KN);
  bfr* VT = (bfr*)(S + S_VT);
  bfr* RWR = (bfr*)(S + S_RWR);
  bfr* RWKK = (bfr*)(S + S_RWKK);
  bfr* RWV = (bfr*)(S + S_RWV);
  bfr* RWG = (bfr*)(S + S_RWG);
  float* RWW = (float*)(S + S_RWW);
  bfr* RWKD = (bfr*)(S + S_RWKD);
  bfr* RWB = (bfr*)(S + S_RWB);
  float* BON = (float*)(S + S_BON);
  bfr* GDQ = (bfr*)(S + S_GDQ);
  bfr* GDK = (bfr*)(S + S_GDK);
  bfr* GDV = (bfr*)(S + S_GDV);
  float* GDAB = (float*)(S + S_GDAB);
  const float* mu = p.rw_mu + (size_t)l * 896;
  const float* w0 = p.rw_w0 + (size_t)l * 512;
  const float* w_up = p.rw_w_up + (size_t)l * 2 * 32 * 256;
  const float* a0 = p.rw_a0 + (size_t)l * 512;
  const float* a_up = p.rw_a_up + (size_t)l * 2 * 32 * 256;
  const float* g_up = p.rw_g_up + (size_t)l * 64 * 256;
  const float* k_k = p.rw_k_k + (size_t)l * 256;
  const float* k_a = p.rw_k_a + (size_t)l * 256;
  const float* r_k = p.rw_r_k + (size_t)l * 256;
  const float* conv_w = p.gd_conv_w + (size_t)l * 5 * 768;
  const float* A_log = p.gd_A_log + (size_t)l * 8;
  const float* dt_bias = p.gd_dt_bias + (size_t)l * 8;
  const float* qg = p.na_q_gain + (size_t)l * 64;
  const float* kg = p.na_k_gain + (size_t)l * 64;

  bfr* wl = (bfr*)smem;
  float* lor = (float*)(smem + 192 * 256 * 2);
  __syncthreads();
  for (int i = tid; i < 192 * 256; i += NTHR) {
    const int row = i >> 8, c = i & 255;
    const float v = row < 64 ? g_up[row * 256 + c] : row < 128 ? w_up[(row - 64) * 256 + c] : a_up[(row - 128) * 256 + c];
    wl[i] = f2bf(v);
  }
  __syncthreads();

  for (int tile = bid; tile < NTOK / 16; tile += nb) {
    const int m0 = tile * 16;
    int seq_lo, seq_hi, bb, tau0;
    if (m0 < NLAT) { bb = m0 >> 14; seq_lo = bb << 14; seq_hi = seq_lo + SEQ; tau0 = m0 - seq_lo; }
    else { bb = (m0 - NLAT) >> 8; seq_lo = NLAT + (bb << 8); seq_hi = seq_lo + CTXL; tau0 = SEQ + (m0 - seq_lo); }
    const f32x4 z4 = {0.f, 0.f, 0.f, 0.f};
    int tid_t = tid; asm volatile("" : "+v"(tid_t));
    const int lane_t = tid_t & 63;
    const int cb = lane_t * 4, hh = lane_t >> 4;
    const int lg = tid_t & 31, lt = tid_t >> 5;
    const int sl = lane_t >> 4, sc4 = (lane_t & 15) * 4;
    asm volatile("" ::: "memory");
    const f32x4 mur = *(const f32x4*)(mu + cb), muk = *(const f32x4*)(mu + 256 + cb), muv = *(const f32x4*)(mu + 512 + cb);
    const f32x4 mul = *(const f32x4*)(mu + 768 + lg * 4);

    f32x4 pr[3][4], pl[3];
    {
      const int mt0 = m0 + 2 * wv;
#pragma unroll
      for (int j = 0; j < 3; ++j)
#pragma unroll
        for (int t = 0; t < 4; ++t) {
          const int m = mt0 - 1 + t;
          const int mc = min(max(m, seq_lo), seq_hi - 1);
          const f32x4 ld = ldbf4(P + (size_t)mc * PINP + A_END + j * 256 + cb);
          pr[j][t] = (m == mc) ? ld : z4;
        }
#pragma unroll
      for (int t = 0; t < 3; ++t) {
        const int m = m0 + lt - 1 + t;
        const int mc = min(max(m, seq_lo), seq_hi - 1);
        const f32x4 ld = ldbf4(P + (size_t)mc * PINP + A_END + 768 + lg * 4);
        pl[t] = (m == mc) ? ld : z4;
      }
    }
    {
      const f32x4 v = pl[1] + mul * (0.5f * (pl[0] + pl[2]) - pl[1]);
#pragma unroll
      for (int i = 0; i < 4; ++i) {
        const int ch = lg * 4 + i;
        lor[ch * 16 + lt] = ch < 32 ? tanhf(v[i]) : ch < 64 ? v[i] : sigmoidf_(v[i]);
      }
    }
    f32x4 rr[2], rk[2], rv[2];
#pragma unroll
    for (int t = 0; t < 2; ++t) {
      rr[t] = pr[0][t + 1] + mur * (0.5f * (pr[0][t] + pr[0][t + 2]) - pr[0][t + 1]);
      rk[t] = pr[1][t + 1] + muk * (0.5f * (pr[1][t] + pr[1][t + 2]) - pr[1][t + 1]);
      rv[t] = pr[2][t + 1] + muv * (0.5f * (pr[2][t] + pr[2][t + 2]) - pr[2][t + 1]);
    }
    LBAR();
    bf16x4 pgr[20], pvr[4];
    const bf16x4 zr = {0, 0, 0, 0};
    const bool is_gd = wv < 3, is_na = (wv >= 3 && wv < 7);
    const int sec = is_gd ? wv * 4 + sl : (wv - 3) * 4 + sl;
    if (is_gd) {
#pragma unroll
      for (int t = 0; t < 20; ++t) {
        const int m = m0 - 2 + t;
        const int mc = min(max(m, seq_lo), seq_hi - 1);
        pgr[t] = *(const bf16x4*)(P + (size_t)mc * PINP + B_END + sec * 64 + sc4);
      }
    } else if (is_na) {
#pragma unroll
      for (int t = 0; t < 16; ++t) pgr[t] = *(const bf16x4*)(P + (size_t)(m0 + t) * PINP + sec * 64 + sc4);
#pragma unroll
      for (int t = 16; t < 20; ++t) pgr[t] = zr;
    } else {
#pragma unroll
      for (int t = 0; t < 20; ++t) pgr[t] = zr;
    }
    {
      const int vc = (tid_t & 127) * 4, tq = (tid_t >> 7) * 4;
#pragma unroll
      for (int t = 0; t < 4; ++t) pvr[t] = *(const bf16x4*)(P + (size_t)(m0 + tq + t) * PINP + 1024 + vc);
    }
    asm volatile("" ::: "memory");
    {
      f32x4 gacc[2], wa0[2], wa1[2], aa0[2], aa1[2];
#pragma unroll
      for (int t = 0; t < 2; ++t) { gacc[t] = z4; wa0[t] = z4; wa1[t] = z4; aa0[t] = z4; aa1[t] = z4; }
#pragma unroll 4
      for (int j = 0; j < 64; ++j) {
        const bf16x4 wq = *(const bf16x4*)(wl + j * 256 + cb);
        const f32x4 wgt = {bf2f(wq[0]), bf2f(wq[1]), bf2f(wq[2]), bf2f(wq[3])};
        const float2 sv = *(const float2*)(lor + (64 + j) * 16 + 2 * wv);
        gacc[0] += wgt * sv.x; gacc[1] += wgt * sv.y;
      }
#pragma unroll 2
      for (int j = 0; j < 32; ++j) {
        const bf16x4 q0 = *(const bf16x4*)(wl + (64 + j) * 256 + cb), q1 = *(const bf16x4*)(wl + (96 + j) * 256 + cb);
        const bf16x4 q2 = *(const bf16x4*)(wl + (128 + j) * 256 + cb), q3 = *(const bf16x4*)(wl + (160 + j) * 256 + cb);
        const f32x4 ww0 = {bf2f(q0[0]), bf2f(q0[1]), bf2f(q0[2]), bf2f(q0[3])}, ww1 = {bf2f(q1[0]), bf2f(q1[1]), bf2f(q1[2]), bf2f(q1[3])};
        const f32x4 aw0 = {bf2f(q2[0]), bf2f(q2[1]), bf2f(q2[2]), bf2f(q2[3])}, aw1 = {bf2f(q3[0]), bf2f(q3[1]), bf2f(q3[2]), bf2f(q3[3])};
        const float2 tv = *(const float2*)(lor + j * 16 + 2 * wv);
        const float2 dv = *(const float2*)(lor + (32 + j) * 16 + 2 * wv);
        wa0[0] += ww0 * tv.x; wa0[1] += ww0 * tv.y; wa1[0] += ww1 * tv.x; wa1[1] += ww1 * tv.y;
        aa0[0] += aw0 * dv.x; aa0[1] += aw0 * dv.y; aa1[0] += aw1 * dv.x; aa1[1] += aw1 * dv.y;
      }
      asm volatile("" ::: "memory");
      const f32x4 kkc = *(const f32x4*)(k_k + cb), kac = *(const f32x4*)(k_a + cb), rkc = *(const f32x4*)(r_k + cb);
      const f32x4 w00 = *(const f32x4*)(w0 + cb), w01 = *(const f32x4*)(w0 + 256 + cb), a00 = *(const f32x4*)(a0 + cb), a01 = *(const f32x4*)(a0 + 256 + cb);
#pragma unroll
      for (int t = 0; t < 2; ++t) {
        const int m = m0 + 2 * wv + t;
        const f32x4 r = rr[t], k = rk[t], v = rv[t];
        const f32x4 kkraw = k * kkc;
        const float ssum = row16_sum((kkraw[0] * kkraw[0] + kkraw[1] * kkraw[1]) + (kkraw[2] * kkraw[2] + kkraw[3] * kkraw[3]));
        const f32x4 kk = kkraw * rsqrtf(ssum + 1e-6f);
        float bon = 0.f;
#pragma unroll
        for (int d = 0; d < 2; ++d) {
          const f32x4 wlin = d == 0 ? w00 + wa0[t] : w01 + wa1[t];
          const f32x4 alin = d == 0 ? a00 + aa0[t] : a01 + aa1[t];
          f32x4 lw, kd, bv;
#pragma unroll
          for (int i = 0; i < 4; ++i) {
            const float w_log = -softplusf_(-wlin[i]) - 0.5f;
            const float a = sigmoidf_(alin[i]);
            lw[i] = -__expf(w_log);
            kd[i] = k[i] * (1.f + (a - 1.f) * kac[i]);
            bv[i] = kk[i] * a;
            bon += r[i] * kd[i] * rkc[i];
          }
          const size_t o = ((size_t)d * NTOK + m) * 256 + cb;
          *(f32x4*)(RWW + o) = lw; *(bf16x4*)(RWKD + o) = pack4(kd[0], kd[1], kd[2], kd[3]); *(bf16x4*)(RWB + o) = pack4(bv[0], bv[1], bv[2], bv[3]);
        }
        bon = row16_sum(bon);
        const size_t o = (size_t)m * 256 + cb;
        *(bf16x4*)(RWR + o) = pack4(r[0], r[1], r[2], r[3]); *(bf16x4*)(RWKK + o) = pack4(kk[0], kk[1], kk[2], kk[3]);
        *(bf16x4*)(RWV + o) = pack4(v[0], v[1], v[2], v[3]); *(bf16x4*)(RWG + o) = pack4(gacc[t][0], gacc[t][1], gacc[t][2], gacc[t][3]);
        if ((lane_t & 15) == 0) BON[(size_t)m * 4 + hh] = bon;
      }
    }
    if (is_gd) {
      f32x4 cw[5];
#pragma unroll
      for (int j = 0; j < 5; ++j) cw[j] = *(const f32x4*)(conv_w + j * 768 + sec * 64 + sc4);
      f32x4 pg[20];
#pragma unroll
      for (int t = 0; t < 20; ++t) {
        const int m = m0 - 2 + t;
        const bool inr = (m >= seq_lo) && (m < seq_hi);
        const f32x4 cv = {bf2f(pgr[t][0]), bf2f(pgr[t][1]), bf2f(pgr[t][2]), bf2f(pgr[t][3])};
        pg[t] = inr ? cv : z4;
      }
#pragma unroll
      for (int t = 0; t < 16; ++t) {
        f32x4 acc = z4;
#pragma unroll
        for (int j = 0; j < 5; ++j) acc += cw[j] * pg[t + j];
        f32x4 val = {siluf_(acc[0]), siluf_(acc[1]), siluf_(acc[2]), siluf_(acc[3])};
        const int m = m0 + t;
        if (sec < 8) {
          const float ss = row16_sum((val[0] * val[0] + val[1] * val[1]) + (val[2] * val[2] + val[3] * val[3]));
          val = val * rsqrtf(ss + 1e-6f);
          if (sec < 4) { const f32x4 vq = val * 0.125f; *(bf16x4*)(GDQ + (size_t)m * 256 + sec * 64 + sc4) = pack4(vq[0], vq[1], vq[2], vq[3]); }
          else *(bf16x4*)(GDK + (size_t)m * 256 + (sec - 4) * 64 + sc4) = pack4(val[0], val[1], val[2], val[3]);
        } else *(bf16x4*)(GDV + (size_t)m * 256 + (sec - 8) * 64 + sc4) = pack4(val[0], val[1], val[2], val[3]);
      }
    } else if (is_na) {
      const f32x4 gq = *(const f32x4*)(qg + sc4) * (0.125f * 1.4426950408889634f), gk = *(const f32x4*)(kg + sc4);
#pragma unroll
      for (int t = 0; t < 16; ++t) {
        f32x4 val = {bf2f(pgr[t][0]), bf2f(pgr[t][1]), bf2f(pgr[t][2]), bf2f(pgr[t][3])};
        const float ss = row16_sum((val[0] * val[0] + val[1] * val[1]) + (val[2] * val[2] + val[3] * val[3]));
        val = val * rsqrtf(ss * (1.f / 64.f) + 1e-6f);
        const int m = m0 + t;
        if (sec < 8) { const f32x4 o = val * gq; *(bf16x4*)(QN + (size_t)m * 512 + sec * 64 + sc4) = pack4(o[0], o[1], o[2], o[3]); }
        else { const f32x4 o = val * gk; *(bf16x4*)(KN + (size_t)m * 512 + (sec - 8) * 64 + sc4) = pack4(o[0], o[1], o[2], o[3]); }
      }
    }
    if (tid_t < 256) {
      const int t = tid_t >> 4, j = tid_t & 15;
      const int m = m0 + t;
      const float pv = bf2f((short)P[(size_t)m * PINP + B_END + 1024 + j]);
      float o;
      if (j < 8) o = -__expf(A_log[j]) * softplusf_(pv + dt_bias[j]);
      else o = sigmoidf_(pv);
      GDAB[(size_t)m * 16 + j] = o;
    }
    {
      const int vc = (tid_t & 127) * 4, tq = (tid_t >> 7) * 4;
#pragma unroll
      for (int i = 0; i < 4; ++i) {
        const int hd = vc + i;
        bfr* dst = VT + ((size_t)(bb * 8 + (hd >> 6)) * (TTOK / 16) + (tau0 >> 4)) * 1024 + (hd & 63) * 16 + tq;
        const bf16x4 o = {pvr[0][i], pvr[1][i], pvr[2][i], pvr[3][i]};
        *(bf16x4*)dst = o;
      }
    }
    LBAR();
  }
  __syncthreads();
}

__device__ __forceinline__ int scan_tok(int b, int d, int s) {
  if (s < CTXL) { int t = d ? (CTXL - 1 - s) : s; return NLAT + b * CTXL + t; }
  int u = s - CTXL; int t = d ? (SEQ - 1 - u) : u; return b * SEQ + t;
}
#define CS 72
#define SLOT_BYTES (64 * CS * 2)
#define F0_STRIDE 68
#define X1_F0 (13 * SLOT_BYTES)
#define X1_ARR (X1_F0 + 64 * F0_STRIDE * 4)

#define MM_FRAGS(As, Bs, a0, a1, b00, b01, b10, b11)                                                     \
  const bf16x8 a0 = *(const bf16x8*)((As) + ((mt * 16 + fr) * CS + fq * 8) * 2);                         \
  const bf16x8 a1 = *(const bf16x8*)((As) + ((mt * 16 + fr) * CS + 32 + fq * 8) * 2);                    \
  const bf16x8 b00 = *(const bf16x8*)((Bs) + ((nt0 * 16 + fr) * CS + fq * 8) * 2);                       \
  const bf16x8 b01 = *(const bf16x8*)((Bs) + ((nt0 * 16 + fr) * CS + 32 + fq * 8) * 2);                  \
  const bf16x8 b10 = *(const bf16x8*)((Bs) + ((nt0 * 16 + 16 + fr) * CS + fq * 8) * 2);                  \
  const bf16x8 b11 = *(const bf16x8*)((Bs) + ((nt0 * 16 + 16 + fr) * CS + 32 + fq * 8) * 2);
#define MM_2TILES(acc0, acc1, a0, a1, b00, b01, b10, b11)                                                \
  acc0 = __builtin_amdgcn_mfma_f32_16x16x32_bf16(a0, b00, acc0, 0, 0, 0);                                \
  acc0 = __builtin_amdgcn_mfma_f32_16x16x32_bf16(a1, b01, acc0, 0, 0, 0);                                \
  acc1 = __builtin_amdgcn_mfma_f32_16x16x32_bf16(a0, b10, acc1, 0, 0, 0);                                \
  acc1 = __builtin_amdgcn_mfma_f32_16x16x32_bf16(a1, b11, acc1, 0, 0, 0);
__device__ __forceinline__ void wr_T(char* slot, int mt, int nt, int fr, int fq, f32x4 v) {
  *(bf16x4*)(slot + ((nt * 16 + fr) * CS + mt * 16 + 4 * fq) * 2) = pack4(v[0], v[1], v[2], v[3]);
}

struct ChunkIn { float lw[8], be[8]; unsigned f0[8], f1[8], f2[8], f3[8], xv[8]; };
template <bool GDN>
__device__ __forceinline__ void chunk_load(PP pp, int t, ChunkIn& ci) {
  const int tid = tid_opaque(), c = tid & 63, tg = wave_id(tid);
  const int chain = t / NCHUNK, n = t - chain * NCHUNK;
  const int d = chain & 1, h = (chain >> 1) & 3, b = (chain >> 3) & 1;
  const char* S = p.ws + OFF_S;
#pragma unroll
  for (int u = 0; u < 8; ++u) {
    const int m = scan_tok(b, d, n * 64 + tg * 8 + u);
    const size_t o = (size_t)m * 256 + h * 64 + c;
    if (!GDN) {
      ci.lw[u] = ((const float*)(S + S_RWW))[(size_t)d * NTOK * 256 + o];
      ci.f0[u] = ((const unsigned short*)(S + S_RWKK))[o];
      ci.f1[u] = ((const unsigned short*)(S + S_RWB))[(size_t)d * NTOK * 256 + o];
      ci.f2[u] = ((const unsigned short*)(S + S_RWKD))[(size_t)d * NTOK * 256 + o];
      ci.f3[u] = ((const unsigned short*)(S + S_RWR))[o];
      ci.xv[u] = ((const unsigned short*)(S + S_RWV))[o];
      ci.be[u] = 1.f;
    } else {
      ci.lw[u] = ((const float*)(S + S_GDAB))[(size_t)m * 16 + d * 4 + h];
      ci.be[u] = ((const float*)(S + S_GDAB))[(size_t)m * 16 + 8 + d * 4 + h];
      ci.f0[u] = ((const unsigned short*)(S + S_GDK))[o];
      ci.f3[u] = ((const unsigned short*)(S + S_GDQ))[o];
      ci.xv[u] = ((const unsigned short*)(S + S_GDV))[o];
      ci.f1[u] = 0u; ci.f2[u] = 0u;
    }
  }
}
template <bool GDN>
__device__ __forceinline__ void chunk_prep_task(PP pp, int t, int t_next, bool has_next, const ChunkIn& ci, ChunkIn& nx, char* smem) {
  const int chain = t / NCHUNK, n = t - chain * NCHUNK;
  const int d = chain & 1, h = (chain >> 1) & 3, b = (chain >> 3) & 1;
  (void)b; (void)d; (void)h;
  const int tid = tid_opaque(), lane = tid & 63, wv = wave_id(tid);
  const int fr = lane & 15, fq = lane >> 4, mt = wv >> 1, nt0 = (wv & 1) * 2;
  char* S = p.ws + OFF_S;
  char* CH = p.ws + OFF_CH;
  const size_t cc = (size_t)chain * NCHUNK + n;
  char* const p0 = smem;
  char* const p1 = smem + 1 * SLOT_BYTES;
  char* const p2 = smem + 2 * SLOT_BYTES;
  char* const p3 = smem + 3 * SLOT_BYTES;
  char* const p4 = smem + 4 * SLOT_BYTES;
  char* const p5 = smem + 5 * SLOT_BYTES;
  char* const p6 = smem + 6 * SLOT_BYTES;
  char* const p7 = smem + 7 * SLOT_BYTES;
  char* const p8 = smem + 8 * SLOT_BYTES;
  char* const p9 = smem + 9 * SLOT_BYTES;
  char* const p10 = smem + 10 * SLOT_BYTES;
  char* const p11 = smem + 11 * SLOT_BYTES;
  char* const p12 = smem + 12 * SLOT_BYTES;
  float* const F0 = (float*)(smem + X1_F0);
  float* const Lv = (float*)(smem + X1_ARR);
  float* const Lm1v = Lv + 64;
  float* const betav = Lv + 128;
  float* const eLv = Lv + 192;
  float* const gC = Lv + 256;
  float* const gsum = Lv + 320;
  char* const sKt = p0;
  char* const sBh = GDN ? p0 : p1;
  char* const sKh = GDN ? p0 : p2;

  {
    const int c = lane, tg = wv;
    const float* lw = ci.lw; const float* be = ci.be;
    float f0[8], f1[8], f2[8], f3[8], xv[8];
#pragma unroll
    for (int u = 0; u < 8; ++u) {
      f0[u] = __uint_as_float(ci.f0[u] << 16); f1[u] = __uint_as_float(ci.f1[u] << 16); f2[u] = __uint_as_float(ci.f2[u] << 16);
      f3[u] = __uint_as_float(ci.f3[u] << 16); xv[u] = __uint_as_float(ci.xv[u] << 16);
    }
    float cum[8];
    cum[0] = lw[0];
#pragma unroll
    for (int u = 1; u < 8; ++u) cum[u] = cum[u - 1] + lw[u];
    gsum[tg * 64 + c] = cum[7];
    LBAR();
    float off = 0.f, LC = 0.f;
#pragma unroll
    for (int g2 = 0; g2 < 8; ++g2) { const float gs = gsum[g2 * 64 + c]; LC += gs; off += (g2 < tg) ? gs : 0.f; }
    bf16x8 vKtT, vBbT, vKbT, vXT;
#pragma unroll
    for (int u = 0; u < 8; ++u) {
      const int t = tg * 8 + u;
      const float L = off + cum[u], Lm1 = L - lw[u];
      if (!GDN) {
        const float eLm1 = __expf(Lm1), enL = __expf(-L), eL = __expf(L), eCL = __expf(LC - L);
        const float kt = f0[u] * eLm1;
        *(bfr*)(p0 + (t * CS + c) * 2) = f2bf(kt);
        *(bfr*)(p1 + (t * CS + c) * 2) = f2bf(f1[u] * enL);
        *(bfr*)(p2 + (t * CS + c) * 2) = f2bf(f2[u] * enL);
        *(bfr*)(p3 + (t * CS + c) * 2) = f2bf(f3[u] * eL);
        vKtT[u] = (short)f2bf(kt);
        vBbT[u] = (short)f2bf(f1[u] * eCL);
        vKbT[u] = (short)f2bf(f2[u] * eCL);
        vXT[u] = (short)f2bf(xv[u]);
      } else {
        *(bfr*)(p0 + (t * CS + c) * 2) = f2bf(f0[u]);
        *(bfr*)(p3 + (t * CS + c) * 2) = f2bf(f3[u]);
        vKtT[u] = (short)f2bf(f0[u] * __expf(Lm1));
        vBbT[u] = (short)f2bf(be[u] * f0[u] * __expf(LC - Lm1));
        vKbT[u] = (short)f2bf(f0[u] * __expf(LC - L));
        vXT[u] = (short)f2bf(be[u] * xv[u]);
        if (c == 0) { Lv[t] = L; Lm1v[t] = Lm1; betav[t] = be[u]; eLv[t] = __expf(L); }
      }
    }
    *(bf16x8*)(p4 + (c * CS + tg * 8) * 2) = vKtT;
    *(bf16x8*)(p5 + (c * CS + tg * 8) * 2) = vBbT;
    *(bf16x8*)(p6 + (c * CS + tg * 8) * 2) = vKbT;
    *(bf16x8*)(p7 + (c * CS + tg * 8) * 2) = vXT;
    if (tg == 0) gC[c] = __expf(LC);
    if (!GDN && tid < 64) { Lv[tid] = 0.f; Lm1v[tid] = 0.f; betav[tid] = 1.f; eLv[tid] = 1.f; }
  }
  LBAR();
  if (has_next) chunk_load<GDN>(pp, t_next, nx);
  {
    {
      MM_FRAGS(sKt, sBh, a0, a1, b00, b01, b10, b11)
      f32x4 c0 = {0.f, 0.f, 0.f, 0.f}, c1 = c0;
      MM_2TILES(c0, c1, a0, a1, b00, b01, b10, b11)
#pragma unroll
      for (int q = 0; q < 2; ++q) {
        const int sI = (nt0 + q) * 16 + fr;
        const f32x4 cv = q ? c1 : c0;
        f32x4 o;
#pragma unroll
        for (int r = 0; r < 4; ++r) {
          const int tI = mt * 16 + 4 * fq + r;
          float v = cv[r];
          if (GDN) v *= betav[sI] * __expf(fminf(Lm1v[tI] - Lm1v[sI], 0.f));
          o[r] = (sI < tI) ? v : 0.f;
        }
        *(f32x4*)(F0 + sI * F0_STRIDE + mt * 16 + 4 * fq) = o;
        wr_T(p11, mt, nt0 + q, fr, fq, o);
      }
    }
    {
      MM_FRAGS(sKt, sKh, a0, a1, b00, b01, b10, b11)
      f32x4 c0 = {0.f, 0.f, 0.f, 0.f}, c1 = c0;
      MM_2TILES(c0, c1, a0, a1, b00, b01, b10, b11)
#pragma unroll
      for (int q = 0; q < 2; ++q) {
        const int sI = (nt0 + q) * 16 + fr;
        const f32x4 cv = q ? c1 : c0;
        f32x4 o;
#pragma unroll
        for (int r = 0; r < 4; ++r) {
          const int tI = mt * 16 + 4 * fq + r;
          float v = cv[r];
          if (GDN) v *= __expf(fminf(Lm1v[tI] - Lv[sI], 0.f));
          o[r] = (sI < tI) ? v : 0.f;
        }
        wr_T(p9, mt, nt0 + q, fr, fq, o);
      }
    }
    {
      MM_FRAGS(sBh, p3, a0, a1, b00, b01, b10, b11)
      f32x4 c0 = {0.f, 0.f, 0.f, 0.f}, c1 = c0;
      MM_2TILES(c0, c1, a0, a1, b00, b01, b10, b11)
#pragma unroll
      for (int q = 0; q < 2; ++q) {
        const int tI = (nt0 + q) * 16 + fr;
        const f32x4 cv = q ? c1 : c0;
        f32x4 o;
#pragma unroll
        for (int r = 0; r < 4; ++r) {
          const int sI = mt * 16 + 4 * fq + r;
          float v = cv[r];
          if (GDN) v *= betav[sI] * __expf(fminf(Lv[tI] - Lm1v[sI], 0.f));
          o[r] = (sI <= tI) ? v : 0.f;
        }
        wr_T(p10, mt, nt0 + q, fr, fq, o);
      }
    }
  }
  LBAR();
  if (wv < 2) {
    const int base = wv * 32, other = 32 - base, c = lane & 31;
    float tr[32];
#pragma unroll
    for (int j = 0; j < 32; ++j) tr[j] = 0.f;
#pragma unroll
    for (int ip = 15; ip >= 0; --ip) {
      const int i = 2 * ip + 1, i2 = 2 * ip;
      float a0 = (c == i) ? 1.f : 0.f, a1 = 0.f, b0 = (c == i2) ? 1.f : 0.f, b1 = 0.f;
      const float aii = F0[(base + i2) * F0_STRIDE + base + i];
#pragma unroll
      for (int jb = ((i + 1) & ~3); jb < 32; jb += 4) {
        const f32x4 a4 = *(const f32x4*)(F0 + (base + i) * F0_STRIDE + base + jb);
        const f32x4 b4 = *(const f32x4*)(F0 + (base + i2) * F0_STRIDE + base + jb);
        a0 -= a4[0] * tr[jb]; a1 -= a4[1] * tr[jb + 1]; a0 -= a4[2] * tr[jb + 2]; a1 -= a4[3] * tr[jb + 3];
        b0 -= b4[0] * tr[jb]; b1 -= b4[1] * tr[jb + 1]; b0 -= b4[2] * tr[jb + 2]; b1 -= b4[3] * tr[jb + 3];
      }
      const float ti = a0 + a1;
      const float ti2 = (b0 + b1) - aii * ti;
      tr[i] = ti; tr[i2] = ti2;
      if (lane < 32) {
        *(bfr*)(p8 + ((base + i) * CS + base + c) * 2) = f2bf(ti);
        *(bfr*)(p8 + ((base + i) * CS + other + c) * 2) = (bfr)0;
        *(bfr*)(p8 + ((base + i2) * CS + base + c) * 2) = f2bf(ti2);
        *(bfr*)(p8 + ((base + i2) * CS + other + c) * 2) = (bfr)0;
      }
    }
    if (lane < 32) {
#pragma unroll
      for (int q = 0; q < 4; ++q) {
        bf16x8 o, z;
#pragma unroll
        for (int j = 0; j < 8; ++j) { o[j] = (short)f2bf(tr[8 * q + j]); z[j] = 0; }
        *(bf16x8*)(p12 + ((base + c) * CS + base + 8 * q) * 2) = o;
        *(bf16x8*)(p12 + ((base + c) * CS + other + 8 * q) * 2) = z;
      }
    }
  }
  LBAR();
  {
    MM_FRAGS(p11, p12, a0, a1, b00, b01, b10, b11)
    f32x4 c0 = {0.f, 0.f, 0.f, 0.f}, c1 = c0;
    MM_2TILES(c0, c1, a0, a1, b00, b01, b10, b11)
    wr_T(p1, mt, nt0, fr, fq, c0);
    wr_T(p1, mt, nt0 + 1, fr, fq, c1);
  }
  LBAR();
  if (mt < 2 && nt0 == 2) {
    MM_FRAGS(p8, p1, a0, a1, b00, b01, b10, b11)
    f32x4 c0 = {0.f, 0.f, 0.f, 0.f}, c1 = c0;
    MM_2TILES(c0, c1, a0, a1, b00, b01, b10, b11)
#pragma unroll
    for (int r = 0; r < 4; ++r) {
      *(bfr*)(p8 + ((mt * 16 + 4 * fq + r) * CS + (nt0) * 16 + fr) * 2) = f2bf(-c0[r]);
      *(bfr*)(p8 + ((mt * 16 + 4 * fq + r) * CS + (nt0 + 1) * 16 + fr) * 2) = f2bf(-c1[r]);
    }
  }
  LBAR();
  {
    {
      MM_FRAGS(p8, p5, a0, a1, b00, b01, b10, b11)
      f32x4 c0 = {0.f, 0.f, 0.f, 0.f}, c1 = c0;
      MM_2TILES(c0, c1, a0, a1, b00, b01, b10, b11)
      wr_T(p11, mt, nt0, fr, fq, -c0);
      wr_T(p11, mt, nt0 + 1, fr, fq, -c1);
    }
    {
      MM_FRAGS(p8, p10, a0, a1, b00, b01, b10, b11)
      f32x4 c0 = {0.f, 0.f, 0.f, 0.f}, c1 = c0;
      MM_2TILES(c0, c1, a0, a1, b00, b01, b10, b11)
      wr_T(p12, mt, nt0, fr, fq, -c0);
      wr_T(p12, mt, nt0 + 1, fr, fq, -c1);
    }
  }
  LBAR();
  {
    {
      MM_FRAGS(p4, p11, a0, a1, b00, b01, b10, b11)
      f32x4 c0 = {0.f, 0.f, 0.f, 0.f}, c1 = c0;
      MM_2TILES(c0, c1, a0, a1, b00, b01, b10, b11)
#pragma unroll
      for (int q = 0; q < 2; ++q) {
        const int cp = (nt0 + q) * 16 + fr;
        f32x4 cv = q ? c1 : c0;
#pragma unroll
        for (int r = 0; r < 4; ++r) { const int cI = mt * 16 + 4 * fq + r; if (cI == cp) cv[r] += gC[cI]; }
        wr_T(p10, mt, nt0 + q, fr, fq, cv);
      }
    }
    {
      MM_FRAGS(p9, p11, a0, a1, b00, b01, b10, b11)
      f32x4 c0 = {0.f, 0.f, 0.f, 0.f}, c1 = c0;
      MM_2TILES(c0, c1, a0, a1, b00, b01, b10, b11)
#pragma unroll
      for (int q = 0; q < 2; ++q) {
        const int cp = (nt0 + q) * 16 + fr;
        f32x4 cv = q ? c1 : c0;
        const bf16x4 kb = *(const bf16x4*)(p6 + (cp * CS + mt * 16 + 4 * fq) * 2);
#pragma unroll
        for (int r = 0; r < 4; ++r) cv[r] += __uint_as_float(((unsigned)(unsigned short)kb[r]) << 16);
        wr_T(p8, mt, nt0 + q, fr, fq, cv);
      }
    }
    {
      MM_FRAGS(p4, p12, a0, a1, b00, b01, b10, b11)
      f32x4 c0 = {0.f, 0.f, 0.f, 0.f}, c1 = c0;
      MM_2TILES(c0, c1, a0, a1, b00, b01, b10, b11)
#pragma unroll
      for (int q = 0; q < 2; ++q) {
        const int tI = (nt0 + q) * 16 + fr;
        f32x4 cv = q ? c1 : c0;
        const bf16x4 rt = *(const bf16x4*)(p3 + (tI * CS + mt * 16 + 4 * fq) * 2);
        const float el = eLv[tI];
#pragma unroll
        for (int r = 0; r < 4; ++r) cv[r] += __uint_as_float(((unsigned)(unsigned short)rt[r]) << 16) * el;
        wr_T(p1, mt, nt0 + q, fr, fq, cv);
      }
    }
    {
      f32x4 c0 = {0.f, 0.f, 0.f, 0.f}, c1 = c0;
      {
        MM_FRAGS(sKh, p3, a0, a1, b00, b01, b10, b11)
        MM_2TILES(c0, c1, a0, a1, b00, b01, b10, b11)
      }
#pragma unroll
      for (int q = 0; q < 2; ++q) {
        const int tI = (nt0 + q) * 16 + fr;
#pragma unroll
        for (int r = 0; r < 4; ++r) {
          const int sI = mt * 16 + 4 * fq + r;
          float v = q ? c1[r] : c0[r];
          if (GDN) v *= __expf(fminf(Lv[tI] - Lv[sI], 0.f));
          v = (sI <= tI) ? v : 0.f;
          if (q) c1[r] = v; else c0[r] = v;
        }
      }
      {
        MM_FRAGS(p9, p12, a0, a1, b00, b01, b10, b11)
        MM_2TILES(c0, c1, a0, a1, b00, b01, b10, b11)
      }
      wr_T(p5, mt, nt0, fr, fq, c0);
      wr_T(p5, mt, nt0 + 1, fr, fq, c1);
    }
  }
  LBAR();
  {
    {
      MM_FRAGS(p8, p7, a0, a1, b00, b01, b10, b11)
      f32x4 c0 = {0.f, 0.f, 0.f, 0.f}, c1 = c0;
      MM_2TILES(c0, c1, a0, a1, b00, b01, b10, b11)
      bfr* QT = (bfr*)(CH + cc * CH_REC + CH_QT);
      *(bf16x4*)(QT + ((mt * 4 + nt0) * 64 + lane) * 4) = pack4(c0[0], c0[1], c0[2], c0[3]);
      *(bf16x4*)(QT + ((mt * 4 + nt0 + 1) * 64 + lane) * 4) = pack4(c1[0], c1[1], c1[2], c1[3]);
    }
    {
      MM_FRAGS(p7, p5, a0, a1, b00, b01, b10, b11)
      f32x4 c0 = {0.f, 0.f, 0.f, 0.f}, c1 = c0;
      MM_2TILES(c0, c1, a0, a1, b00, b01, b10, b11)
      bfr* YX = (bfr*)(CH + cc * CH_REC + CH_YX);
      *(bf16x4*)(YX + ((mt * 4 + nt0) * 64 + lane) * 4) = pack4(c0[0], c0[1], c0[2], c0[3]);
      *(bf16x4*)(YX + ((mt * 4 + nt0 + 1) * 64 + lane) * 4) = pack4(c1[0], c1[1], c1[2], c1[3]);
    }
    {
      const int fm = wv >> 1, fa = wv & 1;
      const int row = fm * 16 + fr;
      {
        const bf16x4 lo = *(const bf16x4*)(p10 + (row * CS + 32 * fa + 4 * fq) * 2);
        const bf16x4 hi = *(const bf16x4*)(p10 + (row * CS + 32 * fa + 16 + 4 * fq) * 2);
        bf16x8 f; f[0] = lo[0]; f[1] = lo[1]; f[2] = lo[2]; f[3] = lo[3]; f[4] = hi[0]; f[5] = hi[1]; f[6] = hi[2]; f[7] = hi[3];
        *(bf16x8*)(CH + cc * CH_REC + CH_PT + (size_t)((fm * 2 + fa) * 64 + lane) * 16) = f;
      }
      {
        const bf16x4 lo = *(const bf16x4*)(p1 + (row * CS + 32 * fa + 4 * fq) * 2);
        const bf16x4 hi = *(const bf16x4*)(p1 + (row * CS + 32 * fa + 16 + 4 * fq) * 2);
        bf16x8 f; f[0] = lo[0]; f[1] = lo[1]; f[2] = lo[2]; f[3] = lo[3]; f[4] = hi[0]; f[5] = hi[1]; f[6] = hi[2]; f[7] = hi[3];
        *(bf16x8*)(CH + cc * CH_REC + CH_RYT + (size_t)((fm * 2 + fa) * 64 + lane) * 16) = f;
      }
    }
  }
  LBAR();
}

template <bool GDN>
__device__ __forceinline__ void chunk_prep_loop(PP pp, int t0, int tend, int nb, char* smem) {
  ChunkIn cur, nxt;
  if (t0 < tend) chunk_load<GDN>(pp, t0, cur);
  for (int t = t0; t < tend; t += nb) {
    const bool has_next = (t + nb) < tend;
    chunk_prep_task<GDN>(pp, t, t + nb, has_next, cur, nxt, smem);
    cur = nxt;
  }
}
__device__ __forceinline__ void phase_chunk_prep(PP pp, int bid, int nb, char* smem) {
  __syncthreads();
  const int half = (NCHAIN / 2) * NCHUNK;
  chunk_prep_loop<false>(pp, bid, half, nb, smem);
  const int k0 = (half - bid + nb - 1) / nb;
  chunk_prep_loop<true>(pp, bid + k0 * nb, NCHAIN * NCHUNK, nb, smem);
  __syncthreads();
}

#define X2_BUF 32768
#define X2_BAR() do { asm volatile("s_waitcnt lgkmcnt(0)" ::: "memory"); __builtin_amdgcn_s_barrier(); asm volatile("" ::: "memory"); } while (0)
__device__ __forceinline__ void chunk_seq_chain(PP pp, int chain, char* smem) {
  __syncthreads();
  const int tid = tid_opaque(), lane = tid & 63, wv = wave_id(tid);
  const int d = chain & 1, h = (chain >> 1) & 3, b = (chain >> 3) & 1, ty = chain >> 4;
  const char* CH = p.ws + OFF_CH;
  bfr* Y = (bfr*)(p.ws + OFF_S + (ty ? S_YGD : S_YRW)) + (size_t)d * NTOK * 256;
  const size_t c0 = (size_t)chain * NCHUNK;
  if (wv >= 4) {
    const int lw = wv - 4;
    const char* src0 = CH + c0 * CH_REC + (size_t)lane * 16;
#define X2_DMA(n) { const char* s_ = src0 + (size_t)(n) * CH_REC; LAS unsigned char* d_ = (LAS unsigned char*)smem + ((n) & 3) * X2_BUF;       \
      _Pragma("unroll") for (int i = 0; i < 8; ++i) {                                                                                       \
        const int piece = i * 4 + lw;                                                                                                       \
        __builtin_amdgcn_global_load_lds((const unsigned*)(s_ + piece * 1024), (LAS unsigned*)(d_ + piece * 1024), 16, 0, 0); } }
    X2_DMA(0) X2_DMA(1) X2_DMA(2)
    asm volatile("s_waitcnt vmcnt(16)" ::: "memory");
    X2_BAR();
    for (int n = 0; n < NCHUNK; ++n) {
      if (n + 3 < NCHUNK) { X2_DMA(n + 3) asm volatile("s_waitcnt vmcnt(16)" ::: "memory"); }
      else if (n + 2 < NCHUNK) asm volatile("s_waitcnt vmcnt(8)" ::: "memory");
      else asm volatile("s_waitcnt vmcnt(0)" ::: "memory");
      X2_BAR();
    }
#undef X2_DMA
  } else {
    const int vt = wv, fr = lane & 15, fq = lane >> 4;
    f32x4 Sacc[4];
#pragma unroll
    for (int i = 0; i < 4; ++i) Sacc[i] = (f32x4){0.f, 0.f, 0.f, 0.f};
    X2_BAR();
    for (int n = 0; n < NCHUNK; ++n) {
      const char* buf = smem + (n & 3) * X2_BUF;
      bf16x8 sB0, sB1;
#pragma unroll
      for (int j = 0; j < 4; ++j) {
        sB0[j] = (short)f2bf(Sacc[0][j]); sB0[4 + j] = (short)f2bf(Sacc[1][j]);
        sB1[j] = (short)f2bf(Sacc[2][j]); sB1[4 + j] = (short)f2bf(Sacc[3][j]);
      }
#pragma unroll
      for (int m = 0; m < 4; ++m) {
        const bf16x8 pa0 = *(const bf16x8*)(buf + ((m * 2 + 0) * 64 + lane) * 16);
        const bf16x8 pa1 = *(const bf16x8*)(buf + ((m * 2 + 1) * 64 + lane) * 16);
        const bf16x8 ra0 = *(const bf16x8*)(buf + 8192 + ((m * 2 + 0) * 64 + lane) * 16);
        const bf16x8 ra1 = *(const bf16x8*)(buf + 8192 + ((m * 2 + 1) * 64 + lane) * 16);
        const bf16x4 qb = *(const bf16x4*)(buf + 16384 + ((m * 4 + vt) * 64 + lane) * 8);
        const bf16x4 yb = *(const bf16x4*)(buf + 24576 + ((vt * 4 + m) * 64 + lane) * 8);
        f32x4 y = {bf2f(yb[0]), bf2f(yb[1]), bf2f(yb[2]), bf2f(yb[3])};
        y = __builtin_amdgcn_mfma_f32_16x16x32_bf16(sB0, ra0, y, 0, 0, 0);
        y = __builtin_amdgcn_mfma_f32_16x16x32_bf16(sB1, ra1, y, 0, 0, 0);
        f32x4 sn = {bf2f(qb[0]), bf2f(qb[1]), bf2f(qb[2]), bf2f(qb[3])};
        sn = __builtin_amdgcn_mfma_f32_16x16x32_bf16(pa0, sB0, sn, 0, 0, 0);
        sn = __builtin_amdgcn_mfma_f32_16x16x32_bf16(pa1, sB1, sn, 0, 0, 0);
        Sacc[m] = sn;
        {
          const int mm = scan_tok(b, d, n * 64 + m * 16 + fr);
          *(bf16x4*)(Y + (size_t)mm * 256 + h * 64 + vt * 16 + 4 * fq) = pack4(y[0], y[1], y[2], y[3]);
        }
      }
      X2_BAR();
    }
  }
}

struct NaPair { int mk0, mk1, tau0, tau1, kr0, kr1, ct0, ct1; };
struct NaFrag { bf16x8 k00, k01, k10, k11; bf16x4 v0[4], v1[4]; };

__device__ __forceinline__ void na_load(NaFrag& f, const bfr* KN, const bfr* VT, size_t vt_base, int h, int fr, int fq, const NaPair& pr) {
  const bfr* k0 = KN + (size_t)(pr.mk0 + fr) * 512 + h * 64 + fq * 8;
  const bfr* k1 = KN + (size_t)(pr.mk1 + fr) * 512 + h * 64 + fq * 8;
  f.k00 = *(const bf16x8*)(k0); f.k01 = *(const bf16x8*)(k0 + 32);
  f.k10 = *(const bf16x8*)(k1); f.k11 = *(const bf16x8*)(k1 + 32);
#pragma unroll
  for (int dt = 0; dt < 4; ++dt) {
    const int vo = (dt * 16 + fr) * 16 + fq * 4;
    f.v0[dt] = *(const bf16x4*)(VT + vt_base + (size_t)(pr.tau0 >> 4) * 1024 + vo);
    f.v1[dt] = *(const bf16x4*)(VT + vt_base + (size_t)(pr.tau1 >> 4) * 1024 + vo);
  }
}

__device__ __forceinline__ void na_compute(const NaFrag& f, const bf16x8 qf0, const bf16x8 qf1, bool local, bool vr0, bool vr1,
                                           int dr0, int dr1, int ct0, int ct1, int qc, int fq, const float* bias_h, f32x4 (&O)[4], float& lsum) {
  f32x4 z = {0.f, 0.f, 0.f, 0.f};
  f32x4 st0 = __builtin_amdgcn_mfma_f32_16x16x32_bf16(f.k00, qf0, z, 0, 0, 0);
  st0 = __builtin_amdgcn_mfma_f32_16x16x32_bf16(f.k01, qf1, st0, 0, 0, 0);
  f32x4 st1 = __builtin_amdgcn_mfma_f32_16x16x32_bf16(f.k10, qf0, z, 0, 0, 0);
  st1 = __builtin_amdgcn_mfma_f32_16x16x32_bf16(f.k11, qf1, st1, 0, 0, 0);
  bf16x8 pf;
  if (local) {
    const int cs = min(max(qc - 8, 0), 48);
    const int kb0 = ct0 * 16 + fq * 4, kb1 = ct1 * 16 + fq * 4;
    const float* bp0 = bias_h + min(max(dr0 * 31 + kb0 - qc + 15, -32), 493);
    const float* bp1 = bias_h + min(max(dr1 * 31 + kb1 - qc + 15, -32), 493);
    const float b00 = bp0[0], b01 = bp0[1], b02 = bp0[2], b03 = bp0[3];
    const float b10 = bp1[0], b11 = bp1[1], b12 = bp1[2], b13 = bp1[3];
    const float bb0[4] = {b00, b01, b02, b03}, bb1[4] = {b10, b11, b12, b13};
#pragma unroll
    for (int r = 0; r < 4; ++r) {
      const bool ok0 = vr0 && (unsigned)(kb0 + r - cs) < 16u, ok1 = vr1 && (unsigned)(kb1 + r - cs) < 16u;
      const float e0 = __builtin_amdgcn_exp2f(st0[r] + bb0[r]), e1 = __builtin_amdgcn_exp2f(st1[r] + bb1[r]);
      const float p0 = ok0 ? e0 : 0.f, p1 = ok1 ? e1 : 0.f;
      lsum += p0 + p1;
      pf[r] = (short)f2bf(p0);
      pf[4 + r] = (short)f2bf(p1);
    }
  } else {
#pragma unroll
    for (int r = 0; r < 4; ++r) {
      const float p0 = __builtin_amdgcn_exp2f(st0[r]), p1 = __builtin_amdgcn_exp2f(st1[r]);
      lsum += p0 + p1;
      pf[r] = (short)f2bf(p0);
      pf[4 + r] = (short)f2bf(p1);
    }
  }
#pragma unroll
  for (int dt = 0; dt < 4; ++dt) {
    bf16x8 vf;
    vf[0] = f.v0[dt][0]; vf[1] = f.v0[dt][1]; vf[2] = f.v0[dt][2]; vf[3] = f.v0[dt][3];
    vf[4] = f.v1[dt][0]; vf[5] = f.v1[dt][1]; vf[6] = f.v1[dt][2]; vf[7] = f.v1[dt][3];
    O[dt] = __builtin_amdgcn_mfma_f32_16x16x32_bf16(vf, pf, O[dt], 0, 0, 0);
  }
}

__device__ __forceinline__ void na_block_task(PP pp, int task, const float* bias_lds) {
  const int tid = tid_opaque(), lane = tid & 63, wv = wave_id(tid);
  const int fr = lane & 15, fq = lane >> 4;
  char* S = p.ws + OFF_S;
  const bfr* QN = (const bfr*)(S + S_QN);
  const bfr* KN = (const bfr*)(S + S_KN);
  const bfr* VT = (const bfr*)(S + S_VT);
  bfr* CC = (bfr*)(p.ws + OFF_CC);
  const bool latent = task < 1024;
  int b, h, mqa, mqb, qra = 0, qrb = 0, cgp = 0;
  if (latent) {
    h = task & 7; const int quad = (task >> 3) & 63; b = task >> 9;
    qra = quad * 4 + (wv >> 2) * 2; qrb = qra + 1; cgp = wv & 3;
    mqa = b * SEQ + qra * 64 + cgp * 16; mqb = mqa + 64;
  } else {
    const int u = task - 1024;
    h = u & 7; b = u >> 3;
    mqa = NLAT + b * CTXL + (wv * 2) * 16; mqb = mqa + 16;
  }
  const bf16x8 qa0 = *(const bf16x8*)(QN + (size_t)(mqa + fr) * 512 + h * 64 + fq * 8);
  const bf16x8 qa1 = *(const bf16x8*)(QN + (size_t)(mqa + fr) * 512 + h * 64 + 32 + fq * 8);
  const bf16x8 qb0 = *(const bf16x8*)(QN + (size_t)(mqb + fr) * 512 + h * 64 + fq * 8);
  const bf16x8 qb1 = *(const bf16x8*)(QN + (size_t)(mqb + fr) * 512 + h * 64 + 32 + fq * 8);
  f32x4 Oa[4], Ob[4];
#pragma unroll
  for (int dt = 0; dt < 4; ++dt) { Oa[dt] = (f32x4){0.f, 0.f, 0.f, 0.f}; Ob[dt] = Oa[dt]; }
  float lsa = 0.f, lsb = 0.f;
  const size_t vt_base = (size_t)(b * 8 + h) * 64 * TTOK;
  const int rsa = min(max(qra - 4, 0), SEQ / 64 - 8), rsb = min(max(qrb - 4, 0), SEQ / 64 - 8);
  const int nrows = latent ? (rsb - rsa + 8) : 0;
  const int ct_first = (cgp <= 1) ? 0 : cgp - 1;
  const int nct = (cgp == 0 || cgp == 3) ? 2 : 3;
  const int ntile = nrows * nct;
  const int nlp = (ntile + 1) >> 1;
  const int npair = nlp + 8;
  const int qc = cgp * 16 + fr;
  auto mkpair = [&](int pi) {
    NaPair pr;
    if (pi < nlp) {
      const int i0 = 2 * pi, i1 = min(2 * pi + 1, ntile - 1);
      const int q0 = (nct == 2) ? (i0 >> 1) : ((i0 * 21846) >> 16), q1 = (nct == 2) ? (i1 >> 1) : ((i1 * 21846) >> 16);
      pr.kr0 = rsa + q0; pr.ct0 = ct_first + i0 - q0 * nct;
      pr.kr1 = rsa + q1; pr.ct1 = ct_first + i1 - q1 * nct;
      if (2 * pi + 1 >= ntile) pr.kr1 = -100;
      const int r1 = rsa + q1;
      pr.tau0 = pr.kr0 * 64 + pr.ct0 * 16; pr.tau1 = r1 * 64 + pr.ct1 * 16;
      pr.mk0 = b * SEQ + pr.tau0; pr.mk1 = b * SEQ + pr.tau1;
    } else {
      const int c = pi - nlp;
      pr.kr0 = pr.kr1 = pr.ct0 = pr.ct1 = 0;
      pr.tau0 = SEQ + c * 32; pr.tau1 = SEQ + c * 32 + 16;
      pr.mk0 = NLAT + b * CTXL + c * 32; pr.mk1 = pr.mk0 + 16;
    }
    return pr;
  };
  NaFrag fa, fb;
  NaPair pa = mkpair(0), pb;
  na_load(fa, KN, VT, vt_base, h, fr, fq, pa);
  const float* bias_h = bias_lds + h * 465;
#define NA_DO(F, PR, PI)                                                                                          \
  {                                                                                                               \
    const bool loc_ = (PI) < nlp;                                                                                 \
    na_compute(F, qa0, qa1, loc_, (unsigned)(PR.kr0 - rsa) < 8u, (unsigned)(PR.kr1 - rsa) < 8u,                   \
               PR.kr0 - qra + 7, PR.kr1 - qra + 7, PR.ct0, PR.ct1, qc, fq, bias_h, Oa, lsa);                      \
    na_compute(F, qb0, qb1, loc_, (unsigned)(PR.kr0 - rsb) < 8u, (unsigned)(PR.kr1 - rsb) < 8u,                   \
               PR.kr0 - qrb + 7, PR.kr1 - qrb + 7, PR.ct0, PR.ct1, qc, fq, bias_h, Ob, lsb);                      \
  }
  for (int pi = 0; pi < npair; pi += 2) {
    pb = mkpair(min(pi + 1, npair - 1)); na_load(fb, KN, VT, vt_base, h, fr, fq, pb);
    NA_DO(fa, pa, pi)
    pa = mkpair(min(pi + 2, npair - 1)); na_load(fa, KN, VT, vt_base, h, fr, fq, pa);
    if (pi + 1 < npair) NA_DO(fb, pb, pi + 1)
  }
#undef NA_DO
  lsa += shfl_xor_l(lsa, 16, lane); lsa += shfl_xor_l(lsa, 32, lane);
  lsb += shfl_xor_l(lsb, 16, lane); lsb += shfl_xor_l(lsb, 32, lane);
  const float ia = 1.f / lsa, ib = 1.f / lsb;
#pragma unroll
  for (int dt = 0; dt < 4; ++dt) {
    *(bf16x4*)(CC + (size_t)(mqa + fr) * 1024 + h * 64 + dt * 16 + fq * 4) = pack4(Oa[dt][0] * ia, Oa[dt][1] * ia, Oa[dt][2] * ia, Oa[dt][3] * ia);
    *(bf16x4*)(CC + (size_t)(mqb + fr) * 1024 + h * 64 + dt * 16 + fq * 4) = pack4(Ob[dt][0] * ib, Ob[dt][1] * ib, Ob[dt][2] * ib, Ob[dt][3] * ib);
  }
}

__device__ __forceinline__ void phase_mix(PP pp, int l, int bid, int nb, char* smem) {
  const int tid = tid_opaque();
  const int nscan_blocks = (nb > 32) ? 32 : nb;
  const int first_attn_block = (nb > 32) ? 32 : 0;
  if (bid < nscan_blocks) {
    for (int c = bid; c < NCHAIN; c += nscan_blocks) chunk_seq_chain(pp, c, smem);
  }
  if (bid >= first_attn_block) {
    float* bias = (float*)smem + 64;
    __syncthreads();
    for (int i = tid; i < 8 * 465 + 128; i += NTHR) { const int j = i - 64; bias[j] = ((unsigned)j < 8u * 465u) ? p.na_rpb[(size_t)l * 8 * 465 + j] * 1.4426950408889634f : 0.f; }
    __syncthreads();
    const int ntask = (l == 0) ? 1024 + 16 : 1024;
    const int nab = nb - first_attn_block;
    for (int t = bid - first_attn_block; t < ntask; t += nab) na_block_task(pp, t, bias);
    __syncthreads();
    phase_convert(pp, l, 1, bid - first_attn_block, nab, smem);
    if (l == 0) phase_convert(pp, 1, 0, bid - first_attn_block, nab, smem);
  }
}

__device__ __forceinline__ void phase_post(PP pp, int l, int bid, int nb) {
  const int tid = tid_opaque(), lane = tid & 63, wv = wave_id(tid);
  char* S = p.ws + OFF_S;
  const bfr* YRW = (const bfr*)(S + S_YRW);
  const bfr* YGD = (const bfr*)(S + S_YGD);
  const bfr* RWV = (const bfr*)(S + S_RWV);
  const bfr* RWG = (const bfr*)(S + S_RWG);
  const float* BON = (const float*)(S + S_BON);
  const bfr* P = (const bfr*)(p.ws + OFF_P);
  bfr* CC = (bfr*)(p.ws + OFF_CC);
  const float* ln_w = p.rw_ln_w + (size_t)l * 256;
  const float* ln_b = p.rw_ln_b + (size_t)l * 256;
  const float* ng = p.gd_norm_g + (size_t)l * 64;
  const int ntok = (l == 0) ? NTOK : NLAT;
  const int cb = lane * 4, hh = lane >> 4;
  const f32x4 lw4 = *(const f32x4*)(ln_w + cb), lb4 = *(const f32x4*)(ln_b + cb), ng4 = *(const f32x4*)(ng + (cb & 63));
  for (int m = bid * 8 + wv; m < ntok; m += nb * 8) {
    const size_t o = (size_t)m * 256 + cb;
    const f32x4 y0 = ldbf4(YRW + o), y1 = ldbf4(YRW + (size_t)NTOK * 256 + o);
    const f32x4 rv = ldbf4(RWV + o), rg = ldbf4(RWG + o);
    const f32x4 g0 = ldbf4(YGD + o), g1 = ldbf4(YGD + (size_t)NTOK * 256 + o);
    const f32x4 z = ldbf4(P + (size_t)m * PINP + B_END + 768 + cb);
    const float bon = BON[(size_t)m * 4 + hh];
    {
      const f32x4 y = y0 + y1;
      const float mean = row16_sum((y[0] + y[1]) + (y[2] + y[3])) * (1.f / 64.f);
      const f32x4 dv = y - mean;
      const float var = row16_sum((dv[0] * dv[0] + dv[1] * dv[1]) + (dv[2] * dv[2] + dv[3] * dv[3])) * (1.f / 64.f);
      const f32x4 out = ((dv * rsqrtf(var + 64e-5f)) * lw4 + lb4 + rv * bon) * rg;
      *(bf16x4*)(CC + (size_t)m * 1024 + 512 + cb) = pack4(out[0], out[1], out[2], out[3]);
    }
    {
      const f32x4 y = g0 + g1;
      const float ms = row16_sum((y[0] * y[0] + y[1] * y[1]) + (y[2] * y[2] + y[3] * y[3])) * (1.f / 64.f);
      const f32x4 sz = {siluf_(z[0]), siluf_(z[1]), siluf_(z[2]), siluf_(z[3])};
      const f32x4 out = (y * rsqrtf(ms + 1e-6f)) * ng4 * sz;
      *(bf16x4*)(CC + (size_t)m * 1024 + 768 + cb) = pack4(out[0], out[1], out[2], out[3]);
    }
  }
}

#define RW_LDS_ROW 36
__device__ __forceinline__ void phase_router(PP pp, int l, int bid, int nb, char* smem) {
  const int tid = tid_opaque(), lane = tid & 63, wv = wave_id(tid);
  const float* xl = p.out;
  const float* xc = (const float*)(p.ws + OFF_CTX);
  const float* mods = (const float*)(p.ws + OFF_MODS) + (size_t)l * 3 * 6144;
  const float* g = p.norm_ffn_g + (size_t)l * 1024;
  const float* rw = p.moe_router_w + (size_t)l * 1024 * 32;
  const float* rb = p.moe_router_b + (size_t)l * 32;
  bfr* H = (bfr*)(p.ws + OFF_H);
  int* cnt = (int*)(p.ws + OFF_CNT);
  int* TOKE = (int*)(p.ws + OFF_TOKE);
  int* TOKP = (int*)(p.ws + OFF_TOKP);
  float* TOKG = (float*)(p.ws + OFF_TOKG);
  float* wl = (float*)smem;
  for (int i = tid; i < 1024 * 8; i += NTHR) {
    int d = i >> 3, q = i & 7;
    *(float4*)(wl + d * RW_LDS_ROW + q * 4) = *(const float4*)(rw + (size_t)d * 32 + q * 4);
  }
  __syncthreads();
  const int ntok = (l == 0) ? NTOK : NLAT;
  const float rbl = rb[lane & 31];
  int* lcnt = (int*)(smem + 147456 + 512);
  if (tid < 32) lcnt[tid] = 0;
  char* stg = smem + 147456 + 3072 + wv * 1024;
  __syncthreads();
  float gch[16];
#pragma unroll
  for (int i = 0; i < 16; ++i) gch[i] = g[lane + 64 * i];
  const int mstride = nb * 16;
  int m0 = (bid * 8 + wv) * 2;
  float xa[16], xb[16];
  {
    const int mc = min(m0, ntok - 2);
    const float* pa = (mc < NLAT) ? xl + (size_t)mc * 1024 : xc + (size_t)(mc - NLAT) * 1024;
    const float* pb = (mc + 1 < NLAT) ? xl + (size_t)(mc + 1) * 1024 : xc + (size_t)(mc + 1 - NLAT) * 1024;
#pragma unroll
    for (int i = 0; i < 16; ++i) { xa[i] = pa[lane + 64 * i]; xb[i] = pb[lane + 64 * i]; }
  }
  for (; m0 < ntok; m0 += mstride) {
    float acc0[32], acc1[32];
#pragma unroll
    for (int e = 0; e < 32; ++e) { acc0[e] = 0.f; acc1[e] = 0.f; }
    float hv0[16], hv1[16];
    {
      const int ma = m0, mb = m0 + 1;
      const float* mda = mods + (size_t)mod_row(ma) * 6144 + 3072;
      float scv[16], shv[16];
#pragma unroll
      for (int i = 0; i < 16; ++i) { scv[i] = mda[1024 + lane + 64 * i]; shv[i] = mda[lane + 64 * i]; }
#pragma unroll
      for (int i = 0; i < 16; ++i) { hv0[i] = xa[i]; hv1[i] = xb[i]; }
      asm volatile("" ::: "memory");
      {
        const int mc = min(m0 + mstride, ntok - 2);
        const float* pa = (mc < NLAT) ? xl + (size_t)mc * 1024 : xc + (size_t)(mc - NLAT) * 1024;
        const float* pb = (mc + 1 < NLAT) ? xl + (size_t)(mc + 1) * 1024 : xc + (size_t)(mc + 1 - NLAT) * 1024;
#pragma unroll
        for (int i = 0; i < 16; ++i) { xa[i] = pa[lane + 64 * i]; xb[i] = pb[lane + 64 * i]; }
      }
      asm volatile("" ::: "memory");
      float ssa = 0.f, ssb = 0.f;
#pragma unroll
      for (int i = 0; i < 16; ++i) { ssa += hv0[i] * hv0[i]; ssb += hv1[i] * hv1[i]; }
      ssa = wave_sum(ssa); ssb = wave_sum(ssb);
      const float rsa = rsqrtf(ssa * (1.f / 1024.f) + 1e-6f), rsb = rsqrtf(ssb * (1.f / 1024.f) + 1e-6f);
#pragma unroll
      for (int i = 0; i < 16; ++i) {
        const float gm = gch[i] * (1.f + scv[i]);
        hv0[i] = hv0[i] * rsa * gm + shv[i];
        hv1[i] = hv1[i] * rsb * gm + shv[i];
      }
      float am0 = 0.f, am1 = 0.f;
#pragma unroll
      for (int i = 0; i < 16; ++i) { am0 = fmaxf(am0, fabsf(hv0[i])); am1 = fmaxf(am1, fabsf(hv1[i])); }
      am0 = wave_max(am0); am1 = wave_max(am1);
      const float sc0 = am0 > 0.f ? am0 * (1.f / 127.f) : 1.f, sc1 = am1 > 0.f ? am1 * (1.f / 127.f) : 1.f;
      const float iv0 = 1.f / sc0, iv1 = 1.f / sc1;
      signed char* H8 = (signed char*)(p.ws + OFF_H);
#pragma unroll
      for (int i = 0; i < 16; ++i) stg[lane + 64 * i] = (signed char)(int)fminf(fmaxf(rintf(hv0[i] * iv0), -127.f), 127.f);
      const uint4 rowa = *(const uint4*)(stg + lane * 16);
      *(uint4*)(H8 + (size_t)ma * 1024 + lane * 16) = rowa;
#pragma unroll
      for (int i = 0; i < 16; ++i) stg[lane + 64 * i] = (signed char)(int)fminf(fmaxf(rintf(hv1[i] * iv1), -127.f), 127.f);
      const uint4 rowb = *(const uint4*)(stg + lane * 16);
      *(uint4*)(H8 + (size_t)mb * 1024 + lane * 16) = rowb;
      if (lane == 0) { float* SCL = (float*)(p.ws + OFF_SCL); SCL[ma] = sc0; SCL[mb] = sc1; }
      asm volatile("" ::: "memory");
    }
#pragma unroll
    for (int i = 0; i < 16; ++i) {
      if ((i & 3) == 0) asm volatile("" ::: "memory");
      const float* wr = wl + (lane + 64 * i) * RW_LDS_ROW;
#pragma unroll
      for (int q = 0; q < 8; ++q) {
        const float4 w = *(const float4*)(wr + q * 4);
        acc0[q * 4 + 0] += hv0[i] * w.x; acc0[q * 4 + 1] += hv0[i] * w.y; acc0[q * 4 + 2] += hv0[i] * w.z; acc0[q * 4 + 3] += hv0[i] * w.w;
        acc1[q * 4 + 0] += hv1[i] * w.x; acc1[q * 4 + 1] += hv1[i] * w.y; acc1[q * 4 + 2] += hv1[i] * w.z; acc1[q * 4 + 3] += hv1[i] * w.w;
      }
    }
#define BFLY(A, N, D)                                                                           \
    _Pragma("unroll") for (int i = 0; i < (N); ++i) {                                            \
      const bool up = (lane & (D)) != 0;                                                         \
      const float keep = up ? A[i + (N)] : A[i];                                                 \
      const float send = up ? A[i] : A[i + (N)];                                                 \
      A[i] = keep + shfl_xor_l(send, (D), lane);                                                   \
    }
    BFLY(acc0, 16, 16) BFLY(acc1, 16, 16)
    BFLY(acc0, 8, 8) BFLY(acc1, 8, 8)
    BFLY(acc0, 4, 4) BFLY(acc1, 4, 4)
    BFLY(acc0, 2, 2) BFLY(acc1, 2, 2)
    BFLY(acc0, 1, 1) BFLY(acc1, 1, 1)
#undef BFLY
    float la = acc0[0] + shfl_xor_l(acc0[0], 32, lane);
    float lb = acc1[0] + shfl_xor_l(acc1[0], 32, lane);
    const int my_e = lane & 31;
    la += rbl; lb += rbl;
    (void)my_e;
#pragma unroll
    for (int tkn = 0; tkn < 2; ++tkn) {
      float v = tkn == 0 ? la : lb;
      float tv[4]; int ti[4];
#pragma unroll
      for (int k = 0; k < 4; ++k) {
        float bv = v; int bi = lane & 31;
#pragma unroll
        for (int o = 16; o >= 1; o >>= 1) {
          float ov = shfl_xor_l(bv, o, lane); int oi = shfl_xor_li(bi, o, lane);
          bool take = (ov > bv) || (ov == bv && oi < bi);
          bv = take ? ov : bv; bi = take ? oi : bi;
        }
        tv[k] = bv; ti[k] = bi;
        if ((lane & 31) == bi) v = -3.0e38f;
      }
      float e1 = __expf(tv[1] - tv[0]), e2 = __expf(tv[2] - tv[0]), e3 = __expf(tv[3] - tv[0]);
      float inv = 1.f / (1.f + e1 + e2 + e3);
      const int m = m0 + tkn;
      if (lane < 4) {
        int e = lane == 0 ? ti[0] : lane == 1 ? ti[1] : lane == 2 ? ti[2] : ti[3];
        float gt = (lane == 0 ? 1.f : lane == 1 ? e1 : lane == 2 ? e2 : e3) * inv;
        int pos = atomicAdd(&lcnt[e], 1);
        TOKE[(size_t)m * 4 + lane] = e; TOKP[(size_t)m * 4 + lane] = pos; TOKG[(size_t)m * 4 + lane] = gt;
      }
    }
  }
  __syncthreads();
  if (tid < 32) ((int*)(p.ws + OFF_BASE))[bid * 32 + tid] = atomicAdd(&cnt[tid], lcnt[tid]);
  __syncthreads();
}

__device__ __forceinline__ void moe_offsets(PP pp, int* toff) {
  const int* cnt = (const int*)(p.ws + OFF_CNT);
  if (tid_opaque() == 0) {
    int a = 0;
    for (int e = 0; e < 32; ++e) { const int c = cnt[e]; toff[e] = a; toff[96 + e] = c; a += (c + 255) >> 8; }
    toff[32] = a;
  }
  __syncthreads();
}
__device__ __forceinline__ void moe_tile_experts(int* toff) {
  int* texp = toff + 128;
  const int ntile = toff[32];
  for (int mt = tid_opaque(); mt < ntile; mt += NTHR) {
    int e = 0;
#pragma unroll 1
    for (int k = 1; k < 32; ++k) e = (mt >= toff[k]) ? k : e;
    texp[mt] = e;
  }
  __syncthreads();
}

__device__ __forceinline__ void phase_slotfill(PP pp, int l, int bid, int nb, char* smem) {
  int* toff = (int*)smem;
  moe_offsets(pp, toff);
  const int tid = tid_opaque(), lane = tid & 63, wv = wave_id(tid);
  const int* TOKE = (const int*)(p.ws + OFF_TOKE);
  const int* TOKP = (const int*)(p.ws + OFF_TOKP);
  const float* TOKG = (const float*)(p.ws + OFF_TOKG);
  const int* cnt = (const int*)(p.ws + OFF_CNT);
  int* TOKS = (int*)(p.ws + OFF_TOKS);
  float* SLG = (float*)(p.ws + OFF_SLG);
  float* SLS = (float*)(p.ws + OFF_SLS);
  const float* SCL = (const float*)(p.ws + OFF_SCL);
  const signed char* H8 = (const signed char*)(p.ws + OFF_H);
  signed char* XG = (signed char*)(p.ws + OFF_S);
  const int n = ((l == 0) ? NTOK : NLAT) * 4;
  int* SLT = (int*)(p.ws + OFF_SLT);
  for (int i = bid * NTHR + tid; i < n; i += nb * NTHR) {
    const int e = TOKE[i];
    const int blk = (((i >> 2) >> 1) % (nb * 8)) >> 3;
    const int slot = toff[e] * 256 + ((const int*)(p.ws + OFF_BASE))[blk * 32 + e] + TOKP[i];
    TOKS[i] = slot; SLT[slot] = i >> 2; SLG[slot] = TOKG[i]; SLS[slot] = SCL[i >> 2];
  }
  for (int gi = bid * NTHR + tid; gi < 32 * 256; gi += nb * NTHR) {
    const int e = gi >> 8, r = gi & 255;
    const int c = toff[96 + e];
    const int npad = ((c + 255) & ~255) - c;
    if (r < npad) { const int base = toff[e] * 256 + c; SLT[base + r] = 0; SLS[base + r] = 0.f; }
  }
  __syncthreads();
}

struct EpiMoe1 {
  const float* bgu; const float* sw; const float* SLS; bfr* ACT;
  __device__ __forceinline__ void operator()(const i32x4 (&acc)[2][2][4][2], const g8::GUnit& u, int wr, int wc, int fr, int fq) const {
    const float* be = bgu + (size_t)u.e * 2048;
    const float* se = sw + (size_t)u.e * 2048;
    const int slot0 = u.pm * 256 + wr * 64 + fr;
    float sav[2][4];
#pragma unroll
    for (int ai = 0; ai < 2; ++ai)
#pragma unroll
      for (int m = 0; m < 4; ++m) sav[ai][m] = SLS[slot0 + ai * 128 + m * 16];
    const int j0 = u.pn * 128 + wc * 32 + fq * 8;
    f32x4 bgv[2], blv[2], sgv[2], slv[2];
#pragma unroll
    for (int bj = 0; bj < 2; ++bj) {
      bgv[bj] = *(const f32x4*)(be + j0 + bj * 4); blv[bj] = *(const f32x4*)(be + 1024 + j0 + bj * 4);
      sgv[bj] = *(const f32x4*)(se + j0 + bj * 4); slv[bj] = *(const f32x4*)(se + 1024 + j0 + bj * 4);
    }
#pragma unroll
    for (int ai = 0; ai < 2; ++ai)
#pragma unroll
      for (int m = 0; m < 4; ++m) {
        const int slot = slot0 + ai * 128 + m * 16;
        const float sa = sav[ai][m];
        f32x4 ov[2];
#pragma unroll
        for (int bj = 0; bj < 2; ++bj) {
          const f32x4 bg = bgv[bj], bl = blv[bj];
          const f32x4 sg = sgv[bj], sl = slv[bj];
#pragma unroll
          for (int q = 0; q < 4; ++q) {
            const float g = (float)acc[ai][bj][m][0][q] * (sa * sg[q]) + bg[q];
            const float li = (float)acc[ai][bj][m][1][q] * (sa * sl[q]) + bl[q];
            const float gv = fminf(g, 7.f);
            const float lv = fminf(fmaxf(li, -7.f), 7.f);
            ov[bj][q] = gv * sigmoidf_(1.702f * gv) * (lv + 1.f);
          }
        }
        *(bf16x8*)(ACT + (size_t)slot * 1024 + j0) = pack8(ov[0], ov[1]);
      }
  }
};
__device__ __forceinline__ void phase_moe1_impl(PP pp, int l, int bid, int nb, char* smem, int* toff) {
  moe_offsets(pp, toff);
  moe_tile_experts(toff);
  g8::MoeSched S{toff, 8, 2048, nb, bid};
  EpiMoe1 E{p.moe_b_gu + (size_t)l * 32 * 2048, (const float*)(p.ws + OFF_SW) + (size_t)l * 32 * 2048, (const float*)(p.ws + OFF_SLS), (bfr*)(p.ws + OFF_P)};
  g8::gemm_stream<true, true>((LAS unsigned char*)smem, p.ws + OFF_H, p.ws + OFF_W + (size_t)l * WL_SIZE + WL_GU, S, E, (const int*)(p.ws + OFF_SLT));
}

struct EpiMoe2 {
  const float* bdn; const float* SLG; bfr* YS;
  __device__ __forceinline__ void operator()(const f32x4 (&acc)[2][2][4][2], const g8::GUnit& u, int wr, int wc, int fr, int fq) const {
    const float* be = bdn + (size_t)u.e * 1024;
    const int slot0 = u.pm * 256 + wr * 64 + fr, col0 = u.pn * 256 + wc * 32 + 8 * fq;
    float gtv[2][4];
#pragma unroll
    for (int ai = 0; ai < 2; ++ai)
#pragma unroll
      for (int m = 0; m < 4; ++m) gtv[ai][m] = SLG[slot0 + ai * 128 + m * 16];
    f32x4 bvv[2][2];
#pragma unroll
    for (int bj = 0; bj < 2; ++bj)
#pragma unroll
      for (int n = 0; n < 2; ++n) bvv[bj][n] = *(const f32x4*)(be + col0 + bj * 128 + n * 4);
#pragma unroll
    for (int ai = 0; ai < 2; ++ai)
#pragma unroll
      for (int m = 0; m < 4; ++m) {
        const int slot = slot0 + ai * 128 + m * 16;
        const float gt = gtv[ai][m];
#pragma unroll
        for (int bj = 0; bj < 2; ++bj) {
          const f32x4 y0 = (acc[ai][bj][m][0] + bvv[bj][0]) * gt;
          const f32x4 y1 = (acc[ai][bj][m][1] + bvv[bj][1]) * gt;
          *(bf16x8*)(YS + (size_t)slot * 1024 + col0 + bj * 128) = pack8(y0, y1);
        }
      }
  }
};
__device__ __forceinline__ void phase_moe2_impl(PP pp, int l, int bid, int nb, char* smem, int* toff) {
  moe_offsets(pp, toff);
  moe_tile_experts(toff);
  g8::MoeSched S{toff, 4, 1024, nb, bid};
  EpiMoe2 E{p.moe_b_down + (size_t)l * 32 * 1024, (const float*)(p.ws + OFF_SLG), (bfr*)(p.ws + OFF_S)};
  g8::gemm_stream<false, false>((LAS unsigned char*)smem, p.ws + OFF_P, p.ws + OFF_W + (size_t)l * WL_SIZE + WL_DN, S, E);
}

__device__ __forceinline__ void phase_combine(PP pp, int l, int bid, int nb) {
  const int tid = tid_opaque(), lane = tid & 63, wv = wave_id(tid);
  const bfr* YS = (const bfr*)(p.ws + OFF_S);
  const int* TOKS = (const int*)(p.ws + OFF_TOKS);
  const float* mods = (const float*)(p.ws + OFF_MODS) + (size_t)l * 3 * 6144;
  const float* mods1 = (const float*)(p.ws + OFF_MODS) + (size_t)3 * 6144;
  const float* g1n = p.norm_mix_g + 1024;
  bfr* H = (bfr*)(p.ws + OFF_H);
  float* xl = p.out;
  float* xc = (float*)(p.ws + OFF_CTX);
  const int ntok = (l == 0) ? NTOK : NLAT;
  if (l == 0) {
    int* cnt = (int*)(p.ws + OFF_CNT);
    const int gt = bid * NTHR + tid;
    if (gt < 32) cnt[gt] = 0;
  }
  for (int m = bid * 8 + wv; m < ntok; m += nb * 8) {
    float* xr = (m < NLAT) ? xl + (size_t)m * 1024 : xc + (size_t)(m - NLAT) * 1024;
    const float* g2 = mods + (size_t)mod_row(m) * 6144 + 5120;
    const int s0 = TOKS[(size_t)m * 4], s1 = TOKS[(size_t)m * 4 + 1], s2 = TOKS[(size_t)m * 4 + 2], s3 = TOKS[(size_t)m * 4 + 3];
    float4 xn[4];
    float ss = 0.f;
#pragma unroll
    for (int i = 0; i < 4; ++i) {
      const int d = (lane + 64 * i) * 4;
      const bf16x4 a = *(const bf16x4*)(YS + (size_t)s0 * 1024 + d);
      const bf16x4 b = *(const bf16x4*)(YS + (size_t)s1 * 1024 + d);
      const bf16x4 c = *(const bf16x4*)(YS + (size_t)s2 * 1024 + d);
      const bf16x4 e = *(const bf16x4*)(YS + (size_t)s3 * 1024 + d);
      const float4 gg = *(const float4*)(g2 + d);
      float4 xv = *(const float4*)(xr + d);
      xv.x += gg.x * ((bf2f(a[0]) + bf2f(b[0])) + (bf2f(c[0]) + bf2f(e[0])));
      xv.y += gg.y * ((bf2f(a[1]) + bf2f(b[1])) + (bf2f(c[1]) + bf2f(e[1])));
      xv.z += gg.z * ((bf2f(a[2]) + bf2f(b[2])) + (bf2f(c[2]) + bf2f(e[2])));
      xv.w += gg.w * ((bf2f(a[3]) + bf2f(b[3])) + (bf2f(c[3]) + bf2f(e[3])));
      *(float4*)(xr + d) = xv;
      xn[i] = xv;
      ss += xv.x * xv.x + xv.y * xv.y + xv.z * xv.z + xv.w * xv.w;
    }
    if (l == 0) {
      ss = wave_sum(ss);
      const float rs = rsqrtf(ss * (1.f / 1024.f) + 1e-6f);
      const float* md = mods1 + (size_t)mod_row(m) * 6144;
      float4 hq[4];
#pragma unroll
      for (int i = 0; i < 4; ++i) {
        const int d = (lane + 64 * i) * 4;
        const float4 gg = *(const float4*)(g1n + d);
        const float4 sh = *(const float4*)(md + d);
        const float4 sc = *(const float4*)(md + 1024 + d);
        hq[i] = make_float4(xn[i].x * rs * gg.x * (1.f + sc.x) + sh.x, xn[i].y * rs * gg.y * (1.f + sc.y) + sh.y,
                            xn[i].z * rs * gg.z * (1.f + sc.z) + sh.z, xn[i].w * rs * gg.w * (1.f + sc.w) + sh.w);
      }
      const float qs = quant_row_store(hq, (signed char*)(p.ws + OFF_H) + (size_t)m * 1024, lane);
      if (lane == 0) ((float*)(p.ws + OFF_SCL))[m] = qs;
    }
  }
}

#define XB_TMO      128
#define XB_XCNT(j)  (256  + 64 * (j))
#define XB_XSUB(j)  (1280 + 64 * (j))
#define XB_XGEN(j)  (2304 + 64 * (j))
#define XB_TOP      3328
#define XB_TOPGEN   3392
#define XCD_BAR_WORDS 3456
#define XB_SPIN_CAP (1u << 22)
__device__ __forceinline__ unsigned xb_ld(unsigned* q) { return __hip_atomic_load(q, __ATOMIC_RELAXED, __HIP_MEMORY_SCOPE_AGENT); }
__device__ __forceinline__ unsigned xb_add(unsigned* q, unsigned v) { return __hip_atomic_fetch_add(q, v, __ATOMIC_RELAXED, __HIP_MEMORY_SCOPE_AGENT); }
__device__ __forceinline__ unsigned xb_xcc_id() { return (unsigned)__builtin_amdgcn_s_getreg((3 << 11) | 20) & 0xFu; }
#define XB_SPIN(cond, bar) do { unsigned _sp = 0; while (cond) { __builtin_amdgcn_s_sleep(1); \
    if ((++_sp & 255u) == 0u) { if (xb_ld(&(bar)[XB_TMO])) break; if (_sp > XB_SPIN_CAP) { atomicAdd(&(bar)[XB_TMO], 1u); break; } } } } while (0)
struct XcdBarrier { unsigned* bar; unsigned x; volatile LAS unsigned* st; };
__device__ __forceinline__ XcdBarrier xcd_barrier_post(unsigned* bar, volatile LAS unsigned* st) {
  XcdBarrier b; b.bar = bar; b.x = xb_xcc_id(); b.st = st;
  if (tid_opaque() == 0) (void)xb_add(&bar[XB_XCNT(b.x)], 1u);
  return b;
}
__device__ __forceinline__ void xcd_barrier_complete(unsigned* bar, unsigned x, unsigned& nloc, unsigned& nx) {
  const unsigned G = gridDim.x;
  unsigned sum, cnt, mine, sp = 0u;
  for (;;) {
    sum = 0u; cnt = 0u; mine = 0u;
#pragma unroll
    for (unsigned j = 0; j < 16; ++j) { const unsigned c = xb_ld(&bar[XB_XCNT(j)]); sum += c; cnt += (c > 0u) ? 1u : 0u; mine = (j == x) ? c : mine; }
    if (sum == G) break;
    __builtin_amdgcn_s_sleep(1);
    if ((++sp & 255u) == 0u) { if (xb_ld(&bar[XB_TMO])) break; if (sp > XB_SPIN_CAP) { atomicAdd(&bar[XB_TMO], 1u); break; } }
  }
  nloc = mine > 0u ? mine : 1u; nx = cnt > 0u ? cnt : 1u;
}
__device__ __forceinline__ void xcd_barrier(const XcdBarrier& b) {
  asm volatile("s_waitcnt vmcnt(0)" ::: "memory");
  __syncthreads();
  if (tid_opaque() == 0) {
    unsigned* bar = b.bar;
    __builtin_amdgcn_s_waitcnt(0);
    unsigned nloc = b.st[0], nx = b.st[1];
    if (nloc == 0u) { xcd_barrier_complete(bar, b.x, nloc, nx); b.st[0] = nloc; b.st[1] = nx; }
    const unsigned old = xb_add(&bar[XB_XSUB(b.x)], 1u);
    const unsigned gen = old / nloc;
    if (old + 1u == (gen + 1u) * nloc) {
      __builtin_amdgcn_fence(__ATOMIC_RELEASE, "agent");
      asm volatile("s_waitcnt vmcnt(0)" ::: "memory");
      const unsigned og = xb_add(&bar[XB_TOP], 1u);
      const unsigned tg = og / nx;
      if (og + 1u == (tg + 1u) * nx) xb_add(&bar[XB_TOPGEN], 1u);
      else XB_SPIN(xb_ld(&bar[XB_TOPGEN]) == tg, bar);
      __builtin_amdgcn_fence(__ATOMIC_ACQUIRE, "agent");
      xb_add(&bar[XB_XGEN(b.x)], 1u);
      asm volatile("s_waitcnt vmcnt(0)" ::: "memory");
    } else {
      XB_SPIN(xb_ld(&bar[XB_XGEN(b.x)]) == gen, bar);
      __builtin_amdgcn_fence(__ATOMIC_ACQUIRE, "agent");
      asm volatile("s_waitcnt vmcnt(0)" ::: "memory");
    }
  }
  __syncthreads();
}

extern __shared__ __attribute__((aligned(16))) char dyn_smem[];

__global__ void __launch_bounds__(NTHR) mega(Params p_unused) {
  cg::grid_group grid = cg::this_grid();
  const int bid0 = blockIdx.x, nb0 = gridDim.x;
#if defined(__HIP_DEVICE_COMPILE__)
  PP pp0 = (PP)__builtin_amdgcn_kernarg_segment_ptr();
#else
  PP pp0 = nullptr;
#endif
#define pp ({ PP q_ = pp0; asm volatile("" : "+s"(q_)); q_; })
#define bid opq(bid0)
#define nb opq(nb0)
  int* toff_s = (int*)(dyn_smem + 147456);
  volatile LAS unsigned* xb_st = (volatile LAS unsigned*)(dyn_smem + 147456 + 256);
  {
    unsigned* barw = (unsigned*)(fresh_ws(pp0) + OFF_BAR);
    if (blockIdx.x == 0) for (int i = threadIdx.x; i < XCD_BAR_WORDS; i += NTHR) barw[i] = 0u;
    if (threadIdx.x == 0) { xb_st[0] = 0u; xb_st[1] = 0u; }
  }
  grid.sync();
  const XcdBarrier xb = xcd_barrier_post((unsigned*)(fresh_ws(pp0) + OFF_BAR), xb_st);
#define GSYNC() xcd_barrier(xb)
  phase_ada(pp, bid, nb, dyn_smem);
  phase_convert(pp, 0, 0, bid, nb, dyn_smem);
  GSYNC();
#define LAYER(LV, LAST)                                      \
  {                                                          \
    if ((LV) == 0) { phase_prenorm(pp, opq(LV), bid, nb); GSYNC(); } \
    phase_gemm_in(pp, opq(LV), bid, nb, dyn_smem);           \
    GSYNC();                                                 \
    phase_prep(pp, opq(LV), bid, nb, dyn_smem);              \
    GSYNC();                                                 \
    phase_chunk_prep(pp, bid, nb, dyn_smem);                 \
    GSYNC();                                                 \
    phase_mix(pp, opq(LV), bid, nb, dyn_smem);               \
    GSYNC();                                                 \
    phase_post(pp, opq(LV), bid, nb);                        \
    GSYNC();                                                 \
    phase_gemm_out(pp, opq(LV), bid, nb, dyn_smem);          \
    GSYNC();                                                 \
    phase_router(pp, opq(LV), bid, nb, dyn_smem);            \
    GSYNC();                                                 \
    phase_slotfill(pp, opq(LV), bid, nb, dyn_smem);          \
    GSYNC();                                                 \
    phase_moe1_impl(pp, opq(LV), bid, nb, dyn_smem, toff_s); \
    GSYNC();                                                 \
    phase_moe2_impl(pp, opq(LV), bid, nb, dyn_smem, toff_s); \
    GSYNC();                                                 \
    phase_combine(pp, opq(LV), bid, nb);                     \
    if (!(LAST)) GSYNC();                                    \
  }
  LAYER(0, false)
  LAYER(1, true)
#undef LAYER
#undef GSYNC
#undef bid
#undef nb
#undef pp
}

#undef p
extern "C" void kernel_launch(void* const* d_in, const int* in_sizes, int n_in, void* d_out, int out_size, void* d_ws,
                              size_t ws_size, hipStream_t stream) {
  Params hp{};
  const float** pp = (const float**)&hp;
  for (int i = 0; i < 34; ++i) pp[i] = (const float*)d_in[i];
  hp.out = (float*)d_out;
  hp.ws = (char*)d_ws;
  static int grid_blocks = 0;
  if (!grid_blocks) {
    (void)hipFuncSetAttribute((const void*)mega, hipFuncAttributeMaxDynamicSharedMemorySize, LDS_BYTES);
    int dev = 0, cus = 0, per_cu = 0;
    (void)hipGetDevice(&dev);
    (void)hipDeviceGetAttribute(&cus, hipDeviceAttributeMultiprocessorCount, dev);
    (void)hipOccupancyMaxActiveBlocksPerMultiprocessor(&per_cu, mega, NTHR, LDS_BYTES);
    if (per_cu < 1) per_cu = 1;
    if (per_cu > 1) per_cu = 1;
    grid_blocks = cus * per_cu;
  }
  void* args[] = {&hp};
  (void)hipLaunchCooperativeKernel((void*)mega, dim3(grid_blocks), dim3(NTHR), args, LDS_BYTES, stream);
}
```

```cpp
#include <hip/hip_runtime.h>
#include <hip/hip_bf16.h>
#include <hip/hip_cooperative_groups.h>
#include <stdint.h>
#include <type_traits>
namespace cg = cooperative_groups;

typedef __attribute__((ext_vector_type(8))) short bf16x8;
typedef __attribute__((ext_vector_type(4))) short bf16x4;
typedef __attribute__((ext_vector_type(4))) float f32x4;
typedef __attribute__((ext_vector_type(4))) int i32x4;
typedef unsigned short bfr;

#define D_MODEL 1024
#define NB 2
#define SEQ 16384
#define CTXL 256
#define NLAT (NB * SEQ)
#define NCTX (NB * CTXL)
#define NTOK (NLAT + NCTX)
#define TTOK (SEQ + CTXL)
#define PIN 3472
#define PINP 3584
#define A_END 1536
#define B_END 2432
#define NEXP 32
#define NSLOT_MAX (NTOK * 4 + NEXP * 256)
#define NTHR 512
#define LDS_BYTES (147456 + 3072 + 8192)

constexpr size_t al256(size_t x) { return (x + 255) & ~(size_t)255; }
constexpr size_t WL_IN = 0;
constexpr size_t WL_OUT = WL_IN + (size_t)PINP * 1024 * 2;
constexpr size_t WL_GU = WL_OUT + (size_t)1024 * 1024 * 2;
constexpr size_t WL_DN = WL_GU + (size_t)32 * 2048 * 1024 * 2;
constexpr size_t WL_SIZE = WL_DN + (size_t)32 * 1024 * 1024 * 2;
constexpr size_t OFF_W = 0;
constexpr size_t OFF_MODS = al256(OFF_W + 2 * WL_SIZE);
constexpr size_t OFF_BAR = al256(OFF_MODS + 2 * 3 * 6144 * 4);
constexpr size_t OFF_SW = al256(OFF_BAR + 3456 * 4);
constexpr size_t OFF_SWIN = al256(OFF_SW + (size_t)2 * 32 * 2048 * 4);
constexpr size_t OFF_SLS = al256(OFF_SWIN + (size_t)2 * PINP * 4);
constexpr size_t OFF_SCL = al256(OFF_SLS + (size_t)(NTOK * 4 + 32 * 256) * 4);
constexpr size_t OFF_CTX = al256(OFF_SCL + (size_t)NTOK * 4);
constexpr size_t OFF_CNT = al256(OFF_CTX + (size_t)NCTX * 1024 * 4);
constexpr size_t OFF_BASE = al256(OFF_CNT + 256);
constexpr size_t OFF_TOKE = al256(OFF_BASE + (size_t)512 * 32 * 4);
constexpr size_t OFF_TOKP = al256(OFF_TOKE + (size_t)NTOK * 4 * 4);
constexpr size_t OFF_TOKG = al256(OFF_TOKP + (size_t)NTOK * 4 * 4);
constexpr size_t OFF_TOKS = al256(OFF_TOKG + (size_t)NTOK * 4 * 4);
constexpr size_t OFF_SLT = al256(OFF_TOKS + (size_t)NTOK * 4 * 4);
constexpr size_t OFF_SLG = al256(OFF_SLT + (size_t)NSLOT_MAX * 4);
constexpr size_t OFF_H = al256(OFF_SLG + (size_t)NSLOT_MAX * 4);
constexpr size_t OFF_CC = al256(OFF_H + (size_t)NTOK * 1024 * 2);
constexpr size_t OFF_P = al256(OFF_CC + (size_t)NTOK * 1024 * 2);
constexpr size_t OFF_S = al256(OFF_P + (size_t)NTOK * PINP * 4);
constexpr size_t TOK256F = (size_t)NTOK * 256 * 4;
constexpr size_t S_QN = 0;
constexpr size_t S_KN = S_QN + (size_t)NTOK * 512 * 2;
constexpr size_t S_VT = S_KN + (size_t)NTOK * 512 * 2;
constexpr size_t S_RWR = S_VT + (size_t)NB * 8 * 64 * TTOK * 2;
constexpr size_t S_RWKK = S_RWR + TOK256F;
constexpr size_t S_RWV = S_RWKK + TOK256F;
constexpr size_t S_RWG = S_RWV + TOK256F;
constexpr size_t S_RWW = S_RWG + TOK256F;
constexpr size_t S_RWKD = S_RWW + 2 * TOK256F;
constexpr size_t S_RWB = S_RWKD + 2 * TOK256F;
constexpr size_t S_BON = S_RWB + 2 * TOK256F;
constexpr size_t S_GDQ = al256(S_BON + (size_t)NTOK * 4 * 4);
constexpr size_t S_GDK = S_GDQ + TOK256F;
constexpr size_t S_GDV = S_GDK + TOK256F;
constexpr size_t S_GDAB = S_GDV + TOK256F;
constexpr size_t S_YRW = al256(S_GDAB + (size_t)NTOK * 16 * 4);
constexpr size_t S_YGD = S_YRW + 2 * TOK256F;
constexpr size_t S_END = S_YGD + 2 * TOK256F;
constexpr size_t S_SIZE = (S_END > (size_t)NSLOT_MAX * 1024 * 4) ? S_END : (size_t)NSLOT_MAX * 1024 * 4;
constexpr int NCHUNK = TTOK / 64;
constexpr int NCHAIN = 32;
constexpr size_t OFF_CH = al256(OFF_S + S_SIZE);
constexpr size_t CH_N = (size_t)NCHAIN * NCHUNK;
constexpr size_t CH_REC = 32768, CH_PT = 0, CH_RYT = 8192, CH_QT = 16384, CH_YX = 24576;
constexpr size_t CH_SIZE = CH_N * CH_REC;
constexpr size_t WS_TOTAL = OFF_CH + CH_SIZE;
static_assert(WS_TOTAL <= (size_t)2048 * 1024 * 1024, "workspace exceeds 4x largest tensor");

struct Params {
  const float *x, *c, *ctx, *c_ctx, *ada_w, *ada_b, *norm_mix_g, *norm_ffn_g, *w_in, *w_out;
  const float *na_q_gain, *na_k_gain, *na_rpb;
  const float *rw_mu, *rw_w0, *rw_w_up, *rw_a0, *rw_a_up, *rw_g_up, *rw_k_k, *rw_k_a, *rw_r_k, *rw_ln_w, *rw_ln_b;
  const float *gd_conv_w, *gd_A_log, *gd_dt_bias, *gd_norm_g;
  const float *moe_router_w, *moe_router_b, *moe_w_gu, *moe_b_gu, *moe_w_down, *moe_b_down;
  float* out;
  char* ws;
};

typedef const __attribute__((address_space(4))) Params* PP;
#define p (*pp)
__device__ __forceinline__ char* fresh_ws(PP pp) { return p.ws; }
__device__ __forceinline__ int tid_opaque() { int t = (int)__builtin_amdgcn_workitem_id_x(); asm volatile("" : "+v"(t)); return t; }
__device__ __forceinline__ int opq(int x) { asm volatile("" : "+s"(x)); return x; }
__device__ __forceinline__ int wave_id(int tid) { return __builtin_amdgcn_readfirstlane(tid >> 6); }
typedef __bf16 bf16v2_t __attribute__((ext_vector_type(2)));
typedef float f32v2_t __attribute__((ext_vector_type(2)));
__device__ __forceinline__ unsigned pk_bf16(float lo, float hi) { f32v2_t v = {lo, hi}; return __builtin_bit_cast(unsigned, __builtin_convertvector(v, bf16v2_t)); }
__device__ __forceinline__ float dot2bf(unsigned a, unsigned b, float c) { return __builtin_amdgcn_fdot2_f32_bf16(__builtin_bit_cast(bf16v2_t, a), __builtin_bit_cast(bf16v2_t, b), c, false); }
__device__ __forceinline__ bfr f2bf(float f) { return (bfr)(pk_bf16(f, f) & 0xffffu); }
__device__ __forceinline__ float bf2f(short v) { return __uint_as_float(((unsigned)(unsigned short)v) << 16); }
__device__ __forceinline__ bf16x4 pack4(float a, float b, float c, float d) {
  typedef __attribute__((ext_vector_type(2))) unsigned u32x2;
  u32x2 w; w[0] = pk_bf16(a, b); w[1] = pk_bf16(c, d);
  return __builtin_bit_cast(bf16x4, w);
}
__device__ __forceinline__ bf16x8 pack8(f32x4 a, f32x4 b) {
  const bf16x4 lo = pack4(a[0], a[1], a[2], a[3]), hi = pack4(b[0], b[1], b[2], b[3]);
  return __builtin_shufflevector(lo, hi, 0, 1, 2, 3, 4, 5, 6, 7);
}
__device__ __forceinline__ int perm_row32(int n) { return (n & ~31) | (((n >> 2) & 1) << 4) | (((n >> 3) & 3) << 2) | (n & 3); }
__device__ __forceinline__ float sigmoidf_(float x) { return __builtin_amdgcn_rcpf(1.f + __expf(-x)); }
__device__ __forceinline__ float siluf_(float x) { return x * __builtin_amdgcn_rcpf(1.f + __expf(-x)); }
__device__ __forceinline__ float softplusf_(float x) { const float e = __expf(fminf(x, 20.f)); const float lg = __logf(1.f + e); const float r = x < -15.f ? e : lg; return x > 20.f ? x : r; }
__device__ __forceinline__ float wave_sum(float v) {
  v += __builtin_bit_cast(float, __builtin_amdgcn_update_dpp(0, __builtin_bit_cast(int, v), 0xB1, 0xF, 0xF, true));
  v += __builtin_bit_cast(float, __builtin_amdgcn_update_dpp(0, __builtin_bit_cast(int, v), 0x4E, 0xF, 0xF, true));
  v += __builtin_bit_cast(float, __builtin_amdgcn_update_dpp(0, __builtin_bit_cast(int, v), 0x141, 0xF, 0xF, true));
  v += __builtin_bit_cast(float, __builtin_amdgcn_update_dpp(0, __builtin_bit_cast(int, v), 0x140, 0xF, 0xF, true));
  v += __builtin_bit_cast(float, __builtin_amdgcn_update_dpp(0, __builtin_bit_cast(int, v), 0x142, 0xA, 0xF, false));
  v += __builtin_bit_cast(float, __builtin_amdgcn_update_dpp(0, __builtin_bit_cast(int, v), 0x143, 0xC, 0xF, false));
  return __builtin_bit_cast(float, __builtin_amdgcn_readlane(__builtin_bit_cast(int, v), 63));
}
__device__ __forceinline__ float wave_max(float v) {
  v = fmaxf(v, __builtin_bit_cast(float, __builtin_amdgcn_update_dpp(0, __builtin_bit_cast(int, v), 0xB1, 0xF, 0xF, true)));
  v = fmaxf(v, __builtin_bit_cast(float, __builtin_amdgcn_update_dpp(0, __builtin_bit_cast(int, v), 0x4E, 0xF, 0xF, true)));
  v = fmaxf(v, __builtin_bit_cast(float, __builtin_amdgcn_update_dpp(0, __builtin_bit_cast(int, v), 0x141, 0xF, 0xF, true)));
  v = fmaxf(v, __builtin_bit_cast(float, __builtin_amdgcn_update_dpp(0, __builtin_bit_cast(int, v), 0x140, 0xF, 0xF, true)));
  const float r1 = __builtin_bit_cast(float, __builtin_amdgcn_readlane(__builtin_bit_cast(int, v), 0));
  const float r2 = __builtin_bit_cast(float, __builtin_amdgcn_readlane(__builtin_bit_cast(int, v), 16));
  const float r3 = __builtin_bit_cast(float, __builtin_amdgcn_readlane(__builtin_bit_cast(int, v), 32));
  const float r4 = __builtin_bit_cast(float, __builtin_amdgcn_readlane(__builtin_bit_cast(int, v), 48));
  return fmaxf(fmaxf(r1, r2), fmaxf(r3, r4));
}
__device__ __forceinline__ float shfl_xor_l(float v, int mask, int lane) {
  return __builtin_bit_cast(float, __builtin_amdgcn_ds_bpermute((lane ^ mask) << 2, __builtin_bit_cast(int, v)));
}
__device__ __forceinline__ int shfl_xor_li(int v, int mask, int lane) {
  return __builtin_amdgcn_ds_bpermute((lane ^ mask) << 2, v);
}
__device__ __forceinline__ float row16_sum(float v) {
  v += __builtin_bit_cast(float, __builtin_amdgcn_update_dpp(0, __builtin_bit_cast(int, v), 0xB1, 0xF, 0xF, true));
  v += __builtin_bit_cast(float, __builtin_amdgcn_update_dpp(0, __builtin_bit_cast(int, v), 0x4E, 0xF, 0xF, true));
  v += __builtin_bit_cast(float, __builtin_amdgcn_update_dpp(0, __builtin_bit_cast(int, v), 0x141, 0xF, 0xF, true));
  v += __builtin_bit_cast(float, __builtin_amdgcn_update_dpp(0, __builtin_bit_cast(int, v), 0x140, 0xF, 0xF, true));
  return v;
}
__device__ __forceinline__ float quant_row_store(const float4 (&v)[4], signed char* dst_row, int lane) {
  float am = 0.f;
#pragma unroll
  for (int i = 0; i < 4; ++i) am = fmaxf(fmaxf(am, fmaxf(fabsf(v[i].x), fabsf(v[i].y))), fmaxf(fabsf(v[i].z), fabsf(v[i].w)));
  am = wave_max(am);
  const float sc = am > 0.f ? am * (1.f / 127.f) : 1.f, iv = 1.f / sc;
#pragma unroll
  for (int i = 0; i < 4; ++i) {
    const int q0 = (int)fminf(fmaxf(rintf(v[i].x * iv), -127.f), 127.f), q1 = (int)fminf(fmaxf(rintf(v[i].y * iv), -127.f), 127.f);
    const int q2 = (int)fminf(fmaxf(rintf(v[i].z * iv), -127.f), 127.f), q3 = (int)fminf(fmaxf(rintf(v[i].w * iv), -127.f), 127.f);
    *(unsigned*)(dst_row + (lane + 64 * i) * 4) = (unsigned)(q0 & 0xff) | ((unsigned)(q1 & 0xff) << 8) | ((unsigned)(q2 & 0xff) << 16) | ((unsigned)(q3 & 0xff) << 24);
  }
  return sc;
}
__device__ __forceinline__ float ldbf1(const bfr* q, size_t i) { return bf2f((short)q[i]); }
__device__ __forceinline__ f32x4 ldbf4(const bfr* q) { const bf16x4 v = *(const bf16x4*)q; return (f32x4){bf2f(v[0]), bf2f(v[1]), bf2f(v[2]), bf2f(v[3])}; }
__device__ __forceinline__ int mod_row(int m) { return m < NLAT ? (m >> 14) : 2; }

__device__ __forceinline__ void phase_ada(PP pp, int bid, int nb, char* smem) {
  float* red = (float*)smem;
  float* mods = (float*)(p.ws + OFF_MODS);
  const int tid = tid_opaque();
  for (int task = bid; task < 2 * 96; task += nb) {
    int l = task / 96, cgp = task % 96;
    int col = cgp * 64 + (tid & 63), ks = tid >> 6;
    const float* W = p.ada_w + (size_t)l * 1024 * 6144;
    float a0 = 0.f, a1 = 0.f, a2 = 0.f;
    for (int d = ks * 128; d < ks * 128 + 128; ++d) {
      float w = W[(size_t)d * 6144 + col];
      a0 += siluf_(p.c[d]) * w;
      a1 += siluf_(p.c[1024 + d]) * w;
      a2 += siluf_(p.c_ctx[d]) * w;
    }
    red[(ks * 3 + 0) * 64 + (tid & 63)] = a0;
    red[(ks * 3 + 1) * 64 + (tid & 63)] = a1;
    red[(ks * 3 + 2) * 64 + (tid & 63)] = a2;
    __syncthreads();
    if (tid < 192) {
      int r = tid >> 6, cc = tid & 63;
      float s = 0.f;
      for (int k = 0; k < 8; ++k) s += red[(k * 3 + r) * 64 + cc];
      mods[(size_t)(l * 3 + r) * 6144 + cgp * 64 + cc] = s + p.ada_b[(size_t)l * 6144 + cgp * 64 + cc];
    }
    __syncthreads();
  }
}

template <bool PERM>
__device__ __forceinline__ void convert_tile(const float* src, int N, bfr* dst, int kt4  , int nt, float* tile  ) {
  const int tid = tid_opaque();
  float4 v[8];
#pragma unroll
  for (int q = 0; q < 8; ++q) {
    const int idx = tid + q * 512;
    const int kk = idx >> 4, n4 = idx & 15;
    v[q] = *(const float4*)(src + (size_t)(kt4 * 256 + kk) * N + nt * 64 + n4 * 4);
  }
#pragma unroll
  for (int q = 0; q < 8; ++q) {
    const int idx = tid + q * 512;
    const int kk = idx >> 4, n4 = idx & 15;
    tile[kk * 65 + n4 * 4 + 0] = v[q].x; tile[kk * 65 + n4 * 4 + 1] = v[q].y;
    tile[kk * 65 + n4 * 4 + 2] = v[q].z; tile[kk * 65 + n4 * 4 + 3] = v[q].w;
  }
  __syncthreads();
  {
    const int nn = tid >> 3, kc = tid & 7;
    const int n = PERM ? perm_row32(nt * 64 + nn) : nt * 64 + nn;
#pragma unroll
    for (int q = 0; q < 4; ++q) {
      const int k0 = (kc + 8 * q) * 8;
      *(bf16x4*)(dst + (size_t)n * 1024 + kt4 * 256 + k0) = pack4(tile[(k0 + 0) * 65 + nn], tile[(k0 + 1) * 65 + nn], tile[(k0 + 2) * 65 + nn], tile[(k0 + 3) * 65 + nn]);
      *(bf16x4*)(dst + (size_t)n * 1024 + kt4 * 256 + k0 + 4) = pack4(tile[(k0 + 4) * 65 + nn], tile[(k0 + 5) * 65 + nn], tile[(k0 + 6) * 65 + nn], tile[(k0 + 7) * 65 + nn]);
    }
  }
  __syncthreads();
}
template <int N, bool INTERLEAVE>
__device__ __forceinline__ void convert_i8(const float* src  , signed char* dst  , float* sw, int ng, char* smem) {
  const int tid = tid_opaque();
  bfr* blk = (bfr*)smem;
  int* cmax = (int*)(smem + 131072);
  if (tid < 64) cmax[tid] = 0;
  __syncthreads();
  {
    const int n4 = tid & 15, kk0 = tid >> 4;
    float m0 = 0.f, m1 = 0.f, m2 = 0.f, m3 = 0.f;
#pragma unroll 8
    for (int ps = 0; ps < 32; ++ps) {
      const int k = ps * 32 + kk0;
      const int ncol = ng * 64 + n4 * 4;
      const int ncl = (N % 64 == 0) ? ncol : min(ncol, N - 4);
      float4 v = *(const float4*)(src + (size_t)k * N + ncl);
      if (N % 64 != 0 && ncol != ncl) v = make_float4(0.f, 0.f, 0.f, 0.f);
      m0 = fmaxf(m0, fabsf(v.x)); m1 = fmaxf(m1, fabsf(v.y)); m2 = fmaxf(m2, fabsf(v.z)); m3 = fmaxf(m3, fabsf(v.w));
      *(bf16x4*)(blk + k * 64 + n4 * 4) = pack4(v.x, v.y, v.z, v.w);
    }
    atomicMax(&cmax[n4 * 4 + 0], __float_as_int(m0)); atomicMax(&cmax[n4 * 4 + 1], __float_as_int(m1));
    atomicMax(&cmax[n4 * 4 + 2], __float_as_int(m2)); atomicMax(&cmax[n4 * 4 + 3], __float_as_int(m3));
  }
  __syncthreads();
  {
    const int nn = tid >> 3, kc = tid & 7;
    const int n = ng * 64 + nn;
    const float am = __int_as_float(cmax[nn]);
    const float sc = am > 0.f ? am * (1.f / 127.f) : 1.f, iv = 1.f / sc;
    const int j = n & 1023;
    const int row = INTERLEAVE ? (j >> 7) * 256 + ((j >> 2) & 1) * 128 + ((j >> 5) & 3) * 32 + ((n >= 1024) ? 16 : 0) + ((j >> 3) & 3) * 4 + (j & 3) : perm_row32(n);
    if (kc == 0) sw[n] = sc;
#pragma unroll 2
    for (int q = 0; q < 8; ++q) {
      const int k0 = (kc + 8 * q) * 16;
      unsigned w[4];
#pragma unroll
      for (int g4 = 0; g4 < 4; ++g4) {
        unsigned acc = 0u;
#pragma unroll
        for (int b = 0; b < 4; ++b) {
          const float v = bf2f((short)blk[(k0 + g4 * 4 + b) * 64 + nn]);
          const int qi = (int)fminf(fmaxf(rintf(v * iv), -127.f), 127.f);
          acc |= ((unsigned)(qi & 0xff)) << (8 * b);
        }
        w[g4] = acc;
      }
      *(uint4*)(dst + (size_t)row * 1024 + k0) = make_uint4(w[0], w[1], w[2], w[3]);
    }
  }
  __syncthreads();
}
__device__ __forceinline__ void phase_convert(PP pp, int l, int part, int bid, int nb, char* smem) {
  float* tile = (float*)smem;
  char* wl = p.ws + OFF_W + (size_t)l * WL_SIZE;
  const int T_IN = 56, T_OUT = 4 * 16, T_GU = 32 * 32, T_DN = 32 * 4 * 16;
  const int t_lo = part == 0 ? 0 : T_IN + T_OUT;
  const int t_hi = part == 0 ? T_IN + T_OUT : T_IN + T_OUT + T_GU + T_DN;
  for (int t = t_lo + bid; t < t_hi; t += nb) {
    if (t < T_IN) {
      convert_i8<PIN, false>(p.w_in + (size_t)l * 1024 * PIN, (signed char*)(wl + WL_IN), (float*)(p.ws + OFF_SWIN) + (size_t)l * PINP, t, smem);
    } else if (t < T_IN + T_OUT) {
      int u = t - T_IN; int kt4 = u / 16, nt = u % 16;
      convert_tile<false>(p.w_out + (size_t)l * 1024 * 1024, 1024, (bfr*)(wl + WL_OUT), kt4, nt, tile);
    } else if (t < T_IN + T_OUT + T_GU) {
      int u = t - T_IN - T_OUT; int e = u / 32, ng = u % 32;
      convert_i8<2048, true>(p.moe_w_gu + ((size_t)l * 32 + e) * 1024 * 2048, (signed char*)(wl + WL_GU) + (size_t)e * 2048 * 1024,
                    (float*)(p.ws + OFF_SW) + ((size_t)l * 32 + e) * 2048, ng, smem);
    } else {
      int u = t - T_IN - T_OUT - T_GU; int e = u / 64; int v = u % 64; int kt4 = v / 16, nt = v % 16;
      convert_tile<true>(p.moe_w_down + ((size_t)l * 32 + e) * 1024 * 1024, 1024, (bfr*)(wl + WL_DN) + (size_t)e * 1024 * 1024, kt4, nt, tile);
    }
  }
}

__device__ __forceinline__ void phase_prenorm(PP pp, int l, int bid, int nb) {
  const int tid = tid_opaque(), lane = tid & 63, wv = wave_id(tid);
  const float* xl = (l == 0) ? p.x : p.out;
  const float* xc = (l == 0) ? p.ctx : (const float*)(p.ws + OFF_CTX);
  const float* mods = (const float*)(p.ws + OFF_MODS) + (size_t)l * 3 * 6144;
  const float* g = p.norm_mix_g + (size_t)l * 1024;
  signed char* H8 = (signed char*)(p.ws + OFF_H);
  float* SCL = (float*)(p.ws + OFF_SCL);
  {
    int* cnt = (int*)(p.ws + OFF_CNT);
    int gt = bid * NTHR + tid;
    if (gt < 32) cnt[gt] = 0;
  }
  for (int m = bid * 8 + wv; m < NTOK; m += nb * 8) {
    const float* xr = (m < NLAT) ? xl + (size_t)m * 1024 : xc + (size_t)(m - NLAT) * 1024;
    const float* md = mods + (size_t)mod_row(m) * 6144;
    float4 v[4];
    float ss = 0.f;
#pragma unroll
    for (int i = 0; i < 4; ++i) {
      v[i] = *(const float4*)(xr + (lane + 64 * i) * 4);
      ss += v[i].x * v[i].x + v[i].y * v[i].y + v[i].z * v[i].z + v[i].w * v[i].w;
    }
    ss = wave_sum(ss);
    float rs = rsqrtf(ss * (1.f / 1024.f) + 1e-6f);
    float4 hq[4];
#pragma unroll
    for (int i = 0; i < 4; ++i) {
      int d = (lane + 64 * i) * 4;
      float4 gg = *(const float4*)(g + d);
      float4 sh = *(const float4*)(md + d);
      float4 sc = *(const float4*)(md + 1024 + d);
      hq[i] = make_float4(v[i].x * rs * gg.x * (1.f + sc.x) + sh.x, v[i].y * rs * gg.y * (1.f + sc.y) + sh.y,
                          v[i].z * rs * gg.z * (1.f + sc.z) + sh.z, v[i].w * rs * gg.w * (1.f + sc.w) + sh.w);
    }
    const float qs = quant_row_store(hq, H8 + (size_t)m * 1024, lane);
    if (lane == 0) SCL[m] = qs;
  }
}

#define LAS __attribute__((address_space(3)))
namespace g8 {
constexpr int BM = 256, BK = 64, HALF = 128, HTB = HALF * BK * 2, STAGE_BYTES = 8 * HTB, KD = 1024;
__device__ __forceinline__ int lds_byte(int r, int c) { const int st = (r >> 4) * 2 + (c >> 5), rr = r & 15, cc = c & 31, ob = rr * 64 + cc * 2; return st * 1024 + (ob ^ (((ob >> 9) & 1) << 5)); }
__device__ __forceinline__ void stage_rc(int b, int& R, int& C) { const int st = b / 1024, sb = b % 1024, swz = sb ^ (((sb >> 9) & 1) << 5); R = (st >> 1) * 16 + swz / 64; C = (st & 1) * 32 + (swz % 64) / 2; }
struct GUnit { int pm, pn, brow0, e; };
__device__ __forceinline__ int unit_index(int i, int c, int G, int total) {
  const int x = c & 7, j = c >> 3, q = total >> 3, r = total & 7;
  const int start = x < r ? x * (q + 1) : r * (q + 1) + (x - r) * q;
  const int size = q + (x < r ? 1 : 0);
  const int li = i * (G >> 3) + j;
  return li < size ? start + li : -1;
}

__device__ __forceinline__ f32x4 mma16(bf16x8 a, bf16x8 b, f32x4 c) { return __builtin_amdgcn_mfma_f32_16x16x32_bf16(a, b, c, 0, 0, 0); }
__device__ __forceinline__ i32x4 mma16(i32x4 a, i32x4 b, i32x4 c) { return __builtin_amdgcn_mfma_i32_16x16x64_i8(a, b, c, 0, 0, 0); }
template <bool I8, bool GATHER, class Sched, class Epi>
__device__ __forceinline__ void gemm_stream(LAS unsigned char* lds, const void* Abase, const void* Btbase, const Sched& S, const Epi& E, const int* slt = nullptr) {
  typedef typename std::conditional<I8, i32x4, f32x4>::type AccT;
  typedef typename std::conditional<I8, i32x4, bf16x8>::type FragT;
  constexpr int KB = I8 ? KD : KD * 2;
  const int tid = tid_opaque(), wid = __builtin_amdgcn_readfirstlane(tid >> 6), lane = tid & 63, wr = wid >> 2, wc = wid & 3, fr = lane & 15, fq = lane >> 4;
  constexpr int nt = KB / 128;
  int R[2], C[2];
  unsigned voffB[2];
#pragma unroll
  for (int i = 0; i < 2; ++i) { stage_rc(tid * 16 + i * 8192, R[i], C[i]); voffB[i] = (unsigned)(R[i] * KB + C[i] * 2); }
#define voffA voffB
  constexpr size_t kstep = (size_t)(BK * 2);
  constexpr size_t hstep = (size_t)HALF * KB;
  const unsigned ldsw = (unsigned)wid * 1024u;
  const int aoff = lds_byte(wr * 64 + fr, fq * 8), boff = lds_byte(wc * 32 + fr, fq * 8);
#define G8_SA(b, h) (((b) * 2 + (h)) * HTB)
#define G8_SB(b, h) ((4 + (b) * 2 + (h)) * HTB)
#define G8_STAGE(bufoff, gbase, v0, v1) do { \
    __builtin_amdgcn_global_load_lds((const unsigned*)((const char*)(gbase) + (v0)), (LAS unsigned*)(lds + (bufoff) + ldsw), 16, 0, 0); \
    __builtin_amdgcn_global_load_lds((const unsigned*)((const char*)(gbase) + (v1)), (LAS unsigned*)(lds + (bufoff) + ldsw + 8192), 16, 0, 0); } while (0)
#define G8_STAGEB(bufoff, gbase) G8_STAGE(bufoff, gbase, voffB[0], voffB[1])
#define G8_STAGEA_U(bufoff, base_u, hsel) G8_STAGE(bufoff, (base_u) + (hsel) * hstep, voffA[0], voffA[1])
#define G8_STAGEA_G(bufoff, koff, o0, o1) G8_STAGE(bufoff, (const char*)Abase + (koff), o0, o1)
#define G8_LDA(dst, b, h) do { _Pragma("unroll") for (int m = 0; m < 4; ++m) _Pragma("unroll") for (int k = 0; k < 2; ++k) dst[m][k] = *(const LAS FragT*)(lds + G8_SA(b, h) + aoff + m * 2048 + k * 1024); } while (0)
#define G8_LDB(dst, b, h) do { _Pragma("unroll") for (int n = 0; n < 2; ++n) _Pragma("unroll") for (int k = 0; k < 2; ++k) dst[n][k] = *(const LAS FragT*)(lds + G8_SB(b, h) + boff + n * 2048 + k * 1024); } while (0)
#define G8_MMA(ai, bj, At, Bt) do { __builtin_amdgcn_s_setprio(1); _Pragma("unroll") for (int m = 0; m < 4; ++m) _Pragma("unroll") for (int n = 0; n < 2; ++n) _Pragma("unroll") for (int k = 0; k < 2; ++k) \
    acc[ai][bj][m][n] = mma16(Bt[n][k], At[m][k], acc[ai][bj][m][n]); __builtin_amdgcn_s_setprio(0); } while (0)
#define G8_WAIT_V(n) asm volatile("s_waitcnt vmcnt(" #n ")" ::: "memory")
#define G8_WAIT_L(n) asm volatile("s_waitcnt lgkmcnt(" #n ")" ::: "memory")
#define G8_BAR __builtin_amdgcn_s_barrier()
#define G8_SCHED __builtin_amdgcn_sched_barrier(0)
  GUnit cur, nxt;
  int ui = 0;
  if (!S.next(0, cur)) return;
  AccT acc[2][2][4][2];
#pragma unroll
  for (int a = 0; a < 2; ++a)
#pragma unroll
    for (int b = 0; b < 2; ++b)
#pragma unroll
      for (int m = 0; m < 4; ++m)
#pragma unroll
        for (int n = 0; n < 2; ++n) acc[a][b][m][n] = AccT{};
  FragT At[4][2], B0[2][2], B1[2][2];
  const char* cA = (const char*)Abase + (size_t)cur.pm * (BM * KB);
  unsigned gA00 = 0, gA01 = 0, gA10 = 0, gA11 = 0, gN00 = 0, gN01 = 0, gN10 = 0, gN11 = 0;
  if (GATHER) {
    const int* sr = slt + cur.pm * BM;
    gA00 = (unsigned)sr[R[0]] * KB + C[0] * 2; gA01 = (unsigned)sr[R[1]] * KB + C[1] * 2;
    gA10 = (unsigned)sr[HALF + R[0]] * KB + C[0] * 2; gA11 = (unsigned)sr[HALF + R[1]] * KB + C[1] * 2;
  }
  const char* cB = (const char*)Btbase + (size_t)cur.brow0 * KB;
  G8_STAGEB(G8_SB(0, 0), cB);
  if (GATHER) G8_STAGEA_G(G8_SA(0, 0), 0, gA00, gA01); else G8_STAGEA_U(G8_SA(0, 0), cA, 0);
  G8_STAGEB(G8_SB(0, 1), cB + hstep);
  if (GATHER) G8_STAGEA_G(G8_SA(0, 1), 0, gA10, gA11); else G8_STAGEA_U(G8_SA(0, 1), cA, 1);
  if (wr == 1) G8_BAR;
  G8_WAIT_V(4); G8_BAR;
  G8_STAGEB(G8_SB(1, 0), cB + kstep);
  if (GATHER) G8_STAGEA_G(G8_SA(1, 0), kstep, gA00, gA01); else G8_STAGEA_U(G8_SA(1, 0), cA + kstep, 0);
  G8_STAGEB(G8_SB(1, 1), cB + hstep + kstep);
  G8_WAIT_V(6); G8_BAR;
  for (;;) {
    const bool has_next = S.next(ui + 1, nxt);
    const char* nA = has_next ? (const char*)Abase + (size_t)nxt.pm * (BM * KB) : cA;
    if (GATHER) {
      if (has_next) {
        const int* sr = slt + nxt.pm * BM;
        gN00 = (unsigned)sr[R[0]] * KB + C[0] * 2; gN01 = (unsigned)sr[R[1]] * KB + C[1] * 2;
        gN10 = (unsigned)sr[HALF + R[0]] * KB + C[0] * 2; gN11 = (unsigned)sr[HALF + R[1]] * KB + C[1] * 2;
      } else { gN00 = gA00; gN01 = gA01; gN10 = gA10; gN11 = gA11; }
    }
    const char* nB = has_next ? (const char*)Btbase + (size_t)nxt.brow0 * KB : cB;
#pragma unroll 1
    for (int t = 0; t < nt; t += 2) {
      const bool last = (t == nt - 2);
      const char* a1 = cA + (size_t)(t + 1) * kstep;
      const char* a2 = last ? nA : cA + (size_t)(t + 2) * kstep;
      const char* b2 = last ? nB : cB + (size_t)(t + 2) * kstep;
      const char* a3 = a2 + kstep;
      const char* b3 = b2 + kstep;
      const size_t k1 = (size_t)(t + 1) * kstep, k2 = last ? 0 : (size_t)(t + 2) * kstep, k3 = k2 + kstep;
      const unsigned w00 = last ? gN00 : gA00, w01 = last ? gN01 : gA01, w10 = last ? gN10 : gA10, w11 = last ? gN11 : gA11;
      G8_LDB(B0, 0, 0); G8_SCHED; G8_LDA(At, 0, 0); if (GATHER) G8_STAGEA_G(G8_SA(1, 1), k1, gA10, gA11); else G8_STAGEA_U(G8_SA(1, 1), a1, 1);
      G8_WAIT_L(8); G8_BAR; G8_WAIT_L(0); G8_MMA(0, 0, At, B0); G8_BAR; G8_SCHED;
      G8_LDB(B1, 0, 1); G8_STAGEB(G8_SB(0, 0), b2);
      G8_BAR; G8_WAIT_L(0); G8_MMA(0, 1, At, B1); G8_BAR;
      G8_LDA(At, 0, 1); if (GATHER) G8_STAGEA_G(G8_SA(0, 0), k2, w00, w01); else G8_STAGEA_U(G8_SA(0, 0), a2, 0);
      G8_BAR; G8_WAIT_L(0); G8_MMA(1, 0, At, B0); G8_BAR; G8_SCHED;
      G8_STAGEB(G8_SB(0, 1), b2 + hstep);
      G8_WAIT_V(6); G8_BAR; G8_MMA(1, 1, At, B1); G8_BAR;
      G8_LDB(B0, 1, 0); G8_SCHED; G8_LDA(At, 1, 0); if (GATHER) G8_STAGEA_G(G8_SA(0, 1), k2, w10, w11); else G8_STAGEA_U(G8_SA(0, 1), a2, 1);
      G8_WAIT_L(8); G8_BAR; G8_WAIT_L(0); G8_MMA(0, 0, At, B0); G8_BAR; G8_SCHED;
      G8_LDB(B1, 1, 1); G8_STAGEB(G8_SB(1, 0), b3);
      G8_BAR; G8_WAIT_L(0); G8_MMA(0, 1, At, B1); G8_BAR;
      G8_LDA(At, 1, 1); if (GATHER) G8_STAGEA_G(G8_SA(1, 0), k3, w00, w01); else G8_STAGEA_U(G8_SA(1, 0), a3, 0);
      G8_BAR; G8_WAIT_L(0); G8_MMA(1, 0, At, B0); G8_BAR; G8_SCHED;
      G8_STAGEB(G8_SB(1, 1), b3 + hstep);
      G8_WAIT_V(6); G8_BAR; G8_MMA(1, 1, At, B1); G8_BAR;
    }
    E(acc, cur, wr, wc, fr, fq);
    if (!has_next) break;
#pragma unroll
    for (int a = 0; a < 2; ++a)
#pragma unroll
      for (int b = 0; b < 2; ++b)
#pragma unroll
        for (int m = 0; m < 4; ++m)
#pragma unroll
          for (int n = 0; n < 2; ++n) acc[a][b][m][n] = AccT{};
    cur = nxt; cA = nA; cB = nB; ++ui;
    gA00 = gN00; gA01 = gN01; gA10 = gN10; gA11 = gN11;
  }
  G8_WAIT_V(0);
  if (wr == 0) G8_BAR;
  G8_BAR;
#undef G8_SA
#undef G8_SB
#undef G8_STAGE
#undef G8_STAGEB
#undef G8_STAGEA_U
#undef G8_STAGEA_G
#undef voffA
#undef G8_LDA
#undef G8_LDB
#undef G8_MMA
#undef G8_WAIT_V
#undef G8_WAIT_L
#undef G8_BAR
#undef G8_SCHED
}

struct DenseSched {
  int nM, nN, G, c;
  __device__ __forceinline__ bool next(int i, GUnit& u) const {
    const int idx = unit_index(i, c, G, nM * nN);
    if (idx < 0) return false;
    u.pm = idx / nN; u.pn = idx - u.pm * nN; u.brow0 = u.pn * BM; u.e = 0;
    return true;
  }
};
struct MoeSched {
  const int* toff; int nN, NE, G, c;
  __device__ __forceinline__ bool next(int i, GUnit& u) const {
    const int idx = unit_index(i, c, G, toff[32] * nN);
    if (idx < 0) return false;
    u.pm = idx / nN; u.pn = idx - u.pm * nN;
    const int e = toff[128 + u.pm];
    u.e = e; u.brow0 = e * NE + u.pn * BM;
    return true;
  }
};
}

struct EpiInProj {
  bfr* P; const float* SCL; const float* sw;
  __device__ __forceinline__ void operator()(const i32x4 (&acc)[2][2][4][2], const g8::GUnit& u, int wr, int wc, int fr, int fq) const {
    const int row0 = u.pm * 256 + wr * 64 + fr, col0 = u.pn * 256 + wc * 32 + 8 * fq;
    f32x4 cs[2][2];
#pragma unroll
    for (int bj = 0; bj < 2; ++bj)
#pragma unroll
      for (int n = 0; n < 2; ++n) cs[bj][n] = *(const f32x4*)(sw + col0 + bj * 128 + n * 4);
    float sav[2][4];
#pragma unroll
    for (int ai = 0; ai < 2; ++ai)
#pragma unroll
      for (int m = 0; m < 4; ++m) sav[ai][m] = SCL[row0 + ai * 128 + m * 16];
#pragma unroll
    for (int ai = 0; ai < 2; ++ai)
#pragma unroll
      for (int m = 0; m < 4; ++m) {
        const int row = row0 + ai * 128 + m * 16;
        const float sa = sav[ai][m];
        bfr* rowp = P + (size_t)row * PINP + col0;
#pragma unroll
        for (int bj = 0; bj < 2; ++bj) {
          const i32x4 a0 = acc[ai][bj][m][0], a1 = acc[ai][bj][m][1];
          f32x4 o0 = {(float)a0[0], (float)a0[1], (float)a0[2], (float)a0[3]};
          f32x4 o1 = {(float)a1[0], (float)a1[1], (float)a1[2], (float)a1[3]};
          o0 = o0 * (cs[bj][0] * sa); o1 = o1 * (cs[bj][1] * sa);
          *(bf16x8*)(rowp + bj * 128) = pack8(o0, o1);
        }
      }
  }
};
__device__ __forceinline__ void phase_gemm_in(PP pp, int l, int bid, int nb, char* smem) {
  g8::DenseSched S{130, 14, nb, bid};
  EpiInProj E{(bfr*)(p.ws + OFF_P), (const float*)(p.ws + OFF_SCL), (const float*)(p.ws + OFF_SWIN) + (size_t)l * PINP};
  g8::gemm_stream<true, false>((LAS unsigned char*)smem, p.ws + OFF_H, p.ws + OFF_W + (size_t)l * WL_SIZE + WL_IN, S, E);
}

struct EpiOutProj {
  const float *xl, *xc, *mods; float *ol, *oc;
  __device__ __forceinline__ void operator()(const f32x4 (&acc)[2][2][4][2], const g8::GUnit& u, int wr, int wc, int fr, int fq) const {
    const bool lat = u.pm < 128;
    const float* xin = lat ? xl + (size_t)u.pm * 256 * 1024 : xc + (size_t)(u.pm - 128) * 256 * 1024;
    float* xo = lat ? ol + (size_t)u.pm * 256 * 1024 : oc + (size_t)(u.pm - 128) * 256 * 1024;
    const float* g1 = mods + (size_t)(lat ? (u.pm >> 6) : 2) * 6144 + 2048;
    const int row0 = wr * 64 + fr, col0 = u.pn * 256 + wc * 32 + 4 * fq;
#pragma unroll
    for (int bj = 0; bj < 2; ++bj)
#pragma unroll
      for (int n = 0; n < 2; ++n) {
        const f32x4 gv = *(const f32x4*)(g1 + col0 + bj * 128 + n * 16);
        f32x4 xv[2][4];
#pragma unroll
        for (int ai = 0; ai < 2; ++ai)
#pragma unroll
          for (int m = 0; m < 4; ++m) xv[ai][m] = *(const f32x4*)(xin + (size_t)(row0 + ai * 128 + m * 16) * 1024 + col0 + bj * 128 + n * 16);
#pragma unroll
        for (int ai = 0; ai < 2; ++ai)
#pragma unroll
          for (int m = 0; m < 4; ++m)
            *(f32x4*)(xo + (size_t)(row0 + ai * 128 + m * 16) * 1024 + col0 + bj * 128 + n * 16) = xv[ai][m] + gv * acc[ai][bj][m][n];
        asm volatile("" ::: "memory");
      }
  }
};
__device__ __forceinline__ void phase_gemm_out(PP pp, int l, int bid, int nb, char* smem) {
  g8::DenseSched S{(l == 0) ? 130 : 128, 4, nb, bid};
  EpiOutProj E{(l == 0) ? p.x : p.out, (l == 0) ? p.ctx : (const float*)(p.ws + OFF_CTX),
               (const float*)(p.ws + OFF_MODS) + (size_t)l * 3 * 6144, p.out, (float*)(p.ws + OFF_CTX)};
  g8::gemm_stream<false, false>((LAS unsigned char*)smem, p.ws + OFF_CC, p.ws + OFF_W + (size_t)l * WL_SIZE + WL_OUT, S, E);
}

#define LBAR() do { asm volatile("s_waitcnt lgkmcnt(0)" ::: "memory"); __builtin_amdgcn_s_barrier(); asm volatile("" ::: "memory"); } while (0)
__device__ __forceinline__ void phase_prep(PP pp, int l, int bid, int nb, char* smem) {
  const int tid = tid_opaque(), lane = tid & 63, wv = wave_id(tid);
  const bfr* P = (const bfr*)(p.ws + OFF_P);
  char* S = p.ws + OFF_S;
  bfr* QN = (bfr*)(S + S_QN);
  bfr* KN = (bfr*)(S + S_KN);
  bfr* VT = (bfr*)(S + S_VT);
  bfr* RWR = (bfr*)(S + S_RWR);
  bfr* RWKK = (bfr*)(S + S_RWKK);
  bfr* RWV = (bfr*)(S + S_RWV);
  bfr* RWG = (bfr*)(S + S_RWG);
  float* RWW = (float*)(S + S_RWW);
  bfr* RWKD = (bfr*)(S + S_RWKD);
  bfr* RWB = (bfr*)(S + S_RWB);
  float* BON = (float*)(S + S_BON);
  bfr* GDQ = (bfr*)(S + S_GDQ);
  bfr* GDK = (bfr*)(S + S_GDK);
  bfr* GDV = (bfr*)(S + S_GDV);
  float* GDAB = (float*)(S + S_GDAB);
  const float* mu = p.rw_mu + (size_t)l * 896;
  const float* w0 = p.rw_w0 + (size_t)l * 512;
  const float* w_up = p.rw_w_up + (size_t)l * 2 * 32 * 256;
  const float* a0 = p.rw_a0 + (size_t)l * 512;
  const float* a_up = p.rw_a_up + (size_t)l * 2 * 32 * 256;
  const float* g_up = p.rw_g_up + (size_t)l * 64 * 256;
  const float* k_k = p.rw_k_k + (size_t)l * 256;
  const float* k_a = p.rw_k_a + (size_t)l * 256;
  const float* r_k = p.rw_r_k + (size_t)l * 256;
  const float* conv_w = p.gd_conv_w + (size_t)l * 5 * 768;
  const float* A_log = p.gd_A_log + (size_t)l * 8;
  const float* dt_bias = p.gd_dt_bias + (size_t)l * 8;
  const float* qg = p.na_q_gain + (size_t)l * 64;
  const float* kg = p.na_k_gain + (size_t)l * 64;

  unsigned* wlp = (unsigned*)smem;
  unsigned* lorp = (unsigned*)(smem + 96 * 256 * 4);
  __syncthreads();
  for (int i = tid; i < 96 * 256; i += NTHR) {
    const int rp = i >> 8, c = i & 255, r0 = 2 * rp;
    const float* src = r0 < 64 ? g_up + r0 * 256 + c : r0 < 128 ? w_up + (r0 - 64) * 256 + c : a_up + (r0 - 128) * 256 + c;
    wlp[i] = pk_bf16(src[0], src[256]);
  }
  __syncthreads();

  for (int tile = bid; tile < NTOK / 16; tile += nb) {
    const int m0 = tile * 16;
    int seq_lo, seq_hi, bb, tau0;
    if (m0 < NLAT) { bb = m0 >> 14; seq_lo = bb << 14; seq_hi = seq_lo + SEQ; tau0 = m0 - seq_lo; }
    else { bb = (m0 - NLAT) >> 8; seq_lo = NLAT + (bb << 8); seq_hi = seq_lo + CTXL; tau0 = SEQ + (m0 - seq_lo); }
    const f32x4 z4 = {0.f, 0.f, 0.f, 0.f};
    int tid_t = tid; asm volatile("" : "+v"(tid_t));
    const int lane_t = tid_t & 63;
    const int cb = lane_t * 4, hh = lane_t >> 4;
    const int lg = tid_t & 31, lt = tid_t >> 5;
    const int sl = lane_t >> 4, sc4 = (lane_t & 15) * 4;
    asm volatile("" ::: "memory");
    const f32x4 mur = *(const f32x4*)(mu + cb), muk = *(const f32x4*)(mu + 256 + cb), muv = *(const f32x4*)(mu + 512 + cb);
    const f32x4 mul = *(const f32x4*)(mu + 768 + lg * 4);

    f32x4 pr[3][4], pl[3];
    {
      const int mt0 = m0 + 2 * wv;
#pragma unroll
      for (int j = 0; j < 3; ++j)
#pragma unroll
        for (int t = 0; t < 4; ++t) {
          const int m = mt0 - 1 + t;
          const int mc = min(max(m, seq_lo), seq_hi - 1);
          const f32x4 ld = ldbf4(P + (size_t)mc * PINP + A_END + j * 256 + cb);
          pr[j][t] = (m == mc) ? ld : z4;
        }
#pragma unroll
      for (int t = 0; t < 3; ++t) {
        const int m = m0 + lt - 1 + t;
        const int mc = min(max(m, seq_lo), seq_hi - 1);
        const f32x4 ld = ldbf4(P + (size_t)mc * PINP + A_END + 768 + lg * 4);
        pl[t] = (m == mc) ? ld : z4;
      }
    }
    {
      const f32x4 v = pl[1] + mul * (0.5f * (pl[0] + pl[2]) - pl[1]);
      float fv[4];
#pragma unroll
      for (int i = 0; i < 4; ++i) {
        const int ch = lg * 4 + i;
        fv[i] = ch < 32 ? tanhf(v[i]) : ch < 64 ? v[i] : sigmoidf_(v[i]);
      }
      lorp[(lg * 2) * 16 + lt] = pk_bf16(fv[0], fv[1]);
      lorp[(lg * 2 + 1) * 16 + lt] = pk_bf16(fv[2], fv[3]);
    }
    f32x4 rr[2], rk[2], rv[2];
#pragma unroll
    for (int t = 0; t < 2; ++t) {
      rr[t] = pr[0][t + 1] + mur * (0.5f * (pr[0][t] + pr[0][t + 2]) - pr[0][t + 1]);
      rk[t] = pr[1][t + 1] + muk * (0.5f * (pr[1][t] + pr[1][t + 2]) - pr[1][t + 1]);
      rv[t] = pr[2][t + 1] + muv * (0.5f * (pr[2][t] + pr[2][t + 2]) - pr[2][t + 1]);
    }
    LBAR();
    bf16x4 pgr[20], pvr[4];
    const bf16x4 zr = {0, 0, 0, 0};
    const bool is_gd = wv < 3, is_na = (wv >= 3 && wv < 7);
    const int sec = is_gd ? wv * 4 + sl : (wv - 3) * 4 + sl;
    if (is_gd) {
#pragma unroll
      for (int t = 0; t < 20; ++t) {
        const int m = m0 - 2 + t;
        const int mc = min(max(m, seq_lo), seq_hi - 1);
        pgr[t] = *(const bf16x4*)(P + (size_t)mc * PINP + B_END + sec * 64 + sc4);
      }
    } else if (is_na) {
#pragma unroll
      for (int t = 0; t < 16; ++t) pgr[t] = *(const bf16x4*)(P + (size_t)(m0 + t) * PINP + sec * 64 + sc4);
#pragma unroll
      for (int t = 16; t < 20; ++t) pgr[t] = zr;
    } else {
#pragma unroll
      for (int t = 0; t < 20; ++t) pgr[t] = zr;
    }
    {
      const int vc = (tid_t & 127) * 4, tq = (tid_t >> 7) * 4;
#pragma unroll
      for (int t = 0; t < 4; ++t) pvr[t] = *(const bf16x4*)(P + (size_t)(m0 + tq + t) * PINP + 1024 + vc);
    }
    asm volatile("" ::: "memory");
    {
      f32x4 gacc[2], wa0[2], wa1[2], aa0[2], aa1[2];
#pragma unroll
      for (int t = 0; t < 2; ++t) { gacc[t] = z4; wa0[t] = z4; wa1[t] = z4; aa0[t] = z4; aa1[t] = z4; }
      typedef __attribute__((ext_vector_type(4))) unsigned u32x4_t;
      typedef __attribute__((ext_vector_type(2))) unsigned u32x2_t;
#pragma unroll 4
      for (int jp = 0; jp < 32; ++jp) {
        const u32x4_t wq = *(const u32x4_t*)(wlp + jp * 256 + cb);
        const u32x2_t sv = *(const u32x2_t*)(lorp + (32 + jp) * 16 + 2 * wv);
#pragma unroll
        for (int i = 0; i < 4; ++i) { gacc[0][i] = dot2bf(wq[i], sv[0], gacc[0][i]); gacc[1][i] = dot2bf(wq[i], sv[1], gacc[1][i]); }
      }
#pragma unroll 2
      for (int jp = 0; jp < 16; ++jp) {
        const u32x4_t q0 = *(const u32x4_t*)(wlp + (32 + jp) * 256 + cb), q1 = *(const u32x4_t*)(wlp + (48 + jp) * 256 + cb);
        const u32x4_t q2 = *(const u32x4_t*)(wlp + (64 + jp) * 256 + cb), q3 = *(const u32x4_t*)(wlp + (80 + jp) * 256 + cb);
        const u32x2_t tv = *(const u32x2_t*)(lorp + jp * 16 + 2 * wv);
        const u32x2_t dv = *(const u32x2_t*)(lorp + (16 + jp) * 16 + 2 * wv);
#pragma unroll
        for (int i = 0; i < 4; ++i) {
          wa0[0][i] = dot2bf(q0[i], tv[0], wa0[0][i]); wa0[1][i] = dot2bf(q0[i], tv[1], wa0[1][i]);
          wa1[0][i] = dot2bf(q1[i], tv[0], wa1[0][i]); wa1[1][i] = dot2bf(q1[i], tv[1], wa1[1][i]);
          aa0[0][i] = dot2bf(q2[i], dv[0], aa0[0][i]); aa0[1][i] = dot2bf(q2[i], dv[1], aa0[1][i]);
          aa1[0][i] = dot2bf(q3[i], dv[0], aa1[0][i]); aa1[1][i] = dot2bf(q3[i], dv[1], aa1[1][i]);
        }
      }
      asm volatile("" ::: "memory");
      const f32x4 kkc = *(const f32x4*)(k_k + cb), kac = *(const f32x4*)(k_a + cb), rkc = *(const f32x4*)(r_k + cb);
      const f32x4 w00 = *(const f32x4*)(w0 + cb), w01 = *(const f32x4*)(w0 + 256 + cb), a00 = *(const f32x4*)(a0 + cb), a01 = *(const f32x4*)(a0 + 256 + cb);
#pragma unroll
      for (int t = 0; t < 2; ++t) {
        const int m = m0 + 2 * wv + t;
        const f32x4 r = rr[t], k = rk[t], v = rv[t];
        const f32x4 kkraw = k * kkc;
        const float ssum = row16_sum((kkraw[0] * kkraw[0] + kkraw[1] * kkraw[1]) + (kkraw[2] * kkraw[2] + kkraw[3] * kkraw[3]));
        const f32x4 kk = kkraw * rsqrtf(ssum + 1e-6f);
        float bon = 0.f;
#pragma unroll
        for (int d = 0; d < 2; ++d) {
          const f32x4 wlin = d == 0 ? w00 + wa0[t] : w01 + wa1[t];
          const f32x4 alin = d == 0 ? a00 + aa0[t] : a01 + aa1[t];
          f32x4 lw, kd, bv;
#pragma unroll
          for (int i = 0; i < 4; ++i) {
            const float w_log = -softplusf_(-wlin[i]) - 0.5f;
            const float a = sigmoidf_(alin[i]);
            lw[i] = -__expf(w_log);
            kd[i] = k[i] * (1.f + (a - 1.f) * kac[i]);
            bv[i] = kk[i] * a;
            bon += r[i] * kd[i] * rkc[i];
          }
          const size_t o = ((size_t)d * NTOK + m) * 256 + cb;
          *(f32x4*)(RWW + o) = lw; *(bf16x4*)(RWKD + o) = pack4(kd[0], kd[1], kd[2], kd[3]); *(bf16x4*)(RWB + o) = pack4(bv[0], bv[1], bv[2], bv[3]);
        }
        bon = row16_sum(bon);
        const size_t o = (size_t)m * 256 + cb;
        *(bf16x4*)(RWR + o) = pack4(r[0], r[1], r[2], r[3]); *(bf16x4*)(RWKK + o) = pack4(kk[0], kk[1], kk[2], kk[3]);
        *(bf16x4*)(RWV + o) = pack4(v[0], v[1], v[2], v[3]); *(bf16x4*)(RWG + o) = pack4(gacc[t][0], gacc[t][1], gacc[t][2], gacc[t][3]);
        if ((lane_t & 15) == 0) BON[(size_t)m * 4 + hh] = bon;
      }
    }
    if (is_gd) {
      f32x4 cw[5];
#pragma unroll
      for (int j = 0; j < 5; ++j) cw[j] = *(const f32x4*)(conv_w + j * 768 + sec * 64 + sc4);
      f32x4 pg[20];
#pragma unroll
      for (int t = 0; t < 20; ++t) {
        const int m = m0 - 2 + t;
        const bool inr = (m >= seq_lo) && (m < seq_hi);
        const f32x4 cv = {bf2f(pgr[t][0]), bf2f(pgr[t][1]), bf2f(pgr[t][2]), bf2f(pgr[t][3])};
        pg[t] = inr ? cv : z4;
      }
#pragma unroll
      for (int t = 0; t < 16; ++t) {
        f32x4 acc = z4;
#pragma unroll
        for (int j = 0; j < 5; ++j) acc += cw[j] * pg[t + j];
        f32x4 val = {siluf_(acc[0]), siluf_(acc[1]), siluf_(acc[2]), siluf_(acc[3])};
        const int m = m0 + t;
        if (sec < 8) {
          const float ss = row16_sum((val[0] * val[0] + val[1] * val[1]) + (val[2] * val[2] + val[3] * val[3]));
          val = val * rsqrtf(ss + 1e-6f);
          if (sec < 4) { const f32x4 vq = val * 0.125f; *(bf16x4*)(GDQ + (size_t)m * 256 + sec * 64 + sc4) = pack4(vq[0], vq[1], vq[2], vq[3]); }
          else *(bf16x4*)(GDK + (size_t)m * 256 + (sec - 4) * 64 + sc4) = pack4(val[0], val[1], val[2], val[3]);
        } else *(bf16x4*)(GDV + (size_t)m * 256 + (sec - 8) * 64 + sc4) = pack4(val[0], val[1], val[2], val[3]);
      }
    } else if (is_na) {
      const f32x4 gq = *(const f32x4*)(qg + sc4) * (0.125f * 1.4426950408889634f), gk = *(const f32x4*)(kg + sc4);
#pragma unroll
      for (int t = 0; t < 16; ++t) {
        f32x4 val = {bf2f(pgr[t][0]), bf2f(pgr[t][1]), bf2f(pgr[t][2]), bf2f(pgr[t][3])};
        const float ss = row16_sum((val[0] * val[0] + val[1] * val[1]) + (val[2] * val[2] + val[3] * val[3]));
        val = val * rsqrtf(ss * (1.f / 64.f) + 1e-6f);
        const int m = m0 + t;
        if (sec < 8) { const f32x4 o = val * gq; *(bf16x4*)(QN + (size_t)m * 512 + sec * 64 + sc4) = pack4(o[0], o[1], o[2], o[3]); }
        else { const f32x4 o = val * gk; *(bf16x4*)(KN + (size_t)m * 512 + (sec - 8) * 64 + sc4) = pack4(o[0], o[1], o[2], o[3]); }
      }
    }
    if (tid_t < 256) {
      const int t = tid_t >> 4, j = tid_t & 15;
      const int m = m0 + t;
      const float pv = bf2f((short)P[(size_t)m * PINP + B_END + 1024 + j]);
      float o;
      if (j < 8) o = -__expf(A_log[j]) * softplusf_(pv + dt_bias[j]);
      else o = sigmoidf_(pv);
      GDAB[(size_t)m * 16 + j] = o;
    }
    {
      const int vc = (tid_t & 127) * 4, tq = (tid_t >> 7) * 4;
#pragma unroll
      for (int i = 0; i < 4; ++i) {
        const int hd = vc + i;
        bfr* dst = VT + ((size_t)(bb * 8 + (hd >> 6)) * (TTOK / 16) + (tau0 >> 4)) * 1024 + (hd & 63) * 16 + tq;
        const bf16x4 o = {pvr[0][i], pvr[1][i], pvr[2][i], pvr[3][i]};
        *(bf16x4*)dst = o;
      }
    }
    LBAR();
  }
  __syncthreads();
}

__device__ __forceinline__ int scan_tok(int b, int d, int s) {
  if (s < CTXL) { int t = d ? (CTXL - 1 - s) : s; return NLAT + b * CTXL + t; }
  int u = s - CTXL; int t = d ? (SEQ - 1 - u) : u; return b * SEQ + t;
}
#define CS 72
#define SLOT_BYTES (64 * CS * 2)
#define F0_STRIDE 68
#define X1_F0 (13 * SLOT_BYTES)
#define X1_ARR (X1_F0 + 64 * F0_STRIDE * 4)

#define MM_FRAGS(As, Bs, a0, a1, b00, b01, b10, b11)                                                     \
  const bf16x8 a0 = *(const bf16x8*)((As) + ((mt * 16 + fr) * CS + fq * 8) * 2);                         \
  const bf16x8 a1 = *(const bf16x8*)((As) + ((mt * 16 + fr) * CS + 32 + fq * 8) * 2);                    \
  const bf16x8 b00 = *(const bf16x8*)((Bs) + ((nt0 * 16 + fr) * CS + fq * 8) * 2);                       \
  const bf16x8 b01 = *(const bf16x8*)((Bs) + ((nt0 * 16 + fr) * CS + 32 + fq * 8) * 2);                  \
  const bf16x8 b10 = *(const bf16x8*)((Bs) + ((nt0 * 16 + 16 + fr) * CS + fq * 8) * 2);                  \
  const bf16x8 b11 = *(const bf16x8*)((Bs) + ((nt0 * 16 + 16 + fr) * CS + 32 + fq * 8) * 2);
#define MM_2TILES(acc0, acc1, a0, a1, b00, b01, b10, b11)                                                \
  acc0 = __builtin_amdgcn_mfma_f32_16x16x32_bf16(a0, b00, acc0, 0, 0, 0);                                \
  acc0 = __builtin_amdgcn_mfma_f32_16x16x32_bf16(a1, b01, acc0, 0, 0, 0);                                \
  acc1 = __builtin_amdgcn_mfma_f32_16x16x32_bf16(a0, b10, acc1, 0, 0, 0);                                \
  acc1 = __builtin_amdgcn_mfma_f32_16x16x32_bf16(a1, b11, acc1, 0, 0, 0);
__device__ __forceinline__ void wr_T(char* slot, int mt, int nt, int fr, int fq, f32x4 v) {
  *(bf16x4*)(slot + ((nt * 16 + fr) * CS + mt * 16 + 4 * fq) * 2) = pack4(v[0], v[1], v[2], v[3]);
}

struct ChunkIn { float lw[8], be[8]; unsigned f0[8], f1[8], f2[8], f3[8], xv[8]; };
template <bool GDN>
__device__ __forceinline__ void chunk_load(PP pp, int t, ChunkIn& ci) {
  const int tid = tid_opaque(), c = tid & 63, tg = wave_id(tid);
  const int chain = t / NCHUNK, n = t - chain * NCHUNK;
  const int d = chain & 1, h = (chain >> 1) & 3, b = (chain >> 3) & 1;
  const char* S = p.ws + OFF_S;
#pragma unroll
  for (int u = 0; u < 8; ++u) {
    const int m = scan_tok(b, d, n * 64 + tg * 8 + u);
    const size_t o = (size_t)m * 256 + h * 64 + c;
    if (!GDN) {
      ci.lw[u] = ((const float*)(S + S_RWW))[(size_t)d * NTOK * 256 + o];
      ci.f0[u] = ((const unsigned short*)(S + S_RWKK))[o];
      ci.f1[u] = ((const unsigned short*)(S + S_RWB))[(size_t)d * NTOK * 256 + o];
      ci.f2[u] = ((const unsigned short*)(S + S_RWKD))[(size_t)d * NTOK * 256 + o];
      ci.f3[u] = ((const unsigned short*)(S + S_RWR))[o];
      ci.xv[u] = ((const unsigned short*)(S + S_RWV))[o];
      ci.be[u] = 1.f;
    } else {
      ci.lw[u] = ((const float*)(S + S_GDAB))[(size_t)m * 16 + d * 4 + h];
      ci.be[u] = ((const float*)(S + S_GDAB))[(size_t)m * 16 + 8 + d * 4 + h];
      ci.f0[u] = ((const unsigned short*)(S + S_GDK))[o];
      ci.f3[u] = ((const unsigned short*)(S + S_GDQ))[o];
      ci.xv[u] = ((const unsigned short*)(S + S_GDV))[o];
      ci.f1[u] = 0u; ci.f2[u] = 0u;
    }
  }
}
template <bool GDN>
__device__ __forceinline__ void chunk_prep_task(PP pp, int t, int t_next, bool has_next, const ChunkIn& ci, ChunkIn& nx, char* smem) {
  const int chain = t / NCHUNK, n = t - chain * NCHUNK;
  const int d = chain & 1, h = (chain >> 1) & 3, b = (chain >> 3) & 1;
  (void)b; (void)d; (void)h;
  const int tid = tid_opaque(), lane = tid & 63, wv = wave_id(tid);
  const int fr = lane & 15, fq = lane >> 4, mt = wv >> 1, nt0 = (wv & 1) * 2;
  char* S = p.ws + OFF_S;
  char* CH = p.ws + OFF_CH;
  const size_t cc = (size_t)chain * NCHUNK + n;
  char* const p0 = smem;
  char* const p1 = smem + 1 * SLOT_BYTES;
  char* const p2 = smem + 2 * SLOT_BYTES;
  char* const p3 = smem + 3 * SLOT_BYTES;
  char* const p4 = smem + 4 * SLOT_BYTES;
  char* const p5 = smem + 5 * SLOT_BYTES;
  char* const p6 = smem + 6 * SLOT_BYTES;
  char* const p7 = smem + 7 * SLOT_BYTES;
  char* const p8 = smem + 8 * SLOT_BYTES;
  char* const p9 = smem + 9 * SLOT_BYTES;
  char* const p10 = smem + 10 * SLOT_BYTES;
  char* const p11 = smem + 11 * SLOT_BYTES;
  char* const p12 = smem + 12 * SLOT_BYTES;
  float* const F0 = (float*)(smem + X1_F0);
  float* const Lv = (float*)(smem + X1_ARR);
  float* const Lm1v = Lv + 64;
  float* const betav = Lv + 128;
  float* const eLv = Lv + 192;
  float* const gC = Lv + 256;
  float* const gsum = Lv + 320;
  char* const sKt = p0;
  char* const sBh = GDN ? p0 : p1;
  char* const sKh = GDN ? p0 : p2;

  {
    const int c = lane, tg = wv;
    const float* lw = ci.lw; const float* be = ci.be;
    float f0[8], f1[8], f2[8], f3[8], xv[8];
#pragma unroll
    for (int u = 0; u < 8; ++u) {
      f0[u] = __uint_as_float(ci.f0[u] << 16); f1[u] = __uint_as_float(ci.f1[u] << 16); f2[u] = __uint_as_float(ci.f2[u] << 16);
      f3[u] = __uint_as_float(ci.f3[u] << 16); xv[u] = __uint_as_float(ci.xv[u] << 16);
    }
    float cum[8];
    cum[0] = lw[0];
#pragma unroll
    for (int u = 1; u < 8; ++u) cum[u] = cum[u - 1] + lw[u];
    gsum[tg * 64 + c] = cum[7];
    LBAR();
    float off = 0.f, LC = 0.f;
#pragma unroll
    for (int g2 = 0; g2 < 8; ++g2) { const float gs = gsum[g2 * 64 + c]; LC += gs; off += (g2 < tg) ? gs : 0.f; }
    bf16x8 vKtT, vBbT, vKbT, vXT;
#pragma unroll
    for (int u = 0; u < 8; ++u) {
      const int t = tg * 8 + u;
      const float L = off + cum[u], Lm1 = L - lw[u];
      if (!GDN) {
        const float eLm1 = __expf(Lm1), enL = __expf(-L), eL = __expf(L), eCL = __expf(LC - L);
        const float kt = f0[u] * eLm1;
        *(bfr*)(p0 + (t * CS + c) * 2) = f2bf(kt);
        *(bfr*)(p1 + (t * CS + c) * 2) = f2bf(f1[u] * enL);
        *(bfr*)(p2 + (t * CS + c) * 2) = f2bf(f2[u] * enL);
        *(bfr*)(p3 + (t * CS + c) * 2) = f2bf(f3[u] * eL);
        vKtT[u] = (short)f2bf(kt);
        vBbT[u] = (short)f2bf(f1[u] * eCL);
        vKbT[u] = (short)f2bf(f2[u] * eCL);
        vXT[u] = (short)f2bf(xv[u]);
      } else {
        *(bfr*)(p0 + (t * CS + c) * 2) = f2bf(f0[u]);
        *(bfr*)(p3 + (t * CS + c) * 2) = f2bf(f3[u]);
        vKtT[u] = (short)f2bf(f0[u] * __expf(Lm1));
        vBbT[u] = (short)f2bf(be[u] * f0[u] * __expf(LC - Lm1));
        vKbT[u] = (short)f2bf(f0[u] * __expf(LC - L));
        vXT[u] = (short)f2bf(be[u] * xv[u]);
        if (c == 0) { Lv[t] = L; Lm1v[t] = Lm1; betav[t] = be[u]; eLv[t] = __expf(L); }
      }
    }
    *(bf16x8*)(p4 + (c * CS + tg * 8) * 2) = vKtT;
    *(bf16x8*)(p5 + (c * CS + tg * 8) * 2) = vBbT;
    *(bf16x8*)(p6 + (c * CS + tg * 8) * 2) = vKbT;
    *(bf16x8*)(p7 + (c * CS + tg * 8) * 2) = vXT;
    if (tg == 0) gC[c] = __expf(LC);
    if (!GDN && tid < 64) { Lv[tid] = 0.f; Lm1v[tid] = 0.f; betav[tid] = 1.f; eLv[tid] = 1.f; }
  }
  LBAR();
  if (has_next) chunk_load<GDN>(pp, t_next, nx);
  {
    {
      MM_FRAGS(sKt, sBh, a0, a1, b00, b01, b10, b11)
      f32x4 c0 = {0.f, 0.f, 0.f, 0.f}, c1 = c0;
      MM_2TILES(c0, c1, a0, a1, b00, b01, b10, b11)
#pragma unroll
      for (int q = 0; q < 2; ++q) {
        const int sI = (nt0 + q) * 16 + fr;
        const f32x4 cv = q ? c1 : c0;
        f32x4 o;
#pragma unroll
        for (int r = 0; r < 4; ++r) {
          const int tI = mt * 16 + 4 * fq + r;
          float v = cv[r];
          if (GDN) v *= betav[sI] * __expf(fminf(Lm1v[tI] - Lm1v[sI], 0.f));
          o[r] = (sI < tI) ? v : 0.f;
        }
        *(f32x4*)(F0 + sI * F0_STRIDE + mt * 16 + 4 * fq) = o;
        wr_T(p11, mt, nt0 + q, fr, fq, o);
      }
    }
    {
      MM_FRAGS(sKt, sKh, a0, a1, b00, b01, b10, b11)
      f32x4 c0 = {0.f, 0.f, 0.f, 0.f}, c1 = c0;
      MM_2TILES(c0, c1, a0, a1, b00, b01, b10, b11)
#pragma unroll
      for (int q = 0; q < 2; ++q) {
        const int sI = (nt0 + q) * 16 + fr;
        const f32x4 cv = q ? c1 : c0;
        f32x4 o;
#pragma unroll
        for (int r = 0; r < 4; ++r) {
          const int tI = mt * 16 + 4 * fq + r;
          float v = cv[r];
          if (GDN) v *= __expf(fminf(Lm1v[tI] - Lv[sI], 0.f));
          o[r] = (sI < tI) ? v : 0.f;
        }
        wr_T(p9, mt, nt0 + q, fr, fq, o);
      }
    }
    {
      MM_FRAGS(sBh, p3, a0, a1, b00, b01, b10, b11)
      f32x4 c0 = {0.f, 0.f, 0.f, 0.f}, c1 = c0;
      MM_2TILES(c0, c1, a0, a1, b00, b01, b10, b11)
#pragma unroll
      for (int q = 0; q < 2; ++q) {
        const int tI = (nt0 + q) * 16 + fr;
        const f32x4 cv = q ? c1 : c0;
        f32x4 o;
#pragma unroll
        for (int r = 0; r < 4; ++r) {
          const int sI = mt * 16 + 4 * fq + r;
          float v = cv[r];
          if (GDN) v *= betav[sI] * __expf(fminf(Lv[tI] - Lm1v[sI], 0.f));
          o[r] = (sI <= tI) ? v : 0.f;
        }
        wr_T(p10, mt, nt0 + q, fr, fq, o);
      }
    }
  }
  LBAR();
  if (wv < 2) {
    const int base = wv * 32, other = 32 - base, c = lane & 31;
    float tr[32];
#pragma unroll
    for (int j = 0; j < 32; ++j) tr[j] = 0.f;
#pragma unroll
    for (int ip = 15; ip >= 0; --ip) {
      const int i = 2 * ip + 1, i2 = 2 * ip;
      float a0 = (c == i) ? 1.f : 0.f, a1 = 0.f, b0 = (c == i2) ? 1.f : 0.f, b1 = 0.f;
      const float aii = F0[(base + i2) * F0_STRIDE + base + i];
#pragma unroll
      for (int jb = ((i + 1) & ~3); jb < 32; jb += 4) {
        const f32x4 a4 = *(const f32x4*)(F0 + (base + i) * F0_STRIDE + base + jb);
        const f32x4 b4 = *(const f32x4*)(F0 + (base + i2) * F0_STRIDE + base + jb);
        a0 -= a4[0] * tr[jb]; a1 -= a4[1] * tr[jb + 1]; a0 -= a4[2] * tr[jb + 2]; a1 -= a4[3] * tr[jb + 3];
        b0 -= b4[0] * tr[jb]; b1 -= b4[1] * tr[jb + 1]; b0 -= b4[2] * tr[jb + 2]; b1 -= b4[3] * tr[jb + 3];
      }
      const float ti = a0 + a1;
      const float ti2 = (b0 + b1) - aii * ti;
      tr[i] = ti; tr[i2] = ti2;
      if (lane < 32) {
        *(bfr*)(p8 + ((base + i) * CS + base + c) * 2) = f2bf(ti);
        *(bfr*)(p8 + ((base + i) * CS + other + c) * 2) = (bfr)0;
        *(bfr*)(p8 + ((base + i2) * CS + base + c) * 2) = f2bf(ti2);
        *(bfr*)(p8 + ((base + i2) * CS + other + c) * 2) = (bfr)0;
      }
    }
    if (lane < 32) {
#pragma unroll
      for (int q = 0; q < 4; ++q) {
        bf16x8 o, z;
#pragma unroll
        for (int j = 0; j < 8; ++j) { o[j] = (short)f2bf(tr[8 * q + j]); z[j] = 0; }
        *(bf16x8*)(p12 + ((base + c) * CS + base + 8 * q) * 2) = o;
        *(bf16x8*)(p12 + ((base + c) * CS + other + 8 * q) * 2) = z;
      }
    }
  }
  LBAR();
  {
    MM_FRAGS(p11, p12, a0, a1, b00, b01, b10, b11)
    f32x4 c0 = {0.f, 0.f, 0.f, 0.f}, c1 = c0;
    MM_2TILES(c0, c1, a0, a1, b00, b01, b10, b11)
    wr_T(p1, mt, nt0, fr, fq, c0);
    wr_T(p1, mt, nt0 + 1, fr, fq, c1);
  }
  LBAR();
  if (mt < 2 && nt0 == 2) {
    MM_FRAGS(p8, p1, a0, a1, b00, b01, b10, b11)
    f32x4 c0 = {0.f, 0.f, 0.f, 0.f}, c1 = c0;
    MM_2TILES(c0, c1, a0, a1, b00, b01, b10, b11)
#pragma unroll
    for (int r = 0; r < 4; ++r) {
      *(bfr*)(p8 + ((mt * 16 + 4 * fq + r) * CS + (nt0) * 16 + fr) * 2) = f2bf(-c0[r]);
      *(bfr*)(p8 + ((mt * 16 + 4 * fq + r) * CS + (nt0 + 1) * 16 + fr) * 2) = f2bf(-c1[r]);
    }
  }
  LBAR();
  {
    {
      MM_FRAGS(p8, p5, a0, a1, b00, b01, b10, b11)
      f32x4 c0 = {0.f, 0.f, 0.f, 0.f}, c1 = c0;
      MM_2TILES(c0, c1, a0, a1, b00, b01, b10, b11)
      wr_T(p11, mt, nt0, fr, fq, -c0);
      wr_T(p11, mt, nt0 + 1, fr, fq, -c1);
    }
    {
      MM_FRAGS(p8, p10, a0, a1, b00, b01, b10, b11)
      f32x4 c0 = {0.f, 0.f, 0.f, 0.f}, c1 = c0;
      MM_2TILES(c0, c1, a0, a1, b00, b01, b10, b11)
      wr_T(p12, mt, nt0, fr, fq, -c0);
      wr_T(p12, mt, nt0 + 1, fr, fq, -c1);
    }
  }
  LBAR();
  {
    {
      MM_FRAGS(p4, p11, a0, a1, b00, b01, b10, b11)
      f32x4 c0 = {0.f, 0.f, 0.f, 0.f}, c1 = c0;
      MM_2TILES(c0, c1, a0, a1, b00, b01, b10, b11)
#pragma unroll
      for (int q = 0; q < 2; ++q) {
        const int cp = (nt0 + q) * 16 + fr;
        f32x4 cv = q ? c1 : c0;
#pragma unroll
        for (int r = 0; r < 4; ++r) { const int cI = mt * 16 + 4 * fq + r; if (cI == cp) cv[r] += gC[cI]; }
        wr_T(p10, mt, nt0 + q, fr, fq, cv);
      }
    }
    {
      MM_FRAGS(p9, p11, a0, a1, b00, b01, b10, b11)
      f32x4 c0 = {0.f, 0.f, 0.f, 0.f}, c1 = c0;
      MM_2TILES(c0, c1, a0, a1, b00, b01, b10, b11)
#pragma unroll
      for (int q = 0; q < 2; ++q) {
        const int cp = (nt0 + q) * 16 + fr;
        f32x4 cv = q ? c1 : c0;
        const bf16x4 kb = *(const bf16x4*)(p6 + (cp * CS + mt * 16 + 4 * fq) * 2);
#pragma unroll
        for (int r = 0; r < 4; ++r) cv[r] += __uint_as_float(((unsigned)(unsigned short)kb[r]) << 16);
        wr_T(p8, mt, nt0 + q, fr, fq, cv);
      }
    }
    {
      MM_FRAGS(p4, p12, a0, a1, b00, b01, b10, b11)
      f32x4 c0 = {0.f, 0.f, 0.f, 0.f}, c1 = c0;
      MM_2TILES(c0, c1, a0, a1, b00, b01, b10, b11)
#pragma unroll
      for (int q = 0; q < 2; ++q) {
        const int tI = (nt0 + q) * 16 + fr;
        f32x4 cv = q ? c1 : c0;
        const bf16x4 rt = *(const bf16x4*)(p3 + (tI * CS + mt * 16 + 4 * fq) * 2);
        const float el = eLv[tI];
#pragma unroll
        for (int r = 0; r < 4; ++r) cv[r] += __uint_as_float(((unsigned)(unsigned short)rt[r]) << 16) * el;
        wr_T(p1, mt, nt0 + q, fr, fq, cv);
      }
    }
    {
      f32x4 c0 = {0.f, 0.f, 0.f, 0.f}, c1 = c0;
      {
        MM_FRAGS(sKh, p3, a0, a1, b00, b01, b10, b11)
        MM_2TILES(c0, c1, a0, a1, b00, b01, b10, b11)
      }
#pragma unroll
      for (int q = 0; q < 2; ++q) {
        const int tI = (nt0 + q) * 16 + fr;
#pragma unroll
        for (int r = 0; r < 4; ++r) {
          const int sI = mt * 16 + 4 * fq + r;
          float v = q ? c1[r] : c0[r];
          if (GDN) v *= __expf(fminf(Lv[tI] - Lv[sI], 0.f));
          v = (sI <= tI) ? v : 0.f;
          if (q) c1[r] = v; else c0[r] = v;
        }
      }
      {
        MM_FRAGS(p9, p12, a0, a1, b00, b01, b10, b11)
        MM_2TILES(c0, c1, a0, a1, b00, b01, b10, b11)
      }
      wr_T(p5, mt, nt0, fr, fq, c0);
      wr_T(p5, mt, nt0 + 1, fr, fq, c1);
    }
  }
  LBAR();
  {
    {
      MM_FRAGS(p8, p7, a0, a1, b00, b01, b10, b11)
      f32x4 c0 = {0.f, 0.f, 0.f, 0.f}, c1 = c0;
      MM_2TILES(c0, c1, a0, a1, b00, b01, b10, b11)
      bfr* QT = (bfr*)(CH + cc * CH_REC + CH_QT);
      *(bf16x4*)(QT + ((mt * 4 + nt0) * 64 + lane) * 4) = pack4(c0[0], c0[1], c0[2], c0[3]);
      *(bf16x4*)(QT + ((mt * 4 + nt0 + 1) * 64 + lane) * 4) = pack4(c1[0], c1[1], c1[2], c1[3]);
    }
    {
      MM_FRAGS(p7, p5, a0, a1, b00, b01, b10, b11)
      f32x4 c0 = {0.f, 0.f, 0.f, 0.f}, c1 = c0;
      MM_2TILES(c0, c1, a0, a1, b00, b01, b10, b11)
      bfr* YX = (bfr*)(CH + cc * CH_REC + CH_YX);
      *(bf16x4*)(YX + ((mt * 4 + nt0) * 64 + lane) * 4) = pack4(c0[0], c0[1], c0[2], c0[3]);
      *(bf16x4*)(YX + ((mt * 4 + nt0 + 1) * 64 + lane) * 4) = pack4(c1[0], c1[1], c1[2], c1[3]);
    }
    {
      const int fm = wv >> 1, fa = wv & 1;
      const int row = fm * 16 + fr;
      {
        const bf16x4 lo = *(const bf16x4*)(p10 + (row * CS + 32 * fa + 4 * fq) * 2);
        const bf16x4 hi = *(const bf16x4*)(p10 + (row * CS + 32 * fa + 16 + 4 * fq) * 2);
        bf16x8 f; f[0] = lo[0]; f[1] = lo[1]; f[2] = lo[2]; f[3] = lo[3]; f[4] = hi[0]; f[5] = hi[1]; f[6] = hi[2]; f[7] = hi[3];
        *(bf16x8*)(CH + cc * CH_REC + CH_PT + (size_t)((fm * 2 + fa) * 64 + lane) * 16) = f;
      }
      {
        const bf16x4 lo = *(const bf16x4*)(p1 + (row * CS + 32 * fa + 4 * fq) * 2);
        const bf16x4 hi = *(const bf16x4*)(p1 + (row * CS + 32 * fa + 16 + 4 * fq) * 2);
        bf16x8 f; f[0] = lo[0]; f[1] = lo[1]; f[2] = lo[2]; f[3] = lo[3]; f[4] = hi[0]; f[5] = hi[1]; f[6] = hi[2]; f[7] = hi[3];
        *(bf16x8*)(CH + cc * CH_REC + CH_RYT + (size_t)((fm * 2 + fa) * 64 + lane) * 16) = f;
      }
    }
  }
  LBAR();
}

template <bool GDN>
__device__ __forceinline__ void chunk_prep_loop(PP pp, int t0, int tend, int nb, char* smem) {
  ChunkIn cur, nxt;
  if (t0 < tend) chunk_load<GDN>(pp, t0, cur);
  for (int t = t0; t < tend; t += nb) {
    const bool has_next = (t + nb) < tend;
    chunk_prep_task<GDN>(pp, t, t + nb, has_next, cur, nxt, smem);
    cur = nxt;
  }
}
__device__ __forceinline__ void phase_chunk_prep(PP pp, int bid, int nb, char* smem) {
  __syncthreads();
  const int half = (NCHAIN / 2) * NCHUNK;
  chunk_prep_loop<false>(pp, bid, half, nb, smem);
  const int k0 = (half - bid + nb - 1) / nb;
  chunk_prep_loop<true>(pp, bid + k0 * nb, NCHAIN * NCHUNK, nb, smem);
  __syncthreads();
}

#define X2_BUF 32768
#define X2_BAR() do { asm volatile("s_waitcnt lgkmcnt(0)" ::: "memory"); __builtin_amdgcn_s_barrier(); asm volatile("" ::: "memory"); } while (0)
__device__ __forceinline__ void chunk_seq_chain(PP pp, int chain, char* smem) {
  __syncthreads();
  const int tid = tid_opaque(), lane = tid & 63, wv = wave_id(tid);
  const int d = chain & 1, h = (chain >> 1) & 3, b = (chain >> 3) & 1, ty = chain >> 4;
  const char* CH = p.ws + OFF_CH;
  bfr* Y = (bfr*)(p.ws + OFF_S + (ty ? S_YGD : S_YRW)) + (size_t)d * NTOK * 256;
  const size_t c0 = (size_t)chain * NCHUNK;
  if (wv >= 4) {
    const int lw = wv - 4;
    const char* src0 = CH + c0 * CH_REC + (size_t)lane * 16;
#define X2_DMA(n) { const char* s_ = src0 + (size_t)(n) * CH_REC; LAS unsigned char* d_ = (LAS unsigned char*)smem + ((n) & 3) * X2_BUF;       \
      _Pragma("unroll") for (int i = 0; i < 8; ++i) {                                                                                       \
        const int piece = i * 4 + lw;                                                                                                       \
        __builtin_amdgcn_global_load_lds((const unsigned*)(s_ + piece * 1024), (LAS unsigned*)(d_ + piece * 1024), 16, 0, 0); } }
    X2_DMA(0) X2_DMA(1) X2_DMA(2)
    asm volatile("s_waitcnt vmcnt(16)" ::: "memory");
    X2_BAR();
    for (int n = 0; n < NCHUNK; ++n) {
      if (n + 3 < NCHUNK) { X2_DMA(n + 3) asm volatile("s_waitcnt vmcnt(16)" ::: "memory"); }
      else if (n + 2 < NCHUNK) asm volatile("s_waitcnt vmcnt(8)" ::: "memory");
      else asm volatile("s_waitcnt vmcnt(0)" ::: "memory");
      X2_BAR();
    }
#undef X2_DMA
  } else {
    const int vt = wv, fr = lane & 15, fq = lane >> 4;
    f32x4 Sacc[4];
#pragma unroll
    for (int i = 0; i < 4; ++i) Sacc[i] = (f32x4){0.f, 0.f, 0.f, 0.f};
    X2_BAR();
    for (int n = 0; n < NCHUNK; ++n) {
      const char* buf = smem + (n & 3) * X2_BUF;
      bf16x8 sB0, sB1;
#pragma unroll
      for (int j = 0; j < 4; ++j) {
        sB0[j] = (short)f2bf(Sacc[0][j]); sB0[4 + j] = (short)f2bf(Sacc[1][j]);
        sB1[j] = (short)f2bf(Sacc[2][j]); sB1[4 + j] = (short)f2bf(Sacc[3][j]);
      }
#pragma unroll
      for (int m = 0; m < 4; ++m) {
        const bf16x8 pa0 = *(const bf16x8*)(buf + ((m * 2 + 0) * 64 + lane) * 16);
        const bf16x8 pa1 = *(const bf16x8*)(buf + ((m * 2 + 1) * 64 + lane) * 16);
        const bf16x8 ra0 = *(const bf16x8*)(buf + 8192 + ((m * 2 + 0) * 64 + lane) * 16);
        const bf16x8 ra1 = *(const bf16x8*)(buf + 8192 + ((m * 2 + 1) * 64 + lane) * 16);
        const bf16x4 qb = *(const bf16x4*)(buf + 16384 + ((m * 4 + vt) * 64 + lane) * 8);
        const bf16x4 yb = *(const bf16x4*)(buf + 24576 + ((vt * 4 + m) * 64 + lane) * 8);
        f32x4 y = {bf2f(yb[0]), bf2f(yb[1]), bf2f(yb[2]), bf2f(yb[3])};
        y = __builtin_amdgcn_mfma_f32_16x16x32_bf16(sB0, ra0, y, 0, 0, 0);
        y = __builtin_amdgcn_mfma_f32_16x16x32_bf16(sB1, ra1, y, 0, 0, 0);
        f32x4 sn = {bf2f(qb[0]), bf2f(qb[1]), bf2f(qb[2]), bf2f(qb[3])};
        sn = __builtin_amdgcn_mfma_f32_16x16x32_bf16(pa0, sB0, sn, 0, 0, 0);
        sn = __builtin_amdgcn_mfma_f32_16x16x32_bf16(pa1, sB1, sn, 0, 0, 0);
        Sacc[m] = sn;
        {
          const int mm = scan_tok(b, d, n * 64 + m * 16 + fr);
          *(bf16x4*)(Y + (size_t)mm * 256 + h * 64 + vt * 16 + 4 * fq) = pack4(y[0], y[1], y[2], y[3]);
        }
      }
      X2_BAR();
    }
  }
}

struct NaPair { int mk0, mk1, tau0, tau1, kr0, kr1, ct0, ct1; };
struct NaFrag { bf16x8 k00, k01, k10, k11; bf16x4 v0[4], v1[4]; };

__device__ __forceinline__ void na_load(NaFrag& f, const bfr* KN, const bfr* VT, size_t vt_base, int h, int fr, int fq, const NaPair& pr) {
  const bfr* k0 = KN + (size_t)(pr.mk0 + fr) * 512 + h * 64 + fq * 8;
  const bfr* k1 = KN + (size_t)(pr.mk1 + fr) * 512 + h * 64 + fq * 8;
  f.k00 = *(const bf16x8*)(k0); f.k01 = *(const bf16x8*)(k0 + 32);
  f.k10 = *(const bf16x8*)(k1); f.k11 = *(const bf16x8*)(k1 + 32);
#pragma unroll
  for (int dt = 0; dt < 4; ++dt) {
    const int vo = (dt * 16 + fr) * 16 + fq * 4;
    f.v0[dt] = *(const bf16x4*)(VT + vt_base + (size_t)(pr.tau0 >> 4) * 1024 + vo);
    f.v1[dt] = *(const bf16x4*)(VT + vt_base + (size_t)(pr.tau1 >> 4) * 1024 + vo);
  }
}

__device__ __forceinline__ void na_compute(const NaFrag& f, const bf16x8 qf0, const bf16x8 qf1, bool local, bool vr0, bool vr1,
                                           int dr0, int dr1, int ct0, int ct1, int qc, int fq, const float* bias_h, f32x4 (&O)[4], float& lsum) {
  f32x4 z = {0.f, 0.f, 0.f, 0.f};
  f32x4 st0 = __builtin_amdgcn_mfma_f32_16x16x32_bf16(f.k00, qf0, z, 0, 0, 0);
  st0 = __builtin_amdgcn_mfma_f32_16x16x32_bf16(f.k01, qf1, st0, 0, 0, 0);
  f32x4 st1 = __builtin_amdgcn_mfma_f32_16x16x32_bf16(f.k10, qf0, z, 0, 0, 0);
  st1 = __builtin_amdgcn_mfma_f32_16x16x32_bf16(f.k11, qf1, st1, 0, 0, 0);
  bf16x8 pf;
  if (local) {
    const int cs = min(max(qc - 8, 0), 48);
    const int kb0 = ct0 * 16 + fq * 4, kb1 = ct1 * 16 + fq * 4;
    const float* bp0 = bias_h + min(max(dr0 * 31 + kb0 - qc + 15, -32), 493);
    const float* bp1 = bias_h + min(max(dr1 * 31 + kb1 - qc + 15, -32), 493);
    const float b00 = bp0[0], b01 = bp0[1], b02 = bp0[2], b03 = bp0[3];
    const float b10 = bp1[0], b11 = bp1[1], b12 = bp1[2], b13 = bp1[3];
    const float bb0[4] = {b00, b01, b02, b03}, bb1[4] = {b10, b11, b12, b13};
#pragma unroll
    for (int r = 0; r < 4; ++r) {
      const bool ok0 = vr0 && (unsigned)(kb0 + r - cs) < 16u, ok1 = vr1 && (unsigned)(kb1 + r - cs) < 16u;
      const float e0 = __builtin_amdgcn_exp2f(st0[r] + bb0[r]), e1 = __builtin_amdgcn_exp2f(st1[r] + bb1[r]);
      const float p0 = ok0 ? e0 : 0.f, p1 = ok1 ? e1 : 0.f;
      lsum += p0 + p1;
      pf[r] = (short)f2bf(p0);
      pf[4 + r] = (short)f2bf(p1);
    }
  } else {
#pragma unroll
    for (int r = 0; r < 4; ++r) {
      const float p0 = __builtin_amdgcn_exp2f(st0[r]), p1 = __builtin_amdgcn_exp2f(st1[r]);
      lsum += p0 + p1;
      pf[r] = (short)f2bf(p0);
      pf[4 + r] = (short)f2bf(p1);
    }
  }
#pragma unroll
  for (int dt = 0; dt < 4; ++dt) {
    bf16x8 vf;
    vf[0] = f.v0[dt][0]; vf[1] = f.v0[dt][1]; vf[2] = f.v0[dt][2]; vf[3] = f.v0[dt][3];
    vf[4] = f.v1[dt][0]; vf[5] = f.v1[dt][1]; vf[6] = f.v1[dt][2]; vf[7] = f.v1[dt][3];
    O[dt] = __builtin_amdgcn_mfma_f32_16x16x32_bf16(vf, pf, O[dt], 0, 0, 0);
  }
}

__device__ __forceinline__ void na_block_task(PP pp, int task, const float* bias_lds) {
  const int tid = tid_opaque(), lane = tid & 63, wv = wave_id(tid);
  const int fr = lane & 15, fq = lane >> 4;
  char* S = p.ws + OFF_S;
  const bfr* QN = (const bfr*)(S + S_QN);
  const bfr* KN = (const bfr*)(S + S_KN);
  const bfr* VT = (const bfr*)(S + S_VT);
  bfr* CC = (bfr*)(p.ws + OFF_CC);
  const bool latent = task < 1024;
  int b, h, mqa, mqb, qra = 0, qrb = 0, cgp = 0;
  if (latent) {
    h = task & 7; const int quad = (task >> 3) & 63; b = task >> 9;
    qra = quad * 4 + (wv >> 2) * 2; qrb = qra + 1; cgp = wv & 3;
    mqa = b * SEQ + qra * 64 + cgp * 16; mqb = mqa + 64;
  } else {
    const int u = task - 1024;
    h = u & 7; b = u >> 3;
    mqa = NLAT + b * CTXL + (wv * 2) * 16; mqb = mqa + 16;
  }
  const bf16x8 qa0 = *(const bf16x8*)(QN + (size_t)(mqa + fr) * 512 + h * 64 + fq * 8);
  const bf16x8 qa1 = *(const bf16x8*)(QN + (size_t)(mqa + fr) * 512 + h * 64 + 32 + fq * 8);
  const bf16x8 qb0 = *(const bf16x8*)(QN + (size_t)(mqb + fr) * 512 + h * 64 + fq * 8);
  const bf16x8 qb1 = *(const bf16x8*)(QN + (size_t)(mqb + fr) * 512 + h * 64 + 32 + fq * 8);
  f32x4 Oa[4], Ob[4];
#pragma unroll
  for (int dt = 0; dt < 4; ++dt) { Oa[dt] = (f32x4){0.f, 0.f, 0.f, 0.f}; Ob[dt] = Oa[dt]; }
  float lsa = 0.f, lsb = 0.f;
  const size_t vt_base = (size_t)(b * 8 + h) * 64 * TTOK;
  const int rsa = min(max(qra - 4, 0), SEQ / 64 - 8), rsb = min(max(qrb - 4, 0), SEQ / 64 - 8);
  const int nrows = latent ? (rsb - rsa + 8) : 0;
  const int ct_first = (cgp <= 1) ? 0 : cgp - 1;
  const int nct = (cgp == 0 || cgp == 3) ? 2 : 3;
  const int ntile = nrows * nct;
  const int nlp = (ntile + 1) >> 1;
  const int npair = nlp + 8;
  const int qc = cgp * 16 + fr;
  auto mkpair = [&](int pi) {
    NaPair pr;
    if (pi < nlp) {
      const int i0 = 2 * pi, i1 = min(2 * pi + 1, ntile - 1);
      const int q0 = (nct == 2) ? (i0 >> 1) : ((i0 * 21846) >> 16), q1 = (nct == 2) ? (i1 >> 1) : ((i1 * 21846) >> 16);
      pr.kr0 = rsa + q0; pr.ct0 = ct_first + i0 - q0 * nct;
      pr.kr1 = rsa + q1; pr.ct1 = ct_first + i1 - q1 * nct;
      if (2 * pi + 1 >= ntile) pr.kr1 = -100;
      const int r1 = rsa + q1;
      pr.tau0 = pr.kr0 * 64 + pr.ct0 * 16; pr.tau1 = r1 * 64 + pr.ct1 * 16;
      pr.mk0 = b * SEQ + pr.tau0; pr.mk1 = b * SEQ + pr.tau1;
    } else {
      const int c = pi - nlp;
      pr.kr0 = pr.kr1 = pr.ct0 = pr.ct1 = 0;
      pr.tau0 = SEQ + c * 32; pr.tau1 = SEQ + c * 32 + 16;
      pr.mk0 = NLAT + b * CTXL + c * 32; pr.mk1 = pr.mk0 + 16;
    }
    return pr;
  };
  NaFrag fa, fb;
  NaPair pa = mkpair(0), pb;
  na_load(fa, KN, VT, vt_base, h, fr, fq, pa);
  const float* bias_h = bias_lds + h * 465;
#define NA_DO(F, PR, PI)                                                                                          \
  {                                                                                                               \
    const bool loc_ = (PI) < nlp;                                                                                 \
    na_compute(F, qa0, qa1, loc_, (unsigned)(PR.kr0 - rsa) < 8u, (unsigned)(PR.kr1 - rsa) < 8u,                   \
               PR.kr0 - qra + 7, PR.kr1 - qra + 7, PR.ct0, PR.ct1, qc, fq, bias_h, Oa, lsa);                      \
    na_compute(F, qb0, qb1, loc_, (unsigned)(PR.kr0 - rsb) < 8u, (unsigned)(PR.kr1 - rsb) < 8u,                   \
               PR.kr0 - qrb + 7, PR.kr1 - qrb + 7, PR.ct0, PR.ct1, qc, fq, bias_h, Ob, lsb);                      \
  }
  for (int pi = 0; pi < npair; pi += 2) {
    pb = mkpair(min(pi + 1, npair - 1)); na_load(fb, KN, VT, vt_base, h, fr, fq, pb);
    NA_DO(fa, pa, pi)
    pa = mkpair(min(pi + 2, npair - 1)); na_load(fa, KN, VT, vt_base, h, fr, fq, pa);
    if (pi + 1 < npair) NA_DO(fb, pb, pi + 1)
  }
#undef NA_DO
  lsa += shfl_xor_l(lsa, 16, lane); lsa += shfl_xor_l(lsa, 32, lane);
  lsb += shfl_xor_l(lsb, 16, lane); lsb += shfl_xor_l(lsb, 32, lane);
  const float ia = 1.f / lsa, ib = 1.f / lsb;
#pragma unroll
  for (int dt = 0; dt < 4; ++dt) {
    *(bf16x4*)(CC + (size_t)(mqa + fr) * 1024 + h * 64 + dt * 16 + fq * 4) = pack4(Oa[dt][0] * ia, Oa[dt][1] * ia, Oa[dt][2] * ia, Oa[dt][3] * ia);
    *(bf16x4*)(CC + (size_t)(mqb + fr) * 1024 + h * 64 + dt * 16 + fq * 4) = pack4(Ob[dt][0] * ib, Ob[dt][1] * ib, Ob[dt][2] * ib, Ob[dt][3] * ib);
  }
}

__device__ __forceinline__ void phase_mix(PP pp, int l, int bid, int nb, char* smem) {
  const int tid = tid_opaque();
  const int nscan_blocks = (nb > 32) ? 32 : nb;
  const int first_attn_block = (nb > 32) ? 32 : 0;
  if (bid < nscan_blocks) {
    for (int c = bid; c < NCHAIN; c += nscan_blocks) chunk_seq_chain(pp, c, smem);
  }
  if (bid >= first_attn_block) {
    float* bias = (float*)smem + 64;
    __syncthreads();
    for (int i = tid; i < 8 * 465 + 128; i += NTHR) { const int j = i - 64; bias[j] = ((unsigned)j < 8u * 465u) ? p.na_rpb[(size_t)l * 8 * 465 + j] * 1.4426950408889634f : 0.f; }
    __syncthreads();
    const int ntask = (l == 0) ? 1024 + 16 : 1024;
    const int nab = nb - first_attn_block;
    for (int t = bid - first_attn_block; t < ntask; t += nab) na_block_task(pp, t, bias);
    __syncthreads();
    phase_convert(pp, l, 1, bid - first_attn_block, nab, smem);
    if (l == 0) phase_convert(pp, 1, 0, bid - first_attn_block, nab, smem);
  }
}

__device__ __forceinline__ void phase_post(PP pp, int l, int bid, int nb) {
  const int tid = tid_opaque(), lane = tid & 63, wv = wave_id(tid);
  char* S = p.ws + OFF_S;
  const bfr* YRW = (const bfr*)(S + S_YRW);
  const bfr* YGD = (const bfr*)(S + S_YGD);
  const bfr* RWV = (const bfr*)(S + S_RWV);
  const bfr* RWG = (const bfr*)(S + S_RWG);
  const float* BON = (const float*)(S + S_BON);
  const bfr* P = (const bfr*)(p.ws + OFF_P);
  bfr* CC = (bfr*)(p.ws + OFF_CC);
  const float* ln_w = p.rw_ln_w + (size_t)l * 256;
  const float* ln_b = p.rw_ln_b + (size_t)l * 256;
  const float* ng = p.gd_norm_g + (size_t)l * 64;
  const int ntok = (l == 0) ? NTOK : NLAT;
  const int cb = lane * 4, hh = lane >> 4;
  const f32x4 lw4 = *(const f32x4*)(ln_w + cb), lb4 = *(const f32x4*)(ln_b + cb), ng4 = *(const f32x4*)(ng + (cb & 63));
  for (int m = bid * 8 + wv; m < ntok; m += nb * 8) {
    const size_t o = (size_t)m * 256 + cb;
    const f32x4 y0 = ldbf4(YRW + o), y1 = ldbf4(YRW + (size_t)NTOK * 256 + o);
    const f32x4 rv = ldbf4(RWV + o), rg = ldbf4(RWG + o);
    const f32x4 g0 = ldbf4(YGD + o), g1 = ldbf4(YGD + (size_t)NTOK * 256 + o);
    const f32x4 z = ldbf4(P + (size_t)m * PINP + B_END + 768 + cb);
    const float bon = BON[(size_t)m * 4 + hh];
    {
      const f32x4 y = y0 + y1;
      const float mean = row16_sum((y[0] + y[1]) + (y[2] + y[3])) * (1.f / 64.f);
      const f32x4 dv = y - mean;
      const float var = row16_sum((dv[0] * dv[0] + dv[1] * dv[1]) + (dv[2] * dv[2] + dv[3] * dv[3])) * (1.f / 64.f);
      const f32x4 out = ((dv * rsqrtf(var + 64e-5f)) * lw4 + lb4 + rv * bon) * rg;
      *(bf16x4*)(CC + (size_t)m * 1024 + 512 + cb) = pack4(out[0], out[1], out[2], out[3]);
    }
    {
      const f32x4 y = g0 + g1;
      const float ms = row16_sum((y[0] * y[0] + y[1] * y[1]) + (y[2] * y[2] + y[3] * y[3])) * (1.f / 64.f);
      const f32x4 sz = {siluf_(z[0]), siluf_(z[1]), siluf_(z[2]), siluf_(z[3])};
      const f32x4 out = (y * rsqrtf(ms + 1e-6f)) * ng4 * sz;
      *(bf16x4*)(CC + (size_t)m * 1024 + 768 + cb) = pack4(out[0], out[1], out[2], out[3]);
    }
  }
}

#define RW_LDS_ROW 36
__device__ __forceinline__ void phase_router(PP pp, int l, int bid, int nb, char* smem) {
  const int tid = tid_opaque(), lane = tid & 63, wv = wave_id(tid);
  const float* xl = p.out;
  const float* xc = (const float*)(p.ws + OFF_CTX);
  const float* mods = (const float*)(p.ws + OFF_MODS) + (size_t)l * 3 * 6144;
  const float* g = p.norm_ffn_g + (size_t)l * 1024;
  const float* rw = p.moe_router_w + (size_t)l * 1024 * 32;
  const float* rb = p.moe_router_b + (size_t)l * 32;
  bfr* H = (bfr*)(p.ws + OFF_H);
  int* cnt = (int*)(p.ws + OFF_CNT);
  int* TOKE = (int*)(p.ws + OFF_TOKE);
  int* TOKP = (int*)(p.ws + OFF_TOKP);
  float* TOKG = (float*)(p.ws + OFF_TOKG);
  float* wl = (float*)smem;
  for (int i = tid; i < 1024 * 8; i += NTHR) {
    int d = i >> 3, q = i & 7;
    *(float4*)(wl + d * RW_LDS_ROW + q * 4) = *(const float4*)(rw + (size_t)d * 32 + q * 4);
  }
  __syncthreads();
  const int ntok = (l == 0) ? NTOK : NLAT;
  const float rbl = rb[lane & 31];
  int* lcnt = (int*)(smem + 147456 + 512);
  if (tid < 32) lcnt[tid] = 0;
  char* stg = smem + 147456 + 3072 + wv * 1024;
  __syncthreads();
  float gch[16];
#pragma unroll
  for (int i = 0; i < 16; ++i) gch[i] = g[lane + 64 * i];
  const int mstride = nb * 16;
  int m0 = (bid * 8 + wv) * 2;
  float xa[16], xb[16];
  {
    const int mc = min(m0, ntok - 2);
    const float* pa = (mc < NLAT) ? xl + (size_t)mc * 1024 : xc + (size_t)(mc - NLAT) * 1024;
    const float* pb = (mc + 1 < NLAT) ? xl + (size_t)(mc + 1) * 1024 : xc + (size_t)(mc + 1 - NLAT) * 1024;
#pragma unroll
    for (int i = 0; i < 16; ++i) { xa[i] = pa[lane + 64 * i]; xb[i] = pb[lane + 64 * i]; }
  }
  for (; m0 < ntok; m0 += mstride) {
    float acc0[32], acc1[32];
#pragma unroll
    for (int e = 0; e < 32; ++e) { acc0[e] = 0.f; acc1[e] = 0.f; }
    float hv0[16], hv1[16];
    {
      const int ma = m0, mb = m0 + 1;
      const float* mda = mods + (size_t)mod_row(ma) * 6144 + 3072;
      float scv[16], shv[16];
#pragma unroll
      for (int i = 0; i < 16; ++i) { scv[i] = mda[1024 + lane + 64 * i]; shv[i] = mda[lane + 64 * i]; }
#pragma unroll
      for (int i = 0; i < 16; ++i) { hv0[i] = xa[i]; hv1[i] = xb[i]; }
      asm volatile("" ::: "memory");
      {
        const int mc = min(m0 + mstride, ntok - 2);
        const float* pa = (mc < NLAT) ? xl + (size_t)mc * 1024 : xc + (size_t)(mc - NLAT) * 1024;
        const float* pb = (mc + 1 < NLAT) ? xl + (size_t)(mc + 1) * 1024 : xc + (size_t)(mc + 1 - NLAT) * 1024;
#pragma unroll
        for (int i = 0; i < 16; ++i) { xa[i] = pa[lane + 64 * i]; xb[i] = pb[lane + 64 * i]; }
      }
      asm volatile("" ::: "memory");
      float ssa = 0.f, ssb = 0.f;
#pragma unroll
      for (int i = 0; i < 16; ++i) { ssa += hv0[i] * hv0[i]; ssb += hv1[i] * hv1[i]; }
      ssa = wave_sum(ssa); ssb = wave_sum(ssb);
      const float rsa = rsqrtf(ssa * (1.f / 1024.f) + 1e-6f), rsb = rsqrtf(ssb * (1.f / 1024.f) + 1e-6f);
#pragma unroll
      for (int i = 0; i < 16; ++i) {
        const float gm = gch[i] * (1.f + scv[i]);
        hv0[i] = hv0[i] * rsa * gm + shv[i];
        hv1[i] = hv1[i] * rsb * gm + shv[i];
      }
      float am0 = 0.f, am1 = 0.f;
#pragma unroll
      for (int i = 0; i < 16; ++i) { am0 = fmaxf(am0, fabsf(hv0[i])); am1 = fmaxf(am1, fabsf(hv1[i])); }
      am0 = wave_max(am0); am1 = wave_max(am1);
      const float sc0 = am0 > 0.f ? am0 * (1.f / 127.f) : 1.f, sc1 = am1 > 0.f ? am1 * (1.f / 127.f) : 1.f;
      const float iv0 = 1.f / sc0, iv1 = 1.f / sc1;
      signed char* H8 = (signed char*)(p.ws + OFF_H);
#pragma unroll
      for (int i = 0; i < 16; ++i) stg[lane + 64 * i] = (signed char)(int)fminf(fmaxf(rintf(hv0[i] * iv0), -127.f), 127.f);
      const uint4 rowa = *(const uint4*)(stg + lane * 16);
      *(uint4*)(H8 + (size_t)ma * 1024 + lane * 16) = rowa;
#pragma unroll
      for (int i = 0; i < 16; ++i) stg[lane + 64 * i] = (signed char)(int)fminf(fmaxf(rintf(hv1[i] * iv1), -127.f), 127.f);
      const uint4 rowb = *(const uint4*)(stg + lane * 16);
      *(uint4*)(H8 + (size_t)mb * 1024 + lane * 16) = rowb;
      if (lane == 0) { float* SCL = (float*)(p.ws + OFF_SCL); SCL[ma] = sc0; SCL[mb] = sc1; }
      asm volatile("" ::: "memory");
    }
#pragma unroll
    for (int i = 0; i < 16; ++i) {
      if ((i & 3) == 0) asm volatile("" ::: "memory");
      const float* wr = wl + (lane + 64 * i) * RW_LDS_ROW;
#pragma unroll
      for (int q = 0; q < 8; ++q) {
        const float4 w = *(const float4*)(wr + q * 4);
        acc0[q * 4 + 0] += hv0[i] * w.x; acc0[q * 4 + 1] += hv0[i] * w.y; acc0[q * 4 + 2] += hv0[i] * w.z; acc0[q * 4 + 3] += hv0[i] * w.w;
        acc1[q * 4 + 0] += hv1[i] * w.x; acc1[q * 4 + 1] += hv1[i] * w.y; acc1[q * 4 + 2] += hv1[i] * w.z; acc1[q * 4 + 3] += hv1[i] * w.w;
      }
    }
#define BFLY(A, N, D)                                                                           \
    _Pragma("unroll") for (int i = 0; i < (N); ++i) {                                            \
      const bool up = (lane & (D)) != 0;                                                         \
      const float keep = up ? A[i + (N)] : A[i];                                                 \
      const float send = up ? A[i] : A[i + (N)];                                                 \
      A[i] = keep + shfl_xor_l(send, (D), lane);                                                   \
    }
    BFLY(acc0, 16, 16) BFLY(acc1, 16, 16)
    BFLY(acc0, 8, 8) BFLY(acc1, 8, 8)
    BFLY(acc0, 4, 4) BFLY(acc1, 4, 4)
    BFLY(acc0, 2, 2) BFLY(acc1, 2, 2)
    BFLY(acc0, 1, 1) BFLY(acc1, 1, 1)
#undef BFLY
    float la = acc0[0] + shfl_xor_l(acc0[0], 32, lane);
    float lb = acc1[0] + shfl_xor_l(acc1[0], 32, lane);
    const int my_e = lane & 31;
    la += rbl; lb += rbl;
    (void)my_e;
#pragma unroll
    for (int tkn = 0; tkn < 2; ++tkn) {
      float v = tkn == 0 ? la : lb;
      float tv[4]; int ti[4];
#pragma unroll
      for (int k = 0; k < 4; ++k) {
        float bv = v; int bi = lane & 31;
#pragma unroll
        for (int o = 16; o >= 1; o >>= 1) {
          float ov = shfl_xor_l(bv, o, lane); int oi = shfl_xor_li(bi, o, lane);
          bool take = (ov > bv) || (ov == bv && oi < bi);
          bv = take ? ov : bv; bi = take ? oi : bi;
        }
        tv[k] = bv; ti[k] = bi;
        if ((lane & 31) == bi) v = -3.0e38f;
      }
      float e1 = __expf(tv[1] - tv[0]), e2 = __expf(tv[2] - tv[0]), e3 = __expf(tv[3] - tv[0]);
      float inv = 1.f / (1.f + e1 + e2 + e3);
      const int m = m0 + tkn;
      if (lane < 4) {
        int e = lane == 0 ? ti[0] : lane == 1 ? ti[1] : lane == 2 ? ti[2] : ti[3];
        float gt = (lane == 0 ? 1.f : lane == 1 ? e1 : lane == 2 ? e2 : e3) * inv;
        int pos = atomicAdd(&lcnt[e], 1);
        TOKE[(size_t)m * 4 + lane] = e; TOKP[(size_t)m * 4 + lane] = pos; TOKG[(size_t)m * 4 + lane] = gt;
      }
    }
  }
  __syncthreads();
  if (tid < 32) ((int*)(p.ws + OFF_BASE))[bid * 32 + tid] = atomicAdd(&cnt[tid], lcnt[tid]);
  __syncthreads();
}

__device__ __forceinline__ void moe_offsets(PP pp, int* toff) {
  const int* cnt = (const int*)(p.ws + OFF_CNT);
  if (tid_opaque() == 0) {
    int a = 0;
    for (int e = 0; e < 32; ++e) { const int c = cnt[e]; toff[e] = a; toff[96 + e] = c; a += (c + 255) >> 8; }
    toff[32] = a;
  }
  __syncthreads();
}
__device__ __forceinline__ void moe_tile_experts(int* toff) {
  int* texp = toff + 128;
  const int ntile = toff[32];
  for (int mt = tid_opaque(); mt < ntile; mt += NTHR) {
    int e = 0;
#pragma unroll 1
    for (int k = 1; k < 32; ++k) e = (mt >= toff[k]) ? k : e;
    texp[mt] = e;
  }
  __syncthreads();
}

__device__ __forceinline__ void phase_slotfill(PP pp, int l, int bid, int nb, char* smem) {
  int* toff = (int*)smem;
  moe_offsets(pp, toff);
  const int tid = tid_opaque(), lane = tid & 63, wv = wave_id(tid);
  const int* TOKE = (const int*)(p.ws + OFF_TOKE);
  const int* TOKP = (const int*)(p.ws + OFF_TOKP);
  const float* TOKG = (const float*)(p.ws + OFF_TOKG);
  const int* cnt = (const int*)(p.ws + OFF_CNT);
  int* TOKS = (int*)(p.ws + OFF_TOKS);
  float* SLG = (float*)(p.ws + OFF_SLG);
  float* SLS = (float*)(p.ws + OFF_SLS);
  const float* SCL = (const float*)(p.ws + OFF_SCL);
  const signed char* H8 = (const signed char*)(p.ws + OFF_H);
  signed char* XG = (signed char*)(p.ws + OFF_S);
  const int n = ((l == 0) ? NTOK : NLAT) * 4;
  int* SLT = (int*)(p.ws + OFF_SLT);
  for (int i = bid * NTHR + tid; i < n; i += nb * NTHR) {
    const int e = TOKE[i];
    const int blk = (((i >> 2) >> 1) % (nb * 8)) >> 3;
    const int slot = toff[e] * 256 + ((const int*)(p.ws + OFF_BASE))[blk * 32 + e] + TOKP[i];
    TOKS[i] = slot; SLT[slot] = i >> 2; SLG[slot] = TOKG[i]; SLS[slot] = SCL[i >> 2];
  }
  for (int gi = bid * NTHR + tid; gi < 32 * 256; gi += nb * NTHR) {
    const int e = gi >> 8, r = gi & 255;
    const int c = toff[96 + e];
    const int npad = ((c + 255) & ~255) - c;
    if (r < npad) { const int base = toff[e] * 256 + c; SLT[base + r] = 0; SLS[base + r] = 0.f; }
  }
  __syncthreads();
}

struct EpiMoe1 {
  const float* bgu; const float* sw; const float* SLS; bfr* ACT;
  __device__ __forceinline__ void operator()(const i32x4 (&acc)[2][2][4][2], const g8::GUnit& u, int wr, int wc, int fr, int fq) const {
    const float* be = bgu + (size_t)u.e * 2048;
    const float* se = sw + (size_t)u.e * 2048;
    const int slot0 = u.pm * 256 + wr * 64 + fr;
    float sav[2][4];
#pragma unroll
    for (int ai = 0; ai < 2; ++ai)
#pragma unroll
      for (int m = 0; m < 4; ++m) sav[ai][m] = SLS[slot0 + ai * 128 + m * 16];
    const int j0 = u.pn * 128 + wc * 32 + fq * 8;
    f32x4 bgv[2], blv[2], sgv[2], slv[2];
#pragma unroll
    for (int bj = 0; bj < 2; ++bj) {
      bgv[bj] = *(const f32x4*)(be + j0 + bj * 4); blv[bj] = *(const f32x4*)(be + 1024 + j0 + bj * 4);
      sgv[bj] = *(const f32x4*)(se + j0 + bj * 4); slv[bj] = *(const f32x4*)(se + 1024 + j0 + bj * 4);
    }
#pragma unroll
    for (int ai = 0; ai < 2; ++ai)
#pragma unroll
      for (int m = 0; m < 4; ++m) {
        const int slot = slot0 + ai * 128 + m * 16;
        const float sa = sav[ai][m];
        f32x4 ov[2];
#pragma unroll
        for (int bj = 0; bj < 2; ++bj) {
          const f32x4 bg = bgv[bj], bl = blv[bj];
          const f32x4 sg = sgv[bj], sl = slv[bj];
#pragma unroll
          for (int q = 0; q < 4; ++q) {
            const float g = (float)acc[ai][bj][m][0][q] * (sa * sg[q]) + bg[q];
            const float li = (float)acc[ai][bj][m][1][q] * (sa * sl[q]) + bl[q];
            const float gv = fminf(g, 7.f);
            const float lv = fminf(fmaxf(li, -7.f), 7.f);
            ov[bj][q] = gv * sigmoidf_(1.702f * gv) * (lv + 1.f);
          }
        }
        *(bf16x8*)(ACT + (size_t)slot * 1024 + j0) = pack8(ov[0], ov[1]);
      }
  }
};
__device__ __forceinline__ void phase_moe1_impl(PP pp, int l, int bid, int nb, char* smem, int* toff) {
  moe_offsets(pp, toff);
  moe_tile_experts(toff);
  g8::MoeSched S{toff, 8, 2048, nb, bid};
  EpiMoe1 E{p.moe_b_gu + (size_t)l * 32 * 2048, (const float*)(p.ws + OFF_SW) + (size_t)l * 32 * 2048, (const float*)(p.ws + OFF_SLS), (bfr*)(p.ws + OFF_P)};
  g8::gemm_stream<true, true>((LAS unsigned char*)smem, p.ws + OFF_H, p.ws + OFF_W + (size_t)l * WL_SIZE + WL_GU, S, E, (const int*)(p.ws + OFF_SLT));
}

struct EpiMoe2 {
  const float* bdn; const float* SLG; bfr* YS;
  __device__ __forceinline__ void operator()(const f32x4 (&acc)[2][2][4][2], const g8::GUnit& u, int wr, int wc, int fr, int fq) const {
    const float* be = bdn + (size_t)u.e * 1024;
    const int slot0 = u.pm * 256 + wr * 64 + fr, col0 = u.pn * 256 + wc * 32 + 8 * fq;
    float gtv[2][4];
#pragma unroll
    for (int ai = 0; ai < 2; ++ai)
#pragma unroll
      for (int m = 0; m < 4; ++m) gtv[ai][m] = SLG[slot0 + ai * 128 + m * 16];
    f32x4 bvv[2][2];
#pragma unroll
    for (int bj = 0; bj < 2; ++bj)
#pragma unroll
      for (int n = 0; n < 2; ++n) bvv[bj][n] = *(const f32x4*)(be + col0 + bj * 128 + n * 4);
#pragma unroll
    for (int ai = 0; ai < 2; ++ai)
#pragma unroll
      for (int m = 0; m < 4; ++m) {
        const int slot = slot0 + ai * 128 + m * 16;
        const float gt = gtv[ai][m];
#pragma unroll
        for (int bj = 0; bj < 2; ++bj) {
          const f32x4 y0 = (acc[ai][bj][m][0] + bvv[bj][0]) * gt;
          const f32x4 y1 = (acc[ai][bj][m][1] + bvv[bj][1]) * gt;
          *(bf16x8*)(YS + (size_t)slot * 1024 + col0 + bj * 128) = pack8(y0, y1);
        }
      }
  }
};
__device__ __forceinline__ void phase_moe2_impl(PP pp, int l, int bid, int nb, char* smem, int* toff) {
  moe_offsets(pp, toff);
  moe_tile_experts(toff);
  g8::MoeSched S{toff, 4, 1024, nb, bid};
  EpiMoe2 E{p.moe_b_down + (size_t)l * 32 * 1024, (const float*)(p.ws + OFF_SLG), (bfr*)(p.ws + OFF_S)};
  g8::gemm_stream<false, false>((LAS unsigned char*)smem, p.ws + OFF_P, p.ws + OFF_W + (size_t)l * WL_SIZE + WL_DN, S, E);
}

__device__ __forceinline__ void phase_combine(PP pp, int l, int bid, int nb) {
  const int tid = tid_opaque(), lane = tid & 63, wv = wave_id(tid);
  const bfr* YS = (const bfr*)(p.ws + OFF_S);
  const int* TOKS = (const int*)(p.ws + OFF_TOKS);
  const float* mods = (const float*)(p.ws + OFF_MODS) + (size_t)l * 3 * 6144;
  const float* mods1 = (const float*)(p.ws + OFF_MODS) + (size_t)3 * 6144;
  const float* g1n = p.norm_mix_g + 1024;
  bfr* H = (bfr*)(p.ws + OFF_H);
  float* xl = p.out;
  float* xc = (float*)(p.ws + OFF_CTX);
  const int ntok = (l == 0) ? NTOK : NLAT;
  if (l == 0) {
    int* cnt = (int*)(p.ws + OFF_CNT);
    const int gt = bid * NTHR + tid;
    if (gt < 32) cnt[gt] = 0;
  }
  for (int m = bid * 8 + wv; m < ntok; m += nb * 8) {
    float* xr = (m < NLAT) ? xl + (size_t)m * 1024 : xc + (size_t)(m - NLAT) * 1024;
    const float* g2 = mods + (size_t)mod_row(m) * 6144 + 5120;
    const int s0 = TOKS[(size_t)m * 4], s1 = TOKS[(size_t)m * 4 + 1], s2 = TOKS[(size_t)m * 4 + 2], s3 = TOKS[(size_t)m * 4 + 3];
    float4 xn[4];
    float ss = 0.f;
#pragma unroll
    for (int i = 0; i < 4; ++i) {
      const int d = (lane + 64 * i) * 4;
      const bf16x4 a = *(const bf16x4*)(YS + (size_t)s0 * 1024 + d);
      const bf16x4 b = *(const bf16x4*)(YS + (size_t)s1 * 1024 + d);
      const bf16x4 c = *(const bf16x4*)(YS + (size_t)s2 * 1024 + d);
      const bf16x4 e = *(const bf16x4*)(YS + (size_t)s3 * 1024 + d);
      const float4 gg = *(const float4*)(g2 + d);
      float4 xv = *(const float4*)(xr + d);
      xv.x += gg.x * ((bf2f(a[0]) + bf2f(b[0])) + (bf2f(c[0]) + bf2f(e[0])));
      xv.y += gg.y * ((bf2f(a[1]) + bf2f(b[1])) + (bf2f(c[1]) + bf2f(e[1])));
      xv.z += gg.z * ((bf2f(a[2]) + bf2f(b[2])) + (bf2f(c[2]) + bf2f(e[2])));
      xv.w += gg.w * ((bf2f(a[3]) + bf2f(b[3])) + (bf2f(c[3]) + bf2f(e[3])));
      *(float4*)(xr + d) = xv;
      xn[i] = xv;
      ss += xv.x * xv.x + xv.y * xv.y + xv.z * xv.z + xv.w * xv.w;
    }
    if (l == 0) {
      ss = wave_sum(ss);
      const float rs = rsqrtf(ss * (1.f / 1024.f) + 1e-6f);
      const float* md = mods1 + (size_t)mod_row(m) * 6144;
      float4 hq[4];
#pragma unroll
      for (int i = 0; i < 4; ++i) {
        const int d = (lane + 64 * i) * 4;
        const float4 gg = *(const float4*)(g1n + d);
        const float4 sh = *(const float4*)(md + d);
        const float4 sc = *(const float4*)(md + 1024 + d);
        hq[i] = make_float4(xn[i].x * rs * gg.x * (1.f + sc.x) + sh.x, xn[i].y * rs * gg.y * (1.f + sc.y) + sh.y,
                            xn[i].z * rs * gg.z * (1.f + sc.z) + sh.z, xn[i].w * rs * gg.w * (1.f + sc.w) + sh.w);
      }
      const float qs = quant_row_store(hq, (signed char*)(p.ws + OFF_H) + (size_t)m * 1024, lane);
      if (lane == 0) ((float*)(p.ws + OFF_SCL))[m] = qs;
    }
  }
}

#define XB_TMO      128
#define XB_XCNT(j)  (256  + 64 * (j))
#define XB_XSUB(j)  (1280 + 64 * (j))
#define XB_XGEN(j)  (2304 + 64 * (j))
#define XB_TOP      3328
#define XB_TOPGEN   3392
#define XCD_BAR_WORDS 3456
#define XB_SPIN_CAP (1u << 22)
__device__ __forceinline__ unsigned xb_ld(unsigned* q) { return __hip_atomic_load(q, __ATOMIC_RELAXED, __HIP_MEMORY_SCOPE_AGENT); }
__device__ __forceinline__ unsigned xb_add(unsigned* q, unsigned v) { return __hip_atomic_fetch_add(q, v, __ATOMIC_RELAXED, __HIP_MEMORY_SCOPE_AGENT); }
__device__ __forceinline__ unsigned xb_xcc_id() { return (unsigned)__builtin_amdgcn_s_getreg((3 << 11) | 20) & 0xFu; }
#define XB_SPIN(cond, bar) do { unsigned _sp = 0; while (cond) { __builtin_amdgcn_s_sleep(1); \
    if ((++_sp & 255u) == 0u) { if (xb_ld(&(bar)[XB_TMO])) break; if (_sp > XB_SPIN_CAP) { atomicAdd(&(bar)[XB_TMO], 1u); break; } } } } while (0)
struct XcdBarrier { unsigned* bar; unsigned x; volatile LAS unsigned* st; };
__device__ __forceinline__ XcdBarrier xcd_barrier_post(unsigned* bar, volatile LAS unsigned* st) {
  XcdBarrier b; b.bar = bar; b.x = xb_xcc_id(); b.st = st;
  if (tid_opaque() == 0) (void)xb_add(&bar[XB_XCNT(b.x)], 1u);
  return b;
}
__device__ __forceinline__ void xcd_barrier_complete(unsigned* bar, unsigned x, unsigned& nloc, unsigned& nx) {
  const unsigned G = gridDim.x;
  unsigned sum, cnt, mine, sp = 0u;
  for (;;) {
    sum = 0u; cnt = 0u; mine = 0u;
#pragma unroll
    for (unsigned j = 0; j < 16; ++j) { const unsigned c = xb_ld(&bar[XB_XCNT(j)]); sum += c; cnt += (c > 0u) ? 1u : 0u; mine = (j == x) ? c : mine; }
    if (sum == G) break;
    __builtin_amdgcn_s_sleep(1);
    if ((++sp & 255u) == 0u) { if (xb_ld(&bar[XB_TMO])) break; if (sp > XB_SPIN_CAP) { atomicAdd(&bar[XB_TMO], 1u); break; } }
  }
  nloc = mine > 0u ? mine : 1u; nx = cnt > 0u ? cnt : 1u;
}
__device__ __forceinline__ void xcd_barrier(const XcdBarrier& b) {
  asm volatile("s_waitcnt vmcnt(0)" ::: "memory");
  __syncthreads();
  if (tid_opaque() == 0) {
    unsigned* bar = b.bar;
    __builtin_amdgcn_s_waitcnt(0);
    unsigned nloc = b.st[0], nx = b.st[1];
    if (nloc == 0u) { xcd_barrier_complete(bar, b.x, nloc, nx); b.st[0] = nloc; b.st[1] = nx; }
    const unsigned old = xb_add(&bar[XB_XSUB(b.x)], 1u);
    const unsigned gen = old / nloc;
    if (old + 1u == (gen + 1u) * nloc) {
      __builtin_amdgcn_fence(__ATOMIC_RELEASE, "agent");
      asm volatile("s_waitcnt vmcnt(0)" ::: "memory");
      const unsigned og = xb_add(&bar[XB_TOP], 1u);
      const unsigned tg = og / nx;
      if (og + 1u == (tg + 1u) * nx) xb_add(&bar[XB_TOPGEN], 1u);
      else XB_SPIN(xb_ld(&bar[XB_TOPGEN]) == tg, bar);
      __builtin_amdgcn_fence(__ATOMIC_ACQUIRE, "agent");
      xb_add(&bar[XB_XGEN(b.x)], 1u);
      asm volatile("s_waitcnt vmcnt(0)" ::: "memory");
    } else {
      XB_SPIN(xb_ld(&bar[XB_XGEN(b.x)]) == gen, bar);
      __builtin_amdgcn_fence(__ATOMIC_ACQUIRE, "agent");
      asm volatile("s_waitcnt vmcnt(0)" ::: "memory");
    }
  }
  __syncthreads();
}

extern __shared__ __attribute__((aligned(16))) char dyn_smem[];

__global__ void __launch_bounds__(NTHR) mega(Params p_unused) {
  cg::grid_group grid = cg::this_grid();
  const int bid0 = blockIdx.x, nb0 = gridDim.x;
#if defined(__HIP_DEVICE_COMPILE__)
  PP pp0 = (PP)__builtin_amdgcn_kernarg_segment_ptr();
#else
  PP pp0 = nullptr;
#endif
#define pp ({ PP q_ = pp0; asm volatile("" : "+s"(q_)); q_; })
#define bid opq(bid0)
#define nb opq(nb0)
  int* toff_s = (int*)(dyn_smem + 147456);
  volatile LAS unsigned* xb_st = (volatile LAS unsigned*)(dyn_smem + 147456 + 256);
  {
    unsigned* barw = (unsigned*)(fresh_ws(pp0) + OFF_BAR);
    if (blockIdx.x == 0) for (int i = threadIdx.x; i < XCD_BAR_WORDS; i += NTHR) barw[i] = 0u;
    if (threadIdx.x == 0) { xb_st[0] = 0u; xb_st[1] = 0u; }
  }
  grid.sync();
  const XcdBarrier xb = xcd_barrier_post((unsigned*)(fresh_ws(pp0) + OFF_BAR), xb_st);
#define GSYNC() xcd_barrier(xb)
  phase_ada(pp, bid, nb, dyn_smem);
  phase_convert(pp, 0, 0, bid, nb, dyn_smem);
  GSYNC();
#define LAYER(LV, LAST)                                      \
  {                                                          \
    if ((LV) == 0) { phase_prenorm(pp, opq(LV), bid, nb); GSYNC(); } \
    phase_gemm_in(pp, opq(LV), bid, nb, dyn_smem);           \
    GSYNC();                                                 \
    phase_prep(pp, opq(LV), bid, nb, dyn_smem);              \
    GSYNC();                                                 \
    phase_chunk_prep(pp, bid, nb, dyn_smem);                 \
    GSYNC();                                                 \
    phase_mix(pp, opq(LV), bid, nb, dyn_smem);               \
    GSYNC();                                                 \
    phase_post(pp, opq(LV), bid, nb);                        \
    GSYNC();                                                 \
    phase_gemm_out(pp, opq(LV), bid, nb, dyn_smem);          \
    GSYNC();                                                 \
    phase_router(pp, opq(LV), bid, nb, dyn_smem);            \
    GSYNC();                                                 \
    phase_slotfill(pp, opq(LV), bid, nb, dyn_smem);          \
    GSYNC();                                                 \
    phase_moe1_impl(pp, opq(LV), bid, nb, dyn_smem, toff_s); \
    GSYNC();                                                 \
    phase_moe2_impl(pp, opq(LV), bid, nb, dyn_smem, toff_s); \
    GSYNC();                                                 \
    phase_combine(pp, opq(LV), bid, nb);                     \
    if (!(LAST)) GSYNC();                                    \
  }
  LAYER(0, false)
  LAYER(1, true)
#undef LAYER
#undef GSYNC
#undef bid
#undef nb
#undef pp
}

#undef p
extern "C" void kernel_launch(void* const* d_in, const int* in_sizes, int n_in, void* d_out, int out_size, void* d_ws,
                              size_t ws_size, hipStream_t stream) {
  Params hp{};
  const float** pp = (const float**)&hp;
  for (int i = 0; i < 34; ++i) pp[i] = (const float*)d_in[i];
  hp.out = (float*)d_out;
  hp.ws = (char*)d_ws;
  static int grid_blocks = 0;
  if (!grid_blocks) {
    (void)hipFuncSetAttribute((const void*)mega, hipFuncAttributeMaxDynamicSharedMemorySize, LDS_BYTES);
    int dev = 0, cus = 0, per_cu = 0;
    (void)hipGetDevice(&dev);
    (void)hipDeviceGetAttribute(&cus, hipDeviceAttributeMultiprocessorCount, dev);
    (void)hipOccupancyMaxActiveBlocksPerMultiprocessor(&per_cu, mega, NTHR, LDS_BYTES);
    if (per_cu < 1) per_cu = 1;
    if (per_cu > 1) per_cu = 1;
    grid_blocks = cus * per_cu;
  }
  void* args[] = {&hp};
  (void)hipLaunchCooperativeKernel((void*)mega, dim3(grid_blocks), dim3(NTHR), args, LDS_BYTES, stream);
}
```

```cpp
#include <hip/hip_runtime.h>
#include <hip/hip_bf16.h>
#include <hip/hip_cooperative_groups.h>
#include <stdint.h>
#include <type_traits>
namespace cg = cooperative_groups;

typedef __attribute__((ext_vector_type(8))) short bf16x8;
typedef __attribute__((ext_vector_type(4))) short bf16x4;
typedef __attribute__((ext_vector_type(4))) float f32x4;
typedef __attribute__((ext_vector_type(4))) int i32x4;
typedef unsigned short bfr;

#define D_MODEL 1024
#define NB 2
#define SEQ 16384
#define CTXL 256
#define NLAT (NB * SEQ)
#define NCTX (NB * CTXL)
#define NTOK (NLAT + NCTX)
#define TTOK (SEQ + CTXL)
#define PIN 3472
#define PINP 3584
#define A_END 1536
#define B_END 2432
#define NEXP 32
#define NSLOT_MAX (NTOK * 4 + NEXP * 256)
#define NTHR 512
#define LDS_BYTES (147456 + 3072 + 8192)

constexpr size_t al256(size_t x) { return (x + 255) & ~(size_t)255; }
constexpr size_t WL_IN = 0;
constexpr size_t WL_OUT = WL_IN + (size_t)PINP * 1024 * 2;
constexpr size_t WL_GU = WL_OUT + (size_t)1024 * 1024 * 2;
constexpr size_t WL_DN = WL_GU + (size_t)32 * 2048 * 1024 * 2;
constexpr size_t WL_SIZE = WL_DN + (size_t)32 * 1024 * 1024 * 2;
constexpr size_t OFF_W = 0;
constexpr size_t OFF_MODS = al256(OFF_W + 2 * WL_SIZE);
constexpr size_t OFF_BAR = al256(OFF_MODS + 2 * 3 * 6144 * 4);
constexpr size_t OFF_SW = al256(OFF_BAR + 3456 * 4);
constexpr size_t OFF_SWIN = al256(OFF_SW + (size_t)2 * 32 * 2048 * 4);
constexpr size_t OFF_SLS = al256(OFF_SWIN + (size_t)2 * PINP * 4);
constexpr size_t OFF_SCL = al256(OFF_SLS + (size_t)(NTOK * 4 + 32 * 256) * 4);
constexpr size_t OFF_CTX = al256(OFF_SCL + (size_t)NTOK * 4);
constexpr size_t OFF_CNT = al256(OFF_CTX + (size_t)NCTX * 1024 * 4);
constexpr size_t OFF_BASE = al256(OFF_CNT + 256);
constexpr size_t OFF_TOKE = al256(OFF_BASE + (size_t)512 * 32 * 4);
constexpr size_t OFF_TOKP = al256(OFF_TOKE + (size_t)NTOK * 4 * 4);
constexpr size_t OFF_TOKG = al256(OFF_TOKP + (size_t)NTOK * 4 * 4);
constexpr size_t OFF_TOKS = al256(OFF_TOKG + (size_t)NTOK * 4 * 4);
constexpr size_t OFF_SLT = al256(OFF_TOKS + (size_t)NTOK * 4 * 4);
constexpr size_t OFF_SLG = al256(OFF_SLT + (size_t)NSLOT_MAX * 4);
constexpr size_t OFF_H = al256(OFF_SLG + (size_t)NSLOT_MAX * 4);
constexpr size_t OFF_CC = al256(OFF_H + (size_t)NTOK * 1024 * 2);
constexpr size_t OFF_P = al256(OFF_CC + (size_t)NTOK * 1024 * 2);
constexpr size_t OFF_S = al256(OFF_P + (size_t)NTOK * PINP * 4);
constexpr size_t TOK256F = (size_t)NTOK * 256 * 4;
constexpr size_t S_QN = 0;
constexpr size_t S_KN = S_QN + (size_t)NTOK * 512 * 2;
constexpr size_t S_VT = S_KN + (size_t)NTOK * 512 * 2;
constexpr size_t S_RWR = S_VT + (size_t)NB * 8 * 64 * TTOK * 2;
constexpr size_t S_RWKK = S_RWR + TOK256F;
constexpr size_t S_RWV = S_RWKK + TOK256F;
constexpr size_t S_RWG = S_RWV + TOK256F;
constexpr size_t S_RWW = S_RWG + TOK256F;
constexpr size_t S_RWKD = S_RWW + 2 * TOK256F;
constexpr size_t S_RWB = S_RWKD + 2 * TOK256F;
constexpr size_t S_BON = S_RWB + 2 * TOK256F;
constexpr size_t S_GDQ = al256(S_BON + (size_t)NTOK * 4 * 4);
constexpr size_t S_GDK = S_GDQ + TOK256F;
constexpr size_t S_GDV = S_GDK + TOK256F;
constexpr size_t S_GDAB = S_GDV + TOK256F;
constexpr size_t S_YRW = al256(S_GDAB + (size_t)NTOK * 16 * 4);
constexpr size_t S_YGD = S_YRW + 2 * TOK256F;
constexpr size_t S_END = S_YGD + 2 * TOK256F;
constexpr size_t S_SIZE = (S_END > (size_t)NSLOT_MAX * 1024 * 4) ? S_END : (size_t)NSLOT_MAX * 1024 * 4;
constexpr int NCHUNK = TTOK / 64;
constexpr int NCHAIN = 32;
constexpr size_t OFF_CH = al256(OFF_S + S_SIZE);
constexpr size_t CH_N = (size_t)NCHAIN * NCHUNK;
constexpr size_t CH_REC = 32768, CH_PT = 0, CH_RYT = 8192, CH_QT = 16384, CH_YX = 24576;
constexpr size_t CH_SIZE = CH_N * CH_REC;
constexpr size_t WS_TOTAL = OFF_CH + CH_SIZE;
static_assert(WS_TOTAL <= (size_t)2048 * 1024 * 1024, "workspace exceeds 4x largest tensor");

struct Params {
  const float *x, *c, *ctx, *c_ctx, *ada_w, *ada_b, *norm_mix_g, *norm_ffn_g, *w_in, *w_out;
  const float *na_q_gain, *na_k_gain, *na_rpb;
  const float *rw_mu, *rw_w0, *rw_w_up, *rw_a0, *rw_a_up, *rw_g_up, *rw_k_k, *rw_k_a, *rw_r_k, *rw_ln_w, *rw_ln_b;
  const float *gd_conv_w, *gd_A_log, *gd_dt_bias, *gd_norm_g;
  const float *moe_router_w, *moe_router_b, *moe_w_gu, *moe_b_gu, *moe_w_down, *moe_b_down;
  float* out;
  char* ws;
};

typedef const __attribute__((address_space(4))) Params* PP;
#define p (*pp)
__device__ __forceinline__ char* fresh_ws(PP pp) { return p.ws; }
__device__ __forceinline__ int tid_opaque() { int t = (int)__builtin_amdgcn_workitem_id_x(); asm volatile("" : "+v"(t)); return t; }
__device__ __forceinline__ int opq(int x) { asm volatile("" : "+s"(x)); return x; }
__device__ __forceinline__ int wave_id(int tid) { return __builtin_amdgcn_readfirstlane(tid >> 6); }
typedef __bf16 bf16v2_t __attribute__((ext_vector_type(2)));
typedef float f32v2_t __attribute__((ext_vector_type(2)));
__device__ __forceinline__ unsigned pk_bf16(float lo, float hi) { f32v2_t v = {lo, hi}; return __builtin_bit_cast(unsigned, __builtin_convertvector(v, bf16v2_t)); }
__device__ __forceinline__ float dot2bf(unsigned a, unsigned b, float c) { return __builtin_amdgcn_fdot2_f32_bf16(__builtin_bit_cast(bf16v2_t, a), __builtin_bit_cast(bf16v2_t, b), c, false); }
__device__ __forceinline__ bfr f2bf(float f) { return (bfr)(pk_bf16(f, f) & 0xffffu); }
__device__ __forceinline__ float bf2f(short v) { return __uint_as_float(((unsigned)(unsigned short)v) << 16); }
__device__ __forceinline__ bf16x4 pack4(float a, float b, float c, float d) {
  typedef __attribute__((ext_vector_type(2))) unsigned u32x2;
  u32x2 w; w[0] = pk_bf16(a, b); w[1] = pk_bf16(c, d);
  return __builtin_bit_cast(bf16x4, w);
}
__device__ __forceinline__ bf16x8 pack8(f32x4 a, f32x4 b) {
  const bf16x4 lo = pack4(a[0], a[1], a[2], a[3]), hi = pack4(b[0], b[1], b[2], b[3]);
  return __builtin_shufflevector(lo, hi, 0, 1, 2, 3, 4, 5, 6, 7);
}
__device__ __forceinline__ int perm_row32(int n) { return (n & ~31) | (((n >> 2) & 1) << 4) | (((n >> 3) & 3) << 2) | (n & 3); }
__device__ __forceinline__ float sigmoidf_(float x) { return __builtin_amdgcn_rcpf(1.f + __expf(-x)); }
__device__ __forceinline__ float siluf_(float x) { return x * __builtin_amdgcn_rcpf(1.f + __expf(-x)); }
__device__ __forceinline__ float softplusf_(float x) { const float e = __expf(fminf(x, 20.f)); const float lg = __logf(1.f + e); const float r = x < -15.f ? e : lg; return x > 20.f ? x : r; }
__device__ __forceinline__ float wave_sum(float v) {
  v += __builtin_bit_cast(float, __builtin_amdgcn_update_dpp(0, __builtin_bit_cast(int, v), 0xB1, 0xF, 0xF, true));
  v += __builtin_bit_cast(float, __builtin_amdgcn_update_dpp(0, __builtin_bit_cast(int, v), 0x4E, 0xF, 0xF, true));
  v += __builtin_bit_cast(float, __builtin_amdgcn_update_dpp(0, __builtin_bit_cast(int, v), 0x141, 0xF, 0xF, true));
  v += __builtin_bit_cast(float, __builtin_amdgcn_update_dpp(0, __builtin_bit_cast(int, v), 0x140, 0xF, 0xF, true));
  v += __builtin_bit_cast(float, __builtin_amdgcn_update_dpp(0, __builtin_bit_cast(int, v), 0x142, 0xA, 0xF, false));
  v += __builtin_bit_cast(float, __builtin_amdgcn_update_dpp(0, __builtin_bit_cast(int, v), 0x143, 0xC, 0xF, false));
  return __builtin_bit_cast(float, __builtin_amdgcn_readlane(__builtin_bit_cast(int, v), 63));
}
__device__ __forceinline__ float wave_max(float v) {
  v = fmaxf(v, __builtin_bit_cast(float, __builtin_amdgcn_update_dpp(0, __builtin_bit_cast(int, v), 0xB1, 0xF, 0xF, true)));
  v = fmaxf(v, __builtin_bit_cast(float, __builtin_amdgcn_update_dpp(0, __builtin_bit_cast(int, v), 0x4E, 0xF, 0xF, true)));
  v = fmaxf(v, __builtin_bit_cast(float, __builtin_amdgcn_update_dpp(0, __builtin_bit_cast(int, v), 0x141, 0xF, 0xF, true)));
  v = fmaxf(v, __builtin_bit_cast(float, __builtin_amdgcn_update_dpp(0, __builtin_bit_cast(int, v), 0x140, 0xF, 0xF, true)));
  const float r1 = __builtin_bit_cast(float, __builtin_amdgcn_readlane(__builtin_bit_cast(int, v), 0));
  const float r2 = __builtin_bit_cast(float, __builtin_amdgcn_readlane(__builtin_bit_cast(int, v), 16));
  const float r3 = __builtin_bit_cast(float, __builtin_amdgcn_readlane(__builtin_bit_cast(int, v), 32));
  const float r4 = __builtin_bit_cast(float, __builtin_amdgcn_readlane(__builtin_bit_cast(int, v), 48));
  return fmaxf(fmaxf(r1, r2), fmaxf(r3, r4));
}
__device__ __forceinline__ float shfl_xor_l(float v, int mask, int lane) {
  return __builtin_bit_cast(float, __builtin_amdgcn_ds_bpermute((lane ^ mask) << 2, __builtin_bit_cast(int, v)));
}
__device__ __forceinline__ int shfl_xor_li(int v, int mask, int lane) {
  return __builtin_amdgcn_ds_bpermute((lane ^ mask) << 2, v);
}
__device__ __forceinline__ float row16_sum(float v) {
  v += __builtin_bit_cast(float, __builtin_amdgcn_update_dpp(0, __builtin_bit_cast(int, v), 0xB1, 0xF, 0xF, true));
  v += __builtin_bit_cast(float, __builtin_amdgcn_update_dpp(0, __builtin_bit_cast(int, v), 0x4E, 0xF, 0xF, true));
  v += __builtin_bit_cast(float, __builtin_amdgcn_update_dpp(0, __builtin_bit_cast(int, v), 0x141, 0xF, 0xF, true));
  v += __builtin_bit_cast(float, __builtin_amdgcn_update_dpp(0, __builtin_bit_cast(int, v), 0x140, 0xF, 0xF, true));
  return v;
}
__device__ __forceinline__ float quant_row_store(const float4 (&v)[4], signed char* dst_row, int lane) {
  float am = 0.f;
#pragma unroll
  for (int i = 0; i < 4; ++i) am = fmaxf(fmaxf(am, fmaxf(fabsf(v[i].x), fabsf(v[i].y))), fmaxf(fabsf(v[i].z), fabsf(v[i].w)));
  am = wave_max(am);
  const float sc = am > 0.f ? am * (1.f / 127.f) : 1.f, iv = 1.f / sc;
#pragma unroll
  for (int i = 0; i < 4; ++i) {
    const int q0 = (int)fminf(fmaxf(rintf(v[i].x * iv), -127.f), 127.f), q1 = (int)fminf(fmaxf(rintf(v[i].y * iv), -127.f), 127.f);
    const int q2 = (int)fminf(fmaxf(rintf(v[i].z * iv), -127.f), 127.f), q3 = (int)fminf(fmaxf(rintf(v[i].w * iv), -127.f), 127.f);
    *(unsigned*)(dst_row + (lane + 64 * i) * 4) = (unsigned)(q0 & 0xff) | ((unsigned)(q1 & 0xff) << 8) | ((unsigned)(q2 & 0xff) << 16) | ((unsigned)(q3 & 0xff) << 24);
  }
  return sc;
}
__device__ __forceinline__ float ldbf1(const bfr* q, size_t i) { return bf2f((short)q[i]); }
__device__ __forceinline__ f32x4 ldbf4(const bfr* q) { const bf16x4 v = *(const bf16x4*)q; return (f32x4){bf2f(v[0]), bf2f(v[1]), bf2f(v[2]), bf2f(v[3])}; }
__device__ __forceinline__ int mod_row(int m) { return m < NLAT ? (m >> 14) : 2; }

__device__ __forceinline__ void phase_ada(PP pp, int bid, int nb, char* smem) {
  float* red = (float*)smem;
  float* mods = (float*)(p.ws + OFF_MODS);
  const int tid = tid_opaque();
  for (int task = bid; task < 2 * 96; task += nb) {
    int l = task / 96, cgp = task % 96;
    int col = cgp * 64 + (tid & 63), ks = tid >> 6;
    const float* W = p.ada_w + (size_t)l * 1024 * 6144;
    float a0 = 0.f, a1 = 0.f, a2 = 0.f;
    for (int d = ks * 128; d < ks * 128 + 128; ++d) {
      float w = W[(size_t)d * 6144 + col];
      a0 += siluf_(p.c[d]) * w;
      a1 += siluf_(p.c[1024 + d]) * w;
      a2 += siluf_(p.c_ctx[d]) * w;
    }
    red[(ks * 3 + 0) * 64 + (tid & 63)] = a0;
    red[(ks * 3 + 1) * 64 + (tid & 63)] = a1;
    red[(ks * 3 + 2) * 64 + (tid & 63)] = a2;
    __syncthreads();
    if (tid < 192) {
      int r = tid >> 6, cc = tid & 63;
      float s = 0.f;
      for (int k = 0; k < 8; ++k) s += red[(k * 3 + r) * 64 + cc];
      mods[(size_t)(l * 3 + r) * 6144 + cgp * 64 + cc] = s + p.ada_b[(size_t)l * 6144 + cgp * 64 + cc];
    }
    __syncthreads();
  }
}

template <bool PERM>
__device__ __forceinline__ void convert_tile(const float* src, int N, bfr* dst, int kt4  , int nt, float* tile  ) {
  const int tid = tid_opaque();
  float4 v[8];
#pragma unroll
  for (int q = 0; q < 8; ++q) {
    const int idx = tid + q * 512;
    const int kk = idx >> 4, n4 = idx & 15;
    v[q] = *(const float4*)(src + (size_t)(kt4 * 256 + kk) * N + nt * 64 + n4 * 4);
  }
#pragma unroll
  for (int q = 0; q < 8; ++q) {
    const int idx = tid + q * 512;
    const int kk = idx >> 4, n4 = idx & 15;
    tile[kk * 65 + n4 * 4 + 0] = v[q].x; tile[kk * 65 + n4 * 4 + 1] = v[q].y;
    tile[kk * 65 + n4 * 4 + 2] = v[q].z; tile[kk * 65 + n4 * 4 + 3] = v[q].w;
  }
  __syncthreads();
  {
    const int nn = tid >> 3, kc = tid & 7;
    const int n = PERM ? perm_row32(nt * 64 + nn) : nt * 64 + nn;
#pragma unroll
    for (int q = 0; q < 4; ++q) {
      const int k0 = (kc + 8 * q) * 8;
      *(bf16x4*)(dst + (size_t)n * 1024 + kt4 * 256 + k0) = pack4(tile[(k0 + 0) * 65 + nn], tile[(k0 + 1) * 65 + nn], tile[(k0 + 2) * 65 + nn], tile[(k0 + 3) * 65 + nn]);
      *(bf16x4*)(dst + (size_t)n * 1024 + kt4 * 256 + k0 + 4) = pack4(tile[(k0 + 4) * 65 + nn], tile[(k0 + 5) * 65 + nn], tile[(k0 + 6) * 65 + nn], tile[(k0 + 7) * 65 + nn]);
    }
  }
  __syncthreads();
}
template <int N, bool INTERLEAVE>
__device__ __forceinline__ void convert_i8(const float* src  , signed char* dst  , float* sw, int ng, char* smem) {
  const int tid = tid_opaque();
  bfr* blk = (bfr*)smem;
  int* cmax = (int*)(smem + 131072);
  if (tid < 64) cmax[tid] = 0;
  __syncthreads();
  {
    const int n4 = tid & 15, kk0 = tid >> 4;
    float m0 = 0.f, m1 = 0.f, m2 = 0.f, m3 = 0.f;
#pragma unroll 8
    for (int ps = 0; ps < 32; ++ps) {
      const int k = ps * 32 + kk0;
      const int ncol = ng * 64 + n4 * 4;
      const int ncl = (N % 64 == 0) ? ncol : min(ncol, N - 4);
      float4 v = *(const float4*)(src + (size_t)k * N + ncl);
      if (N % 64 != 0 && ncol != ncl) v = make_float4(0.f, 0.f, 0.f, 0.f);
      m0 = fmaxf(m0, fabsf(v.x)); m1 = fmaxf(m1, fabsf(v.y)); m2 = fmaxf(m2, fabsf(v.z)); m3 = fmaxf(m3, fabsf(v.w));
      *(bf16x4*)(blk + k * 64 + n4 * 4) = pack4(v.x, v.y, v.z, v.w);
    }
    atomicMax(&cmax[n4 * 4 + 0], __float_as_int(m0)); atomicMax(&cmax[n4 * 4 + 1], __float_as_int(m1));
    atomicMax(&cmax[n4 * 4 + 2], __float_as_int(m2)); atomicMax(&cmax[n4 * 4 + 3], __float_as_int(m3));
  }
  __syncthreads();
  {
    const int nn = tid >> 3, kc = tid & 7;
    const int n = ng * 64 + nn;
    const float am = __int_as_float(cmax[nn]);
    const float sc = am > 0.f ? am * (1.f / 127.f) : 1.f, iv = 1.f / sc;
    const int j = n & 1023;
    const int row = INTERLEAVE ? (j >> 7) * 256 + ((j >> 2) & 1) * 128 + ((j >> 5) & 3) * 32 + ((n >= 1024) ? 16 : 0) + ((j >> 3) & 3) * 4 + (j & 3) : perm_row32(n);
    if (kc == 0) sw[n] = sc;
#pragma unroll 2
    for (int q = 0; q < 8; ++q) {
      const int k0 = (kc + 8 * q) * 16;
      unsigned w[4];
#pragma unroll
      for (int g4 = 0; g4 < 4; ++g4) {
        unsigned acc = 0u;
#pragma unroll
        for (int b = 0; b < 4; ++b) {
          const float v = bf2f((short)blk[(k0 + g4 * 4 + b) * 64 + nn]);
          const int qi = (int)fminf(fmaxf(rintf(v * iv), -127.f), 127.f);
          acc |= ((unsigned)(qi & 0xff)) << (8 * b);
        }
        w[g4] = acc;
      }
      *(uint4*)(dst + (size_t)row * 1024 + k0) = make_uint4(w[0], w[1], w[2], w[3]);
    }
  }
  __syncthreads();
}
__device__ __forceinline__ void phase_convert(PP pp, int l, int part, int bid, int nb, char* smem) {
  float* tile = (float*)smem;
  char* wl = p.ws + OFF_W + (size_t)l * WL_SIZE;
  const int T_IN = 56, T_OUT = 4 * 16, T_GU = 32 * 32, T_DN = 32 * 4 * 16;
  const int t_lo = part == 0 ? 0 : T_IN + T_OUT;
  const int t_hi = part == 0 ? T_IN + T_OUT : T_IN + T_OUT + T_GU + T_DN;
  for (int t = t_lo + bid; t < t_hi; t += nb) {
    if (t < T_IN) {
      convert_i8<PIN, false>(p.w_in + (size_t)l * 1024 * PIN, (signed char*)(wl + WL_IN), (float*)(p.ws + OFF_SWIN) + (size_t)l * PINP, t, smem);
    } else if (t < T_IN + T_OUT) {
      int u = t - T_IN; int kt4 = u / 16, nt = u % 16;
      convert_tile<false>(p.w_out + (size_t)l * 1024 * 1024, 1024, (bfr*)(wl + WL_OUT), kt4, nt, tile);
    } else if (t < T_IN + T_OUT + T_GU) {
      int u = t - T_IN - T_OUT; int e = u / 32, ng = u % 32;
      convert_i8<2048, true>(p.moe_w_gu + ((size_t)l * 32 + e) * 1024 * 2048, (signed char*)(wl + WL_GU) + (size_t)e * 2048 * 1024,
                    (float*)(p.ws + OFF_SW) + ((size_t)l * 32 + e) * 2048, ng, smem);
    } else {
      int u = t - T_IN - T_OUT - T_GU; int e = u / 64; int v = u % 64; int kt4 = v / 16, nt = v % 16;
      convert_tile<true>(p.moe_w_down + ((size_t)l * 32 + e) * 1024 * 1024, 1024, (bfr*)(wl + WL_DN) + (size_t)e * 1024 * 1024, kt4, nt, tile);
    }
  }
}

__device__ __forceinline__ void phase_prenorm(PP pp, int l, int bid, int nb) {
  const int tid = tid_opaque(), lane = tid & 63, wv = wave_id(tid);
  const float* xl = (l == 0) ? p.x : p.out;
  const float* xc = (l == 0) ? p.ctx : (const float*)(p.ws + OFF_CTX);
  const float* mods = (const float*)(p.ws + OFF_MODS) + (size_t)l * 3 * 6144;
  const float* g = p.norm_mix_g + (size_t)l * 1024;
  signed char* H8 = (signed char*)(p.ws + OFF_H);
  float* SCL = (float*)(p.ws + OFF_SCL);
  {
    int* cnt = (int*)(p.ws + OFF_CNT);
    int gt = bid * NTHR + tid;
    if (gt < 32) cnt[gt] = 0;
  }
  for (int m = bid * 8 + wv; m < NTOK; m += nb * 8) {
    const float* xr = (m < NLAT) ? xl + (size_t)m * 1024 : xc + (size_t)(m - NLAT) * 1024;
    const float* md = mods + (size_t)mod_row(m) * 6144;
    float4 v[4];
    float ss = 0.f;
#pragma unroll
    for (int i = 0; i < 4; ++i) {
      v[i] = *(const float4*)(xr + (lane + 64 * i) * 4);
      ss += v[i].x * v[i].x + v[i].y * v[i].y + v[i].z * v[i].z + v[i].w * v[i].w;
    }
    ss = wave_sum(ss);
    float rs = rsqrtf(ss * (1.f / 1024.f) + 1e-6f);
    float4 hq[4];
#pragma unroll
    for (int i = 0; i < 4; ++i) {
      int d = (lane + 64 * i) * 4;
      float4 gg = *(const float4*)(g + d);
      float4 sh = *(const float4*)(md + d);
      float4 sc = *(const float4*)(md + 1024 + d);
      hq[i] = make_float4(v[i].x * rs * gg.x * (1.f + sc.x) + sh.x, v[i].y * rs * gg.y * (1.f + sc.y) + sh.y,
                          v[i].z * rs * gg.z * (1.f + sc.z) + sh.z, v[i].w * rs * gg.w * (1.f + sc.w) + sh.w);
    }
    const float qs = quant_row_store(hq, H8 + (size_t)m * 1024, lane);
    if (lane == 0) SCL[m] = qs;
  }
}

#define LAS __attribute__((address_space(3)))
namespace g8 {
constexpr int BM = 256, BK = 64, HALF = 128, HTB = HALF * BK * 2, STAGE_BYTES = 8 * HTB, KD = 1024;
__device__ __forceinline__ int lds_byte(int r, int c) { const int st = (r >> 4) * 2 + (c >> 5), rr = r & 15, cc = c & 31, ob = rr * 64 + cc * 2; return st * 1024 + (ob ^ (((ob >> 9) & 1) << 5)); }
__device__ __forceinline__ void stage_rc(int b, int& R, int& C) { const int st = b / 1024, sb = b % 1024, swz = sb ^ (((sb >> 9) & 1) << 5); R = (st >> 1) * 16 + swz / 64; C = (st & 1) * 32 + (swz % 64) / 2; }
struct GUnit { int pm, pn, brow0, e; };
__device__ __forceinline__ int unit_index(int i, int c, int G, int total) {
  const int x = c & 7, j = c >> 3, q = total >> 3, r = total & 7;
  const int start = x < r ? x * (q + 1) : r * (q + 1) + (x - r) * q;
  const int size = q + (x < r ? 1 : 0);
  const int li = i * (G >> 3) + j;
  return li < size ? start + li : -1;
}

__device__ __forceinline__ f32x4 mma16(bf16x8 a, bf16x8 b, f32x4 c) { return __builtin_amdgcn_mfma_f32_16x16x32_bf16(a, b, c, 0, 0, 0); }
__device__ __forceinline__ i32x4 mma16(i32x4 a, i32x4 b, i32x4 c) { return __builtin_amdgcn_mfma_i32_16x16x64_i8(a, b, c, 0, 0, 0); }
template <bool I8, bool GATHER, class Sched, class Epi>
__device__ __forceinline__ void gemm_stream(LAS unsigned char* lds, const void* Abase, const void* Btbase, const Sched& S, const Epi& E, const int* slt = nullptr) {
  typedef typename std::conditional<I8, i32x4, f32x4>::type AccT;
  typedef typename std::conditional<I8, i32x4, bf16x8>::type FragT;
  constexpr int KB = I8 ? KD : KD * 2;
  const int tid = tid_opaque(), wid = __builtin_amdgcn_readfirstlane(tid >> 6), lane = tid & 63, wr = wid >> 2, wc = wid & 3, fr = lane & 15, fq = lane >> 4;
  constexpr int nt = KB / 128;
  int R[2], C[2];
  unsigned voffB[2];
#pragma unroll
  for (int i = 0; i < 2; ++i) { stage_rc(tid * 16 + i * 8192, R[i], C[i]); voffB[i] = (unsigned)(R[i] * KB + C[i] * 2); }
#define voffA voffB
  constexpr size_t kstep = (size_t)(BK * 2);
  constexpr size_t hstep = (size_t)HALF * KB;
  const unsigned ldsw = (unsigned)wid * 1024u;
  const int aoff = lds_byte(wr * 64 + fr, fq * 8), boff = lds_byte(wc * 32 + fr, fq * 8);
#define G8_SA(b, h) (((b) * 2 + (h)) * HTB)
#define G8_SB(b, h) ((4 + (b) * 2 + (h)) * HTB)
#define G8_STAGE(bufoff, gbase, v0, v1) do { \
    __builtin_amdgcn_global_load_lds((const unsigned*)((const char*)(gbase) + (v0)), (LAS unsigned*)(lds + (bufoff) + ldsw), 16, 0, 0); \
    __builtin_amdgcn_global_load_lds((const unsigned*)((const char*)(gbase) + (v1)), (LAS unsigned*)(lds + (bufoff) + ldsw + 8192), 16, 0, 0); } while (0)
#define G8_STAGEB(bufoff, gbase) G8_STAGE(bufoff, gbase, voffB[0], voffB[1])
#define G8_STAGEA_U(bufoff, base_u, hsel) G8_STAGE(bufoff, (base_u) + (hsel) * hstep, voffA[0], voffA[1])
#define G8_STAGEA_G(bufoff, koff, o0, o1) G8_STAGE(bufoff, (const char*)Abase + (koff), o0, o1)
#define G8_LDA(dst, b, h) do { _Pragma("unroll") for (int m = 0; m < 4; ++m) _Pragma("unroll") for (int k = 0; k < 2; ++k) dst[m][k] = *(const LAS FragT*)(lds + G8_SA(b, h) + aoff + m * 2048 + k * 1024); } while (0)
#define G8_LDB(dst, b, h) do { _Pragma("unroll") for (int n = 0; n < 2; ++n) _Pragma("unroll") for (int k = 0; k < 2; ++k) dst[n][k] = *(const LAS FragT*)(lds + G8_SB(b, h) + boff + n * 2048 + k * 1024); } while (0)
#define G8_MMA(ai, bj, At, Bt) do { __builtin_amdgcn_s_setprio(1); _Pragma("unroll") for (int m = 0; m < 4; ++m) _Pragma("unroll") for (int n = 0; n < 2; ++n) _Pragma("unroll") for (int k = 0; k < 2; ++k) \
    acc[ai][bj][m][n] = mma16(Bt[n][k], At[m][k], acc[ai][bj][m][n]); __builtin_amdgcn_s_setprio(0); } while (0)
#define G8_WAIT_V(n) asm volatile("s_waitcnt vmcnt(" #n ")" ::: "memory")
#define G8_WAIT_L(n) asm volatile("s_waitcnt lgkmcnt(" #n ")" ::: "memory")
#define G8_BAR __builtin_amdgcn_s_barrier()
#define G8_SCHED __builtin_amdgcn_sched_barrier(0)
  GUnit cur, nxt;
  int ui = 0;
  if (!S.next(0, cur)) return;
  AccT acc[2][2][4][2];
#pragma unroll
  for (int a = 0; a < 2; ++a)
#pragma unroll
    for (int b = 0; b < 2; ++b)
#pragma unroll
      for (int m = 0; m < 4; ++m)
#pragma unroll
        for (int n = 0; n < 2; ++n) acc[a][b][m][n] = AccT{};
  FragT At[4][2], B0[2][2], B1[2][2];
  const char* cA = (const char*)Abase + (size_t)cur.pm * (BM * KB);
  unsigned gA00 = 0, gA01 = 0, gA10 = 0, gA11 = 0, gN00 = 0, gN01 = 0, gN10 = 0, gN11 = 0;
  if (GATHER) {
    const int* sr = slt + cur.pm * BM;
    gA00 = (unsigned)sr[R[0]] * KB + C[0] * 2; gA01 = (unsigned)sr[R[1]] * KB + C[1] * 2;
    gA10 = (unsigned)sr[HALF + R[0]] * KB + C[0] * 2; gA11 = (unsigned)sr[HALF + R[1]] * KB + C[1] * 2;
  }
  const char* cB = (const char*)Btbase + (size_t)cur.brow0 * KB;
  G8_STAGEB(G8_SB(0, 0), cB);
  if (GATHER) G8_STAGEA_G(G8_SA(0, 0), 0, gA00, gA01); else G8_STAGEA_U(G8_SA(0, 0), cA, 0);
  G8_STAGEB(G8_SB(0, 1), cB + hstep);
  if (GATHER) G8_STAGEA_G(G8_SA(0, 1), 0, gA10, gA11); else G8_STAGEA_U(G8_SA(0, 1), cA, 1);
  if (wr == 1) G8_BAR;
  G8_WAIT_V(4); G8_BAR;
  G8_STAGEB(G8_SB(1, 0), cB + kstep);
  if (GATHER) G8_STAGEA_G(G8_SA(1, 0), kstep, gA00, gA01); else G8_STAGEA_U(G8_SA(1, 0), cA + kstep, 0);
  G8_STAGEB(G8_SB(1, 1), cB + hstep + kstep);
  G8_WAIT_V(6); G8_BAR;
  for (;;) {
    const bool has_next = S.next(ui + 1, nxt);
    const char* nA = has_next ? (const char*)Abase + (size_t)nxt.pm * (BM * KB) : cA;
    if (GATHER) {
      if (has_next) {
        const int* sr = slt + nxt.pm * BM;
        gN00 = (unsigned)sr[R[0]] * KB + C[0] * 2; gN01 = (unsigned)sr[R[1]] * KB + C[1] * 2;
        gN10 = (unsigned)sr[HALF + R[0]] * KB + C[0] * 2; gN11 = (unsigned)sr[HALF + R[1]] * KB + C[1] * 2;
      } else { gN00 = gA00; gN01 = gA01; gN10 = gA10; gN11 = gA11; }
    }
    const char* nB = has_next ? (const char*)Btbase + (size_t)nxt.brow0 * KB : cB;
#pragma unroll 1
    for (int t = 0; t < nt; t += 2) {
      const bool last = (t == nt - 2);
      const char* a1 = cA + (size_t)(t + 1) * kstep;
      const char* a2 = last ? nA : cA + (size_t)(t + 2) * kstep;
      const char* b2 = last ? nB : cB + (size_t)(t + 2) * kstep;
      const char* a3 = a2 + kstep;
      const char* b3 = b2 + kstep;
      const size_t k1 = (size_t)(t + 1) * kstep, k2 = last ? 0 : (size_t)(t + 2) * kstep, k3 = k2 + kstep;
      const unsigned w00 = last ? gN00 : gA00, w01 = last ? gN01 : gA01, w10 = last ? gN10 : gA10, w11 = last ? gN11 : gA11;
      G8_LDB(B0, 0, 0); G8_SCHED; G8_LDA(At, 0, 0); if (GATHER) G8_STAGEA_G(G8_SA(1, 1), k1, gA10, gA11); else G8_STAGEA_U(G8_SA(1, 1), a1, 1);
      G8_WAIT_L(8); G8_BAR; G8_WAIT_L(0); G8_MMA(0, 0, At, B0); G8_BAR; G8_SCHED;
      G8_LDB(B1, 0, 1); G8_STAGEB(G8_SB(0, 0), b2);
      G8_BAR; G8_WAIT_L(0); G8_MMA(0, 1, At, B1); G8_BAR;
      G8_LDA(At, 0, 1); if (GATHER) G8_STAGEA_G(G8_SA(0, 0), k2, w00, w01); else G8_STAGEA_U(G8_SA(0, 0), a2, 0);
      G8_BAR; G8_WAIT_L(0); G8_MMA(1, 0, At, B0); G8_BAR; G8_SCHED;
      G8_STAGEB(G8_SB(0, 1), b2 + hstep);
      G8_WAIT_V(6); G8_BAR; G8_MMA(1, 1, At, B1); G8_BAR;
      G8_LDB(B0, 1, 0); G8_SCHED; G8_LDA(At, 1, 0); if (GATHER) G8_STAGEA_G(G8_SA(0, 1), k2, w10, w11); else G8_STAGEA_U(G8_SA(0, 1), a2, 1);
      G8_WAIT_L(8); G8_BAR; G8_WAIT_L(0); G8_MMA(0, 0, At, B0); G8_BAR; G8_SCHED;
      G8_LDB(B1, 1, 1); G8_STAGEB(G8_SB(1, 0), b3);
      G8_BAR; G8_WAIT_L(0); G8_MMA(0, 1, At, B1); G8_BAR;
      G8_LDA(At, 1, 1); if (GATHER) G8_STAGEA_G(G8_SA(1, 0), k3, w00, w01); else G8_STAGEA_U(G8_SA(1, 0), a3, 0);
      G8_BAR; G8_WAIT_L(0); G8_MMA(1, 0, At, B0); G8_BAR; G8_SCHED;
      G8_STAGEB(G8_SB(1, 1), b3 + hstep);
      G8_WAIT_V(6); G8_BAR; G8_MMA(1, 1, At, B1); G8_BAR;
    }
    E(acc, cur, wr, wc, fr, fq);
    if (!has_next) break;
#pragma unroll
    for (int a = 0; a < 2; ++a)
#pragma unroll
      for (int b = 0; b < 2; ++b)
#pragma unroll
        for (int m = 0; m < 4; ++m)
#pragma unroll
          for (int n = 0; n < 2; ++n) acc[a][b][m][n] = AccT{};
    cur = nxt; cA = nA; cB = nB; ++ui;
    gA00 = gN00; gA01 = gN01; gA10 = gN10; gA11 = gN11;
  }
  G8_WAIT_V(0);
  if (wr == 0) G8_BAR;
  G8_BAR;
#undef G8_SA
#undef G8_SB
#undef G8_STAGE
#undef G8_STAGEB
#undef G8_STAGEA_U
#undef G8_STAGEA_G
#undef voffA
#undef G8_LDA
#undef G8_LDB
#undef G8_MMA
#undef G8_WAIT_V
#undef G8_WAIT_L
#undef G8_BAR
#undef G8_SCHED
}

struct DenseSched {
  int nM, nN, G, c;
  __device__ __forceinline__ bool next(int i, GUnit& u) const {
    const int idx = unit_index(i, c, G, nM * nN);
    if (idx < 0) return false;
    u.pm = idx / nN; u.pn = idx - u.pm * nN; u.brow0 = u.pn * BM; u.e = 0;
    return true;
  }
};
struct MoeSched {
  const int* toff; int nN, NE, G, c;
  __device__ __forceinline__ bool next(int i, GUnit& u) const {
    const int idx = unit_index(i, c, G, toff[32] * nN);
    if (idx < 0) return false;
    u.pm = idx / nN; u.pn = idx - u.pm * nN;
    const int e = toff[128 + u.pm];
    u.e = e; u.brow0 = e * NE + u.pn * BM;
    return true;
  }
};
}

struct EpiInProj {
  bfr* P; const float* SCL; const float* sw;
  __device__ __forceinline__ void operator()(const i32x4 (&acc)[2][2][4][2], const g8::GUnit& u, int wr, int wc, int fr, int fq) const {
    const int row0 = u.pm * 256 + wr * 64 + fr, col0 = u.pn * 256 + wc * 32 + 8 * fq;
    f32x4 cs[2][2];
#pragma unroll
    for (int bj = 0; bj < 2; ++bj)
#pragma unroll
      for (int n = 0; n < 2; ++n) cs[bj][n] = *(const f32x4*)(sw + col0 + bj * 128 + n * 4);
    float sav[2][4];
#pragma unroll
    for (int ai = 0; ai < 2; ++ai)
#pragma unroll
      for (int m = 0; m < 4; ++m) sav[ai][m] = SCL[row0 + ai * 128 + m * 16];
#pragma unroll
    for (int ai = 0; ai < 2; ++ai)
#pragma unroll
      for (int m = 0; m < 4; ++m) {
        const int row = row0 + ai * 128 + m * 16;
        const float sa = sav[ai][m];
        bfr* rowp = P + (size_t)row * PINP + col0;
#pragma unroll
        for (int bj = 0; bj < 2; ++bj) {
          const i32x4 a0 = acc[ai][bj][m][0], a1 = acc[ai][bj][m][1];
          f32x4 o0 = {(float)a0[0], (float)a0[1], (float)a0[2], (float)a0[3]};
          f32x4 o1 = {(float)a1[0], (float)a1[1], (float)a1[2], (float)a1[3]};
          o0 = o0 * (cs[bj][0] * sa); o1 = o1 * (cs[bj][1] * sa);
          *(bf16x8*)(rowp + bj * 128) = pack8(o0, o1);
        }
      }
  }
};
__device__ __forceinline__ void phase_gemm_in(PP pp, int l, int bid, int nb, char* smem) {
  g8::DenseSched S{130, 14, nb, bid};
  EpiInProj E{(bfr*)(p.ws + OFF_P), (const float*)(p.ws + OFF_SCL), (const float*)(p.ws + OFF_SWIN) + (size_t)l * PINP};
  g8::gemm_stream<true, false>((LAS unsigned char*)smem, p.ws + OFF_H, p.ws + OFF_W + (size_t)l * WL_SIZE + WL_IN, S, E);
}

struct EpiOutProj {
  const float *xl, *xc, *mods; float *ol, *oc;
  __device__ __forceinline__ void operator()(const f32x4 (&acc)[2][2][4][2], const g8::GUnit& u, int wr, int wc, int fr, int fq) const {
    const bool lat = u.pm < 128;
    const float* xin = lat ? xl + (size_t)u.pm * 256 * 1024 : xc + (size_t)(u.pm - 128) * 256 * 1024;
    float* xo = lat ? ol + (size_t)u.pm * 256 * 1024 : oc + (size_t)(u.pm - 128) * 256 * 1024;
    const float* g1 = mods + (size_t)(lat ? (u.pm >> 6) : 2) * 6144 + 2048;
    const int row0 = wr * 64 + fr, col0 = u.pn * 256 + wc * 32 + 4 * fq;
#pragma unroll
    for (int bj = 0; bj < 2; ++bj)
#pragma unroll
      for (int n = 0; n < 2; ++n) {
        const f32x4 gv = *(const f32x4*)(g1 + col0 + bj * 128 + n * 16);
        f32x4 xv[2][4];
#pragma unroll
        for (int ai = 0; ai < 2; ++ai)
#pragma unroll
          for (int m = 0; m < 4; ++m) xv[ai][m] = *(const f32x4*)(xin + (size_t)(row0 + ai * 128 + m * 16) * 1024 + col0 + bj * 128 + n * 16);
#pragma unroll
        for (int ai = 0; ai < 2; ++ai)
#pragma unroll
          for (int m = 0; m < 4; ++m)
            *(f32x4*)(xo + (size_t)(row0 + ai * 128 + m * 16) * 1024 + col0 + bj * 128 + n * 16) = xv[ai][m] + gv * acc[ai][bj][m][n];
        asm volatile("" ::: "memory");
      }
  }
};
__device__ __forceinline__ void phase_gemm_out(PP pp, int l, int bid, int nb, char* smem) {
  g8::DenseSched S{(l == 0) ? 130 : 128, 4, nb, bid};
  EpiOutProj E{(l == 0) ? p.x : p.out, (l == 0) ? p.ctx : (const float*)(p.ws + OFF_CTX),
               (const float*)(p.ws + OFF_MODS) + (size_t)l * 3 * 6144, p.out, (float*)(p.ws + OFF_CTX)};
  g8::gemm_stream<false, false>((LAS unsigned char*)smem, p.ws + OFF_CC, p.ws + OFF_W + (size_t)l * WL_SIZE + WL_OUT, S, E);
}

#define LBAR() do { asm volatile("s_waitcnt lgkmcnt(0)" ::: "memory"); __builtin_amdgcn_s_barrier(); asm volatile("" ::: "memory"); } while (0)
__device__ __forceinline__ void phase_prep(PP pp, int l, int bid, int nb, char* smem) {
  const int tid = tid_opaque(), lane = tid & 63, wv = wave_id(tid);
  const bfr* P = (const bfr*)(p.ws + OFF_P);
  char* S = p.ws + OFF_S;
  bfr* QN = (bfr*)(S + S_QN);
  bfr* KN = (bfr*)(S + S_KN);
  bfr* VT = (bfr*)(S + S_VT);
  bfr* RWR = (bfr*)(S + S_RWR);
  bfr* RWKK = (bfr*)(S + S_RWKK);
  bfr* RWV = (bfr*)(S + S_RWV);
  bfr* RWG = (bfr*)(S + S_RWG);
  float* RWW = (float*)(S + S_RWW);
  bfr* RWKD = (bfr*)(S + S_RWKD);
  bfr* RWB = (bfr*)(S + S_RWB);
  float* BON = (float*)(S + S_BON);
  bfr* GDQ = (bfr*)(S + S_GDQ);
  bfr* GDK = (bfr*)(S + S_GDK);
  bfr* GDV = (bfr*)(S + S_GDV);
  float* GDAB = (float*)(S + S_GDAB);
  const float* mu = p.rw_mu + (size_t)l * 896;
  const float* w0 = p.rw_w0 + (size_t)l * 512;
  const float* w_up = p.rw_w_up + (size_t)l * 2 * 32 * 256;
  const float* a0 = p.rw_a0 + (size_t)l * 512;
  const float* a_up = p.rw_a_up + (size_t)l * 2 * 32 * 256;
  const float* g_up = p.rw_g_up + (size_t)l * 64 * 256;
  const float* k_k = p.rw_k_k + (size_t)l * 256;
  const float* k_a = p.rw_k_a + (size_t)l * 256;
  const float* r_k = p.rw_r_k + (size_t)l * 256;
  const float* conv_w = p.gd_conv_w + (size_t)l * 5 * 768;
  const float* A_log = p.gd_A_log + (size_t)l * 8;
  const float* dt_bias = p.gd_dt_bias + (size_t)l * 8;
  const float* qg = p.na_q_gain + (size_t)l * 64;
  const float* kg = p.na_k_gain + (size_t)l * 64;

  unsigned* wlp = (unsigned*)smem;
  unsigned* lorp = (unsigned*)(smem + 96 * 256 * 4);
  __syncthreads();
  for (int i = tid; i < 96 * 256; i += NTHR) {
    const int rp = i >> 8, c = i & 255, r0 = 2 * rp;
    const float* src = r0 < 64 ? g_up + r0 * 256 + c : r0 < 128 ? w_up + (r0 - 64) * 256 + c : a_up + (r0 - 128) * 256 + c;
    wlp[i] = pk_bf16(src[0], src[256]);
  }
  __syncthreads();

  for (int tile = bid; tile < NTOK / 16; tile += nb) {
    const int m0 = tile * 16;
    int seq_lo, seq_hi, bb, tau0;
    if (m0 < NLAT) { bb = m0 >> 14; seq_lo = bb << 14; seq_hi = seq_lo + SEQ; tau0 = m0 - seq_lo; }
    else { bb = (m0 - NLAT) >> 8; seq_lo = NLAT + (bb << 8); seq_hi = seq_lo + CTXL; tau0 = SEQ + (m0 - seq_lo); }
    const f32x4 z4 = {0.f, 0.f, 0.f, 0.f};
    int tid_t = tid; asm volatile("" : "+v"(tid_t));
    const int lane_t = tid_t & 63;
    const int cb = lane_t * 4, hh = lane_t >> 4;
    const int lg = tid_t & 31, lt = tid_t >> 5;
    const int sl = lane_t >> 4, sc4 = (lane_t & 15) * 4;
    asm volatile("" ::: "memory");
    const f32x4 mur = *(const f32x4*)(mu + cb), muk = *(const f32x4*)(mu + 256 + cb), muv = *(const f32x4*)(mu + 512 + cb);
    const f32x4 mul = *(const f32x4*)(mu + 768 + lg * 4);

    f32x4 pr[3][4], pl[3];
    {
      const int mt0 = m0 + 2 * wv;
#pragma unroll
      for (int j = 0; j < 3; ++j)
#pragma unroll
        for (int t = 0; t < 4; ++t) {
          const int m = mt0 - 1 + t;
          const int mc = min(max(m, seq_lo), seq_hi - 1);
          const f32x4 ld = ldbf4(P + (size_t)mc * PINP + A_END + j * 256 + cb);
          pr[j][t] = (m == mc) ? ld : z4;
        }
#pragma unroll
      for (int t = 0; t < 3; ++t) {
        const int m = m0 + lt - 1 + t;
        const int mc = min(max(m, seq_lo), seq_hi - 1);
        const f32x4 ld = ldbf4(P + (size_t)mc * PINP + A_END + 768 + lg * 4);
        pl[t] = (m == mc) ? ld : z4;
      }
    }
    {
      const f32x4 v = pl[1] + mul * (0.5f * (pl[0] + pl[2]) - pl[1]);
      float fv[4];
#pragma unroll
      for (int i = 0; i < 4; ++i) {
        const int ch = lg * 4 + i;
        fv[i] = ch < 32 ? tanhf(v[i]) : ch < 64 ? v[i] : sigmoidf_(v[i]);
      }
      lorp[(lg * 2) * 16 + lt] = pk_bf16(fv[0], fv[1]);
      lorp[(lg * 2 + 1) * 16 + lt] = pk_bf16(fv[2], fv[3]);
    }
    f32x4 rr[2], rk[2], rv[2];
#pragma unroll
    for (int t = 0; t < 2; ++t) {
      rr[t] = pr[0][t + 1] + mur * (0.5f * (pr[0][t] + pr[0][t + 2]) - pr[0][t + 1]);
      rk[t] = pr[1][t + 1] + muk * (0.5f * (pr[1][t] + pr[1][t + 2]) - pr[1][t + 1]);
      rv[t] = pr[2][t + 1] + muv * (0.5f * (pr[2][t] + pr[2][t + 2]) - pr[2][t + 1]);
    }
    LBAR();
    bf16x4 pgr[20], pvr[4];
    const bf16x4 zr = {0, 0, 0, 0};
    const bool is_gd = wv < 3, is_na = (wv >= 3 && wv < 7);
    const int sec = is_gd ? wv * 4 + sl : (wv - 3) * 4 + sl;
    if (is_gd) {
#pragma unroll
      for (int t = 0; t < 20; ++t) {
        const int m = m0 - 2 + t;
        const int mc = min(max(m, seq_lo), seq_hi - 1);
        pgr[t] = *(const bf16x4*)(P + (size_t)mc * PINP + B_END + sec * 64 + sc4);
      }
    } else if (is_na) {
#pragma unroll
      for (int t = 0; t < 16; ++t) pgr[t] = *(const bf16x4*)(P + (size_t)(m0 + t) * PINP + sec * 64 + sc4);
#pragma unroll
      for (int t = 16; t < 20; ++t) pgr[t] = zr;
    } else {
#pragma unroll
      for (int t = 0; t < 20; ++t) pgr[t] = zr;
    }
    {
      const int vc = (tid_t & 127) * 4, tq = (tid_t >> 7) * 4;
#pragma unroll
      for (int t = 0; t < 4; ++t) pvr[t] = *(const bf16x4*)(P + (size_t)(m0 + tq + t) * PINP + 1024 + vc);
    }
    asm volatile("" ::: "memory");
    {
      f32x4 gacc[2], wa0[2], wa1[2], aa0[2], aa1[2];
#pragma unroll
      for (int t = 0; t < 2; ++t) { gacc[t] = z4; wa0[t] = z4; wa1[t] = z4; aa0[t] = z4; aa1[t] = z4; }
      typedef __attribute__((ext_vector_type(4))) unsigned u32x4_t;
      typedef __attribute__((ext_vector_type(2))) unsigned u32x2_t;
#pragma unroll 4
      for (int jp = 0; jp < 32; ++jp) {
        const u32x4_t wq = *(const u32x4_t*)(wlp + jp * 256 + cb);
        const u32x2_t sv = *(const u32x2_t*)(lorp + (32 + jp) * 16 + 2 * wv);
#pragma unroll
        for (int i = 0; i < 4; ++i) { gacc[0][i] = dot2bf(wq[i], sv[0], gacc[0][i]); gacc[1][i] = dot2bf(wq[i], sv[1], gacc[1][i]); }
      }
#pragma unroll 2
      for (int jp = 0; jp < 16; ++jp) {
        const u32x4_t q0 = *(const u32x4_t*)(wlp + (32 + jp) * 256 + cb), q1 = *(const u32x4_t*)(wlp + (48 + jp) * 256 + cb);
        const u32x4_t q2 = *(const u32x4_t*)(wlp + (64 + jp) * 256 + cb), q3 = *(const u32x4_t*)(wlp + (80 + jp) * 256 + cb);
        const u32x2_t tv = *(const u32x2_t*)(lorp + jp * 16 + 2 * wv);
        const u32x2_t dv = *(const u32x2_t*)(lorp + (16 + jp) * 16 + 2 * wv);
#pragma unroll
        for (int i = 0; i < 4; ++i) {
          wa0[0][i] = dot2bf(q0[i], tv[0], wa0[0][i]); wa0[1][i] = dot2bf(q0[i], tv[1], wa0[1][i]);
          wa1[0][i] = dot2bf(q1[i], tv[0], wa1[0][i]); wa1[1][i] = dot2bf(q1[i], tv[1], wa1[1][i]);
          aa0[0][i] = dot2bf(q2[i], dv[0], aa0[0][i]); aa0[1][i] = dot2bf(q2[i], dv[1], aa0[1][i]);
          aa1[0][i] = dot2bf(q3[i], dv[0], aa1[0][i]); aa1[1][i] = dot2bf(q3[i], dv[1], aa1[1][i]);
        }
      }
      asm volatile("" ::: "memory");
      const f32x4 kkc = *(const f32x4*)(k_k + cb), kac = *(const f32x4*)(k_a + cb), rkc = *(const f32x4*)(r_k + cb);
      const f32x4 w00 = *(const f32x4*)(w0 + cb), w01 = *(const f32x4*)(w0 + 256 + cb), a00 = *(const f32x4*)(a0 + cb), a01 = *(const f32x4*)(a0 + 256 + cb);
#pragma unroll
      for (int t = 0; t < 2; ++t) {
        const int m = m0 + 2 * wv + t;
        const f32x4 r = rr[t], k = rk[t], v = rv[t];
        const f32x4 kkraw = k * kkc;
        const float ssum = row16_sum((kkraw[0] * kkraw[0] + kkraw[1] * kkraw[1]) + (kkraw[2] * kkraw[2] + kkraw[3] * kkraw[3]));
        const f32x4 kk = kkraw * rsqrtf(ssum + 1e-6f);
        float bon = 0.f;
#pragma unroll
        for (int d = 0; d < 2; ++d) {
          const f32x4 wlin = d == 0 ? w00 + wa0[t] : w01 + wa1[t];
          const f32x4 alin = d == 0 ? a00 + aa0[t] : a01 + aa1[t];
          f32x4 lw, kd, bv;
#pragma unroll
          for (int i = 0; i < 4; ++i) {
            const float w_log = -softplusf_(-wlin[i]) - 0.5f;
            const float a = sigmoidf_(alin[i]);
            lw[i] = -__expf(w_log);
            kd[i] = k[i] * (1.f + (a - 1.f) * kac[i]);
            bv[i] = kk[i] * a;
            bon += r[i] * kd[i] * rkc[i];
          }
          const size_t o = ((size_t)d * NTOK + m) * 256 + cb;
          *(f32x4*)(RWW + o) = lw; *(bf16x4*)(RWKD + o) = pack4(kd[0], kd[1], kd[2], kd[3]); *(bf16x4*)(RWB + o) = pack4(bv[0], bv[1], bv[2], bv[3]);
        }
        bon = row16_sum(bon);
        const size_t o = (size_t)m * 256 + cb;
        *(bf16x4*)(RWR + o) = pack4(r[0], r[1], r[2], r[3]); *(bf16x4*)(RWKK + o) = pack4(kk[0], kk[1], kk[2], kk[3]);
        *(bf16x4*)(RWV + o) = pack4(v[0], v[1], v[2], v[3]); *(bf16x4*)(RWG + o) = pack4(gacc[t][0], gacc[t][1], gacc[t][2], gacc[t][3]);
        if ((lane_t & 15) == 0) BON[(size_t)m * 4 + hh] = bon;
      }
    }
    if (is_gd) {
      f32x4 cw[5];
#pragma unroll
      for (int j = 0; j < 5; ++j) cw[j] = *(const f32x4*)(conv_w + j * 768 + sec * 64 + sc4);
      f32x4 pg[20];
#pragma unroll
      for (int t = 0; t < 20; ++t) {
        const int m = m0 - 2 + t;
        const bool inr = (m >= seq_lo) && (m < seq_hi);
        const f32x4 cv = {bf2f(pgr[t][0]), bf2f(pgr[t][1]), bf2f(pgr[t][2]), bf2f(pgr[t][3])};
        pg[t] = inr ? cv : z4;
      }
#pragma unroll
      for (int t = 0; t < 16; ++t) {
        f32x4 acc = z4;
#pragma unroll
        for (int j = 0; j < 5; ++j) acc += cw[j] * pg[t + j];
        f32x4 val = {siluf_(acc[0]), siluf_(acc[1]), siluf_(acc[2]), siluf_(acc[3])};
        const int m = m0 + t;
        if (sec < 8) {
          const float ss = row16_sum((val[0] * val[0] + val[1] * val[1]) + (val[2] * val[2] + val[3] * val[3]));
          val = val * rsqrtf(ss + 1e-6f);
          if (sec < 4) { const f32x4 vq = val * 0.125f; *(bf16x4*)(GDQ + (size_t)m * 256 + sec * 64 + sc4) = pack4(vq[0], vq[1], vq[2], vq[3]); }
          else *(bf16x4*)(GDK + (size_t)m * 256 + (sec - 4) * 64 + sc4) = pack4(val[0], val[1], val[2], val[3]);
        } else *(bf16x4*)(GDV + (size_t)m * 256 + (sec - 8) * 64 + sc4) = pack4(val[0], val[1], val[2], val[3]);
      }
    } else if (is_na) {
      const f32x4 gq = *(const f32x4*)(qg + sc4) * (0.125f * 1.4426950408889634f), gk = *(const f32x4*)(kg + sc4);
#pragma unroll
      for (int t = 0; t < 16; ++t) {
        f32x4 val = {bf2f(pgr[t][0]), bf2f(pgr[t][1]), bf2f(pgr[t][2]), bf2f(pgr[t][3])};
        const float ss = row16_sum((val[0] * val[0] + val[1] * val[1]) + (val[2] * val[2] + val[3] * val[3]));
        val = val * rsqrtf(ss * (1.f / 64.f) + 1e-6f);
        const int m = m0 + t;
        if (sec < 8) { const f32x4 o = val * gq; *(bf16x4*)(QN + (size_t)m * 512 + sec * 64 + sc4) = pack4(o[0], o[1], o[2], o[3]); }
        else { const f32x4 o = val * gk; *(bf16x4*)(KN + (size_t)m * 512 + (sec - 8) * 64 + sc4) = pack4(o[0], o[1], o[2], o[3]); }
      }
    }
    if (tid_t < 256) {
      const int t = tid_t >> 4, j = tid_t & 15;
      const int m = m0 + t;
      const float pv = bf2f((short)P[(size_t)m * PINP + B_END + 1024 + j]);
      float o;
      if (j < 8) o = -__expf(A_log[j]) * softplusf_(pv + dt_bias[j]);
      else o = sigmoidf_(pv);
      GDAB[(size_t)m * 16 + j] = o;
    }
    {
      const int vc = (tid_t & 127) * 4, tq = (tid_t >> 7) * 4;
#pragma unroll
      for (int i = 0; i < 4; ++i) {
        const int hd = vc + i;
        bfr* dst = VT + ((size_t)(bb * 8 + (hd >> 6)) * (TTOK / 16) + (tau0 >> 4)) * 1024 + (hd & 63) * 16 + tq;
        const bf16x4 o = {pvr[0][i], pvr[1][i], pvr[2][i], pvr[3][i]};
        *(bf16x4*)dst = o;
      }
    }
    LBAR();
  }
  __syncthreads();
}

__device__ __forceinline__ int scan_tok(int b, int d, int s) {
  if (s < CTXL) { int t = d ? (CTXL - 1 - s) : s; return NLAT + b * CTXL + t; }
  int u = s - CTXL; int t = d ? (SEQ - 1 - u) : u; return b * SEQ + t;
}
#define CS 72
#define SLOT_BYTES (64 * CS * 2)
#define F0_STRIDE 68
#define X1_F0 (13 * SLOT_BYTES)
#define X1_ARR (X1_F0 + 64 * F0_STRIDE * 4)

#define MM_FRAGS(As, Bs, a0, a1, b00, b01, b10, b11)                                                     \
  const bf16x8 a0 = *(const bf16x8*)((As) + ((mt * 16 + fr) * CS + fq * 8) * 2);                         \
  const bf16x8 a1 = *(const bf16x8*)((As) + ((mt * 16 + fr) * CS + 32 + fq * 8) * 2);                    \
  const bf16x8 b00 = *(const bf16x8*)((Bs) + ((nt0 * 16 + fr) * CS + fq * 8) * 2);                       \
  const bf16x8 b01 = *(const bf16x8*)((Bs) + ((nt0 * 16 + fr) * CS + 32 + fq * 8) * 2);                  \
  const bf16x8 b10 = *(const bf16x8*)((Bs) + ((nt0 * 16 + 16 + fr) * CS + fq * 8) * 2);                  \
  const bf16x8 b11 = *(const bf16x8*)((Bs) + ((nt0 * 16 + 16 + fr) * CS + 32 + fq * 8) * 2);
#define MM_2TILES(acc0, acc1, a0, a1, b00, b01, b10, b11)                                                \
  acc0 = __builtin_amdgcn_mfma_f32_16x16x32_bf16(a0, b00, acc0, 0, 0, 0);                                \
  acc0 = __builtin_amdgcn_mfma_f32_16x16x32_bf16(a1, b01, acc0, 0, 0, 0);                                \
  acc1 = __builtin_amdgcn_mfma_f32_16x16x32_bf16(a0, b10, acc1, 0, 0, 0);                                \
  acc1 = __builtin_amdgcn_mfma_f32_16x16x32_bf16(a1, b11, acc1, 0, 0, 0);
__device__ __forceinline__ void wr_T(char* slot, int mt, int nt, int fr, int fq, f32x4 v) {
  *(bf16x4*)(slot + ((nt * 16 + fr) * CS + mt * 16 + 4 * fq) * 2) = pack4(v[0], v[1], v[2], v[3]);
}

struct ChunkIn { float lw[8], be[8]; unsigned f0[8], f1[8], f2[8], f3[8], xv[8]; };
template <bool GDN>
__device__ __forceinline__ void chunk_load(PP pp, int t, ChunkIn& ci) {
  const int tid = tid_opaque(), c = tid & 63, tg = wave_id(tid);
  const int chain = t / NCHUNK, n = t - chain * NCHUNK;
  const int d = chain & 1, h = (chain >> 1) & 3, b = (chain >> 3) & 1;
  const char* S = p.ws + OFF_S;
#pragma unroll
  for (int u = 0; u < 8; ++u) {
    const int m = scan_tok(b, d, n * 64 + tg * 8 + u);
    const size_t o = (size_t)m * 256 + h * 64 + c;
    if (!GDN) {
      ci.lw[u] = ((const float*)(S + S_RWW))[(size_t)d * NTOK * 256 + o];
      ci.f0[u] = ((const unsigned short*)(S + S_RWKK))[o];
      ci.f1[u] = ((const unsigned short*)(S + S_RWB))[(size_t)d * NTOK * 256 + o];
      ci.f2[u] = ((const unsigned short*)(S + S_RWKD))[(size_t)d * NTOK * 256 + o];
      ci.f3[u] = ((const unsigned short*)(S + S_RWR))[o];
      ci.xv[u] = ((const unsigned short*)(S + S_RWV))[o];
      ci.be[u] = 1.f;
    } else {
      ci.lw[u] = ((const float*)(S + S_GDAB))[(size_t)m * 16 + d * 4 + h];
      ci.be[u] = ((const float*)(S + S_GDAB))[(size_t)m * 16 + 8 + d * 4 + h];
      ci.f0[u] = ((const unsigned short*)(S + S_GDK))[o];
      ci.f3[u] = ((const unsigned short*)(S + S_GDQ))[o];
      ci.xv[u] = ((const unsigned short*)(S + S_GDV))[o];
      ci.f1[u] = 0u; ci.f2[u] = 0u;
    }
  }
}
template <bool GDN>
__device__ __forceinline__ void chunk_prep_task(PP pp, int t, int t_next, bool has_next, const ChunkIn& ci, ChunkIn& nx, char* smem) {
  const int chain = t / NCHUNK, n = t - chain * NCHUNK;
  const int d = chain & 1, h = (chain >> 1) & 3, b = (chain >> 3) & 1;
  (void)b; (void)d; (void)h;
  const int tid = tid_opaque(), lane = tid & 63, wv = wave_id(tid);
  const int fr = lane & 15, fq = lane >> 4, mt = wv >> 1, nt0 = (wv & 1) * 2;
  char* S = p.ws + OFF_S;
  char* CH = p.ws + OFF_CH;
  const size_t cc = (size_t)chain * NCHUNK + n;
  char* const p0 = smem;
  char* const p1 = smem + 1 * SLOT_BYTES;
  char* const p2 = smem + 2 * SLOT_BYTES;
  char* const p3 = smem + 3 * SLOT_BYTES;
  char* const p4 = smem + 4 * SLOT_BYTES;
  char* const p5 = smem + 5 * SLOT_BYTES;
  char* const p6 = smem + 6 * SLOT_BYTES;
  char* const p7 = smem + 7 * SLOT_BYTES;
  char* const p8 = smem + 8 * SLOT_BYTES;
  char* const p9 = smem + 9 * SLOT_BYTES;
  char* const p10 = smem + 10 * SLOT_BYTES;
  char* const p11 = smem + 11 * SLOT_BYTES;
  char* const p12 = smem + 12 * SLOT_BYTES;
  float* const F0 = (float*)(smem + X1_F0);
  float* const Lv = (float*)(smem + X1_ARR);
  float* const Lm1v = Lv + 64;
  float* const betav = Lv + 128;
  float* const eLv = Lv + 192;
  float* const gC = Lv + 256;
  float* const gsum = Lv + 320;
  char* const sKt = p0;
  char* const sBh = GDN ? p0 : p1;
  char* const sKh = GDN ? p0 : p2;

  {
    const int c = lane, tg = wv;
    const float* lw = ci.lw; const float* be = ci.be;
    float f0[8], f1[8], f2[8], f3[8], xv[8];
#pragma unroll
    for (int u = 0; u < 8; ++u) {
      f0[u] = __uint_as_float(ci.f0[u] << 16); f1[u] = __uint_as_float(ci.f1[u] << 16); f2[u] = __uint_as_float(ci.f2[u] << 16);
      f3[u] = __uint_as_float(ci.f3[u] << 16); xv[u] = __uint_as_float(ci.xv[u] << 16);
    }
    float cum[8];
    cum[0] = lw[0];
#pragma unroll
    for (int u = 1; u < 8; ++u) cum[u] = cum[u - 1] + lw[u];
    gsum[tg * 64 + c] = cum[7];
    LBAR();
    float off = 0.f, LC = 0.f;
#pragma unroll
    for (int g2 = 0; g2 < 8; ++g2) { const float gs = gsum[g2 * 64 + c]; LC += gs; off += (g2 < tg) ? gs : 0.f; }
    bf16x8 vKtT, vBbT, vKbT, vXT;
#pragma unroll
    for (int u = 0; u < 8; ++u) {
      const int t = tg * 8 + u;
      const float L = off + cum[u], Lm1 = L - lw[u];
      if (!GDN) {
        const float eLm1 = __expf(Lm1), enL = __expf(-L), eL = __expf(L), eCL = __expf(LC - L);
        const float kt = f0[u] * eLm1;
        *(bfr*)(p0 + (t * CS + c) * 2) = f2bf(kt);
        *(bfr*)(p1 + (t * CS + c) * 2) = f2bf(f1[u] * enL);
        *(bfr*)(p2 + (t * CS + c) * 2) = f2bf(f2[u] * enL);
        *(bfr*)(p3 + (t * CS + c) * 2) = f2bf(f3[u] * eL);
        vKtT[u] = (short)f2bf(kt);
        vBbT[u] = (short)f2bf(f1[u] * eCL);
        vKbT[u] = (short)f2bf(f2[u] * eCL);
        vXT[u] = (short)f2bf(xv[u]);
      } else {
        *(bfr*)(p0 + (t * CS + c) * 2) = f2bf(f0[u]);
        *(bfr*)(p3 + (t * CS + c) * 2) = f2bf(f3[u]);
        vKtT[u] = (short)f2bf(f0[u] * __expf(Lm1));
        vBbT[u] = (short)f2bf(be[u] * f0[u] * __expf(LC - Lm1));
        vKbT[u] = (short)f2bf(f0[u] * __expf(LC - L));
        vXT[u] = (short)f2bf(be[u] * xv[u]);
        if (c == 0) { Lv[t] = L; Lm1v[t] = Lm1; betav[t] = be[u]; eLv[t] = __expf(L); }
      }
    }
    *(bf16x8*)(p4 + (c * CS + tg * 8) * 2) = vKtT;
    *(bf16x8*)(p5 + (c * CS + tg * 8) * 2) = vBbT;
    *(bf16x8*)(p6 + (c * CS + tg * 8) * 2) = vKbT;
    *(bf16x8*)(p7 + (c * CS + tg * 8) * 2) = vXT;
    if (tg == 0) gC[c] = __expf(LC);
    if (!GDN && tid < 64) { Lv[tid] = 0.f; Lm1v[tid] = 0.f; betav[tid] = 1.f; eLv[tid] = 1.f; }
  }
  LBAR();
  if (has_next) chunk_load<GDN>(pp, t_next, nx);
  {
    {
      MM_FRAGS(sKt, sBh, a0, a1, b00, b01, b10, b11)
      f32x4 c0 = {0.f, 0.f, 0.f, 0.f}, c1 = c0;
      MM_2TILES(c0, c1, a0, a1, b00, b01, b10, b11)
#pragma unroll
      for (int q = 0; q < 2; ++q) {
        const int sI = (nt0 + q) * 16 + fr;
        const f32x4 cv = q ? c1 : c0;
        f32x4 o;
#pragma unroll
        for (int r = 0; r < 4; ++r) {
          const int tI = mt * 16 + 4 * fq + r;
          float v = cv[r];
          if (GDN) v *= betav[sI] * __expf(fminf(Lm1v[tI] - Lm1v[sI], 0.f));
          o[r] = (sI < tI) ? v : 0.f;
        }
        *(f32x4*)(F0 + sI * F0_STRIDE + mt * 16 + 4 * fq) = o;
        wr_T(p11, mt, nt0 + q, fr, fq, o);
      }
    }
    {
      MM_FRAGS(sKt, sKh, a0, a1, b00, b01, b10, b11)
      f32x4 c0 = {0.f, 0.f, 0.f, 0.f}, c1 = c0;
      MM_2TILES(c0, c1, a0, a1, b00, b01, b10, b11)
#pragma unroll
      for (int q = 0; q < 2; ++q) {
        const int sI = (nt0 + q) * 16 + fr;
        const f32x4 cv = q ? c1 : c0;
        f32x4 o;
#pragma unroll
        for (int r = 0; r < 4; ++r) {
          const int tI = mt * 16 + 4 * fq + r;
          float v = cv[r];
          if (GDN) v *= __expf(fminf(Lm1v[tI] - Lv[sI], 0.f));
          o[r] = (sI < tI) ? v : 0.f;
        }
        wr_T(p9, mt, nt0 + q, fr, fq, o);
      }
    }
    {
      MM_FRAGS(sBh, p3, a0, a1, b00, b01, b10, b11)
      f32x4 c0 = {0.f, 0.f, 0.f, 0.f}, c1 = c0;
      MM_2TILES(c0, c1, a0, a1, b00, b01, b10, b11)
#pragma unroll
      for (int q = 0; q < 2; ++q) {
        const int tI = (nt0 + q) * 16 + fr;
        const f32x4 cv = q ? c1 : c0;
        f32x4 o;
#pragma unroll
        for (int r = 0; r < 4; ++r) {
          const int sI = mt * 16 + 4 * fq + r;
          float v = cv[r];
          if (GDN) v *= betav[sI] * __expf(fminf(Lv[tI] - Lm1v[sI], 0.f));
          o[r] = (sI <= tI) ? v : 0.f;
        }
        wr_T(p10, mt, nt0 + q, fr, fq, o);
      }
    }
  }
  LBAR();
  if (wv < 2) {
    const int base = wv * 32, other = 32 - base, c = lane & 31;
    float tr[32];
#pragma unroll
    for (int j = 0; j < 32; ++j) tr[j] = 0.f;
#pragma unroll
    for (int ip = 15; ip >= 0; --ip) {
      const int i = 2 * ip + 1, i2 = 2 * ip;
      float a0 = (c == i) ? 1.f : 0.f, a1 = 0.f, b0 = (c == i2) ? 1.f : 0.f, b1 = 0.f;
      const float aii = F0[(base + i2) * F0_STRIDE + base + i];
#pragma unroll
      for (int jb = ((i + 1) & ~3); jb < 32; jb += 4) {
        const f32x4 a4 = *(const f32x4*)(F0 + (base + i) * F0_STRIDE + base + jb);
        const f32x4 b4 = *(const f32x4*)(F0 + (base + i2) * F0_STRIDE + base + jb);
        a0 -= a4[0] * tr[jb]; a1 -= a4[1] * tr[jb + 1]; a0 -= a4[2] * tr[jb + 2]; a1 -= a4[3] * tr[jb + 3];
        b0 -= b4[0] * tr[jb]; b1 -= b4[1] * tr[jb + 1]; b0 -= b4[2] * tr[jb + 2]; b1 -= b4[3] * tr[jb + 3];
      }
      const float ti = a0 + a1;
      const float ti2 = (b0 + b1) - aii * ti;
      tr[i] = ti; tr[i2] = ti2;
      if (lane < 32) {
        *(bfr*)(p8 + ((base + i) * CS + base + c) * 2) = f2bf(ti);
        *(bfr*)(p8 + ((base + i) * CS + other + c) * 2) = (bfr)0;
        *(bfr*)(p8 + ((base + i2) * CS + base + c) * 2) = f2bf(ti2);
        *(bfr*)(p8 + ((base + i2) * CS + other + c) * 2) = (bfr)0;
      }
    }
    if (lane < 32) {
#pragma unroll
      for (int q = 0; q < 4; ++q) {
        bf16x8 o, z;
#pragma unroll
        for (int j = 0; j < 8; ++j) { o[j] = (short)f2bf(tr[8 * q + j]); z[j] = 0; }
        *(bf16x8*)(p12 + ((base + c) * CS + base + 8 * q) * 2) = o;
        *(bf16x8*)(p12 + ((base + c) * CS + other + 8 * q) * 2) = z;
      }
    }
  }
  LBAR();
  {
    MM_FRAGS(p11, p12, a0, a1, b00, b01, b10, b11)
    f32x4 c0 = {0.f, 0.f, 0.f, 0.f}, c1 = c0;
    MM_2TILES(c0, c1, a0, a1, b00, b01, b10, b11)
    wr_T(p1, mt, nt0, fr, fq, c0);
    wr_T(p1, mt, nt0 + 1, fr, fq, c1);
  }
  LBAR();
  if (mt < 2 && nt0 == 2) {
    MM_FRAGS(p8, p1, a0, a1, b00, b01, b10, b11)
    f32x4 c0 = {0.f, 0.f, 0.f, 0.f}, c1 = c0;
    MM_2TILES(c0, c1, a0, a1, b00, b01, b10, b11)
#pragma unroll
    for (int r = 0; r < 4; ++r) {
      *(bfr*)(p8 + ((mt * 16 + 4 * fq + r) * CS + (nt0) * 16 + fr) * 2) = f2bf(-c0[r]);
      *(bfr*)(p8 + ((mt * 16 + 4 * fq + r) * CS + (nt0 + 1) * 16 + fr) * 2) = f2bf(-c1[r]);
    }
  }
  LBAR();
  {
    {
      MM_FRAGS(p8, p5, a0, a1, b00, b01, b10, b11)
      f32x4 c0 = {0.f, 0.f, 0.f, 0.f}, c1 = c0;
      MM_2TILES(c0, c1, a0, a1, b00, b01, b10, b11)
      wr_T(p11, mt, nt0, fr, fq, -c0);
      wr_T(p11, mt, nt0 + 1, fr, fq, -c1);
    }
    {
      MM_FRAGS(p8, p10, a0, a1, b00, b01, b10, b11)
      f32x4 c0 = {0.f, 0.f, 0.f, 0.f}, c1 = c0;
      MM_2TILES(c0, c1, a0, a1, b00, b01, b10, b11)
      wr_T(p12, mt, nt0, fr, fq, -c0);
      wr_T(p12, mt, nt0 + 1, fr, fq, -c1);
    }
  }
  LBAR();
  {
    {
      MM_FRAGS(p4, p11, a0, a1, b00, b01, b10, b11)
      f32x4 c0 = {0.f, 0.f, 0.f, 0.f}, c1 = c0;
      MM_2TILES(c0, c1, a0, a1, b00, b01, b10, b11)
#pragma unroll
      for (int q = 0; q < 2; ++q) {
        const int cp = (nt0 + q) * 16 + fr;
        f32x4 cv = q ? c1 : c0;
#pragma unroll
        for (int r = 0; r < 4; ++r) { const int cI = mt * 16 + 4 * fq + r; if (cI == cp) cv[r] += gC[cI]; }
        wr_T(p10, mt, nt0 + q, fr, fq, cv);
      }
    }
    {
      MM_FRAGS(p9, p11, a0, a1, b00, b01, b10, b11)
      f32x4 c0 = {0.f, 0.f, 0.f, 0.f}, c1 = c0;
      MM_2TILES(c0, c1, a0, a1, b00, b01, b10, b11)
#pragma unroll
      for (int q = 0; q < 2; ++q) {
        const int cp = (nt0 + q) * 16 + fr;
        f32x4 cv = q ? c1 : c0;
        const bf16x4 kb = *(const bf16x4*)(p6 + (cp * CS + mt * 16 + 4 * fq) * 2);
#pragma unroll
        for (int r = 0; r < 4; ++r) cv[r] += __uint_as_float(((unsigned)(unsigned short)kb[r]) << 16);
        wr_T(p8, mt, nt0 + q, fr, fq, cv);
      }
    }
    {
      MM_FRAGS(p4, p12, a0, a1, b00, b01, b10, b11)
      f32x4 c0 = {0.f, 0.f, 0.f, 0.f}, c1 = c0;
      MM_2TILES(c0, c1, a0, a1, b00, b01, b10, b11)
#pragma unroll
      for (int q = 0; q < 2; ++q) {
        const int tI = (nt0 + q) * 16 + fr;
        f32x4 cv = q ? c1 : c0;
        const bf16x4 rt = *(const bf16x4*)(p3 + (tI * CS + mt * 16 + 4 * fq) * 2);
        const float el = eLv[tI];
#pragma unroll
        for (int r = 0; r < 4; ++r) cv[r] += __uint_as_float(((unsigned)(unsigned short)rt[r]) << 16) * el;
        wr_T(p1, mt, nt0 + q, fr, fq, cv);
      }
    }
    {
      f32x4 c0 = {0.f, 0.f, 0.f, 0.f}, c1 = c0;
      {
        MM_FRAGS(sKh, p3, a0, a1, b00, b01, b10, b11)
        MM_2TILES(c0, c1, a0, a1, b00, b01, b10, b11)
      }
#pragma unroll
      for (int q = 0; q < 2; ++q) {
        const int tI = (nt0 + q) * 16 + fr;
#pragma unroll
        for (int r = 0; r < 4; ++r) {
          const int sI = mt * 16 + 4 * fq + r;
          float v = q ? c1[r] : c0[r];
          if (GDN) v *= __expf(fminf(Lv[tI] - Lv[sI], 0.f));
          v = (sI <= tI) ? v : 0.f;
          if (q) c1[r] = v; else c0[r] = v;
        }
      }
      {
        MM_FRAGS(p9, p12, a0, a1, b00, b01, b10, b11)
        MM_2TILES(c0, c1, a0, a1, b00, b01, b10, b11)
      }
      wr_T(p5, mt, nt0, fr, fq, c0);
      wr_T(p5, mt, nt0 + 1, fr, fq, c1);
    }
  }
  LBAR();
  {
    {
      MM_FRAGS(p8, p7, a0, a1, b00, b01, b10, b11)
      f32x4 c0 = {0.f, 0.f, 0.f, 0.f}, c1 = c0;
      MM_2TILES(c0, c1, a0, a1, b00, b01, b10, b11)
      bfr* QT = (bfr*)(CH + cc * CH_REC + CH_QT);
      *(bf16x4*)(QT + ((mt * 4 + nt0) * 64 + lane) * 4) = pack4(c0[0], c0[1], c0[2], c0[3]);
      *(bf16x4*)(QT + ((mt * 4 + nt0 + 1) * 64 + lane) * 4) = pack4(c1[0], c1[1], c1[2], c1[3]);
    }
    {
      MM_FRAGS(p7, p5, a0, a1, b00, b01, b10, b11)
      f32x4 c0 = {0.f, 0.f, 0.f, 0.f}, c1 = c0;
      MM_2TILES(c0, c1, a0, a1, b00, b01, b10, b11)
      bfr* YX = (bfr*)(CH + cc * CH_REC + CH_YX);
      *(bf16x4*)(YX + ((mt * 4 + nt0) * 64 + lane) * 4) = pack4(c0[0], c0[1], c0[2], c0[3]);
      *(bf16x4*)(YX + ((mt * 4 + nt0 + 1) * 64 + lane) * 4) = pack4(c1[0], c1[1], c1[2], c1[3]);
    }
    {
      const int fm = wv >> 1, fa = wv & 1;
      const int row = fm * 16 + fr;
      {
        const bf16x4 lo = *(const bf16x4*)(p10 + (row * CS + 32 * fa + 4 * fq) * 2);
        const bf16x4 hi = *(const bf16x4*)(p10 + (row * CS + 32 * fa + 16 + 4 * fq) * 2);
        bf16x8 f; f[0] = lo[0]; f[1] = lo[1]; f[2] = lo[2]; f[3] = lo[3]; f[4] = hi[0]; f[5] = hi[1]; f[6] = hi[2]; f[7] = hi[3];
        *(bf16x8*)(CH + cc * CH_REC + CH_PT + (size_t)((fm * 2 + fa) * 64 + lane) * 16) = f;
      }
      {
        const bf16x4 lo = *(const bf16x4*)(p1 + (row * CS + 32 * fa + 4 * fq) * 2);
        const bf16x4 hi = *(const bf16x4*)(p1 + (row * CS + 32 * fa + 16 + 4 * fq) * 2);
        bf16x8 f; f[0] = lo[0]; f[1] = lo[1]; f[2] = lo[2]; f[3] = lo[3]; f[4] = hi[0]; f[5] = hi[1]; f[6] = hi[2]; f[7] = hi[3];
        *(bf16x8*)(CH + cc * CH_REC + CH_RYT + (size_t)((fm * 2 + fa) * 64 + lane) * 16) = f;
      }
    }
  }
  LBAR();
}

template <bool GDN>
__device__ __forceinline__ void chunk_prep_loop(PP pp, int t0, int tend, int nb, char* smem) {
  ChunkIn cur, nxt;
  if (t0 < tend) chunk_load<GDN>(pp, t0, cur);
  for (int t = t0; t < tend; t += nb) {
    const bool has_next = (t + nb) < tend;
    chunk_prep_task<GDN>(pp, t, t + nb, has_next, cur, nxt, smem);
    cur = nxt;
  }
}
__device__ __forceinline__ void phase_chunk_prep(PP pp, int bid, int nb, char* smem) {
  __syncthreads();
  const int half = (NCHAIN / 2) * NCHUNK;
  chunk_prep_loop<false>(pp, bid, half, nb, smem);
  const int k0 = (half - bid + nb - 1) / nb;
  chunk_prep_loop<true>(pp, bid + k0 * nb, NCHAIN * NCHUNK, nb, smem);
  __syncthreads();
}

#define X2_BUF 32768
#define X2_BAR() do { asm volatile("s_waitcnt lgkmcnt(0)" ::: "memory"); __builtin_amdgcn_s_barrier(); asm volatile("" ::: "memory"); } while (0)
__device__ __forceinline__ void chunk_seq_chain(PP pp, int chain, char* smem) {
  __syncthreads();
  const int tid = tid_opaque(), lane = tid & 63, wv = wave_id(tid);
  const int d = chain & 1, h = (chain >> 1) & 3, b = (chain >> 3) & 1, ty = chain >> 4;
  const char* CH = p.ws + OFF_CH;
  bfr* Y = (bfr*)(p.ws + OFF_S + (ty ? S_YGD : S_YRW)) + (size_t)d * NTOK * 256;
  const size_t c0 = (size_t)chain * NCHUNK;
  if (wv >= 4) {
    const int lw = wv - 4;
    const char* src0 = CH + c0 * CH_REC + (size_t)lane * 16;
#define X2_DMA(n) { const char* s_ = src0 + (size_t)(n) * CH_REC; LAS unsigned char* d_ = (LAS unsigned char*)smem + ((n) & 3) * X2_BUF;       \
      _Pragma("unroll") for (int i = 0; i < 8; ++i) {                                                                                       \
        const int piece = i * 4 + lw;                                                                                                       \
        __builtin_amdgcn_global_load_lds((const unsigned*)(s_ + piece * 1024), (LAS unsigned*)(d_ + piece * 1024), 16, 0, 0); } }
    X2_DMA(0) X2_DMA(1) X2_DMA(2)
    asm volatile("s_waitcnt vmcnt(16)" ::: "memory");
    X2_BAR();
    for (int n = 0; n < NCHUNK; ++n) {
      if (n + 3 < NCHUNK) { X2_DMA(n + 3) asm volatile("s_waitcnt vmcnt(16)" ::: "memory"); }
      else if (n + 2 < NCHUNK) asm volatile("s_waitcnt vmcnt(8)" ::: "memory");
      else asm volatile("s_waitcnt vmcnt(0)" ::: "memory");
      X2_BAR();
    }
#undef X2_DMA
  } else {
    const int vt = wv, fr = lane & 15, fq = lane >> 4;
    f32x4 Sacc[4];
#pragma unroll
    for (int i = 0; i < 4; ++i) Sacc[i] = (f32x4){0.f, 0.f, 0.f, 0.f};
    char* const ybase = smem + 4 * X2_BUF;
    const int sgn = d ? -1 : 1;
#define X2_TOK0(NN) (((NN) < CTXL / 64) ? NLAT + b * CTXL + (d ? CTXL - 1 - (NN) * 64 : (NN) * 64) : b * SEQ + (d ? SEQ - 1 - ((NN) * 64 - CTXL) : (NN) * 64 - CTXL))
#define X2_FLUSH(NN) {                                                                                                  \
      const char* yb_ = ybase + ((NN) & 1) * 8192; const int tb_ = X2_TOK0(NN);                                          \
      _Pragma("unroll") for (int it = 0; it < 2; ++it) {                                                                 \
        const int i_ = it * 256 + vt * 64 + lane, r_ = i_ >> 3, pc_ = i_ & 7;                                            \
        const uint4 v_ = *(const uint4*)(yb_ + r_ * 128 + ((pc_ ^ (r_ & 7)) << 4));                                      \
        *(uint4*)(Y + ((long)tb_ + sgn * r_) * 256 + h * 64 + pc_ * 8) = v_; } }
    X2_BAR();
    for (int n = 0; n < NCHUNK; ++n) {
      const char* buf = smem + (n & 3) * X2_BUF;
      char* const ycur = ybase + (n & 1) * 8192;
      if (n > 0) X2_FLUSH(n - 1)
      bf16x8 sB0, sB1;
#pragma unroll
      for (int j = 0; j < 4; ++j) {
        sB0[j] = (short)f2bf(Sacc[0][j]); sB0[4 + j] = (short)f2bf(Sacc[1][j]);
        sB1[j] = (short)f2bf(Sacc[2][j]); sB1[4 + j] = (short)f2bf(Sacc[3][j]);
      }
#pragma unroll
      for (int m = 0; m < 4; ++m) {
        const bf16x8 pa0 = *(const bf16x8*)(buf + ((m * 2 + 0) * 64 + lane) * 16);
        const bf16x8 pa1 = *(const bf16x8*)(buf + ((m * 2 + 1) * 64 + lane) * 16);
        const bf16x8 ra0 = *(const bf16x8*)(buf + 8192 + ((m * 2 + 0) * 64 + lane) * 16);
        const bf16x8 ra1 = *(const bf16x8*)(buf + 8192 + ((m * 2 + 1) * 64 + lane) * 16);
        const bf16x4 qb = *(const bf16x4*)(buf + 16384 + ((m * 4 + vt) * 64 + lane) * 8);
        const bf16x4 yb = *(const bf16x4*)(buf + 24576 + ((vt * 4 + m) * 64 + lane) * 8);
        f32x4 y = {bf2f(yb[0]), bf2f(yb[1]), bf2f(yb[2]), bf2f(yb[3])};
        y = __builtin_amdgcn_mfma_f32_16x16x32_bf16(sB0, ra0, y, 0, 0, 0);
        y = __builtin_amdgcn_mfma_f32_16x16x32_bf16(sB1, ra1, y, 0, 0, 0);
        f32x4 sn = {bf2f(qb[0]), bf2f(qb[1]), bf2f(qb[2]), bf2f(qb[3])};
        sn = __builtin_amdgcn_mfma_f32_16x16x32_bf16(pa0, sB0, sn, 0, 0, 0);
        sn = __builtin_amdgcn_mfma_f32_16x16x32_bf16(pa1, sB1, sn, 0, 0, 0);
        Sacc[m] = sn;
        {
          const int r = m * 16 + fr, pc = vt * 2 + (fq >> 1);
          *(bf16x4*)(ycur + r * 128 + ((pc ^ (r & 7)) << 4) + (fq & 1) * 8) = pack4(y[0], y[1], y[2], y[3]);
        }
      }
      X2_BAR();
    }
    X2_FLUSH(NCHUNK - 1)
#undef X2_FLUSH
#undef X2_TOK0
  }
}

struct NaPair { int mk0, mk1, tau0, tau1, kr0, kr1, ct0, ct1; };
struct NaFrag { bf16x8 k00, k01, k10, k11; bf16x4 v0[4], v1[4]; };

__device__ __forceinline__ void na_load(NaFrag& f, const bfr* KN, const bfr* VT, size_t vt_base, int h, int fr, int fq, const NaPair& pr) {
  const bfr* k0 = KN + (size_t)(pr.mk0 + fr) * 512 + h * 64 + fq * 8;
  const bfr* k1 = KN + (size_t)(pr.mk1 + fr) * 512 + h * 64 + fq * 8;
  f.k00 = *(const bf16x8*)(k0); f.k01 = *(const bf16x8*)(k0 + 32);
  f.k10 = *(const bf16x8*)(k1); f.k11 = *(const bf16x8*)(k1 + 32);
#pragma unroll
  for (int dt = 0; dt < 4; ++dt) {
    const int vo = (dt * 16 + fr) * 16 + fq * 4;
    f.v0[dt] = *(const bf16x4*)(VT + vt_base + (size_t)(pr.tau0 >> 4) * 1024 + vo);
    f.v1[dt] = *(const bf16x4*)(VT + vt_base + (size_t)(pr.tau1 >> 4) * 1024 + vo);
  }
}

__device__ __forceinline__ void na_compute(const NaFrag& f, const bf16x8 qf0, const bf16x8 qf1, bool local, bool vr0, bool vr1,
                                           int dr0, int dr1, int ct0, int ct1, int qc, int fq, const float* bias_h, f32x4 (&O)[4], float& lsum) {
  f32x4 z = {0.f, 0.f, 0.f, 0.f};
  f32x4 st0 = __builtin_amdgcn_mfma_f32_16x16x32_bf16(f.k00, qf0, z, 0, 0, 0);
  st0 = __builtin_amdgcn_mfma_f32_16x16x32_bf16(f.k01, qf1, st0, 0, 0, 0);
  f32x4 st1 = __builtin_amdgcn_mfma_f32_16x16x32_bf16(f.k10, qf0, z, 0, 0, 0);
  st1 = __builtin_amdgcn_mfma_f32_16x16x32_bf16(f.k11, qf1, st1, 0, 0, 0);
  bf16x8 pf;
  if (local) {
    const int cs = min(max(qc - 8, 0), 48);
    const int kb0 = ct0 * 16 + fq * 4, kb1 = ct1 * 16 + fq * 4;
    const float* bp0 = bias_h + min(max(dr0 * 31 + kb0 - qc + 15, -32), 493);
    const float* bp1 = bias_h + min(max(dr1 * 31 + kb1 - qc + 15, -32), 493);
    const float b00 = bp0[0], b01 = bp0[1], b02 = bp0[2], b03 = bp0[3];
    const float b10 = bp1[0], b11 = bp1[1], b12 = bp1[2], b13 = bp1[3];
    const float bb0[4] = {b00, b01, b02, b03}, bb1[4] = {b10, b11, b12, b13};
#pragma unroll
    for (int r = 0; r < 4; ++r) {
      const bool ok0 = vr0 && (unsigned)(kb0 + r - cs) < 16u, ok1 = vr1 && (unsigned)(kb1 + r - cs) < 16u;
      const float e0 = __builtin_amdgcn_exp2f(st0[r] + bb0[r]), e1 = __builtin_amdgcn_exp2f(st1[r] + bb1[r]);
      const float p0 = ok0 ? e0 : 0.f, p1 = ok1 ? e1 : 0.f;
      lsum += p0 + p1;
      pf[r] = (short)f2bf(p0);
      pf[4 + r] = (short)f2bf(p1);
    }
  } else {
#pragma unroll
    for (int r = 0; r < 4; ++r) {
      const float p0 = __builtin_amdgcn_exp2f(st0[r]), p1 = __builtin_amdgcn_exp2f(st1[r]);
      lsum += p0 + p1;
      pf[r] = (short)f2bf(p0);
      pf[4 + r] = (short)f2bf(p1);
    }
  }
#pragma unroll
  for (int dt = 0; dt < 4; ++dt) {
    bf16x8 vf;
    vf[0] = f.v0[dt][0]; vf[1] = f.v0[dt][1]; vf[2] = f.v0[dt][2]; vf[3] = f.v0[dt][3];
    vf[4] = f.v1[dt][0]; vf[5] = f.v1[dt][1]; vf[6] = f.v1[dt][2]; vf[7] = f.v1[dt][3];
    O[dt] = __builtin_amdgcn_mfma_f32_16x16x32_bf16(vf, pf, O[dt], 0, 0, 0);
  }
}

__device__ __forceinline__ void na_block_task(PP pp, int task, const float* bias_lds) {
  const int tid = tid_opaque(), lane = tid & 63, wv = wave_id(tid);
  const int fr = lane & 15, fq = lane >> 4;
  char* S = p.ws + OFF_S;
  const bfr* QN = (const bfr*)(S + S_QN);
  const bfr* KN = (const bfr*)(S + S_KN);
  const bfr* VT = (const bfr*)(S + S_VT);
  bfr* CC = (bfr*)(p.ws + OFF_CC);
  const bool latent = task < 1024;
  int b, h, mqa, mqb, qra = 0, qrb = 0, cgp = 0;
  if (latent) {
    h = task & 7; const int quad = (task >> 3) & 63; b = task >> 9;
    qra = quad * 4 + (wv >> 2) * 2; qrb = qra + 1; cgp = wv & 3;
    mqa = b * SEQ + qra * 64 + cgp * 16; mqb = mqa + 64;
  } else {
    const int u = task - 1024;
    h = u & 7; b = u >> 3;
    mqa = NLAT + b * CTXL + (wv * 2) * 16; mqb = mqa + 16;
  }
  const bf16x8 qa0 = *(const bf16x8*)(QN + (size_t)(mqa + fr) * 512 + h * 64 + fq * 8);
  const bf16x8 qa1 = *(const bf16x8*)(QN + (size_t)(mqa + fr) * 512 + h * 64 + 32 + fq * 8);
  const bf16x8 qb0 = *(const bf16x8*)(QN + (size_t)(mqb + fr) * 512 + h * 64 + fq * 8);
  const bf16x8 qb1 = *(const bf16x8*)(QN + (size_t)(mqb + fr) * 512 + h * 64 + 32 + fq * 8);
  f32x4 Oa[4], Ob[4];
#pragma unroll
  for (int dt = 0; dt < 4; ++dt) { Oa[dt] = (f32x4){0.f, 0.f, 0.f, 0.f}; Ob[dt] = Oa[dt]; }
  float lsa = 0.f, lsb = 0.f;
  const size_t vt_base = (size_t)(b * 8 + h) * 64 * TTOK;
  const int rsa = min(max(qra - 4, 0), SEQ / 64 - 8), rsb = min(max(qrb - 4, 0), SEQ / 64 - 8);
  const int nrows = latent ? (rsb - rsa + 8) : 0;
  const int ct_first = (cgp <= 1) ? 0 : cgp - 1;
  const int nct = (cgp == 0 || cgp == 3) ? 2 : 3;
  const int ntile = nrows * nct;
  const int nlp = (ntile + 1) >> 1;
  const int npair = nlp + 8;
  const int qc = cgp * 16 + fr;
  auto mkpair = [&](int pi) {
    NaPair pr;
    if (pi < nlp) {
      const int i0 = 2 * pi, i1 = min(2 * pi + 1, ntile - 1);
      const int q0 = (nct == 2) ? (i0 >> 1) : ((i0 * 21846) >> 16), q1 = (nct == 2) ? (i1 >> 1) : ((i1 * 21846) >> 16);
      pr.kr0 = rsa + q0; pr.ct0 = ct_first + i0 - q0 * nct;
      pr.kr1 = rsa + q1; pr.ct1 = ct_first + i1 - q1 * nct;
      if (2 * pi + 1 >= ntile) pr.kr1 = -100;
      const int r1 = rsa + q1;
      pr.tau0 = pr.kr0 * 64 + pr.ct0 * 16; pr.tau1 = r1 * 64 + pr.ct1 * 16;
      pr.mk0 = b * SEQ + pr.tau0; pr.mk1 = b * SEQ + pr.tau1;
    } else {
      const int c = pi - nlp;
      pr.kr0 = pr.kr1 = pr.ct0 = pr.ct1 = 0;
      pr.tau0 = SEQ + c * 32; pr.tau1 = SEQ + c * 32 + 16;
      pr.mk0 = NLAT + b * CTXL + c * 32; pr.mk1 = pr.mk0 + 16;
    }
    return pr;
  };
  NaFrag fa, fb;
  NaPair pa = mkpair(0), pb;
  na_load(fa, KN, VT, vt_base, h, fr, fq, pa);
  const float* bias_h = bias_lds + h * 465;
#define NA_DO(F, PR, PI)                                                                                          \
  {                                                                                                               \
    const bool loc_ = (PI) < nlp;                                                                                 \
    na_compute(F, qa0, qa1, loc_, (unsigned)(PR.kr0 - rsa) < 8u, (unsigned)(PR.kr1 - rsa) < 8u,                   \
               PR.kr0 - qra + 7, PR.kr1 - qra + 7, PR.ct0, PR.ct1, qc, fq, bias_h, Oa, lsa);                      \
    na_compute(F, qb0, qb1, loc_, (unsigned)(PR.kr0 - rsb) < 8u, (unsigned)(PR.kr1 - rsb) < 8u,                   \
               PR.kr0 - qrb + 7, PR.kr1 - qrb + 7, PR.ct0, PR.ct1, qc, fq, bias_h, Ob, lsb);                      \
  }
  for (int pi = 0; pi < npair; pi += 2) {
    pb = mkpair(min(pi + 1, npair - 1)); na_load(fb, KN, VT, vt_base, h, fr, fq, pb);
    NA_DO(fa, pa, pi)
    pa = mkpair(min(pi + 2, npair - 1)); na_load(fa, KN, VT, vt_base, h, fr, fq, pa);
    if (pi + 1 < npair) NA_DO(fb, pb, pi + 1)
  }
#undef NA_DO
  lsa += shfl_xor_l(lsa, 16, lane); lsa += shfl_xor_l(lsa, 32, lane);
  lsb += shfl_xor_l(lsb, 16, lane); lsb += shfl_xor_l(lsb, 32, lane);
  const float ia = 1.f / lsa, ib = 1.f / lsb;
#pragma unroll
  for (int dt = 0; dt < 4; ++dt) {
    *(bf16x4*)(CC + (size_t)(mqa + fr) * 1024 + h * 64 + dt * 16 + fq * 4) = pack4(Oa[dt][0] * ia, Oa[dt][1] * ia, Oa[dt][2] * ia, Oa[dt][3] * ia);
    *(bf16x4*)(CC + (size_t)(mqb + fr) * 1024 + h * 64 + dt * 16 + fq * 4) = pack4(Ob[dt][0] * ib, Ob[dt][1] * ib, Ob[dt][2] * ib, Ob[dt][3] * ib);
  }
}

__device__ __forceinline__ void phase_mix(PP pp, int l, int bid, int nb, char* smem) {
  const int tid = tid_opaque();
  const int nscan_blocks = (nb > 32) ? 32 : nb;
  const int first_attn_block = (nb > 32) ? 32 : 0;
  if (bid < nscan_blocks) {
    for (int c = bid; c < NCHAIN; c += nscan_blocks) chunk_seq_chain(pp, c, smem);
  }
  if (bid >= first_attn_block) {
    float* bias = (float*)smem + 64;
    __syncthreads();
    for (int i = tid; i < 8 * 465 + 128; i += NTHR) { const int j = i - 64; bias[j] = ((unsigned)j < 8u * 465u) ? p.na_rpb[(size_t)l * 8 * 465 + j] * 1.4426950408889634f : 0.f; }
    __syncthreads();
    const int ntask = (l == 0) ? 1024 + 16 : 1024;
    const int nab = nb - first_attn_block;
    for (int t = bid - first_attn_block; t < ntask; t += nab) na_block_task(pp, t, bias);
    __syncthreads();
    phase_convert(pp, l, 1, bid - first_attn_block, nab, smem);
    if (l == 0) phase_convert(pp, 1, 0, bid - first_attn_block, nab, smem);
  }
}

__device__ __forceinline__ void phase_post(PP pp, int l, int bid, int nb) {
  const int tid = tid_opaque(), lane = tid & 63, wv = wave_id(tid);
  char* S = p.ws + OFF_S;
  const bfr* YRW = (const bfr*)(S + S_YRW);
  const bfr* YGD = (const bfr*)(S + S_YGD);
  const bfr* RWV = (const bfr*)(S + S_RWV);
  const bfr* RWG = (const bfr*)(S + S_RWG);
  const float* BON = (const float*)(S + S_BON);
  const bfr* P = (const bfr*)(p.ws + OFF_P);
  bfr* CC = (bfr*)(p.ws + OFF_CC);
  const float* ln_w = p.rw_ln_w + (size_t)l * 256;
  const float* ln_b = p.rw_ln_b + (size_t)l * 256;
  const float* ng = p.gd_norm_g + (size_t)l * 64;
  const int ntok = (l == 0) ? NTOK : NLAT;
  const int cb = lane * 4, hh = lane >> 4;
  const f32x4 lw4 = *(const f32x4*)(ln_w + cb), lb4 = *(const f32x4*)(ln_b + cb), ng4 = *(const f32x4*)(ng + (cb & 63));
  for (int m = bid * 8 + wv; m < ntok; m += nb * 8) {
    const size_t o = (size_t)m * 256 + cb;
    const f32x4 y0 = ldbf4(YRW + o), y1 = ldbf4(YRW + (size_t)NTOK * 256 + o);
    const f32x4 rv = ldbf4(RWV + o), rg = ldbf4(RWG + o);
    const f32x4 g0 = ldbf4(YGD + o), g1 = ldbf4(YGD + (size_t)NTOK * 256 + o);
    const f32x4 z = ldbf4(P + (size_t)m * PINP + B_END + 768 + cb);
    const float bon = BON[(size_t)m * 4 + hh];
    {
      const f32x4 y = y0 + y1;
      const float mean = row16_sum((y[0] + y[1]) + (y[2] + y[3])) * (1.f / 64.f);
      const f32x4 dv = y - mean;
      const float var = row16_sum((dv[0] * dv[0] + dv[1] * dv[1]) + (dv[2] * dv[2] + dv[3] * dv[3])) * (1.f / 64.f);
      const f32x4 out = ((dv * rsqrtf(var + 64e-5f)) * lw4 + lb4 + rv * bon) * rg;
      *(bf16x4*)(CC + (size_t)m * 1024 + 512 + cb) = pack4(out[0], out[1], out[2], out[3]);
    }
    {
      const f32x4 y = g0 + g1;
      const float ms = row16_sum((y[0] * y[0] + y[1] * y[1]) + (y[2] * y[2] + y[3] * y[3])) * (1.f / 64.f);
      const f32x4 sz = {siluf_(z[0]), siluf_(z[1]), siluf_(z[2]), siluf_(z[3])};
      const f32x4 out = (y * rsqrtf(ms + 1e-6f)) * ng4 * sz;
      *(bf16x4*)(CC + (size_t)m * 1024 + 768 + cb) = pack4(out[0], out[1], out[2], out[3]);
    }
  }
}

#define RW_LDS_ROW 36
__device__ __forceinline__ void phase_router(PP pp, int l, int bid, int nb, char* smem) {
  const int tid = tid_opaque(), lane = tid & 63, wv = wave_id(tid);
  const float* xl = p.out;
  const float* xc = (const float*)(p.ws + OFF_CTX);
  const float* mods = (const float*)(p.ws + OFF_MODS) + (size_t)l * 3 * 6144;
  const float* g = p.norm_ffn_g + (size_t)l * 1024;
  const float* rw = p.moe_router_w + (size_t)l * 1024 * 32;
  const float* rb = p.moe_router_b + (size_t)l * 32;
  bfr* H = (bfr*)(p.ws + OFF_H);
  int* cnt = (int*)(p.ws + OFF_CNT);
  int* TOKE = (int*)(p.ws + OFF_TOKE);
  int* TOKP = (int*)(p.ws + OFF_TOKP);
  float* TOKG = (float*)(p.ws + OFF_TOKG);
  float* wl = (float*)smem;
  for (int i = tid; i < 1024 * 8; i += NTHR) {
    int d = i >> 3, q = i & 7;
    *(float4*)(wl + d * RW_LDS_ROW + q * 4) = *(const float4*)(rw + (size_t)d * 32 + q * 4);
  }
  __syncthreads();
  const int ntok = (l == 0) ? NTOK : NLAT;
  const float rbl = rb[lane & 31];
  int* lcnt = (int*)(smem + 147456 + 512);
  if (tid < 32) lcnt[tid] = 0;
  char* stg = smem + 147456 + 3072 + wv * 1024;
  __syncthreads();
  float gch[16];
#pragma unroll
  for (int i = 0; i < 16; ++i) gch[i] = g[lane + 64 * i];
  const int mstride = nb * 16;
  int m0 = (bid * 8 + wv) * 2;
  float xa[16], xb[16];
  {
    const int mc = min(m0, ntok - 2);
    const float* pa = (mc < NLAT) ? xl + (size_t)mc * 1024 : xc + (size_t)(mc - NLAT) * 1024;
    const float* pb = (mc + 1 < NLAT) ? xl + (size_t)(mc + 1) * 1024 : xc + (size_t)(mc + 1 - NLAT) * 1024;
#pragma unroll
    for (int i = 0; i < 16; ++i) { xa[i] = pa[lane + 64 * i]; xb[i] = pb[lane + 64 * i]; }
  }
  for (; m0 < ntok; m0 += mstride) {
    float acc0[32], acc1[32];
#pragma unroll
    for (int e = 0; e < 32; ++e) { acc0[e] = 0.f; acc1[e] = 0.f; }
    float hv0[16], hv1[16];
    {
      const int ma = m0, mb = m0 + 1;
      const float* mda = mods + (size_t)mod_row(ma) * 6144 + 3072;
      float scv[16], shv[16];
#pragma unroll
      for (int i = 0; i < 16; ++i) { scv[i] = mda[1024 + lane + 64 * i]; shv[i] = mda[lane + 64 * i]; }
#pragma unroll
      for (int i = 0; i < 16; ++i) { hv0[i] = xa[i]; hv1[i] = xb[i]; }
      asm volatile("" ::: "memory");
      {
        const int mc = min(m0 + mstride, ntok - 2);
        const float* pa = (mc < NLAT) ? xl + (size_t)mc * 1024 : xc + (size_t)(mc - NLAT) * 1024;
        const float* pb = (mc + 1 < NLAT) ? xl + (size_t)(mc + 1) * 1024 : xc + (size_t)(mc + 1 - NLAT) * 1024;
#pragma unroll
        for (int i = 0; i < 16; ++i) { xa[i] = pa[lane + 64 * i]; xb[i] = pb[lane + 64 * i]; }
      }
      asm volatile("" ::: "memory");
      float ssa = 0.f, ssb = 0.f;
#pragma unroll
      for (int i = 0; i < 16; ++i) { ssa += hv0[i] * hv0[i]; ssb += hv1[i] * hv1[i]; }
      ssa = wave_sum(ssa); ssb = wave_sum(ssb);
      const float rsa = rsqrtf(ssa * (1.f / 1024.f) + 1e-6f), rsb = rsqrtf(ssb * (1.f / 1024.f) + 1e-6f);
#pragma unroll
      for (int i = 0; i < 16; ++i) {
        const float gm = gch[i] * (1.f + scv[i]);
        hv0[i] = hv0[i] * rsa * gm + shv[i];
        hv1[i] = hv1[i] * rsb * gm + shv[i];
      }
      float am0 = 0.f, am1 = 0.f;
#pragma unroll
      for (int i = 0; i < 16; ++i) { am0 = fmaxf(am0, fabsf(hv0[i])); am1 = fmaxf(am1, fabsf(hv1[i])); }
      am0 = wave_max(am0); am1 = wave_max(am1);
      const float sc0 = am0 > 0.f ? am0 * (1.f / 127.f) : 1.f, sc1 = am1 > 0.f ? am1 * (1.f / 127.f) : 1.f;
      const float iv0 = 1.f / sc0, iv1 = 1.f / sc1;
      signed char* H8 = (signed char*)(p.ws + OFF_H);
#pragma unroll
      for (int i = 0; i < 16; ++i) stg[lane + 64 * i] = (signed char)(int)fminf(fmaxf(rintf(hv0[i] * iv0), -127.f), 127.f);
      const uint4 rowa = *(const uint4*)(stg + lane * 16);
      *(uint4*)(H8 + (size_t)ma * 1024 + lane * 16) = rowa;
#pragma unroll
      for (int i = 0; i < 16; ++i) stg[lane + 64 * i] = (signed char)(int)fminf(fmaxf(rintf(hv1[i] * iv1), -127.f), 127.f);
      const uint4 rowb = *(const uint4*)(stg + lane * 16);
      *(uint4*)(H8 + (size_t)mb * 1024 + lane * 16) = rowb;
      if (lane == 0) { float* SCL = (float*)(p.ws + OFF_SCL); SCL[ma] = sc0; SCL[mb] = sc1; }
      asm volatile("" ::: "memory");
    }
#pragma unroll
    for (int i = 0; i < 16; ++i) {
      if ((i & 3) == 0) asm volatile("" ::: "memory");
      const float* wr = wl + (lane + 64 * i) * RW_LDS_ROW;
#pragma unroll
      for (int q = 0; q < 8; ++q) {
        const float4 w = *(const float4*)(wr + q * 4);
        acc0[q * 4 + 0] += hv0[i] * w.x; acc0[q * 4 + 1] += hv0[i] * w.y; acc0[q * 4 + 2] += hv0[i] * w.z; acc0[q * 4 + 3] += hv0[i] * w.w;
        acc1[q * 4 + 0] += hv1[i] * w.x; acc1[q * 4 + 1] += hv1[i] * w.y; acc1[q * 4 + 2] += hv1[i] * w.z; acc1[q * 4 + 3] += hv1[i] * w.w;
      }
    }
#define BFLY(A, N, D)                                                                           \
    _Pragma("unroll") for (int i = 0; i < (N); ++i) {                                            \
      const bool up = (lane & (D)) != 0;                                                         \
      const float keep = up ? A[i + (N)] : A[i];                                                 \
      const float send = up ? A[i] : A[i + (N)];                                                 \
      A[i] = keep + shfl_xor_l(send, (D), lane);                                                   \
    }
    BFLY(acc0, 16, 16) BFLY(acc1, 16, 16)
    BFLY(acc0, 8, 8) BFLY(acc1, 8, 8)
    BFLY(acc0, 4, 4) BFLY(acc1, 4, 4)
    BFLY(acc0, 2, 2) BFLY(acc1, 2, 2)
    BFLY(acc0, 1, 1) BFLY(acc1, 1, 1)
#undef BFLY
    float la = acc0[0] + shfl_xor_l(acc0[0], 32, lane);
    float lb = acc1[0] + shfl_xor_l(acc1[0], 32, lane);
    const int my_e = lane & 31;
    la += rbl; lb += rbl;
    (void)my_e;
#pragma unroll
    for (int tkn = 0; tkn < 2; ++tkn) {
      float v = tkn == 0 ? la : lb;
      float tv[4]; int ti[4];
#pragma unroll
      for (int k = 0; k < 4; ++k) {
        float bv = v; int bi = lane & 31;
#pragma unroll
        for (int o = 16; o >= 1; o >>= 1) {
          float ov = shfl_xor_l(bv, o, lane); int oi = shfl_xor_li(bi, o, lane);
          bool take = (ov > bv) || (ov == bv && oi < bi);
          bv = take ? ov : bv; bi = take ? oi : bi;
        }
        tv[k] = bv; ti[k] = bi;
        if ((lane & 31) == bi) v = -3.0e38f;
      }
      float e1 = __expf(tv[1] - tv[0]), e2 = __expf(tv[2] - tv[0]), e3 = __expf(tv[3] - tv[0]);
      float inv = 1.f / (1.f + e1 + e2 + e3);
      const int m = m0 + tkn;
      if (lane < 4) {
        int e = lane == 0 ? ti[0] : lane == 1 ? ti[1] : lane == 2 ? ti[2] : ti[3];
        float gt = (lane == 0 ? 1.f : lane == 1 ? e1 : lane == 2 ? e2 : e3) * inv;
        int pos = atomicAdd(&lcnt[e], 1);
        TOKE[(size_t)m * 4 + lane] = e; TOKP[(size_t)m * 4 + lane] = pos; TOKG[(size_t)m * 4 + lane] = gt;
      }
    }
  }
  __syncthreads();
  if (tid < 32) ((int*)(p.ws + OFF_BASE))[bid * 32 + tid] = atomicAdd(&cnt[tid], lcnt[tid]);
  __syncthreads();
}

__device__ __forceinline__ void moe_offsets(PP pp, int* toff) {
  const int* cnt = (const int*)(p.ws + OFF_CNT);
  if (tid_opaque() == 0) {
    int a = 0;
    for (int e = 0; e < 32; ++e) { const int c = cnt[e]; toff[e] = a; toff[96 + e] = c; a += (c + 255) >> 8; }
    toff[32] = a;
  }
  __syncthreads();
}
__device__ __forceinline__ void moe_tile_experts(int* toff) {
  int* texp = toff + 128;
  const int ntile = toff[32];
  for (int mt = tid_opaque(); mt < ntile; mt += NTHR) {
    int e = 0;
#pragma unroll 1
    for (int k = 1; k < 32; ++k) e = (mt >= toff[k]) ? k : e;
    texp[mt] = e;
  }
  __syncthreads();
}

__device__ __forceinline__ void phase_slotfill(PP pp, int l, int bid, int nb, char* smem) {
  int* toff = (int*)smem;
  moe_offsets(pp, toff);
  const int tid = tid_opaque(), lane = tid & 63, wv = wave_id(tid);
  const int* TOKE = (const int*)(p.ws + OFF_TOKE);
  const int* TOKP = (const int*)(p.ws + OFF_TOKP);
  const float* TOKG = (const float*)(p.ws + OFF_TOKG);
  const int* cnt = (const int*)(p.ws + OFF_CNT);
  int* TOKS = (int*)(p.ws + OFF_TOKS);
  float* SLG = (float*)(p.ws + OFF_SLG);
  float* SLS = (float*)(p.ws + OFF_SLS);
  const float* SCL = (const float*)(p.ws + OFF_SCL);
  const signed char* H8 = (const signed char*)(p.ws + OFF_H);
  signed char* XG = (signed char*)(p.ws + OFF_S);
  const int n = ((l == 0) ? NTOK : NLAT) * 4;
  int* SLT = (int*)(p.ws + OFF_SLT);
  for (int i = bid * NTHR + tid; i < n; i += nb * NTHR) {
    const int e = TOKE[i];
    const int blk = (((i >> 2) >> 1) % (nb * 8)) >> 3;
    const int slot = toff[e] * 256 + ((const int*)(p.ws + OFF_BASE))[blk * 32 + e] + TOKP[i];
    TOKS[i] = slot; SLT[slot] = i >> 2; SLG[slot] = TOKG[i]; SLS[slot] = SCL[i >> 2];
  }
  for (int gi = bid * NTHR + tid; gi < 32 * 256; gi += nb * NTHR) {
    const int e = gi >> 8, r = gi & 255;
    const int c = toff[96 + e];
    const int npad = ((c + 255) & ~255) - c;
    if (r < npad) { const int base = toff[e] * 256 + c; SLT[base + r] = 0; SLS[base + r] = 0.f; }
  }
  __syncthreads();
}

struct EpiMoe1 {
  const float* bgu; const float* sw; const float* SLS; bfr* ACT;
  __device__ __forceinline__ void operator()(const i32x4 (&acc)[2][2][4][2], const g8::GUnit& u, int wr, int wc, int fr, int fq) const {
    const float* be = bgu + (size_t)u.e * 2048;
    const float* se = sw + (size_t)u.e * 2048;
    const int slot0 = u.pm * 256 + wr * 64 + fr;
    float sav[2][4];
#pragma unroll
    for (int ai = 0; ai < 2; ++ai)
#pragma unroll
      for (int m = 0; m < 4; ++m) sav[ai][m] = SLS[slot0 + ai * 128 + m * 16];
    const int j0 = u.pn * 128 + wc * 32 + fq * 8;
    f32x4 bgv[2], blv[2], sgv[2], slv[2];
#pragma unroll
    for (int bj = 0; bj < 2; ++bj) {
      bgv[bj] = *(const f32x4*)(be + j0 + bj * 4); blv[bj] = *(const f32x4*)(be + 1024 + j0 + bj * 4);
      sgv[bj] = *(const f32x4*)(se + j0 + bj * 4); slv[bj] = *(const f32x4*)(se + 1024 + j0 + bj * 4);
    }
#pragma unroll
    for (int ai = 0; ai < 2; ++ai)
#pragma unroll
      for (int m = 0; m < 4; ++m) {
        const int slot = slot0 + ai * 128 + m * 16;
        const float sa = sav[ai][m];
        f32x4 ov[2];
#pragma unroll
        for (int bj = 0; bj < 2; ++bj) {
          const f32x4 bg = bgv[bj], bl = blv[bj];
          const f32x4 sg = sgv[bj], sl = slv[bj];
#pragma unroll
          for (int q = 0; q < 4; ++q) {
            const float g = (float)acc[ai][bj][m][0][q] * (sa * sg[q]) + bg[q];
            const float li = (float)acc[ai][bj][m][1][q] * (sa * sl[q]) + bl[q];
            const float gv = fminf(g, 7.f);
            const float lv = fminf(fmaxf(li, -7.f), 7.f);
            ov[bj][q] = gv * sigmoidf_(1.702f * gv) * (lv + 1.f);
          }
        }
        *(bf16x8*)(ACT + (size_t)slot * 1024 + j0) = pack8(ov[0], ov[1]);
      }
  }
};
__device__ __forceinline__ void phase_moe1_impl(PP pp, int l, int bid, int nb, char* smem, int* toff) {
  moe_offsets(pp, toff);
  moe_tile_experts(toff);
  g8::MoeSched S{toff, 8, 2048, nb, bid};
  EpiMoe1 E{p.moe_b_gu + (size_t)l * 32 * 2048, (const float*)(p.ws + OFF_SW) + (size_t)l * 32 * 2048, (const float*)(p.ws + OFF_SLS), (bfr*)(p.ws + OFF_P)};
  g8::gemm_stream<true, true>((LAS unsigned char*)smem, p.ws + OFF_H, p.ws + OFF_W + (size_t)l * WL_SIZE + WL_GU, S, E, (const int*)(p.ws + OFF_SLT));
}

struct EpiMoe2 {
  const float* bdn; const float* SLG; bfr* YS;
  __device__ __forceinline__ void operator()(const f32x4 (&acc)[2][2][4][2], const g8::GUnit& u, int wr, int wc, int fr, int fq) const {
    const float* be = bdn + (size_t)u.e * 1024;
    const int slot0 = u.pm * 256 + wr * 64 + fr, col0 = u.pn * 256 + wc * 32 + 8 * fq;
    float gtv[2][4];
#pragma unroll
    for (int ai = 0; ai < 2; ++ai)
#pragma unroll
      for (int m = 0; m < 4; ++m) gtv[ai][m] = SLG[slot0 + ai * 128 + m * 16];
    f32x4 bvv[2][2];
#pragma unroll
    for (int bj = 0; bj < 2; ++bj)
#pragma unroll
      for (int n = 0; n < 2; ++n) bvv[bj][n] = *(const f32x4*)(be + col0 + bj * 128 + n * 4);
#pragma unroll
    for (int ai = 0; ai < 2; ++ai)
#pragma unroll
      for (int m = 0; m < 4; ++m) {
        const int slot = slot0 + ai * 128 + m * 16;
        const float gt = gtv[ai][m];
#pragma unroll
        for (int bj = 0; bj < 2; ++bj) {
          const f32x4 y0 = (acc[ai][bj][m][0] + bvv[bj][0]) * gt;
          const f32x4 y1 = (acc[ai][bj][m][1] + bvv[bj][1]) * gt;
          *(bf16x8*)(YS + (size_t)slot * 1024 + col0 + bj * 128) = pack8(y0, y1);
        }
      }
  }
};
__device__ __forceinline__ void phase_moe2_impl(PP pp, int l, int bid, int nb, char* smem, int* toff) {
  moe_offsets(pp, toff);
  moe_tile_experts(toff);
  g8::MoeSched S{toff, 4, 1024, nb, bid};
  EpiMoe2 E{p.moe_b_down + (size_t)l * 32 * 1024, (const float*)(p.ws + OFF_SLG), (bfr*)(p.ws + OFF_S)};
  g8::gemm_stream<false, false>((LAS unsigned char*)smem, p.ws + OFF_P, p.ws + OFF_W + (size_t)l * WL_SIZE + WL_DN, S, E);
}

__device__ __forceinline__ void phase_combine(PP pp, int l, int bid, int nb) {
  const int tid = tid_opaque(), lane = tid & 63, wv = wave_id(tid);
  const bfr* YS = (const bfr*)(p.ws + OFF_S);
  const int* TOKS = (const int*)(p.ws + OFF_TOKS);
  const float* mods = (const float*)(p.ws + OFF_MODS) + (size_t)l * 3 * 6144;
  const float* mods1 = (const float*)(p.ws + OFF_MODS) + (size_t)3 * 6144;
  const float* g1n = p.norm_mix_g + 1024;
  bfr* H = (bfr*)(p.ws + OFF_H);
  float* xl = p.out;
  float* xc = (float*)(p.ws + OFF_CTX);
  const int ntok = (l == 0) ? NTOK : NLAT;
  if (l == 0) {
    int* cnt = (int*)(p.ws + OFF_CNT);
    const int gt = bid * NTHR + tid;
    if (gt < 32) cnt[gt] = 0;
  }
  for (int m = bid * 8 + wv; m < ntok; m += nb * 8) {
    float* xr = (m < NLAT) ? xl + (size_t)m * 1024 : xc + (size_t)(m - NLAT) * 1024;
    const float* g2 = mods + (size_t)mod_row(m) * 6144 + 5120;
    const int s0 = TOKS[(size_t)m * 4], s1 = TOKS[(size_t)m * 4 + 1], s2 = TOKS[(size_t)m * 4 + 2], s3 = TOKS[(size_t)m * 4 + 3];
    float4 xn[4];
    float ss = 0.f;
#pragma unroll
    for (int i = 0; i < 4; ++i) {
      const int d = (lane + 64 * i) * 4;
      const bf16x4 a = *(const bf16x4*)(YS + (size_t)s0 * 1024 + d);
      const bf16x4 b = *(const bf16x4*)(YS + (size_t)s1 * 1024 + d);
      const bf16x4 c = *(const bf16x4*)(YS + (size_t)s2 * 1024 + d);
      const bf16x4 e = *(const bf16x4*)(YS + (size_t)s3 * 1024 + d);
      const float4 gg = *(const float4*)(g2 + d);
      float4 xv = *(const float4*)(xr + d);
      xv.x += gg.x * ((bf2f(a[0]) + bf2f(b[0])) + (bf2f(c[0]) + bf2f(e[0])));
      xv.y += gg.y * ((bf2f(a[1]) + bf2f(b[1])) + (bf2f(c[1]) + bf2f(e[1])));
      xv.z += gg.z * ((bf2f(a[2]) + bf2f(b[2])) + (bf2f(c[2]) + bf2f(e[2])));
      xv.w += gg.w * ((bf2f(a[3]) + bf2f(b[3])) + (bf2f(c[3]) + bf2f(e[3])));
      *(float4*)(xr + d) = xv;
      xn[i] = xv;
      ss += xv.x * xv.x + xv.y * xv.y + xv.z * xv.z + xv.w * xv.w;
    }
    if (l == 0) {
      ss = wave_sum(ss);
      const float rs = rsqrtf(ss * (1.f / 1024.f) + 1e-6f);
      const float* md = mods1 + (size_t)mod_row(m) * 6144;
      float4 hq[4];
#pragma unroll
      for (int i = 0; i < 4; ++i) {
        const int d = (lane + 64 * i) * 4;
        const float4 gg = *(const float4*)(g1n + d);
        const float4 sh = *(const float4*)(md + d);
        const float4 sc = *(const float4*)(md + 1024 + d);
        hq[i] = make_float4(xn[i].x * rs * gg.x * (1.f + sc.x) + sh.x, xn[i].y * rs * gg.y * (1.f + sc.y) + sh.y,
                            xn[i].z * rs * gg.z * (1.f + sc.z) + sh.z, xn[i].w * rs * gg.w * (1.f + sc.w) + sh.w);
      }
      const float qs = quant_row_store(hq, (signed char*)(p.ws + OFF_H) + (size_t)m * 1024, lane);
      if (lane == 0) ((float*)(p.ws + OFF_SCL))[m] = qs;
    }
  }
}

#define XB_TMO      128
#define XB_XCNT(j)  (256  + 64 * (j))
#define XB_XSUB(j)  (1280 + 64 * (j))
#define XB_XGEN(j)  (2304 + 64 * (j))
#define XB_TOP      3328
#define XB_TOPGEN   3392
#define XCD_BAR_WORDS 3456
#define XB_SPIN_CAP (1u << 22)
__device__ __forceinline__ unsigned xb_ld(unsigned* q) { return __hip_atomic_load(q, __ATOMIC_RELAXED, __HIP_MEMORY_SCOPE_AGENT); }
__device__ __forceinline__ unsigned xb_add(unsigned* q, unsigned v) { return __hip_atomic_fetch_add(q, v, __ATOMIC_RELAXED, __HIP_MEMORY_SCOPE_AGENT); }
__device__ __forceinline__ unsigned xb_xcc_id() { return (unsigned)__builtin_amdgcn_s_getreg((3 << 11) | 20) & 0xFu; }
#define XB_SPIN(cond, bar) do { unsigned _sp = 0; while (cond) { __builtin_amdgcn_s_sleep(1); \
    if ((++_sp & 255u) == 0u) { if (xb_ld(&(bar)[XB_TMO])) break; if (_sp > XB_SPIN_CAP) { atomicAdd(&(bar)[XB_TMO], 1u); break; } } } } while (0)
struct XcdBarrier { unsigned* bar; unsigned x; volatile LAS unsigned* st; };
__device__ __forceinline__ XcdBarrier xcd_barrier_post(unsigned* bar, volatile LAS unsigned* st) {
  XcdBarrier b; b.bar = bar; b.x = xb_xcc_id(); b.st = st;
  if (tid_opaque() == 0) (void)xb_add(&bar[XB_XCNT(b.x)], 1u);
  return b;
}
__device__ __forceinline__ void xcd_barrier_complete(unsigned* bar, unsigned x, unsigned& nloc, unsigned& nx) {
  const unsigned G = gridDim.x;
  unsigned sum, cnt, mine, sp = 0u;
  for (;;) {
    sum = 0u; cnt = 0u; mine = 0u;
#pragma unroll
    for (unsigned j = 0; j < 16; ++j) { const unsigned c = xb_ld(&bar[XB_XCNT(j)]); sum += c; cnt += (c > 0u) ? 1u : 0u; mine = (j == x) ? c : mine; }
    if (sum == G) break;
    __builtin_amdgcn_s_sleep(1);
    if ((++sp & 255u) == 0u) { if (xb_ld(&bar[XB_TMO])) break; if (sp > XB_SPIN_CAP) { atomicAdd(&bar[XB_TMO], 1u); break; } }
  }
  nloc = mine > 0u ? mine : 1u; nx = cnt > 0u ? cnt : 1u;
}
__device__ __forceinline__ void xcd_barrier(const XcdBarrier& b) {
  asm volatile("s_waitcnt vmcnt(0)" ::: "memory");
  __syncthreads();
  if (tid_opaque() == 0) {
    unsigned* bar = b.bar;
    __builtin_amdgcn_s_waitcnt(0);
    unsigned nloc = b.st[0], nx = b.st[1];
    if (nloc == 0u) { xcd_barrier_complete(bar, b.x, nloc, nx); b.st[0] = nloc; b.st[1] = nx; }
    const unsigned old = xb_add(&bar[XB_XSUB(b.x)], 1u);
    const unsigned gen = old / nloc;
    if (old + 1u == (gen + 1u) * nloc) {
      __builtin_amdgcn_fence(__ATOMIC_RELEASE, "agent");
      asm volatile("s_waitcnt vmcnt(0)" ::: "memory");
      const unsigned og = xb_add(&bar[XB_TOP], 1u);
      const unsigned tg = og / nx;
      if (og + 1u == (tg + 1u) * nx) xb_add(&bar[XB_TOPGEN], 1u);
      else XB_SPIN(xb_ld(&bar[XB_TOPGEN]) == tg, bar);
      __builtin_amdgcn_fence(__ATOMIC_ACQUIRE, "agent");
      xb_add(&bar[XB_XGEN(b.x)], 1u);
      asm volatile("s_waitcnt vmcnt(0)" ::: "memory");
    } else {
      XB_SPIN(xb_ld(&bar[XB_XGEN(b.x)]) == gen, bar);
      __builtin_amdgcn_fence(__ATOMIC_ACQUIRE, "agent");
      asm volatile("s_waitcnt vmcnt(0)" ::: "memory");
    }
  }
  __syncthreads();
}

extern __shared__ __attribute__((aligned(16))) char dyn_smem[];

__global__ void __launch_bounds__(NTHR) mega(Params p_unused) {
  cg::grid_group grid = cg::this_grid();
  const int bid0 = blockIdx.x, nb0 = gridDim.x;
#if defined(__HIP_DEVICE_COMPILE__)
  PP pp0 = (PP)__builtin_amdgcn_kernarg_segment_ptr();
#else
  PP pp0 = nullptr;
#endif
#define pp ({ PP q_ = pp0; asm volatile("" : "+s"(q_)); q_; })
#define bid opq(bid0)
#define nb opq(nb0)
  int* toff_s = (int*)(dyn_smem + 147456);
  volatile LAS unsigned* xb_st = (volatile LAS unsigned*)(dyn_smem + 147456 + 256);
  {
    unsigned* barw = (unsigned*)(fresh_ws(pp0) + OFF_BAR);
    if (blockIdx.x == 0) for (int i = threadIdx.x; i < XCD_BAR_WORDS; i += NTHR) barw[i] = 0u;
    if (threadIdx.x == 0) { xb_st[0] = 0u; xb_st[1] = 0u; }
  }
  grid.sync();
  const XcdBarrier xb = xcd_barrier_post((unsigned*)(fresh_ws(pp0) + OFF_BAR), xb_st);
#define GSYNC() xcd_barrier(xb)
  phase_ada(pp, bid, nb, dyn_smem);
  phase_convert(pp, 0, 0, bid, nb, dyn_smem);
  GSYNC();
#define LAYER(LV, LAST)                                      \
  {                                                          \
    if ((LV) == 0) { phase_prenorm(pp, opq(LV), bid, nb); GSYNC(); } \
    phase_gemm_in(pp, opq(LV), bid, nb, dyn_smem);           \
    GSYNC();                                                 \
    phase_prep(pp, opq(LV), bid, nb, dyn_smem);              \
    GSYNC();                                                 \
    phase_chunk_prep(pp, bid, nb, dyn_smem);                 \
    GSYNC();                                                 \
    phase_mix(pp, opq(LV), bid, nb, dyn_smem);               \
    GSYNC();                                                 \
    phase_post(pp, opq(LV), bid, nb);                        \
    GSYNC();                                                 \
    phase_gemm_out(pp, opq(LV), bid, nb, dyn_smem);          \
    GSYNC();                                                 \
    phase_router(pp, opq(LV), bid, nb, dyn_smem);            \
    GSYNC();                                                 \
    phase_slotfill(pp, opq(LV), bid, nb, dyn_smem);          \
    GSYNC();                                                 \
    phase_moe1_impl(pp, opq(LV), bid, nb, dyn_smem, toff_s); \
    GSYNC();                                                 \
    phase_moe2_impl(pp, opq(LV), bid, nb, dyn_smem, toff_s); \
    GSYNC();                                                 \
    phase_combine(pp, opq(LV), bid, nb);                     \
    if (!(LAST)) GSYNC();                                    \
  }
  LAYER(0, false)
  LAYER(1, true)
#undef LAYER
#undef GSYNC
#undef bid
#undef nb
#undef pp
}

#undef p
extern "C" void kernel_launch(void* const* d_in, const int* in_sizes, int n_in, void* d_out, int out_size, void* d_ws,
                              size_t ws_size, hipStream_t stream) {
  Params hp{};
  const float** pp = (const float**)&hp;
  for (int i = 0; i < 34; ++i) pp[i] = (const float*)d_in[i];
  hp.out = (float*)d_out;
  hp.ws = (char*)d_ws;
  static int grid_blocks = 0;
  if (!grid_blocks) {
    (void)hipFuncSetAttribute((const void*)mega, hipFuncAttributeMaxDynamicSharedMemorySize, LDS_BYTES);
    int dev = 0, cus = 0, per_cu = 0;
    (void)hipGetDevice(&dev);
    (void)hipDeviceGetAttribute(&cus, hipDeviceAttributeMultiprocessorCount, dev);
    (void)hipOccupancyMaxActiveBlocksPerMultiprocessor(&per_cu, mega, NTHR, LDS_BYTES);
    if (per_cu < 1) per_cu = 1;
    if (per_cu > 1) per_cu = 1;
    grid_blocks = cus * per_cu;
  }
  void* args[] = {&hp};
  (void)hipLaunchCooperativeKernel((void*)mega, dim3(grid_blocks), dim3(NTHR), args, LDS_BYTES, stream);
}
```
